# Optimizing an MI355X kernel written in HIP

```python
import math
import jax, jax.numpy as jnp
from jax import lax
import numpy as np


D_MODEL = 1024
BATCH = 8
SEQ = 4096
DEPTH = 1

A_HEADS = 8
A_HEAD_DIM = 64
A_WIDTH = A_HEADS * A_HEAD_DIM
IDX_HEADS = 16
IDX_DIM = 32
TOPK_MAX = 256
QBLK = 128
REL_BUCKETS = 32
REL_MAX_DIST = 128
G_HEADS = 4
G_DK = 64
G_DV = 128
G_KW = G_HEADS * G_DK
G_VW = G_HEADS * G_DV
G_RANK = 16
G_TAU = 16.0
G_CHUNK = 64
N_GROUPS = 4
EXPERTS_PER_GROUP = 8
N_EXPERTS = N_GROUPS * EXPERTS_PER_GROUP
EXPERT_TOP_K = 2
D_EXPERT = 256
DN_ALPHA = (2.0 * DEPTH) ** 0.25
DN_BETA = (8.0 * DEPTH) ** -0.25
LN_EPS = 1e-5

SPLIT_SIZES = (A_WIDTH, A_WIDTH, A_WIDTH, IDX_HEADS * IDX_DIM, IDX_DIM, IDX_HEADS,
               G_KW, G_KW, G_VW, G_VW, G_RANK, D_MODEL, D_MODEL)
VALUE_SEGMENTS = (2, 8)
SPLIT_OFFSETS = tuple(int(v) for v in np.cumsum(SPLIT_SIZES)[:-1])
D_IN_PROJ = int(sum(SPLIT_SIZES))

kernel_name = "hybrid_dsa_gla_hmoe_deepnorm_adaln"


def layer_norm(x, g=None, b=None):
    xf = x.astype(jnp.float32)
    mu = jnp.mean(xf, axis=-1, keepdims=True)
    var = jnp.mean(jnp.square(xf - mu), axis=-1, keepdims=True)
    y = (xf - mu) * lax.rsqrt(var + LN_EPS)
    if g is not None:
        y = y * g.astype(jnp.float32) + b.astype(jnp.float32)
    return y.astype(x.dtype)


def modulate(x, shift, scale):
    return layer_norm(x) * (1.0 + scale[:, None, :]) + shift[:, None, :]


def t5_bucket(dist):
    max_exact = REL_BUCKETS // 2
    d_f = jnp.maximum(dist, 1).astype(jnp.float32)
    large = max_exact + (jnp.log(d_f / max_exact) / math.log(REL_MAX_DIST / max_exact)
                         * (REL_BUCKETS - max_exact)).astype(jnp.int32)
    large = jnp.minimum(large, REL_BUCKETS - 1)
    return jnp.where(dist < max_exact, dist, large)


def dsa_sparse_attention(q, k, v, iq, ik, iw, rel_bias):
    B, S, H, Dh = q.shape
    topk = min(TOPK_MAX, S // 4)
    n_blk = S // QBLK
    scale = Dh ** -0.5
    iw = iw * (IDX_HEADS ** -0.5 * IDX_DIM ** -0.5)
    key_pos = jnp.arange(S, dtype=jnp.int32)
    gather = jax.vmap(lambda arr, idx: arr[idx])

    def block(i):
        q0 = i * QBLK
        qb = lax.dynamic_slice_in_dim(q, q0, QBLK, axis=1)
        iqb = lax.dynamic_slice_in_dim(iq, q0, QBLK, axis=1)
        iwb = lax.dynamic_slice_in_dim(iw, q0, QBLK, axis=1)
        q_pos = q0 + jnp.arange(QBLK, dtype=jnp.int32)
        idx_logits = jnp.einsum('bqhd,bsd->bqhs', iqb, ik)
        score = jnp.einsum('bqh,bqhs->bqs', iwb, jax.nn.relu(idx_logits)).astype(jnp.float32)
        causal = key_pos[None, :] <= q_pos[:, None]
        score = jnp.where(causal[None], score, -jnp.inf)
        _, sel = lax.top_k(score, topk)
        valid = sel <= q_pos[None, :, None]
        k_sel = gather(k, sel)
        v_sel = gather(v, sel)
        logits = jnp.einsum('bqhd,bqkhd->bhqk', qb, k_sel).astype(jnp.float32) * scale
        bucket = t5_bucket(jnp.maximum(q_pos[None, :, None] - sel, 0))
        bias = rel_bias[bucket]
        logits = logits + jnp.transpose(bias, (0, 3, 1, 2)).astype(jnp.float32)
        logits = jnp.where(valid[:, None], logits, -jnp.inf)
        p = jax.nn.softmax(logits, axis=-1).astype(v.dtype)
        return jnp.einsum('bhqk,bqkhd->bqhd', p, v_sel)

    out = lax.map(block, jnp.arange(n_blk, dtype=jnp.int32))
    return jnp.transpose(out, (1, 0, 2, 3, 4)).reshape(B, S, H, Dh)


def gla_chunked(q, k, v, log_g):
    B, S, H, Dk = q.shape
    Dv = v.shape[-1]
    C = G_CHUNK
    N = S // C

    def chunks(t):
        return jnp.transpose(t.astype(jnp.float32).reshape(B, N, C, H, -1), (0, 3, 1, 2, 4))

    qc = chunks(q) * (Dk ** -0.5)
    kc = chunks(k)
    vc = chunks(v)
    b = jnp.cumsum(chunks(log_g), axis=3)
    b_last = b[:, :, :, -1:, :]
    q_in = qc * jnp.exp(b)
    k_st = kc * jnp.exp(b_last - b)
    q_rel = qc * jnp.exp(b - b_last)
    tril = jnp.tril(jnp.ones((C, C), dtype=bool))
    att = jnp.einsum('bhncd,bhnjd->bhncj', q_rel, k_st)
    att = jnp.where(tril, att, 0.0)
    o_intra = jnp.einsum('bhncj,bhnje->bhnce', att, vc)
    u = jnp.einsum('bhncd,bhnce->bhnde', k_st, vc)
    decay = jnp.exp(b_last[:, :, :, 0, :])

    def step(state, inp):
        dec, uu = inp
        return dec[..., None] * state + uu, state

    _, s_prev = lax.scan(step, jnp.zeros((B, H, Dk, Dv), jnp.float32),
                         (jnp.moveaxis(decay, 2, 0), jnp.moveaxis(u, 2, 0)))
    s_prev = jnp.moveaxis(s_prev, 0, 2)
    o_inter = jnp.einsum('bhncd,bhnde->bhnce', q_in, s_prev)
    o = o_intra + o_inter
    return jnp.transpose(o, (0, 2, 3, 1, 4)).reshape(B, S, H, Dv)


def hier_moe(h, w_rg, b_rg, w_re, b_re, w1, w3, w2):
    B, S, D = h.shape
    t = h.reshape(B * S, D)
    g_prob = jax.nn.softmax((t @ w_rg + b_rg).astype(jnp.float32), axis=-1)
    g_w, g_idx = lax.top_k(g_prob, 1)
    e_logits = (t @ w_re + b_re).astype(jnp.float32).reshape(B * S, N_GROUPS, EXPERTS_PER_GROUP)
    g_onehot = jax.nn.one_hot(g_idx[:, 0], N_GROUPS, dtype=jnp.float32)
    e_in_group = jnp.einsum('tg,tge->te', g_onehot, e_logits)
    e_top, e_idx = lax.top_k(e_in_group, EXPERT_TOP_K)
    e_w = jax.nn.softmax(e_top, axis=-1) * g_w
    expert_id = g_idx * EXPERTS_PER_GROUP + e_idx
    gate = jnp.sum(jax.nn.one_hot(expert_id, N_EXPERTS, dtype=jnp.float32) * e_w[..., None], axis=1)
    gate = gate.astype(h.dtype)
    y = jnp.zeros_like(t)
    for e in range(N_EXPERTS):
        hid = jax.nn.silu(t @ w1[e]) * (t @ w3[e])
        y = y + gate[:, e:e + 1] * (hid @ w2[e])
    return y.reshape(B, S, D)


def setup_inputs(seed: int = 0) -> dict:
    key = jax.random.key(seed)
    ks = jax.random.split(key, 24)
    f32 = jnp.float32
    D = D_MODEL
    nrm = lambda k, shape, s: jax.random.normal(k, shape, f32) * s
    col_scale = jnp.concatenate([jnp.full((n,), DN_BETA if i in VALUE_SEGMENTS else 1.0, f32)
                                 for i, n in enumerate(SPLIT_SIZES)])
    return {
        'x': nrm(ks[0], (BATCH, SEQ, D), 1.0),
        'c': nrm(ks[1], (BATCH, D), 1.0),
        'rel_bias': nrm(ks[2], (REL_BUCKETS, A_HEADS), 0.5),
        'w_ada': nrm(ks[3], (DEPTH, D, 6 * D), 0.5 * D ** -0.5),
        'b_ada': nrm(ks[4], (DEPTH, 6 * D), 0.01),
        'w_in': nrm(ks[5], (DEPTH, D, D_IN_PROJ), D ** -0.5) * col_scale,
        'gla_w_gate': nrm(ks[6], (DEPTH, G_RANK, G_KW), G_RANK ** -0.5),
        'gla_b_gate': nrm(ks[7], (DEPTH, G_KW), 0.1),
        'gla_norm_g': 1.0 + nrm(ks[8], (DEPTH, G_VW), 0.02),
        'w_branch_a': nrm(ks[9], (DEPTH, A_WIDTH, D), A_WIDTH ** -0.5 * DN_BETA),
        'w_branch_b': nrm(ks[10], (DEPTH, G_VW, D), G_VW ** -0.5 * DN_BETA),
        'w_out': nrm(ks[11], (DEPTH, D, D), D ** -0.5 * DN_BETA),
        'ln1_g': 1.0 + nrm(ks[12], (DEPTH, D), 0.02),
        'ln1_b': nrm(ks[13], (DEPTH, D), 0.02),
        'w_router_group': nrm(ks[14], (DEPTH, D, N_GROUPS), D ** -0.5),
        'b_router_group': nrm(ks[15], (DEPTH, N_GROUPS), 0.01),
        'w_router_expert': nrm(ks[16], (DEPTH, D, N_EXPERTS), D ** -0.5),
        'b_router_expert': nrm(ks[17], (DEPTH, N_EXPERTS), 0.01),
        'w_exp_gate': nrm(ks[18], (DEPTH, N_EXPERTS, D, D_EXPERT), D ** -0.5),
        'w_exp_up': nrm(ks[19], (DEPTH, N_EXPERTS, D, D_EXPERT), D ** -0.5),
        'w_exp_down': nrm(ks[20], (DEPTH, N_EXPERTS, D_EXPERT, D), D_EXPERT ** -0.5 * DN_BETA),
        'ln2_g': 1.0 + nrm(ks[21], (DEPTH, D), 0.02),
        'ln2_b': nrm(ks[22], (DEPTH, D), 0.02),
    }


def reference(x, c, rel_bias, w_ada, b_ada, w_in, gla_w_gate, gla_b_gate, gla_norm_g,
              w_branch_a, w_branch_b, w_out, ln1_g, ln1_b, w_router_group, b_router_group,
              w_router_expert, b_router_expert, w_exp_gate, w_exp_up, w_exp_down, ln2_g, ln2_b):
    B, S, D = x.shape
    cond = jax.nn.silu(c)
    for l in range(DEPTH):
        ada = cond @ w_ada[l] + b_ada[l]
        sh1, sc1, gt1, sh2, sc2, gt2 = jnp.split(ada, 6, axis=-1)
        h = modulate(x, sh1, sc1)
        proj = h @ w_in[l]
        (aq, ak, av, iq, ik, iw, gq, gk, gv, gr, glr, gate_a, gate_b) = jnp.split(proj, SPLIT_OFFSETS, axis=-1)
        o_a = dsa_sparse_attention(aq.reshape(B, S, A_HEADS, A_HEAD_DIM),
                                   ak.reshape(B, S, A_HEADS, A_HEAD_DIM),
                                   av.reshape(B, S, A_HEADS, A_HEAD_DIM),
                                   iq.reshape(B, S, IDX_HEADS, IDX_DIM), ik, iw,
                                   rel_bias).reshape(B, S, A_WIDTH)
        log_g = jax.nn.log_sigmoid((glr @ gla_w_gate[l] + gla_b_gate[l]).astype(jnp.float32)) / G_TAU
        o_b = gla_chunked(gq.reshape(B, S, G_HEADS, G_DK), gk.reshape(B, S, G_HEADS, G_DK),
                          gv.reshape(B, S, G_HEADS, G_DV), log_g.reshape(B, S, G_HEADS, G_DK))
        o_b = (layer_norm(o_b) * gla_norm_g[l].reshape(G_HEADS, G_DV).astype(jnp.float32)).astype(x.dtype)
        o_b = (o_b * jax.nn.silu(gr.reshape(B, S, G_HEADS, G_DV))).reshape(B, S, G_VW)
        merged = (jax.nn.sigmoid(gate_a) * (o_a @ w_branch_a[l])
                  + jax.nn.sigmoid(gate_b) * (o_b @ w_branch_b[l]))
        y = merged @ w_out[l]
        x = layer_norm(DN_ALPHA * x + gt1[:, None, :] * y, ln1_g[l], ln1_b[l])
        h2 = modulate(x, sh2, sc2)
        f = hier_moe(h2, w_router_group[l], b_router_group[l], w_router_expert[l], b_router_expert[l],
                     w_exp_gate[l], w_exp_up[l], w_exp_down[l])
        x = layer_norm(DN_ALPHA * x + gt2[:, None, :] * f, ln2_g[l], ln2_b[l])
    return x
```

```cpp
#include <hip/hip_runtime.h>
#include <hip/hip_cooperative_groups.h>
#include <cstdio>
#include <cstdint>
#include <cstring>
#include <cmath>
#ifdef HOST_EMU
#include <cmath>
#include <cstdio>
#include <cstdlib>
#include <cstring>
#include <cstdint>
struct Dim3e { int x, y, z; };
static thread_local Dim3e threadIdx, blockIdx, blockDim, gridDim;
#define __global__
#define __device__
#define __host__
#define __forceinline__ inline
#define __launch_bounds__(...)
typedef void* hipStream_t;
template <class F, class... A> static void host_launch(F f, long nb, int nt, A... a) {
#pragma omp parallel for schedule(dynamic, 4)
    for (long b = 0; b < nb; ++b) {
        blockIdx = {(int)b, 0, 0}; blockDim = {nt, 1, 1}; gridDim = {(int)nb, 1, 1};
        for (int t = 0; t < nt; ++t) { threadIdx = {t, 0, 0}; f(a...); }
    }
}
#define LAUNCH(k, nb, nt, st, ...) host_launch(k, (long)(nb), (int)(nt), __VA_ARGS__)
#define UNROLL
#else
#define LAUNCH(k, nb, nt, st, ...) hipLaunchKernelGGL(k, dim3((unsigned)(nb)), dim3((unsigned)(nt)), 0, st, __VA_ARGS__)
#endif

constexpr int D_MODEL = 1024, A_HEADS = 8, A_HD = 64, A_W = 512, I_HEADS = 16, I_DIM = 32, TOPK_MAX = 256, REL_B = 32,
              G_HEADS = 4, G_DK = 64, G_DV = 128, G_KW = 256, G_VW = 512, G_RANK = 16, N_GROUPS = 4, EPG = 8, N_EXP = 32, D_EXP = 256;
constexpr int O_AQ = 0, O_AK = 512, O_AV = 1024, O_IQ = 1536, O_IK = 2048, O_IW = 2080, O_GQ = 2096, O_GK = 2352, O_GV = 2608, O_GR = 3120,
              O_GLR = 3632, O_GA = 3648, O_GB = 4672, D_IN = 5696;
constexpr float DN_ALPHA = 1.189207115002721f, LN_EPS = 1e-5f;
#define V0_GID long gid = (long)blockIdx.x * blockDim.x + threadIdx.x

__device__ __forceinline__ float v0_silu(float v) { return v / (1.f + expf(-v)); }
__device__ __forceinline__ float v0_sigmoid(float v) { return 1.f / (1.f + expf(-v)); }

__global__ void k0_ada(const float* c, const float* w_ada, const float* b_ada, float* ada, int B) {
    V0_GID; if (gid >= (long)B * 6 * D_MODEL) return;
    const int b = (int)(gid / (6 * D_MODEL)), j = (int)(gid % (6 * D_MODEL));
    float acc = 0.f;
    for (int i = 0; i < D_MODEL; ++i) acc += v0_silu(c[b * D_MODEL + i]) * w_ada[(size_t)i * 6 * D_MODEL + j];
    ada[gid] = acc + b_ada[j];
}
__global__ void k0_lnmod(const float* x, const float* sh, const float* sc, float* h, int nrows) {
    V0_GID; if (gid >= nrows) return;
    const float* xr = x + (size_t)gid * D_MODEL; float* hr = h + (size_t)gid * D_MODEL;
    float mu = 0.f; for (int k = 0; k < D_MODEL; ++k) mu += xr[k]; mu *= (1.f / D_MODEL);
    float var = 0.f; for (int k = 0; k < D_MODEL; ++k) { const float d = xr[k] - mu; var += d * d; } var *= (1.f / D_MODEL);
    const float rs = 1.f / sqrtf(var + LN_EPS);
    for (int k = 0; k < D_MODEL; ++k) hr[k] = (xr[k] - mu) * rs * (1.f + sc[k]) + sh[k];
}
__global__ void k0_gemm(const float* A, int lda, const float* W, int ldw, float* C, int ldc, int M, int N, int K) {
    V0_GID; if (gid >= (long)(M / 4) * N) return;
    const int n = (int)(gid % N); const int m0 = (int)(gid / N) * 4;
    float a0 = 0.f, a1 = 0.f, a2 = 0.f, a3 = 0.f;
    const float* A0 = A + (size_t)m0 * lda;
    for (int k = 0; k < K; ++k) { const float w = W[(size_t)k * ldw + n]; a0 += A0[k] * w; a1 += A0[lda + k] * w; a2 += A0[2 * lda + k] * w; a3 += A0[3 * lda + k] * w; }
    C[(size_t)m0 * ldc + n] = a0; C[(size_t)(m0 + 1) * ldc + n] = a1; C[(size_t)(m0 + 2) * ldc + n] = a2; C[(size_t)(m0 + 3) * ldc + n] = a3;
}
__global__ void k0_scores(const float* P, float* scT, int S) {
    V0_GID; if (gid >= (long)S * S) return;
    const int t = (int)(gid % S), s = (int)(gid / S);
    if (s > t) { scT[gid] = -INFINITY; return; }
    const float* iq = P + (size_t)t * D_IN + O_IQ; const float* ik = P + (size_t)s * D_IN + O_IK; const float* iw = P + (size_t)t * D_IN + O_IW;
    const float cst = 0.044194173824159216f;
    float sc = 0.f;
    for (int h = 0; h < I_HEADS; ++h) { float d = 0.f; for (int k = 0; k < I_DIM; ++k) d += iq[h * I_DIM + k] * ik[k]; sc += (iw[h] * cst) * fmaxf(d, 0.f); }
    scT[gid] = sc;
}
__device__ __forceinline__ unsigned v0_key(float f) { unsigned u; memcpy(&u, &f, 4); return (u & 0x80000000u) ? ~u : (u | 0x80000000u); }
__global__ void k0_topk(const float* scT, int* sel, int* cnt, int S, int topk) {
    V0_GID; if (gid >= S) return;
    const int t = (int)gid; const int n = t + 1; int* sl = sel + (size_t)t * TOPK_MAX;
    if (n <= topk) { for (int s = 0; s < n; ++s) sl[s] = s; cnt[t] = n; return; }
    unsigned T = 0u;
    for (int bit = 31; bit >= 0; --bit) { const unsigned cand = T | (1u << bit); int c = 0; for (int s = 0; s < n; ++s) c += (v0_key(scT[(size_t)s * S + t]) >= cand) ? 1 : 0; if (c >= topk) T = cand; }
    int cgt = 0; for (int s = 0; s < n; ++s) cgt += (v0_key(scT[(size_t)s * S + t]) > T) ? 1 : 0;
    int need = topk - cgt, j = 0;
    for (int s = 0; s < n; ++s) { const unsigned k = v0_key(scT[(size_t)s * S + t]); if (k > T) sl[j++] = s; else if (k == T && need > 0) { sl[j++] = s; --need; } }
    cnt[t] = j;
}
__device__ __forceinline__ int v0_bucket(int d) {
    if (d < 16) return d;
    const float df = (float)d; int large = 16 + (int)(logf(df / 16.f) / 2.0794415416798357f * 16.f);
    return large < 31 ? large : 31;
}
__global__ void __launch_bounds__(256) k0_attn(const float* P, const int* sel, const int* cnt, const float* rel_bias, float* oa, int S) {
    V0_GID; if (gid >= (long)S * A_HEADS) return;
    const int t = (int)(gid / A_HEADS), h = (int)(gid % A_HEADS); const int n = cnt[t]; const int* sl = sel + (size_t)t * TOPK_MAX;
    const float* q = P + (size_t)t * D_IN + O_AQ + h * A_HD;
    float m = -INFINITY;
    for (int j = 0; j < n; ++j) { const int s = sl[j]; const float* k = P + (size_t)s * D_IN + O_AK + h * A_HD; float d = 0.f; for (int e = 0; e < A_HD; ++e) d += q[e] * k[e];
        const float l = d * 0.125f + rel_bias[v0_bucket(t - s) * A_HEADS + h]; m = fmaxf(m, l); }
    float o[A_HD];
#pragma unroll
    for (int e = 0; e < A_HD; ++e) o[e] = 0.f;
    float sum = 0.f;
    for (int j = 0; j < n; ++j) { const int s = sl[j]; const float* k = P + (size_t)s * D_IN + O_AK + h * A_HD; const float* v = P + (size_t)s * D_IN + O_AV + h * A_HD; float d = 0.f;
        for (int e = 0; e < A_HD; ++e) d += q[e] * k[e];
        const float p = expf(d * 0.125f + rel_bias[v0_bucket(t - s) * A_HEADS + h] - m); sum += p;
#pragma unroll
        for (int e = 0; e < A_HD; ++e) o[e] += p * v[e]; }
    const float inv = 1.f / sum;
#pragma unroll
    for (int e = 0; e < A_HD; ++e) oa[(size_t)t * A_W + h * A_HD + e] = o[e] * inv;
}
__global__ void k0_gate(const float* P, const float* wg, const float* bg, float* lg, int S) {
    V0_GID; if (gid >= (long)S * G_KW) return;
    const int t = (int)(gid / G_KW), j = (int)(gid % G_KW);
    float z = bg[j]; for (int r = 0; r < G_RANK; ++r) z += P[(size_t)t * D_IN + O_GLR + r] * wg[r * G_KW + j];
    lg[gid] = (fminf(z, 0.f) - log1pf(expf(-fabsf(z)))) * (1.f / 16.f);
}
__global__ void __launch_bounds__(64) k0_gla(const float* P, const float* lg, float* oraw, int S) {
    V0_GID; if (gid >= G_HEADS * G_DV) return;
    const int h = (int)(gid / G_DV), dv = (int)(gid % G_DV);
    float st[G_DK];
#pragma unroll
    for (int d = 0; d < G_DK; ++d) st[d] = 0.f;
    for (int t = 0; t < S; ++t) {
        const float* row = P + (size_t)t * D_IN; const float vv = row[O_GV + h * G_DV + dv]; float o = 0.f;
#pragma unroll
        for (int d = 0; d < G_DK; ++d) { const float a = expf(lg[(size_t)t * G_KW + h * G_DK + d]); st[d] = a * st[d] + row[O_GK + h * G_DK + d] * vv; o += row[O_GQ + h * G_DK + d] * st[d]; }
        oraw[(size_t)t * G_VW + h * G_DV + dv] = o * 0.125f;
    }
}
__global__ void k0_gla_post(const float* P, const float* oraw, const float* ng, float* ob, int S) {
    V0_GID; if (gid >= (long)S * G_HEADS) return;
    const int t = (int)(gid / G_HEADS), h = (int)(gid % G_HEADS); const float* o = oraw + (size_t)t * G_VW + h * G_DV;
    float mu = 0.f; for (int e = 0; e < G_DV; ++e) mu += o[e]; mu *= (1.f / G_DV);
    float var = 0.f; for (int e = 0; e < G_DV; ++e) { const float d = o[e] - mu; var += d * d; } var *= (1.f / G_DV);
    const float rs = 1.f / sqrtf(var + LN_EPS);
    for (int e = 0; e < G_DV; ++e) ob[(size_t)t * G_VW + h * G_DV + e] = (o[e] - mu) * rs * ng[h * G_DV + e] * v0_silu(P[(size_t)t * D_IN + O_GR + h * G_DV + e]);
}
__global__ void k0_merge(const float* P, const float* ba, const float* bb, float* mg, int S) {
    V0_GID; if (gid >= (long)S * D_MODEL) return;
    const int t = (int)(gid / D_MODEL), n = (int)(gid % D_MODEL);
    mg[gid] = v0_sigmoid(P[(size_t)t * D_IN + O_GA + n]) * ba[gid] + v0_sigmoid(P[(size_t)t * D_IN + O_GB + n]) * bb[gid];
}
__global__ void k0_ln1(const float* x, const float* y, const float* gt1, const float* g1, const float* b1, const float* sh2, const float* sc2, float* x1, float* h2, int nrows) {
    V0_GID; if (gid >= nrows) return;
    const float* xr = x + (size_t)gid * D_MODEL; const float* yr = y + (size_t)gid * D_MODEL; float* x1r = x1 + (size_t)gid * D_MODEL; float* h2r = h2 + (size_t)gid * D_MODEL;
    float mu = 0.f; for (int k = 0; k < D_MODEL; ++k) mu += DN_ALPHA * xr[k] + gt1[k] * yr[k]; mu *= (1.f / D_MODEL);
    float var = 0.f; for (int k = 0; k < D_MODEL; ++k) { const float d = DN_ALPHA * xr[k] + gt1[k] * yr[k] - mu; var += d * d; } var *= (1.f / D_MODEL);
    float rs = 1.f / sqrtf(var + LN_EPS);
    for (int k = 0; k < D_MODEL; ++k) x1r[k] = (DN_ALPHA * xr[k] + gt1[k] * yr[k] - mu) * rs * g1[k] + b1[k];
    mu = 0.f; for (int k = 0; k < D_MODEL; ++k) mu += x1r[k]; mu *= (1.f / D_MODEL);
    var = 0.f; for (int k = 0; k < D_MODEL; ++k) { const float d = x1r[k] - mu; var += d * d; } var *= (1.f / D_MODEL);
    rs = 1.f / sqrtf(var + LN_EPS);
    for (int k = 0; k < D_MODEL; ++k) h2r[k] = (x1r[k] - mu) * rs * (1.f + sc2[k]) + sh2[k];
}
__global__ void k0_route(const float* rl, const float* brg, const float* bre, int* eid, float* ew, int nrows) {
    V0_GID; if (gid >= nrows) return;
    const float* r = rl + (size_t)gid * 36;
    float gl[N_GROUPS]; float gm = -INFINITY; int gi = 0;
#pragma unroll
    for (int g = 0; g < N_GROUPS; ++g) { gl[g] = r[g] + brg[g]; if (gl[g] > gm) { gm = gl[g]; gi = g; } }
    float gs = 0.f;
#pragma unroll
    for (int g = 0; g < N_GROUPS; ++g) gs += expf(gl[g] - gm);
    const float gw = 1.f / gs;
    float v0 = -INFINITY, v1 = -INFINITY; int i0 = 0, i1 = 0;
    for (int e = 0; e < EPG; ++e) { const float v = r[4 + gi * EPG + e] + bre[gi * EPG + e];
        if (v > v0) { v1 = v0; i1 = i0; v0 = v; i0 = e; } else if (v > v1) { v1 = v; i1 = e; } }
    const float e1 = expf(v1 - v0); const float w0 = 1.f / (1.f + e1), w1 = e1 / (1.f + e1);
    eid[gid * 2] = gi * EPG + i0; eid[gid * 2 + 1] = gi * EPG + i1; ew[gid * 2] = w0 * gw; ew[gid * 2 + 1] = w1 * gw;
}
__global__ void k0_moe_hid(const float* h2, const int* eid, const float* w1, const float* w3, float* hid, int nrows) {
    V0_GID; if (gid >= (long)nrows * 2 * D_EXP) return;
    const int j = (int)(gid % D_EXP); const long ts = gid / D_EXP; const int t = (int)(ts / 2); const int e = eid[ts];
    const float* hr = h2 + (size_t)t * D_MODEL; const float* a = w1 + (size_t)e * D_MODEL * D_EXP + j; const float* b = w3 + (size_t)e * D_MODEL * D_EXP + j;
    float g = 0.f, u = 0.f; for (int k = 0; k < D_MODEL; ++k) { g += hr[k] * a[(size_t)k * D_EXP]; u += hr[k] * b[(size_t)k * D_EXP]; }
    hid[gid] = v0_silu(g) * u;
}
__global__ void k0_moe_out(const float* hid, const int* eid, const float* ew, const float* w2, float* f, int nrows) {
    V0_GID; if (gid >= (long)nrows * D_MODEL) return;
    const int n = (int)(gid % D_MODEL); const int t = (int)(gid / D_MODEL); float acc = 0.f;
    for (int sl = 0; sl < 2; ++sl) { const int e = eid[t * 2 + sl]; const float* hr = hid + ((size_t)t * 2 + sl) * D_EXP; const float* w = w2 + (size_t)e * D_EXP * D_MODEL + n; float a = 0.f;
        for (int j = 0; j < D_EXP; ++j) a += hr[j] * w[(size_t)j * D_MODEL]; acc += ew[t * 2 + sl] * a; }
    f[gid] = acc;
}
__global__ void k0_final(const float* x1, const float* f, const float* gt2, const float* g2, const float* b2, float* out, int nrows) {
    V0_GID; if (gid >= nrows) return;
    const float* xr = x1 + (size_t)gid * D_MODEL; const float* fr = f + (size_t)gid * D_MODEL; float* o = out + (size_t)gid * D_MODEL;
    float mu = 0.f; for (int k = 0; k < D_MODEL; ++k) mu += DN_ALPHA * xr[k] + gt2[k] * fr[k]; mu *= (1.f / D_MODEL);
    float var = 0.f; for (int k = 0; k < D_MODEL; ++k) { const float d = DN_ALPHA * xr[k] + gt2[k] * fr[k] - mu; var += d * d; } var *= (1.f / D_MODEL);
    const float rs = 1.f / sqrtf(var + LN_EPS);
    for (int k = 0; k < D_MODEL; ++k) o[k] = (DN_ALPHA * xr[k] + gt2[k] * fr[k] - mu) * rs * g2[k] + b2[k];
}

struct V0Buf { float *ada, *h, *P, *scT, *oa, *lg, *oraw, *ob, *ba, *bb, *mg, *y, *x1, *h2, *rl, *ew, *hid, *f; int *sel, *cnt, *eid; size_t bytes; };
static V0Buf v0_carve(void* base, int B, int S) {
    V0Buf b; char* p = (char*)base; auto take = [&](size_t n) { char* r = p; p += (n + 255) & ~(size_t)255; return r; };
    b.ada = (float*)take((size_t)B * 6 * D_MODEL * 4);
    b.P = (float*)take((size_t)S * D_IN * 4);
    b.h = (float*)take((size_t)S * D_MODEL * 4);
    b.scT = (float*)take((size_t)S * S * 4);
    b.sel = (int*)take((size_t)S * TOPK_MAX * 4); b.cnt = (int*)take((size_t)S * 4);
    b.oa = (float*)take((size_t)S * A_W * 4); b.lg = (float*)take((size_t)S * G_KW * 4); b.oraw = (float*)take((size_t)S * G_VW * 4); b.ob = (float*)take((size_t)S * G_VW * 4);
    b.ba = (float*)take((size_t)S * D_MODEL * 4); b.bb = (float*)take((size_t)S * D_MODEL * 4); b.y = (float*)take((size_t)S * D_MODEL * 4);
    b.x1 = (float*)take((size_t)S * D_MODEL * 4); b.h2 = (float*)take((size_t)S * D_MODEL * 4); b.f = (float*)take((size_t)S * D_MODEL * 4);
    b.mg = b.h;
    b.rl = (float*)take((size_t)S * 36 * 4); b.eid = (int*)take((size_t)S * 2 * 4); b.ew = (float*)take((size_t)S * 2 * 4); b.hid = (float*)take((size_t)S * 2 * D_EXP * 4);
    b.bytes = (size_t)(p - (char*)base); return b;
}
static void v0_forward(void* const* d_in, float* out, void* scratch, int B, int S, hipStream_t st, int only_batch = -1) {
    const float *x = (const float*)d_in[0], *c = (const float*)d_in[1], *rel_bias = (const float*)d_in[2], *w_ada = (const float*)d_in[3], *b_ada = (const float*)d_in[4], *w_in = (const float*)d_in[5],
                *wg = (const float*)d_in[6], *bg = (const float*)d_in[7], *ng = (const float*)d_in[8], *wba = (const float*)d_in[9], *wbb = (const float*)d_in[10], *wout = (const float*)d_in[11],
                *g1 = (const float*)d_in[12], *b1 = (const float*)d_in[13], *wrg = (const float*)d_in[14], *brg = (const float*)d_in[15], *wre = (const float*)d_in[16], *bre = (const float*)d_in[17],
                *w1 = (const float*)d_in[18], *w3 = (const float*)d_in[19], *w2 = (const float*)d_in[20], *g2 = (const float*)d_in[21], *b2 = (const float*)d_in[22];
    V0Buf u = v0_carve(scratch, B, S);
    const int TB = 256; auto nb = [&](long n) { return (n + TB - 1) / TB; };
    const int topk = (TOPK_MAX < S / 4) ? TOPK_MAX : S / 4;
    LAUNCH(k0_ada, nb((long)B * 6 * D_MODEL), TB, st, c, w_ada, b_ada, u.ada, B);
    for (int b = 0; b < B; ++b) {
        if (only_batch >= 0 && b != only_batch) continue;
        const float* xb = x + (size_t)b * S * D_MODEL; const float* ad = u.ada + (size_t)b * 6 * D_MODEL;
        const float *sh1 = ad, *sc1 = ad + D_MODEL, *gt1 = ad + 2 * D_MODEL, *sh2 = ad + 3 * D_MODEL, *sc2 = ad + 4 * D_MODEL, *gt2 = ad + 5 * D_MODEL;
        LAUNCH(k0_lnmod, nb(S), TB, st, xb, sh1, sc1, u.h, S);
        LAUNCH(k0_gemm, nb((long)(S / 4) * D_IN), TB, st, (const float*)u.h, D_MODEL, w_in, D_IN, u.P, D_IN, S, D_IN, D_MODEL);
        LAUNCH(k0_scores, nb((long)S * S), TB, st, (const float*)u.P, u.scT, S);
        LAUNCH(k0_topk, nb(S), TB, st, (const float*)u.scT, u.sel, u.cnt, S, topk);
        LAUNCH(k0_attn, nb((long)S * A_HEADS), TB, st, (const float*)u.P, (const int*)u.sel, (const int*)u.cnt, rel_bias, u.oa, S);
        LAUNCH(k0_gate, nb((long)S * G_KW), TB, st, (const float*)u.P, wg, bg, u.lg, S);
        LAUNCH(k0_gla, (G_HEADS * G_DV + 63) / 64, 64, st, (const float*)u.P, (const float*)u.lg, u.oraw, S);
        LAUNCH(k0_gla_post, nb((long)S * G_HEADS), TB, st, (const float*)u.P, (const float*)u.oraw, ng, u.ob, S);
        LAUNCH(k0_gemm, nb((long)(S / 4) * D_MODEL), TB, st, (const float*)u.oa, A_W, wba, D_MODEL, u.ba, D_MODEL, S, D_MODEL, A_W);
        LAUNCH(k0_gemm, nb((long)(S / 4) * D_MODEL), TB, st, (const float*)u.ob, G_VW, wbb, D_MODEL, u.bb, D_MODEL, S, D_MODEL, G_VW);
        LAUNCH(k0_merge, nb((long)S * D_MODEL), TB, st, (const float*)u.P, (const float*)u.ba, (const float*)u.bb, u.mg, S);
        LAUNCH(k0_gemm, nb((long)(S / 4) * D_MODEL), TB, st, (const float*)u.mg, D_MODEL, wout, D_MODEL, u.y, D_MODEL, S, D_MODEL, D_MODEL);
        LAUNCH(k0_ln1, nb(S), TB, st, xb, (const float*)u.y, gt1, g1, b1, sh2, sc2, u.x1, u.h2, S);
        LAUNCH(k0_gemm, nb((long)(S / 4) * N_GROUPS), TB, st, (const float*)u.h2, D_MODEL, wrg, N_GROUPS, u.rl, 36, S, N_GROUPS, D_MODEL);
        LAUNCH(k0_gemm, nb((long)(S / 4) * N_EXP), TB, st, (const float*)u.h2, D_MODEL, wre, N_EXP, u.rl + 4, 36, S, N_EXP, D_MODEL);
        LAUNCH(k0_route, nb(S), TB, st, (const float*)u.rl, brg, bre, u.eid, u.ew, S);
        LAUNCH(k0_moe_hid, nb((long)S * 2 * D_EXP), TB, st, (const float*)u.h2, (const int*)u.eid, w1, w3, u.hid, S);
        LAUNCH(k0_moe_out, nb((long)S * D_MODEL), TB, st, (const float*)u.hid, (const int*)u.eid, (const float*)u.ew, w2, u.f, S);
        LAUNCH(k0_final, nb(S), TB, st, (const float*)u.x1, (const float*)u.f, gt2, g2, b2, out + (size_t)b * S * D_MODEL, S);
    }
}
extern "C" void kernel_launch(void* const* d_in, const int* in_sizes, int n_in, void* d_out, int out_size,
                              void* d_ws, size_t ws_size, hipStream_t stream) {
    v0_forward(d_in, (float*)d_out, d_ws, 8, 4096, stream);
}
```

```cpp
#include <hip/hip_runtime.h>
#include <hip/hip_cooperative_groups.h>
#include <cstdio>
#include <cstdint>
#include <cstring>
#include <cmath>
#ifdef HOST_EMU
#include <cmath>
#include <cstdio>
#include <cstdlib>
#include <cstring>
#include <cstdint>
struct Dim3e { int x, y, z; };
static thread_local Dim3e threadIdx, blockIdx, blockDim, gridDim;
#define __global__
#define __device__
#define __host__
#define __forceinline__ inline
#define __launch_bounds__(...)
typedef void* hipStream_t;
template <class F, class... A> static void host_launch(F f, long nb, int nt, A... a) {
#pragma omp parallel for schedule(dynamic, 4)
    for (long b = 0; b < nb; ++b) {
        blockIdx = {(int)b, 0, 0}; blockDim = {nt, 1, 1}; gridDim = {(int)nb, 1, 1};
        for (int t = 0; t < nt; ++t) { threadIdx = {t, 0, 0}; f(a...); }
    }
}
#define LAUNCH(k, nb, nt, st, ...) host_launch(k, (long)(nb), (int)(nt), __VA_ARGS__)
#define UNROLL
#else
#define LAUNCH(k, nb, nt, st, ...) hipLaunchKernelGGL(k, dim3((unsigned)(nb)), dim3((unsigned)(nt)), 0, st, __VA_ARGS__)
#endif

constexpr int D_MODEL = 1024, A_HEADS = 8, A_HD = 64, A_W = 512, I_HEADS = 16, I_DIM = 32, TOPK_MAX = 256, REL_B = 32,
              G_HEADS = 4, G_DK = 64, G_DV = 128, G_KW = 256, G_VW = 512, G_RANK = 16, N_GROUPS = 4, EPG = 8, N_EXP = 32, D_EXP = 256;
constexpr int O_AQ = 0, O_AK = 512, O_AV = 1024, O_IQ = 1536, O_IK = 2048, O_IW = 2080, O_GQ = 2096, O_GK = 2352, O_GV = 2608, O_GR = 3120,
              O_GLR = 3632, O_GA = 3648, O_GB = 4672, D_IN = 5696;
constexpr float DN_ALPHA = 1.189207115002721f, LN_EPS = 1e-5f;
#define V0_GID long gid = (long)blockIdx.x * blockDim.x + threadIdx.x

__device__ __forceinline__ float v0_silu(float v) { return v / (1.f + expf(-v)); }
__device__ __forceinline__ float v0_sigmoid(float v) { return 1.f / (1.f + expf(-v)); }

__global__ void k0_ada(const float* c, const float* w_ada, const float* b_ada, float* ada, int B) {
    V0_GID; if (gid >= (long)B * 6 * D_MODEL) return;
    const int b = (int)(gid / (6 * D_MODEL)), j = (int)(gid % (6 * D_MODEL));
    float acc = 0.f;
    for (int i = 0; i < D_MODEL; ++i) acc += v0_silu(c[b * D_MODEL + i]) * w_ada[(size_t)i * 6 * D_MODEL + j];
    ada[gid] = acc + b_ada[j];
}
__global__ void k0_lnmod(const float* x, const float* sh, const float* sc, float* h, int nrows) {
    V0_GID; if (gid >= nrows) return;
    const float* xr = x + (size_t)gid * D_MODEL; float* hr = h + (size_t)gid * D_MODEL;
    float mu = 0.f; for (int k = 0; k < D_MODEL; ++k) mu += xr[k]; mu *= (1.f / D_MODEL);
    float var = 0.f; for (int k = 0; k < D_MODEL; ++k) { const float d = xr[k] - mu; var += d * d; } var *= (1.f / D_MODEL);
    const float rs = 1.f / sqrtf(var + LN_EPS);
    for (int k = 0; k < D_MODEL; ++k) hr[k] = (xr[k] - mu) * rs * (1.f + sc[k]) + sh[k];
}
__global__ void k0_gemm(const float* A, int lda, const float* W, int ldw, float* C, int ldc, int M, int N, int K) {
    V0_GID; if (gid >= (long)(M / 4) * N) return;
    const int n = (int)(gid % N); const int m0 = (int)(gid / N) * 4;
    float a0 = 0.f, a1 = 0.f, a2 = 0.f, a3 = 0.f;
    const float* A0 = A + (size_t)m0 * lda;
    for (int k = 0; k < K; ++k) { const float w = W[(size_t)k * ldw + n]; a0 += A0[k] * w; a1 += A0[lda + k] * w; a2 += A0[2 * lda + k] * w; a3 += A0[3 * lda + k] * w; }
    C[(size_t)m0 * ldc + n] = a0; C[(size_t)(m0 + 1) * ldc + n] = a1; C[(size_t)(m0 + 2) * ldc + n] = a2; C[(size_t)(m0 + 3) * ldc + n] = a3;
}
__global__ void k0_scores(const float* P, float* scT, int S) {
    V0_GID; if (gid >= (long)S * S) return;
    const int t = (int)(gid % S), s = (int)(gid / S);
    if (s > t) { scT[gid] = -INFINITY; return; }
    const float* iq = P + (size_t)t * D_IN + O_IQ; const float* ik = P + (size_t)s * D_IN + O_IK; const float* iw = P + (size_t)t * D_IN + O_IW;
    const float cst = 0.044194173824159216f;
    float sc = 0.f;
    for (int h = 0; h < I_HEADS; ++h) { float d = 0.f; for (int k = 0; k < I_DIM; ++k) d += iq[h * I_DIM + k] * ik[k]; sc += (iw[h] * cst) * fmaxf(d, 0.f); }
    scT[gid] = sc;
}
__device__ __forceinline__ unsigned v0_key(float f) { unsigned u; memcpy(&u, &f, 4); return (u & 0x80000000u) ? ~u : (u | 0x80000000u); }
__global__ void k0_topk(const float* scT, int* sel, int* cnt, int S, int topk) {
    V0_GID; if (gid >= S) return;
    const int t = (int)gid; const int n = t + 1; int* sl = sel + (size_t)t * TOPK_MAX;
    if (n <= topk) { for (int s = 0; s < n; ++s) sl[s] = s; cnt[t] = n; return; }
    unsigned T = 0u;
    for (int bit = 31; bit >= 0; --bit) { const unsigned cand = T | (1u << bit); int c = 0; for (int s = 0; s < n; ++s) c += (v0_key(scT[(size_t)s * S + t]) >= cand) ? 1 : 0; if (c >= topk) T = cand; }
    int cgt = 0; for (int s = 0; s < n; ++s) cgt += (v0_key(scT[(size_t)s * S + t]) > T) ? 1 : 0;
    int need = topk - cgt, j = 0;
    for (int s = 0; s < n; ++s) { const unsigned k = v0_key(scT[(size_t)s * S + t]); if (k > T) sl[j++] = s; else if (k == T && need > 0) { sl[j++] = s; --need; } }
    cnt[t] = j;
}
__device__ __forceinline__ int v0_bucket(int d) {
    if (d < 16) return d;
    const float df = (float)d; int large = 16 + (int)(logf(df / 16.f) / 2.0794415416798357f * 16.f);
    return large < 31 ? large : 31;
}
__global__ void __launch_bounds__(256) k0_attn(const float* P, const int* sel, const int* cnt, const float* rel_bias, float* oa, int S) {
    V0_GID; if (gid >= (long)S * A_HEADS) return;
    const int t = (int)(gid / A_HEADS), h = (int)(gid % A_HEADS); const int n = cnt[t]; const int* sl = sel + (size_t)t * TOPK_MAX;
    const float* q = P + (size_t)t * D_IN + O_AQ + h * A_HD;
    float m = -INFINITY;
    for (int j = 0; j < n; ++j) { const int s = sl[j]; const float* k = P + (size_t)s * D_IN + O_AK + h * A_HD; float d = 0.f; for (int e = 0; e < A_HD; ++e) d += q[e] * k[e];
        const float l = d * 0.125f + rel_bias[v0_bucket(t - s) * A_HEADS + h]; m = fmaxf(m, l); }
    float o[A_HD];
#pragma unroll
    for (int e = 0; e < A_HD; ++e) o[e] = 0.f;
    float sum = 0.f;
    for (int j = 0; j < n; ++j) { const int s = sl[j]; const float* k = P + (size_t)s * D_IN + O_AK + h * A_HD; const float* v = P + (size_t)s * D_IN + O_AV + h * A_HD; float d = 0.f;
        for (int e = 0; e < A_HD; ++e) d += q[e] * k[e];
        const float p = expf(d * 0.125f + rel_bias[v0_bucket(t - s) * A_HEADS + h] - m); sum += p;
#pragma unroll
        for (int e = 0; e < A_HD; ++e) o[e] += p * v[e]; }
    const float inv = 1.f / sum;
#pragma unroll
    for (int e = 0; e < A_HD; ++e) oa[(size_t)t * A_W + h * A_HD + e] = o[e] * inv;
}
__global__ void k0_gate(const float* P, const float* wg, const float* bg, float* lg, int S) {
    V0_GID; if (gid >= (long)S * G_KW) return;
    const int t = (int)(gid / G_KW), j = (int)(gid % G_KW);
    float z = bg[j]; for (int r = 0; r < G_RANK; ++r) z += P[(size_t)t * D_IN + O_GLR + r] * wg[r * G_KW + j];
    lg[gid] = (fminf(z, 0.f) - log1pf(expf(-fabsf(z)))) * (1.f / 16.f);
}
__global__ void __launch_bounds__(64) k0_gla(const float* P, const float* lg, float* oraw, int S) {
    V0_GID; if (gid >= G_HEADS * G_DV) return;
    const int h = (int)(gid / G_DV), dv = (int)(gid % G_DV);
    float st[G_DK];
#pragma unroll
    for (int d = 0; d < G_DK; ++d) st[d] = 0.f;
    for (int t = 0; t < S; ++t) {
        const float* row = P + (size_t)t * D_IN; const float vv = row[O_GV + h * G_DV + dv]; float o = 0.f;
#pragma unroll
        for (int d = 0; d < G_DK; ++d) { const float a = expf(lg[(size_t)t * G_KW + h * G_DK + d]); st[d] = a * st[d] + row[O_GK + h * G_DK + d] * vv; o += row[O_GQ + h * G_DK + d] * st[d]; }
        oraw[(size_t)t * G_VW + h * G_DV + dv] = o * 0.125f;
    }
}
__global__ void k0_gla_post(const float* P, const float* oraw, const float* ng, float* ob, int S) {
    V0_GID; if (gid >= (long)S * G_HEADS) return;
    const int t = (int)(gid / G_HEADS), h = (int)(gid % G_HEADS); const float* o = oraw + (size_t)t * G_VW + h * G_DV;
    float mu = 0.f; for (int e = 0; e < G_DV; ++e) mu += o[e]; mu *= (1.f / G_DV);
    float var = 0.f; for (int e = 0; e < G_DV; ++e) { const float d = o[e] - mu; var += d * d; } var *= (1.f / G_DV);
    const float rs = 1.f / sqrtf(var + LN_EPS);
    for (int e = 0; e < G_DV; ++e) ob[(size_t)t * G_VW + h * G_DV + e] = (o[e] - mu) * rs * ng[h * G_DV + e] * v0_silu(P[(size_t)t * D_IN + O_GR + h * G_DV + e]);
}
__global__ void k0_merge(const float* P, const float* ba, const float* bb, float* mg, int S) {
    V0_GID; if (gid >= (long)S * D_MODEL) return;
    const int t = (int)(gid / D_MODEL), n = (int)(gid % D_MODEL);
    mg[gid] = v0_sigmoid(P[(size_t)t * D_IN + O_GA + n]) * ba[gid] + v0_sigmoid(P[(size_t)t * D_IN + O_GB + n]) * bb[gid];
}
__global__ void k0_ln1(const float* x, const float* y, const float* gt1, const float* g1, const float* b1, const float* sh2, const float* sc2, float* x1, float* h2, int nrows) {
    V0_GID; if (gid >= nrows) return;
    const float* xr = x + (size_t)gid * D_MODEL; const float* yr = y + (size_t)gid * D_MODEL; float* x1r = x1 + (size_t)gid * D_MODEL; float* h2r = h2 + (size_t)gid * D_MODEL;
    float mu = 0.f; for (int k = 0; k < D_MODEL; ++k) mu += DN_ALPHA * xr[k] + gt1[k] * yr[k]; mu *= (1.f / D_MODEL);
    float var = 0.f; for (int k = 0; k < D_MODEL; ++k) { const float d = DN_ALPHA * xr[k] + gt1[k] * yr[k] - mu; var += d * d; } var *= (1.f / D_MODEL);
    float rs = 1.f / sqrtf(var + LN_EPS);
    for (int k = 0; k < D_MODEL; ++k) x1r[k] = (DN_ALPHA * xr[k] + gt1[k] * yr[k] - mu) * rs * g1[k] + b1[k];
    mu = 0.f; for (int k = 0; k < D_MODEL; ++k) mu += x1r[k]; mu *= (1.f / D_MODEL);
    var = 0.f; for (int k = 0; k < D_MODEL; ++k) { const float d = x1r[k] - mu; var += d * d; } var *= (1.f / D_MODEL);
    rs = 1.f / sqrtf(var + LN_EPS);
    for (int k = 0; k < D_MODEL; ++k) h2r[k] = (x1r[k] - mu) * rs * (1.f + sc2[k]) + sh2[k];
}
__global__ void k0_route(const float* rl, const float* brg, const float* bre, int* eid, float* ew, int nrows) {
    V0_GID; if (gid >= nrows) return;
    const float* r = rl + (size_t)gid * 36;
    float gl[N_GROUPS]; float gm = -INFINITY; int gi = 0;
#pragma unroll
    for (int g = 0; g < N_GROUPS; ++g) { gl[g] = r[g] + brg[g]; if (gl[g] > gm) { gm = gl[g]; gi = g; } }
    float gs = 0.f;
#pragma unroll
    for (int g = 0; g < N_GROUPS; ++g) gs += expf(gl[g] - gm);
    const float gw = 1.f / gs;
    float v0 = -INFINITY, v1 = -INFINITY; int i0 = 0, i1 = 0;
    for (int e = 0; e < EPG; ++e) { const float v = r[4 + gi * EPG + e] + bre[gi * EPG + e];
        if (v > v0) { v1 = v0; i1 = i0; v0 = v; i0 = e; } else if (v > v1) { v1 = v; i1 = e; } }
    const float e1 = expf(v1 - v0); const float w0 = 1.f / (1.f + e1), w1 = e1 / (1.f + e1);
    eid[gid * 2] = gi * EPG + i0; eid[gid * 2 + 1] = gi * EPG + i1; ew[gid * 2] = w0 * gw; ew[gid * 2 + 1] = w1 * gw;
}
__global__ void k0_moe_hid(const float* h2, const int* eid, const float* w1, const float* w3, float* hid, int nrows) {
    V0_GID; if (gid >= (long)nrows * 2 * D_EXP) return;
    const int j = (int)(gid % D_EXP); const long ts = gid / D_EXP; const int t = (int)(ts / 2); const int e = eid[ts];
    const float* hr = h2 + (size_t)t * D_MODEL; const float* a = w1 + (size_t)e * D_MODEL * D_EXP + j; const float* b = w3 + (size_t)e * D_MODEL * D_EXP + j;
    float g = 0.f, u = 0.f; for (int k = 0; k < D_MODEL; ++k) { g += hr[k] * a[(size_t)k * D_EXP]; u += hr[k] * b[(size_t)k * D_EXP]; }
    hid[gid] = v0_silu(g) * u;
}
__global__ void k0_moe_out(const float* hid, const int* eid, const float* ew, const float* w2, float* f, int nrows) {
    V0_GID; if (gid >= (long)nrows * D_MODEL) return;
    const int n = (int)(gid % D_MODEL); const int t = (int)(gid / D_MODEL); float acc = 0.f;
    for (int sl = 0; sl < 2; ++sl) { const int e = eid[t * 2 + sl]; const float* hr = hid + ((size_t)t * 2 + sl) * D_EXP; const float* w = w2 + (size_t)e * D_EXP * D_MODEL + n; float a = 0.f;
        for (int j = 0; j < D_EXP; ++j) a += hr[j] * w[(size_t)j * D_MODEL]; acc += ew[t * 2 + sl] * a; }
    f[gid] = acc;
}
__global__ void k0_final(const float* x1, const float* f, const float* gt2, const float* g2, const float* b2, float* out, int nrows) {
    V0_GID; if (gid >= nrows) return;
    const float* xr = x1 + (size_t)gid * D_MODEL; const float* fr = f + (size_t)gid * D_MODEL; float* o = out + (size_t)gid * D_MODEL;
    float mu = 0.f; for (int k = 0; k < D_MODEL; ++k) mu += DN_ALPHA * xr[k] + gt2[k] * fr[k]; mu *= (1.f / D_MODEL);
    float var = 0.f; for (int k = 0; k < D_MODEL; ++k) { const float d = DN_ALPHA * xr[k] + gt2[k] * fr[k] - mu; var += d * d; } var *= (1.f / D_MODEL);
    const float rs = 1.f / sqrtf(var + LN_EPS);
    for (int k = 0; k < D_MODEL; ++k) o[k] = (DN_ALPHA * xr[k] + gt2[k] * fr[k] - mu) * rs * g2[k] + b2[k];
}

struct V0Buf { float *ada, *h, *P, *scT, *oa, *lg, *oraw, *ob, *ba, *bb, *mg, *y, *x1, *h2, *rl, *ew, *hid, *f; int *sel, *cnt, *eid; size_t bytes; };
static V0Buf v0_carve(void* base, int B, int S) {
    V0Buf b; char* p = (char*)base; auto take = [&](size_t n) { char* r = p; p += (n + 255) & ~(size_t)255; return r; };
    b.ada = (float*)take((size_t)B * 6 * D_MODEL * 4);
    b.P = (float*)take((size_t)S * D_IN * 4);
    b.h = (float*)take((size_t)S * D_MODEL * 4);
    b.scT = (float*)take((size_t)S * S * 4);
    b.sel = (int*)take((size_t)S * TOPK_MAX * 4); b.cnt = (int*)take((size_t)S * 4);
    b.oa = (float*)take((size_t)S * A_W * 4); b.lg = (float*)take((size_t)S * G_KW * 4); b.oraw = (float*)take((size_t)S * G_VW * 4); b.ob = (float*)take((size_t)S * G_VW * 4);
    b.ba = (float*)take((size_t)S * D_MODEL * 4); b.bb = (float*)take((size_t)S * D_MODEL * 4); b.y = (float*)take((size_t)S * D_MODEL * 4);
    b.x1 = (float*)take((size_t)S * D_MODEL * 4); b.h2 = (float*)take((size_t)S * D_MODEL * 4); b.f = (float*)take((size_t)S * D_MODEL * 4);
    b.mg = b.h;
    b.rl = (float*)take((size_t)S * 36 * 4); b.eid = (int*)take((size_t)S * 2 * 4); b.ew = (float*)take((size_t)S * 2 * 4); b.hid = (float*)take((size_t)S * 2 * D_EXP * 4);
    b.bytes = (size_t)(p - (char*)base); return b;
}
static void v0_forward(void* const* d_in, float* out, void* scratch, int B, int S, hipStream_t st, int only_batch = -1, int last_batch = -1) {
    const float *x = (const float*)d_in[0], *c = (const float*)d_in[1], *rel_bias = (const float*)d_in[2], *w_ada = (const float*)d_in[3], *b_ada = (const float*)d_in[4], *w_in = (const float*)d_in[5],
                *wg = (const float*)d_in[6], *bg = (const float*)d_in[7], *ng = (const float*)d_in[8], *wba = (const float*)d_in[9], *wbb = (const float*)d_in[10], *wout = (const float*)d_in[11],
                *g1 = (const float*)d_in[12], *b1 = (const float*)d_in[13], *wrg = (const float*)d_in[14], *brg = (const float*)d_in[15], *wre = (const float*)d_in[16], *bre = (const float*)d_in[17],
                *w1 = (const float*)d_in[18], *w3 = (const float*)d_in[19], *w2 = (const float*)d_in[20], *g2 = (const float*)d_in[21], *b2 = (const float*)d_in[22];
    V0Buf u = v0_carve(scratch, B, S);
    const int TB = 256; auto nb = [&](long n) { return (n + TB - 1) / TB; };
    const int topk = (TOPK_MAX < S / 4) ? TOPK_MAX : S / 4;
    LAUNCH(k0_ada, nb((long)B * 6 * D_MODEL), TB, st, c, w_ada, b_ada, u.ada, B);
    for (int bi = 0; bi < B; ++bi) {
        int b = bi; if (last_batch >= 0) b = (bi == B - 1) ? last_batch : (bi < last_batch ? bi : bi + 1);
        if (only_batch >= 0 && b != only_batch) continue;
        const float* xb = x + (size_t)b * S * D_MODEL; const float* ad = u.ada + (size_t)b * 6 * D_MODEL;
        const float *sh1 = ad, *sc1 = ad + D_MODEL, *gt1 = ad + 2 * D_MODEL, *sh2 = ad + 3 * D_MODEL, *sc2 = ad + 4 * D_MODEL, *gt2 = ad + 5 * D_MODEL;
        LAUNCH(k0_lnmod, nb(S), TB, st, xb, sh1, sc1, u.h, S);
        LAUNCH(k0_gemm, nb((long)(S / 4) * D_IN), TB, st, (const float*)u.h, D_MODEL, w_in, D_IN, u.P, D_IN, S, D_IN, D_MODEL);
        LAUNCH(k0_scores, nb((long)S * S), TB, st, (const float*)u.P, u.scT, S);
        LAUNCH(k0_topk, nb(S), TB, st, (const float*)u.scT, u.sel, u.cnt, S, topk);
        LAUNCH(k0_attn, nb((long)S * A_HEADS), TB, st, (const float*)u.P, (const int*)u.sel, (const int*)u.cnt, rel_bias, u.oa, S);
        LAUNCH(k0_gate, nb((long)S * G_KW), TB, st, (const float*)u.P, wg, bg, u.lg, S);
        LAUNCH(k0_gla, (G_HEADS * G_DV + 63) / 64, 64, st, (const float*)u.P, (const float*)u.lg, u.oraw, S);
        LAUNCH(k0_gla_post, nb((long)S * G_HEADS), TB, st, (const float*)u.P, (const float*)u.oraw, ng, u.ob, S);
        LAUNCH(k0_gemm, nb((long)(S / 4) * D_MODEL), TB, st, (const float*)u.oa, A_W, wba, D_MODEL, u.ba, D_MODEL, S, D_MODEL, A_W);
        LAUNCH(k0_gemm, nb((long)(S / 4) * D_MODEL), TB, st, (const float*)u.ob, G_VW, wbb, D_MODEL, u.bb, D_MODEL, S, D_MODEL, G_VW);
        LAUNCH(k0_merge, nb((long)S * D_MODEL), TB, st, (const float*)u.P, (const float*)u.ba, (const float*)u.bb, u.mg, S);
        LAUNCH(k0_gemm, nb((long)(S / 4) * D_MODEL), TB, st, (const float*)u.mg, D_MODEL, wout, D_MODEL, u.y, D_MODEL, S, D_MODEL, D_MODEL);
        LAUNCH(k0_ln1, nb(S), TB, st, xb, (const float*)u.y, gt1, g1, b1, sh2, sc2, u.x1, u.h2, S);
        LAUNCH(k0_gemm, nb((long)(S / 4) * N_GROUPS), TB, st, (const float*)u.h2, D_MODEL, wrg, N_GROUPS, u.rl, 36, S, N_GROUPS, D_MODEL);
        LAUNCH(k0_gemm, nb((long)(S / 4) * N_EXP), TB, st, (const float*)u.h2, D_MODEL, wre, N_EXP, u.rl + 4, 36, S, N_EXP, D_MODEL);
        LAUNCH(k0_route, nb(S), TB, st, (const float*)u.rl, brg, bre, u.eid, u.ew, S);
        LAUNCH(k0_moe_hid, nb((long)S * 2 * D_EXP), TB, st, (const float*)u.h2, (const int*)u.eid, w1, w3, u.hid, S);
        LAUNCH(k0_moe_out, nb((long)S * D_MODEL), TB, st, (const float*)u.hid, (const int*)u.eid, (const float*)u.ew, w2, u.f, S);
        LAUNCH(k0_final, nb(S), TB, st, (const float*)u.x1, (const float*)u.f, gt2, g2, b2, out + (size_t)b * S * D_MODEL, S);
    }
}
namespace pg8 {
#define PG8_LAS __attribute__((address_space(3)))
typedef unsigned short bf16_t;
typedef short bf16x8 __attribute__((ext_vector_type(8)));
typedef float f32x4 __attribute__((ext_vector_type(4)));
typedef unsigned u32x4 __attribute__((ext_vector_type(4)));
constexpr int BM = 256, BK = 64, HALF = 128, HTB = HALF * BK * 2  , STAGE_BYTES = 8 * HTB, NXCD = 8, WGM = 8;

__host__ __device__ __forceinline__ int lds_byte(int r, int c) { const int st = (r >> 4) * 2 + (c >> 5), rr = r & 15, cc = c & 31, ob = rr * 64 + cc * 2; return st * 1024 + (ob ^ (((ob >> 9) & 1) << 5)); }
__host__ __device__ __forceinline__ void stage_rc(int b, int& R, int& C) { const int st = b / 1024, sb = b % 1024, swz = sb ^ (((sb >> 9) & 1) << 5); R = (st >> 1) * 16 + swz / 64; C = (st & 1) * 32 + (swz % 64) / 2; }
__host__ __device__ __forceinline__ int perm32(int rho) { const int n = rho >> 4, i = rho & 15; return 8 * (i >> 2) + 4 * n + (i & 3); }

struct Unit { int pm, pn, pa, pb; };
struct Gemm { const bf16_t* A; const bf16_t* Bt; int M, N, K; };

struct StaticOrder {
    int nM, nN, nwg, G, c;
    __host__ __device__ void init(int M, int N, int G_, int c_) { nM = M / BM; nN = N / BM; nwg = nM * nN; G = G_; c = c_; }
    __host__ __device__ bool next(int i, Unit& u) const {
        const long L = (long)i * G + c; if (L >= nwg) return false;
        int wgid = (int)L; { const int q = nwg / NXCD, r = nwg % NXCD, xcd = wgid % NXCD, off = wgid / NXCD; wgid = (xcd < r ? xcd * (q + 1) : r * (q + 1) + (xcd - r) * q) + off; }
        const int nig = WGM * nN, gid = wgid / nig, fm = gid * WGM, gsz = (nM - fm) < WGM ? (nM - fm) : WGM;
        u.pm = fm + ((wgid % nig) % gsz); u.pn = (wgid % nig) / gsz; u.pa = u.pm; u.pb = u.pn; return true;
    }
    __device__ __forceinline__ void a_ready(const Unit&) const {}
    __device__ __forceinline__ void done(const Unit&) const {}
};

__device__ __forceinline__ unsigned cvt_pk_bf16(float lo, float hi) { unsigned r; asm volatile("v_cvt_pk_bf16_f32 %0, %1, %2" : "=v"(r) : "v"(lo), "v"(hi)); return r; }
typedef float f32x2 __attribute__((ext_vector_type(2)));

template <class Epi, class Sched, bool ALIGN_EPI = false, bool SP2 = false>
__device__ __forceinline__ void gemm_phase(PG8_LAS unsigned char* lds, const Gemm g, const Sched& S, const Epi& E) {
    const int tid = threadIdx.x, wid = __builtin_amdgcn_readfirstlane(tid >> 6), lane = tid & 63, wr = wid >> 2, wc = wid & 3, fr = lane & 15, fq = lane >> 4;
    const int K = g.K, nt = K / BK;
    unsigned voffA[2], voffB[2];
#pragma unroll
    for (int i = 0; i < 2; ++i) { int R, C; stage_rc(tid * 16 + i * 8192, R, C); const int Rb = Epi::PERM ? ((R & ~31) + perm32(R & 31)) : R;
        voffA[i] = (unsigned)(R * K + C) * 2u; voffB[i] = (unsigned)(Rb * K + C) * 2u; }
    const size_t kstep = (size_t)(BK * 2);
    const size_t hstep = (size_t)HALF * K * 2;
    const size_t tstep = 2 * hstep;
    const unsigned ldsw = (unsigned)wid * 1024u;
    const int aoff = lds_byte(wr * 64 + fr, fq * 8), boff = lds_byte(wc * 32 + fr, fq * 8);
#define PG8_SA(b, h) (((b) * 2 + (h)) * HTB)
#define PG8_SB(b, h) ((4 + (b) * 2 + (h)) * HTB)
#define PG8_STAGE(bufoff, gbase, voff) do { _Pragma("unroll") for (int _i = 0; _i < 2; ++_i) \
        __builtin_amdgcn_global_load_lds((const unsigned*)((const char*)(gbase) + (voff)[_i]), (PG8_LAS unsigned*)(lds + (bufoff) + ldsw + _i * 8192), 16, 0, 0); } while (0)
#define PG8_LDA(dst, b, h) do { _Pragma("unroll") for (int m = 0; m < 4; ++m) _Pragma("unroll") for (int k = 0; k < 2; ++k) dst[m][k] = *(const PG8_LAS bf16x8*)(lds + PG8_SA(b, h) + aoff + m * 2048 + k * 1024); } while (0)
#define PG8_LDB(dst, b, h) do { _Pragma("unroll") for (int n = 0; n < 2; ++n) _Pragma("unroll") for (int k = 0; k < 2; ++k) dst[n][k] = *(const PG8_LAS bf16x8*)(lds + PG8_SB(b, h) + boff + n * 2048 + k * 1024); } while (0)
#define PG8_MMA(ai, bj, At, Bt) do { __builtin_amdgcn_s_setprio(1); _Pragma("unroll") for (int m = 0; m < 4; ++m) _Pragma("unroll") for (int n = 0; n < 2; ++n) _Pragma("unroll") for (int k = 0; k < 2; ++k) \
        acc[ai][bj][m][n] = __builtin_amdgcn_mfma_f32_16x16x32_bf16(Bt[n][k], At[m][k], acc[ai][bj][m][n], 0, 0, 0); __builtin_amdgcn_s_setprio(0); } while (0)
#define PG8_WAIT_V(n) asm volatile("s_waitcnt vmcnt(" #n ")" ::: "memory")
#define PG8_WAIT_L(n) asm volatile("s_waitcnt lgkmcnt(" #n ")" ::: "memory")
#define PG8_BAR __builtin_amdgcn_s_barrier()
#define PG8_SCHED __builtin_amdgcn_sched_barrier(0)
    Unit cur, nxt; int ui = 0;
    if (!S.next(0, cur)) return;
    f32x4 acc[2][2][4][2];
#pragma unroll
    for (int a = 0; a < 2; ++a)
#pragma unroll
        for (int b = 0; b < 2; ++b)
#pragma unroll
            for (int m = 0; m < 4; ++m)
#pragma unroll
                for (int n = 0; n < 2; ++n) acc[a][b][m][n] = (f32x4){0.f, 0.f, 0.f, 0.f};
    bf16x8 At[4][2], B0[2][2], B1[2][2];
    const char* cA = (const char*)g.A + (size_t)cur.pa * tstep; const char* cB = (const char*)g.Bt + (size_t)cur.pb * tstep;
    S.a_ready(cur);
    if constexpr (SP2) {
        PG8_STAGE(PG8_SB(0, 0), cB, voffB); PG8_STAGE(PG8_SB(0, 1), cB + hstep, voffB); PG8_STAGE(PG8_SA(0, 0), cA, voffA); PG8_STAGE(PG8_SA(0, 1), cA + hstep, voffA);
        if (wr == 1) PG8_BAR;
        PG8_WAIT_V(2); PG8_BAR;
        PG8_STAGE(PG8_SB(1, 0), cB + kstep, voffB); PG8_STAGE(PG8_SA(1, 0), cA + kstep, voffA); PG8_STAGE(PG8_SB(1, 1), cB + hstep + kstep, voffB);
        PG8_WAIT_V(6); PG8_BAR;
    } else {
        PG8_STAGE(PG8_SB(0, 0), cB, voffB); PG8_STAGE(PG8_SA(0, 0), cA, voffA); PG8_STAGE(PG8_SB(0, 1), cB + hstep, voffB); PG8_STAGE(PG8_SA(0, 1), cA + hstep, voffA);
        if (wr == 1) PG8_BAR;
        PG8_WAIT_V(4); PG8_BAR;
        PG8_STAGE(PG8_SB(1, 0), cB + kstep, voffB); PG8_STAGE(PG8_SA(1, 0), cA + kstep, voffA); PG8_STAGE(PG8_SB(1, 1), cB + hstep + kstep, voffB);
        PG8_WAIT_V(6); PG8_BAR;
    }
    for (;;) {
        const bool has_next = S.next(ui + 1, nxt);
        const char* nA = has_next ? (const char*)g.A + (size_t)nxt.pa * tstep : cA; const char* nB = has_next ? (const char*)g.Bt + (size_t)nxt.pb * tstep : cB;
        for (int t = 0; t < nt; t += 2) {
            const bool last = (t == nt - 2);
            const char* a1 = cA + (size_t)(t + 1) * kstep;
            const char* a2 = last ? nA : cA + (size_t)(t + 2) * kstep; const char* b2 = last ? nB : cB + (size_t)(t + 2) * kstep;
            const char* a3 = a2 + kstep; const char* b3 = b2 + kstep;
            if (last && has_next) S.a_ready(nxt);
            if constexpr (SP2) {
            PG8_LDB(B0, 0, 0); PG8_LDB(B1, 0, 1); PG8_SCHED; PG8_LDA(At, 0, 0); PG8_STAGE(PG8_SA(1, 1), a1 + hstep, voffA);
            PG8_WAIT_V(8); PG8_WAIT_L(0); PG8_BAR; PG8_MMA(0, 0, At, B0); PG8_MMA(0, 1, At, B1); PG8_BAR; PG8_SCHED;
            PG8_LDA(At, 0, 1); PG8_STAGE(PG8_SB(0, 0), b2, voffB); PG8_STAGE(PG8_SB(0, 1), b2 + hstep, voffB); PG8_STAGE(PG8_SA(0, 0), a2, voffA);
            PG8_WAIT_V(8); PG8_WAIT_L(0); PG8_BAR; PG8_MMA(1, 0, At, B0); PG8_MMA(1, 1, At, B1); PG8_BAR; PG8_SCHED;
            PG8_LDB(B0, 1, 0); PG8_LDB(B1, 1, 1); PG8_SCHED; PG8_LDA(At, 1, 0); PG8_STAGE(PG8_SA(0, 1), a2 + hstep, voffA);
            PG8_WAIT_V(8); PG8_WAIT_L(0); PG8_BAR; PG8_MMA(0, 0, At, B0); PG8_MMA(0, 1, At, B1); PG8_BAR; PG8_SCHED;
            PG8_LDA(At, 1, 1); PG8_STAGE(PG8_SB(1, 0), b3, voffB); PG8_STAGE(PG8_SB(1, 1), b3 + hstep, voffB); PG8_STAGE(PG8_SA(1, 0), a3, voffA);
            PG8_WAIT_V(8); PG8_WAIT_L(0); PG8_BAR; PG8_MMA(1, 0, At, B0); PG8_MMA(1, 1, At, B1); PG8_BAR; PG8_SCHED;
            } else {
            PG8_LDB(B0, 0, 0); PG8_SCHED; PG8_LDA(At, 0, 0); PG8_STAGE(PG8_SA(1, 1), a1 + hstep, voffA);
            PG8_WAIT_L(8); PG8_BAR; PG8_WAIT_L(0); PG8_MMA(0, 0, At, B0); PG8_BAR; PG8_SCHED;
            PG8_LDB(B1, 0, 1); PG8_STAGE(PG8_SB(0, 0), b2, voffB);
            PG8_BAR; PG8_WAIT_L(0); PG8_MMA(0, 1, At, B1); PG8_BAR;
            PG8_LDA(At, 0, 1); PG8_STAGE(PG8_SA(0, 0), a2, voffA);
            PG8_BAR; PG8_WAIT_L(0); PG8_MMA(1, 0, At, B0); PG8_BAR; PG8_SCHED;
            PG8_STAGE(PG8_SB(0, 1), b2 + hstep, voffB);
            PG8_WAIT_V(6); PG8_BAR; PG8_MMA(1, 1, At, B1); PG8_BAR;
            PG8_LDB(B0, 1, 0); PG8_SCHED; PG8_LDA(At, 1, 0); PG8_STAGE(PG8_SA(0, 1), a2 + hstep, voffA);
            PG8_WAIT_L(8); PG8_BAR; PG8_WAIT_L(0); PG8_MMA(0, 0, At, B0); PG8_BAR; PG8_SCHED;
            PG8_LDB(B1, 1, 1); PG8_STAGE(PG8_SB(1, 0), b3, voffB);
            PG8_BAR; PG8_WAIT_L(0); PG8_MMA(0, 1, At, B1); PG8_BAR;
            PG8_LDA(At, 1, 1); PG8_STAGE(PG8_SA(1, 0), a3, voffA);
            PG8_BAR; PG8_WAIT_L(0); PG8_MMA(1, 0, At, B0); PG8_BAR; PG8_SCHED;
            PG8_STAGE(PG8_SB(1, 1), b3 + hstep, voffB);
            PG8_WAIT_V(6); PG8_BAR; PG8_MMA(1, 1, At, B1); PG8_BAR;
            }
        }
        if constexpr (ALIGN_EPI) { if (wr == 0) PG8_BAR; }
        if constexpr (!Epi::AFTER_DRAIN) { E(acc, cur, wr, wc, fr, fq); S.done(cur); }
        if (!has_next) break;
#pragma unroll
        for (int a = 0; a < 2; ++a)
#pragma unroll
            for (int b = 0; b < 2; ++b)
#pragma unroll
                for (int m = 0; m < 4; ++m)
#pragma unroll
                    for (int n = 0; n < 2; ++n) acc[a][b][m][n] = (f32x4){0.f, 0.f, 0.f, 0.f};
        cur = nxt; cA = nA; cB = nB; ++ui;
        if constexpr (ALIGN_EPI) { if (wr == 1) PG8_BAR; }
    }
    PG8_WAIT_V(0);
    if constexpr (!ALIGN_EPI) { if (wr == 0) PG8_BAR; }
    PG8_BAR;
    if constexpr (Epi::AFTER_DRAIN) { E.fused(acc, cur, wr, wc, fr, fq, lds, wid, lane); S.done(cur); }
#undef PG8_SA
#undef PG8_SB
#undef PG8_STAGE
#undef PG8_LDA
#undef PG8_LDB
#undef PG8_MMA
#undef PG8_WAIT_V
#undef PG8_WAIT_L
#undef PG8_BAR
#undef PG8_SCHED
}
}

#ifndef PG8_SP2
#define PG8_SP2 true
#endif
#ifndef PG8_ALIGN
#define PG8_ALIGN true
#endif
namespace cg = cooperative_groups;
namespace fk {
using pg8::bf16_t; using pg8::f32x4; using pg8::u32x4; using pg8::bf16x8; using pg8::Unit; using pg8::cvt_pk_bf16;
#define LAS __attribute__((address_space(3)))
#define LDS_WAIT() asm volatile("s_waitcnt lgkmcnt(0)" ::: "memory")
typedef unsigned u32x2 __attribute__((ext_vector_type(2)));
constexpr int NB = 8, NS = 4096, NT = NB * NS;
constexpr int NTHREADS = 512, NWAVES = 8, LDS_BYTES = 155648;
constexpr size_t MiB = (size_t)1 << 20;
constexpr size_t WS_ADA = 0, WS_CNT = 256 * 1024,
    WS_WIN = 1 * MiB, WS_WGAB = 9 * MiB, WS_WBA = 13 * MiB, WS_WBB = 14 * MiB, WS_WOUT = 15 * MiB, WS_W13 = 17 * MiB, WS_W2 = 49 * MiB,
    WS_XN = 65 * MiB, WS_QKV = 129 * MiB, WS_IQ = 225 * MiB, WS_GQK = 257 * MiB, WS_GV = 289 * MiB, WS_GR = 321 * MiB,
    WS_IK = 353 * MiB, WS_IW = 355 * MiB, WS_GLR = 357 * MiB, WS_SC = 358 * MiB, WS_MASK = 490 * MiB, WS_ADAP = 506 * MiB, WS_MISC = 509 * MiB;
constexpr int NPROJ = 3840;
constexpr int KSL = 16;
constexpr float QSCALE = 0.125f * 1.4426950408889634f;

__device__ __forceinline__ void tr_item(const float* W, int ldw, int srccol, bf16_t* WT, int K, int dst_row0, int kb, LAS float* scr, int lane) {
    const int k0 = 64 * kb;
#pragma unroll 8
    for (int i = 0; i < 32; ++i) { const int kk = 2 * i + (lane >> 5); scr[kk * 33 + (lane & 31)] = W[(size_t)(k0 + kk) * ldw + srccol]; }
    LDS_WAIT();
    const int c = lane & 7;
#pragma unroll
    for (int j = 0; j < 4; ++j) { const int n = (lane >> 3) + 8 * j; const LAS float* s = scr + (8 * c) * 33 + n;
        u32x4 o; o.x = cvt_pk_bf16(s[0 * 33], s[1 * 33]); o.y = cvt_pk_bf16(s[2 * 33], s[3 * 33]); o.z = cvt_pk_bf16(s[4 * 33], s[5 * 33]); o.w = cvt_pk_bf16(s[6 * 33], s[7 * 33]);
        *(u32x4*)(WT + (size_t)(dst_row0 + n) * K + k0 + 8 * c) = o; }
    LDS_WAIT();
}
__device__ __forceinline__ int win_src(int n) {
    if (n < 2048) return n;
    if (n < 3584) return n + 48;
    if (n < 3616) return O_IK + (n - 3584);
    if (n < 3632) return O_IW + (n - 3616);
    return O_GLR + (n - 3632);
}
constexpr int I_ADA = 96 * KSL, I_WIN = 114 * 16, I_WGAB = 64 * 16, I_WB = 32 * 8, I_WOUT = 32 * 16, I_W13 = 32 * 16 * 16, I_W2 = 32 * 32 * 4;
constexpr int P0_ITEMS = I_ADA + I_WIN + I_WGAB + 2 * I_WB + I_WOUT + I_W13 + I_W2;
__device__ __forceinline__ void p0_item(int it, const float* const* in, unsigned char* ws, LAS float* scr, int lane) {
    if (it < I_ADA) {
        const int cb = it / KSL, ks = it % KSL, k0 = ks * 64; const float* c = in[1]; const float* w = in[3];
#pragma unroll
        for (int b = 0; b < NB; ++b) { const float cv = c[b * D_MODEL + k0 + lane]; scr[b * 64 + lane] = cv / (1.f + __expf(-cv)); }
        LDS_WAIT();
        float acc[NB];
#pragma unroll
        for (int b = 0; b < NB; ++b) acc[b] = 0.f;
        const int col = cb * 64 + lane;
#pragma unroll 8
        for (int kk = 0; kk < 64; ++kk) { const float wv = w[(size_t)(k0 + kk) * (6 * D_MODEL) + col];
#pragma unroll
            for (int b = 0; b < NB; ++b) acc[b] += scr[b * 64 + kk] * wv; }
        float* adap = (float*)(ws + WS_ADAP);
#pragma unroll
        for (int b = 0; b < NB; ++b) adap[(size_t)(ks * NB + b) * (6 * D_MODEL) + col] = acc[b];
        LDS_WAIT(); return;
    }
    it -= I_ADA;
    const int l31 = lane & 31;
    if (it < I_WIN) { const int nb = it / 16, kb = it % 16; tr_item(in[5], D_IN, win_src(nb * 32 + l31), (bf16_t*)(ws + WS_WIN), 1024, nb * 32, kb, scr, lane); return; }
    it -= I_WIN;
    if (it < I_WGAB) { const int nb = it / 16, kb = it % 16; tr_item(in[5], D_IN, O_GA + nb * 32 + l31, (bf16_t*)(ws + WS_WGAB), 1024, nb * 32, kb, scr, lane); return; }
    it -= I_WGAB;
    if (it < I_WB) { const int nb = it / 8, kb = it % 8; tr_item(in[9], D_MODEL, nb * 32 + l31, (bf16_t*)(ws + WS_WBA), 512, nb * 32, kb, scr, lane); return; }
    it -= I_WB;
    if (it < I_WB) { const int nb = it / 8, kb = it % 8; tr_item(in[10], D_MODEL, nb * 32 + l31, (bf16_t*)(ws + WS_WBB), 512, nb * 32, kb, scr, lane); return; }
    it -= I_WB;
    if (it < I_WOUT) { const int nb = it / 16, kb = it % 16; tr_item(in[11], D_MODEL, nb * 32 + l31, (bf16_t*)(ws + WS_WOUT), 1024, nb * 32, kb, scr, lane); return; }
    it -= I_WOUT;
    if (it < I_W13) {
        const int e = it / 256, r = it % 256, nb = r / 16, kb = r % 16; const int row0 = nb * 32;
        const int half = (row0 & 255) >> 7; const int col = (row0 >> 8) * 128 + (row0 & 127) + l31;
        const float* src = (half ? in[19] : in[18]) + (size_t)e * D_MODEL * D_EXP;
        tr_item(src, D_EXP, col, (bf16_t*)(ws + WS_W13) + (size_t)e * 512 * 1024, 1024, row0, kb, scr, lane); return; }
    it -= I_W13;
    { const int e = it / 128, r = it % 128, nb = r / 4, kb = r % 4;
      tr_item(in[20] + (size_t)e * D_EXP * D_MODEL, D_MODEL, nb * 32 + l31, (bf16_t*)(ws + WS_W2) + (size_t)e * 1024 * 256, 256, nb * 32, kb, scr, lane); }
}

__device__ __forceinline__ float wave_sum(float v) {
#pragma unroll
    for (int o = 1; o < 64; o <<= 1) v += __shfl_xor(v, o);
    return v;
}
__device__ __forceinline__ float ada_sum(const float* adap, const float* b_ada, int b, int j) {
    float s = b_ada[j];
#pragma unroll
    for (int k = 0; k < KSL; ++k) s += adap[(size_t)(k * NB + b) * (6 * D_MODEL) + j];
    return s;
}
__device__ __forceinline__ void p1_phase(const float* const* in, unsigned char* ws, LAS unsigned char* lds, int G) {
    const int tid = threadIdx.x, lane = tid & 63, wave = tid >> 6;
    const float* adap = (const float*)(ws + WS_ADAP); const float* b_ada = in[4]; const float* x = in[0];
    LAS float* sh = (LAS float*)lds; LAS float* sc = sh + D_MODEL;
    for (int blk = blockIdx.x; blk < NT / 128; blk += G) {
        const int b = blk / 32;
        __syncthreads();
        for (int j = tid; j < 2 * D_MODEL; j += NTHREADS) sh[j] = ada_sum(adap, b_ada, b, j);
        if ((blk & 31) == 0) { float* ada = (float*)(ws + WS_ADA) + (size_t)b * 6 * D_MODEL; for (int j = tid; j < 6 * D_MODEL; j += NTHREADS) ada[j] = ada_sum(adap, b_ada, b, j); }
        __syncthreads();
        for (int r = 0; r < 16; ++r) {
            const size_t row = (size_t)blk * 128 + wave * 16 + r;
            const f32x4* xr = (const f32x4*)(x + row * D_MODEL) + lane;
            f32x4 v[4]; float s = 0.f;
#pragma unroll
            for (int j = 0; j < 4; ++j) { v[j] = xr[64 * j]; s += (v[j].x + v[j].y) + (v[j].z + v[j].w); }
            const float mean = wave_sum(s) * (1.f / D_MODEL); float s2 = 0.f;
#pragma unroll
            for (int j = 0; j < 4; ++j) { v[j] = v[j] - mean; s2 += (v[j].x * v[j].x + v[j].y * v[j].y) + (v[j].z * v[j].z + v[j].w * v[j].w); }
            const float rstd = 1.f / sqrtf(wave_sum(s2) * (1.f / D_MODEL) + LN_EPS);
            u32x2* o8 = (u32x2*)((bf16_t*)(ws + WS_XN) + row * D_MODEL) + lane;
#pragma unroll
            for (int j = 0; j < 4; ++j) { const f32x4 a = *(const LAS f32x4*)(sc + 256 * j + 4 * lane), c = *(const LAS f32x4*)(sh + 256 * j + 4 * lane);
                const f32x4 y = v[j] * rstd * (a + 1.f) + c; u32x2 w; w.x = cvt_pk_bf16(y.x, y.y); w.y = cvt_pk_bf16(y.z, y.w); o8[64 * j] = w; }
        }
    }
}

struct EpiProj {
    static constexpr bool PERM = true, AFTER_DRAIN = false;
    unsigned char* ws;
    __device__ __forceinline__ void operator()(const f32x4 (&acc)[2][2][4][2], const Unit& u, int wr, int wc, int fr, int fq) const {
        const int row0 = u.pm * 256 + wr * 64 + fr; const int pn = u.pn;
        if (pn < 14) {
            bf16_t* base; int ld, ct; float sc = 1.f;
            if (pn < 6) { base = (bf16_t*)(ws + WS_QKV); ld = 1536; ct = pn * 256; if (pn < 2) sc = QSCALE; }
            else if (pn < 8) { base = (bf16_t*)(ws + WS_IQ); ld = 512; ct = (pn - 6) * 256; }
            else if (pn < 10) { base = (bf16_t*)(ws + WS_GQK); ld = 512; ct = (pn - 8) * 256; }
            else if (pn < 12) { base = (bf16_t*)(ws + WS_GV); ld = 512; ct = (pn - 10) * 256; }
            else { base = (bf16_t*)(ws + WS_GR); ld = 512; ct = (pn - 12) * 256; }
            const int col0 = ct + wc * 32 + 8 * fq;
#pragma unroll
            for (int ai = 0; ai < 2; ++ai)
#pragma unroll
                for (int m = 0; m < 4; ++m) { bf16_t* rowp = base + (size_t)(row0 + ai * 128 + m * 16) * ld + col0;
#pragma unroll
                    for (int bj = 0; bj < 2; ++bj) { const f32x4 v0 = acc[ai][bj][m][0] * sc, v1 = acc[ai][bj][m][1] * sc;
                        u32x4 w; w.x = cvt_pk_bf16(v0[0], v0[1]); w.y = cvt_pk_bf16(v0[2], v0[3]); w.z = cvt_pk_bf16(v1[0], v1[1]); w.w = cvt_pk_bf16(v1[2], v1[3]);
                        *(u32x4*)(rowp + bj * 128) = w; } }
        } else {
            const int c8 = wc * 32 + 8 * fq;
            if (c8 < 64) {
#pragma unroll
                for (int ai = 0; ai < 2; ++ai)
#pragma unroll
                    for (int m = 0; m < 4; ++m) { const size_t row = (size_t)(row0 + ai * 128 + m * 16); const f32x4 v0 = acc[ai][0][m][0], v1 = acc[ai][0][m][1];
                        if (c8 < 32) { u32x4 w; w.x = cvt_pk_bf16(v0[0], v0[1]); w.y = cvt_pk_bf16(v0[2], v0[3]); w.z = cvt_pk_bf16(v1[0], v1[1]); w.w = cvt_pk_bf16(v1[2], v1[3]);
                            *(u32x4*)((bf16_t*)(ws + WS_IK) + row * 32 + c8) = w; }
                        else if (c8 < 48) { float* p = (float*)(ws + WS_IW) + row * 16 + (c8 - 32); *(f32x4*)p = v0; *(f32x4*)(p + 4) = v1; }
                        else { u32x4 w; w.x = cvt_pk_bf16(v0[0], v0[1]); w.y = cvt_pk_bf16(v0[2], v0[3]); w.z = cvt_pk_bf16(v1[0], v1[1]); w.w = cvt_pk_bf16(v1[2], v1[3]);
                            *(u32x4*)((bf16_t*)(ws + WS_GLR) + row * 16 + (c8 - 48)) = w; } }
            }
        }
    }
};

typedef float f32x4_t __attribute__((ext_vector_type(4)));
constexpr int SC_TILES_PER_B = 528, SC_ITEMS = NB * SC_TILES_PER_B;
__device__ __forceinline__ size_t keys_row_dw(int b, int t) {
    const int qi = t >> 7, r = t & 127; return (size_t)b * (SC_TILES_PER_B * 8192) + (size_t)8192 * (qi * (qi + 1) / 2) + (size_t)r * (qi + 1) * 64;
}
__device__ __forceinline__ unsigned score_key(float sc) {
    const _Float16 hf = (_Float16)sc; const unsigned short hb = __builtin_bit_cast(unsigned short, hf);
    return (hb & 0x8000u) ? (unsigned)(unsigned short)~hb : (unsigned)(hb | 0x8000u);
}
__device__ __forceinline__ void p3a_item(int item, unsigned char* ws, int wave, int lane) {
    const int b = item / SC_TILES_PER_B; int idx = item % SC_TILES_PER_B; int qi = 0; while ((qi + 1) * (qi + 2) / 2 <= idx) ++qi; const int kj = idx - qi * (qi + 1) / 2;
    const int fr = lane & 15, fq = lane >> 4;
    const int t = qi * 128 + wave * 16 + fr; const size_t trow = (size_t)b * NS + t;
    const bf16_t* IQ = (const bf16_t*)(ws + WS_IQ) + trow * 512 + 8 * fq;
    const bf16_t* IK = (const bf16_t*)(ws + WS_IK) + ((size_t)b * NS + kj * 128 + fr) * 32 + 8 * fq;
    const float* IW = (const float*)(ws + WS_IW) + trow * 16;
    bf16x8 kf[8];
#pragma unroll
    for (int kb = 0; kb < 8; ++kb) kf[kb] = *(const bf16x8*)(IK + (size_t)kb * 16 * 32);
    f32x4 acc[8];
#pragma unroll
    for (int kb = 0; kb < 8; ++kb) acc[kb] = (f32x4){0.f, 0.f, 0.f, 0.f};
#pragma unroll 4
    for (int h = 0; h < I_HEADS; ++h) {
        const bf16x8 qf = *(const bf16x8*)(IQ + h * 32); const float w = IW[h] * 0.044194173824159216f;
#pragma unroll
        for (int kb = 0; kb < 8; ++kb) { const f32x4 d = __builtin_amdgcn_mfma_f32_16x16x32_bf16(kf[kb], qf, (f32x4){0.f, 0.f, 0.f, 0.f}, 0, 0, 0);
            acc[kb][0] += w * fmaxf(d[0], 0.f); acc[kb][1] += w * fmaxf(d[1], 0.f); acc[kb][2] += w * fmaxf(d[2], 0.f); acc[kb][3] += w * fmaxf(d[3], 0.f); }
    }
    unsigned* KEYS = (unsigned*)(ws + WS_SC) + keys_row_dw(b, t) + (size_t)kj * 64;
    const bool diag = (kj == qi);
#pragma unroll
    for (int kb = 0; kb < 4; ++kb) { u32x4 o;
#pragma unroll
        for (int r = 0; r < 4; ++r) { const int sl = kb * 16 + 4 * fq + r;
            unsigned lo = score_key(acc[kb][r]), hi = score_key(acc[kb + 4][r]);
            if (diag) { const int tl = wave * 16 + fr; if (sl > tl) lo = 0u; if (sl + 64 > tl) hi = 0u; }
            o[r] = lo | (hi << 16); }
        *(u32x4*)(KEYS + kb * 16 + 4 * fq) = o; }
}

__device__ __forceinline__ int dpp_row_sum(int v) {
    v += __builtin_amdgcn_update_dpp(0, v, 0xB1, 0xF, 0xF, true);
    v += __builtin_amdgcn_update_dpp(0, v, 0x4E, 0xF, 0xF, true);
    v += __builtin_amdgcn_update_dpp(0, v, 0x141, 0xF, 0xF, true);
    v += __builtin_amdgcn_update_dpp(0, v, 0x140, 0xF, 0xF, true);
    return v;
}
__device__ __forceinline__ int wave_sum_i(int v) {
    v = dpp_row_sum(v);
    return __builtin_amdgcn_readlane(v, 0) + __builtin_amdgcn_readlane(v, 16) + __builtin_amdgcn_readlane(v, 32) + __builtin_amdgcn_readlane(v, 48);
}
__device__ __forceinline__ unsigned pk_ge_count(unsigned x, unsigned c2m1, unsigned one2, unsigned cnt2) {
    unsigned d;
    asm volatile("v_pk_sub_u16 %0, %1, %2 clamp\n\tv_pk_min_u16 %0, %0, %3\n\tv_pk_add_u16 %0, %0, %4" : "=&v"(d) : "v"(x), "v"(c2m1), "v"(one2), "v"(cnt2));
    return d;
}
constexpr int TOPK = 256;
__device__ __forceinline__ void p4a_row(int row, unsigned char* ws, int lane) {
    const int b = row / NS, t = row % NS; unsigned long long* MASK = (unsigned long long*)(ws + WS_MASK) + (size_t)row * 64;
    const int nc = (t >> 7) + 1;
    if (t < TOPK) {
        if (lane < 2 * nc) { const int lo = lane * 64; unsigned long long m = 0ull; if (t >= lo + 63) m = ~0ull; else if (t >= lo) m = (2ull << (t - lo)) - 1ull; MASK[lane] = m; }
        return;
    }
    const unsigned* KEYS = (const unsigned*)(ws + WS_SC) + keys_row_dw(b, t) + lane;
    unsigned x[32];
#pragma unroll
    for (int c = 0; c < 32; ++c) x[c] = (c < nc) ? KEYS[c * 64] : 0u;
    const unsigned one2 = 0x00010001u;
    unsigned T = 0u;
    for (int bit = 15; bit >= 0; --bit) {
        const unsigned cand = T | (1u << bit); const unsigned c2m1 = (cand - 1u) * 0x00010001u; unsigned cnt2 = 0u;
#pragma unroll
        for (int c = 0; c < 32; ++c) if (c < nc) cnt2 = pk_ge_count(x[c], c2m1, one2, cnt2);
        const int cnt = wave_sum_i((int)((cnt2 & 0xFFFFu) + (cnt2 >> 16)));
        if (cnt >= TOPK) T = cand;
    }
    int cgt; { const unsigned c2m1 = T * 0x00010001u; unsigned cnt2 = 0u;
#pragma unroll
        for (int c = 0; c < 32; ++c) if (c < nc) cnt2 = pk_ge_count(x[c], c2m1, one2, cnt2);
        cgt = wave_sum_i((int)((cnt2 & 0xFFFFu) + (cnt2 >> 16))); }
    const int need = TOPK - cgt; int run = 0;
#pragma unroll
    for (int c = 0; c < 32; ++c) if (c < nc) {
        const unsigned klo = x[c] & 0xFFFFu, khi = x[c] >> 16;
        const unsigned long long elo = __ballot(klo == T), ehi = __ballot(khi == T);
        const int rlo = run + (int)__builtin_amdgcn_mbcnt_hi((unsigned)(elo >> 32), __builtin_amdgcn_mbcnt_lo((unsigned)elo, 0u));
        const int nlo = __builtin_popcountll(elo);
        const int rhi = run + nlo + (int)__builtin_amdgcn_mbcnt_hi((unsigned)(ehi >> 32), __builtin_amdgcn_mbcnt_lo((unsigned)ehi, 0u));
        run += nlo + __builtin_popcountll(ehi);
        const bool slo = (klo > T) || (klo == T && rlo < need), shi = (khi > T) || (khi == T && rhi < need);
        const unsigned long long mlo = __ballot(slo), mhi = __ballot(shi);
        if (lane == 0) { MASK[2 * c] = mlo; MASK[2 * c + 1] = mhi; }
    }
}

typedef float f32x16 __attribute__((ext_vector_type(16)));
typedef short s16x4 __attribute__((ext_vector_type(4)));
typedef float f32x2_t __attribute__((ext_vector_type(2))); typedef __bf16 bf16x2_t __attribute__((ext_vector_type(2)));
__device__ __forceinline__ unsigned cvtpk_s(float lo, float hi) { f32x2_t v = {lo, hi}; bf16x2_t b = __builtin_convertvector(v, bf16x2_t); return __builtin_bit_cast(unsigned, b); }
__device__ __forceinline__ int crow(int r, int hi) { return (r & 3) + 8 * (r >> 2) + 4 * hi; }
__device__ __forceinline__ s16x4 vtr(const LAS unsigned char* p) { return __builtin_bit_cast(s16x4, __builtin_amdgcn_ds_read_tr16_b64_v4i16((LAS s16x4*)p)); }
constexpr size_t WS_OA = 358 * MiB, WS_OB = 390 * MiB;
constexpr int AT_ROWB = 144, AT_TILE = 64 * AT_ROWB, AT_K = 0, AT_V = 2 * AT_TILE, AT_BT = 4 * AT_TILE;
constexpr float LOG2E = 1.4426950408889634f;
__device__ __forceinline__ void attn_unit(int b, int h, int Q, const float* rel_bias, unsigned char* ws, LAS unsigned char* lds) {
    const int tid = threadIdx.x, lane = tid & 63, wave = __builtin_amdgcn_readfirstlane(tid >> 6), r32 = lane & 31, hh = lane >> 5;
    const size_t rowbase = (size_t)b * NS; const int t0w = 256 * Q + 32 * wave, t = t0w + r32;
    const bf16_t* QKV = (const bf16_t*)(ws + WS_QKV);
    LAS float* BT = (LAS float*)(lds + AT_BT);
    __syncthreads();
    if (tid < 256) BT[tid] = rel_bias[v0_bucket(tid) * A_HEADS + h] * LOG2E;
    const float cB = rel_bias[31 * A_HEADS + h] * LOG2E;
    bf16x8 qr[4];
#pragma unroll
    for (int ks = 0; ks < 4; ++ks) qr[ks] = *(const bf16x8*)(QKV + (rowbase + t) * 1536 + h * 64 + 16 * ks + 8 * hh);
    const int NTL = 4 * (Q + 1);
    const int lastw = (t0w + 31) >> 6;
    const int srow = tid >> 3, sch = tid & 7;
    const bf16_t* kg = QKV + (rowbase + srow) * 1536 + 512 + h * 64 + sch * 8; const bf16_t* vg = kg + 512;
    const int soff = srow * AT_ROWB + sch * 16;
    u32x4 kreg = *(const u32x4*)kg, vreg = *(const u32x4*)vg;
    const unsigned long long* MK = (const unsigned long long*)(ws + WS_MASK) + (rowbase + t) * 64;
    unsigned long long mcur = MK[0], mnext = 0ull;
    *(LAS u32x4*)(lds + AT_K + soff) = kreg; *(LAS u32x4*)(lds + AT_V + soff) = vreg;
    f32x16 o0, o1;
#pragma unroll
    for (int i = 0; i < 16; ++i) { o0[i] = 0.f; o1[i] = 0.f; }
    float m = -INFINITY, l = 0.f;
    const int q4 = (lane & 15) >> 2, p4 = lane & 3, blk = (lane >> 4) & 1;
    const int voff = (4 * hh + q4) * AT_ROWB + (16 * blk + 4 * p4) * 2;
    for (int kt = 0; kt < NTL; ++kt) {
        __syncthreads();
        const int cur = kt & 1;
        const bool more = (kt + 1 < NTL);
        if (more) { kreg = *(const u32x4*)(kg + (size_t)(kt + 1) * 64 * 1536); vreg = *(const u32x4*)(vg + (size_t)(kt + 1) * 64 * 1536); if (kt + 1 <= lastw) mnext = MK[kt + 1]; }
        if (kt <= lastw) {
            const LAS unsigned char* Kb = lds + AT_K + cur * AT_TILE; const LAS unsigned char* Vb = lds + AT_V + cur * AT_TILE;
            const bool far = (t0w - (64 * kt + 63) >= 113);
            f32x16 p0, p1;
            const float c0 = far ? cB : 0.f;
#pragma unroll
            for (int i = 0; i < 16; ++i) { p0[i] = c0; p1[i] = c0; }
#pragma unroll
            for (int ks = 0; ks < 4; ++ks) {
                const bf16x8 k0 = *(const LAS bf16x8*)(Kb + r32 * AT_ROWB + 32 * ks + 16 * hh);
                const bf16x8 k1 = *(const LAS bf16x8*)(Kb + (32 + r32) * AT_ROWB + 32 * ks + 16 * hh);
                p0 = __builtin_amdgcn_mfma_f32_32x32x16_bf16(k0, qr[ks], p0, 0, 0, 0);
                p1 = __builtin_amdgcn_mfma_f32_32x32x16_bf16(k1, qr[ks], p1, 0, 0, 0);
            }
            if (!far) {
                const int d0 = t - 64 * kt - 4 * hh;
#pragma unroll
                for (int i = 0; i < 16; ++i) { const int dd = d0 - ((i & 3) + 8 * (i >> 2)); const int da = dd < 0 ? 0 : dd, db = dd - 32 < 0 ? 0 : dd - 32; p0[i] += BT[da]; p1[i] += BT[db]; }
            }
            float mx = p0[0];
#pragma unroll
            for (int i = 1; i < 16; ++i) mx = fmaxf(mx, p0[i]);
#pragma unroll
            for (int i = 0; i < 16; ++i) mx = fmaxf(mx, p1[i]);
            mx = fmaxf(mx, __shfl_xor(mx, 32));
            const float mn = fmaxf(m, mx); const float alpha = __builtin_amdgcn_exp2f(m - mn); m = mn;
            const unsigned wl = (unsigned)mcur >> (4 * hh), wh = (unsigned)(mcur >> 32) >> (4 * hh);
            float ls = 0.f;
#pragma unroll
            for (int i = 0; i < 16; ++i) { const int c = (i & 3) + 8 * (i >> 2);
                const int m0 = ((int)(wl << (31 - c))) >> 31, m1 = ((int)(wh << (31 - c))) >> 31;
                p0[i] = __uint_as_float(__float_as_uint(__builtin_amdgcn_exp2f(p0[i] - mn)) & (unsigned)m0);
                p1[i] = __uint_as_float(__float_as_uint(__builtin_amdgcn_exp2f(p1[i] - mn)) & (unsigned)m1);
                ls += p0[i] + p1[i]; }
            l = l * alpha + ls;
#pragma unroll
            for (int i = 0; i < 16; ++i) { o0[i] *= alpha; o1[i] *= alpha; }
#pragma unroll
            for (int kb = 0; kb < 2; ++kb)
#pragma unroll
                for (int s = 0; s < 2; ++s) {
                    u32x4 pw;
                    if (kb == 0) { pw.x = cvtpk_s(p0[8 * s], p0[8 * s + 1]); pw.y = cvtpk_s(p0[8 * s + 2], p0[8 * s + 3]); pw.z = cvtpk_s(p0[8 * s + 4], p0[8 * s + 5]); pw.w = cvtpk_s(p0[8 * s + 6], p0[8 * s + 7]); }
                    else { pw.x = cvtpk_s(p1[8 * s], p1[8 * s + 1]); pw.y = cvtpk_s(p1[8 * s + 2], p1[8 * s + 3]); pw.z = cvtpk_s(p1[8 * s + 4], p1[8 * s + 5]); pw.w = cvtpk_s(p1[8 * s + 6], p1[8 * s + 7]); }
                    const bf16x8 pf = __builtin_bit_cast(bf16x8, pw);
                    const LAS unsigned char* vp = Vb + (32 * kb + 16 * s) * AT_ROWB + voff;
                    const s16x4 a0l = vtr(vp), a0h = vtr(vp + 8 * AT_ROWB), a1l = vtr(vp + 64), a1h = vtr(vp + 8 * AT_ROWB + 64);
                    const bf16x8 va0 = (bf16x8){a0l[0], a0l[1], a0l[2], a0l[3], a0h[0], a0h[1], a0h[2], a0h[3]};
                    const bf16x8 va1 = (bf16x8){a1l[0], a1l[1], a1l[2], a1l[3], a1h[0], a1h[1], a1h[2], a1h[3]};
                    o0 = __builtin_amdgcn_mfma_f32_32x32x16_bf16(va0, pf, o0, 0, 0, 0);
                    o1 = __builtin_amdgcn_mfma_f32_32x32x16_bf16(va1, pf, o1, 0, 0, 0);
                }
        }
        if (more) { const int nb = cur ^ 1; *(LAS u32x4*)(lds + AT_K + nb * AT_TILE + soff) = kreg; *(LAS u32x4*)(lds + AT_V + nb * AT_TILE + soff) = vreg; mcur = mnext; }
    }
    l += __shfl_xor(l, 32);
    const float inv = 1.f / l;
    bf16_t* O = (bf16_t*)(ws + WS_OA) + (rowbase + t) * 512 + h * 64 + 4 * hh;
#pragma unroll
    for (int g = 0; g < 4; ++g) {
        u32x2 w0, w1; w0.x = cvtpk_s(o0[4 * g] * inv, o0[4 * g + 1] * inv); w0.y = cvtpk_s(o0[4 * g + 2] * inv, o0[4 * g + 3] * inv);
        w1.x = cvtpk_s(o1[4 * g] * inv, o1[4 * g + 1] * inv); w1.y = cvtpk_s(o1[4 * g + 2] * inv, o1[4 * g + 3] * inv);
        *(u32x2*)(O + 8 * g) = w0; *(u32x2*)(O + 32 + 8 * g) = w1;
    }
}

constexpr int GL_LG = 0, GL_SEG = 16384, GL_A = 18432, GL_B = GL_A + 9216, GL_C = GL_B + 9216, GL_VT = GL_C + 9216, GL_ST = GL_VT + 18432;
constexpr int GROWB = 144;
constexpr int GLA_ITEMS = NB * G_HEADS * 64;
__device__ __forceinline__ void gla_cumdecay(size_t r0, int h, const float* wg, const float* bg, unsigned char* ws, LAS unsigned char* lds) {
    const int tid = threadIdx.x; LAS float* LG = (LAS float*)(lds + GL_LG); LAS float* SEG = (LAS float*)(lds + GL_SEG);
    {   const int c = tid >> 3, dg = tid & 7; const bf16_t* gp = (const bf16_t*)(ws + WS_GLR) + (r0 + c) * 16;
        const u32x4 g0 = *(const u32x4*)gp, g1 = *(const u32x4*)(gp + 8); float gl[16];
#pragma unroll
        for (int j = 0; j < 4; ++j) { gl[2 * j] = __uint_as_float(g0[j] << 16); gl[2 * j + 1] = __uint_as_float(g0[j] & 0xffff0000u); gl[8 + 2 * j] = __uint_as_float(g1[j] << 16); gl[8 + 2 * j + 1] = __uint_as_float(g1[j] & 0xffff0000u); }
        float z[8];
#pragma unroll
        for (int j = 0; j < 8; ++j) z[j] = bg[h * 64 + 8 * dg + j];
#pragma unroll
        for (int r = 0; r < 16; ++r) { const f32x4 w0 = *(const f32x4*)(wg + r * G_KW + h * 64 + 8 * dg), w1 = *(const f32x4*)(wg + r * G_KW + h * 64 + 8 * dg + 4);
            z[0] += gl[r] * w0[0]; z[1] += gl[r] * w0[1]; z[2] += gl[r] * w0[2]; z[3] += gl[r] * w0[3]; z[4] += gl[r] * w1[0]; z[5] += gl[r] * w1[1]; z[6] += gl[r] * w1[2]; z[7] += gl[r] * w1[3]; }
#pragma unroll
        for (int j = 0; j < 8; ++j) z[j] = (fminf(z[j], 0.f) - log1pf(__expf(-fabsf(z[j])))) * (1.f / 16.f);
        *(LAS f32x4*)(LG + c * 64 + 8 * dg) = (f32x4){z[0], z[1], z[2], z[3]}; *(LAS f32x4*)(LG + c * 64 + 8 * dg + 4) = (f32x4){z[4], z[5], z[6], z[7]};
    }
    __syncthreads();
    const int seg = tid >> 6, d = tid & 63; float v[8];
#pragma unroll
    for (int i = 0; i < 8; ++i) v[i] = LG[(8 * seg + i) * 64 + d];
#pragma unroll
    for (int i = 1; i < 8; ++i) v[i] += v[i - 1];
    SEG[seg * 64 + d] = v[7];
    __syncthreads();
    float off = 0.f;
#pragma unroll
    for (int s2 = 0; s2 < 8; ++s2) if (s2 < seg) off += SEG[s2 * 64 + d];
#pragma unroll
    for (int i = 0; i < 8; ++i) LG[(8 * seg + i) * 64 + d] = v[i] + off;
    __syncthreads();
}
__device__ __forceinline__ void bf8_to_f(const u32x4 w, float* f) {
#pragma unroll
    for (int j = 0; j < 4; ++j) { f[2 * j] = __uint_as_float(w[j] << 16); f[2 * j + 1] = __uint_as_float(w[j] & 0xffff0000u); }
}
__device__ __forceinline__ unsigned short f2bf_s(float f) { return (unsigned short)(cvtpk_s(f, 0.f) & 0xffffu); }
__device__ __forceinline__ void gla_stage_vt(size_t r0, int h, unsigned char* ws, LAS unsigned char* lds) {
    const int tid = threadIdx.x, c = tid >> 3, d0 = (tid & 7) * 16; const bf16_t* vp = (const bf16_t*)(ws + WS_GV) + (r0 + c) * 512 + h * 128 + d0;
    const u32x4 a = *(const u32x4*)vp, b2 = *(const u32x4*)(vp + 8);
#pragma unroll
    for (int j = 0; j < 4; ++j) {
        *(LAS unsigned short*)(lds + GL_VT + (d0 + 2 * j) * GROWB + c * 2) = (unsigned short)(a[j] & 0xffffu); *(LAS unsigned short*)(lds + GL_VT + (d0 + 2 * j + 1) * GROWB + c * 2) = (unsigned short)(a[j] >> 16);
        *(LAS unsigned short*)(lds + GL_VT + (d0 + 8 + 2 * j) * GROWB + c * 2) = (unsigned short)(b2[j] & 0xffffu); *(LAS unsigned short*)(lds + GL_VT + (d0 + 8 + 2 * j + 1) * GROWB + c * 2) = (unsigned short)(b2[j] >> 16); }
}
__device__ __forceinline__ void p3b_item(int it, const float* wg, const float* bg, float* UT, unsigned char* ws, LAS unsigned char* lds) {
    const int tid = threadIdx.x, lane = tid & 63, wave = tid >> 6, fr = lane & 15, fq = lane >> 4;
    const int bh = it >> 6, n = it & 63, b = bh >> 2, h = bh & 3; const size_t r0 = (size_t)b * NS + 64 * n;
    __syncthreads();
    gla_cumdecay(r0, h, wg, bg, ws, lds);
    const LAS float* LG = (const LAS float*)(lds + GL_LG);
    {   const int c = tid >> 3, dg = tid & 7; float kf[8]; bf8_to_f(*(const u32x4*)((const bf16_t*)(ws + WS_GQK) + (r0 + c) * 512 + 256 + h * 64 + 8 * dg), kf);
#pragma unroll
        for (int j = 0; j < 8; ++j) { const int d = 8 * dg + j; *(LAS unsigned short*)(lds + GL_A + d * GROWB + c * 2) = f2bf_s(kf[j] * __expf(LG[63 * 64 + d] - LG[c * 64 + d])); }
        if (tid < 64) ((float*)(ws + WS_MISC))[(size_t)it * 64 + tid] = __expf(LG[63 * 64 + tid]);
    }
    gla_stage_vt(r0, h, ws, lds);
    __syncthreads();
    f32x4 acc[4];
#pragma unroll
    for (int i = 0; i < 4; ++i) acc[i] = (f32x4){0.f, 0.f, 0.f, 0.f};
#pragma unroll
    for (int ks = 0; ks < 2; ++ks) { const bf16x8 bv = *(const LAS bf16x8*)(lds + GL_VT + (16 * wave + fr) * GROWB + (32 * ks + 8 * fq) * 2);
#pragma unroll
        for (int i = 0; i < 4; ++i) { const bf16x8 av = *(const LAS bf16x8*)(lds + GL_A + (16 * i + fr) * GROWB + (32 * ks + 8 * fq) * 2); acc[i] = __builtin_amdgcn_mfma_f32_16x16x32_bf16(av, bv, acc[i], 0, 0, 0); } }
#pragma unroll
    for (int i = 0; i < 4; ++i) *(f32x4*)(UT + ((size_t)it * 128 + 16 * wave + fr) * 64 + 16 * i + 4 * fq) = acc[i];
}
__device__ __forceinline__ void p4b_item(int j, const float* UT, bf16_t* SP, unsigned char* ws) {
    const int tid = threadIdx.x, bh = j >> 2, dv = (j & 3) * 32 + (tid >> 4), dk = (tid & 15) * 4; const float* DEC = (const float*)(ws + WS_MISC);
    f32x4 st = (f32x4){0.f, 0.f, 0.f, 0.f};
#pragma unroll 4
    for (int n = 0; n < 64; ++n) { const size_t it = (size_t)bh * 64 + n; const size_t o = (it * 128 + dv) * 64 + dk;
        u32x2 w; w.x = cvtpk_s(st[0], st[1]); w.y = cvtpk_s(st[2], st[3]); *(u32x2*)(SP + o) = w;
        const f32x4 u = *(const f32x4*)(UT + o), dc = *(const f32x4*)(DEC + it * 64 + dk); st = dc * st + u; }
}
__device__ __forceinline__ void p5b_item(int it, const float* wg, const float* bg, const float* ng, const bf16_t* SP, unsigned char* ws, LAS unsigned char* lds) {
    const int tid = threadIdx.x, lane = tid & 63, wave = tid >> 6, r32 = lane & 31, hh = lane >> 5;
    const int bh = it >> 6, n = it & 63, b = bh >> 2, h = bh & 3; const size_t r0 = (size_t)b * NS + 64 * n;
    __syncthreads();
    gla_cumdecay(r0, h, wg, bg, ws, lds);
    const LAS float* LG = (const LAS float*)(lds + GL_LG);
    {   const int c = tid >> 3, dg = tid & 7; const bf16_t* qp = (const bf16_t*)(ws + WS_GQK) + (r0 + c) * 512 + h * 64 + 8 * dg; float qf[8], kf[8]; bf8_to_f(*(const u32x4*)qp, qf); bf8_to_f(*(const u32x4*)(qp + 256), kf);
        float qr[8], ks[8], qi[8];
#pragma unroll
        for (int j = 0; j < 8; ++j) { const int d = 8 * dg + j; const float bc = LG[c * 64 + d], bl = LG[63 * 64 + d]; const float q8 = qf[j] * 0.125f;
            qr[j] = q8 * __expf(bc - bl); ks[j] = kf[j] * __expf(bl - bc); qi[j] = q8 * __expf(bc); }
        u32x4 w;
        w.x = cvtpk_s(qr[0], qr[1]); w.y = cvtpk_s(qr[2], qr[3]); w.z = cvtpk_s(qr[4], qr[5]); w.w = cvtpk_s(qr[6], qr[7]); *(LAS u32x4*)(lds + GL_A + c * GROWB + 16 * dg) = w;
        w.x = cvtpk_s(ks[0], ks[1]); w.y = cvtpk_s(ks[2], ks[3]); w.z = cvtpk_s(ks[4], ks[5]); w.w = cvtpk_s(ks[6], ks[7]); *(LAS u32x4*)(lds + GL_B + c * GROWB + 16 * dg) = w;
        w.x = cvtpk_s(qi[0], qi[1]); w.y = cvtpk_s(qi[2], qi[3]); w.z = cvtpk_s(qi[4], qi[5]); w.w = cvtpk_s(qi[6], qi[7]); *(LAS u32x4*)(lds + GL_C + c * GROWB + 16 * dg) = w;
    }
    gla_stage_vt(r0, h, ws, lds);
    __syncthreads();
    const int dvb = wave >> 1, cb = wave & 1;
    f32x16 o;
#pragma unroll
    for (int i = 0; i < 16; ++i) o[i] = 0.f;
#pragma unroll
    for (int jb = 0; jb < 2; ++jb) if (jb <= cb) {
        f32x16 at;
#pragma unroll
        for (int i = 0; i < 16; ++i) at[i] = 0.f;
#pragma unroll
        for (int ks = 0; ks < 4; ++ks) { const bf16x8 av = *(const LAS bf16x8*)(lds + GL_B + (32 * jb + r32) * GROWB + 32 * ks + 16 * hh), bv = *(const LAS bf16x8*)(lds + GL_A + (32 * cb + r32) * GROWB + 32 * ks + 16 * hh);
            at = __builtin_amdgcn_mfma_f32_32x32x16_bf16(av, bv, at, 0, 0, 0); }
        if (jb == cb) {
#pragma unroll
            for (int i = 0; i < 16; ++i) if (crow(i, hh) > r32) at[i] = 0.f; }
#pragma unroll
        for (int s = 0; s < 2; ++s) {
            u32x4 pw; pw.x = cvtpk_s(at[8 * s], at[8 * s + 1]); pw.y = cvtpk_s(at[8 * s + 2], at[8 * s + 3]); pw.z = cvtpk_s(at[8 * s + 4], at[8 * s + 5]); pw.w = cvtpk_s(at[8 * s + 6], at[8 * s + 7]);
            const LAS unsigned char* vp = lds + GL_VT + (32 * dvb + r32) * GROWB + (32 * jb + 16 * s + 4 * hh) * 2;
            const u32x2 lo = *(const LAS u32x2*)vp, hi = *(const LAS u32x2*)(vp + 16);
            const u32x4 va = (u32x4){lo.x, lo.y, hi.x, hi.y};
            o = __builtin_amdgcn_mfma_f32_32x32x16_bf16(__builtin_bit_cast(bf16x8, va), __builtin_bit_cast(bf16x8, pw), o, 0, 0, 0);
        }
    }
#pragma unroll
    for (int ks = 0; ks < 4; ++ks) { const bf16x8 av = *(const bf16x8*)(SP + ((size_t)it * 128 + 32 * dvb + r32) * 64 + 16 * ks + 8 * hh), bv = *(const LAS bf16x8*)(lds + GL_C + (32 * cb + r32) * GROWB + 32 * ks + 16 * hh);
        o = __builtin_amdgcn_mfma_f32_32x32x16_bf16(av, bv, o, 0, 0, 0); }
    LAS float* ST = (LAS float*)(lds + GL_ST);
    float sm = 0.f;
#pragma unroll
    for (int i = 0; i < 16; ++i) sm += o[i];
    sm += __shfl_xor(sm, 32);
    if (hh == 0) ST[dvb * 64 + 32 * cb + r32] = sm;
    __syncthreads();
    const float mean = (ST[32 * cb + r32] + ST[64 + 32 * cb + r32] + ST[128 + 32 * cb + r32] + ST[192 + 32 * cb + r32]) * (1.f / 128.f);
    float sq = 0.f;
#pragma unroll
    for (int i = 0; i < 16; ++i) { o[i] -= mean; sq += o[i] * o[i]; }
    sq += __shfl_xor(sq, 32);
    if (hh == 0) ST[256 + dvb * 64 + 32 * cb + r32] = sq;
    __syncthreads();
    const float var = (ST[256 + 32 * cb + r32] + ST[256 + 64 + 32 * cb + r32] + ST[256 + 128 + 32 * cb + r32] + ST[256 + 192 + 32 * cb + r32]) * (1.f / 128.f);
    const float rstd = 1.f / sqrtf(var + LN_EPS);
    const size_t trow = r0 + 32 * cb + r32; const int dvbase = h * 128 + 32 * dvb + 4 * hh;
    const bf16_t* grp = (const bf16_t*)(ws + WS_GR) + trow * 512 + dvbase; bf16_t* op = (bf16_t*)(ws + WS_OB) + trow * 512 + dvbase;
#pragma unroll
    for (int g = 0; g < 4; ++g) { const u32x2 gw = *(const u32x2*)(grp + 8 * g); const f32x4 nv = *(const f32x4*)(ng + dvbase + 8 * g);
        float gr[4] = {__uint_as_float(gw.x << 16), __uint_as_float(gw.x & 0xffff0000u), __uint_as_float(gw.y << 16), __uint_as_float(gw.y & 0xffff0000u)}; float y[4];
#pragma unroll
        for (int e = 0; e < 4; ++e) y[e] = o[4 * g + e] * rstd * nv[e] * (gr[e] / (1.f + __expf(-gr[e])));
        u32x2 w; w.x = cvtpk_s(y[0], y[1]); w.y = cvtpk_s(y[2], y[3]); *(u32x2*)(op + 8 * g) = w; }
}

constexpr size_t WS_SG = 129 * MiB;
constexpr size_t WS_MRG = 257 * MiB;
constexpr size_t WS_H2 = WS_XN;
constexpr size_t WS_XG = 129 * MiB;
constexpr size_t WS_HID = 321 * MiB;
constexpr size_t WS_YG = 358 * MiB;
constexpr size_t WS_EID = WS_MISC + 1 * MiB, WS_EW = WS_EID + 256 * 1024, WS_POS = WS_EW + 256 * 1024;
constexpr int LDS_TAB = 131072;
__device__ __forceinline__ u32x4 pack8(const f32x4 a, const f32x4 b) { u32x4 w; w.x = cvtpk_s(a[0], a[1]); w.y = cvtpk_s(a[2], a[3]); w.z = cvtpk_s(b[0], b[1]); w.w = cvtpk_s(b[2], b[3]); return w; }
__device__ __forceinline__ f32x4 sig4(const f32x4 v) { f32x4 r; r[0] = 1.f / (1.f + __expf(-v[0])); r[1] = 1.f / (1.f + __expf(-v[1])); r[2] = 1.f / (1.f + __expf(-v[2])); r[3] = 1.f / (1.f + __expf(-v[3])); return r; }
__device__ __forceinline__ void unpack8(const u32x4 w, f32x4& a, f32x4& b) {
    a[0] = __uint_as_float(w.x << 16); a[1] = __uint_as_float(w.x & 0xffff0000u); a[2] = __uint_as_float(w.y << 16); a[3] = __uint_as_float(w.y & 0xffff0000u);
    b[0] = __uint_as_float(w.z << 16); b[1] = __uint_as_float(w.z & 0xffff0000u); b[2] = __uint_as_float(w.w << 16); b[3] = __uint_as_float(w.w & 0xffff0000u);
}
#define EPI_ROWS(...) _Pragma("unroll") for (int ai = 0; ai < 2; ++ai) _Pragma("unroll") for (int m = 0; m < 4; ++m) { const size_t row = (size_t)(row0 + ai * 128 + m * 16); _Pragma("unroll") for (int bj = 0; bj < 2; ++bj) { __VA_ARGS__ } }
struct EpiSig {
    static constexpr bool PERM = true, AFTER_DRAIN = false; unsigned char* ws;
    __device__ __forceinline__ void operator()(const f32x4 (&acc)[2][2][4][2], const Unit& u, int wr, int wc, int fr, int fq) const {
        const int row0 = u.pm * 256 + wr * 64 + fr, col0 = u.pn * 256 + wc * 32 + 8 * fq; bf16_t* SG = (bf16_t*)(ws + WS_SG);
        EPI_ROWS( *(u32x4*)(SG + row * 2048 + col0 + bj * 128) = pack8(sig4(acc[ai][bj][m][0]), sig4(acc[ai][bj][m][1])); )
    }
};
template <int PASS> struct EpiMrg {
    static constexpr bool PERM = true, AFTER_DRAIN = false; unsigned char* ws;
    __device__ __forceinline__ void operator()(const f32x4 (&acc)[2][2][4][2], const Unit& u, int wr, int wc, int fr, int fq) const {
        const int row0 = u.pm * 256 + wr * 64 + fr, col0 = u.pn * 256 + wc * 32 + 8 * fq; const bf16_t* SG = (const bf16_t*)(ws + WS_SG) + PASS * 1024; bf16_t* MR = (bf16_t*)(ws + WS_MRG);
        EPI_ROWS( f32x4 g0, g1; unpack8(*(const u32x4*)(SG + row * 2048 + col0 + bj * 128), g0, g1); f32x4 r0 = g0 * acc[ai][bj][m][0], r1 = g1 * acc[ai][bj][m][1];
                  if (PASS == 1) { f32x4 p0, p1; unpack8(*(const u32x4*)(MR + row * 1024 + col0 + bj * 128), p0, p1); r0 += p0; r1 += p1; }
                  *(u32x4*)(MR + row * 1024 + col0 + bj * 128) = pack8(r0, r1); )
    }
};
struct EpiV {
    static constexpr bool PERM = false, AFTER_DRAIN = false; const float* x; const float* ada; float* out;
    __device__ __forceinline__ void operator()(const f32x4 (&acc)[2][2][4][2], const Unit& u, int wr, int wc, int fr, int fq) const {
        const int row0 = u.pm * 256 + wr * 64 + fr, col0 = u.pn * 256 + wc * 32 + 4 * fq; const float* gt1 = ada + (size_t)(u.pm >> 4) * 6 * D_MODEL + 2 * D_MODEL;
        EPI_ROWS( _Pragma("unroll") for (int n = 0; n < 2; ++n) { const int c = col0 + bj * 128 + n * 16; const f32x4 xv = *(const f32x4*)(x + row * D_MODEL + c), gv = *(const f32x4*)(gt1 + c);
                  *(f32x4*)(out + row * D_MODEL + c) = xv * DN_ALPHA + gv * acc[ai][bj][m][n]; } )
    }
};
struct EpiHid {
    static constexpr bool PERM = true, AFTER_DRAIN = false; unsigned char* ws;
    __device__ __forceinline__ void operator()(const f32x4 (&acc)[2][2][4][2], const Unit& u, int wr, int wc, int fr, int fq) const {
        const int row0 = u.pm * 256 + wr * 64 + fr, col0 = u.pn * 128 + wc * 32 + 8 * fq; bf16_t* H = (bf16_t*)(ws + WS_HID);
#pragma unroll
        for (int ai = 0; ai < 2; ++ai)
#pragma unroll
            for (int m = 0; m < 4; ++m) { const size_t row = (size_t)(row0 + ai * 128 + m * 16); f32x4 h0, h1;
#pragma unroll
                for (int e = 0; e < 4; ++e) { const float g0 = acc[ai][0][m][0][e], g1 = acc[ai][0][m][1][e]; h0[e] = g0 / (1.f + __expf(-g0)) * acc[ai][1][m][0][e]; h1[e] = g1 / (1.f + __expf(-g1)) * acc[ai][1][m][1][e]; }
                *(u32x4*)(H + row * 256 + col0) = pack8(h0, h1); }
    }
};
struct EpiY {
    static constexpr bool PERM = true, AFTER_DRAIN = false; unsigned char* ws;
    __device__ __forceinline__ void operator()(const f32x4 (&acc)[2][2][4][2], const Unit& u, int wr, int wc, int fr, int fq) const {
        const int row0 = u.pm * 256 + wr * 64 + fr, col0 = u.pn * 256 + wc * 32 + 8 * fq; bf16_t* Y = (bf16_t*)(ws + WS_YG);
        EPI_ROWS( *(u32x4*)(Y + row * 1024 + col0 + bj * 128) = pack8(acc[ai][bj][m][0], acc[ai][bj][m][1]); )
    }
};
__device__ __forceinline__ void build_tables(unsigned char* ws, LAS unsigned char* lds) {
    LAS int* toff = (LAS int*)(lds + LDS_TAB); LAS int* texp = toff + 64; const unsigned* gcnt = (const unsigned*)(ws + WS_CNT);
    __syncthreads();
    if (threadIdx.x == 0) { int o = 0; for (int e = 0; e < N_EXP; ++e) { toff[e] = o; o += ((int)gcnt[e * 32] + 255) >> 8; } toff[32] = o; }
    __syncthreads();
    for (int tl = threadIdx.x; tl < toff[32]; tl += NTHREADS) { int e = 0; while (toff[e + 1] <= tl) ++e; texp[tl] = e; }
    __syncthreads();
}
template <int NPN> struct GroupOrder {
    const LAS int* toff; const LAS int* texp; int G, c;
    __device__ __forceinline__ bool next(int i, Unit& u) const { const int L = i * G + c; if (L >= toff[32] * NPN) return false; const int tl = L / NPN, pn = L % NPN; u.pm = tl; u.pa = tl; u.pn = pn; u.pb = texp[tl] * NPN + pn; return true; }
    __device__ __forceinline__ void a_ready(const Unit&) const {}
    __device__ __forceinline__ void done(const Unit&) const {}
};
__device__ __forceinline__ float dpp_row_sum_f(float v) {
    v += __int_as_float(__builtin_amdgcn_update_dpp(0, __float_as_int(v), 0xB1, 0xF, 0xF, true));
    v += __int_as_float(__builtin_amdgcn_update_dpp(0, __float_as_int(v), 0x4E, 0xF, 0xF, true));
    v += __int_as_float(__builtin_amdgcn_update_dpp(0, __float_as_int(v), 0x141, 0xF, 0xF, true));
    v += __int_as_float(__builtin_amdgcn_update_dpp(0, __float_as_int(v), 0x140, 0xF, 0xF, true));
    return v;
}
__device__ __forceinline__ float wave_sum_u(float v) {
    v = dpp_row_sum_f(v);
    return (__int_as_float(__builtin_amdgcn_readlane(__float_as_int(v), 0)) + __int_as_float(__builtin_amdgcn_readlane(__float_as_int(v), 16)))
         + (__int_as_float(__builtin_amdgcn_readlane(__float_as_int(v), 32)) + __int_as_float(__builtin_amdgcn_readlane(__float_as_int(v), 48)));
}
__device__ __forceinline__ void p8_phase(const float* const* in, float* out, unsigned char* ws, LAS unsigned char* lds, int G) {
    const int tid = threadIdx.x, lane = tid & 63, wave = tid >> 6;
    LAS float* WT = (LAS float*)lds;
    LAS int* lcnt = (LAS int*)(lds + 147456); LAS int* lbase = lcnt + 32; LAS int* ent = lcnt + 64;
    const float* wrg = in[14]; const float* wre = in[16];
    __syncthreads();
    for (int i = tid; i < 36 * 1024; i += NTHREADS) { const int col = i >> 10, k = i & 1023; WT[i] = (col < 4) ? wrg[k * 4 + col] : wre[k * 32 + (col - 4)]; }
    const float* g1 = in[12]; const float* b1 = in[13]; const float* brg = in[15]; const float* bre = in[17];
    for (int blk = blockIdx.x; blk < NT / 128; blk += G) {
        const int b = blk / 32; const float* ada = (const float*)(ws + WS_ADA) + (size_t)b * 6 * D_MODEL; const float* sh2 = ada + 3 * D_MODEL; const float* sc2 = ada + 4 * D_MODEL;
        if (tid < 32) lcnt[tid] = 0;
        __syncthreads();
        for (int r = 0; r < 16; ++r) {
            const int rl = wave * 16 + r; const size_t row = (size_t)blk * 128 + rl;
            f32x4* xr = (f32x4*)(out + row * D_MODEL) + lane;
            f32x4 v[4]; float s = 0.f;
#pragma unroll
            for (int j = 0; j < 4; ++j) { v[j] = xr[64 * j]; s += (v[j].x + v[j].y) + (v[j].z + v[j].w); }
            float mean = wave_sum_u(s) * (1.f / D_MODEL); float s2 = 0.f;
#pragma unroll
            for (int j = 0; j < 4; ++j) { v[j] = v[j] - mean; s2 += (v[j].x * v[j].x + v[j].y * v[j].y) + (v[j].z * v[j].z + v[j].w * v[j].w); }
            float rstd = 1.f / sqrtf(wave_sum_u(s2) * (1.f / D_MODEL) + LN_EPS);
            s = 0.f;
#pragma unroll
            for (int j = 0; j < 4; ++j) { const f32x4 gg = *(const f32x4*)(g1 + 256 * j + 4 * lane), bb = *(const f32x4*)(b1 + 256 * j + 4 * lane); v[j] = v[j] * rstd * gg + bb; xr[64 * j] = v[j]; s += (v[j].x + v[j].y) + (v[j].z + v[j].w); }
            mean = wave_sum_u(s) * (1.f / D_MODEL); s2 = 0.f;
#pragma unroll
            for (int j = 0; j < 4; ++j) { v[j] = v[j] - mean; s2 += (v[j].x * v[j].x + v[j].y * v[j].y) + (v[j].z * v[j].z + v[j].w * v[j].w); }
            rstd = 1.f / sqrtf(wave_sum_u(s2) * (1.f / D_MODEL) + LN_EPS);
            u32x2* o8 = (u32x2*)((bf16_t*)(ws + WS_H2) + row * D_MODEL) + lane;
#pragma unroll
            for (int j = 0; j < 4; ++j) { const f32x4 a4 = *(const f32x4*)(sc2 + 256 * j + 4 * lane), c4 = *(const f32x4*)(sh2 + 256 * j + 4 * lane); v[j] = v[j] * rstd * (a4 + 1.f) + c4;
                u32x2 w; w.x = cvtpk_s(v[j].x, v[j].y); w.y = cvtpk_s(v[j].z, v[j].w); o8[64 * j] = w; }
            float gl[N_GROUPS];
#pragma unroll
            for (int g = 0; g < N_GROUPS; ++g) { float p = 0.f;
#pragma unroll
                for (int j = 0; j < 4; ++j) { const f32x4 w4 = *(const LAS f32x4*)(WT + g * 1024 + 256 * j + 4 * lane); p += (v[j].x * w4.x + v[j].y * w4.y) + (v[j].z * w4.z + v[j].w * w4.w); }
                gl[g] = wave_sum_u(p) + brg[g]; }
            int gi = 0; float gm = gl[0];
#pragma unroll
            for (int g = 1; g < N_GROUPS; ++g) if (gl[g] > gm) { gm = gl[g]; gi = g; }
            float gs = 0.f;
#pragma unroll
            for (int g = 0; g < N_GROUPS; ++g) gs += __expf(gl[g] - gm);
            const float gw = 1.f / gs;
            float v0 = -INFINITY, v1 = -INFINITY; int i0 = 0, i1 = 0;
            for (int e = 0; e < EPG; ++e) { float p = 0.f; const LAS float* wp = WT + (4 + gi * EPG + e) * 1024;
#pragma unroll
                for (int j = 0; j < 4; ++j) { const f32x4 w4 = *(const LAS f32x4*)(wp + 256 * j + 4 * lane); p += (v[j].x * w4.x + v[j].y * w4.y) + (v[j].z * w4.z + v[j].w * w4.w); }
                const float ev = wave_sum_u(p) + bre[gi * EPG + e];
                if (ev > v0) { v1 = v0; i1 = i0; v0 = ev; i0 = e; } else if (ev > v1) { v1 = ev; i1 = e; } }
            const float e1 = __expf(v1 - v0); const float w0 = gw / (1.f + e1), w1 = gw * e1 / (1.f + e1);
            if (lane == 0) { const int ea = gi * EPG + i0, eb = gi * EPG + i1;
                const int pa = atomicAdd((int*)&lcnt[ea], 1), pb = atomicAdd((int*)&lcnt[eb], 1);
                ent[rl * 2] = (ea << 16) | pa; ent[rl * 2 + 1] = (eb << 16) | pb;
                ((int*)(ws + WS_EID))[row * 2] = ea; ((int*)(ws + WS_EID))[row * 2 + 1] = eb; ((float*)(ws + WS_EW))[row * 2] = w0; ((float*)(ws + WS_EW))[row * 2 + 1] = w1; }
        }
        __syncthreads();
        if (tid < 32) lbase[tid] = (int)atomicAdd((unsigned*)(ws + WS_CNT) + tid * 32, (unsigned)lcnt[tid]);
        __syncthreads();
        if (tid < 256) { const int en = ent[tid]; ((int*)(ws + WS_POS))[(size_t)blk * 256 + tid] = lbase[en >> 16] + (en & 0xffff); }
        __syncthreads();
    }
}
__device__ __forceinline__ void p9_phase(unsigned char* ws, LAS unsigned char* lds, int G) {
    build_tables(ws, lds); const LAS int* toff = (const LAS int*)(lds + LDS_TAB);
    const int lane = threadIdx.x & 63, wave = threadIdx.x >> 6;
    for (int ts = blockIdx.x * NWAVES + wave; ts < NT * 2; ts += G * NWAVES) {
        const int e = ((const int*)(ws + WS_EID))[ts], pos = ((const int*)(ws + WS_POS))[ts]; const size_t dst = (size_t)toff[e] * 256 + pos;
        const u32x4* sp = (const u32x4*)((const bf16_t*)(ws + WS_H2) + (size_t)(ts >> 1) * D_MODEL); u32x4* dp = (u32x4*)((bf16_t*)(ws + WS_XG) + dst * D_MODEL);
        dp[lane] = sp[lane]; dp[lane + 64] = sp[lane + 64];
    }
}
__device__ __forceinline__ void p12_phase(const float* const* in, float* out, unsigned char* ws, LAS unsigned char* lds, int G) {
    build_tables(ws, lds); const LAS int* toff = (const LAS int*)(lds + LDS_TAB);
    const int lane = threadIdx.x & 63, wave = threadIdx.x >> 6; const float* g2 = in[21]; const float* b2 = in[22];
    for (int row = blockIdx.x * NWAVES + wave; row < NT; row += G * NWAVES) {
        const int b = row / NS; const float* gt2 = (const float*)(ws + WS_ADA) + (size_t)b * 6 * D_MODEL + 5 * D_MODEL;
        const int e0 = ((const int*)(ws + WS_EID))[row * 2], e1 = ((const int*)(ws + WS_EID))[row * 2 + 1]; const float w0 = ((const float*)(ws + WS_EW))[row * 2], w1 = ((const float*)(ws + WS_EW))[row * 2 + 1];
        const size_t r0 = (size_t)toff[e0] * 256 + ((const int*)(ws + WS_POS))[row * 2], r1 = (size_t)toff[e1] * 256 + ((const int*)(ws + WS_POS))[row * 2 + 1];
        const u32x2* y0 = (const u32x2*)((const bf16_t*)(ws + WS_YG) + r0 * D_MODEL) + lane; const u32x2* y1 = (const u32x2*)((const bf16_t*)(ws + WS_YG) + r1 * D_MODEL) + lane;
        f32x4* xr = (f32x4*)(out + (size_t)row * D_MODEL) + lane;
        f32x4 v[4]; float s = 0.f;
#pragma unroll
        for (int j = 0; j < 4; ++j) { const u32x2 a = y0[64 * j], c = y1[64 * j]; const f32x4 gv = *(const f32x4*)(gt2 + 256 * j + 4 * lane);
            f32x4 f; f.x = w0 * __uint_as_float(a.x << 16) + w1 * __uint_as_float(c.x << 16); f.y = w0 * __uint_as_float(a.x & 0xffff0000u) + w1 * __uint_as_float(c.x & 0xffff0000u);
            f.z = w0 * __uint_as_float(a.y << 16) + w1 * __uint_as_float(c.y << 16); f.w = w0 * __uint_as_float(a.y & 0xffff0000u) + w1 * __uint_as_float(c.y & 0xffff0000u);
            v[j] = xr[64 * j] * DN_ALPHA + gv * f; s += (v[j].x + v[j].y) + (v[j].z + v[j].w); }
        const float mean = wave_sum_u(s) * (1.f / D_MODEL); float s2 = 0.f;
#pragma unroll
        for (int j = 0; j < 4; ++j) { v[j] = v[j] - mean; s2 += (v[j].x * v[j].x + v[j].y * v[j].y) + (v[j].z * v[j].z + v[j].w * v[j].w); }
        const float rstd = 1.f / sqrtf(wave_sum_u(s2) * (1.f / D_MODEL) + LN_EPS);
#pragma unroll
        for (int j = 0; j < 4; ++j) { const f32x4 gg = *(const f32x4*)(g2 + 256 * j + 4 * lane), bb = *(const f32x4*)(b2 + 256 * j + 4 * lane); xr[64 * j] = v[j] * rstd * gg + bb; }
    }
}

constexpr int NPH = 14;
struct Args { const float* in[23]; float* out; unsigned char* ws; int ph_lo, ph_hi; };
__global__ void __launch_bounds__(NTHREADS, 2) mk_fwd(Args a) {
    extern __shared__ __attribute__((aligned(16))) unsigned char lds_raw[];
    LAS unsigned char* lds = (LAS unsigned char*)lds_raw;
    cg::grid_group grid = cg::this_grid();
    const int G = gridDim.x, tid = threadIdx.x, lane = tid & 63, wave = __builtin_amdgcn_readfirstlane(tid >> 6);
    const int lo = a.ph_lo, hi = a.ph_hi;
    unsigned char* ws = a.ws;
#ifndef PHMASK
#define PHMASK 0xFFFF
#endif
#define IN(k) (((PHMASK >> (k)) & 1) && lo <= (k) && (k) < hi)
#define SEAM(k) do { if (IN(k) && IN((k) + 1)) grid.sync(); } while (0)
    if (IN(0)) {
        if (blockIdx.x == 0 && tid < 32) ((unsigned*)(ws + WS_CNT))[tid * 32] = 0u;
        LAS float* scr = (LAS float*)(lds + wave * 16384);
        for (int it = blockIdx.x * NWAVES + wave; it < P0_ITEMS; it += G * NWAVES) p0_item(it, a.in, ws, scr, lane);
    }
    SEAM(0);
    if (IN(1)) p1_phase(a.in, ws, lds, G);
    SEAM(1);
    if (IN(2)) {
        pg8::Gemm g{(const bf16_t*)(ws + WS_XN), (const bf16_t*)(ws + WS_WIN), NT, NPROJ, D_MODEL}; pg8::StaticOrder S; S.init(NT, NPROJ, G, (int)blockIdx.x);
        EpiProj E{ws};
        pg8::gemm_phase<EpiProj, pg8::StaticOrder, PG8_ALIGN, PG8_SP2>(lds, g, S, E);
    }
    SEAM(2);
    if (IN(3)) {
        for (int it = blockIdx.x; it < SC_ITEMS + GLA_ITEMS; it += G) { if (it < SC_ITEMS) p3a_item(it, ws, wave, lane); else p3b_item(it - SC_ITEMS, a.in[6], a.in[7], a.out, ws, lds); }
    }
    SEAM(3);
    if (IN(4)) {
        for (int j = blockIdx.x; j < 128; j += G) p4b_item(j, a.out, (bf16_t*)(a.out + 16 * MiB), ws);
        for (int row = blockIdx.x * NWAVES + wave; row < NT; row += G * NWAVES) p4a_row(row, ws, lane);
    }
    SEAM(4);
    if (IN(5)) {
        const int c = blockIdx.x; const int bh = c >> 2, sx = c & 3;
        for (int it = blockIdx.x; it < GLA_ITEMS; it += G) p5b_item(it, a.in[6], a.in[7], a.in[8], (const bf16_t*)(a.out + 16 * MiB), ws, lds);
        if (c < 256) for (int i = 0; i < 4; ++i) { const int Q = (i == 0) ? sx : (i == 1) ? 7 - sx : (i == 2) ? 8 + sx : 15 - sx; attn_unit(bh >> 3, bh & 7, Q, a.in[2], ws, lds); }
    }
    SEAM(5);
    if (IN(6)) {
        pg8::Gemm g{(const bf16_t*)(ws + WS_XN), (const bf16_t*)(ws + WS_WGAB), NT, 2048, D_MODEL}; pg8::StaticOrder S; S.init(NT, 2048, G, (int)blockIdx.x);
        EpiSig E{ws}; pg8::gemm_phase<EpiSig, pg8::StaticOrder, PG8_ALIGN, PG8_SP2>(lds, g, S, E);
    }
    SEAM(6);
    if (IN(7)) {
        pg8::StaticOrder S; S.init(NT, D_MODEL, G, (int)blockIdx.x);
        { pg8::Gemm g{(const bf16_t*)(ws + WS_OA), (const bf16_t*)(ws + WS_WBA), NT, D_MODEL, 512}; EpiMrg<0> E{ws}; pg8::gemm_phase<EpiMrg<0>, pg8::StaticOrder, PG8_ALIGN, PG8_SP2>(lds, g, S, E); }
        { pg8::Gemm g{(const bf16_t*)(ws + WS_OB), (const bf16_t*)(ws + WS_WBB), NT, D_MODEL, 512}; EpiMrg<1> E{ws}; pg8::gemm_phase<EpiMrg<1>, pg8::StaticOrder, PG8_ALIGN, PG8_SP2>(lds, g, S, E); }
    }
    SEAM(7);
    if (IN(8)) {
        pg8::Gemm g{(const bf16_t*)(ws + WS_MRG), (const bf16_t*)(ws + WS_WOUT), NT, D_MODEL, D_MODEL}; pg8::StaticOrder S; S.init(NT, D_MODEL, G, (int)blockIdx.x);
        EpiV E{a.in[0], (const float*)(ws + WS_ADA), a.out}; pg8::gemm_phase<EpiV, pg8::StaticOrder, PG8_ALIGN, PG8_SP2>(lds, g, S, E);
    }
    SEAM(8);
    if (IN(9)) p8_phase(a.in, a.out, ws, lds, G);
    SEAM(9);
    if (IN(10)) p9_phase(ws, lds, G);
    SEAM(10);
    if (IN(11)) {
        build_tables(ws, lds);
        pg8::Gemm g{(const bf16_t*)(ws + WS_XG), (const bf16_t*)(ws + WS_W13), 0, 0, D_MODEL}; GroupOrder<2> S{(const LAS int*)(lds + LDS_TAB), (const LAS int*)(lds + LDS_TAB) + 64, G, (int)blockIdx.x};
        EpiHid E{ws}; pg8::gemm_phase<EpiHid, GroupOrder<2>, PG8_ALIGN, PG8_SP2>(lds, g, S, E);
    }
    SEAM(11);
    if (IN(12)) {
        build_tables(ws, lds);
        int kd = D_EXP; asm volatile("" : "+s"(kd));
        pg8::Gemm g{(const bf16_t*)(ws + WS_HID), (const bf16_t*)(ws + WS_W2), 0, 0, kd}; GroupOrder<4> S{(const LAS int*)(lds + LDS_TAB), (const LAS int*)(lds + LDS_TAB) + 64, G, (int)blockIdx.x};
        EpiY E{ws}; pg8::gemm_phase<EpiY, GroupOrder<4>, PG8_ALIGN, PG8_SP2>(lds, g, S, E);
    }
    SEAM(12);
    if (IN(13)) p12_phase(a.in, a.out, ws, lds, G);
#undef IN
#undef SEAM
}
}
extern "C" void kernel_launch(void* const* d_in, const int* in_sizes, int n_in, void* d_out, int out_size,
                              void* d_ws, size_t ws_size, hipStream_t stream) {
    using namespace fk;
    static int grid = 0;
    if (grid == 0) {
        int dev = 0, cus = 0, per_cu = 0; (void)hipGetDevice(&dev); (void)hipDeviceGetAttribute(&cus, hipDeviceAttributeMultiprocessorCount, dev);
        (void)hipFuncSetAttribute((const void*)mk_fwd, hipFuncAttributeMaxDynamicSharedMemorySize, LDS_BYTES);
        (void)hipOccupancyMaxActiveBlocksPerMultiprocessor(&per_cu, (const void*)mk_fwd, NTHREADS, LDS_BYTES);
        (void)hipGetLastError();
        grid = cus * (per_cu >= 1 ? 1 : 1);
        if (ws_size < 512 * MiB) { fprintf(stderr, "kernel_launch: workspace too small\n"); grid = -1; }
    }
    if (grid < 0) return;
    Args a{}; for (int i = 0; i < 23; ++i) a.in[i] = (const float*)d_in[i]; a.out = (float*)d_out; a.ws = (unsigned char*)d_ws; a.ph_lo = 0; a.ph_hi = NPH;
    void* args[] = {&a};
    hipError_t e = hipLaunchCooperativeKernel((const void*)mk_fwd, dim3(grid), dim3(NTHREADS), args, LDS_BYTES, stream);
    if (e != hipSuccess) fprintf(stderr, "cooperative launch failed: %s\n", hipGetErrorString(e));
}
```

```cpp
#include <hip/hip_runtime.h>
#include <hip/hip_cooperative_groups.h>
#include <cstdio>
#include <cstdint>
#include <cstring>
#include <cmath>
#ifdef HOST_EMU
#include <cmath>
#include <cstdio>
#include <cstdlib>
#include <cstring>
#include <cstdint>
struct Dim3e { int x, y, z; };
static thread_local Dim3e threadIdx, blockIdx, blockDim, gridDim;
#define __global__
#define __device__
#define __host__
#define __forceinline__ inline
#define __launch_bounds__(...)
typedef void* hipStream_t;
template <class F, class... A> static void host_launch(F f, long nb, int nt, A... a) {
#pragma omp parallel for schedule(dynamic, 4)
    for (long b = 0; b < nb; ++b) {
        blockIdx = {(int)b, 0, 0}; blockDim = {nt, 1, 1}; gridDim = {(int)nb, 1, 1};
        for (int t = 0; t < nt; ++t) { threadIdx = {t, 0, 0}; f(a...); }
    }
}
#define LAUNCH(k, nb, nt, st, ...) host_launch(k, (long)(nb), (int)(nt), __VA_ARGS__)
#define UNROLL
#else
#define LAUNCH(k, nb, nt, st, ...) hipLaunchKernelGGL(k, dim3((unsigned)(nb)), dim3((unsigned)(nt)), 0, st, __VA_ARGS__)
#endif

constexpr int D_MODEL = 1024, A_HEADS = 8, A_HD = 64, A_W = 512, I_HEADS = 16, I_DIM = 32, TOPK_MAX = 256, REL_B = 32,
              G_HEADS = 4, G_DK = 64, G_DV = 128, G_KW = 256, G_VW = 512, G_RANK = 16, N_GROUPS = 4, EPG = 8, N_EXP = 32, D_EXP = 256;
constexpr int O_AQ = 0, O_AK = 512, O_AV = 1024, O_IQ = 1536, O_IK = 2048, O_IW = 2080, O_GQ = 2096, O_GK = 2352, O_GV = 2608, O_GR = 3120,
              O_GLR = 3632, O_GA = 3648, O_GB = 4672, D_IN = 5696;
constexpr float DN_ALPHA = 1.189207115002721f, LN_EPS = 1e-5f;
#define V0_GID long gid = (long)blockIdx.x * blockDim.x + threadIdx.x

__device__ __forceinline__ float v0_silu(float v) { return v / (1.f + expf(-v)); }
__device__ __forceinline__ float v0_sigmoid(float v) { return 1.f / (1.f + expf(-v)); }

__global__ void k0_ada(const float* c, const float* w_ada, const float* b_ada, float* ada, int B) {
    V0_GID; if (gid >= (long)B * 6 * D_MODEL) return;
    const int b = (int)(gid / (6 * D_MODEL)), j = (int)(gid % (6 * D_MODEL));
    float acc = 0.f;
    for (int i = 0; i < D_MODEL; ++i) acc += v0_silu(c[b * D_MODEL + i]) * w_ada[(size_t)i * 6 * D_MODEL + j];
    ada[gid] = acc + b_ada[j];
}
__global__ void k0_lnmod(const float* x, const float* sh, const float* sc, float* h, int nrows) {
    V0_GID; if (gid >= nrows) return;
    const float* xr = x + (size_t)gid * D_MODEL; float* hr = h + (size_t)gid * D_MODEL;
    float mu = 0.f; for (int k = 0; k < D_MODEL; ++k) mu += xr[k]; mu *= (1.f / D_MODEL);
    float var = 0.f; for (int k = 0; k < D_MODEL; ++k) { const float d = xr[k] - mu; var += d * d; } var *= (1.f / D_MODEL);
    const float rs = 1.f / sqrtf(var + LN_EPS);
    for (int k = 0; k < D_MODEL; ++k) hr[k] = (xr[k] - mu) * rs * (1.f + sc[k]) + sh[k];
}
__global__ void k0_gemm(const float* A, int lda, const float* W, int ldw, float* C, int ldc, int M, int N, int K) {
    V0_GID; if (gid >= (long)(M / 4) * N) return;
    const int n = (int)(gid % N); const int m0 = (int)(gid / N) * 4;
    float a0 = 0.f, a1 = 0.f, a2 = 0.f, a3 = 0.f;
    const float* A0 = A + (size_t)m0 * lda;
    for (int k = 0; k < K; ++k) { const float w = W[(size_t)k * ldw + n]; a0 += A0[k] * w; a1 += A0[lda + k] * w; a2 += A0[2 * lda + k] * w; a3 += A0[3 * lda + k] * w; }
    C[(size_t)m0 * ldc + n] = a0; C[(size_t)(m0 + 1) * ldc + n] = a1; C[(size_t)(m0 + 2) * ldc + n] = a2; C[(size_t)(m0 + 3) * ldc + n] = a3;
}
__global__ void k0_scores(const float* P, float* scT, int S) {
    V0_GID; if (gid >= (long)S * S) return;
    const int t = (int)(gid % S), s = (int)(gid / S);
    if (s > t) { scT[gid] = -INFINITY; return; }
    const float* iq = P + (size_t)t * D_IN + O_IQ; const float* ik = P + (size_t)s * D_IN + O_IK; const float* iw = P + (size_t)t * D_IN + O_IW;
    const float cst = 0.044194173824159216f;
    float sc = 0.f;
    for (int h = 0; h < I_HEADS; ++h) { float d = 0.f; for (int k = 0; k < I_DIM; ++k) d += iq[h * I_DIM + k] * ik[k]; sc += (iw[h] * cst) * fmaxf(d, 0.f); }
    scT[gid] = sc;
}
__device__ __forceinline__ unsigned v0_key(float f) { unsigned u; memcpy(&u, &f, 4); return (u & 0x80000000u) ? ~u : (u | 0x80000000u); }
__global__ void k0_topk(const float* scT, int* sel, int* cnt, int S, int topk) {
    V0_GID; if (gid >= S) return;
    const int t = (int)gid; const int n = t + 1; int* sl = sel + (size_t)t * TOPK_MAX;
    if (n <= topk) { for (int s = 0; s < n; ++s) sl[s] = s; cnt[t] = n; return; }
    unsigned T = 0u;
    for (int bit = 31; bit >= 0; --bit) { const unsigned cand = T | (1u << bit); int c = 0; for (int s = 0; s < n; ++s) c += (v0_key(scT[(size_t)s * S + t]) >= cand) ? 1 : 0; if (c >= topk) T = cand; }
    int cgt = 0; for (int s = 0; s < n; ++s) cgt += (v0_key(scT[(size_t)s * S + t]) > T) ? 1 : 0;
    int need = topk - cgt, j = 0;
    for (int s = 0; s < n; ++s) { const unsigned k = v0_key(scT[(size_t)s * S + t]); if (k > T) sl[j++] = s; else if (k == T && need > 0) { sl[j++] = s; --need; } }
    cnt[t] = j;
}
__device__ __forceinline__ int v0_bucket(int d) {
    if (d < 16) return d;
    const float df = (float)d; int large = 16 + (int)(logf(df / 16.f) / 2.0794415416798357f * 16.f);
    return large < 31 ? large : 31;
}
__global__ void __launch_bounds__(256) k0_attn(const float* P, const int* sel, const int* cnt, const float* rel_bias, float* oa, int S) {
    V0_GID; if (gid >= (long)S * A_HEADS) return;
    const int t = (int)(gid / A_HEADS), h = (int)(gid % A_HEADS); const int n = cnt[t]; const int* sl = sel + (size_t)t * TOPK_MAX;
    const float* q = P + (size_t)t * D_IN + O_AQ + h * A_HD;
    float m = -INFINITY;
    for (int j = 0; j < n; ++j) { const int s = sl[j]; const float* k = P + (size_t)s * D_IN + O_AK + h * A_HD; float d = 0.f; for (int e = 0; e < A_HD; ++e) d += q[e] * k[e];
        const float l = d * 0.125f + rel_bias[v0_bucket(t - s) * A_HEADS + h]; m = fmaxf(m, l); }
    float o[A_HD];
#pragma unroll
    for (int e = 0; e < A_HD; ++e) o[e] = 0.f;
    float sum = 0.f;
    for (int j = 0; j < n; ++j) { const int s = sl[j]; const float* k = P + (size_t)s * D_IN + O_AK + h * A_HD; const float* v = P + (size_t)s * D_IN + O_AV + h * A_HD; float d = 0.f;
        for (int e = 0; e < A_HD; ++e) d += q[e] * k[e];
        const float p = expf(d * 0.125f + rel_bias[v0_bucket(t - s) * A_HEADS + h] - m); sum += p;
#pragma unroll
        for (int e = 0; e < A_HD; ++e) o[e] += p * v[e]; }
    const float inv = 1.f / sum;
#pragma unroll
    for (int e = 0; e < A_HD; ++e) oa[(size_t)t * A_W + h * A_HD + e] = o[e] * inv;
}
__global__ void k0_gate(const float* P, const float* wg, const float* bg, float* lg, int S) {
    V0_GID; if (gid >= (long)S * G_KW) return;
    const int t = (int)(gid / G_KW), j = (int)(gid % G_KW);
    float z = bg[j]; for (int r = 0; r < G_RANK; ++r) z += P[(size_t)t * D_IN + O_GLR + r] * wg[r * G_KW + j];
    lg[gid] = (fminf(z, 0.f) - log1pf(expf(-fabsf(z)))) * (1.f / 16.f);
}
__global__ void __launch_bounds__(64) k0_gla(const float* P, const float* lg, float* oraw, int S) {
    V0_GID; if (gid >= G_HEADS * G_DV) return;
    const int h = (int)(gid / G_DV), dv = (int)(gid % G_DV);
    float st[G_DK];
#pragma unroll
    for (int d = 0; d < G_DK; ++d) st[d] = 0.f;
    for (int t = 0; t < S; ++t) {
        const float* row = P + (size_t)t * D_IN; const float vv = row[O_GV + h * G_DV + dv]; float o = 0.f;
#pragma unroll
        for (int d = 0; d < G_DK; ++d) { const float a = expf(lg[(size_t)t * G_KW + h * G_DK + d]); st[d] = a * st[d] + row[O_GK + h * G_DK + d] * vv; o += row[O_GQ + h * G_DK + d] * st[d]; }
        oraw[(size_t)t * G_VW + h * G_DV + dv] = o * 0.125f;
    }
}
__global__ void k0_gla_post(const float* P, const float* oraw, const float* ng, float* ob, int S) {
    V0_GID; if (gid >= (long)S * G_HEADS) return;
    const int t = (int)(gid / G_HEADS), h = (int)(gid % G_HEADS); const float* o = oraw + (size_t)t * G_VW + h * G_DV;
    float mu = 0.f; for (int e = 0; e < G_DV; ++e) mu += o[e]; mu *= (1.f / G_DV);
    float var = 0.f; for (int e = 0; e < G_DV; ++e) { const float d = o[e] - mu; var += d * d; } var *= (1.f / G_DV);
    const float rs = 1.f / sqrtf(var + LN_EPS);
    for (int e = 0; e < G_DV; ++e) ob[(size_t)t * G_VW + h * G_DV + e] = (o[e] - mu) * rs * ng[h * G_DV + e] * v0_silu(P[(size_t)t * D_IN + O_GR + h * G_DV + e]);
}
__global__ void k0_merge(const float* P, const float* ba, const float* bb, float* mg, int S) {
    V0_GID; if (gid >= (long)S * D_MODEL) return;
    const int t = (int)(gid / D_MODEL), n = (int)(gid % D_MODEL);
    mg[gid] = v0_sigmoid(P[(size_t)t * D_IN + O_GA + n]) * ba[gid] + v0_sigmoid(P[(size_t)t * D_IN + O_GB + n]) * bb[gid];
}
__global__ void k0_ln1(const float* x, const float* y, const float* gt1, const float* g1, const float* b1, const float* sh2, const float* sc2, float* x1, float* h2, int nrows) {
    V0_GID; if (gid >= nrows) return;
    const float* xr = x + (size_t)gid * D_MODEL; const float* yr = y + (size_t)gid * D_MODEL; float* x1r = x1 + (size_t)gid * D_MODEL; float* h2r = h2 + (size_t)gid * D_MODEL;
    float mu = 0.f; for (int k = 0; k < D_MODEL; ++k) mu += DN_ALPHA * xr[k] + gt1[k] * yr[k]; mu *= (1.f / D_MODEL);
    float var = 0.f; for (int k = 0; k < D_MODEL; ++k) { const float d = DN_ALPHA * xr[k] + gt1[k] * yr[k] - mu; var += d * d; } var *= (1.f / D_MODEL);
    float rs = 1.f / sqrtf(var + LN_EPS);
    for (int k = 0; k < D_MODEL; ++k) x1r[k] = (DN_ALPHA * xr[k] + gt1[k] * yr[k] - mu) * rs * g1[k] + b1[k];
    mu = 0.f; for (int k = 0; k < D_MODEL; ++k) mu += x1r[k]; mu *= (1.f / D_MODEL);
    var = 0.f; for (int k = 0; k < D_MODEL; ++k) { const float d = x1r[k] - mu; var += d * d; } var *= (1.f / D_MODEL);
    rs = 1.f / sqrtf(var + LN_EPS);
    for (int k = 0; k < D_MODEL; ++k) h2r[k] = (x1r[k] - mu) * rs * (1.f + sc2[k]) + sh2[k];
}
__global__ void k0_route(const float* rl, const float* brg, const float* bre, int* eid, float* ew, int nrows) {
    V0_GID; if (gid >= nrows) return;
    const float* r = rl + (size_t)gid * 36;
    float gl[N_GROUPS]; float gm = -INFINITY; int gi = 0;
#pragma unroll
    for (int g = 0; g < N_GROUPS; ++g) { gl[g] = r[g] + brg[g]; if (gl[g] > gm) { gm = gl[g]; gi = g; } }
    float gs = 0.f;
#pragma unroll
    for (int g = 0; g < N_GROUPS; ++g) gs += expf(gl[g] - gm);
    const float gw = 1.f / gs;
    float v0 = -INFINITY, v1 = -INFINITY; int i0 = 0, i1 = 0;
    for (int e = 0; e < EPG; ++e) { const float v = r[4 + gi * EPG + e] + bre[gi * EPG + e];
        if (v > v0) { v1 = v0; i1 = i0; v0 = v; i0 = e; } else if (v > v1) { v1 = v; i1 = e; } }
    const float e1 = expf(v1 - v0); const float w0 = 1.f / (1.f + e1), w1 = e1 / (1.f + e1);
    eid[gid * 2] = gi * EPG + i0; eid[gid * 2 + 1] = gi * EPG + i1; ew[gid * 2] = w0 * gw; ew[gid * 2 + 1] = w1 * gw;
}
__global__ void k0_moe_hid(const float* h2, const int* eid, const float* w1, const float* w3, float* hid, int nrows) {
    V0_GID; if (gid >= (long)nrows * 2 * D_EXP) return;
    const int j = (int)(gid % D_EXP); const long ts = gid / D_EXP; const int t = (int)(ts / 2); const int e = eid[ts];
    const float* hr = h2 + (size_t)t * D_MODEL; const float* a = w1 + (size_t)e * D_MODEL * D_EXP + j; const float* b = w3 + (size_t)e * D_MODEL * D_EXP + j;
    float g = 0.f, u = 0.f; for (int k = 0; k < D_MODEL; ++k) { g += hr[k] * a[(size_t)k * D_EXP]; u += hr[k] * b[(size_t)k * D_EXP]; }
    hid[gid] = v0_silu(g) * u;
}
__global__ void k0_moe_out(const float* hid, const int* eid, const float* ew, const float* w2, float* f, int nrows) {
    V0_GID; if (gid >= (long)nrows * D_MODEL) return;
    const int n = (int)(gid % D_MODEL); const int t = (int)(gid / D_MODEL); float acc = 0.f;
    for (int sl = 0; sl < 2; ++sl) { const int e = eid[t * 2 + sl]; const float* hr = hid + ((size_t)t * 2 + sl) * D_EXP; const float* w = w2 + (size_t)e * D_EXP * D_MODEL + n; float a = 0.f;
        for (int j = 0; j < D_EXP; ++j) a += hr[j] * w[(size_t)j * D_MODEL]; acc += ew[t * 2 + sl] * a; }
    f[gid] = acc;
}
__global__ void k0_final(const float* x1, const float* f, const float* gt2, const float* g2, const float* b2, float* out, int nrows) {
    V0_GID; if (gid >= nrows) return;
    const float* xr = x1 + (size_t)gid * D_MODEL; const float* fr = f + (size_t)gid * D_MODEL; float* o = out + (size_t)gid * D_MODEL;
    float mu = 0.f; for (int k = 0; k < D_MODEL; ++k) mu += DN_ALPHA * xr[k] + gt2[k] * fr[k]; mu *= (1.f / D_MODEL);
    float var = 0.f; for (int k = 0; k < D_MODEL; ++k) { const float d = DN_ALPHA * xr[k] + gt2[k] * fr[k] - mu; var += d * d; } var *= (1.f / D_MODEL);
    const float rs = 1.f / sqrtf(var + LN_EPS);
    for (int k = 0; k < D_MODEL; ++k) o[k] = (DN_ALPHA * xr[k] + gt2[k] * fr[k] - mu) * rs * g2[k] + b2[k];
}

struct V0Buf { float *ada, *h, *P, *scT, *oa, *lg, *oraw, *ob, *ba, *bb, *mg, *y, *x1, *h2, *rl, *ew, *hid, *f; int *sel, *cnt, *eid; size_t bytes; };
static V0Buf v0_carve(void* base, int B, int S) {
    V0Buf b; char* p = (char*)base; auto take = [&](size_t n) { char* r = p; p += (n + 255) & ~(size_t)255; return r; };
    b.ada = (float*)take((size_t)B * 6 * D_MODEL * 4);
    b.P = (float*)take((size_t)S * D_IN * 4);
    b.h = (float*)take((size_t)S * D_MODEL * 4);
    b.scT = (float*)take((size_t)S * S * 4);
    b.sel = (int*)take((size_t)S * TOPK_MAX * 4); b.cnt = (int*)take((size_t)S * 4);
    b.oa = (float*)take((size_t)S * A_W * 4); b.lg = (float*)take((size_t)S * G_KW * 4); b.oraw = (float*)take((size_t)S * G_VW * 4); b.ob = (float*)take((size_t)S * G_VW * 4);
    b.ba = (float*)take((size_t)S * D_MODEL * 4); b.bb = (float*)take((size_t)S * D_MODEL * 4); b.y = (float*)take((size_t)S * D_MODEL * 4);
    b.x1 = (float*)take((size_t)S * D_MODEL * 4); b.h2 = (float*)take((size_t)S * D_MODEL * 4); b.f = (float*)take((size_t)S * D_MODEL * 4);
    b.mg = b.h;
    b.rl = (float*)take((size_t)S * 36 * 4); b.eid = (int*)take((size_t)S * 2 * 4); b.ew = (float*)take((size_t)S * 2 * 4); b.hid = (float*)take((size_t)S * 2 * D_EXP * 4);
    b.bytes = (size_t)(p - (char*)base); return b;
}
static void v0_forward(void* const* d_in, float* out, void* scratch, int B, int S, hipStream_t st, int only_batch = -1, int last_batch = -1) {
    const float *x = (const float*)d_in[0], *c = (const float*)d_in[1], *rel_bias = (const float*)d_in[2], *w_ada = (const float*)d_in[3], *b_ada = (const float*)d_in[4], *w_in = (const float*)d_in[5],
                *wg = (const float*)d_in[6], *bg = (const float*)d_in[7], *ng = (const float*)d_in[8], *wba = (const float*)d_in[9], *wbb = (const float*)d_in[10], *wout = (const float*)d_in[11],
                *g1 = (const float*)d_in[12], *b1 = (const float*)d_in[13], *wrg = (const float*)d_in[14], *brg = (const float*)d_in[15], *wre = (const float*)d_in[16], *bre = (const float*)d_in[17],
                *w1 = (const float*)d_in[18], *w3 = (const float*)d_in[19], *w2 = (const float*)d_in[20], *g2 = (const float*)d_in[21], *b2 = (const float*)d_in[22];
    V0Buf u = v0_carve(scratch, B, S);
    const int TB = 256; auto nb = [&](long n) { return (n + TB - 1) / TB; };
    const int topk = (TOPK_MAX < S / 4) ? TOPK_MAX : S / 4;
    LAUNCH(k0_ada, nb((long)B * 6 * D_MODEL), TB, st, c, w_ada, b_ada, u.ada, B);
    for (int bi = 0; bi < B; ++bi) {
        int b = bi; if (last_batch >= 0) b = (bi == B - 1) ? last_batch : (bi < last_batch ? bi : bi + 1);
        if (only_batch >= 0 && b != only_batch) continue;
        const float* xb = x + (size_t)b * S * D_MODEL; const float* ad = u.ada + (size_t)b * 6 * D_MODEL;
        const float *sh1 = ad, *sc1 = ad + D_MODEL, *gt1 = ad + 2 * D_MODEL, *sh2 = ad + 3 * D_MODEL, *sc2 = ad + 4 * D_MODEL, *gt2 = ad + 5 * D_MODEL;
        LAUNCH(k0_lnmod, nb(S), TB, st, xb, sh1, sc1, u.h, S);
        LAUNCH(k0_gemm, nb((long)(S / 4) * D_IN), TB, st, (const float*)u.h, D_MODEL, w_in, D_IN, u.P, D_IN, S, D_IN, D_MODEL);
        LAUNCH(k0_scores, nb((long)S * S), TB, st, (const float*)u.P, u.scT, S);
        LAUNCH(k0_topk, nb(S), TB, st, (const float*)u.scT, u.sel, u.cnt, S, topk);
        LAUNCH(k0_attn, nb((long)S * A_HEADS), TB, st, (const float*)u.P, (const int*)u.sel, (const int*)u.cnt, rel_bias, u.oa, S);
        LAUNCH(k0_gate, nb((long)S * G_KW), TB, st, (const float*)u.P, wg, bg, u.lg, S);
        LAUNCH(k0_gla, (G_HEADS * G_DV + 63) / 64, 64, st, (const float*)u.P, (const float*)u.lg, u.oraw, S);
        LAUNCH(k0_gla_post, nb((long)S * G_HEADS), TB, st, (const float*)u.P, (const float*)u.oraw, ng, u.ob, S);
        LAUNCH(k0_gemm, nb((long)(S / 4) * D_MODEL), TB, st, (const float*)u.oa, A_W, wba, D_MODEL, u.ba, D_MODEL, S, D_MODEL, A_W);
        LAUNCH(k0_gemm, nb((long)(S / 4) * D_MODEL), TB, st, (const float*)u.ob, G_VW, wbb, D_MODEL, u.bb, D_MODEL, S, D_MODEL, G_VW);
        LAUNCH(k0_merge, nb((long)S * D_MODEL), TB, st, (const float*)u.P, (const float*)u.ba, (const float*)u.bb, u.mg, S);
        LAUNCH(k0_gemm, nb((long)(S / 4) * D_MODEL), TB, st, (const float*)u.mg, D_MODEL, wout, D_MODEL, u.y, D_MODEL, S, D_MODEL, D_MODEL);
        LAUNCH(k0_ln1, nb(S), TB, st, xb, (const float*)u.y, gt1, g1, b1, sh2, sc2, u.x1, u.h2, S);
        LAUNCH(k0_gemm, nb((long)(S / 4) * N_GROUPS), TB, st, (const float*)u.h2, D_MODEL, wrg, N_GROUPS, u.rl, 36, S, N_GROUPS, D_MODEL);
        LAUNCH(k0_gemm, nb((long)(S / 4) * N_EXP), TB, st, (const float*)u.h2, D_MODEL, wre, N_EXP, u.rl + 4, 36, S, N_EXP, D_MODEL);
        LAUNCH(k0_route, nb(S), TB, st, (const float*)u.rl, brg, bre, u.eid, u.ew, S);
        LAUNCH(k0_moe_hid, nb((long)S * 2 * D_EXP), TB, st, (const float*)u.h2, (const int*)u.eid, w1, w3, u.hid, S);
        LAUNCH(k0_moe_out, nb((long)S * D_MODEL), TB, st, (const float*)u.hid, (const int*)u.eid, (const float*)u.ew, w2, u.f, S);
        LAUNCH(k0_final, nb(S), TB, st, (const float*)u.x1, (const float*)u.f, gt2, g2, b2, out + (size_t)b * S * D_MODEL, S);
    }
}
namespace pg8 {
#define PG8_LAS __attribute__((address_space(3)))
typedef unsigned short bf16_t;
typedef short bf16x8 __attribute__((ext_vector_type(8)));
typedef float f32x4 __attribute__((ext_vector_type(4)));
typedef unsigned u32x4 __attribute__((ext_vector_type(4)));
constexpr int BM = 256, BK = 64, HALF = 128, HTB = HALF * BK * 2  , STAGE_BYTES = 8 * HTB, NXCD = 8, WGM = 8;

__host__ __device__ __forceinline__ int lds_byte(int r, int c) { const int st = (r >> 4) * 2 + (c >> 5), rr = r & 15, cc = c & 31, ob = rr * 64 + cc * 2; return st * 1024 + (ob ^ (((ob >> 9) & 1) << 5)); }
__host__ __device__ __forceinline__ void stage_rc(int b, int& R, int& C) { const int st = b / 1024, sb = b % 1024, swz = sb ^ (((sb >> 9) & 1) << 5); R = (st >> 1) * 16 + swz / 64; C = (st & 1) * 32 + (swz % 64) / 2; }
__host__ __device__ __forceinline__ int perm32(int rho) { const int n = rho >> 4, i = rho & 15; return 8 * (i >> 2) + 4 * n + (i & 3); }

struct Unit { int pm, pn, pa, pb; };
struct Gemm { const bf16_t* A; const bf16_t* Bt; int M, N, K; };

struct StaticOrder {
    int nM, nN, nwg, G, c;
    __host__ __device__ void init(int M, int N, int G_, int c_) { nM = M / BM; nN = N / BM; nwg = nM * nN; G = G_; c = c_; }
    __host__ __device__ bool next(int i, Unit& u) const {
        const long L = (long)i * G + c; if (L >= nwg) return false;
        int wgid = (int)L; { const int q = nwg / NXCD, r = nwg % NXCD, xcd = wgid % NXCD, off = wgid / NXCD; wgid = (xcd < r ? xcd * (q + 1) : r * (q + 1) + (xcd - r) * q) + off; }
        const int nig = WGM * nN, gid = wgid / nig, fm = gid * WGM, gsz = (nM - fm) < WGM ? (nM - fm) : WGM;
        u.pm = fm + ((wgid % nig) % gsz); u.pn = (wgid % nig) / gsz; u.pa = u.pm; u.pb = u.pn; return true;
    }
    __device__ __forceinline__ void a_ready(const Unit&) const {}
    __device__ __forceinline__ void done(const Unit&) const {}
};

__device__ __forceinline__ unsigned cvt_pk_bf16(float lo, float hi) { unsigned r; asm volatile("v_cvt_pk_bf16_f32 %0, %1, %2" : "=v"(r) : "v"(lo), "v"(hi)); return r; }
typedef float f32x2 __attribute__((ext_vector_type(2)));

template <class Epi, class Sched, bool ALIGN_EPI = false, bool SP2 = false>
__device__ __forceinline__ void gemm_phase(PG8_LAS unsigned char* lds, const Gemm g, const Sched& S, const Epi& E) {
    const int tid = threadIdx.x, wid = __builtin_amdgcn_readfirstlane(tid >> 6), lane = tid & 63, wr = wid >> 2, wc = wid & 3, fr = lane & 15, fq = lane >> 4;
    const int K = g.K, nt = K / BK;
    unsigned voffA[2], voffB[2];
#pragma unroll
    for (int i = 0; i < 2; ++i) { int R, C; stage_rc(tid * 16 + i * 8192, R, C); const int Rb = Epi::PERM ? ((R & ~31) + perm32(R & 31)) : R;
        voffA[i] = (unsigned)(R * K + C) * 2u; voffB[i] = (unsigned)(Rb * K + C) * 2u; }
    const size_t kstep = (size_t)(BK * 2);
    const size_t hstep = (size_t)HALF * K * 2;
    const size_t tstep = 2 * hstep;
    const unsigned ldsw = (unsigned)wid * 1024u;
    const int aoff = lds_byte(wr * 64 + fr, fq * 8), boff = lds_byte(wc * 32 + fr, fq * 8);
#define PG8_SA(b, h) (((b) * 2 + (h)) * HTB)
#define PG8_SB(b, h) ((4 + (b) * 2 + (h)) * HTB)
#define PG8_STAGE(bufoff, gbase, voff) do { _Pragma("unroll") for (int _i = 0; _i < 2; ++_i) \
        __builtin_amdgcn_global_load_lds((const unsigned*)((const char*)(gbase) + (voff)[_i]), (PG8_LAS unsigned*)(lds + (bufoff) + ldsw + _i * 8192), 16, 0, 0); } while (0)
#define PG8_LDA(dst, b, h) do { _Pragma("unroll") for (int m = 0; m < 4; ++m) _Pragma("unroll") for (int k = 0; k < 2; ++k) dst[m][k] = *(const PG8_LAS bf16x8*)(lds + PG8_SA(b, h) + aoff + m * 2048 + k * 1024); } while (0)
#define PG8_LDB(dst, b, h) do { _Pragma("unroll") for (int n = 0; n < 2; ++n) _Pragma("unroll") for (int k = 0; k < 2; ++k) dst[n][k] = *(const PG8_LAS bf16x8*)(lds + PG8_SB(b, h) + boff + n * 2048 + k * 1024); } while (0)
#define PG8_MMA(ai, bj, At, Bt) do { __builtin_amdgcn_s_setprio(1); _Pragma("unroll") for (int m = 0; m < 4; ++m) _Pragma("unroll") for (int n = 0; n < 2; ++n) _Pragma("unroll") for (int k = 0; k < 2; ++k) \
        acc[ai][bj][m][n] = __builtin_amdgcn_mfma_f32_16x16x32_bf16(Bt[n][k], At[m][k], acc[ai][bj][m][n], 0, 0, 0); __builtin_amdgcn_s_setprio(0); } while (0)
#define PG8_WAIT_V(n) asm volatile("s_waitcnt vmcnt(" #n ")" ::: "memory")
#define PG8_WAIT_L(n) asm volatile("s_waitcnt lgkmcnt(" #n ")" ::: "memory")
#define PG8_BAR __builtin_amdgcn_s_barrier()
#define PG8_SCHED __builtin_amdgcn_sched_barrier(0)
    Unit cur, nxt; int ui = 0;
    if (!S.next(0, cur)) return;
    f32x4 acc[2][2][4][2];
#pragma unroll
    for (int a = 0; a < 2; ++a)
#pragma unroll
        for (int b = 0; b < 2; ++b)
#pragma unroll
            for (int m = 0; m < 4; ++m)
#pragma unroll
                for (int n = 0; n < 2; ++n) acc[a][b][m][n] = (f32x4){0.f, 0.f, 0.f, 0.f};
    bf16x8 At[4][2], B0[2][2], B1[2][2];
    const char* cA = (const char*)g.A + (size_t)cur.pa * tstep; const char* cB = (const char*)g.Bt + (size_t)cur.pb * tstep;
    S.a_ready(cur);
    if constexpr (SP2) {
        PG8_STAGE(PG8_SB(0, 0), cB, voffB); PG8_STAGE(PG8_SB(0, 1), cB + hstep, voffB); PG8_STAGE(PG8_SA(0, 0), cA, voffA); PG8_STAGE(PG8_SA(0, 1), cA + hstep, voffA);
        if (wr == 1) PG8_BAR;
        PG8_WAIT_V(2); PG8_BAR;
        PG8_STAGE(PG8_SB(1, 0), cB + kstep, voffB); PG8_STAGE(PG8_SA(1, 0), cA + kstep, voffA); PG8_STAGE(PG8_SB(1, 1), cB + hstep + kstep, voffB);
        PG8_WAIT_V(6); PG8_BAR;
    } else {
        PG8_STAGE(PG8_SB(0, 0), cB, voffB); PG8_STAGE(PG8_SA(0, 0), cA, voffA); PG8_STAGE(PG8_SB(0, 1), cB + hstep, voffB); PG8_STAGE(PG8_SA(0, 1), cA + hstep, voffA);
        if (wr == 1) PG8_BAR;
        PG8_WAIT_V(4); PG8_BAR;
        PG8_STAGE(PG8_SB(1, 0), cB + kstep, voffB); PG8_STAGE(PG8_SA(1, 0), cA + kstep, voffA); PG8_STAGE(PG8_SB(1, 1), cB + hstep + kstep, voffB);
        PG8_WAIT_V(6); PG8_BAR;
    }
    for (;;) {
        const bool has_next = S.next(ui + 1, nxt);
        const char* nA = has_next ? (const char*)g.A + (size_t)nxt.pa * tstep : cA; const char* nB = has_next ? (const char*)g.Bt + (size_t)nxt.pb * tstep : cB;
        for (int t = 0; t < nt; t += 2) {
            const bool last = (t == nt - 2);
            const char* a1 = cA + (size_t)(t + 1) * kstep;
            const char* a2 = last ? nA : cA + (size_t)(t + 2) * kstep; const char* b2 = last ? nB : cB + (size_t)(t + 2) * kstep;
            const char* a3 = a2 + kstep; const char* b3 = b2 + kstep;
            if (last && has_next) S.a_ready(nxt);
            if constexpr (SP2) {
            PG8_LDB(B0, 0, 0); PG8_LDB(B1, 0, 1); PG8_SCHED; PG8_LDA(At, 0, 0); PG8_STAGE(PG8_SA(1, 1), a1 + hstep, voffA);
            PG8_WAIT_V(8); PG8_WAIT_L(0); PG8_BAR; PG8_MMA(0, 0, At, B0); PG8_MMA(0, 1, At, B1); PG8_BAR; PG8_SCHED;
            PG8_LDA(At, 0, 1); PG8_STAGE(PG8_SB(0, 0), b2, voffB); PG8_STAGE(PG8_SB(0, 1), b2 + hstep, voffB); PG8_STAGE(PG8_SA(0, 0), a2, voffA);
            PG8_WAIT_V(8); PG8_WAIT_L(0); PG8_BAR; PG8_MMA(1, 0, At, B0); PG8_MMA(1, 1, At, B1); PG8_BAR; PG8_SCHED;
            PG8_LDB(B0, 1, 0); PG8_LDB(B1, 1, 1); PG8_SCHED; PG8_LDA(At, 1, 0); PG8_STAGE(PG8_SA(0, 1), a2 + hstep, voffA);
            PG8_WAIT_V(8); PG8_WAIT_L(0); PG8_BAR; PG8_MMA(0, 0, At, B0); PG8_MMA(0, 1, At, B1); PG8_BAR; PG8_SCHED;
            PG8_LDA(At, 1, 1); PG8_STAGE(PG8_SB(1, 0), b3, voffB); PG8_STAGE(PG8_SB(1, 1), b3 + hstep, voffB); PG8_STAGE(PG8_SA(1, 0), a3, voffA);
            PG8_WAIT_V(8); PG8_WAIT_L(0); PG8_BAR; PG8_MMA(1, 0, At, B0); PG8_MMA(1, 1, At, B1); PG8_BAR; PG8_SCHED;
            } else {
            PG8_LDB(B0, 0, 0); PG8_SCHED; PG8_LDA(At, 0, 0); PG8_STAGE(PG8_SA(1, 1), a1 + hstep, voffA);
            PG8_WAIT_L(8); PG8_BAR; PG8_WAIT_L(0); PG8_MMA(0, 0, At, B0); PG8_BAR; PG8_SCHED;
            PG8_LDB(B1, 0, 1); PG8_STAGE(PG8_SB(0, 0), b2, voffB);
            PG8_BAR; PG8_WAIT_L(0); PG8_MMA(0, 1, At, B1); PG8_BAR;
            PG8_LDA(At, 0, 1); PG8_STAGE(PG8_SA(0, 0), a2, voffA);
            PG8_BAR; PG8_WAIT_L(0); PG8_MMA(1, 0, At, B0); PG8_BAR; PG8_SCHED;
            PG8_STAGE(PG8_SB(0, 1), b2 + hstep, voffB);
            PG8_WAIT_V(6); PG8_BAR; PG8_MMA(1, 1, At, B1); PG8_BAR;
            PG8_LDB(B0, 1, 0); PG8_SCHED; PG8_LDA(At, 1, 0); PG8_STAGE(PG8_SA(0, 1), a2 + hstep, voffA);
            PG8_WAIT_L(8); PG8_BAR; PG8_WAIT_L(0); PG8_MMA(0, 0, At, B0); PG8_BAR; PG8_SCHED;
            PG8_LDB(B1, 1, 1); PG8_STAGE(PG8_SB(1, 0), b3, voffB);
            PG8_BAR; PG8_WAIT_L(0); PG8_MMA(0, 1, At, B1); PG8_BAR;
            PG8_LDA(At, 1, 1); PG8_STAGE(PG8_SA(1, 0), a3, voffA);
            PG8_BAR; PG8_WAIT_L(0); PG8_MMA(1, 0, At, B0); PG8_BAR; PG8_SCHED;
            PG8_STAGE(PG8_SB(1, 1), b3 + hstep, voffB);
            PG8_WAIT_V(6); PG8_BAR; PG8_MMA(1, 1, At, B1); PG8_BAR;
            }
        }
        if constexpr (ALIGN_EPI) { if (wr == 0) PG8_BAR; }
        if constexpr (!Epi::AFTER_DRAIN) { E(acc, cur, wr, wc, fr, fq); S.done(cur); }
        if (!has_next) break;
#pragma unroll
        for (int a = 0; a < 2; ++a)
#pragma unroll
            for (int b = 0; b < 2; ++b)
#pragma unroll
                for (int m = 0; m < 4; ++m)
#pragma unroll
                    for (int n = 0; n < 2; ++n) acc[a][b][m][n] = (f32x4){0.f, 0.f, 0.f, 0.f};
        cur = nxt; cA = nA; cB = nB; ++ui;
        if constexpr (ALIGN_EPI) { if (wr == 1) PG8_BAR; }
    }
    PG8_WAIT_V(0);
    if constexpr (!ALIGN_EPI) { if (wr == 0) PG8_BAR; }
    PG8_BAR;
    if constexpr (Epi::AFTER_DRAIN) { E.fused(acc, cur, wr, wc, fr, fq, lds, wid, lane); S.done(cur); }
#undef PG8_SA
#undef PG8_SB
#undef PG8_STAGE
#undef PG8_LDA
#undef PG8_LDB
#undef PG8_MMA
#undef PG8_WAIT_V
#undef PG8_WAIT_L
#undef PG8_BAR
#undef PG8_SCHED
}
}

#ifndef PG8_SP2
#define PG8_SP2 true
#endif
#ifndef PG8_ALIGN
#define PG8_ALIGN true
#endif
#ifndef DUPSUB
#define DUPSUB 0
#endif
#ifndef USE_CG_SYNC
#define USE_CG_SYNC 0
#endif
#ifndef DUPMASK
#define DUPMASK 0
#define DUPMASK_ON 0
#else
#define DUPMASK_ON 1
#endif
namespace cg = cooperative_groups;
namespace fk {
using pg8::bf16_t; using pg8::f32x4; using pg8::u32x4; using pg8::bf16x8; using pg8::Unit; using pg8::cvt_pk_bf16;
#define LAS __attribute__((address_space(3)))
#define LDS_WAIT() asm volatile("s_waitcnt lgkmcnt(0)" ::: "memory")
typedef unsigned u32x2 __attribute__((ext_vector_type(2)));
constexpr int NB = 8, NS = 4096, NT = NB * NS;
constexpr int NTHREADS = 512, NWAVES = 8, LDS_BYTES = 155648;
constexpr size_t MiB = (size_t)1 << 20;
constexpr size_t WS_ADA = 0, WS_CNT = 256 * 1024,
    WS_WIN = 1 * MiB, WS_WGAB = 9 * MiB, WS_WBA = 13 * MiB, WS_WBB = 14 * MiB, WS_WOUT = 15 * MiB, WS_W13 = 17 * MiB, WS_W2 = 49 * MiB,
    WS_XN = 65 * MiB, WS_QKV = 129 * MiB, WS_IQ = 225 * MiB, WS_GQK = 257 * MiB, WS_GV = 289 * MiB, WS_GR = 321 * MiB,
    WS_IK = 353 * MiB, WS_IW = 355 * MiB, WS_GLR = 357 * MiB, WS_SC = 358 * MiB, WS_MASK = 490 * MiB, WS_ADAP = 506 * MiB, WS_MISC = 509 * MiB;
constexpr int NPROJ = 3840;
constexpr int KSL = 16;
constexpr float QSCALE = 0.125f * 1.4426950408889634f;
typedef float f32x2_t __attribute__((ext_vector_type(2))); typedef __bf16 bf16x2_t __attribute__((ext_vector_type(2)));
__device__ __forceinline__ unsigned cvtpk_s(float lo, float hi) { f32x2_t v = {lo, hi}; bf16x2_t b = __builtin_convertvector(v, bf16x2_t); return __builtin_bit_cast(unsigned, b); }
__device__ __forceinline__ void bf8_to_f(const u32x4 w, float* f) {
#pragma unroll
    for (int j = 0; j < 4; ++j) { f[2 * j] = __uint_as_float(w[j] << 16); f[2 * j + 1] = __uint_as_float(w[j] & 0xffff0000u); }
}

__device__ __forceinline__ void tr_item(const float* W, int ldw, int srccol, bf16_t* WT, int K, int dst_row0, int kb, LAS float* scr, int lane) {
    const int k0 = 64 * kb;
#pragma unroll 8
    for (int i = 0; i < 32; ++i) { const int kk = 2 * i + (lane >> 5); scr[kk * 33 + (lane & 31)] = W[(size_t)(k0 + kk) * ldw + srccol]; }
    LDS_WAIT();
    const int c = lane & 7;
#pragma unroll
    for (int j = 0; j < 4; ++j) { const int n = (lane >> 3) + 8 * j; const LAS float* s = scr + (8 * c) * 33 + n;
        u32x4 o; o.x = cvt_pk_bf16(s[0 * 33], s[1 * 33]); o.y = cvt_pk_bf16(s[2 * 33], s[3 * 33]); o.z = cvt_pk_bf16(s[4 * 33], s[5 * 33]); o.w = cvt_pk_bf16(s[6 * 33], s[7 * 33]);
        *(u32x4*)(WT + (size_t)(dst_row0 + n) * K + k0 + 8 * c) = o; }
    LDS_WAIT();
}
__device__ __forceinline__ int win_src(int n) {
    if (n < 2048) return n;
    if (n < 3584) return n + 48;
    if (n < 3616) return O_IK + (n - 3584);
    if (n < 3632) return O_IW + (n - 3616);
    return O_GLR + (n - 3632);
}
constexpr int I_ADA = 96 * KSL, I_WIN = 114 * 16, I_WGAB = 64 * 16, I_WB = 32 * 8, I_WOUT = 32 * 16, I_W13 = 32 * 16 * 16, I_W2 = 32 * 32 * 4;
constexpr int P0_ITEMS = I_ADA + I_WIN + I_WGAB + 2 * I_WB + I_WOUT + I_W13 + I_W2;
__device__ __forceinline__ void p0_item(int it, const float* const* in, unsigned char* ws, LAS float* scr, int lane) {
    if (it < I_ADA) {
        const int cb = it / KSL, ks = it % KSL, k0 = ks * 64; const float* c = in[1]; const float* w = in[3];
#pragma unroll
        for (int b = 0; b < NB; ++b) { const float cv = c[b * D_MODEL + k0 + lane]; scr[b * 64 + lane] = cv / (1.f + __expf(-cv)); }
        LDS_WAIT();
        float acc[NB];
#pragma unroll
        for (int b = 0; b < NB; ++b) acc[b] = 0.f;
        const int col = cb * 64 + lane;
#pragma unroll 8
        for (int kk = 0; kk < 64; ++kk) { const float wv = w[(size_t)(k0 + kk) * (6 * D_MODEL) + col];
#pragma unroll
            for (int b = 0; b < NB; ++b) acc[b] += scr[b * 64 + kk] * wv; }
        float* adap = (float*)(ws + WS_ADAP);
#pragma unroll
        for (int b = 0; b < NB; ++b) adap[(size_t)(ks * NB + b) * (6 * D_MODEL) + col] = acc[b];
        LDS_WAIT(); return;
    }
    it -= I_ADA;
    const int l31 = lane & 31;
    if (it < I_WIN) { const int nb = it / 16, kb = it % 16; tr_item(in[5], D_IN, win_src(nb * 32 + l31), (bf16_t*)(ws + WS_WIN), 1024, nb * 32, kb, scr, lane); return; }
    it -= I_WIN;
    if (it < I_WGAB) { const int nb = it / 16, kb = it % 16; tr_item(in[5], D_IN, O_GA + nb * 32 + l31, (bf16_t*)(ws + WS_WGAB), 1024, nb * 32, kb, scr, lane); return; }
    it -= I_WGAB;
    if (it < I_WB) { const int nb = it / 8, kb = it % 8; tr_item(in[9], D_MODEL, nb * 32 + l31, (bf16_t*)(ws + WS_WBA), 512, nb * 32, kb, scr, lane); return; }
    it -= I_WB;
    if (it < I_WB) { const int nb = it / 8, kb = it % 8; tr_item(in[10], D_MODEL, nb * 32 + l31, (bf16_t*)(ws + WS_WBB), 512, nb * 32, kb, scr, lane); return; }
    it -= I_WB;
    if (it < I_WOUT) { const int nb = it / 16, kb = it % 16; tr_item(in[11], D_MODEL, nb * 32 + l31, (bf16_t*)(ws + WS_WOUT), 1024, nb * 32, kb, scr, lane); return; }
    it -= I_WOUT;
    if (it < I_W13) {
        const int e = it / 256, r = it % 256, nb = r / 16, kb = r % 16; const int row0 = nb * 32;
        const int half = (row0 & 255) >> 7; const int col = (row0 >> 8) * 128 + (row0 & 127) + l31;
        const float* src = (half ? in[19] : in[18]) + (size_t)e * D_MODEL * D_EXP;
        tr_item(src, D_EXP, col, (bf16_t*)(ws + WS_W13) + (size_t)e * 512 * 1024, 1024, row0, kb, scr, lane); return; }
    it -= I_W13;
    { const int e = it / 128, r = it % 128, nb = r / 4, kb = r % 4;
      tr_item(in[20] + (size_t)e * D_EXP * D_MODEL, D_MODEL, nb * 32 + l31, (bf16_t*)(ws + WS_W2) + (size_t)e * 1024 * 256, 256, nb * 32, kb, scr, lane); }
}

__device__ __forceinline__ float wave_sum(float v) {
#pragma unroll
    for (int o = 1; o < 64; o <<= 1) v += __shfl_xor(v, o);
    return v;
}
__device__ __forceinline__ float ada_sum(const float* adap, const float* b_ada, int b, int j) {
    float s = b_ada[j];
#pragma unroll
    for (int k = 0; k < KSL; ++k) s += adap[(size_t)(k * NB + b) * (6 * D_MODEL) + j];
    return s;
}
__device__ __forceinline__ void p1_phase(const float* const* in, unsigned char* ws, LAS unsigned char* lds, int G) {
    const int tid = threadIdx.x, lane = tid & 63, wave = tid >> 6;
    const float* adap = (const float*)(ws + WS_ADAP); const float* b_ada = in[4]; const float* x = in[0];
    LAS float* sh = (LAS float*)lds; LAS float* sc = sh + D_MODEL;
    for (int blk = blockIdx.x; blk < NT / 128; blk += G) {
        const int b = blk / 32;
        __syncthreads();
        for (int j = tid; j < 2 * D_MODEL; j += NTHREADS) sh[j] = ada_sum(adap, b_ada, b, j);
        if ((blk & 31) == 0) { float* ada = (float*)(ws + WS_ADA) + (size_t)b * 6 * D_MODEL; for (int j = tid; j < 6 * D_MODEL; j += NTHREADS) ada[j] = ada_sum(adap, b_ada, b, j); }
        __syncthreads();
        for (int r = 0; r < 16; ++r) {
            const size_t row = (size_t)blk * 128 + wave * 16 + r;
            const f32x4* xr = (const f32x4*)(x + row * D_MODEL) + lane;
            f32x4 v[4]; float s = 0.f;
#pragma unroll
            for (int j = 0; j < 4; ++j) { v[j] = xr[64 * j]; s += (v[j].x + v[j].y) + (v[j].z + v[j].w); }
            const float mean = wave_sum(s) * (1.f / D_MODEL); float s2 = 0.f;
#pragma unroll
            for (int j = 0; j < 4; ++j) { v[j] = v[j] - mean; s2 += (v[j].x * v[j].x + v[j].y * v[j].y) + (v[j].z * v[j].z + v[j].w * v[j].w); }
            const float rstd = 1.f / sqrtf(wave_sum(s2) * (1.f / D_MODEL) + LN_EPS);
            u32x2* o8 = (u32x2*)((bf16_t*)(ws + WS_XN) + row * D_MODEL) + lane;
#pragma unroll
            for (int j = 0; j < 4; ++j) { const f32x4 a = *(const LAS f32x4*)(sc + 256 * j + 4 * lane), c = *(const LAS f32x4*)(sh + 256 * j + 4 * lane);
                const f32x4 y = v[j] * rstd * (a + 1.f) + c; u32x2 w; w.x = cvt_pk_bf16(y.x, y.y); w.y = cvt_pk_bf16(y.z, y.w); o8[64 * j] = w; }
        }
    }
}

struct EpiProj {
    static constexpr bool PERM = true, AFTER_DRAIN = false;
    unsigned char* ws;
    __device__ __forceinline__ void operator()(const f32x4 (&acc)[2][2][4][2], const Unit& u, int wr, int wc, int fr, int fq) const {
        const int row0 = u.pm * 256 + wr * 64 + fr; const int pn = u.pn;
        if (pn < 14) {
            bf16_t* base; int ld, ct; float sc = 1.f;
            if (pn < 6) { base = (bf16_t*)(ws + WS_QKV); ld = 1536; ct = pn * 256; if (pn < 2) sc = QSCALE; }
            else if (pn < 8) { base = (bf16_t*)(ws + WS_IQ); ld = 512; ct = (pn - 6) * 256; }
            else if (pn < 10) { base = (bf16_t*)(ws + WS_GQK); ld = 512; ct = (pn - 8) * 256; }
            else if (pn < 12) { base = (bf16_t*)(ws + WS_GV); ld = 512; ct = (pn - 10) * 256; }
            else { base = (bf16_t*)(ws + WS_GR); ld = 512; ct = (pn - 12) * 256; }
            const int col0 = ct + wc * 32 + 8 * fq;
#pragma unroll
            for (int ai = 0; ai < 2; ++ai)
#pragma unroll
                for (int m = 0; m < 4; ++m) { bf16_t* rowp = base + (size_t)(row0 + ai * 128 + m * 16) * ld + col0;
#pragma unroll
                    for (int bj = 0; bj < 2; ++bj) { const f32x4 v0 = acc[ai][bj][m][0] * sc, v1 = acc[ai][bj][m][1] * sc;
                        u32x4 w; w.x = cvt_pk_bf16(v0[0], v0[1]); w.y = cvt_pk_bf16(v0[2], v0[3]); w.z = cvt_pk_bf16(v1[0], v1[1]); w.w = cvt_pk_bf16(v1[2], v1[3]);
                        *(u32x4*)(rowp + bj * 128) = w; } }
        } else {
            const int c8 = wc * 32 + 8 * fq;
            if (c8 < 64) {
#pragma unroll
                for (int ai = 0; ai < 2; ++ai)
#pragma unroll
                    for (int m = 0; m < 4; ++m) { const size_t row = (size_t)(row0 + ai * 128 + m * 16); const f32x4 v0 = acc[ai][0][m][0], v1 = acc[ai][0][m][1];
                        if (c8 < 32) { u32x4 w; w.x = cvt_pk_bf16(v0[0], v0[1]); w.y = cvt_pk_bf16(v0[2], v0[3]); w.z = cvt_pk_bf16(v1[0], v1[1]); w.w = cvt_pk_bf16(v1[2], v1[3]);
                            *(u32x4*)((bf16_t*)(ws + WS_IK) + row * 32 + c8) = w; }
                        else if (c8 < 48) { float* p = (float*)(ws + WS_IW) + row * 16 + (c8 - 32); *(f32x4*)p = v0; *(f32x4*)(p + 4) = v1; }
                        else { u32x4 w; w.x = cvt_pk_bf16(v0[0], v0[1]); w.y = cvt_pk_bf16(v0[2], v0[3]); w.z = cvt_pk_bf16(v1[0], v1[1]); w.w = cvt_pk_bf16(v1[2], v1[3]);
                            *(u32x4*)((bf16_t*)(ws + WS_GLR) + row * 16 + (c8 - 48)) = w; } }
            }
        }
    }
};

typedef float f32x4_t __attribute__((ext_vector_type(4)));
constexpr int SC_TILES_PER_B = 528, SC_ITEMS = NB * SC_TILES_PER_B;
__device__ __forceinline__ size_t keys_row_dw(int b, int t) {
    const int qi = t >> 7, r = t & 127; return (size_t)b * (SC_TILES_PER_B * 8192) + (size_t)8192 * (qi * (qi + 1) / 2) + (size_t)r * (qi + 1) * 64;
}
__device__ __forceinline__ unsigned score_key(float sc) {
    const _Float16 hf = (_Float16)sc; const unsigned short hb = __builtin_bit_cast(unsigned short, hf);
    return (hb & 0x8000u) ? (unsigned)(unsigned short)~hb : (unsigned)(hb | 0x8000u);
}
constexpr int SC_SEGS_PER_B = 144, SC_SEGS = NB * SC_SEGS_PER_B;
__device__ __forceinline__ void p3a_segment(int seg, unsigned char* ws, LAS unsigned char* ldsw, int wave, int lane) {
    const int b = seg / SC_SEGS_PER_B; int idx = seg % SC_SEGS_PER_B; int qi = 0; while (idx >= (qi >> 2) + 1) { idx -= (qi >> 2) + 1; ++qi; }
    const int kj0 = 4 * idx, kj1 = (kj0 + 3 < qi) ? kj0 + 3 : qi;
    const int fr = lane & 15, fq = lane >> 4;
    const int t = qi * 128 + wave * 16 + fr; const size_t trow = (size_t)b * NS + t;
    const bf16_t* IQ = (const bf16_t*)(ws + WS_IQ) + trow * 512 + 8 * fq;
    const bf16_t* IK = (const bf16_t*)(ws + WS_IK) + ((size_t)b * NS + fr) * 32 + 8 * fq;
    const float* IW = (const float*)(ws + WS_IW) + trow * 16;
    LAS unsigned char* QL = ldsw; LAS float* WL = (LAS float*)(ldsw + 16384);
    bf16x8 kf[8];
#pragma unroll
    for (int kb = 0; kb < 8; ++kb) kf[kb] = *(const bf16x8*)(IK + ((size_t)kj0 * 128 + kb * 16) * 32);
    float qb[8];
#pragma unroll
    for (int j = 0; j < 8; ++j) qb[j] = 0.f;
#pragma unroll
    for (int hg = 0; hg < 4; ++hg) {
        const f32x4 w4 = *(const f32x4*)(IW + 4 * hg) * (0.5f * 0.044194173824159216f);
        u32x4 q4[4];
#pragma unroll
        for (int i = 0; i < 4; ++i) q4[i] = *(const u32x4*)(IQ + (4 * hg + i) * 32);
#pragma unroll
        for (int i = 0; i < 4; ++i) { *(LAS u32x4*)(QL + (4 * hg + i) * 1024 + lane * 16) = q4[i]; if (fq == 0) WL[(4 * hg + i) * 16 + fr] = w4[i]; float f[8]; bf8_to_f(q4[i], f);
#pragma unroll
            for (int j = 0; j < 8; ++j) qb[j] += w4[i] * f[j]; }
    }
    u32x4 qbw; qbw.x = cvtpk_s(qb[0], qb[1]); qbw.y = cvtpk_s(qb[2], qb[3]); qbw.z = cvtpk_s(qb[4], qb[5]); qbw.w = cvtpk_s(qb[6], qb[7]);
    const bf16x8 qbar = __builtin_bit_cast(bf16x8, qbw);
    LDS_WAIT();
    for (int kj = kj0; kj <= kj1; ++kj) {
        bf16x8 kn[8];
        const int kjn = (kj < kj1) ? kj + 1 : kj;
#pragma unroll
        for (int kb = 0; kb < 8; ++kb) kn[kb] = *(const bf16x8*)(IK + ((size_t)kjn * 128 + kb * 16) * 32);
        f32x4 acc[8];
#pragma unroll
        for (int kb = 0; kb < 8; ++kb) acc[kb] = __builtin_amdgcn_mfma_f32_16x16x32_bf16(kf[kb], qbar, (f32x4){0.f, 0.f, 0.f, 0.f}, 0, 0, 0);
#pragma unroll 4
        for (int h = 0; h < I_HEADS; ++h) {
            const bf16x8 qf = *(const LAS bf16x8*)(QL + h * 1024 + lane * 16); const float w = WL[h * 16 + fr];
#pragma unroll
            for (int kb = 0; kb < 8; ++kb) { const f32x4 d = __builtin_amdgcn_mfma_f32_16x16x32_bf16(kf[kb], qf, (f32x4){0.f, 0.f, 0.f, 0.f}, 0, 0, 0);
                acc[kb][0] += w * fabsf(d[0]); acc[kb][1] += w * fabsf(d[1]); acc[kb][2] += w * fabsf(d[2]); acc[kb][3] += w * fabsf(d[3]); }
        }
        unsigned* KEYS = (unsigned*)(ws + WS_SC) + keys_row_dw(b, t) + (size_t)kj * 64;
        const bool diag = (kj == qi);
#pragma unroll
        for (int kb = 0; kb < 4; ++kb) { u32x4 o;
#pragma unroll
            for (int r = 0; r < 4; ++r) { const int sl = kb * 16 + 4 * fq + r;
                unsigned lo = score_key(acc[kb][r]), hi = score_key(acc[kb + 4][r]);
                if (diag) { const int tl = wave * 16 + fr; if (sl > tl) lo = 0u; if (sl + 64 > tl) hi = 0u; }
                o[r] = lo | (hi << 16); }
            *(u32x4*)(KEYS + kb * 16 + 4 * fq) = o; }
#pragma unroll
        for (int kb = 0; kb < 8; ++kb) kf[kb] = kn[kb];
    }
    LDS_WAIT();
}

__device__ __forceinline__ int dpp_row_sum(int v) {
    v += __builtin_amdgcn_update_dpp(0, v, 0xB1, 0xF, 0xF, true);
    v += __builtin_amdgcn_update_dpp(0, v, 0x4E, 0xF, 0xF, true);
    v += __builtin_amdgcn_update_dpp(0, v, 0x141, 0xF, 0xF, true);
    v += __builtin_amdgcn_update_dpp(0, v, 0x140, 0xF, 0xF, true);
    return v;
}
__device__ __forceinline__ int wave_sum_i(int v) {
    v = dpp_row_sum(v);
    return __builtin_amdgcn_readlane(v, 0) + __builtin_amdgcn_readlane(v, 16) + __builtin_amdgcn_readlane(v, 32) + __builtin_amdgcn_readlane(v, 48);
}
__device__ __forceinline__ void pk_ge_count4(unsigned x0, unsigned x1, unsigned x2, unsigned x3, unsigned c2m1, unsigned one2, unsigned& c0, unsigned& c1, unsigned& c2, unsigned& c3) {
    unsigned d0, d1, d2, d3;
    asm volatile("v_pk_sub_u16 %0, %8, %12 clamp\n\tv_pk_sub_u16 %1, %9, %12 clamp\n\tv_pk_sub_u16 %2, %10, %12 clamp\n\tv_pk_sub_u16 %3, %11, %12 clamp\n\t"
                 "v_pk_min_u16 %0, %0, %13\n\tv_pk_min_u16 %1, %1, %13\n\tv_pk_min_u16 %2, %2, %13\n\tv_pk_min_u16 %3, %3, %13\n\t"
                 "v_pk_add_u16 %4, %4, %0\n\tv_pk_add_u16 %5, %5, %1\n\tv_pk_add_u16 %6, %6, %2\n\tv_pk_add_u16 %7, %7, %3"
                 : "=&v"(d0), "=&v"(d1), "=&v"(d2), "=&v"(d3), "+v"(c0), "+v"(c1), "+v"(c2), "+v"(c3) : "v"(x0), "v"(x1), "v"(x2), "v"(x3), "v"(c2m1), "v"(one2));
}
constexpr int TOPK = 256;
__device__ __forceinline__ int count_ge(const unsigned (&x)[32], int ng, unsigned cand) {
    const unsigned c2m1 = (cand - 1u) * 0x00010001u, one2 = 0x00010001u; unsigned c0 = 0u, c1 = 0u, c2 = 0u, c3 = 0u;
#pragma unroll
    for (int g = 0; g < 4; ++g) if (g < ng) { pk_ge_count4(x[8 * g], x[8 * g + 1], x[8 * g + 2], x[8 * g + 3], c2m1, one2, c0, c1, c2, c3); pk_ge_count4(x[8 * g + 4], x[8 * g + 5], x[8 * g + 6], x[8 * g + 7], c2m1, one2, c0, c1, c2, c3); }
    const unsigned s = (c0 + c1) + (c2 + c3);
    return wave_sum_i((int)((s & 0xFFFFu) + (s >> 16)));
}
__device__ __forceinline__ void p4a_row(int row_, unsigned char* ws, int lane) {
    const int row = __builtin_amdgcn_readfirstlane(row_);
    const int b = row / NS, t = row % NS; unsigned long long* MASK = (unsigned long long*)(ws + WS_MASK) + (size_t)row * 64;
    const int nc = (t >> 7) + 1;
    if (t < TOPK) {
        if (lane < 2 * nc) { const int lo = lane * 64; unsigned long long m = 0ull; if (t >= lo + 63) m = ~0ull; else if (t >= lo) m = (2ull << (t - lo)) - 1ull; MASK[lane] = m; }
        return;
    }
    const unsigned* KEYS = (const unsigned*)(ws + WS_SC) + keys_row_dw(b, t) + lane;
    const int ng = (nc + 7) >> 3;
    unsigned x[32];
#pragma unroll
    for (int g = 0; g < 4; ++g) {
        if (g < ng) {
#pragma unroll
            for (int i = 0; i < 8; ++i) { const int c = 8 * g + i; const int cc = c < nc ? c : nc - 1; const unsigned v = KEYS[cc * 64]; x[c] = c < nc ? v : 0u; }
        } else {
#pragma unroll
            for (int i = 0; i < 8; ++i) x[8 * g + i] = 0u;
        }
    }
    unsigned T = 0u; int cT = 0;
    for (int bit = 15; bit >= 0; --bit) { const unsigned cand = T | (1u << bit); const int cnt = count_ge(x, ng, cand); if (cnt >= TOPK) { T = cand; cT = cnt; } }
    unsigned mw0 = 0u, mw1 = 0u;
    if (cT == TOPK) {
#pragma unroll
        for (int g = 0; g < 4; ++g) if (g < ng) {
#pragma unroll
            for (int i = 0; i < 8; ++i) { const int c = 8 * g + i;
                const unsigned long long mlo = __ballot((x[c] & 0xFFFFu) >= T), mhi = __ballot((x[c] >> 16) >= T);
                asm volatile("s_nop 3\n\tv_writelane_b32 %0, %2, %4\n\tv_writelane_b32 %1, %3, %4" : "+v"(mw0), "+v"(mw1) : "s"((unsigned)mlo), "s"((unsigned)(mlo >> 32)), "n"(2 * c));
                asm volatile("s_nop 3\n\tv_writelane_b32 %0, %2, %4\n\tv_writelane_b32 %1, %3, %4" : "+v"(mw0), "+v"(mw1) : "s"((unsigned)mhi), "s"((unsigned)(mhi >> 32)), "n"(2 * c + 1)); }
        }
    } else {
        const int need = TOPK - count_ge(x, ng, T + 1u); int run = 0;
#pragma unroll
        for (int g = 0; g < 4; ++g) if (g < ng) {
#pragma unroll
            for (int i = 0; i < 8; ++i) { const int c = 8 * g + i;
                const unsigned klo = x[c] & 0xFFFFu, khi = x[c] >> 16;
                const unsigned long long elo = __ballot(klo == T), ehi = __ballot(khi == T);
                const int rlo = run + (int)__builtin_amdgcn_mbcnt_hi((unsigned)(elo >> 32), __builtin_amdgcn_mbcnt_lo((unsigned)elo, 0u));
                const int nlo = __builtin_popcountll(elo);
                const int rhi = run + nlo + (int)__builtin_amdgcn_mbcnt_hi((unsigned)(ehi >> 32), __builtin_amdgcn_mbcnt_lo((unsigned)ehi, 0u));
                run += nlo + __builtin_popcountll(ehi);
                const bool slo = (klo > T) || (klo == T && rlo < need), shi = (khi > T) || (khi == T && rhi < need);
                const unsigned long long mlo = __ballot(slo), mhi = __ballot(shi);
                asm volatile("s_nop 3\n\tv_writelane_b32 %0, %2, %4\n\tv_writelane_b32 %1, %3, %4" : "+v"(mw0), "+v"(mw1) : "s"((unsigned)mlo), "s"((unsigned)(mlo >> 32)), "n"(2 * c));
                asm volatile("s_nop 3\n\tv_writelane_b32 %0, %2, %4\n\tv_writelane_b32 %1, %3, %4" : "+v"(mw0), "+v"(mw1) : "s"((unsigned)mhi), "s"((unsigned)(mhi >> 32)), "n"(2 * c + 1)); }
        }
    }
    if (lane < 2 * nc) MASK[lane] = ((unsigned long long)mw1 << 32) | mw0;
}

typedef float f32x16 __attribute__((ext_vector_type(16)));
typedef short s16x4 __attribute__((ext_vector_type(4)));
__device__ __forceinline__ int crow(int r, int hi) { return (r & 3) + 8 * (r >> 2) + 4 * hi; }
__device__ __forceinline__ s16x4 vtr(const LAS unsigned char* p) { return __builtin_bit_cast(s16x4, __builtin_amdgcn_ds_read_tr16_b64_v4i16((LAS s16x4*)p)); }
constexpr size_t WS_OA = 358 * MiB, WS_OB = 390 * MiB;
constexpr int AT_ROWB = 144, AT_TILE = 64 * AT_ROWB, AT_K = 0, AT_V = 2 * AT_TILE, AT_BT = 4 * AT_TILE;
constexpr float LOG2E = 1.4426950408889634f;
__device__ __forceinline__ void attn_tile(const LAS unsigned char* Kb, const LAS unsigned char* Vb, const LAS float* BT, const bf16x8 (&qr)[4], unsigned long long mword, bool far, float cB, int dist0,
                                          int r32, int hh, int voff, f32x16& o0, f32x16& o1, float& m, float& l) {
    f32x16 p0, p1;
    const float c0 = far ? cB : 0.f;
#pragma unroll
    for (int i = 0; i < 16; ++i) { p0[i] = c0; p1[i] = c0; }
#pragma unroll
    for (int ks = 0; ks < 4; ++ks) {
        const bf16x8 k0 = *(const LAS bf16x8*)(Kb + r32 * AT_ROWB + 32 * ks + 16 * hh);
        const bf16x8 k1 = *(const LAS bf16x8*)(Kb + (32 + r32) * AT_ROWB + 32 * ks + 16 * hh);
        p0 = __builtin_amdgcn_mfma_f32_32x32x16_bf16(k0, qr[ks], p0, 0, 0, 0);
        p1 = __builtin_amdgcn_mfma_f32_32x32x16_bf16(k1, qr[ks], p1, 0, 0, 0);
    }
    if (!far) {
#pragma unroll
        for (int i = 0; i < 16; ++i) { const int dd = dist0 - ((i & 3) + 8 * (i >> 2)); const int da = dd < 0 ? 0 : dd, db = dd - 32 < 0 ? 0 : dd - 32; p0[i] += BT[da]; p1[i] += BT[db]; }
    }
    float mx = p0[0];
#pragma unroll
    for (int i = 1; i < 16; ++i) mx = fmaxf(mx, p0[i]);
#pragma unroll
    for (int i = 0; i < 16; ++i) mx = fmaxf(mx, p1[i]);
    { const auto rr = __builtin_amdgcn_permlane32_swap(__float_as_uint(mx), __float_as_uint(mx), false, false); mx = fmaxf(__uint_as_float(rr[0]), __uint_as_float(rr[1])); }
    const float mn = fmaxf(m, mx); const float alpha = __builtin_amdgcn_exp2f(m - mn); m = mn;
    const unsigned wl = (unsigned)mword >> (4 * hh), wh = (unsigned)(mword >> 32) >> (4 * hh);
    float ls = 0.f;
#pragma unroll
    for (int i = 0; i < 16; ++i) { const int c = (i & 3) + 8 * (i >> 2);
        const int m0 = ((int)(wl << (31 - c))) >> 31, m1 = ((int)(wh << (31 - c))) >> 31;
        p0[i] = __uint_as_float(__float_as_uint(__builtin_amdgcn_exp2f(p0[i] - mn)) & (unsigned)m0);
        p1[i] = __uint_as_float(__float_as_uint(__builtin_amdgcn_exp2f(p1[i] - mn)) & (unsigned)m1);
        ls += p0[i] + p1[i]; }
    l = l * alpha + ls;
#pragma unroll
    for (int i = 0; i < 16; ++i) { o0[i] *= alpha; o1[i] *= alpha; }
#pragma unroll
    for (int kb = 0; kb < 2; ++kb)
#pragma unroll
        for (int s = 0; s < 2; ++s) {
            u32x4 pw;
            if (kb == 0) { pw.x = cvtpk_s(p0[8 * s], p0[8 * s + 1]); pw.y = cvtpk_s(p0[8 * s + 2], p0[8 * s + 3]); pw.z = cvtpk_s(p0[8 * s + 4], p0[8 * s + 5]); pw.w = cvtpk_s(p0[8 * s + 6], p0[8 * s + 7]); }
            else { pw.x = cvtpk_s(p1[8 * s], p1[8 * s + 1]); pw.y = cvtpk_s(p1[8 * s + 2], p1[8 * s + 3]); pw.z = cvtpk_s(p1[8 * s + 4], p1[8 * s + 5]); pw.w = cvtpk_s(p1[8 * s + 6], p1[8 * s + 7]); }
            const bf16x8 pf = __builtin_bit_cast(bf16x8, pw);
            const LAS unsigned char* vp = Vb + (32 * kb + 16 * s) * AT_ROWB + voff;
            const s16x4 a0l = vtr(vp), a0h = vtr(vp + 8 * AT_ROWB), a1l = vtr(vp + 64), a1h = vtr(vp + 8 * AT_ROWB + 64);
            const bf16x8 va0 = (bf16x8){a0l[0], a0l[1], a0l[2], a0l[3], a0h[0], a0h[1], a0h[2], a0h[3]};
            const bf16x8 va1 = (bf16x8){a1l[0], a1l[1], a1l[2], a1l[3], a1h[0], a1h[1], a1h[2], a1h[3]};
            o0 = __builtin_amdgcn_mfma_f32_32x32x16_bf16(va0, pf, o0, 0, 0, 0);
            o1 = __builtin_amdgcn_mfma_f32_32x32x16_bf16(va1, pf, o1, 0, 0, 0);
        }
}
__device__ __forceinline__ void attn_unit(int b, int h, int Q, const float* rel_bias, unsigned char* ws, LAS unsigned char* lds) {
    const int tid = threadIdx.x, lane = tid & 63, wave = __builtin_amdgcn_readfirstlane(tid >> 6), r32 = lane & 31, hh = lane >> 5;
    const size_t rowbase = (size_t)b * NS; const int t0w = 256 * Q + 32 * wave, t = t0w + r32;
    const bf16_t* QKV = (const bf16_t*)(ws + WS_QKV);
    LAS float* BT = (LAS float*)(lds + AT_BT);
    const int NTL = 4 * (Q + 1);
    const int lastw = (t0w + 31) >> 6;
    const int srow = tid >> 3, sch = tid & 7;
    const bf16_t* kg = QKV + (rowbase + srow) * 1536 + 512 + h * 64 + sch * 8; const bf16_t* vg = kg + 512;
    const int soff = srow * AT_ROWB + sch * 16;
    const unsigned long long* MK = (const unsigned long long*)(ws + WS_MASK) + (rowbase + t) * 64;
    const size_t tstride = (size_t)64 * 1536;
    u32x4 k0r = *(const u32x4*)kg, v0r = *(const u32x4*)vg;
    u32x4 kA = *(const u32x4*)(kg + tstride), vA = *(const u32x4*)(vg + tstride);
    u32x4 kB = *(const u32x4*)(kg + 2 * tstride), vB = *(const u32x4*)(vg + 2 * tstride);
    unsigned long long me = MK[0], mo = MK[(1 <= lastw) ? 1 : 0];
    bf16x8 qr[4];
#pragma unroll
    for (int ks = 0; ks < 4; ++ks) qr[ks] = *(const bf16x8*)(QKV + (rowbase + t) * 1536 + h * 64 + 16 * ks + 8 * hh);
    __syncthreads();
    if (tid < 256) BT[tid] = rel_bias[v0_bucket(tid) * A_HEADS + h] * LOG2E;
    const float cB = rel_bias[31 * A_HEADS + h] * LOG2E;
    *(LAS u32x4*)(lds + AT_K + soff) = k0r; *(LAS u32x4*)(lds + AT_V + soff) = v0r;
    f32x16 o0, o1;
#pragma unroll
    for (int i = 0; i < 16; ++i) { o0[i] = 0.f; o1[i] = 0.f; }
    float m = -INFINITY, l = 0.f;
    const int q4 = (lane & 15) >> 2, p4 = lane & 3, blk = (lane >> 4) & 1;
    const int voff = (4 * hh + q4) * AT_ROWB + (16 * blk + 4 * p4) * 2;
    for (int kt = 0; kt < NTL; kt += 2) {
        __syncthreads();
        *(LAS u32x4*)(lds + AT_K + AT_TILE + soff) = kA; *(LAS u32x4*)(lds + AT_V + AT_TILE + soff) = vA;
        { const int tn = (kt + 3 < NTL) ? kt + 3 : NTL - 1; kA = *(const u32x4*)(kg + (size_t)tn * tstride); vA = *(const u32x4*)(vg + (size_t)tn * tstride); }
        if (kt <= lastw) attn_tile(lds + AT_K, lds + AT_V, BT, qr, me, (t0w - (64 * kt + 63) >= 113), cB, t - 64 * kt - 4 * hh, r32, hh, voff, o0, o1, m, l);
        me = MK[(kt + 2 <= lastw) ? kt + 2 : lastw];
        __syncthreads();
        *(LAS u32x4*)(lds + AT_K + soff) = kB; *(LAS u32x4*)(lds + AT_V + soff) = vB;
        { const int tn = (kt + 4 < NTL) ? kt + 4 : NTL - 1; kB = *(const u32x4*)(kg + (size_t)tn * tstride); vB = *(const u32x4*)(vg + (size_t)tn * tstride); }
        if (kt + 1 <= lastw) attn_tile(lds + AT_K + AT_TILE, lds + AT_V + AT_TILE, BT, qr, mo, (t0w - (64 * (kt + 1) + 63) >= 113), cB, t - 64 * (kt + 1) - 4 * hh, r32, hh, voff, o0, o1, m, l);
        mo = MK[(kt + 3 <= lastw) ? kt + 3 : lastw];
    }
    { const auto rr = __builtin_amdgcn_permlane32_swap(__float_as_uint(l), __float_as_uint(l), false, false); l = __uint_as_float(rr[0]) + __uint_as_float(rr[1]); }
    const float inv = 1.f / l;
    bf16_t* O = (bf16_t*)(ws + WS_OA) + (rowbase + t) * 512 + h * 64 + 4 * hh;
#pragma unroll
    for (int g = 0; g < 4; ++g) {
        u32x2 w0, w1; w0.x = cvtpk_s(o0[4 * g] * inv, o0[4 * g + 1] * inv); w0.y = cvtpk_s(o0[4 * g + 2] * inv, o0[4 * g + 3] * inv);
        w1.x = cvtpk_s(o1[4 * g] * inv, o1[4 * g + 1] * inv); w1.y = cvtpk_s(o1[4 * g + 2] * inv, o1[4 * g + 3] * inv);
        *(u32x2*)(O + 8 * g) = w0; *(u32x2*)(O + 32 + 8 * g) = w1;
    }
}

constexpr int GL_LG = 0, GL_SEG = 16384, GL_A = 18432, GL_B = GL_A + 9216, GL_C = GL_B + 9216, GL_VT = GL_C + 9216, GL_ST = GL_VT + 18432;
constexpr int GROWB = 144;
constexpr int GLA_ITEMS = NB * G_HEADS * 64;
__device__ __forceinline__ void gla_cumdecay(const u32x4 g0, const u32x4 g1, int h, const float* wg, const float* bg, LAS unsigned char* lds) {
    const int tid = threadIdx.x; LAS float* LG = (LAS float*)(lds + GL_LG); LAS float* SEG = (LAS float*)(lds + GL_SEG);
    {   const int c = tid >> 3, dg = tid & 7; float gl[16];
#pragma unroll
        for (int j = 0; j < 4; ++j) { gl[2 * j] = __uint_as_float(g0[j] << 16); gl[2 * j + 1] = __uint_as_float(g0[j] & 0xffff0000u); gl[8 + 2 * j] = __uint_as_float(g1[j] << 16); gl[8 + 2 * j + 1] = __uint_as_float(g1[j] & 0xffff0000u); }
        float z[8];
#pragma unroll
        for (int j = 0; j < 8; ++j) z[j] = bg[h * 64 + 8 * dg + j];
#pragma unroll
        for (int r = 0; r < 16; ++r) { const f32x4 w0 = *(const f32x4*)(wg + r * G_KW + h * 64 + 8 * dg), w1 = *(const f32x4*)(wg + r * G_KW + h * 64 + 8 * dg + 4);
            z[0] += gl[r] * w0[0]; z[1] += gl[r] * w0[1]; z[2] += gl[r] * w0[2]; z[3] += gl[r] * w0[3]; z[4] += gl[r] * w1[0]; z[5] += gl[r] * w1[1]; z[6] += gl[r] * w1[2]; z[7] += gl[r] * w1[3]; }
#pragma unroll
        for (int j = 0; j < 8; ++j) z[j] = (fminf(z[j], 0.f) - log1pf(__expf(-fabsf(z[j])))) * (1.f / 16.f);
        *(LAS f32x4*)(LG + c * 64 + 8 * dg) = (f32x4){z[0], z[1], z[2], z[3]}; *(LAS f32x4*)(LG + c * 64 + 8 * dg + 4) = (f32x4){z[4], z[5], z[6], z[7]};
    }
    __syncthreads();
    const int seg = tid >> 6, d = tid & 63; float v[8];
#pragma unroll
    for (int i = 0; i < 8; ++i) v[i] = LG[(8 * seg + i) * 64 + d];
#pragma unroll
    for (int i = 1; i < 8; ++i) v[i] += v[i - 1];
    SEG[seg * 64 + d] = v[7];
    __syncthreads();
    float off = 0.f;
#pragma unroll
    for (int s2 = 0; s2 < 8; ++s2) if (s2 < seg) off += SEG[s2 * 64 + d];
#pragma unroll
    for (int i = 0; i < 8; ++i) LG[(8 * seg + i) * 64 + d] = v[i] + off;
    __syncthreads();
}
__device__ __forceinline__ unsigned short f2bf_s(float f) { return (unsigned short)(cvtpk_s(f, 0.f) & 0xffffu); }
__device__ __forceinline__ void gla_stage_vt(const u32x4 a, const u32x4 b2, LAS unsigned char* lds) {
    const int tid = threadIdx.x, c = tid >> 3, d0 = (tid & 7) * 16;
#pragma unroll
    for (int j = 0; j < 4; ++j) {
        *(LAS unsigned short*)(lds + GL_VT + (d0 + 2 * j) * GROWB + c * 2) = (unsigned short)(a[j] & 0xffffu); *(LAS unsigned short*)(lds + GL_VT + (d0 + 2 * j + 1) * GROWB + c * 2) = (unsigned short)(a[j] >> 16);
        *(LAS unsigned short*)(lds + GL_VT + (d0 + 8 + 2 * j) * GROWB + c * 2) = (unsigned short)(b2[j] & 0xffffu); *(LAS unsigned short*)(lds + GL_VT + (d0 + 8 + 2 * j + 1) * GROWB + c * 2) = (unsigned short)(b2[j] >> 16); }
}
__device__ __forceinline__ void p3b_item(int it, const float* wg, const float* bg, float* UT, unsigned char* ws, LAS unsigned char* lds) {
    const int tid = threadIdx.x, lane = tid & 63, wave = tid >> 6, fr = lane & 15, fq = lane >> 4;
    const int bh = it >> 6, n = it & 63, b = bh >> 2, h = bh & 3; const size_t r0 = (size_t)b * NS + 64 * n;
    const int c_ = tid >> 3, dg_ = tid & 7;
    const bf16_t* gp_ = (const bf16_t*)(ws + WS_GLR) + (r0 + c_) * 16; const u32x4 g0 = *(const u32x4*)gp_, g1 = *(const u32x4*)(gp_ + 8);
    const u32x4 kraw = *(const u32x4*)((const bf16_t*)(ws + WS_GQK) + (r0 + c_) * 512 + 256 + h * 64 + 8 * dg_);
    const bf16_t* vp_ = (const bf16_t*)(ws + WS_GV) + (r0 + c_) * 512 + h * 128 + dg_ * 16; const u32x4 va_ = *(const u32x4*)vp_, vb_ = *(const u32x4*)(vp_ + 8);
    __syncthreads();
    gla_cumdecay(g0, g1, h, wg, bg, lds);
    const LAS float* LG = (const LAS float*)(lds + GL_LG);
    {   const int c = tid >> 3, dg = tid & 7; float kf[8]; bf8_to_f(kraw, kf);
#pragma unroll
        for (int j = 0; j < 8; ++j) { const int d = 8 * dg + j; *(LAS unsigned short*)(lds + GL_A + d * GROWB + c * 2) = f2bf_s(kf[j] * __expf(LG[63 * 64 + d] - LG[c * 64 + d])); }
        if (tid < 64) ((float*)(ws + WS_MISC))[(size_t)it * 64 + tid] = __expf(LG[63 * 64 + tid]);
    }
    gla_stage_vt(va_, vb_, lds);
    __syncthreads();
    f32x4 acc[4];
#pragma unroll
    for (int i = 0; i < 4; ++i) acc[i] = (f32x4){0.f, 0.f, 0.f, 0.f};
#pragma unroll
    for (int ks = 0; ks < 2; ++ks) { const bf16x8 bv = *(const LAS bf16x8*)(lds + GL_VT + (16 * wave + fr) * GROWB + (32 * ks + 8 * fq) * 2);
#pragma unroll
        for (int i = 0; i < 4; ++i) { const bf16x8 av = *(const LAS bf16x8*)(lds + GL_A + (16 * i + fr) * GROWB + (32 * ks + 8 * fq) * 2); acc[i] = __builtin_amdgcn_mfma_f32_16x16x32_bf16(av, bv, acc[i], 0, 0, 0); } }
#pragma unroll
    for (int i = 0; i < 4; ++i) *(f32x4*)(UT + ((size_t)it * 128 + 16 * wave + fr) * 64 + 16 * i + 4 * fq) = acc[i];
}
__device__ __forceinline__ void p4b_item(int j, const float* UT, bf16_t* SP, unsigned char* ws) {
    const int tid = threadIdx.x, bh = j >> 2, dv = (j & 3) * 32 + (tid >> 4), dk = (tid & 15) * 4; const float* DEC = (const float*)(ws + WS_MISC);
    f32x4 st = (f32x4){0.f, 0.f, 0.f, 0.f};
#pragma unroll 4
    for (int n = 0; n < 64; ++n) { const size_t it = (size_t)bh * 64 + n; const size_t o = (it * 128 + dv) * 64 + dk;
        u32x2 w; w.x = cvtpk_s(st[0], st[1]); w.y = cvtpk_s(st[2], st[3]); *(u32x2*)(SP + o) = w;
        const f32x4 u = *(const f32x4*)(UT + o), dc = *(const f32x4*)(DEC + it * 64 + dk); st = dc * st + u; }
}
__device__ __forceinline__ void p5b_item(int it, const float* wg, const float* bg, const float* ng, const bf16_t* SP, unsigned char* ws, LAS unsigned char* lds) {
    const int tid = threadIdx.x, lane = tid & 63, wave = tid >> 6, r32 = lane & 31, hh = lane >> 5;
    const int bh = it >> 6, n = it & 63, b = bh >> 2, h = bh & 3; const size_t r0 = (size_t)b * NS + 64 * n;
    const int c_ = tid >> 3, dg_ = tid & 7; const int dvb = wave >> 1, cb = wave & 1;
    const bf16_t* gp_ = (const bf16_t*)(ws + WS_GLR) + (r0 + c_) * 16; const u32x4 g0 = *(const u32x4*)gp_, g1 = *(const u32x4*)(gp_ + 8);
    const bf16_t* qp_ = (const bf16_t*)(ws + WS_GQK) + (r0 + c_) * 512 + h * 64 + 8 * dg_; const u32x4 qraw = *(const u32x4*)qp_, kraw = *(const u32x4*)(qp_ + 256);
    const bf16_t* vp_ = (const bf16_t*)(ws + WS_GV) + (r0 + c_) * 512 + h * 128 + dg_ * 16; const u32x4 va_ = *(const u32x4*)vp_, vb_ = *(const u32x4*)(vp_ + 8);
    bf16x8 spf[4];
#pragma unroll
    for (int ks = 0; ks < 4; ++ks) spf[ks] = *(const bf16x8*)(SP + ((size_t)it * 128 + 32 * dvb + r32) * 64 + 16 * ks + 8 * hh);
    const size_t trow = r0 + 32 * cb + r32; const int dvbase = h * 128 + 32 * dvb + 4 * hh;
    const bf16_t* grp = (const bf16_t*)(ws + WS_GR) + trow * 512 + dvbase; u32x2 grw[4];
#pragma unroll
    for (int g = 0; g < 4; ++g) grw[g] = *(const u32x2*)(grp + 8 * g);
    __syncthreads();
    gla_cumdecay(g0, g1, h, wg, bg, lds);
    const LAS float* LG = (const LAS float*)(lds + GL_LG);
    {   const int c = tid >> 3, dg = tid & 7; float qf[8], kf[8]; bf8_to_f(qraw, qf); bf8_to_f(kraw, kf);
        float qr[8], ks[8], qi[8];
#pragma unroll
        for (int j = 0; j < 8; ++j) { const int d = 8 * dg + j; const float bc = LG[c * 64 + d], bl = LG[63 * 64 + d]; const float q8 = qf[j] * 0.125f;
            qr[j] = q8 * __expf(bc - bl); ks[j] = kf[j] * __expf(bl - bc); qi[j] = q8 * __expf(bc); }
        u32x4 w;
        w.x = cvtpk_s(qr[0], qr[1]); w.y = cvtpk_s(qr[2], qr[3]); w.z = cvtpk_s(qr[4], qr[5]); w.w = cvtpk_s(qr[6], qr[7]); *(LAS u32x4*)(lds + GL_A + c * GROWB + 16 * dg) = w;
        w.x = cvtpk_s(ks[0], ks[1]); w.y = cvtpk_s(ks[2], ks[3]); w.z = cvtpk_s(ks[4], ks[5]); w.w = cvtpk_s(ks[6], ks[7]); *(LAS u32x4*)(lds + GL_B + c * GROWB + 16 * dg) = w;
        w.x = cvtpk_s(qi[0], qi[1]); w.y = cvtpk_s(qi[2], qi[3]); w.z = cvtpk_s(qi[4], qi[5]); w.w = cvtpk_s(qi[6], qi[7]); *(LAS u32x4*)(lds + GL_C + c * GROWB + 16 * dg) = w;
    }
    gla_stage_vt(va_, vb_, lds);
    __syncthreads();
    f32x16 o;
#pragma unroll
    for (int i = 0; i < 16; ++i) o[i] = 0.f;
#pragma unroll
    for (int jb = 0; jb < 2; ++jb) if (jb <= cb) {
        f32x16 at;
#pragma unroll
        for (int i = 0; i < 16; ++i) at[i] = 0.f;
#pragma unroll
        for (int ks = 0; ks < 4; ++ks) { const bf16x8 av = *(const LAS bf16x8*)(lds + GL_B + (32 * jb + r32) * GROWB + 32 * ks + 16 * hh), bv = *(const LAS bf16x8*)(lds + GL_A + (32 * cb + r32) * GROWB + 32 * ks + 16 * hh);
            at = __builtin_amdgcn_mfma_f32_32x32x16_bf16(av, bv, at, 0, 0, 0); }
        if (jb == cb) {
#pragma unroll
            for (int i = 0; i < 16; ++i) if (crow(i, hh) > r32) at[i] = 0.f; }
#pragma unroll
        for (int s = 0; s < 2; ++s) {
            u32x4 pw; pw.x = cvtpk_s(at[8 * s], at[8 * s + 1]); pw.y = cvtpk_s(at[8 * s + 2], at[8 * s + 3]); pw.z = cvtpk_s(at[8 * s + 4], at[8 * s + 5]); pw.w = cvtpk_s(at[8 * s + 6], at[8 * s + 7]);
            const LAS unsigned char* vp = lds + GL_VT + (32 * dvb + r32) * GROWB + (32 * jb + 16 * s + 4 * hh) * 2;
            const u32x2 lo = *(const LAS u32x2*)vp, hi = *(const LAS u32x2*)(vp + 16);
            const u32x4 va = (u32x4){lo.x, lo.y, hi.x, hi.y};
            o = __builtin_amdgcn_mfma_f32_32x32x16_bf16(__builtin_bit_cast(bf16x8, va), __builtin_bit_cast(bf16x8, pw), o, 0, 0, 0);
        }
    }
#pragma unroll
    for (int ks = 0; ks < 4; ++ks) { const bf16x8 bv = *(const LAS bf16x8*)(lds + GL_C + (32 * cb + r32) * GROWB + 32 * ks + 16 * hh);
        o = __builtin_amdgcn_mfma_f32_32x32x16_bf16(spf[ks], bv, o, 0, 0, 0); }
    LAS float* ST = (LAS float*)(lds + GL_ST);
    float sm = 0.f;
#pragma unroll
    for (int i = 0; i < 16; ++i) sm += o[i];
    sm += __shfl_xor(sm, 32);
    if (hh == 0) ST[dvb * 64 + 32 * cb + r32] = sm;
    __syncthreads();
    const float mean = (ST[32 * cb + r32] + ST[64 + 32 * cb + r32] + ST[128 + 32 * cb + r32] + ST[192 + 32 * cb + r32]) * (1.f / 128.f);
    float sq = 0.f;
#pragma unroll
    for (int i = 0; i < 16; ++i) { o[i] -= mean; sq += o[i] * o[i]; }
    sq += __shfl_xor(sq, 32);
    if (hh == 0) ST[256 + dvb * 64 + 32 * cb + r32] = sq;
    __syncthreads();
    const float var = (ST[256 + 32 * cb + r32] + ST[256 + 64 + 32 * cb + r32] + ST[256 + 128 + 32 * cb + r32] + ST[256 + 192 + 32 * cb + r32]) * (1.f / 128.f);
    const float rstd = 1.f / sqrtf(var + LN_EPS);
    bf16_t* op = (bf16_t*)(ws + WS_OB) + trow * 512 + dvbase;
#pragma unroll
    for (int g = 0; g < 4; ++g) { const u32x2 gw = grw[g]; const f32x4 nv = *(const f32x4*)(ng + dvbase + 8 * g);
        float gr[4] = {__uint_as_float(gw.x << 16), __uint_as_float(gw.x & 0xffff0000u), __uint_as_float(gw.y << 16), __uint_as_float(gw.y & 0xffff0000u)}; float y[4];
#pragma unroll
        for (int e = 0; e < 4; ++e) y[e] = o[4 * g + e] * rstd * nv[e] * (gr[e] / (1.f + __expf(-gr[e])));
        u32x2 w; w.x = cvtpk_s(y[0], y[1]); w.y = cvtpk_s(y[2], y[3]); *(u32x2*)(op + 8 * g) = w; }
}

constexpr size_t WS_SG = 129 * MiB;
constexpr size_t WS_MRG = 257 * MiB;
constexpr size_t WS_H2 = WS_XN;
constexpr size_t WS_XG = 129 * MiB;
constexpr size_t WS_HID = 321 * MiB;
constexpr size_t WS_YG = 358 * MiB;
constexpr size_t WS_EID = WS_MISC + 1 * MiB, WS_EW = WS_EID + 256 * 1024, WS_POS = WS_EW + 256 * 1024;
constexpr int LDS_TAB = 131072;
__device__ __forceinline__ u32x4 pack8(const f32x4 a, const f32x4 b) { u32x4 w; w.x = cvtpk_s(a[0], a[1]); w.y = cvtpk_s(a[2], a[3]); w.z = cvtpk_s(b[0], b[1]); w.w = cvtpk_s(b[2], b[3]); return w; }
__device__ __forceinline__ f32x4 sig4(const f32x4 v) { f32x4 r; r[0] = 1.f / (1.f + __expf(-v[0])); r[1] = 1.f / (1.f + __expf(-v[1])); r[2] = 1.f / (1.f + __expf(-v[2])); r[3] = 1.f / (1.f + __expf(-v[3])); return r; }
__device__ __forceinline__ void unpack8(const u32x4 w, f32x4& a, f32x4& b) {
    a[0] = __uint_as_float(w.x << 16); a[1] = __uint_as_float(w.x & 0xffff0000u); a[2] = __uint_as_float(w.y << 16); a[3] = __uint_as_float(w.y & 0xffff0000u);
    b[0] = __uint_as_float(w.z << 16); b[1] = __uint_as_float(w.z & 0xffff0000u); b[2] = __uint_as_float(w.w << 16); b[3] = __uint_as_float(w.w & 0xffff0000u);
}
#define EPI_ROWS(...) _Pragma("unroll") for (int ai = 0; ai < 2; ++ai) _Pragma("unroll") for (int m = 0; m < 4; ++m) { const size_t row = (size_t)(row0 + ai * 128 + m * 16); _Pragma("unroll") for (int bj = 0; bj < 2; ++bj) { __VA_ARGS__ } }
struct EpiSig {
    static constexpr bool PERM = true, AFTER_DRAIN = false; unsigned char* ws;
    __device__ __forceinline__ void operator()(const f32x4 (&acc)[2][2][4][2], const Unit& u, int wr, int wc, int fr, int fq) const {
        const int row0 = u.pm * 256 + wr * 64 + fr, col0 = u.pn * 256 + wc * 32 + 8 * fq; bf16_t* SG = (bf16_t*)(ws + WS_SG);
        EPI_ROWS( *(u32x4*)(SG + row * 2048 + col0 + bj * 128) = pack8(sig4(acc[ai][bj][m][0]), sig4(acc[ai][bj][m][1])); )
    }
};
template <int PASS> struct EpiMrg {
    static constexpr bool PERM = true, AFTER_DRAIN = false; unsigned char* ws;
    __device__ __forceinline__ void operator()(const f32x4 (&acc)[2][2][4][2], const Unit& u, int wr, int wc, int fr, int fq) const {
        const int row0 = u.pm * 256 + wr * 64 + fr, col0 = u.pn * 256 + wc * 32 + 8 * fq; const bf16_t* SG = (const bf16_t*)(ws + WS_SG) + PASS * 1024; bf16_t* MR = (bf16_t*)(ws + WS_MRG);
        EPI_ROWS( f32x4 g0, g1; unpack8(*(const u32x4*)(SG + row * 2048 + col0 + bj * 128), g0, g1); f32x4 r0 = g0 * acc[ai][bj][m][0], r1 = g1 * acc[ai][bj][m][1];
                  if (PASS == 1) { f32x4 p0, p1; unpack8(*(const u32x4*)(MR + row * 1024 + col0 + bj * 128), p0, p1); r0 += p0; r1 += p1; }
                  *(u32x4*)(MR + row * 1024 + col0 + bj * 128) = pack8(r0, r1); )
    }
};
struct EpiV {
    static constexpr bool PERM = false, AFTER_DRAIN = false; const float* x; const float* ada; float* out;
    __device__ __forceinline__ void operator()(const f32x4 (&acc)[2][2][4][2], const Unit& u, int wr, int wc, int fr, int fq) const {
        const int row0 = u.pm * 256 + wr * 64 + fr, col0 = u.pn * 256 + wc * 32 + 4 * fq; const float* gt1 = ada + (size_t)(u.pm >> 4) * 6 * D_MODEL + 2 * D_MODEL;
        EPI_ROWS( _Pragma("unroll") for (int n = 0; n < 2; ++n) { const int c = col0 + bj * 128 + n * 16; const f32x4 xv = *(const f32x4*)(x + row * D_MODEL + c), gv = *(const f32x4*)(gt1 + c);
                  *(f32x4*)(out + row * D_MODEL + c) = xv * DN_ALPHA + gv * acc[ai][bj][m][n]; } )
    }
};
struct EpiHid {
    static constexpr bool PERM = true, AFTER_DRAIN = false; unsigned char* ws;
    __device__ __forceinline__ void operator()(const f32x4 (&acc)[2][2][4][2], const Unit& u, int wr, int wc, int fr, int fq) const {
        const int row0 = u.pm * 256 + wr * 64 + fr, col0 = u.pn * 128 + wc * 32 + 8 * fq; bf16_t* H = (bf16_t*)(ws + WS_HID);
#pragma unroll
        for (int ai = 0; ai < 2; ++ai)
#pragma unroll
            for (int m = 0; m < 4; ++m) { const size_t row = (size_t)(row0 + ai * 128 + m * 16); f32x4 h0, h1;
#pragma unroll
                for (int e = 0; e < 4; ++e) { const float g0 = acc[ai][0][m][0][e], g1 = acc[ai][0][m][1][e]; h0[e] = g0 / (1.f + __expf(-g0)) * acc[ai][1][m][0][e]; h1[e] = g1 / (1.f + __expf(-g1)) * acc[ai][1][m][1][e]; }
                *(u32x4*)(H + row * 256 + col0) = pack8(h0, h1); }
    }
};
struct EpiY {
    static constexpr bool PERM = true, AFTER_DRAIN = false; unsigned char* ws;
    __device__ __forceinline__ void operator()(const f32x4 (&acc)[2][2][4][2], const Unit& u, int wr, int wc, int fr, int fq) const {
        const int row0 = u.pm * 256 + wr * 64 + fr, col0 = u.pn * 256 + wc * 32 + 8 * fq; bf16_t* Y = (bf16_t*)(ws + WS_YG);
        EPI_ROWS( *(u32x4*)(Y + row * 1024 + col0 + bj * 128) = pack8(acc[ai][bj][m][0], acc[ai][bj][m][1]); )
    }
};
__device__ __forceinline__ void build_tables(unsigned char* ws, LAS unsigned char* lds) {
    LAS int* toff = (LAS int*)(lds + LDS_TAB); LAS int* texp = toff + 64; const unsigned* gcnt = (const unsigned*)(ws + WS_CNT);
    __syncthreads();
    if (threadIdx.x == 0) { int o = 0; for (int e = 0; e < N_EXP; ++e) { toff[e] = o; o += ((int)gcnt[e * 32] + 255) >> 8; } toff[32] = o; }
    __syncthreads();
    for (int tl = threadIdx.x; tl < toff[32]; tl += NTHREADS) { int e = 0; while (toff[e + 1] <= tl) ++e; texp[tl] = e; }
    __syncthreads();
}
template <int NPN> struct GroupOrder {
    const LAS int* toff; const LAS int* texp; int G, c;
    __device__ __forceinline__ bool next(int i, Unit& u) const { const int L = i * G + c; if (L >= toff[32] * NPN) return false; const int tl = L / NPN, pn = L % NPN; u.pm = tl; u.pa = tl; u.pn = pn; u.pb = texp[tl] * NPN + pn; return true; }
    __device__ __forceinline__ void a_ready(const Unit&) const {}
    __device__ __forceinline__ void done(const Unit&) const {}
};
__device__ __forceinline__ float dpp_row_sum_f(float v) {
    v += __int_as_float(__builtin_amdgcn_update_dpp(0, __float_as_int(v), 0xB1, 0xF, 0xF, true));
    v += __int_as_float(__builtin_amdgcn_update_dpp(0, __float_as_int(v), 0x4E, 0xF, 0xF, true));
    v += __int_as_float(__builtin_amdgcn_update_dpp(0, __float_as_int(v), 0x141, 0xF, 0xF, true));
    v += __int_as_float(__builtin_amdgcn_update_dpp(0, __float_as_int(v), 0x140, 0xF, 0xF, true));
    return v;
}
__device__ __forceinline__ float wave_sum_u(float v) {
    v = dpp_row_sum_f(v);
    return (__int_as_float(__builtin_amdgcn_readlane(__float_as_int(v), 0)) + __int_as_float(__builtin_amdgcn_readlane(__float_as_int(v), 16)))
         + (__int_as_float(__builtin_amdgcn_readlane(__float_as_int(v), 32)) + __int_as_float(__builtin_amdgcn_readlane(__float_as_int(v), 48)));
}
__device__ __forceinline__ void p8_phase(const float* const* in, float* out, unsigned char* ws, LAS unsigned char* lds, int G) {
    const int tid = threadIdx.x, lane = tid & 63, wave = tid >> 6;
    LAS float* WT = (LAS float*)lds;
    LAS int* lcnt = (LAS int*)(lds + 147456); LAS int* lbase = lcnt + 32; LAS int* ent = lcnt + 64;
    const float* wrg = in[14]; const float* wre = in[16];
    __syncthreads();
    for (int i = tid; i < 36 * 1024; i += NTHREADS) { const int col = i >> 10, k = i & 1023; WT[i] = (col < 4) ? wrg[k * 4 + col] : wre[k * 32 + (col - 4)]; }
    const float* g1 = in[12]; const float* b1 = in[13]; const float* brg = in[15]; const float* bre = in[17];
    for (int blk = blockIdx.x; blk < NT / 128; blk += G) {
        const int b = blk / 32; const float* ada = (const float*)(ws + WS_ADA) + (size_t)b * 6 * D_MODEL; const float* sh2 = ada + 3 * D_MODEL; const float* sc2 = ada + 4 * D_MODEL;
        if (tid < 32) lcnt[tid] = 0;
        __syncthreads();
        for (int r = 0; r < 16; ++r) {
            const int rl = wave * 16 + r; const size_t row = (size_t)blk * 128 + rl;
            f32x4* xr = (f32x4*)(out + row * D_MODEL) + lane;
            f32x4 v[4]; float s = 0.f;
#pragma unroll
            for (int j = 0; j < 4; ++j) { v[j] = xr[64 * j]; s += (v[j].x + v[j].y) + (v[j].z + v[j].w); }
            float mean = wave_sum_u(s) * (1.f / D_MODEL); float s2 = 0.f;
#pragma unroll
            for (int j = 0; j < 4; ++j) { v[j] = v[j] - mean; s2 += (v[j].x * v[j].x + v[j].y * v[j].y) + (v[j].z * v[j].z + v[j].w * v[j].w); }
            float rstd = 1.f / sqrtf(wave_sum_u(s2) * (1.f / D_MODEL) + LN_EPS);
            s = 0.f;
#pragma unroll
            for (int j = 0; j < 4; ++j) { const f32x4 gg = *(const f32x4*)(g1 + 256 * j + 4 * lane), bb = *(const f32x4*)(b1 + 256 * j + 4 * lane); v[j] = v[j] * rstd * gg + bb; xr[64 * j] = v[j]; s += (v[j].x + v[j].y) + (v[j].z + v[j].w); }
            mean = wave_sum_u(s) * (1.f / D_MODEL); s2 = 0.f;
#pragma unroll
            for (int j = 0; j < 4; ++j) { v[j] = v[j] - mean; s2 += (v[j].x * v[j].x + v[j].y * v[j].y) + (v[j].z * v[j].z + v[j].w * v[j].w); }
            rstd = 1.f / sqrtf(wave_sum_u(s2) * (1.f / D_MODEL) + LN_EPS);
            u32x2* o8 = (u32x2*)((bf16_t*)(ws + WS_H2) + row * D_MODEL) + lane;
#pragma unroll
            for (int j = 0; j < 4; ++j) { const f32x4 a4 = *(const f32x4*)(sc2 + 256 * j + 4 * lane), c4 = *(const f32x4*)(sh2 + 256 * j + 4 * lane); v[j] = v[j] * rstd * (a4 + 1.f) + c4;
                u32x2 w; w.x = cvtpk_s(v[j].x, v[j].y); w.y = cvtpk_s(v[j].z, v[j].w); o8[64 * j] = w; }
            float gl[N_GROUPS];
#pragma unroll
            for (int g = 0; g < N_GROUPS; ++g) { float p = 0.f;
#pragma unroll
                for (int j = 0; j < 4; ++j) { const f32x4 w4 = *(const LAS f32x4*)(WT + g * 1024 + 256 * j + 4 * lane); p += (v[j].x * w4.x + v[j].y * w4.y) + (v[j].z * w4.z + v[j].w * w4.w); }
                gl[g] = wave_sum_u(p) + brg[g]; }
            int gi = 0; float gm = gl[0];
#pragma unroll
            for (int g = 1; g < N_GROUPS; ++g) if (gl[g] > gm) { gm = gl[g]; gi = g; }
            float gs = 0.f;
#pragma unroll
            for (int g = 0; g < N_GROUPS; ++g) gs += __expf(gl[g] - gm);
            const float gw = 1.f / gs;
            float v0 = -INFINITY, v1 = -INFINITY; int i0 = 0, i1 = 0;
            for (int e = 0; e < EPG; ++e) { float p = 0.f; const LAS float* wp = WT + (4 + gi * EPG + e) * 1024;
#pragma unroll
                for (int j = 0; j < 4; ++j) { const f32x4 w4 = *(const LAS f32x4*)(wp + 256 * j + 4 * lane); p += (v[j].x * w4.x + v[j].y * w4.y) + (v[j].z * w4.z + v[j].w * w4.w); }
                const float ev = wave_sum_u(p) + bre[gi * EPG + e];
                if (ev > v0) { v1 = v0; i1 = i0; v0 = ev; i0 = e; } else if (ev > v1) { v1 = ev; i1 = e; } }
            const float e1 = __expf(v1 - v0); const float w0 = gw / (1.f + e1), w1 = gw * e1 / (1.f + e1);
            if (lane == 0) { const int ea = gi * EPG + i0, eb = gi * EPG + i1;
                const int pa = atomicAdd((int*)&lcnt[ea], 1), pb = atomicAdd((int*)&lcnt[eb], 1);
                ent[rl * 2] = (ea << 16) | pa; ent[rl * 2 + 1] = (eb << 16) | pb;
                ((int*)(ws + WS_EID))[row * 2] = ea; ((int*)(ws + WS_EID))[row * 2 + 1] = eb; ((float*)(ws + WS_EW))[row * 2] = w0; ((float*)(ws + WS_EW))[row * 2 + 1] = w1; }
        }
        __syncthreads();
        if (tid < 32) lbase[tid] = (int)atomicAdd((unsigned*)(ws + WS_CNT) + tid * 32, (unsigned)lcnt[tid]);
        __syncthreads();
        if (tid < 256) { const int en = ent[tid]; ((int*)(ws + WS_POS))[(size_t)blk * 256 + tid] = lbase[en >> 16] + (en & 0xffff); }
        __syncthreads();
    }
}
__device__ __forceinline__ void p9_phase(unsigned char* ws, LAS unsigned char* lds, int G) {
    build_tables(ws, lds); const LAS int* toff = (const LAS int*)(lds + LDS_TAB);
    const int lane = threadIdx.x & 63, wave = threadIdx.x >> 6;
    for (int ts = blockIdx.x * NWAVES + wave; ts < NT * 2; ts += G * NWAVES) {
        const int e = ((const int*)(ws + WS_EID))[ts], pos = ((const int*)(ws + WS_POS))[ts]; const size_t dst = (size_t)toff[e] * 256 + pos;
        const u32x4* sp = (const u32x4*)((const bf16_t*)(ws + WS_H2) + (size_t)(ts >> 1) * D_MODEL); u32x4* dp = (u32x4*)((bf16_t*)(ws + WS_XG) + dst * D_MODEL);
        dp[lane] = sp[lane]; dp[lane + 64] = sp[lane + 64];
    }
}
__device__ __forceinline__ void p12_phase(const float* const* in, float* out, unsigned char* ws, LAS unsigned char* lds, int G) {
    build_tables(ws, lds); const LAS int* toff = (const LAS int*)(lds + LDS_TAB);
    const int lane = threadIdx.x & 63, wave = threadIdx.x >> 6; const float* g2 = in[21]; const float* b2 = in[22];
    for (int row = blockIdx.x * NWAVES + wave; row < NT; row += G * NWAVES) {
        const int b = row / NS; const float* gt2 = (const float*)(ws + WS_ADA) + (size_t)b * 6 * D_MODEL + 5 * D_MODEL;
        const int e0 = ((const int*)(ws + WS_EID))[row * 2], e1 = ((const int*)(ws + WS_EID))[row * 2 + 1]; const float w0 = ((const float*)(ws + WS_EW))[row * 2], w1 = ((const float*)(ws + WS_EW))[row * 2 + 1];
        const size_t r0 = (size_t)toff[e0] * 256 + ((const int*)(ws + WS_POS))[row * 2], r1 = (size_t)toff[e1] * 256 + ((const int*)(ws + WS_POS))[row * 2 + 1];
        const u32x2* y0 = (const u32x2*)((const bf16_t*)(ws + WS_YG) + r0 * D_MODEL) + lane; const u32x2* y1 = (const u32x2*)((const bf16_t*)(ws + WS_YG) + r1 * D_MODEL) + lane;
        f32x4* xr = (f32x4*)(out + (size_t)row * D_MODEL) + lane;
        f32x4 v[4]; float s = 0.f;
#pragma unroll
        for (int j = 0; j < 4; ++j) { const u32x2 a = y0[64 * j], c = y1[64 * j]; const f32x4 gv = *(const f32x4*)(gt2 + 256 * j + 4 * lane);
            f32x4 f; f.x = w0 * __uint_as_float(a.x << 16) + w1 * __uint_as_float(c.x << 16); f.y = w0 * __uint_as_float(a.x & 0xffff0000u) + w1 * __uint_as_float(c.x & 0xffff0000u);
            f.z = w0 * __uint_as_float(a.y << 16) + w1 * __uint_as_float(c.y << 16); f.w = w0 * __uint_as_float(a.y & 0xffff0000u) + w1 * __uint_as_float(c.y & 0xffff0000u);
            v[j] = xr[64 * j] * DN_ALPHA + gv * f; s += (v[j].x + v[j].y) + (v[j].z + v[j].w); }
        const float mean = wave_sum_u(s) * (1.f / D_MODEL); float s2 = 0.f;
#pragma unroll
        for (int j = 0; j < 4; ++j) { v[j] = v[j] - mean; s2 += (v[j].x * v[j].x + v[j].y * v[j].y) + (v[j].z * v[j].z + v[j].w * v[j].w); }
        const float rstd = 1.f / sqrtf(wave_sum_u(s2) * (1.f / D_MODEL) + LN_EPS);
#pragma unroll
        for (int j = 0; j < 4; ++j) { const f32x4 gg = *(const f32x4*)(g2 + 256 * j + 4 * lane), bb = *(const f32x4*)(b2 + 256 * j + 4 * lane); xr[64 * j] = v[j] * rstd * gg + bb; }
    }
}

constexpr size_t WS_BAR = 320 * 1024;
#define RLX_AGENT __ATOMIC_RELAXED, __HIP_MEMORY_SCOPE_AGENT
#define XB_TMO      128
#define XB_XCNT(j)  (256  + 64 * (j))
#define XB_XSUB(j)  (1280 + 64 * (j))
#define XB_XGEN(j)  (2304 + 64 * (j))
#define XB_TOP      3328
#define XB_TOPGEN   3392
#define XCD_BAR_WORDS 3456
#define XB_SPIN_CAP (1u << 18)

__device__ __forceinline__ unsigned xb_ld(unsigned* p)              { return __hip_atomic_load(p, __ATOMIC_RELAXED, __HIP_MEMORY_SCOPE_AGENT); }
__device__ __forceinline__ unsigned xb_add(unsigned* p, unsigned v) { return __hip_atomic_fetch_add(p, v, __ATOMIC_RELAXED, __HIP_MEMORY_SCOPE_AGENT); }
__device__ __forceinline__ unsigned xb_xcc_id() { return (unsigned)__builtin_amdgcn_s_getreg((3 << 11) | 20) & 0xFu; }
#define XB_SPIN(cond, bar) do { unsigned _sp = 0; while (cond) { __builtin_amdgcn_s_sleep(1); \
    if ((++_sp & 255u) == 0u) { if (xb_ld(&(bar)[XB_TMO])) break; if (_sp > XB_SPIN_CAP) { atomicAdd(&(bar)[XB_TMO], 1u); break; } } } } while (0)

struct XcdBarrier {
    unsigned* bar; unsigned x;
    volatile LAS unsigned* st;
};

__device__ __forceinline__ XcdBarrier xcd_barrier_post(unsigned* bar, volatile LAS unsigned* st) {
    XcdBarrier b; b.bar = bar; b.x = xb_xcc_id(); b.st = st;
    if (threadIdx.x == 0) (void)xb_add(&bar[XB_XCNT(b.x)], 1u);
    return b;
}
__device__ __forceinline__ void xcd_barrier_complete(unsigned* bar, unsigned x, unsigned& nloc, unsigned& nx) {
    const unsigned G = gridDim.x * gridDim.y * gridDim.z;
    unsigned sum, cnt, mine, sp = 0u;
    for (;;) {
        sum = 0u; cnt = 0u; mine = 0u;
#pragma unroll
        for (unsigned j = 0; j < 16; ++j) { const unsigned c = xb_ld(&bar[XB_XCNT(j)]); sum += c; cnt += (c > 0u) ? 1u : 0u; mine = (j == x) ? c : mine; }
        if (sum == G) break;
        __builtin_amdgcn_s_sleep(1);
        if ((++sp & 255u) == 0u) { if (xb_ld(&bar[XB_TMO])) break; if (sp > XB_SPIN_CAP) { atomicAdd(&bar[XB_TMO], 1u); break; } }
    }
    nloc = mine > 0u ? mine : 1u; nx = cnt > 0u ? cnt : 1u;
}

__device__ __forceinline__ void xcd_barrier(const XcdBarrier& b) {
    asm volatile("s_waitcnt vmcnt(0)" ::: "memory");
    __syncthreads();
    if (threadIdx.x == 0) {
        unsigned* bar = b.bar;
        __builtin_amdgcn_s_waitcnt(0);
        unsigned nloc = b.st[0], nx = b.st[1];
        if (nloc == 0u) { xcd_barrier_complete(bar, b.x, nloc, nx); b.st[0] = nloc; b.st[1] = nx; }
        const unsigned old = xb_add(&bar[XB_XSUB(b.x)], 1u);
        const unsigned gen = old / nloc;
        if (old + 1u == (gen + 1u) * nloc) {
            __builtin_amdgcn_fence(__ATOMIC_RELEASE, "agent");
            asm volatile("s_waitcnt vmcnt(0)" ::: "memory");
            const unsigned og = xb_add(&bar[XB_TOP], 1u);
            const unsigned tg = og / nx;
            if (og + 1u == (tg + 1u) * nx) xb_add(&bar[XB_TOPGEN], 1u);
            else XB_SPIN(xb_ld(&bar[XB_TOPGEN]) == tg, bar);
            __builtin_amdgcn_fence(__ATOMIC_ACQUIRE, "agent");
            xb_add(&bar[XB_XGEN(b.x)], 1u);
            asm volatile("s_waitcnt vmcnt(0)" ::: "memory");
        } else {
            XB_SPIN(xb_ld(&bar[XB_XGEN(b.x)]) == gen, bar);
            __builtin_amdgcn_fence(__ATOMIC_ACQUIRE, "agent");
            asm volatile("s_waitcnt vmcnt(0)" ::: "memory");
        }
    }
    __syncthreads();
}

__device__ __forceinline__ int opaque_i(int v) {
#if DUPMASK_ON
    asm volatile("" : "+v"(v)); v = __builtin_amdgcn_readfirstlane(v);
#endif
    return v; }
constexpr int NPH = 14;
struct Args { const float* in[23]; float* out; unsigned char* ws; int ph_lo, ph_hi; };
__global__ void __launch_bounds__(NTHREADS, 2) mk_fwd(Args a) {
    extern __shared__ __attribute__((aligned(16))) unsigned char lds_raw[];
    LAS unsigned char* lds = (LAS unsigned char*)lds_raw;
    cg::grid_group grid = cg::this_grid();
    const int G = gridDim.x, tid = threadIdx.x, lane = tid & 63, wave = __builtin_amdgcn_readfirstlane(tid >> 6);
    const int lo = a.ph_lo, hi = a.ph_hi;
    unsigned char* ws = a.ws;
    volatile LAS unsigned* bst = (volatile LAS unsigned*)(lds + LDS_BYTES - 16);
    if (tid < 4) bst[tid] = 0u;
    __syncthreads();
    XcdBarrier bar = xcd_barrier_post((unsigned*)(ws + WS_BAR), bst);
    if (a.ph_hi > NPH) grid.sync();
#ifndef PHMASK
#define PHMASK 0xFFFF
#endif
#define IN(k) (((PHMASK >> (k)) & 1) && lo <= (k) && (k) < hi)
#define GRIDBAR() do { if (USE_CG_SYNC) grid.sync(); else xcd_barrier(bar); } while (0)
#define SEAM(k) do { if (IN(k) && IN((k) + 1)) GRIDBAR(); } while (0)
#define PH(k) for (int rep_ = 0; rep_ < (IN(k) ? 1 + ((DUPMASK >> (k)) & 1) : 0); ++rep_) if (rep_ > 0 && (xcd_barrier(bar), false)) {} else
    PH(0) {
        if (blockIdx.x == 0 && tid < 32) ((unsigned*)(ws + WS_CNT))[tid * 32] = 0u;
        LAS float* scr = (LAS float*)(lds + wave * 16384);
        for (int it = blockIdx.x * NWAVES + wave; it < P0_ITEMS; it += G * NWAVES) p0_item(it, a.in, ws, scr, lane);
    }
    SEAM(0);
    PH(1) p1_phase(a.in, ws, lds, G);
    SEAM(1);
    PH(2) {
        pg8::Gemm g{(const bf16_t*)(ws + WS_XN), (const bf16_t*)(ws + WS_WIN), NT, NPROJ, D_MODEL}; pg8::StaticOrder S; S.init(NT, NPROJ, G, (int)blockIdx.x);
        EpiProj E{ws};
        pg8::gemm_phase<EpiProj, pg8::StaticOrder, PG8_ALIGN, PG8_SP2>(lds, g, S, E);
    }
    SEAM(2);
    PH(3) {
        for (int sg = blockIdx.x; sg < SC_SEGS; sg += G) { p3a_segment(sg, ws, lds + wave * 17408, wave, lane); if (DUPSUB & 1) p3a_segment(sg, ws, lds + wave * 17408, wave, lane); }
        for (int it = blockIdx.x; it < GLA_ITEMS; it += G) { p3b_item(it, a.in[6], a.in[7], a.out, ws, lds); if (DUPSUB & 2) p3b_item(it, a.in[6], a.in[7], a.out, ws, lds); }
    }
    SEAM(3);
    PH(4) {
        for (int j = blockIdx.x; j < 128; j += G) { p4b_item(j, a.out, (bf16_t*)(a.out + 16 * MiB), ws); if (DUPSUB & 8) p4b_item(j, a.out, (bf16_t*)(a.out + 16 * MiB), ws); }
        for (int row = blockIdx.x * NWAVES + wave; row < NT; row += G * NWAVES) { p4a_row(row, ws, lane); if (DUPSUB & 4) p4a_row(row, ws, lane); }
    }
    SEAM(4);
    PH(5) {
        const int c = blockIdx.x; const int bh = c >> 2, sx = c & 3;
        for (int it = blockIdx.x; it < GLA_ITEMS; it += G) { p5b_item(it, a.in[6], a.in[7], a.in[8], (const bf16_t*)(a.out + 16 * MiB), ws, lds); if (DUPSUB & 32) p5b_item(it, a.in[6], a.in[7], a.in[8], (const bf16_t*)(a.out + 16 * MiB), ws, lds); }
        if (c < 256) for (int i = 0; i < 4; ++i) { const int Q = (i == 0) ? sx : (i == 1) ? 7 - sx : (i == 2) ? 8 + sx : 15 - sx; attn_unit(bh >> 3, bh & 7, Q, a.in[2], ws, lds); if (DUPSUB & 16) attn_unit(bh >> 3, bh & 7, Q, a.in[2], ws, lds); }
    }
    SEAM(5);
    PH(6) {
        pg8::Gemm g{(const bf16_t*)(ws + WS_XN), (const bf16_t*)(ws + WS_WGAB), NT, 2048, D_MODEL}; pg8::StaticOrder S; S.init(NT, 2048, G, (int)blockIdx.x);
        EpiSig E{ws}; pg8::gemm_phase<EpiSig, pg8::StaticOrder, PG8_ALIGN, PG8_SP2>(lds, g, S, E);
    }
    SEAM(6);
    PH(7) {
        pg8::StaticOrder S; S.init(NT, D_MODEL, G, (int)blockIdx.x);
        { pg8::Gemm g{(const bf16_t*)(ws + WS_OA), (const bf16_t*)(ws + WS_WBA), NT, D_MODEL, 512}; EpiMrg<0> E{ws}; pg8::gemm_phase<EpiMrg<0>, pg8::StaticOrder, PG8_ALIGN, PG8_SP2>(lds, g, S, E); }
        { pg8::Gemm g{(const bf16_t*)(ws + WS_OB), (const bf16_t*)(ws + WS_WBB), NT, D_MODEL, 512}; EpiMrg<1> E{ws}; pg8::gemm_phase<EpiMrg<1>, pg8::StaticOrder, PG8_ALIGN, PG8_SP2>(lds, g, S, E); }
    }
    SEAM(7);
    PH(8) {
        pg8::Gemm g{(const bf16_t*)(ws + WS_MRG), (const bf16_t*)(ws + WS_WOUT), NT, D_MODEL, D_MODEL}; pg8::StaticOrder S; S.init(NT, D_MODEL, G, (int)blockIdx.x);
        EpiV E{a.in[0], (const float*)(ws + WS_ADA), a.out}; pg8::gemm_phase<EpiV, pg8::StaticOrder, PG8_ALIGN, PG8_SP2>(lds, g, S, E);
    }
    SEAM(8);
    PH(9) p8_phase(a.in, a.out, ws, lds, G);
    SEAM(9);
    PH(10) p9_phase(ws, lds, G);
    SEAM(10);
    PH(11) {
        build_tables(ws, lds);
        pg8::Gemm g{(const bf16_t*)(ws + WS_XG), (const bf16_t*)(ws + WS_W13), 0, 0, D_MODEL}; GroupOrder<2> S{(const LAS int*)(lds + LDS_TAB), (const LAS int*)(lds + LDS_TAB) + 64, G, (int)blockIdx.x};
        EpiHid E{ws}; pg8::gemm_phase<EpiHid, GroupOrder<2>, PG8_ALIGN, PG8_SP2>(lds, g, S, E);
    }
    SEAM(11);
    PH(12) {
        build_tables(ws, lds);
        int kd = D_EXP; asm volatile("" : "+s"(kd));
        pg8::Gemm g{(const bf16_t*)(ws + WS_HID), (const bf16_t*)(ws + WS_W2), 0, 0, kd}; GroupOrder<4> S{(const LAS int*)(lds + LDS_TAB), (const LAS int*)(lds + LDS_TAB) + 64, G, (int)blockIdx.x};
        EpiY E{ws}; pg8::gemm_phase<EpiY, GroupOrder<4>, PG8_ALIGN, PG8_SP2>(lds, g, S, E);
    }
    SEAM(12);
    PH(13) p12_phase(a.in, a.out, ws, lds, G);
#ifdef EXTRA_SYNCS
    for (int i_ = 0; i_ < EXTRA_SYNCS; ++i_) GRIDBAR();
#endif
#undef IN
#undef SEAM
#undef PH
}
}
extern "C" void kernel_launch(void* const* d_in, const int* in_sizes, int n_in, void* d_out, int out_size,
                              void* d_ws, size_t ws_size, hipStream_t stream) {
    using namespace fk;
    static int grid = 0;
    if (grid == 0) {
        int dev = 0, cus = 0, per_cu = 0; (void)hipGetDevice(&dev); (void)hipDeviceGetAttribute(&cus, hipDeviceAttributeMultiprocessorCount, dev);
        (void)hipFuncSetAttribute((const void*)mk_fwd, hipFuncAttributeMaxDynamicSharedMemorySize, LDS_BYTES);
        (void)hipOccupancyMaxActiveBlocksPerMultiprocessor(&per_cu, (const void*)mk_fwd, NTHREADS, LDS_BYTES);
        (void)hipGetLastError();
        grid = cus * (per_cu >= 1 ? 1 : 1);
        if (ws_size < 512 * MiB) { fprintf(stderr, "kernel_launch: workspace too small\n"); grid = -1; }
    }
    if (grid < 0) return;
    (void)hipMemsetAsync((unsigned char*)d_ws + WS_BAR, 0, 16384, stream);
    Args a{}; for (int i = 0; i < 23; ++i) a.in[i] = (const float*)d_in[i]; a.out = (float*)d_out; a.ws = (unsigned char*)d_ws; a.ph_lo = 0; a.ph_hi = NPH;
    void* args[] = {&a};
    hipError_t e = hipLaunchCooperativeKernel((const void*)mk_fwd, dim3(grid), dim3(NTHREADS), args, LDS_BYTES, stream);
    if (e != hipSuccess) fprintf(stderr, "cooperative launch failed: %s\n", hipGetErrorString(e));
}
```

```cpp
#include <hip/hip_runtime.h>
#include <hip/hip_cooperative_groups.h>
#include <cstdio>
#include <cstdint>
#include <cstring>
#include <cmath>
#ifdef HOST_EMU
#include <cmath>
#include <cstdio>
#include <cstdlib>
#include <cstring>
#include <cstdint>
struct Dim3e { int x, y, z; };
static thread_local Dim3e threadIdx, blockIdx, blockDim, gridDim;
#define __global__
#define __device__
#define __host__
#define __forceinline__ inline
#define __launch_bounds__(...)
typedef void* hipStream_t;
template <class F, class... A> static void host_launch(F f, long nb, int nt, A... a) {
#pragma omp parallel for schedule(dynamic, 4)
    for (long b = 0; b < nb; ++b) {
        blockIdx = {(int)b, 0, 0}; blockDim = {nt, 1, 1}; gridDim = {(int)nb, 1, 1};
        for (int t = 0; t < nt; ++t) { threadIdx = {t, 0, 0}; f(a...); }
    }
}
#define LAUNCH(k, nb, nt, st, ...) host_launch(k, (long)(nb), (int)(nt), __VA_ARGS__)
#define UNROLL
#else
#define LAUNCH(k, nb, nt, st, ...) hipLaunchKernelGGL(k, dim3((unsigned)(nb)), dim3((unsigned)(nt)), 0, st, __VA_ARGS__)
#endif

constexpr int D_MODEL = 1024, A_HEADS = 8, A_HD = 64, A_W = 512, I_HEADS = 16, I_DIM = 32, TOPK_MAX = 256, REL_B = 32,
              G_HEADS = 4, G_DK = 64, G_DV = 128, G_KW = 256, G_VW = 512, G_RANK = 16, N_GROUPS = 4, EPG = 8, N_EXP = 32, D_EXP = 256;
constexpr int O_AQ = 0, O_AK = 512, O_AV = 1024, O_IQ = 1536, O_IK = 2048, O_IW = 2080, O_GQ = 2096, O_GK = 2352, O_GV = 2608, O_GR = 3120,
              O_GLR = 3632, O_GA = 3648, O_GB = 4672, D_IN = 5696;
constexpr float DN_ALPHA = 1.189207115002721f, LN_EPS = 1e-5f;
#define V0_GID long gid = (long)blockIdx.x * blockDim.x + threadIdx.x

__device__ __forceinline__ float v0_silu(float v) { return v / (1.f + expf(-v)); }
__device__ __forceinline__ float v0_sigmoid(float v) { return 1.f / (1.f + expf(-v)); }

__global__ void k0_ada(const float* c, const float* w_ada, const float* b_ada, float* ada, int B) {
    V0_GID; if (gid >= (long)B * 6 * D_MODEL) return;
    const int b = (int)(gid / (6 * D_MODEL)), j = (int)(gid % (6 * D_MODEL));
    float acc = 0.f;
    for (int i = 0; i < D_MODEL; ++i) acc += v0_silu(c[b * D_MODEL + i]) * w_ada[(size_t)i * 6 * D_MODEL + j];
    ada[gid] = acc + b_ada[j];
}
__global__ void k0_lnmod(const float* x, const float* sh, const float* sc, float* h, int nrows) {
    V0_GID; if (gid >= nrows) return;
    const float* xr = x + (size_t)gid * D_MODEL; float* hr = h + (size_t)gid * D_MODEL;
    float mu = 0.f; for (int k = 0; k < D_MODEL; ++k) mu += xr[k]; mu *= (1.f / D_MODEL);
    float var = 0.f; for (int k = 0; k < D_MODEL; ++k) { const float d = xr[k] - mu; var += d * d; } var *= (1.f / D_MODEL);
    const float rs = 1.f / sqrtf(var + LN_EPS);
    for (int k = 0; k < D_MODEL; ++k) hr[k] = (xr[k] - mu) * rs * (1.f + sc[k]) + sh[k];
}
__global__ void k0_gemm(const float* A, int lda, const float* W, int ldw, float* C, int ldc, int M, int N, int K) {
    V0_GID; if (gid >= (long)(M / 4) * N) return;
    const int n = (int)(gid % N); const int m0 = (int)(gid / N) * 4;
    float a0 = 0.f, a1 = 0.f, a2 = 0.f, a3 = 0.f;
    const float* A0 = A + (size_t)m0 * lda;
    for (int k = 0; k < K; ++k) { const float w = W[(size_t)k * ldw + n]; a0 += A0[k] * w; a1 += A0[lda + k] * w; a2 += A0[2 * lda + k] * w; a3 += A0[3 * lda + k] * w; }
    C[(size_t)m0 * ldc + n] = a0; C[(size_t)(m0 + 1) * ldc + n] = a1; C[(size_t)(m0 + 2) * ldc + n] = a2; C[(size_t)(m0 + 3) * ldc + n] = a3;
}
__global__ void k0_scores(const float* P, float* scT, int S) {
    V0_GID; if (gid >= (long)S * S) return;
    const int t = (int)(gid % S), s = (int)(gid / S);
    if (s > t) { scT[gid] = -INFINITY; return; }
    const float* iq = P + (size_t)t * D_IN + O_IQ; const float* ik = P + (size_t)s * D_IN + O_IK; const float* iw = P + (size_t)t * D_IN + O_IW;
    const float cst = 0.044194173824159216f;
    float sc = 0.f;
    for (int h = 0; h < I_HEADS; ++h) { float d = 0.f; for (int k = 0; k < I_DIM; ++k) d += iq[h * I_DIM + k] * ik[k]; sc += (iw[h] * cst) * fmaxf(d, 0.f); }
    scT[gid] = sc;
}
__device__ __forceinline__ unsigned v0_key(float f) { unsigned u; memcpy(&u, &f, 4); return (u & 0x80000000u) ? ~u : (u | 0x80000000u); }
__global__ void k0_topk(const float* scT, int* sel, int* cnt, int S, int topk) {
    V0_GID; if (gid >= S) return;
    const int t = (int)gid; const int n = t + 1; int* sl = sel + (size_t)t * TOPK_MAX;
    if (n <= topk) { for (int s = 0; s < n; ++s) sl[s] = s; cnt[t] = n; return; }
    unsigned T = 0u;
    for (int bit = 31; bit >= 0; --bit) { const unsigned cand = T | (1u << bit); int c = 0; for (int s = 0; s < n; ++s) c += (v0_key(scT[(size_t)s * S + t]) >= cand) ? 1 : 0; if (c >= topk) T = cand; }
    int cgt = 0; for (int s = 0; s < n; ++s) cgt += (v0_key(scT[(size_t)s * S + t]) > T) ? 1 : 0;
    int need = topk - cgt, j = 0;
    for (int s = 0; s < n; ++s) { const unsigned k = v0_key(scT[(size_t)s * S + t]); if (k > T) sl[j++] = s; else if (k == T && need > 0) { sl[j++] = s; --need; } }
    cnt[t] = j;
}
__device__ __forceinline__ int v0_bucket(int d) {
    if (d < 16) return d;
    const float df = (float)d; int large = 16 + (int)(logf(df / 16.f) / 2.0794415416798357f * 16.f);
    return large < 31 ? large : 31;
}
__global__ void __launch_bounds__(256) k0_attn(const float* P, const int* sel, const int* cnt, const float* rel_bias, float* oa, int S) {
    V0_GID; if (gid >= (long)S * A_HEADS) return;
    const int t = (int)(gid / A_HEADS), h = (int)(gid % A_HEADS); const int n = cnt[t]; const int* sl = sel + (size_t)t * TOPK_MAX;
    const float* q = P + (size_t)t * D_IN + O_AQ + h * A_HD;
    float m = -INFINITY;
    for (int j = 0; j < n; ++j) { const int s = sl[j]; const float* k = P + (size_t)s * D_IN + O_AK + h * A_HD; float d = 0.f; for (int e = 0; e < A_HD; ++e) d += q[e] * k[e];
        const float l = d * 0.125f + rel_bias[v0_bucket(t - s) * A_HEADS + h]; m = fmaxf(m, l); }
    float o[A_HD];
#pragma unroll
    for (int e = 0; e < A_HD; ++e) o[e] = 0.f;
    float sum = 0.f;
    for (int j = 0; j < n; ++j) { const int s = sl[j]; const float* k = P + (size_t)s * D_IN + O_AK + h * A_HD; const float* v = P + (size_t)s * D_IN + O_AV + h * A_HD; float d = 0.f;
        for (int e = 0; e < A_HD; ++e) d += q[e] * k[e];
        const float p = expf(d * 0.125f + rel_bias[v0_bucket(t - s) * A_HEADS + h] - m); sum += p;
#pragma unroll
        for (int e = 0; e < A_HD; ++e) o[e] += p * v[e]; }
    const float inv = 1.f / sum;
#pragma unroll
    for (int e = 0; e < A_HD; ++e) oa[(size_t)t * A_W + h * A_HD + e] = o[e] * inv;
}
__global__ void k0_gate(const float* P, const float* wg, const float* bg, float* lg, int S) {
    V0_GID; if (gid >= (long)S * G_KW) return;
    const int t = (int)(gid / G_KW), j = (int)(gid % G_KW);
    float z = bg[j]; for (int r = 0; r < G_RANK; ++r) z += P[(size_t)t * D_IN + O_GLR + r] * wg[r * G_KW + j];
    lg[gid] = (fminf(z, 0.f) - log1pf(expf(-fabsf(z)))) * (1.f / 16.f);
}
__global__ void __launch_bounds__(64) k0_gla(const float* P, const float* lg, float* oraw, int S) {
    V0_GID; if (gid >= G_HEADS * G_DV) return;
    const int h = (int)(gid / G_DV), dv = (int)(gid % G_DV);
    float st[G_DK];
#pragma unroll
    for (int d = 0; d < G_DK; ++d) st[d] = 0.f;
    for (int t = 0; t < S; ++t) {
        const float* row = P + (size_t)t * D_IN; const float vv = row[O_GV + h * G_DV + dv]; float o = 0.f;
#pragma unroll
        for (int d = 0; d < G_DK; ++d) { const float a = expf(lg[(size_t)t * G_KW + h * G_DK + d]); st[d] = a * st[d] + row[O_GK + h * G_DK + d] * vv; o += row[O_GQ + h * G_DK + d] * st[d]; }
        oraw[(size_t)t * G_VW + h * G_DV + dv] = o * 0.125f;
    }
}
__global__ void k0_gla_post(const float* P, const float* oraw, const float* ng, float* ob, int S) {
    V0_GID; if (gid >= (long)S * G_HEADS) return;
    const int t = (int)(gid / G_HEADS), h = (int)(gid % G_HEADS); const float* o = oraw + (size_t)t * G_VW + h * G_DV;
    float mu = 0.f; for (int e = 0; e < G_DV; ++e) mu += o[e]; mu *= (1.f / G_DV);
    float var = 0.f; for (int e = 0; e < G_DV; ++e) { const float d = o[e] - mu; var += d * d; } var *= (1.f / G_DV);
    const float rs = 1.f / sqrtf(var + LN_EPS);
    for (int e = 0; e < G_DV; ++e) ob[(size_t)t * G_VW + h * G_DV + e] = (o[e] - mu) * rs * ng[h * G_DV + e] * v0_silu(P[(size_t)t * D_IN + O_GR + h * G_DV + e]);
}
__global__ void k0_merge(const float* P, const float* ba, const float* bb, float* mg, int S) {
    V0_GID; if (gid >= (long)S * D_MODEL) return;
    const int t = (int)(gid / D_MODEL), n = (int)(gid % D_MODEL);
    mg[gid] = v0_sigmoid(P[(size_t)t * D_IN + O_GA + n]) * ba[gid] + v0_sigmoid(P[(size_t)t * D_IN + O_GB + n]) * bb[gid];
}
__global__ void k0_ln1(const float* x, const float* y, const float* gt1, const float* g1, const float* b1, const float* sh2, const float* sc2, float* x1, float* h2, int nrows) {
    V0_GID; if (gid >= nrows) return;
    const float* xr = x + (size_t)gid * D_MODEL; const float* yr = y + (size_t)gid * D_MODEL; float* x1r = x1 + (size_t)gid * D_MODEL; float* h2r = h2 + (size_t)gid * D_MODEL;
    float mu = 0.f; for (int k = 0; k < D_MODEL; ++k) mu += DN_ALPHA * xr[k] + gt1[k] * yr[k]; mu *= (1.f / D_MODEL);
    float var = 0.f; for (int k = 0; k < D_MODEL; ++k) { const float d = DN_ALPHA * xr[k] + gt1[k] * yr[k] - mu; var += d * d; } var *= (1.f / D_MODEL);
    float rs = 1.f / sqrtf(var + LN_EPS);
    for (int k = 0; k < D_MODEL; ++k) x1r[k] = (DN_ALPHA * xr[k] + gt1[k] * yr[k] - mu) * rs * g1[k] + b1[k];
    mu = 0.f; for (int k = 0; k < D_MODEL; ++k) mu += x1r[k]; mu *= (1.f / D_MODEL);
    var = 0.f; for (int k = 0; k < D_MODEL; ++k) { const float d = x1r[k] - mu; var += d * d; } var *= (1.f / D_MODEL);
    rs = 1.f / sqrtf(var + LN_EPS);
    for (int k = 0; k < D_MODEL; ++k) h2r[k] = (x1r[k] - mu) * rs * (1.f + sc2[k]) + sh2[k];
}
__global__ void k0_route(const float* rl, const float* brg, const float* bre, int* eid, float* ew, int nrows) {
    V0_GID; if (gid >= nrows) return;
    const float* r = rl + (size_t)gid * 36;
    float gl[N_GROUPS]; float gm = -INFINITY; int gi = 0;
#pragma unroll
    for (int g = 0; g < N_GROUPS; ++g) { gl[g] = r[g] + brg[g]; if (gl[g] > gm) { gm = gl[g]; gi = g; } }
    float gs = 0.f;
#pragma unroll
    for (int g = 0; g < N_GROUPS; ++g) gs += expf(gl[g] - gm);
    const float gw = 1.f / gs;
    float v0 = -INFINITY, v1 = -INFINITY; int i0 = 0, i1 = 0;
    for (int e = 0; e < EPG; ++e) { const float v = r[4 + gi * EPG + e] + bre[gi * EPG + e];
        if (v > v0) { v1 = v0; i1 = i0; v0 = v; i0 = e; } else if (v > v1) { v1 = v; i1 = e; } }
    const float e1 = expf(v1 - v0); const float w0 = 1.f / (1.f + e1), w1 = e1 / (1.f + e1);
    eid[gid * 2] = gi * EPG + i0; eid[gid * 2 + 1] = gi * EPG + i1; ew[gid * 2] = w0 * gw; ew[gid * 2 + 1] = w1 * gw;
}
__global__ void k0_moe_hid(const float* h2, const int* eid, const float* w1, const float* w3, float* hid, int nrows) {
    V0_GID; if (gid >= (long)nrows * 2 * D_EXP) return;
    const int j = (int)(gid % D_EXP); const long ts = gid / D_EXP; const int t = (int)(ts / 2); const int e = eid[ts];
    const float* hr = h2 + (size_t)t * D_MODEL; const float* a = w1 + (size_t)e * D_MODEL * D_EXP + j; const float* b = w3 + (size_t)e * D_MODEL * D_EXP + j;
    float g = 0.f, u = 0.f; for (int k = 0; k < D_MODEL; ++k) { g += hr[k] * a[(size_t)k * D_EXP]; u += hr[k] * b[(size_t)k * D_EXP]; }
    hid[gid] = v0_silu(g) * u;
}
__global__ void k0_moe_out(const float* hid, const int* eid, const float* ew, const float* w2, float* f, int nrows) {
    V0_GID; if (gid >= (long)nrows * D_MODEL) return;
    const int n = (int)(gid % D_MODEL); const int t = (int)(gid / D_MODEL); float acc = 0.f;
    for (int sl = 0; sl < 2; ++sl) { const int e = eid[t * 2 + sl]; const float* hr = hid + ((size_t)t * 2 + sl) * D_EXP; const float* w = w2 + (size_t)e * D_EXP * D_MODEL + n; float a = 0.f;
        for (int j = 0; j < D_EXP; ++j) a += hr[j] * w[(size_t)j * D_MODEL]; acc += ew[t * 2 + sl] * a; }
    f[gid] = acc;
}
__global__ void k0_final(const float* x1, const float* f, const float* gt2, const float* g2, const float* b2, float* out, int nrows) {
    V0_GID; if (gid >= nrows) return;
    const float* xr = x1 + (size_t)gid * D_MODEL; const float* fr = f + (size_t)gid * D_MODEL; float* o = out + (size_t)gid * D_MODEL;
    float mu = 0.f; for (int k = 0; k < D_MODEL; ++k) mu += DN_ALPHA * xr[k] + gt2[k] * fr[k]; mu *= (1.f / D_MODEL);
    float var = 0.f; for (int k = 0; k < D_MODEL; ++k) { const float d = DN_ALPHA * xr[k] + gt2[k] * fr[k] - mu; var += d * d; } var *= (1.f / D_MODEL);
    const float rs = 1.f / sqrtf(var + LN_EPS);
    for (int k = 0; k < D_MODEL; ++k) o[k] = (DN_ALPHA * xr[k] + gt2[k] * fr[k] - mu) * rs * g2[k] + b2[k];
}

struct V0Buf { float *ada, *h, *P, *scT, *oa, *lg, *oraw, *ob, *ba, *bb, *mg, *y, *x1, *h2, *rl, *ew, *hid, *f; int *sel, *cnt, *eid; size_t bytes; };
static V0Buf v0_carve(void* base, int B, int S) {
    V0Buf b; char* p = (char*)base; auto take = [&](size_t n) { char* r = p; p += (n + 255) & ~(size_t)255; return r; };
    b.ada = (float*)take((size_t)B * 6 * D_MODEL * 4);
    b.P = (float*)take((size_t)S * D_IN * 4);
    b.h = (float*)take((size_t)S * D_MODEL * 4);
    b.scT = (float*)take((size_t)S * S * 4);
    b.sel = (int*)take((size_t)S * TOPK_MAX * 4); b.cnt = (int*)take((size_t)S * 4);
    b.oa = (float*)take((size_t)S * A_W * 4); b.lg = (float*)take((size_t)S * G_KW * 4); b.oraw = (float*)take((size_t)S * G_VW * 4); b.ob = (float*)take((size_t)S * G_VW * 4);
    b.ba = (float*)take((size_t)S * D_MODEL * 4); b.bb = (float*)take((size_t)S * D_MODEL * 4); b.y = (float*)take((size_t)S * D_MODEL * 4);
    b.x1 = (float*)take((size_t)S * D_MODEL * 4); b.h2 = (float*)take((size_t)S * D_MODEL * 4); b.f = (float*)take((size_t)S * D_MODEL * 4);
    b.mg = b.h;
    b.rl = (float*)take((size_t)S * 36 * 4); b.eid = (int*)take((size_t)S * 2 * 4); b.ew = (float*)take((size_t)S * 2 * 4); b.hid = (float*)take((size_t)S * 2 * D_EXP * 4);
    b.bytes = (size_t)(p - (char*)base); return b;
}
static void v0_forward(void* const* d_in, float* out, void* scratch, int B, int S, hipStream_t st, int only_batch = -1, int last_batch = -1) {
    const float *x = (const float*)d_in[0], *c = (const float*)d_in[1], *rel_bias = (const float*)d_in[2], *w_ada = (const float*)d_in[3], *b_ada = (const float*)d_in[4], *w_in = (const float*)d_in[5],
                *wg = (const float*)d_in[6], *bg = (const float*)d_in[7], *ng = (const float*)d_in[8], *wba = (const float*)d_in[9], *wbb = (const float*)d_in[10], *wout = (const float*)d_in[11],
                *g1 = (const float*)d_in[12], *b1 = (const float*)d_in[13], *wrg = (const float*)d_in[14], *brg = (const float*)d_in[15], *wre = (const float*)d_in[16], *bre = (const float*)d_in[17],
                *w1 = (const float*)d_in[18], *w3 = (const float*)d_in[19], *w2 = (const float*)d_in[20], *g2 = (const float*)d_in[21], *b2 = (const float*)d_in[22];
    V0Buf u = v0_carve(scratch, B, S);
    const int TB = 256; auto nb = [&](long n) { return (n + TB - 1) / TB; };
    const int topk = (TOPK_MAX < S / 4) ? TOPK_MAX : S / 4;
    LAUNCH(k0_ada, nb((long)B * 6 * D_MODEL), TB, st, c, w_ada, b_ada, u.ada, B);
    for (int bi = 0; bi < B; ++bi) {
        int b = bi; if (last_batch >= 0) b = (bi == B - 1) ? last_batch : (bi < last_batch ? bi : bi + 1);
        if (only_batch >= 0 && b != only_batch) continue;
        const float* xb = x + (size_t)b * S * D_MODEL; const float* ad = u.ada + (size_t)b * 6 * D_MODEL;
        const float *sh1 = ad, *sc1 = ad + D_MODEL, *gt1 = ad + 2 * D_MODEL, *sh2 = ad + 3 * D_MODEL, *sc2 = ad + 4 * D_MODEL, *gt2 = ad + 5 * D_MODEL;
        LAUNCH(k0_lnmod, nb(S), TB, st, xb, sh1, sc1, u.h, S);
        LAUNCH(k0_gemm, nb((long)(S / 4) * D_IN), TB, st, (const float*)u.h, D_MODEL, w_in, D_IN, u.P, D_IN, S, D_IN, D_MODEL);
        LAUNCH(k0_scores, nb((long)S * S), TB, st, (const float*)u.P, u.scT, S);
        LAUNCH(k0_topk, nb(S), TB, st, (const float*)u.scT, u.sel, u.cnt, S, topk);
        LAUNCH(k0_attn, nb((long)S * A_HEADS), TB, st, (const float*)u.P, (const int*)u.sel, (const int*)u.cnt, rel_bias, u.oa, S);
        LAUNCH(k0_gate, nb((long)S * G_KW), TB, st, (const float*)u.P, wg, bg, u.lg, S);
        LAUNCH(k0_gla, (G_HEADS * G_DV + 63) / 64, 64, st, (const float*)u.P, (const float*)u.lg, u.oraw, S);
        LAUNCH(k0_gla_post, nb((long)S * G_HEADS), TB, st, (const float*)u.P, (const float*)u.oraw, ng, u.ob, S);
        LAUNCH(k0_gemm, nb((long)(S / 4) * D_MODEL), TB, st, (const float*)u.oa, A_W, wba, D_MODEL, u.ba, D_MODEL, S, D_MODEL, A_W);
        LAUNCH(k0_gemm, nb((long)(S / 4) * D_MODEL), TB, st, (const float*)u.ob, G_VW, wbb, D_MODEL, u.bb, D_MODEL, S, D_MODEL, G_VW);
        LAUNCH(k0_merge, nb((long)S * D_MODEL), TB, st, (const float*)u.P, (const float*)u.ba, (const float*)u.bb, u.mg, S);
        LAUNCH(k0_gemm, nb((long)(S / 4) * D_MODEL), TB, st, (const float*)u.mg, D_MODEL, wout, D_MODEL, u.y, D_MODEL, S, D_MODEL, D_MODEL);
        LAUNCH(k0_ln1, nb(S), TB, st, xb, (const float*)u.y, gt1, g1, b1, sh2, sc2, u.x1, u.h2, S);
        LAUNCH(k0_gemm, nb((long)(S / 4) * N_GROUPS), TB, st, (const float*)u.h2, D_MODEL, wrg, N_GROUPS, u.rl, 36, S, N_GROUPS, D_MODEL);
        LAUNCH(k0_gemm, nb((long)(S / 4) * N_EXP), TB, st, (const float*)u.h2, D_MODEL, wre, N_EXP, u.rl + 4, 36, S, N_EXP, D_MODEL);
        LAUNCH(k0_route, nb(S), TB, st, (const float*)u.rl, brg, bre, u.eid, u.ew, S);
        LAUNCH(k0_moe_hid, nb((long)S * 2 * D_EXP), TB, st, (const float*)u.h2, (const int*)u.eid, w1, w3, u.hid, S);
        LAUNCH(k0_moe_out, nb((long)S * D_MODEL), TB, st, (const float*)u.hid, (const int*)u.eid, (const float*)u.ew, w2, u.f, S);
        LAUNCH(k0_final, nb(S), TB, st, (const float*)u.x1, (const float*)u.f, gt2, g2, b2, out + (size_t)b * S * D_MODEL, S);
    }
}
namespace pg8 {
#define PG8_LAS __attribute__((address_space(3)))
typedef unsigned short bf16_t;
typedef short bf16x8 __attribute__((ext_vector_type(8)));
typedef float f32x4 __attribute__((ext_vector_type(4)));
typedef unsigned u32x4 __attribute__((ext_vector_type(4)));
constexpr int BM = 256, BK = 64, HALF = 128, HTB = HALF * BK * 2  , STAGE_BYTES = 8 * HTB, NXCD = 8, WGM = 8;

__host__ __device__ __forceinline__ int lds_byte(int r, int c) { const int st = (r >> 4) * 2 + (c >> 5), rr = r & 15, cc = c & 31, ob = rr * 64 + cc * 2; return st * 1024 + (ob ^ (((ob >> 9) & 1) << 5)); }
__host__ __device__ __forceinline__ void stage_rc(int b, int& R, int& C) { const int st = b / 1024, sb = b % 1024, swz = sb ^ (((sb >> 9) & 1) << 5); R = (st >> 1) * 16 + swz / 64; C = (st & 1) * 32 + (swz % 64) / 2; }
__host__ __device__ __forceinline__ int perm32(int rho) { const int n = rho >> 4, i = rho & 15; return 8 * (i >> 2) + 4 * n + (i & 3); }

struct Unit { int pm, pn, pa, pb; };
struct Gemm { const bf16_t* A; const bf16_t* Bt; int M, N, K; };

struct StaticOrder {
    int nM, nN, nwg, G, c;
    __host__ __device__ void init(int M, int N, int G_, int c_) { nM = M / BM; nN = N / BM; nwg = nM * nN; G = G_; c = c_; }
    __host__ __device__ bool next(int i, Unit& u) const {
        const long L = (long)i * G + c; if (L >= nwg) return false;
        int wgid = (int)L; { const int q = nwg / NXCD, r = nwg % NXCD, xcd = wgid % NXCD, off = wgid / NXCD; wgid = (xcd < r ? xcd * (q + 1) : r * (q + 1) + (xcd - r) * q) + off; }
        const int nig = WGM * nN, gid = wgid / nig, fm = gid * WGM, gsz = (nM - fm) < WGM ? (nM - fm) : WGM;
        u.pm = fm + ((wgid % nig) % gsz); u.pn = (wgid % nig) / gsz; u.pa = u.pm; u.pb = u.pn; return true;
    }
    __device__ __forceinline__ void a_ready(const Unit&) const {}
    __device__ __forceinline__ void done(const Unit&) const {}
};

__device__ __forceinline__ unsigned cvt_pk_bf16(float lo, float hi) { unsigned r; asm volatile("v_cvt_pk_bf16_f32 %0, %1, %2" : "=v"(r) : "v"(lo), "v"(hi)); return r; }
typedef float f32x2 __attribute__((ext_vector_type(2)));

template <class Epi, class Sched, bool ALIGN_EPI = false, bool SP2 = false, bool GATHER = false>
__device__ __forceinline__ void gemm_phase(PG8_LAS unsigned char* lds, const Gemm g, const Sched& S, const Epi& E) {
    const int tid = threadIdx.x, wid = __builtin_amdgcn_readfirstlane(tid >> 6), lane = tid & 63, wr = wid >> 2, wc = wid & 3, fr = lane & 15, fq = lane >> 4;
    const int K = g.K, nt = K / BK;
    static_assert(!GATHER || SP2, "gathered A rows: SP2 loop only");
    unsigned voffA[2], voffB[2]; int Rr[2], Cc[2];
#pragma unroll
    for (int i = 0; i < 2; ++i) { int R, C; stage_rc(tid * 16 + i * 8192, R, C); const int Rb = Epi::PERM ? ((R & ~31) + perm32(R & 31)) : R; Rr[i] = R; Cc[i] = C;
        voffA[i] = (unsigned)(R * K + C) * 2u; voffB[i] = (unsigned)(Rb * K + C) * 2u; }
    unsigned vc0[2] = {voffA[0], voffA[1]}, vc1[2] = {voffA[0], voffA[1]}, vn0[2] = {voffA[0], voffA[1]}, vn1[2] = {voffA[0], voffA[1]};
    const size_t kstep = (size_t)(BK * 2);
    const size_t hstep = (size_t)HALF * K * 2;
    const size_t tstep = 2 * hstep;
    const unsigned ldsw = (unsigned)wid * 1024u;
    const int aoff = lds_byte(wr * 64 + fr, fq * 8), boff = lds_byte(wc * 32 + fr, fq * 8);
#define PG8_SA(b, h) (((b) * 2 + (h)) * HTB)
#define PG8_SB(b, h) ((4 + (b) * 2 + (h)) * HTB)
#define PG8_STAGE(bufoff, gbase, voff) do { _Pragma("unroll") for (int _i = 0; _i < 2; ++_i) \
        __builtin_amdgcn_global_load_lds((const unsigned*)((const char*)(gbase) + (voff)[_i]), (PG8_LAS unsigned*)(lds + (bufoff) + ldsw + _i * 8192), 16, 0, 0); } while (0)
#define PG8_LDA(dst, b, h) do { _Pragma("unroll") for (int m = 0; m < 4; ++m) _Pragma("unroll") for (int k = 0; k < 2; ++k) dst[m][k] = *(const PG8_LAS bf16x8*)(lds + PG8_SA(b, h) + aoff + m * 2048 + k * 1024); } while (0)
#define PG8_LDB(dst, b, h) do { _Pragma("unroll") for (int n = 0; n < 2; ++n) _Pragma("unroll") for (int k = 0; k < 2; ++k) dst[n][k] = *(const PG8_LAS bf16x8*)(lds + PG8_SB(b, h) + boff + n * 2048 + k * 1024); } while (0)
#define PG8_MMA(ai, bj, At, Bt) do { __builtin_amdgcn_s_setprio(1); _Pragma("unroll") for (int m = 0; m < 4; ++m) _Pragma("unroll") for (int n = 0; n < 2; ++n) _Pragma("unroll") for (int k = 0; k < 2; ++k) \
        acc[ai][bj][m][n] = __builtin_amdgcn_mfma_f32_16x16x32_bf16(Bt[n][k], At[m][k], acc[ai][bj][m][n], 0, 0, 0); __builtin_amdgcn_s_setprio(0); } while (0)
#define PG8_WAIT_V(n) asm volatile("s_waitcnt vmcnt(" #n ")" ::: "memory")
#define PG8_WAIT_L(n) asm volatile("s_waitcnt lgkmcnt(" #n ")" ::: "memory")
#define PG8_BAR __builtin_amdgcn_s_barrier()
#define PG8_SCHED __builtin_amdgcn_sched_barrier(0)
    Unit cur, nxt; int ui = 0;
    if (!S.next(0, cur)) return;
    f32x4 acc[2][2][4][2];
#pragma unroll
    for (int a = 0; a < 2; ++a)
#pragma unroll
        for (int b = 0; b < 2; ++b)
#pragma unroll
            for (int m = 0; m < 4; ++m)
#pragma unroll
                for (int n = 0; n < 2; ++n) acc[a][b][m][n] = (f32x4){0.f, 0.f, 0.f, 0.f};
    bf16x8 At[4][2], B0[2][2], B1[2][2];
    const char* cA = GATHER ? (const char*)g.A : (const char*)g.A + (size_t)cur.pa * tstep; const char* cB = (const char*)g.Bt + (size_t)cur.pb * tstep;
    const size_t hstepA = GATHER ? 0 : hstep;
    if constexpr (GATHER) {
#pragma unroll
        for (int i = 0; i < 2; ++i) { vc0[i] = (unsigned)S.a_row(cur, Rr[i]) * (unsigned)(K * 2) + (unsigned)(Cc[i] * 2); vc1[i] = (unsigned)S.a_row(cur, HALF + Rr[i]) * (unsigned)(K * 2) + (unsigned)(Cc[i] * 2); } }
    S.a_ready(cur);
    if constexpr (SP2) {
        PG8_STAGE(PG8_SB(0, 0), cB, voffB); PG8_STAGE(PG8_SB(0, 1), cB + hstep, voffB); PG8_STAGE(PG8_SA(0, 0), cA, vc0); PG8_STAGE(PG8_SA(0, 1), cA + hstepA, vc1);
        if (wr == 1) PG8_BAR;
        PG8_WAIT_V(2); PG8_BAR;
        PG8_STAGE(PG8_SB(1, 0), cB + kstep, voffB); PG8_STAGE(PG8_SA(1, 0), cA + kstep, vc0); PG8_STAGE(PG8_SB(1, 1), cB + hstep + kstep, voffB);
        PG8_WAIT_V(6); PG8_BAR;
    } else {
        PG8_STAGE(PG8_SB(0, 0), cB, voffB); PG8_STAGE(PG8_SA(0, 0), cA, voffA); PG8_STAGE(PG8_SB(0, 1), cB + hstep, voffB); PG8_STAGE(PG8_SA(0, 1), cA + hstep, voffA);
        if (wr == 1) PG8_BAR;
        PG8_WAIT_V(4); PG8_BAR;
        PG8_STAGE(PG8_SB(1, 0), cB + kstep, voffB); PG8_STAGE(PG8_SA(1, 0), cA + kstep, voffA); PG8_STAGE(PG8_SB(1, 1), cB + hstep + kstep, voffB);
        PG8_WAIT_V(6); PG8_BAR;
    }
    for (;;) {
        const bool has_next = S.next(ui + 1, nxt);
        const char* nA = GATHER ? cA : (has_next ? (const char*)g.A + (size_t)nxt.pa * tstep : cA); const char* nB = has_next ? (const char*)g.Bt + (size_t)nxt.pb * tstep : cB;
        if constexpr (GATHER) {
#pragma unroll
            for (int i = 0; i < 2; ++i) { vn0[i] = has_next ? (unsigned)S.a_row(nxt, Rr[i]) * (unsigned)(K * 2) + (unsigned)(Cc[i] * 2) : vc0[i]; vn1[i] = has_next ? (unsigned)S.a_row(nxt, HALF + Rr[i]) * (unsigned)(K * 2) + (unsigned)(Cc[i] * 2) : vc1[i]; } }
        for (int t = 0; t < nt; t += 2) {
            const bool last = (t == nt - 2);
            if constexpr (Epi::MID) { if (t == nt / 2) E.mid(acc, cur, wr, wc, fr, fq); }
            const char* a1 = cA + (size_t)(t + 1) * kstep;
            const char* a2 = last ? nA : cA + (size_t)(t + 2) * kstep; const char* b2 = last ? nB : cB + (size_t)(t + 2) * kstep;
            const char* a3 = a2 + kstep; const char* b3 = b2 + kstep;
            if (last && has_next) S.a_ready(nxt);
            if constexpr (SP2) {
            unsigned w0[2], w1[2];
#pragma unroll
            for (int i = 0; i < 2; ++i) { w0[i] = last ? vn0[i] : vc0[i]; w1[i] = last ? vn1[i] : vc1[i]; }
            PG8_LDB(B0, 0, 0); PG8_LDB(B1, 0, 1); PG8_SCHED; PG8_LDA(At, 0, 0); PG8_STAGE(PG8_SA(1, 1), a1 + hstepA, vc1);
            PG8_WAIT_V(8); PG8_WAIT_L(0); PG8_BAR; PG8_MMA(0, 0, At, B0); PG8_MMA(0, 1, At, B1); PG8_BAR; PG8_SCHED;
            PG8_LDA(At, 0, 1); PG8_STAGE(PG8_SB(0, 0), b2, voffB); PG8_STAGE(PG8_SB(0, 1), b2 + hstep, voffB); PG8_STAGE(PG8_SA(0, 0), a2, w0);
            PG8_WAIT_V(8); PG8_WAIT_L(0); PG8_BAR; PG8_MMA(1, 0, At, B0); PG8_MMA(1, 1, At, B1); PG8_BAR; PG8_SCHED;
            PG8_LDB(B0, 1, 0); PG8_LDB(B1, 1, 1); PG8_SCHED; PG8_LDA(At, 1, 0); PG8_STAGE(PG8_SA(0, 1), a2 + hstepA, w1);
            PG8_WAIT_V(8); PG8_WAIT_L(0); PG8_BAR; PG8_MMA(0, 0, At, B0); PG8_MMA(0, 1, At, B1); PG8_BAR; PG8_SCHED;
            PG8_LDA(At, 1, 1); PG8_STAGE(PG8_SB(1, 0), b3, voffB); PG8_STAGE(PG8_SB(1, 1), b3 + hstep, voffB); PG8_STAGE(PG8_SA(1, 0), a3, w0);
            PG8_WAIT_V(8); PG8_WAIT_L(0); PG8_BAR; PG8_MMA(1, 0, At, B0); PG8_MMA(1, 1, At, B1); PG8_BAR; PG8_SCHED;
            } else {
            PG8_LDB(B0, 0, 0); PG8_SCHED; PG8_LDA(At, 0, 0); PG8_STAGE(PG8_SA(1, 1), a1 + hstep, voffA);
            PG8_WAIT_L(8); PG8_BAR; PG8_WAIT_L(0); PG8_MMA(0, 0, At, B0); PG8_BAR; PG8_SCHED;
            PG8_LDB(B1, 0, 1); PG8_STAGE(PG8_SB(0, 0), b2, voffB);
            PG8_BAR; PG8_WAIT_L(0); PG8_MMA(0, 1, At, B1); PG8_BAR;
            PG8_LDA(At, 0, 1); PG8_STAGE(PG8_SA(0, 0), a2, voffA);
            PG8_BAR; PG8_WAIT_L(0); PG8_MMA(1, 0, At, B0); PG8_BAR; PG8_SCHED;
            PG8_STAGE(PG8_SB(0, 1), b2 + hstep, voffB);
            PG8_WAIT_V(6); PG8_BAR; PG8_MMA(1, 1, At, B1); PG8_BAR;
            PG8_LDB(B0, 1, 0); PG8_SCHED; PG8_LDA(At, 1, 0); PG8_STAGE(PG8_SA(0, 1), a2 + hstep, voffA);
            PG8_WAIT_L(8); PG8_BAR; PG8_WAIT_L(0); PG8_MMA(0, 0, At, B0); PG8_BAR; PG8_SCHED;
            PG8_LDB(B1, 1, 1); PG8_STAGE(PG8_SB(1, 0), b3, voffB);
            PG8_BAR; PG8_WAIT_L(0); PG8_MMA(0, 1, At, B1); PG8_BAR;
            PG8_LDA(At, 1, 1); PG8_STAGE(PG8_SA(1, 0), a3, voffA);
            PG8_BAR; PG8_WAIT_L(0); PG8_MMA(1, 0, At, B0); PG8_BAR; PG8_SCHED;
            PG8_STAGE(PG8_SB(1, 1), b3 + hstep, voffB);
            PG8_WAIT_V(6); PG8_BAR; PG8_MMA(1, 1, At, B1); PG8_BAR;
            }
        }
        if constexpr (ALIGN_EPI) { if (wr == 0) PG8_BAR; }
        if constexpr (!Epi::AFTER_DRAIN) { E(acc, cur, wr, wc, fr, fq); S.done(cur); }
        if (!has_next) break;
#pragma unroll
        for (int a = 0; a < 2; ++a)
#pragma unroll
            for (int b = 0; b < 2; ++b)
#pragma unroll
                for (int m = 0; m < 4; ++m)
#pragma unroll
                    for (int n = 0; n < 2; ++n) acc[a][b][m][n] = (f32x4){0.f, 0.f, 0.f, 0.f};
        cur = nxt; cA = nA; cB = nB; ++ui;
        if constexpr (GATHER) { vc0[0] = vn0[0]; vc0[1] = vn0[1]; vc1[0] = vn1[0]; vc1[1] = vn1[1]; }
        if constexpr (ALIGN_EPI) { if (wr == 1) PG8_BAR; }
    }
    PG8_WAIT_V(0);
    if constexpr (!ALIGN_EPI) { if (wr == 0) PG8_BAR; }
    PG8_BAR;
    if constexpr (Epi::AFTER_DRAIN) { E.fused(acc, cur, wr, wc, fr, fq, lds, wid, lane); S.done(cur); }
#undef PG8_SA
#undef PG8_SB
#undef PG8_STAGE
#undef PG8_LDA
#undef PG8_LDB
#undef PG8_MMA
#undef PG8_WAIT_V
#undef PG8_WAIT_L
#undef PG8_BAR
#undef PG8_SCHED
}
}

#ifndef PG8_SP2
#define PG8_SP2 true
#endif
#ifndef PG8_ALIGN
#define PG8_ALIGN true
#endif
#ifndef DUPSUB
#define DUPSUB 0
#endif
#ifndef TSTAMP
#define TSTAMP 0
#endif
#ifndef USE_CG_SYNC
#define USE_CG_SYNC 0
#endif
#ifndef DUPMASK
#define DUPMASK 0
#define DUPMASK_ON 0
#else
#define DUPMASK_ON 1
#endif
namespace cg = cooperative_groups;
namespace fk {
using pg8::bf16_t; using pg8::f32x4; using pg8::u32x4; using pg8::bf16x8; using pg8::Unit; using pg8::cvt_pk_bf16;
#define LAS __attribute__((address_space(3)))
#define LDS_WAIT() asm volatile("s_waitcnt lgkmcnt(0)" ::: "memory")
typedef unsigned u32x2 __attribute__((ext_vector_type(2)));
constexpr int NB = 8, NS = 4096, NT = NB * NS;
constexpr int NTHREADS = 512, NWAVES = 8, LDS_BYTES = 155648;
constexpr size_t MiB = (size_t)1 << 20;
constexpr size_t WS_ADA = 0, WS_CNT = 256 * 1024,
    WS_WIN = 1 * MiB, WS_WGAB = 9 * MiB, WS_WBA = 13 * MiB, WS_WBB = 14 * MiB, WS_WOUT = 15 * MiB, WS_W13 = 17 * MiB, WS_W2 = 49 * MiB,
    WS_XN = 65 * MiB, WS_QKV = 129 * MiB, WS_IQ = 225 * MiB, WS_GQK = 257 * MiB, WS_GV = 289 * MiB, WS_GR = 321 * MiB,
    WS_IK = 353 * MiB, WS_IW = 355 * MiB, WS_GLR = 357 * MiB, WS_SC = 358 * MiB, WS_MASK = 490 * MiB, WS_ADAP = 506 * MiB, WS_MISC = 509 * MiB;
constexpr int NPROJ = 3584;
constexpr size_t WS_WGT = 400 * 1024;
constexpr int KSL = 16;
constexpr float QSCALE = 0.125f * 1.4426950408889634f;
typedef float f32x2_t __attribute__((ext_vector_type(2))); typedef __bf16 bf16x2_t __attribute__((ext_vector_type(2)));
__device__ __forceinline__ unsigned cvtpk_s(float lo, float hi) { f32x2_t v = {lo, hi}; bf16x2_t b = __builtin_convertvector(v, bf16x2_t); return __builtin_bit_cast(unsigned, b); }
__device__ __forceinline__ void bf8_to_f(const u32x4 w, float* f) {
#pragma unroll
    for (int j = 0; j < 4; ++j) { f[2 * j] = __uint_as_float(w[j] << 16); f[2 * j + 1] = __uint_as_float(w[j] & 0xffff0000u); }
}

__device__ __forceinline__ void tr_item(const float* W, int ldw, int srccol, bf16_t* WT, int K, int dst_row0, int kb, LAS float* scr, int lane, int kdst0 = 0) {
    const int k0 = 64 * kb;
#pragma unroll
    for (int i = 0; i < 32; ++i) { const int kk = 2 * i + (lane >> 5); scr[kk * 33 + (lane & 31)] = W[(size_t)(k0 + kk) * ldw + srccol]; }
    LDS_WAIT();
    const int c = lane & 7;
#pragma unroll
    for (int j = 0; j < 4; ++j) { const int n = (lane >> 3) + 8 * j; const LAS float* s = scr + (8 * c) * 33 + n;
        u32x4 o; o.x = cvt_pk_bf16(s[0 * 33], s[1 * 33]); o.y = cvt_pk_bf16(s[2 * 33], s[3 * 33]); o.z = cvt_pk_bf16(s[4 * 33], s[5 * 33]); o.w = cvt_pk_bf16(s[6 * 33], s[7 * 33]);
        *(u32x4*)(WT + (size_t)(dst_row0 + n) * K + kdst0 + k0 + 8 * c) = o; }
    LDS_WAIT();
}
__device__ __forceinline__ int win_src(int n) {
    if (n < 2048) return n;
    if (n < 3584) return n + 48;
    if (n < 3616) return O_IK + (n - 3584);
    if (n < 3632) return O_IW + (n - 3616);
    return O_GLR + (n - 3632);
}
constexpr int I_ADA = 96 * KSL, I_WIN = 114 * 16, I_WGAB = 64 * 16, I_WB = 32 * 8, I_WOUT = 32 * 16, I_W13 = 32 * 16 * 16, I_W2 = 32 * 32 * 4;
constexpr int P0_ITEMS = I_ADA + I_WIN + I_WGAB + 2 * I_WB + I_WOUT + I_W13 + I_W2, P0_EARLY = I_ADA + I_WIN + I_WGAB + 2 * I_WB + I_WOUT;
__device__ __forceinline__ void p0_item(int it, const float* const* in, unsigned char* ws, LAS float* scr, int lane) {
    if (it < I_ADA) {
        const int cb = it / KSL, ks = it % KSL, k0 = ks * 64; const float* c = in[1]; const float* w = in[3];
#pragma unroll
        for (int b = 0; b < NB; ++b) { const float cv = c[b * D_MODEL + k0 + lane]; scr[b * 64 + lane] = cv / (1.f + __expf(-cv)); }
        LDS_WAIT();
        float acc[NB];
#pragma unroll
        for (int b = 0; b < NB; ++b) acc[b] = 0.f;
        const int col = cb * 64 + lane;
#pragma unroll 16
        for (int kk = 0; kk < 64; ++kk) { const float wv = w[(size_t)(k0 + kk) * (6 * D_MODEL) + col];
#pragma unroll
            for (int b = 0; b < NB; ++b) acc[b] += scr[b * 64 + kk] * wv; }
        float* adap = (float*)(ws + WS_ADAP);
#pragma unroll
        for (int b = 0; b < NB; ++b) adap[(size_t)(ks * NB + b) * (6 * D_MODEL) + col] = acc[b];
        LDS_WAIT(); return;
    }
    it -= I_ADA;
    const int l31 = lane & 31;
    if (it < I_WIN) { const int nb = it / 16, kb = it % 16; tr_item(in[5], D_IN, win_src(nb * 32 + l31), (bf16_t*)(ws + WS_WIN), 1024, nb * 32, kb, scr, lane); return; }
    it -= I_WIN;
    if (it < I_WGAB) { const int nb = it / 16, kb = it % 16; tr_item(in[5], D_IN, O_GA + nb * 32 + l31, (bf16_t*)(ws + WS_WGAB), 1024, nb * 32, kb, scr, lane); return; }
    it -= I_WGAB;
    if (it < I_WB) { const int nb = it / 8, kb = it % 8; tr_item(in[9], D_MODEL, nb * 32 + l31, (bf16_t*)(ws + WS_WBA), 1024, nb * 32, kb, scr, lane, 0); return; }
    it -= I_WB;
    if (it < I_WB) { const int nb = it / 8, kb = it % 8; tr_item(in[10], D_MODEL, nb * 32 + l31, (bf16_t*)(ws + WS_WBA), 1024, nb * 32, kb, scr, lane, 512); return; }
    it -= I_WB;
    if (it < I_WOUT) { const int nb = it / 16, kb = it % 16; tr_item(in[11], D_MODEL, nb * 32 + l31, (bf16_t*)(ws + WS_WOUT), 1024, nb * 32, kb, scr, lane); return; }
    it -= I_WOUT;
    if (it < I_W13) {
        const int e = it / 256, r = it % 256, nb = r / 16, kb = r % 16; const int row0 = nb * 32;
        const int half = (row0 & 255) >> 7; const int col = (row0 >> 8) * 128 + (row0 & 127) + l31;
        const float* src = (half ? in[19] : in[18]) + (size_t)e * D_MODEL * D_EXP;
        tr_item(src, D_EXP, col, (bf16_t*)(ws + WS_W13) + (size_t)e * 512 * 1024, 1024, row0, kb, scr, lane); return; }
    it -= I_W13;
    { const int e = it / 128, r = it % 128, nb = r / 4, kb = r % 4;
      tr_item(in[20] + (size_t)e * D_EXP * D_MODEL, D_MODEL, nb * 32 + l31, (bf16_t*)(ws + WS_W2) + (size_t)e * 1024 * 256, 256, nb * 32, kb, scr, lane); }
}

__device__ __forceinline__ float dpp_row_sum_f(float v) {
    v += __int_as_float(__builtin_amdgcn_update_dpp(0, __float_as_int(v), 0xB1, 0xF, 0xF, true));
    v += __int_as_float(__builtin_amdgcn_update_dpp(0, __float_as_int(v), 0x4E, 0xF, 0xF, true));
    v += __int_as_float(__builtin_amdgcn_update_dpp(0, __float_as_int(v), 0x141, 0xF, 0xF, true));
    v += __int_as_float(__builtin_amdgcn_update_dpp(0, __float_as_int(v), 0x140, 0xF, 0xF, true));
    return v;
}
__device__ __forceinline__ float wave_sum_u(float v) {
    v = dpp_row_sum_f(v);
    return (__int_as_float(__builtin_amdgcn_readlane(__float_as_int(v), 0)) + __int_as_float(__builtin_amdgcn_readlane(__float_as_int(v), 16)))
         + (__int_as_float(__builtin_amdgcn_readlane(__float_as_int(v), 32)) + __int_as_float(__builtin_amdgcn_readlane(__float_as_int(v), 48)));
}
template <int R> __device__ __forceinline__ void ln_center(f32x4 (&v)[R][4], float (&rstd)[R], float* meanout = nullptr) {
    float s[R];
#pragma unroll
    for (int r = 0; r < R; ++r) { s[r] = 0.f;
#pragma unroll
        for (int j = 0; j < 4; ++j) s[r] += (v[r][j].x + v[r][j].y) + (v[r][j].z + v[r][j].w); }
#pragma unroll
    for (int r = 0; r < R; ++r) s[r] = dpp_row_sum_f(s[r]);
    float q[R];
#pragma unroll
    for (int r = 0; r < R; ++r) { const float mean = ((__int_as_float(__builtin_amdgcn_readlane(__float_as_int(s[r]), 0)) + __int_as_float(__builtin_amdgcn_readlane(__float_as_int(s[r]), 16)))
                                                   + (__int_as_float(__builtin_amdgcn_readlane(__float_as_int(s[r]), 32)) + __int_as_float(__builtin_amdgcn_readlane(__float_as_int(s[r]), 48)))) * (1.f / D_MODEL);
        if (meanout) meanout[r] = mean;
        q[r] = 0.f;
#pragma unroll
        for (int j = 0; j < 4; ++j) { v[r][j] = v[r][j] - mean; q[r] += (v[r][j].x * v[r][j].x + v[r][j].y * v[r][j].y) + (v[r][j].z * v[r][j].z + v[r][j].w * v[r][j].w); } }
#pragma unroll
    for (int r = 0; r < R; ++r) q[r] = dpp_row_sum_f(q[r]);
#pragma unroll
    for (int r = 0; r < R; ++r) { const float var = ((__int_as_float(__builtin_amdgcn_readlane(__float_as_int(q[r]), 0)) + __int_as_float(__builtin_amdgcn_readlane(__float_as_int(q[r]), 16)))
                                                  + (__int_as_float(__builtin_amdgcn_readlane(__float_as_int(q[r]), 32)) + __int_as_float(__builtin_amdgcn_readlane(__float_as_int(q[r]), 48)))) * (1.f / D_MODEL);
        rstd[r] = 1.f / sqrtf(var + LN_EPS); }
}
__device__ __forceinline__ float wave_sum(float v) {
#pragma unroll
    for (int o = 1; o < 64; o <<= 1) v += __shfl_xor(v, o);
    return v;
}
__device__ __forceinline__ float ada_sum(const float* adap, const float* b_ada, int b, int j) {
    float s = b_ada[j];
#pragma unroll
    for (int k = 0; k < KSL; ++k) s += adap[(size_t)(k * NB + b) * (6 * D_MODEL) + j];
    return s;
}
__device__ __forceinline__ void p1_phase(const float* const* in, unsigned char* ws, LAS unsigned char* lds, int G) {
    const int tid = threadIdx.x, lane = tid & 63, wave = tid >> 6;
    const float* adap = (const float*)(ws + WS_ADAP); const float* b_ada = in[4]; const float* x = in[0];
    LAS float* sh = (LAS float*)lds; LAS float* sc = sh + D_MODEL;
    for (int blk = blockIdx.x; blk < NT / 128; blk += G) {
        const int b = blk / 32;
        __syncthreads();
        for (int j = tid; j < 2 * D_MODEL; j += NTHREADS) sh[j] = ada_sum(adap, b_ada, b, j);
        if ((blk & 31) == 0) { float* ada = (float*)(ws + WS_ADA) + (size_t)b * 6 * D_MODEL; for (int j = tid; j < 6 * D_MODEL; j += NTHREADS) ada[j] = ada_sum(adap, b_ada, b, j); }
        __syncthreads();
        for (int rb = 0; rb < 16; rb += 4) {
            const size_t row0 = (size_t)blk * 128 + wave * 16 + rb;
            f32x4 v[4][4];
#pragma unroll
            for (int r = 0; r < 4; ++r) { const f32x4* xr = (const f32x4*)(x + (row0 + r) * D_MODEL) + lane;
#pragma unroll
                for (int j = 0; j < 4; ++j) v[r][j] = xr[64 * j]; }
            float rstd[4]; ln_center<4>(v, rstd);
#pragma unroll
            for (int j = 0; j < 4; ++j) { const f32x4 a = *(const LAS f32x4*)(sc + 256 * j + 4 * lane) + 1.f, c = *(const LAS f32x4*)(sh + 256 * j + 4 * lane);
#pragma unroll
                for (int r = 0; r < 4; ++r) { const f32x4 y = v[r][j] * rstd[r] * a + c; u32x2 w; w.x = cvtpk_s(y.x, y.y); w.y = cvtpk_s(y.z, y.w);
                    ((u32x2*)((bf16_t*)(ws + WS_XN) + (row0 + r) * D_MODEL) + lane)[64 * j] = w; } }
        }
        asm volatile("s_waitcnt vmcnt(0)" ::: "memory"); __syncthreads();
        {   LAS unsigned char* W64 = lds + 8192; constexpr int WP = 2064;
            const bf16_t* wsrc = (const bf16_t*)(ws + WS_WIN) + (size_t)3584 * 1024;
            for (int i = tid; i < 64 * 128; i += NTHREADS) { const int n = i >> 7, c = i & 127; *(LAS u32x4*)(W64 + n * WP + c * 16) = *(const u32x4*)(wsrc + (size_t)n * 1024 + c * 8); }
            __syncthreads();
            const int fr = lane & 15, fq = lane >> 4; const size_t rowA = (size_t)blk * 128 + wave * 16 + fr;
            const bf16_t* xp = (const bf16_t*)(ws + WS_XN) + rowA * D_MODEL + 8 * fq;
            f32x4 acc[4];
#pragma unroll
            for (int nt = 0; nt < 4; ++nt) acc[nt] = (f32x4){0.f, 0.f, 0.f, 0.f};
#pragma unroll 8
            for (int ks = 0; ks < 32; ++ks) { const bf16x8 bfr = *(const bf16x8*)(xp + 32 * ks);
#pragma unroll
                for (int nt = 0; nt < 4; ++nt) { const bf16x8 afr = *(const LAS bf16x8*)(W64 + (16 * nt + fr) * WP + (32 * ks + 8 * fq) * 2); acc[nt] = __builtin_amdgcn_mfma_f32_16x16x32_bf16(afr, bfr, acc[nt], 0, 0, 0); } }
            { u32x2 w; w.x = cvtpk_s(acc[0][0], acc[0][1]); w.y = cvtpk_s(acc[0][2], acc[0][3]); *(u32x2*)((bf16_t*)(ws + WS_IK) + rowA * 32 + 4 * fq) = w;
              w.x = cvtpk_s(acc[1][0], acc[1][1]); w.y = cvtpk_s(acc[1][2], acc[1][3]); *(u32x2*)((bf16_t*)(ws + WS_IK) + rowA * 32 + 16 + 4 * fq) = w;
              *(f32x4*)((float*)(ws + WS_IW) + rowA * 16 + 4 * fq) = acc[2];
              w.x = cvtpk_s(acc[3][0], acc[3][1]); w.y = cvtpk_s(acc[3][2], acc[3][3]); *(u32x2*)((bf16_t*)(ws + WS_GLR) + rowA * 16 + 4 * fq) = w; }
        }
    }
}

struct EpiProj {
    static constexpr bool PERM = true, AFTER_DRAIN = false, MID = false;
    unsigned char* ws;
    __device__ __forceinline__ void operator()(const f32x4 (&acc)[2][2][4][2], const Unit& u, int wr, int wc, int fr, int fq) const {
        const int row0 = u.pm * 256 + wr * 64 + fr; const int pn = u.pn;
        {
            bf16_t* base; int ld, ct; float sc = 1.f;
            if (pn < 6) { base = (bf16_t*)(ws + WS_QKV); ld = 1536; ct = pn * 256; if (pn < 2) sc = QSCALE; }
            else if (pn < 8) { base = (bf16_t*)(ws + WS_IQ); ld = 512; ct = (pn - 6) * 256; }
            else if (pn < 10) { base = (bf16_t*)(ws + WS_GQK); ld = 512; ct = (pn - 8) * 256; }
            else if (pn < 12) { base = (bf16_t*)(ws + WS_GV); ld = 512; ct = (pn - 10) * 256; }
            else { base = (bf16_t*)(ws + WS_GR); ld = 512; ct = (pn - 12) * 256; }
            const int col0 = ct + wc * 32 + 8 * fq;
#pragma unroll
            for (int ai = 0; ai < 2; ++ai)
#pragma unroll
                for (int m = 0; m < 4; ++m) { bf16_t* rowp = base + (size_t)(row0 + ai * 128 + m * 16) * ld + col0;
#pragma unroll
                    for (int bj = 0; bj < 2; ++bj) { const f32x4 v0 = acc[ai][bj][m][0] * sc, v1 = acc[ai][bj][m][1] * sc;
                        u32x4 w; w.x = cvt_pk_bf16(v0[0], v0[1]); w.y = cvt_pk_bf16(v0[2], v0[3]); w.z = cvt_pk_bf16(v1[0], v1[1]); w.w = cvt_pk_bf16(v1[2], v1[3]);
                        *(u32x4*)(rowp + bj * 128) = w; } }
        }
    }
};

typedef float f32x4_t __attribute__((ext_vector_type(4)));
constexpr int SC_TILES_PER_B = 528, SC_ITEMS = NB * SC_TILES_PER_B;
__device__ __forceinline__ size_t keys_row_dw(int b, int t) {
    const int qi = t >> 7, r = t & 127; return (size_t)b * (SC_TILES_PER_B * 8192) + (size_t)8192 * (qi * (qi + 1) / 2) + (size_t)r * (qi + 1) * 64;
}
__device__ __forceinline__ unsigned score_key(float sc) {
    const _Float16 hf = (_Float16)sc; const unsigned short hb = __builtin_bit_cast(unsigned short, hf);
    return (hb & 0x8000u) ? (unsigned)(unsigned short)~hb : (unsigned)(hb | 0x8000u);
}
__device__ __forceinline__ void fma_abs4(f32x4& acc, const f32x4& d, float w) {
    float a0 = acc[0], a1 = acc[1], a2 = acc[2], a3 = acc[3];
    asm volatile("v_fma_f32 %0, |%4|, %8, %0\n\tv_fma_f32 %1, |%5|, %8, %1\n\tv_fma_f32 %2, |%6|, %8, %2\n\tv_fma_f32 %3, |%7|, %8, %3"
                 : "+v"(a0), "+v"(a1), "+v"(a2), "+v"(a3) : "v"(d[0]), "v"(d[1]), "v"(d[2]), "v"(d[3]), "v"(w));
    acc[0] = a0; acc[1] = a1; acc[2] = a2; acc[3] = a3;
}
constexpr int SC_SEGS_PER_B = 144, SC_SEGS = NB * SC_SEGS_PER_B;
__device__ __forceinline__ unsigned score_key2(float lo, float hi) {
    typedef _Float16 h2 __attribute__((ext_vector_type(2)));
    const unsigned x = __builtin_bit_cast(unsigned, __builtin_amdgcn_cvt_pkrtz(lo, hi));
    unsigned m; asm("v_pk_ashrrev_i16 %0, %2, %1" : "=v"(m) : "v"(x), "v"(0x000F000Fu));
    return x ^ (m | 0x80008000u);
}
__device__ __forceinline__ void p3a_run(int b, int qi, int kj0, int kj1, unsigned char* ws, LAS unsigned char* ldsw, int wave, int lane) {
    const int fr = lane & 15, fq = lane >> 4;
    const int t = qi * 128 + wave * 16 + fr; const size_t trow = (size_t)b * NS + t;
    const bf16_t* IQ = (const bf16_t*)(ws + WS_IQ) + trow * 512 + 8 * fq;
    const bf16_t* IK = (const bf16_t*)(ws + WS_IK) + ((size_t)b * NS + fr) * 32 + 8 * fq;
    const float* IW = (const float*)(ws + WS_IW) + trow * 16;
    LAS unsigned char* QL = ldsw; LAS float* WL = (LAS float*)(ldsw + 16384);
    bf16x8 kf[8];
#pragma unroll
    for (int kb = 0; kb < 8; ++kb) kf[kb] = *(const bf16x8*)(IK + ((size_t)kj0 * 128 + kb * 16) * 32);
    float qb[8];
#pragma unroll
    for (int j = 0; j < 8; ++j) qb[j] = 0.f;
#pragma unroll
    for (int hg = 0; hg < 4; ++hg) {
        const f32x4 w4 = *(const f32x4*)(IW + 4 * hg) * (0.5f * 0.044194173824159216f);
        u32x4 q4[4];
#pragma unroll
        for (int i = 0; i < 4; ++i) q4[i] = *(const u32x4*)(IQ + (4 * hg + i) * 32);
#pragma unroll
        for (int i = 0; i < 4; ++i) { *(LAS u32x4*)(QL + (4 * hg + i) * 1024 + lane * 16) = q4[i]; if (fq == 0) WL[(4 * hg + i) * 16 + fr] = w4[i]; float f[8]; bf8_to_f(q4[i], f);
#pragma unroll
            for (int j = 0; j < 8; ++j) qb[j] += w4[i] * f[j]; }
    }
    u32x4 qbw; qbw.x = cvtpk_s(qb[0], qb[1]); qbw.y = cvtpk_s(qb[2], qb[3]); qbw.z = cvtpk_s(qb[4], qb[5]); qbw.w = cvtpk_s(qb[6], qb[7]);
    const bf16x8 qbar = __builtin_bit_cast(bf16x8, qbw);
    LDS_WAIT();
    for (int kj = kj0; kj <= kj1; ++kj) {
        bf16x8 kn[8];
        const int kjn = (kj < kj1) ? kj + 1 : kj;
#pragma unroll
        for (int kb = 0; kb < 8; ++kb) kn[kb] = *(const bf16x8*)(IK + ((size_t)kjn * 128 + kb * 16) * 32);
        f32x4 acc[8];
#pragma unroll
        for (int kb = 0; kb < 8; ++kb) acc[kb] = __builtin_amdgcn_mfma_f32_16x16x32_bf16(kf[kb], qbar, (f32x4){0.f, 0.f, 0.f, 0.f}, 0, 0, 0);
        f32x4 dA[8], dB[8];
        { const bf16x8 qf = *(const LAS bf16x8*)(QL + lane * 16);
#pragma unroll
          for (int kb = 0; kb < 8; ++kb) dA[kb] = __builtin_amdgcn_mfma_f32_16x16x32_bf16(kf[kb], qf, (f32x4){0.f, 0.f, 0.f, 0.f}, 0, 0, 0); }
#pragma unroll 1
        for (int h = 0; h < I_HEADS; h += 2) {
            { const bf16x8 qf = *(const LAS bf16x8*)(QL + (h + 1) * 1024 + lane * 16);
#pragma unroll
              for (int kb = 0; kb < 8; ++kb) dB[kb] = __builtin_amdgcn_mfma_f32_16x16x32_bf16(kf[kb], qf, (f32x4){0.f, 0.f, 0.f, 0.f}, 0, 0, 0); }
            __builtin_amdgcn_sched_barrier(0);
            { const float w = WL[h * 16 + fr];
#pragma unroll
              for (int kb = 0; kb < 8; ++kb) fma_abs4(acc[kb], dA[kb], w); }
            __builtin_amdgcn_sched_barrier(0);
            { const int hn = (h + 2 < I_HEADS) ? h + 2 : h; const bf16x8 qf = *(const LAS bf16x8*)(QL + hn * 1024 + lane * 16);
#pragma unroll
              for (int kb = 0; kb < 8; ++kb) dA[kb] = __builtin_amdgcn_mfma_f32_16x16x32_bf16(kf[kb], qf, (f32x4){0.f, 0.f, 0.f, 0.f}, 0, 0, 0); }
            __builtin_amdgcn_sched_barrier(0);
            { const float w = WL[(h + 1) * 16 + fr];
#pragma unroll
              for (int kb = 0; kb < 8; ++kb) fma_abs4(acc[kb], dB[kb], w); }
            __builtin_amdgcn_sched_barrier(0);
        }
        unsigned* KEYS = (unsigned*)(ws + WS_SC) + keys_row_dw(b, t) + (size_t)kj * 64;
        const bool diag = (kj == qi);
#pragma unroll
        for (int kb = 0; kb < 4; ++kb) { u32x4 o;
#pragma unroll
            for (int r = 0; r < 4; ++r) { const int sl = kb * 16 + 4 * fq + r;
                unsigned kk = score_key2(acc[kb][r], acc[kb + 4][r]);
                if (diag) { const int tl = wave * 16 + fr; if (sl > tl) kk &= 0xFFFF0000u; if (sl + 64 > tl) kk &= 0x0000FFFFu; }
                o[r] = kk; }
            *(u32x4*)(KEYS + kb * 16 + 4 * fq) = o; }
#pragma unroll
        for (int kb = 0; kb < 8; ++kb) kf[kb] = kn[kb];
    }
    LDS_WAIT();
}

__device__ __forceinline__ int dpp_row_sum(int v) {
    v += __builtin_amdgcn_update_dpp(0, v, 0xB1, 0xF, 0xF, true);
    v += __builtin_amdgcn_update_dpp(0, v, 0x4E, 0xF, 0xF, true);
    v += __builtin_amdgcn_update_dpp(0, v, 0x141, 0xF, 0xF, true);
    v += __builtin_amdgcn_update_dpp(0, v, 0x140, 0xF, 0xF, true);
    return v;
}
__device__ __forceinline__ int wave_sum_i(int v) {
    v = dpp_row_sum(v);
    return __builtin_amdgcn_readlane(v, 0) + __builtin_amdgcn_readlane(v, 16) + __builtin_amdgcn_readlane(v, 32) + __builtin_amdgcn_readlane(v, 48);
}
__device__ __forceinline__ void pk_ge_count4(unsigned x0, unsigned x1, unsigned x2, unsigned x3, unsigned c2m1, unsigned one2, unsigned& c0, unsigned& c1, unsigned& c2, unsigned& c3) {
    unsigned d0, d1, d2, d3;
    asm volatile("v_pk_sub_u16 %0, %8, %12 clamp\n\tv_pk_sub_u16 %1, %9, %12 clamp\n\tv_pk_sub_u16 %2, %10, %12 clamp\n\tv_pk_sub_u16 %3, %11, %12 clamp\n\t"
                 "v_pk_min_u16 %0, %0, %13\n\tv_pk_min_u16 %1, %1, %13\n\tv_pk_min_u16 %2, %2, %13\n\tv_pk_min_u16 %3, %3, %13\n\t"
                 "v_pk_add_u16 %4, %4, %0\n\tv_pk_add_u16 %5, %5, %1\n\tv_pk_add_u16 %6, %6, %2\n\tv_pk_add_u16 %7, %7, %3"
                 : "=&v"(d0), "=&v"(d1), "=&v"(d2), "=&v"(d3), "+v"(c0), "+v"(c1), "+v"(c2), "+v"(c3) : "v"(x0), "v"(x1), "v"(x2), "v"(x3), "v"(c2m1), "v"(one2));
}
constexpr int TOPK = 256;
__device__ __forceinline__ int count_ge(const unsigned (&x)[32], int ng, unsigned cand) {
    const unsigned c2m1 = (cand - 1u) * 0x00010001u, one2 = 0x00010001u; unsigned c0 = 0u, c1 = 0u, c2 = 0u, c3 = 0u;
#pragma unroll
    for (int g = 0; g < 4; ++g) if (g < ng) { pk_ge_count4(x[8 * g], x[8 * g + 1], x[8 * g + 2], x[8 * g + 3], c2m1, one2, c0, c1, c2, c3); pk_ge_count4(x[8 * g + 4], x[8 * g + 5], x[8 * g + 6], x[8 * g + 7], c2m1, one2, c0, c1, c2, c3); }
    const unsigned s = (c0 + c1) + (c2 + c3);
    return wave_sum_i((int)((s & 0xFFFFu) + (s >> 16)));
}
__device__ __forceinline__ void p4a_load(int row_, unsigned char* ws, int lane, unsigned (&x)[32]) {
    const int row = __builtin_amdgcn_readfirstlane(row_); const int b = row / NS, t = row % NS; const int nc = (t >> 7) + 1;
    const unsigned* KEYS = (const unsigned*)(ws + WS_SC) + keys_row_dw(b, t) + lane;
#pragma unroll
    for (int c = 0; c < 32; ++c) { const int cc = c < nc ? c : nc - 1; const unsigned v = KEYS[cc * 64]; x[c] = c < nc ? v : 0u; }
}
__device__ __forceinline__ void p4a_row(int row_, unsigned char* ws, int lane, const unsigned (&x)[32], unsigned& guess) {
    const int row = __builtin_amdgcn_readfirstlane(row_);
    const int t = row % NS; unsigned long long* MASK = (unsigned long long*)(ws + WS_MASK) + (size_t)row * 64;
    const int nc = (t >> 7) + 1;
    if (t < TOPK) {
        if (lane < 2 * nc) { const int lo = lane * 64; unsigned long long m = 0ull; if (t >= lo + 63) m = ~0ull; else if (t >= lo) m = (2ull << (t - lo)) - 1ull; MASK[lane] = m; }
        return;
    }
    const int ng = (nc + 7) >> 3;
    unsigned lo = 1u, hi = 0x10000u; int cT = 0;
    if (guess != 0u) { const unsigned gl = guess > 257u ? guess - 256u : 1u, gh = guess + 256u < 0x10000u ? guess + 256u : 0x10000u;
        const int cl = count_ge(x, ng, gl); if (cl >= TOPK) { lo = gl; cT = cl; } else hi = gl;
        if (cl >= TOPK && gh < 0x10000u) { const int ch = count_ge(x, ng, gh); if (ch >= TOPK) { lo = gh; cT = ch; } else hi = gh; } }
    while (hi - lo > 1u) { const unsigned mid = (lo + hi) >> 1; const int cnt = count_ge(x, ng, mid); if (cnt >= TOPK) { lo = mid; cT = cnt; } else hi = mid; }
    const unsigned T = lo; guess = T;
    if (cT == 0) cT = count_ge(x, ng, T);
    unsigned mw0 = 0u, mw1 = 0u;
    if (cT == TOPK) {
#pragma unroll
        for (int g = 0; g < 4; ++g) if (g < ng) {
#pragma unroll
            for (int i = 0; i < 8; ++i) { const int c = 8 * g + i;
                const unsigned long long mlo = __ballot((x[c] & 0xFFFFu) >= T), mhi = __ballot((x[c] >> 16) >= T);
                asm volatile("s_nop 3\n\tv_writelane_b32 %0, %2, %4\n\tv_writelane_b32 %1, %3, %4" : "+v"(mw0), "+v"(mw1) : "s"((unsigned)mlo), "s"((unsigned)(mlo >> 32)), "n"(2 * c));
                asm volatile("s_nop 3\n\tv_writelane_b32 %0, %2, %4\n\tv_writelane_b32 %1, %3, %4" : "+v"(mw0), "+v"(mw1) : "s"((unsigned)mhi), "s"((unsigned)(mhi >> 32)), "n"(2 * c + 1)); }
        }
    } else {
        const int need = TOPK - count_ge(x, ng, T + 1u); int run = 0;
#pragma unroll
        for (int g = 0; g < 4; ++g) if (g < ng) {
#pragma unroll
            for (int i = 0; i < 8; ++i) { const int c = 8 * g + i;
                const unsigned klo = x[c] & 0xFFFFu, khi = x[c] >> 16;
                const unsigned long long elo = __ballot(klo == T), ehi = __ballot(khi == T);
                const int rlo = run + (int)__builtin_amdgcn_mbcnt_hi((unsigned)(elo >> 32), __builtin_amdgcn_mbcnt_lo((unsigned)elo, 0u));
                const int nlo = __builtin_popcountll(elo);
                const int rhi = run + nlo + (int)__builtin_amdgcn_mbcnt_hi((unsigned)(ehi >> 32), __builtin_amdgcn_mbcnt_lo((unsigned)ehi, 0u));
                run += nlo + __builtin_popcountll(ehi);
                const bool slo = (klo > T) || (klo == T && rlo < need), shi = (khi > T) || (khi == T && rhi < need);
                const unsigned long long mlo = __ballot(slo), mhi = __ballot(shi);
                asm volatile("s_nop 3\n\tv_writelane_b32 %0, %2, %4\n\tv_writelane_b32 %1, %3, %4" : "+v"(mw0), "+v"(mw1) : "s"((unsigned)mlo), "s"((unsigned)(mlo >> 32)), "n"(2 * c));
                asm volatile("s_nop 3\n\tv_writelane_b32 %0, %2, %4\n\tv_writelane_b32 %1, %3, %4" : "+v"(mw0), "+v"(mw1) : "s"((unsigned)mhi), "s"((unsigned)(mhi >> 32)), "n"(2 * c + 1)); }
        }
    }
    if (lane < 2 * nc) MASK[lane] = ((unsigned long long)mw1 << 32) | mw0;
}

typedef float f32x16 __attribute__((ext_vector_type(16)));
typedef short s16x4 __attribute__((ext_vector_type(4)));
__device__ __forceinline__ int crow(int r, int hi) { return (r & 3) + 8 * (r >> 2) + 4 * hi; }
__device__ __forceinline__ s16x4 vtr(const LAS unsigned char* p) { return __builtin_bit_cast(s16x4, __builtin_amdgcn_ds_read_tr16_b64_v4i16((LAS s16x4*)p)); }
constexpr size_t WS_OAB = 358 * MiB;
constexpr int AT_ROWB = 144, AT_TILE = 64 * AT_ROWB;
constexpr int AT_VROWB = 192, AT_VTILE = 64 * AT_VROWB;
constexpr float LOG2E = 1.4426950408889634f;
constexpr float ATHR = 8.f;
__device__ __forceinline__ int sext_bit(unsigned w, int c) { int r; asm("v_bfe_i32 %0, %1, %2, 1" : "=v"(r) : "v"(w), "n"(c)); return r; }
__device__ __forceinline__ void attn_s(const LAS unsigned char* Kb, const LAS float* BT, const bf16x8 (&qr)[4], unsigned long long mword, bool far, bool first, int dist0,
                                       int r32, int hh, f32x16& o0, f32x16& o1, f32x16& o2, f32x16& nmB, float& mref, u32x4 (&pk)[4]) {
    f32x16 p0, p1;
#pragma unroll
    for (int ks = 0; ks < 4; ++ks) {
        const bf16x8 k0 = *(const LAS bf16x8*)(Kb + r32 * AT_ROWB + 32 * ks + 16 * hh);
        const bf16x8 k1 = *(const LAS bf16x8*)(Kb + (32 + r32) * AT_ROWB + 32 * ks + 16 * hh);
        if (ks == 0) { p0 = __builtin_amdgcn_mfma_f32_32x32x16_bf16(k0, qr[0], nmB, 0, 0, 0); p1 = __builtin_amdgcn_mfma_f32_32x32x16_bf16(k1, qr[0], nmB, 0, 0, 0); }
        else { p0 = __builtin_amdgcn_mfma_f32_32x32x16_bf16(k0, qr[ks], p0, 0, 0, 0); p1 = __builtin_amdgcn_mfma_f32_32x32x16_bf16(k1, qr[ks], p1, 0, 0, 0); }
    }
    if (!far) {
        const LAS float* bp = BT + (96 - 27 - 32) + dist0;
#pragma unroll
        for (int i = 0; i < 16; ++i) { const int c = (i & 3) + 8 * (i >> 2); p0[i] += bp[32 + 27 - c]; p1[i] += bp[27 - c]; }
    }
    float m0 = __builtin_fmaxf(__builtin_fmaxf(p0[0], p0[1]), p0[2]), m1 = __builtin_fmaxf(__builtin_fmaxf(p1[0], p1[1]), p1[2]);
#pragma unroll
    for (int i = 3; i < 15; i += 2) { m0 = __builtin_fmaxf(__builtin_fmaxf(m0, p0[i]), p0[i + 1]); m1 = __builtin_fmaxf(__builtin_fmaxf(m1, p1[i]), p1[i + 1]); }
    float mx = __builtin_fmaxf(__builtin_fmaxf(m0, m1), __builtin_fmaxf(p0[15], p1[15]));
    { const auto rr = __builtin_amdgcn_permlane32_swap(__float_as_uint(mx), __float_as_uint(mx), false, false); mx = __builtin_fmaxf(__uint_as_float(rr[0]), __uint_as_float(rr[1])); }
    if (first || __any(mx > ATHR)) {
        const float dl = (first || mx > ATHR) ? mx : 0.f; mref += dl; const float f = __builtin_amdgcn_exp2f(-dl);
#pragma unroll
        for (int i = 0; i < 16; ++i) { p0[i] -= dl; p1[i] -= dl; nmB[i] -= dl; o0[i] *= f; o1[i] *= f; o2[i] *= f; }
    }
    const unsigned wl = (unsigned)mword >> (4 * hh), wh = (unsigned)(mword >> 32) >> (4 * hh);
#pragma unroll
    for (int i = 0; i < 16; ++i) { const int c = (i & 3) + 8 * (i >> 2);
        p0[i] = __uint_as_float(__float_as_uint(__builtin_amdgcn_exp2f(p0[i])) & (unsigned)sext_bit(wl, c));
        p1[i] = __uint_as_float(__float_as_uint(__builtin_amdgcn_exp2f(p1[i])) & (unsigned)sext_bit(wh, c)); }
#pragma unroll
    for (int s2 = 0; s2 < 2; ++s2) {
        pk[s2].x = cvtpk_s(p0[8 * s2], p0[8 * s2 + 1]); pk[s2].y = cvtpk_s(p0[8 * s2 + 2], p0[8 * s2 + 3]); pk[s2].z = cvtpk_s(p0[8 * s2 + 4], p0[8 * s2 + 5]); pk[s2].w = cvtpk_s(p0[8 * s2 + 6], p0[8 * s2 + 7]);
        pk[2 + s2].x = cvtpk_s(p1[8 * s2], p1[8 * s2 + 1]); pk[2 + s2].y = cvtpk_s(p1[8 * s2 + 2], p1[8 * s2 + 3]); pk[2 + s2].z = cvtpk_s(p1[8 * s2 + 4], p1[8 * s2 + 5]); pk[2 + s2].w = cvtpk_s(p1[8 * s2 + 6], p1[8 * s2 + 7]); }
}
__device__ __forceinline__ void attn_pv(const LAS unsigned char* Vb, const u32x4 (&pk)[4], int voff, f32x16& o0, f32x16& o1, f32x16& o2) {
    const u32x4 onesw = (u32x4){0x3F803F80u, 0x3F803F80u, 0x3F803F80u, 0x3F803F80u}; const bf16x8 ones = __builtin_bit_cast(bf16x8, onesw);
#pragma unroll
    for (int q = 0; q < 4; ++q) {
        const bf16x8 pf = __builtin_bit_cast(bf16x8, pk[q]);
        const LAS unsigned char* vp = Vb + (16 * q) * AT_VROWB + voff;
        const s16x4 a0l = vtr(vp), a0h = vtr(vp + 8 * AT_VROWB), a1l = vtr(vp + 64), a1h = vtr(vp + 8 * AT_VROWB + 64);
        const bf16x8 va0 = (bf16x8){a0l[0], a0l[1], a0l[2], a0l[3], a0h[0], a0h[1], a0h[2], a0h[3]};
        const bf16x8 va1 = (bf16x8){a1l[0], a1l[1], a1l[2], a1l[3], a1h[0], a1h[1], a1h[2], a1h[3]};
        o0 = __builtin_amdgcn_mfma_f32_32x32x16_bf16(va0, pf, o0, 0, 0, 0);
        o1 = __builtin_amdgcn_mfma_f32_32x32x16_bf16(va1, pf, o1, 0, 0, 0);
        o2 = __builtin_amdgcn_mfma_f32_32x32x16_bf16(ones, pf, o2, 0, 0, 0);
    }
}
constexpr int AT_KB = 0, AT_VB = 2 * AT_TILE, AT_BT3 = AT_VB + 3 * AT_VTILE;
template <bool GB> __device__ __forceinline__ void attn_unit(int b, int h, int Q, const float* rel_bias, unsigned char* ws, LAS unsigned char* lds) {
    const int tid = threadIdx.x, lane = tid & 63, wave = __builtin_amdgcn_readfirstlane(tid >> 6), r32 = lane & 31, hh = lane >> 5;
    const size_t rowbase = (size_t)b * NS; const int t0w = 256 * Q + 32 * wave, t = t0w + r32;
    const bf16_t* QKV = (const bf16_t*)(ws + WS_QKV);
    LAS float* BT = (LAS float*)(lds + AT_BT3);
    const int NTL = 4 * (Q + 1);
    const int lastw = (t0w + 31) >> 6;
    const int srow = tid >> 3, sch = tid & 7;
    const bf16_t* kg = QKV + (rowbase + srow) * 1536 + 512 + h * 64 + sch * 8; const bf16_t* vg = kg + 512;
    const int soff = srow * AT_ROWB + sch * 16, svoff = srow * AT_VROWB + sch * 16;
    const unsigned long long* MK = (const unsigned long long*)(ws + WS_MASK) + (rowbase + t) * 64;
    const size_t tstride = (size_t)64 * 1536;
    u32x4 k0r = *(const u32x4*)kg, v0r = *(const u32x4*)vg;
    u32x4 kA = *(const u32x4*)(kg + tstride), vA = *(const u32x4*)(vg + tstride);
    u32x4 kB = *(const u32x4*)(kg + 2 * tstride), vB = *(const u32x4*)(vg + 2 * tstride);
    unsigned long long me = MK[0], mo = MK[(1 <= lastw) ? 1 : 0];
    bf16x8 qr[4];
#pragma unroll
    for (int ks = 0; ks < 4; ++ks) qr[ks] = *(const bf16x8*)(QKV + (rowbase + t) * 1536 + h * 64 + 16 * ks + 8 * hh);
    const float cB = rel_bias[31 * A_HEADS + h] * LOG2E;
    __syncthreads();
    if (tid < 352) { const int d = tid - 96; BT[tid] = rel_bias[v0_bucket(d < 0 ? 0 : d) * A_HEADS + h] * LOG2E - cB; }
    *(LAS u32x4*)(lds + AT_KB + soff) = k0r; *(LAS u32x4*)(lds + AT_VB + svoff) = v0r;
    f32x16 o0, o1, o2, nmB;
#pragma unroll
    for (int i = 0; i < 16; ++i) { o0[i] = 0.f; o1[i] = 0.f; o2[i] = 0.f; nmB[i] = cB; }
    float mref = 0.f;
    const int q4 = (lane & 15) >> 2, p4 = lane & 3, blk = (lane >> 4) & 1;
    const int voff = (4 * hh + q4) * AT_VROWB + (16 * blk + 4 * p4) * 2;
    u32x4 pk[4];
#pragma unroll
    for (int q = 0; q < 4; ++q) pk[q] = (u32x4){0u, 0u, 0u, 0u};
    int vcur = 0, vnext = AT_VTILE, vprev = 2 * AT_VTILE;
    for (int kt = 0; kt < NTL; kt += 2) {
        __syncthreads();
        *(LAS u32x4*)(lds + AT_KB + AT_TILE + soff) = kA; *(LAS u32x4*)(lds + AT_VB + vnext + svoff) = vA;
        { const int tn = (kt + 3 < NTL) ? kt + 3 : NTL - 1; kA = *(const u32x4*)(kg + (size_t)tn * tstride); vA = *(const u32x4*)(vg + (size_t)tn * tstride); }
        if (GB) { if (kt >= 1 && kt - 1 <= lastw) attn_pv(lds + AT_VB + vprev, pk, voff, o0, o1, o2); }
        if (kt <= lastw) attn_s(lds + AT_KB, BT, qr, me, (t0w - (64 * kt + 63) >= 113), kt == 0, t - 64 * kt - 4 * hh, r32, hh, o0, o1, o2, nmB, mref, pk);
        if (!GB) { if (kt <= lastw) attn_pv(lds + AT_VB + vcur, pk, voff, o0, o1, o2); }
        me = MK[(kt + 2 <= lastw) ? kt + 2 : lastw];
        { const int tmp = vprev; vprev = vcur; vcur = vnext; vnext = tmp; }
        __syncthreads();
        *(LAS u32x4*)(lds + AT_KB + soff) = kB; *(LAS u32x4*)(lds + AT_VB + vnext + svoff) = vB;
        { const int tn = (kt + 4 < NTL) ? kt + 4 : NTL - 1; kB = *(const u32x4*)(kg + (size_t)tn * tstride); vB = *(const u32x4*)(vg + (size_t)tn * tstride); }
        if (GB) { if (kt <= lastw) attn_pv(lds + AT_VB + vprev, pk, voff, o0, o1, o2); }
        if (kt + 1 <= lastw) attn_s(lds + AT_KB + AT_TILE, BT, qr, mo, (t0w - (64 * (kt + 1) + 63) >= 113), false, t - 64 * (kt + 1) - 4 * hh, r32, hh, o0, o1, o2, nmB, mref, pk);
        if (!GB) { if (kt + 1 <= lastw) attn_pv(lds + AT_VB + vcur, pk, voff, o0, o1, o2); }
        mo = MK[(kt + 3 <= lastw) ? kt + 3 : lastw];
        { const int tmp = vprev; vprev = vcur; vcur = vnext; vnext = tmp; }
    }
    if (GB) {
        if (NTL - 1 <= lastw) attn_pv(lds + AT_VB + vprev, pk, voff, o0, o1, o2);
    }
    const float inv = 1.f / o2[0];
    bf16_t* O = (bf16_t*)(ws + WS_OAB) + (rowbase + t) * 1024 + h * 64 + 4 * hh;
#pragma unroll
    for (int g = 0; g < 4; ++g) {
        u32x2 w0, w1; w0.x = cvtpk_s(o0[4 * g] * inv, o0[4 * g + 1] * inv); w0.y = cvtpk_s(o0[4 * g + 2] * inv, o0[4 * g + 3] * inv);
        w1.x = cvtpk_s(o1[4 * g] * inv, o1[4 * g + 1] * inv); w1.y = cvtpk_s(o1[4 * g + 2] * inv, o1[4 * g + 3] * inv);
        *(u32x2*)(O + 8 * g) = w0; *(u32x2*)(O + 32 + 8 * g) = w1;
    }
}

constexpr int GL_LG = 0, GL_SEG = 16384, GL_A = 18432, GL_B = GL_A + 9216, GL_C = GL_B + 9216, GL_VT = GL_C + 9216, GL_ST = GL_VT + 18432;
constexpr int GROWB = 144;
constexpr int GLA_ITEMS = NB * G_HEADS * 64;
__device__ __forceinline__ void gla_cumdecay(const u32x4 g0, const u32x4 g1, int h, const float* wg, const float* bg, LAS unsigned char* lds, float* lgc) {
    const int tid = threadIdx.x; LAS float* LG = (LAS float*)(lds + GL_LG); LAS float* SEG = (LAS float*)(lds + GL_SEG);
    {   const int c = tid >> 3, dg = tid & 7; float gl[16];
#pragma unroll
        for (int j = 0; j < 4; ++j) { gl[2 * j] = __uint_as_float(g0[j] << 16); gl[2 * j + 1] = __uint_as_float(g0[j] & 0xffff0000u); gl[8 + 2 * j] = __uint_as_float(g1[j] << 16); gl[8 + 2 * j + 1] = __uint_as_float(g1[j] & 0xffff0000u); }
        float z[8];
#pragma unroll
        for (int j = 0; j < 8; ++j) z[j] = bg[h * 64 + 8 * dg + j];
#pragma unroll
        for (int r = 0; r < 16; ++r) { const f32x4 w0 = *(const f32x4*)(wg + r * G_KW + h * 64 + 8 * dg), w1 = *(const f32x4*)(wg + r * G_KW + h * 64 + 8 * dg + 4);
            z[0] += gl[r] * w0[0]; z[1] += gl[r] * w0[1]; z[2] += gl[r] * w0[2]; z[3] += gl[r] * w0[3]; z[4] += gl[r] * w1[0]; z[5] += gl[r] * w1[1]; z[6] += gl[r] * w1[2]; z[7] += gl[r] * w1[3]; }
#pragma unroll
        for (int j = 0; j < 8; ++j) z[j] = (fminf(z[j], 0.f) - log1pf(__expf(-fabsf(z[j])))) * (1.f / 16.f);
        *(LAS f32x4*)(LG + c * 64 + 8 * dg) = (f32x4){z[0], z[1], z[2], z[3]}; *(LAS f32x4*)(LG + c * 64 + 8 * dg + 4) = (f32x4){z[4], z[5], z[6], z[7]};
    }
    __syncthreads();
    const int seg = tid >> 6, d = tid & 63; float v[8];
#pragma unroll
    for (int i = 0; i < 8; ++i) v[i] = LG[(8 * seg + i) * 64 + d];
#pragma unroll
    for (int i = 1; i < 8; ++i) v[i] += v[i - 1];
    SEG[seg * 64 + d] = v[7];
    __syncthreads();
    float off = 0.f;
#pragma unroll
    for (int s2 = 0; s2 < 8; ++s2) if (s2 < seg) off += SEG[s2 * 64 + d];
#pragma unroll
    for (int i = 0; i < 8; ++i) { const float bv = v[i] + off; LG[(8 * seg + i) * 64 + d] = bv; lgc[(8 * seg + i) * 64 + d] = bv; }
    __syncthreads();
}
__device__ __forceinline__ unsigned short f2bf_s(float f) { return (unsigned short)(cvtpk_s(f, 0.f) & 0xffffu); }
__device__ __forceinline__ void gla_stage_vt(const u32x4 a, const u32x4 b2, LAS unsigned char* lds) {
    const int tid = threadIdx.x, c = tid >> 3, d0 = (tid & 7) * 16;
#pragma unroll
    for (int j = 0; j < 4; ++j) {
        *(LAS unsigned short*)(lds + GL_VT + (d0 + 2 * j) * GROWB + c * 2) = (unsigned short)(a[j] & 0xffffu); *(LAS unsigned short*)(lds + GL_VT + (d0 + 2 * j + 1) * GROWB + c * 2) = (unsigned short)(a[j] >> 16);
        *(LAS unsigned short*)(lds + GL_VT + (d0 + 8 + 2 * j) * GROWB + c * 2) = (unsigned short)(b2[j] & 0xffffu); *(LAS unsigned short*)(lds + GL_VT + (d0 + 8 + 2 * j + 1) * GROWB + c * 2) = (unsigned short)(b2[j] >> 16); }
}
__device__ __forceinline__ void p3b_item(int it, const float* wg, const float* bg, float* UT, float* LGC, unsigned char* ws, LAS unsigned char* lds) {
    const int tid = threadIdx.x, lane = tid & 63, wave = tid >> 6, fr = lane & 15, fq = lane >> 4;
    const int bh = it >> 6, n = it & 63, b = bh >> 2, h = bh & 3; const size_t r0 = (size_t)b * NS + 64 * n;
    const int c_ = tid >> 3, dg_ = tid & 7;
    const bf16_t* gp_ = (const bf16_t*)(ws + WS_GLR) + (r0 + c_) * 16; const u32x4 g0 = *(const u32x4*)gp_, g1 = *(const u32x4*)(gp_ + 8);
    const u32x4 kraw = *(const u32x4*)((const bf16_t*)(ws + WS_GQK) + (r0 + c_) * 512 + 256 + h * 64 + 8 * dg_);
    const bf16_t* vp_ = (const bf16_t*)(ws + WS_GV) + (r0 + c_) * 512 + h * 128 + dg_ * 16; const u32x4 va_ = *(const u32x4*)vp_, vb_ = *(const u32x4*)(vp_ + 8);
    __syncthreads();
    gla_cumdecay(g0, g1, h, wg, bg, lds, LGC + (size_t)it * 4096);
    const LAS float* LG = (const LAS float*)(lds + GL_LG);
    {   const int c = tid >> 3, dg = tid & 7; float kf[8]; bf8_to_f(kraw, kf);
#pragma unroll
        for (int j = 0; j < 8; ++j) { const int d = 8 * dg + j; *(LAS unsigned short*)(lds + GL_A + d * GROWB + c * 2) = f2bf_s(kf[j] * __expf(LG[63 * 64 + d] - LG[c * 64 + d])); }
        if (tid < 64) ((float*)(ws + WS_MISC))[(size_t)it * 64 + tid] = __expf(LG[63 * 64 + tid]);
    }
    gla_stage_vt(va_, vb_, lds);
    __syncthreads();
    f32x4 acc[4];
#pragma unroll
    for (int i = 0; i < 4; ++i) acc[i] = (f32x4){0.f, 0.f, 0.f, 0.f};
#pragma unroll
    for (int ks = 0; ks < 2; ++ks) { const bf16x8 bv = *(const LAS bf16x8*)(lds + GL_VT + (16 * wave + fr) * GROWB + (32 * ks + 8 * fq) * 2);
#pragma unroll
        for (int i = 0; i < 4; ++i) { const bf16x8 av = *(const LAS bf16x8*)(lds + GL_A + (16 * i + fr) * GROWB + (32 * ks + 8 * fq) * 2); acc[i] = __builtin_amdgcn_mfma_f32_16x16x32_bf16(av, bv, acc[i], 0, 0, 0); } }
#pragma unroll
    for (int i = 0; i < 4; ++i) *(f32x4*)(UT + ((size_t)it * 128 + 16 * wave + fr) * 64 + 16 * i + 4 * fq) = acc[i];
}
__device__ __forceinline__ void p4b_item(int j, const float* UT, bf16_t* SP, unsigned char* ws) {
    const int tid = threadIdx.x, bh = j >> 3, dv = (j & 7) * 16 + (tid >> 5), dk = (tid & 31) * 2; const float* DEC = (const float*)(ws + WS_MISC);
    typedef float f32x2v __attribute__((ext_vector_type(2)));
    f32x2v st = (f32x2v){0.f, 0.f};
#pragma unroll 8
    for (int n = 0; n < 64; ++n) { const size_t it = (size_t)bh * 64 + n; const size_t o = (it * 128 + dv) * 64 + dk;
        *(unsigned*)(SP + o) = cvtpk_s(st[0], st[1]);
        const f32x2v u = *(const f32x2v*)(UT + o), dc = *(const f32x2v*)(DEC + it * 64 + dk); st = dc * st + u; }
}
__device__ __forceinline__ void p5b_item(int it, const float* LGC, const float* ng, const bf16_t* SP, unsigned char* ws, LAS unsigned char* lds) {
    const int tid = threadIdx.x, lane = tid & 63, wave = tid >> 6, r32 = lane & 31, hh = lane >> 5;
    const int bh = it >> 6, n = it & 63, b = bh >> 2, h = bh & 3; const size_t r0 = (size_t)b * NS + 64 * n;
    const int c_ = tid >> 3, dg_ = tid & 7; const int dvb = wave >> 1, cb = wave & 1;
    const f32x4 lg0 = *(const f32x4*)(LGC + (size_t)it * 4096 + c_ * 64 + 8 * dg_), lg1 = *(const f32x4*)(LGC + (size_t)it * 4096 + c_ * 64 + 8 * dg_ + 4);
    const bf16_t* qp_ = (const bf16_t*)(ws + WS_GQK) + (r0 + c_) * 512 + h * 64 + 8 * dg_; const u32x4 qraw = *(const u32x4*)qp_, kraw = *(const u32x4*)(qp_ + 256);
    const bf16_t* vp_ = (const bf16_t*)(ws + WS_GV) + (r0 + c_) * 512 + h * 128 + dg_ * 16; const u32x4 va_ = *(const u32x4*)vp_, vb_ = *(const u32x4*)(vp_ + 8);
    bf16x8 spf[4];
#pragma unroll
    for (int ks = 0; ks < 4; ++ks) spf[ks] = *(const bf16x8*)(SP + ((size_t)it * 128 + 32 * dvb + r32) * 64 + 16 * ks + 8 * hh);
    const size_t trow = r0 + 32 * cb + r32; const int dvbase = h * 128 + 32 * dvb + 4 * hh;
    const bf16_t* grp = (const bf16_t*)(ws + WS_GR) + trow * 512 + dvbase; u32x2 grw[4];
#pragma unroll
    for (int g = 0; g < 4; ++g) grw[g] = *(const u32x2*)(grp + 8 * g);
    __syncthreads();
    { LAS float* LGw = (LAS float*)(lds + GL_LG); *(LAS f32x4*)(LGw + c_ * 64 + 8 * dg_) = lg0; *(LAS f32x4*)(LGw + c_ * 64 + 8 * dg_ + 4) = lg1; }
    __syncthreads();
    const LAS float* LG = (const LAS float*)(lds + GL_LG);
    {   const int c = tid >> 3, dg = tid & 7; float qf[8], kf[8]; bf8_to_f(qraw, qf); bf8_to_f(kraw, kf);
        float qr[8], ks[8], qi[8];
#pragma unroll
        for (int j = 0; j < 8; ++j) { const int d = 8 * dg + j; const float bc = LG[c * 64 + d], bl = LG[63 * 64 + d]; const float q8 = qf[j] * 0.125f;
            qr[j] = q8 * __expf(bc - bl); ks[j] = kf[j] * __expf(bl - bc); qi[j] = q8 * __expf(bc); }
        u32x4 w;
        w.x = cvtpk_s(qr[0], qr[1]); w.y = cvtpk_s(qr[2], qr[3]); w.z = cvtpk_s(qr[4], qr[5]); w.w = cvtpk_s(qr[6], qr[7]); *(LAS u32x4*)(lds + GL_A + c * GROWB + 16 * dg) = w;
        w.x = cvtpk_s(ks[0], ks[1]); w.y = cvtpk_s(ks[2], ks[3]); w.z = cvtpk_s(ks[4], ks[5]); w.w = cvtpk_s(ks[6], ks[7]); *(LAS u32x4*)(lds + GL_B + c * GROWB + 16 * dg) = w;
        w.x = cvtpk_s(qi[0], qi[1]); w.y = cvtpk_s(qi[2], qi[3]); w.z = cvtpk_s(qi[4], qi[5]); w.w = cvtpk_s(qi[6], qi[7]); *(LAS u32x4*)(lds + GL_C + c * GROWB + 16 * dg) = w;
    }
    gla_stage_vt(va_, vb_, lds);
    __syncthreads();
    f32x16 o;
#pragma unroll
    for (int i = 0; i < 16; ++i) o[i] = 0.f;
#pragma unroll
    for (int jb = 0; jb < 2; ++jb) if (jb <= cb) {
        f32x16 at;
#pragma unroll
        for (int i = 0; i < 16; ++i) at[i] = 0.f;
#pragma unroll
        for (int ks = 0; ks < 4; ++ks) { const bf16x8 av = *(const LAS bf16x8*)(lds + GL_B + (32 * jb + r32) * GROWB + 32 * ks + 16 * hh), bv = *(const LAS bf16x8*)(lds + GL_A + (32 * cb + r32) * GROWB + 32 * ks + 16 * hh);
            at = __builtin_amdgcn_mfma_f32_32x32x16_bf16(av, bv, at, 0, 0, 0); }
        if (jb == cb) {
#pragma unroll
            for (int i = 0; i < 16; ++i) if (crow(i, hh) > r32) at[i] = 0.f; }
#pragma unroll
        for (int s = 0; s < 2; ++s) {
            u32x4 pw; pw.x = cvtpk_s(at[8 * s], at[8 * s + 1]); pw.y = cvtpk_s(at[8 * s + 2], at[8 * s + 3]); pw.z = cvtpk_s(at[8 * s + 4], at[8 * s + 5]); pw.w = cvtpk_s(at[8 * s + 6], at[8 * s + 7]);
            const LAS unsigned char* vp = lds + GL_VT + (32 * dvb + r32) * GROWB + (32 * jb + 16 * s + 4 * hh) * 2;
            const u32x2 lo = *(const LAS u32x2*)vp, hi = *(const LAS u32x2*)(vp + 16);
            const u32x4 va = (u32x4){lo.x, lo.y, hi.x, hi.y};
            o = __builtin_amdgcn_mfma_f32_32x32x16_bf16(__builtin_bit_cast(bf16x8, va), __builtin_bit_cast(bf16x8, pw), o, 0, 0, 0);
        }
    }
#pragma unroll
    for (int ks = 0; ks < 4; ++ks) { const bf16x8 bv = *(const LAS bf16x8*)(lds + GL_C + (32 * cb + r32) * GROWB + 32 * ks + 16 * hh);
        o = __builtin_amdgcn_mfma_f32_32x32x16_bf16(spf[ks], bv, o, 0, 0, 0); }
    LAS float* ST = (LAS float*)(lds + GL_ST);
    float sm = 0.f;
#pragma unroll
    for (int i = 0; i < 16; ++i) sm += o[i];
    sm += __shfl_xor(sm, 32);
    if (hh == 0) ST[dvb * 64 + 32 * cb + r32] = sm;
    __syncthreads();
    const float mean = (ST[32 * cb + r32] + ST[64 + 32 * cb + r32] + ST[128 + 32 * cb + r32] + ST[192 + 32 * cb + r32]) * (1.f / 128.f);
    float sq = 0.f;
#pragma unroll
    for (int i = 0; i < 16; ++i) { o[i] -= mean; sq += o[i] * o[i]; }
    sq += __shfl_xor(sq, 32);
    if (hh == 0) ST[256 + dvb * 64 + 32 * cb + r32] = sq;
    __syncthreads();
    const float var = (ST[256 + 32 * cb + r32] + ST[256 + 64 + 32 * cb + r32] + ST[256 + 128 + 32 * cb + r32] + ST[256 + 192 + 32 * cb + r32]) * (1.f / 128.f);
    const float rstd = 1.f / sqrtf(var + LN_EPS);
    bf16_t* op = (bf16_t*)(ws + WS_OAB) + trow * 1024 + 512 + dvbase;
#pragma unroll
    for (int g = 0; g < 4; ++g) { const u32x2 gw = grw[g]; const f32x4 nv = *(const f32x4*)(ng + dvbase + 8 * g);
        float gr[4] = {__uint_as_float(gw.x << 16), __uint_as_float(gw.x & 0xffff0000u), __uint_as_float(gw.y << 16), __uint_as_float(gw.y & 0xffff0000u)}; float y[4];
#pragma unroll
        for (int e = 0; e < 4; ++e) y[e] = o[4 * g + e] * rstd * nv[e] * (gr[e] * __builtin_amdgcn_rcpf(1.f + __expf(-gr[e])));
        u32x2 w; w.x = cvtpk_s(y[0], y[1]); w.y = cvtpk_s(y[2], y[3]); *(u32x2*)(op + 8 * g) = w; }
}

constexpr int GL_HALF = 67584;
__device__ __forceinline__ void gla_cumdecay2(size_t r0, int h, const bf16_t* WGT, const float* bg, unsigned char* ws, LAS unsigned char* ldh, float* lgc) {
    const int tl = threadIdx.x & 255, lane = threadIdx.x & 63, wl = (threadIdx.x >> 6) & 3, r32 = lane & 31, hh = lane >> 5; LAS float* LG = (LAS float*)(ldh + GL_LG); LAS float* SEG = (LAS float*)(ldh + GL_SEG);
    {   const int cb = wl >> 1, db = wl & 1;
        const bf16x8 af = *(const bf16x8*)((const bf16_t*)(ws + WS_GLR) + (r0 + 32 * cb + r32) * 16 + 8 * hh), bfr = *(const bf16x8*)(WGT + (size_t)(h * 64 + 32 * db + r32) * 16 + 8 * hh);
        const float bias = bg[h * 64 + 32 * db + r32]; f32x16 z;
#pragma unroll
        for (int i = 0; i < 16; ++i) z[i] = bias;
        z = __builtin_amdgcn_mfma_f32_32x32x16_bf16(af, bfr, z, 0, 0, 0);
#pragma unroll
        for (int i = 0; i < 16; ++i) { const float zz = z[i]; LG[(32 * cb + crow(i, hh)) * 64 + 32 * db + r32] = (fminf(zz, 0.f) - __logf(1.f + __expf(-fabsf(zz)))) * (1.f / 16.f); }
    }
    __syncthreads();
    const int seg = tl >> 6, d = tl & 63; float v[16];
#pragma unroll
    for (int i = 0; i < 16; ++i) v[i] = LG[(16 * seg + i) * 64 + d];
#pragma unroll
    for (int i = 1; i < 16; ++i) v[i] += v[i - 1];
    SEG[seg * 64 + d] = v[15];
    __syncthreads();
    float off = 0.f;
#pragma unroll
    for (int s2 = 0; s2 < 4; ++s2) if (s2 < seg) off += SEG[s2 * 64 + d];
#pragma unroll
    for (int i = 0; i < 16; ++i) { const float bv = v[i] + off; LG[(16 * seg + i) * 64 + d] = bv; lgc[(16 * seg + i) * 64 + d] = bv; }
    __syncthreads();
}
__device__ __forceinline__ void gla_stage_vt2(const u32x4 (&vv)[4], LAS unsigned char* ldh) {
    const int tl = threadIdx.x & 255, c = tl >> 2, d0 = (tl & 3) * 32;
#pragma unroll
    for (int k = 0; k < 4; ++k)
#pragma unroll
        for (int j = 0; j < 4; ++j) {
            *(LAS unsigned short*)(ldh + GL_VT + (d0 + 8 * k + 2 * j) * GROWB + c * 2) = (unsigned short)(vv[k][j] & 0xffffu);
            *(LAS unsigned short*)(ldh + GL_VT + (d0 + 8 * k + 2 * j + 1) * GROWB + c * 2) = (unsigned short)(vv[k][j] >> 16); }
}
__device__ __forceinline__ void p3b_pair(int p, const float* wg, const float* bg, float* UT, float* LGC, unsigned char* ws, LAS unsigned char* lds) {
    const int tid = threadIdx.x, hb = tid >> 8, tl = tid & 255, lane = tid & 63, wl = (tid >> 6) & 3, fr = lane & 15, fq = lane >> 4;
    const int it = 2 * p + hb; LAS unsigned char* ldh = lds + hb * GL_HALF;
    const int bh = it >> 6, n = it & 63, b = bh >> 2, h = bh & 3; const size_t r0 = (size_t)b * NS + 64 * n;
    const int c_ = tl >> 2, dq_ = tl & 3;
    const bf16_t* kp_ = (const bf16_t*)(ws + WS_GQK) + (r0 + c_) * 512 + 256 + h * 64 + 16 * dq_; const u32x4 k0 = *(const u32x4*)kp_, k1 = *(const u32x4*)(kp_ + 8);
    const bf16_t* vp_ = (const bf16_t*)(ws + WS_GV) + (r0 + c_) * 512 + h * 128 + 32 * dq_; u32x4 vv[4];
#pragma unroll
    for (int k = 0; k < 4; ++k) vv[k] = *(const u32x4*)(vp_ + 8 * k);
    __syncthreads();
    gla_cumdecay2(r0, h, (const bf16_t*)(ws + WS_WGT), bg, ws, ldh, LGC + (size_t)it * 4096);
    const LAS float* LG = (const LAS float*)(ldh + GL_LG);
    {   float kf[16]; bf8_to_f(k0, kf); bf8_to_f(k1, kf + 8);
#pragma unroll
        for (int j = 0; j < 16; ++j) { const int d = 16 * dq_ + j; *(LAS unsigned short*)(ldh + GL_A + d * GROWB + c_ * 2) = f2bf_s(kf[j] * __expf(LG[63 * 64 + d] - LG[c_ * 64 + d])); }
        if (tl < 64) ((float*)(ws + WS_MISC))[(size_t)it * 64 + tl] = __expf(LG[63 * 64 + tl]);
    }
    gla_stage_vt2(vv, ldh);
    __syncthreads();
#pragma unroll
    for (int dvi = 0; dvi < 2; ++dvi) {
        const int dvblk = 2 * wl + dvi;
        f32x4 acc[4];
#pragma unroll
        for (int i = 0; i < 4; ++i) acc[i] = (f32x4){0.f, 0.f, 0.f, 0.f};
#pragma unroll
        for (int ks = 0; ks < 2; ++ks) { const bf16x8 bv = *(const LAS bf16x8*)(ldh + GL_VT + (16 * dvblk + fr) * GROWB + (32 * ks + 8 * fq) * 2);
#pragma unroll
            for (int i = 0; i < 4; ++i) { const bf16x8 av = *(const LAS bf16x8*)(ldh + GL_A + (16 * i + fr) * GROWB + (32 * ks + 8 * fq) * 2); acc[i] = __builtin_amdgcn_mfma_f32_16x16x32_bf16(av, bv, acc[i], 0, 0, 0); } }
#pragma unroll
        for (int i = 0; i < 4; ++i) *(f32x4*)(UT + ((size_t)it * 128 + 16 * dvblk + fr) * 64 + 16 * i + 4 * fq) = acc[i];
    }
}
__device__ __forceinline__ void p5b_pair(int p, const float* LGC, const float* ng, const bf16_t* SP, unsigned char* ws, LAS unsigned char* lds) {
    const int tid = threadIdx.x, hb = tid >> 8, tl = tid & 255, lane = tid & 63, wl = (tid >> 6) & 3, r32 = lane & 31, hh = lane >> 5;
    const int it = 2 * p + hb; LAS unsigned char* ldh = lds + hb * GL_HALF;
    const int bh = it >> 6, n = it & 63, b = bh >> 2, h = bh & 3; const size_t r0 = (size_t)b * NS + 64 * n;
    const int c_ = tl >> 2, dq_ = tl & 3; const int dvb = wl;
    f32x4 lg[4];
#pragma unroll
    for (int k = 0; k < 4; ++k) lg[k] = *(const f32x4*)(LGC + (size_t)it * 4096 + c_ * 64 + 16 * dq_ + 4 * k);
    const bf16_t* qp_ = (const bf16_t*)(ws + WS_GQK) + (r0 + c_) * 512 + h * 64 + 16 * dq_; const u32x4 q0 = *(const u32x4*)qp_, q1 = *(const u32x4*)(qp_ + 8), k0 = *(const u32x4*)(qp_ + 256), k1 = *(const u32x4*)(qp_ + 264);
    const bf16_t* vp_ = (const bf16_t*)(ws + WS_GV) + (r0 + c_) * 512 + h * 128 + 32 * dq_; u32x4 vv[4];
#pragma unroll
    for (int k = 0; k < 4; ++k) vv[k] = *(const u32x4*)(vp_ + 8 * k);
    bf16x8 spf[4];
#pragma unroll
    for (int ks = 0; ks < 4; ++ks) spf[ks] = *(const bf16x8*)(SP + ((size_t)it * 128 + 32 * dvb + r32) * 64 + 16 * ks + 8 * hh);
    const int dvbase = h * 128 + 32 * dvb + 4 * hh; u32x2 grw[2][4];
#pragma unroll
    for (int cb = 0; cb < 2; ++cb)
#pragma unroll
        for (int g = 0; g < 4; ++g) grw[cb][g] = *(const u32x2*)((const bf16_t*)(ws + WS_GR) + (r0 + 32 * cb + r32) * 512 + dvbase + 8 * g);
    __syncthreads();
    { LAS float* LGw = (LAS float*)(ldh + GL_LG);
#pragma unroll
      for (int k = 0; k < 4; ++k) *(LAS f32x4*)(LGw + c_ * 64 + 16 * dq_ + 4 * k) = lg[k]; }
    __syncthreads();
    const LAS float* LG = (const LAS float*)(ldh + GL_LG);
    {   float qf[16], kf[16]; bf8_to_f(q0, qf); bf8_to_f(q1, qf + 8); bf8_to_f(k0, kf); bf8_to_f(k1, kf + 8);
        float qr[16], ks[16], qi[16];
#pragma unroll
        for (int j = 0; j < 16; ++j) { const int d = 16 * dq_ + j; const float bc = LG[c_ * 64 + d], bl = LG[63 * 64 + d]; const float q8 = qf[j] * 0.125f;
            qr[j] = q8 * __expf(bc - bl); ks[j] = kf[j] * __expf(bl - bc); qi[j] = q8 * __expf(bc); }
#pragma unroll
        for (int k = 0; k < 2; ++k) { u32x4 w;
            w.x = cvtpk_s(qr[8 * k], qr[8 * k + 1]); w.y = cvtpk_s(qr[8 * k + 2], qr[8 * k + 3]); w.z = cvtpk_s(qr[8 * k + 4], qr[8 * k + 5]); w.w = cvtpk_s(qr[8 * k + 6], qr[8 * k + 7]); *(LAS u32x4*)(ldh + GL_A + c_ * GROWB + 32 * dq_ + 16 * k) = w;
            w.x = cvtpk_s(ks[8 * k], ks[8 * k + 1]); w.y = cvtpk_s(ks[8 * k + 2], ks[8 * k + 3]); w.z = cvtpk_s(ks[8 * k + 4], ks[8 * k + 5]); w.w = cvtpk_s(ks[8 * k + 6], ks[8 * k + 7]); *(LAS u32x4*)(ldh + GL_B + c_ * GROWB + 32 * dq_ + 16 * k) = w;
            w.x = cvtpk_s(qi[8 * k], qi[8 * k + 1]); w.y = cvtpk_s(qi[8 * k + 2], qi[8 * k + 3]); w.z = cvtpk_s(qi[8 * k + 4], qi[8 * k + 5]); w.w = cvtpk_s(qi[8 * k + 6], qi[8 * k + 7]); *(LAS u32x4*)(ldh + GL_C + c_ * GROWB + 32 * dq_ + 16 * k) = w; }
    }
    gla_stage_vt2(vv, ldh);
    __syncthreads();
    f32x16 o[2];
#pragma unroll
    for (int cb = 0; cb < 2; ++cb) {
#pragma unroll
        for (int i = 0; i < 16; ++i) o[cb][i] = 0.f;
#pragma unroll
        for (int jb = 0; jb < 2; ++jb) if (jb <= cb) {
            f32x16 at;
#pragma unroll
            for (int i = 0; i < 16; ++i) at[i] = 0.f;
#pragma unroll
            for (int ks = 0; ks < 4; ++ks) { const bf16x8 av = *(const LAS bf16x8*)(ldh + GL_B + (32 * jb + r32) * GROWB + 32 * ks + 16 * hh), bv = *(const LAS bf16x8*)(ldh + GL_A + (32 * cb + r32) * GROWB + 32 * ks + 16 * hh);
                at = __builtin_amdgcn_mfma_f32_32x32x16_bf16(av, bv, at, 0, 0, 0); }
            if (jb == cb) {
#pragma unroll
                for (int i = 0; i < 16; ++i) if (crow(i, hh) > r32) at[i] = 0.f; }
#pragma unroll
            for (int s2 = 0; s2 < 2; ++s2) {
                u32x4 pw; pw.x = cvtpk_s(at[8 * s2], at[8 * s2 + 1]); pw.y = cvtpk_s(at[8 * s2 + 2], at[8 * s2 + 3]); pw.z = cvtpk_s(at[8 * s2 + 4], at[8 * s2 + 5]); pw.w = cvtpk_s(at[8 * s2 + 6], at[8 * s2 + 7]);
                const LAS unsigned char* vp = ldh + GL_VT + (32 * dvb + r32) * GROWB + (32 * jb + 16 * s2 + 4 * hh) * 2;
                const u32x2 lo = *(const LAS u32x2*)vp, hi = *(const LAS u32x2*)(vp + 16);
                const u32x4 va = (u32x4){lo.x, lo.y, hi.x, hi.y};
                o[cb] = __builtin_amdgcn_mfma_f32_32x32x16_bf16(__builtin_bit_cast(bf16x8, va), __builtin_bit_cast(bf16x8, pw), o[cb], 0, 0, 0);
            }
        }
#pragma unroll
        for (int ks = 0; ks < 4; ++ks) { const bf16x8 bv = *(const LAS bf16x8*)(ldh + GL_C + (32 * cb + r32) * GROWB + 32 * ks + 16 * hh);
            o[cb] = __builtin_amdgcn_mfma_f32_32x32x16_bf16(spf[ks], bv, o[cb], 0, 0, 0); }
    }
    LAS float* ST = (LAS float*)(ldh + GL_ST);
#pragma unroll
    for (int cb = 0; cb < 2; ++cb) { float sm = 0.f;
#pragma unroll
        for (int i = 0; i < 16; ++i) sm += o[cb][i];
        sm += __shfl_xor(sm, 32);
        if (hh == 0) ST[dvb * 64 + 32 * cb + r32] = sm; }
    __syncthreads();
    float mean[2];
#pragma unroll
    for (int cb = 0; cb < 2; ++cb) { const int cc = 32 * cb + r32; mean[cb] = (ST[cc] + ST[64 + cc] + ST[128 + cc] + ST[192 + cc]) * (1.f / 128.f); float sq = 0.f;
#pragma unroll
        for (int i = 0; i < 16; ++i) { o[cb][i] -= mean[cb]; sq += o[cb][i] * o[cb][i]; }
        sq += __shfl_xor(sq, 32);
        if (hh == 0) ST[256 + dvb * 64 + cc] = sq; }
    __syncthreads();
#pragma unroll
    for (int cb = 0; cb < 2; ++cb) { const int cc = 32 * cb + r32; const float var = (ST[256 + cc] + ST[256 + 64 + cc] + ST[256 + 128 + cc] + ST[256 + 192 + cc]) * (1.f / 128.f);
        const float rstd = 1.f / sqrtf(var + LN_EPS);
        bf16_t* op = (bf16_t*)(ws + WS_OAB) + (r0 + cc) * 1024 + 512 + dvbase;
#pragma unroll
        for (int g = 0; g < 4; ++g) { const u32x2 gw = grw[cb][g]; const f32x4 nv = *(const f32x4*)(ng + dvbase + 8 * g);
            float gr[4] = {__uint_as_float(gw.x << 16), __uint_as_float(gw.x & 0xffff0000u), __uint_as_float(gw.y << 16), __uint_as_float(gw.y & 0xffff0000u)}; float y[4];
#pragma unroll
            for (int e = 0; e < 4; ++e) y[e] = o[cb][4 * g + e] * rstd * nv[e] * (gr[e] * __builtin_amdgcn_rcpf(1.f + __expf(-gr[e])));
            u32x2 w; w.x = cvtpk_s(y[0], y[1]); w.y = cvtpk_s(y[2], y[3]); *(u32x2*)(op + 8 * g) = w; } }
}

constexpr size_t WS_SG = 129 * MiB;
constexpr size_t WS_MRG = 257 * MiB;
constexpr size_t WS_H2 = WS_XN;
constexpr size_t WS_XG = 129 * MiB;
constexpr size_t WS_HID = 321 * MiB;
constexpr size_t WS_YG = 358 * MiB;
constexpr size_t WS_EID = WS_MISC + 1 * MiB, WS_EW = WS_EID + 256 * 1024, WS_POS = WS_EW + 256 * 1024, WS_ST1 = WS_POS + 256 * 1024;
constexpr size_t WS_LIST = 490 * MiB;
constexpr int LDS_TAB = 131072;
__device__ __forceinline__ u32x4 pack8(const f32x4 a, const f32x4 b) { u32x4 w; w.x = cvtpk_s(a[0], a[1]); w.y = cvtpk_s(a[2], a[3]); w.z = cvtpk_s(b[0], b[1]); w.w = cvtpk_s(b[2], b[3]); return w; }
__device__ __forceinline__ f32x4 sig4(const f32x4 v) { f32x4 r; r[0] = __builtin_amdgcn_rcpf(1.f + __expf(-v[0])); r[1] = __builtin_amdgcn_rcpf(1.f + __expf(-v[1])); r[2] = __builtin_amdgcn_rcpf(1.f + __expf(-v[2])); r[3] = __builtin_amdgcn_rcpf(1.f + __expf(-v[3])); return r; }
__device__ __forceinline__ void unpack8(const u32x4 w, f32x4& a, f32x4& b) {
    a[0] = __uint_as_float(w.x << 16); a[1] = __uint_as_float(w.x & 0xffff0000u); a[2] = __uint_as_float(w.y << 16); a[3] = __uint_as_float(w.y & 0xffff0000u);
    b[0] = __uint_as_float(w.z << 16); b[1] = __uint_as_float(w.z & 0xffff0000u); b[2] = __uint_as_float(w.w << 16); b[3] = __uint_as_float(w.w & 0xffff0000u);
}
#define EPI_ROWS(...) _Pragma("unroll") for (int ai = 0; ai < 2; ++ai) _Pragma("unroll") for (int m = 0; m < 4; ++m) { const size_t row = (size_t)(row0 + ai * 128 + m * 16); _Pragma("unroll") for (int bj = 0; bj < 2; ++bj) { __VA_ARGS__ } }
struct EpiSig {
    static constexpr bool PERM = true, AFTER_DRAIN = false, MID = false; unsigned char* ws; int half;
    __device__ __forceinline__ void operator()(const f32x4 (&acc)[2][2][4][2], const Unit& u, int wr, int wc, int fr, int fq) const {
        const int row0 = u.pm * 256 + wr * 64 + fr, col0 = half * 1024 + u.pn * 256 + wc * 32 + 8 * fq; bf16_t* SG = (bf16_t*)(ws + WS_SG);
        EPI_ROWS( *(u32x4*)(SG + row * 2048 + col0 + bj * 128) = pack8(sig4(acc[ai][bj][m][0]), sig4(acc[ai][bj][m][1])); )
    }
};
struct EpiMrgF {
    static constexpr bool PERM = true, AFTER_DRAIN = false, MID = true; unsigned char* ws;
    __device__ __forceinline__ void mid(f32x4 (&acc)[2][2][4][2], const Unit& u, int wr, int wc, int fr, int fq) const {
        const int row0 = u.pm * 256 + wr * 64 + fr, col0 = u.pn * 256 + wc * 32 + 8 * fq; const bf16_t* SG = (const bf16_t*)(ws + WS_SG);
        const bf16_t* p = SG + (size_t)row0 * 2048 + col0;
#pragma unroll
        for (int ai = 0; ai < 2; ++ai)
#pragma unroll
            for (int m = 0; m < 4; ++m) {
                asm volatile("" : "+v"(p));
#pragma unroll
                for (int bj = 0; bj < 2; ++bj) { f32x4 a0, a1, b0, b1; unpack8(*(const u32x4*)(p + bj * 128), a0, a1); unpack8(*(const u32x4*)(p + 1024 + bj * 128), b0, b1);
#pragma unroll
                    for (int e = 0; e < 4; ++e) { acc[ai][bj][m][0][e] *= a0[e] * __builtin_amdgcn_rcpf(fmaxf(b0[e], 1e-30f)); acc[ai][bj][m][1][e] *= a1[e] * __builtin_amdgcn_rcpf(fmaxf(b1[e], 1e-30f)); } }
                p += (m == 3 ? (128 - 48) : 16) * 2048; }
    }
    __device__ __forceinline__ void operator()(const f32x4 (&acc)[2][2][4][2], const Unit& u, int wr, int wc, int fr, int fq) const {
        const int row0 = u.pm * 256 + wr * 64 + fr, col0 = u.pn * 256 + wc * 32 + 8 * fq; const bf16_t* SG = (const bf16_t*)(ws + WS_SG) + 1024; bf16_t* MR = (bf16_t*)(ws + WS_MRG);
        EPI_ROWS( f32x4 g0, g1; unpack8(*(const u32x4*)(SG + row * 2048 + col0 + bj * 128), g0, g1); *(u32x4*)(MR + row * 1024 + col0 + bj * 128) = pack8(g0 * acc[ai][bj][m][0], g1 * acc[ai][bj][m][1]); )
    }
};
struct EpiV {
    static constexpr bool PERM = false, AFTER_DRAIN = false, MID = false; const float* x; const float* ada; float* out;
    __device__ __forceinline__ void operator()(const f32x4 (&acc)[2][2][4][2], const Unit& u, int wr, int wc, int fr, int fq) const {
        const int row0 = u.pm * 256 + wr * 64 + fr, col0 = u.pn * 256 + wc * 32 + 4 * fq; const float* gt1 = ada + (size_t)(u.pm >> 4) * 6 * D_MODEL + 2 * D_MODEL;
        EPI_ROWS( _Pragma("unroll") for (int n = 0; n < 2; ++n) { const int c = col0 + bj * 128 + n * 16; const f32x4 xv = *(const f32x4*)(x + row * D_MODEL + c), gv = *(const f32x4*)(gt1 + c);
                  *(f32x4*)(out + row * D_MODEL + c) = xv * DN_ALPHA + gv * acc[ai][bj][m][n]; } )
    }
};
struct EpiHid {
    static constexpr bool PERM = true, AFTER_DRAIN = false, MID = false; unsigned char* ws;
    __device__ __forceinline__ void operator()(const f32x4 (&acc)[2][2][4][2], const Unit& u, int wr, int wc, int fr, int fq) const {
        const int row0 = u.pm * 256 + wr * 64 + fr, col0 = u.pn * 128 + wc * 32 + 8 * fq; bf16_t* H = (bf16_t*)(ws + WS_HID);
#pragma unroll
        for (int ai = 0; ai < 2; ++ai)
#pragma unroll
            for (int m = 0; m < 4; ++m) { const size_t row = (size_t)(row0 + ai * 128 + m * 16); f32x4 h0, h1;
#pragma unroll
                for (int e = 0; e < 4; ++e) { const float g0 = acc[ai][0][m][0][e], g1 = acc[ai][0][m][1][e]; h0[e] = g0 * __builtin_amdgcn_rcpf(1.f + __expf(-g0)) * acc[ai][1][m][0][e]; h1[e] = g1 * __builtin_amdgcn_rcpf(1.f + __expf(-g1)) * acc[ai][1][m][1][e]; }
                *(u32x4*)(H + row * 256 + col0) = pack8(h0, h1); }
    }
};
struct EpiY {
    static constexpr bool PERM = true, AFTER_DRAIN = false, MID = false; unsigned char* ws;
    __device__ __forceinline__ void operator()(const f32x4 (&acc)[2][2][4][2], const Unit& u, int wr, int wc, int fr, int fq) const {
        const int row0 = u.pm * 256 + wr * 64 + fr, col0 = u.pn * 256 + wc * 32 + 8 * fq; bf16_t* Y = (bf16_t*)(ws + WS_YG);
        EPI_ROWS( *(u32x4*)(Y + row * 1024 + col0 + bj * 128) = pack8(acc[ai][bj][m][0], acc[ai][bj][m][1]); )
    }
};
__device__ __forceinline__ void build_tables(unsigned char* ws, LAS unsigned char* lds) {
    LAS int* toff = (LAS int*)(lds + LDS_TAB); LAS int* texp = toff + 64; const unsigned* gcnt = (const unsigned*)(ws + WS_CNT);
    __syncthreads();
    if (threadIdx.x == 0) { int o = 0; for (int e = 0; e < N_EXP; ++e) { toff[e] = o; const int ce = (int)gcnt[e * 32]; toff[400 + e] = ce; o += (ce + 255) >> 8; } toff[32] = o; }
    __syncthreads();
    for (int tl = threadIdx.x; tl < toff[32]; tl += NTHREADS) { int e = 0; while (toff[e + 1] <= tl) ++e; texp[tl] = e; }
    __syncthreads();
}
template <int NPN> struct GroupOrder {
    const LAS int* toff; const LAS int* texp; int G, c;
    __device__ __forceinline__ bool next(int i, Unit& u) const { const int L = i * G + c; if (L >= toff[32] * NPN) return false; const int tl = L / NPN, pn = L % NPN; u.pm = tl; u.pa = tl; u.pn = pn; u.pb = texp[tl] * NPN + pn; return true; }
    __device__ __forceinline__ void a_ready(const Unit&) const {}
    __device__ __forceinline__ void done(const Unit&) const {}
    const int* list;
    __device__ __forceinline__ int a_row(const Unit& u, int r) const { const int e = texp[u.pa]; const int idx = (u.pa - toff[e]) * 256 + r; return idx < toff[400 + e] ? list[e * 32768 + idx] : 0; }
};
constexpr int WT_LD = 1028;
constexpr int P8_LCNT = 36 * WT_LD * 4;
__device__ __forceinline__ float dot16(const f32x4 (&v)[4], const LAS float* wp, int lane) {
    float p = 0.f;
#pragma unroll
    for (int j = 0; j < 4; ++j) { const f32x4 w4 = *(const LAS f32x4*)(wp + 256 * j + 4 * lane); p += (v[j].x * w4.x + v[j].y * w4.y) + (v[j].z * w4.z + v[j].w * w4.w); }
    return p;
}
__device__ __forceinline__ float rl4sum(float v) {
    return (__int_as_float(__builtin_amdgcn_readlane(__float_as_int(v), 0)) + __int_as_float(__builtin_amdgcn_readlane(__float_as_int(v), 16)))
         + (__int_as_float(__builtin_amdgcn_readlane(__float_as_int(v), 32)) + __int_as_float(__builtin_amdgcn_readlane(__float_as_int(v), 48)));
}
template <bool REAL> __device__ __forceinline__ void p8_phase(const float* const* in, float* out, float* x1dst, bf16_t* h2dst, unsigned char* ws, LAS unsigned char* lds, int G) {
    const int tid = threadIdx.x, lane = tid & 63, wave = tid >> 6;
    LAS float* WT = (LAS float*)lds;
    LAS int* lcnt = (LAS int*)(lds + P8_LCNT); LAS int* lbase = lcnt + 32; LAS int* ent = lcnt + 64;
    const float* wrg = in[14]; const float* wre = in[16];
    __syncthreads();
    for (int i = tid; i < 1024; i += NTHREADS) { const f32x4 w = *(const f32x4*)(wrg + 4 * i); WT[0 * WT_LD + i] = w.x; WT[1 * WT_LD + i] = w.y; WT[2 * WT_LD + i] = w.z; WT[3 * WT_LD + i] = w.w; }
    for (int i = tid; i < 8192; i += NTHREADS) { const f32x4 w = *(const f32x4*)(wre + 4 * i); const int k = i >> 3, c = 4 * (i & 7);
        WT[(4 + c) * WT_LD + k] = w.x; WT[(5 + c) * WT_LD + k] = w.y; WT[(6 + c) * WT_LD + k] = w.z; WT[(7 + c) * WT_LD + k] = w.w; }
    const float* g1 = in[12]; const float* b1 = in[13]; const float* brg = in[15]; const float* bre = in[17];
    for (int blk = blockIdx.x; blk < NT / 128; blk += G) {
        const int b = blk / 32; const float* ada = (const float*)(ws + WS_ADA) + (size_t)b * 6 * D_MODEL; const float* sh2 = ada + 3 * D_MODEL; const float* sc2 = ada + 4 * D_MODEL;
        if (tid < 32) lcnt[tid] = 0;
        __syncthreads();
        for (int rb = 0; rb < 16; rb += 4) {
            const int rl0 = wave * 16 + rb; const size_t row0 = (size_t)blk * 128 + rl0;
            f32x4 v[4][4];
#pragma unroll
            for (int r = 0; r < 4; ++r) { const f32x4* xr = (const f32x4*)(out + (row0 + r) * D_MODEL) + lane;
#pragma unroll
                for (int j = 0; j < 4; ++j) v[r][j] = xr[64 * j]; }
            float rstd[4], mean1[4]; ln_center<4>(v, rstd, mean1);
            if (REAL && lane < 4) { typedef float f32x2v __attribute__((ext_vector_type(2))); ((f32x2v*)(ws + WS_ST1))[row0 + lane] = (f32x2v){lane == 0 ? mean1[0] : lane == 1 ? mean1[1] : lane == 2 ? mean1[2] : mean1[3], lane == 0 ? rstd[0] : lane == 1 ? rstd[1] : lane == 2 ? rstd[2] : rstd[3]}; }
#pragma unroll
            for (int j = 0; j < 4; ++j) { const f32x4 gg = *(const f32x4*)(g1 + 256 * j + 4 * lane), bb = *(const f32x4*)(b1 + 256 * j + 4 * lane);
#pragma unroll
                for (int r = 0; r < 4; ++r) v[r][j] = v[r][j] * rstd[r] * gg + bb; }
            ln_center<4>(v, rstd);
#pragma unroll
            for (int j = 0; j < 4; ++j) { const f32x4 a4 = *(const f32x4*)(sc2 + 256 * j + 4 * lane) + 1.f, c4 = *(const f32x4*)(sh2 + 256 * j + 4 * lane);
#pragma unroll
                for (int r = 0; r < 4; ++r) { v[r][j] = v[r][j] * rstd[r] * a4 + c4; u32x2 w; w.x = cvtpk_s(v[r][j].x, v[r][j].y); w.y = cvtpk_s(v[r][j].z, v[r][j].w);
                    ((u32x2*)(h2dst + (row0 + r) * D_MODEL) + lane)[64 * j] = w; } }
#pragma unroll
            for (int r = 0; r < 4; ++r) {
                float gp[N_GROUPS];
#pragma unroll
                for (int g = 0; g < N_GROUPS; ++g) gp[g] = dpp_row_sum_f(dot16(v[r], WT + g * WT_LD, lane));
                float gl[N_GROUPS];
#pragma unroll
                for (int g = 0; g < N_GROUPS; ++g) gl[g] = rl4sum(gp[g]) + brg[g];
                int gi = 0; float gm = gl[0];
#pragma unroll
                for (int g = 1; g < N_GROUPS; ++g) if (gl[g] > gm) { gm = gl[g]; gi = g; }
                float gs = 0.f;
#pragma unroll
                for (int g = 0; g < N_GROUPS; ++g) gs += __expf(gl[g] - gm);
                const float gw = 1.f / gs;
                float ep[EPG];
#pragma unroll
                for (int e = 0; e < EPG; ++e) ep[e] = dpp_row_sum_f(dot16(v[r], WT + (4 + gi * EPG + e) * WT_LD, lane));
                float v0 = -INFINITY, v1 = -INFINITY; int i0 = 0, i1 = 0;
#pragma unroll
                for (int e = 0; e < EPG; ++e) { const float ev = rl4sum(ep[e]) + bre[gi * EPG + e];
                    if (ev > v0) { v1 = v0; i1 = i0; v0 = ev; i0 = e; } else if (ev > v1) { v1 = ev; i1 = e; } }
                const float e1 = __expf(v1 - v0); const float w0 = gw / (1.f + e1), w1 = gw * e1 / (1.f + e1);
                if (REAL && lane == 0) { const int ea = gi * EPG + i0, eb = gi * EPG + i1; const int rl = rl0 + r; const size_t row = row0 + r;
                    const int pa = atomicAdd((int*)&lcnt[ea], 1), pb = atomicAdd((int*)&lcnt[eb], 1);
                    ent[rl * 2] = (ea << 16) | pa; ent[rl * 2 + 1] = (eb << 16) | pb;
                    ((int*)(ws + WS_EID))[row * 2] = ea; ((int*)(ws + WS_EID))[row * 2 + 1] = eb; ((float*)(ws + WS_EW))[row * 2] = w0; ((float*)(ws + WS_EW))[row * 2 + 1] = w1; }
            }
        }
        __syncthreads();
        if (REAL && tid < 32) lbase[tid] = (int)atomicAdd((unsigned*)(ws + WS_CNT) + tid * 32, (unsigned)lcnt[tid]);
        __syncthreads();
        if (REAL && tid < 256) { const int en = ent[tid]; const int e = en >> 16, pos = lbase[e] + (en & 0xffff); ((int*)(ws + WS_POS))[(size_t)blk * 256 + tid] = pos; ((int*)(ws + WS_LIST))[e * 32768 + pos] = blk * 128 + (tid >> 1); }
        __syncthreads();
    }
}
__device__ __forceinline__ void p9_phase(unsigned char* ws, LAS unsigned char* lds, int G) {
    build_tables(ws, lds); const LAS int* toff = (const LAS int*)(lds + LDS_TAB);
    const int lane = threadIdx.x & 63, wave = threadIdx.x >> 6;
    for (int base = (blockIdx.x * NWAVES + wave) * 32; base < NT * 2; base += G * NWAVES * 32) {
        for (int k = 0; k < 32; k += 4) {
            const int ts0 = base + k; const int li = ts0 + (lane & 3);
            const int ev = ((const int*)(ws + WS_EID))[li], pv = ((const int*)(ws + WS_POS))[li];
            u32x4 d0[4], d1[4]; size_t dst[4];
#pragma unroll
            for (int r = 0; r < 4; ++r) { const int e = __builtin_amdgcn_readlane(ev, r), pos = __builtin_amdgcn_readlane(pv, r); dst[r] = (size_t)toff[e] * 256 + pos;
                const u32x4* sp = (const u32x4*)((const bf16_t*)(ws + WS_H2) + (size_t)((ts0 + r) >> 1) * D_MODEL); d0[r] = sp[lane]; d1[r] = sp[lane + 64]; }
#pragma unroll
            for (int r = 0; r < 4; ++r) { u32x4* dp = (u32x4*)((bf16_t*)(ws + WS_XG) + dst[r] * D_MODEL); dp[lane] = d0[r]; dp[lane + 64] = d1[r]; }
        }
    }
}
__device__ __forceinline__ void p12_phase(const float* const* in, float* out, float* dst, unsigned char* ws, LAS unsigned char* lds, int G) {
    build_tables(ws, lds); const LAS int* toff = (const LAS int*)(lds + LDS_TAB);
    const int lane = threadIdx.x & 63, wave = threadIdx.x >> 6; const float* g2 = in[21]; const float* b2 = in[22]; const float* g1 = in[12]; const float* b1 = in[13];
    for (int blk = blockIdx.x; blk < NT / 128; blk += G) {
        const int b = blk / 32; const float* gt2 = (const float*)(ws + WS_ADA) + (size_t)b * 6 * D_MODEL + 5 * D_MODEL;
        for (int rb = 0; rb < 16; rb += 4) {
            const size_t row0 = (size_t)blk * 128 + wave * 16 + rb;
            const size_t li = row0 * 2 + (lane & 7);
            const int ev = ((const int*)(ws + WS_EID))[li], pv = ((const int*)(ws + WS_POS))[li]; const float wv = ((const float*)(ws + WS_EW))[li];
            typedef float f32x2v __attribute__((ext_vector_type(2))); const f32x2v stv = ((const f32x2v*)(ws + WS_ST1))[row0 + (lane & 3)];
            f32x4 v[4][4]; u32x2 ya[4][4], yb[4][4]; float w0[4], w1[4], m1[4], r1[4];
#pragma unroll
            for (int r = 0; r < 4; ++r) {
                const int e0 = __builtin_amdgcn_readlane(ev, 2 * r), e1 = __builtin_amdgcn_readlane(ev, 2 * r + 1), p0 = __builtin_amdgcn_readlane(pv, 2 * r), p1 = __builtin_amdgcn_readlane(pv, 2 * r + 1);
                w0[r] = __int_as_float(__builtin_amdgcn_readlane(__float_as_int(wv), 2 * r)); w1[r] = __int_as_float(__builtin_amdgcn_readlane(__float_as_int(wv), 2 * r + 1));
                m1[r] = __int_as_float(__builtin_amdgcn_readlane(__float_as_int(stv.x), r)); r1[r] = __int_as_float(__builtin_amdgcn_readlane(__float_as_int(stv.y), r));
                const u32x2* y0 = (const u32x2*)((const bf16_t*)(ws + WS_YG) + ((size_t)toff[e0] * 256 + p0) * D_MODEL) + lane; const u32x2* y1 = (const u32x2*)((const bf16_t*)(ws + WS_YG) + ((size_t)toff[e1] * 256 + p1) * D_MODEL) + lane;
                const f32x4* xr = (const f32x4*)(out + (row0 + r) * D_MODEL) + lane;
#pragma unroll
                for (int j = 0; j < 4; ++j) { v[r][j] = xr[64 * j]; ya[r][j] = y0[64 * j]; yb[r][j] = y1[64 * j]; } }
#pragma unroll
            for (int j = 0; j < 4; ++j) { const f32x4 gv = *(const f32x4*)(gt2 + 256 * j + 4 * lane), g1v = *(const f32x4*)(g1 + 256 * j + 4 * lane), b1v = *(const f32x4*)(b1 + 256 * j + 4 * lane);
#pragma unroll
                for (int r = 0; r < 4; ++r) { const u32x2 a = ya[r][j], c = yb[r][j]; f32x4 f; v[r][j] = (v[r][j] - m1[r]) * r1[r] * g1v + b1v;
                    f.x = w0[r] * __uint_as_float(a.x << 16) + w1[r] * __uint_as_float(c.x << 16); f.y = w0[r] * __uint_as_float(a.x & 0xffff0000u) + w1[r] * __uint_as_float(c.x & 0xffff0000u);
                    f.z = w0[r] * __uint_as_float(a.y << 16) + w1[r] * __uint_as_float(c.y << 16); f.w = w0[r] * __uint_as_float(a.y & 0xffff0000u) + w1[r] * __uint_as_float(c.y & 0xffff0000u);
                    v[r][j] = v[r][j] * DN_ALPHA + gv * f; } }
            float rstd[4]; ln_center<4>(v, rstd);
#pragma unroll
            for (int j = 0; j < 4; ++j) { const f32x4 gg = *(const f32x4*)(g2 + 256 * j + 4 * lane), bb = *(const f32x4*)(b2 + 256 * j + 4 * lane);
#pragma unroll
                for (int r = 0; r < 4; ++r) ((f32x4*)(dst + (row0 + r) * D_MODEL) + lane)[64 * j] = v[r][j] * rstd[r] * gg + bb; }
        }
    }
}

constexpr size_t WS_TS = 384 * 1024;
constexpr size_t WS_BAR = 320 * 1024;
#define RLX_AGENT __ATOMIC_RELAXED, __HIP_MEMORY_SCOPE_AGENT
#define XB_TMO      128
#define XB_XCNT(j)  (256  + 64 * (j))
#define XB_XSUB(j)  (1280 + 64 * (j))
#define XB_XGEN(j)  (2304 + 64 * (j))
#define XB_TOP      3328
#define XB_TOPGEN   3392
#define XCD_BAR_WORDS 3456
#define XB_SPIN_CAP (1u << 18)

__device__ __forceinline__ unsigned xb_ld(unsigned* p)              { return __hip_atomic_load(p, __ATOMIC_RELAXED, __HIP_MEMORY_SCOPE_AGENT); }
__device__ __forceinline__ unsigned xb_add(unsigned* p, unsigned v) { return __hip_atomic_fetch_add(p, v, __ATOMIC_RELAXED, __HIP_MEMORY_SCOPE_AGENT); }
__device__ __forceinline__ unsigned xb_xcc_id() { return (unsigned)__builtin_amdgcn_s_getreg((3 << 11) | 20) & 0xFu; }
#define XB_SPIN(cond, bar) do { unsigned _sp = 0; while (cond) { __builtin_amdgcn_s_sleep(1); \
    if ((++_sp & 255u) == 0u) { if (xb_ld(&(bar)[XB_TMO])) break; if (_sp > XB_SPIN_CAP) { atomicAdd(&(bar)[XB_TMO], 1u); break; } } } } while (0)

struct XcdBarrier {
    unsigned* bar; unsigned x;
    volatile LAS unsigned* st;
};

__device__ __forceinline__ XcdBarrier xcd_barrier_post(unsigned* bar, volatile LAS unsigned* st) {
    XcdBarrier b; b.bar = bar; b.x = xb_xcc_id(); b.st = st;
    if (threadIdx.x == 0) (void)xb_add(&bar[XB_XCNT(b.x)], 1u);
    return b;
}
__device__ __forceinline__ void xcd_barrier_complete(unsigned* bar, unsigned x, unsigned& nloc, unsigned& nx) {
    const unsigned G = gridDim.x * gridDim.y * gridDim.z;
    unsigned sum, cnt, mine, sp = 0u;
    for (;;) {
        sum = 0u; cnt = 0u; mine = 0u;
#pragma unroll
        for (unsigned j = 0; j < 16; ++j) { const unsigned c = xb_ld(&bar[XB_XCNT(j)]); sum += c; cnt += (c > 0u) ? 1u : 0u; mine = (j == x) ? c : mine; }
        if (sum == G) break;
        __builtin_amdgcn_s_sleep(1);
        if ((++sp & 255u) == 0u) { if (xb_ld(&bar[XB_TMO])) break; if (sp > XB_SPIN_CAP) { atomicAdd(&bar[XB_TMO], 1u); break; } }
    }
    nloc = mine > 0u ? mine : 1u; nx = cnt > 0u ? cnt : 1u;
}

__device__ __forceinline__ void xcd_barrier(const XcdBarrier& b) {
    asm volatile("s_waitcnt vmcnt(0)" ::: "memory");
    __syncthreads();
    if (threadIdx.x == 0) {
        unsigned* bar = b.bar;
        __builtin_amdgcn_s_waitcnt(0);
        unsigned nloc = b.st[0], nx = b.st[1];
        if (nloc == 0u) { xcd_barrier_complete(bar, b.x, nloc, nx); b.st[0] = nloc; b.st[1] = nx; }
        const unsigned old = xb_add(&bar[XB_XSUB(b.x)], 1u);
        const unsigned gen = old / nloc;
        if (old + 1u == (gen + 1u) * nloc) {
            __builtin_amdgcn_fence(__ATOMIC_RELEASE, "agent");
            asm volatile("s_waitcnt vmcnt(0)" ::: "memory");
            const unsigned og = xb_add(&bar[XB_TOP], 1u);
            const unsigned tg = og / nx;
            if (og + 1u == (tg + 1u) * nx) xb_add(&bar[XB_TOPGEN], 1u);
            else XB_SPIN(xb_ld(&bar[XB_TOPGEN]) == tg, bar);
            __builtin_amdgcn_fence(__ATOMIC_ACQUIRE, "agent");
            xb_add(&bar[XB_XGEN(b.x)], 1u);
            asm volatile("s_waitcnt vmcnt(0)" ::: "memory");
        } else {
            XB_SPIN(xb_ld(&bar[XB_XGEN(b.x)]) == gen, bar);
            __builtin_amdgcn_fence(__ATOMIC_ACQUIRE, "agent");
            asm volatile("s_waitcnt vmcnt(0)" ::: "memory");
        }
    }
    __syncthreads();
}

__device__ __forceinline__ int opaque_i(int v) {
#if DUPMASK_ON
    asm volatile("" : "+v"(v)); v = __builtin_amdgcn_readfirstlane(v);
#endif
    return v; }
constexpr int NPH = 14;
struct Args { const float* in[23]; float* out; unsigned char* ws; int ph_lo, ph_hi; };
__global__ void __launch_bounds__(NTHREADS, 2) mk_fwd(Args a) {
    extern __shared__ __attribute__((aligned(16))) unsigned char lds_raw[];
    LAS unsigned char* lds = (LAS unsigned char*)lds_raw;
    cg::grid_group grid = cg::this_grid();
    const int G = gridDim.x, tid = threadIdx.x, lane = tid & 63, wave = __builtin_amdgcn_readfirstlane(tid >> 6);
    const int lo = a.ph_lo, hi = a.ph_hi;
    unsigned char* ws = a.ws;
    volatile LAS unsigned* bst = (volatile LAS unsigned*)(lds + LDS_BYTES - 16);
    if (tid < 4) bst[tid] = 0u;
    __syncthreads();
    XcdBarrier bar = xcd_barrier_post((unsigned*)(ws + WS_BAR), bst);
    if (TSTAMP && blockIdx.x == 0 && tid == 0) ((unsigned long long*)(ws + WS_TS))[0] = __builtin_amdgcn_s_memrealtime();
    if (a.ph_hi > NPH) grid.sync();
#ifndef PHMASK
#define PHMASK 0xFFFF
#endif
#define IN(k) (((PHMASK >> (k)) & 1) && lo <= (k) && (k) < hi)
#define GRIDBAR() do { if (USE_CG_SYNC) grid.sync(); else xcd_barrier(bar); } while (0)
#define SEAM(k) do { if (IN(k) && IN((k) + 1)) GRIDBAR(); if (TSTAMP && blockIdx.x == 0 && tid == 0) ((unsigned long long*)(ws + WS_TS))[(k) + 1] = __builtin_amdgcn_s_memrealtime(); } while (0)
#define PH(k) for (int rep_ = 0; rep_ < (IN(k) ? 1 + ((DUPMASK >> (k)) & 1) : 0); ++rep_) if (rep_ > 0 && (xcd_barrier(bar), false)) {} else
    PH(0) {
        if (blockIdx.x == 0 && tid < 32) ((unsigned*)(ws + WS_CNT))[tid * 32] = 0u;
        if (blockIdx.x == 1 && tid < 256) { const float* wgp = a.in[6] + tid; u32x4 w0, w1;
            w0.x = cvtpk_s(wgp[0], wgp[256]); w0.y = cvtpk_s(wgp[512], wgp[768]); w0.z = cvtpk_s(wgp[1024], wgp[1280]); w0.w = cvtpk_s(wgp[1536], wgp[1792]);
            w1.x = cvtpk_s(wgp[2048], wgp[2304]); w1.y = cvtpk_s(wgp[2560], wgp[2816]); w1.z = cvtpk_s(wgp[3072], wgp[3328]); w1.w = cvtpk_s(wgp[3584], wgp[3840]);
            u32x4* dst = (u32x4*)((bf16_t*)(ws + WS_WGT) + tid * 16); dst[0] = w0; dst[1] = w1; }
        LAS float* scr = (LAS float*)(lds + wave * 16384);
        for (int it = blockIdx.x * NWAVES + wave; it < P0_ITEMS; it += G * NWAVES) p0_item(it, a.in, ws, scr, lane);
    }
    SEAM(0);
    PH(1) p1_phase(a.in, ws, lds, G);
    SEAM(1);
    PH(2) {
        pg8::Gemm g{(const bf16_t*)(ws + WS_XN), (const bf16_t*)(ws + WS_WIN), NT, NPROJ, D_MODEL}; pg8::StaticOrder S; S.init(NT, NPROJ, G, (int)blockIdx.x);
        EpiProj E{ws};
        pg8::gemm_phase<EpiProj, pg8::StaticOrder, PG8_ALIGN, PG8_SP2>(lds, g, S, E);
#ifdef DUP_P2
        xcd_barrier(bar);
        pg8::gemm_phase<EpiProj, pg8::StaticOrder, PG8_ALIGN, PG8_SP2>(lds, g, S, E);
#endif
    }
    SEAM(2);
    PH(3) {
        for (int u = blockIdx.x; u < 256; u += G) { const int p = u >> 1, b = p >> 4, qi = p & 15, qj = 31 - qi; LAS unsigned char* lw = lds + wave * 17408;
            for (int rep = 0; rep < ((DUPSUB & 1) ? 2 : 1); ++rep) {
                if ((u & 1) == 0) { p3a_run(b, qi, 0, qi, ws, lw, wave, lane); p3a_run(b, qj, 0, 15 - qi, ws, lw, wave, lane); }
                else p3a_run(b, qj, 16 - qi, qj, ws, lw, wave, lane); } }
        for (int p = blockIdx.x; p < GLA_ITEMS / 2; p += G) { p3b_pair(p, a.in[6], a.in[7], a.out, a.out + 24 * MiB, ws, lds); if (DUPSUB & 2) p3b_pair(p, a.in[6], a.in[7], a.out, a.out + 24 * MiB, ws, lds); }
    }
    SEAM(3);
    PH(4) {
        for (int j = blockIdx.x; j < 256; j += G) { p4b_item(j, a.out, (bf16_t*)(a.out + 16 * MiB), ws); if (DUPSUB & 8) p4b_item(j, a.out, (bf16_t*)(a.out + 16 * MiB), ws); }
        {
            const int W = blockIdx.x * NWAVES + wave;
            unsigned xa[32], xb[32], ga = 0u, gb = 0u;
            p4a_load(W, ws, lane, xa);
#pragma unroll 1
            for (int bb = 0; bb < NB; ++bb) {
                const int r0 = bb * NS + W, r1 = bb * NS + (NS - 1 - W), r2 = ((bb + 1 < NB) ? bb + 1 : bb) * NS + W;
                p4a_load(r1, ws, lane, xb);
                p4a_row(r0, ws, lane, xa, ga); if (DUPSUB & 4) p4a_row(r0, ws, lane, xa, ga);
                p4a_load(r2, ws, lane, xa);
                p4a_row(r1, ws, lane, xb, gb); if (DUPSUB & 4) p4a_row(r1, ws, lane, xb, gb);
            }
        }
    }
    SEAM(4);
    PH(5) {
        const int c = blockIdx.x; const int bh = c >> 2, sx = c & 3;
        for (int p = blockIdx.x; p < GLA_ITEMS / 2; p += G) { p5b_pair(p, a.out + 24 * MiB, a.in[8], (const bf16_t*)(a.out + 16 * MiB), ws, lds); if (DUPSUB & 32) p5b_pair(p, a.out + 24 * MiB, a.in[8], (const bf16_t*)(a.out + 16 * MiB), ws, lds); }
        if (c < 256) for (int i = 0; i < 4; ++i) { const int Q = (i == 0) ? sx : (i == 1) ? 7 - sx : (i == 2) ? 8 + sx : 15 - sx; if (wave < 4) attn_unit<false>(bh >> 3, bh & 7, Q, a.in[2], ws, lds); else attn_unit<true>(bh >> 3, bh & 7, Q, a.in[2], ws, lds);
            if (DUPSUB & 16) { if (wave < 4) attn_unit<false>(bh >> 3, bh & 7, Q, a.in[2], ws, lds); else attn_unit<true>(bh >> 3, bh & 7, Q, a.in[2], ws, lds); } }
    }
    SEAM(5);
    PH(6) {
        pg8::StaticOrder S; S.init(NT, D_MODEL, G, (int)blockIdx.x);
        { pg8::Gemm g{(const bf16_t*)(ws + WS_XN), (const bf16_t*)(ws + WS_WGAB), NT, D_MODEL, D_MODEL}; EpiSig E{ws, 0}; pg8::gemm_phase<EpiSig, pg8::StaticOrder, PG8_ALIGN, PG8_SP2>(lds, g, S, E); }
        { pg8::Gemm g{(const bf16_t*)(ws + WS_XN), (const bf16_t*)(ws + WS_WGAB) + (size_t)1024 * 1024, NT, D_MODEL, D_MODEL}; EpiSig E{ws, 1}; pg8::gemm_phase<EpiSig, pg8::StaticOrder, PG8_ALIGN, PG8_SP2>(lds, g, S, E); }
        { pg8::Gemm g{(const bf16_t*)(ws + WS_OAB), (const bf16_t*)(ws + WS_WBA), NT, D_MODEL, D_MODEL}; EpiMrgF E{ws}; pg8::gemm_phase<EpiMrgF, pg8::StaticOrder, PG8_ALIGN, PG8_SP2>(lds, g, S, E); }
    }
    SEAM(7);
    PH(8) {
        pg8::Gemm g{(const bf16_t*)(ws + WS_MRG), (const bf16_t*)(ws + WS_WOUT), NT, D_MODEL, D_MODEL}; pg8::StaticOrder S; S.init(NT, D_MODEL, G, (int)blockIdx.x);
        EpiV E{a.in[0], (const float*)(ws + WS_ADA), a.out}; pg8::gemm_phase<EpiV, pg8::StaticOrder, PG8_ALIGN, PG8_SP2>(lds, g, S, E);
    }
    SEAM(8);
#ifdef DUP_P8
    p8_phase<false>(a.in, a.out, (float*)(ws + 129 * MiB), (bf16_t*)(ws + 260 * MiB), ws, lds, G); xcd_barrier(bar);
#endif
    PH(9) p8_phase<true>(a.in, a.out, a.out, (bf16_t*)(ws + WS_H2), ws, lds, G);
    if (IN(9) && IN(11)) { GRIDBAR(); if (TSTAMP && blockIdx.x == 0 && tid == 0) ((unsigned long long*)(ws + WS_TS))[10] = __builtin_amdgcn_s_memrealtime(); }
    PH(11) {
        build_tables(ws, lds);
        pg8::Gemm g{(const bf16_t*)(ws + WS_H2), (const bf16_t*)(ws + WS_W13), 0, 0, D_MODEL}; GroupOrder<2> S{(const LAS int*)(lds + LDS_TAB), (const LAS int*)(lds + LDS_TAB) + 64, G, (int)blockIdx.x, (const int*)(ws + WS_LIST)};
        EpiHid E{ws}; pg8::gemm_phase<EpiHid, GroupOrder<2>, PG8_ALIGN, PG8_SP2, true>(lds, g, S, E);
    }
    SEAM(11);
    PH(12) {
        build_tables(ws, lds);
        int kd = D_EXP; asm volatile("" : "+s"(kd));
        pg8::Gemm g{(const bf16_t*)(ws + WS_HID), (const bf16_t*)(ws + WS_W2), 0, 0, kd}; GroupOrder<4> S{(const LAS int*)(lds + LDS_TAB), (const LAS int*)(lds + LDS_TAB) + 64, G, (int)blockIdx.x, nullptr};
        EpiY E{ws}; pg8::gemm_phase<EpiY, GroupOrder<4>, PG8_ALIGN, PG8_SP2>(lds, g, S, E);
    }
    SEAM(12);
#ifdef DUP_P12
    p12_phase(a.in, a.out, (float*)(ws + 129 * MiB), ws, lds, G); xcd_barrier(bar);
#endif
    PH(13) p12_phase(a.in, a.out, a.out, ws, lds, G);
    if (TSTAMP) { xcd_barrier(bar); if (blockIdx.x == 0 && tid == 0) ((unsigned long long*)(ws + WS_TS))[14] = __builtin_amdgcn_s_memrealtime(); }
#ifdef EXTRA_SYNCS
    for (int i_ = 0; i_ < EXTRA_SYNCS; ++i_) GRIDBAR();
#endif
#undef IN
#undef SEAM
#undef PH
}
}
#if TSTAMP
__global__ void kd_ts(float* out, long n, const unsigned long long* ts, int ka, int kb) {
    const float da = (ka == 14) ? (float)(ts[14] - ts[0]) * 0.01f / 10.f : (float)(ts[ka + 1] - ts[ka]) * 0.01f;
    const float sc = 1.f + da * 0.0005f;
    for (long i = (long)blockIdx.x * blockDim.x + threadIdx.x; i < n; i += (long)gridDim.x * blockDim.x) out[i] *= sc;
}
#endif
extern "C" void kernel_launch(void* const* d_in, const int* in_sizes, int n_in, void* d_out, int out_size,
                              void* d_ws, size_t ws_size, hipStream_t stream) {
    using namespace fk;
    static int grid = 0;
    if (grid == 0) {
        int dev = 0, cus = 0, per_cu = 0; (void)hipGetDevice(&dev); (void)hipDeviceGetAttribute(&cus, hipDeviceAttributeMultiprocessorCount, dev);
        (void)hipFuncSetAttribute((const void*)mk_fwd, hipFuncAttributeMaxDynamicSharedMemorySize, LDS_BYTES);
        (void)hipOccupancyMaxActiveBlocksPerMultiprocessor(&per_cu, (const void*)mk_fwd, NTHREADS, LDS_BYTES);
        (void)hipGetLastError();
        grid = cus * (per_cu >= 1 ? 1 : 1);
        if (ws_size < 512 * MiB) { fprintf(stderr, "kernel_launch: workspace too small\n"); grid = -1; }
    }
    if (grid < 0) return;
    (void)hipMemsetAsync((unsigned char*)d_ws + WS_BAR, 0, 16384, stream);
    Args a{}; for (int i = 0; i < 23; ++i) a.in[i] = (const float*)d_in[i]; a.out = (float*)d_out; a.ws = (unsigned char*)d_ws; a.ph_lo = 0; a.ph_hi = NPH;
    void* args[] = {&a};
    hipError_t e = hipLaunchCooperativeKernel((const void*)mk_fwd, dim3(grid), dim3(NTHREADS), args, LDS_BYTES, stream);
    if (e != hipSuccess) fprintf(stderr, "cooperative launch failed: %s\n", hipGetErrorString(e));
#if TSTAMP
    hipLaunchKernelGGL(kd_ts, dim3(1024), dim3(256), 0, stream, (float*)d_out, (long)out_size, (const unsigned long long*)((unsigned char*)d_ws + WS_TS), TS_A, TS_B);
#endif
}
```

```cpp
#include <hip/hip_runtime.h>
#include <hip/hip_cooperative_groups.h>
#include <cstdio>
#include <cstdint>
#include <cstring>
#include <cmath>
#ifdef HOST_EMU
#include <cmath>
#include <cstdio>
#include <cstdlib>
#include <cstring>
#include <cstdint>
struct Dim3e { int x, y, z; };
static thread_local Dim3e threadIdx, blockIdx, blockDim, gridDim;
#define __global__
#define __device__
#define __host__
#define __forceinline__ inline
#define __launch_bounds__(...)
typedef void* hipStream_t;
template <class F, class... A> static void host_launch(F f, long nb, int nt, A... a) {
#pragma omp parallel for schedule(dynamic, 4)
    for (long b = 0; b < nb; ++b) {
        blockIdx = {(int)b, 0, 0}; blockDim = {nt, 1, 1}; gridDim = {(int)nb, 1, 1};
        for (int t = 0; t < nt; ++t) { threadIdx = {t, 0, 0}; f(a...); }
    }
}
#define LAUNCH(k, nb, nt, st, ...) host_launch(k, (long)(nb), (int)(nt), __VA_ARGS__)
#define UNROLL
#else
#define LAUNCH(k, nb, nt, st, ...) hipLaunchKernelGGL(k, dim3((unsigned)(nb)), dim3((unsigned)(nt)), 0, st, __VA_ARGS__)
#endif

constexpr int D_MODEL = 1024, A_HEADS = 8, A_HD = 64, A_W = 512, I_HEADS = 16, I_DIM = 32, TOPK_MAX = 256, REL_B = 32,
              G_HEADS = 4, G_DK = 64, G_DV = 128, G_KW = 256, G_VW = 512, G_RANK = 16, N_GROUPS = 4, EPG = 8, N_EXP = 32, D_EXP = 256;
constexpr int O_AQ = 0, O_AK = 512, O_AV = 1024, O_IQ = 1536, O_IK = 2048, O_IW = 2080, O_GQ = 2096, O_GK = 2352, O_GV = 2608, O_GR = 3120,
              O_GLR = 3632, O_GA = 3648, O_GB = 4672, D_IN = 5696;
constexpr float DN_ALPHA = 1.189207115002721f, LN_EPS = 1e-5f;
#define V0_GID long gid = (long)blockIdx.x * blockDim.x + threadIdx.x

__device__ __forceinline__ float v0_silu(float v) { return v / (1.f + expf(-v)); }
__device__ __forceinline__ float v0_sigmoid(float v) { return 1.f / (1.f + expf(-v)); }

__global__ void k0_ada(const float* c, const float* w_ada, const float* b_ada, float* ada, int B) {
    V0_GID; if (gid >= (long)B * 6 * D_MODEL) return;
    const int b = (int)(gid / (6 * D_MODEL)), j = (int)(gid % (6 * D_MODEL));
    float acc = 0.f;
    for (int i = 0; i < D_MODEL; ++i) acc += v0_silu(c[b * D_MODEL + i]) * w_ada[(size_t)i * 6 * D_MODEL + j];
    ada[gid] = acc + b_ada[j];
}
__global__ void k0_lnmod(const float* x, const float* sh, const float* sc, float* h, int nrows) {
    V0_GID; if (gid >= nrows) return;
    const float* xr = x + (size_t)gid * D_MODEL; float* hr = h + (size_t)gid * D_MODEL;
    float mu = 0.f; for (int k = 0; k < D_MODEL; ++k) mu += xr[k]; mu *= (1.f / D_MODEL);
    float var = 0.f; for (int k = 0; k < D_MODEL; ++k) { const float d = xr[k] - mu; var += d * d; } var *= (1.f / D_MODEL);
    const float rs = 1.f / sqrtf(var + LN_EPS);
    for (int k = 0; k < D_MODEL; ++k) hr[k] = (xr[k] - mu) * rs * (1.f + sc[k]) + sh[k];
}
__global__ void k0_gemm(const float* A, int lda, const float* W, int ldw, float* C, int ldc, int M, int N, int K) {
    V0_GID; if (gid >= (long)(M / 4) * N) return;
    const int n = (int)(gid % N); const int m0 = (int)(gid / N) * 4;
    float a0 = 0.f, a1 = 0.f, a2 = 0.f, a3 = 0.f;
    const float* A0 = A + (size_t)m0 * lda;
    for (int k = 0; k < K; ++k) { const float w = W[(size_t)k * ldw + n]; a0 += A0[k] * w; a1 += A0[lda + k] * w; a2 += A0[2 * lda + k] * w; a3 += A0[3 * lda + k] * w; }
    C[(size_t)m0 * ldc + n] = a0; C[(size_t)(m0 + 1) * ldc + n] = a1; C[(size_t)(m0 + 2) * ldc + n] = a2; C[(size_t)(m0 + 3) * ldc + n] = a3;
}
__global__ void k0_scores(const float* P, float* scT, int S) {
    V0_GID; if (gid >= (long)S * S) return;
    const int t = (int)(gid % S), s = (int)(gid / S);
    if (s > t) { scT[gid] = -INFINITY; return; }
    const float* iq = P + (size_t)t * D_IN + O_IQ; const float* ik = P + (size_t)s * D_IN + O_IK; const float* iw = P + (size_t)t * D_IN + O_IW;
    const float cst = 0.044194173824159216f;
    float sc = 0.f;
    for (int h = 0; h < I_HEADS; ++h) { float d = 0.f; for (int k = 0; k < I_DIM; ++k) d += iq[h * I_DIM + k] * ik[k]; sc += (iw[h] * cst) * fmaxf(d, 0.f); }
    scT[gid] = sc;
}
__device__ __forceinline__ unsigned v0_key(float f) { unsigned u; memcpy(&u, &f, 4); return (u & 0x80000000u) ? ~u : (u | 0x80000000u); }
__global__ void k0_topk(const float* scT, int* sel, int* cnt, int S, int topk) {
    V0_GID; if (gid >= S) return;
    const int t = (int)gid; const int n = t + 1; int* sl = sel + (size_t)t * TOPK_MAX;
    if (n <= topk) { for (int s = 0; s < n; ++s) sl[s] = s; cnt[t] = n; return; }
    unsigned T = 0u;
    for (int bit = 31; bit >= 0; --bit) { const unsigned cand = T | (1u << bit); int c = 0; for (int s = 0; s < n; ++s) c += (v0_key(scT[(size_t)s * S + t]) >= cand) ? 1 : 0; if (c >= topk) T = cand; }
    int cgt = 0; for (int s = 0; s < n; ++s) cgt += (v0_key(scT[(size_t)s * S + t]) > T) ? 1 : 0;
    int need = topk - cgt, j = 0;
    for (int s = 0; s < n; ++s) { const unsigned k = v0_key(scT[(size_t)s * S + t]); if (k > T) sl[j++] = s; else if (k == T && need > 0) { sl[j++] = s; --need; } }
    cnt[t] = j;
}
__device__ __forceinline__ int v0_bucket(int d) {
    if (d < 16) return d;
    const float df = (float)d; int large = 16 + (int)(logf(df / 16.f) / 2.0794415416798357f * 16.f);
    return large < 31 ? large : 31;
}
__global__ void __launch_bounds__(256) k0_attn(const float* P, const int* sel, const int* cnt, const float* rel_bias, float* oa, int S) {
    V0_GID; if (gid >= (long)S * A_HEADS) return;
    const int t = (int)(gid / A_HEADS), h = (int)(gid % A_HEADS); const int n = cnt[t]; const int* sl = sel + (size_t)t * TOPK_MAX;
    const float* q = P + (size_t)t * D_IN + O_AQ + h * A_HD;
    float m = -INFINITY;
    for (int j = 0; j < n; ++j) { const int s = sl[j]; const float* k = P + (size_t)s * D_IN + O_AK + h * A_HD; float d = 0.f; for (int e = 0; e < A_HD; ++e) d += q[e] * k[e];
        const float l = d * 0.125f + rel_bias[v0_bucket(t - s) * A_HEADS + h]; m = fmaxf(m, l); }
    float o[A_HD];
#pragma unroll
    for (int e = 0; e < A_HD; ++e) o[e] = 0.f;
    float sum = 0.f;
    for (int j = 0; j < n; ++j) { const int s = sl[j]; const float* k = P + (size_t)s * D_IN + O_AK + h * A_HD; const float* v = P + (size_t)s * D_IN + O_AV + h * A_HD; float d = 0.f;
        for (int e = 0; e < A_HD; ++e) d += q[e] * k[e];
        const float p = expf(d * 0.125f + rel_bias[v0_bucket(t - s) * A_HEADS + h] - m); sum += p;
#pragma unroll
        for (int e = 0; e < A_HD; ++e) o[e] += p * v[e]; }
    const float inv = 1.f / sum;
#pragma unroll
    for (int e = 0; e < A_HD; ++e) oa[(size_t)t * A_W + h * A_HD + e] = o[e] * inv;
}
__global__ void k0_gate(const float* P, const float* wg, const float* bg, float* lg, int S) {
    V0_GID; if (gid >= (long)S * G_KW) return;
    const int t = (int)(gid / G_KW), j = (int)(gid % G_KW);
    float z = bg[j]; for (int r = 0; r < G_RANK; ++r) z += P[(size_t)t * D_IN + O_GLR + r] * wg[r * G_KW + j];
    lg[gid] = (fminf(z, 0.f) - log1pf(expf(-fabsf(z)))) * (1.f / 16.f);
}
__global__ void __launch_bounds__(64) k0_gla(const float* P, const float* lg, float* oraw, int S) {
    V0_GID; if (gid >= G_HEADS * G_DV) return;
    const int h = (int)(gid / G_DV), dv = (int)(gid % G_DV);
    float st[G_DK];
#pragma unroll
    for (int d = 0; d < G_DK; ++d) st[d] = 0.f;
    for (int t = 0; t < S; ++t) {
        const float* row = P + (size_t)t * D_IN; const float vv = row[O_GV + h * G_DV + dv]; float o = 0.f;
#pragma unroll
        for (int d = 0; d < G_DK; ++d) { const float a = expf(lg[(size_t)t * G_KW + h * G_DK + d]); st[d] = a * st[d] + row[O_GK + h * G_DK + d] * vv; o += row[O_GQ + h * G_DK + d] * st[d]; }
        oraw[(size_t)t * G_VW + h * G_DV + dv] = o * 0.125f;
    }
}
__global__ void k0_gla_post(const float* P, const float* oraw, const float* ng, float* ob, int S) {
    V0_GID; if (gid >= (long)S * G_HEADS) return;
    const int t = (int)(gid / G_HEADS), h = (int)(gid % G_HEADS); const float* o = oraw + (size_t)t * G_VW + h * G_DV;
    float mu = 0.f; for (int e = 0; e < G_DV; ++e) mu += o[e]; mu *= (1.f / G_DV);
    float var = 0.f; for (int e = 0; e < G_DV; ++e) { const float d = o[e] - mu; var += d * d; } var *= (1.f / G_DV);
    const float rs = 1.f / sqrtf(var + LN_EPS);
    for (int e = 0; e < G_DV; ++e) ob[(size_t)t * G_VW + h * G_DV + e] = (o[e] - mu) * rs * ng[h * G_DV + e] * v0_silu(P[(size_t)t * D_IN + O_GR + h * G_DV + e]);
}
__global__ void k0_merge(const float* P, const float* ba, const float* bb, float* mg, int S) {
    V0_GID; if (gid >= (long)S * D_MODEL) return;
    const int t = (int)(gid / D_MODEL), n = (int)(gid % D_MODEL);
    mg[gid] = v0_sigmoid(P[(size_t)t * D_IN + O_GA + n]) * ba[gid] + v0_sigmoid(P[(size_t)t * D_IN + O_GB + n]) * bb[gid];
}
__global__ void k0_ln1(const float* x, const float* y, const float* gt1, const float* g1, const float* b1, const float* sh2, const float* sc2, float* x1, float* h2, int nrows) {
    V0_GID; if (gid >= nrows) return;
    const float* xr = x + (size_t)gid * D_MODEL; const float* yr = y + (size_t)gid * D_MODEL; float* x1r = x1 + (size_t)gid * D_MODEL; float* h2r = h2 + (size_t)gid * D_MODEL;
    float mu = 0.f; for (int k = 0; k < D_MODEL; ++k) mu += DN_ALPHA * xr[k] + gt1[k] * yr[k]; mu *= (1.f / D_MODEL);
    float var = 0.f; for (int k = 0; k < D_MODEL; ++k) { const float d = DN_ALPHA * xr[k] + gt1[k] * yr[k] - mu; var += d * d; } var *= (1.f / D_MODEL);
    float rs = 1.f / sqrtf(var + LN_EPS);
    for (int k = 0; k < D_MODEL; ++k) x1r[k] = (DN_ALPHA * xr[k] + gt1[k] * yr[k] - mu) * rs * g1[k] + b1[k];
    mu = 0.f; for (int k = 0; k < D_MODEL; ++k) mu += x1r[k]; mu *= (1.f / D_MODEL);
    var = 0.f; for (int k = 0; k < D_MODEL; ++k) { const float d = x1r[k] - mu; var += d * d; } var *= (1.f / D_MODEL);
    rs = 1.f / sqrtf(var + LN_EPS);
    for (int k = 0; k < D_MODEL; ++k) h2r[k] = (x1r[k] - mu) * rs * (1.f + sc2[k]) + sh2[k];
}
__global__ void k0_route(const float* rl, const float* brg, const float* bre, int* eid, float* ew, int nrows) {
    V0_GID; if (gid >= nrows) return;
    const float* r = rl + (size_t)gid * 36;
    float gl[N_GROUPS]; float gm = -INFINITY; int gi = 0;
#pragma unroll
    for (int g = 0; g < N_GROUPS; ++g) { gl[g] = r[g] + brg[g]; if (gl[g] > gm) { gm = gl[g]; gi = g; } }
    float gs = 0.f;
#pragma unroll
    for (int g = 0; g < N_GROUPS; ++g) gs += expf(gl[g] - gm);
    const float gw = 1.f / gs;
    float v0 = -INFINITY, v1 = -INFINITY; int i0 = 0, i1 = 0;
    for (int e = 0; e < EPG; ++e) { const float v = r[4 + gi * EPG + e] + bre[gi * EPG + e];
        if (v > v0) { v1 = v0; i1 = i0; v0 = v; i0 = e; } else if (v > v1) { v1 = v; i1 = e; } }
    const float e1 = expf(v1 - v0); const float w0 = 1.f / (1.f + e1), w1 = e1 / (1.f + e1);
    eid[gid * 2] = gi * EPG + i0; eid[gid * 2 + 1] = gi * EPG + i1; ew[gid * 2] = w0 * gw; ew[gid * 2 + 1] = w1 * gw;
}
__global__ void k0_moe_hid(const float* h2, const int* eid, const float* w1, const float* w3, float* hid, int nrows) {
    V0_GID; if (gid >= (long)nrows * 2 * D_EXP) return;
    const int j = (int)(gid % D_EXP); const long ts = gid / D_EXP; const int t = (int)(ts / 2); const int e = eid[ts];
    const float* hr = h2 + (size_t)t * D_MODEL; const float* a = w1 + (size_t)e * D_MODEL * D_EXP + j; const float* b = w3 + (size_t)e * D_MODEL * D_EXP + j;
    float g = 0.f, u = 0.f; for (int k = 0; k < D_MODEL; ++k) { g += hr[k] * a[(size_t)k * D_EXP]; u += hr[k] * b[(size_t)k * D_EXP]; }
    hid[gid] = v0_silu(g) * u;
}
__global__ void k0_moe_out(const float* hid, const int* eid, const float* ew, const float* w2, float* f, int nrows) {
    V0_GID; if (gid >= (long)nrows * D_MODEL) return;
    const int n = (int)(gid % D_MODEL); const int t = (int)(gid / D_MODEL); float acc = 0.f;
    for (int sl = 0; sl < 2; ++sl) { const int e = eid[t * 2 + sl]; const float* hr = hid + ((size_t)t * 2 + sl) * D_EXP; const float* w = w2 + (size_t)e * D_EXP * D_MODEL + n; float a = 0.f;
        for (int j = 0; j < D_EXP; ++j) a += hr[j] * w[(size_t)j * D_MODEL]; acc += ew[t * 2 + sl] * a; }
    f[gid] = acc;
}
__global__ void k0_final(const float* x1, const float* f, const float* gt2, const float* g2, const float* b2, float* out, int nrows) {
    V0_GID; if (gid >= nrows) return;
    const float* xr = x1 + (size_t)gid * D_MODEL; const float* fr = f + (size_t)gid * D_MODEL; float* o = out + (size_t)gid * D_MODEL;
    float mu = 0.f; for (int k = 0; k < D_MODEL; ++k) mu += DN_ALPHA * xr[k] + gt2[k] * fr[k]; mu *= (1.f / D_MODEL);
    float var = 0.f; for (int k = 0; k < D_MODEL; ++k) { const float d = DN_ALPHA * xr[k] + gt2[k] * fr[k] - mu; var += d * d; } var *= (1.f / D_MODEL);
    const float rs = 1.f / sqrtf(var + LN_EPS);
    for (int k = 0; k < D_MODEL; ++k) o[k] = (DN_ALPHA * xr[k] + gt2[k] * fr[k] - mu) * rs * g2[k] + b2[k];
}

struct V0Buf { float *ada, *h, *P, *scT, *oa, *lg, *oraw, *ob, *ba, *bb, *mg, *y, *x1, *h2, *rl, *ew, *hid, *f; int *sel, *cnt, *eid; size_t bytes; };
static V0Buf v0_carve(void* base, int B, int S) {
    V0Buf b; char* p = (char*)base; auto take = [&](size_t n) { char* r = p; p += (n + 255) & ~(size_t)255; return r; };
    b.ada = (float*)take((size_t)B * 6 * D_MODEL * 4);
    b.P = (float*)take((size_t)S * D_IN * 4);
    b.h = (float*)take((size_t)S * D_MODEL * 4);
    b.scT = (float*)take((size_t)S * S * 4);
    b.sel = (int*)take((size_t)S * TOPK_MAX * 4); b.cnt = (int*)take((size_t)S * 4);
    b.oa = (float*)take((size_t)S * A_W * 4); b.lg = (float*)take((size_t)S * G_KW * 4); b.oraw = (float*)take((size_t)S * G_VW * 4); b.ob = (float*)take((size_t)S * G_VW * 4);
    b.ba = (float*)take((size_t)S * D_MODEL * 4); b.bb = (float*)take((size_t)S * D_MODEL * 4); b.y = (float*)take((size_t)S * D_MODEL * 4);
    b.x1 = (float*)take((size_t)S * D_MODEL * 4); b.h2 = (float*)take((size_t)S * D_MODEL * 4); b.f = (float*)take((size_t)S * D_MODEL * 4);
    b.mg = b.h;
    b.rl = (float*)take((size_t)S * 36 * 4); b.eid = (int*)take((size_t)S * 2 * 4); b.ew = (float*)take((size_t)S * 2 * 4); b.hid = (float*)take((size_t)S * 2 * D_EXP * 4);
    b.bytes = (size_t)(p - (char*)base); return b;
}
static void v0_forward(void* const* d_in, float* out, void* scratch, int B, int S, hipStream_t st, int only_batch = -1, int last_batch = -1) {
    const float *x = (const float*)d_in[0], *c = (const float*)d_in[1], *rel_bias = (const float*)d_in[2], *w_ada = (const float*)d_in[3], *b_ada = (const float*)d_in[4], *w_in = (const float*)d_in[5],
                *wg = (const float*)d_in[6], *bg = (const float*)d_in[7], *ng = (const float*)d_in[8], *wba = (const float*)d_in[9], *wbb = (const float*)d_in[10], *wout = (const float*)d_in[11],
                *g1 = (const float*)d_in[12], *b1 = (const float*)d_in[13], *wrg = (const float*)d_in[14], *brg = (const float*)d_in[15], *wre = (const float*)d_in[16], *bre = (const float*)d_in[17],
                *w1 = (const float*)d_in[18], *w3 = (const float*)d_in[19], *w2 = (const float*)d_in[20], *g2 = (const float*)d_in[21], *b2 = (const float*)d_in[22];
    V0Buf u = v0_carve(scratch, B, S);
    const int TB = 256; auto nb = [&](long n) { return (n + TB - 1) / TB; };
    const int topk = (TOPK_MAX < S / 4) ? TOPK_MAX : S / 4;
    LAUNCH(k0_ada, nb((long)B * 6 * D_MODEL), TB, st, c, w_ada, b_ada, u.ada, B);
    for (int bi = 0; bi < B; ++bi) {
        int b = bi; if (last_batch >= 0) b = (bi == B - 1) ? last_batch : (bi < last_batch ? bi : bi + 1);
        if (only_batch >= 0 && b != only_batch) continue;
        const float* xb = x + (size_t)b * S * D_MODEL; const float* ad = u.ada + (size_t)b * 6 * D_MODEL;
        const float *sh1 = ad, *sc1 = ad + D_MODEL, *gt1 = ad + 2 * D_MODEL, *sh2 = ad + 3 * D_MODEL, *sc2 = ad + 4 * D_MODEL, *gt2 = ad + 5 * D_MODEL;
        LAUNCH(k0_lnmod, nb(S), TB, st, xb, sh1, sc1, u.h, S);
        LAUNCH(k0_gemm, nb((long)(S / 4) * D_IN), TB, st, (const float*)u.h, D_MODEL, w_in, D_IN, u.P, D_IN, S, D_IN, D_MODEL);
        LAUNCH(k0_scores, nb((long)S * S), TB, st, (const float*)u.P, u.scT, S);
        LAUNCH(k0_topk, nb(S), TB, st, (const float*)u.scT, u.sel, u.cnt, S, topk);
        LAUNCH(k0_attn, nb((long)S * A_HEADS), TB, st, (const float*)u.P, (const int*)u.sel, (const int*)u.cnt, rel_bias, u.oa, S);
        LAUNCH(k0_gate, nb((long)S * G_KW), TB, st, (const float*)u.P, wg, bg, u.lg, S);
        LAUNCH(k0_gla, (G_HEADS * G_DV + 63) / 64, 64, st, (const float*)u.P, (const float*)u.lg, u.oraw, S);
        LAUNCH(k0_gla_post, nb((long)S * G_HEADS), TB, st, (const float*)u.P, (const float*)u.oraw, ng, u.ob, S);
        LAUNCH(k0_gemm, nb((long)(S / 4) * D_MODEL), TB, st, (const float*)u.oa, A_W, wba, D_MODEL, u.ba, D_MODEL, S, D_MODEL, A_W);
        LAUNCH(k0_gemm, nb((long)(S / 4) * D_MODEL), TB, st, (const float*)u.ob, G_VW, wbb, D_MODEL, u.bb, D_MODEL, S, D_MODEL, G_VW);
        LAUNCH(k0_merge, nb((long)S * D_MODEL), TB, st, (const float*)u.P, (const float*)u.ba, (const float*)u.bb, u.mg, S);
        LAUNCH(k0_gemm, nb((long)(S / 4) * D_MODEL), TB, st, (const float*)u.mg, D_MODEL, wout, D_MODEL, u.y, D_MODEL, S, D_MODEL, D_MODEL);
        LAUNCH(k0_ln1, nb(S), TB, st, xb, (const float*)u.y, gt1, g1, b1, sh2, sc2, u.x1, u.h2, S);
        LAUNCH(k0_gemm, nb((long)(S / 4) * N_GROUPS), TB, st, (const float*)u.h2, D_MODEL, wrg, N_GROUPS, u.rl, 36, S, N_GROUPS, D_MODEL);
        LAUNCH(k0_gemm, nb((long)(S / 4) * N_EXP), TB, st, (const float*)u.h2, D_MODEL, wre, N_EXP, u.rl + 4, 36, S, N_EXP, D_MODEL);
        LAUNCH(k0_route, nb(S), TB, st, (const float*)u.rl, brg, bre, u.eid, u.ew, S);
        LAUNCH(k0_moe_hid, nb((long)S * 2 * D_EXP), TB, st, (const float*)u.h2, (const int*)u.eid, w1, w3, u.hid, S);
        LAUNCH(k0_moe_out, nb((long)S * D_MODEL), TB, st, (const float*)u.hid, (const int*)u.eid, (const float*)u.ew, w2, u.f, S);
        LAUNCH(k0_final, nb(S), TB, st, (const float*)u.x1, (const float*)u.f, gt2, g2, b2, out + (size_t)b * S * D_MODEL, S);
    }
}
namespace pg8 {
#define PG8_LAS __attribute__((address_space(3)))
typedef unsigned short bf16_t;
typedef short bf16x8 __attribute__((ext_vector_type(8)));
typedef float f32x4 __attribute__((ext_vector_type(4)));
typedef unsigned u32x4 __attribute__((ext_vector_type(4)));
constexpr int BM = 256, BK = 64, HALF = 128, HTB = HALF * BK * 2  , STAGE_BYTES = 8 * HTB, NXCD = 8, WGM = 8;

__host__ __device__ __forceinline__ int lds_byte(int r, int c) { const int st = (r >> 4) * 2 + (c >> 5), rr = r & 15, cc = c & 31, ob = rr * 64 + cc * 2; return st * 1024 + (ob ^ (((ob >> 9) & 1) << 5)); }
__host__ __device__ __forceinline__ void stage_rc(int b, int& R, int& C) { const int st = b / 1024, sb = b % 1024, swz = sb ^ (((sb >> 9) & 1) << 5); R = (st >> 1) * 16 + swz / 64; C = (st & 1) * 32 + (swz % 64) / 2; }
__host__ __device__ __forceinline__ int perm32(int rho) { const int n = rho >> 4, i = rho & 15; return 8 * (i >> 2) + 4 * n + (i & 3); }

struct Unit { int pm, pn, pa, pb; };
struct Gemm { const bf16_t* A; const bf16_t* Bt; int M, N, K; };

struct StaticOrder {
    int nM, nN, nwg, G, c;
    __host__ __device__ void init(int M, int N, int G_, int c_) { nM = M / BM; nN = N / BM; nwg = nM * nN; G = G_; c = c_; }
    __host__ __device__ bool next(int i, Unit& u) const {
        const long L = (long)i * G + c; if (L >= nwg) return false;
        int wgid = (int)L; { const int q = nwg / NXCD, r = nwg % NXCD, xcd = wgid % NXCD, off = wgid / NXCD; wgid = (xcd < r ? xcd * (q + 1) : r * (q + 1) + (xcd - r) * q) + off; }
        const int nig = WGM * nN, gid = wgid / nig, fm = gid * WGM, gsz = (nM - fm) < WGM ? (nM - fm) : WGM;
        u.pm = fm + ((wgid % nig) % gsz); u.pn = (wgid % nig) / gsz; u.pa = u.pm; u.pb = u.pn; return true;
    }
    __device__ __forceinline__ void a_ready(const Unit&) const {}
    __device__ __forceinline__ void done(const Unit&) const {}
};

__device__ __forceinline__ unsigned cvt_pk_bf16(float lo, float hi) { unsigned r; asm volatile("v_cvt_pk_bf16_f32 %0, %1, %2" : "=v"(r) : "v"(lo), "v"(hi)); return r; }
typedef float f32x2 __attribute__((ext_vector_type(2)));

template <class Epi, class Sched, bool ALIGN_EPI = false, bool SP2 = false, bool GATHER = false>
__device__ __forceinline__ void gemm_phase(PG8_LAS unsigned char* lds, const Gemm g, const Sched& S, const Epi& E) {
    const int tid = threadIdx.x, wid = __builtin_amdgcn_readfirstlane(tid >> 6), lane = tid & 63, wr = wid >> 2, wc = wid & 3, fr = lane & 15, fq = lane >> 4;
    const int K = g.K, nt = K / BK;
    static_assert(!GATHER || SP2, "gathered A rows: SP2 loop only");
    unsigned voffA[2], voffB[2]; int Rr[2], Cc[2];
#pragma unroll
    for (int i = 0; i < 2; ++i) { int R, C; stage_rc(tid * 16 + i * 8192, R, C); const int Rb = Epi::PERM ? ((R & ~31) + perm32(R & 31)) : R; Rr[i] = R; Cc[i] = C;
        voffA[i] = (unsigned)(R * K + C) * 2u; voffB[i] = (unsigned)(Rb * K + C) * 2u; }
    unsigned vc0[2] = {voffA[0], voffA[1]}, vc1[2] = {voffA[0], voffA[1]}, vn0[2] = {voffA[0], voffA[1]}, vn1[2] = {voffA[0], voffA[1]};
    const size_t kstep = (size_t)(BK * 2);
    const size_t hstep = (size_t)HALF * K * 2;
    const size_t tstep = 2 * hstep;
    const unsigned ldsw = (unsigned)wid * 1024u;
    const int aoff = lds_byte(wr * 64 + fr, fq * 8), boff = lds_byte(wc * 32 + fr, fq * 8);
#define PG8_SA(b, h) (((b) * 2 + (h)) * HTB)
#define PG8_SB(b, h) ((4 + (b) * 2 + (h)) * HTB)
#define PG8_STAGE(bufoff, gbase, voff) do { _Pragma("unroll") for (int _i = 0; _i < 2; ++_i) \
        __builtin_amdgcn_global_load_lds((const unsigned*)((const char*)(gbase) + (voff)[_i]), (PG8_LAS unsigned*)(lds + (bufoff) + ldsw + _i * 8192), 16, 0, 0); } while (0)
#define PG8_LDA(dst, b, h) do { _Pragma("unroll") for (int m = 0; m < 4; ++m) _Pragma("unroll") for (int k = 0; k < 2; ++k) dst[m][k] = *(const PG8_LAS bf16x8*)(lds + PG8_SA(b, h) + aoff + m * 2048 + k * 1024); } while (0)
#define PG8_LDB(dst, b, h) do { _Pragma("unroll") for (int n = 0; n < 2; ++n) _Pragma("unroll") for (int k = 0; k < 2; ++k) dst[n][k] = *(const PG8_LAS bf16x8*)(lds + PG8_SB(b, h) + boff + n * 2048 + k * 1024); } while (0)
#define PG8_MMA(ai, bj, At, Bt) do { __builtin_amdgcn_s_setprio(1); _Pragma("unroll") for (int m = 0; m < 4; ++m) _Pragma("unroll") for (int n = 0; n < 2; ++n) _Pragma("unroll") for (int k = 0; k < 2; ++k) \
        acc[ai][bj][m][n] = __builtin_amdgcn_mfma_f32_16x16x32_bf16(Bt[n][k], At[m][k], acc[ai][bj][m][n], 0, 0, 0); __builtin_amdgcn_s_setprio(0); } while (0)
#define PG8_WAIT_V(n) asm volatile("s_waitcnt vmcnt(" #n ")" ::: "memory")
#define PG8_WAIT_L(n) asm volatile("s_waitcnt lgkmcnt(" #n ")" ::: "memory")
#define PG8_BAR __builtin_amdgcn_s_barrier()
#define PG8_SCHED __builtin_amdgcn_sched_barrier(0)
    Unit cur, nxt; int ui = 0;
    if (!S.next(0, cur)) return;
    f32x4 acc[2][2][4][2];
#pragma unroll
    for (int a = 0; a < 2; ++a)
#pragma unroll
        for (int b = 0; b < 2; ++b)
#pragma unroll
            for (int m = 0; m < 4; ++m)
#pragma unroll
                for (int n = 0; n < 2; ++n) acc[a][b][m][n] = (f32x4){0.f, 0.f, 0.f, 0.f};
    bf16x8 At[4][2], B0[2][2], B1[2][2];
    const char* cA = GATHER ? (const char*)g.A : (const char*)g.A + (size_t)cur.pa * tstep; const char* cB = (const char*)g.Bt + (size_t)cur.pb * tstep;
    const size_t hstepA = GATHER ? 0 : hstep;
    if constexpr (GATHER) {
#pragma unroll
        for (int i = 0; i < 2; ++i) { vc0[i] = (unsigned)S.a_row(cur, Rr[i]) * (unsigned)(K * 2) + (unsigned)(Cc[i] * 2); vc1[i] = (unsigned)S.a_row(cur, HALF + Rr[i]) * (unsigned)(K * 2) + (unsigned)(Cc[i] * 2); } }
    S.a_ready(cur);
    if constexpr (SP2) {
        PG8_STAGE(PG8_SB(0, 0), cB, voffB); PG8_STAGE(PG8_SB(0, 1), cB + hstep, voffB); PG8_STAGE(PG8_SA(0, 0), cA, vc0); PG8_STAGE(PG8_SA(0, 1), cA + hstepA, vc1);
        if (wr == 1) PG8_BAR;
        PG8_WAIT_V(2); PG8_BAR;
        PG8_STAGE(PG8_SB(1, 0), cB + kstep, voffB); PG8_STAGE(PG8_SA(1, 0), cA + kstep, vc0); PG8_STAGE(PG8_SB(1, 1), cB + hstep + kstep, voffB);
        PG8_WAIT_V(6); PG8_BAR;
    } else {
        PG8_STAGE(PG8_SB(0, 0), cB, voffB); PG8_STAGE(PG8_SA(0, 0), cA, voffA); PG8_STAGE(PG8_SB(0, 1), cB + hstep, voffB); PG8_STAGE(PG8_SA(0, 1), cA + hstep, voffA);
        if (wr == 1) PG8_BAR;
        PG8_WAIT_V(4); PG8_BAR;
        PG8_STAGE(PG8_SB(1, 0), cB + kstep, voffB); PG8_STAGE(PG8_SA(1, 0), cA + kstep, voffA); PG8_STAGE(PG8_SB(1, 1), cB + hstep + kstep, voffB);
        PG8_WAIT_V(6); PG8_BAR;
    }
    for (;;) {
        const bool has_next = S.next(ui + 1, nxt);
        const char* nA = GATHER ? cA : (has_next ? (const char*)g.A + (size_t)nxt.pa * tstep : cA); const char* nB = has_next ? (const char*)g.Bt + (size_t)nxt.pb * tstep : cB;
        if constexpr (GATHER) {
#pragma unroll
            for (int i = 0; i < 2; ++i) { vn0[i] = has_next ? (unsigned)S.a_row(nxt, Rr[i]) * (unsigned)(K * 2) + (unsigned)(Cc[i] * 2) : vc0[i]; vn1[i] = has_next ? (unsigned)S.a_row(nxt, HALF + Rr[i]) * (unsigned)(K * 2) + (unsigned)(Cc[i] * 2) : vc1[i]; } }
        for (int t = 0; t < nt; t += 2) {
            const bool last = (t == nt - 2);
            if constexpr (Epi::MID) { if (t == nt / 2) E.mid(acc, cur, wr, wc, fr, fq); }
            const char* a1 = cA + (size_t)(t + 1) * kstep;
            const char* a2 = last ? nA : cA + (size_t)(t + 2) * kstep; const char* b2 = last ? nB : cB + (size_t)(t + 2) * kstep;
            const char* a3 = a2 + kstep; const char* b3 = b2 + kstep;
            if (last && has_next) S.a_ready(nxt);
            if constexpr (SP2) {
            unsigned w0[2], w1[2];
#pragma unroll
            for (int i = 0; i < 2; ++i) { w0[i] = last ? vn0[i] : vc0[i]; w1[i] = last ? vn1[i] : vc1[i]; }
            PG8_LDB(B0, 0, 0); PG8_LDB(B1, 0, 1); PG8_SCHED; PG8_LDA(At, 0, 0); PG8_STAGE(PG8_SA(1, 1), a1 + hstepA, vc1);
            PG8_WAIT_V(8); PG8_WAIT_L(0); PG8_BAR; PG8_MMA(0, 0, At, B0); PG8_MMA(0, 1, At, B1); PG8_BAR; PG8_SCHED;
            PG8_LDA(At, 0, 1); PG8_STAGE(PG8_SB(0, 0), b2, voffB); PG8_STAGE(PG8_SB(0, 1), b2 + hstep, voffB); PG8_STAGE(PG8_SA(0, 0), a2, w0);
            PG8_WAIT_V(8); PG8_WAIT_L(0); PG8_BAR; PG8_MMA(1, 0, At, B0); PG8_MMA(1, 1, At, B1); PG8_BAR; PG8_SCHED;
            PG8_LDB(B0, 1, 0); PG8_LDB(B1, 1, 1); PG8_SCHED; PG8_LDA(At, 1, 0); PG8_STAGE(PG8_SA(0, 1), a2 + hstepA, w1);
            PG8_WAIT_V(8); PG8_WAIT_L(0); PG8_BAR; PG8_MMA(0, 0, At, B0); PG8_MMA(0, 1, At, B1); PG8_BAR; PG8_SCHED;
            PG8_LDA(At, 1, 1); PG8_STAGE(PG8_SB(1, 0), b3, voffB); PG8_STAGE(PG8_SB(1, 1), b3 + hstep, voffB); PG8_STAGE(PG8_SA(1, 0), a3, w0);
            PG8_WAIT_V(8); PG8_WAIT_L(0); PG8_BAR; PG8_MMA(1, 0, At, B0); PG8_MMA(1, 1, At, B1); PG8_BAR; PG8_SCHED;
            } else {
            PG8_LDB(B0, 0, 0); PG8_SCHED; PG8_LDA(At, 0, 0); PG8_STAGE(PG8_SA(1, 1), a1 + hstep, voffA);
            PG8_WAIT_L(8); PG8_BAR; PG8_WAIT_L(0); PG8_MMA(0, 0, At, B0); PG8_BAR; PG8_SCHED;
            PG8_LDB(B1, 0, 1); PG8_STAGE(PG8_SB(0, 0), b2, voffB);
            PG8_BAR; PG8_WAIT_L(0); PG8_MMA(0, 1, At, B1); PG8_BAR;
            PG8_LDA(At, 0, 1); PG8_STAGE(PG8_SA(0, 0), a2, voffA);
            PG8_BAR; PG8_WAIT_L(0); PG8_MMA(1, 0, At, B0); PG8_BAR; PG8_SCHED;
            PG8_STAGE(PG8_SB(0, 1), b2 + hstep, voffB);
            PG8_WAIT_V(6); PG8_BAR; PG8_MMA(1, 1, At, B1); PG8_BAR;
            PG8_LDB(B0, 1, 0); PG8_SCHED; PG8_LDA(At, 1, 0); PG8_STAGE(PG8_SA(0, 1), a2 + hstep, voffA);
            PG8_WAIT_L(8); PG8_BAR; PG8_WAIT_L(0); PG8_MMA(0, 0, At, B0); PG8_BAR; PG8_SCHED;
            PG8_LDB(B1, 1, 1); PG8_STAGE(PG8_SB(1, 0), b3, voffB);
            PG8_BAR; PG8_WAIT_L(0); PG8_MMA(0, 1, At, B1); PG8_BAR;
            PG8_LDA(At, 1, 1); PG8_STAGE(PG8_SA(1, 0), a3, voffA);
            PG8_BAR; PG8_WAIT_L(0); PG8_MMA(1, 0, At, B0); PG8_BAR; PG8_SCHED;
            PG8_STAGE(PG8_SB(1, 1), b3 + hstep, voffB);
            PG8_WAIT_V(6); PG8_BAR; PG8_MMA(1, 1, At, B1); PG8_BAR;
            }
        }
        if constexpr (ALIGN_EPI) { if (wr == 0) PG8_BAR; }
        if constexpr (!Epi::AFTER_DRAIN) { E(acc, cur, wr, wc, fr, fq); S.done(cur); }
        if (!has_next) break;
#pragma unroll
        for (int a = 0; a < 2; ++a)
#pragma unroll
            for (int b = 0; b < 2; ++b)
#pragma unroll
                for (int m = 0; m < 4; ++m)
#pragma unroll
                    for (int n = 0; n < 2; ++n) acc[a][b][m][n] = (f32x4){0.f, 0.f, 0.f, 0.f};
        cur = nxt; cA = nA; cB = nB; ++ui;
        if constexpr (GATHER) { vc0[0] = vn0[0]; vc0[1] = vn0[1]; vc1[0] = vn1[0]; vc1[1] = vn1[1]; }
        if constexpr (ALIGN_EPI) { if (wr == 1) PG8_BAR; }
    }
    PG8_WAIT_V(0);
    if constexpr (!ALIGN_EPI) { if (wr == 0) PG8_BAR; }
    PG8_BAR;
    if constexpr (Epi::AFTER_DRAIN) { E.fused(acc, cur, wr, wc, fr, fq, lds, wid, lane); S.done(cur); }
#undef PG8_SA
#undef PG8_SB
#undef PG8_STAGE
#undef PG8_LDA
#undef PG8_LDB
#undef PG8_MMA
#undef PG8_WAIT_V
#undef PG8_WAIT_L
#undef PG8_BAR
#undef PG8_SCHED
}
}

#ifndef PG8_SP2
#define PG8_SP2 true
#endif
#ifndef PG8_ALIGN
#define PG8_ALIGN true
#endif
#ifndef DUPSUB
#define DUPSUB 0
#endif
#ifndef TSTAMP
#define TSTAMP 0
#endif
#ifndef USE_CG_SYNC
#define USE_CG_SYNC 0
#endif
#ifndef DUPMASK
#define DUPMASK 0
#define DUPMASK_ON 0
#else
#define DUPMASK_ON 1
#endif
namespace cg = cooperative_groups;
namespace fk {
using pg8::bf16_t; using pg8::f32x4; using pg8::u32x4; using pg8::bf16x8; using pg8::Unit; using pg8::cvt_pk_bf16;
#define LAS __attribute__((address_space(3)))
#define LDS_WAIT() asm volatile("s_waitcnt lgkmcnt(0)" ::: "memory")
typedef unsigned u32x2 __attribute__((ext_vector_type(2)));
constexpr int NB = 8, NS = 4096, NT = NB * NS;
constexpr int NTHREADS = 512, NWAVES = 8, LDS_BYTES = 155648;
constexpr size_t MiB = (size_t)1 << 20;
constexpr size_t WS_ADA = 0, WS_CNT = 256 * 1024,
    WS_WIN = 1 * MiB, WS_WGAB = 9 * MiB, WS_WBA = 13 * MiB, WS_WBB = 14 * MiB, WS_WOUT = 15 * MiB, WS_W13 = 17 * MiB, WS_W2 = 49 * MiB,
    WS_XN = 65 * MiB, WS_QKV = 129 * MiB, WS_IQ = 225 * MiB, WS_GQK = 257 * MiB, WS_GV = 289 * MiB, WS_GR = 321 * MiB,
    WS_IK = 353 * MiB, WS_IW = 355 * MiB, WS_GLR = 357 * MiB, WS_SC = 358 * MiB, WS_MASK = 490 * MiB, WS_ADAP = 506 * MiB, WS_MISC = 509 * MiB;
constexpr int NPROJ = 3584;
constexpr size_t WS_WGT = 400 * 1024;
constexpr int KSL = 16;
constexpr float QSCALE = 0.125f * 1.4426950408889634f;
typedef float f32x2_t __attribute__((ext_vector_type(2))); typedef __bf16 bf16x2_t __attribute__((ext_vector_type(2)));
__device__ __forceinline__ unsigned cvtpk_s(float lo, float hi) { f32x2_t v = {lo, hi}; bf16x2_t b = __builtin_convertvector(v, bf16x2_t); return __builtin_bit_cast(unsigned, b); }
__device__ __forceinline__ void bf8_to_f(const u32x4 w, float* f) {
#pragma unroll
    for (int j = 0; j < 4; ++j) { f[2 * j] = __uint_as_float(w[j] << 16); f[2 * j + 1] = __uint_as_float(w[j] & 0xffff0000u); }
}

__device__ __forceinline__ void tr_item(const float* W, int ldw, int srccol, bf16_t* WT, int K, int dst_row0, int kb, LAS float* scr, int lane, int kdst0 = 0) {
    const int k0 = 64 * kb;
#pragma unroll
    for (int i = 0; i < 32; ++i) { const int kk = 2 * i + (lane >> 5); scr[kk * 33 + (lane & 31)] = W[(size_t)(k0 + kk) * ldw + srccol]; }
    LDS_WAIT();
    const int c = lane & 7;
#pragma unroll
    for (int j = 0; j < 4; ++j) { const int n = (lane >> 3) + 8 * j; const LAS float* s = scr + (8 * c) * 33 + n;
        u32x4 o; o.x = cvt_pk_bf16(s[0 * 33], s[1 * 33]); o.y = cvt_pk_bf16(s[2 * 33], s[3 * 33]); o.z = cvt_pk_bf16(s[4 * 33], s[5 * 33]); o.w = cvt_pk_bf16(s[6 * 33], s[7 * 33]);
        *(u32x4*)(WT + (size_t)(dst_row0 + n) * K + kdst0 + k0 + 8 * c) = o; }
    LDS_WAIT();
}
__device__ __forceinline__ int win_src(int n) {
    if (n < 2048) return n;
    if (n < 3584) return n + 48;
    if (n < 3616) return O_IK + (n - 3584);
    if (n < 3632) return O_IW + (n - 3616);
    return O_GLR + (n - 3632);
}
constexpr int I_ADA = 96 * KSL, I_WIN = 114 * 16, I_WGAB = 64 * 16, I_WB = 32 * 8, I_WOUT = 32 * 16, I_W13 = 32 * 16 * 16, I_W2 = 32 * 32 * 4;
constexpr int P0_ITEMS = I_ADA + I_WIN + I_WGAB + 2 * I_WB + I_WOUT + I_W13 + I_W2, P0_EARLY = I_ADA + I_WIN + I_WGAB + 2 * I_WB + I_WOUT;
__device__ __forceinline__ void p0_item(int it, const float* const* in, unsigned char* ws, LAS float* scr, int lane) {
    if (it < I_ADA) {
        const int cb = it / KSL, ks = it % KSL, k0 = ks * 64; const float* c = in[1]; const float* w = in[3];
#pragma unroll
        for (int b = 0; b < NB; ++b) { const float cv = c[b * D_MODEL + k0 + lane]; scr[b * 64 + lane] = cv / (1.f + __expf(-cv)); }
        LDS_WAIT();
        float acc[NB];
#pragma unroll
        for (int b = 0; b < NB; ++b) acc[b] = 0.f;
        const int col = cb * 64 + lane;
#pragma unroll 16
        for (int kk = 0; kk < 64; ++kk) { const float wv = w[(size_t)(k0 + kk) * (6 * D_MODEL) + col];
#pragma unroll
            for (int b = 0; b < NB; ++b) acc[b] += scr[b * 64 + kk] * wv; }
        float* adap = (float*)(ws + WS_ADAP);
#pragma unroll
        for (int b = 0; b < NB; ++b) adap[(size_t)(ks * NB + b) * (6 * D_MODEL) + col] = acc[b];
        LDS_WAIT(); return;
    }
    it -= I_ADA;
    const int l31 = lane & 31;
    if (it < I_WIN) { const int nb = it / 16, kb = it % 16; tr_item(in[5], D_IN, win_src(nb * 32 + l31), (bf16_t*)(ws + WS_WIN), 1024, nb * 32, kb, scr, lane); return; }
    it -= I_WIN;
    if (it < I_WGAB) { const int nb = it / 16, kb = it % 16; tr_item(in[5], D_IN, O_GA + nb * 32 + l31, (bf16_t*)(ws + WS_WGAB), 1024, nb * 32, kb, scr, lane); return; }
    it -= I_WGAB;
    if (it < I_WB) { const int nb = it / 8, kb = it % 8; tr_item(in[9], D_MODEL, nb * 32 + l31, (bf16_t*)(ws + WS_WBA), 1024, nb * 32, kb, scr, lane, 0); return; }
    it -= I_WB;
    if (it < I_WB) { const int nb = it / 8, kb = it % 8; tr_item(in[10], D_MODEL, nb * 32 + l31, (bf16_t*)(ws + WS_WBA), 1024, nb * 32, kb, scr, lane, 512); return; }
    it -= I_WB;
    if (it < I_WOUT) { const int nb = it / 16, kb = it % 16; tr_item(in[11], D_MODEL, nb * 32 + l31, (bf16_t*)(ws + WS_WOUT), 1024, nb * 32, kb, scr, lane); return; }
    it -= I_WOUT;
    if (it < I_W13) {
        const int e = it / 256, r = it % 256, nb = r / 16, kb = r % 16; const int row0 = nb * 32;
        const int half = (row0 & 255) >> 7; const int col = (row0 >> 8) * 128 + (row0 & 127) + l31;
        const float* src = (half ? in[19] : in[18]) + (size_t)e * D_MODEL * D_EXP;
        tr_item(src, D_EXP, col, (bf16_t*)(ws + WS_W13) + (size_t)e * 512 * 1024, 1024, row0, kb, scr, lane); return; }
    it -= I_W13;
    { const int e = it / 128, r = it % 128, nb = r / 4, kb = r % 4;
      tr_item(in[20] + (size_t)e * D_EXP * D_MODEL, D_MODEL, nb * 32 + l31, (bf16_t*)(ws + WS_W2) + (size_t)e * 1024 * 256, 256, nb * 32, kb, scr, lane); }
}

__device__ __forceinline__ float dpp_row_sum_f(float v) {
    v += __int_as_float(__builtin_amdgcn_update_dpp(0, __float_as_int(v), 0xB1, 0xF, 0xF, true));
    v += __int_as_float(__builtin_amdgcn_update_dpp(0, __float_as_int(v), 0x4E, 0xF, 0xF, true));
    v += __int_as_float(__builtin_amdgcn_update_dpp(0, __float_as_int(v), 0x141, 0xF, 0xF, true));
    v += __int_as_float(__builtin_amdgcn_update_dpp(0, __float_as_int(v), 0x140, 0xF, 0xF, true));
    return v;
}
__device__ __forceinline__ float wave_sum_u(float v) {
    v = dpp_row_sum_f(v);
    return (__int_as_float(__builtin_amdgcn_readlane(__float_as_int(v), 0)) + __int_as_float(__builtin_amdgcn_readlane(__float_as_int(v), 16)))
         + (__int_as_float(__builtin_amdgcn_readlane(__float_as_int(v), 32)) + __int_as_float(__builtin_amdgcn_readlane(__float_as_int(v), 48)));
}
template <int R> __device__ __forceinline__ void ln_center(f32x4 (&v)[R][4], float (&rstd)[R], float* meanout = nullptr) {
    float s[R];
#pragma unroll
    for (int r = 0; r < R; ++r) { s[r] = 0.f;
#pragma unroll
        for (int j = 0; j < 4; ++j) s[r] += (v[r][j].x + v[r][j].y) + (v[r][j].z + v[r][j].w); }
#pragma unroll
    for (int r = 0; r < R; ++r) s[r] = dpp_row_sum_f(s[r]);
    float q[R];
#pragma unroll
    for (int r = 0; r < R; ++r) { const float mean = ((__int_as_float(__builtin_amdgcn_readlane(__float_as_int(s[r]), 0)) + __int_as_float(__builtin_amdgcn_readlane(__float_as_int(s[r]), 16)))
                                                   + (__int_as_float(__builtin_amdgcn_readlane(__float_as_int(s[r]), 32)) + __int_as_float(__builtin_amdgcn_readlane(__float_as_int(s[r]), 48)))) * (1.f / D_MODEL);
        if (meanout) meanout[r] = mean;
        q[r] = 0.f;
#pragma unroll
        for (int j = 0; j < 4; ++j) { v[r][j] = v[r][j] - mean; q[r] += (v[r][j].x * v[r][j].x + v[r][j].y * v[r][j].y) + (v[r][j].z * v[r][j].z + v[r][j].w * v[r][j].w); } }
#pragma unroll
    for (int r = 0; r < R; ++r) q[r] = dpp_row_sum_f(q[r]);
#pragma unroll
    for (int r = 0; r < R; ++r) { const float var = ((__int_as_float(__builtin_amdgcn_readlane(__float_as_int(q[r]), 0)) + __int_as_float(__builtin_amdgcn_readlane(__float_as_int(q[r]), 16)))
                                                  + (__int_as_float(__builtin_amdgcn_readlane(__float_as_int(q[r]), 32)) + __int_as_float(__builtin_amdgcn_readlane(__float_as_int(q[r]), 48)))) * (1.f / D_MODEL);
        rstd[r] = 1.f / sqrtf(var + LN_EPS); }
}
__device__ __forceinline__ float wave_sum(float v) {
#pragma unroll
    for (int o = 1; o < 64; o <<= 1) v += __shfl_xor(v, o);
    return v;
}
__device__ __forceinline__ float ada_sum(const float* adap, const float* b_ada, int b, int j) {
    float s = b_ada[j];
#pragma unroll
    for (int k = 0; k < KSL; ++k) s += adap[(size_t)(k * NB + b) * (6 * D_MODEL) + j];
    return s;
}
__device__ __forceinline__ void p1_phase(const float* const* in, unsigned char* ws, LAS unsigned char* lds, int G) {
    const int tid = threadIdx.x, lane = tid & 63, wave = tid >> 6;
    const float* adap = (const float*)(ws + WS_ADAP); const float* b_ada = in[4]; const float* x = in[0];
    LAS float* sh = (LAS float*)lds; LAS float* sc = sh + D_MODEL;
    for (int blk = blockIdx.x; blk < NT / 128; blk += G) {
        const int b = blk / 32;
        __syncthreads();
        for (int j = tid; j < 2 * D_MODEL; j += NTHREADS) sh[j] = ada_sum(adap, b_ada, b, j);
        if ((blk & 31) == 0) { float* ada = (float*)(ws + WS_ADA) + (size_t)b * 6 * D_MODEL; for (int j = tid; j < 6 * D_MODEL; j += NTHREADS) ada[j] = ada_sum(adap, b_ada, b, j); }
        __syncthreads();
        for (int rb = 0; rb < 16; rb += 4) {
            const size_t row0 = (size_t)blk * 128 + wave * 16 + rb;
            f32x4 v[4][4];
#pragma unroll
            for (int r = 0; r < 4; ++r) { const f32x4* xr = (const f32x4*)(x + (row0 + r) * D_MODEL) + lane;
#pragma unroll
                for (int j = 0; j < 4; ++j) v[r][j] = xr[64 * j]; }
            float rstd[4]; ln_center<4>(v, rstd);
#pragma unroll
            for (int j = 0; j < 4; ++j) { const f32x4 a = *(const LAS f32x4*)(sc + 256 * j + 4 * lane) + 1.f, c = *(const LAS f32x4*)(sh + 256 * j + 4 * lane);
#pragma unroll
                for (int r = 0; r < 4; ++r) { const f32x4 y = v[r][j] * rstd[r] * a + c; u32x2 w; w.x = cvtpk_s(y.x, y.y); w.y = cvtpk_s(y.z, y.w);
                    ((u32x2*)((bf16_t*)(ws + WS_XN) + (row0 + r) * D_MODEL) + lane)[64 * j] = w; } }
        }
        asm volatile("s_waitcnt vmcnt(0)" ::: "memory"); __syncthreads();
        {   LAS unsigned char* W64 = lds + 8192; constexpr int WP = 2064;
            const bf16_t* wsrc = (const bf16_t*)(ws + WS_WIN) + (size_t)3584 * 1024;
            for (int i = tid; i < 64 * 128; i += NTHREADS) { const int n = i >> 7, c = i & 127; *(LAS u32x4*)(W64 + n * WP + c * 16) = *(const u32x4*)(wsrc + (size_t)n * 1024 + c * 8); }
            __syncthreads();
            const int fr = lane & 15, fq = lane >> 4; const size_t rowA = (size_t)blk * 128 + wave * 16 + fr;
            const bf16_t* xp = (const bf16_t*)(ws + WS_XN) + rowA * D_MODEL + 8 * fq;
            f32x4 acc[4];
#pragma unroll
            for (int nt = 0; nt < 4; ++nt) acc[nt] = (f32x4){0.f, 0.f, 0.f, 0.f};
#pragma unroll 8
            for (int ks = 0; ks < 32; ++ks) { const bf16x8 bfr = *(const bf16x8*)(xp + 32 * ks);
#pragma unroll
                for (int nt = 0; nt < 4; ++nt) { const bf16x8 afr = *(const LAS bf16x8*)(W64 + (16 * nt + fr) * WP + (32 * ks + 8 * fq) * 2); acc[nt] = __builtin_amdgcn_mfma_f32_16x16x32_bf16(afr, bfr, acc[nt], 0, 0, 0); } }
            { u32x2 w; w.x = cvtpk_s(acc[0][0], acc[0][1]); w.y = cvtpk_s(acc[0][2], acc[0][3]); *(u32x2*)((bf16_t*)(ws + WS_IK) + rowA * 32 + 4 * fq) = w;
              w.x = cvtpk_s(acc[1][0], acc[1][1]); w.y = cvtpk_s(acc[1][2], acc[1][3]); *(u32x2*)((bf16_t*)(ws + WS_IK) + rowA * 32 + 16 + 4 * fq) = w;
              *(f32x4*)((float*)(ws + WS_IW) + rowA * 16 + 4 * fq) = acc[2];
              w.x = cvtpk_s(acc[3][0], acc[3][1]); w.y = cvtpk_s(acc[3][2], acc[3][3]); *(u32x2*)((bf16_t*)(ws + WS_GLR) + rowA * 16 + 4 * fq) = w; }
        }
    }
}

struct EpiProj {
    static constexpr bool PERM = true, AFTER_DRAIN = false, MID = false;
    unsigned char* ws;
    __device__ __forceinline__ void operator()(const f32x4 (&acc)[2][2][4][2], const Unit& u, int wr, int wc, int fr, int fq) const {
        const int row0 = u.pm * 256 + wr * 64 + fr; const int pn = u.pn;
        {
            bf16_t* base; int ld, ct; float sc = 1.f;
            if (pn < 6) { base = (bf16_t*)(ws + WS_QKV); ld = 1536; ct = pn * 256; if (pn < 2) sc = QSCALE; }
            else if (pn < 8) { base = (bf16_t*)(ws + WS_IQ); ld = 512; ct = (pn - 6) * 256; }
            else if (pn < 10) { base = (bf16_t*)(ws + WS_GQK); ld = 512; ct = (pn - 8) * 256; }
            else if (pn < 12) { base = (bf16_t*)(ws + WS_GV); ld = 512; ct = (pn - 10) * 256; }
            else { base = (bf16_t*)(ws + WS_GR); ld = 512; ct = (pn - 12) * 256; }
            const int col0 = ct + wc * 32 + 8 * fq;
#pragma unroll
            for (int ai = 0; ai < 2; ++ai)
#pragma unroll
                for (int m = 0; m < 4; ++m) { bf16_t* rowp = base + (size_t)(row0 + ai * 128 + m * 16) * ld + col0;
#pragma unroll
                    for (int bj = 0; bj < 2; ++bj) { const f32x4 v0 = acc[ai][bj][m][0] * sc, v1 = acc[ai][bj][m][1] * sc;
                        u32x4 w; w.x = cvt_pk_bf16(v0[0], v0[1]); w.y = cvt_pk_bf16(v0[2], v0[3]); w.z = cvt_pk_bf16(v1[0], v1[1]); w.w = cvt_pk_bf16(v1[2], v1[3]);
                        *(u32x4*)(rowp + bj * 128) = w; } }
        }
    }
};

typedef float f32x4_t __attribute__((ext_vector_type(4)));
constexpr int SC_TILES_PER_B = 528, SC_ITEMS = NB * SC_TILES_PER_B;
__device__ __forceinline__ size_t keys_row_dw(int b, int t) {
    const int qi = t >> 7, r = t & 127; return (size_t)b * (SC_TILES_PER_B * 8192) + (size_t)8192 * (qi * (qi + 1) / 2) + (size_t)r * (qi + 1) * 64;
}
__device__ __forceinline__ unsigned score_key(float sc) {
    const _Float16 hf = (_Float16)sc; const unsigned short hb = __builtin_bit_cast(unsigned short, hf);
    return (hb & 0x8000u) ? (unsigned)(unsigned short)~hb : (unsigned)(hb | 0x8000u);
}
__device__ __forceinline__ void fma_abs4(f32x4& acc, const f32x4& d, float w) {
    float a0 = acc[0], a1 = acc[1], a2 = acc[2], a3 = acc[3];
    asm volatile("v_fma_f32 %0, |%4|, %8, %0\n\tv_fma_f32 %1, |%5|, %8, %1\n\tv_fma_f32 %2, |%6|, %8, %2\n\tv_fma_f32 %3, |%7|, %8, %3"
                 : "+v"(a0), "+v"(a1), "+v"(a2), "+v"(a3) : "v"(d[0]), "v"(d[1]), "v"(d[2]), "v"(d[3]), "v"(w));
    acc[0] = a0; acc[1] = a1; acc[2] = a2; acc[3] = a3;
}
constexpr int SC_SEGS_PER_B = 144, SC_SEGS = NB * SC_SEGS_PER_B;
__device__ __forceinline__ unsigned score_key2(float lo, float hi) {
    typedef _Float16 h2 __attribute__((ext_vector_type(2)));
    const unsigned x = __builtin_bit_cast(unsigned, __builtin_amdgcn_cvt_pkrtz(lo, hi));
    unsigned m; asm("v_pk_ashrrev_i16 %0, %2, %1" : "=v"(m) : "v"(x), "v"(0x000F000Fu));
    return x ^ (m | 0x80008000u);
}
__device__ __forceinline__ void p3a_run(int b, int qi, int kj0, int kj1, unsigned char* ws, LAS unsigned char* ldsw, int wave, int lane) {
    const int fr = lane & 15, fq = lane >> 4;
    const int t = qi * 128 + wave * 16 + fr; const size_t trow = (size_t)b * NS + t;
    const bf16_t* IQ = (const bf16_t*)(ws + WS_IQ) + trow * 512 + 8 * fq;
    const bf16_t* IK = (const bf16_t*)(ws + WS_IK) + ((size_t)b * NS + fr) * 32 + 8 * fq;
    const float* IW = (const float*)(ws + WS_IW) + trow * 16;
    LAS unsigned char* QL = ldsw; LAS float* WL = (LAS float*)(ldsw + 16384);
    bf16x8 kf[8];
#pragma unroll
    for (int kb = 0; kb < 8; ++kb) kf[kb] = *(const bf16x8*)(IK + ((size_t)kj0 * 128 + kb * 16) * 32);
    float qb[8];
#pragma unroll
    for (int j = 0; j < 8; ++j) qb[j] = 0.f;
#pragma unroll
    for (int hg = 0; hg < 4; ++hg) {
        const f32x4 w4 = *(const f32x4*)(IW + 4 * hg) * (0.5f * 0.044194173824159216f);
        u32x4 q4[4];
#pragma unroll
        for (int i = 0; i < 4; ++i) q4[i] = *(const u32x4*)(IQ + (4 * hg + i) * 32);
#pragma unroll
        for (int i = 0; i < 4; ++i) { *(LAS u32x4*)(QL + (4 * hg + i) * 1024 + lane * 16) = q4[i]; if (fq == 0) WL[(4 * hg + i) * 16 + fr] = w4[i]; float f[8]; bf8_to_f(q4[i], f);
#pragma unroll
            for (int j = 0; j < 8; ++j) qb[j] += w4[i] * f[j]; }
    }
    u32x4 qbw; qbw.x = cvtpk_s(qb[0], qb[1]); qbw.y = cvtpk_s(qb[2], qb[3]); qbw.z = cvtpk_s(qb[4], qb[5]); qbw.w = cvtpk_s(qb[6], qb[7]);
    const bf16x8 qbar = __builtin_bit_cast(bf16x8, qbw);
    LDS_WAIT();
    for (int kj = kj0; kj <= kj1; ++kj) {
        bf16x8 kn[8];
        const int kjn = (kj < kj1) ? kj + 1 : kj;
#pragma unroll
        for (int kb = 0; kb < 8; ++kb) kn[kb] = *(const bf16x8*)(IK + ((size_t)kjn * 128 + kb * 16) * 32);
        f32x4 acc[8];
#pragma unroll
        for (int kb = 0; kb < 8; ++kb) acc[kb] = __builtin_amdgcn_mfma_f32_16x16x32_bf16(kf[kb], qbar, (f32x4){0.f, 0.f, 0.f, 0.f}, 0, 0, 0);
        f32x4 dA[8], dB[8];
        { const bf16x8 qf = *(const LAS bf16x8*)(QL + lane * 16);
#pragma unroll
          for (int kb = 0; kb < 8; ++kb) dA[kb] = __builtin_amdgcn_mfma_f32_16x16x32_bf16(kf[kb], qf, (f32x4){0.f, 0.f, 0.f, 0.f}, 0, 0, 0); }
#pragma unroll 1
        for (int h = 0; h < I_HEADS; h += 2) {
            { const bf16x8 qf = *(const LAS bf16x8*)(QL + (h + 1) * 1024 + lane * 16);
#pragma unroll
              for (int kb = 0; kb < 8; ++kb) dB[kb] = __builtin_amdgcn_mfma_f32_16x16x32_bf16(kf[kb], qf, (f32x4){0.f, 0.f, 0.f, 0.f}, 0, 0, 0); }
            __builtin_amdgcn_sched_barrier(0);
            { const float w = WL[h * 16 + fr];
#pragma unroll
              for (int kb = 0; kb < 8; ++kb) fma_abs4(acc[kb], dA[kb], w); }
            __builtin_amdgcn_sched_barrier(0);
            { const int hn = (h + 2 < I_HEADS) ? h + 2 : h; const bf16x8 qf = *(const LAS bf16x8*)(QL + hn * 1024 + lane * 16);
#pragma unroll
              for (int kb = 0; kb < 8; ++kb) dA[kb] = __builtin_amdgcn_mfma_f32_16x16x32_bf16(kf[kb], qf, (f32x4){0.f, 0.f, 0.f, 0.f}, 0, 0, 0); }
            __builtin_amdgcn_sched_barrier(0);
            { const float w = WL[(h + 1) * 16 + fr];
#pragma unroll
              for (int kb = 0; kb < 8; ++kb) fma_abs4(acc[kb], dB[kb], w); }
            __builtin_amdgcn_sched_barrier(0);
        }
        unsigned* KEYS = (unsigned*)(ws + WS_SC) + keys_row_dw(b, t) + (size_t)kj * 64;
        const bool diag = (kj == qi);
#pragma unroll
        for (int kb = 0; kb < 4; ++kb) { u32x4 o;
#pragma unroll
            for (int r = 0; r < 4; ++r) { const int sl = kb * 16 + 4 * fq + r;
                unsigned kk = score_key2(acc[kb][r], acc[kb + 4][r]);
                if (diag) { const int tl = wave * 16 + fr; if (sl > tl) kk &= 0xFFFF0000u; if (sl + 64 > tl) kk &= 0x0000FFFFu; }
                o[r] = kk; }
            *(u32x4*)(KEYS + kb * 16 + 4 * fq) = o; }
#pragma unroll
        for (int kb = 0; kb < 8; ++kb) kf[kb] = kn[kb];
    }
    LDS_WAIT();
}

__device__ __forceinline__ int dpp_row_sum(int v) {
    v += __builtin_amdgcn_update_dpp(0, v, 0xB1, 0xF, 0xF, true);
    v += __builtin_amdgcn_update_dpp(0, v, 0x4E, 0xF, 0xF, true);
    v += __builtin_amdgcn_update_dpp(0, v, 0x141, 0xF, 0xF, true);
    v += __builtin_amdgcn_update_dpp(0, v, 0x140, 0xF, 0xF, true);
    return v;
}
__device__ __forceinline__ int wave_sum_i(int v) {
    v = dpp_row_sum(v);
    return __builtin_amdgcn_readlane(v, 0) + __builtin_amdgcn_readlane(v, 16) + __builtin_amdgcn_readlane(v, 32) + __builtin_amdgcn_readlane(v, 48);
}
__device__ __forceinline__ void pk_ge_count4(unsigned x0, unsigned x1, unsigned x2, unsigned x3, unsigned c2m1, unsigned one2, unsigned& c0, unsigned& c1, unsigned& c2, unsigned& c3) {
    unsigned d0, d1, d2, d3;
    asm volatile("v_pk_sub_u16 %0, %8, %12 clamp\n\tv_pk_sub_u16 %1, %9, %12 clamp\n\tv_pk_sub_u16 %2, %10, %12 clamp\n\tv_pk_sub_u16 %3, %11, %12 clamp\n\t"
                 "v_pk_min_u16 %0, %0, %13\n\tv_pk_min_u16 %1, %1, %13\n\tv_pk_min_u16 %2, %2, %13\n\tv_pk_min_u16 %3, %3, %13\n\t"
                 "v_pk_add_u16 %4, %4, %0\n\tv_pk_add_u16 %5, %5, %1\n\tv_pk_add_u16 %6, %6, %2\n\tv_pk_add_u16 %7, %7, %3"
                 : "=&v"(d0), "=&v"(d1), "=&v"(d2), "=&v"(d3), "+v"(c0), "+v"(c1), "+v"(c2), "+v"(c3) : "v"(x0), "v"(x1), "v"(x2), "v"(x3), "v"(c2m1), "v"(one2));
}
constexpr int TOPK = 256;
__device__ __forceinline__ int count_ge(const unsigned (&x)[32], int ng, unsigned cand) {
    const unsigned c2m1 = (cand - 1u) * 0x00010001u, one2 = 0x00010001u; unsigned c0 = 0u, c1 = 0u, c2 = 0u, c3 = 0u;
#pragma unroll
    for (int g = 0; g < 4; ++g) if (g < ng) { pk_ge_count4(x[8 * g], x[8 * g + 1], x[8 * g + 2], x[8 * g + 3], c2m1, one2, c0, c1, c2, c3); pk_ge_count4(x[8 * g + 4], x[8 * g + 5], x[8 * g + 6], x[8 * g + 7], c2m1, one2, c0, c1, c2, c3); }
    const unsigned s = (c0 + c1) + (c2 + c3);
    return wave_sum_i((int)((s & 0xFFFFu) + (s >> 16)));
}
__device__ __forceinline__ void p4a_load(int row_, unsigned char* ws, int lane, unsigned (&x)[32]) {
    const int row = __builtin_amdgcn_readfirstlane(row_); const int b = row / NS, t = row % NS; const int nc = (t >> 7) + 1;
    const unsigned* KEYS = (const unsigned*)(ws + WS_SC) + keys_row_dw(b, t) + lane;
#pragma unroll
    for (int c = 0; c < 32; ++c) { const int cc = c < nc ? c : nc - 1; const unsigned v = KEYS[cc * 64]; x[c] = c < nc ? v : 0u; }
}
__device__ __forceinline__ int scan16_incl(int v) {
    v += __builtin_amdgcn_update_dpp(0, v, 0x111, 0xF, 0xF, true);
    v += __builtin_amdgcn_update_dpp(0, v, 0x112, 0xF, 0xF, true);
    v += __builtin_amdgcn_update_dpp(0, v, 0x114, 0xF, 0xF, true);
    v += __builtin_amdgcn_update_dpp(0, v, 0x118, 0xF, 0xF, true);
    return v;
}
__device__ __forceinline__ int scan64_incl(int v, int lane) {
    v = scan16_incl(v);
    const int t0 = __builtin_amdgcn_readlane(v, 15), t1 = __builtin_amdgcn_readlane(v, 31), t2 = __builtin_amdgcn_readlane(v, 47);
    return v + (lane >= 16 ? t0 : 0) + (lane >= 32 ? t1 : 0) + (lane >= 48 ? t2 : 0);
}
__device__ __forceinline__ void lds_inc(LAS unsigned char* p) { __hip_atomic_fetch_add((LAS unsigned*)p, 1u, __ATOMIC_RELAXED, __HIP_MEMORY_SCOPE_WORKGROUP); }
#define WAVE_LDS_ORDER() do { asm volatile("" ::: "memory"); __builtin_amdgcn_fence(__ATOMIC_ACQ_REL, "wavefront"); __builtin_amdgcn_wave_barrier(); asm volatile("" ::: "memory"); } while (0)
constexpr int SEL_LDS = 8192;
__device__ __forceinline__ void p4a_row(int row_, unsigned char* ws, int lane, const unsigned (&x)[32], LAS unsigned char* H) {
    const int row = __builtin_amdgcn_readfirstlane(row_);
    const int t = row % NS; unsigned long long* MASK = (unsigned long long*)(ws + WS_MASK) + (size_t)row * 64;
    const int nc = (t >> 7) + 1;
    if (t < TOPK) {
        if (lane < 2 * nc) { const int lo = lane * 64; unsigned long long m = 0ull; if (t >= lo + 63) m = ~0ull; else if (t >= lo) m = (2ull << (t - lo)) - 1ull; MASK[lane] = m; }
        return;
    }
    const int ng = (nc + 7) >> 3;
    { const u32x4 z = (u32x4){0u, 0u, 0u, 0u};
#pragma unroll
      for (int i = 0; i < 4; ++i) *(LAS u32x4*)(H + i * 1024 + lane * 16) = z;
      *(LAS unsigned*)(H + 4096 + lane * 4) = 0u; }
    WAVE_LDS_ORDER();
#pragma unroll
    for (int c = 0; c < 32; ++c) if (c < nc) { lds_inc(H + ((x[c] >> 4) & 0xFFCu)); lds_inc(H + ((x[c] >> 20) & 0xFFCu)); }
    WAVE_LDS_ORDER();
    int Bsel, cA;
    {   const LAS unsigned char* hp = H + (63 - lane) * 64;
        const u32x4 h0 = *(const LAS u32x4*)hp, h1 = *(const LAS u32x4*)(hp + 16), h2 = *(const LAS u32x4*)(hp + 32), h3 = *(const LAS u32x4*)(hp + 48);
        const int sl = (int)(((h0.x + h0.y) + (h0.z + h0.w)) + ((h1.x + h1.y) + (h1.z + h1.w)) + ((h2.x + h2.y) + (h2.z + h2.w)) + ((h3.x + h3.y) + (h3.z + h3.w)));
        const int P = scan64_incl(sl, lane);
        const int Ls = __builtin_ctzll(__ballot(P >= TOPK));
        const int E = __builtin_amdgcn_readlane(P - sl, Ls);
        const int hj = (int)*(const LAS unsigned*)(H + ((63 - Ls) * 16 + 15 - (lane & 15)) * 4);
        const int Pj = scan16_incl(hj);
        const int jl = __builtin_ctzll(__ballot(E + Pj >= TOPK) & 0xFFFFull);
        Bsel = (63 - Ls) * 16 + 15 - jl; cA = E + __builtin_amdgcn_readlane(Pj - hj, jl);
    }
    {   const unsigned Bs2 = ((unsigned)Bsel << 6) * 0x00010001u;
#pragma unroll
        for (int c = 0; c < 32; ++c) if (c < nc) { const unsigned y = x[c] ^ Bs2;
            if ((y & 0xFFFFu) < 64u) lds_inc(H + 4096 + ((y & 63u) << 2));
            if (y < 0x400000u) lds_inc(H + 4096 + ((y >> 16) << 2)); }
    }
    WAVE_LDS_ORDER();
    unsigned T; int cT, need;
    {   const int c2 = (int)*(const LAS unsigned*)(H + 4096 + (63 - lane) * 4);
        const int P2 = scan64_incl(c2, lane);
        const int L2 = __builtin_ctzll(__ballot(cA + P2 >= TOPK));
        cT = cA + __builtin_amdgcn_readlane(P2, L2); need = TOPK - (cT - __builtin_amdgcn_readlane(c2, L2));
        T = ((unsigned)Bsel << 6) + (unsigned)(63 - L2);
    }
    unsigned mw0 = 0u, mw1 = 0u;
    if (cT == TOPK) {
#pragma unroll
        for (int g = 0; g < 4; ++g) if (g < ng) {
#pragma unroll
            for (int i = 0; i < 8; ++i) { const int c = 8 * g + i;
                const unsigned long long mlo = __ballot((x[c] & 0xFFFFu) >= T), mhi = __ballot((x[c] >> 16) >= T);
                asm volatile("s_nop 3\n\tv_writelane_b32 %0, %2, %4\n\tv_writelane_b32 %1, %3, %4" : "+v"(mw0), "+v"(mw1) : "s"((unsigned)mlo), "s"((unsigned)(mlo >> 32)), "n"(2 * c));
                asm volatile("s_nop 3\n\tv_writelane_b32 %0, %2, %4\n\tv_writelane_b32 %1, %3, %4" : "+v"(mw0), "+v"(mw1) : "s"((unsigned)mhi), "s"((unsigned)(mhi >> 32)), "n"(2 * c + 1)); }
        }
    } else {
        int run = 0;
#pragma unroll
        for (int g = 0; g < 4; ++g) if (g < ng) {
#pragma unroll
            for (int i = 0; i < 8; ++i) { const int c = 8 * g + i;
                const unsigned klo = x[c] & 0xFFFFu, khi = x[c] >> 16;
                const unsigned long long elo = __ballot(klo == T), ehi = __ballot(khi == T);
                const int rlo = run + (int)__builtin_amdgcn_mbcnt_hi((unsigned)(elo >> 32), __builtin_amdgcn_mbcnt_lo((unsigned)elo, 0u));
                const int nlo = __builtin_popcountll(elo);
                const int rhi = run + nlo + (int)__builtin_amdgcn_mbcnt_hi((unsigned)(ehi >> 32), __builtin_amdgcn_mbcnt_lo((unsigned)ehi, 0u));
                run += nlo + __builtin_popcountll(ehi);
                const bool slo = (klo > T) || (klo == T && rlo < need), shi = (khi > T) || (khi == T && rhi < need);
                const unsigned long long mlo = __ballot(slo), mhi = __ballot(shi);
                asm volatile("s_nop 3\n\tv_writelane_b32 %0, %2, %4\n\tv_writelane_b32 %1, %3, %4" : "+v"(mw0), "+v"(mw1) : "s"((unsigned)mlo), "s"((unsigned)(mlo >> 32)), "n"(2 * c));
                asm volatile("s_nop 3\n\tv_writelane_b32 %0, %2, %4\n\tv_writelane_b32 %1, %3, %4" : "+v"(mw0), "+v"(mw1) : "s"((unsigned)mhi), "s"((unsigned)(mhi >> 32)), "n"(2 * c + 1)); }
        }
    }
    if (lane < 2 * nc) MASK[lane] = ((unsigned long long)mw1 << 32) | mw0;
}

typedef float f32x16 __attribute__((ext_vector_type(16)));
typedef short s16x4 __attribute__((ext_vector_type(4)));
__device__ __forceinline__ int crow(int r, int hi) { return (r & 3) + 8 * (r >> 2) + 4 * hi; }
__device__ __forceinline__ s16x4 vtr(const LAS unsigned char* p) { return __builtin_bit_cast(s16x4, __builtin_amdgcn_ds_read_tr16_b64_v4i16((LAS s16x4*)p)); }
constexpr size_t WS_OAB = 358 * MiB;
constexpr int AT_ROWB = 144, AT_TILE = 64 * AT_ROWB;
constexpr int AT_VROWB = 192, AT_VTILE = 64 * AT_VROWB;
constexpr float LOG2E = 1.4426950408889634f;
constexpr float ATHR = 8.f;
__device__ __forceinline__ int sext_bit(unsigned w, int c) { int r; asm("v_bfe_i32 %0, %1, %2, 1" : "=v"(r) : "v"(w), "n"(c)); return r; }
__device__ __forceinline__ void attn_s(const LAS unsigned char* Kb, const LAS float* BT, const bf16x8 (&qr)[4], unsigned long long mword, bool far, bool first, int dist0,
                                       int r32, int hh, f32x16& o0, f32x16& o1, f32x16& o2, f32x16& nmB, float& mref, u32x4 (&pk)[4]) {
    f32x16 p0, p1;
#pragma unroll
    for (int ks = 0; ks < 4; ++ks) {
        const bf16x8 k0 = *(const LAS bf16x8*)(Kb + r32 * AT_ROWB + 32 * ks + 16 * hh);
        const bf16x8 k1 = *(const LAS bf16x8*)(Kb + (32 + r32) * AT_ROWB + 32 * ks + 16 * hh);
        if (ks == 0) { p0 = __builtin_amdgcn_mfma_f32_32x32x16_bf16(k0, qr[0], nmB, 0, 0, 0); p1 = __builtin_amdgcn_mfma_f32_32x32x16_bf16(k1, qr[0], nmB, 0, 0, 0); }
        else { p0 = __builtin_amdgcn_mfma_f32_32x32x16_bf16(k0, qr[ks], p0, 0, 0, 0); p1 = __builtin_amdgcn_mfma_f32_32x32x16_bf16(k1, qr[ks], p1, 0, 0, 0); }
    }
    if (!far) {
        const LAS float* bp = BT + (96 - 27 - 32) + dist0;
#pragma unroll
        for (int i = 0; i < 16; ++i) { const int c = (i & 3) + 8 * (i >> 2); p0[i] += bp[32 + 27 - c]; p1[i] += bp[27 - c]; }
    }
    float m0 = __builtin_fmaxf(__builtin_fmaxf(p0[0], p0[1]), p0[2]), m1 = __builtin_fmaxf(__builtin_fmaxf(p1[0], p1[1]), p1[2]);
#pragma unroll
    for (int i = 3; i < 15; i += 2) { m0 = __builtin_fmaxf(__builtin_fmaxf(m0, p0[i]), p0[i + 1]); m1 = __builtin_fmaxf(__builtin_fmaxf(m1, p1[i]), p1[i + 1]); }
    float mx = __builtin_fmaxf(__builtin_fmaxf(m0, m1), __builtin_fmaxf(p0[15], p1[15]));
    { const auto rr = __builtin_amdgcn_permlane32_swap(__float_as_uint(mx), __float_as_uint(mx), false, false); mx = __builtin_fmaxf(__uint_as_float(rr[0]), __uint_as_float(rr[1])); }
    if (first || __any(mx > ATHR)) {
        const float dl = (first || mx > ATHR) ? mx : 0.f; mref += dl; const float f = __builtin_amdgcn_exp2f(-dl);
#pragma unroll
        for (int i = 0; i < 16; ++i) { p0[i] -= dl; p1[i] -= dl; nmB[i] -= dl; o0[i] *= f; o1[i] *= f; o2[i] *= f; }
    }
    const unsigned wl = (unsigned)mword >> (4 * hh), wh = (unsigned)(mword >> 32) >> (4 * hh);
#pragma unroll
    for (int i = 0; i < 16; ++i) { const int c = (i & 3) + 8 * (i >> 2);
        p0[i] = __uint_as_float(__float_as_uint(__builtin_amdgcn_exp2f(p0[i])) & (unsigned)sext_bit(wl, c));
        p1[i] = __uint_as_float(__float_as_uint(__builtin_amdgcn_exp2f(p1[i])) & (unsigned)sext_bit(wh, c)); }
#pragma unroll
    for (int s2 = 0; s2 < 2; ++s2) {
        pk[s2].x = cvtpk_s(p0[8 * s2], p0[8 * s2 + 1]); pk[s2].y = cvtpk_s(p0[8 * s2 + 2], p0[8 * s2 + 3]); pk[s2].z = cvtpk_s(p0[8 * s2 + 4], p0[8 * s2 + 5]); pk[s2].w = cvtpk_s(p0[8 * s2 + 6], p0[8 * s2 + 7]);
        pk[2 + s2].x = cvtpk_s(p1[8 * s2], p1[8 * s2 + 1]); pk[2 + s2].y = cvtpk_s(p1[8 * s2 + 2], p1[8 * s2 + 3]); pk[2 + s2].z = cvtpk_s(p1[8 * s2 + 4], p1[8 * s2 + 5]); pk[2 + s2].w = cvtpk_s(p1[8 * s2 + 6], p1[8 * s2 + 7]); }
}
__device__ __forceinline__ void attn_pv(const LAS unsigned char* Vb, const u32x4 (&pk)[4], int voff, f32x16& o0, f32x16& o1, f32x16& o2) {
    const u32x4 onesw = (u32x4){0x3F803F80u, 0x3F803F80u, 0x3F803F80u, 0x3F803F80u}; const bf16x8 ones = __builtin_bit_cast(bf16x8, onesw);
#pragma unroll
    for (int q = 0; q < 4; ++q) {
        const bf16x8 pf = __builtin_bit_cast(bf16x8, pk[q]);
        const LAS unsigned char* vp = Vb + (16 * q) * AT_VROWB + voff;
        const s16x4 a0l = vtr(vp), a0h = vtr(vp + 8 * AT_VROWB), a1l = vtr(vp + 64), a1h = vtr(vp + 8 * AT_VROWB + 64);
        const bf16x8 va0 = (bf16x8){a0l[0], a0l[1], a0l[2], a0l[3], a0h[0], a0h[1], a0h[2], a0h[3]};
        const bf16x8 va1 = (bf16x8){a1l[0], a1l[1], a1l[2], a1l[3], a1h[0], a1h[1], a1h[2], a1h[3]};
        o0 = __builtin_amdgcn_mfma_f32_32x32x16_bf16(va0, pf, o0, 0, 0, 0);
        o1 = __builtin_amdgcn_mfma_f32_32x32x16_bf16(va1, pf, o1, 0, 0, 0);
        o2 = __builtin_amdgcn_mfma_f32_32x32x16_bf16(ones, pf, o2, 0, 0, 0);
    }
}
constexpr int AT_KB = 0, AT_VB = 2 * AT_TILE, AT_BT3 = AT_VB + 3 * AT_VTILE;
template <bool GB> __device__ __forceinline__ void attn_unit(int b, int h, int Q, const float* rel_bias, unsigned char* ws, LAS unsigned char* lds) {
    const int tid = threadIdx.x, lane = tid & 63, wave = __builtin_amdgcn_readfirstlane(tid >> 6), r32 = lane & 31, hh = lane >> 5;
    const size_t rowbase = (size_t)b * NS; const int t0w = 256 * Q + 32 * wave, t = t0w + r32;
    const bf16_t* QKV = (const bf16_t*)(ws + WS_QKV);
    LAS float* BT = (LAS float*)(lds + AT_BT3);
    const int NTL = 4 * (Q + 1);
    const int lastw = (t0w + 31) >> 6;
    const int srow = tid >> 3, sch = tid & 7;
    const bf16_t* kg = QKV + (rowbase + srow) * 1536 + 512 + h * 64 + sch * 8; const bf16_t* vg = kg + 512;
    const int soff = srow * AT_ROWB + sch * 16, svoff = srow * AT_VROWB + sch * 16;
    const unsigned long long* MK = (const unsigned long long*)(ws + WS_MASK) + (rowbase + t) * 64;
    const size_t tstride = (size_t)64 * 1536;
    u32x4 k0r = *(const u32x4*)kg, v0r = *(const u32x4*)vg;
    u32x4 kA = *(const u32x4*)(kg + tstride), vA = *(const u32x4*)(vg + tstride);
    u32x4 kB = *(const u32x4*)(kg + 2 * tstride), vB = *(const u32x4*)(vg + 2 * tstride);
    unsigned long long me = MK[0], mo = MK[(1 <= lastw) ? 1 : 0];
    bf16x8 qr[4];
#pragma unroll
    for (int ks = 0; ks < 4; ++ks) qr[ks] = *(const bf16x8*)(QKV + (rowbase + t) * 1536 + h * 64 + 16 * ks + 8 * hh);
    const float cB = rel_bias[31 * A_HEADS + h] * LOG2E;
    __syncthreads();
    if (tid < 352) { const int d = tid - 96; BT[tid] = rel_bias[v0_bucket(d < 0 ? 0 : d) * A_HEADS + h] * LOG2E - cB; }
    *(LAS u32x4*)(lds + AT_KB + soff) = k0r; *(LAS u32x4*)(lds + AT_VB + svoff) = v0r;
    f32x16 o0, o1, o2, nmB;
#pragma unroll
    for (int i = 0; i < 16; ++i) { o0[i] = 0.f; o1[i] = 0.f; o2[i] = 0.f; nmB[i] = cB; }
    float mref = 0.f;
    const int q4 = (lane & 15) >> 2, p4 = lane & 3, blk = (lane >> 4) & 1;
    const int voff = (4 * hh + q4) * AT_VROWB + (16 * blk + 4 * p4) * 2;
    u32x4 pk[4];
#pragma unroll
    for (int q = 0; q < 4; ++q) pk[q] = (u32x4){0u, 0u, 0u, 0u};
    int vcur = 0, vnext = AT_VTILE, vprev = 2 * AT_VTILE;
    for (int kt = 0; kt < NTL; kt += 2) {
        __syncthreads();
        *(LAS u32x4*)(lds + AT_KB + AT_TILE + soff) = kA; *(LAS u32x4*)(lds + AT_VB + vnext + svoff) = vA;
        { const int tn = (kt + 3 < NTL) ? kt + 3 : NTL - 1; kA = *(const u32x4*)(kg + (size_t)tn * tstride); vA = *(const u32x4*)(vg + (size_t)tn * tstride); }
        if (GB) { if (kt >= 1 && kt - 1 <= lastw) attn_pv(lds + AT_VB + vprev, pk, voff, o0, o1, o2); }
        if (kt <= lastw) attn_s(lds + AT_KB, BT, qr, me, (t0w - (64 * kt + 63) >= 113), kt == 0, t - 64 * kt - 4 * hh, r32, hh, o0, o1, o2, nmB, mref, pk);
        if (!GB) { if (kt <= lastw) attn_pv(lds + AT_VB + vcur, pk, voff, o0, o1, o2); }
        me = MK[(kt + 2 <= lastw) ? kt + 2 : lastw];
        { const int tmp = vprev; vprev = vcur; vcur = vnext; vnext = tmp; }
        __syncthreads();
        *(LAS u32x4*)(lds + AT_KB + soff) = kB; *(LAS u32x4*)(lds + AT_VB + vnext + svoff) = vB;
        { const int tn = (kt + 4 < NTL) ? kt + 4 : NTL - 1; kB = *(const u32x4*)(kg + (size_t)tn * tstride); vB = *(const u32x4*)(vg + (size_t)tn * tstride); }
        if (GB) { if (kt <= lastw) attn_pv(lds + AT_VB + vprev, pk, voff, o0, o1, o2); }
        if (kt + 1 <= lastw) attn_s(lds + AT_KB + AT_TILE, BT, qr, mo, (t0w - (64 * (kt + 1) + 63) >= 113), false, t - 64 * (kt + 1) - 4 * hh, r32, hh, o0, o1, o2, nmB, mref, pk);
        if (!GB) { if (kt + 1 <= lastw) attn_pv(lds + AT_VB + vcur, pk, voff, o0, o1, o2); }
        mo = MK[(kt + 3 <= lastw) ? kt + 3 : lastw];
        { const int tmp = vprev; vprev = vcur; vcur = vnext; vnext = tmp; }
    }
    if (GB) {
        if (NTL - 1 <= lastw) attn_pv(lds + AT_VB + vprev, pk, voff, o0, o1, o2);
    }
    const float inv = 1.f / o2[0];
    bf16_t* O = (bf16_t*)(ws + WS_OAB) + (rowbase + t) * 1024 + h * 64 + 4 * hh;
#pragma unroll
    for (int g = 0; g < 4; ++g) {
        u32x2 w0, w1; w0.x = cvtpk_s(o0[4 * g] * inv, o0[4 * g + 1] * inv); w0.y = cvtpk_s(o0[4 * g + 2] * inv, o0[4 * g + 3] * inv);
        w1.x = cvtpk_s(o1[4 * g] * inv, o1[4 * g + 1] * inv); w1.y = cvtpk_s(o1[4 * g + 2] * inv, o1[4 * g + 3] * inv);
        *(u32x2*)(O + 8 * g) = w0; *(u32x2*)(O + 32 + 8 * g) = w1;
    }
}

constexpr int GL_LG = 0, GL_SEG = 16384, GL_A = 18432, GL_B = GL_A + 9216, GL_C = GL_B + 9216, GL_VT = GL_C + 9216, GL_ST = GL_VT + 18432;
constexpr int GROWB = 144;
constexpr int GLA_ITEMS = NB * G_HEADS * 64;
__device__ __forceinline__ void gla_cumdecay(const u32x4 g0, const u32x4 g1, int h, const float* wg, const float* bg, LAS unsigned char* lds, float* lgc) {
    const int tid = threadIdx.x; LAS float* LG = (LAS float*)(lds + GL_LG); LAS float* SEG = (LAS float*)(lds + GL_SEG);
    {   const int c = tid >> 3, dg = tid & 7; float gl[16];
#pragma unroll
        for (int j = 0; j < 4; ++j) { gl[2 * j] = __uint_as_float(g0[j] << 16); gl[2 * j + 1] = __uint_as_float(g0[j] & 0xffff0000u); gl[8 + 2 * j] = __uint_as_float(g1[j] << 16); gl[8 + 2 * j + 1] = __uint_as_float(g1[j] & 0xffff0000u); }
        float z[8];
#pragma unroll
        for (int j = 0; j < 8; ++j) z[j] = bg[h * 64 + 8 * dg + j];
#pragma unroll
        for (int r = 0; r < 16; ++r) { const f32x4 w0 = *(const f32x4*)(wg + r * G_KW + h * 64 + 8 * dg), w1 = *(const f32x4*)(wg + r * G_KW + h * 64 + 8 * dg + 4);
            z[0] += gl[r] * w0[0]; z[1] += gl[r] * w0[1]; z[2] += gl[r] * w0[2]; z[3] += gl[r] * w0[3]; z[4] += gl[r] * w1[0]; z[5] += gl[r] * w1[1]; z[6] += gl[r] * w1[2]; z[7] += gl[r] * w1[3]; }
#pragma unroll
        for (int j = 0; j < 8; ++j) z[j] = (fminf(z[j], 0.f) - log1pf(__expf(-fabsf(z[j])))) * (1.f / 16.f);
        *(LAS f32x4*)(LG + c * 64 + 8 * dg) = (f32x4){z[0], z[1], z[2], z[3]}; *(LAS f32x4*)(LG + c * 64 + 8 * dg + 4) = (f32x4){z[4], z[5], z[6], z[7]};
    }
    __syncthreads();
    const int seg = tid >> 6, d = tid & 63; float v[8];
#pragma unroll
    for (int i = 0; i < 8; ++i) v[i] = LG[(8 * seg + i) * 64 + d];
#pragma unroll
    for (int i = 1; i < 8; ++i) v[i] += v[i - 1];
    SEG[seg * 64 + d] = v[7];
    __syncthreads();
    float off = 0.f;
#pragma unroll
    for (int s2 = 0; s2 < 8; ++s2) if (s2 < seg) off += SEG[s2 * 64 + d];
#pragma unroll
    for (int i = 0; i < 8; ++i) { const float bv = v[i] + off; LG[(8 * seg + i) * 64 + d] = bv; lgc[(8 * seg + i) * 64 + d] = bv; }
    __syncthreads();
}
__device__ __forceinline__ unsigned short f2bf_s(float f) { return (unsigned short)(cvtpk_s(f, 0.f) & 0xffffu); }
__device__ __forceinline__ void gla_stage_vt(const u32x4 a, const u32x4 b2, LAS unsigned char* lds) {
    const int tid = threadIdx.x, c = tid >> 3, d0 = (tid & 7) * 16;
#pragma unroll
    for (int j = 0; j < 4; ++j) {
        *(LAS unsigned short*)(lds + GL_VT + (d0 + 2 * j) * GROWB + c * 2) = (unsigned short)(a[j] & 0xffffu); *(LAS unsigned short*)(lds + GL_VT + (d0 + 2 * j + 1) * GROWB + c * 2) = (unsigned short)(a[j] >> 16);
        *(LAS unsigned short*)(lds + GL_VT + (d0 + 8 + 2 * j) * GROWB + c * 2) = (unsigned short)(b2[j] & 0xffffu); *(LAS unsigned short*)(lds + GL_VT + (d0 + 8 + 2 * j + 1) * GROWB + c * 2) = (unsigned short)(b2[j] >> 16); }
}
__device__ __forceinline__ void p3b_item(int it, const float* wg, const float* bg, float* UT, float* LGC, unsigned char* ws, LAS unsigned char* lds) {
    const int tid = threadIdx.x, lane = tid & 63, wave = tid >> 6, fr = lane & 15, fq = lane >> 4;
    const int bh = it >> 6, n = it & 63, b = bh >> 2, h = bh & 3; const size_t r0 = (size_t)b * NS + 64 * n;
    const int c_ = tid >> 3, dg_ = tid & 7;
    const bf16_t* gp_ = (const bf16_t*)(ws + WS_GLR) + (r0 + c_) * 16; const u32x4 g0 = *(const u32x4*)gp_, g1 = *(const u32x4*)(gp_ + 8);
    const u32x4 kraw = *(const u32x4*)((const bf16_t*)(ws + WS_GQK) + (r0 + c_) * 512 + 256 + h * 64 + 8 * dg_);
    const bf16_t* vp_ = (const bf16_t*)(ws + WS_GV) + (r0 + c_) * 512 + h * 128 + dg_ * 16; const u32x4 va_ = *(const u32x4*)vp_, vb_ = *(const u32x4*)(vp_ + 8);
    __syncthreads();
    gla_cumdecay(g0, g1, h, wg, bg, lds, LGC + (size_t)it * 4096);
    const LAS float* LG = (const LAS float*)(lds + GL_LG);
    {   const int c = tid >> 3, dg = tid & 7; float kf[8]; bf8_to_f(kraw, kf);
#pragma unroll
        for (int j = 0; j < 8; ++j) { const int d = 8 * dg + j; *(LAS unsigned short*)(lds + GL_A + d * GROWB + c * 2) = f2bf_s(kf[j] * __expf(LG[63 * 64 + d] - LG[c * 64 + d])); }
        if (tid < 64) ((float*)(ws + WS_MISC))[(size_t)it * 64 + tid] = __expf(LG[63 * 64 + tid]);
    }
    gla_stage_vt(va_, vb_, lds);
    __syncthreads();
    f32x4 acc[4];
#pragma unroll
    for (int i = 0; i < 4; ++i) acc[i] = (f32x4){0.f, 0.f, 0.f, 0.f};
#pragma unroll
    for (int ks = 0; ks < 2; ++ks) { const bf16x8 bv = *(const LAS bf16x8*)(lds + GL_VT + (16 * wave + fr) * GROWB + (32 * ks + 8 * fq) * 2);
#pragma unroll
        for (int i = 0; i < 4; ++i) { const bf16x8 av = *(const LAS bf16x8*)(lds + GL_A + (16 * i + fr) * GROWB + (32 * ks + 8 * fq) * 2); acc[i] = __builtin_amdgcn_mfma_f32_16x16x32_bf16(av, bv, acc[i], 0, 0, 0); } }
#pragma unroll
    for (int i = 0; i < 4; ++i) *(f32x4*)(UT + ((size_t)it * 128 + 16 * wave + fr) * 64 + 16 * i + 4 * fq) = acc[i];
}
__device__ __forceinline__ void p4b_item(int j, const float* UT, bf16_t* SP, unsigned char* ws) {
    const int tid = threadIdx.x, bh = j >> 3, dv = (j & 7) * 16 + (tid >> 5), dk = (tid & 31) * 2; const float* DEC = (const float*)(ws + WS_MISC);
    typedef float f32x2v __attribute__((ext_vector_type(2)));
    f32x2v st = (f32x2v){0.f, 0.f};
#pragma unroll 8
    for (int n = 0; n < 64; ++n) { const size_t it = (size_t)bh * 64 + n; const size_t o = (it * 128 + dv) * 64 + dk;
        *(unsigned*)(SP + o) = cvtpk_s(st[0], st[1]);
        const f32x2v u = *(const f32x2v*)(UT + o), dc = *(const f32x2v*)(DEC + it * 64 + dk); st = dc * st + u; }
}
__device__ __forceinline__ void p5b_item(int it, const float* LGC, const float* ng, const bf16_t* SP, unsigned char* ws, LAS unsigned char* lds) {
    const int tid = threadIdx.x, lane = tid & 63, wave = tid >> 6, r32 = lane & 31, hh = lane >> 5;
    const int bh = it >> 6, n = it & 63, b = bh >> 2, h = bh & 3; const size_t r0 = (size_t)b * NS + 64 * n;
    const int c_ = tid >> 3, dg_ = tid & 7; const int dvb = wave >> 1, cb = wave & 1;
    const f32x4 lg0 = *(const f32x4*)(LGC + (size_t)it * 4096 + c_ * 64 + 8 * dg_), lg1 = *(const f32x4*)(LGC + (size_t)it * 4096 + c_ * 64 + 8 * dg_ + 4);
    const bf16_t* qp_ = (const bf16_t*)(ws + WS_GQK) + (r0 + c_) * 512 + h * 64 + 8 * dg_; const u32x4 qraw = *(const u32x4*)qp_, kraw = *(const u32x4*)(qp_ + 256);
    const bf16_t* vp_ = (const bf16_t*)(ws + WS_GV) + (r0 + c_) * 512 + h * 128 + dg_ * 16; const u32x4 va_ = *(const u32x4*)vp_, vb_ = *(const u32x4*)(vp_ + 8);
    bf16x8 spf[4];
#pragma unroll
    for (int ks = 0; ks < 4; ++ks) spf[ks] = *(const bf16x8*)(SP + ((size_t)it * 128 + 32 * dvb + r32) * 64 + 16 * ks + 8 * hh);
    const size_t trow = r0 + 32 * cb + r32; const int dvbase = h * 128 + 32 * dvb + 4 * hh;
    const bf16_t* grp = (const bf16_t*)(ws + WS_GR) + trow * 512 + dvbase; u32x2 grw[4];
#pragma unroll
    for (int g = 0; g < 4; ++g) grw[g] = *(const u32x2*)(grp + 8 * g);
    __syncthreads();
    { LAS float* LGw = (LAS float*)(lds + GL_LG); *(LAS f32x4*)(LGw + c_ * 64 + 8 * dg_) = lg0; *(LAS f32x4*)(LGw + c_ * 64 + 8 * dg_ + 4) = lg1; }
    __syncthreads();
    const LAS float* LG = (const LAS float*)(lds + GL_LG);
    {   const int c = tid >> 3, dg = tid & 7; float qf[8], kf[8]; bf8_to_f(qraw, qf); bf8_to_f(kraw, kf);
        float qr[8], ks[8], qi[8];
#pragma unroll
        for (int j = 0; j < 8; ++j) { const int d = 8 * dg + j; const float bc = LG[c * 64 + d], bl = LG[63 * 64 + d]; const float q8 = qf[j] * 0.125f;
            qr[j] = q8 * __expf(bc - bl); ks[j] = kf[j] * __expf(bl - bc); qi[j] = q8 * __expf(bc); }
        u32x4 w;
        w.x = cvtpk_s(qr[0], qr[1]); w.y = cvtpk_s(qr[2], qr[3]); w.z = cvtpk_s(qr[4], qr[5]); w.w = cvtpk_s(qr[6], qr[7]); *(LAS u32x4*)(lds + GL_A + c * GROWB + 16 * dg) = w;
        w.x = cvtpk_s(ks[0], ks[1]); w.y = cvtpk_s(ks[2], ks[3]); w.z = cvtpk_s(ks[4], ks[5]); w.w = cvtpk_s(ks[6], ks[7]); *(LAS u32x4*)(lds + GL_B + c * GROWB + 16 * dg) = w;
        w.x = cvtpk_s(qi[0], qi[1]); w.y = cvtpk_s(qi[2], qi[3]); w.z = cvtpk_s(qi[4], qi[5]); w.w = cvtpk_s(qi[6], qi[7]); *(LAS u32x4*)(lds + GL_C + c * GROWB + 16 * dg) = w;
    }
    gla_stage_vt(va_, vb_, lds);
    __syncthreads();
    f32x16 o;
#pragma unroll
    for (int i = 0; i < 16; ++i) o[i] = 0.f;
#pragma unroll
    for (int jb = 0; jb < 2; ++jb) if (jb <= cb) {
        f32x16 at;
#pragma unroll
        for (int i = 0; i < 16; ++i) at[i] = 0.f;
#pragma unroll
        for (int ks = 0; ks < 4; ++ks) { const bf16x8 av = *(const LAS bf16x8*)(lds + GL_B + (32 * jb + r32) * GROWB + 32 * ks + 16 * hh), bv = *(const LAS bf16x8*)(lds + GL_A + (32 * cb + r32) * GROWB + 32 * ks + 16 * hh);
            at = __builtin_amdgcn_mfma_f32_32x32x16_bf16(av, bv, at, 0, 0, 0); }
        if (jb == cb) {
#pragma unroll
            for (int i = 0; i < 16; ++i) if (crow(i, hh) > r32) at[i] = 0.f; }
#pragma unroll
        for (int s = 0; s < 2; ++s) {
            u32x4 pw; pw.x = cvtpk_s(at[8 * s], at[8 * s + 1]); pw.y = cvtpk_s(at[8 * s + 2], at[8 * s + 3]); pw.z = cvtpk_s(at[8 * s + 4], at[8 * s + 5]); pw.w = cvtpk_s(at[8 * s + 6], at[8 * s + 7]);
            const LAS unsigned char* vp = lds + GL_VT + (32 * dvb + r32) * GROWB + (32 * jb + 16 * s + 4 * hh) * 2;
            const u32x2 lo = *(const LAS u32x2*)vp, hi = *(const LAS u32x2*)(vp + 16);
            const u32x4 va = (u32x4){lo.x, lo.y, hi.x, hi.y};
            o = __builtin_amdgcn_mfma_f32_32x32x16_bf16(__builtin_bit_cast(bf16x8, va), __builtin_bit_cast(bf16x8, pw), o, 0, 0, 0);
        }
    }
#pragma unroll
    for (int ks = 0; ks < 4; ++ks) { const bf16x8 bv = *(const LAS bf16x8*)(lds + GL_C + (32 * cb + r32) * GROWB + 32 * ks + 16 * hh);
        o = __builtin_amdgcn_mfma_f32_32x32x16_bf16(spf[ks], bv, o, 0, 0, 0); }
    LAS float* ST = (LAS float*)(lds + GL_ST);
    float sm = 0.f;
#pragma unroll
    for (int i = 0; i < 16; ++i) sm += o[i];
    sm += __shfl_xor(sm, 32);
    if (hh == 0) ST[dvb * 64 + 32 * cb + r32] = sm;
    __syncthreads();
    const float mean = (ST[32 * cb + r32] + ST[64 + 32 * cb + r32] + ST[128 + 32 * cb + r32] + ST[192 + 32 * cb + r32]) * (1.f / 128.f);
    float sq = 0.f;
#pragma unroll
    for (int i = 0; i < 16; ++i) { o[i] -= mean; sq += o[i] * o[i]; }
    sq += __shfl_xor(sq, 32);
    if (hh == 0) ST[256 + dvb * 64 + 32 * cb + r32] = sq;
    __syncthreads();
    const float var = (ST[256 + 32 * cb + r32] + ST[256 + 64 + 32 * cb + r32] + ST[256 + 128 + 32 * cb + r32] + ST[256 + 192 + 32 * cb + r32]) * (1.f / 128.f);
    const float rstd = 1.f / sqrtf(var + LN_EPS);
    bf16_t* op = (bf16_t*)(ws + WS_OAB) + trow * 1024 + 512 + dvbase;
#pragma unroll
    for (int g = 0; g < 4; ++g) { const u32x2 gw = grw[g]; const f32x4 nv = *(const f32x4*)(ng + dvbase + 8 * g);
        float gr[4] = {__uint_as_float(gw.x << 16), __uint_as_float(gw.x & 0xffff0000u), __uint_as_float(gw.y << 16), __uint_as_float(gw.y & 0xffff0000u)}; float y[4];
#pragma unroll
        for (int e = 0; e < 4; ++e) y[e] = o[4 * g + e] * rstd * nv[e] * (gr[e] * __builtin_amdgcn_rcpf(1.f + __expf(-gr[e])));
        u32x2 w; w.x = cvtpk_s(y[0], y[1]); w.y = cvtpk_s(y[2], y[3]); *(u32x2*)(op + 8 * g) = w; }
}

constexpr int GL_HALF = 67584;
__device__ __forceinline__ void gla_cumdecay2(size_t r0, int h, const bf16_t* WGT, const float* bg, unsigned char* ws, LAS unsigned char* ldh, float* lgc) {
    const int tl = threadIdx.x & 255, lane = threadIdx.x & 63, wl = (threadIdx.x >> 6) & 3, r32 = lane & 31, hh = lane >> 5; LAS float* LG = (LAS float*)(ldh + GL_LG); LAS float* SEG = (LAS float*)(ldh + GL_SEG);
    {   const int cb = wl >> 1, db = wl & 1;
        const bf16x8 af = *(const bf16x8*)((const bf16_t*)(ws + WS_GLR) + (r0 + 32 * cb + r32) * 16 + 8 * hh), bfr = *(const bf16x8*)(WGT + (size_t)(h * 64 + 32 * db + r32) * 16 + 8 * hh);
        const float bias = bg[h * 64 + 32 * db + r32]; f32x16 z;
#pragma unroll
        for (int i = 0; i < 16; ++i) z[i] = bias;
        z = __builtin_amdgcn_mfma_f32_32x32x16_bf16(af, bfr, z, 0, 0, 0);
#pragma unroll
        for (int i = 0; i < 16; ++i) { const float zz = z[i]; LG[(32 * cb + crow(i, hh)) * 64 + 32 * db + r32] = (fminf(zz, 0.f) - __logf(1.f + __expf(-fabsf(zz)))) * (1.f / 16.f); }
    }
    __syncthreads();
    const int seg = tl >> 6, d = tl & 63; float v[16];
#pragma unroll
    for (int i = 0; i < 16; ++i) v[i] = LG[(16 * seg + i) * 64 + d];
#pragma unroll
    for (int i = 1; i < 16; ++i) v[i] += v[i - 1];
    SEG[seg * 64 + d] = v[15];
    __syncthreads();
    float off = 0.f;
#pragma unroll
    for (int s2 = 0; s2 < 4; ++s2) if (s2 < seg) off += SEG[s2 * 64 + d];
#pragma unroll
    for (int i = 0; i < 16; ++i) { const float bv = v[i] + off; LG[(16 * seg + i) * 64 + d] = bv; lgc[(16 * seg + i) * 64 + d] = bv; }
    __syncthreads();
}
__device__ __forceinline__ void gla_stage_vt2(const u32x4 (&vv)[4], LAS unsigned char* ldh) {
    const int tl = threadIdx.x & 255, c = tl >> 2, d0 = (tl & 3) * 32;
#pragma unroll
    for (int k = 0; k < 4; ++k)
#pragma unroll
        for (int j = 0; j < 4; ++j) {
            *(LAS unsigned short*)(ldh + GL_VT + (d0 + 8 * k + 2 * j) * GROWB + c * 2) = (unsigned short)(vv[k][j] & 0xffffu);
            *(LAS unsigned short*)(ldh + GL_VT + (d0 + 8 * k + 2 * j + 1) * GROWB + c * 2) = (unsigned short)(vv[k][j] >> 16); }
}
__device__ __forceinline__ void p3b_pair(int p, const float* wg, const float* bg, float* UT, float* LGC, unsigned char* ws, LAS unsigned char* lds) {
    const int tid = threadIdx.x, hb = tid >> 8, tl = tid & 255, lane = tid & 63, wl = (tid >> 6) & 3, fr = lane & 15, fq = lane >> 4;
    const int it = 2 * p + hb; LAS unsigned char* ldh = lds + hb * GL_HALF;
    const int bh = it >> 6, n = it & 63, b = bh >> 2, h = bh & 3; const size_t r0 = (size_t)b * NS + 64 * n;
    const int c_ = tl >> 2, dq_ = tl & 3;
    const bf16_t* kp_ = (const bf16_t*)(ws + WS_GQK) + (r0 + c_) * 512 + 256 + h * 64 + 16 * dq_; const u32x4 k0 = *(const u32x4*)kp_, k1 = *(const u32x4*)(kp_ + 8);
    const bf16_t* vp_ = (const bf16_t*)(ws + WS_GV) + (r0 + c_) * 512 + h * 128 + 32 * dq_; u32x4 vv[4];
#pragma unroll
    for (int k = 0; k < 4; ++k) vv[k] = *(const u32x4*)(vp_ + 8 * k);
    __syncthreads();
    gla_cumdecay2(r0, h, (const bf16_t*)(ws + WS_WGT), bg, ws, ldh, LGC + (size_t)it * 4096);
    const LAS float* LG = (const LAS float*)(ldh + GL_LG);
    {   float kf[16]; bf8_to_f(k0, kf); bf8_to_f(k1, kf + 8);
#pragma unroll
        for (int j = 0; j < 16; ++j) { const int d = 16 * dq_ + j; *(LAS unsigned short*)(ldh + GL_A + d * GROWB + c_ * 2) = f2bf_s(kf[j] * __expf(LG[63 * 64 + d] - LG[c_ * 64 + d])); }
        if (tl < 64) ((float*)(ws + WS_MISC))[(size_t)it * 64 + tl] = __expf(LG[63 * 64 + tl]);
    }
    gla_stage_vt2(vv, ldh);
    __syncthreads();
#pragma unroll
    for (int dvi = 0; dvi < 2; ++dvi) {
        const int dvblk = 2 * wl + dvi;
        f32x4 acc[4];
#pragma unroll
        for (int i = 0; i < 4; ++i) acc[i] = (f32x4){0.f, 0.f, 0.f, 0.f};
#pragma unroll
        for (int ks = 0; ks < 2; ++ks) { const bf16x8 bv = *(const LAS bf16x8*)(ldh + GL_VT + (16 * dvblk + fr) * GROWB + (32 * ks + 8 * fq) * 2);
#pragma unroll
            for (int i = 0; i < 4; ++i) { const bf16x8 av = *(const LAS bf16x8*)(ldh + GL_A + (16 * i + fr) * GROWB + (32 * ks + 8 * fq) * 2); acc[i] = __builtin_amdgcn_mfma_f32_16x16x32_bf16(av, bv, acc[i], 0, 0, 0); } }
#pragma unroll
        for (int i = 0; i < 4; ++i) *(f32x4*)(UT + ((size_t)it * 128 + 16 * dvblk + fr) * 64 + 16 * i + 4 * fq) = acc[i];
    }
}
__device__ __forceinline__ void p5b_pair(int p, const float* LGC, const float* ng, const bf16_t* SP, unsigned char* ws, LAS unsigned char* lds) {
    const int tid = threadIdx.x, hb = tid >> 8, tl = tid & 255, lane = tid & 63, wl = (tid >> 6) & 3, r32 = lane & 31, hh = lane >> 5;
    const int it = 2 * p + hb; LAS unsigned char* ldh = lds + hb * GL_HALF;
    const int bh = it >> 6, n = it & 63, b = bh >> 2, h = bh & 3; const size_t r0 = (size_t)b * NS + 64 * n;
    const int c_ = tl >> 2, dq_ = tl & 3; const int dvb = wl;
    f32x4 lg[4];
#pragma unroll
    for (int k = 0; k < 4; ++k) lg[k] = *(const f32x4*)(LGC + (size_t)it * 4096 + c_ * 64 + 16 * dq_ + 4 * k);
    const bf16_t* qp_ = (const bf16_t*)(ws + WS_GQK) + (r0 + c_) * 512 + h * 64 + 16 * dq_; const u32x4 q0 = *(const u32x4*)qp_, q1 = *(const u32x4*)(qp_ + 8), k0 = *(const u32x4*)(qp_ + 256), k1 = *(const u32x4*)(qp_ + 264);
    const bf16_t* vp_ = (const bf16_t*)(ws + WS_GV) + (r0 + c_) * 512 + h * 128 + 32 * dq_; u32x4 vv[4];
#pragma unroll
    for (int k = 0; k < 4; ++k) vv[k] = *(const u32x4*)(vp_ + 8 * k);
    bf16x8 spf[4];
#pragma unroll
    for (int ks = 0; ks < 4; ++ks) spf[ks] = *(const bf16x8*)(SP + ((size_t)it * 128 + 32 * dvb + r32) * 64 + 16 * ks + 8 * hh);
    const int dvbase = h * 128 + 32 * dvb + 4 * hh; u32x2 grw[2][4];
#pragma unroll
    for (int cb = 0; cb < 2; ++cb)
#pragma unroll
        for (int g = 0; g < 4; ++g) grw[cb][g] = *(const u32x2*)((const bf16_t*)(ws + WS_GR) + (r0 + 32 * cb + r32) * 512 + dvbase + 8 * g);
    __syncthreads();
    { LAS float* LGw = (LAS float*)(ldh + GL_LG);
#pragma unroll
      for (int k = 0; k < 4; ++k) *(LAS f32x4*)(LGw + c_ * 64 + 16 * dq_ + 4 * k) = lg[k]; }
    __syncthreads();
    const LAS float* LG = (const LAS float*)(ldh + GL_LG);
    {   float qf[16], kf[16]; bf8_to_f(q0, qf); bf8_to_f(q1, qf + 8); bf8_to_f(k0, kf); bf8_to_f(k1, kf + 8);
        float qr[16], ks[16], qi[16];
#pragma unroll
        for (int j = 0; j < 16; ++j) { const int d = 16 * dq_ + j; const float bc = LG[c_ * 64 + d], bl = LG[63 * 64 + d]; const float q8 = qf[j] * 0.125f;
            qr[j] = q8 * __expf(bc - bl); ks[j] = kf[j] * __expf(bl - bc); qi[j] = q8 * __expf(bc); }
#pragma unroll
        for (int k = 0; k < 2; ++k) { u32x4 w;
            w.x = cvtpk_s(qr[8 * k], qr[8 * k + 1]); w.y = cvtpk_s(qr[8 * k + 2], qr[8 * k + 3]); w.z = cvtpk_s(qr[8 * k + 4], qr[8 * k + 5]); w.w = cvtpk_s(qr[8 * k + 6], qr[8 * k + 7]); *(LAS u32x4*)(ldh + GL_A + c_ * GROWB + 32 * dq_ + 16 * k) = w;
            w.x = cvtpk_s(ks[8 * k], ks[8 * k + 1]); w.y = cvtpk_s(ks[8 * k + 2], ks[8 * k + 3]); w.z = cvtpk_s(ks[8 * k + 4], ks[8 * k + 5]); w.w = cvtpk_s(ks[8 * k + 6], ks[8 * k + 7]); *(LAS u32x4*)(ldh + GL_B + c_ * GROWB + 32 * dq_ + 16 * k) = w;
            w.x = cvtpk_s(qi[8 * k], qi[8 * k + 1]); w.y = cvtpk_s(qi[8 * k + 2], qi[8 * k + 3]); w.z = cvtpk_s(qi[8 * k + 4], qi[8 * k + 5]); w.w = cvtpk_s(qi[8 * k + 6], qi[8 * k + 7]); *(LAS u32x4*)(ldh + GL_C + c_ * GROWB + 32 * dq_ + 16 * k) = w; }
    }
    gla_stage_vt2(vv, ldh);
    __syncthreads();
    f32x16 o[2];
#pragma unroll
    for (int cb = 0; cb < 2; ++cb) {
#pragma unroll
        for (int i = 0; i < 16; ++i) o[cb][i] = 0.f;
#pragma unroll
        for (int jb = 0; jb < 2; ++jb) if (jb <= cb) {
            f32x16 at;
#pragma unroll
            for (int i = 0; i < 16; ++i) at[i] = 0.f;
#pragma unroll
            for (int ks = 0; ks < 4; ++ks) { const bf16x8 av = *(const LAS bf16x8*)(ldh + GL_B + (32 * jb + r32) * GROWB + 32 * ks + 16 * hh), bv = *(const LAS bf16x8*)(ldh + GL_A + (32 * cb + r32) * GROWB + 32 * ks + 16 * hh);
                at = __builtin_amdgcn_mfma_f32_32x32x16_bf16(av, bv, at, 0, 0, 0); }
            if (jb == cb) {
#pragma unroll
                for (int i = 0; i < 16; ++i) if (crow(i, hh) > r32) at[i] = 0.f; }
#pragma unroll
            for (int s2 = 0; s2 < 2; ++s2) {
                u32x4 pw; pw.x = cvtpk_s(at[8 * s2], at[8 * s2 + 1]); pw.y = cvtpk_s(at[8 * s2 + 2], at[8 * s2 + 3]); pw.z = cvtpk_s(at[8 * s2 + 4], at[8 * s2 + 5]); pw.w = cvtpk_s(at[8 * s2 + 6], at[8 * s2 + 7]);
                const LAS unsigned char* vp = ldh + GL_VT + (32 * dvb + r32) * GROWB + (32 * jb + 16 * s2 + 4 * hh) * 2;
                const u32x2 lo = *(const LAS u32x2*)vp, hi = *(const LAS u32x2*)(vp + 16);
                const u32x4 va = (u32x4){lo.x, lo.y, hi.x, hi.y};
                o[cb] = __builtin_amdgcn_mfma_f32_32x32x16_bf16(__builtin_bit_cast(bf16x8, va), __builtin_bit_cast(bf16x8, pw), o[cb], 0, 0, 0);
            }
        }
#pragma unroll
        for (int ks = 0; ks < 4; ++ks) { const bf16x8 bv = *(const LAS bf16x8*)(ldh + GL_C + (32 * cb + r32) * GROWB + 32 * ks + 16 * hh);
            o[cb] = __builtin_amdgcn_mfma_f32_32x32x16_bf16(spf[ks], bv, o[cb], 0, 0, 0); }
    }
    LAS float* ST = (LAS float*)(ldh + GL_ST);
#pragma unroll
    for (int cb = 0; cb < 2; ++cb) { float sm = 0.f;
#pragma unroll
        for (int i = 0; i < 16; ++i) sm += o[cb][i];
        sm += __shfl_xor(sm, 32);
        if (hh == 0) ST[dvb * 64 + 32 * cb + r32] = sm; }
    __syncthreads();
    float mean[2];
#pragma unroll
    for (int cb = 0; cb < 2; ++cb) { const int cc = 32 * cb + r32; mean[cb] = (ST[cc] + ST[64 + cc] + ST[128 + cc] + ST[192 + cc]) * (1.f / 128.f); float sq = 0.f;
#pragma unroll
        for (int i = 0; i < 16; ++i) { o[cb][i] -= mean[cb]; sq += o[cb][i] * o[cb][i]; }
        sq += __shfl_xor(sq, 32);
        if (hh == 0) ST[256 + dvb * 64 + cc] = sq; }
    __syncthreads();
#pragma unroll
    for (int cb = 0; cb < 2; ++cb) { const int cc = 32 * cb + r32; const float var = (ST[256 + cc] + ST[256 + 64 + cc] + ST[256 + 128 + cc] + ST[256 + 192 + cc]) * (1.f / 128.f);
        const float rstd = 1.f / sqrtf(var + LN_EPS);
        bf16_t* op = (bf16_t*)(ws + WS_OAB) + (r0 + cc) * 1024 + 512 + dvbase;
#pragma unroll
        for (int g = 0; g < 4; ++g) { const u32x2 gw = grw[cb][g]; const f32x4 nv = *(const f32x4*)(ng + dvbase + 8 * g);
            float gr[4] = {__uint_as_float(gw.x << 16), __uint_as_float(gw.x & 0xffff0000u), __uint_as_float(gw.y << 16), __uint_as_float(gw.y & 0xffff0000u)}; float y[4];
#pragma unroll
            for (int e = 0; e < 4; ++e) y[e] = o[cb][4 * g + e] * rstd * nv[e] * (gr[e] * __builtin_amdgcn_rcpf(1.f + __expf(-gr[e])));
            u32x2 w; w.x = cvtpk_s(y[0], y[1]); w.y = cvtpk_s(y[2], y[3]); *(u32x2*)(op + 8 * g) = w; } }
}

constexpr size_t WS_SG = 129 * MiB;
constexpr size_t WS_MRG = 257 * MiB;
constexpr size_t WS_H2 = WS_XN;
constexpr size_t WS_XG = 129 * MiB;
constexpr size_t WS_HID = 321 * MiB;
constexpr size_t WS_YG = 358 * MiB;
constexpr size_t WS_EID = WS_MISC + 1 * MiB, WS_EW = WS_EID + 256 * 1024, WS_POS = WS_EW + 256 * 1024, WS_ST1 = WS_POS + 256 * 1024;
constexpr size_t WS_LIST = 490 * MiB;
constexpr int LDS_TAB = 131072;
__device__ __forceinline__ u32x4 pack8(const f32x4 a, const f32x4 b) { u32x4 w; w.x = cvtpk_s(a[0], a[1]); w.y = cvtpk_s(a[2], a[3]); w.z = cvtpk_s(b[0], b[1]); w.w = cvtpk_s(b[2], b[3]); return w; }
__device__ __forceinline__ f32x4 sig4(const f32x4 v) { f32x4 r; r[0] = __builtin_amdgcn_rcpf(1.f + __expf(-v[0])); r[1] = __builtin_amdgcn_rcpf(1.f + __expf(-v[1])); r[2] = __builtin_amdgcn_rcpf(1.f + __expf(-v[2])); r[3] = __builtin_amdgcn_rcpf(1.f + __expf(-v[3])); return r; }
__device__ __forceinline__ void unpack8(const u32x4 w, f32x4& a, f32x4& b) {
    a[0] = __uint_as_float(w.x << 16); a[1] = __uint_as_float(w.x & 0xffff0000u); a[2] = __uint_as_float(w.y << 16); a[3] = __uint_as_float(w.y & 0xffff0000u);
    b[0] = __uint_as_float(w.z << 16); b[1] = __uint_as_float(w.z & 0xffff0000u); b[2] = __uint_as_float(w.w << 16); b[3] = __uint_as_float(w.w & 0xffff0000u);
}
#define EPI_ROWS(...) _Pragma("unroll") for (int ai = 0; ai < 2; ++ai) _Pragma("unroll") for (int m = 0; m < 4; ++m) { const size_t row = (size_t)(row0 + ai * 128 + m * 16); _Pragma("unroll") for (int bj = 0; bj < 2; ++bj) { __VA_ARGS__ } }
struct EpiSig {
    static constexpr bool PERM = true, AFTER_DRAIN = false, MID = false; unsigned char* ws; int half;
    __device__ __forceinline__ void operator()(const f32x4 (&acc)[2][2][4][2], const Unit& u, int wr, int wc, int fr, int fq) const {
        const int row0 = u.pm * 256 + wr * 64 + fr, col0 = half * 1024 + u.pn * 256 + wc * 32 + 8 * fq; bf16_t* SG = (bf16_t*)(ws + WS_SG);
        EPI_ROWS( *(u32x4*)(SG + row * 2048 + col0 + bj * 128) = pack8(sig4(acc[ai][bj][m][0]), sig4(acc[ai][bj][m][1])); )
    }
};
struct EpiMrgF {
    static constexpr bool PERM = true, AFTER_DRAIN = false, MID = true; unsigned char* ws;
    __device__ __forceinline__ void mid(f32x4 (&acc)[2][2][4][2], const Unit& u, int wr, int wc, int fr, int fq) const {
        const int row0 = u.pm * 256 + wr * 64 + fr, col0 = u.pn * 256 + wc * 32 + 8 * fq; const bf16_t* SG = (const bf16_t*)(ws + WS_SG);
        const bf16_t* p = SG + (size_t)row0 * 2048 + col0;
#pragma unroll
        for (int ai = 0; ai < 2; ++ai)
#pragma unroll
            for (int m = 0; m < 4; ++m) {
                asm volatile("" : "+v"(p));
#pragma unroll
                for (int bj = 0; bj < 2; ++bj) { f32x4 a0, a1, b0, b1; unpack8(*(const u32x4*)(p + bj * 128), a0, a1); unpack8(*(const u32x4*)(p + 1024 + bj * 128), b0, b1);
#pragma unroll
                    for (int e = 0; e < 4; ++e) { acc[ai][bj][m][0][e] *= a0[e] * __builtin_amdgcn_rcpf(fmaxf(b0[e], 1e-30f)); acc[ai][bj][m][1][e] *= a1[e] * __builtin_amdgcn_rcpf(fmaxf(b1[e], 1e-30f)); } }
                p += (m == 3 ? (128 - 48) : 16) * 2048; }
    }
    __device__ __forceinline__ void operator()(const f32x4 (&acc)[2][2][4][2], const Unit& u, int wr, int wc, int fr, int fq) const {
        const int row0 = u.pm * 256 + wr * 64 + fr, col0 = u.pn * 256 + wc * 32 + 8 * fq; const bf16_t* SG = (const bf16_t*)(ws + WS_SG) + 1024; bf16_t* MR = (bf16_t*)(ws + WS_MRG);
        EPI_ROWS( f32x4 g0, g1; unpack8(*(const u32x4*)(SG + row * 2048 + col0 + bj * 128), g0, g1); *(u32x4*)(MR + row * 1024 + col0 + bj * 128) = pack8(g0 * acc[ai][bj][m][0], g1 * acc[ai][bj][m][1]); )
    }
};
struct EpiV {
    static constexpr bool PERM = false, AFTER_DRAIN = false, MID = false; const float* x; const float* ada; float* out;
    __device__ __forceinline__ void operator()(const f32x4 (&acc)[2][2][4][2], const Unit& u, int wr, int wc, int fr, int fq) const {
        const int row0 = u.pm * 256 + wr * 64 + fr, col0 = u.pn * 256 + wc * 32 + 4 * fq; const float* gt1 = ada + (size_t)(u.pm >> 4) * 6 * D_MODEL + 2 * D_MODEL;
        EPI_ROWS( _Pragma("unroll") for (int n = 0; n < 2; ++n) { const int c = col0 + bj * 128 + n * 16; const f32x4 xv = *(const f32x4*)(x + row * D_MODEL + c), gv = *(const f32x4*)(gt1 + c);
                  *(f32x4*)(out + row * D_MODEL + c) = xv * DN_ALPHA + gv * acc[ai][bj][m][n]; } )
    }
};
struct EpiHid {
    static constexpr bool PERM = true, AFTER_DRAIN = false, MID = false; unsigned char* ws;
    __device__ __forceinline__ void operator()(const f32x4 (&acc)[2][2][4][2], const Unit& u, int wr, int wc, int fr, int fq) const {
        const int row0 = u.pm * 256 + wr * 64 + fr, col0 = u.pn * 128 + wc * 32 + 8 * fq; bf16_t* H = (bf16_t*)(ws + WS_HID);
#pragma unroll
        for (int ai = 0; ai < 2; ++ai)
#pragma unroll
            for (int m = 0; m < 4; ++m) { const size_t row = (size_t)(row0 + ai * 128 + m * 16); f32x4 h0, h1;
#pragma unroll
                for (int e = 0; e < 4; ++e) { const float g0 = acc[ai][0][m][0][e], g1 = acc[ai][0][m][1][e]; h0[e] = g0 * __builtin_amdgcn_rcpf(1.f + __expf(-g0)) * acc[ai][1][m][0][e]; h1[e] = g1 * __builtin_amdgcn_rcpf(1.f + __expf(-g1)) * acc[ai][1][m][1][e]; }
                *(u32x4*)(H + row * 256 + col0) = pack8(h0, h1); }
    }
};
struct EpiY {
    static constexpr bool PERM = true, AFTER_DRAIN = false, MID = false; unsigned char* ws;
    __device__ __forceinline__ void operator()(const f32x4 (&acc)[2][2][4][2], const Unit& u, int wr, int wc, int fr, int fq) const {
        const int row0 = u.pm * 256 + wr * 64 + fr, col0 = u.pn * 256 + wc * 32 + 8 * fq; bf16_t* Y = (bf16_t*)(ws + WS_YG);
        EPI_ROWS( *(u32x4*)(Y + row * 1024 + col0 + bj * 128) = pack8(acc[ai][bj][m][0], acc[ai][bj][m][1]); )
    }
};
__device__ __forceinline__ void build_tables(unsigned char* ws, LAS unsigned char* lds) {
    LAS int* toff = (LAS int*)(lds + LDS_TAB); LAS int* texp = toff + 64; const unsigned* gcnt = (const unsigned*)(ws + WS_CNT);
    __syncthreads();
    if (threadIdx.x == 0) { int o = 0; for (int e = 0; e < N_EXP; ++e) { toff[e] = o; const int ce = (int)gcnt[e * 32]; toff[400 + e] = ce; o += (ce + 255) >> 8; } toff[32] = o; }
    __syncthreads();
    for (int tl = threadIdx.x; tl < toff[32]; tl += NTHREADS) { int e = 0; while (toff[e + 1] <= tl) ++e; texp[tl] = e; }
    __syncthreads();
}
template <int NPN> struct GroupOrder {
    const LAS int* toff; const LAS int* texp; int G, c;
    __device__ __forceinline__ bool next(int i, Unit& u) const { const int L = i * G + c; if (L >= toff[32] * NPN) return false; const int tl = L / NPN, pn = L % NPN; u.pm = tl; u.pa = tl; u.pn = pn; u.pb = texp[tl] * NPN + pn; return true; }
    __device__ __forceinline__ void a_ready(const Unit&) const {}
    __device__ __forceinline__ void done(const Unit&) const {}
    const int* list;
    __device__ __forceinline__ int a_row(const Unit& u, int r) const { const int e = texp[u.pa]; const int idx = (u.pa - toff[e]) * 256 + r; return idx < toff[400 + e] ? list[e * 32768 + idx] : 0; }
};
constexpr int WT_LD = 1028;
constexpr int P8_LCNT = 36 * WT_LD * 4;
__device__ __forceinline__ float dot16(const f32x4 (&v)[4], const LAS float* wp, int lane) {
    float p = 0.f;
#pragma unroll
    for (int j = 0; j < 4; ++j) { const f32x4 w4 = *(const LAS f32x4*)(wp + 256 * j + 4 * lane); p += (v[j].x * w4.x + v[j].y * w4.y) + (v[j].z * w4.z + v[j].w * w4.w); }
    return p;
}
__device__ __forceinline__ float rl4sum(float v) {
    return (__int_as_float(__builtin_amdgcn_readlane(__float_as_int(v), 0)) + __int_as_float(__builtin_amdgcn_readlane(__float_as_int(v), 16)))
         + (__int_as_float(__builtin_amdgcn_readlane(__float_as_int(v), 32)) + __int_as_float(__builtin_amdgcn_readlane(__float_as_int(v), 48)));
}
template <bool REAL> __device__ __forceinline__ void p8_phase(const float* const* in, float* out, float* x1dst, bf16_t* h2dst, unsigned char* ws, LAS unsigned char* lds, int G) {
    const int tid = threadIdx.x, lane = tid & 63, wave = tid >> 6;
    LAS float* WT = (LAS float*)lds;
    LAS int* lcnt = (LAS int*)(lds + P8_LCNT); LAS int* lbase = lcnt + 32; LAS int* ent = lcnt + 64;
    const float* wrg = in[14]; const float* wre = in[16];
    __syncthreads();
    for (int i = tid; i < 1024; i += NTHREADS) { const f32x4 w = *(const f32x4*)(wrg + 4 * i); WT[0 * WT_LD + i] = w.x; WT[1 * WT_LD + i] = w.y; WT[2 * WT_LD + i] = w.z; WT[3 * WT_LD + i] = w.w; }
    for (int i = tid; i < 8192; i += NTHREADS) { const f32x4 w = *(const f32x4*)(wre + 4 * i); const int k = i >> 3, c = 4 * (i & 7);
        WT[(4 + c) * WT_LD + k] = w.x; WT[(5 + c) * WT_LD + k] = w.y; WT[(6 + c) * WT_LD + k] = w.z; WT[(7 + c) * WT_LD + k] = w.w; }
    const float* g1 = in[12]; const float* b1 = in[13]; const float* brg = in[15]; const float* bre = in[17];
    for (int blk = blockIdx.x; blk < NT / 128; blk += G) {
        const int b = blk / 32; const float* ada = (const float*)(ws + WS_ADA) + (size_t)b * 6 * D_MODEL; const float* sh2 = ada + 3 * D_MODEL; const float* sc2 = ada + 4 * D_MODEL;
        if (tid < 32) lcnt[tid] = 0;
        __syncthreads();
        for (int rb = 0; rb < 16; rb += 4) {
            const int rl0 = wave * 16 + rb; const size_t row0 = (size_t)blk * 128 + rl0;
            f32x4 v[4][4];
#pragma unroll
            for (int r = 0; r < 4; ++r) { const f32x4* xr = (const f32x4*)(out + (row0 + r) * D_MODEL) + lane;
#pragma unroll
                for (int j = 0; j < 4; ++j) v[r][j] = xr[64 * j]; }
            float rstd[4], mean1[4]; ln_center<4>(v, rstd, mean1);
            if (REAL && lane < 4) { typedef float f32x2v __attribute__((ext_vector_type(2))); ((f32x2v*)(ws + WS_ST1))[row0 + lane] = (f32x2v){lane == 0 ? mean1[0] : lane == 1 ? mean1[1] : lane == 2 ? mean1[2] : mean1[3], lane == 0 ? rstd[0] : lane == 1 ? rstd[1] : lane == 2 ? rstd[2] : rstd[3]}; }
#pragma unroll
            for (int j = 0; j < 4; ++j) { const f32x4 gg = *(const f32x4*)(g1 + 256 * j + 4 * lane), bb = *(const f32x4*)(b1 + 256 * j + 4 * lane);
#pragma unroll
                for (int r = 0; r < 4; ++r) v[r][j] = v[r][j] * rstd[r] * gg + bb; }
            ln_center<4>(v, rstd);
#pragma unroll
            for (int j = 0; j < 4; ++j) { const f32x4 a4 = *(const f32x4*)(sc2 + 256 * j + 4 * lane) + 1.f, c4 = *(const f32x4*)(sh2 + 256 * j + 4 * lane);
#pragma unroll
                for (int r = 0; r < 4; ++r) { v[r][j] = v[r][j] * rstd[r] * a4 + c4; u32x2 w; w.x = cvtpk_s(v[r][j].x, v[r][j].y); w.y = cvtpk_s(v[r][j].z, v[r][j].w);
                    ((u32x2*)(h2dst + (row0 + r) * D_MODEL) + lane)[64 * j] = w; } }
#pragma unroll
            for (int r = 0; r < 4; ++r) {
                float gp[N_GROUPS];
#pragma unroll
                for (int g = 0; g < N_GROUPS; ++g) gp[g] = dpp_row_sum_f(dot16(v[r], WT + g * WT_LD, lane));
                float gl[N_GROUPS];
#pragma unroll
                for (int g = 0; g < N_GROUPS; ++g) gl[g] = rl4sum(gp[g]) + brg[g];
                int gi = 0; float gm = gl[0];
#pragma unroll
                for (int g = 1; g < N_GROUPS; ++g) if (gl[g] > gm) { gm = gl[g]; gi = g; }
                float gs = 0.f;
#pragma unroll
                for (int g = 0; g < N_GROUPS; ++g) gs += __expf(gl[g] - gm);
                const float gw = 1.f / gs;
                float ep[EPG];
#pragma unroll
                for (int e = 0; e < EPG; ++e) ep[e] = dpp_row_sum_f(dot16(v[r], WT + (4 + gi * EPG + e) * WT_LD, lane));
                float v0 = -INFINITY, v1 = -INFINITY; int i0 = 0, i1 = 0;
#pragma unroll
                for (int e = 0; e < EPG; ++e) { const float ev = rl4sum(ep[e]) + bre[gi * EPG + e];
                    if (ev > v0) { v1 = v0; i1 = i0; v0 = ev; i0 = e; } else if (ev > v1) { v1 = ev; i1 = e; } }
                const float e1 = __expf(v1 - v0); const float w0 = gw / (1.f + e1), w1 = gw * e1 / (1.f + e1);
                if (REAL && lane == 0) { const int ea = gi * EPG + i0, eb = gi * EPG + i1; const int rl = rl0 + r; const size_t row = row0 + r;
                    const int pa = atomicAdd((int*)&lcnt[ea], 1), pb = atomicAdd((int*)&lcnt[eb], 1);
                    ent[rl * 2] = (ea << 16) | pa; ent[rl * 2 + 1] = (eb << 16) | pb;
                    ((int*)(ws + WS_EID))[row * 2] = ea; ((int*)(ws + WS_EID))[row * 2 + 1] = eb; ((float*)(ws + WS_EW))[row * 2] = w0; ((float*)(ws + WS_EW))[row * 2 + 1] = w1; }
            }
        }
        __syncthreads();
        if (REAL && tid < 32) lbase[tid] = (int)atomicAdd((unsigned*)(ws + WS_CNT) + tid * 32, (unsigned)lcnt[tid]);
        __syncthreads();
        if (REAL && tid < 256) { const int en = ent[tid]; const int e = en >> 16, pos = lbase[e] + (en & 0xffff); ((int*)(ws + WS_POS))[(size_t)blk * 256 + tid] = pos; ((int*)(ws + WS_LIST))[e * 32768 + pos] = blk * 128 + (tid >> 1); }
        __syncthreads();
    }
}
__device__ __forceinline__ void p9_phase(unsigned char* ws, LAS unsigned char* lds, int G) {
    build_tables(ws, lds); const LAS int* toff = (const LAS int*)(lds + LDS_TAB);
    const int lane = threadIdx.x & 63, wave = threadIdx.x >> 6;
    for (int base = (blockIdx.x * NWAVES + wave) * 32; base < NT * 2; base += G * NWAVES * 32) {
        for (int k = 0; k < 32; k += 4) {
            const int ts0 = base + k; const int li = ts0 + (lane & 3);
            const int ev = ((const int*)(ws + WS_EID))[li], pv = ((const int*)(ws + WS_POS))[li];
            u32x4 d0[4], d1[4]; size_t dst[4];
#pragma unroll
            for (int r = 0; r < 4; ++r) { const int e = __builtin_amdgcn_readlane(ev, r), pos = __builtin_amdgcn_readlane(pv, r); dst[r] = (size_t)toff[e] * 256 + pos;
                const u32x4* sp = (const u32x4*)((const bf16_t*)(ws + WS_H2) + (size_t)((ts0 + r) >> 1) * D_MODEL); d0[r] = sp[lane]; d1[r] = sp[lane + 64]; }
#pragma unroll
            for (int r = 0; r < 4; ++r) { u32x4* dp = (u32x4*)((bf16_t*)(ws + WS_XG) + dst[r] * D_MODEL); dp[lane] = d0[r]; dp[lane + 64] = d1[r]; }
        }
    }
}
__device__ __forceinline__ void p12_phase(const float* const* in, float* out, float* dst, unsigned char* ws, LAS unsigned char* lds, int G) {
    build_tables(ws, lds); const LAS int* toff = (const LAS int*)(lds + LDS_TAB);
    const int lane = threadIdx.x & 63, wave = threadIdx.x >> 6; const float* g2 = in[21]; const float* b2 = in[22]; const float* g1 = in[12]; const float* b1 = in[13];
    for (int blk = blockIdx.x; blk < NT / 128; blk += G) {
        const int b = blk / 32; const float* gt2 = (const float*)(ws + WS_ADA) + (size_t)b * 6 * D_MODEL + 5 * D_MODEL;
        for (int rb = 0; rb < 16; rb += 4) {
            const size_t row0 = (size_t)blk * 128 + wave * 16 + rb;
            const size_t li = row0 * 2 + (lane & 7);
            const int ev = ((const int*)(ws + WS_EID))[li], pv = ((const int*)(ws + WS_POS))[li]; const float wv = ((const float*)(ws + WS_EW))[li];
            typedef float f32x2v __attribute__((ext_vector_type(2))); const f32x2v stv = ((const f32x2v*)(ws + WS_ST1))[row0 + (lane & 3)];
            f32x4 v[4][4]; u32x2 ya[4][4], yb[4][4]; float w0[4], w1[4], m1[4], r1[4];
#pragma unroll
            for (int r = 0; r < 4; ++r) {
                const int e0 = __builtin_amdgcn_readlane(ev, 2 * r), e1 = __builtin_amdgcn_readlane(ev, 2 * r + 1), p0 = __builtin_amdgcn_readlane(pv, 2 * r), p1 = __builtin_amdgcn_readlane(pv, 2 * r + 1);
                w0[r] = __int_as_float(__builtin_amdgcn_readlane(__float_as_int(wv), 2 * r)); w1[r] = __int_as_float(__builtin_amdgcn_readlane(__float_as_int(wv), 2 * r + 1));
                m1[r] = __int_as_float(__builtin_amdgcn_readlane(__float_as_int(stv.x), r)); r1[r] = __int_as_float(__builtin_amdgcn_readlane(__float_as_int(stv.y), r));
                const u32x2* y0 = (const u32x2*)((const bf16_t*)(ws + WS_YG) + ((size_t)toff[e0] * 256 + p0) * D_MODEL) + lane; const u32x2* y1 = (const u32x2*)((const bf16_t*)(ws + WS_YG) + ((size_t)toff[e1] * 256 + p1) * D_MODEL) + lane;
                const f32x4* xr = (const f32x4*)(out + (row0 + r) * D_MODEL) + lane;
#pragma unroll
                for (int j = 0; j < 4; ++j) { v[r][j] = xr[64 * j]; ya[r][j] = y0[64 * j]; yb[r][j] = y1[64 * j]; } }
#pragma unroll
            for (int j = 0; j < 4; ++j) { const f32x4 gv = *(const f32x4*)(gt2 + 256 * j + 4 * lane), g1v = *(const f32x4*)(g1 + 256 * j + 4 * lane), b1v = *(const f32x4*)(b1 + 256 * j + 4 * lane);
#pragma unroll
                for (int r = 0; r < 4; ++r) { const u32x2 a = ya[r][j], c = yb[r][j]; f32x4 f; v[r][j] = (v[r][j] - m1[r]) * r1[r] * g1v + b1v;
                    f.x = w0[r] * __uint_as_float(a.x << 16) + w1[r] * __uint_as_float(c.x << 16); f.y = w0[r] * __uint_as_float(a.x & 0xffff0000u) + w1[r] * __uint_as_float(c.x & 0xffff0000u);
                    f.z = w0[r] * __uint_as_float(a.y << 16) + w1[r] * __uint_as_float(c.y << 16); f.w = w0[r] * __uint_as_float(a.y & 0xffff0000u) + w1[r] * __uint_as_float(c.y & 0xffff0000u);
                    v[r][j] = v[r][j] * DN_ALPHA + gv * f; } }
            float rstd[4]; ln_center<4>(v, rstd);
#pragma unroll
            for (int j = 0; j < 4; ++j) { const f32x4 gg = *(const f32x4*)(g2 + 256 * j + 4 * lane), bb = *(const f32x4*)(b2 + 256 * j + 4 * lane);
#pragma unroll
                for (int r = 0; r < 4; ++r) ((f32x4*)(dst + (row0 + r) * D_MODEL) + lane)[64 * j] = v[r][j] * rstd[r] * gg + bb; }
        }
    }
}

constexpr size_t WS_TS = 384 * 1024;
constexpr size_t WS_BAR = 320 * 1024;
#define RLX_AGENT __ATOMIC_RELAXED, __HIP_MEMORY_SCOPE_AGENT
#define XB_TMO      128
#define XB_XCNT(j)  (256  + 64 * (j))
#define XB_XSUB(j)  (1280 + 64 * (j))
#define XB_XGEN(j)  (2304 + 64 * (j))
#define XB_TOP      3328
#define XB_TOPGEN   3392
#define XCD_BAR_WORDS 3456
#define XB_SPIN_CAP (1u << 18)

__device__ __forceinline__ unsigned xb_ld(unsigned* p)              { return __hip_atomic_load(p, __ATOMIC_RELAXED, __HIP_MEMORY_SCOPE_AGENT); }
__device__ __forceinline__ unsigned xb_add(unsigned* p, unsigned v) { return __hip_atomic_fetch_add(p, v, __ATOMIC_RELAXED, __HIP_MEMORY_SCOPE_AGENT); }
__device__ __forceinline__ unsigned xb_xcc_id() { return (unsigned)__builtin_amdgcn_s_getreg((3 << 11) | 20) & 0xFu; }
#define XB_SPIN(cond, bar) do { unsigned _sp = 0; while (cond) { __builtin_amdgcn_s_sleep(1); \
    if ((++_sp & 255u) == 0u) { if (xb_ld(&(bar)[XB_TMO])) break; if (_sp > XB_SPIN_CAP) { atomicAdd(&(bar)[XB_TMO], 1u); break; } } } } while (0)

struct XcdBarrier {
    unsigned* bar; unsigned x;
    volatile LAS unsigned* st;
};

__device__ __forceinline__ XcdBarrier xcd_barrier_post(unsigned* bar, volatile LAS unsigned* st) {
    XcdBarrier b; b.bar = bar; b.x = xb_xcc_id(); b.st = st;
    if (threadIdx.x == 0) (void)xb_add(&bar[XB_XCNT(b.x)], 1u);
    return b;
}
__device__ __forceinline__ void xcd_barrier_complete(unsigned* bar, unsigned x, unsigned& nloc, unsigned& nx) {
    const unsigned G = gridDim.x * gridDim.y * gridDim.z;
    unsigned sum, cnt, mine, sp = 0u;
    for (;;) {
        sum = 0u; cnt = 0u; mine = 0u;
#pragma unroll
        for (unsigned j = 0; j < 16; ++j) { const unsigned c = xb_ld(&bar[XB_XCNT(j)]); sum += c; cnt += (c > 0u) ? 1u : 0u; mine = (j == x) ? c : mine; }
        if (sum == G) break;
        __builtin_amdgcn_s_sleep(1);
        if ((++sp & 255u) == 0u) { if (xb_ld(&bar[XB_TMO])) break; if (sp > XB_SPIN_CAP) { atomicAdd(&bar[XB_TMO], 1u); break; } }
    }
    nloc = mine > 0u ? mine : 1u; nx = cnt > 0u ? cnt : 1u;
}

__device__ __forceinline__ void xcd_barrier(const XcdBarrier& b) {
    asm volatile("s_waitcnt vmcnt(0)" ::: "memory");
    __syncthreads();
    if (threadIdx.x == 0) {
        unsigned* bar = b.bar;
        __builtin_amdgcn_s_waitcnt(0);
        unsigned nloc = b.st[0], nx = b.st[1];
        if (nloc == 0u) { xcd_barrier_complete(bar, b.x, nloc, nx); b.st[0] = nloc; b.st[1] = nx; }
        const unsigned old = xb_add(&bar[XB_XSUB(b.x)], 1u);
        const unsigned gen = old / nloc;
        if (old + 1u == (gen + 1u) * nloc) {
            __builtin_amdgcn_fence(__ATOMIC_RELEASE, "agent");
            asm volatile("s_waitcnt vmcnt(0)" ::: "memory");
            const unsigned og = xb_add(&bar[XB_TOP], 1u);
            const unsigned tg = og / nx;
            if (og + 1u == (tg + 1u) * nx) xb_add(&bar[XB_TOPGEN], 1u);
            else XB_SPIN(xb_ld(&bar[XB_TOPGEN]) == tg, bar);
            __builtin_amdgcn_fence(__ATOMIC_ACQUIRE, "agent");
            xb_add(&bar[XB_XGEN(b.x)], 1u);
            asm volatile("s_waitcnt vmcnt(0)" ::: "memory");
        } else {
            XB_SPIN(xb_ld(&bar[XB_XGEN(b.x)]) == gen, bar);
            __builtin_amdgcn_fence(__ATOMIC_ACQUIRE, "agent");
            asm volatile("s_waitcnt vmcnt(0)" ::: "memory");
        }
    }
    __syncthreads();
}

__device__ __forceinline__ int opaque_i(int v) {
#if DUPMASK_ON
    asm volatile("" : "+v"(v)); v = __builtin_amdgcn_readfirstlane(v);
#endif
    return v; }
constexpr int NPH = 14;
struct Args { const float* in[23]; float* out; unsigned char* ws; int ph_lo, ph_hi; };
__global__ void __launch_bounds__(NTHREADS, 2) mk_fwd(Args a) {
    extern __shared__ __attribute__((aligned(16))) unsigned char lds_raw[];
    LAS unsigned char* lds = (LAS unsigned char*)lds_raw;
    cg::grid_group grid = cg::this_grid();
    const int G = gridDim.x, tid = threadIdx.x, lane = tid & 63, wave = __builtin_amdgcn_readfirstlane(tid >> 6);
    const int lo = a.ph_lo, hi = a.ph_hi;
    unsigned char* ws = a.ws;
    volatile LAS unsigned* bst = (volatile LAS unsigned*)(lds + LDS_BYTES - 16);
    if (tid < 4) bst[tid] = 0u;
    __syncthreads();
    XcdBarrier bar = xcd_barrier_post((unsigned*)(ws + WS_BAR), bst);
    if (TSTAMP && blockIdx.x == 0 && tid == 0) ((unsigned long long*)(ws + WS_TS))[0] = __builtin_amdgcn_s_memrealtime();
    if (a.ph_hi > NPH) grid.sync();
#ifndef PHMASK
#define PHMASK 0xFFFF
#endif
#define IN(k) (((PHMASK >> (k)) & 1) && lo <= (k) && (k) < hi)
#define GRIDBAR() do { if (USE_CG_SYNC) grid.sync(); else xcd_barrier(bar); } while (0)
#define SEAM(k) do { if (IN(k) && IN((k) + 1)) GRIDBAR(); if (TSTAMP && blockIdx.x == 0 && tid == 0) ((unsigned long long*)(ws + WS_TS))[(k) + 1] = __builtin_amdgcn_s_memrealtime(); } while (0)
#define PH(k) for (int rep_ = 0; rep_ < (IN(k) ? 1 + ((DUPMASK >> (k)) & 1) : 0); ++rep_) if (rep_ > 0 && (xcd_barrier(bar), false)) {} else
    PH(0) {
        if (blockIdx.x == 0 && tid < 32) ((unsigned*)(ws + WS_CNT))[tid * 32] = 0u;
        if (blockIdx.x == 1 && tid < 256) { const float* wgp = a.in[6] + tid; u32x4 w0, w1;
            w0.x = cvtpk_s(wgp[0], wgp[256]); w0.y = cvtpk_s(wgp[512], wgp[768]); w0.z = cvtpk_s(wgp[1024], wgp[1280]); w0.w = cvtpk_s(wgp[1536], wgp[1792]);
            w1.x = cvtpk_s(wgp[2048], wgp[2304]); w1.y = cvtpk_s(wgp[2560], wgp[2816]); w1.z = cvtpk_s(wgp[3072], wgp[3328]); w1.w = cvtpk_s(wgp[3584], wgp[3840]);
            u32x4* dst = (u32x4*)((bf16_t*)(ws + WS_WGT) + tid * 16); dst[0] = w0; dst[1] = w1; }
        LAS float* scr = (LAS float*)(lds + wave * 16384);
        for (int it = blockIdx.x * NWAVES + wave; it < P0_ITEMS; it += G * NWAVES) p0_item(it, a.in, ws, scr, lane);
    }
    SEAM(0);
    PH(1) p1_phase(a.in, ws, lds, G);
    SEAM(1);
    PH(2) {
        pg8::Gemm g{(const bf16_t*)(ws + WS_XN), (const bf16_t*)(ws + WS_WIN), NT, NPROJ, D_MODEL}; pg8::StaticOrder S; S.init(NT, NPROJ, G, (int)blockIdx.x);
        EpiProj E{ws};
        pg8::gemm_phase<EpiProj, pg8::StaticOrder, PG8_ALIGN, PG8_SP2>(lds, g, S, E);
#ifdef DUP_P2
        xcd_barrier(bar);
        pg8::gemm_phase<EpiProj, pg8::StaticOrder, PG8_ALIGN, PG8_SP2>(lds, g, S, E);
#endif
    }
    SEAM(2);
    PH(3) {
        for (int u = blockIdx.x; u < 256; u += G) { const int p = u >> 1, b = p >> 4, qi = p & 15, qj = 31 - qi; LAS unsigned char* lw = lds + wave * 17408;
            for (int rep = 0; rep < ((DUPSUB & 1) ? 2 : 1); ++rep) {
                if ((u & 1) == 0) { p3a_run(b, qi, 0, qi, ws, lw, wave, lane); p3a_run(b, qj, 0, 15 - qi, ws, lw, wave, lane); }
                else p3a_run(b, qj, 16 - qi, qj, ws, lw, wave, lane); } }
        for (int p = blockIdx.x; p < GLA_ITEMS / 2; p += G) { p3b_pair(p, a.in[6], a.in[7], a.out, a.out + 24 * MiB, ws, lds); if (DUPSUB & 2) p3b_pair(p, a.in[6], a.in[7], a.out, a.out + 24 * MiB, ws, lds); }
    }
    SEAM(3);
    PH(4) {
        for (int j = blockIdx.x; j < 256; j += G) { p4b_item(j, a.out, (bf16_t*)(a.out + 16 * MiB), ws); if (DUPSUB & 8) p4b_item(j, a.out, (bf16_t*)(a.out + 16 * MiB), ws); }
        {
            const int W = blockIdx.x * NWAVES + wave;
            unsigned xa[32], xb[32]; LAS unsigned char* Hw = lds + wave * SEL_LDS;
            p4a_load(W, ws, lane, xa);
#pragma unroll 1
            for (int bb = 0; bb < NB; ++bb) {
                const int r0 = bb * NS + W, r1 = bb * NS + (NS - 1 - W), r2 = ((bb + 1 < NB) ? bb + 1 : bb) * NS + W;
                p4a_load(r1, ws, lane, xb);
                p4a_row(r0, ws, lane, xa, Hw); if (DUPSUB & 4) p4a_row(r0, ws, lane, xa, Hw);
                p4a_load(r2, ws, lane, xa);
                p4a_row(r1, ws, lane, xb, Hw); if (DUPSUB & 4) p4a_row(r1, ws, lane, xb, Hw);
            }
        }
    }
    SEAM(4);
    PH(5) {
        const int c = blockIdx.x; const int bh = c >> 2, sx = c & 3;
        for (int p = blockIdx.x; p < GLA_ITEMS / 2; p += G) { p5b_pair(p, a.out + 24 * MiB, a.in[8], (const bf16_t*)(a.out + 16 * MiB), ws, lds); if (DUPSUB & 32) p5b_pair(p, a.out + 24 * MiB, a.in[8], (const bf16_t*)(a.out + 16 * MiB), ws, lds); }
        if (c < 256) for (int i = 0; i < 4; ++i) { const int Q = (i == 0) ? sx : (i == 1) ? 7 - sx : (i == 2) ? 8 + sx : 15 - sx; if (wave < 4) attn_unit<false>(bh >> 3, bh & 7, Q, a.in[2], ws, lds); else attn_unit<true>(bh >> 3, bh & 7, Q, a.in[2], ws, lds);
            if (DUPSUB & 16) { if (wave < 4) attn_unit<false>(bh >> 3, bh & 7, Q, a.in[2], ws, lds); else attn_unit<true>(bh >> 3, bh & 7, Q, a.in[2], ws, lds); } }
    }
    SEAM(5);
    PH(6) {
        pg8::StaticOrder S; S.init(NT, D_MODEL, G, (int)blockIdx.x);
        { pg8::Gemm g{(const bf16_t*)(ws + WS_XN), (const bf16_t*)(ws + WS_WGAB), NT, D_MODEL, D_MODEL}; EpiSig E{ws, 0}; pg8::gemm_phase<EpiSig, pg8::StaticOrder, PG8_ALIGN, PG8_SP2>(lds, g, S, E); }
        { pg8::Gemm g{(const bf16_t*)(ws + WS_XN), (const bf16_t*)(ws + WS_WGAB) + (size_t)1024 * 1024, NT, D_MODEL, D_MODEL}; EpiSig E{ws, 1}; pg8::gemm_phase<EpiSig, pg8::StaticOrder, PG8_ALIGN, PG8_SP2>(lds, g, S, E); }
        { pg8::Gemm g{(const bf16_t*)(ws + WS_OAB), (const bf16_t*)(ws + WS_WBA), NT, D_MODEL, D_MODEL}; EpiMrgF E{ws}; pg8::gemm_phase<EpiMrgF, pg8::StaticOrder, PG8_ALIGN, PG8_SP2>(lds, g, S, E); }
    }
    SEAM(7);
    PH(8) {
        pg8::Gemm g{(const bf16_t*)(ws + WS_MRG), (const bf16_t*)(ws + WS_WOUT), NT, D_MODEL, D_MODEL}; pg8::StaticOrder S; S.init(NT, D_MODEL, G, (int)blockIdx.x);
        EpiV E{a.in[0], (const float*)(ws + WS_ADA), a.out}; pg8::gemm_phase<EpiV, pg8::StaticOrder, PG8_ALIGN, PG8_SP2>(lds, g, S, E);
    }
    SEAM(8);
#ifdef DUP_P8
    p8_phase<false>(a.in, a.out, (float*)(ws + 129 * MiB), (bf16_t*)(ws + 260 * MiB), ws, lds, G); xcd_barrier(bar);
#endif
    PH(9) p8_phase<true>(a.in, a.out, a.out, (bf16_t*)(ws + WS_H2), ws, lds, G);
    if (IN(9) && IN(11)) { GRIDBAR(); if (TSTAMP && blockIdx.x == 0 && tid == 0) ((unsigned long long*)(ws + WS_TS))[10] = __builtin_amdgcn_s_memrealtime(); }
    PH(11) {
        build_tables(ws, lds);
        pg8::Gemm g{(const bf16_t*)(ws + WS_H2), (const bf16_t*)(ws + WS_W13), 0, 0, D_MODEL}; GroupOrder<2> S{(const LAS int*)(lds + LDS_TAB), (const LAS int*)(lds + LDS_TAB) + 64, G, (int)blockIdx.x, (const int*)(ws + WS_LIST)};
        EpiHid E{ws}; pg8::gemm_phase<EpiHid, GroupOrder<2>, PG8_ALIGN, PG8_SP2, true>(lds, g, S, E);
    }
    SEAM(11);
    PH(12) {
        build_tables(ws, lds);
        int kd = D_EXP; asm volatile("" : "+s"(kd));
        pg8::Gemm g{(const bf16_t*)(ws + WS_HID), (const bf16_t*)(ws + WS_W2), 0, 0, kd}; GroupOrder<4> S{(const LAS int*)(lds + LDS_TAB), (const LAS int*)(lds + LDS_TAB) + 64, G, (int)blockIdx.x, nullptr};
        EpiY E{ws}; pg8::gemm_phase<EpiY, GroupOrder<4>, PG8_ALIGN, PG8_SP2>(lds, g, S, E);
    }
    SEAM(12);
#ifdef DUP_P12
    p12_phase(a.in, a.out, (float*)(ws + 129 * MiB), ws, lds, G); xcd_barrier(bar);
#endif
    PH(13) p12_phase(a.in, a.out, a.out, ws, lds, G);
    if (TSTAMP) { xcd_barrier(bar); if (blockIdx.x == 0 && tid == 0) ((unsigned long long*)(ws + WS_TS))[14] = __builtin_amdgcn_s_memrealtime(); }
#ifdef EXTRA_SYNCS
    for (int i_ = 0; i_ < EXTRA_SYNCS; ++i_) GRIDBAR();
#endif
#undef IN
#undef SEAM
#undef PH
}
}
#if TSTAMP
__global__ void kd_ts(float* out, long n, const unsigned long long* ts, int ka, int kb) {
    const float da = (ka == 14) ? (float)(ts[14] - ts[0]) * 0.01f / 10.f : (float)(ts[ka + 1] - ts[ka]) * 0.01f;
    const float sc = 1.f + da * 0.0005f;
    for (long i = (long)blockIdx.x * blockDim.x + threadIdx.x; i < n; i += (long)gridDim.x * blockDim.x) out[i] *= sc;
}
#endif
extern "C" void kernel_launch(void* const* d_in, const int* in_sizes, int n_in, void* d_out, int out_size,
                              void* d_ws, size_t ws_size, hipStream_t stream) {
    using namespace fk;
    static int grid = 0;
    if (grid == 0) {
        int dev = 0, cus = 0, per_cu = 0; (void)hipGetDevice(&dev); (void)hipDeviceGetAttribute(&cus, hipDeviceAttributeMultiprocessorCount, dev);
        (void)hipFuncSetAttribute((const void*)mk_fwd, hipFuncAttributeMaxDynamicSharedMemorySize, LDS_BYTES);
        (void)hipOccupancyMaxActiveBlocksPerMultiprocessor(&per_cu, (const void*)mk_fwd, NTHREADS, LDS_BYTES);
        (void)hipGetLastError();
        grid = cus * (per_cu >= 1 ? 1 : 1);
        if (ws_size < 512 * MiB) { fprintf(stderr, "kernel_launch: workspace too small\n"); grid = -1; }
    }
    if (grid < 0) return;
    (void)hipMemsetAsync((unsigned char*)d_ws + WS_BAR, 0, 16384, stream);
    Args a{}; for (int i = 0; i < 23; ++i) a.in[i] = (const float*)d_in[i]; a.out = (float*)d_out; a.ws = (unsigned char*)d_ws; a.ph_lo = 0; a.ph_hi = NPH;
    void* args[] = {&a};
    hipError_t e = hipLaunchCooperativeKernel((const void*)mk_fwd, dim3(grid), dim3(NTHREADS), args, LDS_BYTES, stream);
    if (e != hipSuccess) fprintf(stderr, "cooperative launch failed: %s\n", hipGetErrorString(e));
#if TSTAMP
    hipLaunchKernelGGL(kd_ts, dim3(1024), dim3(256), 0, stream, (float*)d_out, (long)out_size, (const unsigned long long*)((unsigned char*)d_ws + WS_TS), TS_A, TS_B);
#endif
}
```

```cpp
#include <hip/hip_runtime.h>
#include <hip/hip_cooperative_groups.h>
#include <cstdio>
#include <cstdint>
#include <cstring>
#include <cmath>
#ifdef HOST_EMU
#include <cmath>
#include <cstdio>
#include <cstdlib>
#include <cstring>
#include <cstdint>
struct Dim3e { int x, y, z; };
static thread_local Dim3e threadIdx, blockIdx, blockDim, gridDim;
#define __global__
#define __device__
#define __host__
#define __forceinline__ inline
#define __launch_bounds__(...)
typedef void* hipStream_t;
template <class F, class... A> static void host_launch(F f, long nb, int nt, A... a) {
#pragma omp parallel for schedule(dynamic, 4)
    for (long b = 0; b < nb; ++b) {
        blockIdx = {(int)b, 0, 0}; blockDim = {nt, 1, 1}; gridDim = {(int)nb, 1, 1};
        for (int t = 0; t < nt; ++t) { threadIdx = {t, 0, 0}; f(a...); }
    }
}
#define LAUNCH(k, nb, nt, st, ...) host_launch(k, (long)(nb), (int)(nt), __VA_ARGS__)
#define UNROLL
#else
#define LAUNCH(k, nb, nt, st, ...) hipLaunchKernelGGL(k, dim3((unsigned)(nb)), dim3((unsigned)(nt)), 0, st, __VA_ARGS__)
#endif

constexpr int D_MODEL = 1024, A_HEADS = 8, A_HD = 64, A_W = 512, I_HEADS = 16, I_DIM = 32, TOPK_MAX = 256, REL_B = 32,
              G_HEADS = 4, G_DK = 64, G_DV = 128, G_KW = 256, G_VW = 512, G_RANK = 16, N_GROUPS = 4, EPG = 8, N_EXP = 32, D_EXP = 256;
constexpr int O_AQ = 0, O_AK = 512, O_AV = 1024, O_IQ = 1536, O_IK = 2048, O_IW = 2080, O_GQ = 2096, O_GK = 2352, O_GV = 2608, O_GR = 3120,
              O_GLR = 3632, O_GA = 3648, O_GB = 4672, D_IN = 5696;
constexpr float DN_ALPHA = 1.189207115002721f, LN_EPS = 1e-5f;
#define V0_GID long gid = (long)blockIdx.x * blockDim.x + threadIdx.x

__device__ __forceinline__ float v0_silu(float v) { return v / (1.f + expf(-v)); }
__device__ __forceinline__ float v0_sigmoid(float v) { return 1.f / (1.f + expf(-v)); }

__global__ void k0_ada(const float* c, const float* w_ada, const float* b_ada, float* ada, int B) {
    V0_GID; if (gid >= (long)B * 6 * D_MODEL) return;
    const int b = (int)(gid / (6 * D_MODEL)), j = (int)(gid % (6 * D_MODEL));
    float acc = 0.f;
    for (int i = 0; i < D_MODEL; ++i) acc += v0_silu(c[b * D_MODEL + i]) * w_ada[(size_t)i * 6 * D_MODEL + j];
    ada[gid] = acc + b_ada[j];
}
__global__ void k0_lnmod(const float* x, const float* sh, const float* sc, float* h, int nrows) {
    V0_GID; if (gid >= nrows) return;
    const float* xr = x + (size_t)gid * D_MODEL; float* hr = h + (size_t)gid * D_MODEL;
    float mu = 0.f; for (int k = 0; k < D_MODEL; ++k) mu += xr[k]; mu *= (1.f / D_MODEL);
    float var = 0.f; for (int k = 0; k < D_MODEL; ++k) { const float d = xr[k] - mu; var += d * d; } var *= (1.f / D_MODEL);
    const float rs = 1.f / sqrtf(var + LN_EPS);
    for (int k = 0; k < D_MODEL; ++k) hr[k] = (xr[k] - mu) * rs * (1.f + sc[k]) + sh[k];
}
__global__ void k0_gemm(const float* A, int lda, const float* W, int ldw, float* C, int ldc, int M, int N, int K) {
    V0_GID; if (gid >= (long)(M / 4) * N) return;
    const int n = (int)(gid % N); const int m0 = (int)(gid / N) * 4;
    float a0 = 0.f, a1 = 0.f, a2 = 0.f, a3 = 0.f;
    const float* A0 = A + (size_t)m0 * lda;
    for (int k = 0; k < K; ++k) { const float w = W[(size_t)k * ldw + n]; a0 += A0[k] * w; a1 += A0[lda + k] * w; a2 += A0[2 * lda + k] * w; a3 += A0[3 * lda + k] * w; }
    C[(size_t)m0 * ldc + n] = a0; C[(size_t)(m0 + 1) * ldc + n] = a1; C[(size_t)(m0 + 2) * ldc + n] = a2; C[(size_t)(m0 + 3) * ldc + n] = a3;
}
__global__ void k0_scores(const float* P, float* scT, int S) {
    V0_GID; if (gid >= (long)S * S) return;
    const int t = (int)(gid % S), s = (int)(gid / S);
    if (s > t) { scT[gid] = -INFINITY; return; }
    const float* iq = P + (size_t)t * D_IN + O_IQ; const float* ik = P + (size_t)s * D_IN + O_IK; const float* iw = P + (size_t)t * D_IN + O_IW;
    const float cst = 0.044194173824159216f;
    float sc = 0.f;
    for (int h = 0; h < I_HEADS; ++h) { float d = 0.f; for (int k = 0; k < I_DIM; ++k) d += iq[h * I_DIM + k] * ik[k]; sc += (iw[h] * cst) * fmaxf(d, 0.f); }
    scT[gid] = sc;
}
__device__ __forceinline__ unsigned v0_key(float f) { unsigned u; memcpy(&u, &f, 4); return (u & 0x80000000u) ? ~u : (u | 0x80000000u); }
__global__ void k0_topk(const float* scT, int* sel, int* cnt, int S, int topk) {
    V0_GID; if (gid >= S) return;
    const int t = (int)gid; const int n = t + 1; int* sl = sel + (size_t)t * TOPK_MAX;
    if (n <= topk) { for (int s = 0; s < n; ++s) sl[s] = s; cnt[t] = n; return; }
    unsigned T = 0u;
    for (int bit = 31; bit >= 0; --bit) { const unsigned cand = T | (1u << bit); int c = 0; for (int s = 0; s < n; ++s) c += (v0_key(scT[(size_t)s * S + t]) >= cand) ? 1 : 0; if (c >= topk) T = cand; }
    int cgt = 0; for (int s = 0; s < n; ++s) cgt += (v0_key(scT[(size_t)s * S + t]) > T) ? 1 : 0;
    int need = topk - cgt, j = 0;
    for (int s = 0; s < n; ++s) { const unsigned k = v0_key(scT[(size_t)s * S + t]); if (k > T) sl[j++] = s; else if (k == T && need > 0) { sl[j++] = s; --need; } }
    cnt[t] = j;
}
__device__ __forceinline__ int v0_bucket(int d) {
    if (d < 16) return d;
    const float df = (float)d; int large = 16 + (int)(logf(df / 16.f) / 2.0794415416798357f * 16.f);
    return large < 31 ? large : 31;
}
__global__ void __launch_bounds__(256) k0_attn(const float* P, const int* sel, const int* cnt, const float* rel_bias, float* oa, int S) {
    V0_GID; if (gid >= (long)S * A_HEADS) return;
    const int t = (int)(gid / A_HEADS), h = (int)(gid % A_HEADS); const int n = cnt[t]; const int* sl = sel + (size_t)t * TOPK_MAX;
    const float* q = P + (size_t)t * D_IN + O_AQ + h * A_HD;
    float m = -INFINITY;
    for (int j = 0; j < n; ++j) { const int s = sl[j]; const float* k = P + (size_t)s * D_IN + O_AK + h * A_HD; float d = 0.f; for (int e = 0; e < A_HD; ++e) d += q[e] * k[e];
        const float l = d * 0.125f + rel_bias[v0_bucket(t - s) * A_HEADS + h]; m = fmaxf(m, l); }
    float o[A_HD];
#pragma unroll
    for (int e = 0; e < A_HD; ++e) o[e] = 0.f;
    float sum = 0.f;
    for (int j = 0; j < n; ++j) { const int s = sl[j]; const float* k = P + (size_t)s * D_IN + O_AK + h * A_HD; const float* v = P + (size_t)s * D_IN + O_AV + h * A_HD; float d = 0.f;
        for (int e = 0; e < A_HD; ++e) d += q[e] * k[e];
        const float p = expf(d * 0.125f + rel_bias[v0_bucket(t - s) * A_HEADS + h] - m); sum += p;
#pragma unroll
        for (int e = 0; e < A_HD; ++e) o[e] += p * v[e]; }
    const float inv = 1.f / sum;
#pragma unroll
    for (int e = 0; e < A_HD; ++e) oa[(size_t)t * A_W + h * A_HD + e] = o[e] * inv;
}
__global__ void k0_gate(const float* P, const float* wg, const float* bg, float* lg, int S) {
    V0_GID; if (gid >= (long)S * G_KW) return;
    const int t = (int)(gid / G_KW), j = (int)(gid % G_KW);
    float z = bg[j]; for (int r = 0; r < G_RANK; ++r) z += P[(size_t)t * D_IN + O_GLR + r] * wg[r * G_KW + j];
    lg[gid] = (fminf(z, 0.f) - log1pf(expf(-fabsf(z)))) * (1.f / 16.f);
}
__global__ void __launch_bounds__(64) k0_gla(const float* P, const float* lg, float* oraw, int S) {
    V0_GID; if (gid >= G_HEADS * G_DV) return;
    const int h = (int)(gid / G_DV), dv = (int)(gid % G_DV);
    float st[G_DK];
#pragma unroll
    for (int d = 0; d < G_DK; ++d) st[d] = 0.f;
    for (int t = 0; t < S; ++t) {
        const float* row = P + (size_t)t * D_IN; const float vv = row[O_GV + h * G_DV + dv]; float o = 0.f;
#pragma unroll
        for (int d = 0; d < G_DK; ++d) { const float a = expf(lg[(size_t)t * G_KW + h * G_DK + d]); st[d] = a * st[d] + row[O_GK + h * G_DK + d] * vv; o += row[O_GQ + h * G_DK + d] * st[d]; }
        oraw[(size_t)t * G_VW + h * G_DV + dv] = o * 0.125f;
    }
}
__global__ void k0_gla_post(const float* P, const float* oraw, const float* ng, float* ob, int S) {
    V0_GID; if (gid >= (long)S * G_HEADS) return;
    const int t = (int)(gid / G_HEADS), h = (int)(gid % G_HEADS); const float* o = oraw + (size_t)t * G_VW + h * G_DV;
    float mu = 0.f; for (int e = 0; e < G_DV; ++e) mu += o[e]; mu *= (1.f / G_DV);
    float var = 0.f; for (int e = 0; e < G_DV; ++e) { const float d = o[e] - mu; var += d * d; } var *= (1.f / G_DV);
    const float rs = 1.f / sqrtf(var + LN_EPS);
    for (int e = 0; e < G_DV; ++e) ob[(size_t)t * G_VW + h * G_DV + e] = (o[e] - mu) * rs * ng[h * G_DV + e] * v0_silu(P[(size_t)t * D_IN + O_GR + h * G_DV + e]);
}
__global__ void k0_merge(const float* P, const float* ba, const float* bb, float* mg, int S) {
    V0_GID; if (gid >= (long)S * D_MODEL) return;
    const int t = (int)(gid / D_MODEL), n = (int)(gid % D_MODEL);
    mg[gid] = v0_sigmoid(P[(size_t)t * D_IN + O_GA + n]) * ba[gid] + v0_sigmoid(P[(size_t)t * D_IN + O_GB + n]) * bb[gid];
}
__global__ void k0_ln1(const float* x, const float* y, const float* gt1, const float* g1, const float* b1, const float* sh2, const float* sc2, float* x1, float* h2, int nrows) {
    V0_GID; if (gid >= nrows) return;
    const float* xr = x + (size_t)gid * D_MODEL; const float* yr = y + (size_t)gid * D_MODEL; float* x1r = x1 + (size_t)gid * D_MODEL; float* h2r = h2 + (size_t)gid * D_MODEL;
    float mu = 0.f; for (int k = 0; k < D_MODEL; ++k) mu += DN_ALPHA * xr[k] + gt1[k] * yr[k]; mu *= (1.f / D_MODEL);
    float var = 0.f; for (int k = 0; k < D_MODEL; ++k) { const float d = DN_ALPHA * xr[k] + gt1[k] * yr[k] - mu; var += d * d; } var *= (1.f / D_MODEL);
    float rs = 1.f / sqrtf(var + LN_EPS);
    for (int k = 0; k < D_MODEL; ++k) x1r[k] = (DN_ALPHA * xr[k] + gt1[k] * yr[k] - mu) * rs * g1[k] + b1[k];
    mu = 0.f; for (int k = 0; k < D_MODEL; ++k) mu += x1r[k]; mu *= (1.f / D_MODEL);
    var = 0.f; for (int k = 0; k < D_MODEL; ++k) { const float d = x1r[k] - mu; var += d * d; } var *= (1.f / D_MODEL);
    rs = 1.f / sqrtf(var + LN_EPS);
    for (int k = 0; k < D_MODEL; ++k) h2r[k] = (x1r[k] - mu) * rs * (1.f + sc2[k]) + sh2[k];
}
__global__ void k0_route(const float* rl, const float* brg, const float* bre, int* eid, float* ew, int nrows) {
    V0_GID; if (gid >= nrows) return;
    const float* r = rl + (size_t)gid * 36;
    float gl[N_GROUPS]; float gm = -INFINITY; int gi = 0;
#pragma unroll
    for (int g = 0; g < N_GROUPS; ++g) { gl[g] = r[g] + brg[g]; if (gl[g] > gm) { gm = gl[g]; gi = g; } }
    float gs = 0.f;
#pragma unroll
    for (int g = 0; g < N_GROUPS; ++g) gs += expf(gl[g] - gm);
    const float gw = 1.f / gs;
    float v0 = -INFINITY, v1 = -INFINITY; int i0 = 0, i1 = 0;
    for (int e = 0; e < EPG; ++e) { const float v = r[4 + gi * EPG + e] + bre[gi * EPG + e];
        if (v > v0) { v1 = v0; i1 = i0; v0 = v; i0 = e; } else if (v > v1) { v1 = v; i1 = e; } }
    const float e1 = expf(v1 - v0); const float w0 = 1.f / (1.f + e1), w1 = e1 / (1.f + e1);
    eid[gid * 2] = gi * EPG + i0; eid[gid * 2 + 1] = gi * EPG + i1; ew[gid * 2] = w0 * gw; ew[gid * 2 + 1] = w1 * gw;
}
__global__ void k0_moe_hid(const float* h2, const int* eid, const float* w1, const float* w3, float* hid, int nrows) {
    V0_GID; if (gid >= (long)nrows * 2 * D_EXP) return;
    const int j = (int)(gid % D_EXP); const long ts = gid / D_EXP; const int t = (int)(ts / 2); const int e = eid[ts];
    const float* hr = h2 + (size_t)t * D_MODEL; const float* a = w1 + (size_t)e * D_MODEL * D_EXP + j; const float* b = w3 + (size_t)e * D_MODEL * D_EXP + j;
    float g = 0.f, u = 0.f; for (int k = 0; k < D_MODEL; ++k) { g += hr[k] * a[(size_t)k * D_EXP]; u += hr[k] * b[(size_t)k * D_EXP]; }
    hid[gid] = v0_silu(g) * u;
}
__global__ void k0_moe_out(const float* hid, const int* eid, const float* ew, const float* w2, float* f, int nrows) {
    V0_GID; if (gid >= (long)nrows * D_MODEL) return;
    const int n = (int)(gid % D_MODEL); const int t = (int)(gid / D_MODEL); float acc = 0.f;
    for (int sl = 0; sl < 2; ++sl) { const int e = eid[t * 2 + sl]; const float* hr = hid + ((size_t)t * 2 + sl) * D_EXP; const float* w = w2 + (size_t)e * D_EXP * D_MODEL + n; float a = 0.f;
        for (int j = 0; j < D_EXP; ++j) a += hr[j] * w[(size_t)j * D_MODEL]; acc += ew[t * 2 + sl] * a; }
    f[gid] = acc;
}
__global__ void k0_final(const float* x1, const float* f, const float* gt2, const float* g2, const float* b2, float* out, int nrows) {
    V0_GID; if (gid >= nrows) return;
    const float* xr = x1 + (size_t)gid * D_MODEL; const float* fr = f + (size_t)gid * D_MODEL; float* o = out + (size_t)gid * D_MODEL;
    float mu = 0.f; for (int k = 0; k < D_MODEL; ++k) mu += DN_ALPHA * xr[k] + gt2[k] * fr[k]; mu *= (1.f / D_MODEL);
    float var = 0.f; for (int k = 0; k < D_MODEL; ++k) { const float d = DN_ALPHA * xr[k] + gt2[k] * fr[k] - mu; var += d * d; } var *= (1.f / D_MODEL);
    const float rs = 1.f / sqrtf(var + LN_EPS);
    for (int k = 0; k < D_MODEL; ++k) o[k] = (DN_ALPHA * xr[k] + gt2[k] * fr[k] - mu) * rs * g2[k] + b2[k];
}

struct V0Buf { float *ada, *h, *P, *scT, *oa, *lg, *oraw, *ob, *ba, *bb, *mg, *y, *x1, *h2, *rl, *ew, *hid, *f; int *sel, *cnt, *eid; size_t bytes; };
static V0Buf v0_carve(void* base, int B, int S) {
    V0Buf b; char* p = (char*)base; auto take = [&](size_t n) { char* r = p; p += (n + 255) & ~(size_t)255; return r; };
    b.ada = (float*)take((size_t)B * 6 * D_MODEL * 4);
    b.P = (float*)take((size_t)S * D_IN * 4);
    b.h = (float*)take((size_t)S * D_MODEL * 4);
    b.scT = (float*)take((size_t)S * S * 4);
    b.sel = (int*)take((size_t)S * TOPK_MAX * 4); b.cnt = (int*)take((size_t)S * 4);
    b.oa = (float*)take((size_t)S * A_W * 4); b.lg = (float*)take((size_t)S * G_KW * 4); b.oraw = (float*)take((size_t)S * G_VW * 4); b.ob = (float*)take((size_t)S * G_VW * 4);
    b.ba = (float*)take((size_t)S * D_MODEL * 4); b.bb = (float*)take((size_t)S * D_MODEL * 4); b.y = (float*)take((size_t)S * D_MODEL * 4);
    b.x1 = (float*)take((size_t)S * D_MODEL * 4); b.h2 = (float*)take((size_t)S * D_MODEL * 4); b.f = (float*)take((size_t)S * D_MODEL * 4);
    b.mg = b.h;
    b.rl = (float*)take((size_t)S * 36 * 4); b.eid = (int*)take((size_t)S * 2 * 4); b.ew = (float*)take((size_t)S * 2 * 4); b.hid = (float*)take((size_t)S * 2 * D_EXP * 4);
    b.bytes = (size_t)(p - (char*)base); return b;
}
static void v0_forward(void* const* d_in, float* out, void* scratch, int B, int S, hipStream_t st, int only_batch = -1, int last_batch = -1) {
    const float *x = (const float*)d_in[0], *c = (const float*)d_in[1], *rel_bias = (const float*)d_in[2], *w_ada = (const float*)d_in[3], *b_ada = (const float*)d_in[4], *w_in = (const float*)d_in[5],
                *wg = (const float*)d_in[6], *bg = (const float*)d_in[7], *ng = (const float*)d_in[8], *wba = (const float*)d_in[9], *wbb = (const float*)d_in[10], *wout = (const float*)d_in[11],
                *g1 = (const float*)d_in[12], *b1 = (const float*)d_in[13], *wrg = (const float*)d_in[14], *brg = (const float*)d_in[15], *wre = (const float*)d_in[16], *bre = (const float*)d_in[17],
                *w1 = (const float*)d_in[18], *w3 = (const float*)d_in[19], *w2 = (const float*)d_in[20], *g2 = (const float*)d_in[21], *b2 = (const float*)d_in[22];
    V0Buf u = v0_carve(scratch, B, S);
    const int TB = 256; auto nb = [&](long n) { return (n + TB - 1) / TB; };
    const int topk = (TOPK_MAX < S / 4) ? TOPK_MAX : S / 4;
    LAUNCH(k0_ada, nb((long)B * 6 * D_MODEL), TB, st, c, w_ada, b_ada, u.ada, B);
    for (int bi = 0; bi < B; ++bi) {
        int b = bi; if (last_batch >= 0) b = (bi == B - 1) ? last_batch : (bi < last_batch ? bi : bi + 1);
        if (only_batch >= 0 && b != only_batch) continue;
        const float* xb = x + (size_t)b * S * D_MODEL; const float* ad = u.ada + (size_t)b * 6 * D_MODEL;
        const float *sh1 = ad, *sc1 = ad + D_MODEL, *gt1 = ad + 2 * D_MODEL, *sh2 = ad + 3 * D_MODEL, *sc2 = ad + 4 * D_MODEL, *gt2 = ad + 5 * D_MODEL;
        LAUNCH(k0_lnmod, nb(S), TB, st, xb, sh1, sc1, u.h, S);
        LAUNCH(k0_gemm, nb((long)(S / 4) * D_IN), TB, st, (const float*)u.h, D_MODEL, w_in, D_IN, u.P, D_IN, S, D_IN, D_MODEL);
        LAUNCH(k0_scores, nb((long)S * S), TB, st, (const float*)u.P, u.scT, S);
        LAUNCH(k0_topk, nb(S), TB, st, (const float*)u.scT, u.sel, u.cnt, S, topk);
        LAUNCH(k0_attn, nb((long)S * A_HEADS), TB, st, (const float*)u.P, (const int*)u.sel, (const int*)u.cnt, rel_bias, u.oa, S);
        LAUNCH(k0_gate, nb((long)S * G_KW), TB, st, (const float*)u.P, wg, bg, u.lg, S);
        LAUNCH(k0_gla, (G_HEADS * G_DV + 63) / 64, 64, st, (const float*)u.P, (const float*)u.lg, u.oraw, S);
        LAUNCH(k0_gla_post, nb((long)S * G_HEADS), TB, st, (const float*)u.P, (const float*)u.oraw, ng, u.ob, S);
        LAUNCH(k0_gemm, nb((long)(S / 4) * D_MODEL), TB, st, (const float*)u.oa, A_W, wba, D_MODEL, u.ba, D_MODEL, S, D_MODEL, A_W);
        LAUNCH(k0_gemm, nb((long)(S / 4) * D_MODEL), TB, st, (const float*)u.ob, G_VW, wbb, D_MODEL, u.bb, D_MODEL, S, D_MODEL, G_VW);
        LAUNCH(k0_merge, nb((long)S * D_MODEL), TB, st, (const float*)u.P, (const float*)u.ba, (const float*)u.bb, u.mg, S);
        LAUNCH(k0_gemm, nb((long)(S / 4) * D_MODEL), TB, st, (const float*)u.mg, D_MODEL, wout, D_MODEL, u.y, D_MODEL, S, D_MODEL, D_MODEL);
        LAUNCH(k0_ln1, nb(S), TB, st, xb, (const float*)u.y, gt1, g1, b1, sh2, sc2, u.x1, u.h2, S);
        LAUNCH(k0_gemm, nb((long)(S / 4) * N_GROUPS), TB, st, (const float*)u.h2, D_MODEL, wrg, N_GROUPS, u.rl, 36, S, N_GROUPS, D_MODEL);
        LAUNCH(k0_gemm, nb((long)(S / 4) * N_EXP), TB, st, (const float*)u.h2, D_MODEL, wre, N_EXP, u.rl + 4, 36, S, N_EXP, D_MODEL);
        LAUNCH(k0_route, nb(S), TB, st, (const float*)u.rl, brg, bre, u.eid, u.ew, S);
        LAUNCH(k0_moe_hid, nb((long)S * 2 * D_EXP), TB, st, (const float*)u.h2, (const int*)u.eid, w1, w3, u.hid, S);
        LAUNCH(k0_moe_out, nb((long)S * D_MODEL), TB, st, (const float*)u.hid, (const int*)u.eid, (const float*)u.ew, w2, u.f, S);
        LAUNCH(k0_final, nb(S), TB, st, (const float*)u.x1, (const float*)u.f, gt2, g2, b2, out + (size_t)b * S * D_MODEL, S);
    }
}
namespace pg8 {
#define PG8_LAS __attribute__((address_space(3)))
typedef unsigned short bf16_t;
typedef short bf16x8 __attribute__((ext_vector_type(8)));
typedef float f32x4 __attribute__((ext_vector_type(4)));
typedef unsigned u32x4 __attribute__((ext_vector_type(4)));
constexpr int BM = 256, BK = 64, HALF = 128, HTB = HALF * BK * 2  , STAGE_BYTES = 8 * HTB, NXCD = 8, WGM = 8;

__host__ __device__ __forceinline__ int lds_byte(int r, int c) { const int st = (r >> 4) * 2 + (c >> 5), rr = r & 15, cc = c & 31, ob = rr * 64 + cc * 2; return st * 1024 + (ob ^ (((ob >> 9) & 1) << 5)); }
__host__ __device__ __forceinline__ void stage_rc(int b, int& R, int& C) { const int st = b / 1024, sb = b % 1024, swz = sb ^ (((sb >> 9) & 1) << 5); R = (st >> 1) * 16 + swz / 64; C = (st & 1) * 32 + (swz % 64) / 2; }
__host__ __device__ __forceinline__ int perm32(int rho) { const int n = rho >> 4, i = rho & 15; return 8 * (i >> 2) + 4 * n + (i & 3); }

struct Unit { int pm, pn, pa, pb; };
struct Gemm { const bf16_t* A; const bf16_t* Bt; int M, N, K; };

struct StaticOrder {
    int nM, nN, nwg, G, c;
    __host__ __device__ void init(int M, int N, int G_, int c_) { nM = M / BM; nN = N / BM; nwg = nM * nN; G = G_; c = c_; }
    __host__ __device__ bool next(int i, Unit& u) const {
        const long L = (long)i * G + c; if (L >= nwg) return false;
        int wgid = (int)L; { const int q = nwg / NXCD, r = nwg % NXCD, xcd = wgid % NXCD, off = wgid / NXCD; wgid = (xcd < r ? xcd * (q + 1) : r * (q + 1) + (xcd - r) * q) + off; }
        const int nig = WGM * nN, gid = wgid / nig, fm = gid * WGM, gsz = (nM - fm) < WGM ? (nM - fm) : WGM;
        u.pm = fm + ((wgid % nig) % gsz); u.pn = (wgid % nig) / gsz; u.pa = u.pm; u.pb = u.pn; return true;
    }
    __device__ __forceinline__ void a_ready(const Unit&) const {}
    __device__ __forceinline__ void done(const Unit&) const {}
};

__device__ __forceinline__ unsigned cvt_pk_bf16(float lo, float hi) { unsigned r; asm volatile("v_cvt_pk_bf16_f32 %0, %1, %2" : "=v"(r) : "v"(lo), "v"(hi)); return r; }
typedef float f32x2 __attribute__((ext_vector_type(2)));

template <class Epi, class Sched, bool ALIGN_EPI = false, bool SP2 = false, bool GATHER = false>
__device__ __forceinline__ void gemm_phase(PG8_LAS unsigned char* lds, const Gemm g, const Sched& S, const Epi& E) {
    const int tid = threadIdx.x, wid = __builtin_amdgcn_readfirstlane(tid >> 6), lane = tid & 63, wr = wid >> 2, wc = wid & 3, fr = lane & 15, fq = lane >> 4;
    const int K = g.K, nt = K / BK;
    static_assert(!GATHER || SP2, "gathered A rows: SP2 loop only");
    unsigned voffA[2], voffB[2]; int Rr[2], Cc[2];
#pragma unroll
    for (int i = 0; i < 2; ++i) { int R, C; stage_rc(tid * 16 + i * 8192, R, C); const int Rb = Epi::PERM ? ((R & ~31) + perm32(R & 31)) : R; Rr[i] = R; Cc[i] = C;
        voffA[i] = (unsigned)(R * K + C) * 2u; voffB[i] = (unsigned)(Rb * K + C) * 2u; }
    unsigned vc0[2] = {voffA[0], voffA[1]}, vc1[2] = {voffA[0], voffA[1]}, vn0[2] = {voffA[0], voffA[1]}, vn1[2] = {voffA[0], voffA[1]};
    const size_t kstep = (size_t)(BK * 2);
    const size_t hstep = (size_t)HALF * K * 2;
    const size_t tstep = 2 * hstep;
    const unsigned ldsw = (unsigned)wid * 1024u;
    const int aoff = lds_byte(wr * 64 + fr, fq * 8), boff = lds_byte(wc * 32 + fr, fq * 8);
#define PG8_SA(b, h) (((b) * 2 + (h)) * HTB)
#define PG8_SB(b, h) ((4 + (b) * 2 + (h)) * HTB)
#define PG8_STAGE(bufoff, gbase, voff) do { _Pragma("unroll") for (int _i = 0; _i < 2; ++_i) \
        __builtin_amdgcn_global_load_lds((const unsigned*)((const char*)(gbase) + (voff)[_i]), (PG8_LAS unsigned*)(lds + (bufoff) + ldsw + _i * 8192), 16, 0, 0); } while (0)
#define PG8_LDA(dst, b, h) do { _Pragma("unroll") for (int m = 0; m < 4; ++m) _Pragma("unroll") for (int k = 0; k < 2; ++k) dst[m][k] = *(const PG8_LAS bf16x8*)(lds + PG8_SA(b, h) + aoff + m * 2048 + k * 1024); } while (0)
#define PG8_LDB(dst, b, h) do { _Pragma("unroll") for (int n = 0; n < 2; ++n) _Pragma("unroll") for (int k = 0; k < 2; ++k) dst[n][k] = *(const PG8_LAS bf16x8*)(lds + PG8_SB(b, h) + boff + n * 2048 + k * 1024); } while (0)
#define PG8_MMA(ai, bj, At, Bt) do { __builtin_amdgcn_s_setprio(1); _Pragma("unroll") for (int m = 0; m < 4; ++m) _Pragma("unroll") for (int n = 0; n < 2; ++n) _Pragma("unroll") for (int k = 0; k < 2; ++k) \
        acc[ai][bj][m][n] = __builtin_amdgcn_mfma_f32_16x16x32_bf16(Bt[n][k], At[m][k], acc[ai][bj][m][n], 0, 0, 0); __builtin_amdgcn_s_setprio(0); } while (0)
#define PG8_WAIT_V(n) asm volatile("s_waitcnt vmcnt(" #n ")" ::: "memory")
#define PG8_WAIT_L(n) asm volatile("s_waitcnt lgkmcnt(" #n ")" ::: "memory")
#define PG8_BAR __builtin_amdgcn_s_barrier()
#define PG8_SCHED __builtin_amdgcn_sched_barrier(0)
    Unit cur, nxt; int ui = 0;
    if (!S.next(0, cur)) return;
    f32x4 acc[2][2][4][2];
#pragma unroll
    for (int a = 0; a < 2; ++a)
#pragma unroll
        for (int b = 0; b < 2; ++b)
#pragma unroll
            for (int m = 0; m < 4; ++m)
#pragma unroll
                for (int n = 0; n < 2; ++n) acc[a][b][m][n] = (f32x4){0.f, 0.f, 0.f, 0.f};
    bf16x8 At[4][2], B0[2][2], B1[2][2];
    const char* cA = GATHER ? (const char*)g.A : (const char*)g.A + (size_t)cur.pa * tstep; const char* cB = (const char*)g.Bt + (size_t)cur.pb * tstep;
    const size_t hstepA = GATHER ? 0 : hstep;
    if constexpr (GATHER) {
#pragma unroll
        for (int i = 0; i < 2; ++i) { vc0[i] = (unsigned)S.a_row(cur, Rr[i]) * (unsigned)(K * 2) + (unsigned)(Cc[i] * 2); vc1[i] = (unsigned)S.a_row(cur, HALF + Rr[i]) * (unsigned)(K * 2) + (unsigned)(Cc[i] * 2); } }
    S.a_ready(cur);
    if constexpr (SP2) {
        PG8_STAGE(PG8_SB(0, 0), cB, voffB); PG8_STAGE(PG8_SB(0, 1), cB + hstep, voffB); PG8_STAGE(PG8_SA(0, 0), cA, vc0); PG8_STAGE(PG8_SA(0, 1), cA + hstepA, vc1);
        if (wr == 1) PG8_BAR;
        PG8_WAIT_V(2); PG8_BAR;
        PG8_STAGE(PG8_SB(1, 0), cB + kstep, voffB); PG8_STAGE(PG8_SA(1, 0), cA + kstep, vc0); PG8_STAGE(PG8_SB(1, 1), cB + hstep + kstep, voffB);
        PG8_WAIT_V(6); PG8_BAR;
    } else {
        PG8_STAGE(PG8_SB(0, 0), cB, voffB); PG8_STAGE(PG8_SA(0, 0), cA, voffA); PG8_STAGE(PG8_SB(0, 1), cB + hstep, voffB); PG8_STAGE(PG8_SA(0, 1), cA + hstep, voffA);
        if (wr == 1) PG8_BAR;
        PG8_WAIT_V(4); PG8_BAR;
        PG8_STAGE(PG8_SB(1, 0), cB + kstep, voffB); PG8_STAGE(PG8_SA(1, 0), cA + kstep, voffA); PG8_STAGE(PG8_SB(1, 1), cB + hstep + kstep, voffB);
        PG8_WAIT_V(6); PG8_BAR;
    }
    for (;;) {
        const bool has_next = S.next(ui + 1, nxt);
        const char* nA = GATHER ? cA : (has_next ? (const char*)g.A + (size_t)nxt.pa * tstep : cA); const char* nB = has_next ? (const char*)g.Bt + (size_t)nxt.pb * tstep : cB;
        if constexpr (GATHER) {
#pragma unroll
            for (int i = 0; i < 2; ++i) { vn0[i] = has_next ? (unsigned)S.a_row(nxt, Rr[i]) * (unsigned)(K * 2) + (unsigned)(Cc[i] * 2) : vc0[i]; vn1[i] = has_next ? (unsigned)S.a_row(nxt, HALF + Rr[i]) * (unsigned)(K * 2) + (unsigned)(Cc[i] * 2) : vc1[i]; } }
        for (int t = 0; t < nt; t += 2) {
            const bool last = (t == nt - 2);
            if constexpr (Epi::MID) { if (t == nt / 2) E.mid(acc, cur, wr, wc, fr, fq); }
            const char* a1 = cA + (size_t)(t + 1) * kstep;
            const char* a2 = last ? nA : cA + (size_t)(t + 2) * kstep; const char* b2 = last ? nB : cB + (size_t)(t + 2) * kstep;
            const char* a3 = a2 + kstep; const char* b3 = b2 + kstep;
            if (last && has_next) S.a_ready(nxt);
            if constexpr (SP2) {
            unsigned w0[2], w1[2];
#pragma unroll
            for (int i = 0; i < 2; ++i) { w0[i] = last ? vn0[i] : vc0[i]; w1[i] = last ? vn1[i] : vc1[i]; }
            PG8_LDB(B0, 0, 0); PG8_LDB(B1, 0, 1); PG8_SCHED; PG8_LDA(At, 0, 0); PG8_STAGE(PG8_SA(1, 1), a1 + hstepA, vc1);
            PG8_WAIT_V(8); PG8_WAIT_L(0); PG8_BAR; PG8_MMA(0, 0, At, B0); PG8_MMA(0, 1, At, B1); PG8_BAR; PG8_SCHED;
            PG8_LDA(At, 0, 1); PG8_STAGE(PG8_SB(0, 0), b2, voffB); PG8_STAGE(PG8_SB(0, 1), b2 + hstep, voffB); PG8_STAGE(PG8_SA(0, 0), a2, w0);
            PG8_WAIT_V(8); PG8_WAIT_L(0); PG8_BAR; PG8_MMA(1, 0, At, B0); PG8_MMA(1, 1, At, B1); PG8_BAR; PG8_SCHED;
            PG8_LDB(B0, 1, 0); PG8_LDB(B1, 1, 1); PG8_SCHED; PG8_LDA(At, 1, 0); PG8_STAGE(PG8_SA(0, 1), a2 + hstepA, w1);
            PG8_WAIT_V(8); PG8_WAIT_L(0); PG8_BAR; PG8_MMA(0, 0, At, B0); PG8_MMA(0, 1, At, B1); PG8_BAR; PG8_SCHED;
            PG8_LDA(At, 1, 1); PG8_STAGE(PG8_SB(1, 0), b3, voffB); PG8_STAGE(PG8_SB(1, 1), b3 + hstep, voffB); PG8_STAGE(PG8_SA(1, 0), a3, w0);
            PG8_WAIT_V(8); PG8_WAIT_L(0); PG8_BAR; PG8_MMA(1, 0, At, B0); PG8_MMA(1, 1, At, B1); PG8_BAR; PG8_SCHED;
            } else {
            PG8_LDB(B0, 0, 0); PG8_SCHED; PG8_LDA(At, 0, 0); PG8_STAGE(PG8_SA(1, 1), a1 + hstep, voffA);
            PG8_WAIT_L(8); PG8_BAR; PG8_WAIT_L(0); PG8_MMA(0, 0, At, B0); PG8_BAR; PG8_SCHED;
            PG8_LDB(B1, 0, 1); PG8_STAGE(PG8_SB(0, 0), b2, voffB);
            PG8_BAR; PG8_WAIT_L(0); PG8_MMA(0, 1, At, B1); PG8_BAR;
            PG8_LDA(At, 0, 1); PG8_STAGE(PG8_SA(0, 0), a2, voffA);
            PG8_BAR; PG8_WAIT_L(0); PG8_MMA(1, 0, At, B0); PG8_BAR; PG8_SCHED;
            PG8_STAGE(PG8_SB(0, 1), b2 + hstep, voffB);
            PG8_WAIT_V(6); PG8_BAR; PG8_MMA(1, 1, At, B1); PG8_BAR;
            PG8_LDB(B0, 1, 0); PG8_SCHED; PG8_LDA(At, 1, 0); PG8_STAGE(PG8_SA(0, 1), a2 + hstep, voffA);
            PG8_WAIT_L(8); PG8_BAR; PG8_WAIT_L(0); PG8_MMA(0, 0, At, B0); PG8_BAR; PG8_SCHED;
            PG8_LDB(B1, 1, 1); PG8_STAGE(PG8_SB(1, 0), b3, voffB);
            PG8_BAR; PG8_WAIT_L(0); PG8_MMA(0, 1, At, B1); PG8_BAR;
            PG8_LDA(At, 1, 1); PG8_STAGE(PG8_SA(1, 0), a3, voffA);
            PG8_BAR; PG8_WAIT_L(0); PG8_MMA(1, 0, At, B0); PG8_BAR; PG8_SCHED;
            PG8_STAGE(PG8_SB(1, 1), b3 + hstep, voffB);
            PG8_WAIT_V(6); PG8_BAR; PG8_MMA(1, 1, At, B1); PG8_BAR;
            }
        }
        if constexpr (ALIGN_EPI) { if (wr == 0) PG8_BAR; }
        if constexpr (!Epi::AFTER_DRAIN) { E(acc, cur, wr, wc, fr, fq); S.done(cur); }
        if (!has_next) break;
#pragma unroll
        for (int a = 0; a < 2; ++a)
#pragma unroll
            for (int b = 0; b < 2; ++b)
#pragma unroll
                for (int m = 0; m < 4; ++m)
#pragma unroll
                    for (int n = 0; n < 2; ++n) acc[a][b][m][n] = (f32x4){0.f, 0.f, 0.f, 0.f};
        cur = nxt; cA = nA; cB = nB; ++ui;
        if constexpr (GATHER) { vc0[0] = vn0[0]; vc0[1] = vn0[1]; vc1[0] = vn1[0]; vc1[1] = vn1[1]; }
        if constexpr (ALIGN_EPI) { if (wr == 1) PG8_BAR; }
    }
    PG8_WAIT_V(0);
    if constexpr (!ALIGN_EPI) { if (wr == 0) PG8_BAR; }
    PG8_BAR;
    if constexpr (Epi::AFTER_DRAIN) { E.fused(acc, cur, wr, wc, fr, fq, lds, wid, lane); S.done(cur); }
#undef PG8_SA
#undef PG8_SB
#undef PG8_STAGE
#undef PG8_LDA
#undef PG8_LDB
#undef PG8_MMA
#undef PG8_WAIT_V
#undef PG8_WAIT_L
#undef PG8_BAR
#undef PG8_SCHED
}
}

#ifndef PG8_SP2
#define PG8_SP2 true
#endif
#ifndef PG8_ALIGN
#define PG8_ALIGN true
#endif
#ifndef DUPSUB
#define DUPSUB 0
#endif
#ifndef TSTAMP
#define TSTAMP 0
#endif
#ifndef USE_CG_SYNC
#define USE_CG_SYNC 0
#endif
#ifndef DUPMASK
#define DUPMASK 0
#define DUPMASK_ON 0
#else
#define DUPMASK_ON 1
#endif
namespace cg = cooperative_groups;
namespace fk {
using pg8::bf16_t; using pg8::f32x4; using pg8::u32x4; using pg8::bf16x8; using pg8::Unit; using pg8::cvt_pk_bf16;
#define LAS __attribute__((address_space(3)))
#define LDS_WAIT() asm volatile("s_waitcnt lgkmcnt(0)" ::: "memory")
typedef unsigned u32x2 __attribute__((ext_vector_type(2)));
constexpr int NB = 8, NS = 4096, NT = NB * NS;
constexpr int NTHREADS = 512, NWAVES = 8, LDS_BYTES = 155648;
constexpr size_t MiB = (size_t)1 << 20;
constexpr size_t WS_ADA = 0, WS_CNT = 256 * 1024,
    WS_WIN = 1 * MiB, WS_WGAB = 9 * MiB, WS_WBA = 13 * MiB, WS_WBB = 14 * MiB, WS_WOUT = 15 * MiB, WS_W13 = 17 * MiB, WS_W2 = 49 * MiB,
    WS_XN = 65 * MiB, WS_QKV = 129 * MiB, WS_IQ = 225 * MiB, WS_GQK = 257 * MiB, WS_GV = 289 * MiB, WS_GR = 321 * MiB,
    WS_IK = 353 * MiB, WS_IW = 355 * MiB, WS_GLR = 357 * MiB, WS_SC = 358 * MiB, WS_MASK = 490 * MiB, WS_ADAP = 506 * MiB, WS_MISC = 509 * MiB;
constexpr int NPROJ = 3584;
constexpr size_t WS_WGT = 400 * 1024;
constexpr int KSL = 16;
constexpr float QSCALE = 0.125f * 1.4426950408889634f;
typedef float f32x2_t __attribute__((ext_vector_type(2))); typedef __bf16 bf16x2_t __attribute__((ext_vector_type(2)));
__device__ __forceinline__ unsigned cvtpk_s(float lo, float hi) { f32x2_t v = {lo, hi}; bf16x2_t b = __builtin_convertvector(v, bf16x2_t); return __builtin_bit_cast(unsigned, b); }
__device__ __forceinline__ void bf8_to_f(const u32x4 w, float* f) {
#pragma unroll
    for (int j = 0; j < 4; ++j) { f[2 * j] = __uint_as_float(w[j] << 16); f[2 * j + 1] = __uint_as_float(w[j] & 0xffff0000u); }
}

__device__ __forceinline__ void tr_item(const float* W, int ldw, int srccol, bf16_t* WT, int K, int dst_row0, int kb, LAS float* scr, int lane, int kdst0 = 0) {
    const int k0 = 64 * kb;
#pragma unroll
    for (int i = 0; i < 32; ++i) { const int kk = 2 * i + (lane >> 5); scr[kk * 33 + (lane & 31)] = W[(size_t)(k0 + kk) * ldw + srccol]; }
    LDS_WAIT();
    const int c = lane & 7;
#pragma unroll
    for (int j = 0; j < 4; ++j) { const int n = (lane >> 3) + 8 * j; const LAS float* s = scr + (8 * c) * 33 + n;
        u32x4 o; o.x = cvt_pk_bf16(s[0 * 33], s[1 * 33]); o.y = cvt_pk_bf16(s[2 * 33], s[3 * 33]); o.z = cvt_pk_bf16(s[4 * 33], s[5 * 33]); o.w = cvt_pk_bf16(s[6 * 33], s[7 * 33]);
        *(u32x4*)(WT + (size_t)(dst_row0 + n) * K + kdst0 + k0 + 8 * c) = o; }
    LDS_WAIT();
}
__device__ __forceinline__ int win_src(int n) {
    if (n < 2048) return n;
    if (n < 3584) return n + 48;
    if (n < 3616) return O_IK + (n - 3584);
    if (n < 3632) return O_IW + (n - 3616);
    return O_GLR + (n - 3632);
}
constexpr int I_ADA = 96 * KSL, I_WIN = 114 * 16, I_WGAB = 64 * 16, I_WB = 32 * 8, I_WOUT = 32 * 16, I_W13 = 32 * 16 * 16, I_W2 = 32 * 32 * 4;
constexpr int P0_ITEMS = I_ADA + I_WIN + I_WGAB + 2 * I_WB + I_WOUT + I_W13 + I_W2, P0_EARLY = I_ADA + I_WIN + I_WGAB + 2 * I_WB + I_WOUT;
__device__ __forceinline__ void p0_item(int it, const float* const* in, unsigned char* ws, LAS float* scr, int lane) {
    if (it < I_ADA) {
        const int cb = it / KSL, ks = it % KSL, k0 = ks * 64; const float* c = in[1]; const float* w = in[3];
#pragma unroll
        for (int b = 0; b < NB; ++b) { const float cv = c[b * D_MODEL + k0 + lane]; scr[b * 64 + lane] = cv / (1.f + __expf(-cv)); }
        LDS_WAIT();
        float acc[NB];
#pragma unroll
        for (int b = 0; b < NB; ++b) acc[b] = 0.f;
        const int col = cb * 64 + lane;
#pragma unroll 16
        for (int kk = 0; kk < 64; ++kk) { const float wv = w[(size_t)(k0 + kk) * (6 * D_MODEL) + col];
#pragma unroll
            for (int b = 0; b < NB; ++b) acc[b] += scr[b * 64 + kk] * wv; }
        float* adap = (float*)(ws + WS_ADAP);
#pragma unroll
        for (int b = 0; b < NB; ++b) adap[(size_t)(ks * NB + b) * (6 * D_MODEL) + col] = acc[b];
        LDS_WAIT(); return;
    }
    it -= I_ADA;
    const int l31 = lane & 31;
    if (it < I_WIN) { const int nb = it / 16, kb = it % 16; tr_item(in[5], D_IN, win_src(nb * 32 + l31), (bf16_t*)(ws + WS_WIN), 1024, nb * 32, kb, scr, lane); return; }
    it -= I_WIN;
    if (it < I_WGAB) { const int nb = it / 16, kb = it % 16; tr_item(in[5], D_IN, O_GA + nb * 32 + l31, (bf16_t*)(ws + WS_WGAB), 1024, nb * 32, kb, scr, lane); return; }
    it -= I_WGAB;
    if (it < I_WB) { const int nb = it / 8, kb = it % 8; tr_item(in[9], D_MODEL, nb * 32 + l31, (bf16_t*)(ws + WS_WBA), 1024, nb * 32, kb, scr, lane, 0); return; }
    it -= I_WB;
    if (it < I_WB) { const int nb = it / 8, kb = it % 8; tr_item(in[10], D_MODEL, nb * 32 + l31, (bf16_t*)(ws + WS_WBA), 1024, nb * 32, kb, scr, lane, 512); return; }
    it -= I_WB;
    if (it < I_WOUT) { const int nb = it / 16, kb = it % 16; tr_item(in[11], D_MODEL, nb * 32 + l31, (bf16_t*)(ws + WS_WOUT), 1024, nb * 32, kb, scr, lane); return; }
    it -= I_WOUT;
    if (it < I_W13) {
        const int e = it / 256, r = it % 256, nb = r / 16, kb = r % 16; const int row0 = nb * 32;
        const int half = (row0 & 255) >> 7; const int col = (row0 >> 8) * 128 + (row0 & 127) + l31;
        const float* src = (half ? in[19] : in[18]) + (size_t)e * D_MODEL * D_EXP;
        tr_item(src, D_EXP, col, (bf16_t*)(ws + WS_W13) + (size_t)e * 512 * 1024, 1024, row0, kb, scr, lane); return; }
    it -= I_W13;
    { const int e = it / 128, r = it % 128, nb = r / 4, kb = r % 4;
      tr_item(in[20] + (size_t)e * D_EXP * D_MODEL, D_MODEL, nb * 32 + l31, (bf16_t*)(ws + WS_W2) + (size_t)e * 1024 * 256, 256, nb * 32, kb, scr, lane); }
}

__device__ __forceinline__ float dpp_row_sum_f(float v) {
    v += __int_as_float(__builtin_amdgcn_update_dpp(0, __float_as_int(v), 0xB1, 0xF, 0xF, true));
    v += __int_as_float(__builtin_amdgcn_update_dpp(0, __float_as_int(v), 0x4E, 0xF, 0xF, true));
    v += __int_as_float(__builtin_amdgcn_update_dpp(0, __float_as_int(v), 0x141, 0xF, 0xF, true));
    v += __int_as_float(__builtin_amdgcn_update_dpp(0, __float_as_int(v), 0x140, 0xF, 0xF, true));
    return v;
}
__device__ __forceinline__ float wave_sum_u(float v) {
    v = dpp_row_sum_f(v);
    return (__int_as_float(__builtin_amdgcn_readlane(__float_as_int(v), 0)) + __int_as_float(__builtin_amdgcn_readlane(__float_as_int(v), 16)))
         + (__int_as_float(__builtin_amdgcn_readlane(__float_as_int(v), 32)) + __int_as_float(__builtin_amdgcn_readlane(__float_as_int(v), 48)));
}
template <int R> __device__ __forceinline__ void ln_center(f32x4 (&v)[R][4], float (&rstd)[R], float* meanout = nullptr) {
    float s[R];
#pragma unroll
    for (int r = 0; r < R; ++r) { s[r] = 0.f;
#pragma unroll
        for (int j = 0; j < 4; ++j) s[r] += (v[r][j].x + v[r][j].y) + (v[r][j].z + v[r][j].w); }
#pragma unroll
    for (int r = 0; r < R; ++r) s[r] = dpp_row_sum_f(s[r]);
    float q[R];
#pragma unroll
    for (int r = 0; r < R; ++r) { const float mean = ((__int_as_float(__builtin_amdgcn_readlane(__float_as_int(s[r]), 0)) + __int_as_float(__builtin_amdgcn_readlane(__float_as_int(s[r]), 16)))
                                                   + (__int_as_float(__builtin_amdgcn_readlane(__float_as_int(s[r]), 32)) + __int_as_float(__builtin_amdgcn_readlane(__float_as_int(s[r]), 48)))) * (1.f / D_MODEL);
        if (meanout) meanout[r] = mean;
        q[r] = 0.f;
#pragma unroll
        for (int j = 0; j < 4; ++j) { v[r][j] = v[r][j] - mean; q[r] += (v[r][j].x * v[r][j].x + v[r][j].y * v[r][j].y) + (v[r][j].z * v[r][j].z + v[r][j].w * v[r][j].w); } }
#pragma unroll
    for (int r = 0; r < R; ++r) q[r] = dpp_row_sum_f(q[r]);
#pragma unroll
    for (int r = 0; r < R; ++r) { const float var = ((__int_as_float(__builtin_amdgcn_readlane(__float_as_int(q[r]), 0)) + __int_as_float(__builtin_amdgcn_readlane(__float_as_int(q[r]), 16)))
                                                  + (__int_as_float(__builtin_amdgcn_readlane(__float_as_int(q[r]), 32)) + __int_as_float(__builtin_amdgcn_readlane(__float_as_int(q[r]), 48)))) * (1.f / D_MODEL);
        rstd[r] = 1.f / sqrtf(var + LN_EPS); }
}
__device__ __forceinline__ float wave_sum(float v) {
#pragma unroll
    for (int o = 1; o < 64; o <<= 1) v += __shfl_xor(v, o);
    return v;
}
__device__ __forceinline__ float ada_sum(const float* adap, const float* b_ada, int b, int j) {
    float s = b_ada[j];
#pragma unroll
    for (int k = 0; k < KSL; ++k) s += adap[(size_t)(k * NB + b) * (6 * D_MODEL) + j];
    return s;
}
__device__ __forceinline__ void p1_phase(const float* const* in, unsigned char* ws, LAS unsigned char* lds, int G) {
    const int tid = threadIdx.x, lane = tid & 63, wave = tid >> 6;
    const float* adap = (const float*)(ws + WS_ADAP); const float* b_ada = in[4]; const float* x = in[0];
    LAS float* sh = (LAS float*)lds; LAS float* sc = sh + D_MODEL;
    for (int blk = blockIdx.x; blk < NT / 128; blk += G) {
        const int b = blk / 32;
        __syncthreads();
        for (int j = tid; j < 2 * D_MODEL; j += NTHREADS) sh[j] = ada_sum(adap, b_ada, b, j);
        if ((blk & 31) == 0) { float* ada = (float*)(ws + WS_ADA) + (size_t)b * 6 * D_MODEL; for (int j = tid; j < 6 * D_MODEL; j += NTHREADS) ada[j] = ada_sum(adap, b_ada, b, j); }
        __syncthreads();
        for (int rb = 0; rb < 16; rb += 4) {
            const size_t row0 = (size_t)blk * 128 + wave * 16 + rb;
            f32x4 v[4][4];
#pragma unroll
            for (int r = 0; r < 4; ++r) { const f32x4* xr = (const f32x4*)(x + (row0 + r) * D_MODEL) + lane;
#pragma unroll
                for (int j = 0; j < 4; ++j) v[r][j] = xr[64 * j]; }
            float rstd[4]; ln_center<4>(v, rstd);
#pragma unroll
            for (int j = 0; j < 4; ++j) { const f32x4 a = *(const LAS f32x4*)(sc + 256 * j + 4 * lane) + 1.f, c = *(const LAS f32x4*)(sh + 256 * j + 4 * lane);
#pragma unroll
                for (int r = 0; r < 4; ++r) { const f32x4 y = v[r][j] * rstd[r] * a + c; u32x2 w; w.x = cvtpk_s(y.x, y.y); w.y = cvtpk_s(y.z, y.w);
                    ((u32x2*)((bf16_t*)(ws + WS_XN) + (row0 + r) * D_MODEL) + lane)[64 * j] = w; } }
        }
        asm volatile("s_waitcnt vmcnt(0)" ::: "memory"); __syncthreads();
        {   LAS unsigned char* W64 = lds + 8192; constexpr int WP = 2064;
            const bf16_t* wsrc = (const bf16_t*)(ws + WS_WIN) + (size_t)3584 * 1024;
            for (int i = tid; i < 64 * 128; i += NTHREADS) { const int n = i >> 7, c = i & 127; *(LAS u32x4*)(W64 + n * WP + c * 16) = *(const u32x4*)(wsrc + (size_t)n * 1024 + c * 8); }
            __syncthreads();
            const int fr = lane & 15, fq = lane >> 4; const size_t rowA = (size_t)blk * 128 + wave * 16 + fr;
            const bf16_t* xp = (const bf16_t*)(ws + WS_XN) + rowA * D_MODEL + 8 * fq;
            f32x4 acc[4];
#pragma unroll
            for (int nt = 0; nt < 4; ++nt) acc[nt] = (f32x4){0.f, 0.f, 0.f, 0.f};
#pragma unroll 8
            for (int ks = 0; ks < 32; ++ks) { const bf16x8 bfr = *(const bf16x8*)(xp + 32 * ks);
#pragma unroll
                for (int nt = 0; nt < 4; ++nt) { const bf16x8 afr = *(const LAS bf16x8*)(W64 + (16 * nt + fr) * WP + (32 * ks + 8 * fq) * 2); acc[nt] = __builtin_amdgcn_mfma_f32_16x16x32_bf16(afr, bfr, acc[nt], 0, 0, 0); } }
            { u32x2 w; w.x = cvtpk_s(acc[0][0], acc[0][1]); w.y = cvtpk_s(acc[0][2], acc[0][3]); *(u32x2*)((bf16_t*)(ws + WS_IK) + rowA * 32 + 4 * fq) = w;
              w.x = cvtpk_s(acc[1][0], acc[1][1]); w.y = cvtpk_s(acc[1][2], acc[1][3]); *(u32x2*)((bf16_t*)(ws + WS_IK) + rowA * 32 + 16 + 4 * fq) = w;
              *(f32x4*)((float*)(ws + WS_IW) + rowA * 16 + 4 * fq) = acc[2];
              w.x = cvtpk_s(acc[3][0], acc[3][1]); w.y = cvtpk_s(acc[3][2], acc[3][3]); *(u32x2*)((bf16_t*)(ws + WS_GLR) + rowA * 16 + 4 * fq) = w; }
        }
    }
}

struct EpiProj {
    static constexpr bool PERM = true, AFTER_DRAIN = false, MID = false;
    unsigned char* ws;
    __device__ __forceinline__ void operator()(const f32x4 (&acc)[2][2][4][2], const Unit& u, int wr, int wc, int fr, int fq) const {
        const int row0 = u.pm * 256 + wr * 64 + fr; const int pn = u.pn;
        {
            bf16_t* base; int ld, ct; float sc = 1.f;
            if (pn < 6) { base = (bf16_t*)(ws + WS_QKV); ld = 1536; ct = pn * 256; if (pn < 2) sc = QSCALE; }
            else if (pn < 8) { base = (bf16_t*)(ws + WS_IQ); ld = 512; ct = (pn - 6) * 256; }
            else if (pn < 10) { base = (bf16_t*)(ws + WS_GQK); ld = 512; ct = (pn - 8) * 256; }
            else if (pn < 12) { base = (bf16_t*)(ws + WS_GV); ld = 512; ct = (pn - 10) * 256; }
            else { base = (bf16_t*)(ws + WS_GR); ld = 512; ct = (pn - 12) * 256; }
            const int col0 = ct + wc * 32 + 8 * fq;
#pragma unroll
            for (int ai = 0; ai < 2; ++ai)
#pragma unroll
                for (int m = 0; m < 4; ++m) { bf16_t* rowp = base + (size_t)(row0 + ai * 128 + m * 16) * ld + col0;
#pragma unroll
                    for (int bj = 0; bj < 2; ++bj) { const f32x4 v0 = acc[ai][bj][m][0] * sc, v1 = acc[ai][bj][m][1] * sc;
                        u32x4 w; w.x = cvt_pk_bf16(v0[0], v0[1]); w.y = cvt_pk_bf16(v0[2], v0[3]); w.z = cvt_pk_bf16(v1[0], v1[1]); w.w = cvt_pk_bf16(v1[2], v1[3]);
                        *(u32x4*)(rowp + bj * 128) = w; } }
        }
    }
};

typedef float f32x4_t __attribute__((ext_vector_type(4)));
constexpr int SC_TILES_PER_B = 528, SC_ITEMS = NB * SC_TILES_PER_B;
__device__ __forceinline__ size_t keys_row_dw(int b, int t) {
    const int qi = t >> 7, r = t & 127; return (size_t)b * (SC_TILES_PER_B * 8192) + (size_t)8192 * (qi * (qi + 1) / 2) + (size_t)r * (qi + 1) * 64;
}
__device__ __forceinline__ unsigned score_key(float sc) {
    const _Float16 hf = (_Float16)sc; const unsigned short hb = __builtin_bit_cast(unsigned short, hf);
    return (hb & 0x8000u) ? (unsigned)(unsigned short)~hb : (unsigned)(hb | 0x8000u);
}
__device__ __forceinline__ void fma_abs4(f32x4& acc, const f32x4& d, float w) {
    float a0 = acc[0], a1 = acc[1], a2 = acc[2], a3 = acc[3];
    asm volatile("v_fma_f32 %0, |%4|, %8, %0\n\tv_fma_f32 %1, |%5|, %8, %1\n\tv_fma_f32 %2, |%6|, %8, %2\n\tv_fma_f32 %3, |%7|, %8, %3"
                 : "+v"(a0), "+v"(a1), "+v"(a2), "+v"(a3) : "v"(d[0]), "v"(d[1]), "v"(d[2]), "v"(d[3]), "v"(w));
    acc[0] = a0; acc[1] = a1; acc[2] = a2; acc[3] = a3;
}
constexpr int SC_SEGS_PER_B = 144, SC_SEGS = NB * SC_SEGS_PER_B;
__device__ __forceinline__ unsigned score_key2(float lo, float hi) {
    typedef _Float16 h2 __attribute__((ext_vector_type(2)));
    const unsigned x = __builtin_bit_cast(unsigned, __builtin_amdgcn_cvt_pkrtz(lo, hi));
    unsigned m; asm("v_pk_ashrrev_i16 %0, %2, %1" : "=v"(m) : "v"(x), "v"(0x000F000Fu));
    return x ^ (m | 0x80008000u);
}
__device__ __forceinline__ void p3a_run(int b, int qi, int kj0, int kj1, unsigned char* ws, LAS unsigned char* ldsw, int wave, int lane) {
    const int fr = lane & 15, fq = lane >> 4;
    const int t = qi * 128 + wave * 16 + fr; const size_t trow = (size_t)b * NS + t;
    const bf16_t* IQ = (const bf16_t*)(ws + WS_IQ) + trow * 512 + 8 * fq;
    const bf16_t* IK = (const bf16_t*)(ws + WS_IK) + ((size_t)b * NS + fr) * 32 + 8 * fq;
    const float* IW = (const float*)(ws + WS_IW) + trow * 16;
    LAS unsigned char* QL = ldsw; LAS float* WL = (LAS float*)(ldsw + 16384);
    bf16x8 kf[8];
#pragma unroll
    for (int kb = 0; kb < 8; ++kb) kf[kb] = *(const bf16x8*)(IK + ((size_t)kj0 * 128 + kb * 16) * 32);
    float qb[8];
#pragma unroll
    for (int j = 0; j < 8; ++j) qb[j] = 0.f;
#pragma unroll
    for (int hg = 0; hg < 4; ++hg) {
        const f32x4 w4 = *(const f32x4*)(IW + 4 * hg) * (0.5f * 0.044194173824159216f);
        u32x4 q4[4];
#pragma unroll
        for (int i = 0; i < 4; ++i) q4[i] = *(const u32x4*)(IQ + (4 * hg + i) * 32);
#pragma unroll
        for (int i = 0; i < 4; ++i) { *(LAS u32x4*)(QL + (4 * hg + i) * 1024 + lane * 16) = q4[i]; if (fq == 0) WL[(4 * hg + i) * 16 + fr] = w4[i]; float f[8]; bf8_to_f(q4[i], f);
#pragma unroll
            for (int j = 0; j < 8; ++j) qb[j] += w4[i] * f[j]; }
    }
    u32x4 qbw; qbw.x = cvtpk_s(qb[0], qb[1]); qbw.y = cvtpk_s(qb[2], qb[3]); qbw.z = cvtpk_s(qb[4], qb[5]); qbw.w = cvtpk_s(qb[6], qb[7]);
    const bf16x8 qbar = __builtin_bit_cast(bf16x8, qbw);
    LDS_WAIT();
    for (int kj = kj0; kj <= kj1; ++kj) {
        bf16x8 kn[8];
        const int kjn = (kj < kj1) ? kj + 1 : kj;
#pragma unroll
        for (int kb = 0; kb < 8; ++kb) kn[kb] = *(const bf16x8*)(IK + ((size_t)kjn * 128 + kb * 16) * 32);
        f32x4 acc[8];
#pragma unroll
        for (int kb = 0; kb < 8; ++kb) acc[kb] = __builtin_amdgcn_mfma_f32_16x16x32_bf16(kf[kb], qbar, (f32x4){0.f, 0.f, 0.f, 0.f}, 0, 0, 0);
        f32x4 dA[8], dB[8];
        { const bf16x8 qf = *(const LAS bf16x8*)(QL + lane * 16);
#pragma unroll
          for (int kb = 0; kb < 8; ++kb) dA[kb] = __builtin_amdgcn_mfma_f32_16x16x32_bf16(kf[kb], qf, (f32x4){0.f, 0.f, 0.f, 0.f}, 0, 0, 0); }
#pragma unroll 1
        for (int h = 0; h < I_HEADS; h += 2) {
            { const bf16x8 qf = *(const LAS bf16x8*)(QL + (h + 1) * 1024 + lane * 16);
#pragma unroll
              for (int kb = 0; kb < 8; ++kb) dB[kb] = __builtin_amdgcn_mfma_f32_16x16x32_bf16(kf[kb], qf, (f32x4){0.f, 0.f, 0.f, 0.f}, 0, 0, 0); }
            __builtin_amdgcn_sched_barrier(0);
            { const float w = WL[h * 16 + fr];
#pragma unroll
              for (int kb = 0; kb < 8; ++kb) fma_abs4(acc[kb], dA[kb], w); }
            __builtin_amdgcn_sched_barrier(0);
            { const int hn = (h + 2 < I_HEADS) ? h + 2 : h; const bf16x8 qf = *(const LAS bf16x8*)(QL + hn * 1024 + lane * 16);
#pragma unroll
              for (int kb = 0; kb < 8; ++kb) dA[kb] = __builtin_amdgcn_mfma_f32_16x16x32_bf16(kf[kb], qf, (f32x4){0.f, 0.f, 0.f, 0.f}, 0, 0, 0); }
            __builtin_amdgcn_sched_barrier(0);
            { const float w = WL[(h + 1) * 16 + fr];
#pragma unroll
              for (int kb = 0; kb < 8; ++kb) fma_abs4(acc[kb], dB[kb], w); }
            __builtin_amdgcn_sched_barrier(0);
        }
        unsigned* KEYS = (unsigned*)(ws + WS_SC) + keys_row_dw(b, t) + (size_t)kj * 64;
        const bool diag = (kj == qi);
#pragma unroll
        for (int kb = 0; kb < 4; ++kb) { u32x4 o;
#pragma unroll
            for (int r = 0; r < 4; ++r) { const int sl = kb * 16 + 4 * fq + r;
                unsigned kk = score_key2(acc[kb][r], acc[kb + 4][r]);
                if (diag) { const int tl = wave * 16 + fr; if (sl > tl) kk &= 0xFFFF0000u; if (sl + 64 > tl) kk &= 0x0000FFFFu; }
                o[r] = kk; }
            *(u32x4*)(KEYS + kb * 16 + 4 * fq) = o; }
#pragma unroll
        for (int kb = 0; kb < 8; ++kb) kf[kb] = kn[kb];
    }
    LDS_WAIT();
}

__device__ __forceinline__ int dpp_row_sum(int v) {
    v += __builtin_amdgcn_update_dpp(0, v, 0xB1, 0xF, 0xF, true);
    v += __builtin_amdgcn_update_dpp(0, v, 0x4E, 0xF, 0xF, true);
    v += __builtin_amdgcn_update_dpp(0, v, 0x141, 0xF, 0xF, true);
    v += __builtin_amdgcn_update_dpp(0, v, 0x140, 0xF, 0xF, true);
    return v;
}
__device__ __forceinline__ int wave_sum_i(int v) {
    v = dpp_row_sum(v);
    return __builtin_amdgcn_readlane(v, 0) + __builtin_amdgcn_readlane(v, 16) + __builtin_amdgcn_readlane(v, 32) + __builtin_amdgcn_readlane(v, 48);
}
__device__ __forceinline__ void pk_ge_count4(unsigned x0, unsigned x1, unsigned x2, unsigned x3, unsigned c2m1, unsigned one2, unsigned& c0, unsigned& c1, unsigned& c2, unsigned& c3) {
    unsigned d0, d1, d2, d3;
    asm volatile("v_pk_sub_u16 %0, %8, %12 clamp\n\tv_pk_sub_u16 %1, %9, %12 clamp\n\tv_pk_sub_u16 %2, %10, %12 clamp\n\tv_pk_sub_u16 %3, %11, %12 clamp\n\t"
                 "v_pk_min_u16 %0, %0, %13\n\tv_pk_min_u16 %1, %1, %13\n\tv_pk_min_u16 %2, %2, %13\n\tv_pk_min_u16 %3, %3, %13\n\t"
                 "v_pk_add_u16 %4, %4, %0\n\tv_pk_add_u16 %5, %5, %1\n\tv_pk_add_u16 %6, %6, %2\n\tv_pk_add_u16 %7, %7, %3"
                 : "=&v"(d0), "=&v"(d1), "=&v"(d2), "=&v"(d3), "+v"(c0), "+v"(c1), "+v"(c2), "+v"(c3) : "v"(x0), "v"(x1), "v"(x2), "v"(x3), "v"(c2m1), "v"(one2));
}
constexpr int TOPK = 256;
__device__ __forceinline__ int count_ge(const unsigned (&x)[32], int ng, unsigned cand) {
    const unsigned c2m1 = (cand - 1u) * 0x00010001u, one2 = 0x00010001u; unsigned c0 = 0u, c1 = 0u, c2 = 0u, c3 = 0u;
#pragma unroll
    for (int g = 0; g < 4; ++g) if (g < ng) { pk_ge_count4(x[8 * g], x[8 * g + 1], x[8 * g + 2], x[8 * g + 3], c2m1, one2, c0, c1, c2, c3); pk_ge_count4(x[8 * g + 4], x[8 * g + 5], x[8 * g + 6], x[8 * g + 7], c2m1, one2, c0, c1, c2, c3); }
    const unsigned s = (c0 + c1) + (c2 + c3);
    return wave_sum_i((int)((s & 0xFFFFu) + (s >> 16)));
}
__device__ __forceinline__ void p4a_load(int row_, unsigned char* ws, int lane, unsigned (&x)[32]) {
    const int row = __builtin_amdgcn_readfirstlane(row_); const int b = row / NS, t = row % NS; const int nc = (t >> 7) + 1;
    const unsigned* KEYS = (const unsigned*)(ws + WS_SC) + keys_row_dw(b, t) + lane;
    const unsigned dead = (unsigned)((lane & 15) << 6) * 0x00010001u;
#pragma unroll
    for (int c = 0; c < 32; ++c) { const int cc = c < nc ? c : nc - 1; const unsigned v = KEYS[cc * 64]; x[c] = c < nc ? v : dead; }
}
__device__ __forceinline__ int scan16_incl(int v) {
    v += __builtin_amdgcn_update_dpp(0, v, 0x111, 0xF, 0xF, true);
    v += __builtin_amdgcn_update_dpp(0, v, 0x112, 0xF, 0xF, true);
    v += __builtin_amdgcn_update_dpp(0, v, 0x114, 0xF, 0xF, true);
    v += __builtin_amdgcn_update_dpp(0, v, 0x118, 0xF, 0xF, true);
    return v;
}
__device__ __forceinline__ int scan64_incl(int v, int lane) {
    v = scan16_incl(v);
    const int t0 = __builtin_amdgcn_readlane(v, 15), t1 = __builtin_amdgcn_readlane(v, 31), t2 = __builtin_amdgcn_readlane(v, 47);
    return v + (lane >= 16 ? t0 : 0) + (lane >= 32 ? t1 : 0) + (lane >= 48 ? t2 : 0);
}
__device__ __forceinline__ void lds_inc(unsigned addr) { __hip_atomic_fetch_add((LAS unsigned*)(unsigned long)addr, 1u, __ATOMIC_RELAXED, __HIP_MEMORY_SCOPE_WORKGROUP); }
#define WAVE_LDS_ORDER() do { asm volatile("" ::: "memory"); __builtin_amdgcn_fence(__ATOMIC_ACQ_REL, "wavefront"); __builtin_amdgcn_wave_barrier(); asm volatile("" ::: "memory"); } while (0)
constexpr int SEL_LDS = 8192;
__device__ __forceinline__ void tie_fix(unsigned long long& m, unsigned long long e, int& run, int need) {
    if (e != 0ull) { const int n = __builtin_popcountll(e); int keep = need - run; run += n;
        if (keep < n) { if (keep < 0) keep = 0; unsigned long long d = e; for (int i = 0; i < keep; ++i) d &= d - 1ull; m &= ~d; } }
}
#define PUT4(mw0, mw1, a0, a1, a2, a3, L0) asm volatile("s_nop 3\n\tv_writelane_b32 %0, %2, %10\n\tv_writelane_b32 %1, %3, %10\n\tv_writelane_b32 %0, %4, %11\n\tv_writelane_b32 %1, %5, %11\n\t" \
        "v_writelane_b32 %0, %6, %12\n\tv_writelane_b32 %1, %7, %12\n\tv_writelane_b32 %0, %8, %13\n\tv_writelane_b32 %1, %9, %13" : "+v"(mw0), "+v"(mw1) \
        : "s"((unsigned)(a0)), "s"((unsigned)((a0) >> 32)), "s"((unsigned)(a1)), "s"((unsigned)((a1) >> 32)), "s"((unsigned)(a2)), "s"((unsigned)((a2) >> 32)), "s"((unsigned)(a3)), "s"((unsigned)((a3) >> 32)), \
          "n"(L0), "n"((L0) + 1), "n"((L0) + 2), "n"((L0) + 3))
__device__ __forceinline__ void p4a_row(int row_, unsigned char* ws, int lane, const unsigned (&x)[32], LAS unsigned char* H) {
    const int row = __builtin_amdgcn_readfirstlane(row_);
    const int t = row % NS; unsigned long long* MASK = (unsigned long long*)(ws + WS_MASK) + (size_t)row * 64;
    const int nc = (t >> 7) + 1;
    if (t < TOPK) {
        if (lane < 2 * nc) { const int lo = lane * 64; unsigned long long m = 0ull; if (t >= lo + 63) m = ~0ull; else if (t >= lo) m = (2ull << (t - lo)) - 1ull; MASK[lane] = m; }
        return;
    }
#define BIN1(v) ((0xFFCu & (v)) | (~0xFFCu & hb))
    const unsigned hb = (unsigned)(unsigned long)H;
    { const u32x4 z = (u32x4){0u, 0u, 0u, 0u};
#pragma unroll
      for (int i = 0; i < 4; ++i) *(LAS u32x4*)(H + i * 1024 + lane * 16) = z;
      *(LAS unsigned*)(H + 4096 + lane * 4) = 0u; }
    WAVE_LDS_ORDER();
#pragma unroll
    for (int c = 0; c < 32; c += 2) if (c < nc) {
        lds_inc(BIN1(x[c] >> 4)); lds_inc(BIN1(x[c] >> 20)); lds_inc(BIN1(x[c + 1] >> 4)); lds_inc(BIN1(x[c + 1] >> 20)); }
    WAVE_LDS_ORDER();
    int Bsel, cA;
    {   const LAS unsigned char* hp = H + (63 - lane) * 64;
        const u32x4 h0 = *(const LAS u32x4*)hp, h1 = *(const LAS u32x4*)(hp + 16), h2 = *(const LAS u32x4*)(hp + 32), h3 = *(const LAS u32x4*)(hp + 48);
        const int sl = (int)(((h0.x + h0.y) + (h0.z + h0.w)) + ((h1.x + h1.y) + (h1.z + h1.w)) + ((h2.x + h2.y) + (h2.z + h2.w)) + ((h3.x + h3.y) + (h3.z + h3.w)));
        const int P = scan64_incl(sl, lane);
        const int Ls = __builtin_ctzll(__ballot(P >= TOPK));
        const int E = __builtin_amdgcn_readlane(P - sl, Ls);
        const int hj = (int)*(const LAS unsigned*)(H + ((63 - Ls) * 16 + 15 - (lane & 15)) * 4);
        const int Pj = scan16_incl(hj);
        const int jl = __builtin_ctzll(__ballot(E + Pj >= TOPK) & 0xFFFFull);
        Bsel = (63 - Ls) * 16 + 15 - jl; cA = E + __builtin_amdgcn_readlane(Pj - hj, jl);
    }
    {   const unsigned Bs2 = ((unsigned)Bsel << 6) * 0x00010001u; const unsigned dump = 64u + (unsigned)lane, hb2 = hb + 4096u;
#pragma unroll
        for (int c = 0; c < 32; c += 2) if (c < nc) {
#pragma unroll
            for (int i = 0; i < 2; ++i) { const unsigned y = x[c + i] ^ Bs2;
                const unsigned il = (unsigned)(unsigned short)__builtin_elementwise_min((unsigned short)y, (unsigned short)dump), ih = __builtin_elementwise_min(y >> 16, dump);
                lds_inc((il << 2) + hb2); lds_inc((ih << 2) + hb2); } }
    }
    WAVE_LDS_ORDER();
    unsigned T; int cT, need;
    {   const int c2 = (int)*(const LAS unsigned*)(H + 4096 + (63 - lane) * 4);
        const int P2 = scan64_incl(c2, lane);
        const int L2 = __builtin_ctzll(__ballot(cA + P2 >= TOPK));
        cT = cA + __builtin_amdgcn_readlane(P2, L2); need = TOPK - (cT - __builtin_amdgcn_readlane(c2, L2));
        T = ((unsigned)Bsel << 6) + (unsigned)(63 - L2);
    }
    unsigned mw0 = 0u, mw1 = 0u;
    const bool tie = (cT != TOPK);
    const unsigned Th = T << 16; const unsigned short Ts = (unsigned short)T; int run = 0;
#pragma unroll
    for (int c = 0; c < 32; c += 2) if (c < nc) {
        unsigned long long a0 = __ballot((unsigned short)x[c] >= Ts), a1 = __ballot(x[c] >= Th), a2 = __ballot((unsigned short)x[c + 1] >= Ts), a3 = __ballot(x[c + 1] >= Th);
        if (tie) {
            const unsigned long long e0 = __ballot((unsigned short)x[c] == Ts), e1 = __ballot((x[c] >> 16) == T), e2 = __ballot((unsigned short)x[c + 1] == Ts), e3 = __ballot((x[c + 1] >> 16) == T);
            tie_fix(a0, e0, run, need); tie_fix(a1, e1, run, need); tie_fix(a2, e2, run, need); tie_fix(a3, e3, run, need);
        }
        PUT4(mw0, mw1, a0, a1, a2, a3, 2 * c);
    }
    if (lane < 2 * nc) MASK[lane] = ((unsigned long long)mw1 << 32) | mw0;
}

typedef float f32x16 __attribute__((ext_vector_type(16)));
typedef short s16x4 __attribute__((ext_vector_type(4)));
__device__ __forceinline__ int crow(int r, int hi) { return (r & 3) + 8 * (r >> 2) + 4 * hi; }
__device__ __forceinline__ s16x4 vtr(const LAS unsigned char* p) { return __builtin_bit_cast(s16x4, __builtin_amdgcn_ds_read_tr16_b64_v4i16((LAS s16x4*)p)); }
constexpr size_t WS_OAB = 358 * MiB;
constexpr int AT_ROWB = 144, AT_TILE = 64 * AT_ROWB;
constexpr int AT_VROWB = 192, AT_VTILE = 64 * AT_VROWB;
constexpr float LOG2E = 1.4426950408889634f;
constexpr float ATHR = 8.f;
__device__ __forceinline__ int sext_bit(unsigned w, int c) { int r; asm("v_bfe_i32 %0, %1, %2, 1" : "=v"(r) : "v"(w), "n"(c)); return r; }
__device__ __forceinline__ void attn_s(const LAS unsigned char* Kb, const LAS float* BT, const bf16x8 (&qr)[4], unsigned long long mword, bool far, bool first, int dist0,
                                       int r32, int hh, f32x16& o0, f32x16& o1, f32x16& o2, f32x16& nmB, float& mref, u32x4 (&pk)[4]) {
    f32x16 p0, p1;
#pragma unroll
    for (int ks = 0; ks < 4; ++ks) {
        const bf16x8 k0 = *(const LAS bf16x8*)(Kb + r32 * AT_ROWB + 32 * ks + 16 * hh);
        const bf16x8 k1 = *(const LAS bf16x8*)(Kb + (32 + r32) * AT_ROWB + 32 * ks + 16 * hh);
        if (ks == 0) { p0 = __builtin_amdgcn_mfma_f32_32x32x16_bf16(k0, qr[0], nmB, 0, 0, 0); p1 = __builtin_amdgcn_mfma_f32_32x32x16_bf16(k1, qr[0], nmB, 0, 0, 0); }
        else { p0 = __builtin_amdgcn_mfma_f32_32x32x16_bf16(k0, qr[ks], p0, 0, 0, 0); p1 = __builtin_amdgcn_mfma_f32_32x32x16_bf16(k1, qr[ks], p1, 0, 0, 0); }
    }
    if (!far) {
        const LAS float* bp = BT + (96 - 27 - 32) + dist0;
#pragma unroll
        for (int i = 0; i < 16; ++i) { const int c = (i & 3) + 8 * (i >> 2); p0[i] += bp[32 + 27 - c]; p1[i] += bp[27 - c]; }
    }
    float m0 = __builtin_fmaxf(__builtin_fmaxf(p0[0], p0[1]), p0[2]), m1 = __builtin_fmaxf(__builtin_fmaxf(p1[0], p1[1]), p1[2]);
#pragma unroll
    for (int i = 3; i < 15; i += 2) { m0 = __builtin_fmaxf(__builtin_fmaxf(m0, p0[i]), p0[i + 1]); m1 = __builtin_fmaxf(__builtin_fmaxf(m1, p1[i]), p1[i + 1]); }
    float mx = __builtin_fmaxf(__builtin_fmaxf(m0, m1), __builtin_fmaxf(p0[15], p1[15]));
    { const auto rr = __builtin_amdgcn_permlane32_swap(__float_as_uint(mx), __float_as_uint(mx), false, false); mx = __builtin_fmaxf(__uint_as_float(rr[0]), __uint_as_float(rr[1])); }
    if (first || __any(mx > ATHR)) {
        const float dl = (first || mx > ATHR) ? mx : 0.f; mref += dl; const float f = __builtin_amdgcn_exp2f(-dl);
#pragma unroll
        for (int i = 0; i < 16; ++i) { p0[i] -= dl; p1[i] -= dl; nmB[i] -= dl; o0[i] *= f; o1[i] *= f; o2[i] *= f; }
    }
    const unsigned wl = (unsigned)mword >> (4 * hh), wh = (unsigned)(mword >> 32) >> (4 * hh);
#pragma unroll
    for (int i = 0; i < 16; ++i) { const int c = (i & 3) + 8 * (i >> 2);
        p0[i] = __uint_as_float(__float_as_uint(__builtin_amdgcn_exp2f(p0[i])) & (unsigned)sext_bit(wl, c));
        p1[i] = __uint_as_float(__float_as_uint(__builtin_amdgcn_exp2f(p1[i])) & (unsigned)sext_bit(wh, c)); }
#pragma unroll
    for (int s2 = 0; s2 < 2; ++s2) {
        pk[s2].x = cvtpk_s(p0[8 * s2], p0[8 * s2 + 1]); pk[s2].y = cvtpk_s(p0[8 * s2 + 2], p0[8 * s2 + 3]); pk[s2].z = cvtpk_s(p0[8 * s2 + 4], p0[8 * s2 + 5]); pk[s2].w = cvtpk_s(p0[8 * s2 + 6], p0[8 * s2 + 7]);
        pk[2 + s2].x = cvtpk_s(p1[8 * s2], p1[8 * s2 + 1]); pk[2 + s2].y = cvtpk_s(p1[8 * s2 + 2], p1[8 * s2 + 3]); pk[2 + s2].z = cvtpk_s(p1[8 * s2 + 4], p1[8 * s2 + 5]); pk[2 + s2].w = cvtpk_s(p1[8 * s2 + 6], p1[8 * s2 + 7]); }
}
__device__ __forceinline__ void attn_pv(const LAS unsigned char* Vb, const u32x4 (&pk)[4], int voff, f32x16& o0, f32x16& o1, f32x16& o2) {
    const u32x4 onesw = (u32x4){0x3F803F80u, 0x3F803F80u, 0x3F803F80u, 0x3F803F80u}; const bf16x8 ones = __builtin_bit_cast(bf16x8, onesw);
#pragma unroll
    for (int q = 0; q < 4; ++q) {
        const bf16x8 pf = __builtin_bit_cast(bf16x8, pk[q]);
        const LAS unsigned char* vp = Vb + (16 * q) * AT_VROWB + voff;
        const s16x4 a0l = vtr(vp), a0h = vtr(vp + 8 * AT_VROWB), a1l = vtr(vp + 64), a1h = vtr(vp + 8 * AT_VROWB + 64);
        const bf16x8 va0 = (bf16x8){a0l[0], a0l[1], a0l[2], a0l[3], a0h[0], a0h[1], a0h[2], a0h[3]};
        const bf16x8 va1 = (bf16x8){a1l[0], a1l[1], a1l[2], a1l[3], a1h[0], a1h[1], a1h[2], a1h[3]};
        o0 = __builtin_amdgcn_mfma_f32_32x32x16_bf16(va0, pf, o0, 0, 0, 0);
        o1 = __builtin_amdgcn_mfma_f32_32x32x16_bf16(va1, pf, o1, 0, 0, 0);
        o2 = __builtin_amdgcn_mfma_f32_32x32x16_bf16(ones, pf, o2, 0, 0, 0);
    }
}
constexpr int AT_KB = 0, AT_VB = 2 * AT_TILE, AT_BT3 = AT_VB + 3 * AT_VTILE;
template <bool GB> __device__ __forceinline__ void attn_unit(int b, int h, int Q, const float* rel_bias, unsigned char* ws, LAS unsigned char* lds) {
    const int tid = threadIdx.x, lane = tid & 63, wave = __builtin_amdgcn_readfirstlane(tid >> 6), r32 = lane & 31, hh = lane >> 5;
    const size_t rowbase = (size_t)b * NS; const int t0w = 256 * Q + 32 * wave, t = t0w + r32;
    const bf16_t* QKV = (const bf16_t*)(ws + WS_QKV);
    LAS float* BT = (LAS float*)(lds + AT_BT3);
    const int NTL = 4 * (Q + 1);
    const int lastw = (t0w + 31) >> 6;
    const int srow = tid >> 3, sch = tid & 7;
    const bf16_t* kg = QKV + (rowbase + srow) * 1536 + 512 + h * 64 + sch * 8; const bf16_t* vg = kg + 512;
    const int soff = srow * AT_ROWB + sch * 16, svoff = srow * AT_VROWB + sch * 16;
    const unsigned long long* MK = (const unsigned long long*)(ws + WS_MASK) + (rowbase + t) * 64;
    const size_t tstride = (size_t)64 * 1536;
    u32x4 k0r = *(const u32x4*)kg, v0r = *(const u32x4*)vg;
    u32x4 kA = *(const u32x4*)(kg + tstride), vA = *(const u32x4*)(vg + tstride);
    u32x4 kB = *(const u32x4*)(kg + 2 * tstride), vB = *(const u32x4*)(vg + 2 * tstride);
    unsigned long long me = MK[0], mo = MK[(1 <= lastw) ? 1 : 0];
    bf16x8 qr[4];
#pragma unroll
    for (int ks = 0; ks < 4; ++ks) qr[ks] = *(const bf16x8*)(QKV + (rowbase + t) * 1536 + h * 64 + 16 * ks + 8 * hh);
    const float cB = rel_bias[31 * A_HEADS + h] * LOG2E;
    __syncthreads();
    if (tid < 352) { const int d = tid - 96; BT[tid] = rel_bias[v0_bucket(d < 0 ? 0 : d) * A_HEADS + h] * LOG2E - cB; }
    *(LAS u32x4*)(lds + AT_KB + soff) = k0r; *(LAS u32x4*)(lds + AT_VB + svoff) = v0r;
    f32x16 o0, o1, o2, nmB;
#pragma unroll
    for (int i = 0; i < 16; ++i) { o0[i] = 0.f; o1[i] = 0.f; o2[i] = 0.f; nmB[i] = cB; }
    float mref = 0.f;
    const int q4 = (lane & 15) >> 2, p4 = lane & 3, blk = (lane >> 4) & 1;
    const int voff = (4 * hh + q4) * AT_VROWB + (16 * blk + 4 * p4) * 2;
    u32x4 pk[4];
#pragma unroll
    for (int q = 0; q < 4; ++q) pk[q] = (u32x4){0u, 0u, 0u, 0u};
    int vcur = 0, vnext = AT_VTILE, vprev = 2 * AT_VTILE;
    for (int kt = 0; kt < NTL; kt += 2) {
        __syncthreads();
        *(LAS u32x4*)(lds + AT_KB + AT_TILE + soff) = kA; *(LAS u32x4*)(lds + AT_VB + vnext + svoff) = vA;
        { const int tn = (kt + 3 < NTL) ? kt + 3 : NTL - 1; kA = *(const u32x4*)(kg + (size_t)tn * tstride); vA = *(const u32x4*)(vg + (size_t)tn * tstride); }
        if (GB) { if (kt >= 1 && kt - 1 <= lastw) attn_pv(lds + AT_VB + vprev, pk, voff, o0, o1, o2); }
        if (kt <= lastw) attn_s(lds + AT_KB, BT, qr, me, (t0w - (64 * kt + 63) >= 113), kt == 0, t - 64 * kt - 4 * hh, r32, hh, o0, o1, o2, nmB, mref, pk);
        if (!GB) { if (kt <= lastw) attn_pv(lds + AT_VB + vcur, pk, voff, o0, o1, o2); }
        me = MK[(kt + 2 <= lastw) ? kt + 2 : lastw];
        { const int tmp = vprev; vprev = vcur; vcur = vnext; vnext = tmp; }
        __syncthreads();
        *(LAS u32x4*)(lds + AT_KB + soff) = kB; *(LAS u32x4*)(lds + AT_VB + vnext + svoff) = vB;
        { const int tn = (kt + 4 < NTL) ? kt + 4 : NTL - 1; kB = *(const u32x4*)(kg + (size_t)tn * tstride); vB = *(const u32x4*)(vg + (size_t)tn * tstride); }
        if (GB) { if (kt <= lastw) attn_pv(lds + AT_VB + vprev, pk, voff, o0, o1, o2); }
        if (kt + 1 <= lastw) attn_s(lds + AT_KB + AT_TILE, BT, qr, mo, (t0w - (64 * (kt + 1) + 63) >= 113), false, t - 64 * (kt + 1) - 4 * hh, r32, hh, o0, o1, o2, nmB, mref, pk);
        if (!GB) { if (kt + 1 <= lastw) attn_pv(lds + AT_VB + vcur, pk, voff, o0, o1, o2); }
        mo = MK[(kt + 3 <= lastw) ? kt + 3 : lastw];
        { const int tmp = vprev; vprev = vcur; vcur = vnext; vnext = tmp; }
    }
    if (GB) {
        if (NTL - 1 <= lastw) attn_pv(lds + AT_VB + vprev, pk, voff, o0, o1, o2);
    }
    const float inv = 1.f / o2[0];
    bf16_t* O = (bf16_t*)(ws + WS_OAB) + (rowbase + t) * 1024 + h * 64 + 4 * hh;
#pragma unroll
    for (int g = 0; g < 4; ++g) {
        u32x2 w0, w1; w0.x = cvtpk_s(o0[4 * g] * inv, o0[4 * g + 1] * inv); w0.y = cvtpk_s(o0[4 * g + 2] * inv, o0[4 * g + 3] * inv);
        w1.x = cvtpk_s(o1[4 * g] * inv, o1[4 * g + 1] * inv); w1.y = cvtpk_s(o1[4 * g + 2] * inv, o1[4 * g + 3] * inv);
        *(u32x2*)(O + 8 * g) = w0; *(u32x2*)(O + 32 + 8 * g) = w1;
    }
}

constexpr int GL_LG = 0, GL_SEG = 16384, GL_A = 18432, GL_B = GL_A + 9216, GL_C = GL_B + 9216, GL_VT = GL_C + 9216, GL_ST = GL_VT + 18432;
constexpr int GROWB = 144;
constexpr int GLA_ITEMS = NB * G_HEADS * 64;
__device__ __forceinline__ void gla_cumdecay(const u32x4 g0, const u32x4 g1, int h, const float* wg, const float* bg, LAS unsigned char* lds, float* lgc) {
    const int tid = threadIdx.x; LAS float* LG = (LAS float*)(lds + GL_LG); LAS float* SEG = (LAS float*)(lds + GL_SEG);
    {   const int c = tid >> 3, dg = tid & 7; float gl[16];
#pragma unroll
        for (int j = 0; j < 4; ++j) { gl[2 * j] = __uint_as_float(g0[j] << 16); gl[2 * j + 1] = __uint_as_float(g0[j] & 0xffff0000u); gl[8 + 2 * j] = __uint_as_float(g1[j] << 16); gl[8 + 2 * j + 1] = __uint_as_float(g1[j] & 0xffff0000u); }
        float z[8];
#pragma unroll
        for (int j = 0; j < 8; ++j) z[j] = bg[h * 64 + 8 * dg + j];
#pragma unroll
        for (int r = 0; r < 16; ++r) { const f32x4 w0 = *(const f32x4*)(wg + r * G_KW + h * 64 + 8 * dg), w1 = *(const f32x4*)(wg + r * G_KW + h * 64 + 8 * dg + 4);
            z[0] += gl[r] * w0[0]; z[1] += gl[r] * w0[1]; z[2] += gl[r] * w0[2]; z[3] += gl[r] * w0[3]; z[4] += gl[r] * w1[0]; z[5] += gl[r] * w1[1]; z[6] += gl[r] * w1[2]; z[7] += gl[r] * w1[3]; }
#pragma unroll
        for (int j = 0; j < 8; ++j) z[j] = (fminf(z[j], 0.f) - log1pf(__expf(-fabsf(z[j])))) * (1.f / 16.f);
        *(LAS f32x4*)(LG + c * 64 + 8 * dg) = (f32x4){z[0], z[1], z[2], z[3]}; *(LAS f32x4*)(LG + c * 64 + 8 * dg + 4) = (f32x4){z[4], z[5], z[6], z[7]};
    }
    __syncthreads();
    const int seg = tid >> 6, d = tid & 63; float v[8];
#pragma unroll
    for (int i = 0; i < 8; ++i) v[i] = LG[(8 * seg + i) * 64 + d];
#pragma unroll
    for (int i = 1; i < 8; ++i) v[i] += v[i - 1];
    SEG[seg * 64 + d] = v[7];
    __syncthreads();
    float off = 0.f;
#pragma unroll
    for (int s2 = 0; s2 < 8; ++s2) if (s2 < seg) off += SEG[s2 * 64 + d];
#pragma unroll
    for (int i = 0; i < 8; ++i) { const float bv = v[i] + off; LG[(8 * seg + i) * 64 + d] = bv; lgc[(8 * seg + i) * 64 + d] = bv; }
    __syncthreads();
}
__device__ __forceinline__ unsigned short f2bf_s(float f) { return (unsigned short)(cvtpk_s(f, 0.f) & 0xffffu); }
__device__ __forceinline__ void gla_stage_vt(const u32x4 a, const u32x4 b2, LAS unsigned char* lds) {
    const int tid = threadIdx.x, c = tid >> 3, d0 = (tid & 7) * 16;
#pragma unroll
    for (int j = 0; j < 4; ++j) {
        *(LAS unsigned short*)(lds + GL_VT + (d0 + 2 * j) * GROWB + c * 2) = (unsigned short)(a[j] & 0xffffu); *(LAS unsigned short*)(lds + GL_VT + (d0 + 2 * j + 1) * GROWB + c * 2) = (unsigned short)(a[j] >> 16);
        *(LAS unsigned short*)(lds + GL_VT + (d0 + 8 + 2 * j) * GROWB + c * 2) = (unsigned short)(b2[j] & 0xffffu); *(LAS unsigned short*)(lds + GL_VT + (d0 + 8 + 2 * j + 1) * GROWB + c * 2) = (unsigned short)(b2[j] >> 16); }
}
__device__ __forceinline__ void p3b_item(int it, const float* wg, const float* bg, float* UT, float* LGC, unsigned char* ws, LAS unsigned char* lds) {
    const int tid = threadIdx.x, lane = tid & 63, wave = tid >> 6, fr = lane & 15, fq = lane >> 4;
    const int bh = it >> 6, n = it & 63, b = bh >> 2, h = bh & 3; const size_t r0 = (size_t)b * NS + 64 * n;
    const int c_ = tid >> 3, dg_ = tid & 7;
    const bf16_t* gp_ = (const bf16_t*)(ws + WS_GLR) + (r0 + c_) * 16; const u32x4 g0 = *(const u32x4*)gp_, g1 = *(const u32x4*)(gp_ + 8);
    const u32x4 kraw = *(const u32x4*)((const bf16_t*)(ws + WS_GQK) + (r0 + c_) * 512 + 256 + h * 64 + 8 * dg_);
    const bf16_t* vp_ = (const bf16_t*)(ws + WS_GV) + (r0 + c_) * 512 + h * 128 + dg_ * 16; const u32x4 va_ = *(const u32x4*)vp_, vb_ = *(const u32x4*)(vp_ + 8);
    __syncthreads();
    gla_cumdecay(g0, g1, h, wg, bg, lds, LGC + (size_t)it * 4096);
    const LAS float* LG = (const LAS float*)(lds + GL_LG);
    {   const int c = tid >> 3, dg = tid & 7; float kf[8]; bf8_to_f(kraw, kf);
#pragma unroll
        for (int j = 0; j < 8; ++j) { const int d = 8 * dg + j; *(LAS unsigned short*)(lds + GL_A + d * GROWB + c * 2) = f2bf_s(kf[j] * __expf(LG[63 * 64 + d] - LG[c * 64 + d])); }
        if (tid < 64) ((float*)(ws + WS_MISC))[(size_t)it * 64 + tid] = __expf(LG[63 * 64 + tid]);
    }
    gla_stage_vt(va_, vb_, lds);
    __syncthreads();
    f32x4 acc[4];
#pragma unroll
    for (int i = 0; i < 4; ++i) acc[i] = (f32x4){0.f, 0.f, 0.f, 0.f};
#pragma unroll
    for (int ks = 0; ks < 2; ++ks) { const bf16x8 bv = *(const LAS bf16x8*)(lds + GL_VT + (16 * wave + fr) * GROWB + (32 * ks + 8 * fq) * 2);
#pragma unroll
        for (int i = 0; i < 4; ++i) { const bf16x8 av = *(const LAS bf16x8*)(lds + GL_A + (16 * i + fr) * GROWB + (32 * ks + 8 * fq) * 2); acc[i] = __builtin_amdgcn_mfma_f32_16x16x32_bf16(av, bv, acc[i], 0, 0, 0); } }
#pragma unroll
    for (int i = 0; i < 4; ++i) *(f32x4*)(UT + ((size_t)it * 128 + 16 * wave + fr) * 64 + 16 * i + 4 * fq) = acc[i];
}
__device__ __forceinline__ void p4b_item(int j, const float* UT, bf16_t* SP, unsigned char* ws) {
    const int tid = threadIdx.x, bh = j >> 3, dv = (j & 7) * 16 + (tid >> 5), dk = (tid & 31) * 2; const float* DEC = (const float*)(ws + WS_MISC);
    typedef float f32x2v __attribute__((ext_vector_type(2)));
    f32x2v st = (f32x2v){0.f, 0.f};
#pragma unroll 8
    for (int n = 0; n < 64; ++n) { const size_t it = (size_t)bh * 64 + n; const size_t o = (it * 128 + dv) * 64 + dk;
        *(unsigned*)(SP + o) = cvtpk_s(st[0], st[1]);
        const f32x2v u = *(const f32x2v*)(UT + o), dc = *(const f32x2v*)(DEC + it * 64 + dk); st = dc * st + u; }
}
__device__ __forceinline__ void p5b_item(int it, const float* LGC, const float* ng, const bf16_t* SP, unsigned char* ws, LAS unsigned char* lds) {
    const int tid = threadIdx.x, lane = tid & 63, wave = tid >> 6, r32 = lane & 31, hh = lane >> 5;
    const int bh = it >> 6, n = it & 63, b = bh >> 2, h = bh & 3; const size_t r0 = (size_t)b * NS + 64 * n;
    const int c_ = tid >> 3, dg_ = tid & 7; const int dvb = wave >> 1, cb = wave & 1;
    const f32x4 lg0 = *(const f32x4*)(LGC + (size_t)it * 4096 + c_ * 64 + 8 * dg_), lg1 = *(const f32x4*)(LGC + (size_t)it * 4096 + c_ * 64 + 8 * dg_ + 4);
    const bf16_t* qp_ = (const bf16_t*)(ws + WS_GQK) + (r0 + c_) * 512 + h * 64 + 8 * dg_; const u32x4 qraw = *(const u32x4*)qp_, kraw = *(const u32x4*)(qp_ + 256);
    const bf16_t* vp_ = (const bf16_t*)(ws + WS_GV) + (r0 + c_) * 512 + h * 128 + dg_ * 16; const u32x4 va_ = *(const u32x4*)vp_, vb_ = *(const u32x4*)(vp_ + 8);
    bf16x8 spf[4];
#pragma unroll
    for (int ks = 0; ks < 4; ++ks) spf[ks] = *(const bf16x8*)(SP + ((size_t)it * 128 + 32 * dvb + r32) * 64 + 16 * ks + 8 * hh);
    const size_t trow = r0 + 32 * cb + r32; const int dvbase = h * 128 + 32 * dvb + 4 * hh;
    const bf16_t* grp = (const bf16_t*)(ws + WS_GR) + trow * 512 + dvbase; u32x2 grw[4];
#pragma unroll
    for (int g = 0; g < 4; ++g) grw[g] = *(const u32x2*)(grp + 8 * g);
    __syncthreads();
    { LAS float* LGw = (LAS float*)(lds + GL_LG); *(LAS f32x4*)(LGw + c_ * 64 + 8 * dg_) = lg0; *(LAS f32x4*)(LGw + c_ * 64 + 8 * dg_ + 4) = lg1; }
    __syncthreads();
    const LAS float* LG = (const LAS float*)(lds + GL_LG);
    {   const int c = tid >> 3, dg = tid & 7; float qf[8], kf[8]; bf8_to_f(qraw, qf); bf8_to_f(kraw, kf);
        float qr[8], ks[8], qi[8];
#pragma unroll
        for (int j = 0; j < 8; ++j) { const int d = 8 * dg + j; const float bc = LG[c * 64 + d], bl = LG[63 * 64 + d]; const float q8 = qf[j] * 0.125f;
            qr[j] = q8 * __expf(bc - bl); ks[j] = kf[j] * __expf(bl - bc); qi[j] = q8 * __expf(bc); }
        u32x4 w;
        w.x = cvtpk_s(qr[0], qr[1]); w.y = cvtpk_s(qr[2], qr[3]); w.z = cvtpk_s(qr[4], qr[5]); w.w = cvtpk_s(qr[6], qr[7]); *(LAS u32x4*)(lds + GL_A + c * GROWB + 16 * dg) = w;
        w.x = cvtpk_s(ks[0], ks[1]); w.y = cvtpk_s(ks[2], ks[3]); w.z = cvtpk_s(ks[4], ks[5]); w.w = cvtpk_s(ks[6], ks[7]); *(LAS u32x4*)(lds + GL_B + c * GROWB + 16 * dg) = w;
        w.x = cvtpk_s(qi[0], qi[1]); w.y = cvtpk_s(qi[2], qi[3]); w.z = cvtpk_s(qi[4], qi[5]); w.w = cvtpk_s(qi[6], qi[7]); *(LAS u32x4*)(lds + GL_C + c * GROWB + 16 * dg) = w;
    }
    gla_stage_vt(va_, vb_, lds);
    __syncthreads();
    f32x16 o;
#pragma unroll
    for (int i = 0; i < 16; ++i) o[i] = 0.f;
#pragma unroll
    for (int jb = 0; jb < 2; ++jb) if (jb <= cb) {
        f32x16 at;
#pragma unroll
        for (int i = 0; i < 16; ++i) at[i] = 0.f;
#pragma unroll
        for (int ks = 0; ks < 4; ++ks) { const bf16x8 av = *(const LAS bf16x8*)(lds + GL_B + (32 * jb + r32) * GROWB + 32 * ks + 16 * hh), bv = *(const LAS bf16x8*)(lds + GL_A + (32 * cb + r32) * GROWB + 32 * ks + 16 * hh);
            at = __builtin_amdgcn_mfma_f32_32x32x16_bf16(av, bv, at, 0, 0, 0); }
        if (jb == cb) {
#pragma unroll
            for (int i = 0; i < 16; ++i) if (crow(i, hh) > r32) at[i] = 0.f; }
#pragma unroll
        for (int s = 0; s < 2; ++s) {
            u32x4 pw; pw.x = cvtpk_s(at[8 * s], at[8 * s + 1]); pw.y = cvtpk_s(at[8 * s + 2], at[8 * s + 3]); pw.z = cvtpk_s(at[8 * s + 4], at[8 * s + 5]); pw.w = cvtpk_s(at[8 * s + 6], at[8 * s + 7]);
            const LAS unsigned char* vp = lds + GL_VT + (32 * dvb + r32) * GROWB + (32 * jb + 16 * s + 4 * hh) * 2;
            const u32x2 lo = *(const LAS u32x2*)vp, hi = *(const LAS u32x2*)(vp + 16);
            const u32x4 va = (u32x4){lo.x, lo.y, hi.x, hi.y};
            o = __builtin_amdgcn_mfma_f32_32x32x16_bf16(__builtin_bit_cast(bf16x8, va), __builtin_bit_cast(bf16x8, pw), o, 0, 0, 0);
        }
    }
#pragma unroll
    for (int ks = 0; ks < 4; ++ks) { const bf16x8 bv = *(const LAS bf16x8*)(lds + GL_C + (32 * cb + r32) * GROWB + 32 * ks + 16 * hh);
        o = __builtin_amdgcn_mfma_f32_32x32x16_bf16(spf[ks], bv, o, 0, 0, 0); }
    LAS float* ST = (LAS float*)(lds + GL_ST);
    float sm = 0.f;
#pragma unroll
    for (int i = 0; i < 16; ++i) sm += o[i];
    sm += __shfl_xor(sm, 32);
    if (hh == 0) ST[dvb * 64 + 32 * cb + r32] = sm;
    __syncthreads();
    const float mean = (ST[32 * cb + r32] + ST[64 + 32 * cb + r32] + ST[128 + 32 * cb + r32] + ST[192 + 32 * cb + r32]) * (1.f / 128.f);
    float sq = 0.f;
#pragma unroll
    for (int i = 0; i < 16; ++i) { o[i] -= mean; sq += o[i] * o[i]; }
    sq += __shfl_xor(sq, 32);
    if (hh == 0) ST[256 + dvb * 64 + 32 * cb + r32] = sq;
    __syncthreads();
    const float var = (ST[256 + 32 * cb + r32] + ST[256 + 64 + 32 * cb + r32] + ST[256 + 128 + 32 * cb + r32] + ST[256 + 192 + 32 * cb + r32]) * (1.f / 128.f);
    const float rstd = 1.f / sqrtf(var + LN_EPS);
    bf16_t* op = (bf16_t*)(ws + WS_OAB) + trow * 1024 + 512 + dvbase;
#pragma unroll
    for (int g = 0; g < 4; ++g) { const u32x2 gw = grw[g]; const f32x4 nv = *(const f32x4*)(ng + dvbase + 8 * g);
        float gr[4] = {__uint_as_float(gw.x << 16), __uint_as_float(gw.x & 0xffff0000u), __uint_as_float(gw.y << 16), __uint_as_float(gw.y & 0xffff0000u)}; float y[4];
#pragma unroll
        for (int e = 0; e < 4; ++e) y[e] = o[4 * g + e] * rstd * nv[e] * (gr[e] * __builtin_amdgcn_rcpf(1.f + __expf(-gr[e])));
        u32x2 w; w.x = cvtpk_s(y[0], y[1]); w.y = cvtpk_s(y[2], y[3]); *(u32x2*)(op + 8 * g) = w; }
}

constexpr int GL_HALF = 67584;
__device__ __forceinline__ void gla_cumdecay2(size_t r0, int h, const bf16_t* WGT, const float* bg, unsigned char* ws, LAS unsigned char* ldh, float* lgc) {
    const int tl = threadIdx.x & 255, lane = threadIdx.x & 63, wl = (threadIdx.x >> 6) & 3, r32 = lane & 31, hh = lane >> 5; LAS float* LG = (LAS float*)(ldh + GL_LG); LAS float* SEG = (LAS float*)(ldh + GL_SEG);
    {   const int cb = wl >> 1, db = wl & 1;
        const bf16x8 af = *(const bf16x8*)((const bf16_t*)(ws + WS_GLR) + (r0 + 32 * cb + r32) * 16 + 8 * hh), bfr = *(const bf16x8*)(WGT + (size_t)(h * 64 + 32 * db + r32) * 16 + 8 * hh);
        const float bias = bg[h * 64 + 32 * db + r32]; f32x16 z;
#pragma unroll
        for (int i = 0; i < 16; ++i) z[i] = bias;
        z = __builtin_amdgcn_mfma_f32_32x32x16_bf16(af, bfr, z, 0, 0, 0);
#pragma unroll
        for (int i = 0; i < 16; ++i) { const float zz = z[i]; LG[(32 * cb + crow(i, hh)) * 64 + 32 * db + r32] = (fminf(zz, 0.f) - __logf(1.f + __expf(-fabsf(zz)))) * (1.f / 16.f); }
    }
    __syncthreads();
    const int seg = tl >> 6, d = tl & 63; float v[16];
#pragma unroll
    for (int i = 0; i < 16; ++i) v[i] = LG[(16 * seg + i) * 64 + d];
#pragma unroll
    for (int i = 1; i < 16; ++i) v[i] += v[i - 1];
    SEG[seg * 64 + d] = v[15];
    __syncthreads();
    float off = 0.f;
#pragma unroll
    for (int s2 = 0; s2 < 4; ++s2) if (s2 < seg) off += SEG[s2 * 64 + d];
#pragma unroll
    for (int i = 0; i < 16; ++i) { const float bv = v[i] + off; LG[(16 * seg + i) * 64 + d] = bv; lgc[(16 * seg + i) * 64 + d] = bv; }
    __syncthreads();
}
__device__ __forceinline__ void gla_stage_vt2(const u32x4 (&vv)[4], LAS unsigned char* ldh) {
    const int tl = threadIdx.x & 255, c = tl >> 2, d0 = (tl & 3) * 32;
#pragma unroll
    for (int k = 0; k < 4; ++k)
#pragma unroll
        for (int j = 0; j < 4; ++j) {
            *(LAS unsigned short*)(ldh + GL_VT + (d0 + 8 * k + 2 * j) * GROWB + c * 2) = (unsigned short)(vv[k][j] & 0xffffu);
            *(LAS unsigned short*)(ldh + GL_VT + (d0 + 8 * k + 2 * j + 1) * GROWB + c * 2) = (unsigned short)(vv[k][j] >> 16); }
}
__device__ __forceinline__ void p3b_pair(int p, const float* wg, const float* bg, float* UT, float* LGC, unsigned char* ws, LAS unsigned char* lds) {
    const int tid = threadIdx.x, hb = tid >> 8, tl = tid & 255, lane = tid & 63, wl = (tid >> 6) & 3, fr = lane & 15, fq = lane >> 4;
    const int it = 2 * p + hb; LAS unsigned char* ldh = lds + hb * GL_HALF;
    const int bh = it >> 6, n = it & 63, b = bh >> 2, h = bh & 3; const size_t r0 = (size_t)b * NS + 64 * n;
    const int c_ = tl >> 2, dq_ = tl & 3;
    const bf16_t* kp_ = (const bf16_t*)(ws + WS_GQK) + (r0 + c_) * 512 + 256 + h * 64 + 16 * dq_; const u32x4 k0 = *(const u32x4*)kp_, k1 = *(const u32x4*)(kp_ + 8);
    const bf16_t* vp_ = (const bf16_t*)(ws + WS_GV) + (r0 + c_) * 512 + h * 128 + 32 * dq_; u32x4 vv[4];
#pragma unroll
    for (int k = 0; k < 4; ++k) vv[k] = *(const u32x4*)(vp_ + 8 * k);
    __syncthreads();
    gla_cumdecay2(r0, h, (const bf16_t*)(ws + WS_WGT), bg, ws, ldh, LGC + (size_t)it * 4096);
    const LAS float* LG = (const LAS float*)(ldh + GL_LG);
    {   float kf[16]; bf8_to_f(k0, kf); bf8_to_f(k1, kf + 8);
#pragma unroll
        for (int j = 0; j < 16; ++j) { const int d = 16 * dq_ + j; *(LAS unsigned short*)(ldh + GL_A + d * GROWB + c_ * 2) = f2bf_s(kf[j] * __expf(LG[63 * 64 + d] - LG[c_ * 64 + d])); }
        if (tl < 64) ((float*)(ws + WS_MISC))[(size_t)it * 64 + tl] = __expf(LG[63 * 64 + tl]);
    }
    gla_stage_vt2(vv, ldh);
    __syncthreads();
#pragma unroll
    for (int dvi = 0; dvi < 2; ++dvi) {
        const int dvblk = 2 * wl + dvi;
        f32x4 acc[4];
#pragma unroll
        for (int i = 0; i < 4; ++i) acc[i] = (f32x4){0.f, 0.f, 0.f, 0.f};
#pragma unroll
        for (int ks = 0; ks < 2; ++ks) { const bf16x8 bv = *(const LAS bf16x8*)(ldh + GL_VT + (16 * dvblk + fr) * GROWB + (32 * ks + 8 * fq) * 2);
#pragma unroll
            for (int i = 0; i < 4; ++i) { const bf16x8 av = *(const LAS bf16x8*)(ldh + GL_A + (16 * i + fr) * GROWB + (32 * ks + 8 * fq) * 2); acc[i] = __builtin_amdgcn_mfma_f32_16x16x32_bf16(av, bv, acc[i], 0, 0, 0); } }
#pragma unroll
        for (int i = 0; i < 4; ++i) *(f32x4*)(UT + ((size_t)it * 128 + 16 * dvblk + fr) * 64 + 16 * i + 4 * fq) = acc[i];
    }
}
__device__ __forceinline__ void p5b_pair(int p, const float* LGC, const float* ng, const bf16_t* SP, unsigned char* ws, LAS unsigned char* lds) {
    const int tid = threadIdx.x, hb = tid >> 8, tl = tid & 255, lane = tid & 63, wl = (tid >> 6) & 3, r32 = lane & 31, hh = lane >> 5;
    const int it = 2 * p + hb; LAS unsigned char* ldh = lds + hb * GL_HALF;
    const int bh = it >> 6, n = it & 63, b = bh >> 2, h = bh & 3; const size_t r0 = (size_t)b * NS + 64 * n;
    const int c_ = tl >> 2, dq_ = tl & 3; const int dvb = wl;
    f32x4 lg[4];
#pragma unroll
    for (int k = 0; k < 4; ++k) lg[k] = *(const f32x4*)(LGC + (size_t)it * 4096 + c_ * 64 + 16 * dq_ + 4 * k);
    const bf16_t* qp_ = (const bf16_t*)(ws + WS_GQK) + (r0 + c_) * 512 + h * 64 + 16 * dq_; const u32x4 q0 = *(const u32x4*)qp_, q1 = *(const u32x4*)(qp_ + 8), k0 = *(const u32x4*)(qp_ + 256), k1 = *(const u32x4*)(qp_ + 264);
    const bf16_t* vp_ = (const bf16_t*)(ws + WS_GV) + (r0 + c_) * 512 + h * 128 + 32 * dq_; u32x4 vv[4];
#pragma unroll
    for (int k = 0; k < 4; ++k) vv[k] = *(const u32x4*)(vp_ + 8 * k);
    bf16x8 spf[4];
#pragma unroll
    for (int ks = 0; ks < 4; ++ks) spf[ks] = *(const bf16x8*)(SP + ((size_t)it * 128 + 32 * dvb + r32) * 64 + 16 * ks + 8 * hh);
    const int dvbase = h * 128 + 32 * dvb + 4 * hh; u32x2 grw[2][4];
#pragma unroll
    for (int cb = 0; cb < 2; ++cb)
#pragma unroll
        for (int g = 0; g < 4; ++g) grw[cb][g] = *(const u32x2*)((const bf16_t*)(ws + WS_GR) + (r0 + 32 * cb + r32) * 512 + dvbase + 8 * g);
    __syncthreads();
    { LAS float* LGw = (LAS float*)(ldh + GL_LG);
#pragma unroll
      for (int k = 0; k < 4; ++k) *(LAS f32x4*)(LGw + c_ * 64 + 16 * dq_ + 4 * k) = lg[k]; }
    __syncthreads();
    const LAS float* LG = (const LAS float*)(ldh + GL_LG);
    {   float qf[16], kf[16]; bf8_to_f(q0, qf); bf8_to_f(q1, qf + 8); bf8_to_f(k0, kf); bf8_to_f(k1, kf + 8);
        float qr[16], ks[16], qi[16];
#pragma unroll
        for (int j = 0; j < 16; ++j) { const int d = 16 * dq_ + j; const float bc = LG[c_ * 64 + d], bl = LG[63 * 64 + d]; const float q8 = qf[j] * 0.125f;
            qr[j] = q8 * __expf(bc - bl); ks[j] = kf[j] * __expf(bl - bc); qi[j] = q8 * __expf(bc); }
#pragma unroll
        for (int k = 0; k < 2; ++k) { u32x4 w;
            w.x = cvtpk_s(qr[8 * k], qr[8 * k + 1]); w.y = cvtpk_s(qr[8 * k + 2], qr[8 * k + 3]); w.z = cvtpk_s(qr[8 * k + 4], qr[8 * k + 5]); w.w = cvtpk_s(qr[8 * k + 6], qr[8 * k + 7]); *(LAS u32x4*)(ldh + GL_A + c_ * GROWB + 32 * dq_ + 16 * k) = w;
            w.x = cvtpk_s(ks[8 * k], ks[8 * k + 1]); w.y = cvtpk_s(ks[8 * k + 2], ks[8 * k + 3]); w.z = cvtpk_s(ks[8 * k + 4], ks[8 * k + 5]); w.w = cvtpk_s(ks[8 * k + 6], ks[8 * k + 7]); *(LAS u32x4*)(ldh + GL_B + c_ * GROWB + 32 * dq_ + 16 * k) = w;
            w.x = cvtpk_s(qi[8 * k], qi[8 * k + 1]); w.y = cvtpk_s(qi[8 * k + 2], qi[8 * k + 3]); w.z = cvtpk_s(qi[8 * k + 4], qi[8 * k + 5]); w.w = cvtpk_s(qi[8 * k + 6], qi[8 * k + 7]); *(LAS u32x4*)(ldh + GL_C + c_ * GROWB + 32 * dq_ + 16 * k) = w; }
    }
    gla_stage_vt2(vv, ldh);
    __syncthreads();
    f32x16 o[2];
#pragma unroll
    for (int cb = 0; cb < 2; ++cb) {
#pragma unroll
        for (int i = 0; i < 16; ++i) o[cb][i] = 0.f;
#pragma unroll
        for (int jb = 0; jb < 2; ++jb) if (jb <= cb) {
            f32x16 at;
#pragma unroll
            for (int i = 0; i < 16; ++i) at[i] = 0.f;
#pragma unroll
            for (int ks = 0; ks < 4; ++ks) { const bf16x8 av = *(const LAS bf16x8*)(ldh + GL_B + (32 * jb + r32) * GROWB + 32 * ks + 16 * hh), bv = *(const LAS bf16x8*)(ldh + GL_A + (32 * cb + r32) * GROWB + 32 * ks + 16 * hh);
                at = __builtin_amdgcn_mfma_f32_32x32x16_bf16(av, bv, at, 0, 0, 0); }
            if (jb == cb) {
#pragma unroll
                for (int i = 0; i < 16; ++i) if (crow(i, hh) > r32) at[i] = 0.f; }
#pragma unroll
            for (int s2 = 0; s2 < 2; ++s2) {
                u32x4 pw; pw.x = cvtpk_s(at[8 * s2], at[8 * s2 + 1]); pw.y = cvtpk_s(at[8 * s2 + 2], at[8 * s2 + 3]); pw.z = cvtpk_s(at[8 * s2 + 4], at[8 * s2 + 5]); pw.w = cvtpk_s(at[8 * s2 + 6], at[8 * s2 + 7]);
                const LAS unsigned char* vp = ldh + GL_VT + (32 * dvb + r32) * GROWB + (32 * jb + 16 * s2 + 4 * hh) * 2;
                const u32x2 lo = *(const LAS u32x2*)vp, hi = *(const LAS u32x2*)(vp + 16);
                const u32x4 va = (u32x4){lo.x, lo.y, hi.x, hi.y};
                o[cb] = __builtin_amdgcn_mfma_f32_32x32x16_bf16(__builtin_bit_cast(bf16x8, va), __builtin_bit_cast(bf16x8, pw), o[cb], 0, 0, 0);
            }
        }
#pragma unroll
        for (int ks = 0; ks < 4; ++ks) { const bf16x8 bv = *(const LAS bf16x8*)(ldh + GL_C + (32 * cb + r32) * GROWB + 32 * ks + 16 * hh);
            o[cb] = __builtin_amdgcn_mfma_f32_32x32x16_bf16(spf[ks], bv, o[cb], 0, 0, 0); }
    }
    LAS float* ST = (LAS float*)(ldh + GL_ST);
#pragma unroll
    for (int cb = 0; cb < 2; ++cb) { float sm = 0.f;
#pragma unroll
        for (int i = 0; i < 16; ++i) sm += o[cb][i];
        sm += __shfl_xor(sm, 32);
        if (hh == 0) ST[dvb * 64 + 32 * cb + r32] = sm; }
    __syncthreads();
    float mean[2];
#pragma unroll
    for (int cb = 0; cb < 2; ++cb) { const int cc = 32 * cb + r32; mean[cb] = (ST[cc] + ST[64 + cc] + ST[128 + cc] + ST[192 + cc]) * (1.f / 128.f); float sq = 0.f;
#pragma unroll
        for (int i = 0; i < 16; ++i) { o[cb][i] -= mean[cb]; sq += o[cb][i] * o[cb][i]; }
        sq += __shfl_xor(sq, 32);
        if (hh == 0) ST[256 + dvb * 64 + cc] = sq; }
    __syncthreads();
#pragma unroll
    for (int cb = 0; cb < 2; ++cb) { const int cc = 32 * cb + r32; const float var = (ST[256 + cc] + ST[256 + 64 + cc] + ST[256 + 128 + cc] + ST[256 + 192 + cc]) * (1.f / 128.f);
        const float rstd = 1.f / sqrtf(var + LN_EPS);
        bf16_t* op = (bf16_t*)(ws + WS_OAB) + (r0 + cc) * 1024 + 512 + dvbase;
#pragma unroll
        for (int g = 0; g < 4; ++g) { const u32x2 gw = grw[cb][g]; const f32x4 nv = *(const f32x4*)(ng + dvbase + 8 * g);
            float gr[4] = {__uint_as_float(gw.x << 16), __uint_as_float(gw.x & 0xffff0000u), __uint_as_float(gw.y << 16), __uint_as_float(gw.y & 0xffff0000u)}; float y[4];
#pragma unroll
            for (int e = 0; e < 4; ++e) y[e] = o[cb][4 * g + e] * rstd * nv[e] * (gr[e] * __builtin_amdgcn_rcpf(1.f + __expf(-gr[e])));
            u32x2 w; w.x = cvtpk_s(y[0], y[1]); w.y = cvtpk_s(y[2], y[3]); *(u32x2*)(op + 8 * g) = w; } }
}

constexpr size_t WS_SG = 129 * MiB;
constexpr size_t WS_MRG = 257 * MiB;
constexpr size_t WS_H2 = WS_XN;
constexpr size_t WS_XG = 129 * MiB;
constexpr size_t WS_HID = 321 * MiB;
constexpr size_t WS_YG = 358 * MiB;
constexpr size_t WS_EID = WS_MISC + 1 * MiB, WS_EW = WS_EID + 256 * 1024, WS_POS = WS_EW + 256 * 1024, WS_ST1 = WS_POS + 256 * 1024;
constexpr size_t WS_LIST = 490 * MiB;
constexpr int LDS_TAB = 131072;
__device__ __forceinline__ u32x4 pack8(const f32x4 a, const f32x4 b) { u32x4 w; w.x = cvtpk_s(a[0], a[1]); w.y = cvtpk_s(a[2], a[3]); w.z = cvtpk_s(b[0], b[1]); w.w = cvtpk_s(b[2], b[3]); return w; }
__device__ __forceinline__ f32x4 sig4(const f32x4 v) { f32x4 r; r[0] = __builtin_amdgcn_rcpf(1.f + __expf(-v[0])); r[1] = __builtin_amdgcn_rcpf(1.f + __expf(-v[1])); r[2] = __builtin_amdgcn_rcpf(1.f + __expf(-v[2])); r[3] = __builtin_amdgcn_rcpf(1.f + __expf(-v[3])); return r; }
__device__ __forceinline__ void unpack8(const u32x4 w, f32x4& a, f32x4& b) {
    a[0] = __uint_as_float(w.x << 16); a[1] = __uint_as_float(w.x & 0xffff0000u); a[2] = __uint_as_float(w.y << 16); a[3] = __uint_as_float(w.y & 0xffff0000u);
    b[0] = __uint_as_float(w.z << 16); b[1] = __uint_as_float(w.z & 0xffff0000u); b[2] = __uint_as_float(w.w << 16); b[3] = __uint_as_float(w.w & 0xffff0000u);
}
#define EPI_ROWS(...) _Pragma("unroll") for (int ai = 0; ai < 2; ++ai) _Pragma("unroll") for (int m = 0; m < 4; ++m) { const size_t row = (size_t)(row0 + ai * 128 + m * 16); _Pragma("unroll") for (int bj = 0; bj < 2; ++bj) { __VA_ARGS__ } }
struct EpiSig {
    static constexpr bool PERM = true, AFTER_DRAIN = false, MID = false; unsigned char* ws; int half;
    __device__ __forceinline__ void operator()(const f32x4 (&acc)[2][2][4][2], const Unit& u, int wr, int wc, int fr, int fq) const {
        const int row0 = u.pm * 256 + wr * 64 + fr, col0 = half * 1024 + u.pn * 256 + wc * 32 + 8 * fq; bf16_t* SG = (bf16_t*)(ws + WS_SG);
        EPI_ROWS( *(u32x4*)(SG + row * 2048 + col0 + bj * 128) = pack8(sig4(acc[ai][bj][m][0]), sig4(acc[ai][bj][m][1])); )
    }
};
struct EpiMrgF {
    static constexpr bool PERM = true, AFTER_DRAIN = false, MID = true; unsigned char* ws;
    __device__ __forceinline__ void mid(f32x4 (&acc)[2][2][4][2], const Unit& u, int wr, int wc, int fr, int fq) const {
        const int row0 = u.pm * 256 + wr * 64 + fr, col0 = u.pn * 256 + wc * 32 + 8 * fq; const bf16_t* SG = (const bf16_t*)(ws + WS_SG);
        const bf16_t* p = SG + (size_t)row0 * 2048 + col0;
#pragma unroll
        for (int ai = 0; ai < 2; ++ai)
#pragma unroll
            for (int m = 0; m < 4; ++m) {
                asm volatile("" : "+v"(p));
#pragma unroll
                for (int bj = 0; bj < 2; ++bj) { f32x4 a0, a1, b0, b1; unpack8(*(const u32x4*)(p + bj * 128), a0, a1); unpack8(*(const u32x4*)(p + 1024 + bj * 128), b0, b1);
#pragma unroll
                    for (int e = 0; e < 4; ++e) { acc[ai][bj][m][0][e] *= a0[e] * __builtin_amdgcn_rcpf(fmaxf(b0[e], 1e-30f)); acc[ai][bj][m][1][e] *= a1[e] * __builtin_amdgcn_rcpf(fmaxf(b1[e], 1e-30f)); } }
                p += (m == 3 ? (128 - 48) : 16) * 2048; }
    }
    __device__ __forceinline__ void operator()(const f32x4 (&acc)[2][2][4][2], const Unit& u, int wr, int wc, int fr, int fq) const {
        const int row0 = u.pm * 256 + wr * 64 + fr, col0 = u.pn * 256 + wc * 32 + 8 * fq; const bf16_t* SG = (const bf16_t*)(ws + WS_SG) + 1024; bf16_t* MR = (bf16_t*)(ws + WS_MRG);
        EPI_ROWS( f32x4 g0, g1; unpack8(*(const u32x4*)(SG + row * 2048 + col0 + bj * 128), g0, g1); *(u32x4*)(MR + row * 1024 + col0 + bj * 128) = pack8(g0 * acc[ai][bj][m][0], g1 * acc[ai][bj][m][1]); )
    }
};
struct EpiV {
    static constexpr bool PERM = false, AFTER_DRAIN = false, MID = false; const float* x; const float* ada; float* out;
    __device__ __forceinline__ void operator()(const f32x4 (&acc)[2][2][4][2], const Unit& u, int wr, int wc, int fr, int fq) const {
        const int row0 = u.pm * 256 + wr * 64 + fr, col0 = u.pn * 256 + wc * 32 + 4 * fq; const float* gt1 = ada + (size_t)(u.pm >> 4) * 6 * D_MODEL + 2 * D_MODEL;
        EPI_ROWS( _Pragma("unroll") for (int n = 0; n < 2; ++n) { const int c = col0 + bj * 128 + n * 16; const f32x4 xv = *(const f32x4*)(x + row * D_MODEL + c), gv = *(const f32x4*)(gt1 + c);
                  *(f32x4*)(out + row * D_MODEL + c) = xv * DN_ALPHA + gv * acc[ai][bj][m][n]; } )
    }
};
struct EpiHid {
    static constexpr bool PERM = true, AFTER_DRAIN = false, MID = false; unsigned char* ws;
    __device__ __forceinline__ void operator()(const f32x4 (&acc)[2][2][4][2], const Unit& u, int wr, int wc, int fr, int fq) const {
        const int row0 = u.pm * 256 + wr * 64 + fr, col0 = u.pn * 128 + wc * 32 + 8 * fq; bf16_t* H = (bf16_t*)(ws + WS_HID);
#pragma unroll
        for (int ai = 0; ai < 2; ++ai)
#pragma unroll
            for (int m = 0; m < 4; ++m) { const size_t row = (size_t)(row0 + ai * 128 + m * 16); f32x4 h0, h1;
#pragma unroll
                for (int e = 0; e < 4; ++e) { const float g0 = acc[ai][0][m][0][e], g1 = acc[ai][0][m][1][e]; h0[e] = g0 * __builtin_amdgcn_rcpf(1.f + __expf(-g0)) * acc[ai][1][m][0][e]; h1[e] = g1 * __builtin_amdgcn_rcpf(1.f + __expf(-g1)) * acc[ai][1][m][1][e]; }
                *(u32x4*)(H + row * 256 + col0) = pack8(h0, h1); }
    }
};
struct EpiY {
    static constexpr bool PERM = true, AFTER_DRAIN = false, MID = false; unsigned char* ws;
    __device__ __forceinline__ void operator()(const f32x4 (&acc)[2][2][4][2], const Unit& u, int wr, int wc, int fr, int fq) const {
        const int row0 = u.pm * 256 + wr * 64 + fr, col0 = u.pn * 256 + wc * 32 + 8 * fq; bf16_t* Y = (bf16_t*)(ws + WS_YG);
        EPI_ROWS( *(u32x4*)(Y + row * 1024 + col0 + bj * 128) = pack8(acc[ai][bj][m][0], acc[ai][bj][m][1]); )
    }
};
__device__ __forceinline__ void build_tables(unsigned char* ws, LAS unsigned char* lds) {
    LAS int* toff = (LAS int*)(lds + LDS_TAB); LAS int* texp = toff + 64; const unsigned* gcnt = (const unsigned*)(ws + WS_CNT);
    __syncthreads();
    if (threadIdx.x == 0) { int o = 0; for (int e = 0; e < N_EXP; ++e) { toff[e] = o; const int ce = (int)gcnt[e * 32]; toff[400 + e] = ce; o += (ce + 255) >> 8; } toff[32] = o; }
    __syncthreads();
    for (int tl = threadIdx.x; tl < toff[32]; tl += NTHREADS) { int e = 0; while (toff[e + 1] <= tl) ++e; texp[tl] = e; }
    __syncthreads();
}
template <int NPN> struct GroupOrder {
    const LAS int* toff; const LAS int* texp; int G, c;
    __device__ __forceinline__ bool next(int i, Unit& u) const { const int L = i * G + c; if (L >= toff[32] * NPN) return false; const int tl = L / NPN, pn = L % NPN; u.pm = tl; u.pa = tl; u.pn = pn; u.pb = texp[tl] * NPN + pn; return true; }
    __device__ __forceinline__ void a_ready(const Unit&) const {}
    __device__ __forceinline__ void done(const Unit&) const {}
    const int* list;
    __device__ __forceinline__ int a_row(const Unit& u, int r) const { const int e = texp[u.pa]; const int idx = (u.pa - toff[e]) * 256 + r; return idx < toff[400 + e] ? list[e * 32768 + idx] : 0; }
};
constexpr int WT_LD = 1028;
constexpr int P8_LCNT = 36 * WT_LD * 4;
__device__ __forceinline__ float dot16(const f32x4 (&v)[4], const LAS float* wp, int lane) {
    float p = 0.f;
#pragma unroll
    for (int j = 0; j < 4; ++j) { const f32x4 w4 = *(const LAS f32x4*)(wp + 256 * j + 4 * lane); p += (v[j].x * w4.x + v[j].y * w4.y) + (v[j].z * w4.z + v[j].w * w4.w); }
    return p;
}
__device__ __forceinline__ float rl4sum(float v) {
    return (__int_as_float(__builtin_amdgcn_readlane(__float_as_int(v), 0)) + __int_as_float(__builtin_amdgcn_readlane(__float_as_int(v), 16)))
         + (__int_as_float(__builtin_amdgcn_readlane(__float_as_int(v), 32)) + __int_as_float(__builtin_amdgcn_readlane(__float_as_int(v), 48)));
}
template <bool REAL> __device__ __forceinline__ void p8_phase(const float* const* in, float* out, float* x1dst, bf16_t* h2dst, unsigned char* ws, LAS unsigned char* lds, int G) {
    const int tid = threadIdx.x, lane = tid & 63, wave = tid >> 6;
    LAS float* WT = (LAS float*)lds;
    LAS int* lcnt = (LAS int*)(lds + P8_LCNT); LAS int* lbase = lcnt + 32; LAS int* ent = lcnt + 64;
    const float* wrg = in[14]; const float* wre = in[16];
    __syncthreads();
    for (int i = tid; i < 1024; i += NTHREADS) { const f32x4 w = *(const f32x4*)(wrg + 4 * i); WT[0 * WT_LD + i] = w.x; WT[1 * WT_LD + i] = w.y; WT[2 * WT_LD + i] = w.z; WT[3 * WT_LD + i] = w.w; }
    for (int i = tid; i < 8192; i += NTHREADS) { const f32x4 w = *(const f32x4*)(wre + 4 * i); const int k = i >> 3, c = 4 * (i & 7);
        WT[(4 + c) * WT_LD + k] = w.x; WT[(5 + c) * WT_LD + k] = w.y; WT[(6 + c) * WT_LD + k] = w.z; WT[(7 + c) * WT_LD + k] = w.w; }
    const float* g1 = in[12]; const float* b1 = in[13]; const float* brg = in[15]; const float* bre = in[17];
    for (int blk = blockIdx.x; blk < NT / 128; blk += G) {
        const int b = blk / 32; const float* ada = (const float*)(ws + WS_ADA) + (size_t)b * 6 * D_MODEL; const float* sh2 = ada + 3 * D_MODEL; const float* sc2 = ada + 4 * D_MODEL;
        if (tid < 32) lcnt[tid] = 0;
        __syncthreads();
        for (int rb = 0; rb < 16; rb += 4) {
            const int rl0 = wave * 16 + rb; const size_t row0 = (size_t)blk * 128 + rl0;
            f32x4 v[4][4];
#pragma unroll
            for (int r = 0; r < 4; ++r) { const f32x4* xr = (const f32x4*)(out + (row0 + r) * D_MODEL) + lane;
#pragma unroll
                for (int j = 0; j < 4; ++j) v[r][j] = xr[64 * j]; }
            float rstd[4], mean1[4]; ln_center<4>(v, rstd, mean1);
            if (REAL && lane < 4) { typedef float f32x2v __attribute__((ext_vector_type(2))); ((f32x2v*)(ws + WS_ST1))[row0 + lane] = (f32x2v){lane == 0 ? mean1[0] : lane == 1 ? mean1[1] : lane == 2 ? mean1[2] : mean1[3], lane == 0 ? rstd[0] : lane == 1 ? rstd[1] : lane == 2 ? rstd[2] : rstd[3]}; }
#pragma unroll
            for (int j = 0; j < 4; ++j) { const f32x4 gg = *(const f32x4*)(g1 + 256 * j + 4 * lane), bb = *(const f32x4*)(b1 + 256 * j + 4 * lane);
#pragma unroll
                for (int r = 0; r < 4; ++r) v[r][j] = v[r][j] * rstd[r] * gg + bb; }
            ln_center<4>(v, rstd);
#pragma unroll
            for (int j = 0; j < 4; ++j) { const f32x4 a4 = *(const f32x4*)(sc2 + 256 * j + 4 * lane) + 1.f, c4 = *(const f32x4*)(sh2 + 256 * j + 4 * lane);
#pragma unroll
                for (int r = 0; r < 4; ++r) { v[r][j] = v[r][j] * rstd[r] * a4 + c4; u32x2 w; w.x = cvtpk_s(v[r][j].x, v[r][j].y); w.y = cvtpk_s(v[r][j].z, v[r][j].w);
                    ((u32x2*)(h2dst + (row0 + r) * D_MODEL) + lane)[64 * j] = w; } }
#pragma unroll
            for (int r = 0; r < 4; ++r) {
                float gp[N_GROUPS];
#pragma unroll
                for (int g = 0; g < N_GROUPS; ++g) gp[g] = dpp_row_sum_f(dot16(v[r], WT + g * WT_LD, lane));
                float gl[N_GROUPS];
#pragma unroll
                for (int g = 0; g < N_GROUPS; ++g) gl[g] = rl4sum(gp[g]) + brg[g];
                int gi = 0; float gm = gl[0];
#pragma unroll
                for (int g = 1; g < N_GROUPS; ++g) if (gl[g] > gm) { gm = gl[g]; gi = g; }
                float gs = 0.f;
#pragma unroll
                for (int g = 0; g < N_GROUPS; ++g) gs += __expf(gl[g] - gm);
                const float gw = 1.f / gs;
                float ep[EPG];
#pragma unroll
                for (int e = 0; e < EPG; ++e) ep[e] = dpp_row_sum_f(dot16(v[r], WT + (4 + gi * EPG + e) * WT_LD, lane));
                float v0 = -INFINITY, v1 = -INFINITY; int i0 = 0, i1 = 0;
#pragma unroll
                for (int e = 0; e < EPG; ++e) { const float ev = rl4sum(ep[e]) + bre[gi * EPG + e];
                    if (ev > v0) { v1 = v0; i1 = i0; v0 = ev; i0 = e; } else if (ev > v1) { v1 = ev; i1 = e; } }
                const float e1 = __expf(v1 - v0); const float w0 = gw / (1.f + e1), w1 = gw * e1 / (1.f + e1);
                if (REAL && lane == 0) { const int ea = gi * EPG + i0, eb = gi * EPG + i1; const int rl = rl0 + r; const size_t row = row0 + r;
                    const int pa = atomicAdd((int*)&lcnt[ea], 1), pb = atomicAdd((int*)&lcnt[eb], 1);
                    ent[rl * 2] = (ea << 16) | pa; ent[rl * 2 + 1] = (eb << 16) | pb;
                    ((int*)(ws + WS_EID))[row * 2] = ea; ((int*)(ws + WS_EID))[row * 2 + 1] = eb; ((float*)(ws + WS_EW))[row * 2] = w0; ((float*)(ws + WS_EW))[row * 2 + 1] = w1; }
            }
        }
        __syncthreads();
        if (REAL && tid < 32) lbase[tid] = (int)atomicAdd((unsigned*)(ws + WS_CNT) + tid * 32, (unsigned)lcnt[tid]);
        __syncthreads();
        if (REAL && tid < 256) { const int en = ent[tid]; const int e = en >> 16, pos = lbase[e] + (en & 0xffff); ((int*)(ws + WS_POS))[(size_t)blk * 256 + tid] = pos; ((int*)(ws + WS_LIST))[e * 32768 + pos] = blk * 128 + (tid >> 1); }
        __syncthreads();
    }
}
__device__ __forceinline__ void p9_phase(unsigned char* ws, LAS unsigned char* lds, int G) {
    build_tables(ws, lds); const LAS int* toff = (const LAS int*)(lds + LDS_TAB);
    const int lane = threadIdx.x & 63, wave = threadIdx.x >> 6;
    for (int base = (blockIdx.x * NWAVES + wave) * 32; base < NT * 2; base += G * NWAVES * 32) {
        for (int k = 0; k < 32; k += 4) {
            const int ts0 = base + k; const int li = ts0 + (lane & 3);
            const int ev = ((const int*)(ws + WS_EID))[li], pv = ((const int*)(ws + WS_POS))[li];
            u32x4 d0[4], d1[4]; size_t dst[4];
#pragma unroll
            for (int r = 0; r < 4; ++r) { const int e = __builtin_amdgcn_readlane(ev, r), pos = __builtin_amdgcn_readlane(pv, r); dst[r] = (size_t)toff[e] * 256 + pos;
                const u32x4* sp = (const u32x4*)((const bf16_t*)(ws + WS_H2) + (size_t)((ts0 + r) >> 1) * D_MODEL); d0[r] = sp[lane]; d1[r] = sp[lane + 64]; }
#pragma unroll
            for (int r = 0; r < 4; ++r) { u32x4* dp = (u32x4*)((bf16_t*)(ws + WS_XG) + dst[r] * D_MODEL); dp[lane] = d0[r]; dp[lane + 64] = d1[r]; }
        }
    }
}
__device__ __forceinline__ void p12_phase(const float* const* in, float* out, float* dst, unsigned char* ws, LAS unsigned char* lds, int G) {
    build_tables(ws, lds); const LAS int* toff = (const LAS int*)(lds + LDS_TAB);
    const int lane = threadIdx.x & 63, wave = threadIdx.x >> 6; const float* g2 = in[21]; const float* b2 = in[22]; const float* g1 = in[12]; const float* b1 = in[13];
    for (int blk = blockIdx.x; blk < NT / 128; blk += G) {
        const int b = blk / 32; const float* gt2 = (const float*)(ws + WS_ADA) + (size_t)b * 6 * D_MODEL + 5 * D_MODEL;
        for (int rb = 0; rb < 16; rb += 4) {
            const size_t row0 = (size_t)blk * 128 + wave * 16 + rb;
            const size_t li = row0 * 2 + (lane & 7);
            const int ev = ((const int*)(ws + WS_EID))[li], pv = ((const int*)(ws + WS_POS))[li]; const float wv = ((const float*)(ws + WS_EW))[li];
            typedef float f32x2v __attribute__((ext_vector_type(2))); const f32x2v stv = ((const f32x2v*)(ws + WS_ST1))[row0 + (lane & 3)];
            f32x4 v[4][4]; u32x2 ya[4][4], yb[4][4]; float w0[4], w1[4], m1[4], r1[4];
#pragma unroll
            for (int r = 0; r < 4; ++r) {
                const int e0 = __builtin_amdgcn_readlane(ev, 2 * r), e1 = __builtin_amdgcn_readlane(ev, 2 * r + 1), p0 = __builtin_amdgcn_readlane(pv, 2 * r), p1 = __builtin_amdgcn_readlane(pv, 2 * r + 1);
                w0[r] = __int_as_float(__builtin_amdgcn_readlane(__float_as_int(wv), 2 * r)); w1[r] = __int_as_float(__builtin_amdgcn_readlane(__float_as_int(wv), 2 * r + 1));
                m1[r] = __int_as_float(__builtin_amdgcn_readlane(__float_as_int(stv.x), r)); r1[r] = __int_as_float(__builtin_amdgcn_readlane(__float_as_int(stv.y), r));
                const u32x2* y0 = (const u32x2*)((const bf16_t*)(ws + WS_YG) + ((size_t)toff[e0] * 256 + p0) * D_MODEL) + lane; const u32x2* y1 = (const u32x2*)((const bf16_t*)(ws + WS_YG) + ((size_t)toff[e1] * 256 + p1) * D_MODEL) + lane;
                const f32x4* xr = (const f32x4*)(out + (row0 + r) * D_MODEL) + lane;
#pragma unroll
                for (int j = 0; j < 4; ++j) { v[r][j] = xr[64 * j]; ya[r][j] = y0[64 * j]; yb[r][j] = y1[64 * j]; } }
#pragma unroll
            for (int j = 0; j < 4; ++j) { const f32x4 gv = *(const f32x4*)(gt2 + 256 * j + 4 * lane), g1v = *(const f32x4*)(g1 + 256 * j + 4 * lane), b1v = *(const f32x4*)(b1 + 256 * j + 4 * lane);
#pragma unroll
                for (int r = 0; r < 4; ++r) { const u32x2 a = ya[r][j], c = yb[r][j]; f32x4 f; v[r][j] = (v[r][j] - m1[r]) * r1[r] * g1v + b1v;
                    f.x = w0[r] * __uint_as_float(a.x << 16) + w1[r] * __uint_as_float(c.x << 16); f.y = w0[r] * __uint_as_float(a.x & 0xffff0000u) + w1[r] * __uint_as_float(c.x & 0xffff0000u);
                    f.z = w0[r] * __uint_as_float(a.y << 16) + w1[r] * __uint_as_float(c.y << 16); f.w = w0[r] * __uint_as_float(a.y & 0xffff0000u) + w1[r] * __uint_as_float(c.y & 0xffff0000u);
                    v[r][j] = v[r][j] * DN_ALPHA + gv * f; } }
            float rstd[4]; ln_center<4>(v, rstd);
#pragma unroll
            for (int j = 0; j < 4; ++j) { const f32x4 gg = *(const f32x4*)(g2 + 256 * j + 4 * lane), bb = *(const f32x4*)(b2 + 256 * j + 4 * lane);
#pragma unroll
                for (int r = 0; r < 4; ++r) ((f32x4*)(dst + (row0 + r) * D_MODEL) + lane)[64 * j] = v[r][j] * rstd[r] * gg + bb; }
        }
    }
}

constexpr size_t WS_TS = 384 * 1024;
constexpr size_t WS_BAR = 320 * 1024;
#define RLX_AGENT __ATOMIC_RELAXED, __HIP_MEMORY_SCOPE_AGENT
#define XB_TMO      128
#define XB_XCNT(j)  (256  + 64 * (j))
#define XB_XSUB(j)  (1280 + 64 * (j))
#define XB_XGEN(j)  (2304 + 64 * (j))
#define XB_TOP      3328
#define XB_TOPGEN   3392
#define XCD_BAR_WORDS 3456
#define XB_SPIN_CAP (1u << 18)

__device__ __forceinline__ unsigned xb_ld(unsigned* p)              { return __hip_atomic_load(p, __ATOMIC_RELAXED, __HIP_MEMORY_SCOPE_AGENT); }
__device__ __forceinline__ unsigned xb_add(unsigned* p, unsigned v) { return __hip_atomic_fetch_add(p, v, __ATOMIC_RELAXED, __HIP_MEMORY_SCOPE_AGENT); }
__device__ __forceinline__ unsigned xb_xcc_id() { return (unsigned)__builtin_amdgcn_s_getreg((3 << 11) | 20) & 0xFu; }
#define XB_SPIN(cond, bar) do { unsigned _sp = 0; while (cond) { __builtin_amdgcn_s_sleep(1); \
    if ((++_sp & 255u) == 0u) { if (xb_ld(&(bar)[XB_TMO])) break; if (_sp > XB_SPIN_CAP) { atomicAdd(&(bar)[XB_TMO], 1u); break; } } } } while (0)

struct XcdBarrier {
    unsigned* bar; unsigned x;
    volatile LAS unsigned* st;
};

__device__ __forceinline__ XcdBarrier xcd_barrier_post(unsigned* bar, volatile LAS unsigned* st) {
    XcdBarrier b; b.bar = bar; b.x = xb_xcc_id(); b.st = st;
    if (threadIdx.x == 0) (void)xb_add(&bar[XB_XCNT(b.x)], 1u);
    return b;
}
__device__ __forceinline__ void xcd_barrier_complete(unsigned* bar, unsigned x, unsigned& nloc, unsigned& nx) {
    const unsigned G = gridDim.x * gridDim.y * gridDim.z;
    unsigned sum, cnt, mine, sp = 0u;
    for (;;) {
        sum = 0u; cnt = 0u; mine = 0u;
#pragma unroll
        for (unsigned j = 0; j < 16; ++j) { const unsigned c = xb_ld(&bar[XB_XCNT(j)]); sum += c; cnt += (c > 0u) ? 1u : 0u; mine = (j == x) ? c : mine; }
        if (sum == G) break;
        __builtin_amdgcn_s_sleep(1);
        if ((++sp & 255u) == 0u) { if (xb_ld(&bar[XB_TMO])) break; if (sp > XB_SPIN_CAP) { atomicAdd(&bar[XB_TMO], 1u); break; } }
    }
    nloc = mine > 0u ? mine : 1u; nx = cnt > 0u ? cnt : 1u;
}

__device__ __forceinline__ void xcd_barrier(const XcdBarrier& b) {
    asm volatile("s_waitcnt vmcnt(0)" ::: "memory");
    __syncthreads();
    if (threadIdx.x == 0) {
        unsigned* bar = b.bar;
        __builtin_amdgcn_s_waitcnt(0);
        unsigned nloc = b.st[0], nx = b.st[1];
        if (nloc == 0u) { xcd_barrier_complete(bar, b.x, nloc, nx); b.st[0] = nloc; b.st[1] = nx; }
        const unsigned old = xb_add(&bar[XB_XSUB(b.x)], 1u);
        const unsigned gen = old / nloc;
        if (old + 1u == (gen + 1u) * nloc) {
            __builtin_amdgcn_fence(__ATOMIC_RELEASE, "agent");
            asm volatile("s_waitcnt vmcnt(0)" ::: "memory");
            const unsigned og = xb_add(&bar[XB_TOP], 1u);
            const unsigned tg = og / nx;
            if (og + 1u == (tg + 1u) * nx) xb_add(&bar[XB_TOPGEN], 1u);
            else XB_SPIN(xb_ld(&bar[XB_TOPGEN]) == tg, bar);
            __builtin_amdgcn_fence(__ATOMIC_ACQUIRE, "agent");
            xb_add(&bar[XB_XGEN(b.x)], 1u);
            asm volatile("s_waitcnt vmcnt(0)" ::: "memory");
        } else {
            XB_SPIN(xb_ld(&bar[XB_XGEN(b.x)]) == gen, bar);
            __builtin_amdgcn_fence(__ATOMIC_ACQUIRE, "agent");
            asm volatile("s_waitcnt vmcnt(0)" ::: "memory");
        }
    }
    __syncthreads();
}

__device__ __forceinline__ int opaque_i(int v) {
#if DUPMASK_ON
    asm volatile("" : "+v"(v)); v = __builtin_amdgcn_readfirstlane(v);
#endif
    return v; }
constexpr int NPH = 14;
struct Args { const float* in[23]; float* out; unsigned char* ws; int ph_lo, ph_hi; };
__global__ void __launch_bounds__(NTHREADS, 2) mk_fwd(Args a) {
    extern __shared__ __attribute__((aligned(16))) unsigned char lds_raw[];
    LAS unsigned char* lds = (LAS unsigned char*)lds_raw;
    cg::grid_group grid = cg::this_grid();
    const int G = gridDim.x, tid = threadIdx.x, lane = tid & 63, wave = __builtin_amdgcn_readfirstlane(tid >> 6);
    const int lo = a.ph_lo, hi = a.ph_hi;
    unsigned char* ws = a.ws;
    volatile LAS unsigned* bst = (volatile LAS unsigned*)(lds + LDS_BYTES - 16);
    if (tid < 4) bst[tid] = 0u;
    __syncthreads();
    XcdBarrier bar = xcd_barrier_post((unsigned*)(ws + WS_BAR), bst);
    if (TSTAMP && blockIdx.x == 0 && tid == 0) ((unsigned long long*)(ws + WS_TS))[0] = __builtin_amdgcn_s_memrealtime();
    if (a.ph_hi > NPH) grid.sync();
#ifndef PHMASK
#define PHMASK 0xFFFF
#endif
#define IN(k) (((PHMASK >> (k)) & 1) && lo <= (k) && (k) < hi)
#define GRIDBAR() do { if (USE_CG_SYNC) grid.sync(); else xcd_barrier(bar); } while (0)
#define SEAM(k) do { if (IN(k) && IN((k) + 1)) GRIDBAR(); if (TSTAMP && blockIdx.x == 0 && tid == 0) ((unsigned long long*)(ws + WS_TS))[(k) + 1] = __builtin_amdgcn_s_memrealtime(); } while (0)
#define PH(k) for (int rep_ = 0; rep_ < (IN(k) ? 1 + ((DUPMASK >> (k)) & 1) : 0); ++rep_) if (rep_ > 0 && (xcd_barrier(bar), false)) {} else
    PH(0) {
        if (blockIdx.x == 0 && tid < 32) ((unsigned*)(ws + WS_CNT))[tid * 32] = 0u;
        if (blockIdx.x == 1 && tid < 256) { const float* wgp = a.in[6] + tid; u32x4 w0, w1;
            w0.x = cvtpk_s(wgp[0], wgp[256]); w0.y = cvtpk_s(wgp[512], wgp[768]); w0.z = cvtpk_s(wgp[1024], wgp[1280]); w0.w = cvtpk_s(wgp[1536], wgp[1792]);
            w1.x = cvtpk_s(wgp[2048], wgp[2304]); w1.y = cvtpk_s(wgp[2560], wgp[2816]); w1.z = cvtpk_s(wgp[3072], wgp[3328]); w1.w = cvtpk_s(wgp[3584], wgp[3840]);
            u32x4* dst = (u32x4*)((bf16_t*)(ws + WS_WGT) + tid * 16); dst[0] = w0; dst[1] = w1; }
        LAS float* scr = (LAS float*)(lds + wave * 16384);
        for (int it = blockIdx.x * NWAVES + wave; it < P0_ITEMS; it += G * NWAVES) p0_item(it, a.in, ws, scr, lane);
    }
    SEAM(0);
    PH(1) p1_phase(a.in, ws, lds, G);
    SEAM(1);
    PH(2) {
        pg8::Gemm g{(const bf16_t*)(ws + WS_XN), (const bf16_t*)(ws + WS_WIN), NT, NPROJ, D_MODEL}; pg8::StaticOrder S; S.init(NT, NPROJ, G, (int)blockIdx.x);
        EpiProj E{ws};
        pg8::gemm_phase<EpiProj, pg8::StaticOrder, PG8_ALIGN, PG8_SP2>(lds, g, S, E);
#ifdef DUP_P2
        xcd_barrier(bar);
        pg8::gemm_phase<EpiProj, pg8::StaticOrder, PG8_ALIGN, PG8_SP2>(lds, g, S, E);
#endif
    }
    SEAM(2);
    PH(3) {
        for (int u = blockIdx.x; u < 256; u += G) { const int p = u >> 1, b = p >> 4, qi = p & 15, qj = 31 - qi; LAS unsigned char* lw = lds + wave * 17408;
            for (int rep = 0; rep < ((DUPSUB & 1) ? 2 : 1); ++rep) {
                if ((u & 1) == 0) { p3a_run(b, qi, 0, qi, ws, lw, wave, lane); p3a_run(b, qj, 0, 15 - qi, ws, lw, wave, lane); }
                else p3a_run(b, qj, 16 - qi, qj, ws, lw, wave, lane); } }
        for (int p = blockIdx.x; p < GLA_ITEMS / 2; p += G) { p3b_pair(p, a.in[6], a.in[7], a.out, a.out + 24 * MiB, ws, lds); if (DUPSUB & 2) p3b_pair(p, a.in[6], a.in[7], a.out, a.out + 24 * MiB, ws, lds); }
    }
    SEAM(3);
    PH(4) {
        for (int j = blockIdx.x; j < 256; j += G) { p4b_item(j, a.out, (bf16_t*)(a.out + 16 * MiB), ws); if (DUPSUB & 8) p4b_item(j, a.out, (bf16_t*)(a.out + 16 * MiB), ws); }
        {
            const int W = blockIdx.x * NWAVES + wave;
            unsigned xa[32], xb[32]; LAS unsigned char* Hw = lds + wave * SEL_LDS;
            p4a_load(W, ws, lane, xa);
#pragma unroll 1
            for (int bb = 0; bb < NB; ++bb) {
                const int r0 = bb * NS + W, r1 = bb * NS + (NS - 1 - W), r2 = ((bb + 1 < NB) ? bb + 1 : bb) * NS + W;
                p4a_load(r1, ws, lane, xb);
                p4a_row(r0, ws, lane, xa, Hw); if (DUPSUB & 4) p4a_row(r0, ws, lane, xa, Hw);
                p4a_load(r2, ws, lane, xa);
                p4a_row(r1, ws, lane, xb, Hw); if (DUPSUB & 4) p4a_row(r1, ws, lane, xb, Hw);
            }
        }
    }
    SEAM(4);
    PH(5) {
        const int c = blockIdx.x; const int bh = c >> 2, sx = c & 3;
        for (int p = blockIdx.x; p < GLA_ITEMS / 2; p += G) { p5b_pair(p, a.out + 24 * MiB, a.in[8], (const bf16_t*)(a.out + 16 * MiB), ws, lds); if (DUPSUB & 32) p5b_pair(p, a.out + 24 * MiB, a.in[8], (const bf16_t*)(a.out + 16 * MiB), ws, lds); }
        if (c < 256) for (int i = 0; i < 4; ++i) { const int Q = (i == 0) ? sx : (i == 1) ? 7 - sx : (i == 2) ? 8 + sx : 15 - sx; if (wave < 4) attn_unit<false>(bh >> 3, bh & 7, Q, a.in[2], ws, lds); else attn_unit<true>(bh >> 3, bh & 7, Q, a.in[2], ws, lds);
            if (DUPSUB & 16) { if (wave < 4) attn_unit<false>(bh >> 3, bh & 7, Q, a.in[2], ws, lds); else attn_unit<true>(bh >> 3, bh & 7, Q, a.in[2], ws, lds); } }
    }
    SEAM(5);
    PH(6) {
        pg8::StaticOrder S; S.init(NT, D_MODEL, G, (int)blockIdx.x);
        { pg8::Gemm g{(const bf16_t*)(ws + WS_XN), (const bf16_t*)(ws + WS_WGAB), NT, D_MODEL, D_MODEL}; EpiSig E{ws, 0}; pg8::gemm_phase<EpiSig, pg8::StaticOrder, PG8_ALIGN, PG8_SP2>(lds, g, S, E); }
        { pg8::Gemm g{(const bf16_t*)(ws + WS_XN), (const bf16_t*)(ws + WS_WGAB) + (size_t)1024 * 1024, NT, D_MODEL, D_MODEL}; EpiSig E{ws, 1}; pg8::gemm_phase<EpiSig, pg8::StaticOrder, PG8_ALIGN, PG8_SP2>(lds, g, S, E); }
        { pg8::Gemm g{(const bf16_t*)(ws + WS_OAB), (const bf16_t*)(ws + WS_WBA), NT, D_MODEL, D_MODEL}; EpiMrgF E{ws}; pg8::gemm_phase<EpiMrgF, pg8::StaticOrder, PG8_ALIGN, PG8_SP2>(lds, g, S, E); }
    }
    SEAM(7);
    PH(8) {
        pg8::Gemm g{(const bf16_t*)(ws + WS_MRG), (const bf16_t*)(ws + WS_WOUT), NT, D_MODEL, D_MODEL}; pg8::StaticOrder S; S.init(NT, D_MODEL, G, (int)blockIdx.x);
        EpiV E{a.in[0], (const float*)(ws + WS_ADA), a.out}; pg8::gemm_phase<EpiV, pg8::StaticOrder, PG8_ALIGN, PG8_SP2>(lds, g, S, E);
    }
    SEAM(8);
#ifdef DUP_P8
    p8_phase<false>(a.in, a.out, (float*)(ws + 129 * MiB), (bf16_t*)(ws + 260 * MiB), ws, lds, G); xcd_barrier(bar);
#endif
    PH(9) p8_phase<true>(a.in, a.out, a.out, (bf16_t*)(ws + WS_H2), ws, lds, G);
    if (IN(9) && IN(11)) { GRIDBAR(); if (TSTAMP && blockIdx.x == 0 && tid == 0) ((unsigned long long*)(ws + WS_TS))[10] = __builtin_amdgcn_s_memrealtime(); }
    PH(11) {
        build_tables(ws, lds);
        pg8::Gemm g{(const bf16_t*)(ws + WS_H2), (const bf16_t*)(ws + WS_W13), 0, 0, D_MODEL}; GroupOrder<2> S{(const LAS int*)(lds + LDS_TAB), (const LAS int*)(lds + LDS_TAB) + 64, G, (int)blockIdx.x, (const int*)(ws + WS_LIST)};
        EpiHid E{ws}; pg8::gemm_phase<EpiHid, GroupOrder<2>, PG8_ALIGN, PG8_SP2, true>(lds, g, S, E);
    }
    SEAM(11);
    PH(12) {
        build_tables(ws, lds);
        int kd = D_EXP; asm volatile("" : "+s"(kd));
        pg8::Gemm g{(const bf16_t*)(ws + WS_HID), (const bf16_t*)(ws + WS_W2), 0, 0, kd}; GroupOrder<4> S{(const LAS int*)(lds + LDS_TAB), (const LAS int*)(lds + LDS_TAB) + 64, G, (int)blockIdx.x, nullptr};
        EpiY E{ws}; pg8::gemm_phase<EpiY, GroupOrder<4>, PG8_ALIGN, PG8_SP2>(lds, g, S, E);
    }
    SEAM(12);
#ifdef DUP_P12
    p12_phase(a.in, a.out, (float*)(ws + 129 * MiB), ws, lds, G); xcd_barrier(bar);
#endif
    PH(13) p12_phase(a.in, a.out, a.out, ws, lds, G);
    if (TSTAMP) { xcd_barrier(bar); if (blockIdx.x == 0 && tid == 0) ((unsigned long long*)(ws + WS_TS))[14] = __builtin_amdgcn_s_memrealtime(); }
#ifdef EXTRA_SYNCS
    for (int i_ = 0; i_ < EXTRA_SYNCS; ++i_) GRIDBAR();
#endif
#undef IN
#undef SEAM
#undef PH
}
}
#if TSTAMP
__global__ void kd_ts(float* out, long n, const unsigned long long* ts, int ka, int kb) {
    const float da = (ka == 14) ? (float)(ts[14] - ts[0]) * 0.01f / 10.f : (float)(ts[ka + 1] - ts[ka]) * 0.01f;
    const float sc = 1.f + da * 0.0005f;
    for (long i = (long)blockIdx.x * blockDim.x + threadIdx.x; i < n; i += (long)gridDim.x * blockDim.x) out[i] *= sc;
}
#endif
extern "C" void kernel_launch(void* const* d_in, const int* in_sizes, int n_in, void* d_out, int out_size,
                              void* d_ws, size_t ws_size, hipStream_t stream) {
    using namespace fk;
    static int grid = 0;
    if (grid == 0) {
        int dev = 0, cus = 0, per_cu = 0; (void)hipGetDevice(&dev); (void)hipDeviceGetAttribute(&cus, hipDeviceAttributeMultiprocessorCount, dev);
        (void)hipFuncSetAttribute((const void*)mk_fwd, hipFuncAttributeMaxDynamicSharedMemorySize, LDS_BYTES);
        (void)hipOccupancyMaxActiveBlocksPerMultiprocessor(&per_cu, (const void*)mk_fwd, NTHREADS, LDS_BYTES);
        (void)hipGetLastError();
        grid = cus * (per_cu >= 1 ? 1 : 1);
        if (ws_size < 512 * MiB) { fprintf(stderr, "kernel_launch: workspace too small\n"); grid = -1; }
    }
    if (grid < 0) return;
    (void)hipMemsetAsync((unsigned char*)d_ws + WS_BAR, 0, 16384, stream);
    Args a{}; for (int i = 0; i < 23; ++i) a.in[i] = (const float*)d_in[i]; a.out = (float*)d_out; a.ws = (unsigned char*)d_ws; a.ph_lo = 0; a.ph_hi = NPH;
    void* args[] = {&a};
    hipError_t e = hipLaunchCooperativeKernel((const void*)mk_fwd, dim3(grid), dim3(NTHREADS), args, LDS_BYTES, stream);
    if (e != hipSuccess) fprintf(stderr, "cooperative launch failed: %s\n", hipGetErrorString(e));
#if TSTAMP
    hipLaunchKernelGGL(kd_ts, dim3(1024), dim3(256), 0, stream, (float*)d_out, (long)out_size, (const unsigned long long*)((unsigned char*)d_ws + WS_TS), TS_A, TS_B);
#endif
}
```

```cpp
#include <hip/hip_runtime.h>
#include <hip/hip_cooperative_groups.h>
#include <cstdio>
#include <cstdint>
#include <cstring>
#include <cmath>
#ifdef HOST_EMU
#include <cmath>
#include <cstdio>
#include <cstdlib>
#include <cstring>
#include <cstdint>
struct Dim3e { int x, y, z; };
static thread_local Dim3e threadIdx, blockIdx, blockDim, gridDim;
#define __global__
#define __device__
#define __host__
#define __forceinline__ inline
#define __launch_bounds__(...)
typedef void* hipStream_t;
template <class F, class... A> static void host_launch(F f, long nb, int nt, A... a) {
#pragma omp parallel for schedule(dynamic, 4)
    for (long b = 0; b < nb; ++b) {
        blockIdx = {(int)b, 0, 0}; blockDim = {nt, 1, 1}; gridDim = {(int)nb, 1, 1};
        for (int t = 0; t < nt; ++t) { threadIdx = {t, 0, 0}; f(a...); }
    }
}
#define LAUNCH(k, nb, nt, st, ...) host_launch(k, (long)(nb), (int)(nt), __VA_ARGS__)
#define UNROLL
#else
#define LAUNCH(k, nb, nt, st, ...) hipLaunchKernelGGL(k, dim3((unsigned)(nb)), dim3((unsigned)(nt)), 0, st, __VA_ARGS__)
#endif

constexpr int D_MODEL = 1024, A_HEADS = 8, A_HD = 64, A_W = 512, I_HEADS = 16, I_DIM = 32, TOPK_MAX = 256, REL_B = 32,
              G_HEADS = 4, G_DK = 64, G_DV = 128, G_KW = 256, G_VW = 512, G_RANK = 16, N_GROUPS = 4, EPG = 8, N_EXP = 32, D_EXP = 256;
constexpr int O_AQ = 0, O_AK = 512, O_AV = 1024, O_IQ = 1536, O_IK = 2048, O_IW = 2080, O_GQ = 2096, O_GK = 2352, O_GV = 2608, O_GR = 3120,
              O_GLR = 3632, O_GA = 3648, O_GB = 4672, D_IN = 5696;
constexpr float DN_ALPHA = 1.189207115002721f, LN_EPS = 1e-5f;
#define V0_GID long gid = (long)blockIdx.x * blockDim.x + threadIdx.x

__device__ __forceinline__ float v0_silu(float v) { return v / (1.f + expf(-v)); }
__device__ __forceinline__ float v0_sigmoid(float v) { return 1.f / (1.f + expf(-v)); }

__global__ void k0_ada(const float* c, const float* w_ada, const float* b_ada, float* ada, int B) {
    V0_GID; if (gid >= (long)B * 6 * D_MODEL) return;
    const int b = (int)(gid / (6 * D_MODEL)), j = (int)(gid % (6 * D_MODEL));
    float acc = 0.f;
    for (int i = 0; i < D_MODEL; ++i) acc += v0_silu(c[b * D_MODEL + i]) * w_ada[(size_t)i * 6 * D_MODEL + j];
    ada[gid] = acc + b_ada[j];
}
__global__ void k0_lnmod(const float* x, const float* sh, const float* sc, float* h, int nrows) {
    V0_GID; if (gid >= nrows) return;
    const float* xr = x + (size_t)gid * D_MODEL; float* hr = h + (size_t)gid * D_MODEL;
    float mu = 0.f; for (int k = 0; k < D_MODEL; ++k) mu += xr[k]; mu *= (1.f / D_MODEL);
    float var = 0.f; for (int k = 0; k < D_MODEL; ++k) { const float d = xr[k] - mu; var += d * d; } var *= (1.f / D_MODEL);
    const float rs = 1.f / sqrtf(var + LN_EPS);
    for (int k = 0; k < D_MODEL; ++k) hr[k] = (xr[k] - mu) * rs * (1.f + sc[k]) + sh[k];
}
__global__ void k0_gemm(const float* A, int lda, const float* W, int ldw, float* C, int ldc, int M, int N, int K) {
    V0_GID; if (gid >= (long)(M / 4) * N) return;
    const int n = (int)(gid % N); const int m0 = (int)(gid / N) * 4;
    float a0 = 0.f, a1 = 0.f, a2 = 0.f, a3 = 0.f;
    const float* A0 = A + (size_t)m0 * lda;
    for (int k = 0; k < K; ++k) { const float w = W[(size_t)k * ldw + n]; a0 += A0[k] * w; a1 += A0[lda + k] * w; a2 += A0[2 * lda + k] * w; a3 += A0[3 * lda + k] * w; }
    C[(size_t)m0 * ldc + n] = a0; C[(size_t)(m0 + 1) * ldc + n] = a1; C[(size_t)(m0 + 2) * ldc + n] = a2; C[(size_t)(m0 + 3) * ldc + n] = a3;
}
__global__ void k0_scores(const float* P, float* scT, int S) {
    V0_GID; if (gid >= (long)S * S) return;
    const int t = (int)(gid % S), s = (int)(gid / S);
    if (s > t) { scT[gid] = -INFINITY; return; }
    const float* iq = P + (size_t)t * D_IN + O_IQ; const float* ik = P + (size_t)s * D_IN + O_IK; const float* iw = P + (size_t)t * D_IN + O_IW;
    const float cst = 0.044194173824159216f;
    float sc = 0.f;
    for (int h = 0; h < I_HEADS; ++h) { float d = 0.f; for (int k = 0; k < I_DIM; ++k) d += iq[h * I_DIM + k] * ik[k]; sc += (iw[h] * cst) * fmaxf(d, 0.f); }
    scT[gid] = sc;
}
__device__ __forceinline__ unsigned v0_key(float f) { unsigned u; memcpy(&u, &f, 4); return (u & 0x80000000u) ? ~u : (u | 0x80000000u); }
__global__ void k0_topk(const float* scT, int* sel, int* cnt, int S, int topk) {
    V0_GID; if (gid >= S) return;
    const int t = (int)gid; const int n = t + 1; int* sl = sel + (size_t)t * TOPK_MAX;
    if (n <= topk) { for (int s = 0; s < n; ++s) sl[s] = s; cnt[t] = n; return; }
    unsigned T = 0u;
    for (int bit = 31; bit >= 0; --bit) { const unsigned cand = T | (1u << bit); int c = 0; for (int s = 0; s < n; ++s) c += (v0_key(scT[(size_t)s * S + t]) >= cand) ? 1 : 0; if (c >= topk) T = cand; }
    int cgt = 0; for (int s = 0; s < n; ++s) cgt += (v0_key(scT[(size_t)s * S + t]) > T) ? 1 : 0;
    int need = topk - cgt, j = 0;
    for (int s = 0; s < n; ++s) { const unsigned k = v0_key(scT[(size_t)s * S + t]); if (k > T) sl[j++] = s; else if (k == T && need > 0) { sl[j++] = s; --need; } }
    cnt[t] = j;
}
__device__ __forceinline__ int v0_bucket(int d) {
    if (d < 16) return d;
    const float df = (float)d; int large = 16 + (int)(logf(df / 16.f) / 2.0794415416798357f * 16.f);
    return large < 31 ? large : 31;
}
__global__ void __launch_bounds__(256) k0_attn(const float* P, const int* sel, const int* cnt, const float* rel_bias, float* oa, int S) {
    V0_GID; if (gid >= (long)S * A_HEADS) return;
    const int t = (int)(gid / A_HEADS), h = (int)(gid % A_HEADS); const int n = cnt[t]; const int* sl = sel + (size_t)t * TOPK_MAX;
    const float* q = P + (size_t)t * D_IN + O_AQ + h * A_HD;
    float m = -INFINITY;
    for (int j = 0; j < n; ++j) { const int s = sl[j]; const float* k = P + (size_t)s * D_IN + O_AK + h * A_HD; float d = 0.f; for (int e = 0; e < A_HD; ++e) d += q[e] * k[e];
        const float l = d * 0.125f + rel_bias[v0_bucket(t - s) * A_HEADS + h]; m = fmaxf(m, l); }
    float o[A_HD];
#pragma unroll
    for (int e = 0; e < A_HD; ++e) o[e] = 0.f;
    float sum = 0.f;
    for (int j = 0; j < n; ++j) { const int s = sl[j]; const float* k = P + (size_t)s * D_IN + O_AK + h * A_HD; const float* v = P + (size_t)s * D_IN + O_AV + h * A_HD; float d = 0.f;
        for (int e = 0; e < A_HD; ++e) d += q[e] * k[e];
        const float p = expf(d * 0.125f + rel_bias[v0_bucket(t - s) * A_HEADS + h] - m); sum += p;
#pragma unroll
        for (int e = 0; e < A_HD; ++e) o[e] += p * v[e]; }
    const float inv = 1.f / sum;
#pragma unroll
    for (int e = 0; e < A_HD; ++e) oa[(size_t)t * A_W + h * A_HD + e] = o[e] * inv;
}
__global__ void k0_gate(const float* P, const float* wg, const float* bg, float* lg, int S) {
    V0_GID; if (gid >= (long)S * G_KW) return;
    const int t = (int)(gid / G_KW), j = (int)(gid % G_KW);
    float z = bg[j]; for (int r = 0; r < G_RANK; ++r) z += P[(size_t)t * D_IN + O_GLR + r] * wg[r * G_KW + j];
    lg[gid] = (fminf(z, 0.f) - log1pf(expf(-fabsf(z)))) * (1.f / 16.f);
}
__global__ void __launch_bounds__(64) k0_gla(const float* P, const float* lg, float* oraw, int S) {
    V0_GID; if (gid >= G_HEADS * G_DV) return;
    const int h = (int)(gid / G_DV), dv = (int)(gid % G_DV);
    float st[G_DK];
#pragma unroll
    for (int d = 0; d < G_DK; ++d) st[d] = 0.f;
    for (int t = 0; t < S; ++t) {
        const float* row = P + (size_t)t * D_IN; const float vv = row[O_GV + h * G_DV + dv]; float o = 0.f;
#pragma unroll
        for (int d = 0; d < G_DK; ++d) { const float a = expf(lg[(size_t)t * G_KW + h * G_DK + d]); st[d] = a * st[d] + row[O_GK + h * G_DK + d] * vv; o += row[O_GQ + h * G_DK + d] * st[d]; }
        oraw[(size_t)t * G_VW + h * G_DV + dv] = o * 0.125f;
    }
}
__global__ void k0_gla_post(const float* P, const float* oraw, const float* ng, float* ob, int S) {
    V0_GID; if (gid >= (long)S * G_HEADS) return;
    const int t = (int)(gid / G_HEADS), h = (int)(gid % G_HEADS); const float* o = oraw + (size_t)t * G_VW + h * G_DV;
    float mu = 0.f; for (int e = 0; e < G_DV; ++e) mu += o[e]; mu *= (1.f / G_DV);
    float var = 0.f; for (int e = 0; e < G_DV; ++e) { const float d = o[e] - mu; var += d * d; } var *= (1.f / G_DV);
    const float rs = 1.f / sqrtf(var + LN_EPS);
    for (int e = 0; e < G_DV; ++e) ob[(size_t)t * G_VW + h * G_DV + e] = (o[e] - mu) * rs * ng[h * G_DV + e] * v0_silu(P[(size_t)t * D_IN + O_GR + h * G_DV + e]);
}
__global__ void k0_merge(const float* P, const float* ba, const float* bb, float* mg, int S) {
    V0_GID; if (gid >= (long)S * D_MODEL) return;
    const int t = (int)(gid / D_MODEL), n = (int)(gid % D_MODEL);
    mg[gid] = v0_sigmoid(P[(size_t)t * D_IN + O_GA + n]) * ba[gid] + v0_sigmoid(P[(size_t)t * D_IN + O_GB + n]) * bb[gid];
}
__global__ void k0_ln1(const float* x, const float* y, const float* gt1, const float* g1, const float* b1, const float* sh2, const float* sc2, float* x1, float* h2, int nrows) {
    V0_GID; if (gid >= nrows) return;
    const float* xr = x + (size_t)gid * D_MODEL; const float* yr = y + (size_t)gid * D_MODEL; float* x1r = x1 + (size_t)gid * D_MODEL; float* h2r = h2 + (size_t)gid * D_MODEL;
    float mu = 0.f; for (int k = 0; k < D_MODEL; ++k) mu += DN_ALPHA * xr[k] + gt1[k] * yr[k]; mu *= (1.f / D_MODEL);
    float var = 0.f; for (int k = 0; k < D_MODEL; ++k) { const float d = DN_ALPHA * xr[k] + gt1[k] * yr[k] - mu; var += d * d; } var *= (1.f / D_MODEL);
    float rs = 1.f / sqrtf(var + LN_EPS);
    for (int k = 0; k < D_MODEL; ++k) x1r[k] = (DN_ALPHA * xr[k] + gt1[k] * yr[k] - mu) * rs * g1[k] + b1[k];
    mu = 0.f; for (int k = 0; k < D_MODEL; ++k) mu += x1r[k]; mu *= (1.f / D_MODEL);
    var = 0.f; for (int k = 0; k < D_MODEL; ++k) { const float d = x1r[k] - mu; var += d * d; } var *= (1.f / D_MODEL);
    rs = 1.f / sqrtf(var + LN_EPS);
    for (int k = 0; k < D_MODEL; ++k) h2r[k] = (x1r[k] - mu) * rs * (1.f + sc2[k]) + sh2[k];
}
__global__ void k0_route(const float* rl, const float* brg, const float* bre, int* eid, float* ew, int nrows) {
    V0_GID; if (gid >= nrows) return;
    const float* r = rl + (size_t)gid * 36;
    float gl[N_GROUPS]; float gm = -INFINITY; int gi = 0;
#pragma unroll
    for (int g = 0; g < N_GROUPS; ++g) { gl[g] = r[g] + brg[g]; if (gl[g] > gm) { gm = gl[g]; gi = g; } }
    float gs = 0.f;
#pragma unroll
    for (int g = 0; g < N_GROUPS; ++g) gs += expf(gl[g] - gm);
    const float gw = 1.f / gs;
    float v0 = -INFINITY, v1 = -INFINITY; int i0 = 0, i1 = 0;
    for (int e = 0; e < EPG; ++e) { const float v = r[4 + gi * EPG + e] + bre[gi * EPG + e];
        if (v > v0) { v1 = v0; i1 = i0; v0 = v; i0 = e; } else if (v > v1) { v1 = v; i1 = e; } }
    const float e1 = expf(v1 - v0); const float w0 = 1.f / (1.f + e1), w1 = e1 / (1.f + e1);
    eid[gid * 2] = gi * EPG + i0; eid[gid * 2 + 1] = gi * EPG + i1; ew[gid * 2] = w0 * gw; ew[gid * 2 + 1] = w1 * gw;
}
__global__ void k0_moe_hid(const float* h2, const int* eid, const float* w1, const float* w3, float* hid, int nrows) {
    V0_GID; if (gid >= (long)nrows * 2 * D_EXP) return;
    const int j = (int)(gid % D_EXP); const long ts = gid / D_EXP; const int t = (int)(ts / 2); const int e = eid[ts];
    const float* hr = h2 + (size_t)t * D_MODEL; const float* a = w1 + (size_t)e * D_MODEL * D_EXP + j; const float* b = w3 + (size_t)e * D_MODEL * D_EXP + j;
    float g = 0.f, u = 0.f; for (int k = 0; k < D_MODEL; ++k) { g += hr[k] * a[(size_t)k * D_EXP]; u += hr[k] * b[(size_t)k * D_EXP]; }
    hid[gid] = v0_silu(g) * u;
}
__global__ void k0_moe_out(const float* hid, const int* eid, const float* ew, const float* w2, float* f, int nrows) {
    V0_GID; if (gid >= (long)nrows * D_MODEL) return;
    const int n = (int)(gid % D_MODEL); const int t = (int)(gid / D_MODEL); float acc = 0.f;
    for (int sl = 0; sl < 2; ++sl) { const int e = eid[t * 2 + sl]; const float* hr = hid + ((size_t)t * 2 + sl) * D_EXP; const float* w = w2 + (size_t)e * D_EXP * D_MODEL + n; float a = 0.f;
        for (int j = 0; j < D_EXP; ++j) a += hr[j] * w[(size_t)j * D_MODEL]; acc += ew[t * 2 + sl] * a; }
    f[gid] = acc;
}
__global__ void k0_final(const float* x1, const float* f, const float* gt2, const float* g2, const float* b2, float* out, int nrows) {
    V0_GID; if (gid >= nrows) return;
    const float* xr = x1 + (size_t)gid * D_MODEL; const float* fr = f + (size_t)gid * D_MODEL; float* o = out + (size_t)gid * D_MODEL;
    float mu = 0.f; for (int k = 0; k < D_MODEL; ++k) mu += DN_ALPHA * xr[k] + gt2[k] * fr[k]; mu *= (1.f / D_MODEL);
    float var = 0.f; for (int k = 0; k < D_MODEL; ++k) { const float d = DN_ALPHA * xr[k] + gt2[k] * fr[k] - mu; var += d * d; } var *= (1.f / D_MODEL);
    const float rs = 1.f / sqrtf(var + LN_EPS);
    for (int k = 0; k < D_MODEL; ++k) o[k] = (DN_ALPHA * xr[k] + gt2[k] * fr[k] - mu) * rs * g2[k] + b2[k];
}

struct V0Buf { float *ada, *h, *P, *scT, *oa, *lg, *oraw, *ob, *ba, *bb, *mg, *y, *x1, *h2, *rl, *ew, *hid, *f; int *sel, *cnt, *eid; size_t bytes; };
static V0Buf v0_carve(void* base, int B, int S) {
    V0Buf b; char* p = (char*)base; auto take = [&](size_t n) { char* r = p; p += (n + 255) & ~(size_t)255; return r; };
    b.ada = (float*)take((size_t)B * 6 * D_MODEL * 4);
    b.P = (float*)take((size_t)S * D_IN * 4);
    b.h = (float*)take((size_t)S * D_MODEL * 4);
    b.scT = (float*)take((size_t)S * S * 4);
    b.sel = (int*)take((size_t)S * TOPK_MAX * 4); b.cnt = (int*)take((size_t)S * 4);
    b.oa = (float*)take((size_t)S * A_W * 4); b.lg = (float*)take((size_t)S * G_KW * 4); b.oraw = (float*)take((size_t)S * G_VW * 4); b.ob = (float*)take((size_t)S * G_VW * 4);
    b.ba = (float*)take((size_t)S * D_MODEL * 4); b.bb = (float*)take((size_t)S * D_MODEL * 4); b.y = (float*)take((size_t)S * D_MODEL * 4);
    b.x1 = (float*)take((size_t)S * D_MODEL * 4); b.h2 = (float*)take((size_t)S * D_MODEL * 4); b.f = (float*)take((size_t)S * D_MODEL * 4);
    b.mg = b.h;
    b.rl = (float*)take((size_t)S * 36 * 4); b.eid = (int*)take((size_t)S * 2 * 4); b.ew = (float*)take((size_t)S * 2 * 4); b.hid = (float*)take((size_t)S * 2 * D_EXP * 4);
    b.bytes = (size_t)(p - (char*)base); return b;
}
static void v0_forward(void* const* d_in, float* out, void* scratch, int B, int S, hipStream_t st, int only_batch = -1, int last_batch = -1) {
    const float *x = (const float*)d_in[0], *c = (const float*)d_in[1], *rel_bias = (const float*)d_in[2], *w_ada = (const float*)d_in[3], *b_ada = (const float*)d_in[4], *w_in = (const float*)d_in[5],
                *wg = (const float*)d_in[6], *bg = (const float*)d_in[7], *ng = (const float*)d_in[8], *wba = (const float*)d_in[9], *wbb = (const float*)d_in[10], *wout = (const float*)d_in[11],
                *g1 = (const float*)d_in[12], *b1 = (const float*)d_in[13], *wrg = (const float*)d_in[14], *brg = (const float*)d_in[15], *wre = (const float*)d_in[16], *bre = (const float*)d_in[17],
                *w1 = (const float*)d_in[18], *w3 = (const float*)d_in[19], *w2 = (const float*)d_in[20], *g2 = (const float*)d_in[21], *b2 = (const float*)d_in[22];
    V0Buf u = v0_carve(scratch, B, S);
    const int TB = 256; auto nb = [&](long n) { return (n + TB - 1) / TB; };
    const int topk = (TOPK_MAX < S / 4) ? TOPK_MAX : S / 4;
    LAUNCH(k0_ada, nb((long)B * 6 * D_MODEL), TB, st, c, w_ada, b_ada, u.ada, B);
    for (int bi = 0; bi < B; ++bi) {
        int b = bi; if (last_batch >= 0) b = (bi == B - 1) ? last_batch : (bi < last_batch ? bi : bi + 1);
        if (only_batch >= 0 && b != only_batch) continue;
        const float* xb = x + (size_t)b * S * D_MODEL; const float* ad = u.ada + (size_t)b * 6 * D_MODEL;
        const float *sh1 = ad, *sc1 = ad + D_MODEL, *gt1 = ad + 2 * D_MODEL, *sh2 = ad + 3 * D_MODEL, *sc2 = ad + 4 * D_MODEL, *gt2 = ad + 5 * D_MODEL;
        LAUNCH(k0_lnmod, nb(S), TB, st, xb, sh1, sc1, u.h, S);
        LAUNCH(k0_gemm, nb((long)(S / 4) * D_IN), TB, st, (const float*)u.h, D_MODEL, w_in, D_IN, u.P, D_IN, S, D_IN, D_MODEL);
        LAUNCH(k0_scores, nb((long)S * S), TB, st, (const float*)u.P, u.scT, S);
        LAUNCH(k0_topk, nb(S), TB, st, (const float*)u.scT, u.sel, u.cnt, S, topk);
        LAUNCH(k0_attn, nb((long)S * A_HEADS), TB, st, (const float*)u.P, (const int*)u.sel, (const int*)u.cnt, rel_bias, u.oa, S);
        LAUNCH(k0_gate, nb((long)S * G_KW), TB, st, (const float*)u.P, wg, bg, u.lg, S);
        LAUNCH(k0_gla, (G_HEADS * G_DV + 63) / 64, 64, st, (const float*)u.P, (const float*)u.lg, u.oraw, S);
        LAUNCH(k0_gla_post, nb((long)S * G_HEADS), TB, st, (const float*)u.P, (const float*)u.oraw, ng, u.ob, S);
        LAUNCH(k0_gemm, nb((long)(S / 4) * D_MODEL), TB, st, (const float*)u.oa, A_W, wba, D_MODEL, u.ba, D_MODEL, S, D_MODEL, A_W);
        LAUNCH(k0_gemm, nb((long)(S / 4) * D_MODEL), TB, st, (const float*)u.ob, G_VW, wbb, D_MODEL, u.bb, D_MODEL, S, D_MODEL, G_VW);
        LAUNCH(k0_merge, nb((long)S * D_MODEL), TB, st, (const float*)u.P, (const float*)u.ba, (const float*)u.bb, u.mg, S);
        LAUNCH(k0_gemm, nb((long)(S / 4) * D_MODEL), TB, st, (const float*)u.mg, D_MODEL, wout, D_MODEL, u.y, D_MODEL, S, D_MODEL, D_MODEL);
        LAUNCH(k0_ln1, nb(S), TB, st, xb, (const float*)u.y, gt1, g1, b1, sh2, sc2, u.x1, u.h2, S);
        LAUNCH(k0_gemm, nb((long)(S / 4) * N_GROUPS), TB, st, (const float*)u.h2, D_MODEL, wrg, N_GROUPS, u.rl, 36, S, N_GROUPS, D_MODEL);
        LAUNCH(k0_gemm, nb((long)(S / 4) * N_EXP), TB, st, (const float*)u.h2, D_MODEL, wre, N_EXP, u.rl + 4, 36, S, N_EXP, D_MODEL);
        LAUNCH(k0_route, nb(S), TB, st, (const float*)u.rl, brg, bre, u.eid, u.ew, S);
        LAUNCH(k0_moe_hid, nb((long)S * 2 * D_EXP), TB, st, (const float*)u.h2, (const int*)u.eid, w1, w3, u.hid, S);
        LAUNCH(k0_moe_out, nb((long)S * D_MODEL), TB, st, (const float*)u.hid, (const int*)u.eid, (const float*)u.ew, w2, u.f, S);
        LAUNCH(k0_final, nb(S), TB, st, (const float*)u.x1, (const float*)u.f, gt2, g2, b2, out + (size_t)b * S * D_MODEL, S);
    }
}
namespace pg8 {
#define PG8_LAS __attribute__((address_space(3)))
typedef unsigned short bf16_t;
typedef short bf16x8 __attribute__((ext_vector_type(8)));
typedef float f32x4 __attribute__((ext_vector_type(4)));
typedef unsigned u32x4 __attribute__((ext_vector_type(4)));
constexpr int BM = 256, BK = 64, HALF = 128, HTB = HALF * BK * 2  , STAGE_BYTES = 8 * HTB, NXCD = 8, WGM = 8;

__host__ __device__ __forceinline__ int lds_byte(int r, int c) { const int st = (r >> 4) * 2 + (c >> 5), rr = r & 15, cc = c & 31, ob = rr * 64 + cc * 2; return st * 1024 + (ob ^ (((ob >> 9) & 1) << 5)); }
__host__ __device__ __forceinline__ void stage_rc(int b, int& R, int& C) { const int st = b / 1024, sb = b % 1024, swz = sb ^ (((sb >> 9) & 1) << 5); R = (st >> 1) * 16 + swz / 64; C = (st & 1) * 32 + (swz % 64) / 2; }
__host__ __device__ __forceinline__ int perm32(int rho) { const int n = rho >> 4, i = rho & 15; return 8 * (i >> 2) + 4 * n + (i & 3); }

struct Unit { int pm, pn, pa, pb; };
struct Gemm { const bf16_t* A; const bf16_t* Bt; int M, N, K; };

struct StaticOrder {
    int nM, nN, nwg, G, c;
    __host__ __device__ void init(int M, int N, int G_, int c_) { nM = M / BM; nN = N / BM; nwg = nM * nN; G = G_; c = c_; }
    __host__ __device__ bool next(int i, Unit& u) const {
        const long L = (long)i * G + c; if (L >= nwg) return false;
        int wgid = (int)L; { const int q = nwg / NXCD, r = nwg % NXCD, xcd = wgid % NXCD, off = wgid / NXCD; wgid = (xcd < r ? xcd * (q + 1) : r * (q + 1) + (xcd - r) * q) + off; }
        const int nig = WGM * nN, gid = wgid / nig, fm = gid * WGM, gsz = (nM - fm) < WGM ? (nM - fm) : WGM;
        u.pm = fm + ((wgid % nig) % gsz); u.pn = (wgid % nig) / gsz; u.pa = u.pm; u.pb = u.pn; return true;
    }
    __device__ __forceinline__ void a_ready(const Unit&) const {}
    __device__ __forceinline__ void done(const Unit&) const {}
};

__device__ __forceinline__ unsigned cvt_pk_bf16(float lo, float hi) { unsigned r; asm volatile("v_cvt_pk_bf16_f32 %0, %1, %2" : "=v"(r) : "v"(lo), "v"(hi)); return r; }
typedef float f32x2 __attribute__((ext_vector_type(2)));

template <class Epi, class Sched, bool ALIGN_EPI = false, bool SP2 = false, bool GATHER = false>
__device__ __forceinline__ void gemm_phase(PG8_LAS unsigned char* lds, const Gemm g, const Sched& S, const Epi& E) {
    const int tid = threadIdx.x, wid = __builtin_amdgcn_readfirstlane(tid >> 6), lane = tid & 63, wr = wid >> 2, wc = wid & 3, fr = lane & 15, fq = lane >> 4;
    const int K = g.K, nt = K / BK;
    static_assert(!GATHER || SP2, "gathered A rows: SP2 loop only");
    unsigned voffA[2], voffB[2]; int Rr[2], Cc[2];
#pragma unroll
    for (int i = 0; i < 2; ++i) { int R, C; stage_rc(tid * 16 + i * 8192, R, C); const int Rb = Epi::PERM ? ((R & ~31) + perm32(R & 31)) : R; Rr[i] = R; Cc[i] = C;
        voffA[i] = (unsigned)(R * K + C) * 2u; voffB[i] = (unsigned)(Rb * K + C) * 2u; }
    unsigned vc0[2] = {voffA[0], voffA[1]}, vc1[2] = {voffA[0], voffA[1]}, vn0[2] = {voffA[0], voffA[1]}, vn1[2] = {voffA[0], voffA[1]};
    const size_t kstep = (size_t)(BK * 2);
    const size_t hstep = (size_t)HALF * K * 2;
    const size_t tstep = 2 * hstep;
    const unsigned ldsw = (unsigned)wid * 1024u;
    const int aoff = lds_byte(wr * 64 + fr, fq * 8), boff = lds_byte(wc * 32 + fr, fq * 8);
#define PG8_SA(b, h) (((b) * 2 + (h)) * HTB)
#define PG8_SB(b, h) ((4 + (b) * 2 + (h)) * HTB)
#define PG8_STAGE(bufoff, gbase, voff) do { _Pragma("unroll") for (int _i = 0; _i < 2; ++_i) \
        __builtin_amdgcn_global_load_lds((const unsigned*)((const char*)(gbase) + (voff)[_i]), (PG8_LAS unsigned*)(lds + (bufoff) + ldsw + _i * 8192), 16, 0, 0); } while (0)
#define PG8_LDA(dst, b, h) do { _Pragma("unroll") for (int m = 0; m < 4; ++m) _Pragma("unroll") for (int k = 0; k < 2; ++k) dst[m][k] = *(const PG8_LAS bf16x8*)(lds + PG8_SA(b, h) + aoff + m * 2048 + k * 1024); } while (0)
#define PG8_LDB(dst, b, h) do { _Pragma("unroll") for (int n = 0; n < 2; ++n) _Pragma("unroll") for (int k = 0; k < 2; ++k) dst[n][k] = *(const PG8_LAS bf16x8*)(lds + PG8_SB(b, h) + boff + n * 2048 + k * 1024); } while (0)
#define PG8_MMA(ai, bj, At, Bt) do { __builtin_amdgcn_s_setprio(1); _Pragma("unroll") for (int m = 0; m < 4; ++m) _Pragma("unroll") for (int n = 0; n < 2; ++n) _Pragma("unroll") for (int k = 0; k < 2; ++k) \
        acc[ai][bj][m][n] = __builtin_amdgcn_mfma_f32_16x16x32_bf16(Bt[n][k], At[m][k], acc[ai][bj][m][n], 0, 0, 0); __builtin_amdgcn_s_setprio(0); } while (0)
#define PG8_WAIT_V(n) asm volatile("s_waitcnt vmcnt(" #n ")" ::: "memory")
#define PG8_WAIT_L(n) asm volatile("s_waitcnt lgkmcnt(" #n ")" ::: "memory")
#define PG8_BAR __builtin_amdgcn_s_barrier()
#define PG8_SCHED __builtin_amdgcn_sched_barrier(0)
    Unit cur, nxt; int ui = 0;
    if (!S.next(0, cur)) return;
    f32x4 acc[2][2][4][2];
#pragma unroll
    for (int a = 0; a < 2; ++a)
#pragma unroll
        for (int b = 0; b < 2; ++b)
#pragma unroll
            for (int m = 0; m < 4; ++m)
#pragma unroll
                for (int n = 0; n < 2; ++n) acc[a][b][m][n] = (f32x4){0.f, 0.f, 0.f, 0.f};
    bf16x8 At[4][2], B0[2][2], B1[2][2];
    const char* cA = GATHER ? (const char*)g.A : (const char*)g.A + (size_t)cur.pa * tstep; const char* cB = (const char*)g.Bt + (size_t)cur.pb * tstep;
    const size_t hstepA = GATHER ? 0 : hstep;
    if constexpr (GATHER) {
#pragma unroll
        for (int i = 0; i < 2; ++i) { vc0[i] = (unsigned)S.a_row(cur, Rr[i]) * (unsigned)(K * 2) + (unsigned)(Cc[i] * 2); vc1[i] = (unsigned)S.a_row(cur, HALF + Rr[i]) * (unsigned)(K * 2) + (unsigned)(Cc[i] * 2); } }
    S.a_ready(cur);
    if constexpr (SP2) {
        PG8_STAGE(PG8_SB(0, 0), cB, voffB); PG8_STAGE(PG8_SB(0, 1), cB + hstep, voffB); PG8_STAGE(PG8_SA(0, 0), cA, vc0); PG8_STAGE(PG8_SA(0, 1), cA + hstepA, vc1);
        if (wr == 1) PG8_BAR;
        PG8_WAIT_V(2); PG8_BAR;
        PG8_STAGE(PG8_SB(1, 0), cB + kstep, voffB); PG8_STAGE(PG8_SA(1, 0), cA + kstep, vc0); PG8_STAGE(PG8_SB(1, 1), cB + hstep + kstep, voffB);
        PG8_WAIT_V(6); PG8_BAR;
    } else {
        PG8_STAGE(PG8_SB(0, 0), cB, voffB); PG8_STAGE(PG8_SA(0, 0), cA, voffA); PG8_STAGE(PG8_SB(0, 1), cB + hstep, voffB); PG8_STAGE(PG8_SA(0, 1), cA + hstep, voffA);
        if (wr == 1) PG8_BAR;
        PG8_WAIT_V(4); PG8_BAR;
        PG8_STAGE(PG8_SB(1, 0), cB + kstep, voffB); PG8_STAGE(PG8_SA(1, 0), cA + kstep, voffA); PG8_STAGE(PG8_SB(1, 1), cB + hstep + kstep, voffB);
        PG8_WAIT_V(6); PG8_BAR;
    }
    for (;;) {
        const bool has_next = S.next(ui + 1, nxt);
        const char* nA = GATHER ? cA : (has_next ? (const char*)g.A + (size_t)nxt.pa * tstep : cA); const char* nB = has_next ? (const char*)g.Bt + (size_t)nxt.pb * tstep : cB;
        if constexpr (GATHER) {
#pragma unroll
            for (int i = 0; i < 2; ++i) { vn0[i] = has_next ? (unsigned)S.a_row(nxt, Rr[i]) * (unsigned)(K * 2) + (unsigned)(Cc[i] * 2) : vc0[i]; vn1[i] = has_next ? (unsigned)S.a_row(nxt, HALF + Rr[i]) * (unsigned)(K * 2) + (unsigned)(Cc[i] * 2) : vc1[i]; } }
        for (int t = 0; t < nt; t += 2) {
            const bool last = (t == nt - 2);
            if constexpr (Epi::MID) { if (t == nt / 2) E.mid(acc, cur, wr, wc, fr, fq); }
            const char* a1 = cA + (size_t)(t + 1) * kstep;
            const char* a2 = last ? nA : cA + (size_t)(t + 2) * kstep; const char* b2 = last ? nB : cB + (size_t)(t + 2) * kstep;
            const char* a3 = a2 + kstep; const char* b3 = b2 + kstep;
            if (last && has_next) S.a_ready(nxt);
            if constexpr (SP2) {
            unsigned w0[2], w1[2];
#pragma unroll
            for (int i = 0; i < 2; ++i) { w0[i] = last ? vn0[i] : vc0[i]; w1[i] = last ? vn1[i] : vc1[i]; }
            PG8_LDB(B0, 0, 0); PG8_LDB(B1, 0, 1); PG8_SCHED; PG8_LDA(At, 0, 0); PG8_STAGE(PG8_SA(1, 1), a1 + hstepA, vc1);
            PG8_WAIT_V(8); PG8_WAIT_L(0); PG8_BAR; PG8_MMA(0, 0, At, B0); PG8_MMA(0, 1, At, B1); PG8_BAR; PG8_SCHED;
            PG8_LDA(At, 0, 1); PG8_STAGE(PG8_SB(0, 0), b2, voffB); PG8_STAGE(PG8_SB(0, 1), b2 + hstep, voffB); PG8_STAGE(PG8_SA(0, 0), a2, w0);
            PG8_WAIT_V(8); PG8_WAIT_L(0); PG8_BAR; PG8_MMA(1, 0, At, B0); PG8_MMA(1, 1, At, B1); PG8_BAR; PG8_SCHED;
            PG8_LDB(B0, 1, 0); PG8_LDB(B1, 1, 1); PG8_SCHED; PG8_LDA(At, 1, 0); PG8_STAGE(PG8_SA(0, 1), a2 + hstepA, w1);
            PG8_WAIT_V(8); PG8_WAIT_L(0); PG8_BAR; PG8_MMA(0, 0, At, B0); PG8_MMA(0, 1, At, B1); PG8_BAR; PG8_SCHED;
            PG8_LDA(At, 1, 1); PG8_STAGE(PG8_SB(1, 0), b3, voffB); PG8_STAGE(PG8_SB(1, 1), b3 + hstep, voffB); PG8_STAGE(PG8_SA(1, 0), a3, w0);
            PG8_WAIT_V(8); PG8_WAIT_L(0); PG8_BAR; PG8_MMA(1, 0, At, B0); PG8_MMA(1, 1, At, B1); PG8_BAR; PG8_SCHED;
            } else {
            PG8_LDB(B0, 0, 0); PG8_SCHED; PG8_LDA(At, 0, 0); PG8_STAGE(PG8_SA(1, 1), a1 + hstep, voffA);
            PG8_WAIT_L(8); PG8_BAR; PG8_WAIT_L(0); PG8_MMA(0, 0, At, B0); PG8_BAR; PG8_SCHED;
            PG8_LDB(B1, 0, 1); PG8_STAGE(PG8_SB(0, 0), b2, voffB);
            PG8_BAR; PG8_WAIT_L(0); PG8_MMA(0, 1, At, B1); PG8_BAR;
            PG8_LDA(At, 0, 1); PG8_STAGE(PG8_SA(0, 0), a2, voffA);
            PG8_BAR; PG8_WAIT_L(0); PG8_MMA(1, 0, At, B0); PG8_BAR; PG8_SCHED;
            PG8_STAGE(PG8_SB(0, 1), b2 + hstep, voffB);
            PG8_WAIT_V(6); PG8_BAR; PG8_MMA(1, 1, At, B1); PG8_BAR;
            PG8_LDB(B0, 1, 0); PG8_SCHED; PG8_LDA(At, 1, 0); PG8_STAGE(PG8_SA(0, 1), a2 + hstep, voffA);
            PG8_WAIT_L(8); PG8_BAR; PG8_WAIT_L(0); PG8_MMA(0, 0, At, B0); PG8_BAR; PG8_SCHED;
            PG8_LDB(B1, 1, 1); PG8_STAGE(PG8_SB(1, 0), b3, voffB);
            PG8_BAR; PG8_WAIT_L(0); PG8_MMA(0, 1, At, B1); PG8_BAR;
            PG8_LDA(At, 1, 1); PG8_STAGE(PG8_SA(1, 0), a3, voffA);
            PG8_BAR; PG8_WAIT_L(0); PG8_MMA(1, 0, At, B0); PG8_BAR; PG8_SCHED;
            PG8_STAGE(PG8_SB(1, 1), b3 + hstep, voffB);
            PG8_WAIT_V(6); PG8_BAR; PG8_MMA(1, 1, At, B1); PG8_BAR;
            }
        }
        if constexpr (ALIGN_EPI) { if (wr == 0) PG8_BAR; }
        if constexpr (!Epi::AFTER_DRAIN) { E(acc, cur, wr, wc, fr, fq); S.done(cur); }
        if (!has_next) break;
#pragma unroll
        for (int a = 0; a < 2; ++a)
#pragma unroll
            for (int b = 0; b < 2; ++b)
#pragma unroll
                for (int m = 0; m < 4; ++m)
#pragma unroll
                    for (int n = 0; n < 2; ++n) acc[a][b][m][n] = (f32x4){0.f, 0.f, 0.f, 0.f};
        cur = nxt; cA = nA; cB = nB; ++ui;
        if constexpr (GATHER) { vc0[0] = vn0[0]; vc0[1] = vn0[1]; vc1[0] = vn1[0]; vc1[1] = vn1[1]; }
        if constexpr (ALIGN_EPI) { if (wr == 1) PG8_BAR; }
    }
    PG8_WAIT_V(0);
    if constexpr (!ALIGN_EPI) { if (wr == 0) PG8_BAR; }
    PG8_BAR;
    if constexpr (Epi::AFTER_DRAIN) { E.fused(acc, cur, wr, wc, fr, fq, lds, wid, lane); S.done(cur); }
#undef PG8_SA
#undef PG8_SB
#undef PG8_STAGE
#undef PG8_LDA
#undef PG8_LDB
#undef PG8_MMA
#undef PG8_WAIT_V
#undef PG8_WAIT_L
#undef PG8_BAR
#undef PG8_SCHED
}
}

#ifndef PG8_SP2
#define PG8_SP2 true
#endif
#ifndef PG8_ALIGN
#define PG8_ALIGN true
#endif
#ifndef DUPSUB
#define DUPSUB 0
#endif
#ifndef TSTAMP
#define TSTAMP 0
#endif
#ifndef USE_CG_SYNC
#define USE_CG_SYNC 0
#endif
#ifndef DUPMASK
#define DUPMASK 0
#define DUPMASK_ON 0
#else
#define DUPMASK_ON 1
#endif
namespace cg = cooperative_groups;
namespace fk {
using pg8::bf16_t; using pg8::f32x4; using pg8::u32x4; using pg8::bf16x8; using pg8::Unit; using pg8::cvt_pk_bf16;
#define LAS __attribute__((address_space(3)))
#define LDS_WAIT() asm volatile("s_waitcnt lgkmcnt(0)" ::: "memory")
typedef unsigned u32x2 __attribute__((ext_vector_type(2)));
constexpr int NB = 8, NS = 4096, NT = NB * NS;
constexpr int NTHREADS = 512, NWAVES = 8, LDS_BYTES = 155648;
constexpr size_t MiB = (size_t)1 << 20;
constexpr size_t WS_ADA = 0, WS_CNT = 256 * 1024,
    WS_WIN = 1 * MiB, WS_WGAB = 9 * MiB, WS_WBA = 13 * MiB, WS_WBB = 14 * MiB, WS_WOUT = 15 * MiB, WS_W13 = 17 * MiB, WS_W2 = 49 * MiB,
    WS_XN = 65 * MiB, WS_QKV = 129 * MiB, WS_IQ = 225 * MiB, WS_GQK = 257 * MiB, WS_GV = 289 * MiB, WS_GR = 321 * MiB,
    WS_IK = 353 * MiB, WS_IW = 355 * MiB, WS_GLR = 357 * MiB, WS_SC = 358 * MiB, WS_MASK = 490 * MiB, WS_ADAP = 506 * MiB, WS_MISC = 509 * MiB;
constexpr int NPROJ = 3584;
constexpr size_t WS_WGT = 400 * 1024;
constexpr int KSL = 16;
constexpr float QSCALE = 0.125f * 1.4426950408889634f;
typedef float f32x2_t __attribute__((ext_vector_type(2))); typedef __bf16 bf16x2_t __attribute__((ext_vector_type(2)));
__device__ __forceinline__ unsigned cvtpk_s(float lo, float hi) { f32x2_t v = {lo, hi}; bf16x2_t b = __builtin_convertvector(v, bf16x2_t); return __builtin_bit_cast(unsigned, b); }
__device__ __forceinline__ void bf8_to_f(const u32x4 w, float* f) {
#pragma unroll
    for (int j = 0; j < 4; ++j) { f[2 * j] = __uint_as_float(w[j] << 16); f[2 * j + 1] = __uint_as_float(w[j] & 0xffff0000u); }
}

__device__ __forceinline__ void tr_item(const float* W, int ldw, int srccol, bf16_t* WT, int K, int dst_row0, int kb, LAS float* scr, int lane, int kdst0 = 0) {
    const int k0 = 64 * kb;
#pragma unroll
    for (int i = 0; i < 32; ++i) { const int kk = 2 * i + (lane >> 5); scr[kk * 33 + (lane & 31)] = W[(size_t)(k0 + kk) * ldw + srccol]; }
    LDS_WAIT();
    const int c = lane & 7;
#pragma unroll
    for (int j = 0; j < 4; ++j) { const int n = (lane >> 3) + 8 * j; const LAS float* s = scr + (8 * c) * 33 + n;
        u32x4 o; o.x = cvt_pk_bf16(s[0 * 33], s[1 * 33]); o.y = cvt_pk_bf16(s[2 * 33], s[3 * 33]); o.z = cvt_pk_bf16(s[4 * 33], s[5 * 33]); o.w = cvt_pk_bf16(s[6 * 33], s[7 * 33]);
        *(u32x4*)(WT + (size_t)(dst_row0 + n) * K + kdst0 + k0 + 8 * c) = o; }
    LDS_WAIT();
}
__device__ __forceinline__ int win_src(int n) {
    if (n < 2048) return n;
    if (n < 3584) return n + 48;
    if (n < 3616) return O_IK + (n - 3584);
    if (n < 3632) return O_IW + (n - 3616);
    return O_GLR + (n - 3632);
}
constexpr int I_ADA = 96 * KSL, I_WIN = 114 * 16, I_WGAB = 64 * 16, I_WB = 32 * 8, I_WOUT = 32 * 16, I_W13 = 32 * 16 * 16, I_W2 = 32 * 32 * 4;
constexpr int P0_ITEMS = I_ADA + I_WIN + I_WGAB + 2 * I_WB + I_WOUT + I_W13 + I_W2, P0_EARLY = I_ADA + I_WIN + I_WGAB + 2 * I_WB + I_WOUT;
__device__ __forceinline__ void p0_item(int it, const float* const* in, unsigned char* ws, LAS float* scr, int lane) {
    if (it < I_ADA) {
        const int cb = it / KSL, ks = it % KSL, k0 = ks * 64; const float* c = in[1]; const float* w = in[3];
#pragma unroll
        for (int b = 0; b < NB; ++b) { const float cv = c[b * D_MODEL + k0 + lane]; scr[b * 64 + lane] = cv / (1.f + __expf(-cv)); }
        LDS_WAIT();
        float acc[NB];
#pragma unroll
        for (int b = 0; b < NB; ++b) acc[b] = 0.f;
        const int col = cb * 64 + lane;
#pragma unroll 16
        for (int kk = 0; kk < 64; ++kk) { const float wv = w[(size_t)(k0 + kk) * (6 * D_MODEL) + col];
#pragma unroll
            for (int b = 0; b < NB; ++b) acc[b] += scr[b * 64 + kk] * wv; }
        float* adap = (float*)(ws + WS_ADAP);
#pragma unroll
        for (int b = 0; b < NB; ++b) adap[(size_t)(ks * NB + b) * (6 * D_MODEL) + col] = acc[b];
        LDS_WAIT(); return;
    }
    it -= I_ADA;
    const int l31 = lane & 31;
    if (it < I_WIN) { const int nb = it / 16, kb = it % 16; tr_item(in[5], D_IN, win_src(nb * 32 + l31), (bf16_t*)(ws + WS_WIN), 1024, nb * 32, kb, scr, lane); return; }
    it -= I_WIN;
    if (it < I_WGAB) { const int nb = it / 16, kb = it % 16; tr_item(in[5], D_IN, O_GA + nb * 32 + l31, (bf16_t*)(ws + WS_WGAB), 1024, nb * 32, kb, scr, lane); return; }
    it -= I_WGAB;
    if (it < I_WB) { const int nb = it / 8, kb = it % 8; tr_item(in[9], D_MODEL, nb * 32 + l31, (bf16_t*)(ws + WS_WBA), 1024, nb * 32, kb, scr, lane, 0); return; }
    it -= I_WB;
    if (it < I_WB) { const int nb = it / 8, kb = it % 8; tr_item(in[10], D_MODEL, nb * 32 + l31, (bf16_t*)(ws + WS_WBA), 1024, nb * 32, kb, scr, lane, 512); return; }
    it -= I_WB;
    if (it < I_WOUT) { const int nb = it / 16, kb = it % 16; tr_item(in[11], D_MODEL, nb * 32 + l31, (bf16_t*)(ws + WS_WOUT), 1024, nb * 32, kb, scr, lane); return; }
    it -= I_WOUT;
    if (it < I_W13) {
        const int e = it / 256, r = it % 256, nb = r / 16, kb = r % 16; const int row0 = nb * 32;
        const int half = (row0 & 255) >> 7; const int col = (row0 >> 8) * 128 + (row0 & 127) + l31;
        const float* src = (half ? in[19] : in[18]) + (size_t)e * D_MODEL * D_EXP;
        tr_item(src, D_EXP, col, (bf16_t*)(ws + WS_W13) + (size_t)e * 512 * 1024, 1024, row0, kb, scr, lane); return; }
    it -= I_W13;
    { const int e = it / 128, r = it % 128, nb = r / 4, kb = r % 4;
      tr_item(in[20] + (size_t)e * D_EXP * D_MODEL, D_MODEL, nb * 32 + l31, (bf16_t*)(ws + WS_W2) + (size_t)e * 1024 * 256, 256, nb * 32, kb, scr, lane); }
}

__device__ __forceinline__ float dpp_row_sum_f(float v) {
    v += __int_as_float(__builtin_amdgcn_update_dpp(0, __float_as_int(v), 0xB1, 0xF, 0xF, true));
    v += __int_as_float(__builtin_amdgcn_update_dpp(0, __float_as_int(v), 0x4E, 0xF, 0xF, true));
    v += __int_as_float(__builtin_amdgcn_update_dpp(0, __float_as_int(v), 0x141, 0xF, 0xF, true));
    v += __int_as_float(__builtin_amdgcn_update_dpp(0, __float_as_int(v), 0x140, 0xF, 0xF, true));
    return v;
}
__device__ __forceinline__ float wave_sum_u(float v) {
    v = dpp_row_sum_f(v);
    return (__int_as_float(__builtin_amdgcn_readlane(__float_as_int(v), 0)) + __int_as_float(__builtin_amdgcn_readlane(__float_as_int(v), 16)))
         + (__int_as_float(__builtin_amdgcn_readlane(__float_as_int(v), 32)) + __int_as_float(__builtin_amdgcn_readlane(__float_as_int(v), 48)));
}
template <int R> __device__ __forceinline__ void ln_center(f32x4 (&v)[R][4], float (&rstd)[R], float* meanout = nullptr) {
    float s[R];
#pragma unroll
    for (int r = 0; r < R; ++r) { s[r] = 0.f;
#pragma unroll
        for (int j = 0; j < 4; ++j) s[r] += (v[r][j].x + v[r][j].y) + (v[r][j].z + v[r][j].w); }
#pragma unroll
    for (int r = 0; r < R; ++r) s[r] = dpp_row_sum_f(s[r]);
    float q[R];
#pragma unroll
    for (int r = 0; r < R; ++r) { const float mean = ((__int_as_float(__builtin_amdgcn_readlane(__float_as_int(s[r]), 0)) + __int_as_float(__builtin_amdgcn_readlane(__float_as_int(s[r]), 16)))
                                                   + (__int_as_float(__builtin_amdgcn_readlane(__float_as_int(s[r]), 32)) + __int_as_float(__builtin_amdgcn_readlane(__float_as_int(s[r]), 48)))) * (1.f / D_MODEL);
        if (meanout) meanout[r] = mean;
        q[r] = 0.f;
#pragma unroll
        for (int j = 0; j < 4; ++j) { v[r][j] = v[r][j] - mean; q[r] += (v[r][j].x * v[r][j].x + v[r][j].y * v[r][j].y) + (v[r][j].z * v[r][j].z + v[r][j].w * v[r][j].w); } }
#pragma unroll
    for (int r = 0; r < R; ++r) q[r] = dpp_row_sum_f(q[r]);
#pragma unroll
    for (int r = 0; r < R; ++r) { const float var = ((__int_as_float(__builtin_amdgcn_readlane(__float_as_int(q[r]), 0)) + __int_as_float(__builtin_amdgcn_readlane(__float_as_int(q[r]), 16)))
                                                  + (__int_as_float(__builtin_amdgcn_readlane(__float_as_int(q[r]), 32)) + __int_as_float(__builtin_amdgcn_readlane(__float_as_int(q[r]), 48)))) * (1.f / D_MODEL);
        rstd[r] = 1.f / sqrtf(var + LN_EPS); }
}
__device__ __forceinline__ float wave_sum(float v) {
#pragma unroll
    for (int o = 1; o < 64; o <<= 1) v += __shfl_xor(v, o);
    return v;
}
__device__ __forceinline__ float ada_sum(const float* adap, const float* b_ada, int b, int j) {
    float s = b_ada[j];
#pragma unroll
    for (int k = 0; k < KSL; ++k) s += adap[(size_t)(k * NB + b) * (6 * D_MODEL) + j];
    return s;
}
__device__ __forceinline__ void p1_phase(const float* const* in, unsigned char* ws, LAS unsigned char* lds, int G) {
    const int tid = threadIdx.x, lane = tid & 63, wave = tid >> 6;
    const float* adap = (const float*)(ws + WS_ADAP); const float* b_ada = in[4]; const float* x = in[0];
    LAS float* sh = (LAS float*)lds; LAS float* sc = sh + D_MODEL;
    for (int blk = blockIdx.x; blk < NT / 128; blk += G) {
        const int b = blk / 32;
        __syncthreads();
        for (int j = tid; j < 2 * D_MODEL; j += NTHREADS) sh[j] = ada_sum(adap, b_ada, b, j);
        if ((blk & 31) == 0) { float* ada = (float*)(ws + WS_ADA) + (size_t)b * 6 * D_MODEL; for (int j = tid; j < 6 * D_MODEL; j += NTHREADS) ada[j] = ada_sum(adap, b_ada, b, j); }
        __syncthreads();
        for (int rb = 0; rb < 16; rb += 4) {
            const size_t row0 = (size_t)blk * 128 + wave * 16 + rb;
            f32x4 v[4][4];
#pragma unroll
            for (int r = 0; r < 4; ++r) { const f32x4* xr = (const f32x4*)(x + (row0 + r) * D_MODEL) + lane;
#pragma unroll
                for (int j = 0; j < 4; ++j) v[r][j] = xr[64 * j]; }
            float rstd[4]; ln_center<4>(v, rstd);
#pragma unroll
            for (int j = 0; j < 4; ++j) { const f32x4 a = *(const LAS f32x4*)(sc + 256 * j + 4 * lane) + 1.f, c = *(const LAS f32x4*)(sh + 256 * j + 4 * lane);
#pragma unroll
                for (int r = 0; r < 4; ++r) { const f32x4 y = v[r][j] * rstd[r] * a + c; u32x2 w; w.x = cvtpk_s(y.x, y.y); w.y = cvtpk_s(y.z, y.w);
                    ((u32x2*)((bf16_t*)(ws + WS_XN) + (row0 + r) * D_MODEL) + lane)[64 * j] = w; } }
        }
        asm volatile("s_waitcnt vmcnt(0)" ::: "memory"); __syncthreads();
        {   LAS unsigned char* W64 = lds + 8192; constexpr int WP = 2064;
            const bf16_t* wsrc = (const bf16_t*)(ws + WS_WIN) + (size_t)3584 * 1024;
            for (int i = tid; i < 64 * 128; i += NTHREADS) { const int n = i >> 7, c = i & 127; *(LAS u32x4*)(W64 + n * WP + c * 16) = *(const u32x4*)(wsrc + (size_t)n * 1024 + c * 8); }
            __syncthreads();
            const int fr = lane & 15, fq = lane >> 4; const size_t rowA = (size_t)blk * 128 + wave * 16 + fr;
            const bf16_t* xp = (const bf16_t*)(ws + WS_XN) + rowA * D_MODEL + 8 * fq;
            f32x4 acc[4];
#pragma unroll
            for (int nt = 0; nt < 4; ++nt) acc[nt] = (f32x4){0.f, 0.f, 0.f, 0.f};
#pragma unroll 8
            for (int ks = 0; ks < 32; ++ks) { const bf16x8 bfr = *(const bf16x8*)(xp + 32 * ks);
#pragma unroll
                for (int nt = 0; nt < 4; ++nt) { const bf16x8 afr = *(const LAS bf16x8*)(W64 + (16 * nt + fr) * WP + (32 * ks + 8 * fq) * 2); acc[nt] = __builtin_amdgcn_mfma_f32_16x16x32_bf16(afr, bfr, acc[nt], 0, 0, 0); } }
            { u32x2 w; w.x = cvtpk_s(acc[0][0], acc[0][1]); w.y = cvtpk_s(acc[0][2], acc[0][3]); *(u32x2*)((bf16_t*)(ws + WS_IK) + rowA * 32 + 4 * fq) = w;
              w.x = cvtpk_s(acc[1][0], acc[1][1]); w.y = cvtpk_s(acc[1][2], acc[1][3]); *(u32x2*)((bf16_t*)(ws + WS_IK) + rowA * 32 + 16 + 4 * fq) = w;
              *(f32x4*)((float*)(ws + WS_IW) + rowA * 16 + 4 * fq) = acc[2];
              w.x = cvtpk_s(acc[3][0], acc[3][1]); w.y = cvtpk_s(acc[3][2], acc[3][3]); *(u32x2*)((bf16_t*)(ws + WS_GLR) + rowA * 16 + 4 * fq) = w; }
        }
    }
}

struct EpiProj {
    static constexpr bool PERM = true, AFTER_DRAIN = false, MID = false;
    unsigned char* ws;
    __device__ __forceinline__ void operator()(const f32x4 (&acc)[2][2][4][2], const Unit& u, int wr, int wc, int fr, int fq) const {
        const int row0 = u.pm * 256 + wr * 64 + fr; const int pn = u.pn;
        {
            bf16_t* base; int ld, ct; float sc = 1.f;
            if (pn < 6) { base = (bf16_t*)(ws + WS_QKV); ld = 1536; ct = pn * 256; if (pn < 2) sc = QSCALE; }
            else if (pn < 8) { base = (bf16_t*)(ws + WS_IQ); ld = 512; ct = (pn - 6) * 256; }
            else if (pn < 10) { base = (bf16_t*)(ws + WS_GQK); ld = 512; ct = (pn - 8) * 256; }
            else if (pn < 12) { base = (bf16_t*)(ws + WS_GV); ld = 512; ct = (pn - 10) * 256; }
            else { base = (bf16_t*)(ws + WS_GR); ld = 512; ct = (pn - 12) * 256; }
            const int col0 = ct + wc * 32 + 8 * fq;
#pragma unroll
            for (int ai = 0; ai < 2; ++ai)
#pragma unroll
                for (int m = 0; m < 4; ++m) { bf16_t* rowp = base + (size_t)(row0 + ai * 128 + m * 16) * ld + col0;
#pragma unroll
                    for (int bj = 0; bj < 2; ++bj) { const f32x4 v0 = acc[ai][bj][m][0] * sc, v1 = acc[ai][bj][m][1] * sc;
                        u32x4 w; w.x = cvt_pk_bf16(v0[0], v0[1]); w.y = cvt_pk_bf16(v0[2], v0[3]); w.z = cvt_pk_bf16(v1[0], v1[1]); w.w = cvt_pk_bf16(v1[2], v1[3]);
                        *(u32x4*)(rowp + bj * 128) = w; } }
        }
    }
};

typedef float f32x4_t __attribute__((ext_vector_type(4)));
constexpr int SC_TILES_PER_B = 528, SC_ITEMS = NB * SC_TILES_PER_B;
__device__ __forceinline__ size_t keys_row_dw(int b, int t) {
    const int qi = t >> 7, r = t & 127; return (size_t)b * (SC_TILES_PER_B * 8192) + (size_t)8192 * (qi * (qi + 1) / 2) + (size_t)r * (qi + 1) * 64;
}
__device__ __forceinline__ unsigned score_key(float sc) {
    const _Float16 hf = (_Float16)sc; const unsigned short hb = __builtin_bit_cast(unsigned short, hf);
    return (hb & 0x8000u) ? (unsigned)(unsigned short)~hb : (unsigned)(hb | 0x8000u);
}
__device__ __forceinline__ void fma_abs4(f32x4& acc, const f32x4& d, float w) {
    float a0 = acc[0], a1 = acc[1], a2 = acc[2], a3 = acc[3];
    asm volatile("v_fma_f32 %0, |%4|, %8, %0\n\tv_fma_f32 %1, |%5|, %8, %1\n\tv_fma_f32 %2, |%6|, %8, %2\n\tv_fma_f32 %3, |%7|, %8, %3"
                 : "+v"(a0), "+v"(a1), "+v"(a2), "+v"(a3) : "v"(d[0]), "v"(d[1]), "v"(d[2]), "v"(d[3]), "v"(w));
    acc[0] = a0; acc[1] = a1; acc[2] = a2; acc[3] = a3;
}
constexpr int SC_SEGS_PER_B = 144, SC_SEGS = NB * SC_SEGS_PER_B;
__device__ __forceinline__ unsigned score_key2(float lo, float hi) {
    typedef _Float16 h2 __attribute__((ext_vector_type(2)));
    const unsigned x = __builtin_bit_cast(unsigned, __builtin_amdgcn_cvt_pkrtz(lo, hi));
    unsigned m; asm("v_pk_ashrrev_i16 %0, %2, %1" : "=v"(m) : "v"(x), "v"(0x000F000Fu));
    return x ^ (m | 0x80008000u);
}
__device__ __forceinline__ void p3a_run(int b, int qi, int kj0, int kj1, unsigned char* ws, LAS unsigned char* ldsw, int wave, int lane) {
    const int fr = lane & 15, fq = lane >> 4;
    const int t = qi * 128 + wave * 16 + fr; const size_t trow = (size_t)b * NS + t;
    const bf16_t* IQ = (const bf16_t*)(ws + WS_IQ) + trow * 512 + 8 * fq;
    const bf16_t* IK = (const bf16_t*)(ws + WS_IK) + ((size_t)b * NS + fr) * 32 + 8 * fq;
    const float* IW = (const float*)(ws + WS_IW) + trow * 16;
    LAS unsigned char* QL = ldsw; LAS float* WL = (LAS float*)(ldsw + 16384);
    bf16x8 kf[8];
#pragma unroll
    for (int kb = 0; kb < 8; ++kb) kf[kb] = *(const bf16x8*)(IK + ((size_t)kj0 * 128 + kb * 16) * 32);
    float qb[8];
#pragma unroll
    for (int j = 0; j < 8; ++j) qb[j] = 0.f;
#pragma unroll
    for (int hg = 0; hg < 4; ++hg) {
        const f32x4 w4 = *(const f32x4*)(IW + 4 * hg) * (0.5f * 0.044194173824159216f);
        u32x4 q4[4];
#pragma unroll
        for (int i = 0; i < 4; ++i) q4[i] = *(const u32x4*)(IQ + (4 * hg + i) * 32);
#pragma unroll
        for (int i = 0; i < 4; ++i) { *(LAS u32x4*)(QL + (4 * hg + i) * 1024 + lane * 16) = q4[i]; if (fq == 0) WL[(4 * hg + i) * 16 + fr] = w4[i]; float f[8]; bf8_to_f(q4[i], f);
#pragma unroll
            for (int j = 0; j < 8; ++j) qb[j] += w4[i] * f[j]; }
    }
    u32x4 qbw; qbw.x = cvtpk_s(qb[0], qb[1]); qbw.y = cvtpk_s(qb[2], qb[3]); qbw.z = cvtpk_s(qb[4], qb[5]); qbw.w = cvtpk_s(qb[6], qb[7]);
    const bf16x8 qbar = __builtin_bit_cast(bf16x8, qbw);
    LDS_WAIT();
    for (int kj = kj0; kj <= kj1; ++kj) {
        bf16x8 kn[8];
        const int kjn = (kj < kj1) ? kj + 1 : kj;
#pragma unroll
        for (int kb = 0; kb < 8; ++kb) kn[kb] = *(const bf16x8*)(IK + ((size_t)kjn * 128 + kb * 16) * 32);
        f32x4 acc[8];
#pragma unroll
        for (int kb = 0; kb < 8; ++kb) acc[kb] = __builtin_amdgcn_mfma_f32_16x16x32_bf16(kf[kb], qbar, (f32x4){0.f, 0.f, 0.f, 0.f}, 0, 0, 0);
        f32x4 dA[8], dB[8];
        { const bf16x8 qf = *(const LAS bf16x8*)(QL + lane * 16);
#pragma unroll
          for (int kb = 0; kb < 8; ++kb) dA[kb] = __builtin_amdgcn_mfma_f32_16x16x32_bf16(kf[kb], qf, (f32x4){0.f, 0.f, 0.f, 0.f}, 0, 0, 0); }
#pragma unroll 1
        for (int h = 0; h < I_HEADS; h += 2) {
            { const bf16x8 qf = *(const LAS bf16x8*)(QL + (h + 1) * 1024 + lane * 16);
#pragma unroll
              for (int kb = 0; kb < 8; ++kb) dB[kb] = __builtin_amdgcn_mfma_f32_16x16x32_bf16(kf[kb], qf, (f32x4){0.f, 0.f, 0.f, 0.f}, 0, 0, 0); }
            __builtin_amdgcn_sched_barrier(0);
            { const float w = WL[h * 16 + fr];
#pragma unroll
              for (int kb = 0; kb < 8; ++kb) fma_abs4(acc[kb], dA[kb], w); }
            __builtin_amdgcn_sched_barrier(0);
            { const int hn = (h + 2 < I_HEADS) ? h + 2 : h; const bf16x8 qf = *(const LAS bf16x8*)(QL + hn * 1024 + lane * 16);
#pragma unroll
              for (int kb = 0; kb < 8; ++kb) dA[kb] = __builtin_amdgcn_mfma_f32_16x16x32_bf16(kf[kb], qf, (f32x4){0.f, 0.f, 0.f, 0.f}, 0, 0, 0); }
            __builtin_amdgcn_sched_barrier(0);
            { const float w = WL[(h + 1) * 16 + fr];
#pragma unroll
              for (int kb = 0; kb < 8; ++kb) fma_abs4(acc[kb], dB[kb], w); }
            __builtin_amdgcn_sched_barrier(0);
        }
        unsigned* KEYS = (unsigned*)(ws + WS_SC) + keys_row_dw(b, t) + (size_t)kj * 64;
        const bool diag = (kj == qi);
#pragma unroll
        for (int kb = 0; kb < 4; ++kb) { u32x4 o;
#pragma unroll
            for (int r = 0; r < 4; ++r) o[r] = score_key2(acc[kb][r], acc[kb + 4][r]);
            if (diag) { asm volatile("" ::: "memory");
#pragma unroll
                for (int r = 0; r < 4; ++r) { const int sl = kb * 16 + 4 * fq + r, tl = wave * 16 + fr; if (sl > tl) o[r] &= 0xFFFF0000u; if (sl + 64 > tl) o[r] &= 0x0000FFFFu; } }
            *(u32x4*)(KEYS + kb * 16 + 4 * fq) = o; }
#pragma unroll
        for (int kb = 0; kb < 8; ++kb) kf[kb] = kn[kb];
    }
    LDS_WAIT();
}

__device__ __forceinline__ int dpp_row_sum(int v) {
    v += __builtin_amdgcn_update_dpp(0, v, 0xB1, 0xF, 0xF, true);
    v += __builtin_amdgcn_update_dpp(0, v, 0x4E, 0xF, 0xF, true);
    v += __builtin_amdgcn_update_dpp(0, v, 0x141, 0xF, 0xF, true);
    v += __builtin_amdgcn_update_dpp(0, v, 0x140, 0xF, 0xF, true);
    return v;
}
__device__ __forceinline__ int wave_sum_i(int v) {
    v = dpp_row_sum(v);
    return __builtin_amdgcn_readlane(v, 0) + __builtin_amdgcn_readlane(v, 16) + __builtin_amdgcn_readlane(v, 32) + __builtin_amdgcn_readlane(v, 48);
}
__device__ __forceinline__ void pk_ge_count4(unsigned x0, unsigned x1, unsigned x2, unsigned x3, unsigned c2m1, unsigned one2, unsigned& c0, unsigned& c1, unsigned& c2, unsigned& c3) {
    unsigned d0, d1, d2, d3;
    asm volatile("v_pk_sub_u16 %0, %8, %12 clamp\n\tv_pk_sub_u16 %1, %9, %12 clamp\n\tv_pk_sub_u16 %2, %10, %12 clamp\n\tv_pk_sub_u16 %3, %11, %12 clamp\n\t"
                 "v_pk_min_u16 %0, %0, %13\n\tv_pk_min_u16 %1, %1, %13\n\tv_pk_min_u16 %2, %2, %13\n\tv_pk_min_u16 %3, %3, %13\n\t"
                 "v_pk_add_u16 %4, %4, %0\n\tv_pk_add_u16 %5, %5, %1\n\tv_pk_add_u16 %6, %6, %2\n\tv_pk_add_u16 %7, %7, %3"
                 : "=&v"(d0), "=&v"(d1), "=&v"(d2), "=&v"(d3), "+v"(c0), "+v"(c1), "+v"(c2), "+v"(c3) : "v"(x0), "v"(x1), "v"(x2), "v"(x3), "v"(c2m1), "v"(one2));
}
constexpr int TOPK = 256;
__device__ __forceinline__ int count_ge(const unsigned (&x)[32], int ng, unsigned cand) {
    const unsigned c2m1 = (cand - 1u) * 0x00010001u, one2 = 0x00010001u; unsigned c0 = 0u, c1 = 0u, c2 = 0u, c3 = 0u;
#pragma unroll
    for (int g = 0; g < 4; ++g) if (g < ng) { pk_ge_count4(x[8 * g], x[8 * g + 1], x[8 * g + 2], x[8 * g + 3], c2m1, one2, c0, c1, c2, c3); pk_ge_count4(x[8 * g + 4], x[8 * g + 5], x[8 * g + 6], x[8 * g + 7], c2m1, one2, c0, c1, c2, c3); }
    const unsigned s = (c0 + c1) + (c2 + c3);
    return wave_sum_i((int)((s & 0xFFFFu) + (s >> 16)));
}
__device__ __forceinline__ void p4a_load(int row_, unsigned char* ws, int lane, unsigned (&x)[32]) {
    const int row = __builtin_amdgcn_readfirstlane(row_); const int b = row / NS, t = row % NS; const int nc = (t >> 7) + 1;
    const unsigned* KEYS = (const unsigned*)(ws + WS_SC) + keys_row_dw(b, t) + lane;
    const unsigned dead = (unsigned)((lane & 15) << 6) * 0x00010001u;
#pragma unroll
    for (int c = 0; c < 32; ++c) { const int cc = c < nc ? c : nc - 1; const unsigned v = KEYS[cc * 64]; x[c] = c < nc ? v : dead; }
}
__device__ __forceinline__ int scan16_incl(int v) {
    v += __builtin_amdgcn_update_dpp(0, v, 0x111, 0xF, 0xF, true);
    v += __builtin_amdgcn_update_dpp(0, v, 0x112, 0xF, 0xF, true);
    v += __builtin_amdgcn_update_dpp(0, v, 0x114, 0xF, 0xF, true);
    v += __builtin_amdgcn_update_dpp(0, v, 0x118, 0xF, 0xF, true);
    return v;
}
__device__ __forceinline__ int scan64_incl(int v, int lane) {
    v = scan16_incl(v);
    const int t0 = __builtin_amdgcn_readlane(v, 15), t1 = __builtin_amdgcn_readlane(v, 31), t2 = __builtin_amdgcn_readlane(v, 47);
    return v + (lane >= 16 ? t0 : 0) + (lane >= 32 ? t1 : 0) + (lane >= 48 ? t2 : 0);
}
__device__ __forceinline__ void lds_inc(unsigned addr) { __hip_atomic_fetch_add((LAS unsigned*)(unsigned long)addr, 1u, __ATOMIC_RELAXED, __HIP_MEMORY_SCOPE_WORKGROUP); }
#define WAVE_LDS_ORDER() do { asm volatile("" ::: "memory"); __builtin_amdgcn_fence(__ATOMIC_ACQ_REL, "wavefront"); __builtin_amdgcn_wave_barrier(); asm volatile("" ::: "memory"); } while (0)
constexpr int SEL_LDS = 8192;
__device__ __forceinline__ void tie_fix(unsigned long long& m, unsigned long long e, int& run, int need) {
    if (e != 0ull) { const int n = __builtin_popcountll(e); int keep = need - run; run += n;
        if (keep < n) { if (keep < 0) keep = 0; unsigned long long d = e; for (int i = 0; i < keep; ++i) d &= d - 1ull; m &= ~d; } }
}
#define PUT4(mw0, mw1, a0, a1, a2, a3, L0) asm volatile("s_nop 3\n\tv_writelane_b32 %0, %2, %10\n\tv_writelane_b32 %1, %3, %10\n\tv_writelane_b32 %0, %4, %11\n\tv_writelane_b32 %1, %5, %11\n\t" \
        "v_writelane_b32 %0, %6, %12\n\tv_writelane_b32 %1, %7, %12\n\tv_writelane_b32 %0, %8, %13\n\tv_writelane_b32 %1, %9, %13" : "+v"(mw0), "+v"(mw1) \
        : "s"((unsigned)(a0)), "s"((unsigned)((a0) >> 32)), "s"((unsigned)(a1)), "s"((unsigned)((a1) >> 32)), "s"((unsigned)(a2)), "s"((unsigned)((a2) >> 32)), "s"((unsigned)(a3)), "s"((unsigned)((a3) >> 32)), \
          "n"(L0), "n"((L0) + 1), "n"((L0) + 2), "n"((L0) + 3))
__device__ __forceinline__ void p4a_row(int row_, unsigned char* ws, int lane, const unsigned (&x)[32], LAS unsigned char* H) {
    const int row = __builtin_amdgcn_readfirstlane(row_);
    const int t = row % NS; unsigned long long* MASK = (unsigned long long*)(ws + WS_MASK) + (size_t)row * 64;
    const int nc = (t >> 7) + 1;
    if (t < TOPK) {
        if (lane < 2 * nc) { const int lo = lane * 64; unsigned long long m = 0ull; if (t >= lo + 63) m = ~0ull; else if (t >= lo) m = (2ull << (t - lo)) - 1ull; MASK[lane] = m; }
        return;
    }
#define BIN1(v) ((0xFFCu & (v)) | (~0xFFCu & hb))
    const unsigned hb = (unsigned)(unsigned long)H;
    { const u32x4 z = (u32x4){0u, 0u, 0u, 0u};
#pragma unroll
      for (int i = 0; i < 4; ++i) *(LAS u32x4*)(H + i * 1024 + lane * 16) = z;
      *(LAS unsigned*)(H + 4096 + lane * 4) = 0u; }
    WAVE_LDS_ORDER();
#pragma unroll
    for (int c = 0; c < 32; c += 2) if (c < nc) {
        lds_inc(BIN1(x[c] >> 4)); lds_inc(BIN1(x[c] >> 20)); lds_inc(BIN1(x[c + 1] >> 4)); lds_inc(BIN1(x[c + 1] >> 20)); }
    WAVE_LDS_ORDER();
    int Bsel, cA;
    {   const LAS unsigned char* hp = H + (63 - lane) * 64;
        const u32x4 h0 = *(const LAS u32x4*)hp, h1 = *(const LAS u32x4*)(hp + 16), h2 = *(const LAS u32x4*)(hp + 32), h3 = *(const LAS u32x4*)(hp + 48);
        const int sl = (int)(((h0.x + h0.y) + (h0.z + h0.w)) + ((h1.x + h1.y) + (h1.z + h1.w)) + ((h2.x + h2.y) + (h2.z + h2.w)) + ((h3.x + h3.y) + (h3.z + h3.w)));
        const int P = scan64_incl(sl, lane);
        const int Ls = __builtin_ctzll(__ballot(P >= TOPK));
        const int E = __builtin_amdgcn_readlane(P - sl, Ls);
        const int hj = (int)*(const LAS unsigned*)(H + ((63 - Ls) * 16 + 15 - (lane & 15)) * 4);
        const int Pj = scan16_incl(hj);
        const int jl = __builtin_ctzll(__ballot(E + Pj >= TOPK) & 0xFFFFull);
        Bsel = (63 - Ls) * 16 + 15 - jl; cA = E + __builtin_amdgcn_readlane(Pj - hj, jl);
    }
    {   const unsigned Bs2 = ((unsigned)Bsel << 6) * 0x00010001u; const unsigned dump = 64u + (unsigned)lane, hb2 = hb + 4096u;
#pragma unroll
        for (int c = 0; c < 32; c += 2) if (c < nc) {
#pragma unroll
            for (int i = 0; i < 2; ++i) { const unsigned y = x[c + i] ^ Bs2;
                const unsigned il = (unsigned)(unsigned short)__builtin_elementwise_min((unsigned short)y, (unsigned short)dump), ih = __builtin_elementwise_min(y >> 16, dump);
                lds_inc((il << 2) + hb2); lds_inc((ih << 2) + hb2); } }
    }
    WAVE_LDS_ORDER();
    unsigned T; int cT, need;
    {   const int c2 = (int)*(const LAS unsigned*)(H + 4096 + (63 - lane) * 4);
        const int P2 = scan64_incl(c2, lane);
        const int L2 = __builtin_ctzll(__ballot(cA + P2 >= TOPK));
        cT = cA + __builtin_amdgcn_readlane(P2, L2); need = TOPK - (cT - __builtin_amdgcn_readlane(c2, L2));
        T = ((unsigned)Bsel << 6) + (unsigned)(63 - L2);
    }
    unsigned mw0 = 0u, mw1 = 0u;
    const bool tie = (cT != TOPK);
    const unsigned Th = T << 16; const unsigned short Ts = (unsigned short)T; int run = 0;
#pragma unroll
    for (int c = 0; c < 32; c += 2) if (c < nc) {
        unsigned long long a0 = __ballot((unsigned short)x[c] >= Ts), a1 = __ballot(x[c] >= Th), a2 = __ballot((unsigned short)x[c + 1] >= Ts), a3 = __ballot(x[c + 1] >= Th);
        if (tie) {
            const unsigned long long e0 = __ballot((unsigned short)x[c] == Ts), e1 = __ballot((x[c] >> 16) == T), e2 = __ballot((unsigned short)x[c + 1] == Ts), e3 = __ballot((x[c + 1] >> 16) == T);
            tie_fix(a0, e0, run, need); tie_fix(a1, e1, run, need); tie_fix(a2, e2, run, need); tie_fix(a3, e3, run, need);
        }
        PUT4(mw0, mw1, a0, a1, a2, a3, 2 * c);
    }
    if (lane < 2 * nc) MASK[lane] = ((unsigned long long)mw1 << 32) | mw0;
}

typedef float f32x16 __attribute__((ext_vector_type(16)));
typedef short s16x4 __attribute__((ext_vector_type(4)));
__device__ __forceinline__ int crow(int r, int hi) { return (r & 3) + 8 * (r >> 2) + 4 * hi; }
__device__ __forceinline__ s16x4 vtr(const LAS unsigned char* p) { return __builtin_bit_cast(s16x4, __builtin_amdgcn_ds_read_tr16_b64_v4i16((LAS s16x4*)p)); }
constexpr size_t WS_OAB = 358 * MiB;
constexpr int AT_ROWB = 144, AT_TILE = 64 * AT_ROWB;
constexpr int AT_VROWB = 192, AT_VTILE = 64 * AT_VROWB;
constexpr float LOG2E = 1.4426950408889634f;
constexpr float ATHR = 8.f;
__device__ __forceinline__ int sext_bit(unsigned w, int c) { int r; asm("v_bfe_i32 %0, %1, %2, 1" : "=v"(r) : "v"(w), "n"(c)); return r; }
__device__ __forceinline__ void attn_s(const LAS unsigned char* Kb, const LAS float* BT, const bf16x8 (&qr)[4], unsigned long long mword, bool far, bool first, int dist0,
                                       int r32, int hh, f32x16& o0, f32x16& o1, f32x16& o2, f32x16& nmB, float& mref, u32x4 (&pk)[4]) {
    f32x16 p0, p1;
#pragma unroll
    for (int ks = 0; ks < 4; ++ks) {
        const bf16x8 k0 = *(const LAS bf16x8*)(Kb + r32 * AT_ROWB + 32 * ks + 16 * hh);
        const bf16x8 k1 = *(const LAS bf16x8*)(Kb + (32 + r32) * AT_ROWB + 32 * ks + 16 * hh);
        if (ks == 0) { p0 = __builtin_amdgcn_mfma_f32_32x32x16_bf16(k0, qr[0], nmB, 0, 0, 0); p1 = __builtin_amdgcn_mfma_f32_32x32x16_bf16(k1, qr[0], nmB, 0, 0, 0); }
        else { p0 = __builtin_amdgcn_mfma_f32_32x32x16_bf16(k0, qr[ks], p0, 0, 0, 0); p1 = __builtin_amdgcn_mfma_f32_32x32x16_bf16(k1, qr[ks], p1, 0, 0, 0); }
    }
    if (!far) {
        const LAS float* bp = BT + (96 - 27 - 32) + dist0;
#pragma unroll
        for (int i = 0; i < 16; ++i) { const int c = (i & 3) + 8 * (i >> 2); p0[i] += bp[32 + 27 - c]; p1[i] += bp[27 - c]; }
    }
    float m0 = __builtin_fmaxf(__builtin_fmaxf(p0[0], p0[1]), p0[2]), m1 = __builtin_fmaxf(__builtin_fmaxf(p1[0], p1[1]), p1[2]);
#pragma unroll
    for (int i = 3; i < 15; i += 2) { m0 = __builtin_fmaxf(__builtin_fmaxf(m0, p0[i]), p0[i + 1]); m1 = __builtin_fmaxf(__builtin_fmaxf(m1, p1[i]), p1[i + 1]); }
    float mx = __builtin_fmaxf(__builtin_fmaxf(m0, m1), __builtin_fmaxf(p0[15], p1[15]));
    { const auto rr = __builtin_amdgcn_permlane32_swap(__float_as_uint(mx), __float_as_uint(mx), false, false); mx = __builtin_fmaxf(__uint_as_float(rr[0]), __uint_as_float(rr[1])); }
    if (first || __any(mx > ATHR)) {
        const float dl = (first || mx > ATHR) ? mx : 0.f; mref += dl; const float f = __builtin_amdgcn_exp2f(-dl);
#pragma unroll
        for (int i = 0; i < 16; ++i) { p0[i] -= dl; p1[i] -= dl; nmB[i] -= dl; o0[i] *= f; o1[i] *= f; o2[i] *= f; }
    }
    const unsigned wl = (unsigned)mword >> (4 * hh), wh = (unsigned)(mword >> 32) >> (4 * hh);
#pragma unroll
    for (int i = 0; i < 16; ++i) { const int c = (i & 3) + 8 * (i >> 2);
        p0[i] = __uint_as_float(__float_as_uint(__builtin_amdgcn_exp2f(p0[i])) & (unsigned)sext_bit(wl, c));
        p1[i] = __uint_as_float(__float_as_uint(__builtin_amdgcn_exp2f(p1[i])) & (unsigned)sext_bit(wh, c)); }
#pragma unroll
    for (int s2 = 0; s2 < 2; ++s2) {
        pk[s2].x = cvtpk_s(p0[8 * s2], p0[8 * s2 + 1]); pk[s2].y = cvtpk_s(p0[8 * s2 + 2], p0[8 * s2 + 3]); pk[s2].z = cvtpk_s(p0[8 * s2 + 4], p0[8 * s2 + 5]); pk[s2].w = cvtpk_s(p0[8 * s2 + 6], p0[8 * s2 + 7]);
        pk[2 + s2].x = cvtpk_s(p1[8 * s2], p1[8 * s2 + 1]); pk[2 + s2].y = cvtpk_s(p1[8 * s2 + 2], p1[8 * s2 + 3]); pk[2 + s2].z = cvtpk_s(p1[8 * s2 + 4], p1[8 * s2 + 5]); pk[2 + s2].w = cvtpk_s(p1[8 * s2 + 6], p1[8 * s2 + 7]); }
}
__device__ __forceinline__ void attn_pv(const LAS unsigned char* Vb, const u32x4 (&pk)[4], int voff, f32x16& o0, f32x16& o1, f32x16& o2) {
    const u32x4 onesw = (u32x4){0x3F803F80u, 0x3F803F80u, 0x3F803F80u, 0x3F803F80u}; const bf16x8 ones = __builtin_bit_cast(bf16x8, onesw);
#pragma unroll
    for (int q = 0; q < 4; ++q) {
        const bf16x8 pf = __builtin_bit_cast(bf16x8, pk[q]);
        const LAS unsigned char* vp = Vb + (16 * q) * AT_VROWB + voff;
        const s16x4 a0l = vtr(vp), a0h = vtr(vp + 8 * AT_VROWB), a1l = vtr(vp + 64), a1h = vtr(vp + 8 * AT_VROWB + 64);
        const bf16x8 va0 = (bf16x8){a0l[0], a0l[1], a0l[2], a0l[3], a0h[0], a0h[1], a0h[2], a0h[3]};
        const bf16x8 va1 = (bf16x8){a1l[0], a1l[1], a1l[2], a1l[3], a1h[0], a1h[1], a1h[2], a1h[3]};
        o0 = __builtin_amdgcn_mfma_f32_32x32x16_bf16(va0, pf, o0, 0, 0, 0);
        o1 = __builtin_amdgcn_mfma_f32_32x32x16_bf16(va1, pf, o1, 0, 0, 0);
        o2 = __builtin_amdgcn_mfma_f32_32x32x16_bf16(ones, pf, o2, 0, 0, 0);
    }
}
constexpr int AT_KB = 0, AT_VB = 2 * AT_TILE, AT_BT3 = AT_VB + 3 * AT_VTILE;
template <bool GB> __device__ __forceinline__ void attn_unit(int b, int h, int Q, const float* rel_bias, unsigned char* ws, LAS unsigned char* lds) {
    const int tid = threadIdx.x, lane = tid & 63, wave = __builtin_amdgcn_readfirstlane(tid >> 6), r32 = lane & 31, hh = lane >> 5;
    const size_t rowbase = (size_t)b * NS; const int t0w = 256 * Q + 32 * wave, t = t0w + r32;
    const bf16_t* QKV = (const bf16_t*)(ws + WS_QKV);
    LAS float* BT = (LAS float*)(lds + AT_BT3);
    const int NTL = 4 * (Q + 1);
    const int lastw = (t0w + 31) >> 6;
    const int srow = tid >> 3, sch = tid & 7;
    const bf16_t* kg = QKV + (rowbase + srow) * 1536 + 512 + h * 64 + sch * 8; const bf16_t* vg = kg + 512;
    const int soff = srow * AT_ROWB + sch * 16, svoff = srow * AT_VROWB + sch * 16;
    const unsigned long long* MK = (const unsigned long long*)(ws + WS_MASK) + (rowbase + t) * 64;
    const size_t tstride = (size_t)64 * 1536;
    u32x4 k0r = *(const u32x4*)kg, v0r = *(const u32x4*)vg;
    u32x4 kA = *(const u32x4*)(kg + tstride), vA = *(const u32x4*)(vg + tstride);
    u32x4 kB = *(const u32x4*)(kg + 2 * tstride), vB = *(const u32x4*)(vg + 2 * tstride);
    unsigned long long me = MK[0], mo = MK[(1 <= lastw) ? 1 : 0];
    bf16x8 qr[4];
#pragma unroll
    for (int ks = 0; ks < 4; ++ks) qr[ks] = *(const bf16x8*)(QKV + (rowbase + t) * 1536 + h * 64 + 16 * ks + 8 * hh);
    const float cB = rel_bias[31 * A_HEADS + h] * LOG2E;
    __syncthreads();
    if (tid < 352) { const int d = tid - 96; BT[tid] = rel_bias[v0_bucket(d < 0 ? 0 : d) * A_HEADS + h] * LOG2E - cB; }
    *(LAS u32x4*)(lds + AT_KB + soff) = k0r; *(LAS u32x4*)(lds + AT_VB + svoff) = v0r;
    f32x16 o0, o1, o2, nmB;
#pragma unroll
    for (int i = 0; i < 16; ++i) { o0[i] = 0.f; o1[i] = 0.f; o2[i] = 0.f; nmB[i] = cB; }
    float mref = 0.f;
    const int q4 = (lane & 15) >> 2, p4 = lane & 3, blk = (lane >> 4) & 1;
    const int voff = (4 * hh + q4) * AT_VROWB + (16 * blk + 4 * p4) * 2;
    u32x4 pk[4];
#pragma unroll
    for (int q = 0; q < 4; ++q) pk[q] = (u32x4){0u, 0u, 0u, 0u};
    int vcur = 0, vnext = AT_VTILE, vprev = 2 * AT_VTILE;
    for (int kt = 0; kt < NTL; kt += 2) {
        __syncthreads();
        *(LAS u32x4*)(lds + AT_KB + AT_TILE + soff) = kA; *(LAS u32x4*)(lds + AT_VB + vnext + svoff) = vA;
        { const int tn = (kt + 3 < NTL) ? kt + 3 : NTL - 1; kA = *(const u32x4*)(kg + (size_t)tn * tstride); vA = *(const u32x4*)(vg + (size_t)tn * tstride); }
        if (GB) { if (kt >= 1 && kt - 1 <= lastw) attn_pv(lds + AT_VB + vprev, pk, voff, o0, o1, o2); }
        if (kt <= lastw) attn_s(lds + AT_KB, BT, qr, me, (t0w - (64 * kt + 63) >= 113), kt == 0, t - 64 * kt - 4 * hh, r32, hh, o0, o1, o2, nmB, mref, pk);
        if (!GB) { if (kt <= lastw) attn_pv(lds + AT_VB + vcur, pk, voff, o0, o1, o2); }
        me = MK[(kt + 2 <= lastw) ? kt + 2 : lastw];
        { const int tmp = vprev; vprev = vcur; vcur = vnext; vnext = tmp; }
        __syncthreads();
        *(LAS u32x4*)(lds + AT_KB + soff) = kB; *(LAS u32x4*)(lds + AT_VB + vnext + svoff) = vB;
        { const int tn = (kt + 4 < NTL) ? kt + 4 : NTL - 1; kB = *(const u32x4*)(kg + (size_t)tn * tstride); vB = *(const u32x4*)(vg + (size_t)tn * tstride); }
        if (GB) { if (kt <= lastw) attn_pv(lds + AT_VB + vprev, pk, voff, o0, o1, o2); }
        if (kt + 1 <= lastw) attn_s(lds + AT_KB + AT_TILE, BT, qr, mo, (t0w - (64 * (kt + 1) + 63) >= 113), false, t - 64 * (kt + 1) - 4 * hh, r32, hh, o0, o1, o2, nmB, mref, pk);
        if (!GB) { if (kt + 1 <= lastw) attn_pv(lds + AT_VB + vcur, pk, voff, o0, o1, o2); }
        mo = MK[(kt + 3 <= lastw) ? kt + 3 : lastw];
        { const int tmp = vprev; vprev = vcur; vcur = vnext; vnext = tmp; }
    }
    if (GB) {
        if (NTL - 1 <= lastw) attn_pv(lds + AT_VB + vprev, pk, voff, o0, o1, o2);
    }
    const float inv = 1.f / o2[0];
    bf16_t* O = (bf16_t*)(ws + WS_OAB) + (rowbase + t) * 1024 + h * 64 + 4 * hh;
#pragma unroll
    for (int g = 0; g < 4; ++g) {
        u32x2 w0, w1; w0.x = cvtpk_s(o0[4 * g] * inv, o0[4 * g + 1] * inv); w0.y = cvtpk_s(o0[4 * g + 2] * inv, o0[4 * g + 3] * inv);
        w1.x = cvtpk_s(o1[4 * g] * inv, o1[4 * g + 1] * inv); w1.y = cvtpk_s(o1[4 * g + 2] * inv, o1[4 * g + 3] * inv);
        *(u32x2*)(O + 8 * g) = w0; *(u32x2*)(O + 32 + 8 * g) = w1;
    }
}

constexpr int GL_LG = 0, GL_SEG = 16384, GL_A = 18432, GL_B = GL_A + 9216, GL_C = GL_B + 9216, GL_VT = GL_C + 9216, GL_ST = GL_VT + 18432;
constexpr int GROWB = 144;
constexpr int GLA_ITEMS = NB * G_HEADS * 64;
__device__ __forceinline__ void gla_cumdecay(const u32x4 g0, const u32x4 g1, int h, const float* wg, const float* bg, LAS unsigned char* lds, float* lgc) {
    const int tid = threadIdx.x; LAS float* LG = (LAS float*)(lds + GL_LG); LAS float* SEG = (LAS float*)(lds + GL_SEG);
    {   const int c = tid >> 3, dg = tid & 7; float gl[16];
#pragma unroll
        for (int j = 0; j < 4; ++j) { gl[2 * j] = __uint_as_float(g0[j] << 16); gl[2 * j + 1] = __uint_as_float(g0[j] & 0xffff0000u); gl[8 + 2 * j] = __uint_as_float(g1[j] << 16); gl[8 + 2 * j + 1] = __uint_as_float(g1[j] & 0xffff0000u); }
        float z[8];
#pragma unroll
        for (int j = 0; j < 8; ++j) z[j] = bg[h * 64 + 8 * dg + j];
#pragma unroll
        for (int r = 0; r < 16; ++r) { const f32x4 w0 = *(const f32x4*)(wg + r * G_KW + h * 64 + 8 * dg), w1 = *(const f32x4*)(wg + r * G_KW + h * 64 + 8 * dg + 4);
            z[0] += gl[r] * w0[0]; z[1] += gl[r] * w0[1]; z[2] += gl[r] * w0[2]; z[3] += gl[r] * w0[3]; z[4] += gl[r] * w1[0]; z[5] += gl[r] * w1[1]; z[6] += gl[r] * w1[2]; z[7] += gl[r] * w1[3]; }
#pragma unroll
        for (int j = 0; j < 8; ++j) z[j] = (fminf(z[j], 0.f) - log1pf(__expf(-fabsf(z[j])))) * (1.f / 16.f);
        *(LAS f32x4*)(LG + c * 64 + 8 * dg) = (f32x4){z[0], z[1], z[2], z[3]}; *(LAS f32x4*)(LG + c * 64 + 8 * dg + 4) = (f32x4){z[4], z[5], z[6], z[7]};
    }
    __syncthreads();
    const int seg = tid >> 6, d = tid & 63; float v[8];
#pragma unroll
    for (int i = 0; i < 8; ++i) v[i] = LG[(8 * seg + i) * 64 + d];
#pragma unroll
    for (int i = 1; i < 8; ++i) v[i] += v[i - 1];
    SEG[seg * 64 + d] = v[7];
    __syncthreads();
    float off = 0.f;
#pragma unroll
    for (int s2 = 0; s2 < 8; ++s2) if (s2 < seg) off += SEG[s2 * 64 + d];
#pragma unroll
    for (int i = 0; i < 8; ++i) { const float bv = v[i] + off; LG[(8 * seg + i) * 64 + d] = bv; lgc[(8 * seg + i) * 64 + d] = bv; }
    __syncthreads();
}
__device__ __forceinline__ unsigned short f2bf_s(float f) { return (unsigned short)(cvtpk_s(f, 0.f) & 0xffffu); }
__device__ __forceinline__ void gla_stage_vt(const u32x4 a, const u32x4 b2, LAS unsigned char* lds) {
    const int tid = threadIdx.x, c = tid >> 3, d0 = (tid & 7) * 16;
#pragma unroll
    for (int j = 0; j < 4; ++j) {
        *(LAS unsigned short*)(lds + GL_VT + (d0 + 2 * j) * GROWB + c * 2) = (unsigned short)(a[j] & 0xffffu); *(LAS unsigned short*)(lds + GL_VT + (d0 + 2 * j + 1) * GROWB + c * 2) = (unsigned short)(a[j] >> 16);
        *(LAS unsigned short*)(lds + GL_VT + (d0 + 8 + 2 * j) * GROWB + c * 2) = (unsigned short)(b2[j] & 0xffffu); *(LAS unsigned short*)(lds + GL_VT + (d0 + 8 + 2 * j + 1) * GROWB + c * 2) = (unsigned short)(b2[j] >> 16); }
}
__device__ __forceinline__ void p3b_item(int it, const float* wg, const float* bg, float* UT, float* LGC, unsigned char* ws, LAS unsigned char* lds) {
    const int tid = threadIdx.x, lane = tid & 63, wave = tid >> 6, fr = lane & 15, fq = lane >> 4;
    const int bh = it >> 6, n = it & 63, b = bh >> 2, h = bh & 3; const size_t r0 = (size_t)b * NS + 64 * n;
    const int c_ = tid >> 3, dg_ = tid & 7;
    const bf16_t* gp_ = (const bf16_t*)(ws + WS_GLR) + (r0 + c_) * 16; const u32x4 g0 = *(const u32x4*)gp_, g1 = *(const u32x4*)(gp_ + 8);
    const u32x4 kraw = *(const u32x4*)((const bf16_t*)(ws + WS_GQK) + (r0 + c_) * 512 + 256 + h * 64 + 8 * dg_);
    const bf16_t* vp_ = (const bf16_t*)(ws + WS_GV) + (r0 + c_) * 512 + h * 128 + dg_ * 16; const u32x4 va_ = *(const u32x4*)vp_, vb_ = *(const u32x4*)(vp_ + 8);
    __syncthreads();
    gla_cumdecay(g0, g1, h, wg, bg, lds, LGC + (size_t)it * 4096);
    const LAS float* LG = (const LAS float*)(lds + GL_LG);
    {   const int c = tid >> 3, dg = tid & 7; float kf[8]; bf8_to_f(kraw, kf);
#pragma unroll
        for (int j = 0; j < 8; ++j) { const int d = 8 * dg + j; *(LAS unsigned short*)(lds + GL_A + d * GROWB + c * 2) = f2bf_s(kf[j] * __expf(LG[63 * 64 + d] - LG[c * 64 + d])); }
        if (tid < 64) ((float*)(ws + WS_MISC))[(size_t)it * 64 + tid] = __expf(LG[63 * 64 + tid]);
    }
    gla_stage_vt(va_, vb_, lds);
    __syncthreads();
    f32x4 acc[4];
#pragma unroll
    for (int i = 0; i < 4; ++i) acc[i] = (f32x4){0.f, 0.f, 0.f, 0.f};
#pragma unroll
    for (int ks = 0; ks < 2; ++ks) { const bf16x8 bv = *(const LAS bf16x8*)(lds + GL_VT + (16 * wave + fr) * GROWB + (32 * ks + 8 * fq) * 2);
#pragma unroll
        for (int i = 0; i < 4; ++i) { const bf16x8 av = *(const LAS bf16x8*)(lds + GL_A + (16 * i + fr) * GROWB + (32 * ks + 8 * fq) * 2); acc[i] = __builtin_amdgcn_mfma_f32_16x16x32_bf16(av, bv, acc[i], 0, 0, 0); } }
#pragma unroll
    for (int i = 0; i < 4; ++i) *(f32x4*)(UT + ((size_t)it * 128 + 16 * wave + fr) * 64 + 16 * i + 4 * fq) = acc[i];
}
__device__ __forceinline__ void p4b_item(int j, const float* UT, bf16_t* SP, unsigned char* ws) {
    const int tid = threadIdx.x, bh = j >> 3, dv = (j & 7) * 16 + (tid >> 5), dk = (tid & 31) * 2; const float* DEC = (const float*)(ws + WS_MISC);
    typedef float f32x2v __attribute__((ext_vector_type(2)));
    f32x2v st = (f32x2v){0.f, 0.f};
#pragma unroll 8
    for (int n = 0; n < 64; ++n) { const size_t it = (size_t)bh * 64 + n; const size_t o = (it * 128 + dv) * 64 + dk;
        *(unsigned*)(SP + o) = cvtpk_s(st[0], st[1]);
        const f32x2v u = *(const f32x2v*)(UT + o), dc = *(const f32x2v*)(DEC + it * 64 + dk); st = dc * st + u; }
}
__device__ __forceinline__ void p5b_item(int it, const float* LGC, const float* ng, const bf16_t* SP, unsigned char* ws, LAS unsigned char* lds) {
    const int tid = threadIdx.x, lane = tid & 63, wave = tid >> 6, r32 = lane & 31, hh = lane >> 5;
    const int bh = it >> 6, n = it & 63, b = bh >> 2, h = bh & 3; const size_t r0 = (size_t)b * NS + 64 * n;
    const int c_ = tid >> 3, dg_ = tid & 7; const int dvb = wave >> 1, cb = wave & 1;
    const f32x4 lg0 = *(const f32x4*)(LGC + (size_t)it * 4096 + c_ * 64 + 8 * dg_), lg1 = *(const f32x4*)(LGC + (size_t)it * 4096 + c_ * 64 + 8 * dg_ + 4);
    const bf16_t* qp_ = (const bf16_t*)(ws + WS_GQK) + (r0 + c_) * 512 + h * 64 + 8 * dg_; const u32x4 qraw = *(const u32x4*)qp_, kraw = *(const u32x4*)(qp_ + 256);
    const bf16_t* vp_ = (const bf16_t*)(ws + WS_GV) + (r0 + c_) * 512 + h * 128 + dg_ * 16; const u32x4 va_ = *(const u32x4*)vp_, vb_ = *(const u32x4*)(vp_ + 8);
    bf16x8 spf[4];
#pragma unroll
    for (int ks = 0; ks < 4; ++ks) spf[ks] = *(const bf16x8*)(SP + ((size_t)it * 128 + 32 * dvb + r32) * 64 + 16 * ks + 8 * hh);
    const size_t trow = r0 + 32 * cb + r32; const int dvbase = h * 128 + 32 * dvb + 4 * hh;
    const bf16_t* grp = (const bf16_t*)(ws + WS_GR) + trow * 512 + dvbase; u32x2 grw[4];
#pragma unroll
    for (int g = 0; g < 4; ++g) grw[g] = *(const u32x2*)(grp + 8 * g);
    __syncthreads();
    { LAS float* LGw = (LAS float*)(lds + GL_LG); *(LAS f32x4*)(LGw + c_ * 64 + 8 * dg_) = lg0; *(LAS f32x4*)(LGw + c_ * 64 + 8 * dg_ + 4) = lg1; }
    __syncthreads();
    const LAS float* LG = (const LAS float*)(lds + GL_LG);
    {   const int c = tid >> 3, dg = tid & 7; float qf[8], kf[8]; bf8_to_f(qraw, qf); bf8_to_f(kraw, kf);
        float qr[8], ks[8], qi[8];
#pragma unroll
        for (int j = 0; j < 8; ++j) { const int d = 8 * dg + j; const float bc = LG[c * 64 + d], bl = LG[63 * 64 + d]; const float q8 = qf[j] * 0.125f;
            qr[j] = q8 * __expf(bc - bl); ks[j] = kf[j] * __expf(bl - bc); qi[j] = q8 * __expf(bc); }
        u32x4 w;
        w.x = cvtpk_s(qr[0], qr[1]); w.y = cvtpk_s(qr[2], qr[3]); w.z = cvtpk_s(qr[4], qr[5]); w.w = cvtpk_s(qr[6], qr[7]); *(LAS u32x4*)(lds + GL_A + c * GROWB + 16 * dg) = w;
        w.x = cvtpk_s(ks[0], ks[1]); w.y = cvtpk_s(ks[2], ks[3]); w.z = cvtpk_s(ks[4], ks[5]); w.w = cvtpk_s(ks[6], ks[7]); *(LAS u32x4*)(lds + GL_B + c * GROWB + 16 * dg) = w;
        w.x = cvtpk_s(qi[0], qi[1]); w.y = cvtpk_s(qi[2], qi[3]); w.z = cvtpk_s(qi[4], qi[5]); w.w = cvtpk_s(qi[6], qi[7]); *(LAS u32x4*)(lds + GL_C + c * GROWB + 16 * dg) = w;
    }
    gla_stage_vt(va_, vb_, lds);
    __syncthreads();
    f32x16 o;
#pragma unroll
    for (int i = 0; i < 16; ++i) o[i] = 0.f;
#pragma unroll
    for (int jb = 0; jb < 2; ++jb) if (jb <= cb) {
        f32x16 at;
#pragma unroll
        for (int i = 0; i < 16; ++i) at[i] = 0.f;
#pragma unroll
        for (int ks = 0; ks < 4; ++ks) { const bf16x8 av = *(const LAS bf16x8*)(lds + GL_B + (32 * jb + r32) * GROWB + 32 * ks + 16 * hh), bv = *(const LAS bf16x8*)(lds + GL_A + (32 * cb + r32) * GROWB + 32 * ks + 16 * hh);
            at = __builtin_amdgcn_mfma_f32_32x32x16_bf16(av, bv, at, 0, 0, 0); }
        if (jb == cb) {
#pragma unroll
            for (int i = 0; i < 16; ++i) if (crow(i, hh) > r32) at[i] = 0.f; }
#pragma unroll
        for (int s = 0; s < 2; ++s) {
            u32x4 pw; pw.x = cvtpk_s(at[8 * s], at[8 * s + 1]); pw.y = cvtpk_s(at[8 * s + 2], at[8 * s + 3]); pw.z = cvtpk_s(at[8 * s + 4], at[8 * s + 5]); pw.w = cvtpk_s(at[8 * s + 6], at[8 * s + 7]);
            const LAS unsigned char* vp = lds + GL_VT + (32 * dvb + r32) * GROWB + (32 * jb + 16 * s + 4 * hh) * 2;
            const u32x2 lo = *(const LAS u32x2*)vp, hi = *(const LAS u32x2*)(vp + 16);
            const u32x4 va = (u32x4){lo.x, lo.y, hi.x, hi.y};
            o = __builtin_amdgcn_mfma_f32_32x32x16_bf16(__builtin_bit_cast(bf16x8, va), __builtin_bit_cast(bf16x8, pw), o, 0, 0, 0);
        }
    }
#pragma unroll
    for (int ks = 0; ks < 4; ++ks) { const bf16x8 bv = *(const LAS bf16x8*)(lds + GL_C + (32 * cb + r32) * GROWB + 32 * ks + 16 * hh);
        o = __builtin_amdgcn_mfma_f32_32x32x16_bf16(spf[ks], bv, o, 0, 0, 0); }
    LAS float* ST = (LAS float*)(lds + GL_ST);
    float sm = 0.f;
#pragma unroll
    for (int i = 0; i < 16; ++i) sm += o[i];
    sm += __shfl_xor(sm, 32);
    if (hh == 0) ST[dvb * 64 + 32 * cb + r32] = sm;
    __syncthreads();
    const float mean = (ST[32 * cb + r32] + ST[64 + 32 * cb + r32] + ST[128 + 32 * cb + r32] + ST[192 + 32 * cb + r32]) * (1.f / 128.f);
    float sq = 0.f;
#pragma unroll
    for (int i = 0; i < 16; ++i) { o[i] -= mean; sq += o[i] * o[i]; }
    sq += __shfl_xor(sq, 32);
    if (hh == 0) ST[256 + dvb * 64 + 32 * cb + r32] = sq;
    __syncthreads();
    const float var = (ST[256 + 32 * cb + r32] + ST[256 + 64 + 32 * cb + r32] + ST[256 + 128 + 32 * cb + r32] + ST[256 + 192 + 32 * cb + r32]) * (1.f / 128.f);
    const float rstd = 1.f / sqrtf(var + LN_EPS);
    bf16_t* op = (bf16_t*)(ws + WS_OAB) + trow * 1024 + 512 + dvbase;
#pragma unroll
    for (int g = 0; g < 4; ++g) { const u32x2 gw = grw[g]; const f32x4 nv = *(const f32x4*)(ng + dvbase + 8 * g);
        float gr[4] = {__uint_as_float(gw.x << 16), __uint_as_float(gw.x & 0xffff0000u), __uint_as_float(gw.y << 16), __uint_as_float(gw.y & 0xffff0000u)}; float y[4];
#pragma unroll
        for (int e = 0; e < 4; ++e) y[e] = o[4 * g + e] * rstd * nv[e] * (gr[e] * __builtin_amdgcn_rcpf(1.f + __expf(-gr[e])));
        u32x2 w; w.x = cvtpk_s(y[0], y[1]); w.y = cvtpk_s(y[2], y[3]); *(u32x2*)(op + 8 * g) = w; }
}

constexpr int GL_HALF = 67584;
__device__ __forceinline__ void gla_cumdecay2(size_t r0, int h, const bf16_t* WGT, const float* bg, unsigned char* ws, LAS unsigned char* ldh, float* lgc) {
    const int tl = threadIdx.x & 255, lane = threadIdx.x & 63, wl = (threadIdx.x >> 6) & 3, r32 = lane & 31, hh = lane >> 5; LAS float* LG = (LAS float*)(ldh + GL_LG); LAS float* SEG = (LAS float*)(ldh + GL_SEG);
    {   const int cb = wl >> 1, db = wl & 1;
        const bf16x8 af = *(const bf16x8*)((const bf16_t*)(ws + WS_GLR) + (r0 + 32 * cb + r32) * 16 + 8 * hh), bfr = *(const bf16x8*)(WGT + (size_t)(h * 64 + 32 * db + r32) * 16 + 8 * hh);
        const float bias = bg[h * 64 + 32 * db + r32]; f32x16 z;
#pragma unroll
        for (int i = 0; i < 16; ++i) z[i] = bias;
        z = __builtin_amdgcn_mfma_f32_32x32x16_bf16(af, bfr, z, 0, 0, 0);
#pragma unroll
        for (int i = 0; i < 16; ++i) { const float zz = z[i]; LG[(32 * cb + crow(i, hh)) * 64 + 32 * db + r32] = (fminf(zz, 0.f) - __logf(1.f + __expf(-fabsf(zz)))) * (1.f / 16.f); }
    }
    __syncthreads();
    const int seg = tl >> 6, d = tl & 63; float v[16];
#pragma unroll
    for (int i = 0; i < 16; ++i) v[i] = LG[(16 * seg + i) * 64 + d];
#pragma unroll
    for (int i = 1; i < 16; ++i) v[i] += v[i - 1];
    SEG[seg * 64 + d] = v[15];
    __syncthreads();
    float off = 0.f;
#pragma unroll
    for (int s2 = 0; s2 < 4; ++s2) if (s2 < seg) off += SEG[s2 * 64 + d];
#pragma unroll
    for (int i = 0; i < 16; ++i) { const float bv = v[i] + off; LG[(16 * seg + i) * 64 + d] = bv; lgc[(16 * seg + i) * 64 + d] = bv; }
    __syncthreads();
}
__device__ __forceinline__ void gla_stage_vt2(const u32x4 (&vv)[4], LAS unsigned char* ldh) {
    const int tl = threadIdx.x & 255, c = tl >> 2, d0 = (tl & 3) * 32;
#pragma unroll
    for (int k = 0; k < 4; ++k)
#pragma unroll
        for (int j = 0; j < 4; ++j) {
            *(LAS unsigned short*)(ldh + GL_VT + (d0 + 8 * k + 2 * j) * GROWB + c * 2) = (unsigned short)(vv[k][j] & 0xffffu);
            *(LAS unsigned short*)(ldh + GL_VT + (d0 + 8 * k + 2 * j + 1) * GROWB + c * 2) = (unsigned short)(vv[k][j] >> 16); }
}
__device__ __forceinline__ void p3b_pair(int p, const float* wg, const float* bg, float* UT, float* LGC, unsigned char* ws, LAS unsigned char* lds) {
    const int tid = threadIdx.x, hb = tid >> 8, tl = tid & 255, lane = tid & 63, wl = (tid >> 6) & 3, fr = lane & 15, fq = lane >> 4;
    const int it = 2 * p + hb; LAS unsigned char* ldh = lds + hb * GL_HALF;
    const int bh = it >> 6, n = it & 63, b = bh >> 2, h = bh & 3; const size_t r0 = (size_t)b * NS + 64 * n;
    const int c_ = tl >> 2, dq_ = tl & 3;
    const bf16_t* kp_ = (const bf16_t*)(ws + WS_GQK) + (r0 + c_) * 512 + 256 + h * 64 + 16 * dq_; const u32x4 k0 = *(const u32x4*)kp_, k1 = *(const u32x4*)(kp_ + 8);
    const bf16_t* vp_ = (const bf16_t*)(ws + WS_GV) + (r0 + c_) * 512 + h * 128 + 32 * dq_; u32x4 vv[4];
#pragma unroll
    for (int k = 0; k < 4; ++k) vv[k] = *(const u32x4*)(vp_ + 8 * k);
    __syncthreads();
    gla_cumdecay2(r0, h, (const bf16_t*)(ws + WS_WGT), bg, ws, ldh, LGC + (size_t)it * 4096);
    const LAS float* LG = (const LAS float*)(ldh + GL_LG);
    {   float kf[16]; bf8_to_f(k0, kf); bf8_to_f(k1, kf + 8);
#pragma unroll
        for (int j = 0; j < 16; ++j) { const int d = 16 * dq_ + j; *(LAS unsigned short*)(ldh + GL_A + d * GROWB + c_ * 2) = f2bf_s(kf[j] * __expf(LG[63 * 64 + d] - LG[c_ * 64 + d])); }
        if (tl < 64) ((float*)(ws + WS_MISC))[(size_t)it * 64 + tl] = __expf(LG[63 * 64 + tl]);
    }
    gla_stage_vt2(vv, ldh);
    __syncthreads();
#pragma unroll
    for (int dvi = 0; dvi < 2; ++dvi) {
        const int dvblk = 2 * wl + dvi;
        f32x4 acc[4];
#pragma unroll
        for (int i = 0; i < 4; ++i) acc[i] = (f32x4){0.f, 0.f, 0.f, 0.f};
#pragma unroll
        for (int ks = 0; ks < 2; ++ks) { const bf16x8 bv = *(const LAS bf16x8*)(ldh + GL_VT + (16 * dvblk + fr) * GROWB + (32 * ks + 8 * fq) * 2);
#pragma unroll
            for (int i = 0; i < 4; ++i) { const bf16x8 av = *(const LAS bf16x8*)(ldh + GL_A + (16 * i + fr) * GROWB + (32 * ks + 8 * fq) * 2); acc[i] = __builtin_amdgcn_mfma_f32_16x16x32_bf16(av, bv, acc[i], 0, 0, 0); } }
#pragma unroll
        for (int i = 0; i < 4; ++i) *(f32x4*)(UT + ((size_t)it * 128 + 16 * dvblk + fr) * 64 + 16 * i + 4 * fq) = acc[i];
    }
}
__device__ __forceinline__ void p5b_pair(int p, const float* LGC, const float* ng, const bf16_t* SP, unsigned char* ws, LAS unsigned char* lds) {
    const int tid = threadIdx.x, hb = tid >> 8, tl = tid & 255, lane = tid & 63, wl = (tid >> 6) & 3, r32 = lane & 31, hh = lane >> 5;
    const int it = 2 * p + hb; LAS unsigned char* ldh = lds + hb * GL_HALF;
    const int bh = it >> 6, n = it & 63, b = bh >> 2, h = bh & 3; const size_t r0 = (size_t)b * NS + 64 * n;
    const int c_ = tl >> 2, dq_ = tl & 3; const int dvb = wl;
    f32x4 lg[4];
#pragma unroll
    for (int k = 0; k < 4; ++k) lg[k] = *(const f32x4*)(LGC + (size_t)it * 4096 + c_ * 64 + 16 * dq_ + 4 * k);
    const bf16_t* qp_ = (const bf16_t*)(ws + WS_GQK) + (r0 + c_) * 512 + h * 64 + 16 * dq_; const u32x4 q0 = *(const u32x4*)qp_, q1 = *(const u32x4*)(qp_ + 8), k0 = *(const u32x4*)(qp_ + 256), k1 = *(const u32x4*)(qp_ + 264);
    const bf16_t* vp_ = (const bf16_t*)(ws + WS_GV) + (r0 + c_) * 512 + h * 128 + 32 * dq_; u32x4 vv[4];
#pragma unroll
    for (int k = 0; k < 4; ++k) vv[k] = *(const u32x4*)(vp_ + 8 * k);
    bf16x8 spf[4];
#pragma unroll
    for (int ks = 0; ks < 4; ++ks) spf[ks] = *(const bf16x8*)(SP + ((size_t)it * 128 + 32 * dvb + r32) * 64 + 16 * ks + 8 * hh);
    const int dvbase = h * 128 + 32 * dvb + 4 * hh; u32x2 grw[2][4];
#pragma unroll
    for (int cb = 0; cb < 2; ++cb)
#pragma unroll
        for (int g = 0; g < 4; ++g) grw[cb][g] = *(const u32x2*)((const bf16_t*)(ws + WS_GR) + (r0 + 32 * cb + r32) * 512 + dvbase + 8 * g);
    __syncthreads();
    { LAS float* LGw = (LAS float*)(ldh + GL_LG);
#pragma unroll
      for (int k = 0; k < 4; ++k) *(LAS f32x4*)(LGw + c_ * 64 + 16 * dq_ + 4 * k) = lg[k]; }
    __syncthreads();
    const LAS float* LG = (const LAS float*)(ldh + GL_LG);
    {   float qf[16], kf[16]; bf8_to_f(q0, qf); bf8_to_f(q1, qf + 8); bf8_to_f(k0, kf); bf8_to_f(k1, kf + 8);
        float qr[16], ks[16], qi[16];
#pragma unroll
        for (int j = 0; j < 16; ++j) { const int d = 16 * dq_ + j; const float bc = LG[c_ * 64 + d], bl = LG[63 * 64 + d]; const float q8 = qf[j] * 0.125f;
            qr[j] = q8 * __expf(bc - bl); ks[j] = kf[j] * __expf(bl - bc); qi[j] = q8 * __expf(bc); }
#pragma unroll
        for (int k = 0; k < 2; ++k) { u32x4 w;
            w.x = cvtpk_s(qr[8 * k], qr[8 * k + 1]); w.y = cvtpk_s(qr[8 * k + 2], qr[8 * k + 3]); w.z = cvtpk_s(qr[8 * k + 4], qr[8 * k + 5]); w.w = cvtpk_s(qr[8 * k + 6], qr[8 * k + 7]); *(LAS u32x4*)(ldh + GL_A + c_ * GROWB + 32 * dq_ + 16 * k) = w;
            w.x = cvtpk_s(ks[8 * k], ks[8 * k + 1]); w.y = cvtpk_s(ks[8 * k + 2], ks[8 * k + 3]); w.z = cvtpk_s(ks[8 * k + 4], ks[8 * k + 5]); w.w = cvtpk_s(ks[8 * k + 6], ks[8 * k + 7]); *(LAS u32x4*)(ldh + GL_B + c_ * GROWB + 32 * dq_ + 16 * k) = w;
            w.x = cvtpk_s(qi[8 * k], qi[8 * k + 1]); w.y = cvtpk_s(qi[8 * k + 2], qi[8 * k + 3]); w.z = cvtpk_s(qi[8 * k + 4], qi[8 * k + 5]); w.w = cvtpk_s(qi[8 * k + 6], qi[8 * k + 7]); *(LAS u32x4*)(ldh + GL_C + c_ * GROWB + 32 * dq_ + 16 * k) = w; }
    }
    gla_stage_vt2(vv, ldh);
    __syncthreads();
    f32x16 o[2];
#pragma unroll
    for (int cb = 0; cb < 2; ++cb) {
#pragma unroll
        for (int i = 0; i < 16; ++i) o[cb][i] = 0.f;
#pragma unroll
        for (int jb = 0; jb < 2; ++jb) if (jb <= cb) {
            f32x16 at;
#pragma unroll
            for (int i = 0; i < 16; ++i) at[i] = 0.f;
#pragma unroll
            for (int ks = 0; ks < 4; ++ks) { const bf16x8 av = *(const LAS bf16x8*)(ldh + GL_B + (32 * jb + r32) * GROWB + 32 * ks + 16 * hh), bv = *(const LAS bf16x8*)(ldh + GL_A + (32 * cb + r32) * GROWB + 32 * ks + 16 * hh);
                at = __builtin_amdgcn_mfma_f32_32x32x16_bf16(av, bv, at, 0, 0, 0); }
            if (jb == cb) {
#pragma unroll
                for (int i = 0; i < 16; ++i) if (crow(i, hh) > r32) at[i] = 0.f; }
#pragma unroll
            for (int s2 = 0; s2 < 2; ++s2) {
                u32x4 pw; pw.x = cvtpk_s(at[8 * s2], at[8 * s2 + 1]); pw.y = cvtpk_s(at[8 * s2 + 2], at[8 * s2 + 3]); pw.z = cvtpk_s(at[8 * s2 + 4], at[8 * s2 + 5]); pw.w = cvtpk_s(at[8 * s2 + 6], at[8 * s2 + 7]);
                const LAS unsigned char* vp = ldh + GL_VT + (32 * dvb + r32) * GROWB + (32 * jb + 16 * s2 + 4 * hh) * 2;
                const u32x2 lo = *(const LAS u32x2*)vp, hi = *(const LAS u32x2*)(vp + 16);
                const u32x4 va = (u32x4){lo.x, lo.y, hi.x, hi.y};
                o[cb] = __builtin_amdgcn_mfma_f32_32x32x16_bf16(__builtin_bit_cast(bf16x8, va), __builtin_bit_cast(bf16x8, pw), o[cb], 0, 0, 0);
            }
        }
#pragma unroll
        for (int ks = 0; ks < 4; ++ks) { const bf16x8 bv = *(const LAS bf16x8*)(ldh + GL_C + (32 * cb + r32) * GROWB + 32 * ks + 16 * hh);
            o[cb] = __builtin_amdgcn_mfma_f32_32x32x16_bf16(spf[ks], bv, o[cb], 0, 0, 0); }
    }
    LAS float* ST = (LAS float*)(ldh + GL_ST);
#pragma unroll
    for (int cb = 0; cb < 2; ++cb) { float sm = 0.f;
#pragma unroll
        for (int i = 0; i < 16; ++i) sm += o[cb][i];
        sm += __shfl_xor(sm, 32);
        if (hh == 0) ST[dvb * 64 + 32 * cb + r32] = sm; }
    __syncthreads();
    float mean[2];
#pragma unroll
    for (int cb = 0; cb < 2; ++cb) { const int cc = 32 * cb + r32; mean[cb] = (ST[cc] + ST[64 + cc] + ST[128 + cc] + ST[192 + cc]) * (1.f / 128.f); float sq = 0.f;
#pragma unroll
        for (int i = 0; i < 16; ++i) { o[cb][i] -= mean[cb]; sq += o[cb][i] * o[cb][i]; }
        sq += __shfl_xor(sq, 32);
        if (hh == 0) ST[256 + dvb * 64 + cc] = sq; }
    __syncthreads();
#pragma unroll
    for (int cb = 0; cb < 2; ++cb) { const int cc = 32 * cb + r32; const float var = (ST[256 + cc] + ST[256 + 64 + cc] + ST[256 + 128 + cc] + ST[256 + 192 + cc]) * (1.f / 128.f);
        const float rstd = 1.f / sqrtf(var + LN_EPS);
        bf16_t* op = (bf16_t*)(ws + WS_OAB) + (r0 + cc) * 1024 + 512 + dvbase;
#pragma unroll
        for (int g = 0; g < 4; ++g) { const u32x2 gw = grw[cb][g]; const f32x4 nv = *(const f32x4*)(ng + dvbase + 8 * g);
            float gr[4] = {__uint_as_float(gw.x << 16), __uint_as_float(gw.x & 0xffff0000u), __uint_as_float(gw.y << 16), __uint_as_float(gw.y & 0xffff0000u)}; float y[4];
#pragma unroll
            for (int e = 0; e < 4; ++e) y[e] = o[cb][4 * g + e] * rstd * nv[e] * (gr[e] * __builtin_amdgcn_rcpf(1.f + __expf(-gr[e])));
            u32x2 w; w.x = cvtpk_s(y[0], y[1]); w.y = cvtpk_s(y[2], y[3]); *(u32x2*)(op + 8 * g) = w; } }
}

constexpr size_t WS_SG = 129 * MiB;
constexpr size_t WS_MRG = 257 * MiB;
constexpr size_t WS_H2 = WS_XN;
constexpr size_t WS_XG = 129 * MiB;
constexpr size_t WS_HID = 321 * MiB;
constexpr size_t WS_YG = 358 * MiB;
constexpr size_t WS_EID = WS_MISC + 1 * MiB, WS_EW = WS_EID + 256 * 1024, WS_POS = WS_EW + 256 * 1024, WS_ST1 = WS_POS + 256 * 1024;
constexpr size_t WS_LIST = 490 * MiB;
constexpr int LDS_TAB = 131072;
__device__ __forceinline__ u32x4 pack8(const f32x4 a, const f32x4 b) { u32x4 w; w.x = cvtpk_s(a[0], a[1]); w.y = cvtpk_s(a[2], a[3]); w.z = cvtpk_s(b[0], b[1]); w.w = cvtpk_s(b[2], b[3]); return w; }
__device__ __forceinline__ f32x4 sig4(const f32x4 v) { f32x4 r; r[0] = __builtin_amdgcn_rcpf(1.f + __expf(-v[0])); r[1] = __builtin_amdgcn_rcpf(1.f + __expf(-v[1])); r[2] = __builtin_amdgcn_rcpf(1.f + __expf(-v[2])); r[3] = __builtin_amdgcn_rcpf(1.f + __expf(-v[3])); return r; }
__device__ __forceinline__ void unpack8(const u32x4 w, f32x4& a, f32x4& b) {
    a[0] = __uint_as_float(w.x << 16); a[1] = __uint_as_float(w.x & 0xffff0000u); a[2] = __uint_as_float(w.y << 16); a[3] = __uint_as_float(w.y & 0xffff0000u);
    b[0] = __uint_as_float(w.z << 16); b[1] = __uint_as_float(w.z & 0xffff0000u); b[2] = __uint_as_float(w.w << 16); b[3] = __uint_as_float(w.w & 0xffff0000u);
}
#define EPI_ROWS(...) _Pragma("unroll") for (int ai = 0; ai < 2; ++ai) _Pragma("unroll") for (int m = 0; m < 4; ++m) { const size_t row = (size_t)(row0 + ai * 128 + m * 16); _Pragma("unroll") for (int bj = 0; bj < 2; ++bj) { __VA_ARGS__ } }
struct EpiSig {
    static constexpr bool PERM = true, AFTER_DRAIN = false, MID = false; unsigned char* ws; int half;
    __device__ __forceinline__ void operator()(const f32x4 (&acc)[2][2][4][2], const Unit& u, int wr, int wc, int fr, int fq) const {
        const int row0 = u.pm * 256 + wr * 64 + fr, col0 = half * 1024 + u.pn * 256 + wc * 32 + 8 * fq; bf16_t* SG = (bf16_t*)(ws + WS_SG);
        EPI_ROWS( *(u32x4*)(SG + row * 2048 + col0 + bj * 128) = pack8(sig4(acc[ai][bj][m][0]), sig4(acc[ai][bj][m][1])); )
    }
};
struct EpiMrgF {
    static constexpr bool PERM = true, AFTER_DRAIN = false, MID = true; unsigned char* ws;
    __device__ __forceinline__ void mid(f32x4 (&acc)[2][2][4][2], const Unit& u, int wr, int wc, int fr, int fq) const {
        const int row0 = u.pm * 256 + wr * 64 + fr, col0 = u.pn * 256 + wc * 32 + 8 * fq; const bf16_t* SG = (const bf16_t*)(ws + WS_SG);
        const bf16_t* p = SG + (size_t)row0 * 2048 + col0;
#pragma unroll
        for (int ai = 0; ai < 2; ++ai)
#pragma unroll
            for (int m = 0; m < 4; ++m) {
                asm volatile("" : "+v"(p));
#pragma unroll
                for (int bj = 0; bj < 2; ++bj) { f32x4 a0, a1, b0, b1; unpack8(*(const u32x4*)(p + bj * 128), a0, a1); unpack8(*(const u32x4*)(p + 1024 + bj * 128), b0, b1);
#pragma unroll
                    for (int e = 0; e < 4; ++e) { acc[ai][bj][m][0][e] *= a0[e] * __builtin_amdgcn_rcpf(fmaxf(b0[e], 1e-30f)); acc[ai][bj][m][1][e] *= a1[e] * __builtin_amdgcn_rcpf(fmaxf(b1[e], 1e-30f)); } }
                p += (m == 3 ? (128 - 48) : 16) * 2048; }
    }
    __device__ __forceinline__ void operator()(const f32x4 (&acc)[2][2][4][2], const Unit& u, int wr, int wc, int fr, int fq) const {
        const int row0 = u.pm * 256 + wr * 64 + fr, col0 = u.pn * 256 + wc * 32 + 8 * fq; const bf16_t* SG = (const bf16_t*)(ws + WS_SG) + 1024; bf16_t* MR = (bf16_t*)(ws + WS_MRG);
        EPI_ROWS( f32x4 g0, g1; unpack8(*(const u32x4*)(SG + row * 2048 + col0 + bj * 128), g0, g1); *(u32x4*)(MR + row * 1024 + col0 + bj * 128) = pack8(g0 * acc[ai][bj][m][0], g1 * acc[ai][bj][m][1]); )
    }
};
struct EpiV {
    static constexpr bool PERM = false, AFTER_DRAIN = false, MID = false; const float* x; const float* ada; float* out;
    __device__ __forceinline__ void operator()(const f32x4 (&acc)[2][2][4][2], const Unit& u, int wr, int wc, int fr, int fq) const {
        const int row0 = u.pm * 256 + wr * 64 + fr, col0 = u.pn * 256 + wc * 32 + 4 * fq; const float* gt1 = ada + (size_t)(u.pm >> 4) * 6 * D_MODEL + 2 * D_MODEL;
        EPI_ROWS( _Pragma("unroll") for (int n = 0; n < 2; ++n) { const int c = col0 + bj * 128 + n * 16; const f32x4 xv = *(const f32x4*)(x + row * D_MODEL + c), gv = *(const f32x4*)(gt1 + c);
                  *(f32x4*)(out + row * D_MODEL + c) = xv * DN_ALPHA + gv * acc[ai][bj][m][n]; } )
    }
};
struct EpiHid {
    static constexpr bool PERM = true, AFTER_DRAIN = false, MID = false; unsigned char* ws;
    __device__ __forceinline__ void operator()(const f32x4 (&acc)[2][2][4][2], const Unit& u, int wr, int wc, int fr, int fq) const {
        const int row0 = u.pm * 256 + wr * 64 + fr, col0 = u.pn * 128 + wc * 32 + 8 * fq; bf16_t* H = (bf16_t*)(ws + WS_HID);
#pragma unroll
        for (int ai = 0; ai < 2; ++ai)
#pragma unroll
            for (int m = 0; m < 4; ++m) { const size_t row = (size_t)(row0 + ai * 128 + m * 16); f32x4 h0, h1;
#pragma unroll
                for (int e = 0; e < 4; ++e) { const float g0 = acc[ai][0][m][0][e], g1 = acc[ai][0][m][1][e]; h0[e] = g0 * __builtin_amdgcn_rcpf(1.f + __expf(-g0)) * acc[ai][1][m][0][e]; h1[e] = g1 * __builtin_amdgcn_rcpf(1.f + __expf(-g1)) * acc[ai][1][m][1][e]; }
                *(u32x4*)(H + row * 256 + col0) = pack8(h0, h1); }
    }
};
struct EpiY {
    static constexpr bool PERM = true, AFTER_DRAIN = false, MID = false; unsigned char* ws;
    __device__ __forceinline__ void operator()(const f32x4 (&acc)[2][2][4][2], const Unit& u, int wr, int wc, int fr, int fq) const {
        const int row0 = u.pm * 256 + wr * 64 + fr, col0 = u.pn * 256 + wc * 32 + 8 * fq; bf16_t* Y = (bf16_t*)(ws + WS_YG);
        EPI_ROWS( *(u32x4*)(Y + row * 1024 + col0 + bj * 128) = pack8(acc[ai][bj][m][0], acc[ai][bj][m][1]); )
    }
};
__device__ __forceinline__ void build_tables(unsigned char* ws, LAS unsigned char* lds) {
    LAS int* toff = (LAS int*)(lds + LDS_TAB); LAS int* texp = toff + 64; const unsigned* gcnt = (const unsigned*)(ws + WS_CNT);
    __syncthreads();
    if (threadIdx.x == 0) { int o = 0; for (int e = 0; e < N_EXP; ++e) { toff[e] = o; const int ce = (int)gcnt[e * 32]; toff[400 + e] = ce; o += (ce + 255) >> 8; } toff[32] = o; }
    __syncthreads();
    for (int tl = threadIdx.x; tl < toff[32]; tl += NTHREADS) { int e = 0; while (toff[e + 1] <= tl) ++e; texp[tl] = e; }
    __syncthreads();
}
template <int NPN> struct GroupOrder {
    const LAS int* toff; const LAS int* texp; int G, c;
    __device__ __forceinline__ bool next(int i, Unit& u) const { const int L = i * G + c; if (L >= toff[32] * NPN) return false; const int tl = L / NPN, pn = L % NPN; u.pm = tl; u.pa = tl; u.pn = pn; u.pb = texp[tl] * NPN + pn; return true; }
    __device__ __forceinline__ void a_ready(const Unit&) const {}
    __device__ __forceinline__ void done(const Unit&) const {}
    const int* list;
    __device__ __forceinline__ int a_row(const Unit& u, int r) const { const int e = texp[u.pa]; const int idx = (u.pa - toff[e]) * 256 + r; return idx < toff[400 + e] ? list[e * 32768 + idx] : 0; }
};
constexpr int WT_LD = 1028;
constexpr int P8_LCNT = 36 * WT_LD * 4;
__device__ __forceinline__ float dot16(const f32x4 (&v)[4], const LAS float* wp, int lane) {
    float p = 0.f;
#pragma unroll
    for (int j = 0; j < 4; ++j) { const f32x4 w4 = *(const LAS f32x4*)(wp + 256 * j + 4 * lane); p += (v[j].x * w4.x + v[j].y * w4.y) + (v[j].z * w4.z + v[j].w * w4.w); }
    return p;
}
__device__ __forceinline__ float rl4sum(float v) {
    return (__int_as_float(__builtin_amdgcn_readlane(__float_as_int(v), 0)) + __int_as_float(__builtin_amdgcn_readlane(__float_as_int(v), 16)))
         + (__int_as_float(__builtin_amdgcn_readlane(__float_as_int(v), 32)) + __int_as_float(__builtin_amdgcn_readlane(__float_as_int(v), 48)));
}
template <bool REAL> __device__ __forceinline__ void p8_phase(const float* const* in, float* out, float* x1dst, bf16_t* h2dst, unsigned char* ws, LAS unsigned char* lds, int G) {
    const int tid = threadIdx.x, lane = tid & 63, wave = tid >> 6;
    LAS float* WT = (LAS float*)lds;
    LAS int* lcnt = (LAS int*)(lds + P8_LCNT); LAS int* lbase = lcnt + 32; LAS int* ent = lcnt + 64;
    const float* wrg = in[14]; const float* wre = in[16];
    __syncthreads();
    for (int i = tid; i < 1024; i += NTHREADS) { const f32x4 w = *(const f32x4*)(wrg + 4 * i); WT[0 * WT_LD + i] = w.x; WT[1 * WT_LD + i] = w.y; WT[2 * WT_LD + i] = w.z; WT[3 * WT_LD + i] = w.w; }
    for (int i = tid; i < 8192; i += NTHREADS) { const f32x4 w = *(const f32x4*)(wre + 4 * i); const int k = i >> 3, c = 4 * (i & 7);
        WT[(4 + c) * WT_LD + k] = w.x; WT[(5 + c) * WT_LD + k] = w.y; WT[(6 + c) * WT_LD + k] = w.z; WT[(7 + c) * WT_LD + k] = w.w; }
    const float* g1 = in[12]; const float* b1 = in[13]; const float* brg = in[15]; const float* bre = in[17];
    for (int blk = blockIdx.x; blk < NT / 128; blk += G) {
        const int b = blk / 32; const float* ada = (const float*)(ws + WS_ADA) + (size_t)b * 6 * D_MODEL; const float* sh2 = ada + 3 * D_MODEL; const float* sc2 = ada + 4 * D_MODEL;
        if (tid < 32) lcnt[tid] = 0;
        __syncthreads();
        for (int rb = 0; rb < 16; rb += 4) {
            const int rl0 = wave * 16 + rb; const size_t row0 = (size_t)blk * 128 + rl0;
            f32x4 v[4][4];
#pragma unroll
            for (int r = 0; r < 4; ++r) { const f32x4* xr = (const f32x4*)(out + (row0 + r) * D_MODEL) + lane;
#pragma unroll
                for (int j = 0; j < 4; ++j) v[r][j] = xr[64 * j]; }
            float rstd[4], mean1[4]; ln_center<4>(v, rstd, mean1);
            if (REAL && lane < 4) { typedef float f32x2v __attribute__((ext_vector_type(2))); ((f32x2v*)(ws + WS_ST1))[row0 + lane] = (f32x2v){lane == 0 ? mean1[0] : lane == 1 ? mean1[1] : lane == 2 ? mean1[2] : mean1[3], lane == 0 ? rstd[0] : lane == 1 ? rstd[1] : lane == 2 ? rstd[2] : rstd[3]}; }
#pragma unroll
            for (int j = 0; j < 4; ++j) { const f32x4 gg = *(const f32x4*)(g1 + 256 * j + 4 * lane), bb = *(const f32x4*)(b1 + 256 * j + 4 * lane);
#pragma unroll
                for (int r = 0; r < 4; ++r) v[r][j] = v[r][j] * rstd[r] * gg + bb; }
            ln_center<4>(v, rstd);
#pragma unroll
            for (int j = 0; j < 4; ++j) { const f32x4 a4 = *(const f32x4*)(sc2 + 256 * j + 4 * lane) + 1.f, c4 = *(const f32x4*)(sh2 + 256 * j + 4 * lane);
#pragma unroll
                for (int r = 0; r < 4; ++r) { v[r][j] = v[r][j] * rstd[r] * a4 + c4; u32x2 w; w.x = cvtpk_s(v[r][j].x, v[r][j].y); w.y = cvtpk_s(v[r][j].z, v[r][j].w);
                    ((u32x2*)(h2dst + (row0 + r) * D_MODEL) + lane)[64 * j] = w; } }
#pragma unroll
            for (int r = 0; r < 4; ++r) {
                float gp[N_GROUPS];
#pragma unroll
                for (int g = 0; g < N_GROUPS; ++g) gp[g] = dpp_row_sum_f(dot16(v[r], WT + g * WT_LD, lane));
                float gl[N_GROUPS];
#pragma unroll
                for (int g = 0; g < N_GROUPS; ++g) gl[g] = rl4sum(gp[g]) + brg[g];
                int gi = 0; float gm = gl[0];
#pragma unroll
                for (int g = 1; g < N_GROUPS; ++g) if (gl[g] > gm) { gm = gl[g]; gi = g; }
                float gs = 0.f;
#pragma unroll
                for (int g = 0; g < N_GROUPS; ++g) gs += __expf(gl[g] - gm);
                const float gw = 1.f / gs;
                float ep[EPG];
#pragma unroll
                for (int e = 0; e < EPG; ++e) ep[e] = dpp_row_sum_f(dot16(v[r], WT + (4 + gi * EPG + e) * WT_LD, lane));
                float v0 = -INFINITY, v1 = -INFINITY; int i0 = 0, i1 = 0;
#pragma unroll
                for (int e = 0; e < EPG; ++e) { const float ev = rl4sum(ep[e]) + bre[gi * EPG + e];
                    if (ev > v0) { v1 = v0; i1 = i0; v0 = ev; i0 = e; } else if (ev > v1) { v1 = ev; i1 = e; } }
                const float e1 = __expf(v1 - v0); const float w0 = gw / (1.f + e1), w1 = gw * e1 / (1.f + e1);
                if (REAL && lane == 0) { const int ea = gi * EPG + i0, eb = gi * EPG + i1; const int rl = rl0 + r; const size_t row = row0 + r;
                    const int pa = atomicAdd((int*)&lcnt[ea], 1), pb = atomicAdd((int*)&lcnt[eb], 1);
                    ent[rl * 2] = (ea << 16) | pa; ent[rl * 2 + 1] = (eb << 16) | pb;
                    ((int*)(ws + WS_EID))[row * 2] = ea; ((int*)(ws + WS_EID))[row * 2 + 1] = eb; ((float*)(ws + WS_EW))[row * 2] = w0; ((float*)(ws + WS_EW))[row * 2 + 1] = w1; }
            }
        }
        __syncthreads();
        if (REAL && tid < 32) lbase[tid] = (int)atomicAdd((unsigned*)(ws + WS_CNT) + tid * 32, (unsigned)lcnt[tid]);
        __syncthreads();
        if (REAL && tid < 256) { const int en = ent[tid]; const int e = en >> 16, pos = lbase[e] + (en & 0xffff); ((int*)(ws + WS_POS))[(size_t)blk * 256 + tid] = pos; ((int*)(ws + WS_LIST))[e * 32768 + pos] = blk * 128 + (tid >> 1); }
        __syncthreads();
    }
}
__device__ __forceinline__ void p9_phase(unsigned char* ws, LAS unsigned char* lds, int G) {
    build_tables(ws, lds); const LAS int* toff = (const LAS int*)(lds + LDS_TAB);
    const int lane = threadIdx.x & 63, wave = threadIdx.x >> 6;
    for (int base = (blockIdx.x * NWAVES + wave) * 32; base < NT * 2; base += G * NWAVES * 32) {
        for (int k = 0; k < 32; k += 4) {
            const int ts0 = base + k; const int li = ts0 + (lane & 3);
            const int ev = ((const int*)(ws + WS_EID))[li], pv = ((const int*)(ws + WS_POS))[li];
            u32x4 d0[4], d1[4]; size_t dst[4];
#pragma unroll
            for (int r = 0; r < 4; ++r) { const int e = __builtin_amdgcn_readlane(ev, r), pos = __builtin_amdgcn_readlane(pv, r); dst[r] = (size_t)toff[e] * 256 + pos;
                const u32x4* sp = (const u32x4*)((const bf16_t*)(ws + WS_H2) + (size_t)((ts0 + r) >> 1) * D_MODEL); d0[r] = sp[lane]; d1[r] = sp[lane + 64]; }
#pragma unroll
            for (int r = 0; r < 4; ++r) { u32x4* dp = (u32x4*)((bf16_t*)(ws + WS_XG) + dst[r] * D_MODEL); dp[lane] = d0[r]; dp[lane + 64] = d1[r]; }
        }
    }
}
__device__ __forceinline__ void p12_phase(const float* const* in, float* out, float* dst, unsigned char* ws, LAS unsigned char* lds, int G) {
    build_tables(ws, lds); const LAS int* toff = (const LAS int*)(lds + LDS_TAB);
    const int lane = threadIdx.x & 63, wave = threadIdx.x >> 6; const float* g2 = in[21]; const float* b2 = in[22]; const float* g1 = in[12]; const float* b1 = in[13];
    for (int blk = blockIdx.x; blk < NT / 128; blk += G) {
        const int b = blk / 32; const float* gt2 = (const float*)(ws + WS_ADA) + (size_t)b * 6 * D_MODEL + 5 * D_MODEL;
        for (int rb = 0; rb < 16; rb += 4) {
            const size_t row0 = (size_t)blk * 128 + wave * 16 + rb;
            const size_t li = row0 * 2 + (lane & 7);
            const int ev = ((const int*)(ws + WS_EID))[li], pv = ((const int*)(ws + WS_POS))[li]; const float wv = ((const float*)(ws + WS_EW))[li];
            typedef float f32x2v __attribute__((ext_vector_type(2))); const f32x2v stv = ((const f32x2v*)(ws + WS_ST1))[row0 + (lane & 3)];
            f32x4 v[4][4]; u32x2 ya[4][4], yb[4][4]; float w0[4], w1[4], m1[4], r1[4];
#pragma unroll
            for (int r = 0; r < 4; ++r) {
                const int e0 = __builtin_amdgcn_readlane(ev, 2 * r), e1 = __builtin_amdgcn_readlane(ev, 2 * r + 1), p0 = __builtin_amdgcn_readlane(pv, 2 * r), p1 = __builtin_amdgcn_readlane(pv, 2 * r + 1);
                w0[r] = __int_as_float(__builtin_amdgcn_readlane(__float_as_int(wv), 2 * r)); w1[r] = __int_as_float(__builtin_amdgcn_readlane(__float_as_int(wv), 2 * r + 1));
                m1[r] = __int_as_float(__builtin_amdgcn_readlane(__float_as_int(stv.x), r)); r1[r] = __int_as_float(__builtin_amdgcn_readlane(__float_as_int(stv.y), r));
                const u32x2* y0 = (const u32x2*)((const bf16_t*)(ws + WS_YG) + ((size_t)toff[e0] * 256 + p0) * D_MODEL) + lane; const u32x2* y1 = (const u32x2*)((const bf16_t*)(ws + WS_YG) + ((size_t)toff[e1] * 256 + p1) * D_MODEL) + lane;
                const f32x4* xr = (const f32x4*)(out + (row0 + r) * D_MODEL) + lane;
#pragma unroll
                for (int j = 0; j < 4; ++j) { v[r][j] = xr[64 * j]; ya[r][j] = y0[64 * j]; yb[r][j] = y1[64 * j]; } }
#pragma unroll
            for (int j = 0; j < 4; ++j) { const f32x4 gv = *(const f32x4*)(gt2 + 256 * j + 4 * lane), g1v = *(const f32x4*)(g1 + 256 * j + 4 * lane), b1v = *(const f32x4*)(b1 + 256 * j + 4 * lane);
#pragma unroll
                for (int r = 0; r < 4; ++r) { const u32x2 a = ya[r][j], c = yb[r][j]; f32x4 f; v[r][j] = (v[r][j] - m1[r]) * r1[r] * g1v + b1v;
                    f.x = w0[r] * __uint_as_float(a.x << 16) + w1[r] * __uint_as_float(c.x << 16); f.y = w0[r] * __uint_as_float(a.x & 0xffff0000u) + w1[r] * __uint_as_float(c.x & 0xffff0000u);
                    f.z = w0[r] * __uint_as_float(a.y << 16) + w1[r] * __uint_as_float(c.y << 16); f.w = w0[r] * __uint_as_float(a.y & 0xffff0000u) + w1[r] * __uint_as_float(c.y & 0xffff0000u);
                    v[r][j] = v[r][j] * DN_ALPHA + gv * f; } }
            float rstd[4]; ln_center<4>(v, rstd);
#pragma unroll
            for (int j = 0; j < 4; ++j) { const f32x4 gg = *(const f32x4*)(g2 + 256 * j + 4 * lane), bb = *(const f32x4*)(b2 + 256 * j + 4 * lane);
#pragma unroll
                for (int r = 0; r < 4; ++r) ((f32x4*)(dst + (row0 + r) * D_MODEL) + lane)[64 * j] = v[r][j] * rstd[r] * gg + bb; }
        }
    }
}

constexpr size_t WS_TS = 384 * 1024;
constexpr size_t WS_BAR = 320 * 1024;
#define RLX_AGENT __ATOMIC_RELAXED, __HIP_MEMORY_SCOPE_AGENT
#define XB_TMO      128
#define XB_XCNT(j)  (256  + 64 * (j))
#define XB_XSUB(j)  (1280 + 64 * (j))
#define XB_XGEN(j)  (2304 + 64 * (j))
#define XB_TOP      3328
#define XB_TOPGEN   3392
#define XCD_BAR_WORDS 3456
#define XB_SPIN_CAP (1u << 18)

__device__ __forceinline__ unsigned xb_ld(unsigned* p)              { return __hip_atomic_load(p, __ATOMIC_RELAXED, __HIP_MEMORY_SCOPE_AGENT); }
__device__ __forceinline__ unsigned xb_add(unsigned* p, unsigned v) { return __hip_atomic_fetch_add(p, v, __ATOMIC_RELAXED, __HIP_MEMORY_SCOPE_AGENT); }
__device__ __forceinline__ unsigned xb_xcc_id() { return (unsigned)__builtin_amdgcn_s_getreg((3 << 11) | 20) & 0xFu; }
#define XB_SPIN(cond, bar) do { unsigned _sp = 0; while (cond) { __builtin_amdgcn_s_sleep(1); \
    if ((++_sp & 255u) == 0u) { if (xb_ld(&(bar)[XB_TMO])) break; if (_sp > XB_SPIN_CAP) { atomicAdd(&(bar)[XB_TMO], 1u); break; } } } } while (0)

struct XcdBarrier {
    unsigned* bar; unsigned x;
    volatile LAS unsigned* st;
};

__device__ __forceinline__ XcdBarrier xcd_barrier_post(unsigned* bar, volatile LAS unsigned* st) {
    XcdBarrier b; b.bar = bar; b.x = xb_xcc_id(); b.st = st;
    if (threadIdx.x == 0) (void)xb_add(&bar[XB_XCNT(b.x)], 1u);
    return b;
}
__device__ __forceinline__ void xcd_barrier_complete(unsigned* bar, unsigned x, unsigned& nloc, unsigned& nx) {
    const unsigned G = gridDim.x * gridDim.y * gridDim.z;
    unsigned sum, cnt, mine, sp = 0u;
    for (;;) {
        sum = 0u; cnt = 0u; mine = 0u;
#pragma unroll
        for (unsigned j = 0; j < 16; ++j) { const unsigned c = xb_ld(&bar[XB_XCNT(j)]); sum += c; cnt += (c > 0u) ? 1u : 0u; mine = (j == x) ? c : mine; }
        if (sum == G) break;
        __builtin_amdgcn_s_sleep(1);
        if ((++sp & 255u) == 0u) { if (xb_ld(&bar[XB_TMO])) break; if (sp > XB_SPIN_CAP) { atomicAdd(&bar[XB_TMO], 1u); break; } }
    }
    nloc = mine > 0u ? mine : 1u; nx = cnt > 0u ? cnt : 1u;
}

__device__ __forceinline__ void xcd_barrier(const XcdBarrier& b) {
    asm volatile("s_waitcnt vmcnt(0)" ::: "memory");
    __syncthreads();
    if (threadIdx.x == 0) {
        unsigned* bar = b.bar;
        __builtin_amdgcn_s_waitcnt(0);
        unsigned nloc = b.st[0], nx = b.st[1];
        if (nloc == 0u) { xcd_barrier_complete(bar, b.x, nloc, nx); b.st[0] = nloc; b.st[1] = nx; }
        const unsigned old = xb_add(&bar[XB_XSUB(b.x)], 1u);
        const unsigned gen = old / nloc;
        if (old + 1u == (gen + 1u) * nloc) {
            __builtin_amdgcn_fence(__ATOMIC_RELEASE, "agent");
            asm volatile("s_waitcnt vmcnt(0)" ::: "memory");
            const unsigned og = xb_add(&bar[XB_TOP], 1u);
            const unsigned tg = og / nx;
            if (og + 1u == (tg + 1u) * nx) xb_add(&bar[XB_TOPGEN], 1u);
            else XB_SPIN(xb_ld(&bar[XB_TOPGEN]) == tg, bar);
            __builtin_amdgcn_fence(__ATOMIC_ACQUIRE, "agent");
            xb_add(&bar[XB_XGEN(b.x)], 1u);
            asm volatile("s_waitcnt vmcnt(0)" ::: "memory");
        } else {
            XB_SPIN(xb_ld(&bar[XB_XGEN(b.x)]) == gen, bar);
            __builtin_amdgcn_fence(__ATOMIC_ACQUIRE, "agent");
            asm volatile("s_waitcnt vmcnt(0)" ::: "memory");
        }
    }
    __syncthreads();
}

__device__ __forceinline__ int opaque_i(int v) {
#if DUPMASK_ON
    asm volatile("" : "+v"(v)); v = __builtin_amdgcn_readfirstlane(v);
#endif
    return v; }
constexpr int NPH = 14;
struct Args { const float* in[23]; float* out; unsigned char* ws; int ph_lo, ph_hi; };
__global__ void __launch_bounds__(NTHREADS, 2) mk_fwd(Args a) {
    extern __shared__ __attribute__((aligned(16))) unsigned char lds_raw[];
    LAS unsigned char* lds = (LAS unsigned char*)lds_raw;
    cg::grid_group grid = cg::this_grid();
    const int G = gridDim.x, tid = threadIdx.x, lane = tid & 63, wave = __builtin_amdgcn_readfirstlane(tid >> 6);
    const int lo = a.ph_lo, hi = a.ph_hi;
    unsigned char* ws = a.ws;
    volatile LAS unsigned* bst = (volatile LAS unsigned*)(lds + LDS_BYTES - 16);
    if (tid < 4) bst[tid] = 0u;
    __syncthreads();
    XcdBarrier bar = xcd_barrier_post((unsigned*)(ws + WS_BAR), bst);
    if (TSTAMP && blockIdx.x == 0 && tid == 0) ((unsigned long long*)(ws + WS_TS))[0] = __builtin_amdgcn_s_memrealtime();
    if (a.ph_hi > NPH) grid.sync();
#ifndef PHMASK
#define PHMASK 0xFFFF
#endif
#define IN(k) (((PHMASK >> (k)) & 1) && lo <= (k) && (k) < hi)
#define GRIDBAR() do { if (USE_CG_SYNC) grid.sync(); else xcd_barrier(bar); } while (0)
#define SEAM(k) do { if (IN(k) && IN((k) + 1)) GRIDBAR(); if (TSTAMP && blockIdx.x == 0 && tid == 0) ((unsigned long long*)(ws + WS_TS))[(k) + 1] = __builtin_amdgcn_s_memrealtime(); } while (0)
#define PH(k) for (int rep_ = 0; rep_ < (IN(k) ? 1 + ((DUPMASK >> (k)) & 1) : 0); ++rep_) if (rep_ > 0 && (xcd_barrier(bar), false)) {} else
    PH(0) {
        if (blockIdx.x == 0 && tid < 32) ((unsigned*)(ws + WS_CNT))[tid * 32] = 0u;
        if (blockIdx.x == 1 && tid < 256) { const float* wgp = a.in[6] + tid; u32x4 w0, w1;
            w0.x = cvtpk_s(wgp[0], wgp[256]); w0.y = cvtpk_s(wgp[512], wgp[768]); w0.z = cvtpk_s(wgp[1024], wgp[1280]); w0.w = cvtpk_s(wgp[1536], wgp[1792]);
            w1.x = cvtpk_s(wgp[2048], wgp[2304]); w1.y = cvtpk_s(wgp[2560], wgp[2816]); w1.z = cvtpk_s(wgp[3072], wgp[3328]); w1.w = cvtpk_s(wgp[3584], wgp[3840]);
            u32x4* dst = (u32x4*)((bf16_t*)(ws + WS_WGT) + tid * 16); dst[0] = w0; dst[1] = w1; }
        LAS float* scr = (LAS float*)(lds + wave * 16384);
        for (int it = blockIdx.x * NWAVES + wave; it < P0_ITEMS; it += G * NWAVES) p0_item(it, a.in, ws, scr, lane);
    }
    SEAM(0);
    PH(1) p1_phase(a.in, ws, lds, G);
    SEAM(1);
    PH(2) {
        pg8::Gemm g{(const bf16_t*)(ws + WS_XN), (const bf16_t*)(ws + WS_WIN), NT, NPROJ, D_MODEL}; pg8::StaticOrder S; S.init(NT, NPROJ, G, (int)blockIdx.x);
        EpiProj E{ws};
        pg8::gemm_phase<EpiProj, pg8::StaticOrder, PG8_ALIGN, PG8_SP2>(lds, g, S, E);
#ifdef DUP_P2
        xcd_barrier(bar);
        pg8::gemm_phase<EpiProj, pg8::StaticOrder, PG8_ALIGN, PG8_SP2>(lds, g, S, E);
#endif
    }
    SEAM(2);
    PH(3) {
        for (int u = blockIdx.x; u < 256; u += G) { const int p = u >> 1, b = p >> 4, qi = p & 15, qj = 31 - qi; LAS unsigned char* lw = lds + wave * 17408;
            for (int rep = 0; rep < ((DUPSUB & 1) ? 2 : 1); ++rep) {
                if ((u & 1) == 0) { p3a_run(b, qi, 0, qi, ws, lw, wave, lane); p3a_run(b, qj, 0, 15 - qi, ws, lw, wave, lane); }
                else p3a_run(b, qj, 16 - qi, qj, ws, lw, wave, lane); } }
        for (int p = blockIdx.x; p < GLA_ITEMS / 2; p += G) { p3b_pair(p, a.in[6], a.in[7], a.out, a.out + 24 * MiB, ws, lds); if (DUPSUB & 2) p3b_pair(p, a.in[6], a.in[7], a.out, a.out + 24 * MiB, ws, lds); }
    }
    SEAM(3);
    PH(4) {
        for (int j = blockIdx.x; j < 256; j += G) { p4b_item(j, a.out, (bf16_t*)(a.out + 16 * MiB), ws); if (DUPSUB & 8) p4b_item(j, a.out, (bf16_t*)(a.out + 16 * MiB), ws); }
        {
            const int W = blockIdx.x * NWAVES + wave;
            unsigned xa[32], xb[32]; LAS unsigned char* Hw = lds + wave * SEL_LDS;
            p4a_load(W, ws, lane, xa);
#pragma unroll 1
            for (int bb = 0; bb < NB; ++bb) {
                const int r0 = bb * NS + W, r1 = bb * NS + (NS - 1 - W), r2 = ((bb + 1 < NB) ? bb + 1 : bb) * NS + W;
                p4a_load(r1, ws, lane, xb);
                p4a_row(r0, ws, lane, xa, Hw); if (DUPSUB & 4) p4a_row(r0, ws, lane, xa, Hw);
                p4a_load(r2, ws, lane, xa);
                p4a_row(r1, ws, lane, xb, Hw); if (DUPSUB & 4) p4a_row(r1, ws, lane, xb, Hw);
            }
        }
    }
    SEAM(4);
    PH(5) {
        const int c = blockIdx.x; const int bh = c >> 2, sx = c & 3;
        for (int p = blockIdx.x; p < GLA_ITEMS / 2; p += G) { p5b_pair(p, a.out + 24 * MiB, a.in[8], (const bf16_t*)(a.out + 16 * MiB), ws, lds); if (DUPSUB & 32) p5b_pair(p, a.out + 24 * MiB, a.in[8], (const bf16_t*)(a.out + 16 * MiB), ws, lds); }
        if (c < 256) for (int i = 0; i < 4; ++i) { const int Q = (i == 0) ? sx : (i == 1) ? 7 - sx : (i == 2) ? 8 + sx : 15 - sx; if (wave < 4) attn_unit<false>(bh >> 3, bh & 7, Q, a.in[2], ws, lds); else attn_unit<true>(bh >> 3, bh & 7, Q, a.in[2], ws, lds);
            if (DUPSUB & 16) { if (wave < 4) attn_unit<false>(bh >> 3, bh & 7, Q, a.in[2], ws, lds); else attn_unit<true>(bh >> 3, bh & 7, Q, a.in[2], ws, lds); } }
    }
    SEAM(5);
    PH(6) {
        pg8::StaticOrder S; S.init(NT, D_MODEL, G, (int)blockIdx.x);
        { pg8::Gemm g{(const bf16_t*)(ws + WS_XN), (const bf16_t*)(ws + WS_WGAB), NT, D_MODEL, D_MODEL}; EpiSig E{ws, 0}; pg8::gemm_phase<EpiSig, pg8::StaticOrder, PG8_ALIGN, PG8_SP2>(lds, g, S, E); }
        { pg8::Gemm g{(const bf16_t*)(ws + WS_XN), (const bf16_t*)(ws + WS_WGAB) + (size_t)1024 * 1024, NT, D_MODEL, D_MODEL}; EpiSig E{ws, 1}; pg8::gemm_phase<EpiSig, pg8::StaticOrder, PG8_ALIGN, PG8_SP2>(lds, g, S, E); }
        { pg8::Gemm g{(const bf16_t*)(ws + WS_OAB), (const bf16_t*)(ws + WS_WBA), NT, D_MODEL, D_MODEL}; EpiMrgF E{ws}; pg8::gemm_phase<EpiMrgF, pg8::StaticOrder, PG8_ALIGN, PG8_SP2>(lds, g, S, E); }
    }
    SEAM(7);
    PH(8) {
        pg8::Gemm g{(const bf16_t*)(ws + WS_MRG), (const bf16_t*)(ws + WS_WOUT), NT, D_MODEL, D_MODEL}; pg8::StaticOrder S; S.init(NT, D_MODEL, G, (int)blockIdx.x);
        EpiV E{a.in[0], (const float*)(ws + WS_ADA), a.out}; pg8::gemm_phase<EpiV, pg8::StaticOrder, PG8_ALIGN, PG8_SP2>(lds, g, S, E);
    }
    SEAM(8);
#ifdef DUP_P8
    p8_phase<false>(a.in, a.out, (float*)(ws + 129 * MiB), (bf16_t*)(ws + 260 * MiB), ws, lds, G); xcd_barrier(bar);
#endif
    PH(9) p8_phase<true>(a.in, a.out, a.out, (bf16_t*)(ws + WS_H2), ws, lds, G);
    if (IN(9) && IN(11)) { GRIDBAR(); if (TSTAMP && blockIdx.x == 0 && tid == 0) ((unsigned long long*)(ws + WS_TS))[10] = __builtin_amdgcn_s_memrealtime(); }
    PH(11) {
        build_tables(ws, lds);
        pg8::Gemm g{(const bf16_t*)(ws + WS_H2), (const bf16_t*)(ws + WS_W13), 0, 0, D_MODEL}; GroupOrder<2> S{(const LAS int*)(lds + LDS_TAB), (const LAS int*)(lds + LDS_TAB) + 64, G, (int)blockIdx.x, (const int*)(ws + WS_LIST)};
        EpiHid E{ws}; pg8::gemm_phase<EpiHid, GroupOrder<2>, PG8_ALIGN, PG8_SP2, true>(lds, g, S, E);
    }
    SEAM(11);
    PH(12) {
        build_tables(ws, lds);
        int kd = D_EXP; asm volatile("" : "+s"(kd));
        pg8::Gemm g{(const bf16_t*)(ws + WS_HID), (const bf16_t*)(ws + WS_W2), 0, 0, kd}; GroupOrder<4> S{(const LAS int*)(lds + LDS_TAB), (const LAS int*)(lds + LDS_TAB) + 64, G, (int)blockIdx.x, nullptr};
        EpiY E{ws}; pg8::gemm_phase<EpiY, GroupOrder<4>, PG8_ALIGN, PG8_SP2>(lds, g, S, E);
    }
    SEAM(12);
#ifdef DUP_P12
    p12_phase(a.in, a.out, (float*)(ws + 129 * MiB), ws, lds, G); xcd_barrier(bar);
#endif
    PH(13) p12_phase(a.in, a.out, a.out, ws, lds, G);
    if (TSTAMP) { xcd_barrier(bar); if (blockIdx.x == 0 && tid == 0) ((unsigned long long*)(ws + WS_TS))[14] = __builtin_amdgcn_s_memrealtime(); }
#ifdef EXTRA_SYNCS
    for (int i_ = 0; i_ < EXTRA_SYNCS; ++i_) GRIDBAR();
#endif
#undef IN
#undef SEAM
#undef PH
}
}
#if TSTAMP
__global__ void kd_ts(float* out, long n, const unsigned long long* ts, int ka, int kb) {
    const float da = (ka == 14) ? (float)(ts[14] - ts[0]) * 0.01f / 10.f : (float)(ts[ka + 1] - ts[ka]) * 0.01f;
    const float sc = 1.f + da * 0.0005f;
    for (long i = (long)blockIdx.x * blockDim.x + threadIdx.x; i < n; i += (long)gridDim.x * blockDim.x) out[i] *= sc;
}
#endif
extern "C" void kernel_launch(void* const* d_in, const int* in_sizes, int n_in, void* d_out, int out_size,
                              void* d_ws, size_t ws_size, hipStream_t stream) {
    using namespace fk;
    static int grid = 0;
    if (grid == 0) {
        int dev = 0, cus = 0, per_cu = 0; (void)hipGetDevice(&dev); (void)hipDeviceGetAttribute(&cus, hipDeviceAttributeMultiprocessorCount, dev);
        (void)hipFuncSetAttribute((const void*)mk_fwd, hipFuncAttributeMaxDynamicSharedMemorySize, LDS_BYTES);
        (void)hipOccupancyMaxActiveBlocksPerMultiprocessor(&per_cu, (const void*)mk_fwd, NTHREADS, LDS_BYTES);
        (void)hipGetLastError();
        grid = cus * (per_cu >= 1 ? 1 : 1);
        if (ws_size < 512 * MiB) { fprintf(stderr, "kernel_launch: workspace too small\n"); grid = -1; }
    }
    if (grid < 0) return;
    (void)hipMemsetAsync((unsigned char*)d_ws + WS_BAR, 0, 16384, stream);
    Args a{}; for (int i = 0; i < 23; ++i) a.in[i] = (const float*)d_in[i]; a.out = (float*)d_out; a.ws = (unsigned char*)d_ws; a.ph_lo = 0; a.ph_hi = NPH;
    void* args[] = {&a};
    hipError_t e = hipLaunchCooperativeKernel((const void*)mk_fwd, dim3(grid), dim3(NTHREADS), args, LDS_BYTES, stream);
    if (e != hipSuccess) fprintf(stderr, "cooperative launch failed: %s\n", hipGetErrorString(e));
#if TSTAMP
    hipLaunchKernelGGL(kd_ts, dim3(1024), dim3(256), 0, stream, (float*)d_out, (long)out_size, (const unsigned long long*)((unsigned char*)d_ws + WS_TS), TS_A, TS_B);
#endif
}
```

```cpp
#include <hip/hip_runtime.h>
#include <hip/hip_cooperative_groups.h>
#include <cstdio>
#include <cstdint>
#include <cstring>
#include <cmath>
#ifdef HOST_EMU
#include <cmath>
#include <cstdio>
#include <cstdlib>
#include <cstring>
#include <cstdint>
struct Dim3e { int x, y, z; };
static thread_local Dim3e threadIdx, blockIdx, blockDim, gridDim;
#define __global__
#define __device__
#define __host__
#define __forceinline__ inline
#define __launch_bounds__(...)
typedef void* hipStream_t;
template <class F, class... A> static void host_launch(F f, long nb, int nt, A... a) {
#pragma omp parallel for schedule(dynamic, 4)
    for (long b = 0; b < nb; ++b) {
        blockIdx = {(int)b, 0, 0}; blockDim = {nt, 1, 1}; gridDim = {(int)nb, 1, 1};
        for (int t = 0; t < nt; ++t) { threadIdx = {t, 0, 0}; f(a...); }
    }
}
#define LAUNCH(k, nb, nt, st, ...) host_launch(k, (long)(nb), (int)(nt), __VA_ARGS__)
#define UNROLL
#else
#define LAUNCH(k, nb, nt, st, ...) hipLaunchKernelGGL(k, dim3((unsigned)(nb)), dim3((unsigned)(nt)), 0, st, __VA_ARGS__)
#endif

constexpr int D_MODEL = 1024, A_HEADS = 8, A_HD = 64, A_W = 512, I_HEADS = 16, I_DIM = 32, TOPK_MAX = 256, REL_B = 32,
              G_HEADS = 4, G_DK = 64, G_DV = 128, G_KW = 256, G_VW = 512, G_RANK = 16, N_GROUPS = 4, EPG = 8, N_EXP = 32, D_EXP = 256;
constexpr int O_AQ = 0, O_AK = 512, O_AV = 1024, O_IQ = 1536, O_IK = 2048, O_IW = 2080, O_GQ = 2096, O_GK = 2352, O_GV = 2608, O_GR = 3120,
              O_GLR = 3632, O_GA = 3648, O_GB = 4672, D_IN = 5696;
constexpr float DN_ALPHA = 1.189207115002721f, LN_EPS = 1e-5f;
#define V0_GID long gid = (long)blockIdx.x * blockDim.x + threadIdx.x

__device__ __forceinline__ float v0_silu(float v) { return v / (1.f + expf(-v)); }
__device__ __forceinline__ float v0_sigmoid(float v) { return 1.f / (1.f + expf(-v)); }

__global__ void k0_ada(const float* c, const float* w_ada, const float* b_ada, float* ada, int B) {
    V0_GID; if (gid >= (long)B * 6 * D_MODEL) return;
    const int b = (int)(gid / (6 * D_MODEL)), j = (int)(gid % (6 * D_MODEL));
    float acc = 0.f;
    for (int i = 0; i < D_MODEL; ++i) acc += v0_silu(c[b * D_MODEL + i]) * w_ada[(size_t)i * 6 * D_MODEL + j];
    ada[gid] = acc + b_ada[j];
}
__global__ void k0_lnmod(const float* x, const float* sh, const float* sc, float* h, int nrows) {
    V0_GID; if (gid >= nrows) return;
    const float* xr = x + (size_t)gid * D_MODEL; float* hr = h + (size_t)gid * D_MODEL;
    float mu = 0.f; for (int k = 0; k < D_MODEL; ++k) mu += xr[k]; mu *= (1.f / D_MODEL);
    float var = 0.f; for (int k = 0; k < D_MODEL; ++k) { const float d = xr[k] - mu; var += d * d; } var *= (1.f / D_MODEL);
    const float rs = 1.f / sqrtf(var + LN_EPS);
    for (int k = 0; k < D_MODEL; ++k) hr[k] = (xr[k] - mu) * rs * (1.f + sc[k]) + sh[k];
}
__global__ void k0_gemm(const float* A, int lda, const float* W, int ldw, float* C, int ldc, int M, int N, int K) {
    V0_GID; if (gid >= (long)(M / 4) * N) return;
    const int n = (int)(gid % N); const int m0 = (int)(gid / N) * 4;
    float a0 = 0.f, a1 = 0.f, a2 = 0.f, a3 = 0.f;
    const float* A0 = A + (size_t)m0 * lda;
    for (int k = 0; k < K; ++k) { const float w = W[(size_t)k * ldw + n]; a0 += A0[k] * w; a1 += A0[lda + k] * w; a2 += A0[2 * lda + k] * w; a3 += A0[3 * lda + k] * w; }
    C[(size_t)m0 * ldc + n] = a0; C[(size_t)(m0 + 1) * ldc + n] = a1; C[(size_t)(m0 + 2) * ldc + n] = a2; C[(size_t)(m0 + 3) * ldc + n] = a3;
}
__global__ void k0_scores(const float* P, float* scT, int S) {
    V0_GID; if (gid >= (long)S * S) return;
    const int t = (int)(gid % S), s = (int)(gid / S);
    if (s > t) { scT[gid] = -INFINITY; return; }
    const float* iq = P + (size_t)t * D_IN + O_IQ; const float* ik = P + (size_t)s * D_IN + O_IK; const float* iw = P + (size_t)t * D_IN + O_IW;
    const float cst = 0.044194173824159216f;
    float sc = 0.f;
    for (int h = 0; h < I_HEADS; ++h) { float d = 0.f; for (int k = 0; k < I_DIM; ++k) d += iq[h * I_DIM + k] * ik[k]; sc += (iw[h] * cst) * fmaxf(d, 0.f); }
    scT[gid] = sc;
}
__device__ __forceinline__ unsigned v0_key(float f) { unsigned u; memcpy(&u, &f, 4); return (u & 0x80000000u) ? ~u : (u | 0x80000000u); }
__global__ void k0_topk(const float* scT, int* sel, int* cnt, int S, int topk) {
    V0_GID; if (gid >= S) return;
    const int t = (int)gid; const int n = t + 1; int* sl = sel + (size_t)t * TOPK_MAX;
    if (n <= topk) { for (int s = 0; s < n; ++s) sl[s] = s; cnt[t] = n; return; }
    unsigned T = 0u;
    for (int bit = 31; bit >= 0; --bit) { const unsigned cand = T | (1u << bit); int c = 0; for (int s = 0; s < n; ++s) c += (v0_key(scT[(size_t)s * S + t]) >= cand) ? 1 : 0; if (c >= topk) T = cand; }
    int cgt = 0; for (int s = 0; s < n; ++s) cgt += (v0_key(scT[(size_t)s * S + t]) > T) ? 1 : 0;
    int need = topk - cgt, j = 0;
    for (int s = 0; s < n; ++s) { const unsigned k = v0_key(scT[(size_t)s * S + t]); if (k > T) sl[j++] = s; else if (k == T && need > 0) { sl[j++] = s; --need; } }
    cnt[t] = j;
}
__device__ __forceinline__ int v0_bucket(int d) {
    if (d < 16) return d;
    const float df = (float)d; int large = 16 + (int)(logf(df / 16.f) / 2.0794415416798357f * 16.f);
    return large < 31 ? large : 31;
}
__global__ void __launch_bounds__(256) k0_attn(const float* P, const int* sel, const int* cnt, const float* rel_bias, float* oa, int S) {
    V0_GID; if (gid >= (long)S * A_HEADS) return;
    const int t = (int)(gid / A_HEADS), h = (int)(gid % A_HEADS); const int n = cnt[t]; const int* sl = sel + (size_t)t * TOPK_MAX;
    const float* q = P + (size_t)t * D_IN + O_AQ + h * A_HD;
    float m = -INFINITY;
    for (int j = 0; j < n; ++j) { const int s = sl[j]; const float* k = P + (size_t)s * D_IN + O_AK + h * A_HD; float d = 0.f; for (int e = 0; e < A_HD; ++e) d += q[e] * k[e];
        const float l = d * 0.125f + rel_bias[v0_bucket(t - s) * A_HEADS + h]; m = fmaxf(m, l); }
    float o[A_HD];
#pragma unroll
    for (int e = 0; e < A_HD; ++e) o[e] = 0.f;
    float sum = 0.f;
    for (int j = 0; j < n; ++j) { const int s = sl[j]; const float* k = P + (size_t)s * D_IN + O_AK + h * A_HD; const float* v = P + (size_t)s * D_IN + O_AV + h * A_HD; float d = 0.f;
        for (int e = 0; e < A_HD; ++e) d += q[e] * k[e];
        const float p = expf(d * 0.125f + rel_bias[v0_bucket(t - s) * A_HEADS + h] - m); sum += p;
#pragma unroll
        for (int e = 0; e < A_HD; ++e) o[e] += p * v[e]; }
    const float inv = 1.f / sum;
#pragma unroll
    for (int e = 0; e < A_HD; ++e) oa[(size_t)t * A_W + h * A_HD + e] = o[e] * inv;
}
__global__ void k0_gate(const float* P, const float* wg, const float* bg, float* lg, int S) {
    V0_GID; if (gid >= (long)S * G_KW) return;
    const int t = (int)(gid / G_KW), j = (int)(gid % G_KW);
    float z = bg[j]; for (int r = 0; r < G_RANK; ++r) z += P[(size_t)t * D_IN + O_GLR + r] * wg[r * G_KW + j];
    lg[gid] = (fminf(z, 0.f) - log1pf(expf(-fabsf(z)))) * (1.f / 16.f);
}
__global__ void __launch_bounds__(64) k0_gla(const float* P, const float* lg, float* oraw, int S) {
    V0_GID; if (gid >= G_HEADS * G_DV) return;
    const int h = (int)(gid / G_DV), dv = (int)(gid % G_DV);
    float st[G_DK];
#pragma unroll
    for (int d = 0; d < G_DK; ++d) st[d] = 0.f;
    for (int t = 0; t < S; ++t) {
        const float* row = P + (size_t)t * D_IN; const float vv = row[O_GV + h * G_DV + dv]; float o = 0.f;
#pragma unroll
        for (int d = 0; d < G_DK; ++d) { const float a = expf(lg[(size_t)t * G_KW + h * G_DK + d]); st[d] = a * st[d] + row[O_GK + h * G_DK + d] * vv; o += row[O_GQ + h * G_DK + d] * st[d]; }
        oraw[(size_t)t * G_VW + h * G_DV + dv] = o * 0.125f;
    }
}
__global__ void k0_gla_post(const float* P, const float* oraw, const float* ng, float* ob, int S) {
    V0_GID; if (gid >= (long)S * G_HEADS) return;
    const int t = (int)(gid / G_HEADS), h = (int)(gid % G_HEADS); const float* o = oraw + (size_t)t * G_VW + h * G_DV;
    float mu = 0.f; for (int e = 0; e < G_DV; ++e) mu += o[e]; mu *= (1.f / G_DV);
    float var = 0.f; for (int e = 0; e < G_DV; ++e) { const float d = o[e] - mu; var += d * d; } var *= (1.f / G_DV);
    const float rs = 1.f / sqrtf(var + LN_EPS);
    for (int e = 0; e < G_DV; ++e) ob[(size_t)t * G_VW + h * G_DV + e] = (o[e] - mu) * rs * ng[h * G_DV + e] * v0_silu(P[(size_t)t * D_IN + O_GR + h * G_DV + e]);
}
__global__ void k0_merge(const float* P, const float* ba, const float* bb, float* mg, int S) {
    V0_GID; if (gid >= (long)S * D_MODEL) return;
    const int t = (int)(gid / D_MODEL), n = (int)(gid % D_MODEL);
    mg[gid] = v0_sigmoid(P[(size_t)t * D_IN + O_GA + n]) * ba[gid] + v0_sigmoid(P[(size_t)t * D_IN + O_GB + n]) * bb[gid];
}
__global__ void k0_ln1(const float* x, const float* y, const float* gt1, const float* g1, const float* b1, const float* sh2, const float* sc2, float* x1, float* h2, int nrows) {
    V0_GID; if (gid >= nrows) return;
    const float* xr = x + (size_t)gid * D_MODEL; const float* yr = y + (size_t)gid * D_MODEL; float* x1r = x1 + (size_t)gid * D_MODEL; float* h2r = h2 + (size_t)gid * D_MODEL;
    float mu = 0.f; for (int k = 0; k < D_MODEL; ++k) mu += DN_ALPHA * xr[k] + gt1[k] * yr[k]; mu *= (1.f / D_MODEL);
    float var = 0.f; for (int k = 0; k < D_MODEL; ++k) { const float d = DN_ALPHA * xr[k] + gt1[k] * yr[k] - mu; var += d * d; } var *= (1.f / D_MODEL);
    float rs = 1.f / sqrtf(var + LN_EPS);
    for (int k = 0; k < D_MODEL; ++k) x1r[k] = (DN_ALPHA * xr[k] + gt1[k] * yr[k] - mu) * rs * g1[k] + b1[k];
    mu = 0.f; for (int k = 0; k < D_MODEL; ++k) mu += x1r[k]; mu *= (1.f / D_MODEL);
    var = 0.f; for (int k = 0; k < D_MODEL; ++k) { const float d = x1r[k] - mu; var += d * d; } var *= (1.f / D_MODEL);
    rs = 1.f / sqrtf(var + LN_EPS);
    for (int k = 0; k < D_MODEL; ++k) h2r[k] = (x1r[k] - mu) * rs * (1.f + sc2[k]) + sh2[k];
}
__global__ void k0_route(const float* rl, const float* brg, const float* bre, int* eid, float* ew, int nrows) {
    V0_GID; if (gid >= nrows) return;
    const float* r = rl + (size_t)gid * 36;
    float gl[N_GROUPS]; float gm = -INFINITY; int gi = 0;
#pragma unroll
    for (int g = 0; g < N_GROUPS; ++g) { gl[g] = r[g] + brg[g]; if (gl[g] > gm) { gm = gl[g]; gi = g; } }
    float gs = 0.f;
#pragma unroll
    for (int g = 0; g < N_GROUPS; ++g) gs += expf(gl[g] - gm);
    const float gw = 1.f / gs;
    float v0 = -INFINITY, v1 = -INFINITY; int i0 = 0, i1 = 0;
    for (int e = 0; e < EPG; ++e) { const float v = r[4 + gi * EPG + e] + bre[gi * EPG + e];
        if (v > v0) { v1 = v0; i1 = i0; v0 = v; i0 = e; } else if (v > v1) { v1 = v; i1 = e; } }
    const float e1 = expf(v1 - v0); const float w0 = 1.f / (1.f + e1), w1 = e1 / (1.f + e1);
    eid[gid * 2] = gi * EPG + i0; eid[gid * 2 + 1] = gi * EPG + i1; ew[gid * 2] = w0 * gw; ew[gid * 2 + 1] = w1 * gw;
}
__global__ void k0_moe_hid(const float* h2, const int* eid, const float* w1, const float* w3, float* hid, int nrows) {
    V0_GID; if (gid >= (long)nrows * 2 * D_EXP) return;
    const int j = (int)(gid % D_EXP); const long ts = gid / D_EXP; const int t = (int)(ts / 2); const int e = eid[ts];
    const float* hr = h2 + (size_t)t * D_MODEL; const float* a = w1 + (size_t)e * D_MODEL * D_EXP + j; const float* b = w3 + (size_t)e * D_MODEL * D_EXP + j;
    float g = 0.f, u = 0.f; for (int k = 0; k < D_MODEL; ++k) { g += hr[k] * a[(size_t)k * D_EXP]; u += hr[k] * b[(size_t)k * D_EXP]; }
    hid[gid] = v0_silu(g) * u;
}
__global__ void k0_moe_out(const float* hid, const int* eid, const float* ew, const float* w2, float* f, int nrows) {
    V0_GID; if (gid >= (long)nrows * D_MODEL) return;
    const int n = (int)(gid % D_MODEL); const int t = (int)(gid / D_MODEL); float acc = 0.f;
    for (int sl = 0; sl < 2; ++sl) { const int e = eid[t * 2 + sl]; const float* hr = hid + ((size_t)t * 2 + sl) * D_EXP; const float* w = w2 + (size_t)e * D_EXP * D_MODEL + n; float a = 0.f;
        for (int j = 0; j < D_EXP; ++j) a += hr[j] * w[(size_t)j * D_MODEL]; acc += ew[t * 2 + sl] * a; }
    f[gid] = acc;
}
__global__ void k0_final(const float* x1, const float* f, const float* gt2, const float* g2, const float* b2, float* out, int nrows) {
    V0_GID; if (gid >= nrows) return;
    const float* xr = x1 + (size_t)gid * D_MODEL; const float* fr = f + (size_t)gid * D_MODEL; float* o = out + (size_t)gid * D_MODEL;
    float mu = 0.f; for (int k = 0; k < D_MODEL; ++k) mu += DN_ALPHA * xr[k] + gt2[k] * fr[k]; mu *= (1.f / D_MODEL);
    float var = 0.f; for (int k = 0; k < D_MODEL; ++k) { const float d = DN_ALPHA * xr[k] + gt2[k] * fr[k] - mu; var += d * d; } var *= (1.f / D_MODEL);
    const float rs = 1.f / sqrtf(var + LN_EPS);
    for (int k = 0; k < D_MODEL; ++k) o[k] = (DN_ALPHA * xr[k] + gt2[k] * fr[k] - mu) * rs * g2[k] + b2[k];
}

struct V0Buf { float *ada, *h, *P, *scT, *oa, *lg, *oraw, *ob, *ba, *bb, *mg, *y, *x1, *h2, *rl, *ew, *hid, *f; int *sel, *cnt, *eid; size_t bytes; };
static V0Buf v0_carve(void* base, int B, int S) {
    V0Buf b; char* p = (char*)base; auto take = [&](size_t n) { char* r = p; p += (n + 255) & ~(size_t)255; return r; };
    b.ada = (float*)take((size_t)B * 6 * D_MODEL * 4);
    b.P = (float*)take((size_t)S * D_IN * 4);
    b.h = (float*)take((size_t)S * D_MODEL * 4);
    b.scT = (float*)take((size_t)S * S * 4);
    b.sel = (int*)take((size_t)S * TOPK_MAX * 4); b.cnt = (int*)take((size_t)S * 4);
    b.oa = (float*)take((size_t)S * A_W * 4); b.lg = (float*)take((size_t)S * G_KW * 4); b.oraw = (float*)take((size_t)S * G_VW * 4); b.ob = (float*)take((size_t)S * G_VW * 4);
    b.ba = (float*)take((size_t)S * D_MODEL * 4); b.bb = (float*)take((size_t)S * D_MODEL * 4); b.y = (float*)take((size_t)S * D_MODEL * 4);
    b.x1 = (float*)take((size_t)S * D_MODEL * 4); b.h2 = (float*)take((size_t)S * D_MODEL * 4); b.f = (float*)take((size_t)S * D_MODEL * 4);
    b.mg = b.h;
    b.rl = (float*)take((size_t)S * 36 * 4); b.eid = (int*)take((size_t)S * 2 * 4); b.ew = (float*)take((size_t)S * 2 * 4); b.hid = (float*)take((size_t)S * 2 * D_EXP * 4);
    b.bytes = (size_t)(p - (char*)base); return b;
}
static void v0_forward(void* const* d_in, float* out, void* scratch, int B, int S, hipStream_t st, int only_batch = -1, int last_batch = -1) {
    const float *x = (const float*)d_in[0], *c = (const float*)d_in[1], *rel_bias = (const float*)d_in[2], *w_ada = (const float*)d_in[3], *b_ada = (const float*)d_in[4], *w_in = (const float*)d_in[5],
                *wg = (const float*)d_in[6], *bg = (const float*)d_in[7], *ng = (const float*)d_in[8], *wba = (const float*)d_in[9], *wbb = (const float*)d_in[10], *wout = (const float*)d_in[11],
                *g1 = (const float*)d_in[12], *b1 = (const float*)d_in[13], *wrg = (const float*)d_in[14], *brg = (const float*)d_in[15], *wre = (const float*)d_in[16], *bre = (const float*)d_in[17],
                *w1 = (const float*)d_in[18], *w3 = (const float*)d_in[19], *w2 = (const float*)d_in[20], *g2 = (const float*)d_in[21], *b2 = (const float*)d_in[22];
    V0Buf u = v0_carve(scratch, B, S);
    const int TB = 256; auto nb = [&](long n) { return (n + TB - 1) / TB; };
    const int topk = (TOPK_MAX < S / 4) ? TOPK_MAX : S / 4;
    LAUNCH(k0_ada, nb((long)B * 6 * D_MODEL), TB, st, c, w_ada, b_ada, u.ada, B);
    for (int bi = 0; bi < B; ++bi) {
        int b = bi; if (last_batch >= 0) b = (bi == B - 1) ? last_batch : (bi < last_batch ? bi : bi + 1);
        if (only_batch >= 0 && b != only_batch) continue;
        const float* xb = x + (size_t)b * S * D_MODEL; const float* ad = u.ada + (size_t)b * 6 * D_MODEL;
        const float *sh1 = ad, *sc1 = ad + D_MODEL, *gt1 = ad + 2 * D_MODEL, *sh2 = ad + 3 * D_MODEL, *sc2 = ad + 4 * D_MODEL, *gt2 = ad + 5 * D_MODEL;
        LAUNCH(k0_lnmod, nb(S), TB, st, xb, sh1, sc1, u.h, S);
        LAUNCH(k0_gemm, nb((long)(S / 4) * D_IN), TB, st, (const float*)u.h, D_MODEL, w_in, D_IN, u.P, D_IN, S, D_IN, D_MODEL);
        LAUNCH(k0_scores, nb((long)S * S), TB, st, (const float*)u.P, u.scT, S);
        LAUNCH(k0_topk, nb(S), TB, st, (const float*)u.scT, u.sel, u.cnt, S, topk);
        LAUNCH(k0_attn, nb((long)S * A_HEADS), TB, st, (const float*)u.P, (const int*)u.sel, (const int*)u.cnt, rel_bias, u.oa, S);
        LAUNCH(k0_gate, nb((long)S * G_KW), TB, st, (const float*)u.P, wg, bg, u.lg, S);
        LAUNCH(k0_gla, (G_HEADS * G_DV + 63) / 64, 64, st, (const float*)u.P, (const float*)u.lg, u.oraw, S);
        LAUNCH(k0_gla_post, nb((long)S * G_HEADS), TB, st, (const float*)u.P, (const float*)u.oraw, ng, u.ob, S);
        LAUNCH(k0_gemm, nb((long)(S / 4) * D_MODEL), TB, st, (const float*)u.oa, A_W, wba, D_MODEL, u.ba, D_MODEL, S, D_MODEL, A_W);
        LAUNCH(k0_gemm, nb((long)(S / 4) * D_MODEL), TB, st, (const float*)u.ob, G_VW, wbb, D_MODEL, u.bb, D_MODEL, S, D_MODEL, G_VW);
        LAUNCH(k0_merge, nb((long)S * D_MODEL), TB, st, (const float*)u.P, (const float*)u.ba, (const float*)u.bb, u.mg, S);
        LAUNCH(k0_gemm, nb((long)(S / 4) * D_MODEL), TB, st, (const float*)u.mg, D_MODEL, wout, D_MODEL, u.y, D_MODEL, S, D_MODEL, D_MODEL);
        LAUNCH(k0_ln1, nb(S), TB, st, xb, (const float*)u.y, gt1, g1, b1, sh2, sc2, u.x1, u.h2, S);
        LAUNCH(k0_gemm, nb((long)(S / 4) * N_GROUPS), TB, st, (const float*)u.h2, D_MODEL, wrg, N_GROUPS, u.rl, 36, S, N_GROUPS, D_MODEL);
        LAUNCH(k0_gemm, nb((long)(S / 4) * N_EXP), TB, st, (const float*)u.h2, D_MODEL, wre, N_EXP, u.rl + 4, 36, S, N_EXP, D_MODEL);
        LAUNCH(k0_route, nb(S), TB, st, (const float*)u.rl, brg, bre, u.eid, u.ew, S);
        LAUNCH(k0_moe_hid, nb((long)S * 2 * D_EXP), TB, st, (const float*)u.h2, (const int*)u.eid, w1, w3, u.hid, S);
        LAUNCH(k0_moe_out, nb((long)S * D_MODEL), TB, st, (const float*)u.hid, (const int*)u.eid, (const float*)u.ew, w2, u.f, S);
        LAUNCH(k0_final, nb(S), TB, st, (const float*)u.x1, (const float*)u.f, gt2, g2, b2, out + (size_t)b * S * D_MODEL, S);
    }
}
namespace pg8 {
#define PG8_LAS __attribute__((address_space(3)))
typedef unsigned short bf16_t;
typedef short bf16x8 __attribute__((ext_vector_type(8)));
typedef float f32x4 __attribute__((ext_vector_type(4)));
typedef unsigned u32x4 __attribute__((ext_vector_type(4)));
constexpr int BM = 256, BK = 64, HALF = 128, HTB = HALF * BK * 2  , STAGE_BYTES = 8 * HTB, NXCD = 8, WGM = 8;

__host__ __device__ __forceinline__ int lds_byte(int r, int c) { const int st = (r >> 4) * 2 + (c >> 5), rr = r & 15, cc = c & 31, ob = rr * 64 + cc * 2; return st * 1024 + (ob ^ (((ob >> 9) & 1) << 5)); }
__host__ __device__ __forceinline__ void stage_rc(int b, int& R, int& C) { const int st = b / 1024, sb = b % 1024, swz = sb ^ (((sb >> 9) & 1) << 5); R = (st >> 1) * 16 + swz / 64; C = (st & 1) * 32 + (swz % 64) / 2; }
__host__ __device__ __forceinline__ int perm32(int rho) { const int n = rho >> 4, i = rho & 15; return 8 * (i >> 2) + 4 * n + (i & 3); }

struct Unit { int pm, pn, pa, pb; };
struct Gemm { const bf16_t* A; const bf16_t* Bt; int M, N, K; };

struct StaticOrder {
    int nM, nN, nwg, G, c;
    __host__ __device__ void init(int M, int N, int G_, int c_) { nM = M / BM; nN = N / BM; nwg = nM * nN; G = G_; c = c_; }
    __host__ __device__ bool next(int i, Unit& u) const {
        const long L = (long)i * G + c; if (L >= nwg) return false;
        int wgid = (int)L; { const int q = nwg / NXCD, r = nwg % NXCD, xcd = wgid % NXCD, off = wgid / NXCD; wgid = (xcd < r ? xcd * (q + 1) : r * (q + 1) + (xcd - r) * q) + off; }
        const int nig = WGM * nN, gid = wgid / nig, fm = gid * WGM, gsz = (nM - fm) < WGM ? (nM - fm) : WGM;
        u.pm = fm + ((wgid % nig) % gsz); u.pn = (wgid % nig) / gsz; u.pa = u.pm; u.pb = u.pn; return true;
    }
    __device__ __forceinline__ void a_ready(const Unit&) const {}
    __device__ __forceinline__ void done(const Unit&) const {}
};

__device__ __forceinline__ unsigned cvt_pk_bf16(float lo, float hi) { unsigned r; asm volatile("v_cvt_pk_bf16_f32 %0, %1, %2" : "=v"(r) : "v"(lo), "v"(hi)); return r; }
typedef float f32x2 __attribute__((ext_vector_type(2)));

template <class Epi, class Sched, bool ALIGN_EPI = false, bool SP2 = false, bool GATHER = false>
__device__ __forceinline__ void gemm_phase(PG8_LAS unsigned char* lds, const Gemm g, const Sched& S, const Epi& E) {
    const int tid = threadIdx.x, wid = __builtin_amdgcn_readfirstlane(tid >> 6), lane = tid & 63, wr = wid >> 2, wc = wid & 3, fr = lane & 15, fq = lane >> 4;
    const int K = g.K, nt = K / BK;
    static_assert(!GATHER || SP2, "gathered A rows: SP2 loop only");
    unsigned voffA[2], voffB[2]; int Rr[2], Cc[2];
#pragma unroll
    for (int i = 0; i < 2; ++i) { int R, C; stage_rc(tid * 16 + i * 8192, R, C); const int Rb = Epi::PERM ? ((R & ~31) + perm32(R & 31)) : R; Rr[i] = R; Cc[i] = C;
        voffA[i] = (unsigned)(R * K + C) * 2u; voffB[i] = (unsigned)(Rb * K + C) * 2u; }
    unsigned vc0[2] = {voffA[0], voffA[1]}, vc1[2] = {voffA[0], voffA[1]}, vn0[2] = {voffA[0], voffA[1]}, vn1[2] = {voffA[0], voffA[1]};
    const size_t kstep = (size_t)(BK * 2);
    const size_t hstep = (size_t)HALF * K * 2;
    const size_t tstep = 2 * hstep;
    const unsigned ldsw = (unsigned)wid * 1024u;
    const int aoff = lds_byte(wr * 64 + fr, fq * 8), boff = lds_byte(wc * 32 + fr, fq * 8);
#define PG8_SA(b, h) (((b) * 2 + (h)) * HTB)
#define PG8_SB(b, h) ((4 + (b) * 2 + (h)) * HTB)
#define PG8_STAGE(bufoff, gbase, voff) do { _Pragma("unroll") for (int _i = 0; _i < 2; ++_i) \
        __builtin_amdgcn_global_load_lds((const unsigned*)((const char*)(gbase) + (voff)[_i]), (PG8_LAS unsigned*)(lds + (bufoff) + ldsw + _i * 8192), 16, 0, 0); } while (0)
#define PG8_LDA(dst, b, h) do { _Pragma("unroll") for (int m = 0; m < 4; ++m) _Pragma("unroll") for (int k = 0; k < 2; ++k) dst[m][k] = *(const PG8_LAS bf16x8*)(lds + PG8_SA(b, h) + aoff + m * 2048 + k * 1024); } while (0)
#define PG8_LDB(dst, b, h) do { _Pragma("unroll") for (int n = 0; n < 2; ++n) _Pragma("unroll") for (int k = 0; k < 2; ++k) dst[n][k] = *(const PG8_LAS bf16x8*)(lds + PG8_SB(b, h) + boff + n * 2048 + k * 1024); } while (0)
#define PG8_MMA(ai, bj, At, Bt) do { __builtin_amdgcn_s_setprio(1); _Pragma("unroll") for (int m = 0; m < 4; ++m) _Pragma("unroll") for (int n = 0; n < 2; ++n) _Pragma("unroll") for (int k = 0; k < 2; ++k) \
        acc[ai][bj][m][n] = __builtin_amdgcn_mfma_f32_16x16x32_bf16(Bt[n][k], At[m][k], acc[ai][bj][m][n], 0, 0, 0); __builtin_amdgcn_s_setprio(0); } while (0)
#define PG8_WAIT_V(n) asm volatile("s_waitcnt vmcnt(" #n ")" ::: "memory")
#define PG8_WAIT_L(n) asm volatile("s_waitcnt lgkmcnt(" #n ")" ::: "memory")
#define PG8_BAR __builtin_amdgcn_s_barrier()
#define PG8_SCHED __builtin_amdgcn_sched_barrier(0)
    Unit cur, nxt; int ui = 0;
    if (!S.next(0, cur)) return;
    f32x4 acc[2][2][4][2];
#pragma unroll
    for (int a = 0; a < 2; ++a)
#pragma unroll
        for (int b = 0; b < 2; ++b)
#pragma unroll
            for (int m = 0; m < 4; ++m)
#pragma unroll
                for (int n = 0; n < 2; ++n) acc[a][b][m][n] = (f32x4){0.f, 0.f, 0.f, 0.f};
    bf16x8 At[4][2], B0[2][2], B1[2][2];
    const char* cA = GATHER ? (const char*)g.A : (const char*)g.A + (size_t)cur.pa * tstep; const char* cB = (const char*)g.Bt + (size_t)cur.pb * tstep;
    const size_t hstepA = GATHER ? 0 : hstep;
    if constexpr (GATHER) {
#pragma unroll
        for (int i = 0; i < 2; ++i) { vc0[i] = (unsigned)S.a_row(cur, Rr[i]) * (unsigned)(K * 2) + (unsigned)(Cc[i] * 2); vc1[i] = (unsigned)S.a_row(cur, HALF + Rr[i]) * (unsigned)(K * 2) + (unsigned)(Cc[i] * 2); } }
    S.a_ready(cur);
    if constexpr (SP2) {
        PG8_STAGE(PG8_SB(0, 0), cB, voffB); PG8_STAGE(PG8_SB(0, 1), cB + hstep, voffB); PG8_STAGE(PG8_SA(0, 0), cA, vc0); PG8_STAGE(PG8_SA(0, 1), cA + hstepA, vc1);
        if (wr == 1) PG8_BAR;
        PG8_WAIT_V(2); PG8_BAR;
        PG8_STAGE(PG8_SB(1, 0), cB + kstep, voffB); PG8_STAGE(PG8_SA(1, 0), cA + kstep, vc0); PG8_STAGE(PG8_SB(1, 1), cB + hstep + kstep, voffB);
        PG8_WAIT_V(6); PG8_BAR;
    } else {
        PG8_STAGE(PG8_SB(0, 0), cB, voffB); PG8_STAGE(PG8_SA(0, 0), cA, voffA); PG8_STAGE(PG8_SB(0, 1), cB + hstep, voffB); PG8_STAGE(PG8_SA(0, 1), cA + hstep, voffA);
        if (wr == 1) PG8_BAR;
        PG8_WAIT_V(4); PG8_BAR;
        PG8_STAGE(PG8_SB(1, 0), cB + kstep, voffB); PG8_STAGE(PG8_SA(1, 0), cA + kstep, voffA); PG8_STAGE(PG8_SB(1, 1), cB + hstep + kstep, voffB);
        PG8_WAIT_V(6); PG8_BAR;
    }
    for (;;) {
        const bool has_next = S.next(ui + 1, nxt);
        const char* nA = GATHER ? cA : (has_next ? (const char*)g.A + (size_t)nxt.pa * tstep : cA); const char* nB = has_next ? (const char*)g.Bt + (size_t)nxt.pb * tstep : cB;
        if constexpr (GATHER) {
#pragma unroll
            for (int i = 0; i < 2; ++i) { vn0[i] = has_next ? (unsigned)S.a_row(nxt, Rr[i]) * (unsigned)(K * 2) + (unsigned)(Cc[i] * 2) : vc0[i]; vn1[i] = has_next ? (unsigned)S.a_row(nxt, HALF + Rr[i]) * (unsigned)(K * 2) + (unsigned)(Cc[i] * 2) : vc1[i]; } }
        for (int t = 0; t < nt; t += 2) {
            const bool last = (t == nt - 2);
            if constexpr (Epi::MID) { if (t == nt / 2) E.mid(acc, cur, wr, wc, fr, fq); }
            const char* a1 = cA + (size_t)(t + 1) * kstep;
            const char* a2 = last ? nA : cA + (size_t)(t + 2) * kstep; const char* b2 = last ? nB : cB + (size_t)(t + 2) * kstep;
            const char* a3 = a2 + kstep; const char* b3 = b2 + kstep;
            if (last && has_next) S.a_ready(nxt);
            if constexpr (SP2) {
            unsigned w0[2], w1[2];
#pragma unroll
            for (int i = 0; i < 2; ++i) { w0[i] = last ? vn0[i] : vc0[i]; w1[i] = last ? vn1[i] : vc1[i]; }
            PG8_LDB(B0, 0, 0); PG8_LDB(B1, 0, 1); PG8_SCHED; PG8_LDA(At, 0, 0); PG8_STAGE(PG8_SA(1, 1), a1 + hstepA, vc1);
            PG8_WAIT_V(8); PG8_WAIT_L(0); PG8_BAR; PG8_MMA(0, 0, At, B0); PG8_MMA(0, 1, At, B1); PG8_BAR; PG8_SCHED;
            PG8_LDA(At, 0, 1); PG8_STAGE(PG8_SB(0, 0), b2, voffB); PG8_STAGE(PG8_SB(0, 1), b2 + hstep, voffB); PG8_STAGE(PG8_SA(0, 0), a2, w0);
            PG8_WAIT_V(8); PG8_WAIT_L(0); PG8_BAR; PG8_MMA(1, 0, At, B0); PG8_MMA(1, 1, At, B1); PG8_BAR; PG8_SCHED;
            PG8_LDB(B0, 1, 0); PG8_LDB(B1, 1, 1); PG8_SCHED; PG8_LDA(At, 1, 0); PG8_STAGE(PG8_SA(0, 1), a2 + hstepA, w1);
            PG8_WAIT_V(8); PG8_WAIT_L(0); PG8_BAR; PG8_MMA(0, 0, At, B0); PG8_MMA(0, 1, At, B1); PG8_BAR; PG8_SCHED;
            PG8_LDA(At, 1, 1); PG8_STAGE(PG8_SB(1, 0), b3, voffB); PG8_STAGE(PG8_SB(1, 1), b3 + hstep, voffB); PG8_STAGE(PG8_SA(1, 0), a3, w0);
            PG8_WAIT_V(8); PG8_WAIT_L(0); PG8_BAR; PG8_MMA(1, 0, At, B0); PG8_MMA(1, 1, At, B1); PG8_BAR; PG8_SCHED;
            } else {
            PG8_LDB(B0, 0, 0); PG8_SCHED; PG8_LDA(At, 0, 0); PG8_STAGE(PG8_SA(1, 1), a1 + hstep, voffA);
            PG8_WAIT_L(8); PG8_BAR; PG8_WAIT_L(0); PG8_MMA(0, 0, At, B0); PG8_BAR; PG8_SCHED;
            PG8_LDB(B1, 0, 1); PG8_STAGE(PG8_SB(0, 0), b2, voffB);
            PG8_BAR; PG8_WAIT_L(0); PG8_MMA(0, 1, At, B1); PG8_BAR;
            PG8_LDA(At, 0, 1); PG8_STAGE(PG8_SA(0, 0), a2, voffA);
            PG8_BAR; PG8_WAIT_L(0); PG8_MMA(1, 0, At, B0); PG8_BAR; PG8_SCHED;
            PG8_STAGE(PG8_SB(0, 1), b2 + hstep, voffB);
            PG8_WAIT_V(6); PG8_BAR; PG8_MMA(1, 1, At, B1); PG8_BAR;
            PG8_LDB(B0, 1, 0); PG8_SCHED; PG8_LDA(At, 1, 0); PG8_STAGE(PG8_SA(0, 1), a2 + hstep, voffA);
            PG8_WAIT_L(8); PG8_BAR; PG8_WAIT_L(0); PG8_MMA(0, 0, At, B0); PG8_BAR; PG8_SCHED;
            PG8_LDB(B1, 1, 1); PG8_STAGE(PG8_SB(1, 0), b3, voffB);
            PG8_BAR; PG8_WAIT_L(0); PG8_MMA(0, 1, At, B1); PG8_BAR;
            PG8_LDA(At, 1, 1); PG8_STAGE(PG8_SA(1, 0), a3, voffA);
            PG8_BAR; PG8_WAIT_L(0); PG8_MMA(1, 0, At, B0); PG8_BAR; PG8_SCHED;
            PG8_STAGE(PG8_SB(1, 1), b3 + hstep, voffB);
            PG8_WAIT_V(6); PG8_BAR; PG8_MMA(1, 1, At, B1); PG8_BAR;
            }
        }
        if constexpr (ALIGN_EPI) { if (wr == 0) PG8_BAR; }
        if constexpr (!Epi::AFTER_DRAIN) { E(acc, cur, wr, wc, fr, fq); S.done(cur); }
        if (!has_next) break;
#pragma unroll
        for (int a = 0; a < 2; ++a)
#pragma unroll
            for (int b = 0; b < 2; ++b)
#pragma unroll
                for (int m = 0; m < 4; ++m)
#pragma unroll
                    for (int n = 0; n < 2; ++n) acc[a][b][m][n] = (f32x4){0.f, 0.f, 0.f, 0.f};
        cur = nxt; cA = nA; cB = nB; ++ui;
        if constexpr (GATHER) { vc0[0] = vn0[0]; vc0[1] = vn0[1]; vc1[0] = vn1[0]; vc1[1] = vn1[1]; }
        if constexpr (ALIGN_EPI) { if (wr == 1) PG8_BAR; }
    }
    PG8_WAIT_V(0);
    if constexpr (!ALIGN_EPI) { if (wr == 0) PG8_BAR; }
    PG8_BAR;
    if constexpr (Epi::AFTER_DRAIN) { E.fused(acc, cur, wr, wc, fr, fq, lds, wid, lane); S.done(cur); }
#undef PG8_SA
#undef PG8_SB
#undef PG8_STAGE
#undef PG8_LDA
#undef PG8_LDB
#undef PG8_MMA
#undef PG8_WAIT_V
#undef PG8_WAIT_L
#undef PG8_BAR
#undef PG8_SCHED
}
}

#ifndef PG8_SP2
#define PG8_SP2 true
#endif
#ifndef PG8_ALIGN
#define PG8_ALIGN true
#endif
#ifndef DUPSUB
#define DUPSUB 0
#endif
#ifndef TSTAMP
#define TSTAMP 0
#endif
#ifndef USE_CG_SYNC
#define USE_CG_SYNC 0
#endif
#ifndef DUPMASK
#define DUPMASK 0
#define DUPMASK_ON 0
#else
#define DUPMASK_ON 1
#endif
namespace cg = cooperative_groups;
namespace fk {
using pg8::bf16_t; using pg8::f32x4; using pg8::u32x4; using pg8::bf16x8; using pg8::Unit; using pg8::cvt_pk_bf16;
#define LAS __attribute__((address_space(3)))
#define LDS_WAIT() asm volatile("s_waitcnt lgkmcnt(0)" ::: "memory")
typedef unsigned u32x2 __attribute__((ext_vector_type(2)));
constexpr int NB = 8, NS = 4096, NT = NB * NS;
constexpr int NTHREADS = 512, NWAVES = 8, LDS_BYTES = 155648;
constexpr size_t MiB = (size_t)1 << 20;
constexpr size_t WS_ADA = 0, WS_CNT = 256 * 1024,
    WS_WIN = 1 * MiB, WS_WGAB = 9 * MiB, WS_WBA = 13 * MiB, WS_WBB = 14 * MiB, WS_WOUT = 15 * MiB, WS_W13 = 17 * MiB, WS_W2 = 49 * MiB,
    WS_XN = 65 * MiB, WS_QKV = 129 * MiB, WS_IQ = 225 * MiB, WS_GQK = 257 * MiB, WS_GV = 289 * MiB, WS_GR = 321 * MiB,
    WS_IK = 353 * MiB, WS_IW = 355 * MiB, WS_GLR = 357 * MiB, WS_SC = 358 * MiB, WS_MASK = 490 * MiB, WS_ADAP = 506 * MiB, WS_MISC = 509 * MiB;
constexpr int NPROJ = 3584;
constexpr size_t WS_WGT = 400 * 1024;
constexpr int KSL = 16;
constexpr float QSCALE = 0.125f * 1.4426950408889634f;
typedef float f32x2_t __attribute__((ext_vector_type(2))); typedef __bf16 bf16x2_t __attribute__((ext_vector_type(2)));
__device__ __forceinline__ unsigned cvtpk_s(float lo, float hi) { f32x2_t v = {lo, hi}; bf16x2_t b = __builtin_convertvector(v, bf16x2_t); return __builtin_bit_cast(unsigned, b); }
__device__ __forceinline__ void bf8_to_f(const u32x4 w, float* f) {
#pragma unroll
    for (int j = 0; j < 4; ++j) { f[2 * j] = __uint_as_float(w[j] << 16); f[2 * j + 1] = __uint_as_float(w[j] & 0xffff0000u); }
}

__device__ __forceinline__ void tr_item(const float* W, int ldw, int srccol, bf16_t* WT, int K, int dst_row0, int kb, LAS float* scr, int lane, int kdst0 = 0) {
    const int k0 = 64 * kb;
#pragma unroll
    for (int i = 0; i < 32; ++i) { const int kk = 2 * i + (lane >> 5); scr[kk * 33 + (lane & 31)] = W[(size_t)(k0 + kk) * ldw + srccol]; }
    LDS_WAIT();
    const int c = lane & 7;
#pragma unroll
    for (int j = 0; j < 4; ++j) { const int n = (lane >> 3) + 8 * j; const LAS float* s = scr + (8 * c) * 33 + n;
        u32x4 o; o.x = cvt_pk_bf16(s[0 * 33], s[1 * 33]); o.y = cvt_pk_bf16(s[2 * 33], s[3 * 33]); o.z = cvt_pk_bf16(s[4 * 33], s[5 * 33]); o.w = cvt_pk_bf16(s[6 * 33], s[7 * 33]);
        *(u32x4*)(WT + (size_t)(dst_row0 + n) * K + kdst0 + k0 + 8 * c) = o; }
    LDS_WAIT();
}
__device__ __forceinline__ int win_src(int n) {
    if (n < 2048) return n;
    if (n < 3584) return n + 48;
    if (n < 3616) return O_IK + (n - 3584);
    if (n < 3632) return O_IW + (n - 3616);
    return O_GLR + (n - 3632);
}
constexpr int I_ADA = 96 * KSL, I_WIN = 114 * 16, I_WGAB = 64 * 16, I_WB = 32 * 8, I_WOUT = 32 * 16, I_W13 = 32 * 16 * 16, I_W2 = 32 * 32 * 4;
constexpr int P0_ITEMS = I_ADA + I_WIN + I_WGAB + 2 * I_WB + I_WOUT + I_W13 + I_W2, P0_EARLY = I_ADA + I_WIN + I_WGAB + 2 * I_WB + I_WOUT;
__device__ __forceinline__ void p0_item(int it, const float* const* in, unsigned char* ws, LAS float* scr, int lane) {
    if (it < I_ADA) {
        const int cb = it / KSL, ks = it % KSL, k0 = ks * 64; const float* c = in[1]; const float* w = in[3];
#pragma unroll
        for (int b = 0; b < NB; ++b) { const float cv = c[b * D_MODEL + k0 + lane]; scr[b * 64 + lane] = cv / (1.f + __expf(-cv)); }
        LDS_WAIT();
        float acc[NB];
#pragma unroll
        for (int b = 0; b < NB; ++b) acc[b] = 0.f;
        const int col = cb * 64 + lane;
#pragma unroll 16
        for (int kk = 0; kk < 64; ++kk) { const float wv = w[(size_t)(k0 + kk) * (6 * D_MODEL) + col];
#pragma unroll
            for (int b = 0; b < NB; ++b) acc[b] += scr[b * 64 + kk] * wv; }
        float* adap = (float*)(ws + WS_ADAP);
#pragma unroll
        for (int b = 0; b < NB; ++b) adap[(size_t)(ks * NB + b) * (6 * D_MODEL) + col] = acc[b];
        LDS_WAIT(); return;
    }
    it -= I_ADA;
    const int l31 = lane & 31;
    if (it < I_WIN) { const int nb = it / 16, kb = it % 16; tr_item(in[5], D_IN, win_src(nb * 32 + l31), (bf16_t*)(ws + WS_WIN), 1024, nb * 32, kb, scr, lane); return; }
    it -= I_WIN;
    if (it < I_WGAB) { const int nb = it / 16, kb = it % 16; tr_item(in[5], D_IN, O_GA + nb * 32 + l31, (bf16_t*)(ws + WS_WGAB), 1024, nb * 32, kb, scr, lane); return; }
    it -= I_WGAB;
    if (it < I_WB) { const int nb = it / 8, kb = it % 8; tr_item(in[9], D_MODEL, nb * 32 + l31, (bf16_t*)(ws + WS_WBA), 1024, nb * 32, kb, scr, lane, 0); return; }
    it -= I_WB;
    if (it < I_WB) { const int nb = it / 8, kb = it % 8; tr_item(in[10], D_MODEL, nb * 32 + l31, (bf16_t*)(ws + WS_WBA), 1024, nb * 32, kb, scr, lane, 512); return; }
    it -= I_WB;
    if (it < I_WOUT) { const int nb = it / 16, kb = it % 16; tr_item(in[11], D_MODEL, nb * 32 + l31, (bf16_t*)(ws + WS_WOUT), 1024, nb * 32, kb, scr, lane); return; }
    it -= I_WOUT;
    if (it < I_W13) {
        const int e = it / 256, r = it % 256, nb = r / 16, kb = r % 16; const int row0 = nb * 32;
        const int half = (row0 & 255) >> 7; const int col = (row0 >> 8) * 128 + (row0 & 127) + l31;
        const float* src = (half ? in[19] : in[18]) + (size_t)e * D_MODEL * D_EXP;
        tr_item(src, D_EXP, col, (bf16_t*)(ws + WS_W13) + (size_t)e * 512 * 1024, 1024, row0, kb, scr, lane); return; }
    it -= I_W13;
    { const int e = it / 128, r = it % 128, nb = r / 4, kb = r % 4;
      tr_item(in[20] + (size_t)e * D_EXP * D_MODEL, D_MODEL, nb * 32 + l31, (bf16_t*)(ws + WS_W2) + (size_t)e * 1024 * 256, 256, nb * 32, kb, scr, lane); }
}

__device__ __forceinline__ float dpp_row_sum_f(float v) {
    v += __int_as_float(__builtin_amdgcn_update_dpp(0, __float_as_int(v), 0xB1, 0xF, 0xF, true));
    v += __int_as_float(__builtin_amdgcn_update_dpp(0, __float_as_int(v), 0x4E, 0xF, 0xF, true));
    v += __int_as_float(__builtin_amdgcn_update_dpp(0, __float_as_int(v), 0x141, 0xF, 0xF, true));
    v += __int_as_float(__builtin_amdgcn_update_dpp(0, __float_as_int(v), 0x140, 0xF, 0xF, true));
    return v;
}
__device__ __forceinline__ float wave_sum_u(float v) {
    v = dpp_row_sum_f(v);
    return (__int_as_float(__builtin_amdgcn_readlane(__float_as_int(v), 0)) + __int_as_float(__builtin_amdgcn_readlane(__float_as_int(v), 16)))
         + (__int_as_float(__builtin_amdgcn_readlane(__float_as_int(v), 32)) + __int_as_float(__builtin_amdgcn_readlane(__float_as_int(v), 48)));
}
template <int R> __device__ __forceinline__ void ln_center(f32x4 (&v)[R][4], float (&rstd)[R], float* meanout = nullptr) {
    float s[R];
#pragma unroll
    for (int r = 0; r < R; ++r) { s[r] = 0.f;
#pragma unroll
        for (int j = 0; j < 4; ++j) s[r] += (v[r][j].x + v[r][j].y) + (v[r][j].z + v[r][j].w); }
#pragma unroll
    for (int r = 0; r < R; ++r) s[r] = dpp_row_sum_f(s[r]);
    float q[R];
#pragma unroll
    for (int r = 0; r < R; ++r) { const float mean = ((__int_as_float(__builtin_amdgcn_readlane(__float_as_int(s[r]), 0)) + __int_as_float(__builtin_amdgcn_readlane(__float_as_int(s[r]), 16)))
                                                   + (__int_as_float(__builtin_amdgcn_readlane(__float_as_int(s[r]), 32)) + __int_as_float(__builtin_amdgcn_readlane(__float_as_int(s[r]), 48)))) * (1.f / D_MODEL);
        if (meanout) meanout[r] = mean;
        q[r] = 0.f;
#pragma unroll
        for (int j = 0; j < 4; ++j) { v[r][j] = v[r][j] - mean; q[r] += (v[r][j].x * v[r][j].x + v[r][j].y * v[r][j].y) + (v[r][j].z * v[r][j].z + v[r][j].w * v[r][j].w); } }
#pragma unroll
    for (int r = 0; r < R; ++r) q[r] = dpp_row_sum_f(q[r]);
#pragma unroll
    for (int r = 0; r < R; ++r) { const float var = ((__int_as_float(__builtin_amdgcn_readlane(__float_as_int(q[r]), 0)) + __int_as_float(__builtin_amdgcn_readlane(__float_as_int(q[r]), 16)))
                                                  + (__int_as_float(__builtin_amdgcn_readlane(__float_as_int(q[r]), 32)) + __int_as_float(__builtin_amdgcn_readlane(__float_as_int(q[r]), 48)))) * (1.f / D_MODEL);
        rstd[r] = 1.f / sqrtf(var + LN_EPS); }
}
__device__ __forceinline__ float wave_sum(float v) {
#pragma unroll
    for (int o = 1; o < 64; o <<= 1) v += __shfl_xor(v, o);
    return v;
}
__device__ __forceinline__ float ada_sum(const float* adap, const float* b_ada, int b, int j) {
    float s = b_ada[j];
#pragma unroll
    for (int k = 0; k < KSL; ++k) s += adap[(size_t)(k * NB + b) * (6 * D_MODEL) + j];
    return s;
}
__device__ __forceinline__ void p1_phase(const float* const* in, unsigned char* ws, LAS unsigned char* lds, int G) {
    const int tid = threadIdx.x, lane = tid & 63, wave = tid >> 6;
    const float* adap = (const float*)(ws + WS_ADAP); const float* b_ada = in[4]; const float* x = in[0];
    LAS float* sh = (LAS float*)lds; LAS float* sc = sh + D_MODEL;
    for (int blk = blockIdx.x; blk < NT / 128; blk += G) {
        const int b = blk / 32;
        __syncthreads();
        for (int j = tid; j < 2 * D_MODEL; j += NTHREADS) sh[j] = ada_sum(adap, b_ada, b, j);
        if ((blk & 31) == 0) { float* ada = (float*)(ws + WS_ADA) + (size_t)b * 6 * D_MODEL; for (int j = tid; j < 6 * D_MODEL; j += NTHREADS) ada[j] = ada_sum(adap, b_ada, b, j); }
        __syncthreads();
        for (int rb = 0; rb < 16; rb += 4) {
            const size_t row0 = (size_t)blk * 128 + wave * 16 + rb;
            f32x4 v[4][4];
#pragma unroll
            for (int r = 0; r < 4; ++r) { const f32x4* xr = (const f32x4*)(x + (row0 + r) * D_MODEL) + lane;
#pragma unroll
                for (int j = 0; j < 4; ++j) v[r][j] = xr[64 * j]; }
            float rstd[4]; ln_center<4>(v, rstd);
#pragma unroll
            for (int j = 0; j < 4; ++j) { const f32x4 a = *(const LAS f32x4*)(sc + 256 * j + 4 * lane) + 1.f, c = *(const LAS f32x4*)(sh + 256 * j + 4 * lane);
#pragma unroll
                for (int r = 0; r < 4; ++r) { const f32x4 y = v[r][j] * rstd[r] * a + c; u32x2 w; w.x = cvtpk_s(y.x, y.y); w.y = cvtpk_s(y.z, y.w);
                    ((u32x2*)((bf16_t*)(ws + WS_XN) + (row0 + r) * D_MODEL) + lane)[64 * j] = w; } }
        }
        asm volatile("s_waitcnt vmcnt(0)" ::: "memory"); __syncthreads();
        {   LAS unsigned char* W64 = lds + 8192; constexpr int WP = 2064;
            const bf16_t* wsrc = (const bf16_t*)(ws + WS_WIN) + (size_t)3584 * 1024;
            for (int i = tid; i < 64 * 128; i += NTHREADS) { const int n = i >> 7, c = i & 127; *(LAS u32x4*)(W64 + n * WP + c * 16) = *(const u32x4*)(wsrc + (size_t)n * 1024 + c * 8); }
            __syncthreads();
            const int fr = lane & 15, fq = lane >> 4; const size_t rowA = (size_t)blk * 128 + wave * 16 + fr;
            const bf16_t* xp = (const bf16_t*)(ws + WS_XN) + rowA * D_MODEL + 8 * fq;
            f32x4 acc[4];
#pragma unroll
            for (int nt = 0; nt < 4; ++nt) acc[nt] = (f32x4){0.f, 0.f, 0.f, 0.f};
#pragma unroll 8
            for (int ks = 0; ks < 32; ++ks) { const bf16x8 bfr = *(const bf16x8*)(xp + 32 * ks);
#pragma unroll
                for (int nt = 0; nt < 4; ++nt) { const bf16x8 afr = *(const LAS bf16x8*)(W64 + (16 * nt + fr) * WP + (32 * ks + 8 * fq) * 2); acc[nt] = __builtin_amdgcn_mfma_f32_16x16x32_bf16(afr, bfr, acc[nt], 0, 0, 0); } }
            { u32x2 w; w.x = cvtpk_s(acc[0][0], acc[0][1]); w.y = cvtpk_s(acc[0][2], acc[0][3]); *(u32x2*)((bf16_t*)(ws + WS_IK) + rowA * 32 + 4 * fq) = w;
              w.x = cvtpk_s(acc[1][0], acc[1][1]); w.y = cvtpk_s(acc[1][2], acc[1][3]); *(u32x2*)((bf16_t*)(ws + WS_IK) + rowA * 32 + 16 + 4 * fq) = w;
              *(f32x4*)((float*)(ws + WS_IW) + rowA * 16 + 4 * fq) = acc[2];
              w.x = cvtpk_s(acc[3][0], acc[3][1]); w.y = cvtpk_s(acc[3][2], acc[3][3]); *(u32x2*)((bf16_t*)(ws + WS_GLR) + rowA * 16 + 4 * fq) = w; }
        }
    }
}

struct EpiProj {
    static constexpr bool PERM = true, AFTER_DRAIN = false, MID = false;
    unsigned char* ws;
    __device__ __forceinline__ void operator()(const f32x4 (&acc)[2][2][4][2], const Unit& u, int wr, int wc, int fr, int fq) const {
        const int row0 = u.pm * 256 + wr * 64 + fr; const int pn = u.pn;
        {
            bf16_t* base; int ld, ct; float sc = 1.f;
            if (pn < 6) { base = (bf16_t*)(ws + WS_QKV); ld = 1536; ct = pn * 256; if (pn < 2) sc = QSCALE; }
            else if (pn < 8) { base = (bf16_t*)(ws + WS_IQ); ld = 512; ct = (pn - 6) * 256; }
            else if (pn < 10) { base = (bf16_t*)(ws + WS_GQK); ld = 512; ct = (pn - 8) * 256; }
            else if (pn < 12) { base = (bf16_t*)(ws + WS_GV); ld = 512; ct = (pn - 10) * 256; }
            else { base = (bf16_t*)(ws + WS_GR); ld = 512; ct = (pn - 12) * 256; }
            const int col0 = ct + wc * 32 + 8 * fq;
#pragma unroll
            for (int ai = 0; ai < 2; ++ai)
#pragma unroll
                for (int m = 0; m < 4; ++m) { bf16_t* rowp = base + (size_t)(row0 + ai * 128 + m * 16) * ld + col0;
#pragma unroll
                    for (int bj = 0; bj < 2; ++bj) { const f32x4 v0 = acc[ai][bj][m][0] * sc, v1 = acc[ai][bj][m][1] * sc;
                        u32x4 w; w.x = cvt_pk_bf16(v0[0], v0[1]); w.y = cvt_pk_bf16(v0[2], v0[3]); w.z = cvt_pk_bf16(v1[0], v1[1]); w.w = cvt_pk_bf16(v1[2], v1[3]);
                        *(u32x4*)(rowp + bj * 128) = w; } }
        }
    }
};

typedef float f32x4_t __attribute__((ext_vector_type(4)));
constexpr int SC_TILES_PER_B = 528, SC_ITEMS = NB * SC_TILES_PER_B;
__device__ __forceinline__ size_t keys_row_dw(int b, int t) {
    const int qi = t >> 7, r = t & 127; return (size_t)b * (SC_TILES_PER_B * 8192) + (size_t)8192 * (qi * (qi + 1) / 2) + (size_t)r * (qi + 1) * 64;
}
__device__ __forceinline__ unsigned score_key(float sc) {
    const _Float16 hf = (_Float16)sc; const unsigned short hb = __builtin_bit_cast(unsigned short, hf);
    return (hb & 0x8000u) ? (unsigned)(unsigned short)~hb : (unsigned)(hb | 0x8000u);
}
__device__ __forceinline__ void fma_abs4(f32x4& acc, const f32x4& d, float w) {
    float a0 = acc[0], a1 = acc[1], a2 = acc[2], a3 = acc[3];
    asm volatile("v_fma_f32 %0, |%4|, %8, %0\n\tv_fma_f32 %1, |%5|, %8, %1\n\tv_fma_f32 %2, |%6|, %8, %2\n\tv_fma_f32 %3, |%7|, %8, %3"
                 : "+v"(a0), "+v"(a1), "+v"(a2), "+v"(a3) : "v"(d[0]), "v"(d[1]), "v"(d[2]), "v"(d[3]), "v"(w));
    acc[0] = a0; acc[1] = a1; acc[2] = a2; acc[3] = a3;
}
constexpr int SC_SEGS_PER_B = 144, SC_SEGS = NB * SC_SEGS_PER_B;
__device__ __forceinline__ unsigned score_key2(float lo, float hi) {
    typedef _Float16 h2 __attribute__((ext_vector_type(2)));
    const unsigned x = __builtin_bit_cast(unsigned, __builtin_amdgcn_cvt_pkrtz(lo, hi));
    unsigned m; asm("v_pk_ashrrev_i16 %0, %2, %1" : "=v"(m) : "v"(x), "v"(0x000F000Fu));
    return x ^ (m | 0x80008000u);
}
__device__ __forceinline__ void p3a_run(int b, int qi, int kj0, int kj1, unsigned char* ws, LAS unsigned char* ldsw, int wave, int lane) {
    const int fr = lane & 15, fq = lane >> 4;
    const int t = qi * 128 + wave * 16 + fr; const size_t trow = (size_t)b * NS + t;
    const bf16_t* IQ = (const bf16_t*)(ws + WS_IQ) + trow * 512 + 8 * fq;
    const bf16_t* IK = (const bf16_t*)(ws + WS_IK) + ((size_t)b * NS + fr) * 32 + 8 * fq;
    const float* IW = (const float*)(ws + WS_IW) + trow * 16;
    LAS unsigned char* QL = ldsw; LAS float* WL = (LAS float*)(ldsw + 16384);
    bf16x8 kf[8];
#pragma unroll
    for (int kb = 0; kb < 8; ++kb) kf[kb] = *(const bf16x8*)(IK + ((size_t)kj0 * 128 + kb * 16) * 32);
    float qb[8];
#pragma unroll
    for (int j = 0; j < 8; ++j) qb[j] = 0.f;
#pragma unroll
    for (int hg = 0; hg < 4; ++hg) {
        const f32x4 w4 = *(const f32x4*)(IW + 4 * hg) * (0.5f * 0.044194173824159216f);
        u32x4 q4[4];
#pragma unroll
        for (int i = 0; i < 4; ++i) q4[i] = *(const u32x4*)(IQ + (4 * hg + i) * 32);
#pragma unroll
        for (int i = 0; i < 4; ++i) { *(LAS u32x4*)(QL + (4 * hg + i) * 1024 + lane * 16) = q4[i]; if (fq == 0) WL[(4 * hg + i) * 16 + fr] = w4[i]; float f[8]; bf8_to_f(q4[i], f);
#pragma unroll
            for (int j = 0; j < 8; ++j) qb[j] += w4[i] * f[j]; }
    }
    u32x4 qbw; qbw.x = cvtpk_s(qb[0], qb[1]); qbw.y = cvtpk_s(qb[2], qb[3]); qbw.z = cvtpk_s(qb[4], qb[5]); qbw.w = cvtpk_s(qb[6], qb[7]);
    const bf16x8 qbar = __builtin_bit_cast(bf16x8, qbw);
    LDS_WAIT();
    for (int kj = kj0; kj <= kj1; ++kj) {
        bf16x8 kn[8];
        const int kjn = (kj < kj1) ? kj + 1 : kj;
#pragma unroll
        for (int kb = 0; kb < 8; ++kb) kn[kb] = *(const bf16x8*)(IK + ((size_t)kjn * 128 + kb * 16) * 32);
        f32x4 acc[8];
#pragma unroll
        for (int kb = 0; kb < 8; ++kb) acc[kb] = __builtin_amdgcn_mfma_f32_16x16x32_bf16(kf[kb], qbar, (f32x4){0.f, 0.f, 0.f, 0.f}, 0, 0, 0);
        f32x4 dA[8], dB[8];
        { const bf16x8 qf = *(const LAS bf16x8*)(QL + lane * 16);
#pragma unroll
          for (int kb = 0; kb < 8; ++kb) dA[kb] = __builtin_amdgcn_mfma_f32_16x16x32_bf16(kf[kb], qf, (f32x4){0.f, 0.f, 0.f, 0.f}, 0, 0, 0); }
#pragma unroll 1
        for (int h = 0; h < I_HEADS; h += 2) {
            { const bf16x8 qf = *(const LAS bf16x8*)(QL + (h + 1) * 1024 + lane * 16);
#pragma unroll
              for (int kb = 0; kb < 8; ++kb) dB[kb] = __builtin_amdgcn_mfma_f32_16x16x32_bf16(kf[kb], qf, (f32x4){0.f, 0.f, 0.f, 0.f}, 0, 0, 0); }
            __builtin_amdgcn_sched_barrier(0);
            { const float w = WL[h * 16 + fr];
#pragma unroll
              for (int kb = 0; kb < 8; ++kb) fma_abs4(acc[kb], dA[kb], w); }
            __builtin_amdgcn_sched_barrier(0);
            { const int hn = (h + 2 < I_HEADS) ? h + 2 : h; const bf16x8 qf = *(const LAS bf16x8*)(QL + hn * 1024 + lane * 16);
#pragma unroll
              for (int kb = 0; kb < 8; ++kb) dA[kb] = __builtin_amdgcn_mfma_f32_16x16x32_bf16(kf[kb], qf, (f32x4){0.f, 0.f, 0.f, 0.f}, 0, 0, 0); }
            __builtin_amdgcn_sched_barrier(0);
            { const float w = WL[(h + 1) * 16 + fr];
#pragma unroll
              for (int kb = 0; kb < 8; ++kb) fma_abs4(acc[kb], dB[kb], w); }
            __builtin_amdgcn_sched_barrier(0);
        }
        unsigned* KEYS = (unsigned*)(ws + WS_SC) + keys_row_dw(b, t) + (size_t)kj * 64;
        const bool diag = (kj == qi);
#pragma unroll
        for (int kb = 0; kb < 4; ++kb) { u32x4 o;
#pragma unroll
            for (int r = 0; r < 4; ++r) o[r] = score_key2(acc[kb][r], acc[kb + 4][r]);
            if (diag) { asm volatile("" ::: "memory");
#pragma unroll
                for (int r = 0; r < 4; ++r) { const int sl = kb * 16 + 4 * fq + r, tl = wave * 16 + fr; if (sl > tl) o[r] &= 0xFFFF0000u; if (sl + 64 > tl) o[r] &= 0x0000FFFFu; } }
            *(u32x4*)(KEYS + kb * 16 + 4 * fq) = o; }
#pragma unroll
        for (int kb = 0; kb < 8; ++kb) kf[kb] = kn[kb];
    }
    LDS_WAIT();
}

__device__ __forceinline__ int dpp_row_sum(int v) {
    v += __builtin_amdgcn_update_dpp(0, v, 0xB1, 0xF, 0xF, true);
    v += __builtin_amdgcn_update_dpp(0, v, 0x4E, 0xF, 0xF, true);
    v += __builtin_amdgcn_update_dpp(0, v, 0x141, 0xF, 0xF, true);
    v += __builtin_amdgcn_update_dpp(0, v, 0x140, 0xF, 0xF, true);
    return v;
}
__device__ __forceinline__ int wave_sum_i(int v) {
    v = dpp_row_sum(v);
    return __builtin_amdgcn_readlane(v, 0) + __builtin_amdgcn_readlane(v, 16) + __builtin_amdgcn_readlane(v, 32) + __builtin_amdgcn_readlane(v, 48);
}
__device__ __forceinline__ void pk_ge_count4(unsigned x0, unsigned x1, unsigned x2, unsigned x3, unsigned c2m1, unsigned one2, unsigned& c0, unsigned& c1, unsigned& c2, unsigned& c3) {
    unsigned d0, d1, d2, d3;
    asm volatile("v_pk_sub_u16 %0, %8, %12 clamp\n\tv_pk_sub_u16 %1, %9, %12 clamp\n\tv_pk_sub_u16 %2, %10, %12 clamp\n\tv_pk_sub_u16 %3, %11, %12 clamp\n\t"
                 "v_pk_min_u16 %0, %0, %13\n\tv_pk_min_u16 %1, %1, %13\n\tv_pk_min_u16 %2, %2, %13\n\tv_pk_min_u16 %3, %3, %13\n\t"
                 "v_pk_add_u16 %4, %4, %0\n\tv_pk_add_u16 %5, %5, %1\n\tv_pk_add_u16 %6, %6, %2\n\tv_pk_add_u16 %7, %7, %3"
                 : "=&v"(d0), "=&v"(d1), "=&v"(d2), "=&v"(d3), "+v"(c0), "+v"(c1), "+v"(c2), "+v"(c3) : "v"(x0), "v"(x1), "v"(x2), "v"(x3), "v"(c2m1), "v"(one2));
}
constexpr int TOPK = 256;
__device__ __forceinline__ int count_ge(const unsigned (&x)[32], int ng, unsigned cand) {
    const unsigned c2m1 = (cand - 1u) * 0x00010001u, one2 = 0x00010001u; unsigned c0 = 0u, c1 = 0u, c2 = 0u, c3 = 0u;
#pragma unroll
    for (int g = 0; g < 4; ++g) if (g < ng) { pk_ge_count4(x[8 * g], x[8 * g + 1], x[8 * g + 2], x[8 * g + 3], c2m1, one2, c0, c1, c2, c3); pk_ge_count4(x[8 * g + 4], x[8 * g + 5], x[8 * g + 6], x[8 * g + 7], c2m1, one2, c0, c1, c2, c3); }
    const unsigned s = (c0 + c1) + (c2 + c3);
    return wave_sum_i((int)((s & 0xFFFFu) + (s >> 16)));
}
__device__ __forceinline__ void p4a_load(int row_, unsigned char* ws, int lane, unsigned (&x)[32]) {
    const int row = __builtin_amdgcn_readfirstlane(row_); const int b = row / NS, t = row % NS; const int nc = (t >> 7) + 1;
    const unsigned* KEYS = (const unsigned*)(ws + WS_SC) + keys_row_dw(b, t); const unsigned* DEADK = (const unsigned*)(ws + 392 * 1024);
#pragma unroll
    for (int c = 0; c < 32; ++c) { const unsigned* base = c < nc ? KEYS + c * 64 : DEADK; x[c] = base[lane]; }
}
__device__ __forceinline__ int scan16_incl(int v) {
    v += __builtin_amdgcn_update_dpp(0, v, 0x111, 0xF, 0xF, true);
    v += __builtin_amdgcn_update_dpp(0, v, 0x112, 0xF, 0xF, true);
    v += __builtin_amdgcn_update_dpp(0, v, 0x114, 0xF, 0xF, true);
    v += __builtin_amdgcn_update_dpp(0, v, 0x118, 0xF, 0xF, true);
    return v;
}
__device__ __forceinline__ int scan64_incl(int v, int lane) {
    v = scan16_incl(v);
    const int t0 = __builtin_amdgcn_readlane(v, 15), t1 = __builtin_amdgcn_readlane(v, 31), t2 = __builtin_amdgcn_readlane(v, 47);
    return v + (lane >= 16 ? t0 : 0) + (lane >= 32 ? t1 : 0) + (lane >= 48 ? t2 : 0);
}
__device__ __forceinline__ unsigned bin_lo(unsigned x, unsigned hb) { unsigned a; asm("v_bfe_u32 %0, %1, 6, 10\n\tv_lshl_add_u32 %0, %0, 2, %2" : "=&v"(a) : "v"(x), "s"(hb)); return a; }
__device__ __forceinline__ unsigned bin_hi(unsigned x, unsigned hb) { unsigned a; asm("v_lshrrev_b32 %0, 22, %1\n\tv_lshl_add_u32 %0, %0, 2, %2" : "=&v"(a) : "v"(x), "s"(hb)); return a; }
__device__ __forceinline__ void lds_inc(unsigned addr) { __hip_atomic_fetch_add((LAS unsigned*)(unsigned long)addr, 1u, __ATOMIC_RELAXED, __HIP_MEMORY_SCOPE_WORKGROUP); }
#define WAVE_LDS_ORDER() do { asm volatile("" ::: "memory"); __builtin_amdgcn_fence(__ATOMIC_ACQ_REL, "wavefront"); __builtin_amdgcn_wave_barrier(); asm volatile("" ::: "memory"); } while (0)
constexpr int SEL_LDS = 8192;
__device__ __forceinline__ void tie_fix(unsigned long long& m, unsigned long long e, int& run, int need) {
    if (e != 0ull) { const int n = __builtin_popcountll(e); int keep = need - run; run += n;
        if (keep < n) { if (keep < 0) keep = 0; unsigned long long d = e; for (int i = 0; i < keep; ++i) d &= d - 1ull; m &= ~d; } }
}
#define PUT4(mw0, mw1, a0, a1, a2, a3, L0) asm volatile("s_nop 3\n\tv_writelane_b32 %0, %2, %10\n\tv_writelane_b32 %1, %3, %10\n\tv_writelane_b32 %0, %4, %11\n\tv_writelane_b32 %1, %5, %11\n\t" \
        "v_writelane_b32 %0, %6, %12\n\tv_writelane_b32 %1, %7, %12\n\tv_writelane_b32 %0, %8, %13\n\tv_writelane_b32 %1, %9, %13" : "+v"(mw0), "+v"(mw1) \
        : "s"((unsigned)(a0)), "s"((unsigned)((a0) >> 32)), "s"((unsigned)(a1)), "s"((unsigned)((a1) >> 32)), "s"((unsigned)(a2)), "s"((unsigned)((a2) >> 32)), "s"((unsigned)(a3)), "s"((unsigned)((a3) >> 32)), \
          "n"(L0), "n"((L0) + 1), "n"((L0) + 2), "n"((L0) + 3))
__device__ __forceinline__ void p4a_row(int row_, unsigned char* ws, int lane, const unsigned (&x)[32], LAS unsigned char* H) {
    const int row = __builtin_amdgcn_readfirstlane(row_);
    const int t = row % NS; unsigned long long* MASK = (unsigned long long*)(ws + WS_MASK) + (size_t)row * 64;
    const int nc = (t >> 7) + 1;
    if (t < TOPK) {
        if (lane < 2 * nc) { const int lo = lane * 64; unsigned long long m = 0ull; if (t >= lo + 63) m = ~0ull; else if (t >= lo) m = (2ull << (t - lo)) - 1ull; MASK[lane] = m; }
        return;
    }
    const unsigned hb = (unsigned)(unsigned long)H;
    { const u32x4 z = (u32x4){0u, 0u, 0u, 0u};
#pragma unroll
      for (int i = 0; i < 4; ++i) *(LAS u32x4*)(H + i * 1024 + lane * 16) = z;
      *(LAS unsigned*)(H + 4096 + lane * 4) = 0u; }
    WAVE_LDS_ORDER();
#pragma unroll
    for (int c = 0; c < 32; c += 2) if (c < nc) {
        lds_inc(bin_lo(x[c], hb)); lds_inc(bin_hi(x[c], hb)); lds_inc(bin_lo(x[c + 1], hb)); lds_inc(bin_hi(x[c + 1], hb)); }
    WAVE_LDS_ORDER();
    int Bsel, cA;
    {   const LAS unsigned char* hp = H + (63 - lane) * 64;
        const u32x4 h0 = *(const LAS u32x4*)hp, h1 = *(const LAS u32x4*)(hp + 16), h2 = *(const LAS u32x4*)(hp + 32), h3 = *(const LAS u32x4*)(hp + 48);
        const int sl = (int)(((h0.x + h0.y) + (h0.z + h0.w)) + ((h1.x + h1.y) + (h1.z + h1.w)) + ((h2.x + h2.y) + (h2.z + h2.w)) + ((h3.x + h3.y) + (h3.z + h3.w)));
        const int P = scan64_incl(sl, lane);
        const int Ls = __builtin_ctzll(__ballot(P >= TOPK));
        const int E = __builtin_amdgcn_readlane(P - sl, Ls);
        const int hj = (int)*(const LAS unsigned*)(H + ((63 - Ls) * 16 + 15 - (lane & 15)) * 4);
        const int Pj = scan16_incl(hj);
        const int jl = __builtin_ctzll(__ballot(E + Pj >= TOPK) & 0xFFFFull);
        Bsel = (63 - Ls) * 16 + 15 - jl; cA = E + __builtin_amdgcn_readlane(Pj - hj, jl);
    }
    {   const unsigned Bs2 = ((unsigned)Bsel << 6) * 0x00010001u; const unsigned dump = 64u + (unsigned)lane, hb2 = hb + 4096u;
#pragma unroll
        for (int c = 0; c < 32; c += 2) if (c < nc) {
#pragma unroll
            for (int i = 0; i < 2; ++i) { const unsigned y = x[c + i] ^ Bs2;
                const unsigned il = (unsigned)(unsigned short)__builtin_elementwise_min((unsigned short)y, (unsigned short)dump), ih = __builtin_elementwise_min(y >> 16, dump);
                lds_inc((il << 2) + hb2); lds_inc((ih << 2) + hb2); } }
    }
    WAVE_LDS_ORDER();
    unsigned T; int cT, need;
    {   const int c2 = (int)*(const LAS unsigned*)(H + 4096 + (63 - lane) * 4);
        const int P2 = scan64_incl(c2, lane);
        const int L2 = __builtin_ctzll(__ballot(cA + P2 >= TOPK));
        cT = cA + __builtin_amdgcn_readlane(P2, L2); need = TOPK - (cT - __builtin_amdgcn_readlane(c2, L2));
        T = ((unsigned)Bsel << 6) + (unsigned)(63 - L2);
    }
    unsigned mw0 = 0u, mw1 = 0u;
    const bool tie = (cT != TOPK);
    const unsigned Th = T << 16; const unsigned short Ts = (unsigned short)T; int run = 0;
#pragma unroll
    for (int c = 0; c < 32; c += 2) if (c < nc) {
        unsigned long long a0 = __ballot((unsigned short)x[c] >= Ts), a1 = __ballot(x[c] >= Th), a2 = __ballot((unsigned short)x[c + 1] >= Ts), a3 = __ballot(x[c + 1] >= Th);
        if (tie) {
            const unsigned long long e0 = __ballot((unsigned short)x[c] == Ts), e1 = __ballot((x[c] >> 16) == T), e2 = __ballot((unsigned short)x[c + 1] == Ts), e3 = __ballot((x[c + 1] >> 16) == T);
            tie_fix(a0, e0, run, need); tie_fix(a1, e1, run, need); tie_fix(a2, e2, run, need); tie_fix(a3, e3, run, need);
        }
        PUT4(mw0, mw1, a0, a1, a2, a3, 2 * c);
    }
    if (lane < 2 * nc) MASK[lane] = ((unsigned long long)mw1 << 32) | mw0;
}

typedef float f32x16 __attribute__((ext_vector_type(16)));
typedef short s16x4 __attribute__((ext_vector_type(4)));
__device__ __forceinline__ int crow(int r, int hi) { return (r & 3) + 8 * (r >> 2) + 4 * hi; }
__device__ __forceinline__ s16x4 vtr(const LAS unsigned char* p) { return __builtin_bit_cast(s16x4, __builtin_amdgcn_ds_read_tr16_b64_v4i16((LAS s16x4*)p)); }
constexpr size_t WS_OAB = 358 * MiB;
constexpr int AT_ROWB = 144, AT_TILE = 64 * AT_ROWB;
constexpr int AT_VROWB = 192, AT_VTILE = 64 * AT_VROWB;
constexpr float LOG2E = 1.4426950408889634f;
constexpr float ATHR = 8.f;
__device__ __forceinline__ int sext_bit(unsigned w, int c) { int r; asm("v_bfe_i32 %0, %1, %2, 1" : "=v"(r) : "v"(w), "n"(c)); return r; }
__device__ __forceinline__ void attn_s(const LAS unsigned char* Kb, const LAS float* BT, const bf16x8 (&qr)[4], unsigned long long mword, bool far, bool first, int dist0,
                                       int r32, int hh, f32x16& o0, f32x16& o1, f32x16& o2, f32x16& nmB, float& mref, u32x4 (&pk)[4]) {
    f32x16 p0, p1;
#pragma unroll
    for (int ks = 0; ks < 4; ++ks) {
        const bf16x8 k0 = *(const LAS bf16x8*)(Kb + r32 * AT_ROWB + 32 * ks + 16 * hh);
        const bf16x8 k1 = *(const LAS bf16x8*)(Kb + (32 + r32) * AT_ROWB + 32 * ks + 16 * hh);
        if (ks == 0) { p0 = __builtin_amdgcn_mfma_f32_32x32x16_bf16(k0, qr[0], nmB, 0, 0, 0); p1 = __builtin_amdgcn_mfma_f32_32x32x16_bf16(k1, qr[0], nmB, 0, 0, 0); }
        else { p0 = __builtin_amdgcn_mfma_f32_32x32x16_bf16(k0, qr[ks], p0, 0, 0, 0); p1 = __builtin_amdgcn_mfma_f32_32x32x16_bf16(k1, qr[ks], p1, 0, 0, 0); }
    }
    if (!far) {
        const LAS float* bp = BT + (96 - 27 - 32) + dist0;
#pragma unroll
        for (int i = 0; i < 16; ++i) { const int c = (i & 3) + 8 * (i >> 2); p0[i] += bp[32 + 27 - c]; p1[i] += bp[27 - c]; }
    }
    float m0 = __builtin_fmaxf(__builtin_fmaxf(p0[0], p0[1]), p0[2]), m1 = __builtin_fmaxf(__builtin_fmaxf(p1[0], p1[1]), p1[2]);
#pragma unroll
    for (int i = 3; i < 15; i += 2) { m0 = __builtin_fmaxf(__builtin_fmaxf(m0, p0[i]), p0[i + 1]); m1 = __builtin_fmaxf(__builtin_fmaxf(m1, p1[i]), p1[i + 1]); }
    float mx = __builtin_fmaxf(__builtin_fmaxf(m0, m1), __builtin_fmaxf(p0[15], p1[15]));
    { const auto rr = __builtin_amdgcn_permlane32_swap(__float_as_uint(mx), __float_as_uint(mx), false, false); mx = __builtin_fmaxf(__uint_as_float(rr[0]), __uint_as_float(rr[1])); }
    if (first || __any(mx > ATHR)) {
        const float dl = (first || mx > ATHR) ? mx : 0.f; mref += dl; const float f = __builtin_amdgcn_exp2f(-dl);
#pragma unroll
        for (int i = 0; i < 16; ++i) { p0[i] -= dl; p1[i] -= dl; nmB[i] -= dl; o0[i] *= f; o1[i] *= f; o2[i] *= f; }
    }
    const unsigned wl = (unsigned)mword >> (4 * hh), wh = (unsigned)(mword >> 32) >> (4 * hh);
#pragma unroll
    for (int i = 0; i < 16; ++i) { const int c = (i & 3) + 8 * (i >> 2);
        p0[i] = __uint_as_float(__float_as_uint(__builtin_amdgcn_exp2f(p0[i])) & (unsigned)sext_bit(wl, c));
        p1[i] = __uint_as_float(__float_as_uint(__builtin_amdgcn_exp2f(p1[i])) & (unsigned)sext_bit(wh, c)); }
#pragma unroll
    for (int s2 = 0; s2 < 2; ++s2) {
        pk[s2].x = cvtpk_s(p0[8 * s2], p0[8 * s2 + 1]); pk[s2].y = cvtpk_s(p0[8 * s2 + 2], p0[8 * s2 + 3]); pk[s2].z = cvtpk_s(p0[8 * s2 + 4], p0[8 * s2 + 5]); pk[s2].w = cvtpk_s(p0[8 * s2 + 6], p0[8 * s2 + 7]);
        pk[2 + s2].x = cvtpk_s(p1[8 * s2], p1[8 * s2 + 1]); pk[2 + s2].y = cvtpk_s(p1[8 * s2 + 2], p1[8 * s2 + 3]); pk[2 + s2].z = cvtpk_s(p1[8 * s2 + 4], p1[8 * s2 + 5]); pk[2 + s2].w = cvtpk_s(p1[8 * s2 + 6], p1[8 * s2 + 7]); }
}
__device__ __forceinline__ void attn_pv(const LAS unsigned char* Vb, const u32x4 (&pk)[4], int voff, f32x16& o0, f32x16& o1, f32x16& o2) {
    const u32x4 onesw = (u32x4){0x3F803F80u, 0x3F803F80u, 0x3F803F80u, 0x3F803F80u}; const bf16x8 ones = __builtin_bit_cast(bf16x8, onesw);
#pragma unroll
    for (int q = 0; q < 4; ++q) {
        const bf16x8 pf = __builtin_bit_cast(bf16x8, pk[q]);
        const LAS unsigned char* vp = Vb + (16 * q) * AT_VROWB + voff;
        const s16x4 a0l = vtr(vp), a0h = vtr(vp + 8 * AT_VROWB), a1l = vtr(vp + 64), a1h = vtr(vp + 8 * AT_VROWB + 64);
        const bf16x8 va0 = (bf16x8){a0l[0], a0l[1], a0l[2], a0l[3], a0h[0], a0h[1], a0h[2], a0h[3]};
        const bf16x8 va1 = (bf16x8){a1l[0], a1l[1], a1l[2], a1l[3], a1h[0], a1h[1], a1h[2], a1h[3]};
        o0 = __builtin_amdgcn_mfma_f32_32x32x16_bf16(va0, pf, o0, 0, 0, 0);
        o1 = __builtin_amdgcn_mfma_f32_32x32x16_bf16(va1, pf, o1, 0, 0, 0);
        o2 = __builtin_amdgcn_mfma_f32_32x32x16_bf16(ones, pf, o2, 0, 0, 0);
    }
}
constexpr int AT_KB = 0, AT_VB = 2 * AT_TILE, AT_BT3 = AT_VB + 3 * AT_VTILE;
template <bool GB> __device__ __forceinline__ void attn_unit(int b, int h, int Q, const float* rel_bias, unsigned char* ws, LAS unsigned char* lds) {
    const int tid = threadIdx.x, lane = tid & 63, wave = __builtin_amdgcn_readfirstlane(tid >> 6), r32 = lane & 31, hh = lane >> 5;
    const size_t rowbase = (size_t)b * NS; const int t0w = 256 * Q + 32 * wave, t = t0w + r32;
    const bf16_t* QKV = (const bf16_t*)(ws + WS_QKV);
    LAS float* BT = (LAS float*)(lds + AT_BT3);
    const int NTL = 4 * (Q + 1);
    const int lastw = (t0w + 31) >> 6;
    const int srow = tid >> 3, sch = tid & 7;
    const bf16_t* kg = QKV + (rowbase + srow) * 1536 + 512 + h * 64 + sch * 8; const bf16_t* vg = kg + 512;
    const int soff = srow * AT_ROWB + sch * 16, svoff = srow * AT_VROWB + sch * 16;
    const unsigned long long* MK = (const unsigned long long*)(ws + WS_MASK) + (rowbase + t) * 64;
    const size_t tstride = (size_t)64 * 1536;
    u32x4 k0r = *(const u32x4*)kg, v0r = *(const u32x4*)vg;
    u32x4 kA = *(const u32x4*)(kg + tstride), vA = *(const u32x4*)(vg + tstride);
    u32x4 kB = *(const u32x4*)(kg + 2 * tstride), vB = *(const u32x4*)(vg + 2 * tstride);
    unsigned long long me = MK[0], mo = MK[(1 <= lastw) ? 1 : 0];
    bf16x8 qr[4];
#pragma unroll
    for (int ks = 0; ks < 4; ++ks) qr[ks] = *(const bf16x8*)(QKV + (rowbase + t) * 1536 + h * 64 + 16 * ks + 8 * hh);
    const float cB = rel_bias[31 * A_HEADS + h] * LOG2E;
    __syncthreads();
    if (tid < 352) { const int d = tid - 96; BT[tid] = rel_bias[v0_bucket(d < 0 ? 0 : d) * A_HEADS + h] * LOG2E - cB; }
    *(LAS u32x4*)(lds + AT_KB + soff) = k0r; *(LAS u32x4*)(lds + AT_VB + svoff) = v0r;
    f32x16 o0, o1, o2, nmB;
#pragma unroll
    for (int i = 0; i < 16; ++i) { o0[i] = 0.f; o1[i] = 0.f; o2[i] = 0.f; nmB[i] = cB; }
    float mref = 0.f;
    const int q4 = (lane & 15) >> 2, p4 = lane & 3, blk = (lane >> 4) & 1;
    const int voff = (4 * hh + q4) * AT_VROWB + (16 * blk + 4 * p4) * 2;
    u32x4 pk[4];
#pragma unroll
    for (int q = 0; q < 4; ++q) pk[q] = (u32x4){0u, 0u, 0u, 0u};
    int vcur = 0, vnext = AT_VTILE, vprev = 2 * AT_VTILE;
    for (int kt = 0; kt < NTL; kt += 2) {
        __syncthreads();
        *(LAS u32x4*)(lds + AT_KB + AT_TILE + soff) = kA; *(LAS u32x4*)(lds + AT_VB + vnext + svoff) = vA;
        { const int tn = (kt + 3 < NTL) ? kt + 3 : NTL - 1; kA = *(const u32x4*)(kg + (size_t)tn * tstride); vA = *(const u32x4*)(vg + (size_t)tn * tstride); }
        if (GB) { if (kt >= 1 && kt - 1 <= lastw) attn_pv(lds + AT_VB + vprev, pk, voff, o0, o1, o2); }
        if (kt <= lastw) attn_s(lds + AT_KB, BT, qr, me, (t0w - (64 * kt + 63) >= 113), kt == 0, t - 64 * kt - 4 * hh, r32, hh, o0, o1, o2, nmB, mref, pk);
        if (!GB) { if (kt <= lastw) attn_pv(lds + AT_VB + vcur, pk, voff, o0, o1, o2); }
        me = MK[(kt + 2 <= lastw) ? kt + 2 : lastw];
        { const int tmp = vprev; vprev = vcur; vcur = vnext; vnext = tmp; }
        __syncthreads();
        *(LAS u32x4*)(lds + AT_KB + soff) = kB; *(LAS u32x4*)(lds + AT_VB + vnext + svoff) = vB;
        { const int tn = (kt + 4 < NTL) ? kt + 4 : NTL - 1; kB = *(const u32x4*)(kg + (size_t)tn * tstride); vB = *(const u32x4*)(vg + (size_t)tn * tstride); }
        if (GB) { if (kt <= lastw) attn_pv(lds + AT_VB + vprev, pk, voff, o0, o1, o2); }
        if (kt + 1 <= lastw) attn_s(lds + AT_KB + AT_TILE, BT, qr, mo, (t0w - (64 * (kt + 1) + 63) >= 113), false, t - 64 * (kt + 1) - 4 * hh, r32, hh, o0, o1, o2, nmB, mref, pk);
        if (!GB) { if (kt + 1 <= lastw) attn_pv(lds + AT_VB + vcur, pk, voff, o0, o1, o2); }
        mo = MK[(kt + 3 <= lastw) ? kt + 3 : lastw];
        { const int tmp = vprev; vprev = vcur; vcur = vnext; vnext = tmp; }
    }
    if (GB) {
        if (NTL - 1 <= lastw) attn_pv(lds + AT_VB + vprev, pk, voff, o0, o1, o2);
    }
    const float inv = 1.f / o2[0];
    bf16_t* O = (bf16_t*)(ws + WS_OAB) + (rowbase + t) * 1024 + h * 64 + 4 * hh;
#pragma unroll
    for (int g = 0; g < 4; ++g) {
        u32x2 w0, w1; w0.x = cvtpk_s(o0[4 * g] * inv, o0[4 * g + 1] * inv); w0.y = cvtpk_s(o0[4 * g + 2] * inv, o0[4 * g + 3] * inv);
        w1.x = cvtpk_s(o1[4 * g] * inv, o1[4 * g + 1] * inv); w1.y = cvtpk_s(o1[4 * g + 2] * inv, o1[4 * g + 3] * inv);
        *(u32x2*)(O + 8 * g) = w0; *(u32x2*)(O + 32 + 8 * g) = w1;
    }
}

constexpr int GL_LG = 0, GL_SEG = 16384, GL_A = 18432, GL_B = GL_A + 9216, GL_C = GL_B + 9216, GL_VT = GL_C + 9216, GL_ST = GL_VT + 18432;
constexpr int GROWB = 144;
constexpr int GLA_ITEMS = NB * G_HEADS * 64;
__device__ __forceinline__ void gla_cumdecay(const u32x4 g0, const u32x4 g1, int h, const float* wg, const float* bg, LAS unsigned char* lds, float* lgc) {
    const int tid = threadIdx.x; LAS float* LG = (LAS float*)(lds + GL_LG); LAS float* SEG = (LAS float*)(lds + GL_SEG);
    {   const int c = tid >> 3, dg = tid & 7; float gl[16];
#pragma unroll
        for (int j = 0; j < 4; ++j) { gl[2 * j] = __uint_as_float(g0[j] << 16); gl[2 * j + 1] = __uint_as_float(g0[j] & 0xffff0000u); gl[8 + 2 * j] = __uint_as_float(g1[j] << 16); gl[8 + 2 * j + 1] = __uint_as_float(g1[j] & 0xffff0000u); }
        float z[8];
#pragma unroll
        for (int j = 0; j < 8; ++j) z[j] = bg[h * 64 + 8 * dg + j];
#pragma unroll
        for (int r = 0; r < 16; ++r) { const f32x4 w0 = *(const f32x4*)(wg + r * G_KW + h * 64 + 8 * dg), w1 = *(const f32x4*)(wg + r * G_KW + h * 64 + 8 * dg + 4);
            z[0] += gl[r] * w0[0]; z[1] += gl[r] * w0[1]; z[2] += gl[r] * w0[2]; z[3] += gl[r] * w0[3]; z[4] += gl[r] * w1[0]; z[5] += gl[r] * w1[1]; z[6] += gl[r] * w1[2]; z[7] += gl[r] * w1[3]; }
#pragma unroll
        for (int j = 0; j < 8; ++j) z[j] = (fminf(z[j], 0.f) - log1pf(__expf(-fabsf(z[j])))) * (1.f / 16.f);
        *(LAS f32x4*)(LG + c * 64 + 8 * dg) = (f32x4){z[0], z[1], z[2], z[3]}; *(LAS f32x4*)(LG + c * 64 + 8 * dg + 4) = (f32x4){z[4], z[5], z[6], z[7]};
    }
    __syncthreads();
    const int seg = tid >> 6, d = tid & 63; float v[8];
#pragma unroll
    for (int i = 0; i < 8; ++i) v[i] = LG[(8 * seg + i) * 64 + d];
#pragma unroll
    for (int i = 1; i < 8; ++i) v[i] += v[i - 1];
    SEG[seg * 64 + d] = v[7];
    __syncthreads();
    float off = 0.f;
#pragma unroll
    for (int s2 = 0; s2 < 8; ++s2) if (s2 < seg) off += SEG[s2 * 64 + d];
#pragma unroll
    for (int i = 0; i < 8; ++i) { const float bv = v[i] + off; LG[(8 * seg + i) * 64 + d] = bv; lgc[(8 * seg + i) * 64 + d] = bv; }
    __syncthreads();
}
__device__ __forceinline__ unsigned short f2bf_s(float f) { return (unsigned short)(cvtpk_s(f, 0.f) & 0xffffu); }
__device__ __forceinline__ void gla_stage_vt(const u32x4 a, const u32x4 b2, LAS unsigned char* lds) {
    const int tid = threadIdx.x, c = tid >> 3, d0 = (tid & 7) * 16;
#pragma unroll
    for (int j = 0; j < 4; ++j) {
        *(LAS unsigned short*)(lds + GL_VT + (d0 + 2 * j) * GROWB + c * 2) = (unsigned short)(a[j] & 0xffffu); *(LAS unsigned short*)(lds + GL_VT + (d0 + 2 * j + 1) * GROWB + c * 2) = (unsigned short)(a[j] >> 16);
        *(LAS unsigned short*)(lds + GL_VT + (d0 + 8 + 2 * j) * GROWB + c * 2) = (unsigned short)(b2[j] & 0xffffu); *(LAS unsigned short*)(lds + GL_VT + (d0 + 8 + 2 * j + 1) * GROWB + c * 2) = (unsigned short)(b2[j] >> 16); }
}
__device__ __forceinline__ void p3b_item(int it, const float* wg, const float* bg, float* UT, float* LGC, unsigned char* ws, LAS unsigned char* lds) {
    const int tid = threadIdx.x, lane = tid & 63, wave = tid >> 6, fr = lane & 15, fq = lane >> 4;
    const int bh = it >> 6, n = it & 63, b = bh >> 2, h = bh & 3; const size_t r0 = (size_t)b * NS + 64 * n;
    const int c_ = tid >> 3, dg_ = tid & 7;
    const bf16_t* gp_ = (const bf16_t*)(ws + WS_GLR) + (r0 + c_) * 16; const u32x4 g0 = *(const u32x4*)gp_, g1 = *(const u32x4*)(gp_ + 8);
    const u32x4 kraw = *(const u32x4*)((const bf16_t*)(ws + WS_GQK) + (r0 + c_) * 512 + 256 + h * 64 + 8 * dg_);
    const bf16_t* vp_ = (const bf16_t*)(ws + WS_GV) + (r0 + c_) * 512 + h * 128 + dg_ * 16; const u32x4 va_ = *(const u32x4*)vp_, vb_ = *(const u32x4*)(vp_ + 8);
    __syncthreads();
    gla_cumdecay(g0, g1, h, wg, bg, lds, LGC + (size_t)it * 4096);
    const LAS float* LG = (const LAS float*)(lds + GL_LG);
    {   const int c = tid >> 3, dg = tid & 7; float kf[8]; bf8_to_f(kraw, kf);
#pragma unroll
        for (int j = 0; j < 8; ++j) { const int d = 8 * dg + j; *(LAS unsigned short*)(lds + GL_A + d * GROWB + c * 2) = f2bf_s(kf[j] * __expf(LG[63 * 64 + d] - LG[c * 64 + d])); }
        if (tid < 64) ((float*)(ws + WS_MISC))[(size_t)it * 64 + tid] = __expf(LG[63 * 64 + tid]);
    }
    gla_stage_vt(va_, vb_, lds);
    __syncthreads();
    f32x4 acc[4];
#pragma unroll
    for (int i = 0; i < 4; ++i) acc[i] = (f32x4){0.f, 0.f, 0.f, 0.f};
#pragma unroll
    for (int ks = 0; ks < 2; ++ks) { const bf16x8 bv = *(const LAS bf16x8*)(lds + GL_VT + (16 * wave + fr) * GROWB + (32 * ks + 8 * fq) * 2);
#pragma unroll
        for (int i = 0; i < 4; ++i) { const bf16x8 av = *(const LAS bf16x8*)(lds + GL_A + (16 * i + fr) * GROWB + (32 * ks + 8 * fq) * 2); acc[i] = __builtin_amdgcn_mfma_f32_16x16x32_bf16(av, bv, acc[i], 0, 0, 0); } }
#pragma unroll
    for (int i = 0; i < 4; ++i) *(f32x4*)(UT + ((size_t)it * 128 + 16 * wave + fr) * 64 + 16 * i + 4 * fq) = acc[i];
}
__device__ __forceinline__ void p4b_item(int j, const float* UT, bf16_t* SP, unsigned char* ws) {
    const int tid = threadIdx.x, bh = j >> 3, dv = (j & 7) * 16 + (tid >> 5), dk = (tid & 31) * 2; const float* DEC = (const float*)(ws + WS_MISC);
    typedef float f32x2v __attribute__((ext_vector_type(2)));
    f32x2v st = (f32x2v){0.f, 0.f};
#pragma unroll 8
    for (int n = 0; n < 64; ++n) { const size_t it = (size_t)bh * 64 + n; const size_t o = (it * 128 + dv) * 64 + dk;
        *(unsigned*)(SP + o) = cvtpk_s(st[0], st[1]);
        const f32x2v u = *(const f32x2v*)(UT + o), dc = *(const f32x2v*)(DEC + it * 64 + dk); st = dc * st + u; }
}
__device__ __forceinline__ void p5b_item(int it, const float* LGC, const float* ng, const bf16_t* SP, unsigned char* ws, LAS unsigned char* lds) {
    const int tid = threadIdx.x, lane = tid & 63, wave = tid >> 6, r32 = lane & 31, hh = lane >> 5;
    const int bh = it >> 6, n = it & 63, b = bh >> 2, h = bh & 3; const size_t r0 = (size_t)b * NS + 64 * n;
    const int c_ = tid >> 3, dg_ = tid & 7; const int dvb = wave >> 1, cb = wave & 1;
    const f32x4 lg0 = *(const f32x4*)(LGC + (size_t)it * 4096 + c_ * 64 + 8 * dg_), lg1 = *(const f32x4*)(LGC + (size_t)it * 4096 + c_ * 64 + 8 * dg_ + 4);
    const bf16_t* qp_ = (const bf16_t*)(ws + WS_GQK) + (r0 + c_) * 512 + h * 64 + 8 * dg_; const u32x4 qraw = *(const u32x4*)qp_, kraw = *(const u32x4*)(qp_ + 256);
    const bf16_t* vp_ = (const bf16_t*)(ws + WS_GV) + (r0 + c_) * 512 + h * 128 + dg_ * 16; const u32x4 va_ = *(const u32x4*)vp_, vb_ = *(const u32x4*)(vp_ + 8);
    bf16x8 spf[4];
#pragma unroll
    for (int ks = 0; ks < 4; ++ks) spf[ks] = *(const bf16x8*)(SP + ((size_t)it * 128 + 32 * dvb + r32) * 64 + 16 * ks + 8 * hh);
    const size_t trow = r0 + 32 * cb + r32; const int dvbase = h * 128 + 32 * dvb + 4 * hh;
    const bf16_t* grp = (const bf16_t*)(ws + WS_GR) + trow * 512 + dvbase; u32x2 grw[4];
#pragma unroll
    for (int g = 0; g < 4; ++g) grw[g] = *(const u32x2*)(grp + 8 * g);
    __syncthreads();
    { LAS float* LGw = (LAS float*)(lds + GL_LG); *(LAS f32x4*)(LGw + c_ * 64 + 8 * dg_) = lg0; *(LAS f32x4*)(LGw + c_ * 64 + 8 * dg_ + 4) = lg1; }
    __syncthreads();
    const LAS float* LG = (const LAS float*)(lds + GL_LG);
    {   const int c = tid >> 3, dg = tid & 7; float qf[8], kf[8]; bf8_to_f(qraw, qf); bf8_to_f(kraw, kf);
        float qr[8], ks[8], qi[8];
#pragma unroll
        for (int j = 0; j < 8; ++j) { const int d = 8 * dg + j; const float bc = LG[c * 64 + d], bl = LG[63 * 64 + d]; const float q8 = qf[j] * 0.125f;
            qr[j] = q8 * __expf(bc - bl); ks[j] = kf[j] * __expf(bl - bc); qi[j] = q8 * __expf(bc); }
        u32x4 w;
        w.x = cvtpk_s(qr[0], qr[1]); w.y = cvtpk_s(qr[2], qr[3]); w.z = cvtpk_s(qr[4], qr[5]); w.w = cvtpk_s(qr[6], qr[7]); *(LAS u32x4*)(lds + GL_A + c * GROWB + 16 * dg) = w;
        w.x = cvtpk_s(ks[0], ks[1]); w.y = cvtpk_s(ks[2], ks[3]); w.z = cvtpk_s(ks[4], ks[5]); w.w = cvtpk_s(ks[6], ks[7]); *(LAS u32x4*)(lds + GL_B + c * GROWB + 16 * dg) = w;
        w.x = cvtpk_s(qi[0], qi[1]); w.y = cvtpk_s(qi[2], qi[3]); w.z = cvtpk_s(qi[4], qi[5]); w.w = cvtpk_s(qi[6], qi[7]); *(LAS u32x4*)(lds + GL_C + c * GROWB + 16 * dg) = w;
    }
    gla_stage_vt(va_, vb_, lds);
    __syncthreads();
    f32x16 o;
#pragma unroll
    for (int i = 0; i < 16; ++i) o[i] = 0.f;
#pragma unroll
    for (int jb = 0; jb < 2; ++jb) if (jb <= cb) {
        f32x16 at;
#pragma unroll
        for (int i = 0; i < 16; ++i) at[i] = 0.f;
#pragma unroll
        for (int ks = 0; ks < 4; ++ks) { const bf16x8 av = *(const LAS bf16x8*)(lds + GL_B + (32 * jb + r32) * GROWB + 32 * ks + 16 * hh), bv = *(const LAS bf16x8*)(lds + GL_A + (32 * cb + r32) * GROWB + 32 * ks + 16 * hh);
            at = __builtin_amdgcn_mfma_f32_32x32x16_bf16(av, bv, at, 0, 0, 0); }
        if (jb == cb) {
#pragma unroll
            for (int i = 0; i < 16; ++i) if (crow(i, hh) > r32) at[i] = 0.f; }
#pragma unroll
        for (int s = 0; s < 2; ++s) {
            u32x4 pw; pw.x = cvtpk_s(at[8 * s], at[8 * s + 1]); pw.y = cvtpk_s(at[8 * s + 2], at[8 * s + 3]); pw.z = cvtpk_s(at[8 * s + 4], at[8 * s + 5]); pw.w = cvtpk_s(at[8 * s + 6], at[8 * s + 7]);
            const LAS unsigned char* vp = lds + GL_VT + (32 * dvb + r32) * GROWB + (32 * jb + 16 * s + 4 * hh) * 2;
            const u32x2 lo = *(const LAS u32x2*)vp, hi = *(const LAS u32x2*)(vp + 16);
            const u32x4 va = (u32x4){lo.x, lo.y, hi.x, hi.y};
            o = __builtin_amdgcn_mfma_f32_32x32x16_bf16(__builtin_bit_cast(bf16x8, va), __builtin_bit_cast(bf16x8, pw), o, 0, 0, 0);
        }
    }
#pragma unroll
    for (int ks = 0; ks < 4; ++ks) { const bf16x8 bv = *(const LAS bf16x8*)(lds + GL_C + (32 * cb + r32) * GROWB + 32 * ks + 16 * hh);
        o = __builtin_amdgcn_mfma_f32_32x32x16_bf16(spf[ks], bv, o, 0, 0, 0); }
    LAS float* ST = (LAS float*)(lds + GL_ST);
    float sm = 0.f;
#pragma unroll
    for (int i = 0; i < 16; ++i) sm += o[i];
    sm += __shfl_xor(sm, 32);
    if (hh == 0) ST[dvb * 64 + 32 * cb + r32] = sm;
    __syncthreads();
    const float mean = (ST[32 * cb + r32] + ST[64 + 32 * cb + r32] + ST[128 + 32 * cb + r32] + ST[192 + 32 * cb + r32]) * (1.f / 128.f);
    float sq = 0.f;
#pragma unroll
    for (int i = 0; i < 16; ++i) { o[i] -= mean; sq += o[i] * o[i]; }
    sq += __shfl_xor(sq, 32);
    if (hh == 0) ST[256 + dvb * 64 + 32 * cb + r32] = sq;
    __syncthreads();
    const float var = (ST[256 + 32 * cb + r32] + ST[256 + 64 + 32 * cb + r32] + ST[256 + 128 + 32 * cb + r32] + ST[256 + 192 + 32 * cb + r32]) * (1.f / 128.f);
    const float rstd = 1.f / sqrtf(var + LN_EPS);
    bf16_t* op = (bf16_t*)(ws + WS_OAB) + trow * 1024 + 512 + dvbase;
#pragma unroll
    for (int g = 0; g < 4; ++g) { const u32x2 gw = grw[g]; const f32x4 nv = *(const f32x4*)(ng + dvbase + 8 * g);
        float gr[4] = {__uint_as_float(gw.x << 16), __uint_as_float(gw.x & 0xffff0000u), __uint_as_float(gw.y << 16), __uint_as_float(gw.y & 0xffff0000u)}; float y[4];
#pragma unroll
        for (int e = 0; e < 4; ++e) y[e] = o[4 * g + e] * rstd * nv[e] * (gr[e] * __builtin_amdgcn_rcpf(1.f + __expf(-gr[e])));
        u32x2 w; w.x = cvtpk_s(y[0], y[1]); w.y = cvtpk_s(y[2], y[3]); *(u32x2*)(op + 8 * g) = w; }
}

constexpr int GL_HALF = 67584;
__device__ __forceinline__ void gla_cumdecay2(size_t r0, int h, const bf16_t* WGT, const float* bg, unsigned char* ws, LAS unsigned char* ldh, float* lgc) {
    const int tl = threadIdx.x & 255, lane = threadIdx.x & 63, wl = (threadIdx.x >> 6) & 3, r32 = lane & 31, hh = lane >> 5; LAS float* LG = (LAS float*)(ldh + GL_LG); LAS float* SEG = (LAS float*)(ldh + GL_SEG);
    {   const int cb = wl >> 1, db = wl & 1;
        const bf16x8 af = *(const bf16x8*)((const bf16_t*)(ws + WS_GLR) + (r0 + 32 * cb + r32) * 16 + 8 * hh), bfr = *(const bf16x8*)(WGT + (size_t)(h * 64 + 32 * db + r32) * 16 + 8 * hh);
        const float bias = bg[h * 64 + 32 * db + r32]; f32x16 z;
#pragma unroll
        for (int i = 0; i < 16; ++i) z[i] = bias;
        z = __builtin_amdgcn_mfma_f32_32x32x16_bf16(af, bfr, z, 0, 0, 0);
#pragma unroll
        for (int i = 0; i < 16; ++i) { const float zz = z[i]; LG[(32 * cb + crow(i, hh)) * 64 + 32 * db + r32] = (fminf(zz, 0.f) - __logf(1.f + __expf(-fabsf(zz)))) * (1.f / 16.f); }
    }
    __syncthreads();
    const int seg = tl >> 6, d = tl & 63; float v[16];
#pragma unroll
    for (int i = 0; i < 16; ++i) v[i] = LG[(16 * seg + i) * 64 + d];
#pragma unroll
    for (int i = 1; i < 16; ++i) v[i] += v[i - 1];
    SEG[seg * 64 + d] = v[15];
    __syncthreads();
    float off = 0.f;
#pragma unroll
    for (int s2 = 0; s2 < 4; ++s2) if (s2 < seg) off += SEG[s2 * 64 + d];
#pragma unroll
    for (int i = 0; i < 16; ++i) { const float bv = v[i] + off; LG[(16 * seg + i) * 64 + d] = bv; lgc[(16 * seg + i) * 64 + d] = bv; }
    __syncthreads();
}
__device__ __forceinline__ void gla_stage_vt2(const u32x4 (&vv)[4], LAS unsigned char* ldh) {
    const int tl = threadIdx.x & 255, c = tl >> 2, d0 = (tl & 3) * 32;
#pragma unroll
    for (int k = 0; k < 4; ++k)
#pragma unroll
        for (int j = 0; j < 4; ++j) {
            *(LAS unsigned short*)(ldh + GL_VT + (d0 + 8 * k + 2 * j) * GROWB + c * 2) = (unsigned short)(vv[k][j] & 0xffffu);
            *(LAS unsigned short*)(ldh + GL_VT + (d0 + 8 * k + 2 * j + 1) * GROWB + c * 2) = (unsigned short)(vv[k][j] >> 16); }
}
__device__ __forceinline__ void p3b_pair(int p, const float* wg, const float* bg, float* UT, float* LGC, unsigned char* ws, LAS unsigned char* lds) {
    const int tid = threadIdx.x, hb = tid >> 8, tl = tid & 255, lane = tid & 63, wl = (tid >> 6) & 3, fr = lane & 15, fq = lane >> 4;
    const int it = 2 * p + hb; LAS unsigned char* ldh = lds + hb * GL_HALF;
    const int bh = it >> 6, n = it & 63, b = bh >> 2, h = bh & 3; const size_t r0 = (size_t)b * NS + 64 * n;
    const int c_ = tl >> 2, dq_ = tl & 3;
    const bf16_t* kp_ = (const bf16_t*)(ws + WS_GQK) + (r0 + c_) * 512 + 256 + h * 64 + 16 * dq_; const u32x4 k0 = *(const u32x4*)kp_, k1 = *(const u32x4*)(kp_ + 8);
    const bf16_t* vp_ = (const bf16_t*)(ws + WS_GV) + (r0 + c_) * 512 + h * 128 + 32 * dq_; u32x4 vv[4];
#pragma unroll
    for (int k = 0; k < 4; ++k) vv[k] = *(const u32x4*)(vp_ + 8 * k);
    __syncthreads();
    gla_cumdecay2(r0, h, (const bf16_t*)(ws + WS_WGT), bg, ws, ldh, LGC + (size_t)it * 4096);
    const LAS float* LG = (const LAS float*)(ldh + GL_LG);
    {   float kf[16]; bf8_to_f(k0, kf); bf8_to_f(k1, kf + 8);
#pragma unroll
        for (int j = 0; j < 16; ++j) { const int d = 16 * dq_ + j; *(LAS unsigned short*)(ldh + GL_A + d * GROWB + c_ * 2) = f2bf_s(kf[j] * __expf(LG[63 * 64 + d] - LG[c_ * 64 + d])); }
        if (tl < 64) ((float*)(ws + WS_MISC))[(size_t)it * 64 + tl] = __expf(LG[63 * 64 + tl]);
    }
    gla_stage_vt2(vv, ldh);
    __syncthreads();
#pragma unroll
    for (int dvi = 0; dvi < 2; ++dvi) {
        const int dvblk = 2 * wl + dvi;
        f32x4 acc[4];
#pragma unroll
        for (int i = 0; i < 4; ++i) acc[i] = (f32x4){0.f, 0.f, 0.f, 0.f};
#pragma unroll
        for (int ks = 0; ks < 2; ++ks) { const bf16x8 bv = *(const LAS bf16x8*)(ldh + GL_VT + (16 * dvblk + fr) * GROWB + (32 * ks + 8 * fq) * 2);
#pragma unroll
            for (int i = 0; i < 4; ++i) { const bf16x8 av = *(const LAS bf16x8*)(ldh + GL_A + (16 * i + fr) * GROWB + (32 * ks + 8 * fq) * 2); acc[i] = __builtin_amdgcn_mfma_f32_16x16x32_bf16(av, bv, acc[i], 0, 0, 0); } }
#pragma unroll
        for (int i = 0; i < 4; ++i) *(f32x4*)(UT + ((size_t)it * 128 + 16 * dvblk + fr) * 64 + 16 * i + 4 * fq) = acc[i];
    }
}
__device__ __forceinline__ void p5b_pair(int p, const float* LGC, const float* ng, const bf16_t* SP, unsigned char* ws, LAS unsigned char* lds) {
    const int tid = threadIdx.x, hb = tid >> 8, tl = tid & 255, lane = tid & 63, wl = (tid >> 6) & 3, r32 = lane & 31, hh = lane >> 5;
    const int it = 2 * p + hb; LAS unsigned char* ldh = lds + hb * GL_HALF;
    const int bh = it >> 6, n = it & 63, b = bh >> 2, h = bh & 3; const size_t r0 = (size_t)b * NS + 64 * n;
    const int c_ = tl >> 2, dq_ = tl & 3; const int dvb = wl;
    f32x4 lg[4];
#pragma unroll
    for (int k = 0; k < 4; ++k) lg[k] = *(const f32x4*)(LGC + (size_t)it * 4096 + c_ * 64 + 16 * dq_ + 4 * k);
    const bf16_t* qp_ = (const bf16_t*)(ws + WS_GQK) + (r0 + c_) * 512 + h * 64 + 16 * dq_; const u32x4 q0 = *(const u32x4*)qp_, q1 = *(const u32x4*)(qp_ + 8), k0 = *(const u32x4*)(qp_ + 256), k1 = *(const u32x4*)(qp_ + 264);
    const bf16_t* vp_ = (const bf16_t*)(ws + WS_GV) + (r0 + c_) * 512 + h * 128 + 32 * dq_; u32x4 vv[4];
#pragma unroll
    for (int k = 0; k < 4; ++k) vv[k] = *(const u32x4*)(vp_ + 8 * k);
    bf16x8 spf[4];
#pragma unroll
    for (int ks = 0; ks < 4; ++ks) spf[ks] = *(const bf16x8*)(SP + ((size_t)it * 128 + 32 * dvb + r32) * 64 + 16 * ks + 8 * hh);
    const int dvbase = h * 128 + 32 * dvb + 4 * hh; u32x2 grw[2][4];
#pragma unroll
    for (int cb = 0; cb < 2; ++cb)
#pragma unroll
        for (int g = 0; g < 4; ++g) grw[cb][g] = *(const u32x2*)((const bf16_t*)(ws + WS_GR) + (r0 + 32 * cb + r32) * 512 + dvbase + 8 * g);
    __syncthreads();
    { LAS float* LGw = (LAS float*)(ldh + GL_LG);
#pragma unroll
      for (int k = 0; k < 4; ++k) *(LAS f32x4*)(LGw + c_ * 64 + 16 * dq_ + 4 * k) = lg[k]; }
    __syncthreads();
    const LAS float* LG = (const LAS float*)(ldh + GL_LG);
    {   float qf[16], kf[16]; bf8_to_f(q0, qf); bf8_to_f(q1, qf + 8); bf8_to_f(k0, kf); bf8_to_f(k1, kf + 8);
        float qr[16], ks[16], qi[16];
#pragma unroll
        for (int j = 0; j < 16; ++j) { const int d = 16 * dq_ + j; const float bc = LG[c_ * 64 + d], bl = LG[63 * 64 + d]; const float q8 = qf[j] * 0.125f;
            qr[j] = q8 * __expf(bc - bl); ks[j] = kf[j] * __expf(bl - bc); qi[j] = q8 * __expf(bc); }
#pragma unroll
        for (int k = 0; k < 2; ++k) { u32x4 w;
            w.x = cvtpk_s(qr[8 * k], qr[8 * k + 1]); w.y = cvtpk_s(qr[8 * k + 2], qr[8 * k + 3]); w.z = cvtpk_s(qr[8 * k + 4], qr[8 * k + 5]); w.w = cvtpk_s(qr[8 * k + 6], qr[8 * k + 7]); *(LAS u32x4*)(ldh + GL_A + c_ * GROWB + 32 * dq_ + 16 * k) = w;
            w.x = cvtpk_s(ks[8 * k], ks[8 * k + 1]); w.y = cvtpk_s(ks[8 * k + 2], ks[8 * k + 3]); w.z = cvtpk_s(ks[8 * k + 4], ks[8 * k + 5]); w.w = cvtpk_s(ks[8 * k + 6], ks[8 * k + 7]); *(LAS u32x4*)(ldh + GL_B + c_ * GROWB + 32 * dq_ + 16 * k) = w;
            w.x = cvtpk_s(qi[8 * k], qi[8 * k + 1]); w.y = cvtpk_s(qi[8 * k + 2], qi[8 * k + 3]); w.z = cvtpk_s(qi[8 * k + 4], qi[8 * k + 5]); w.w = cvtpk_s(qi[8 * k + 6], qi[8 * k + 7]); *(LAS u32x4*)(ldh + GL_C + c_ * GROWB + 32 * dq_ + 16 * k) = w; }
    }
    gla_stage_vt2(vv, ldh);
    __syncthreads();
    f32x16 o[2];
#pragma unroll
    for (int cb = 0; cb < 2; ++cb) {
#pragma unroll
        for (int i = 0; i < 16; ++i) o[cb][i] = 0.f;
#pragma unroll
        for (int jb = 0; jb < 2; ++jb) if (jb <= cb) {
            f32x16 at;
#pragma unroll
            for (int i = 0; i < 16; ++i) at[i] = 0.f;
#pragma unroll
            for (int ks = 0; ks < 4; ++ks) { const bf16x8 av = *(const LAS bf16x8*)(ldh + GL_B + (32 * jb + r32) * GROWB + 32 * ks + 16 * hh), bv = *(const LAS bf16x8*)(ldh + GL_A + (32 * cb + r32) * GROWB + 32 * ks + 16 * hh);
                at = __builtin_amdgcn_mfma_f32_32x32x16_bf16(av, bv, at, 0, 0, 0); }
            if (jb == cb) {
#pragma unroll
                for (int i = 0; i < 16; ++i) if (crow(i, hh) > r32) at[i] = 0.f; }
#pragma unroll
            for (int s2 = 0; s2 < 2; ++s2) {
                u32x4 pw; pw.x = cvtpk_s(at[8 * s2], at[8 * s2 + 1]); pw.y = cvtpk_s(at[8 * s2 + 2], at[8 * s2 + 3]); pw.z = cvtpk_s(at[8 * s2 + 4], at[8 * s2 + 5]); pw.w = cvtpk_s(at[8 * s2 + 6], at[8 * s2 + 7]);
                const LAS unsigned char* vp = ldh + GL_VT + (32 * dvb + r32) * GROWB + (32 * jb + 16 * s2 + 4 * hh) * 2;
                const u32x2 lo = *(const LAS u32x2*)vp, hi = *(const LAS u32x2*)(vp + 16);
                const u32x4 va = (u32x4){lo.x, lo.y, hi.x, hi.y};
                o[cb] = __builtin_amdgcn_mfma_f32_32x32x16_bf16(__builtin_bit_cast(bf16x8, va), __builtin_bit_cast(bf16x8, pw), o[cb], 0, 0, 0);
            }
        }
#pragma unroll
        for (int ks = 0; ks < 4; ++ks) { const bf16x8 bv = *(const LAS bf16x8*)(ldh + GL_C + (32 * cb + r32) * GROWB + 32 * ks + 16 * hh);
            o[cb] = __builtin_amdgcn_mfma_f32_32x32x16_bf16(spf[ks], bv, o[cb], 0, 0, 0); }
    }
    LAS float* ST = (LAS float*)(ldh + GL_ST);
#pragma unroll
    for (int cb = 0; cb < 2; ++cb) { float sm = 0.f;
#pragma unroll
        for (int i = 0; i < 16; ++i) sm += o[cb][i];
        sm += __shfl_xor(sm, 32);
        if (hh == 0) ST[dvb * 64 + 32 * cb + r32] = sm; }
    __syncthreads();
    float mean[2];
#pragma unroll
    for (int cb = 0; cb < 2; ++cb) { const int cc = 32 * cb + r32; mean[cb] = (ST[cc] + ST[64 + cc] + ST[128 + cc] + ST[192 + cc]) * (1.f / 128.f); float sq = 0.f;
#pragma unroll
        for (int i = 0; i < 16; ++i) { o[cb][i] -= mean[cb]; sq += o[cb][i] * o[cb][i]; }
        sq += __shfl_xor(sq, 32);
        if (hh == 0) ST[256 + dvb * 64 + cc] = sq; }
    __syncthreads();
#pragma unroll
    for (int cb = 0; cb < 2; ++cb) { const int cc = 32 * cb + r32; const float var = (ST[256 + cc] + ST[256 + 64 + cc] + ST[256 + 128 + cc] + ST[256 + 192 + cc]) * (1.f / 128.f);
        const float rstd = 1.f / sqrtf(var + LN_EPS);
        bf16_t* op = (bf16_t*)(ws + WS_OAB) + (r0 + cc) * 1024 + 512 + dvbase;
#pragma unroll
        for (int g = 0; g < 4; ++g) { const u32x2 gw = grw[cb][g]; const f32x4 nv = *(const f32x4*)(ng + dvbase + 8 * g);
            float gr[4] = {__uint_as_float(gw.x << 16), __uint_as_float(gw.x & 0xffff0000u), __uint_as_float(gw.y << 16), __uint_as_float(gw.y & 0xffff0000u)}; float y[4];
#pragma unroll
            for (int e = 0; e < 4; ++e) y[e] = o[cb][4 * g + e] * rstd * nv[e] * (gr[e] * __builtin_amdgcn_rcpf(1.f + __expf(-gr[e])));
            u32x2 w; w.x = cvtpk_s(y[0], y[1]); w.y = cvtpk_s(y[2], y[3]); *(u32x2*)(op + 8 * g) = w; } }
}

constexpr size_t WS_SG = 129 * MiB;
constexpr size_t WS_MRG = 257 * MiB;
constexpr size_t WS_H2 = WS_XN;
constexpr size_t WS_XG = 129 * MiB;
constexpr size_t WS_HID = 321 * MiB;
constexpr size_t WS_YG = 358 * MiB;
constexpr size_t WS_EID = WS_MISC + 1 * MiB, WS_EW = WS_EID + 256 * 1024, WS_POS = WS_EW + 256 * 1024, WS_ST1 = WS_POS + 256 * 1024;
constexpr size_t WS_LIST = 490 * MiB;
constexpr int LDS_TAB = 131072;
__device__ __forceinline__ u32x4 pack8(const f32x4 a, const f32x4 b) { u32x4 w; w.x = cvtpk_s(a[0], a[1]); w.y = cvtpk_s(a[2], a[3]); w.z = cvtpk_s(b[0], b[1]); w.w = cvtpk_s(b[2], b[3]); return w; }
__device__ __forceinline__ f32x4 sig4(const f32x4 v) { f32x4 r; r[0] = __builtin_amdgcn_rcpf(1.f + __expf(-v[0])); r[1] = __builtin_amdgcn_rcpf(1.f + __expf(-v[1])); r[2] = __builtin_amdgcn_rcpf(1.f + __expf(-v[2])); r[3] = __builtin_amdgcn_rcpf(1.f + __expf(-v[3])); return r; }
__device__ __forceinline__ void unpack8(const u32x4 w, f32x4& a, f32x4& b) {
    a[0] = __uint_as_float(w.x << 16); a[1] = __uint_as_float(w.x & 0xffff0000u); a[2] = __uint_as_float(w.y << 16); a[3] = __uint_as_float(w.y & 0xffff0000u);
    b[0] = __uint_as_float(w.z << 16); b[1] = __uint_as_float(w.z & 0xffff0000u); b[2] = __uint_as_float(w.w << 16); b[3] = __uint_as_float(w.w & 0xffff0000u);
}
#define EPI_ROWS(...) _Pragma("unroll") for (int ai = 0; ai < 2; ++ai) _Pragma("unroll") for (int m = 0; m < 4; ++m) { const size_t row = (size_t)(row0 + ai * 128 + m * 16); _Pragma("unroll") for (int bj = 0; bj < 2; ++bj) { __VA_ARGS__ } }
struct EpiSig {
    static constexpr bool PERM = true, AFTER_DRAIN = false, MID = false; unsigned char* ws; int half;
    __device__ __forceinline__ void operator()(const f32x4 (&acc)[2][2][4][2], const Unit& u, int wr, int wc, int fr, int fq) const {
        const int row0 = u.pm * 256 + wr * 64 + fr, col0 = half * 1024 + u.pn * 256 + wc * 32 + 8 * fq; bf16_t* SG = (bf16_t*)(ws + WS_SG);
        EPI_ROWS( *(u32x4*)(SG + row * 2048 + col0 + bj * 128) = pack8(sig4(acc[ai][bj][m][0]), sig4(acc[ai][bj][m][1])); )
    }
};
struct EpiMrgF {
    static constexpr bool PERM = true, AFTER_DRAIN = false, MID = true; unsigned char* ws;
    __device__ __forceinline__ void mid(f32x4 (&acc)[2][2][4][2], const Unit& u, int wr, int wc, int fr, int fq) const {
        const int row0 = u.pm * 256 + wr * 64 + fr, col0 = u.pn * 256 + wc * 32 + 8 * fq; const bf16_t* SG = (const bf16_t*)(ws + WS_SG);
        const bf16_t* p = SG + (size_t)row0 * 2048 + col0;
#pragma unroll
        for (int ai = 0; ai < 2; ++ai)
#pragma unroll
            for (int m = 0; m < 4; ++m) {
                asm volatile("" : "+v"(p));
#pragma unroll
                for (int bj = 0; bj < 2; ++bj) { f32x4 a0, a1, b0, b1; unpack8(*(const u32x4*)(p + bj * 128), a0, a1); unpack8(*(const u32x4*)(p + 1024 + bj * 128), b0, b1);
#pragma unroll
                    for (int e = 0; e < 4; ++e) { acc[ai][bj][m][0][e] *= a0[e] * __builtin_amdgcn_rcpf(fmaxf(b0[e], 1e-30f)); acc[ai][bj][m][1][e] *= a1[e] * __builtin_amdgcn_rcpf(fmaxf(b1[e], 1e-30f)); } }
                p += (m == 3 ? (128 - 48) : 16) * 2048; }
    }
    __device__ __forceinline__ void operator()(const f32x4 (&acc)[2][2][4][2], const Unit& u, int wr, int wc, int fr, int fq) const {
        const int row0 = u.pm * 256 + wr * 64 + fr, col0 = u.pn * 256 + wc * 32 + 8 * fq; const bf16_t* SG = (const bf16_t*)(ws + WS_SG) + 1024; bf16_t* MR = (bf16_t*)(ws + WS_MRG);
        EPI_ROWS( f32x4 g0, g1; unpack8(*(const u32x4*)(SG + row * 2048 + col0 + bj * 128), g0, g1); *(u32x4*)(MR + row * 1024 + col0 + bj * 128) = pack8(g0 * acc[ai][bj][m][0], g1 * acc[ai][bj][m][1]); )
    }
};
struct EpiV {
    static constexpr bool PERM = false, AFTER_DRAIN = false, MID = false; const float* x; const float* ada; float* out;
    __device__ __forceinline__ void operator()(const f32x4 (&acc)[2][2][4][2], const Unit& u, int wr, int wc, int fr, int fq) const {
        const int row0 = u.pm * 256 + wr * 64 + fr, col0 = u.pn * 256 + wc * 32 + 4 * fq; const float* gt1 = ada + (size_t)(u.pm >> 4) * 6 * D_MODEL + 2 * D_MODEL;
        EPI_ROWS( _Pragma("unroll") for (int n = 0; n < 2; ++n) { const int c = col0 + bj * 128 + n * 16; const f32x4 xv = *(const f32x4*)(x + row * D_MODEL + c), gv = *(const f32x4*)(gt1 + c);
                  *(f32x4*)(out + row * D_MODEL + c) = xv * DN_ALPHA + gv * acc[ai][bj][m][n]; } )
    }
};
struct EpiHid {
    static constexpr bool PERM = true, AFTER_DRAIN = false, MID = false; unsigned char* ws;
    __device__ __forceinline__ void operator()(const f32x4 (&acc)[2][2][4][2], const Unit& u, int wr, int wc, int fr, int fq) const {
        const int row0 = u.pm * 256 + wr * 64 + fr, col0 = u.pn * 128 + wc * 32 + 8 * fq; bf16_t* H = (bf16_t*)(ws + WS_HID);
#pragma unroll
        for (int ai = 0; ai < 2; ++ai)
#pragma unroll
            for (int m = 0; m < 4; ++m) { const size_t row = (size_t)(row0 + ai * 128 + m * 16); f32x4 h0, h1;
#pragma unroll
                for (int e = 0; e < 4; ++e) { const float g0 = acc[ai][0][m][0][e], g1 = acc[ai][0][m][1][e]; h0[e] = g0 * __builtin_amdgcn_rcpf(1.f + __expf(-g0)) * acc[ai][1][m][0][e]; h1[e] = g1 * __builtin_amdgcn_rcpf(1.f + __expf(-g1)) * acc[ai][1][m][1][e]; }
                *(u32x4*)(H + row * 256 + col0) = pack8(h0, h1); }
    }
};
struct EpiY {
    static constexpr bool PERM = true, AFTER_DRAIN = false, MID = false; unsigned char* ws;
    __device__ __forceinline__ void operator()(const f32x4 (&acc)[2][2][4][2], const Unit& u, int wr, int wc, int fr, int fq) const {
        const int row0 = u.pm * 256 + wr * 64 + fr, col0 = u.pn * 256 + wc * 32 + 8 * fq; bf16_t* Y = (bf16_t*)(ws + WS_YG);
        EPI_ROWS( *(u32x4*)(Y + row * 1024 + col0 + bj * 128) = pack8(acc[ai][bj][m][0], acc[ai][bj][m][1]); )
    }
};
__device__ __forceinline__ void build_tables(unsigned char* ws, LAS unsigned char* lds) {
    LAS int* toff = (LAS int*)(lds + LDS_TAB); LAS int* texp = toff + 64; const unsigned* gcnt = (const unsigned*)(ws + WS_CNT);
    __syncthreads();
    if (threadIdx.x == 0) { int o = 0; for (int e = 0; e < N_EXP; ++e) { toff[e] = o; const int ce = (int)gcnt[e * 32]; toff[400 + e] = ce; o += (ce + 255) >> 8; } toff[32] = o; }
    __syncthreads();
    for (int tl = threadIdx.x; tl < toff[32]; tl += NTHREADS) { int e = 0; while (toff[e + 1] <= tl) ++e; texp[tl] = e; }
    __syncthreads();
}
template <int NPN> struct GroupOrder {
    const LAS int* toff; const LAS int* texp; int G, c;
    __device__ __forceinline__ bool next(int i, Unit& u) const { const int L = i * G + c; if (L >= toff[32] * NPN) return false; const int tl = L / NPN, pn = L % NPN; u.pm = tl; u.pa = tl; u.pn = pn; u.pb = texp[tl] * NPN + pn; return true; }
    __device__ __forceinline__ void a_ready(const Unit&) const {}
    __device__ __forceinline__ void done(const Unit&) const {}
    const int* list;
    __device__ __forceinline__ int a_row(const Unit& u, int r) const { const int e = texp[u.pa]; const int idx = (u.pa - toff[e]) * 256 + r; return idx < toff[400 + e] ? list[e * 32768 + idx] : 0; }
};
constexpr int WT_LD = 1028;
constexpr int P8_LCNT = 36 * WT_LD * 4;
__device__ __forceinline__ float dot16(const f32x4 (&v)[4], const LAS float* wp, int lane) {
    float p = 0.f;
#pragma unroll
    for (int j = 0; j < 4; ++j) { const f32x4 w4 = *(const LAS f32x4*)(wp + 256 * j + 4 * lane); p += (v[j].x * w4.x + v[j].y * w4.y) + (v[j].z * w4.z + v[j].w * w4.w); }
    return p;
}
__device__ __forceinline__ float rl4sum(float v) {
    return (__int_as_float(__builtin_amdgcn_readlane(__float_as_int(v), 0)) + __int_as_float(__builtin_amdgcn_readlane(__float_as_int(v), 16)))
         + (__int_as_float(__builtin_amdgcn_readlane(__float_as_int(v), 32)) + __int_as_float(__builtin_amdgcn_readlane(__float_as_int(v), 48)));
}
template <bool REAL> __device__ __forceinline__ void p8_phase(const float* const* in, float* out, float* x1dst, bf16_t* h2dst, unsigned char* ws, LAS unsigned char* lds, int G) {
    const int tid = threadIdx.x, lane = tid & 63, wave = tid >> 6;
    LAS float* WT = (LAS float*)lds;
    LAS int* lcnt = (LAS int*)(lds + P8_LCNT); LAS int* lbase = lcnt + 32; LAS int* ent = lcnt + 64;
    const float* wrg = in[14]; const float* wre = in[16];
    __syncthreads();
    for (int i = tid; i < 1024; i += NTHREADS) { const f32x4 w = *(const f32x4*)(wrg + 4 * i); WT[0 * WT_LD + i] = w.x; WT[1 * WT_LD + i] = w.y; WT[2 * WT_LD + i] = w.z; WT[3 * WT_LD + i] = w.w; }
    for (int i = tid; i < 8192; i += NTHREADS) { const f32x4 w = *(const f32x4*)(wre + 4 * i); const int k = i >> 3, c = 4 * (i & 7);
        WT[(4 + c) * WT_LD + k] = w.x; WT[(5 + c) * WT_LD + k] = w.y; WT[(6 + c) * WT_LD + k] = w.z; WT[(7 + c) * WT_LD + k] = w.w; }
    const float* g1 = in[12]; const float* b1 = in[13]; const float* brg = in[15]; const float* bre = in[17];
    for (int blk = blockIdx.x; blk < NT / 128; blk += G) {
        const int b = blk / 32; const float* ada = (const float*)(ws + WS_ADA) + (size_t)b * 6 * D_MODEL; const float* sh2 = ada + 3 * D_MODEL; const float* sc2 = ada + 4 * D_MODEL;
        if (tid < 32) lcnt[tid] = 0;
        __syncthreads();
        for (int rb = 0; rb < 16; rb += 4) {
            const int rl0 = wave * 16 + rb; const size_t row0 = (size_t)blk * 128 + rl0;
            f32x4 v[4][4];
#pragma unroll
            for (int r = 0; r < 4; ++r) { const f32x4* xr = (const f32x4*)(out + (row0 + r) * D_MODEL) + lane;
#pragma unroll
                for (int j = 0; j < 4; ++j) v[r][j] = xr[64 * j]; }
            float rstd[4], mean1[4]; ln_center<4>(v, rstd, mean1);
            if (REAL && lane < 4) { typedef float f32x2v __attribute__((ext_vector_type(2))); ((f32x2v*)(ws + WS_ST1))[row0 + lane] = (f32x2v){lane == 0 ? mean1[0] : lane == 1 ? mean1[1] : lane == 2 ? mean1[2] : mean1[3], lane == 0 ? rstd[0] : lane == 1 ? rstd[1] : lane == 2 ? rstd[2] : rstd[3]}; }
#pragma unroll
            for (int j = 0; j < 4; ++j) { const f32x4 gg = *(const f32x4*)(g1 + 256 * j + 4 * lane), bb = *(const f32x4*)(b1 + 256 * j + 4 * lane);
#pragma unroll
                for (int r = 0; r < 4; ++r) v[r][j] = v[r][j] * rstd[r] * gg + bb; }
            ln_center<4>(v, rstd);
#pragma unroll
            for (int j = 0; j < 4; ++j) { const f32x4 a4 = *(const f32x4*)(sc2 + 256 * j + 4 * lane) + 1.f, c4 = *(const f32x4*)(sh2 + 256 * j + 4 * lane);
#pragma unroll
                for (int r = 0; r < 4; ++r) { v[r][j] = v[r][j] * rstd[r] * a4 + c4; u32x2 w; w.x = cvtpk_s(v[r][j].x, v[r][j].y); w.y = cvtpk_s(v[r][j].z, v[r][j].w);
                    ((u32x2*)(h2dst + (row0 + r) * D_MODEL) + lane)[64 * j] = w; } }
#pragma unroll
            for (int r = 0; r < 4; ++r) {
                float gp[N_GROUPS];
#pragma unroll
                for (int g = 0; g < N_GROUPS; ++g) gp[g] = dpp_row_sum_f(dot16(v[r], WT + g * WT_LD, lane));
                float gl[N_GROUPS];
#pragma unroll
                for (int g = 0; g < N_GROUPS; ++g) gl[g] = rl4sum(gp[g]) + brg[g];
                int gi = 0; float gm = gl[0];
#pragma unroll
                for (int g = 1; g < N_GROUPS; ++g) if (gl[g] > gm) { gm = gl[g]; gi = g; }
                float gs = 0.f;
#pragma unroll
                for (int g = 0; g < N_GROUPS; ++g) gs += __expf(gl[g] - gm);
                const float gw = 1.f / gs;
                float ep[EPG];
#pragma unroll
                for (int e = 0; e < EPG; ++e) ep[e] = dpp_row_sum_f(dot16(v[r], WT + (4 + gi * EPG + e) * WT_LD, lane));
                float v0 = -INFINITY, v1 = -INFINITY; int i0 = 0, i1 = 0;
#pragma unroll
                for (int e = 0; e < EPG; ++e) { const float ev = rl4sum(ep[e]) + bre[gi * EPG + e];
                    if (ev > v0) { v1 = v0; i1 = i0; v0 = ev; i0 = e; } else if (ev > v1) { v1 = ev; i1 = e; } }
                const float e1 = __expf(v1 - v0); const float w0 = gw / (1.f + e1), w1 = gw * e1 / (1.f + e1);
                if (REAL && lane == 0) { const int ea = gi * EPG + i0, eb = gi * EPG + i1; const int rl = rl0 + r; const size_t row = row0 + r;
                    const int pa = atomicAdd((int*)&lcnt[ea], 1), pb = atomicAdd((int*)&lcnt[eb], 1);
                    ent[rl * 2] = (ea << 16) | pa; ent[rl * 2 + 1] = (eb << 16) | pb;
                    ((int*)(ws + WS_EID))[row * 2] = ea; ((int*)(ws + WS_EID))[row * 2 + 1] = eb; ((float*)(ws + WS_EW))[row * 2] = w0; ((float*)(ws + WS_EW))[row * 2 + 1] = w1; }
            }
        }
        __syncthreads();
        if (REAL && tid < 32) lbase[tid] = (int)atomicAdd((unsigned*)(ws + WS_CNT) + tid * 32, (unsigned)lcnt[tid]);
        __syncthreads();
        if (REAL && tid < 256) { const int en = ent[tid]; const int e = en >> 16, pos = lbase[e] + (en & 0xffff); ((int*)(ws + WS_POS))[(size_t)blk * 256 + tid] = pos; ((int*)(ws + WS_LIST))[e * 32768 + pos] = blk * 128 + (tid >> 1); }
        __syncthreads();
    }
}
__device__ __forceinline__ void p9_phase(unsigned char* ws, LAS unsigned char* lds, int G) {
    build_tables(ws, lds); const LAS int* toff = (const LAS int*)(lds + LDS_TAB);
    const int lane = threadIdx.x & 63, wave = threadIdx.x >> 6;
    for (int base = (blockIdx.x * NWAVES + wave) * 32; base < NT * 2; base += G * NWAVES * 32) {
        for (int k = 0; k < 32; k += 4) {
            const int ts0 = base + k; const int li = ts0 + (lane & 3);
            const int ev = ((const int*)(ws + WS_EID))[li], pv = ((const int*)(ws + WS_POS))[li];
            u32x4 d0[4], d1[4]; size_t dst[4];
#pragma unroll
            for (int r = 0; r < 4; ++r) { const int e = __builtin_amdgcn_readlane(ev, r), pos = __builtin_amdgcn_readlane(pv, r); dst[r] = (size_t)toff[e] * 256 + pos;
                const u32x4* sp = (const u32x4*)((const bf16_t*)(ws + WS_H2) + (size_t)((ts0 + r) >> 1) * D_MODEL); d0[r] = sp[lane]; d1[r] = sp[lane + 64]; }
#pragma unroll
            for (int r = 0; r < 4; ++r) { u32x4* dp = (u32x4*)((bf16_t*)(ws + WS_XG) + dst[r] * D_MODEL); dp[lane] = d0[r]; dp[lane + 64] = d1[r]; }
        }
    }
}
__device__ __forceinline__ void p12_phase(const float* const* in, float* out, float* dst, unsigned char* ws, LAS unsigned char* lds, int G) {
    build_tables(ws, lds); const LAS int* toff = (const LAS int*)(lds + LDS_TAB);
    const int lane = threadIdx.x & 63, wave = threadIdx.x >> 6; const float* g2 = in[21]; const float* b2 = in[22]; const float* g1 = in[12]; const float* b1 = in[13];
    for (int blk = blockIdx.x; blk < NT / 128; blk += G) {
        const int b = blk / 32; const float* gt2 = (const float*)(ws + WS_ADA) + (size_t)b * 6 * D_MODEL + 5 * D_MODEL;
        for (int rb = 0; rb < 16; rb += 4) {
            const size_t row0 = (size_t)blk * 128 + wave * 16 + rb;
            const size_t li = row0 * 2 + (lane & 7);
            const int ev = ((const int*)(ws + WS_EID))[li], pv = ((const int*)(ws + WS_POS))[li]; const float wv = ((const float*)(ws + WS_EW))[li];
            typedef float f32x2v __attribute__((ext_vector_type(2))); const f32x2v stv = ((const f32x2v*)(ws + WS_ST1))[row0 + (lane & 3)];
            f32x4 v[4][4]; u32x2 ya[4][4], yb[4][4]; float w0[4], w1[4], m1[4], r1[4];
#pragma unroll
            for (int r = 0; r < 4; ++r) {
                const int e0 = __builtin_amdgcn_readlane(ev, 2 * r), e1 = __builtin_amdgcn_readlane(ev, 2 * r + 1), p0 = __builtin_amdgcn_readlane(pv, 2 * r), p1 = __builtin_amdgcn_readlane(pv, 2 * r + 1);
                w0[r] = __int_as_float(__builtin_amdgcn_readlane(__float_as_int(wv), 2 * r)); w1[r] = __int_as_float(__builtin_amdgcn_readlane(__float_as_int(wv), 2 * r + 1));
                m1[r] = __int_as_float(__builtin_amdgcn_readlane(__float_as_int(stv.x), r)); r1[r] = __int_as_float(__builtin_amdgcn_readlane(__float_as_int(stv.y), r));
                const u32x2* y0 = (const u32x2*)((const bf16_t*)(ws + WS_YG) + ((size_t)toff[e0] * 256 + p0) * D_MODEL) + lane; const u32x2* y1 = (const u32x2*)((const bf16_t*)(ws + WS_YG) + ((size_t)toff[e1] * 256 + p1) * D_MODEL) + lane;
                const f32x4* xr = (const f32x4*)(out + (row0 + r) * D_MODEL) + lane;
#pragma unroll
                for (int j = 0; j < 4; ++j) { v[r][j] = xr[64 * j]; ya[r][j] = y0[64 * j]; yb[r][j] = y1[64 * j]; } }
#pragma unroll
            for (int j = 0; j < 4; ++j) { const f32x4 gv = *(const f32x4*)(gt2 + 256 * j + 4 * lane), g1v = *(const f32x4*)(g1 + 256 * j + 4 * lane), b1v = *(const f32x4*)(b1 + 256 * j + 4 * lane);
#pragma unroll
                for (int r = 0; r < 4; ++r) { const u32x2 a = ya[r][j], c = yb[r][j]; f32x4 f; v[r][j] = (v[r][j] - m1[r]) * r1[r] * g1v + b1v;
                    f.x = w0[r] * __uint_as_float(a.x << 16) + w1[r] * __uint_as_float(c.x << 16); f.y = w0[r] * __uint_as_float(a.x & 0xffff0000u) + w1[r] * __uint_as_float(c.x & 0xffff0000u);
                    f.z = w0[r] * __uint_as_float(a.y << 16) + w1[r] * __uint_as_float(c.y << 16); f.w = w0[r] * __uint_as_float(a.y & 0xffff0000u) + w1[r] * __uint_as_float(c.y & 0xffff0000u);
                    v[r][j] = v[r][j] * DN_ALPHA + gv * f; } }
            float rstd[4]; ln_center<4>(v, rstd);
#pragma unroll
            for (int j = 0; j < 4; ++j) { const f32x4 gg = *(const f32x4*)(g2 + 256 * j + 4 * lane), bb = *(const f32x4*)(b2 + 256 * j + 4 * lane);
#pragma unroll
                for (int r = 0; r < 4; ++r) ((f32x4*)(dst + (row0 + r) * D_MODEL) + lane)[64 * j] = v[r][j] * rstd[r] * gg + bb; }
        }
    }
}

constexpr size_t WS_TS = 384 * 1024;
constexpr size_t WS_DEAD = 392 * 1024;
constexpr size_t WS_BAR = 320 * 1024;
#define RLX_AGENT __ATOMIC_RELAXED, __HIP_MEMORY_SCOPE_AGENT
#define XB_TMO      128
#define XB_XCNT(j)  (256  + 64 * (j))
#define XB_XSUB(j)  (1280 + 64 * (j))
#define XB_XGEN(j)  (2304 + 64 * (j))
#define XB_TOP      3328
#define XB_TOPGEN   3392
#define XCD_BAR_WORDS 3456
#define XB_SPIN_CAP (1u << 18)

__device__ __forceinline__ unsigned xb_ld(unsigned* p)              { return __hip_atomic_load(p, __ATOMIC_RELAXED, __HIP_MEMORY_SCOPE_AGENT); }
__device__ __forceinline__ unsigned xb_add(unsigned* p, unsigned v) { return __hip_atomic_fetch_add(p, v, __ATOMIC_RELAXED, __HIP_MEMORY_SCOPE_AGENT); }
__device__ __forceinline__ unsigned xb_xcc_id() { return (unsigned)__builtin_amdgcn_s_getreg((3 << 11) | 20) & 0xFu; }
#define XB_SPIN(cond, bar) do { unsigned _sp = 0; while (cond) { __builtin_amdgcn_s_sleep(1); \
    if ((++_sp & 255u) == 0u) { if (xb_ld(&(bar)[XB_TMO])) break; if (_sp > XB_SPIN_CAP) { atomicAdd(&(bar)[XB_TMO], 1u); break; } } } } while (0)

struct XcdBarrier {
    unsigned* bar; unsigned x;
    volatile LAS unsigned* st;
};

__device__ __forceinline__ XcdBarrier xcd_barrier_post(unsigned* bar, volatile LAS unsigned* st) {
    XcdBarrier b; b.bar = bar; b.x = xb_xcc_id(); b.st = st;
    if (threadIdx.x == 0) (void)xb_add(&bar[XB_XCNT(b.x)], 1u);
    return b;
}
__device__ __forceinline__ void xcd_barrier_complete(unsigned* bar, unsigned x, unsigned& nloc, unsigned& nx) {
    const unsigned G = gridDim.x * gridDim.y * gridDim.z;
    unsigned sum, cnt, mine, sp = 0u;
    for (;;) {
        sum = 0u; cnt = 0u; mine = 0u;
#pragma unroll
        for (unsigned j = 0; j < 16; ++j) { const unsigned c = xb_ld(&bar[XB_XCNT(j)]); sum += c; cnt += (c > 0u) ? 1u : 0u; mine = (j == x) ? c : mine; }
        if (sum == G) break;
        __builtin_amdgcn_s_sleep(1);
        if ((++sp & 255u) == 0u) { if (xb_ld(&bar[XB_TMO])) break; if (sp > XB_SPIN_CAP) { atomicAdd(&bar[XB_TMO], 1u); break; } }
    }
    nloc = mine > 0u ? mine : 1u; nx = cnt > 0u ? cnt : 1u;
}

__device__ __forceinline__ void xcd_barrier(const XcdBarrier& b) {
    asm volatile("s_waitcnt vmcnt(0)" ::: "memory");
    __syncthreads();
    if (threadIdx.x == 0) {
        unsigned* bar = b.bar;
        __builtin_amdgcn_s_waitcnt(0);
        unsigned nloc = b.st[0], nx = b.st[1];
        if (nloc == 0u) { xcd_barrier_complete(bar, b.x, nloc, nx); b.st[0] = nloc; b.st[1] = nx; }
        const unsigned old = xb_add(&bar[XB_XSUB(b.x)], 1u);
        const unsigned gen = old / nloc;
        if (old + 1u == (gen + 1u) * nloc) {
            __builtin_amdgcn_fence(__ATOMIC_RELEASE, "agent");
            asm volatile("s_waitcnt vmcnt(0)" ::: "memory");
            const unsigned og = xb_add(&bar[XB_TOP], 1u);
            const unsigned tg = og / nx;
            if (og + 1u == (tg + 1u) * nx) xb_add(&bar[XB_TOPGEN], 1u);
            else XB_SPIN(xb_ld(&bar[XB_TOPGEN]) == tg, bar);
            __builtin_amdgcn_fence(__ATOMIC_ACQUIRE, "agent");
            xb_add(&bar[XB_XGEN(b.x)], 1u);
            asm volatile("s_waitcnt vmcnt(0)" ::: "memory");
        } else {
            XB_SPIN(xb_ld(&bar[XB_XGEN(b.x)]) == gen, bar);
            __builtin_amdgcn_fence(__ATOMIC_ACQUIRE, "agent");
            asm volatile("s_waitcnt vmcnt(0)" ::: "memory");
        }
    }
    __syncthreads();
}

__device__ __forceinline__ int opaque_i(int v) {
#if DUPMASK_ON
    asm volatile("" : "+v"(v)); v = __builtin_amdgcn_readfirstlane(v);
#endif
    return v; }
constexpr int NPH = 14;
struct Args { const float* in[23]; float* out; unsigned char* ws; int ph_lo, ph_hi; };
__global__ void __launch_bounds__(NTHREADS, 2) mk_fwd(Args a) {
    extern __shared__ __attribute__((aligned(16))) unsigned char lds_raw[];
    LAS unsigned char* lds = (LAS unsigned char*)lds_raw;
    cg::grid_group grid = cg::this_grid();
    const int G = gridDim.x, tid = threadIdx.x, lane = tid & 63, wave = __builtin_amdgcn_readfirstlane(tid >> 6);
    const int lo = a.ph_lo, hi = a.ph_hi;
    unsigned char* ws = a.ws;
    volatile LAS unsigned* bst = (volatile LAS unsigned*)(lds + LDS_BYTES - 16);
    if (tid < 4) bst[tid] = 0u;
    __syncthreads();
    XcdBarrier bar = xcd_barrier_post((unsigned*)(ws + WS_BAR), bst);
    if (TSTAMP && blockIdx.x == 0 && tid == 0) ((unsigned long long*)(ws + WS_TS))[0] = __builtin_amdgcn_s_memrealtime();
    if (a.ph_hi > NPH) grid.sync();
#ifndef PHMASK
#define PHMASK 0xFFFF
#endif
#define IN(k) (((PHMASK >> (k)) & 1) && lo <= (k) && (k) < hi)
#define GRIDBAR() do { if (USE_CG_SYNC) grid.sync(); else xcd_barrier(bar); } while (0)
#define SEAM(k) do { if (IN(k) && IN((k) + 1)) GRIDBAR(); if (TSTAMP && blockIdx.x == 0 && tid == 0) ((unsigned long long*)(ws + WS_TS))[(k) + 1] = __builtin_amdgcn_s_memrealtime(); } while (0)
#define PH(k) for (int rep_ = 0; rep_ < (IN(k) ? 1 + ((DUPMASK >> (k)) & 1) : 0); ++rep_) if (rep_ > 0 && (xcd_barrier(bar), false)) {} else
    PH(0) {
        if (blockIdx.x == 0 && tid < 32) ((unsigned*)(ws + WS_CNT))[tid * 32] = 0u;
        if (blockIdx.x == 2 && tid < 64) ((unsigned*)(ws + WS_DEAD))[tid] = (unsigned)((tid & 15) << 6) * 0x00010001u;
        if (blockIdx.x == 1 && tid < 256) { const float* wgp = a.in[6] + tid; u32x4 w0, w1;
            w0.x = cvtpk_s(wgp[0], wgp[256]); w0.y = cvtpk_s(wgp[512], wgp[768]); w0.z = cvtpk_s(wgp[1024], wgp[1280]); w0.w = cvtpk_s(wgp[1536], wgp[1792]);
            w1.x = cvtpk_s(wgp[2048], wgp[2304]); w1.y = cvtpk_s(wgp[2560], wgp[2816]); w1.z = cvtpk_s(wgp[3072], wgp[3328]); w1.w = cvtpk_s(wgp[3584], wgp[3840]);
            u32x4* dst = (u32x4*)((bf16_t*)(ws + WS_WGT) + tid * 16); dst[0] = w0; dst[1] = w1; }
        LAS float* scr = (LAS float*)(lds + wave * 16384);
        for (int it = blockIdx.x * NWAVES + wave; it < P0_ITEMS; it += G * NWAVES) p0_item(it, a.in, ws, scr, lane);
    }
    SEAM(0);
    PH(1) p1_phase(a.in, ws, lds, G);
    SEAM(1);
    PH(2) {
        pg8::Gemm g{(const bf16_t*)(ws + WS_XN), (const bf16_t*)(ws + WS_WIN), NT, NPROJ, D_MODEL}; pg8::StaticOrder S; S.init(NT, NPROJ, G, (int)blockIdx.x);
        EpiProj E{ws};
        pg8::gemm_phase<EpiProj, pg8::StaticOrder, PG8_ALIGN, PG8_SP2>(lds, g, S, E);
#ifdef DUP_P2
        xcd_barrier(bar);
        pg8::gemm_phase<EpiProj, pg8::StaticOrder, PG8_ALIGN, PG8_SP2>(lds, g, S, E);
#endif
    }
    SEAM(2);
    PH(3) {
        for (int u = blockIdx.x; u < 256; u += G) { const int p = u >> 1, b = p >> 4, qi = p & 15, qj = 31 - qi; LAS unsigned char* lw = lds + wave * 17408;
            for (int rep = 0; rep < ((DUPSUB & 1) ? 2 : 1); ++rep) {
                if ((u & 1) == 0) { p3a_run(b, qi, 0, qi, ws, lw, wave, lane); p3a_run(b, qj, 0, 15 - qi, ws, lw, wave, lane); }
                else p3a_run(b, qj, 16 - qi, qj, ws, lw, wave, lane); } }
        for (int p = blockIdx.x; p < GLA_ITEMS / 2; p += G) { p3b_pair(p, a.in[6], a.in[7], a.out, a.out + 24 * MiB, ws, lds); if (DUPSUB & 2) p3b_pair(p, a.in[6], a.in[7], a.out, a.out + 24 * MiB, ws, lds); }
    }
    SEAM(3);
    PH(4) {
        for (int j = blockIdx.x; j < 256; j += G) { p4b_item(j, a.out, (bf16_t*)(a.out + 16 * MiB), ws); if (DUPSUB & 8) p4b_item(j, a.out, (bf16_t*)(a.out + 16 * MiB), ws); }
        {
            const int W = blockIdx.x * NWAVES + wave;
            unsigned xa[32], xb[32]; LAS unsigned char* Hw = lds + wave * SEL_LDS;
            p4a_load(W, ws, lane, xa);
#pragma unroll 1
            for (int bb = 0; bb < NB; ++bb) {
                const int r0 = bb * NS + W, r1 = bb * NS + (NS - 1 - W), r2 = ((bb + 1 < NB) ? bb + 1 : bb) * NS + W;
                p4a_load(r1, ws, lane, xb);
                p4a_row(r0, ws, lane, xa, Hw); if (DUPSUB & 4) p4a_row(r0, ws, lane, xa, Hw);
                p4a_load(r2, ws, lane, xa);
                p4a_row(r1, ws, lane, xb, Hw); if (DUPSUB & 4) p4a_row(r1, ws, lane, xb, Hw);
            }
        }
    }
    SEAM(4);
    PH(5) {
        const int c = blockIdx.x; const int bh = c >> 2, sx = c & 3;
        for (int p = blockIdx.x; p < GLA_ITEMS / 2; p += G) { p5b_pair(p, a.out + 24 * MiB, a.in[8], (const bf16_t*)(a.out + 16 * MiB), ws, lds); if (DUPSUB & 32) p5b_pair(p, a.out + 24 * MiB, a.in[8], (const bf16_t*)(a.out + 16 * MiB), ws, lds); }
        if (c < 256) for (int i = 0; i < 4; ++i) { const int Q = (i == 0) ? sx : (i == 1) ? 7 - sx : (i == 2) ? 8 + sx : 15 - sx; if (wave < 4) attn_unit<false>(bh >> 3, bh & 7, Q, a.in[2], ws, lds); else attn_unit<true>(bh >> 3, bh & 7, Q, a.in[2], ws, lds);
            if (DUPSUB & 16) { if (wave < 4) attn_unit<false>(bh >> 3, bh & 7, Q, a.in[2], ws, lds); else attn_unit<true>(bh >> 3, bh & 7, Q, a.in[2], ws, lds); } }
    }
    SEAM(5);
    PH(6) {
        pg8::StaticOrder S; S.init(NT, D_MODEL, G, (int)blockIdx.x);
        { pg8::Gemm g{(const bf16_t*)(ws + WS_XN), (const bf16_t*)(ws + WS_WGAB), NT, D_MODEL, D_MODEL}; EpiSig E{ws, 0}; pg8::gemm_phase<EpiSig, pg8::StaticOrder, PG8_ALIGN, PG8_SP2>(lds, g, S, E); }
        { pg8::Gemm g{(const bf16_t*)(ws + WS_XN), (const bf16_t*)(ws + WS_WGAB) + (size_t)1024 * 1024, NT, D_MODEL, D_MODEL}; EpiSig E{ws, 1}; pg8::gemm_phase<EpiSig, pg8::StaticOrder, PG8_ALIGN, PG8_SP2>(lds, g, S, E); }
        { pg8::Gemm g{(const bf16_t*)(ws + WS_OAB), (const bf16_t*)(ws + WS_WBA), NT, D_MODEL, D_MODEL}; EpiMrgF E{ws}; pg8::gemm_phase<EpiMrgF, pg8::StaticOrder, PG8_ALIGN, PG8_SP2>(lds, g, S, E); }
    }
    SEAM(7);
    PH(8) {
        pg8::Gemm g{(const bf16_t*)(ws + WS_MRG), (const bf16_t*)(ws + WS_WOUT), NT, D_MODEL, D_MODEL}; pg8::StaticOrder S; S.init(NT, D_MODEL, G, (int)blockIdx.x);
        EpiV E{a.in[0], (const float*)(ws + WS_ADA), a.out}; pg8::gemm_phase<EpiV, pg8::StaticOrder, PG8_ALIGN, PG8_SP2>(lds, g, S, E);
    }
    SEAM(8);
#ifdef DUP_P8
    p8_phase<false>(a.in, a.out, (float*)(ws + 129 * MiB), (bf16_t*)(ws + 260 * MiB), ws, lds, G); xcd_barrier(bar);
#endif
    PH(9) p8_phase<true>(a.in, a.out, a.out, (bf16_t*)(ws + WS_H2), ws, lds, G);
    if (IN(9) && IN(11)) { GRIDBAR(); if (TSTAMP && blockIdx.x == 0 && tid == 0) ((unsigned long long*)(ws + WS_TS))[10] = __builtin_amdgcn_s_memrealtime(); }
    PH(11) {
        build_tables(ws, lds);
        pg8::Gemm g{(const bf16_t*)(ws + WS_H2), (const bf16_t*)(ws + WS_W13), 0, 0, D_MODEL}; GroupOrder<2> S{(const LAS int*)(lds + LDS_TAB), (const LAS int*)(lds + LDS_TAB) + 64, G, (int)blockIdx.x, (const int*)(ws + WS_LIST)};
        EpiHid E{ws}; pg8::gemm_phase<EpiHid, GroupOrder<2>, PG8_ALIGN, PG8_SP2, true>(lds, g, S, E);
    }
    SEAM(11);
    PH(12) {
        build_tables(ws, lds);
        int kd = D_EXP; asm volatile("" : "+s"(kd));
        pg8::Gemm g{(const bf16_t*)(ws + WS_HID), (const bf16_t*)(ws + WS_W2), 0, 0, kd}; GroupOrder<4> S{(const LAS int*)(lds + LDS_TAB), (const LAS int*)(lds + LDS_TAB) + 64, G, (int)blockIdx.x, nullptr};
        EpiY E{ws}; pg8::gemm_phase<EpiY, GroupOrder<4>, PG8_ALIGN, PG8_SP2>(lds, g, S, E);
    }
    SEAM(12);
#ifdef DUP_P12
    p12_phase(a.in, a.out, (float*)(ws + 129 * MiB), ws, lds, G); xcd_barrier(bar);
#endif
    PH(13) p12_phase(a.in, a.out, a.out, ws, lds, G);
    if (TSTAMP) { xcd_barrier(bar); if (blockIdx.x == 0 && tid == 0) ((unsigned long long*)(ws + WS_TS))[14] = __builtin_amdgcn_s_memrealtime(); }
#ifdef EXTRA_SYNCS
    for (int i_ = 0; i_ < EXTRA_SYNCS; ++i_) GRIDBAR();
#endif
#undef IN
#undef SEAM
#undef PH
}
}
#if TSTAMP
__global__ void kd_ts(float* out, long n, const unsigned long long* ts, int ka, int kb) {
    const float da = (ka == 14) ? (float)(ts[14] - ts[0]) * 0.01f / 10.f : (float)(ts[ka + 1] - ts[ka]) * 0.01f;
    const float sc = 1.f + da * 0.0005f;
    for (long i = (long)blockIdx.x * blockDim.x + threadIdx.x; i < n; i += (long)gridDim.x * blockDim.x) out[i] *= sc;
}
#endif
extern "C" void kernel_launch(void* const* d_in, const int* in_sizes, int n_in, void* d_out, int out_size,
                              void* d_ws, size_t ws_size, hipStream_t stream) {
    using namespace fk;
    static int grid = 0;
    if (grid == 0) {
        int dev = 0, cus = 0, per_cu = 0; (void)hipGetDevice(&dev); (void)hipDeviceGetAttribute(&cus, hipDeviceAttributeMultiprocessorCount, dev);
        (void)hipFuncSetAttribute((const void*)mk_fwd, hipFuncAttributeMaxDynamicSharedMemorySize, LDS_BYTES);
        (void)hipOccupancyMaxActiveBlocksPerMultiprocessor(&per_cu, (const void*)mk_fwd, NTHREADS, LDS_BYTES);
        (void)hipGetLastError();
        grid = cus * (per_cu >= 1 ? 1 : 1);
        if (ws_size < 512 * MiB) { fprintf(stderr, "kernel_launch: workspace too small\n"); grid = -1; }
    }
    if (grid < 0) return;
    (void)hipMemsetAsync((unsigned char*)d_ws + WS_BAR, 0, 16384, stream);
    Args a{}; for (int i = 0; i < 23; ++i) a.in[i] = (const float*)d_in[i]; a.out = (float*)d_out; a.ws = (unsigned char*)d_ws; a.ph_lo = 0; a.ph_hi = NPH;
    void* args[] = {&a};
    hipError_t e = hipLaunchCooperativeKernel((const void*)mk_fwd, dim3(grid), dim3(NTHREADS), args, LDS_BYTES, stream);
    if (e != hipSuccess) fprintf(stderr, "cooperative launch failed: %s\n", hipGetErrorString(e));
#if TSTAMP
    hipLaunchKernelGGL(kd_ts, dim3(1024), dim3(256), 0, stream, (float*)d_out, (long)out_size, (const unsigned long long*)((unsigned char*)d_ws + WS_TS), TS_A, TS_B);
#endif
}
```

```cpp
#include <hip/hip_runtime.h>
#include <hip/hip_cooperative_groups.h>
#include <cstdio>
#include <cstdint>
#include <cstring>
#include <cmath>
#ifdef HOST_EMU
#include <cmath>
#include <cstdio>
#include <cstdlib>
#include <cstring>
#include <cstdint>
struct Dim3e { int x, y, z; };
static thread_local Dim3e threadIdx, blockIdx, blockDim, gridDim;
#define __global__
#define __device__
#define __host__
#define __forceinline__ inline
#define __launch_bounds__(...)
typedef void* hipStream_t;
template <class F, class... A> static void host_launch(F f, long nb, int nt, A... a) {
#pragma omp parallel for schedule(dynamic, 4)
    for (long b = 0; b < nb; ++b) {
        blockIdx = {(int)b, 0, 0}; blockDim = {nt, 1, 1}; gridDim = {(int)nb, 1, 1};
        for (int t = 0; t < nt; ++t) { threadIdx = {t, 0, 0}; f(a...); }
    }
}
#define LAUNCH(k, nb, nt, st, ...) host_launch(k, (long)(nb), (int)(nt), __VA_ARGS__)
#define UNROLL
#else
#define LAUNCH(k, nb, nt, st, ...) hipLaunchKernelGGL(k, dim3((unsigned)(nb)), dim3((unsigned)(nt)), 0, st, __VA_ARGS__)
#endif

constexpr int D_MODEL = 1024, A_HEADS = 8, A_HD = 64, A_W = 512, I_HEADS = 16, I_DIM = 32, TOPK_MAX = 256, REL_B = 32,
              G_HEADS = 4, G_DK = 64, G_DV = 128, G_KW = 256, G_VW = 512, G_RANK = 16, N_GROUPS = 4, EPG = 8, N_EXP = 32, D_EXP = 256;
constexpr int O_AQ = 0, O_AK = 512, O_AV = 1024, O_IQ = 1536, O_IK = 2048, O_IW = 2080, O_GQ = 2096, O_GK = 2352, O_GV = 2608, O_GR = 3120,
              O_GLR = 3632, O_GA = 3648, O_GB = 4672, D_IN = 5696;
constexpr float DN_ALPHA = 1.189207115002721f, LN_EPS = 1e-5f;
#define V0_GID long gid = (long)blockIdx.x * blockDim.x + threadIdx.x

__device__ __forceinline__ float v0_silu(float v) { return v / (1.f + expf(-v)); }
__device__ __forceinline__ float v0_sigmoid(float v) { return 1.f / (1.f + expf(-v)); }

__global__ void k0_ada(const float* c, const float* w_ada, const float* b_ada, float* ada, int B) {
    V0_GID; if (gid >= (long)B * 6 * D_MODEL) return;
    const int b = (int)(gid / (6 * D_MODEL)), j = (int)(gid % (6 * D_MODEL));
    float acc = 0.f;
    for (int i = 0; i < D_MODEL; ++i) acc += v0_silu(c[b * D_MODEL + i]) * w_ada[(size_t)i * 6 * D_MODEL + j];
    ada[gid] = acc + b_ada[j];
}
__global__ void k0_lnmod(const float* x, const float* sh, const float* sc, float* h, int nrows) {
    V0_GID; if (gid >= nrows) return;
    const float* xr = x + (size_t)gid * D_MODEL; float* hr = h + (size_t)gid * D_MODEL;
    float mu = 0.f; for (int k = 0; k < D_MODEL; ++k) mu += xr[k]; mu *= (1.f / D_MODEL);
    float var = 0.f; for (int k = 0; k < D_MODEL; ++k) { const float d = xr[k] - mu; var += d * d; } var *= (1.f / D_MODEL);
    const float rs = 1.f / sqrtf(var + LN_EPS);
    for (int k = 0; k < D_MODEL; ++k) hr[k] = (xr[k] - mu) * rs * (1.f + sc[k]) + sh[k];
}
__global__ void k0_gemm(const float* A, int lda, const float* W, int ldw, float* C, int ldc, int M, int N, int K) {
    V0_GID; if (gid >= (long)(M / 4) * N) return;
    const int n = (int)(gid % N); const int m0 = (int)(gid / N) * 4;
    float a0 = 0.f, a1 = 0.f, a2 = 0.f, a3 = 0.f;
    const float* A0 = A + (size_t)m0 * lda;
    for (int k = 0; k < K; ++k) { const float w = W[(size_t)k * ldw + n]; a0 += A0[k] * w; a1 += A0[lda + k] * w; a2 += A0[2 * lda + k] * w; a3 += A0[3 * lda + k] * w; }
    C[(size_t)m0 * ldc + n] = a0; C[(size_t)(m0 + 1) * ldc + n] = a1; C[(size_t)(m0 + 2) * ldc + n] = a2; C[(size_t)(m0 + 3) * ldc + n] = a3;
}
__global__ void k0_scores(const float* P, float* scT, int S) {
    V0_GID; if (gid >= (long)S * S) return;
    const int t = (int)(gid % S), s = (int)(gid / S);
    if (s > t) { scT[gid] = -INFINITY; return; }
    const float* iq = P + (size_t)t * D_IN + O_IQ; const float* ik = P + (size_t)s * D_IN + O_IK; const float* iw = P + (size_t)t * D_IN + O_IW;
    const float cst = 0.044194173824159216f;
    float sc = 0.f;
    for (int h = 0; h < I_HEADS; ++h) { float d = 0.f; for (int k = 0; k < I_DIM; ++k) d += iq[h * I_DIM + k] * ik[k]; sc += (iw[h] * cst) * fmaxf(d, 0.f); }
    scT[gid] = sc;
}
__device__ __forceinline__ unsigned v0_key(float f) { unsigned u; memcpy(&u, &f, 4); return (u & 0x80000000u) ? ~u : (u | 0x80000000u); }
__global__ void k0_topk(const float* scT, int* sel, int* cnt, int S, int topk) {
    V0_GID; if (gid >= S) return;
    const int t = (int)gid; const int n = t + 1; int* sl = sel + (size_t)t * TOPK_MAX;
    if (n <= topk) { for (int s = 0; s < n; ++s) sl[s] = s; cnt[t] = n; return; }
    unsigned T = 0u;
    for (int bit = 31; bit >= 0; --bit) { const unsigned cand = T | (1u << bit); int c = 0; for (int s = 0; s < n; ++s) c += (v0_key(scT[(size_t)s * S + t]) >= cand) ? 1 : 0; if (c >= topk) T = cand; }
    int cgt = 0; for (int s = 0; s < n; ++s) cgt += (v0_key(scT[(size_t)s * S + t]) > T) ? 1 : 0;
    int need = topk - cgt, j = 0;
    for (int s = 0; s < n; ++s) { const unsigned k = v0_key(scT[(size_t)s * S + t]); if (k > T) sl[j++] = s; else if (k == T && need > 0) { sl[j++] = s; --need; } }
    cnt[t] = j;
}
__device__ __forceinline__ int v0_bucket(int d) {
    if (d < 16) return d;
    const float df = (float)d; int large = 16 + (int)(logf(df / 16.f) / 2.0794415416798357f * 16.f);
    return large < 31 ? large : 31;
}
__global__ void __launch_bounds__(256) k0_attn(const float* P, const int* sel, const int* cnt, const float* rel_bias, float* oa, int S) {
    V0_GID; if (gid >= (long)S * A_HEADS) return;
    const int t = (int)(gid / A_HEADS), h = (int)(gid % A_HEADS); const int n = cnt[t]; const int* sl = sel + (size_t)t * TOPK_MAX;
    const float* q = P + (size_t)t * D_IN + O_AQ + h * A_HD;
    float m = -INFINITY;
    for (int j = 0; j < n; ++j) { const int s = sl[j]; const float* k = P + (size_t)s * D_IN + O_AK + h * A_HD; float d = 0.f; for (int e = 0; e < A_HD; ++e) d += q[e] * k[e];
        const float l = d * 0.125f + rel_bias[v0_bucket(t - s) * A_HEADS + h]; m = fmaxf(m, l); }
    float o[A_HD];
#pragma unroll
    for (int e = 0; e < A_HD; ++e) o[e] = 0.f;
    float sum = 0.f;
    for (int j = 0; j < n; ++j) { const int s = sl[j]; const float* k = P + (size_t)s * D_IN + O_AK + h * A_HD; const float* v = P + (size_t)s * D_IN + O_AV + h * A_HD; float d = 0.f;
        for (int e = 0; e < A_HD; ++e) d += q[e] * k[e];
        const float p = expf(d * 0.125f + rel_bias[v0_bucket(t - s) * A_HEADS + h] - m); sum += p;
#pragma unroll
        for (int e = 0; e < A_HD; ++e) o[e] += p * v[e]; }
    const float inv = 1.f / sum;
#pragma unroll
    for (int e = 0; e < A_HD; ++e) oa[(size_t)t * A_W + h * A_HD + e] = o[e] * inv;
}
__global__ void k0_gate(const float* P, const float* wg, const float* bg, float* lg, int S) {
    V0_GID; if (gid >= (long)S * G_KW) return;
    const int t = (int)(gid / G_KW), j = (int)(gid % G_KW);
    float z = bg[j]; for (int r = 0; r < G_RANK; ++r) z += P[(size_t)t * D_IN + O_GLR + r] * wg[r * G_KW + j];
    lg[gid] = (fminf(z, 0.f) - log1pf(expf(-fabsf(z)))) * (1.f / 16.f);
}
__global__ void __launch_bounds__(64) k0_gla(const float* P, const float* lg, float* oraw, int S) {
    V0_GID; if (gid >= G_HEADS * G_DV) return;
    const int h = (int)(gid / G_DV), dv = (int)(gid % G_DV);
    float st[G_DK];
#pragma unroll
    for (int d = 0; d < G_DK; ++d) st[d] = 0.f;
    for (int t = 0; t < S; ++t) {
        const float* row = P + (size_t)t * D_IN; const float vv = row[O_GV + h * G_DV + dv]; float o = 0.f;
#pragma unroll
        for (int d = 0; d < G_DK; ++d) { const float a = expf(lg[(size_t)t * G_KW + h * G_DK + d]); st[d] = a * st[d] + row[O_GK + h * G_DK + d] * vv; o += row[O_GQ + h * G_DK + d] * st[d]; }
        oraw[(size_t)t * G_VW + h * G_DV + dv] = o * 0.125f;
    }
}
__global__ void k0_gla_post(const float* P, const float* oraw, const float* ng, float* ob, int S) {
    V0_GID; if (gid >= (long)S * G_HEADS) return;
    const int t = (int)(gid / G_HEADS), h = (int)(gid % G_HEADS); const float* o = oraw + (size_t)t * G_VW + h * G_DV;
    float mu = 0.f; for (int e = 0; e < G_DV; ++e) mu += o[e]; mu *= (1.f / G_DV);
    float var = 0.f; for (int e = 0; e < G_DV; ++e) { const float d = o[e] - mu; var += d * d; } var *= (1.f / G_DV);
    const float rs = 1.f / sqrtf(var + LN_EPS);
    for (int e = 0; e < G_DV; ++e) ob[(size_t)t * G_VW + h * G_DV + e] = (o[e] - mu) * rs * ng[h * G_DV + e] * v0_silu(P[(size_t)t * D_IN + O_GR + h * G_DV + e]);
}
__global__ void k0_merge(const float* P, const float* ba, const float* bb, float* mg, int S) {
    V0_GID; if (gid >= (long)S * D_MODEL) return;
    const int t = (int)(gid / D_MODEL), n = (int)(gid % D_MODEL);
    mg[gid] = v0_sigmoid(P[(size_t)t * D_IN + O_GA + n]) * ba[gid] + v0_sigmoid(P[(size_t)t * D_IN + O_GB + n]) * bb[gid];
}
__global__ void k0_ln1(const float* x, const float* y, const float* gt1, const float* g1, const float* b1, const float* sh2, const float* sc2, float* x1, float* h2, int nrows) {
    V0_GID; if (gid >= nrows) return;
    const float* xr = x + (size_t)gid * D_MODEL; const float* yr = y + (size_t)gid * D_MODEL; float* x1r = x1 + (size_t)gid * D_MODEL; float* h2r = h2 + (size_t)gid * D_MODEL;
    float mu = 0.f; for (int k = 0; k < D_MODEL; ++k) mu += DN_ALPHA * xr[k] + gt1[k] * yr[k]; mu *= (1.f / D_MODEL);
    float var = 0.f; for (int k = 0; k < D_MODEL; ++k) { const float d = DN_ALPHA * xr[k] + gt1[k] * yr[k] - mu; var += d * d; } var *= (1.f / D_MODEL);
    float rs = 1.f / sqrtf(var + LN_EPS);
    for (int k = 0; k < D_MODEL; ++k) x1r[k] = (DN_ALPHA * xr[k] + gt1[k] * yr[k] - mu) * rs * g1[k] + b1[k];
    mu = 0.f; for (int k = 0; k < D_MODEL; ++k) mu += x1r[k]; mu *= (1.f / D_MODEL);
    var = 0.f; for (int k = 0; k < D_MODEL; ++k) { const float d = x1r[k] - mu; var += d * d; } var *= (1.f / D_MODEL);
    rs = 1.f / sqrtf(var + LN_EPS);
    for (int k = 0; k < D_MODEL; ++k) h2r[k] = (x1r[k] - mu) * rs * (1.f + sc2[k]) + sh2[k];
}
__global__ void k0_route(const float* rl, const float* brg, const float* bre, int* eid, float* ew, int nrows) {
    V0_GID; if (gid >= nrows) return;
    const float* r = rl + (size_t)gid * 36;
    float gl[N_GROUPS]; float gm = -INFINITY; int gi = 0;
#pragma unroll
    for (int g = 0; g < N_GROUPS; ++g) { gl[g] = r[g] + brg[g]; if (gl[g] > gm) { gm = gl[g]; gi = g; } }
    float gs = 0.f;
#pragma unroll
    for (int g = 0; g < N_GROUPS; ++g) gs += expf(gl[g] - gm);
    const float gw = 1.f / gs;
    float v0 = -INFINITY, v1 = -INFINITY; int i0 = 0, i1 = 0;
    for (int e = 0; e < EPG; ++e) { const float v = r[4 + gi * EPG + e] + bre[gi * EPG + e];
        if (v > v0) { v1 = v0; i1 = i0; v0 = v; i0 = e; } else if (v > v1) { v1 = v; i1 = e; } }
    const float e1 = expf(v1 - v0); const float w0 = 1.f / (1.f + e1), w1 = e1 / (1.f + e1);
    eid[gid * 2] = gi * EPG + i0; eid[gid * 2 + 1] = gi * EPG + i1; ew[gid * 2] = w0 * gw; ew[gid * 2 + 1] = w1 * gw;
}
__global__ void k0_moe_hid(const float* h2, const int* eid, const float* w1, const float* w3, float* hid, int nrows) {
    V0_GID; if (gid >= (long)nrows * 2 * D_EXP) return;
    const int j = (int)(gid % D_EXP); const long ts = gid / D_EXP; const int t = (int)(ts / 2); const int e = eid[ts];
    const float* hr = h2 + (size_t)t * D_MODEL; const float* a = w1 + (size_t)e * D_MODEL * D_EXP + j; const float* b = w3 + (size_t)e * D_MODEL * D_EXP + j;
    float g = 0.f, u = 0.f; for (int k = 0; k < D_MODEL; ++k) { g += hr[k] * a[(size_t)k * D_EXP]; u += hr[k] * b[(size_t)k * D_EXP]; }
    hid[gid] = v0_silu(g) * u;
}
__global__ void k0_moe_out(const float* hid, const int* eid, const float* ew, const float* w2, float* f, int nrows) {
    V0_GID; if (gid >= (long)nrows * D_MODEL) return;
    const int n = (int)(gid % D_MODEL); const int t = (int)(gid / D_MODEL); float acc = 0.f;
    for (int sl = 0; sl < 2; ++sl) { const int e = eid[t * 2 + sl]; const float* hr = hid + ((size_t)t * 2 + sl) * D_EXP; const float* w = w2 + (size_t)e * D_EXP * D_MODEL + n; float a = 0.f;
        for (int j = 0; j < D_EXP; ++j) a += hr[j] * w[(size_t)j * D_MODEL]; acc += ew[t * 2 + sl] * a; }
    f[gid] = acc;
}
__global__ void k0_final(const float* x1, const float* f, const float* gt2, const float* g2, const float* b2, float* out, int nrows) {
    V0_GID; if (gid >= nrows) return;
    const float* xr = x1 + (size_t)gid * D_MODEL; const float* fr = f + (size_t)gid * D_MODEL; float* o = out + (size_t)gid * D_MODEL;
    float mu = 0.f; for (int k = 0; k < D_MODEL; ++k) mu += DN_ALPHA * xr[k] + gt2[k] * fr[k]; mu *= (1.f / D_MODEL);
    float var = 0.f; for (int k = 0; k < D_MODEL; ++k) { const float d = DN_ALPHA * xr[k] + gt2[k] * fr[k] - mu; var += d * d; } var *= (1.f / D_MODEL);
    const float rs = 1.f / sqrtf(var + LN_EPS);
    for (int k = 0; k < D_MODEL; ++k) o[k] = (DN_ALPHA * xr[k] + gt2[k] * fr[k] - mu) * rs * g2[k] + b2[k];
}

struct V0Buf { float *ada, *h, *P, *scT, *oa, *lg, *oraw, *ob, *ba, *bb, *mg, *y, *x1, *h2, *rl, *ew, *hid, *f; int *sel, *cnt, *eid; size_t bytes; };
static V0Buf v0_carve(void* base, int B, int S) {
    V0Buf b; char* p = (char*)base; auto take = [&](size_t n) { char* r = p; p += (n + 255) & ~(size_t)255; return r; };
    b.ada = (float*)take((size_t)B * 6 * D_MODEL * 4);
    b.P = (float*)take((size_t)S * D_IN * 4);
    b.h = (float*)take((size_t)S * D_MODEL * 4);
    b.scT = (float*)take((size_t)S * S * 4);
    b.sel = (int*)take((size_t)S * TOPK_MAX * 4); b.cnt = (int*)take((size_t)S * 4);
    b.oa = (float*)take((size_t)S * A_W * 4); b.lg = (float*)take((size_t)S * G_KW * 4); b.oraw = (float*)take((size_t)S * G_VW * 4); b.ob = (float*)take((size_t)S * G_VW * 4);
    b.ba = (float*)take((size_t)S * D_MODEL * 4); b.bb = (float*)take((size_t)S * D_MODEL * 4); b.y = (float*)take((size_t)S * D_MODEL * 4);
    b.x1 = (float*)take((size_t)S * D_MODEL * 4); b.h2 = (float*)take((size_t)S * D_MODEL * 4); b.f = (float*)take((size_t)S * D_MODEL * 4);
    b.mg = b.h;
    b.rl = (float*)take((size_t)S * 36 * 4); b.eid = (int*)take((size_t)S * 2 * 4); b.ew = (float*)take((size_t)S * 2 * 4); b.hid = (float*)take((size_t)S * 2 * D_EXP * 4);
    b.bytes = (size_t)(p - (char*)base); return b;
}
static void v0_forward(void* const* d_in, float* out, void* scratch, int B, int S, hipStream_t st, int only_batch = -1, int last_batch = -1) {
    const float *x = (const float*)d_in[0], *c = (const float*)d_in[1], *rel_bias = (const float*)d_in[2], *w_ada = (const float*)d_in[3], *b_ada = (const float*)d_in[4], *w_in = (const float*)d_in[5],
                *wg = (const float*)d_in[6], *bg = (const float*)d_in[7], *ng = (const float*)d_in[8], *wba = (const float*)d_in[9], *wbb = (const float*)d_in[10], *wout = (const float*)d_in[11],
                *g1 = (const float*)d_in[12], *b1 = (const float*)d_in[13], *wrg = (const float*)d_in[14], *brg = (const float*)d_in[15], *wre = (const float*)d_in[16], *bre = (const float*)d_in[17],
                *w1 = (const float*)d_in[18], *w3 = (const float*)d_in[19], *w2 = (const float*)d_in[20], *g2 = (const float*)d_in[21], *b2 = (const float*)d_in[22];
    V0Buf u = v0_carve(scratch, B, S);
    const int TB = 256; auto nb = [&](long n) { return (n + TB - 1) / TB; };
    const int topk = (TOPK_MAX < S / 4) ? TOPK_MAX : S / 4;
    LAUNCH(k0_ada, nb((long)B * 6 * D_MODEL), TB, st, c, w_ada, b_ada, u.ada, B);
    for (int bi = 0; bi < B; ++bi) {
        int b = bi; if (last_batch >= 0) b = (bi == B - 1) ? last_batch : (bi < last_batch ? bi : bi + 1);
        if (only_batch >= 0 && b != only_batch) continue;
        const float* xb = x + (size_t)b * S * D_MODEL; const float* ad = u.ada + (size_t)b * 6 * D_MODEL;
        const float *sh1 = ad, *sc1 = ad + D_MODEL, *gt1 = ad + 2 * D_MODEL, *sh2 = ad + 3 * D_MODEL, *sc2 = ad + 4 * D_MODEL, *gt2 = ad + 5 * D_MODEL;
        LAUNCH(k0_lnmod, nb(S), TB, st, xb, sh1, sc1, u.h, S);
        LAUNCH(k0_gemm, nb((long)(S / 4) * D_IN), TB, st, (const float*)u.h, D_MODEL, w_in, D_IN, u.P, D_IN, S, D_IN, D_MODEL);
        LAUNCH(k0_scores, nb((long)S * S), TB, st, (const float*)u.P, u.scT, S);
        LAUNCH(k0_topk, nb(S), TB, st, (const float*)u.scT, u.sel, u.cnt, S, topk);
        LAUNCH(k0_attn, nb((long)S * A_HEADS), TB, st, (const float*)u.P, (const int*)u.sel, (const int*)u.cnt, rel_bias, u.oa, S);
        LAUNCH(k0_gate, nb((long)S * G_KW), TB, st, (const float*)u.P, wg, bg, u.lg, S);
        LAUNCH(k0_gla, (G_HEADS * G_DV + 63) / 64, 64, st, (const float*)u.P, (const float*)u.lg, u.oraw, S);
        LAUNCH(k0_gla_post, nb((long)S * G_HEADS), TB, st, (const float*)u.P, (const float*)u.oraw, ng, u.ob, S);
        LAUNCH(k0_gemm, nb((long)(S / 4) * D_MODEL), TB, st, (const float*)u.oa, A_W, wba, D_MODEL, u.ba, D_MODEL, S, D_MODEL, A_W);
        LAUNCH(k0_gemm, nb((long)(S / 4) * D_MODEL), TB, st, (const float*)u.ob, G_VW, wbb, D_MODEL, u.bb, D_MODEL, S, D_MODEL, G_VW);
        LAUNCH(k0_merge, nb((long)S * D_MODEL), TB, st, (const float*)u.P, (const float*)u.ba, (const float*)u.bb, u.mg, S);
        LAUNCH(k0_gemm, nb((long)(S / 4) * D_MODEL), TB, st, (const float*)u.mg, D_MODEL, wout, D_MODEL, u.y, D_MODEL, S, D_MODEL, D_MODEL);
        LAUNCH(k0_ln1, nb(S), TB, st, xb, (const float*)u.y, gt1, g1, b1, sh2, sc2, u.x1, u.h2, S);
        LAUNCH(k0_gemm, nb((long)(S / 4) * N_GROUPS), TB, st, (const float*)u.h2, D_MODEL, wrg, N_GROUPS, u.rl, 36, S, N_GROUPS, D_MODEL);
        LAUNCH(k0_gemm, nb((long)(S / 4) * N_EXP), TB, st, (const float*)u.h2, D_MODEL, wre, N_EXP, u.rl + 4, 36, S, N_EXP, D_MODEL);
        LAUNCH(k0_route, nb(S), TB, st, (const float*)u.rl, brg, bre, u.eid, u.ew, S);
        LAUNCH(k0_moe_hid, nb((long)S * 2 * D_EXP), TB, st, (const float*)u.h2, (const int*)u.eid, w1, w3, u.hid, S);
        LAUNCH(k0_moe_out, nb((long)S * D_MODEL), TB, st, (const float*)u.hid, (const int*)u.eid, (const float*)u.ew, w2, u.f, S);
        LAUNCH(k0_final, nb(S), TB, st, (const float*)u.x1, (const float*)u.f, gt2, g2, b2, out + (size_t)b * S * D_MODEL, S);
    }
}
namespace pg8 {
#define PG8_LAS __attribute__((address_space(3)))
typedef unsigned short bf16_t;
typedef short bf16x8 __attribute__((ext_vector_type(8)));
typedef float f32x4 __attribute__((ext_vector_type(4)));
typedef unsigned u32x4 __attribute__((ext_vector_type(4)));
constexpr int BM = 256, BK = 64, HALF = 128, HTB = HALF * BK * 2  , STAGE_BYTES = 8 * HTB, NXCD = 8, WGM = 8;

__host__ __device__ __forceinline__ int lds_byte(int r, int c) { const int st = (r >> 4) * 2 + (c >> 5), rr = r & 15, cc = c & 31, ob = rr * 64 + cc * 2; return st * 1024 + (ob ^ (((ob >> 9) & 1) << 5)); }
__host__ __device__ __forceinline__ void stage_rc(int b, int& R, int& C) { const int st = b / 1024, sb = b % 1024, swz = sb ^ (((sb >> 9) & 1) << 5); R = (st >> 1) * 16 + swz / 64; C = (st & 1) * 32 + (swz % 64) / 2; }
__host__ __device__ __forceinline__ int perm32(int rho) { const int n = rho >> 4, i = rho & 15; return 8 * (i >> 2) + 4 * n + (i & 3); }

struct Unit { int pm, pn, pa, pb; };
struct Gemm { const bf16_t* A; const bf16_t* Bt; int M, N, K; };

struct StaticOrder {
    int nM, nN, nwg, G, c;
    __host__ __device__ void init(int M, int N, int G_, int c_) { nM = M / BM; nN = N / BM; nwg = nM * nN; G = G_; c = c_; }
    __host__ __device__ bool next(int i, Unit& u) const {
        const long L = (long)i * G + c; if (L >= nwg) return false;
        int wgid = (int)L; { const int q = nwg / NXCD, r = nwg % NXCD, xcd = wgid % NXCD, off = wgid / NXCD; wgid = (xcd < r ? xcd * (q + 1) : r * (q + 1) + (xcd - r) * q) + off; }
        const int nig = WGM * nN, gid = wgid / nig, fm = gid * WGM, gsz = (nM - fm) < WGM ? (nM - fm) : WGM;
        u.pm = fm + ((wgid % nig) % gsz); u.pn = (wgid % nig) / gsz; u.pa = u.pm; u.pb = u.pn; return true;
    }
    __device__ __forceinline__ void a_ready(const Unit&) const {}
    __device__ __forceinline__ void done(const Unit&) const {}
};

__device__ __forceinline__ unsigned cvt_pk_bf16(float lo, float hi) { unsigned r; asm volatile("v_cvt_pk_bf16_f32 %0, %1, %2" : "=v"(r) : "v"(lo), "v"(hi)); return r; }
typedef float f32x2 __attribute__((ext_vector_type(2)));

template <class Epi, class Sched, bool ALIGN_EPI = false, bool SP2 = false, bool GATHER = false>
__device__ __forceinline__ void gemm_phase(PG8_LAS unsigned char* lds, const Gemm g, const Sched& S, const Epi& E) {
    const int tid = threadIdx.x, wid = __builtin_amdgcn_readfirstlane(tid >> 6), lane = tid & 63, wr = wid >> 2, wc = wid & 3, fr = lane & 15, fq = lane >> 4;
    const int K = g.K, nt = K / BK;
    static_assert(!GATHER || SP2, "gathered A rows: SP2 loop only");
    unsigned voffA[2], voffB[2]; int Rr[2], Cc[2];
#pragma unroll
    for (int i = 0; i < 2; ++i) { int R, C; stage_rc(tid * 16 + i * 8192, R, C); const int Rb = Epi::PERM ? ((R & ~31) + perm32(R & 31)) : R; Rr[i] = R; Cc[i] = C;
        voffA[i] = (unsigned)(R * K + C) * 2u; voffB[i] = (unsigned)(Rb * K + C) * 2u; }
    unsigned vc0[2] = {voffA[0], voffA[1]}, vc1[2] = {voffA[0], voffA[1]}, vn0[2] = {voffA[0], voffA[1]}, vn1[2] = {voffA[0], voffA[1]};
    const size_t kstep = (size_t)(BK * 2);
    const size_t hstep = (size_t)HALF * K * 2;
    const size_t tstep = 2 * hstep;
    const unsigned ldsw = (unsigned)wid * 1024u;
    const int aoff = lds_byte(wr * 64 + fr, fq * 8), boff = lds_byte(wc * 32 + fr, fq * 8);
#define PG8_SA(b, h) (((b) * 2 + (h)) * HTB)
#define PG8_SB(b, h) ((4 + (b) * 2 + (h)) * HTB)
#define PG8_STAGE(bufoff, gbase, voff) do { _Pragma("unroll") for (int _i = 0; _i < 2; ++_i) \
        __builtin_amdgcn_global_load_lds((const unsigned*)((const char*)(gbase) + (voff)[_i]), (PG8_LAS unsigned*)(lds + (bufoff) + ldsw + _i * 8192), 16, 0, 0); } while (0)
#define PG8_LDA(dst, b, h) do { _Pragma("unroll") for (int m = 0; m < 4; ++m) _Pragma("unroll") for (int k = 0; k < 2; ++k) dst[m][k] = *(const PG8_LAS bf16x8*)(lds + PG8_SA(b, h) + aoff + m * 2048 + k * 1024); } while (0)
#define PG8_LDB(dst, b, h) do { _Pragma("unroll") for (int n = 0; n < 2; ++n) _Pragma("unroll") for (int k = 0; k < 2; ++k) dst[n][k] = *(const PG8_LAS bf16x8*)(lds + PG8_SB(b, h) + boff + n * 2048 + k * 1024); } while (0)
#define PG8_MMA(ai, bj, At, Bt) do { __builtin_amdgcn_s_setprio(1); _Pragma("unroll") for (int m = 0; m < 4; ++m) _Pragma("unroll") for (int n = 0; n < 2; ++n) _Pragma("unroll") for (int k = 0; k < 2; ++k) \
        acc[ai][bj][m][n] = __builtin_amdgcn_mfma_f32_16x16x32_bf16(Bt[n][k], At[m][k], acc[ai][bj][m][n], 0, 0, 0); __builtin_amdgcn_s_setprio(0); } while (0)
#define PG8_WAIT_V(n) asm volatile("s_waitcnt vmcnt(" #n ")" ::: "memory")
#define PG8_WAIT_L(n) asm volatile("s_waitcnt lgkmcnt(" #n ")" ::: "memory")
#define PG8_BAR __builtin_amdgcn_s_barrier()
#define PG8_SCHED __builtin_amdgcn_sched_barrier(0)
    Unit cur, nxt; int ui = 0;
    if (!S.next(0, cur)) return;
    f32x4 acc[2][2][4][2];
#pragma unroll
    for (int a = 0; a < 2; ++a)
#pragma unroll
        for (int b = 0; b < 2; ++b)
#pragma unroll
            for (int m = 0; m < 4; ++m)
#pragma unroll
                for (int n = 0; n < 2; ++n) acc[a][b][m][n] = (f32x4){0.f, 0.f, 0.f, 0.f};
    bf16x8 At[4][2], B0[2][2], B1[2][2];
    const char* cA = GATHER ? (const char*)g.A : (const char*)g.A + (size_t)cur.pa * tstep; const char* cB = (const char*)g.Bt + (size_t)cur.pb * tstep;
    const size_t hstepA = GATHER ? 0 : hstep;
    if constexpr (GATHER) {
#pragma unroll
        for (int i = 0; i < 2; ++i) { vc0[i] = (unsigned)S.a_row(cur, Rr[i]) * (unsigned)(K * 2) + (unsigned)(Cc[i] * 2); vc1[i] = (unsigned)S.a_row(cur, HALF + Rr[i]) * (unsigned)(K * 2) + (unsigned)(Cc[i] * 2); } }
    S.a_ready(cur);
    if constexpr (SP2) {
        PG8_STAGE(PG8_SB(0, 0), cB, voffB); PG8_STAGE(PG8_SB(0, 1), cB + hstep, voffB); PG8_STAGE(PG8_SA(0, 0), cA, vc0); PG8_STAGE(PG8_SA(0, 1), cA + hstepA, vc1);
        if (wr == 1) PG8_BAR;
        PG8_WAIT_V(2); PG8_BAR;
        PG8_STAGE(PG8_SB(1, 0), cB + kstep, voffB); PG8_STAGE(PG8_SA(1, 0), cA + kstep, vc0); PG8_STAGE(PG8_SB(1, 1), cB + hstep + kstep, voffB);
        PG8_WAIT_V(6); PG8_BAR;
    } else {
        PG8_STAGE(PG8_SB(0, 0), cB, voffB); PG8_STAGE(PG8_SA(0, 0), cA, voffA); PG8_STAGE(PG8_SB(0, 1), cB + hstep, voffB); PG8_STAGE(PG8_SA(0, 1), cA + hstep, voffA);
        if (wr == 1) PG8_BAR;
        PG8_WAIT_V(4); PG8_BAR;
        PG8_STAGE(PG8_SB(1, 0), cB + kstep, voffB); PG8_STAGE(PG8_SA(1, 0), cA + kstep, voffA); PG8_STAGE(PG8_SB(1, 1), cB + hstep + kstep, voffB);
        PG8_WAIT_V(6); PG8_BAR;
    }
    for (;;) {
        const bool has_next = S.next(ui + 1, nxt);
        const char* nA = GATHER ? cA : (has_next ? (const char*)g.A + (size_t)nxt.pa * tstep : cA); const char* nB = has_next ? (const char*)g.Bt + (size_t)nxt.pb * tstep : cB;
        if constexpr (GATHER) {
#pragma unroll
            for (int i = 0; i < 2; ++i) { vn0[i] = has_next ? (unsigned)S.a_row(nxt, Rr[i]) * (unsigned)(K * 2) + (unsigned)(Cc[i] * 2) : vc0[i]; vn1[i] = has_next ? (unsigned)S.a_row(nxt, HALF + Rr[i]) * (unsigned)(K * 2) + (unsigned)(Cc[i] * 2) : vc1[i]; } }
        for (int t = 0; t < nt; t += 2) {
            const bool last = (t == nt - 2);
            if constexpr (Epi::MID) { if (t == nt / 2) E.mid(acc, cur, wr, wc, fr, fq); }
            const char* a1 = cA + (size_t)(t + 1) * kstep;
            const char* a2 = last ? nA : cA + (size_t)(t + 2) * kstep; const char* b2 = last ? nB : cB + (size_t)(t + 2) * kstep;
            const char* a3 = a2 + kstep; const char* b3 = b2 + kstep;
            if (last && has_next) S.a_ready(nxt);
            if constexpr (SP2) {
            unsigned w0[2], w1[2];
#pragma unroll
            for (int i = 0; i < 2; ++i) { w0[i] = last ? vn0[i] : vc0[i]; w1[i] = last ? vn1[i] : vc1[i]; }
            PG8_LDB(B0, 0, 0); PG8_LDB(B1, 0, 1); PG8_SCHED; PG8_LDA(At, 0, 0); PG8_STAGE(PG8_SA(1, 1), a1 + hstepA, vc1);
            PG8_WAIT_V(8); PG8_WAIT_L(0); PG8_BAR; PG8_MMA(0, 0, At, B0); PG8_MMA(0, 1, At, B1); PG8_BAR; PG8_SCHED;
            PG8_LDA(At, 0, 1); PG8_STAGE(PG8_SB(0, 0), b2, voffB); PG8_STAGE(PG8_SB(0, 1), b2 + hstep, voffB); PG8_STAGE(PG8_SA(0, 0), a2, w0);
            PG8_WAIT_V(8); PG8_WAIT_L(0); PG8_BAR; PG8_MMA(1, 0, At, B0); PG8_MMA(1, 1, At, B1); PG8_BAR; PG8_SCHED;
            PG8_LDB(B0, 1, 0); PG8_LDB(B1, 1, 1); PG8_SCHED; PG8_LDA(At, 1, 0); PG8_STAGE(PG8_SA(0, 1), a2 + hstepA, w1);
            PG8_WAIT_V(8); PG8_WAIT_L(0); PG8_BAR; PG8_MMA(0, 0, At, B0); PG8_MMA(0, 1, At, B1); PG8_BAR; PG8_SCHED;
            PG8_LDA(At, 1, 1); PG8_STAGE(PG8_SB(1, 0), b3, voffB); PG8_STAGE(PG8_SB(1, 1), b3 + hstep, voffB); PG8_STAGE(PG8_SA(1, 0), a3, w0);
            PG8_WAIT_V(8); PG8_WAIT_L(0); PG8_BAR; PG8_MMA(1, 0, At, B0); PG8_MMA(1, 1, At, B1); PG8_BAR; PG8_SCHED;
            } else {
            PG8_LDB(B0, 0, 0); PG8_SCHED; PG8_LDA(At, 0, 0); PG8_STAGE(PG8_SA(1, 1), a1 + hstep, voffA);
            PG8_WAIT_L(8); PG8_BAR; PG8_WAIT_L(0); PG8_MMA(0, 0, At, B0); PG8_BAR; PG8_SCHED;
            PG8_LDB(B1, 0, 1); PG8_STAGE(PG8_SB(0, 0), b2, voffB);
            PG8_BAR; PG8_WAIT_L(0); PG8_MMA(0, 1, At, B1); PG8_BAR;
            PG8_LDA(At, 0, 1); PG8_STAGE(PG8_SA(0, 0), a2, voffA);
            PG8_BAR; PG8_WAIT_L(0); PG8_MMA(1, 0, At, B0); PG8_BAR; PG8_SCHED;
            PG8_STAGE(PG8_SB(0, 1), b2 + hstep, voffB);
            PG8_WAIT_V(6); PG8_BAR; PG8_MMA(1, 1, At, B1); PG8_BAR;
            PG8_LDB(B0, 1, 0); PG8_SCHED; PG8_LDA(At, 1, 0); PG8_STAGE(PG8_SA(0, 1), a2 + hstep, voffA);
            PG8_WAIT_L(8); PG8_BAR; PG8_WAIT_L(0); PG8_MMA(0, 0, At, B0); PG8_BAR; PG8_SCHED;
            PG8_LDB(B1, 1, 1); PG8_STAGE(PG8_SB(1, 0), b3, voffB);
            PG8_BAR; PG8_WAIT_L(0); PG8_MMA(0, 1, At, B1); PG8_BAR;
            PG8_LDA(At, 1, 1); PG8_STAGE(PG8_SA(1, 0), a3, voffA);
            PG8_BAR; PG8_WAIT_L(0); PG8_MMA(1, 0, At, B0); PG8_BAR; PG8_SCHED;
            PG8_STAGE(PG8_SB(1, 1), b3 + hstep, voffB);
            PG8_WAIT_V(6); PG8_BAR; PG8_MMA(1, 1, At, B1); PG8_BAR;
            }
        }
        if constexpr (ALIGN_EPI) { if (wr == 0) PG8_BAR; }
        if constexpr (!Epi::AFTER_DRAIN) { E(acc, cur, wr, wc, fr, fq); S.done(cur); }
        if (!has_next) break;
#pragma unroll
        for (int a = 0; a < 2; ++a)
#pragma unroll
            for (int b = 0; b < 2; ++b)
#pragma unroll
                for (int m = 0; m < 4; ++m)
#pragma unroll
                    for (int n = 0; n < 2; ++n) acc[a][b][m][n] = (f32x4){0.f, 0.f, 0.f, 0.f};
        cur = nxt; cA = nA; cB = nB; ++ui;
        if constexpr (GATHER) { vc0[0] = vn0[0]; vc0[1] = vn0[1]; vc1[0] = vn1[0]; vc1[1] = vn1[1]; }
        if constexpr (ALIGN_EPI) { if (wr == 1) PG8_BAR; }
    }
    PG8_WAIT_V(0);
    if constexpr (!ALIGN_EPI) { if (wr == 0) PG8_BAR; }
    PG8_BAR;
    if constexpr (Epi::AFTER_DRAIN) { E.fused(acc, cur, wr, wc, fr, fq, lds, wid, lane); S.done(cur); }
#undef PG8_SA
#undef PG8_SB
#undef PG8_STAGE
#undef PG8_LDA
#undef PG8_LDB
#undef PG8_MMA
#undef PG8_WAIT_V
#undef PG8_WAIT_L
#undef PG8_BAR
#undef PG8_SCHED
}
}

#ifndef PG8_SP2
#define PG8_SP2 true
#endif
#ifndef PG8_ALIGN
#define PG8_ALIGN true
#endif
#ifndef DUPSUB
#define DUPSUB 0
#endif
#ifndef TSTAMP
#define TSTAMP 0
#endif
#ifndef USE_CG_SYNC
#define USE_CG_SYNC 0
#endif
#ifndef DUPMASK
#define DUPMASK 0
#define DUPMASK_ON 0
#else
#define DUPMASK_ON 1
#endif
namespace cg = cooperative_groups;
namespace fk {
using pg8::bf16_t; using pg8::f32x4; using pg8::u32x4; using pg8::bf16x8; using pg8::Unit; using pg8::cvt_pk_bf16;
#define LAS __attribute__((address_space(3)))
#define LDS_WAIT() asm volatile("s_waitcnt lgkmcnt(0)" ::: "memory")
typedef unsigned u32x2 __attribute__((ext_vector_type(2)));
constexpr int NB = 8, NS = 4096, NT = NB * NS;
constexpr int NTHREADS = 512, NWAVES = 8, LDS_BYTES = 155648;
constexpr size_t MiB = (size_t)1 << 20;
constexpr size_t WS_ADA = 0, WS_CNT = 256 * 1024,
    WS_WIN = 1 * MiB, WS_WGAB = 9 * MiB, WS_WBA = 13 * MiB, WS_WBB = 14 * MiB, WS_WOUT = 15 * MiB, WS_W13 = 17 * MiB, WS_W2 = 49 * MiB,
    WS_XN = 65 * MiB, WS_QKV = 129 * MiB, WS_IQ = 225 * MiB, WS_GQK = 257 * MiB, WS_GV = 289 * MiB, WS_GR = 321 * MiB,
    WS_IK = 353 * MiB, WS_IW = 355 * MiB, WS_GLR = 357 * MiB, WS_SC = 358 * MiB, WS_MASK = 490 * MiB, WS_ADAP = 506 * MiB, WS_MISC = 509 * MiB;
constexpr int NPROJ = 3584;
constexpr size_t WS_WGT = 400 * 1024;
constexpr int KSL = 16;
constexpr float QSCALE = 0.125f * 1.4426950408889634f;
typedef float f32x2_t __attribute__((ext_vector_type(2))); typedef __bf16 bf16x2_t __attribute__((ext_vector_type(2)));
__device__ __forceinline__ unsigned cvtpk_s(float lo, float hi) { f32x2_t v = {lo, hi}; bf16x2_t b = __builtin_convertvector(v, bf16x2_t); return __builtin_bit_cast(unsigned, b); }
__device__ __forceinline__ void bf8_to_f(const u32x4 w, float* f) {
#pragma unroll
    for (int j = 0; j < 4; ++j) { f[2 * j] = __uint_as_float(w[j] << 16); f[2 * j + 1] = __uint_as_float(w[j] & 0xffff0000u); }
}

__device__ __forceinline__ void tr_item(const float* W, int ldw, int srccol, bf16_t* WT, int K, int dst_row0, int kb, LAS float* scr, int lane, int kdst0 = 0) {
    const int k0 = 64 * kb;
#pragma unroll
    for (int i = 0; i < 32; ++i) { const int kk = 2 * i + (lane >> 5); scr[kk * 33 + (lane & 31)] = W[(size_t)(k0 + kk) * ldw + srccol]; }
    LDS_WAIT();
    const int c = lane & 7;
#pragma unroll
    for (int j = 0; j < 4; ++j) { const int n = (lane >> 3) + 8 * j; const LAS float* s = scr + (8 * c) * 33 + n;
        u32x4 o; o.x = cvt_pk_bf16(s[0 * 33], s[1 * 33]); o.y = cvt_pk_bf16(s[2 * 33], s[3 * 33]); o.z = cvt_pk_bf16(s[4 * 33], s[5 * 33]); o.w = cvt_pk_bf16(s[6 * 33], s[7 * 33]);
        *(u32x4*)(WT + (size_t)(dst_row0 + n) * K + kdst0 + k0 + 8 * c) = o; }
    LDS_WAIT();
}
__device__ __forceinline__ int win_src(int n) {
    if (n < 2048) return n;
    if (n < 3584) return n + 48;
    if (n < 3616) return O_IK + (n - 3584);
    if (n < 3632) return O_IW + (n - 3616);
    return O_GLR + (n - 3632);
}
constexpr int I_ADA = 96 * KSL, I_WIN = 114 * 16, I_WGAB = 64 * 16, I_WB = 32 * 8, I_WOUT = 32 * 16, I_W13 = 32 * 16 * 16, I_W2 = 32 * 32 * 4;
constexpr int P0_ITEMS = I_ADA + I_WIN + I_WGAB + 2 * I_WB + I_WOUT + I_W13 + I_W2, P0_EARLY = I_ADA + I_WIN + I_WGAB + 2 * I_WB + I_WOUT;
__device__ __forceinline__ void p0_item(int it, const float* const* in, unsigned char* ws, LAS float* scr, int lane) {
    if (it < I_ADA) {
        const int cb = it / KSL, ks = it % KSL, k0 = ks * 64; const float* c = in[1]; const float* w = in[3];
#pragma unroll
        for (int b = 0; b < NB; ++b) { const float cv = c[b * D_MODEL + k0 + lane]; scr[b * 64 + lane] = cv / (1.f + __expf(-cv)); }
        LDS_WAIT();
        float acc[NB];
#pragma unroll
        for (int b = 0; b < NB; ++b) acc[b] = 0.f;
        const int col = cb * 64 + lane;
#pragma unroll 16
        for (int kk = 0; kk < 64; ++kk) { const float wv = w[(size_t)(k0 + kk) * (6 * D_MODEL) + col];
#pragma unroll
            for (int b = 0; b < NB; ++b) acc[b] += scr[b * 64 + kk] * wv; }
        float* adap = (float*)(ws + WS_ADAP);
#pragma unroll
        for (int b = 0; b < NB; ++b) adap[(size_t)(ks * NB + b) * (6 * D_MODEL) + col] = acc[b];
        LDS_WAIT(); return;
    }
    it -= I_ADA;
    const int l31 = lane & 31;
    if (it < I_WIN) { const int nb = it / 16, kb = it % 16; tr_item(in[5], D_IN, win_src(nb * 32 + l31), (bf16_t*)(ws + WS_WIN), 1024, nb * 32, kb, scr, lane); return; }
    it -= I_WIN;
    if (it < I_WGAB) { const int nb = it / 16, kb = it % 16; tr_item(in[5], D_IN, O_GA + nb * 32 + l31, (bf16_t*)(ws + WS_WGAB), 1024, nb * 32, kb, scr, lane); return; }
    it -= I_WGAB;
    if (it < I_WB) { const int nb = it / 8, kb = it % 8; tr_item(in[9], D_MODEL, nb * 32 + l31, (bf16_t*)(ws + WS_WBA), 1024, nb * 32, kb, scr, lane, 0); return; }
    it -= I_WB;
    if (it < I_WB) { const int nb = it / 8, kb = it % 8; tr_item(in[10], D_MODEL, nb * 32 + l31, (bf16_t*)(ws + WS_WBA), 1024, nb * 32, kb, scr, lane, 512); return; }
    it -= I_WB;
    if (it < I_WOUT) { const int nb = it / 16, kb = it % 16; tr_item(in[11], D_MODEL, nb * 32 + l31, (bf16_t*)(ws + WS_WOUT), 1024, nb * 32, kb, scr, lane); return; }
    it -= I_WOUT;
    if (it < I_W13) {
        const int e = it / 256, r = it % 256, nb = r / 16, kb = r % 16; const int row0 = nb * 32;
        const int half = (row0 & 255) >> 7; const int col = (row0 >> 8) * 128 + (row0 & 127) + l31;
        const float* src = (half ? in[19] : in[18]) + (size_t)e * D_MODEL * D_EXP;
        tr_item(src, D_EXP, col, (bf16_t*)(ws + WS_W13) + (size_t)e * 512 * 1024, 1024, row0, kb, scr, lane); return; }
    it -= I_W13;
    { const int e = it / 128, r = it % 128, nb = r / 4, kb = r % 4;
      tr_item(in[20] + (size_t)e * D_EXP * D_MODEL, D_MODEL, nb * 32 + l31, (bf16_t*)(ws + WS_W2) + (size_t)e * 1024 * 256, 256, nb * 32, kb, scr, lane); }
}

__device__ __forceinline__ float dpp_row_sum_f(float v) {
    v += __int_as_float(__builtin_amdgcn_update_dpp(0, __float_as_int(v), 0xB1, 0xF, 0xF, true));
    v += __int_as_float(__builtin_amdgcn_update_dpp(0, __float_as_int(v), 0x4E, 0xF, 0xF, true));
    v += __int_as_float(__builtin_amdgcn_update_dpp(0, __float_as_int(v), 0x141, 0xF, 0xF, true));
    v += __int_as_float(__builtin_amdgcn_update_dpp(0, __float_as_int(v), 0x140, 0xF, 0xF, true));
    return v;
}
__device__ __forceinline__ float wave_sum_u(float v) {
    v = dpp_row_sum_f(v);
    return (__int_as_float(__builtin_amdgcn_readlane(__float_as_int(v), 0)) + __int_as_float(__builtin_amdgcn_readlane(__float_as_int(v), 16)))
         + (__int_as_float(__builtin_amdgcn_readlane(__float_as_int(v), 32)) + __int_as_float(__builtin_amdgcn_readlane(__float_as_int(v), 48)));
}
template <int R> __device__ __forceinline__ void ln_center(f32x4 (&v)[R][4], float (&rstd)[R], float* meanout = nullptr) {
    float s[R];
#pragma unroll
    for (int r = 0; r < R; ++r) { s[r] = 0.f;
#pragma unroll
        for (int j = 0; j < 4; ++j) s[r] += (v[r][j].x + v[r][j].y) + (v[r][j].z + v[r][j].w); }
#pragma unroll
    for (int r = 0; r < R; ++r) s[r] = dpp_row_sum_f(s[r]);
    float q[R];
#pragma unroll
    for (int r = 0; r < R; ++r) { const float mean = ((__int_as_float(__builtin_amdgcn_readlane(__float_as_int(s[r]), 0)) + __int_as_float(__builtin_amdgcn_readlane(__float_as_int(s[r]), 16)))
                                                   + (__int_as_float(__builtin_amdgcn_readlane(__float_as_int(s[r]), 32)) + __int_as_float(__builtin_amdgcn_readlane(__float_as_int(s[r]), 48)))) * (1.f / D_MODEL);
        if (meanout) meanout[r] = mean;
        q[r] = 0.f;
#pragma unroll
        for (int j = 0; j < 4; ++j) { v[r][j] = v[r][j] - mean; q[r] += (v[r][j].x * v[r][j].x + v[r][j].y * v[r][j].y) + (v[r][j].z * v[r][j].z + v[r][j].w * v[r][j].w); } }
#pragma unroll
    for (int r = 0; r < R; ++r) q[r] = dpp_row_sum_f(q[r]);
#pragma unroll
    for (int r = 0; r < R; ++r) { const float var = ((__int_as_float(__builtin_amdgcn_readlane(__float_as_int(q[r]), 0)) + __int_as_float(__builtin_amdgcn_readlane(__float_as_int(q[r]), 16)))
                                                  + (__int_as_float(__builtin_amdgcn_readlane(__float_as_int(q[r]), 32)) + __int_as_float(__builtin_amdgcn_readlane(__float_as_int(q[r]), 48)))) * (1.f / D_MODEL);
        rstd[r] = 1.f / sqrtf(var + LN_EPS); }
}
__device__ __forceinline__ float wave_sum(float v) {
#pragma unroll
    for (int o = 1; o < 64; o <<= 1) v += __shfl_xor(v, o);
    return v;
}
__device__ __forceinline__ float ada_sum(const float* adap, const float* b_ada, int b, int j) {
    float s = b_ada[j];
#pragma unroll
    for (int k = 0; k < KSL; ++k) s += adap[(size_t)(k * NB + b) * (6 * D_MODEL) + j];
    return s;
}
__device__ __forceinline__ void p1_phase(const float* const* in, unsigned char* ws, LAS unsigned char* lds, int G) {
    const int tid = threadIdx.x, lane = tid & 63, wave = tid >> 6;
    const float* adap = (const float*)(ws + WS_ADAP); const float* b_ada = in[4]; const float* x = in[0];
    LAS float* sh = (LAS float*)lds; LAS float* sc = sh + D_MODEL;
    for (int blk = blockIdx.x; blk < NT / 128; blk += G) {
        const int b = blk / 32;
        __syncthreads();
        for (int j = tid; j < 2 * D_MODEL; j += NTHREADS) sh[j] = ada_sum(adap, b_ada, b, j);
        if ((blk & 31) == 0) { float* ada = (float*)(ws + WS_ADA) + (size_t)b * 6 * D_MODEL; for (int j = tid; j < 6 * D_MODEL; j += NTHREADS) ada[j] = ada_sum(adap, b_ada, b, j); }
        __syncthreads();
        for (int rb = 0; rb < 16; rb += 4) {
            const size_t row0 = (size_t)blk * 128 + wave * 16 + rb;
            f32x4 v[4][4];
#pragma unroll
            for (int r = 0; r < 4; ++r) { const f32x4* xr = (const f32x4*)(x + (row0 + r) * D_MODEL) + lane;
#pragma unroll
                for (int j = 0; j < 4; ++j) v[r][j] = xr[64 * j]; }
            float rstd[4]; ln_center<4>(v, rstd);
#pragma unroll
            for (int j = 0; j < 4; ++j) { const f32x4 a = *(const LAS f32x4*)(sc + 256 * j + 4 * lane) + 1.f, c = *(const LAS f32x4*)(sh + 256 * j + 4 * lane);
#pragma unroll
                for (int r = 0; r < 4; ++r) { const f32x4 y = v[r][j] * rstd[r] * a + c; u32x2 w; w.x = cvtpk_s(y.x, y.y); w.y = cvtpk_s(y.z, y.w);
                    ((u32x2*)((bf16_t*)(ws + WS_XN) + (row0 + r) * D_MODEL) + lane)[64 * j] = w; } }
        }
        asm volatile("s_waitcnt vmcnt(0)" ::: "memory"); __syncthreads();
        {   LAS unsigned char* W64 = lds + 8192; constexpr int WP = 2064;
            const bf16_t* wsrc = (const bf16_t*)(ws + WS_WIN) + (size_t)3584 * 1024;
            for (int i = tid; i < 64 * 128; i += NTHREADS) { const int n = i >> 7, c = i & 127; *(LAS u32x4*)(W64 + n * WP + c * 16) = *(const u32x4*)(wsrc + (size_t)n * 1024 + c * 8); }
            __syncthreads();
            const int fr = lane & 15, fq = lane >> 4; const size_t rowA = (size_t)blk * 128 + wave * 16 + fr;
            const bf16_t* xp = (const bf16_t*)(ws + WS_XN) + rowA * D_MODEL + 8 * fq;
            f32x4 acc[4];
#pragma unroll
            for (int nt = 0; nt < 4; ++nt) acc[nt] = (f32x4){0.f, 0.f, 0.f, 0.f};
#pragma unroll 8
            for (int ks = 0; ks < 32; ++ks) { const bf16x8 bfr = *(const bf16x8*)(xp + 32 * ks);
#pragma unroll
                for (int nt = 0; nt < 4; ++nt) { const bf16x8 afr = *(const LAS bf16x8*)(W64 + (16 * nt + fr) * WP + (32 * ks + 8 * fq) * 2); acc[nt] = __builtin_amdgcn_mfma_f32_16x16x32_bf16(afr, bfr, acc[nt], 0, 0, 0); } }
            { u32x2 w; w.x = cvtpk_s(acc[0][0], acc[0][1]); w.y = cvtpk_s(acc[0][2], acc[0][3]); *(u32x2*)((bf16_t*)(ws + WS_IK) + rowA * 32 + 4 * fq) = w;
              w.x = cvtpk_s(acc[1][0], acc[1][1]); w.y = cvtpk_s(acc[1][2], acc[1][3]); *(u32x2*)((bf16_t*)(ws + WS_IK) + rowA * 32 + 16 + 4 * fq) = w;
              *(f32x4*)((float*)(ws + WS_IW) + rowA * 16 + 4 * fq) = acc[2];
              w.x = cvtpk_s(acc[3][0], acc[3][1]); w.y = cvtpk_s(acc[3][2], acc[3][3]); *(u32x2*)((bf16_t*)(ws + WS_GLR) + rowA * 16 + 4 * fq) = w; }
        }
    }
}

struct EpiProj {
    static constexpr bool PERM = true, AFTER_DRAIN = false, MID = false;
    unsigned char* ws;
    __device__ __forceinline__ void operator()(const f32x4 (&acc)[2][2][4][2], const Unit& u, int wr, int wc, int fr, int fq) const {
        const int row0 = u.pm * 256 + wr * 64 + fr; const int pn = u.pn;
        {
            bf16_t* base; int ld, ct; float sc = 1.f;
            if (pn < 6) { base = (bf16_t*)(ws + WS_QKV); ld = 1536; ct = pn * 256; if (pn < 2) sc = QSCALE; }
            else if (pn < 8) { base = (bf16_t*)(ws + WS_IQ); ld = 512; ct = (pn - 6) * 256; }
            else if (pn < 10) { base = (bf16_t*)(ws + WS_GQK); ld = 512; ct = (pn - 8) * 256; }
            else if (pn < 12) { base = (bf16_t*)(ws + WS_GV); ld = 512; ct = (pn - 10) * 256; }
            else { base = (bf16_t*)(ws + WS_GR); ld = 512; ct = (pn - 12) * 256; }
            const int col0 = ct + wc * 32 + 8 * fq;
#pragma unroll
            for (int ai = 0; ai < 2; ++ai)
#pragma unroll
                for (int m = 0; m < 4; ++m) { bf16_t* rowp = base + (size_t)(row0 + ai * 128 + m * 16) * ld + col0;
#pragma unroll
                    for (int bj = 0; bj < 2; ++bj) { const f32x4 v0 = acc[ai][bj][m][0] * sc, v1 = acc[ai][bj][m][1] * sc;
                        u32x4 w; w.x = cvt_pk_bf16(v0[0], v0[1]); w.y = cvt_pk_bf16(v0[2], v0[3]); w.z = cvt_pk_bf16(v1[0], v1[1]); w.w = cvt_pk_bf16(v1[2], v1[3]);
                        *(u32x4*)(rowp + bj * 128) = w; } }
        }
    }
};

typedef float f32x4_t __attribute__((ext_vector_type(4)));
constexpr int SC_TILES_PER_B = 528, SC_ITEMS = NB * SC_TILES_PER_B;
__device__ __forceinline__ size_t keys_row_dw(int b, int t) {
    const int qi = t >> 7, r = t & 127; return (size_t)b * (SC_TILES_PER_B * 8192) + (size_t)8192 * (qi * (qi + 1) / 2) + (size_t)r * (qi + 1) * 64;
}
__device__ __forceinline__ unsigned score_key(float sc) {
    const _Float16 hf = (_Float16)sc; const unsigned short hb = __builtin_bit_cast(unsigned short, hf);
    return (hb & 0x8000u) ? (unsigned)(unsigned short)~hb : (unsigned)(hb | 0x8000u);
}
__device__ __forceinline__ void fma_abs4(f32x4& acc, const f32x4& d, float w) {
    float a0 = acc[0], a1 = acc[1], a2 = acc[2], a3 = acc[3];
    asm volatile("v_fma_f32 %0, |%4|, %8, %0\n\tv_fma_f32 %1, |%5|, %8, %1\n\tv_fma_f32 %2, |%6|, %8, %2\n\tv_fma_f32 %3, |%7|, %8, %3"
                 : "+v"(a0), "+v"(a1), "+v"(a2), "+v"(a3) : "v"(d[0]), "v"(d[1]), "v"(d[2]), "v"(d[3]), "v"(w));
    acc[0] = a0; acc[1] = a1; acc[2] = a2; acc[3] = a3;
}
constexpr int SC_SEGS_PER_B = 144, SC_SEGS = NB * SC_SEGS_PER_B;
__device__ __forceinline__ unsigned score_key2(float lo, float hi) {
    typedef _Float16 h2 __attribute__((ext_vector_type(2)));
    const unsigned x = __builtin_bit_cast(unsigned, __builtin_amdgcn_cvt_pkrtz(lo, hi));
    unsigned m; asm("v_pk_ashrrev_i16 %0, %2, %1" : "=v"(m) : "v"(x), "v"(0x000F000Fu));
    return x ^ (m | 0x80008000u);
}
__device__ __forceinline__ void p3a_run(int b, int qi, int kj0, int kj1, unsigned char* ws, LAS unsigned char* ldsw, int wave, int lane) {
    const int fr = lane & 15, fq = lane >> 4;
    const int t = qi * 128 + wave * 16 + fr; const size_t trow = (size_t)b * NS + t;
    const bf16_t* IQ = (const bf16_t*)(ws + WS_IQ) + trow * 512 + 8 * fq;
    const bf16_t* IK = (const bf16_t*)(ws + WS_IK) + ((size_t)b * NS + fr) * 32 + 8 * fq;
    const float* IW = (const float*)(ws + WS_IW) + trow * 16;
    LAS unsigned char* QL = ldsw; LAS float* WL = (LAS float*)(ldsw + 16384);
    bf16x8 kf[8];
#pragma unroll
    for (int kb = 0; kb < 8; ++kb) kf[kb] = *(const bf16x8*)(IK + ((size_t)kj0 * 128 + kb * 16) * 32);
    float qb[8];
#pragma unroll
    for (int j = 0; j < 8; ++j) qb[j] = 0.f;
#pragma unroll
    for (int hg = 0; hg < 4; ++hg) {
        const f32x4 w4 = *(const f32x4*)(IW + 4 * hg) * (0.5f * 0.044194173824159216f);
        u32x4 q4[4];
#pragma unroll
        for (int i = 0; i < 4; ++i) q4[i] = *(const u32x4*)(IQ + (4 * hg + i) * 32);
#pragma unroll
        for (int i = 0; i < 4; ++i) { *(LAS u32x4*)(QL + (4 * hg + i) * 1024 + lane * 16) = q4[i]; if (fq == 0) WL[(4 * hg + i) * 16 + fr] = w4[i]; float f[8]; bf8_to_f(q4[i], f);
#pragma unroll
            for (int j = 0; j < 8; ++j) qb[j] += w4[i] * f[j]; }
    }
    u32x4 qbw; qbw.x = cvtpk_s(qb[0], qb[1]); qbw.y = cvtpk_s(qb[2], qb[3]); qbw.z = cvtpk_s(qb[4], qb[5]); qbw.w = cvtpk_s(qb[6], qb[7]);
    const bf16x8 qbar = __builtin_bit_cast(bf16x8, qbw);
    LDS_WAIT();
    for (int kj = kj0; kj <= kj1; ++kj) {
        bf16x8 kn[8];
        const int kjn = (kj < kj1) ? kj + 1 : kj;
#pragma unroll
        for (int kb = 0; kb < 8; ++kb) kn[kb] = *(const bf16x8*)(IK + ((size_t)kjn * 128 + kb * 16) * 32);
        f32x4 acc[8];
#pragma unroll
        for (int kb = 0; kb < 8; ++kb) acc[kb] = __builtin_amdgcn_mfma_f32_16x16x32_bf16(kf[kb], qbar, (f32x4){0.f, 0.f, 0.f, 0.f}, 0, 0, 0);
        f32x4 dA[8], dB[8];
        { const bf16x8 qf = *(const LAS bf16x8*)(QL + lane * 16);
#pragma unroll
          for (int kb = 0; kb < 8; ++kb) dA[kb] = __builtin_amdgcn_mfma_f32_16x16x32_bf16(kf[kb], qf, (f32x4){0.f, 0.f, 0.f, 0.f}, 0, 0, 0); }
#pragma unroll 1
        for (int h = 0; h < I_HEADS; h += 2) {
            { const bf16x8 qf = *(const LAS bf16x8*)(QL + (h + 1) * 1024 + lane * 16);
#pragma unroll
              for (int kb = 0; kb < 8; ++kb) dB[kb] = __builtin_amdgcn_mfma_f32_16x16x32_bf16(kf[kb], qf, (f32x4){0.f, 0.f, 0.f, 0.f}, 0, 0, 0); }
            __builtin_amdgcn_sched_barrier(0);
            { const float w = WL[h * 16 + fr];
#pragma unroll
              for (int kb = 0; kb < 8; ++kb) fma_abs4(acc[kb], dA[kb], w); }
            __builtin_amdgcn_sched_barrier(0);
            { const int hn = (h + 2 < I_HEADS) ? h + 2 : h; const bf16x8 qf = *(const LAS bf16x8*)(QL + hn * 1024 + lane * 16);
#pragma unroll
              for (int kb = 0; kb < 8; ++kb) dA[kb] = __builtin_amdgcn_mfma_f32_16x16x32_bf16(kf[kb], qf, (f32x4){0.f, 0.f, 0.f, 0.f}, 0, 0, 0); }
            __builtin_amdgcn_sched_barrier(0);
            { const float w = WL[(h + 1) * 16 + fr];
#pragma unroll
              for (int kb = 0; kb < 8; ++kb) fma_abs4(acc[kb], dB[kb], w); }
            __builtin_amdgcn_sched_barrier(0);
        }
        unsigned* KEYS = (unsigned*)(ws + WS_SC) + keys_row_dw(b, t) + (size_t)kj * 64;
        const bool diag = (kj == qi);
#pragma unroll
        for (int kb = 0; kb < 4; ++kb) { u32x4 o;
#pragma unroll
            for (int r = 0; r < 4; ++r) o[r] = score_key2(acc[kb][r], acc[kb + 4][r]);
            if (diag) { asm volatile("" ::: "memory");
#pragma unroll
                for (int r = 0; r < 4; ++r) { const int sl = kb * 16 + 4 * fq + r, tl = wave * 16 + fr; if (sl > tl) o[r] &= 0xFFFF0000u; if (sl + 64 > tl) o[r] &= 0x0000FFFFu; } }
            *(u32x4*)(KEYS + kb * 16 + 4 * fq) = o; }
#pragma unroll
        for (int kb = 0; kb < 8; ++kb) kf[kb] = kn[kb];
    }
    LDS_WAIT();
}

__device__ __forceinline__ int dpp_row_sum(int v) {
    v += __builtin_amdgcn_update_dpp(0, v, 0xB1, 0xF, 0xF, true);
    v += __builtin_amdgcn_update_dpp(0, v, 0x4E, 0xF, 0xF, true);
    v += __builtin_amdgcn_update_dpp(0, v, 0x141, 0xF, 0xF, true);
    v += __builtin_amdgcn_update_dpp(0, v, 0x140, 0xF, 0xF, true);
    return v;
}
__device__ __forceinline__ int wave_sum_i(int v) {
    v = dpp_row_sum(v);
    return __builtin_amdgcn_readlane(v, 0) + __builtin_amdgcn_readlane(v, 16) + __builtin_amdgcn_readlane(v, 32) + __builtin_amdgcn_readlane(v, 48);
}
__device__ __forceinline__ void pk_ge_count4(unsigned x0, unsigned x1, unsigned x2, unsigned x3, unsigned c2m1, unsigned one2, unsigned& c0, unsigned& c1, unsigned& c2, unsigned& c3) {
    unsigned d0, d1, d2, d3;
    asm volatile("v_pk_sub_u16 %0, %8, %12 clamp\n\tv_pk_sub_u16 %1, %9, %12 clamp\n\tv_pk_sub_u16 %2, %10, %12 clamp\n\tv_pk_sub_u16 %3, %11, %12 clamp\n\t"
                 "v_pk_min_u16 %0, %0, %13\n\tv_pk_min_u16 %1, %1, %13\n\tv_pk_min_u16 %2, %2, %13\n\tv_pk_min_u16 %3, %3, %13\n\t"
                 "v_pk_add_u16 %4, %4, %0\n\tv_pk_add_u16 %5, %5, %1\n\tv_pk_add_u16 %6, %6, %2\n\tv_pk_add_u16 %7, %7, %3"
                 : "=&v"(d0), "=&v"(d1), "=&v"(d2), "=&v"(d3), "+v"(c0), "+v"(c1), "+v"(c2), "+v"(c3) : "v"(x0), "v"(x1), "v"(x2), "v"(x3), "v"(c2m1), "v"(one2));
}
constexpr int TOPK = 256;
__device__ __forceinline__ int count_ge(const unsigned (&x)[32], int ng, unsigned cand) {
    const unsigned c2m1 = (cand - 1u) * 0x00010001u, one2 = 0x00010001u; unsigned c0 = 0u, c1 = 0u, c2 = 0u, c3 = 0u;
#pragma unroll
    for (int g = 0; g < 4; ++g) if (g < ng) { pk_ge_count4(x[8 * g], x[8 * g + 1], x[8 * g + 2], x[8 * g + 3], c2m1, one2, c0, c1, c2, c3); pk_ge_count4(x[8 * g + 4], x[8 * g + 5], x[8 * g + 6], x[8 * g + 7], c2m1, one2, c0, c1, c2, c3); }
    const unsigned s = (c0 + c1) + (c2 + c3);
    return wave_sum_i((int)((s & 0xFFFFu) + (s >> 16)));
}
__device__ __forceinline__ void p4a_load(int row_, unsigned char* ws, int lane, unsigned (&x)[32]) {
    const int row = __builtin_amdgcn_readfirstlane(row_); const int b = row / NS, t = row % NS; const int nc = (t >> 7) + 1;
    const unsigned* KEYS = (const unsigned*)(ws + WS_SC) + keys_row_dw(b, t); const unsigned* DEADK = (const unsigned*)(ws + 392 * 1024);
#pragma unroll
    for (int c = 0; c < 32; ++c) { const unsigned* base = c < nc ? KEYS + c * 64 : DEADK; x[c] = base[lane]; }
}
__device__ __forceinline__ int scan16_incl(int v) {
    v += __builtin_amdgcn_update_dpp(0, v, 0x111, 0xF, 0xF, true);
    v += __builtin_amdgcn_update_dpp(0, v, 0x112, 0xF, 0xF, true);
    v += __builtin_amdgcn_update_dpp(0, v, 0x114, 0xF, 0xF, true);
    v += __builtin_amdgcn_update_dpp(0, v, 0x118, 0xF, 0xF, true);
    return v;
}
__device__ __forceinline__ int scan64_incl(int v, int lane) {
    v = scan16_incl(v);
    const int t0 = __builtin_amdgcn_readlane(v, 15), t1 = __builtin_amdgcn_readlane(v, 31), t2 = __builtin_amdgcn_readlane(v, 47);
    return v + (lane >= 16 ? t0 : 0) + (lane >= 32 ? t1 : 0) + (lane >= 48 ? t2 : 0);
}
__device__ __forceinline__ unsigned bin_lo(unsigned x, unsigned hb) { unsigned a; asm("v_bfe_u32 %0, %1, 6, 10\n\tv_lshl_add_u32 %0, %0, 2, %2" : "=&v"(a) : "v"(x), "s"(hb)); return a; }
__device__ __forceinline__ unsigned bin_hi(unsigned x, unsigned hb) { unsigned a; asm("v_lshrrev_b32 %0, 22, %1\n\tv_lshl_add_u32 %0, %0, 2, %2" : "=&v"(a) : "v"(x), "s"(hb)); return a; }
__device__ __forceinline__ void lds_inc(unsigned addr) { __hip_atomic_fetch_add((LAS unsigned*)(unsigned long)addr, 1u, __ATOMIC_RELAXED, __HIP_MEMORY_SCOPE_WORKGROUP); }
#define WAVE_LDS_ORDER() do { asm volatile("" ::: "memory"); __builtin_amdgcn_fence(__ATOMIC_ACQ_REL, "wavefront"); __builtin_amdgcn_wave_barrier(); asm volatile("" ::: "memory"); } while (0)
constexpr int SEL_LDS = 8192;
__device__ __forceinline__ void tie_fix(unsigned long long& m, unsigned long long e, int& run, int need) {
    if (e != 0ull) { const int n = __builtin_popcountll(e); int keep = need - run; run += n;
        if (keep < n) { if (keep < 0) keep = 0; unsigned long long d = e; for (int i = 0; i < keep; ++i) d &= d - 1ull; m &= ~d; } }
}
#define PUT4(mw0, mw1, a0, a1, a2, a3, L0) asm volatile("s_nop 3\n\tv_writelane_b32 %0, %2, %10\n\tv_writelane_b32 %1, %3, %10\n\tv_writelane_b32 %0, %4, %11\n\tv_writelane_b32 %1, %5, %11\n\t" \
        "v_writelane_b32 %0, %6, %12\n\tv_writelane_b32 %1, %7, %12\n\tv_writelane_b32 %0, %8, %13\n\tv_writelane_b32 %1, %9, %13" : "+v"(mw0), "+v"(mw1) \
        : "s"((unsigned)(a0)), "s"((unsigned)((a0) >> 32)), "s"((unsigned)(a1)), "s"((unsigned)((a1) >> 32)), "s"((unsigned)(a2)), "s"((unsigned)((a2) >> 32)), "s"((unsigned)(a3)), "s"((unsigned)((a3) >> 32)), \
          "n"(L0), "n"((L0) + 1), "n"((L0) + 2), "n"((L0) + 3))
__device__ __forceinline__ void p4a_row(int row_, unsigned char* ws, int lane, const unsigned (&x)[32], LAS unsigned char* H) {
    const int row = __builtin_amdgcn_readfirstlane(row_);
    const int t = row % NS; unsigned long long* MASK = (unsigned long long*)(ws + WS_MASK) + (size_t)row * 64;
    const int nc = (t >> 7) + 1;
    if (t < TOPK) {
        if (lane < 2 * nc) { const int lo = lane * 64; unsigned long long m = 0ull; if (t >= lo + 63) m = ~0ull; else if (t >= lo) m = (2ull << (t - lo)) - 1ull; MASK[lane] = m; }
        return;
    }
    const unsigned hb = (unsigned)(unsigned long)H;
    { const u32x4 z = (u32x4){0u, 0u, 0u, 0u};
#pragma unroll
      for (int i = 0; i < 4; ++i) *(LAS u32x4*)(H + i * 1024 + lane * 16) = z;
      *(LAS unsigned*)(H + 4096 + lane * 4) = 0u; }
    WAVE_LDS_ORDER();
#pragma unroll
    for (int c = 0; c < 32; c += 2) if (c < nc) {
        lds_inc(bin_lo(x[c], hb)); lds_inc(bin_hi(x[c], hb)); lds_inc(bin_lo(x[c + 1], hb)); lds_inc(bin_hi(x[c + 1], hb)); }
    WAVE_LDS_ORDER();
    int Bsel, cA;
    {   const LAS unsigned char* hp = H + (63 - lane) * 64;
        const u32x4 h0 = *(const LAS u32x4*)hp, h1 = *(const LAS u32x4*)(hp + 16), h2 = *(const LAS u32x4*)(hp + 32), h3 = *(const LAS u32x4*)(hp + 48);
        const int sl = (int)(((h0.x + h0.y) + (h0.z + h0.w)) + ((h1.x + h1.y) + (h1.z + h1.w)) + ((h2.x + h2.y) + (h2.z + h2.w)) + ((h3.x + h3.y) + (h3.z + h3.w)));
        const int P = scan64_incl(sl, lane);
        const int Ls = __builtin_ctzll(__ballot(P >= TOPK));
        const int E = __builtin_amdgcn_readlane(P - sl, Ls);
        const int hj = (int)*(const LAS unsigned*)(H + ((63 - Ls) * 16 + 15 - (lane & 15)) * 4);
        const int Pj = scan16_incl(hj);
        const int jl = __builtin_ctzll(__ballot(E + Pj >= TOPK) & 0xFFFFull);
        Bsel = (63 - Ls) * 16 + 15 - jl; cA = E + __builtin_amdgcn_readlane(Pj - hj, jl);
    }
    {   const unsigned Bs2 = ((unsigned)Bsel << 6) * 0x00010001u; const unsigned dump = 64u + (unsigned)lane, hb2 = hb + 4096u;
#pragma unroll
        for (int c = 0; c < 32; c += 2) if (c < nc) {
#pragma unroll
            for (int i = 0; i < 2; ++i) { const unsigned y = x[c + i] ^ Bs2;
                const unsigned il = (unsigned)(unsigned short)__builtin_elementwise_min((unsigned short)y, (unsigned short)dump), ih = __builtin_elementwise_min(y >> 16, dump);
                lds_inc((il << 2) + hb2); lds_inc((ih << 2) + hb2); } }
    }
    WAVE_LDS_ORDER();
    unsigned T; int cT, need;
    {   const int c2 = (int)*(const LAS unsigned*)(H + 4096 + (63 - lane) * 4);
        const int P2 = scan64_incl(c2, lane);
        const int L2 = __builtin_ctzll(__ballot(cA + P2 >= TOPK));
        cT = cA + __builtin_amdgcn_readlane(P2, L2); need = TOPK - (cT - __builtin_amdgcn_readlane(c2, L2));
        T = ((unsigned)Bsel << 6) + (unsigned)(63 - L2);
    }
    unsigned mw0 = 0u, mw1 = 0u;
    const bool tie = (cT != TOPK);
    const unsigned Th = T << 16; const unsigned short Ts = (unsigned short)T; int run = 0;
#pragma unroll
    for (int c = 0; c < 32; c += 2) if (c < nc) {
        unsigned long long a0 = __ballot((unsigned short)x[c] >= Ts), a1 = __ballot(x[c] >= Th), a2 = __ballot((unsigned short)x[c + 1] >= Ts), a3 = __ballot(x[c + 1] >= Th);
        if (tie) {
            const unsigned long long e0 = __ballot((unsigned short)x[c] == Ts), e1 = __ballot((x[c] >> 16) == T), e2 = __ballot((unsigned short)x[c + 1] == Ts), e3 = __ballot((x[c + 1] >> 16) == T);
            tie_fix(a0, e0, run, need); tie_fix(a1, e1, run, need); tie_fix(a2, e2, run, need); tie_fix(a3, e3, run, need);
        }
        PUT4(mw0, mw1, a0, a1, a2, a3, 2 * c);
    }
    if (lane < 2 * nc) MASK[lane] = ((unsigned long long)mw1 << 32) | mw0;
}

typedef float f32x16 __attribute__((ext_vector_type(16)));
typedef short s16x4 __attribute__((ext_vector_type(4)));
__device__ __forceinline__ int crow(int r, int hi) { return (r & 3) + 8 * (r >> 2) + 4 * hi; }
__device__ __forceinline__ s16x4 vtr(const LAS unsigned char* p) { return __builtin_bit_cast(s16x4, __builtin_amdgcn_ds_read_tr16_b64_v4i16((LAS s16x4*)p)); }
constexpr size_t WS_OAB = 358 * MiB;
constexpr int AT_ROWB = 144, AT_TILE = 64 * AT_ROWB;
constexpr int AT_VROWB = 192, AT_VTILE = 64 * AT_VROWB;
constexpr float LOG2E = 1.4426950408889634f;
constexpr float ATHR = 8.f;
__device__ __forceinline__ int sext_bit(unsigned w, int c) { int r; asm("v_bfe_i32 %0, %1, %2, 1" : "=v"(r) : "v"(w), "n"(c)); return r; }
__device__ __forceinline__ void attn_s(const LAS unsigned char* Kb, const LAS float* BT, const bf16x8 (&qr)[4], unsigned long long mword, bool far, bool first, int dist0,
                                       int r32, int hh, f32x16& o0, f32x16& o1, f32x16& o2, f32x16& nmB, float& mref, u32x4 (&pk)[4]) {
    f32x16 p0, p1;
#pragma unroll
    for (int ks = 0; ks < 4; ++ks) {
        const bf16x8 k0 = *(const LAS bf16x8*)(Kb + r32 * AT_ROWB + 32 * ks + 16 * hh);
        const bf16x8 k1 = *(const LAS bf16x8*)(Kb + (32 + r32) * AT_ROWB + 32 * ks + 16 * hh);
        if (ks == 0) { p0 = __builtin_amdgcn_mfma_f32_32x32x16_bf16(k0, qr[0], nmB, 0, 0, 0); p1 = __builtin_amdgcn_mfma_f32_32x32x16_bf16(k1, qr[0], nmB, 0, 0, 0); }
        else { p0 = __builtin_amdgcn_mfma_f32_32x32x16_bf16(k0, qr[ks], p0, 0, 0, 0); p1 = __builtin_amdgcn_mfma_f32_32x32x16_bf16(k1, qr[ks], p1, 0, 0, 0); }
    }
    if (!far) {
        const LAS float* bp = BT + (96 - 27 - 32) + dist0;
#pragma unroll
        for (int i = 0; i < 16; ++i) { const int c = (i & 3) + 8 * (i >> 2); p0[i] += bp[32 + 27 - c]; p1[i] += bp[27 - c]; }
    }
    float m0 = __builtin_fmaxf(__builtin_fmaxf(p0[0], p0[1]), p0[2]), m1 = __builtin_fmaxf(__builtin_fmaxf(p1[0], p1[1]), p1[2]);
#pragma unroll
    for (int i = 3; i < 15; i += 2) { m0 = __builtin_fmaxf(__builtin_fmaxf(m0, p0[i]), p0[i + 1]); m1 = __builtin_fmaxf(__builtin_fmaxf(m1, p1[i]), p1[i + 1]); }
    float mx = __builtin_fmaxf(__builtin_fmaxf(m0, m1), __builtin_fmaxf(p0[15], p1[15]));
    { const auto rr = __builtin_amdgcn_permlane32_swap(__float_as_uint(mx), __float_as_uint(mx), false, false); mx = __builtin_fmaxf(__uint_as_float(rr[0]), __uint_as_float(rr[1])); }
    if (first || __any(mx > ATHR)) {
        const float dl = (first || mx > ATHR) ? mx : 0.f; mref += dl; const float f = __builtin_amdgcn_exp2f(-dl);
#pragma unroll
        for (int i = 0; i < 16; ++i) { p0[i] -= dl; p1[i] -= dl; nmB[i] -= dl; o0[i] *= f; o1[i] *= f; o2[i] *= f; }
    }
    const unsigned wl = (unsigned)mword >> (4 * hh), wh = (unsigned)(mword >> 32) >> (4 * hh);
#pragma unroll
    for (int i = 0; i < 16; ++i) { const int c = (i & 3) + 8 * (i >> 2);
        p0[i] = __uint_as_float(__float_as_uint(__builtin_amdgcn_exp2f(p0[i])) & (unsigned)sext_bit(wl, c));
        p1[i] = __uint_as_float(__float_as_uint(__builtin_amdgcn_exp2f(p1[i])) & (unsigned)sext_bit(wh, c)); }
#pragma unroll
    for (int s2 = 0; s2 < 2; ++s2) {
        pk[s2].x = cvtpk_s(p0[8 * s2], p0[8 * s2 + 1]); pk[s2].y = cvtpk_s(p0[8 * s2 + 2], p0[8 * s2 + 3]); pk[s2].z = cvtpk_s(p0[8 * s2 + 4], p0[8 * s2 + 5]); pk[s2].w = cvtpk_s(p0[8 * s2 + 6], p0[8 * s2 + 7]);
        pk[2 + s2].x = cvtpk_s(p1[8 * s2], p1[8 * s2 + 1]); pk[2 + s2].y = cvtpk_s(p1[8 * s2 + 2], p1[8 * s2 + 3]); pk[2 + s2].z = cvtpk_s(p1[8 * s2 + 4], p1[8 * s2 + 5]); pk[2 + s2].w = cvtpk_s(p1[8 * s2 + 6], p1[8 * s2 + 7]); }
}
__device__ __forceinline__ void attn_pv(const LAS unsigned char* Vb, const u32x4 (&pk)[4], int voff, f32x16& o0, f32x16& o1, f32x16& o2) {
    const u32x4 onesw = (u32x4){0x3F803F80u, 0x3F803F80u, 0x3F803F80u, 0x3F803F80u}; const bf16x8 ones = __builtin_bit_cast(bf16x8, onesw);
#pragma unroll
    for (int q = 0; q < 4; ++q) {
        const bf16x8 pf = __builtin_bit_cast(bf16x8, pk[q]);
        const LAS unsigned char* vp = Vb + (16 * q) * AT_VROWB + voff;
        const s16x4 a0l = vtr(vp), a0h = vtr(vp + 8 * AT_VROWB), a1l = vtr(vp + 64), a1h = vtr(vp + 8 * AT_VROWB + 64);
        const bf16x8 va0 = (bf16x8){a0l[0], a0l[1], a0l[2], a0l[3], a0h[0], a0h[1], a0h[2], a0h[3]};
        const bf16x8 va1 = (bf16x8){a1l[0], a1l[1], a1l[2], a1l[3], a1h[0], a1h[1], a1h[2], a1h[3]};
        o0 = __builtin_amdgcn_mfma_f32_32x32x16_bf16(va0, pf, o0, 0, 0, 0);
        o1 = __builtin_amdgcn_mfma_f32_32x32x16_bf16(va1, pf, o1, 0, 0, 0);
        o2 = __builtin_amdgcn_mfma_f32_32x32x16_bf16(ones, pf, o2, 0, 0, 0);
    }
}
constexpr int AT_KB = 0, AT_VB = 2 * AT_TILE, AT_BT3 = AT_VB + 3 * AT_VTILE;
template <bool GB> __device__ __forceinline__ void attn_unit(int b, int h, int Q, const float* rel_bias, unsigned char* ws, LAS unsigned char* lds) {
    const int tid = threadIdx.x, lane = tid & 63, wave = __builtin_amdgcn_readfirstlane(tid >> 6), r32 = lane & 31, hh = lane >> 5;
    const size_t rowbase = (size_t)b * NS; const int t0w = 256 * Q + 32 * wave, t = t0w + r32;
    const bf16_t* QKV = (const bf16_t*)(ws + WS_QKV);
    LAS float* BT = (LAS float*)(lds + AT_BT3);
    const int NTL = 4 * (Q + 1);
    const int lastw = (t0w + 31) >> 6;
    const int srow = tid >> 3, sch = tid & 7;
    const bf16_t* kg = QKV + (rowbase + srow) * 1536 + 512 + h * 64 + sch * 8; const bf16_t* vg = kg + 512;
    const int soff = srow * AT_ROWB + sch * 16, svoff = srow * AT_VROWB + sch * 16;
    const unsigned long long* MK = (const unsigned long long*)(ws + WS_MASK) + (rowbase + t) * 64;
    const size_t tstride = (size_t)64 * 1536;
    u32x4 k0r = *(const u32x4*)kg, v0r = *(const u32x4*)vg;
    u32x4 kA = *(const u32x4*)(kg + tstride), vA = *(const u32x4*)(vg + tstride);
    u32x4 kB = *(const u32x4*)(kg + 2 * tstride), vB = *(const u32x4*)(vg + 2 * tstride);
    unsigned long long me = MK[0], mo = MK[(1 <= lastw) ? 1 : 0];
    bf16x8 qr[4];
#pragma unroll
    for (int ks = 0; ks < 4; ++ks) qr[ks] = *(const bf16x8*)(QKV + (rowbase + t) * 1536 + h * 64 + 16 * ks + 8 * hh);
    const float cB = rel_bias[31 * A_HEADS + h] * LOG2E;
    __syncthreads();
    if (tid < 352) { const int d = tid - 96; BT[tid] = rel_bias[v0_bucket(d < 0 ? 0 : d) * A_HEADS + h] * LOG2E - cB; }
    *(LAS u32x4*)(lds + AT_KB + soff) = k0r; *(LAS u32x4*)(lds + AT_VB + svoff) = v0r;
    f32x16 o0, o1, o2, nmB;
#pragma unroll
    for (int i = 0; i < 16; ++i) { o0[i] = 0.f; o1[i] = 0.f; o2[i] = 0.f; nmB[i] = cB; }
    float mref = 0.f;
    const int q4 = (lane & 15) >> 2, p4 = lane & 3, blk = (lane >> 4) & 1;
    const int voff = (4 * hh + q4) * AT_VROWB + (16 * blk + 4 * p4) * 2;
    u32x4 pk[4];
#pragma unroll
    for (int q = 0; q < 4; ++q) pk[q] = (u32x4){0u, 0u, 0u, 0u};
    int vcur = 0, vnext = AT_VTILE, vprev = 2 * AT_VTILE;
    for (int kt = 0; kt < NTL; kt += 2) {
        __syncthreads();
        *(LAS u32x4*)(lds + AT_KB + AT_TILE + soff) = kA; *(LAS u32x4*)(lds + AT_VB + vnext + svoff) = vA;
        { const int tn = (kt + 3 < NTL) ? kt + 3 : NTL - 1; kA = *(const u32x4*)(kg + (size_t)tn * tstride); vA = *(const u32x4*)(vg + (size_t)tn * tstride); }
        if (GB) { if (kt >= 1 && kt - 1 <= lastw) attn_pv(lds + AT_VB + vprev, pk, voff, o0, o1, o2); }
        if (kt <= lastw) attn_s(lds + AT_KB, BT, qr, me, (t0w - (64 * kt + 63) >= 113), kt == 0, t - 64 * kt - 4 * hh, r32, hh, o0, o1, o2, nmB, mref, pk);
        if (!GB) { if (kt <= lastw) attn_pv(lds + AT_VB + vcur, pk, voff, o0, o1, o2); }
        me = MK[(kt + 2 <= lastw) ? kt + 2 : lastw];
        { const int tmp = vprev; vprev = vcur; vcur = vnext; vnext = tmp; }
        __syncthreads();
        *(LAS u32x4*)(lds + AT_KB + soff) = kB; *(LAS u32x4*)(lds + AT_VB + vnext + svoff) = vB;
        { const int tn = (kt + 4 < NTL) ? kt + 4 : NTL - 1; kB = *(const u32x4*)(kg + (size_t)tn * tstride); vB = *(const u32x4*)(vg + (size_t)tn * tstride); }
        if (GB) { if (kt <= lastw) attn_pv(lds + AT_VB + vprev, pk, voff, o0, o1, o2); }
        if (kt + 1 <= lastw) attn_s(lds + AT_KB + AT_TILE, BT, qr, mo, (t0w - (64 * (kt + 1) + 63) >= 113), false, t - 64 * (kt + 1) - 4 * hh, r32, hh, o0, o1, o2, nmB, mref, pk);
        if (!GB) { if (kt + 1 <= lastw) attn_pv(lds + AT_VB + vcur, pk, voff, o0, o1, o2); }
        mo = MK[(kt + 3 <= lastw) ? kt + 3 : lastw];
        { const int tmp = vprev; vprev = vcur; vcur = vnext; vnext = tmp; }
    }
    if (GB) {
        if (NTL - 1 <= lastw) attn_pv(lds + AT_VB + vprev, pk, voff, o0, o1, o2);
    }
    const float inv = 1.f / o2[0];
    bf16_t* O = (bf16_t*)(ws + WS_OAB) + (rowbase + t) * 1024 + h * 64 + 4 * hh;
#pragma unroll
    for (int g = 0; g < 4; ++g) {
        u32x2 w0, w1; w0.x = cvtpk_s(o0[4 * g] * inv, o0[4 * g + 1] * inv); w0.y = cvtpk_s(o0[4 * g + 2] * inv, o0[4 * g + 3] * inv);
        w1.x = cvtpk_s(o1[4 * g] * inv, o1[4 * g + 1] * inv); w1.y = cvtpk_s(o1[4 * g + 2] * inv, o1[4 * g + 3] * inv);
        *(u32x2*)(O + 8 * g) = w0; *(u32x2*)(O + 32 + 8 * g) = w1;
    }
}

constexpr int GL_LG = 0, GL_SEG = 16384, GL_A = 18432, GL_B = GL_A + 9216, GL_C = GL_B + 9216, GL_VT = GL_C + 9216, GL_ST = GL_VT + 18432;
constexpr int GROWB = 144;
constexpr int GLA_ITEMS = NB * G_HEADS * 64;
__device__ __forceinline__ void gla_cumdecay(const u32x4 g0, const u32x4 g1, int h, const float* wg, const float* bg, LAS unsigned char* lds, float* lgc) {
    const int tid = threadIdx.x; LAS float* LG = (LAS float*)(lds + GL_LG); LAS float* SEG = (LAS float*)(lds + GL_SEG);
    {   const int c = tid >> 3, dg = tid & 7; float gl[16];
#pragma unroll
        for (int j = 0; j < 4; ++j) { gl[2 * j] = __uint_as_float(g0[j] << 16); gl[2 * j + 1] = __uint_as_float(g0[j] & 0xffff0000u); gl[8 + 2 * j] = __uint_as_float(g1[j] << 16); gl[8 + 2 * j + 1] = __uint_as_float(g1[j] & 0xffff0000u); }
        float z[8];
#pragma unroll
        for (int j = 0; j < 8; ++j) z[j] = bg[h * 64 + 8 * dg + j];
#pragma unroll
        for (int r = 0; r < 16; ++r) { const f32x4 w0 = *(const f32x4*)(wg + r * G_KW + h * 64 + 8 * dg), w1 = *(const f32x4*)(wg + r * G_KW + h * 64 + 8 * dg + 4);
            z[0] += gl[r] * w0[0]; z[1] += gl[r] * w0[1]; z[2] += gl[r] * w0[2]; z[3] += gl[r] * w0[3]; z[4] += gl[r] * w1[0]; z[5] += gl[r] * w1[1]; z[6] += gl[r] * w1[2]; z[7] += gl[r] * w1[3]; }
#pragma unroll
        for (int j = 0; j < 8; ++j) z[j] = (fminf(z[j], 0.f) - log1pf(__expf(-fabsf(z[j])))) * (1.f / 16.f);
        *(LAS f32x4*)(LG + c * 64 + 8 * dg) = (f32x4){z[0], z[1], z[2], z[3]}; *(LAS f32x4*)(LG + c * 64 + 8 * dg + 4) = (f32x4){z[4], z[5], z[6], z[7]};
    }
    __syncthreads();
    const int seg = tid >> 6, d = tid & 63; float v[8];
#pragma unroll
    for (int i = 0; i < 8; ++i) v[i] = LG[(8 * seg + i) * 64 + d];
#pragma unroll
    for (int i = 1; i < 8; ++i) v[i] += v[i - 1];
    SEG[seg * 64 + d] = v[7];
    __syncthreads();
    float off = 0.f;
#pragma unroll
    for (int s2 = 0; s2 < 8; ++s2) if (s2 < seg) off += SEG[s2 * 64 + d];
#pragma unroll
    for (int i = 0; i < 8; ++i) { const float bv = v[i] + off; LG[(8 * seg + i) * 64 + d] = bv; lgc[(8 * seg + i) * 64 + d] = bv; }
    __syncthreads();
}
__device__ __forceinline__ unsigned short f2bf_s(float f) { return (unsigned short)(cvtpk_s(f, 0.f) & 0xffffu); }
__device__ __forceinline__ void gla_stage_vt(const u32x4 a, const u32x4 b2, LAS unsigned char* lds) {
    const int tid = threadIdx.x, c = tid >> 3, d0 = (tid & 7) * 16;
#pragma unroll
    for (int j = 0; j < 4; ++j) {
        *(LAS unsigned short*)(lds + GL_VT + (d0 + 2 * j) * GROWB + c * 2) = (unsigned short)(a[j] & 0xffffu); *(LAS unsigned short*)(lds + GL_VT + (d0 + 2 * j + 1) * GROWB + c * 2) = (unsigned short)(a[j] >> 16);
        *(LAS unsigned short*)(lds + GL_VT + (d0 + 8 + 2 * j) * GROWB + c * 2) = (unsigned short)(b2[j] & 0xffffu); *(LAS unsigned short*)(lds + GL_VT + (d0 + 8 + 2 * j + 1) * GROWB + c * 2) = (unsigned short)(b2[j] >> 16); }
}
__device__ __forceinline__ void p3b_item(int it, const float* wg, const float* bg, float* UT, float* LGC, unsigned char* ws, LAS unsigned char* lds) {
    const int tid = threadIdx.x, lane = tid & 63, wave = tid >> 6, fr = lane & 15, fq = lane >> 4;
    const int bh = it >> 6, n = it & 63, b = bh >> 2, h = bh & 3; const size_t r0 = (size_t)b * NS + 64 * n;
    const int c_ = tid >> 3, dg_ = tid & 7;
    const bf16_t* gp_ = (const bf16_t*)(ws + WS_GLR) + (r0 + c_) * 16; const u32x4 g0 = *(const u32x4*)gp_, g1 = *(const u32x4*)(gp_ + 8);
    const u32x4 kraw = *(const u32x4*)((const bf16_t*)(ws + WS_GQK) + (r0 + c_) * 512 + 256 + h * 64 + 8 * dg_);
    const bf16_t* vp_ = (const bf16_t*)(ws + WS_GV) + (r0 + c_) * 512 + h * 128 + dg_ * 16; const u32x4 va_ = *(const u32x4*)vp_, vb_ = *(const u32x4*)(vp_ + 8);
    __syncthreads();
    gla_cumdecay(g0, g1, h, wg, bg, lds, LGC + (size_t)it * 4096);
    const LAS float* LG = (const LAS float*)(lds + GL_LG);
    {   const int c = tid >> 3, dg = tid & 7; float kf[8]; bf8_to_f(kraw, kf);
#pragma unroll
        for (int j = 0; j < 8; ++j) { const int d = 8 * dg + j; *(LAS unsigned short*)(lds + GL_A + d * GROWB + c * 2) = f2bf_s(kf[j] * __expf(LG[63 * 64 + d] - LG[c * 64 + d])); }
        if (tid < 64) ((float*)(ws + WS_MISC))[(size_t)it * 64 + tid] = __expf(LG[63 * 64 + tid]);
    }
    gla_stage_vt(va_, vb_, lds);
    __syncthreads();
    f32x4 acc[4];
#pragma unroll
    for (int i = 0; i < 4; ++i) acc[i] = (f32x4){0.f, 0.f, 0.f, 0.f};
#pragma unroll
    for (int ks = 0; ks < 2; ++ks) { const bf16x8 bv = *(const LAS bf16x8*)(lds + GL_VT + (16 * wave + fr) * GROWB + (32 * ks + 8 * fq) * 2);
#pragma unroll
        for (int i = 0; i < 4; ++i) { const bf16x8 av = *(const LAS bf16x8*)(lds + GL_A + (16 * i + fr) * GROWB + (32 * ks + 8 * fq) * 2); acc[i] = __builtin_amdgcn_mfma_f32_16x16x32_bf16(av, bv, acc[i], 0, 0, 0); } }
#pragma unroll
    for (int i = 0; i < 4; ++i) *(f32x4*)(UT + ((size_t)it * 128 + 16 * wave + fr) * 64 + 16 * i + 4 * fq) = acc[i];
}
__device__ __forceinline__ void p4b_item(int j, const float* UT, bf16_t* SP, unsigned char* ws) {
    const int tid = threadIdx.x, bh = j >> 3, dv = (j & 7) * 16 + (tid >> 5), dk = (tid & 31) * 2; const float* DEC = (const float*)(ws + WS_MISC);
    typedef float f32x2v __attribute__((ext_vector_type(2)));
    f32x2v st = (f32x2v){0.f, 0.f};
#pragma unroll 8
    for (int n = 0; n < 64; ++n) { const size_t it = (size_t)bh * 64 + n; const size_t o = (it * 128 + dv) * 64 + dk;
        *(unsigned*)(SP + o) = cvtpk_s(st[0], st[1]);
        const f32x2v u = *(const f32x2v*)(UT + o), dc = *(const f32x2v*)(DEC + it * 64 + dk); st = dc * st + u; }
}
__device__ __forceinline__ void p4b_item4(int j, const float* UT, bf16_t* SP, unsigned char* ws) {
    const int tid = threadIdx.x, bh = j >> 3, dv0 = (j & 7) * 16 + (tid >> 5), dk = (tid & 31) * 2; const float* DEC = (const float*)(ws + WS_MISC);
    typedef float f32x2v __attribute__((ext_vector_type(2)));
    f32x2v st[4];
#pragma unroll
    for (int i = 0; i < 4; ++i) st[i] = (f32x2v){0.f, 0.f};
#pragma unroll 4
    for (int n = 0; n < 64; ++n) { const size_t it = (size_t)bh * 64 + n; const f32x2v dc = *(const f32x2v*)(DEC + it * 64 + dk);
#pragma unroll
        for (int i = 0; i < 4; ++i) { const size_t o = (it * 128 + dv0 + 4 * i) * 64 + dk;
            *(unsigned*)(SP + o) = cvtpk_s(st[i][0], st[i][1]);
            const f32x2v u = *(const f32x2v*)(UT + o); st[i] = dc * st[i] + u; } }
}
__device__ __forceinline__ void p5b_item(int it, const float* LGC, const float* ng, const bf16_t* SP, unsigned char* ws, LAS unsigned char* lds) {
    const int tid = threadIdx.x, lane = tid & 63, wave = tid >> 6, r32 = lane & 31, hh = lane >> 5;
    const int bh = it >> 6, n = it & 63, b = bh >> 2, h = bh & 3; const size_t r0 = (size_t)b * NS + 64 * n;
    const int c_ = tid >> 3, dg_ = tid & 7; const int dvb = wave >> 1, cb = wave & 1;
    const f32x4 lg0 = *(const f32x4*)(LGC + (size_t)it * 4096 + c_ * 64 + 8 * dg_), lg1 = *(const f32x4*)(LGC + (size_t)it * 4096 + c_ * 64 + 8 * dg_ + 4);
    const bf16_t* qp_ = (const bf16_t*)(ws + WS_GQK) + (r0 + c_) * 512 + h * 64 + 8 * dg_; const u32x4 qraw = *(const u32x4*)qp_, kraw = *(const u32x4*)(qp_ + 256);
    const bf16_t* vp_ = (const bf16_t*)(ws + WS_GV) + (r0 + c_) * 512 + h * 128 + dg_ * 16; const u32x4 va_ = *(const u32x4*)vp_, vb_ = *(const u32x4*)(vp_ + 8);
    bf16x8 spf[4];
#pragma unroll
    for (int ks = 0; ks < 4; ++ks) spf[ks] = *(const bf16x8*)(SP + ((size_t)it * 128 + 32 * dvb + r32) * 64 + 16 * ks + 8 * hh);
    const size_t trow = r0 + 32 * cb + r32; const int dvbase = h * 128 + 32 * dvb + 4 * hh;
    const bf16_t* grp = (const bf16_t*)(ws + WS_GR) + trow * 512 + dvbase; u32x2 grw[4];
#pragma unroll
    for (int g = 0; g < 4; ++g) grw[g] = *(const u32x2*)(grp + 8 * g);
    __syncthreads();
    { LAS float* LGw = (LAS float*)(lds + GL_LG); *(LAS f32x4*)(LGw + c_ * 64 + 8 * dg_) = lg0; *(LAS f32x4*)(LGw + c_ * 64 + 8 * dg_ + 4) = lg1; }
    __syncthreads();
    const LAS float* LG = (const LAS float*)(lds + GL_LG);
    {   const int c = tid >> 3, dg = tid & 7; float qf[8], kf[8]; bf8_to_f(qraw, qf); bf8_to_f(kraw, kf);
        float qr[8], ks[8], qi[8];
#pragma unroll
        for (int j = 0; j < 8; ++j) { const int d = 8 * dg + j; const float bc = LG[c * 64 + d], bl = LG[63 * 64 + d]; const float q8 = qf[j] * 0.125f;
            qr[j] = q8 * __expf(bc - bl); ks[j] = kf[j] * __expf(bl - bc); qi[j] = q8 * __expf(bc); }
        u32x4 w;
        w.x = cvtpk_s(qr[0], qr[1]); w.y = cvtpk_s(qr[2], qr[3]); w.z = cvtpk_s(qr[4], qr[5]); w.w = cvtpk_s(qr[6], qr[7]); *(LAS u32x4*)(lds + GL_A + c * GROWB + 16 * dg) = w;
        w.x = cvtpk_s(ks[0], ks[1]); w.y = cvtpk_s(ks[2], ks[3]); w.z = cvtpk_s(ks[4], ks[5]); w.w = cvtpk_s(ks[6], ks[7]); *(LAS u32x4*)(lds + GL_B + c * GROWB + 16 * dg) = w;
        w.x = cvtpk_s(qi[0], qi[1]); w.y = cvtpk_s(qi[2], qi[3]); w.z = cvtpk_s(qi[4], qi[5]); w.w = cvtpk_s(qi[6], qi[7]); *(LAS u32x4*)(lds + GL_C + c * GROWB + 16 * dg) = w;
    }
    gla_stage_vt(va_, vb_, lds);
    __syncthreads();
    f32x16 o;
#pragma unroll
    for (int i = 0; i < 16; ++i) o[i] = 0.f;
#pragma unroll
    for (int jb = 0; jb < 2; ++jb) if (jb <= cb) {
        f32x16 at;
#pragma unroll
        for (int i = 0; i < 16; ++i) at[i] = 0.f;
#pragma unroll
        for (int ks = 0; ks < 4; ++ks) { const bf16x8 av = *(const LAS bf16x8*)(lds + GL_B + (32 * jb + r32) * GROWB + 32 * ks + 16 * hh), bv = *(const LAS bf16x8*)(lds + GL_A + (32 * cb + r32) * GROWB + 32 * ks + 16 * hh);
            at = __builtin_amdgcn_mfma_f32_32x32x16_bf16(av, bv, at, 0, 0, 0); }
        if (jb == cb) {
#pragma unroll
            for (int i = 0; i < 16; ++i) if (crow(i, hh) > r32) at[i] = 0.f; }
#pragma unroll
        for (int s = 0; s < 2; ++s) {
            u32x4 pw; pw.x = cvtpk_s(at[8 * s], at[8 * s + 1]); pw.y = cvtpk_s(at[8 * s + 2], at[8 * s + 3]); pw.z = cvtpk_s(at[8 * s + 4], at[8 * s + 5]); pw.w = cvtpk_s(at[8 * s + 6], at[8 * s + 7]);
            const LAS unsigned char* vp = lds + GL_VT + (32 * dvb + r32) * GROWB + (32 * jb + 16 * s + 4 * hh) * 2;
            const u32x2 lo = *(const LAS u32x2*)vp, hi = *(const LAS u32x2*)(vp + 16);
            const u32x4 va = (u32x4){lo.x, lo.y, hi.x, hi.y};
            o = __builtin_amdgcn_mfma_f32_32x32x16_bf16(__builtin_bit_cast(bf16x8, va), __builtin_bit_cast(bf16x8, pw), o, 0, 0, 0);
        }
    }
#pragma unroll
    for (int ks = 0; ks < 4; ++ks) { const bf16x8 bv = *(const LAS bf16x8*)(lds + GL_C + (32 * cb + r32) * GROWB + 32 * ks + 16 * hh);
        o = __builtin_amdgcn_mfma_f32_32x32x16_bf16(spf[ks], bv, o, 0, 0, 0); }
    LAS float* ST = (LAS float*)(lds + GL_ST);
    float sm = 0.f;
#pragma unroll
    for (int i = 0; i < 16; ++i) sm += o[i];
    sm += __shfl_xor(sm, 32);
    if (hh == 0) ST[dvb * 64 + 32 * cb + r32] = sm;
    __syncthreads();
    const float mean = (ST[32 * cb + r32] + ST[64 + 32 * cb + r32] + ST[128 + 32 * cb + r32] + ST[192 + 32 * cb + r32]) * (1.f / 128.f);
    float sq = 0.f;
#pragma unroll
    for (int i = 0; i < 16; ++i) { o[i] -= mean; sq += o[i] * o[i]; }
    sq += __shfl_xor(sq, 32);
    if (hh == 0) ST[256 + dvb * 64 + 32 * cb + r32] = sq;
    __syncthreads();
    const float var = (ST[256 + 32 * cb + r32] + ST[256 + 64 + 32 * cb + r32] + ST[256 + 128 + 32 * cb + r32] + ST[256 + 192 + 32 * cb + r32]) * (1.f / 128.f);
    const float rstd = 1.f / sqrtf(var + LN_EPS);
    bf16_t* op = (bf16_t*)(ws + WS_OAB) + trow * 1024 + 512 + dvbase;
#pragma unroll
    for (int g = 0; g < 4; ++g) { const u32x2 gw = grw[g]; const f32x4 nv = *(const f32x4*)(ng + dvbase + 8 * g);
        float gr[4] = {__uint_as_float(gw.x << 16), __uint_as_float(gw.x & 0xffff0000u), __uint_as_float(gw.y << 16), __uint_as_float(gw.y & 0xffff0000u)}; float y[4];
#pragma unroll
        for (int e = 0; e < 4; ++e) y[e] = o[4 * g + e] * rstd * nv[e] * (gr[e] * __builtin_amdgcn_rcpf(1.f + __expf(-gr[e])));
        u32x2 w; w.x = cvtpk_s(y[0], y[1]); w.y = cvtpk_s(y[2], y[3]); *(u32x2*)(op + 8 * g) = w; }
}

constexpr int GL_HALF = 67584;
__device__ __forceinline__ void gla_cumdecay2(size_t r0, int h, const bf16_t* WGT, const float* bg, unsigned char* ws, LAS unsigned char* ldh, float* lgc) {
    const int tl = threadIdx.x & 255, lane = threadIdx.x & 63, wl = (threadIdx.x >> 6) & 3, r32 = lane & 31, hh = lane >> 5; LAS float* LG = (LAS float*)(ldh + GL_LG); LAS float* SEG = (LAS float*)(ldh + GL_SEG);
    {   const int cb = wl >> 1, db = wl & 1;
        const bf16x8 af = *(const bf16x8*)((const bf16_t*)(ws + WS_GLR) + (r0 + 32 * cb + r32) * 16 + 8 * hh), bfr = *(const bf16x8*)(WGT + (size_t)(h * 64 + 32 * db + r32) * 16 + 8 * hh);
        const float bias = bg[h * 64 + 32 * db + r32]; f32x16 z;
#pragma unroll
        for (int i = 0; i < 16; ++i) z[i] = bias;
        z = __builtin_amdgcn_mfma_f32_32x32x16_bf16(af, bfr, z, 0, 0, 0);
#pragma unroll
        for (int i = 0; i < 16; ++i) { const float zz = z[i]; LG[(32 * cb + crow(i, hh)) * 64 + 32 * db + r32] = (fminf(zz, 0.f) - __logf(1.f + __expf(-fabsf(zz)))) * (1.f / 16.f); }
    }
    __syncthreads();
    const int seg = tl >> 6, d = tl & 63; float v[16];
#pragma unroll
    for (int i = 0; i < 16; ++i) v[i] = LG[(16 * seg + i) * 64 + d];
#pragma unroll
    for (int i = 1; i < 16; ++i) v[i] += v[i - 1];
    SEG[seg * 64 + d] = v[15];
    __syncthreads();
    float off = 0.f;
#pragma unroll
    for (int s2 = 0; s2 < 4; ++s2) if (s2 < seg) off += SEG[s2 * 64 + d];
#pragma unroll
    for (int i = 0; i < 16; ++i) { const float bv = v[i] + off; LG[(16 * seg + i) * 64 + d] = bv; lgc[(16 * seg + i) * 64 + d] = bv; }
    __syncthreads();
}
__device__ __forceinline__ void gla_stage_vt2(const u32x4 (&vv)[4], LAS unsigned char* ldh) {
    const int tl = threadIdx.x & 255, c = tl >> 2, d0 = (tl & 3) * 32;
#pragma unroll
    for (int k = 0; k < 4; ++k)
#pragma unroll
        for (int j = 0; j < 4; ++j) {
            *(LAS unsigned short*)(ldh + GL_VT + (d0 + 8 * k + 2 * j) * GROWB + c * 2) = (unsigned short)(vv[k][j] & 0xffffu);
            *(LAS unsigned short*)(ldh + GL_VT + (d0 + 8 * k + 2 * j + 1) * GROWB + c * 2) = (unsigned short)(vv[k][j] >> 16); }
}
__device__ __forceinline__ void p3b_pair(int p, const float* wg, const float* bg, float* UT, float* LGC, unsigned char* ws, LAS unsigned char* lds) {
    const int tid = threadIdx.x, hb = tid >> 8, tl = tid & 255, lane = tid & 63, wl = (tid >> 6) & 3, fr = lane & 15, fq = lane >> 4;
    const int it = 2 * p + hb; LAS unsigned char* ldh = lds + hb * GL_HALF;
    const int bh = it >> 6, n = it & 63, b = bh >> 2, h = bh & 3; const size_t r0 = (size_t)b * NS + 64 * n;
    const int c_ = tl >> 2, dq_ = tl & 3;
    const bf16_t* kp_ = (const bf16_t*)(ws + WS_GQK) + (r0 + c_) * 512 + 256 + h * 64 + 16 * dq_; const u32x4 k0 = *(const u32x4*)kp_, k1 = *(const u32x4*)(kp_ + 8);
    const bf16_t* vp_ = (const bf16_t*)(ws + WS_GV) + (r0 + c_) * 512 + h * 128 + 32 * dq_; u32x4 vv[4];
#pragma unroll
    for (int k = 0; k < 4; ++k) vv[k] = *(const u32x4*)(vp_ + 8 * k);
    __syncthreads();
    gla_cumdecay2(r0, h, (const bf16_t*)(ws + WS_WGT), bg, ws, ldh, LGC + (size_t)it * 4096);
    const LAS float* LG = (const LAS float*)(ldh + GL_LG);
    {   float kf[16]; bf8_to_f(k0, kf); bf8_to_f(k1, kf + 8);
#pragma unroll
        for (int j = 0; j < 16; ++j) { const int d = 16 * dq_ + j; *(LAS unsigned short*)(ldh + GL_A + d * GROWB + c_ * 2) = f2bf_s(kf[j] * __expf(LG[63 * 64 + d] - LG[c_ * 64 + d])); }
        if (tl < 64) ((float*)(ws + WS_MISC))[(size_t)it * 64 + tl] = __expf(LG[63 * 64 + tl]);
    }
    gla_stage_vt2(vv, ldh);
    __syncthreads();
#pragma unroll
    for (int dvi = 0; dvi < 2; ++dvi) {
        const int dvblk = 2 * wl + dvi;
        f32x4 acc[4];
#pragma unroll
        for (int i = 0; i < 4; ++i) acc[i] = (f32x4){0.f, 0.f, 0.f, 0.f};
#pragma unroll
        for (int ks = 0; ks < 2; ++ks) { const bf16x8 bv = *(const LAS bf16x8*)(ldh + GL_VT + (16 * dvblk + fr) * GROWB + (32 * ks + 8 * fq) * 2);
#pragma unroll
            for (int i = 0; i < 4; ++i) { const bf16x8 av = *(const LAS bf16x8*)(ldh + GL_A + (16 * i + fr) * GROWB + (32 * ks + 8 * fq) * 2); acc[i] = __builtin_amdgcn_mfma_f32_16x16x32_bf16(av, bv, acc[i], 0, 0, 0); } }
#pragma unroll
        for (int i = 0; i < 4; ++i) *(f32x4*)(UT + ((size_t)it * 128 + 16 * dvblk + fr) * 64 + 16 * i + 4 * fq) = acc[i];
    }
}
__device__ __forceinline__ void p5b_pair(int p, const float* LGC, const float* ng, const bf16_t* SP, unsigned char* ws, LAS unsigned char* lds) {
    const int tid = threadIdx.x, hb = tid >> 8, tl = tid & 255, lane = tid & 63, wl = (tid >> 6) & 3, r32 = lane & 31, hh = lane >> 5;
    const int it = 2 * p + hb; LAS unsigned char* ldh = lds + hb * GL_HALF;
    const int bh = it >> 6, n = it & 63, b = bh >> 2, h = bh & 3; const size_t r0 = (size_t)b * NS + 64 * n;
    const int c_ = tl >> 2, dq_ = tl & 3; const int dvb = wl;
    f32x4 lg[4];
#pragma unroll
    for (int k = 0; k < 4; ++k) lg[k] = *(const f32x4*)(LGC + (size_t)it * 4096 + c_ * 64 + 16 * dq_ + 4 * k);
    const bf16_t* qp_ = (const bf16_t*)(ws + WS_GQK) + (r0 + c_) * 512 + h * 64 + 16 * dq_; const u32x4 q0 = *(const u32x4*)qp_, q1 = *(const u32x4*)(qp_ + 8), k0 = *(const u32x4*)(qp_ + 256), k1 = *(const u32x4*)(qp_ + 264);
    const bf16_t* vp_ = (const bf16_t*)(ws + WS_GV) + (r0 + c_) * 512 + h * 128 + 32 * dq_; u32x4 vv[4];
#pragma unroll
    for (int k = 0; k < 4; ++k) vv[k] = *(const u32x4*)(vp_ + 8 * k);
    bf16x8 spf[4];
#pragma unroll
    for (int ks = 0; ks < 4; ++ks) spf[ks] = *(const bf16x8*)(SP + ((size_t)it * 128 + 32 * dvb + r32) * 64 + 16 * ks + 8 * hh);
    const int dvbase = h * 128 + 32 * dvb + 4 * hh; u32x2 grw[2][4];
#pragma unroll
    for (int cb = 0; cb < 2; ++cb)
#pragma unroll
        for (int g = 0; g < 4; ++g) grw[cb][g] = *(const u32x2*)((const bf16_t*)(ws + WS_GR) + (r0 + 32 * cb + r32) * 512 + dvbase + 8 * g);
    __syncthreads();
    { LAS float* LGw = (LAS float*)(ldh + GL_LG);
#pragma unroll
      for (int k = 0; k < 4; ++k) *(LAS f32x4*)(LGw + c_ * 64 + 16 * dq_ + 4 * k) = lg[k]; }
    __syncthreads();
    const LAS float* LG = (const LAS float*)(ldh + GL_LG);
    {   float qf[16], kf[16]; bf8_to_f(q0, qf); bf8_to_f(q1, qf + 8); bf8_to_f(k0, kf); bf8_to_f(k1, kf + 8);
        float qr[16], ks[16], qi[16];
#pragma unroll
        for (int j = 0; j < 16; ++j) { const int d = 16 * dq_ + j; const float bc = LG[c_ * 64 + d], bl = LG[63 * 64 + d]; const float q8 = qf[j] * 0.125f;
            qr[j] = q8 * __expf(bc - bl); ks[j] = kf[j] * __expf(bl - bc); qi[j] = q8 * __expf(bc); }
#pragma unroll
        for (int k = 0; k < 2; ++k) { u32x4 w;
            w.x = cvtpk_s(qr[8 * k], qr[8 * k + 1]); w.y = cvtpk_s(qr[8 * k + 2], qr[8 * k + 3]); w.z = cvtpk_s(qr[8 * k + 4], qr[8 * k + 5]); w.w = cvtpk_s(qr[8 * k + 6], qr[8 * k + 7]); *(LAS u32x4*)(ldh + GL_A + c_ * GROWB + 32 * dq_ + 16 * k) = w;
            w.x = cvtpk_s(ks[8 * k], ks[8 * k + 1]); w.y = cvtpk_s(ks[8 * k + 2], ks[8 * k + 3]); w.z = cvtpk_s(ks[8 * k + 4], ks[8 * k + 5]); w.w = cvtpk_s(ks[8 * k + 6], ks[8 * k + 7]); *(LAS u32x4*)(ldh + GL_B + c_ * GROWB + 32 * dq_ + 16 * k) = w;
            w.x = cvtpk_s(qi[8 * k], qi[8 * k + 1]); w.y = cvtpk_s(qi[8 * k + 2], qi[8 * k + 3]); w.z = cvtpk_s(qi[8 * k + 4], qi[8 * k + 5]); w.w = cvtpk_s(qi[8 * k + 6], qi[8 * k + 7]); *(LAS u32x4*)(ldh + GL_C + c_ * GROWB + 32 * dq_ + 16 * k) = w; }
    }
    gla_stage_vt2(vv, ldh);
    __syncthreads();
    f32x16 o[2];
#pragma unroll
    for (int cb = 0; cb < 2; ++cb) {
#pragma unroll
        for (int i = 0; i < 16; ++i) o[cb][i] = 0.f;
#pragma unroll
        for (int jb = 0; jb < 2; ++jb) if (jb <= cb) {
            f32x16 at;
#pragma unroll
            for (int i = 0; i < 16; ++i) at[i] = 0.f;
#pragma unroll
            for (int ks = 0; ks < 4; ++ks) { const bf16x8 av = *(const LAS bf16x8*)(ldh + GL_B + (32 * jb + r32) * GROWB + 32 * ks + 16 * hh), bv = *(const LAS bf16x8*)(ldh + GL_A + (32 * cb + r32) * GROWB + 32 * ks + 16 * hh);
                at = __builtin_amdgcn_mfma_f32_32x32x16_bf16(av, bv, at, 0, 0, 0); }
            if (jb == cb) {
#pragma unroll
                for (int i = 0; i < 16; ++i) if (crow(i, hh) > r32) at[i] = 0.f; }
#pragma unroll
            for (int s2 = 0; s2 < 2; ++s2) {
                u32x4 pw; pw.x = cvtpk_s(at[8 * s2], at[8 * s2 + 1]); pw.y = cvtpk_s(at[8 * s2 + 2], at[8 * s2 + 3]); pw.z = cvtpk_s(at[8 * s2 + 4], at[8 * s2 + 5]); pw.w = cvtpk_s(at[8 * s2 + 6], at[8 * s2 + 7]);
                const LAS unsigned char* vp = ldh + GL_VT + (32 * dvb + r32) * GROWB + (32 * jb + 16 * s2 + 4 * hh) * 2;
                const u32x2 lo = *(const LAS u32x2*)vp, hi = *(const LAS u32x2*)(vp + 16);
                const u32x4 va = (u32x4){lo.x, lo.y, hi.x, hi.y};
                o[cb] = __builtin_amdgcn_mfma_f32_32x32x16_bf16(__builtin_bit_cast(bf16x8, va), __builtin_bit_cast(bf16x8, pw), o[cb], 0, 0, 0);
            }
        }
#pragma unroll
        for (int ks = 0; ks < 4; ++ks) { const bf16x8 bv = *(const LAS bf16x8*)(ldh + GL_C + (32 * cb + r32) * GROWB + 32 * ks + 16 * hh);
            o[cb] = __builtin_amdgcn_mfma_f32_32x32x16_bf16(spf[ks], bv, o[cb], 0, 0, 0); }
    }
    LAS float* ST = (LAS float*)(ldh + GL_ST);
#pragma unroll
    for (int cb = 0; cb < 2; ++cb) { float sm = 0.f;
#pragma unroll
        for (int i = 0; i < 16; ++i) sm += o[cb][i];
        sm += __shfl_xor(sm, 32);
        if (hh == 0) ST[dvb * 64 + 32 * cb + r32] = sm; }
    __syncthreads();
    float mean[2];
#pragma unroll
    for (int cb = 0; cb < 2; ++cb) { const int cc = 32 * cb + r32; mean[cb] = (ST[cc] + ST[64 + cc] + ST[128 + cc] + ST[192 + cc]) * (1.f / 128.f); float sq = 0.f;
#pragma unroll
        for (int i = 0; i < 16; ++i) { o[cb][i] -= mean[cb]; sq += o[cb][i] * o[cb][i]; }
        sq += __shfl_xor(sq, 32);
        if (hh == 0) ST[256 + dvb * 64 + cc] = sq; }
    __syncthreads();
#pragma unroll
    for (int cb = 0; cb < 2; ++cb) { const int cc = 32 * cb + r32; const float var = (ST[256 + cc] + ST[256 + 64 + cc] + ST[256 + 128 + cc] + ST[256 + 192 + cc]) * (1.f / 128.f);
        const float rstd = 1.f / sqrtf(var + LN_EPS);
        bf16_t* op = (bf16_t*)(ws + WS_OAB) + (r0 + cc) * 1024 + 512 + dvbase;
#pragma unroll
        for (int g = 0; g < 4; ++g) { const u32x2 gw = grw[cb][g]; const f32x4 nv = *(const f32x4*)(ng + dvbase + 8 * g);
            float gr[4] = {__uint_as_float(gw.x << 16), __uint_as_float(gw.x & 0xffff0000u), __uint_as_float(gw.y << 16), __uint_as_float(gw.y & 0xffff0000u)}; float y[4];
#pragma unroll
            for (int e = 0; e < 4; ++e) y[e] = o[cb][4 * g + e] * rstd * nv[e] * (gr[e] * __builtin_amdgcn_rcpf(1.f + __expf(-gr[e])));
            u32x2 w; w.x = cvtpk_s(y[0], y[1]); w.y = cvtpk_s(y[2], y[3]); *(u32x2*)(op + 8 * g) = w; } }
}

constexpr size_t WS_SG = 129 * MiB;
constexpr size_t WS_MRG = 257 * MiB;
constexpr size_t WS_H2 = WS_XN;
constexpr size_t WS_XG = 129 * MiB;
constexpr size_t WS_HID = 321 * MiB;
constexpr size_t WS_YG = 358 * MiB;
constexpr size_t WS_EID = WS_MISC + 1 * MiB, WS_EW = WS_EID + 256 * 1024, WS_POS = WS_EW + 256 * 1024, WS_ST1 = WS_POS + 256 * 1024;
constexpr size_t WS_LIST = 490 * MiB;
constexpr int LDS_TAB = 131072;
__device__ __forceinline__ u32x4 pack8(const f32x4 a, const f32x4 b) { u32x4 w; w.x = cvtpk_s(a[0], a[1]); w.y = cvtpk_s(a[2], a[3]); w.z = cvtpk_s(b[0], b[1]); w.w = cvtpk_s(b[2], b[3]); return w; }
__device__ __forceinline__ f32x4 sig4(const f32x4 v) { f32x4 r; r[0] = __builtin_amdgcn_rcpf(1.f + __expf(-v[0])); r[1] = __builtin_amdgcn_rcpf(1.f + __expf(-v[1])); r[2] = __builtin_amdgcn_rcpf(1.f + __expf(-v[2])); r[3] = __builtin_amdgcn_rcpf(1.f + __expf(-v[3])); return r; }
__device__ __forceinline__ void unpack8(const u32x4 w, f32x4& a, f32x4& b) {
    a[0] = __uint_as_float(w.x << 16); a[1] = __uint_as_float(w.x & 0xffff0000u); a[2] = __uint_as_float(w.y << 16); a[3] = __uint_as_float(w.y & 0xffff0000u);
    b[0] = __uint_as_float(w.z << 16); b[1] = __uint_as_float(w.z & 0xffff0000u); b[2] = __uint_as_float(w.w << 16); b[3] = __uint_as_float(w.w & 0xffff0000u);
}
#define EPI_ROWS(...) _Pragma("unroll") for (int ai = 0; ai < 2; ++ai) _Pragma("unroll") for (int m = 0; m < 4; ++m) { const size_t row = (size_t)(row0 + ai * 128 + m * 16); _Pragma("unroll") for (int bj = 0; bj < 2; ++bj) { __VA_ARGS__ } }
struct EpiSig {
    static constexpr bool PERM = true, AFTER_DRAIN = false, MID = false; unsigned char* ws; int half;
    __device__ __forceinline__ void operator()(const f32x4 (&acc)[2][2][4][2], const Unit& u, int wr, int wc, int fr, int fq) const {
        const int row0 = u.pm * 256 + wr * 64 + fr, col0 = half * 1024 + u.pn * 256 + wc * 32 + 8 * fq; bf16_t* SG = (bf16_t*)(ws + WS_SG);
        EPI_ROWS( *(u32x4*)(SG + row * 2048 + col0 + bj * 128) = pack8(sig4(acc[ai][bj][m][0]), sig4(acc[ai][bj][m][1])); )
    }
};
struct EpiMrgF {
    static constexpr bool PERM = true, AFTER_DRAIN = false, MID = true; unsigned char* ws;
    __device__ __forceinline__ void mid(f32x4 (&acc)[2][2][4][2], const Unit& u, int wr, int wc, int fr, int fq) const {
        const int row0 = u.pm * 256 + wr * 64 + fr, col0 = u.pn * 256 + wc * 32 + 8 * fq; const bf16_t* SG = (const bf16_t*)(ws + WS_SG);
        const bf16_t* p = SG + (size_t)row0 * 2048 + col0;
#pragma unroll
        for (int ai = 0; ai < 2; ++ai)
#pragma unroll
            for (int m = 0; m < 4; ++m) {
                asm volatile("" : "+v"(p));
#pragma unroll
                for (int bj = 0; bj < 2; ++bj) { f32x4 a0, a1, b0, b1; unpack8(*(const u32x4*)(p + bj * 128), a0, a1); unpack8(*(const u32x4*)(p + 1024 + bj * 128), b0, b1);
#pragma unroll
                    for (int e = 0; e < 4; ++e) { acc[ai][bj][m][0][e] *= a0[e] * __builtin_amdgcn_rcpf(fmaxf(b0[e], 1e-30f)); acc[ai][bj][m][1][e] *= a1[e] * __builtin_amdgcn_rcpf(fmaxf(b1[e], 1e-30f)); } }
                p += (m == 3 ? (128 - 48) : 16) * 2048; }
    }
    __device__ __forceinline__ void operator()(const f32x4 (&acc)[2][2][4][2], const Unit& u, int wr, int wc, int fr, int fq) const {
        const int row0 = u.pm * 256 + wr * 64 + fr, col0 = u.pn * 256 + wc * 32 + 8 * fq; const bf16_t* SG = (const bf16_t*)(ws + WS_SG) + 1024; bf16_t* MR = (bf16_t*)(ws + WS_MRG);
        EPI_ROWS( f32x4 g0, g1; unpack8(*(const u32x4*)(SG + row * 2048 + col0 + bj * 128), g0, g1); *(u32x4*)(MR + row * 1024 + col0 + bj * 128) = pack8(g0 * acc[ai][bj][m][0], g1 * acc[ai][bj][m][1]); )
    }
};
struct EpiV {
    static constexpr bool PERM = false, AFTER_DRAIN = false, MID = false; const float* x; const float* ada; float* out;
    __device__ __forceinline__ void operator()(const f32x4 (&acc)[2][2][4][2], const Unit& u, int wr, int wc, int fr, int fq) const {
        const int row0 = u.pm * 256 + wr * 64 + fr, col0 = u.pn * 256 + wc * 32 + 4 * fq; const float* gt1 = ada + (size_t)(u.pm >> 4) * 6 * D_MODEL + 2 * D_MODEL;
        EPI_ROWS( _Pragma("unroll") for (int n = 0; n < 2; ++n) { const int c = col0 + bj * 128 + n * 16; const f32x4 xv = *(const f32x4*)(x + row * D_MODEL + c), gv = *(const f32x4*)(gt1 + c);
                  *(f32x4*)(out + row * D_MODEL + c) = xv * DN_ALPHA + gv * acc[ai][bj][m][n]; } )
    }
};
struct EpiHid {
    static constexpr bool PERM = true, AFTER_DRAIN = false, MID = false; unsigned char* ws;
    __device__ __forceinline__ void operator()(const f32x4 (&acc)[2][2][4][2], const Unit& u, int wr, int wc, int fr, int fq) const {
        const int row0 = u.pm * 256 + wr * 64 + fr, col0 = u.pn * 128 + wc * 32 + 8 * fq; bf16_t* H = (bf16_t*)(ws + WS_HID);
#pragma unroll
        for (int ai = 0; ai < 2; ++ai)
#pragma unroll
            for (int m = 0; m < 4; ++m) { const size_t row = (size_t)(row0 + ai * 128 + m * 16); f32x4 h0, h1;
#pragma unroll
                for (int e = 0; e < 4; ++e) { const float g0 = acc[ai][0][m][0][e], g1 = acc[ai][0][m][1][e]; h0[e] = g0 * __builtin_amdgcn_rcpf(1.f + __expf(-g0)) * acc[ai][1][m][0][e]; h1[e] = g1 * __builtin_amdgcn_rcpf(1.f + __expf(-g1)) * acc[ai][1][m][1][e]; }
                *(u32x4*)(H + row * 256 + col0) = pack8(h0, h1); }
    }
};
struct EpiY {
    static constexpr bool PERM = true, AFTER_DRAIN = false, MID = false; unsigned char* ws;
    __device__ __forceinline__ void operator()(const f32x4 (&acc)[2][2][4][2], const Unit& u, int wr, int wc, int fr, int fq) const {
        const int row0 = u.pm * 256 + wr * 64 + fr, col0 = u.pn * 256 + wc * 32 + 8 * fq; bf16_t* Y = (bf16_t*)(ws + WS_YG);
        EPI_ROWS( *(u32x4*)(Y + row * 1024 + col0 + bj * 128) = pack8(acc[ai][bj][m][0], acc[ai][bj][m][1]); )
    }
};
__device__ __forceinline__ void build_tables(unsigned char* ws, LAS unsigned char* lds) {
    LAS int* toff = (LAS int*)(lds + LDS_TAB); LAS int* texp = toff + 64; const unsigned* gcnt = (const unsigned*)(ws + WS_CNT);
    __syncthreads();
    if (threadIdx.x == 0) { int o = 0; for (int e = 0; e < N_EXP; ++e) { toff[e] = o; const int ce = (int)gcnt[e * 32]; toff[400 + e] = ce; o += (ce + 255) >> 8; } toff[32] = o; }
    __syncthreads();
    for (int tl = threadIdx.x; tl < toff[32]; tl += NTHREADS) { int e = 0; while (toff[e + 1] <= tl) ++e; texp[tl] = e; }
    __syncthreads();
}
template <int NPN> struct GroupOrder {
    const LAS int* toff; const LAS int* texp; int G, c;
    __device__ __forceinline__ bool next(int i, Unit& u) const { const int L = i * G + c; if (L >= toff[32] * NPN) return false; const int tl = L / NPN, pn = L % NPN; u.pm = tl; u.pa = tl; u.pn = pn; u.pb = texp[tl] * NPN + pn; return true; }
    __device__ __forceinline__ void a_ready(const Unit&) const {}
    __device__ __forceinline__ void done(const Unit&) const {}
    const int* list;
    __device__ __forceinline__ int a_row(const Unit& u, int r) const { const int e = texp[u.pa]; const int idx = (u.pa - toff[e]) * 256 + r; return idx < toff[400 + e] ? list[e * 32768 + idx] : 0; }
};
constexpr int WT_LD = 1028;
constexpr int P8_LCNT = 36 * WT_LD * 4;
__device__ __forceinline__ float dot16(const f32x4 (&v)[4], const LAS float* wp, int lane) {
    float p = 0.f;
#pragma unroll
    for (int j = 0; j < 4; ++j) { const f32x4 w4 = *(const LAS f32x4*)(wp + 256 * j + 4 * lane); p += (v[j].x * w4.x + v[j].y * w4.y) + (v[j].z * w4.z + v[j].w * w4.w); }
    return p;
}
__device__ __forceinline__ float rl4sum(float v) {
    return (__int_as_float(__builtin_amdgcn_readlane(__float_as_int(v), 0)) + __int_as_float(__builtin_amdgcn_readlane(__float_as_int(v), 16)))
         + (__int_as_float(__builtin_amdgcn_readlane(__float_as_int(v), 32)) + __int_as_float(__builtin_amdgcn_readlane(__float_as_int(v), 48)));
}
template <bool REAL> __device__ __forceinline__ void p8_phase(const float* const* in, float* out, float* x1dst, bf16_t* h2dst, unsigned char* ws, LAS unsigned char* lds, int G) {
    const int tid = threadIdx.x, lane = tid & 63, wave = tid >> 6;
    LAS float* WT = (LAS float*)lds;
    LAS int* lcnt = (LAS int*)(lds + P8_LCNT); LAS int* lbase = lcnt + 32; LAS int* ent = lcnt + 64;
    const float* wrg = in[14]; const float* wre = in[16];
    __syncthreads();
    for (int i = tid; i < 1024; i += NTHREADS) { const f32x4 w = *(const f32x4*)(wrg + 4 * i); WT[0 * WT_LD + i] = w.x; WT[1 * WT_LD + i] = w.y; WT[2 * WT_LD + i] = w.z; WT[3 * WT_LD + i] = w.w; }
    for (int i = tid; i < 8192; i += NTHREADS) { const f32x4 w = *(const f32x4*)(wre + 4 * i); const int k = i >> 3, c = 4 * (i & 7);
        WT[(4 + c) * WT_LD + k] = w.x; WT[(5 + c) * WT_LD + k] = w.y; WT[(6 + c) * WT_LD + k] = w.z; WT[(7 + c) * WT_LD + k] = w.w; }
    const float* g1 = in[12]; const float* b1 = in[13]; const float* brg = in[15]; const float* bre = in[17];
    for (int blk = blockIdx.x; blk < NT / 128; blk += G) {
        const int b = blk / 32; const float* ada = (const float*)(ws + WS_ADA) + (size_t)b * 6 * D_MODEL; const float* sh2 = ada + 3 * D_MODEL; const float* sc2 = ada + 4 * D_MODEL;
        if (tid < 32) lcnt[tid] = 0;
        __syncthreads();
        for (int rb = 0; rb < 16; rb += 4) {
            const int rl0 = wave * 16 + rb; const size_t row0 = (size_t)blk * 128 + rl0;
            f32x4 v[4][4];
#pragma unroll
            for (int r = 0; r < 4; ++r) { const f32x4* xr = (const f32x4*)(out + (row0 + r) * D_MODEL) + lane;
#pragma unroll
                for (int j = 0; j < 4; ++j) v[r][j] = xr[64 * j]; }
            float rstd[4], mean1[4]; ln_center<4>(v, rstd, mean1);
            if (REAL && lane < 4) { typedef float f32x2v __attribute__((ext_vector_type(2))); ((f32x2v*)(ws + WS_ST1))[row0 + lane] = (f32x2v){lane == 0 ? mean1[0] : lane == 1 ? mean1[1] : lane == 2 ? mean1[2] : mean1[3], lane == 0 ? rstd[0] : lane == 1 ? rstd[1] : lane == 2 ? rstd[2] : rstd[3]}; }
#pragma unroll
            for (int j = 0; j < 4; ++j) { const f32x4 gg = *(const f32x4*)(g1 + 256 * j + 4 * lane), bb = *(const f32x4*)(b1 + 256 * j + 4 * lane);
#pragma unroll
                for (int r = 0; r < 4; ++r) v[r][j] = v[r][j] * rstd[r] * gg + bb; }
            ln_center<4>(v, rstd);
#pragma unroll
            for (int j = 0; j < 4; ++j) { const f32x4 a4 = *(const f32x4*)(sc2 + 256 * j + 4 * lane) + 1.f, c4 = *(const f32x4*)(sh2 + 256 * j + 4 * lane);
#pragma unroll
                for (int r = 0; r < 4; ++r) { v[r][j] = v[r][j] * rstd[r] * a4 + c4; u32x2 w; w.x = cvtpk_s(v[r][j].x, v[r][j].y); w.y = cvtpk_s(v[r][j].z, v[r][j].w);
                    ((u32x2*)(h2dst + (row0 + r) * D_MODEL) + lane)[64 * j] = w; } }
#pragma unroll
            for (int r = 0; r < 4; ++r) {
                float gp[N_GROUPS];
#pragma unroll
                for (int g = 0; g < N_GROUPS; ++g) gp[g] = dpp_row_sum_f(dot16(v[r], WT + g * WT_LD, lane));
                float gl[N_GROUPS];
#pragma unroll
                for (int g = 0; g < N_GROUPS; ++g) gl[g] = rl4sum(gp[g]) + brg[g];
                int gi = 0; float gm = gl[0];
#pragma unroll
                for (int g = 1; g < N_GROUPS; ++g) if (gl[g] > gm) { gm = gl[g]; gi = g; }
                float gs = 0.f;
#pragma unroll
                for (int g = 0; g < N_GROUPS; ++g) gs += __expf(gl[g] - gm);
                const float gw = 1.f / gs;
                float ep[EPG];
#pragma unroll
                for (int e = 0; e < EPG; ++e) ep[e] = dpp_row_sum_f(dot16(v[r], WT + (4 + gi * EPG + e) * WT_LD, lane));
                float v0 = -INFINITY, v1 = -INFINITY; int i0 = 0, i1 = 0;
#pragma unroll
                for (int e = 0; e < EPG; ++e) { const float ev = rl4sum(ep[e]) + bre[gi * EPG + e];
                    if (ev > v0) { v1 = v0; i1 = i0; v0 = ev; i0 = e; } else if (ev > v1) { v1 = ev; i1 = e; } }
                const float e1 = __expf(v1 - v0); const float w0 = gw / (1.f + e1), w1 = gw * e1 / (1.f + e1);
                if (REAL && lane == 0) { const int ea = gi * EPG + i0, eb = gi * EPG + i1; const int rl = rl0 + r; const size_t row = row0 + r;
                    const int pa = atomicAdd((int*)&lcnt[ea], 1), pb = atomicAdd((int*)&lcnt[eb], 1);
                    ent[rl * 2] = (ea << 16) | pa; ent[rl * 2 + 1] = (eb << 16) | pb;
                    ((int*)(ws + WS_EID))[row * 2] = ea; ((int*)(ws + WS_EID))[row * 2 + 1] = eb; ((float*)(ws + WS_EW))[row * 2] = w0; ((float*)(ws + WS_EW))[row * 2 + 1] = w1; }
            }
        }
        __syncthreads();
        if (REAL && tid < 32) lbase[tid] = (int)atomicAdd((unsigned*)(ws + WS_CNT) + tid * 32, (unsigned)lcnt[tid]);
        __syncthreads();
        if (REAL && tid < 256) { const int en = ent[tid]; const int e = en >> 16, pos = lbase[e] + (en & 0xffff); ((int*)(ws + WS_POS))[(size_t)blk * 256 + tid] = pos; ((int*)(ws + WS_LIST))[e * 32768 + pos] = blk * 128 + (tid >> 1); }
        __syncthreads();
    }
}
__device__ __forceinline__ void p9_phase(unsigned char* ws, LAS unsigned char* lds, int G) {
    build_tables(ws, lds); const LAS int* toff = (const LAS int*)(lds + LDS_TAB);
    const int lane = threadIdx.x & 63, wave = threadIdx.x >> 6;
    for (int base = (blockIdx.x * NWAVES + wave) * 32; base < NT * 2; base += G * NWAVES * 32) {
        for (int k = 0; k < 32; k += 4) {
            const int ts0 = base + k; const int li = ts0 + (lane & 3);
            const int ev = ((const int*)(ws + WS_EID))[li], pv = ((const int*)(ws + WS_POS))[li];
            u32x4 d0[4], d1[4]; size_t dst[4];
#pragma unroll
            for (int r = 0; r < 4; ++r) { const int e = __builtin_amdgcn_readlane(ev, r), pos = __builtin_amdgcn_readlane(pv, r); dst[r] = (size_t)toff[e] * 256 + pos;
                const u32x4* sp = (const u32x4*)((const bf16_t*)(ws + WS_H2) + (size_t)((ts0 + r) >> 1) * D_MODEL); d0[r] = sp[lane]; d1[r] = sp[lane + 64]; }
#pragma unroll
            for (int r = 0; r < 4; ++r) { u32x4* dp = (u32x4*)((bf16_t*)(ws + WS_XG) + dst[r] * D_MODEL); dp[lane] = d0[r]; dp[lane + 64] = d1[r]; }
        }
    }
}
__device__ __forceinline__ void p12_phase(const float* const* in, float* out, float* dst, unsigned char* ws, LAS unsigned char* lds, int G) {
    build_tables(ws, lds); const LAS int* toff = (const LAS int*)(lds + LDS_TAB);
    const int lane = threadIdx.x & 63, wave = threadIdx.x >> 6; const float* g2 = in[21]; const float* b2 = in[22]; const float* g1 = in[12]; const float* b1 = in[13];
    for (int blk = blockIdx.x; blk < NT / 128; blk += G) {
        const int b = blk / 32; const float* gt2 = (const float*)(ws + WS_ADA) + (size_t)b * 6 * D_MODEL + 5 * D_MODEL;
        for (int rb = 0; rb < 16; rb += 4) {
            const size_t row0 = (size_t)blk * 128 + wave * 16 + rb;
            const size_t li = row0 * 2 + (lane & 7);
            const int ev = ((const int*)(ws + WS_EID))[li], pv = ((const int*)(ws + WS_POS))[li]; const float wv = ((const float*)(ws + WS_EW))[li];
            typedef float f32x2v __attribute__((ext_vector_type(2))); const f32x2v stv = ((const f32x2v*)(ws + WS_ST1))[row0 + (lane & 3)];
            f32x4 v[4][4]; u32x2 ya[4][4], yb[4][4]; float w0[4], w1[4], m1[4], r1[4];
#pragma unroll
            for (int r = 0; r < 4; ++r) {
                const int e0 = __builtin_amdgcn_readlane(ev, 2 * r), e1 = __builtin_amdgcn_readlane(ev, 2 * r + 1), p0 = __builtin_amdgcn_readlane(pv, 2 * r), p1 = __builtin_amdgcn_readlane(pv, 2 * r + 1);
                w0[r] = __int_as_float(__builtin_amdgcn_readlane(__float_as_int(wv), 2 * r)); w1[r] = __int_as_float(__builtin_amdgcn_readlane(__float_as_int(wv), 2 * r + 1));
                m1[r] = __int_as_float(__builtin_amdgcn_readlane(__float_as_int(stv.x), r)); r1[r] = __int_as_float(__builtin_amdgcn_readlane(__float_as_int(stv.y), r));
                const u32x2* y0 = (const u32x2*)((const bf16_t*)(ws + WS_YG) + ((size_t)toff[e0] * 256 + p0) * D_MODEL) + lane; const u32x2* y1 = (const u32x2*)((const bf16_t*)(ws + WS_YG) + ((size_t)toff[e1] * 256 + p1) * D_MODEL) + lane;
                const f32x4* xr = (const f32x4*)(out + (row0 + r) * D_MODEL) + lane;
#pragma unroll
                for (int j = 0; j < 4; ++j) { v[r][j] = xr[64 * j]; ya[r][j] = y0[64 * j]; yb[r][j] = y1[64 * j]; } }
#pragma unroll
            for (int j = 0; j < 4; ++j) { const f32x4 gv = *(const f32x4*)(gt2 + 256 * j + 4 * lane), g1v = *(const f32x4*)(g1 + 256 * j + 4 * lane), b1v = *(const f32x4*)(b1 + 256 * j + 4 * lane);
#pragma unroll
                for (int r = 0; r < 4; ++r) { const u32x2 a = ya[r][j], c = yb[r][j]; f32x4 f; v[r][j] = (v[r][j] - m1[r]) * r1[r] * g1v + b1v;
                    f.x = w0[r] * __uint_as_float(a.x << 16) + w1[r] * __uint_as_float(c.x << 16); f.y = w0[r] * __uint_as_float(a.x & 0xffff0000u) + w1[r] * __uint_as_float(c.x & 0xffff0000u);
                    f.z = w0[r] * __uint_as_float(a.y << 16) + w1[r] * __uint_as_float(c.y << 16); f.w = w0[r] * __uint_as_float(a.y & 0xffff0000u) + w1[r] * __uint_as_float(c.y & 0xffff0000u);
                    v[r][j] = v[r][j] * DN_ALPHA + gv * f; } }
            float rstd[4]; ln_center<4>(v, rstd);
#pragma unroll
            for (int j = 0; j < 4; ++j) { const f32x4 gg = *(const f32x4*)(g2 + 256 * j + 4 * lane), bb = *(const f32x4*)(b2 + 256 * j + 4 * lane);
#pragma unroll
                for (int r = 0; r < 4; ++r) ((f32x4*)(dst + (row0 + r) * D_MODEL) + lane)[64 * j] = v[r][j] * rstd[r] * gg + bb; }
        }
    }
}

constexpr size_t WS_TS = 384 * 1024;
constexpr size_t WS_DEAD = 392 * 1024;
constexpr size_t WS_BAR = 320 * 1024;
#define RLX_AGENT __ATOMIC_RELAXED, __HIP_MEMORY_SCOPE_AGENT
#define XB_TMO      128
#define XB_XCNT(j)  (256  + 64 * (j))
#define XB_XSUB(j)  (1280 + 64 * (j))
#define XB_XGEN(j)  (2304 + 64 * (j))
#define XB_TOP      3328
#define XB_TOPGEN   3392
#define XCD_BAR_WORDS 3456
#define XB_SPIN_CAP (1u << 18)

__device__ __forceinline__ unsigned xb_ld(unsigned* p)              { return __hip_atomic_load(p, __ATOMIC_RELAXED, __HIP_MEMORY_SCOPE_AGENT); }
__device__ __forceinline__ unsigned xb_add(unsigned* p, unsigned v) { return __hip_atomic_fetch_add(p, v, __ATOMIC_RELAXED, __HIP_MEMORY_SCOPE_AGENT); }
__device__ __forceinline__ unsigned xb_xcc_id() { return (unsigned)__builtin_amdgcn_s_getreg((3 << 11) | 20) & 0xFu; }
#define XB_SPIN(cond, bar) do { unsigned _sp = 0; while (cond) { __builtin_amdgcn_s_sleep(1); \
    if ((++_sp & 255u) == 0u) { if (xb_ld(&(bar)[XB_TMO])) break; if (_sp > XB_SPIN_CAP) { atomicAdd(&(bar)[XB_TMO], 1u); break; } } } } while (0)

struct XcdBarrier {
    unsigned* bar; unsigned x;
    volatile LAS unsigned* st;
};

__device__ __forceinline__ XcdBarrier xcd_barrier_post(unsigned* bar, volatile LAS unsigned* st) {
    XcdBarrier b; b.bar = bar; b.x = xb_xcc_id(); b.st = st;
    if (threadIdx.x == 0) (void)xb_add(&bar[XB_XCNT(b.x)], 1u);
    return b;
}
__device__ __forceinline__ void xcd_barrier_complete(unsigned* bar, unsigned x, unsigned& nloc, unsigned& nx) {
    const unsigned G = gridDim.x * gridDim.y * gridDim.z;
    unsigned sum, cnt, mine, sp = 0u;
    for (;;) {
        sum = 0u; cnt = 0u; mine = 0u;
#pragma unroll
        for (unsigned j = 0; j < 16; ++j) { const unsigned c = xb_ld(&bar[XB_XCNT(j)]); sum += c; cnt += (c > 0u) ? 1u : 0u; mine = (j == x) ? c : mine; }
        if (sum == G) break;
        __builtin_amdgcn_s_sleep(1);
        if ((++sp & 255u) == 0u) { if (xb_ld(&bar[XB_TMO])) break; if (sp > XB_SPIN_CAP) { atomicAdd(&bar[XB_TMO], 1u); break; } }
    }
    nloc = mine > 0u ? mine : 1u; nx = cnt > 0u ? cnt : 1u;
}

__device__ __forceinline__ void xcd_barrier(const XcdBarrier& b) {
    asm volatile("s_waitcnt vmcnt(0)" ::: "memory");
    __syncthreads();
    if (threadIdx.x == 0) {
        unsigned* bar = b.bar;
        __builtin_amdgcn_s_waitcnt(0);
        unsigned nloc = b.st[0], nx = b.st[1];
        if (nloc == 0u) { xcd_barrier_complete(bar, b.x, nloc, nx); b.st[0] = nloc; b.st[1] = nx; }
        const unsigned old = xb_add(&bar[XB_XSUB(b.x)], 1u);
        const unsigned gen = old / nloc;
        if (old + 1u == (gen + 1u) * nloc) {
            __builtin_amdgcn_fence(__ATOMIC_RELEASE, "agent");
            asm volatile("s_waitcnt vmcnt(0)" ::: "memory");
            const unsigned og = xb_add(&bar[XB_TOP], 1u);
            const unsigned tg = og / nx;
            if (og + 1u == (tg + 1u) * nx) xb_add(&bar[XB_TOPGEN], 1u);
            else XB_SPIN(xb_ld(&bar[XB_TOPGEN]) == tg, bar);
            __builtin_amdgcn_fence(__ATOMIC_ACQUIRE, "agent");
            xb_add(&bar[XB_XGEN(b.x)], 1u);
            asm volatile("s_waitcnt vmcnt(0)" ::: "memory");
        } else {
            XB_SPIN(xb_ld(&bar[XB_XGEN(b.x)]) == gen, bar);
            __builtin_amdgcn_fence(__ATOMIC_ACQUIRE, "agent");
            asm volatile("s_waitcnt vmcnt(0)" ::: "memory");
        }
    }
    __syncthreads();
}

__device__ __forceinline__ int opaque_i(int v) {
#if DUPMASK_ON
    asm volatile("" : "+v"(v)); v = __builtin_amdgcn_readfirstlane(v);
#endif
    return v; }
constexpr int NPH = 14;
struct Args { const float* in[23]; float* out; unsigned char* ws; int ph_lo, ph_hi; };
__global__ void __launch_bounds__(NTHREADS, 2) mk_fwd(Args a) {
    extern __shared__ __attribute__((aligned(16))) unsigned char lds_raw[];
    LAS unsigned char* lds = (LAS unsigned char*)lds_raw;
    cg::grid_group grid = cg::this_grid();
    const int G = gridDim.x, tid = threadIdx.x, lane = tid & 63, wave = __builtin_amdgcn_readfirstlane(tid >> 6);
    const int lo = a.ph_lo, hi = a.ph_hi;
    unsigned char* ws = a.ws;
    volatile LAS unsigned* bst = (volatile LAS unsigned*)(lds + LDS_BYTES - 16);
    if (tid < 4) bst[tid] = 0u;
    __syncthreads();
    XcdBarrier bar = xcd_barrier_post((unsigned*)(ws + WS_BAR), bst);
    if (TSTAMP && blockIdx.x == 0 && tid == 0) ((unsigned long long*)(ws + WS_TS))[0] = __builtin_amdgcn_s_memrealtime();
    if (a.ph_hi > NPH) grid.sync();
#ifndef PHMASK
#define PHMASK 0xFFFF
#endif
#define IN(k) (((PHMASK >> (k)) & 1) && lo <= (k) && (k) < hi)
#define GRIDBAR() do { if (USE_CG_SYNC) grid.sync(); else xcd_barrier(bar); } while (0)
#define SEAM(k) do { if (IN(k) && IN((k) + 1)) GRIDBAR(); if (TSTAMP && blockIdx.x == 0 && tid == 0) ((unsigned long long*)(ws + WS_TS))[(k) + 1] = __builtin_amdgcn_s_memrealtime(); } while (0)
#define PH(k) for (int rep_ = 0; rep_ < (IN(k) ? 1 + ((DUPMASK >> (k)) & 1) : 0); ++rep_) if (rep_ > 0 && (xcd_barrier(bar), false)) {} else
    PH(0) {
        if (blockIdx.x == 0 && tid < 32) ((unsigned*)(ws + WS_CNT))[tid * 32] = 0u;
        if (blockIdx.x == 2 && tid < 64) ((unsigned*)(ws + WS_DEAD))[tid] = (unsigned)((tid & 15) << 6) * 0x00010001u;
        if (blockIdx.x == 1 && tid < 256) { const float* wgp = a.in[6] + tid; u32x4 w0, w1;
            w0.x = cvtpk_s(wgp[0], wgp[256]); w0.y = cvtpk_s(wgp[512], wgp[768]); w0.z = cvtpk_s(wgp[1024], wgp[1280]); w0.w = cvtpk_s(wgp[1536], wgp[1792]);
            w1.x = cvtpk_s(wgp[2048], wgp[2304]); w1.y = cvtpk_s(wgp[2560], wgp[2816]); w1.z = cvtpk_s(wgp[3072], wgp[3328]); w1.w = cvtpk_s(wgp[3584], wgp[3840]);
            u32x4* dst = (u32x4*)((bf16_t*)(ws + WS_WGT) + tid * 16); dst[0] = w0; dst[1] = w1; }
        LAS float* scr = (LAS float*)(lds + wave * 16384);
        for (int it = blockIdx.x * NWAVES + wave; it < P0_ITEMS; it += G * NWAVES) p0_item(it, a.in, ws, scr, lane);
    }
    SEAM(0);
    PH(1) p1_phase(a.in, ws, lds, G);
    SEAM(1);
    PH(2) {
        pg8::Gemm g{(const bf16_t*)(ws + WS_XN), (const bf16_t*)(ws + WS_WIN), NT, NPROJ, D_MODEL}; pg8::StaticOrder S; S.init(NT, NPROJ, G, (int)blockIdx.x);
        EpiProj E{ws};
        pg8::gemm_phase<EpiProj, pg8::StaticOrder, PG8_ALIGN, PG8_SP2>(lds, g, S, E);
#ifdef DUP_P2
        xcd_barrier(bar);
        pg8::gemm_phase<EpiProj, pg8::StaticOrder, PG8_ALIGN, PG8_SP2>(lds, g, S, E);
#endif
    }
    SEAM(2);
    PH(3) {
        for (int u = blockIdx.x; u < 256; u += G) { const int p = u >> 1, b = p >> 4, qi = p & 15, qj = 31 - qi; LAS unsigned char* lw = lds + wave * 17408;
            for (int rep = 0; rep < ((DUPSUB & 1) ? 2 : 1); ++rep) {
                if ((u & 1) == 0) { p3a_run(b, qi, 0, qi, ws, lw, wave, lane); if (qi < 15) p3a_run(b, qj, 0, 14 - qi, ws, lw, wave, lane); }
                else p3a_run(b, qj, 15 - qi, qj, ws, lw, wave, lane); } }
        for (int p = blockIdx.x; p < GLA_ITEMS / 2; p += G) { p3b_pair(p, a.in[6], a.in[7], a.out, a.out + 24 * MiB, ws, lds); if (DUPSUB & 2) p3b_pair(p, a.in[6], a.in[7], a.out, a.out + 24 * MiB, ws, lds); }
    }
    SEAM(3);
    PH(4) {
        LAS unsigned* rowctr = (LAS unsigned*)(lds + NWAVES * SEL_LDS);
        if (tid == 0) *rowctr = 0u;
        __syncthreads();
        if (wave < 2) for (int j = blockIdx.x; j < 256; j += G) { p4b_item4(j, a.out, (bf16_t*)(a.out + 16 * MiB), ws); if (DUPSUB & 8) p4b_item4(j, a.out, (bf16_t*)(a.out + 16 * MiB), ws); }
        {
            unsigned xa[32], xb[32]; LAS unsigned char* Hw = lds + wave * SEL_LDS;
#define SEL_GRAB() __builtin_amdgcn_readfirstlane((int)(lane == 0 ? __hip_atomic_fetch_add(rowctr, 1u, __ATOMIC_RELAXED, __HIP_MEMORY_SCOPE_WORKGROUP) : 0u))
#define SEL_ROW(i_) (((i_) < 64 ? (i_) >> 3 : ((i_) - 64) >> 3) * NS + ((i_) < 64 ? NS - 1 - ((int)blockIdx.x * NWAVES + ((i_) & 7)) : (int)blockIdx.x * NWAVES + ((i_) & 7)))
            int i0 = SEL_GRAB();
            p4a_load(SEL_ROW(i0 < 127 ? i0 : 127), ws, lane, xa);
#pragma unroll 1
            while (i0 < 128) {
                const int i1 = SEL_GRAB();
                p4a_load(SEL_ROW(i1 < 127 ? i1 : 127), ws, lane, xb);
                p4a_row(SEL_ROW(i0), ws, lane, xa, Hw); if (DUPSUB & 4) p4a_row(SEL_ROW(i0), ws, lane, xa, Hw);
                if (i1 >= 128) break;
                i0 = SEL_GRAB();
                p4a_load(SEL_ROW(i0 < 127 ? i0 : 127), ws, lane, xa);
                p4a_row(SEL_ROW(i1), ws, lane, xb, Hw); if (DUPSUB & 4) p4a_row(SEL_ROW(i1), ws, lane, xb, Hw);
            }
        }
    }
    SEAM(4);
    PH(5) {
        const int c = blockIdx.x; const int bh = c >> 2, sx = c & 3;
        for (int p = blockIdx.x; p < GLA_ITEMS / 2; p += G) { p5b_pair(p, a.out + 24 * MiB, a.in[8], (const bf16_t*)(a.out + 16 * MiB), ws, lds); if (DUPSUB & 32) p5b_pair(p, a.out + 24 * MiB, a.in[8], (const bf16_t*)(a.out + 16 * MiB), ws, lds); }
        if (c < 256) for (int i = 0; i < 4; ++i) { const int Q = (i == 0) ? sx : (i == 1) ? 7 - sx : (i == 2) ? 8 + sx : 15 - sx; if (wave < 4) attn_unit<false>(bh >> 3, bh & 7, Q, a.in[2], ws, lds); else attn_unit<true>(bh >> 3, bh & 7, Q, a.in[2], ws, lds);
            if (DUPSUB & 16) { if (wave < 4) attn_unit<false>(bh >> 3, bh & 7, Q, a.in[2], ws, lds); else attn_unit<true>(bh >> 3, bh & 7, Q, a.in[2], ws, lds); } }
    }
    SEAM(5);
    PH(6) {
        pg8::StaticOrder S; S.init(NT, D_MODEL, G, (int)blockIdx.x);
        { pg8::Gemm g{(const bf16_t*)(ws + WS_XN), (const bf16_t*)(ws + WS_WGAB), NT, D_MODEL, D_MODEL}; EpiSig E{ws, 0}; pg8::gemm_phase<EpiSig, pg8::StaticOrder, PG8_ALIGN, PG8_SP2>(lds, g, S, E); }
        { pg8::Gemm g{(const bf16_t*)(ws + WS_XN), (const bf16_t*)(ws + WS_WGAB) + (size_t)1024 * 1024, NT, D_MODEL, D_MODEL}; EpiSig E{ws, 1}; pg8::gemm_phase<EpiSig, pg8::StaticOrder, PG8_ALIGN, PG8_SP2>(lds, g, S, E); }
        { pg8::Gemm g{(const bf16_t*)(ws + WS_OAB), (const bf16_t*)(ws + WS_WBA), NT, D_MODEL, D_MODEL}; EpiMrgF E{ws}; pg8::gemm_phase<EpiMrgF, pg8::StaticOrder, PG8_ALIGN, PG8_SP2>(lds, g, S, E); }
    }
    SEAM(7);
    PH(8) {
        pg8::Gemm g{(const bf16_t*)(ws + WS_MRG), (const bf16_t*)(ws + WS_WOUT), NT, D_MODEL, D_MODEL}; pg8::StaticOrder S; S.init(NT, D_MODEL, G, (int)blockIdx.x);
        EpiV E{a.in[0], (const float*)(ws + WS_ADA), a.out}; pg8::gemm_phase<EpiV, pg8::StaticOrder, PG8_ALIGN, PG8_SP2>(lds, g, S, E);
    }
    SEAM(8);
#ifdef DUP_P8
    p8_phase<false>(a.in, a.out, (float*)(ws + 129 * MiB), (bf16_t*)(ws + 260 * MiB), ws, lds, G); xcd_barrier(bar);
#endif
    PH(9) p8_phase<true>(a.in, a.out, a.out, (bf16_t*)(ws + WS_H2), ws, lds, G);
    if (IN(9) && IN(11)) { GRIDBAR(); if (TSTAMP && blockIdx.x == 0 && tid == 0) ((unsigned long long*)(ws + WS_TS))[10] = __builtin_amdgcn_s_memrealtime(); }
    PH(11) {
        build_tables(ws, lds);
        pg8::Gemm g{(const bf16_t*)(ws + WS_H2), (const bf16_t*)(ws + WS_W13), 0, 0, D_MODEL}; GroupOrder<2> S{(const LAS int*)(lds + LDS_TAB), (const LAS int*)(lds + LDS_TAB) + 64, G, (int)blockIdx.x, (const int*)(ws + WS_LIST)};
        EpiHid E{ws}; pg8::gemm_phase<EpiHid, GroupOrder<2>, PG8_ALIGN, PG8_SP2, true>(lds, g, S, E);
    }
    SEAM(11);
    PH(12) {
        build_tables(ws, lds);
        int kd = D_EXP; asm volatile("" : "+s"(kd));
        pg8::Gemm g{(const bf16_t*)(ws + WS_HID), (const bf16_t*)(ws + WS_W2), 0, 0, kd}; GroupOrder<4> S{(const LAS int*)(lds + LDS_TAB), (const LAS int*)(lds + LDS_TAB) + 64, G, (int)blockIdx.x, nullptr};
        EpiY E{ws}; pg8::gemm_phase<EpiY, GroupOrder<4>, PG8_ALIGN, PG8_SP2>(lds, g, S, E);
    }
    SEAM(12);
#ifdef DUP_P12
    p12_phase(a.in, a.out, (float*)(ws + 129 * MiB), ws, lds, G); xcd_barrier(bar);
#endif
    PH(13) p12_phase(a.in, a.out, a.out, ws, lds, G);
    if (TSTAMP) { xcd_barrier(bar); if (blockIdx.x == 0 && tid == 0) ((unsigned long long*)(ws + WS_TS))[14] = __builtin_amdgcn_s_memrealtime(); }
#ifdef EXTRA_SYNCS
    for (int i_ = 0; i_ < EXTRA_SYNCS; ++i_) GRIDBAR();
#endif
#undef IN
#undef SEAM
#undef PH
}
}
#if TSTAMP
__global__ void kd_ts(float* out, long n, const unsigned long long* ts, int ka, int kb) {
    const float da = (ka == 14) ? (float)(ts[14] - ts[0]) * 0.01f / 10.f : (float)(ts[ka + 1] - ts[ka]) * 0.01f;
    const float sc = 1.f + da * 0.0005f;
    for (long i = (long)blockIdx.x * blockDim.x + threadIdx.x; i < n; i += (long)gridDim.x * blockDim.x) out[i] *= sc;
}
#endif
extern "C" void kernel_launch(void* const* d_in, const int* in_sizes, int n_in, void* d_out, int out_size,
                              void* d_ws, size_t ws_size, hipStream_t stream) {
    using namespace fk;
    static int grid = 0;
    if (grid == 0) {
        int dev = 0, cus = 0, per_cu = 0; (void)hipGetDevice(&dev); (void)hipDeviceGetAttribute(&cus, hipDeviceAttributeMultiprocessorCount, dev);
        (void)hipFuncSetAttribute((const void*)mk_fwd, hipFuncAttributeMaxDynamicSharedMemorySize, LDS_BYTES);
        (void)hipOccupancyMaxActiveBlocksPerMultiprocessor(&per_cu, (const void*)mk_fwd, NTHREADS, LDS_BYTES);
        (void)hipGetLastError();
        grid = cus * (per_cu >= 1 ? 1 : 1);
        if (ws_size < 512 * MiB) { fprintf(stderr, "kernel_launch: workspace too small\n"); grid = -1; }
    }
    if (grid < 0) return;
    (void)hipMemsetAsync((unsigned char*)d_ws + WS_BAR, 0, 16384, stream);
    Args a{}; for (int i = 0; i < 23; ++i) a.in[i] = (const float*)d_in[i]; a.out = (float*)d_out; a.ws = (unsigned char*)d_ws; a.ph_lo = 0; a.ph_hi = NPH;
    void* args[] = {&a};
    hipError_t e = hipLaunchCooperativeKernel((const void*)mk_fwd, dim3(grid), dim3(NTHREADS), args, LDS_BYTES, stream);
    if (e != hipSuccess) fprintf(stderr, "cooperative launch failed: %s\n", hipGetErrorString(e));
#if TSTAMP
    hipLaunchKernelGGL(kd_ts, dim3(1024), dim3(256), 0, stream, (float*)d_out, (long)out_size, (const unsigned long long*)((unsigned char*)d_ws + WS_TS), TS_A, TS_B);
#endif
}
```

```cpp
#include <hip/hip_runtime.h>
#include <hip/hip_cooperative_groups.h>
#include <cstdio>
#include <cstdint>
#include <cstring>
#include <cmath>
#ifdef HOST_EMU
#include <cmath>
#include <cstdio>
#include <cstdlib>
#include <cstring>
#include <cstdint>
struct Dim3e { int x, y, z; };
static thread_local Dim3e threadIdx, blockIdx, blockDim, gridDim;
#define __global__
#define __device__
#define __host__
#define __forceinline__ inline
#define __launch_bounds__(...)
typedef void* hipStream_t;
template <class F, class... A> static void host_launch(F f, long nb, int nt, A... a) {
#pragma omp parallel for schedule(dynamic, 4)
    for (long b = 0; b < nb; ++b) {
        blockIdx = {(int)b, 0, 0}; blockDim = {nt, 1, 1}; gridDim = {(int)nb, 1, 1};
        for (int t = 0; t < nt; ++t) { threadIdx = {t, 0, 0}; f(a...); }
    }
}
#define LAUNCH(k, nb, nt, st, ...) host_launch(k, (long)(nb), (int)(nt), __VA_ARGS__)
#define UNROLL
#else
#define LAUNCH(k, nb, nt, st, ...) hipLaunchKernelGGL(k, dim3((unsigned)(nb)), dim3((unsigned)(nt)), 0, st, __VA_ARGS__)
#endif

constexpr int D_MODEL = 1024, A_HEADS = 8, A_HD = 64, A_W = 512, I_HEADS = 16, I_DIM = 32, TOPK_MAX = 256, REL_B = 32,
              G_HEADS = 4, G_DK = 64, G_DV = 128, G_KW = 256, G_VW = 512, G_RANK = 16, N_GROUPS = 4, EPG = 8, N_EXP = 32, D_EXP = 256;
constexpr int O_AQ = 0, O_AK = 512, O_AV = 1024, O_IQ = 1536, O_IK = 2048, O_IW = 2080, O_GQ = 2096, O_GK = 2352, O_GV = 2608, O_GR = 3120,
              O_GLR = 3632, O_GA = 3648, O_GB = 4672, D_IN = 5696;
constexpr float DN_ALPHA = 1.189207115002721f, LN_EPS = 1e-5f;
#define V0_GID long gid = (long)blockIdx.x * blockDim.x + threadIdx.x

__device__ __forceinline__ float v0_silu(float v) { return v / (1.f + expf(-v)); }
__device__ __forceinline__ float v0_sigmoid(float v) { return 1.f / (1.f + expf(-v)); }

__global__ void k0_ada(const float* c, const float* w_ada, const float* b_ada, float* ada, int B) {
    V0_GID; if (gid >= (long)B * 6 * D_MODEL) return;
    const int b = (int)(gid / (6 * D_MODEL)), j = (int)(gid % (6 * D_MODEL));
    float acc = 0.f;
    for (int i = 0; i < D_MODEL; ++i) acc += v0_silu(c[b * D_MODEL + i]) * w_ada[(size_t)i * 6 * D_MODEL + j];
    ada[gid] = acc + b_ada[j];
}
__global__ void k0_lnmod(const float* x, const float* sh, const float* sc, float* h, int nrows) {
    V0_GID; if (gid >= nrows) return;
    const float* xr = x + (size_t)gid * D_MODEL; float* hr = h + (size_t)gid * D_MODEL;
    float mu = 0.f; for (int k = 0; k < D_MODEL; ++k) mu += xr[k]; mu *= (1.f / D_MODEL);
    float var = 0.f; for (int k = 0; k < D_MODEL; ++k) { const float d = xr[k] - mu; var += d * d; } var *= (1.f / D_MODEL);
    const float rs = 1.f / sqrtf(var + LN_EPS);
    for (int k = 0; k < D_MODEL; ++k) hr[k] = (xr[k] - mu) * rs * (1.f + sc[k]) + sh[k];
}
__global__ void k0_gemm(const float* A, int lda, const float* W, int ldw, float* C, int ldc, int M, int N, int K) {
    V0_GID; if (gid >= (long)(M / 4) * N) return;
    const int n = (int)(gid % N); const int m0 = (int)(gid / N) * 4;
    float a0 = 0.f, a1 = 0.f, a2 = 0.f, a3 = 0.f;
    const float* A0 = A + (size_t)m0 * lda;
    for (int k = 0; k < K; ++k) { const float w = W[(size_t)k * ldw + n]; a0 += A0[k] * w; a1 += A0[lda + k] * w; a2 += A0[2 * lda + k] * w; a3 += A0[3 * lda + k] * w; }
    C[(size_t)m0 * ldc + n] = a0; C[(size_t)(m0 + 1) * ldc + n] = a1; C[(size_t)(m0 + 2) * ldc + n] = a2; C[(size_t)(m0 + 3) * ldc + n] = a3;
}
__global__ void k0_scores(const float* P, float* scT, int S) {
    V0_GID; if (gid >= (long)S * S) return;
    const int t = (int)(gid % S), s = (int)(gid / S);
    if (s > t) { scT[gid] = -INFINITY; return; }
    const float* iq = P + (size_t)t * D_IN + O_IQ; const float* ik = P + (size_t)s * D_IN + O_IK; const float* iw = P + (size_t)t * D_IN + O_IW;
    const float cst = 0.044194173824159216f;
    float sc = 0.f;
    for (int h = 0; h < I_HEADS; ++h) { float d = 0.f; for (int k = 0; k < I_DIM; ++k) d += iq[h * I_DIM + k] * ik[k]; sc += (iw[h] * cst) * fmaxf(d, 0.f); }
    scT[gid] = sc;
}
__device__ __forceinline__ unsigned v0_key(float f) { unsigned u; memcpy(&u, &f, 4); return (u & 0x80000000u) ? ~u : (u | 0x80000000u); }
__global__ void k0_topk(const float* scT, int* sel, int* cnt, int S, int topk) {
    V0_GID; if (gid >= S) return;
    const int t = (int)gid; const int n = t + 1; int* sl = sel + (size_t)t * TOPK_MAX;
    if (n <= topk) { for (int s = 0; s < n; ++s) sl[s] = s; cnt[t] = n; return; }
    unsigned T = 0u;
    for (int bit = 31; bit >= 0; --bit) { const unsigned cand = T | (1u << bit); int c = 0; for (int s = 0; s < n; ++s) c += (v0_key(scT[(size_t)s * S + t]) >= cand) ? 1 : 0; if (c >= topk) T = cand; }
    int cgt = 0; for (int s = 0; s < n; ++s) cgt += (v0_key(scT[(size_t)s * S + t]) > T) ? 1 : 0;
    int need = topk - cgt, j = 0;
    for (int s = 0; s < n; ++s) { const unsigned k = v0_key(scT[(size_t)s * S + t]); if (k > T) sl[j++] = s; else if (k == T && need > 0) { sl[j++] = s; --need; } }
    cnt[t] = j;
}
__device__ __forceinline__ int v0_bucket(int d) {
    if (d < 16) return d;
    const float df = (float)d; int large = 16 + (int)(logf(df / 16.f) / 2.0794415416798357f * 16.f);
    return large < 31 ? large : 31;
}
__global__ void __launch_bounds__(256) k0_attn(const float* P, const int* sel, const int* cnt, const float* rel_bias, float* oa, int S) {
    V0_GID; if (gid >= (long)S * A_HEADS) return;
    const int t = (int)(gid / A_HEADS), h = (int)(gid % A_HEADS); const int n = cnt[t]; const int* sl = sel + (size_t)t * TOPK_MAX;
    const float* q = P + (size_t)t * D_IN + O_AQ + h * A_HD;
    float m = -INFINITY;
    for (int j = 0; j < n; ++j) { const int s = sl[j]; const float* k = P + (size_t)s * D_IN + O_AK + h * A_HD; float d = 0.f; for (int e = 0; e < A_HD; ++e) d += q[e] * k[e];
        const float l = d * 0.125f + rel_bias[v0_bucket(t - s) * A_HEADS + h]; m = fmaxf(m, l); }
    float o[A_HD];
#pragma unroll
    for (int e = 0; e < A_HD; ++e) o[e] = 0.f;
    float sum = 0.f;
    for (int j = 0; j < n; ++j) { const int s = sl[j]; const float* k = P + (size_t)s * D_IN + O_AK + h * A_HD; const float* v = P + (size_t)s * D_IN + O_AV + h * A_HD; float d = 0.f;
        for (int e = 0; e < A_HD; ++e) d += q[e] * k[e];
        const float p = expf(d * 0.125f + rel_bias[v0_bucket(t - s) * A_HEADS + h] - m); sum += p;
#pragma unroll
        for (int e = 0; e < A_HD; ++e) o[e] += p * v[e]; }
    const float inv = 1.f / sum;
#pragma unroll
    for (int e = 0; e < A_HD; ++e) oa[(size_t)t * A_W + h * A_HD + e] = o[e] * inv;
}
__global__ void k0_gate(const float* P, const float* wg, const float* bg, float* lg, int S) {
    V0_GID; if (gid >= (long)S * G_KW) return;
    const int t = (int)(gid / G_KW), j = (int)(gid % G_KW);
    float z = bg[j]; for (int r = 0; r < G_RANK; ++r) z += P[(size_t)t * D_IN + O_GLR + r] * wg[r * G_KW + j];
    lg[gid] = (fminf(z, 0.f) - log1pf(expf(-fabsf(z)))) * (1.f / 16.f);
}
__global__ void __launch_bounds__(64) k0_gla(const float* P, const float* lg, float* oraw, int S) {
    V0_GID; if (gid >= G_HEADS * G_DV) return;
    const int h = (int)(gid / G_DV), dv = (int)(gid % G_DV);
    float st[G_DK];
#pragma unroll
    for (int d = 0; d < G_DK; ++d) st[d] = 0.f;
    for (int t = 0; t < S; ++t) {
        const float* row = P + (size_t)t * D_IN; const float vv = row[O_GV + h * G_DV + dv]; float o = 0.f;
#pragma unroll
        for (int d = 0; d < G_DK; ++d) { const float a = expf(lg[(size_t)t * G_KW + h * G_DK + d]); st[d] = a * st[d] + row[O_GK + h * G_DK + d] * vv; o += row[O_GQ + h * G_DK + d] * st[d]; }
        oraw[(size_t)t * G_VW + h * G_DV + dv] = o * 0.125f;
    }
}
__global__ void k0_gla_post(const float* P, const float* oraw, const float* ng, float* ob, int S) {
    V0_GID; if (gid >= (long)S * G_HEADS) return;
    const int t = (int)(gid / G_HEADS), h = (int)(gid % G_HEADS); const float* o = oraw + (size_t)t * G_VW + h * G_DV;
    float mu = 0.f; for (int e = 0; e < G_DV; ++e) mu += o[e]; mu *= (1.f / G_DV);
    float var = 0.f; for (int e = 0; e < G_DV; ++e) { const float d = o[e] - mu; var += d * d; } var *= (1.f / G_DV);
    const float rs = 1.f / sqrtf(var + LN_EPS);
    for (int e = 0; e < G_DV; ++e) ob[(size_t)t * G_VW + h * G_DV + e] = (o[e] - mu) * rs * ng[h * G_DV + e] * v0_silu(P[(size_t)t * D_IN + O_GR + h * G_DV + e]);
}
__global__ void k0_merge(const float* P, const float* ba, const float* bb, float* mg, int S) {
    V0_GID; if (gid >= (long)S * D_MODEL) return;
    const int t = (int)(gid / D_MODEL), n = (int)(gid % D_MODEL);
    mg[gid] = v0_sigmoid(P[(size_t)t * D_IN + O_GA + n]) * ba[gid] + v0_sigmoid(P[(size_t)t * D_IN + O_GB + n]) * bb[gid];
}
__global__ void k0_ln1(const float* x, const float* y, const float* gt1, const float* g1, const float* b1, const float* sh2, const float* sc2, float* x1, float* h2, int nrows) {
    V0_GID; if (gid >= nrows) return;
    const float* xr = x + (size_t)gid * D_MODEL; const float* yr = y + (size_t)gid * D_MODEL; float* x1r = x1 + (size_t)gid * D_MODEL; float* h2r = h2 + (size_t)gid * D_MODEL;
    float mu = 0.f; for (int k = 0; k < D_MODEL; ++k) mu += DN_ALPHA * xr[k] + gt1[k] * yr[k]; mu *= (1.f / D_MODEL);
    float var = 0.f; for (int k = 0; k < D_MODEL; ++k) { const float d = DN_ALPHA * xr[k] + gt1[k] * yr[k] - mu; var += d * d; } var *= (1.f / D_MODEL);
    float rs = 1.f / sqrtf(var + LN_EPS);
    for (int k = 0; k < D_MODEL; ++k) x1r[k] = (DN_ALPHA * xr[k] + gt1[k] * yr[k] - mu) * rs * g1[k] + b1[k];
    mu = 0.f; for (int k = 0; k < D_MODEL; ++k) mu += x1r[k]; mu *= (1.f / D_MODEL);
    var = 0.f; for (int k = 0; k < D_MODEL; ++k) { const float d = x1r[k] - mu; var += d * d; } var *= (1.f / D_MODEL);
    rs = 1.f / sqrtf(var + LN_EPS);
    for (int k = 0; k < D_MODEL; ++k) h2r[k] = (x1r[k] - mu) * rs * (1.f + sc2[k]) + sh2[k];
}
__global__ void k0_route(const float* rl, const float* brg, const float* bre, int* eid, float* ew, int nrows) {
    V0_GID; if (gid >= nrows) return;
    const float* r = rl + (size_t)gid * 36;
    float gl[N_GROUPS]; float gm = -INFINITY; int gi = 0;
#pragma unroll
    for (int g = 0; g < N_GROUPS; ++g) { gl[g] = r[g] + brg[g]; if (gl[g] > gm) { gm = gl[g]; gi = g; } }
    float gs = 0.f;
#pragma unroll
    for (int g = 0; g < N_GROUPS; ++g) gs += expf(gl[g] - gm);
    const float gw = 1.f / gs;
    float v0 = -INFINITY, v1 = -INFINITY; int i0 = 0, i1 = 0;
    for (int e = 0; e < EPG; ++e) { const float v = r[4 + gi * EPG + e] + bre[gi * EPG + e];
        if (v > v0) { v1 = v0; i1 = i0; v0 = v; i0 = e; } else if (v > v1) { v1 = v; i1 = e; } }
    const float e1 = expf(v1 - v0); const float w0 = 1.f / (1.f + e1), w1 = e1 / (1.f + e1);
    eid[gid * 2] = gi * EPG + i0; eid[gid * 2 + 1] = gi * EPG + i1; ew[gid * 2] = w0 * gw; ew[gid * 2 + 1] = w1 * gw;
}
__global__ void k0_moe_hid(const float* h2, const int* eid, const float* w1, const float* w3, float* hid, int nrows) {
    V0_GID; if (gid >= (long)nrows * 2 * D_EXP) return;
    const int j = (int)(gid % D_EXP); const long ts = gid / D_EXP; const int t = (int)(ts / 2); const int e = eid[ts];
    const float* hr = h2 + (size_t)t * D_MODEL; const float* a = w1 + (size_t)e * D_MODEL * D_EXP + j; const float* b = w3 + (size_t)e * D_MODEL * D_EXP + j;
    float g = 0.f, u = 0.f; for (int k = 0; k < D_MODEL; ++k) { g += hr[k] * a[(size_t)k * D_EXP]; u += hr[k] * b[(size_t)k * D_EXP]; }
    hid[gid] = v0_silu(g) * u;
}
__global__ void k0_moe_out(const float* hid, const int* eid, const float* ew, const float* w2, float* f, int nrows) {
    V0_GID; if (gid >= (long)nrows * D_MODEL) return;
    const int n = (int)(gid % D_MODEL); const int t = (int)(gid / D_MODEL); float acc = 0.f;
    for (int sl = 0; sl < 2; ++sl) { const int e = eid[t * 2 + sl]; const float* hr = hid + ((size_t)t * 2 + sl) * D_EXP; const float* w = w2 + (size_t)e * D_EXP * D_MODEL + n; float a = 0.f;
        for (int j = 0; j < D_EXP; ++j) a += hr[j] * w[(size_t)j * D_MODEL]; acc += ew[t * 2 + sl] * a; }
    f[gid] = acc;
}
__global__ void k0_final(const float* x1, const float* f, const float* gt2, const float* g2, const float* b2, float* out, int nrows) {
    V0_GID; if (gid >= nrows) return;
    const float* xr = x1 + (size_t)gid * D_MODEL; const float* fr = f + (size_t)gid * D_MODEL; float* o = out + (size_t)gid * D_MODEL;
    float mu = 0.f; for (int k = 0; k < D_MODEL; ++k) mu += DN_ALPHA * xr[k] + gt2[k] * fr[k]; mu *= (1.f / D_MODEL);
    float var = 0.f; for (int k = 0; k < D_MODEL; ++k) { const float d = DN_ALPHA * xr[k] + gt2[k] * fr[k] - mu; var += d * d; } var *= (1.f / D_MODEL);
    const float rs = 1.f / sqrtf(var + LN_EPS);
    for (int k = 0; k < D_MODEL; ++k) o[k] = (DN_ALPHA * xr[k] + gt2[k] * fr[k] - mu) * rs * g2[k] + b2[k];
}

struct V0Buf { float *ada, *h, *P, *scT, *oa, *lg, *oraw, *ob, *ba, *bb, *mg, *y, *x1, *h2, *rl, *ew, *hid, *f; int *sel, *cnt, *eid; size_t bytes; };
static V0Buf v0_carve(void* base, int B, int S) {
    V0Buf b; char* p = (char*)base; auto take = [&](size_t n) { char* r = p; p += (n + 255) & ~(size_t)255; return r; };
    b.ada = (float*)take((size_t)B * 6 * D_MODEL * 4);
    b.P = (float*)take((size_t)S * D_IN * 4);
    b.h = (float*)take((size_t)S * D_MODEL * 4);
    b.scT = (float*)take((size_t)S * S * 4);
    b.sel = (int*)take((size_t)S * TOPK_MAX * 4); b.cnt = (int*)take((size_t)S * 4);
    b.oa = (float*)take((size_t)S * A_W * 4); b.lg = (float*)take((size_t)S * G_KW * 4); b.oraw = (float*)take((size_t)S * G_VW * 4); b.ob = (float*)take((size_t)S * G_VW * 4);
    b.ba = (float*)take((size_t)S * D_MODEL * 4); b.bb = (float*)take((size_t)S * D_MODEL * 4); b.y = (float*)take((size_t)S * D_MODEL * 4);
    b.x1 = (float*)take((size_t)S * D_MODEL * 4); b.h2 = (float*)take((size_t)S * D_MODEL * 4); b.f = (float*)take((size_t)S * D_MODEL * 4);
    b.mg = b.h;
    b.rl = (float*)take((size_t)S * 36 * 4); b.eid = (int*)take((size_t)S * 2 * 4); b.ew = (float*)take((size_t)S * 2 * 4); b.hid = (float*)take((size_t)S * 2 * D_EXP * 4);
    b.bytes = (size_t)(p - (char*)base); return b;
}
static void v0_forward(void* const* d_in, float* out, void* scratch, int B, int S, hipStream_t st, int only_batch = -1, int last_batch = -1) {
    const float *x = (const float*)d_in[0], *c = (const float*)d_in[1], *rel_bias = (const float*)d_in[2], *w_ada = (const float*)d_in[3], *b_ada = (const float*)d_in[4], *w_in = (const float*)d_in[5],
                *wg = (const float*)d_in[6], *bg = (const float*)d_in[7], *ng = (const float*)d_in[8], *wba = (const float*)d_in[9], *wbb = (const float*)d_in[10], *wout = (const float*)d_in[11],
                *g1 = (const float*)d_in[12], *b1 = (const float*)d_in[13], *wrg = (const float*)d_in[14], *brg = (const float*)d_in[15], *wre = (const float*)d_in[16], *bre = (const float*)d_in[17],
                *w1 = (const float*)d_in[18], *w3 = (const float*)d_in[19], *w2 = (const float*)d_in[20], *g2 = (const float*)d_in[21], *b2 = (const float*)d_in[22];
    V0Buf u = v0_carve(scratch, B, S);
    const int TB = 256; auto nb = [&](long n) { return (n + TB - 1) / TB; };
    const int topk = (TOPK_MAX < S / 4) ? TOPK_MAX : S / 4;
    LAUNCH(k0_ada, nb((long)B * 6 * D_MODEL), TB, st, c, w_ada, b_ada, u.ada, B);
    for (int bi = 0; bi < B; ++bi) {
        int b = bi; if (last_batch >= 0) b = (bi == B - 1) ? last_batch : (bi < last_batch ? bi : bi + 1);
        if (only_batch >= 0 && b != only_batch) continue;
        const float* xb = x + (size_t)b * S * D_MODEL; const float* ad = u.ada + (size_t)b * 6 * D_MODEL;
        const float *sh1 = ad, *sc1 = ad + D_MODEL, *gt1 = ad + 2 * D_MODEL, *sh2 = ad + 3 * D_MODEL, *sc2 = ad + 4 * D_MODEL, *gt2 = ad + 5 * D_MODEL;
        LAUNCH(k0_lnmod, nb(S), TB, st, xb, sh1, sc1, u.h, S);
        LAUNCH(k0_gemm, nb((long)(S / 4) * D_IN), TB, st, (const float*)u.h, D_MODEL, w_in, D_IN, u.P, D_IN, S, D_IN, D_MODEL);
        LAUNCH(k0_scores, nb((long)S * S), TB, st, (const float*)u.P, u.scT, S);
        LAUNCH(k0_topk, nb(S), TB, st, (const float*)u.scT, u.sel, u.cnt, S, topk);
        LAUNCH(k0_attn, nb((long)S * A_HEADS), TB, st, (const float*)u.P, (const int*)u.sel, (const int*)u.cnt, rel_bias, u.oa, S);
        LAUNCH(k0_gate, nb((long)S * G_KW), TB, st, (const float*)u.P, wg, bg, u.lg, S);
        LAUNCH(k0_gla, (G_HEADS * G_DV + 63) / 64, 64, st, (const float*)u.P, (const float*)u.lg, u.oraw, S);
        LAUNCH(k0_gla_post, nb((long)S * G_HEADS), TB, st, (const float*)u.P, (const float*)u.oraw, ng, u.ob, S);
        LAUNCH(k0_gemm, nb((long)(S / 4) * D_MODEL), TB, st, (const float*)u.oa, A_W, wba, D_MODEL, u.ba, D_MODEL, S, D_MODEL, A_W);
        LAUNCH(k0_gemm, nb((long)(S / 4) * D_MODEL), TB, st, (const float*)u.ob, G_VW, wbb, D_MODEL, u.bb, D_MODEL, S, D_MODEL, G_VW);
        LAUNCH(k0_merge, nb((long)S * D_MODEL), TB, st, (const float*)u.P, (const float*)u.ba, (const float*)u.bb, u.mg, S);
        LAUNCH(k0_gemm, nb((long)(S / 4) * D_MODEL), TB, st, (const float*)u.mg, D_MODEL, wout, D_MODEL, u.y, D_MODEL, S, D_MODEL, D_MODEL);
        LAUNCH(k0_ln1, nb(S), TB, st, xb, (const float*)u.y, gt1, g1, b1, sh2, sc2, u.x1, u.h2, S);
        LAUNCH(k0_gemm, nb((long)(S / 4) * N_GROUPS), TB, st, (const float*)u.h2, D_MODEL, wrg, N_GROUPS, u.rl, 36, S, N_GROUPS, D_MODEL);
        LAUNCH(k0_gemm, nb((long)(S / 4) * N_EXP), TB, st, (const float*)u.h2, D_MODEL, wre, N_EXP, u.rl + 4, 36, S, N_EXP, D_MODEL);
        LAUNCH(k0_route, nb(S), TB, st, (const float*)u.rl, brg, bre, u.eid, u.ew, S);
        LAUNCH(k0_moe_hid, nb((long)S * 2 * D_EXP), TB, st, (const float*)u.h2, (const int*)u.eid, w1, w3, u.hid, S);
        LAUNCH(k0_moe_out, nb((long)S * D_MODEL), TB, st, (const float*)u.hid, (const int*)u.eid, (const float*)u.ew, w2, u.f, S);
        LAUNCH(k0_final, nb(S), TB, st, (const float*)u.x1, (const float*)u.f, gt2, g2, b2, out + (size_t)b * S * D_MODEL, S);
    }
}
namespace pg8 {
#define PG8_LAS __attribute__((address_space(3)))
typedef unsigned short bf16_t;
typedef short bf16x8 __attribute__((ext_vector_type(8)));
typedef float f32x4 __attribute__((ext_vector_type(4)));
typedef unsigned u32x4 __attribute__((ext_vector_type(4)));
constexpr int BM = 256, BK = 64, HALF = 128, HTB = HALF * BK * 2  , STAGE_BYTES = 8 * HTB, NXCD = 8, WGM = 8;

__host__ __device__ __forceinline__ int lds_byte(int r, int c) { const int st = (r >> 4) * 2 + (c >> 5), rr = r & 15, cc = c & 31, ob = rr * 64 + cc * 2; return st * 1024 + (ob ^ (((ob >> 9) & 1) << 5)); }
__host__ __device__ __forceinline__ void stage_rc(int b, int& R, int& C) { const int st = b / 1024, sb = b % 1024, swz = sb ^ (((sb >> 9) & 1) << 5); R = (st >> 1) * 16 + swz / 64; C = (st & 1) * 32 + (swz % 64) / 2; }
__host__ __device__ __forceinline__ int perm32(int rho) { const int n = rho >> 4, i = rho & 15; return 8 * (i >> 2) + 4 * n + (i & 3); }

struct Unit { int pm, pn, pa, pb; };
struct Gemm { const bf16_t* A; const bf16_t* Bt; int M, N, K; };

struct StaticOrder {
    int nM, nN, nwg, G, c;
    __host__ __device__ void init(int M, int N, int G_, int c_) { nM = M / BM; nN = N / BM; nwg = nM * nN; G = G_; c = c_; }
    __host__ __device__ bool next(int i, Unit& u) const {
        const long L = (long)i * G + c; if (L >= nwg) return false;
        int wgid = (int)L; { const int q = nwg / NXCD, r = nwg % NXCD, xcd = wgid % NXCD, off = wgid / NXCD; wgid = (xcd < r ? xcd * (q + 1) : r * (q + 1) + (xcd - r) * q) + off; }
        const int nig = WGM * nN, gid = wgid / nig, fm = gid * WGM, gsz = (nM - fm) < WGM ? (nM - fm) : WGM;
        u.pm = fm + ((wgid % nig) % gsz); u.pn = (wgid % nig) / gsz; u.pa = u.pm; u.pb = u.pn; return true;
    }
    __device__ __forceinline__ void a_ready(const Unit&) const {}
    __device__ __forceinline__ void done(const Unit&) const {}
};

__device__ __forceinline__ unsigned cvt_pk_bf16(float lo, float hi) { unsigned r; asm volatile("v_cvt_pk_bf16_f32 %0, %1, %2" : "=v"(r) : "v"(lo), "v"(hi)); return r; }
typedef float f32x2 __attribute__((ext_vector_type(2)));

template <class Epi, class Sched, bool ALIGN_EPI = false, bool SP2 = false, bool GATHER = false>
__device__ __forceinline__ void gemm_phase(PG8_LAS unsigned char* lds, const Gemm g, const Sched& S, const Epi& E) {
    const int tid = threadIdx.x, wid = __builtin_amdgcn_readfirstlane(tid >> 6), lane = tid & 63, wr = wid >> 2, wc = wid & 3, fr = lane & 15, fq = lane >> 4;
    const int K = g.K, nt = K / BK;
    static_assert(!GATHER || SP2, "gathered A rows: SP2 loop only");
    unsigned voffA[2], voffB[2]; int Rr[2], Cc[2];
#pragma unroll
    for (int i = 0; i < 2; ++i) { int R, C; stage_rc(tid * 16 + i * 8192, R, C); const int Rb = Epi::PERM ? ((R & ~31) + perm32(R & 31)) : R; Rr[i] = R; Cc[i] = C;
        voffA[i] = (unsigned)(R * K + C) * 2u; voffB[i] = (unsigned)(Rb * K + C) * 2u; }
    unsigned vc0[2] = {voffA[0], voffA[1]}, vc1[2] = {voffA[0], voffA[1]}, vn0[2] = {voffA[0], voffA[1]}, vn1[2] = {voffA[0], voffA[1]};
    const size_t kstep = (size_t)(BK * 2);
    const size_t hstep = (size_t)HALF * K * 2;
    const size_t tstep = 2 * hstep;
    const unsigned ldsw = (unsigned)wid * 1024u;
    const int aoff = lds_byte(wr * 64 + fr, fq * 8), boff = lds_byte(wc * 32 + fr, fq * 8);
#define PG8_SA(b, h) (((b) * 2 + (h)) * HTB)
#define PG8_SB(b, h) ((4 + (b) * 2 + (h)) * HTB)
#define PG8_STAGE(bufoff, gbase, voff) do { _Pragma("unroll") for (int _i = 0; _i < 2; ++_i) \
        __builtin_amdgcn_global_load_lds((const unsigned*)((const char*)(gbase) + (voff)[_i]), (PG8_LAS unsigned*)(lds + (bufoff) + ldsw + _i * 8192), 16, 0, 0); } while (0)
#define PG8_LDA(dst, b, h) do { _Pragma("unroll") for (int m = 0; m < 4; ++m) _Pragma("unroll") for (int k = 0; k < 2; ++k) dst[m][k] = *(const PG8_LAS bf16x8*)(lds + PG8_SA(b, h) + aoff + m * 2048 + k * 1024); } while (0)
#define PG8_LDB(dst, b, h) do { _Pragma("unroll") for (int n = 0; n < 2; ++n) _Pragma("unroll") for (int k = 0; k < 2; ++k) dst[n][k] = *(const PG8_LAS bf16x8*)(lds + PG8_SB(b, h) + boff + n * 2048 + k * 1024); } while (0)
#define PG8_MMA(ai, bj, At, Bt) do { __builtin_amdgcn_s_setprio(1); _Pragma("unroll") for (int m = 0; m < 4; ++m) _Pragma("unroll") for (int n = 0; n < 2; ++n) _Pragma("unroll") for (int k = 0; k < 2; ++k) \
        acc[ai][bj][m][n] = __builtin_amdgcn_mfma_f32_16x16x32_bf16(Bt[n][k], At[m][k], acc[ai][bj][m][n], 0, 0, 0); __builtin_amdgcn_s_setprio(0); } while (0)
#define PG8_WAIT_V(n) asm volatile("s_waitcnt vmcnt(" #n ")" ::: "memory")
#define PG8_WAIT_L(n) asm volatile("s_waitcnt lgkmcnt(" #n ")" ::: "memory")
#define PG8_BAR __builtin_amdgcn_s_barrier()
#define PG8_SCHED __builtin_amdgcn_sched_barrier(0)
    Unit cur, nxt; int ui = 0;
    if (!S.next(0, cur)) return;
    f32x4 acc[2][2][4][2];
#pragma unroll
    for (int a = 0; a < 2; ++a)
#pragma unroll
        for (int b = 0; b < 2; ++b)
#pragma unroll
            for (int m = 0; m < 4; ++m)
#pragma unroll
                for (int n = 0; n < 2; ++n) acc[a][b][m][n] = (f32x4){0.f, 0.f, 0.f, 0.f};
    bf16x8 At[4][2], B0[2][2], B1[2][2];
    const char* cA = GATHER ? (const char*)g.A : (const char*)g.A + (size_t)cur.pa * tstep; const char* cB = (const char*)g.Bt + (size_t)cur.pb * tstep;
    const size_t hstepA = GATHER ? 0 : hstep;
    if constexpr (GATHER) {
#pragma unroll
        for (int i = 0; i < 2; ++i) { vc0[i] = (unsigned)S.a_row(cur, Rr[i]) * (unsigned)(K * 2) + (unsigned)(Cc[i] * 2); vc1[i] = (unsigned)S.a_row(cur, HALF + Rr[i]) * (unsigned)(K * 2) + (unsigned)(Cc[i] * 2); } }
    S.a_ready(cur);
    if constexpr (SP2) {
        PG8_STAGE(PG8_SB(0, 0), cB, voffB); PG8_STAGE(PG8_SB(0, 1), cB + hstep, voffB); PG8_STAGE(PG8_SA(0, 0), cA, vc0); PG8_STAGE(PG8_SA(0, 1), cA + hstepA, vc1);
        if (wr == 1) PG8_BAR;
        PG8_WAIT_V(2); PG8_BAR;
        PG8_STAGE(PG8_SB(1, 0), cB + kstep, voffB); PG8_STAGE(PG8_SA(1, 0), cA + kstep, vc0); PG8_STAGE(PG8_SB(1, 1), cB + hstep + kstep, voffB);
        PG8_WAIT_V(6); PG8_BAR;
    } else {
        PG8_STAGE(PG8_SB(0, 0), cB, voffB); PG8_STAGE(PG8_SA(0, 0), cA, voffA); PG8_STAGE(PG8_SB(0, 1), cB + hstep, voffB); PG8_STAGE(PG8_SA(0, 1), cA + hstep, voffA);
        if (wr == 1) PG8_BAR;
        PG8_WAIT_V(4); PG8_BAR;
        PG8_STAGE(PG8_SB(1, 0), cB + kstep, voffB); PG8_STAGE(PG8_SA(1, 0), cA + kstep, voffA); PG8_STAGE(PG8_SB(1, 1), cB + hstep + kstep, voffB);
        PG8_WAIT_V(6); PG8_BAR;
    }
    for (;;) {
        const bool has_next = S.next(ui + 1, nxt);
        const char* nA = GATHER ? cA : (has_next ? (const char*)g.A + (size_t)nxt.pa * tstep : cA); const char* nB = has_next ? (const char*)g.Bt + (size_t)nxt.pb * tstep : cB;
        if constexpr (GATHER) {
#pragma unroll
            for (int i = 0; i < 2; ++i) { vn0[i] = has_next ? (unsigned)S.a_row(nxt, Rr[i]) * (unsigned)(K * 2) + (unsigned)(Cc[i] * 2) : vc0[i]; vn1[i] = has_next ? (unsigned)S.a_row(nxt, HALF + Rr[i]) * (unsigned)(K * 2) + (unsigned)(Cc[i] * 2) : vc1[i]; } }
        for (int t = 0; t < nt; t += 2) {
            const bool last = (t == nt - 2);
            if constexpr (Epi::MID) { if (t == nt / 2) E.mid(acc, cur, wr, wc, fr, fq); }
            const char* a1 = cA + (size_t)(t + 1) * kstep;
            const char* a2 = last ? nA : cA + (size_t)(t + 2) * kstep; const char* b2 = last ? nB : cB + (size_t)(t + 2) * kstep;
            const char* a3 = a2 + kstep; const char* b3 = b2 + kstep;
            if (last && has_next) S.a_ready(nxt);
            if constexpr (SP2) {
            unsigned w0[2], w1[2];
#pragma unroll
            for (int i = 0; i < 2; ++i) { w0[i] = last ? vn0[i] : vc0[i]; w1[i] = last ? vn1[i] : vc1[i]; }
            PG8_LDB(B0, 0, 0); PG8_LDB(B1, 0, 1); PG8_SCHED; PG8_LDA(At, 0, 0); PG8_STAGE(PG8_SA(1, 1), a1 + hstepA, vc1);
            PG8_WAIT_V(8); PG8_WAIT_L(0); PG8_BAR; PG8_MMA(0, 0, At, B0); PG8_MMA(0, 1, At, B1); PG8_BAR; PG8_SCHED;
            PG8_LDA(At, 0, 1); PG8_STAGE(PG8_SB(0, 0), b2, voffB); PG8_STAGE(PG8_SB(0, 1), b2 + hstep, voffB); PG8_STAGE(PG8_SA(0, 0), a2, w0);
            PG8_WAIT_V(8); PG8_WAIT_L(0); PG8_BAR; PG8_MMA(1, 0, At, B0); PG8_MMA(1, 1, At, B1); PG8_BAR; PG8_SCHED;
            PG8_LDB(B0, 1, 0); PG8_LDB(B1, 1, 1); PG8_SCHED; PG8_LDA(At, 1, 0); PG8_STAGE(PG8_SA(0, 1), a2 + hstepA, w1);
            PG8_WAIT_V(8); PG8_WAIT_L(0); PG8_BAR; PG8_MMA(0, 0, At, B0); PG8_MMA(0, 1, At, B1); PG8_BAR; PG8_SCHED;
            PG8_LDA(At, 1, 1); PG8_STAGE(PG8_SB(1, 0), b3, voffB); PG8_STAGE(PG8_SB(1, 1), b3 + hstep, voffB); PG8_STAGE(PG8_SA(1, 0), a3, w0);
            PG8_WAIT_V(8); PG8_WAIT_L(0); PG8_BAR; PG8_MMA(1, 0, At, B0); PG8_MMA(1, 1, At, B1); PG8_BAR; PG8_SCHED;
            } else {
            PG8_LDB(B0, 0, 0); PG8_SCHED; PG8_LDA(At, 0, 0); PG8_STAGE(PG8_SA(1, 1), a1 + hstep, voffA);
            PG8_WAIT_L(8); PG8_BAR; PG8_WAIT_L(0); PG8_MMA(0, 0, At, B0); PG8_BAR; PG8_SCHED;
            PG8_LDB(B1, 0, 1); PG8_STAGE(PG8_SB(0, 0), b2, voffB);
            PG8_BAR; PG8_WAIT_L(0); PG8_MMA(0, 1, At, B1); PG8_BAR;
            PG8_LDA(At, 0, 1); PG8_STAGE(PG8_SA(0, 0), a2, voffA);
            PG8_BAR; PG8_WAIT_L(0); PG8_MMA(1, 0, At, B0); PG8_BAR; PG8_SCHED;
            PG8_STAGE(PG8_SB(0, 1), b2 + hstep, voffB);
            PG8_WAIT_V(6); PG8_BAR; PG8_MMA(1, 1, At, B1); PG8_BAR;
            PG8_LDB(B0, 1, 0); PG8_SCHED; PG8_LDA(At, 1, 0); PG8_STAGE(PG8_SA(0, 1), a2 + hstep, voffA);
            PG8_WAIT_L(8); PG8_BAR; PG8_WAIT_L(0); PG8_MMA(0, 0, At, B0); PG8_BAR; PG8_SCHED;
            PG8_LDB(B1, 1, 1); PG8_STAGE(PG8_SB(1, 0), b3, voffB);
            PG8_BAR; PG8_WAIT_L(0); PG8_MMA(0, 1, At, B1); PG8_BAR;
            PG8_LDA(At, 1, 1); PG8_STAGE(PG8_SA(1, 0), a3, voffA);
            PG8_BAR; PG8_WAIT_L(0); PG8_MMA(1, 0, At, B0); PG8_BAR; PG8_SCHED;
            PG8_STAGE(PG8_SB(1, 1), b3 + hstep, voffB);
            PG8_WAIT_V(6); PG8_BAR; PG8_MMA(1, 1, At, B1); PG8_BAR;
            }
        }
        if constexpr (ALIGN_EPI) { if (wr == 0) PG8_BAR; }
        if constexpr (!Epi::AFTER_DRAIN) { E(acc, cur, wr, wc, fr, fq); S.done(cur); }
        if (!has_next) break;
#pragma unroll
        for (int a = 0; a < 2; ++a)
#pragma unroll
            for (int b = 0; b < 2; ++b)
#pragma unroll
                for (int m = 0; m < 4; ++m)
#pragma unroll
                    for (int n = 0; n < 2; ++n) acc[a][b][m][n] = (f32x4){0.f, 0.f, 0.f, 0.f};
        cur = nxt; cA = nA; cB = nB; ++ui;
        if constexpr (GATHER) { vc0[0] = vn0[0]; vc0[1] = vn0[1]; vc1[0] = vn1[0]; vc1[1] = vn1[1]; }
        if constexpr (ALIGN_EPI) { if (wr == 1) PG8_BAR; }
    }
    PG8_WAIT_V(0);
    if constexpr (!ALIGN_EPI) { if (wr == 0) PG8_BAR; }
    PG8_BAR;
    if constexpr (Epi::AFTER_DRAIN) { E.fused(acc, cur, wr, wc, fr, fq, lds, wid, lane); S.done(cur); }
#undef PG8_SA
#undef PG8_SB
#undef PG8_STAGE
#undef PG8_LDA
#undef PG8_LDB
#undef PG8_MMA
#undef PG8_WAIT_V
#undef PG8_WAIT_L
#undef PG8_BAR
#undef PG8_SCHED
}
}

#ifndef PG8_SP2
#define PG8_SP2 true
#endif
#ifndef PG8_ALIGN
#define PG8_ALIGN true
#endif
#ifndef DUPSUB
#define DUPSUB 0
#endif
#ifndef TSTAMP
#define TSTAMP 0
#endif
#ifndef USE_CG_SYNC
#define USE_CG_SYNC 0
#endif
#ifndef DUPMASK
#define DUPMASK 0
#define DUPMASK_ON 0
#else
#define DUPMASK_ON 1
#endif
namespace cg = cooperative_groups;
namespace fk {
using pg8::bf16_t; using pg8::f32x4; using pg8::u32x4; using pg8::bf16x8; using pg8::Unit; using pg8::cvt_pk_bf16;
#define LAS __attribute__((address_space(3)))
#define LDS_WAIT() asm volatile("s_waitcnt lgkmcnt(0)" ::: "memory")
typedef unsigned u32x2 __attribute__((ext_vector_type(2)));
constexpr int NB = 8, NS = 4096, NT = NB * NS;
constexpr int NTHREADS = 512, NWAVES = 8, LDS_BYTES = 155648;
constexpr size_t MiB = (size_t)1 << 20;
constexpr size_t WS_ADA = 0, WS_CNT = 256 * 1024,
    WS_WIN = 1 * MiB, WS_WGAB = 9 * MiB, WS_WBA = 13 * MiB, WS_WBB = 14 * MiB, WS_WOUT = 15 * MiB, WS_W13 = 17 * MiB, WS_W2 = 49 * MiB,
    WS_XN = 65 * MiB, WS_QKV = 129 * MiB, WS_IQ = 225 * MiB, WS_GQK = 257 * MiB, WS_GV = 289 * MiB, WS_GR = 321 * MiB,
    WS_IK = 353 * MiB, WS_IW = 355 * MiB, WS_GLR = 357 * MiB, WS_SC = 358 * MiB, WS_MASK = 490 * MiB, WS_ADAP = 506 * MiB, WS_MISC = 509 * MiB;
constexpr int NPROJ = 3584;
constexpr size_t WS_WGT = 400 * 1024;
constexpr int KSL = 16;
constexpr float QSCALE = 0.125f * 1.4426950408889634f;
typedef float f32x2_t __attribute__((ext_vector_type(2))); typedef __bf16 bf16x2_t __attribute__((ext_vector_type(2)));
__device__ __forceinline__ unsigned cvtpk_s(float lo, float hi) { f32x2_t v = {lo, hi}; bf16x2_t b = __builtin_convertvector(v, bf16x2_t); return __builtin_bit_cast(unsigned, b); }
__device__ __forceinline__ void bf8_to_f(const u32x4 w, float* f) {
#pragma unroll
    for (int j = 0; j < 4; ++j) { f[2 * j] = __uint_as_float(w[j] << 16); f[2 * j + 1] = __uint_as_float(w[j] & 0xffff0000u); }
}

__device__ __forceinline__ void tr_item(const float* W, int ldw, int srccol, bf16_t* WT, int K, int dst_row0, int kb, LAS float* scr, int lane, int kdst0 = 0) {
    const int k0 = 64 * kb;
#pragma unroll
    for (int i = 0; i < 32; ++i) { const int kk = 2 * i + (lane >> 5); scr[kk * 33 + (lane & 31)] = W[(size_t)(k0 + kk) * ldw + srccol]; }
    LDS_WAIT();
    const int c = lane & 7;
#pragma unroll
    for (int j = 0; j < 4; ++j) { const int n = (lane >> 3) + 8 * j; const LAS float* s = scr + (8 * c) * 33 + n;
        u32x4 o; o.x = cvt_pk_bf16(s[0 * 33], s[1 * 33]); o.y = cvt_pk_bf16(s[2 * 33], s[3 * 33]); o.z = cvt_pk_bf16(s[4 * 33], s[5 * 33]); o.w = cvt_pk_bf16(s[6 * 33], s[7 * 33]);
        *(u32x4*)(WT + (size_t)(dst_row0 + n) * K + kdst0 + k0 + 8 * c) = o; }
    LDS_WAIT();
}
__device__ __forceinline__ int win_src(int n) {
    if (n < 2048) return n;
    if (n < 3584) return n + 48;
    if (n < 3616) return O_IK + (n - 3584);
    if (n < 3632) return O_IW + (n - 3616);
    return O_GLR + (n - 3632);
}
constexpr int I_ADA = 96 * KSL, I_WIN = 114 * 16, I_WGAB = 64 * 16, I_WB = 32 * 8, I_WOUT = 32 * 16, I_W13 = 32 * 16 * 16, I_W2 = 32 * 32 * 4;
constexpr int P0_ITEMS = I_ADA + I_WIN + I_WGAB + 2 * I_WB + I_WOUT + I_W13 + I_W2, P0_EARLY = I_ADA + I_WIN + I_WGAB + 2 * I_WB + I_WOUT;
__device__ __forceinline__ void p0_item(int it, const float* const* in, unsigned char* ws, LAS float* scr, int lane) {
    if (it < I_ADA) {
        const int cb = it / KSL, ks = it % KSL, k0 = ks * 64; const float* c = in[1]; const float* w = in[3];
#pragma unroll
        for (int b = 0; b < NB; ++b) { const float cv = c[b * D_MODEL + k0 + lane]; scr[b * 64 + lane] = cv / (1.f + __expf(-cv)); }
        LDS_WAIT();
        float acc[NB];
#pragma unroll
        for (int b = 0; b < NB; ++b) acc[b] = 0.f;
        const int col = cb * 64 + lane;
#pragma unroll 16
        for (int kk = 0; kk < 64; ++kk) { const float wv = w[(size_t)(k0 + kk) * (6 * D_MODEL) + col];
#pragma unroll
            for (int b = 0; b < NB; ++b) acc[b] += scr[b * 64 + kk] * wv; }
        float* adap = (float*)(ws + WS_ADAP);
#pragma unroll
        for (int b = 0; b < NB; ++b) adap[(size_t)(ks * NB + b) * (6 * D_MODEL) + col] = acc[b];
        LDS_WAIT(); return;
    }
    it -= I_ADA;
    const int l31 = lane & 31;
    if (it < I_WIN) { const int nb = it / 16, kb = it % 16; tr_item(in[5], D_IN, win_src(nb * 32 + l31), (bf16_t*)(ws + WS_WIN), 1024, nb * 32, kb, scr, lane); return; }
    it -= I_WIN;
    if (it < I_WGAB) { const int nb = it / 16, kb = it % 16; tr_item(in[5], D_IN, O_GA + nb * 32 + l31, (bf16_t*)(ws + WS_WGAB), 1024, nb * 32, kb, scr, lane); return; }
    it -= I_WGAB;
    if (it < I_WB) { const int nb = it / 8, kb = it % 8; tr_item(in[9], D_MODEL, nb * 32 + l31, (bf16_t*)(ws + WS_WBA), 1024, nb * 32, kb, scr, lane, 0); return; }
    it -= I_WB;
    if (it < I_WB) { const int nb = it / 8, kb = it % 8; tr_item(in[10], D_MODEL, nb * 32 + l31, (bf16_t*)(ws + WS_WBA), 1024, nb * 32, kb, scr, lane, 512); return; }
    it -= I_WB;
    if (it < I_WOUT) { const int nb = it / 16, kb = it % 16; tr_item(in[11], D_MODEL, nb * 32 + l31, (bf16_t*)(ws + WS_WOUT), 1024, nb * 32, kb, scr, lane); return; }
    it -= I_WOUT;
    if (it < I_W13) {
        const int e = it / 256, r = it % 256, nb = r / 16, kb = r % 16; const int row0 = nb * 32;
        const int half = (row0 & 255) >> 7; const int col = (row0 >> 8) * 128 + (row0 & 127) + l31;
        const float* src = (half ? in[19] : in[18]) + (size_t)e * D_MODEL * D_EXP;
        tr_item(src, D_EXP, col, (bf16_t*)(ws + WS_W13) + (size_t)e * 512 * 1024, 1024, row0, kb, scr, lane); return; }
    it -= I_W13;
    { const int e = it / 128, r = it % 128, nb = r / 4, kb = r % 4;
      tr_item(in[20] + (size_t)e * D_EXP * D_MODEL, D_MODEL, nb * 32 + l31, (bf16_t*)(ws + WS_W2) + (size_t)e * 1024 * 256, 256, nb * 32, kb, scr, lane); }
}

__device__ __forceinline__ float dpp_row_sum_f(float v) {
    v += __int_as_float(__builtin_amdgcn_update_dpp(0, __float_as_int(v), 0xB1, 0xF, 0xF, true));
    v += __int_as_float(__builtin_amdgcn_update_dpp(0, __float_as_int(v), 0x4E, 0xF, 0xF, true));
    v += __int_as_float(__builtin_amdgcn_update_dpp(0, __float_as_int(v), 0x141, 0xF, 0xF, true));
    v += __int_as_float(__builtin_amdgcn_update_dpp(0, __float_as_int(v), 0x140, 0xF, 0xF, true));
    return v;
}
__device__ __forceinline__ float wave_sum_u(float v) {
    v = dpp_row_sum_f(v);
    return (__int_as_float(__builtin_amdgcn_readlane(__float_as_int(v), 0)) + __int_as_float(__builtin_amdgcn_readlane(__float_as_int(v), 16)))
         + (__int_as_float(__builtin_amdgcn_readlane(__float_as_int(v), 32)) + __int_as_float(__builtin_amdgcn_readlane(__float_as_int(v), 48)));
}
template <int R> __device__ __forceinline__ void ln_center(f32x4 (&v)[R][4], float (&rstd)[R], float* meanout = nullptr) {
    float s[R];
#pragma unroll
    for (int r = 0; r < R; ++r) { s[r] = 0.f;
#pragma unroll
        for (int j = 0; j < 4; ++j) s[r] += (v[r][j].x + v[r][j].y) + (v[r][j].z + v[r][j].w); }
#pragma unroll
    for (int r = 0; r < R; ++r) s[r] = dpp_row_sum_f(s[r]);
    float q[R];
#pragma unroll
    for (int r = 0; r < R; ++r) { const float mean = ((__int_as_float(__builtin_amdgcn_readlane(__float_as_int(s[r]), 0)) + __int_as_float(__builtin_amdgcn_readlane(__float_as_int(s[r]), 16)))
                                                   + (__int_as_float(__builtin_amdgcn_readlane(__float_as_int(s[r]), 32)) + __int_as_float(__builtin_amdgcn_readlane(__float_as_int(s[r]), 48)))) * (1.f / D_MODEL);
        if (meanout) meanout[r] = mean;
        q[r] = 0.f;
#pragma unroll
        for (int j = 0; j < 4; ++j) { v[r][j] = v[r][j] - mean; q[r] += (v[r][j].x * v[r][j].x + v[r][j].y * v[r][j].y) + (v[r][j].z * v[r][j].z + v[r][j].w * v[r][j].w); } }
#pragma unroll
    for (int r = 0; r < R; ++r) q[r] = dpp_row_sum_f(q[r]);
#pragma unroll
    for (int r = 0; r < R; ++r) { const float var = ((__int_as_float(__builtin_amdgcn_readlane(__float_as_int(q[r]), 0)) + __int_as_float(__builtin_amdgcn_readlane(__float_as_int(q[r]), 16)))
                                                  + (__int_as_float(__builtin_amdgcn_readlane(__float_as_int(q[r]), 32)) + __int_as_float(__builtin_amdgcn_readlane(__float_as_int(q[r]), 48)))) * (1.f / D_MODEL);
        rstd[r] = 1.f / sqrtf(var + LN_EPS); }
}
__device__ __forceinline__ float wave_sum(float v) {
#pragma unroll
    for (int o = 1; o < 64; o <<= 1) v += __shfl_xor(v, o);
    return v;
}
__device__ __forceinline__ float ada_sum(const float* adap, const float* b_ada, int b, int j) {
    float s = b_ada[j];
#pragma unroll
    for (int k = 0; k < KSL; ++k) s += adap[(size_t)(k * NB + b) * (6 * D_MODEL) + j];
    return s;
}
__device__ __forceinline__ void p1_phase(const float* const* in, unsigned char* ws, LAS unsigned char* lds, int G) {
    const int tid = threadIdx.x, lane = tid & 63, wave = tid >> 6;
    const float* adap = (const float*)(ws + WS_ADAP); const float* b_ada = in[4]; const float* x = in[0];
    LAS float* sh = (LAS float*)lds; LAS float* sc = sh + D_MODEL;
    for (int blk = blockIdx.x; blk < NT / 128; blk += G) {
        const int b = blk / 32;
        __syncthreads();
        for (int j = tid; j < 2 * D_MODEL; j += NTHREADS) sh[j] = ada_sum(adap, b_ada, b, j);
        if ((blk & 31) == 0) { float* ada = (float*)(ws + WS_ADA) + (size_t)b * 6 * D_MODEL; for (int j = tid; j < 6 * D_MODEL; j += NTHREADS) ada[j] = ada_sum(adap, b_ada, b, j); }
        __syncthreads();
        for (int rb = 0; rb < 16; rb += 4) {
            const size_t row0 = (size_t)blk * 128 + wave * 16 + rb;
            f32x4 v[4][4];
#pragma unroll
            for (int r = 0; r < 4; ++r) { const f32x4* xr = (const f32x4*)(x + (row0 + r) * D_MODEL) + lane;
#pragma unroll
                for (int j = 0; j < 4; ++j) v[r][j] = xr[64 * j]; }
            float rstd[4]; ln_center<4>(v, rstd);
#pragma unroll
            for (int j = 0; j < 4; ++j) { const f32x4 a = *(const LAS f32x4*)(sc + 256 * j + 4 * lane) + 1.f, c = *(const LAS f32x4*)(sh + 256 * j + 4 * lane);
#pragma unroll
                for (int r = 0; r < 4; ++r) { const f32x4 y = v[r][j] * rstd[r] * a + c; u32x2 w; w.x = cvtpk_s(y.x, y.y); w.y = cvtpk_s(y.z, y.w);
                    ((u32x2*)((bf16_t*)(ws + WS_XN) + (row0 + r) * D_MODEL) + lane)[64 * j] = w; } }
        }
        asm volatile("s_waitcnt vmcnt(0)" ::: "memory"); __syncthreads();
        {   LAS unsigned char* W64 = lds + 8192; constexpr int WP = 2064;
            const bf16_t* wsrc = (const bf16_t*)(ws + WS_WIN) + (size_t)3584 * 1024;
            for (int i = tid; i < 64 * 128; i += NTHREADS) { const int n = i >> 7, c = i & 127; *(LAS u32x4*)(W64 + n * WP + c * 16) = *(const u32x4*)(wsrc + (size_t)n * 1024 + c * 8); }
            __syncthreads();
            const int fr = lane & 15, fq = lane >> 4; const size_t rowA = (size_t)blk * 128 + wave * 16 + fr;
            const bf16_t* xp = (const bf16_t*)(ws + WS_XN) + rowA * D_MODEL + 8 * fq;
            f32x4 acc[4];
#pragma unroll
            for (int nt = 0; nt < 4; ++nt) acc[nt] = (f32x4){0.f, 0.f, 0.f, 0.f};
#pragma unroll 8
            for (int ks = 0; ks < 32; ++ks) { const bf16x8 bfr = *(const bf16x8*)(xp + 32 * ks);
#pragma unroll
                for (int nt = 0; nt < 4; ++nt) { const bf16x8 afr = *(const LAS bf16x8*)(W64 + (16 * nt + fr) * WP + (32 * ks + 8 * fq) * 2); acc[nt] = __builtin_amdgcn_mfma_f32_16x16x32_bf16(afr, bfr, acc[nt], 0, 0, 0); } }
            { u32x2 w; w.x = cvtpk_s(acc[0][0], acc[0][1]); w.y = cvtpk_s(acc[0][2], acc[0][3]); *(u32x2*)((bf16_t*)(ws + WS_IK) + rowA * 32 + 4 * fq) = w;
              w.x = cvtpk_s(acc[1][0], acc[1][1]); w.y = cvtpk_s(acc[1][2], acc[1][3]); *(u32x2*)((bf16_t*)(ws + WS_IK) + rowA * 32 + 16 + 4 * fq) = w;
              *(f32x4*)((float*)(ws + WS_IW) + rowA * 16 + 4 * fq) = acc[2];
              w.x = cvtpk_s(acc[3][0], acc[3][1]); w.y = cvtpk_s(acc[3][2], acc[3][3]); *(u32x2*)((bf16_t*)(ws + WS_GLR) + rowA * 16 + 4 * fq) = w; }
        }
    }
}

struct EpiProj {
    static constexpr bool PERM = true, AFTER_DRAIN = false, MID = false;
    unsigned char* ws;
    __device__ __forceinline__ void operator()(const f32x4 (&acc)[2][2][4][2], const Unit& u, int wr, int wc, int fr, int fq) const {
        const int row0 = u.pm * 256 + wr * 64 + fr; const int pn = u.pn;
        {
            bf16_t* base; int ld, ct; float sc = 1.f;
            if (pn < 6) { base = (bf16_t*)(ws + WS_QKV); ld = 1536; ct = pn * 256; if (pn < 2) sc = QSCALE; }
            else if (pn < 8) { base = (bf16_t*)(ws + WS_IQ); ld = 512; ct = (pn - 6) * 256; }
            else if (pn < 10) { base = (bf16_t*)(ws + WS_GQK); ld = 512; ct = (pn - 8) * 256; }
            else if (pn < 12) { base = (bf16_t*)(ws + WS_GV); ld = 512; ct = (pn - 10) * 256; }
            else { base = (bf16_t*)(ws + WS_GR); ld = 512; ct = (pn - 12) * 256; }
            const int col0 = ct + wc * 32 + 8 * fq;
#pragma unroll
            for (int ai = 0; ai < 2; ++ai)
#pragma unroll
                for (int m = 0; m < 4; ++m) { bf16_t* rowp = base + (size_t)(row0 + ai * 128 + m * 16) * ld + col0;
#pragma unroll
                    for (int bj = 0; bj < 2; ++bj) { const f32x4 v0 = acc[ai][bj][m][0] * sc, v1 = acc[ai][bj][m][1] * sc;
                        u32x4 w; w.x = cvt_pk_bf16(v0[0], v0[1]); w.y = cvt_pk_bf16(v0[2], v0[3]); w.z = cvt_pk_bf16(v1[0], v1[1]); w.w = cvt_pk_bf16(v1[2], v1[3]);
                        *(u32x4*)(rowp + bj * 128) = w; } }
        }
    }
};

typedef float f32x4_t __attribute__((ext_vector_type(4)));
constexpr int SC_TILES_PER_B = 528, SC_ITEMS = NB * SC_TILES_PER_B;
__device__ __forceinline__ size_t keys_row_dw(int b, int t) {
    const int qi = t >> 7, r = t & 127; return (size_t)b * (SC_TILES_PER_B * 8192) + (size_t)8192 * (qi * (qi + 1) / 2) + (size_t)r * (qi + 1) * 64;
}
__device__ __forceinline__ unsigned score_key(float sc) {
    const _Float16 hf = (_Float16)sc; const unsigned short hb = __builtin_bit_cast(unsigned short, hf);
    return (hb & 0x8000u) ? (unsigned)(unsigned short)~hb : (unsigned)(hb | 0x8000u);
}
__device__ __forceinline__ void fma_abs4(f32x4& acc, const f32x4& d, float w) {
    float a0 = acc[0], a1 = acc[1], a2 = acc[2], a3 = acc[3];
    asm volatile("v_fma_f32 %0, |%4|, %8, %0\n\tv_fma_f32 %1, |%5|, %8, %1\n\tv_fma_f32 %2, |%6|, %8, %2\n\tv_fma_f32 %3, |%7|, %8, %3"
                 : "+v"(a0), "+v"(a1), "+v"(a2), "+v"(a3) : "v"(d[0]), "v"(d[1]), "v"(d[2]), "v"(d[3]), "v"(w));
    acc[0] = a0; acc[1] = a1; acc[2] = a2; acc[3] = a3;
}
constexpr int SC_SEGS_PER_B = 144, SC_SEGS = NB * SC_SEGS_PER_B;
__device__ __forceinline__ unsigned score_key2(float lo, float hi) {
    typedef _Float16 h2 __attribute__((ext_vector_type(2)));
    const unsigned x = __builtin_bit_cast(unsigned, __builtin_amdgcn_cvt_pkrtz(lo, hi));
    unsigned m; asm("v_pk_ashrrev_i16 %0, %2, %1" : "=v"(m) : "v"(x), "v"(0x000F000Fu));
    return x ^ (m | 0x80008000u);
}
__device__ __forceinline__ void p3a_run(int b, int qi, int kj0, int kj1, unsigned char* ws, LAS unsigned char* ldsw, int wave, int lane) {
    const int fr = lane & 15, fq = lane >> 4;
    const int t = qi * 128 + wave * 16 + fr; const size_t trow = (size_t)b * NS + t;
    const bf16_t* IQ = (const bf16_t*)(ws + WS_IQ) + trow * 512 + 8 * fq;
    const bf16_t* IK = (const bf16_t*)(ws + WS_IK) + ((size_t)b * NS + fr) * 32 + 8 * fq;
    const float* IW = (const float*)(ws + WS_IW) + trow * 16;
    LAS unsigned char* QL = ldsw; LAS float* WL = (LAS float*)(ldsw + 16384);
    bf16x8 kf[8];
#pragma unroll
    for (int kb = 0; kb < 8; ++kb) kf[kb] = *(const bf16x8*)(IK + ((size_t)kj0 * 128 + kb * 16) * 32);
    float qb[8];
#pragma unroll
    for (int j = 0; j < 8; ++j) qb[j] = 0.f;
#pragma unroll
    for (int hg = 0; hg < 4; ++hg) {
        const f32x4 w4 = *(const f32x4*)(IW + 4 * hg) * (0.5f * 0.044194173824159216f);
        u32x4 q4[4];
#pragma unroll
        for (int i = 0; i < 4; ++i) q4[i] = *(const u32x4*)(IQ + (4 * hg + i) * 32);
#pragma unroll
        for (int i = 0; i < 4; ++i) { *(LAS u32x4*)(QL + (4 * hg + i) * 1024 + lane * 16) = q4[i]; if (fq == 0) WL[(4 * hg + i) * 16 + fr] = w4[i]; float f[8]; bf8_to_f(q4[i], f);
#pragma unroll
            for (int j = 0; j < 8; ++j) qb[j] += w4[i] * f[j]; }
    }
    u32x4 qbw; qbw.x = cvtpk_s(qb[0], qb[1]); qbw.y = cvtpk_s(qb[2], qb[3]); qbw.z = cvtpk_s(qb[4], qb[5]); qbw.w = cvtpk_s(qb[6], qb[7]);
    const bf16x8 qbar = __builtin_bit_cast(bf16x8, qbw);
    LDS_WAIT();
    for (int kj = kj0; kj <= kj1; ++kj) {
        bf16x8 kn[8];
        const int kjn = (kj < kj1) ? kj + 1 : kj;
#pragma unroll
        for (int kb = 0; kb < 8; ++kb) kn[kb] = *(const bf16x8*)(IK + ((size_t)kjn * 128 + kb * 16) * 32);
        f32x4 acc[8];
#pragma unroll
        for (int kb = 0; kb < 8; ++kb) acc[kb] = __builtin_amdgcn_mfma_f32_16x16x32_bf16(kf[kb], qbar, (f32x4){0.f, 0.f, 0.f, 0.f}, 0, 0, 0);
        f32x4 dA[8], dB[8];
        { const bf16x8 qf = *(const LAS bf16x8*)(QL + lane * 16);
#pragma unroll
          for (int kb = 0; kb < 8; ++kb) dA[kb] = __builtin_amdgcn_mfma_f32_16x16x32_bf16(kf[kb], qf, (f32x4){0.f, 0.f, 0.f, 0.f}, 0, 0, 0); }
#pragma unroll 1
        for (int h = 0; h < I_HEADS; h += 2) {
            { const bf16x8 qf = *(const LAS bf16x8*)(QL + (h + 1) * 1024 + lane * 16);
#pragma unroll
              for (int kb = 0; kb < 8; ++kb) dB[kb] = __builtin_amdgcn_mfma_f32_16x16x32_bf16(kf[kb], qf, (f32x4){0.f, 0.f, 0.f, 0.f}, 0, 0, 0); }
            __builtin_amdgcn_sched_barrier(0);
            { const float w = WL[h * 16 + fr];
#pragma unroll
              for (int kb = 0; kb < 8; ++kb) fma_abs4(acc[kb], dA[kb], w); }
            __builtin_amdgcn_sched_barrier(0);
            { const int hn = (h + 2 < I_HEADS) ? h + 2 : h; const bf16x8 qf = *(const LAS bf16x8*)(QL + hn * 1024 + lane * 16);
#pragma unroll
              for (int kb = 0; kb < 8; ++kb) dA[kb] = __builtin_amdgcn_mfma_f32_16x16x32_bf16(kf[kb], qf, (f32x4){0.f, 0.f, 0.f, 0.f}, 0, 0, 0); }
            __builtin_amdgcn_sched_barrier(0);
            { const float w = WL[(h + 1) * 16 + fr];
#pragma unroll
              for (int kb = 0; kb < 8; ++kb) fma_abs4(acc[kb], dB[kb], w); }
            __builtin_amdgcn_sched_barrier(0);
        }
        unsigned* KEYS = (unsigned*)(ws + WS_SC) + keys_row_dw(b, t) + (size_t)kj * 64;
        const bool diag = (kj == qi);
#pragma unroll
        for (int kb = 0; kb < 4; ++kb) { u32x4 o;
#pragma unroll
            for (int r = 0; r < 4; ++r) o[r] = score_key2(acc[kb][r], acc[kb + 4][r]);
            if (diag) { asm volatile("" ::: "memory");
#pragma unroll
                for (int r = 0; r < 4; ++r) { const int sl = kb * 16 + 4 * fq + r, tl = wave * 16 + fr; if (sl > tl) o[r] &= 0xFFFF0000u; if (sl + 64 > tl) o[r] &= 0x0000FFFFu; } }
            *(u32x4*)(KEYS + kb * 16 + 4 * fq) = o; }
#pragma unroll
        for (int kb = 0; kb < 8; ++kb) kf[kb] = kn[kb];
    }
    LDS_WAIT();
}

__device__ __forceinline__ int dpp_row_sum(int v) {
    v += __builtin_amdgcn_update_dpp(0, v, 0xB1, 0xF, 0xF, true);
    v += __builtin_amdgcn_update_dpp(0, v, 0x4E, 0xF, 0xF, true);
    v += __builtin_amdgcn_update_dpp(0, v, 0x141, 0xF, 0xF, true);
    v += __builtin_amdgcn_update_dpp(0, v, 0x140, 0xF, 0xF, true);
    return v;
}
__device__ __forceinline__ int wave_sum_i(int v) {
    v = dpp_row_sum(v);
    return __builtin_amdgcn_readlane(v, 0) + __builtin_amdgcn_readlane(v, 16) + __builtin_amdgcn_readlane(v, 32) + __builtin_amdgcn_readlane(v, 48);
}
__device__ __forceinline__ void pk_ge_count4(unsigned x0, unsigned x1, unsigned x2, unsigned x3, unsigned c2m1, unsigned one2, unsigned& c0, unsigned& c1, unsigned& c2, unsigned& c3) {
    unsigned d0, d1, d2, d3;
    asm volatile("v_pk_sub_u16 %0, %8, %12 clamp\n\tv_pk_sub_u16 %1, %9, %12 clamp\n\tv_pk_sub_u16 %2, %10, %12 clamp\n\tv_pk_sub_u16 %3, %11, %12 clamp\n\t"
                 "v_pk_min_u16 %0, %0, %13\n\tv_pk_min_u16 %1, %1, %13\n\tv_pk_min_u16 %2, %2, %13\n\tv_pk_min_u16 %3, %3, %13\n\t"
                 "v_pk_add_u16 %4, %4, %0\n\tv_pk_add_u16 %5, %5, %1\n\tv_pk_add_u16 %6, %6, %2\n\tv_pk_add_u16 %7, %7, %3"
                 : "=&v"(d0), "=&v"(d1), "=&v"(d2), "=&v"(d3), "+v"(c0), "+v"(c1), "+v"(c2), "+v"(c3) : "v"(x0), "v"(x1), "v"(x2), "v"(x3), "v"(c2m1), "v"(one2));
}
constexpr int TOPK = 256;
__device__ __forceinline__ int count_ge(const unsigned (&x)[32], int ng, unsigned cand) {
    const unsigned c2m1 = (cand - 1u) * 0x00010001u, one2 = 0x00010001u; unsigned c0 = 0u, c1 = 0u, c2 = 0u, c3 = 0u;
#pragma unroll
    for (int g = 0; g < 4; ++g) if (g < ng) { pk_ge_count4(x[8 * g], x[8 * g + 1], x[8 * g + 2], x[8 * g + 3], c2m1, one2, c0, c1, c2, c3); pk_ge_count4(x[8 * g + 4], x[8 * g + 5], x[8 * g + 6], x[8 * g + 7], c2m1, one2, c0, c1, c2, c3); }
    const unsigned s = (c0 + c1) + (c2 + c3);
    return wave_sum_i((int)((s & 0xFFFFu) + (s >> 16)));
}
__device__ __forceinline__ void p4a_load(int row_, unsigned char* ws, int lane, unsigned (&x)[32]) {
    const int row = __builtin_amdgcn_readfirstlane(row_); const int b = row / NS, t = row % NS; const int nc = (t >> 7) + 1;
    const unsigned* KEYS = (const unsigned*)(ws + WS_SC) + keys_row_dw(b, t); const unsigned* DEADK = (const unsigned*)(ws + 392 * 1024);
#pragma unroll
    for (int c = 0; c < 32; ++c) { const unsigned* base = c < nc ? KEYS + c * 64 : DEADK; x[c] = base[lane]; }
}
__device__ __forceinline__ int scan16_incl(int v) {
    v += __builtin_amdgcn_update_dpp(0, v, 0x111, 0xF, 0xF, true);
    v += __builtin_amdgcn_update_dpp(0, v, 0x112, 0xF, 0xF, true);
    v += __builtin_amdgcn_update_dpp(0, v, 0x114, 0xF, 0xF, true);
    v += __builtin_amdgcn_update_dpp(0, v, 0x118, 0xF, 0xF, true);
    return v;
}
__device__ __forceinline__ int scan64_incl(int v, int lane) {
    v = scan16_incl(v);
    const int t0 = __builtin_amdgcn_readlane(v, 15), t1 = __builtin_amdgcn_readlane(v, 31), t2 = __builtin_amdgcn_readlane(v, 47);
    return v + (lane >= 16 ? t0 : 0) + (lane >= 32 ? t1 : 0) + (lane >= 48 ? t2 : 0);
}
__device__ __forceinline__ unsigned bin_lo(unsigned x, unsigned hb) { unsigned a; asm("v_bfe_u32 %0, %1, 6, 10\n\tv_lshl_add_u32 %0, %0, 2, %2" : "=&v"(a) : "v"(x), "s"(hb)); return a; }
__device__ __forceinline__ unsigned bin_hi(unsigned x, unsigned hb) { unsigned a; asm("v_lshrrev_b32 %0, 22, %1\n\tv_lshl_add_u32 %0, %0, 2, %2" : "=&v"(a) : "v"(x), "s"(hb)); return a; }
__device__ __forceinline__ void lds_inc(unsigned addr) { __hip_atomic_fetch_add((LAS unsigned*)(unsigned long)addr, 1u, __ATOMIC_RELAXED, __HIP_MEMORY_SCOPE_WORKGROUP); }
#define WAVE_LDS_ORDER() do { asm volatile("" ::: "memory"); __builtin_amdgcn_fence(__ATOMIC_ACQ_REL, "wavefront"); __builtin_amdgcn_wave_barrier(); asm volatile("" ::: "memory"); } while (0)
constexpr int SEL_LDS = 8192;
__device__ __forceinline__ void tie_fix(unsigned long long& m, unsigned long long e, int& run, int need) {
    if (e != 0ull) { const int n = __builtin_popcountll(e); int keep = need - run; run += n;
        if (keep < n) { if (keep < 0) keep = 0; unsigned long long d = e; for (int i = 0; i < keep; ++i) d &= d - 1ull; m &= ~d; } }
}
#define PUT4(mw0, mw1, a0, a1, a2, a3, L0) asm volatile("s_nop 3\n\tv_writelane_b32 %0, %2, %10\n\tv_writelane_b32 %1, %3, %10\n\tv_writelane_b32 %0, %4, %11\n\tv_writelane_b32 %1, %5, %11\n\t" \
        "v_writelane_b32 %0, %6, %12\n\tv_writelane_b32 %1, %7, %12\n\tv_writelane_b32 %0, %8, %13\n\tv_writelane_b32 %1, %9, %13" : "+v"(mw0), "+v"(mw1) \
        : "s"((unsigned)(a0)), "s"((unsigned)((a0) >> 32)), "s"((unsigned)(a1)), "s"((unsigned)((a1) >> 32)), "s"((unsigned)(a2)), "s"((unsigned)((a2) >> 32)), "s"((unsigned)(a3)), "s"((unsigned)((a3) >> 32)), \
          "n"(L0), "n"((L0) + 1), "n"((L0) + 2), "n"((L0) + 3))
__device__ __forceinline__ void p4a_row(int row_, unsigned char* ws, int lane, const unsigned (&x)[32], LAS unsigned char* H) {
    const int row = __builtin_amdgcn_readfirstlane(row_);
    const int t = row % NS; unsigned long long* MASK = (unsigned long long*)(ws + WS_MASK) + (size_t)row * 64;
    const int nc = (t >> 7) + 1;
    if (t < TOPK) {
        if (lane < 2 * nc) { const int lo = lane * 64; unsigned long long m = 0ull; if (t >= lo + 63) m = ~0ull; else if (t >= lo) m = (2ull << (t - lo)) - 1ull; MASK[lane] = m; }
        return;
    }
    const unsigned hb = (unsigned)(unsigned long)H;
    { const u32x4 z = (u32x4){0u, 0u, 0u, 0u};
#pragma unroll
      for (int i = 0; i < 4; ++i) *(LAS u32x4*)(H + i * 1024 + lane * 16) = z;
      *(LAS unsigned*)(H + 4096 + lane * 4) = 0u; }
    WAVE_LDS_ORDER();
#pragma unroll
    for (int c = 0; c < 32; c += 2) if (c < nc) {
        lds_inc(bin_lo(x[c], hb)); lds_inc(bin_hi(x[c], hb)); lds_inc(bin_lo(x[c + 1], hb)); lds_inc(bin_hi(x[c + 1], hb)); }
    WAVE_LDS_ORDER();
    int Bsel, cA;
    {   const LAS unsigned char* hp = H + (63 - lane) * 64;
        const u32x4 h0 = *(const LAS u32x4*)hp, h1 = *(const LAS u32x4*)(hp + 16), h2 = *(const LAS u32x4*)(hp + 32), h3 = *(const LAS u32x4*)(hp + 48);
        const int sl = (int)(((h0.x + h0.y) + (h0.z + h0.w)) + ((h1.x + h1.y) + (h1.z + h1.w)) + ((h2.x + h2.y) + (h2.z + h2.w)) + ((h3.x + h3.y) + (h3.z + h3.w)));
        const int P = scan64_incl(sl, lane);
        const int Ls = __builtin_ctzll(__ballot(P >= TOPK));
        const int E = __builtin_amdgcn_readlane(P - sl, Ls);
        const int hj = (int)*(const LAS unsigned*)(H + ((63 - Ls) * 16 + 15 - (lane & 15)) * 4);
        const int Pj = scan16_incl(hj);
        const int jl = __builtin_ctzll(__ballot(E + Pj >= TOPK) & 0xFFFFull);
        Bsel = (63 - Ls) * 16 + 15 - jl; cA = E + __builtin_amdgcn_readlane(Pj - hj, jl);
    }
    {   const unsigned Bs2 = ((unsigned)Bsel << 6) * 0x00010001u; const unsigned dump = 64u + (unsigned)lane, hb2 = hb + 4096u;
#pragma unroll
        for (int c = 0; c < 32; c += 2) if (c < nc) {
#pragma unroll
            for (int i = 0; i < 2; ++i) { const unsigned y = x[c + i] ^ Bs2;
                const unsigned il = (unsigned)(unsigned short)__builtin_elementwise_min((unsigned short)y, (unsigned short)dump), ih = __builtin_elementwise_min(y >> 16, dump);
                lds_inc((il << 2) + hb2); lds_inc((ih << 2) + hb2); } }
    }
    WAVE_LDS_ORDER();
    unsigned T; int cT, need;
    {   const int c2 = (int)*(const LAS unsigned*)(H + 4096 + (63 - lane) * 4);
        const int P2 = scan64_incl(c2, lane);
        const int L2 = __builtin_ctzll(__ballot(cA + P2 >= TOPK));
        cT = cA + __builtin_amdgcn_readlane(P2, L2); need = TOPK - (cT - __builtin_amdgcn_readlane(c2, L2));
        T = ((unsigned)Bsel << 6) + (unsigned)(63 - L2);
    }
    unsigned mw0 = 0u, mw1 = 0u;
    const bool tie = (cT != TOPK);
    const unsigned Th = T << 16; const unsigned short Ts = (unsigned short)T; int run = 0;
#pragma unroll
    for (int c = 0; c < 32; c += 2) if (c < nc) {
        unsigned long long a0 = __ballot((unsigned short)x[c] >= Ts), a1 = __ballot(x[c] >= Th), a2 = __ballot((unsigned short)x[c + 1] >= Ts), a3 = __ballot(x[c + 1] >= Th);
        if (tie) {
            const unsigned long long e0 = __ballot((unsigned short)x[c] == Ts), e1 = __ballot((x[c] >> 16) == T), e2 = __ballot((unsigned short)x[c + 1] == Ts), e3 = __ballot((x[c + 1] >> 16) == T);
            tie_fix(a0, e0, run, need); tie_fix(a1, e1, run, need); tie_fix(a2, e2, run, need); tie_fix(a3, e3, run, need);
        }
        PUT4(mw0, mw1, a0, a1, a2, a3, 2 * c);
    }
    if (lane < 2 * nc) MASK[lane] = ((unsigned long long)mw1 << 32) | mw0;
}

typedef float f32x16 __attribute__((ext_vector_type(16)));
typedef short s16x4 __attribute__((ext_vector_type(4)));
__device__ __forceinline__ int crow(int r, int hi) { return (r & 3) + 8 * (r >> 2) + 4 * hi; }
__device__ __forceinline__ s16x4 vtr(const LAS unsigned char* p) { return __builtin_bit_cast(s16x4, __builtin_amdgcn_ds_read_tr16_b64_v4i16((LAS s16x4*)p)); }
constexpr size_t WS_OAB = 358 * MiB;
constexpr int AT_ROWB = 144, AT_TILE = 64 * AT_ROWB;
constexpr int AT_VROWB = 192, AT_VTILE = 64 * AT_VROWB;
constexpr float LOG2E = 1.4426950408889634f;
constexpr float ATHR = 8.f;
__device__ __forceinline__ int sext_bit(unsigned w, int c) { int r; asm("v_bfe_i32 %0, %1, %2, 1" : "=v"(r) : "v"(w), "n"(c)); return r; }
__device__ __forceinline__ void attn_s(const LAS unsigned char* Kb, const LAS float* BT, const bf16x8 (&qr)[4], unsigned long long mword, bool far, bool first, int dist0,
                                       int r32, int hh, f32x16& o0, f32x16& o1, float& lsum, f32x16& nmB, float& mref, u32x4 (&pk)[4]) {
    f32x16 p0, p1;
#pragma unroll
    for (int ks = 0; ks < 4; ++ks) {
        const bf16x8 k0 = *(const LAS bf16x8*)(Kb + r32 * AT_ROWB + 32 * ks + 16 * hh);
        const bf16x8 k1 = *(const LAS bf16x8*)(Kb + (32 + r32) * AT_ROWB + 32 * ks + 16 * hh);
        if (ks == 0) { p0 = __builtin_amdgcn_mfma_f32_32x32x16_bf16(k0, qr[0], nmB, 0, 0, 0); p1 = __builtin_amdgcn_mfma_f32_32x32x16_bf16(k1, qr[0], nmB, 0, 0, 0); }
        else { p0 = __builtin_amdgcn_mfma_f32_32x32x16_bf16(k0, qr[ks], p0, 0, 0, 0); p1 = __builtin_amdgcn_mfma_f32_32x32x16_bf16(k1, qr[ks], p1, 0, 0, 0); }
    }
    if (!far) {
        const LAS float* bp = BT + (96 - 27 - 32) + dist0;
#pragma unroll
        for (int i = 0; i < 16; ++i) { const int c = (i & 3) + 8 * (i >> 2); p0[i] += bp[32 + 27 - c]; p1[i] += bp[27 - c]; }
    }
    float m0 = __builtin_fmaxf(__builtin_fmaxf(p0[0], p0[1]), p0[2]), m1 = __builtin_fmaxf(__builtin_fmaxf(p1[0], p1[1]), p1[2]);
#pragma unroll
    for (int i = 3; i < 15; i += 2) { m0 = __builtin_fmaxf(__builtin_fmaxf(m0, p0[i]), p0[i + 1]); m1 = __builtin_fmaxf(__builtin_fmaxf(m1, p1[i]), p1[i + 1]); }
    float mx = __builtin_fmaxf(__builtin_fmaxf(m0, m1), __builtin_fmaxf(p0[15], p1[15]));
    { const auto rr = __builtin_amdgcn_permlane32_swap(__float_as_uint(mx), __float_as_uint(mx), false, false); mx = __builtin_fmaxf(__uint_as_float(rr[0]), __uint_as_float(rr[1])); }
    if (first || __any(mx > ATHR)) {
        const float dl = (first || mx > ATHR) ? mx : 0.f; mref += dl; const float f = __builtin_amdgcn_exp2f(-dl);
#pragma unroll
        for (int i = 0; i < 16; ++i) { p0[i] -= dl; p1[i] -= dl; nmB[i] -= dl; o0[i] *= f; o1[i] *= f; }
        lsum *= f;
    }
    const unsigned wl = (unsigned)mword >> (4 * hh), wh = (unsigned)(mword >> 32) >> (4 * hh);
#pragma unroll
    for (int i = 0; i < 16; ++i) { const int c = (i & 3) + 8 * (i >> 2);
        p0[i] = __uint_as_float(__float_as_uint(__builtin_amdgcn_exp2f(p0[i])) & (unsigned)sext_bit(wl, c));
        p1[i] = __uint_as_float(__float_as_uint(__builtin_amdgcn_exp2f(p1[i])) & (unsigned)sext_bit(wh, c)); }
    {
        typedef float f32x2s __attribute__((ext_vector_type(2)));
        f32x2s a[8];
#pragma unroll
        for (int j = 0; j < 8; ++j) a[j] = (f32x2s){p0[2 * j], p0[2 * j + 1]} + (f32x2s){p1[2 * j], p1[2 * j + 1]};
        const f32x2s b0 = (a[0] + a[1]) + (a[2] + a[3]), b1 = (a[4] + a[5]) + (a[6] + a[7]); const f32x2s c2 = b0 + b1;
        lsum += c2.x + c2.y; }
#pragma unroll
    for (int s2 = 0; s2 < 2; ++s2) {
        pk[s2].x = cvtpk_s(p0[8 * s2], p0[8 * s2 + 1]); pk[s2].y = cvtpk_s(p0[8 * s2 + 2], p0[8 * s2 + 3]); pk[s2].z = cvtpk_s(p0[8 * s2 + 4], p0[8 * s2 + 5]); pk[s2].w = cvtpk_s(p0[8 * s2 + 6], p0[8 * s2 + 7]);
        pk[2 + s2].x = cvtpk_s(p1[8 * s2], p1[8 * s2 + 1]); pk[2 + s2].y = cvtpk_s(p1[8 * s2 + 2], p1[8 * s2 + 3]); pk[2 + s2].z = cvtpk_s(p1[8 * s2 + 4], p1[8 * s2 + 5]); pk[2 + s2].w = cvtpk_s(p1[8 * s2 + 6], p1[8 * s2 + 7]); }
}
__device__ __forceinline__ void attn_pv(const LAS unsigned char* Vb, const u32x4 (&pk)[4], int voff, f32x16& o0, f32x16& o1) {
#pragma unroll
    for (int q = 0; q < 4; ++q) {
        const bf16x8 pf = __builtin_bit_cast(bf16x8, pk[q]);
        const LAS unsigned char* vp = Vb + (16 * q) * AT_VROWB + voff;
        const s16x4 a0l = vtr(vp), a0h = vtr(vp + 8 * AT_VROWB), a1l = vtr(vp + 64), a1h = vtr(vp + 8 * AT_VROWB + 64);
        const bf16x8 va0 = (bf16x8){a0l[0], a0l[1], a0l[2], a0l[3], a0h[0], a0h[1], a0h[2], a0h[3]};
        const bf16x8 va1 = (bf16x8){a1l[0], a1l[1], a1l[2], a1l[3], a1h[0], a1h[1], a1h[2], a1h[3]};
        o0 = __builtin_amdgcn_mfma_f32_32x32x16_bf16(va0, pf, o0, 0, 0, 0);
        o1 = __builtin_amdgcn_mfma_f32_32x32x16_bf16(va1, pf, o1, 0, 0, 0);
    }
}
constexpr int AT_KB = 0, AT_VB = 2 * AT_TILE, AT_BT3 = AT_VB + 3 * AT_VTILE;
template <bool GB> __device__ __forceinline__ void attn_unit(int b, int h, int Q, const float* rel_bias, unsigned char* ws, LAS unsigned char* lds) {
    const int tid = threadIdx.x, lane = tid & 63, wave = __builtin_amdgcn_readfirstlane(tid >> 6), r32 = lane & 31, hh = lane >> 5;
    const size_t rowbase = (size_t)b * NS; const int t0w = 256 * Q + 32 * wave, t = t0w + r32;
    const bf16_t* QKV = (const bf16_t*)(ws + WS_QKV);
    LAS float* BT = (LAS float*)(lds + AT_BT3);
    const int NTL = 4 * (Q + 1);
    const int lastw = (t0w + 31) >> 6;
    const int srow = tid >> 3, sch = tid & 7;
    const bf16_t* kg = QKV + (rowbase + srow) * 1536 + 512 + h * 64 + sch * 8; const bf16_t* vg = kg + 512;
    const int soff = srow * AT_ROWB + sch * 16, svoff = srow * AT_VROWB + sch * 16;
    const unsigned long long* MK = (const unsigned long long*)(ws + WS_MASK) + (rowbase + t) * 64;
    const size_t tstride = (size_t)64 * 1536;
    u32x4 k0r = *(const u32x4*)kg, v0r = *(const u32x4*)vg;
    u32x4 kA = *(const u32x4*)(kg + tstride), vA = *(const u32x4*)(vg + tstride);
    u32x4 kB = *(const u32x4*)(kg + 2 * tstride), vB = *(const u32x4*)(vg + 2 * tstride);
    unsigned long long me = MK[0], mo = MK[(1 <= lastw) ? 1 : 0];
    bf16x8 qr[4];
#pragma unroll
    for (int ks = 0; ks < 4; ++ks) qr[ks] = *(const bf16x8*)(QKV + (rowbase + t) * 1536 + h * 64 + 16 * ks + 8 * hh);
    const float cB = rel_bias[31 * A_HEADS + h] * LOG2E;
    __syncthreads();
    if (tid < 352) { const int d = tid - 96; BT[tid] = rel_bias[v0_bucket(d < 0 ? 0 : d) * A_HEADS + h] * LOG2E - cB; }
    *(LAS u32x4*)(lds + AT_KB + soff) = k0r; *(LAS u32x4*)(lds + AT_VB + svoff) = v0r;
    f32x16 o0, o1, nmB; float lsum = 0.f;
#pragma unroll
    for (int i = 0; i < 16; ++i) { o0[i] = 0.f; o1[i] = 0.f; nmB[i] = cB; }
    float mref = 0.f;
    const int q4 = (lane & 15) >> 2, p4 = lane & 3, blk = (lane >> 4) & 1;
    const int voff = (4 * hh + q4) * AT_VROWB + (16 * blk + 4 * p4) * 2;
    u32x4 pk[4];
#pragma unroll
    for (int q = 0; q < 4; ++q) pk[q] = (u32x4){0u, 0u, 0u, 0u};
    int vcur = 0, vnext = AT_VTILE, vprev = 2 * AT_VTILE;
    for (int kt = 0; kt < NTL; kt += 2) {
        __syncthreads();
        *(LAS u32x4*)(lds + AT_KB + AT_TILE + soff) = kA; *(LAS u32x4*)(lds + AT_VB + vnext + svoff) = vA;
        { const int tn = (kt + 3 < NTL) ? kt + 3 : NTL - 1; kA = *(const u32x4*)(kg + (size_t)tn * tstride); vA = *(const u32x4*)(vg + (size_t)tn * tstride); }
        if (GB) { if (kt >= 1 && kt - 1 <= lastw) attn_pv(lds + AT_VB + vprev, pk, voff, o0, o1); }
        if (kt <= lastw) attn_s(lds + AT_KB, BT, qr, me, (t0w - (64 * kt + 63) >= 113), kt == 0, t - 64 * kt - 4 * hh, r32, hh, o0, o1, lsum, nmB, mref, pk);
        if (!GB) { if (kt <= lastw) attn_pv(lds + AT_VB + vcur, pk, voff, o0, o1); }
        me = MK[(kt + 2 <= lastw) ? kt + 2 : lastw];
        { const int tmp = vprev; vprev = vcur; vcur = vnext; vnext = tmp; }
        __syncthreads();
        *(LAS u32x4*)(lds + AT_KB + soff) = kB; *(LAS u32x4*)(lds + AT_VB + vnext + svoff) = vB;
        { const int tn = (kt + 4 < NTL) ? kt + 4 : NTL - 1; kB = *(const u32x4*)(kg + (size_t)tn * tstride); vB = *(const u32x4*)(vg + (size_t)tn * tstride); }
        if (GB) { if (kt <= lastw) attn_pv(lds + AT_VB + vprev, pk, voff, o0, o1); }
        if (kt + 1 <= lastw) attn_s(lds + AT_KB + AT_TILE, BT, qr, mo, (t0w - (64 * (kt + 1) + 63) >= 113), false, t - 64 * (kt + 1) - 4 * hh, r32, hh, o0, o1, lsum, nmB, mref, pk);
        if (!GB) { if (kt + 1 <= lastw) attn_pv(lds + AT_VB + vcur, pk, voff, o0, o1); }
        mo = MK[(kt + 3 <= lastw) ? kt + 3 : lastw];
        { const int tmp = vprev; vprev = vcur; vcur = vnext; vnext = tmp; }
    }
    if (GB) {
        if (NTL - 1 <= lastw) attn_pv(lds + AT_VB + vprev, pk, voff, o0, o1);
    }
    float inv; { const auto rr = __builtin_amdgcn_permlane32_swap(__float_as_uint(lsum), __float_as_uint(lsum), false, false); inv = 1.f / (__uint_as_float(rr[0]) + __uint_as_float(rr[1])); }
    bf16_t* O = (bf16_t*)(ws + WS_OAB) + (rowbase + t) * 1024 + h * 64 + 4 * hh;
#pragma unroll
    for (int g = 0; g < 4; ++g) {
        u32x2 w0, w1; w0.x = cvtpk_s(o0[4 * g] * inv, o0[4 * g + 1] * inv); w0.y = cvtpk_s(o0[4 * g + 2] * inv, o0[4 * g + 3] * inv);
        w1.x = cvtpk_s(o1[4 * g] * inv, o1[4 * g + 1] * inv); w1.y = cvtpk_s(o1[4 * g + 2] * inv, o1[4 * g + 3] * inv);
        *(u32x2*)(O + 8 * g) = w0; *(u32x2*)(O + 32 + 8 * g) = w1;
    }
}

constexpr int GL_LG = 0, GL_SEG = 16384, GL_A = 18432, GL_B = GL_A + 9216, GL_C = GL_B + 9216, GL_VT = GL_C + 9216, GL_ST = GL_VT + 18432;
constexpr int GROWB = 144;
constexpr int GLA_ITEMS = NB * G_HEADS * 64;
__device__ __forceinline__ void gla_cumdecay(const u32x4 g0, const u32x4 g1, int h, const float* wg, const float* bg, LAS unsigned char* lds, float* lgc) {
    const int tid = threadIdx.x; LAS float* LG = (LAS float*)(lds + GL_LG); LAS float* SEG = (LAS float*)(lds + GL_SEG);
    {   const int c = tid >> 3, dg = tid & 7; float gl[16];
#pragma unroll
        for (int j = 0; j < 4; ++j) { gl[2 * j] = __uint_as_float(g0[j] << 16); gl[2 * j + 1] = __uint_as_float(g0[j] & 0xffff0000u); gl[8 + 2 * j] = __uint_as_float(g1[j] << 16); gl[8 + 2 * j + 1] = __uint_as_float(g1[j] & 0xffff0000u); }
        float z[8];
#pragma unroll
        for (int j = 0; j < 8; ++j) z[j] = bg[h * 64 + 8 * dg + j];
#pragma unroll
        for (int r = 0; r < 16; ++r) { const f32x4 w0 = *(const f32x4*)(wg + r * G_KW + h * 64 + 8 * dg), w1 = *(const f32x4*)(wg + r * G_KW + h * 64 + 8 * dg + 4);
            z[0] += gl[r] * w0[0]; z[1] += gl[r] * w0[1]; z[2] += gl[r] * w0[2]; z[3] += gl[r] * w0[3]; z[4] += gl[r] * w1[0]; z[5] += gl[r] * w1[1]; z[6] += gl[r] * w1[2]; z[7] += gl[r] * w1[3]; }
#pragma unroll
        for (int j = 0; j < 8; ++j) z[j] = (fminf(z[j], 0.f) - log1pf(__expf(-fabsf(z[j])))) * (1.f / 16.f);
        *(LAS f32x4*)(LG + c * 64 + 8 * dg) = (f32x4){z[0], z[1], z[2], z[3]}; *(LAS f32x4*)(LG + c * 64 + 8 * dg + 4) = (f32x4){z[4], z[5], z[6], z[7]};
    }
    __syncthreads();
    const int seg = tid >> 6, d = tid & 63; float v[8];
#pragma unroll
    for (int i = 0; i < 8; ++i) v[i] = LG[(8 * seg + i) * 64 + d];
#pragma unroll
    for (int i = 1; i < 8; ++i) v[i] += v[i - 1];
    SEG[seg * 64 + d] = v[7];
    __syncthreads();
    float off = 0.f;
#pragma unroll
    for (int s2 = 0; s2 < 8; ++s2) if (s2 < seg) off += SEG[s2 * 64 + d];
#pragma unroll
    for (int i = 0; i < 8; ++i) { const float bv = v[i] + off; LG[(8 * seg + i) * 64 + d] = bv; lgc[(8 * seg + i) * 64 + d] = bv; }
    __syncthreads();
}
__device__ __forceinline__ unsigned short f2bf_s(float f) { return (unsigned short)(cvtpk_s(f, 0.f) & 0xffffu); }
__device__ __forceinline__ void gla_stage_vt(const u32x4 a, const u32x4 b2, LAS unsigned char* lds) {
    const int tid = threadIdx.x, c = tid >> 3, d0 = (tid & 7) * 16;
#pragma unroll
    for (int j = 0; j < 4; ++j) {
        *(LAS unsigned short*)(lds + GL_VT + (d0 + 2 * j) * GROWB + c * 2) = (unsigned short)(a[j] & 0xffffu); *(LAS unsigned short*)(lds + GL_VT + (d0 + 2 * j + 1) * GROWB + c * 2) = (unsigned short)(a[j] >> 16);
        *(LAS unsigned short*)(lds + GL_VT + (d0 + 8 + 2 * j) * GROWB + c * 2) = (unsigned short)(b2[j] & 0xffffu); *(LAS unsigned short*)(lds + GL_VT + (d0 + 8 + 2 * j + 1) * GROWB + c * 2) = (unsigned short)(b2[j] >> 16); }
}
__device__ __forceinline__ void p3b_item(int it, const float* wg, const float* bg, float* UT, float* LGC, unsigned char* ws, LAS unsigned char* lds) {
    const int tid = threadIdx.x, lane = tid & 63, wave = tid >> 6, fr = lane & 15, fq = lane >> 4;
    const int bh = it >> 6, n = it & 63, b = bh >> 2, h = bh & 3; const size_t r0 = (size_t)b * NS + 64 * n;
    const int c_ = tid >> 3, dg_ = tid & 7;
    const bf16_t* gp_ = (const bf16_t*)(ws + WS_GLR) + (r0 + c_) * 16; const u32x4 g0 = *(const u32x4*)gp_, g1 = *(const u32x4*)(gp_ + 8);
    const u32x4 kraw = *(const u32x4*)((const bf16_t*)(ws + WS_GQK) + (r0 + c_) * 512 + 256 + h * 64 + 8 * dg_);
    const bf16_t* vp_ = (const bf16_t*)(ws + WS_GV) + (r0 + c_) * 512 + h * 128 + dg_ * 16; const u32x4 va_ = *(const u32x4*)vp_, vb_ = *(const u32x4*)(vp_ + 8);
    __syncthreads();
    gla_cumdecay(g0, g1, h, wg, bg, lds, LGC + (size_t)it * 4096);
    const LAS float* LG = (const LAS float*)(lds + GL_LG);
    {   const int c = tid >> 3, dg = tid & 7; float kf[8]; bf8_to_f(kraw, kf);
#pragma unroll
        for (int j = 0; j < 8; ++j) { const int d = 8 * dg + j; *(LAS unsigned short*)(lds + GL_A + d * GROWB + c * 2) = f2bf_s(kf[j] * __expf(LG[63 * 64 + d] - LG[c * 64 + d])); }
        if (tid < 64) ((float*)(ws + WS_MISC))[(size_t)it * 64 + tid] = __expf(LG[63 * 64 + tid]);
    }
    gla_stage_vt(va_, vb_, lds);
    __syncthreads();
    f32x4 acc[4];
#pragma unroll
    for (int i = 0; i < 4; ++i) acc[i] = (f32x4){0.f, 0.f, 0.f, 0.f};
#pragma unroll
    for (int ks = 0; ks < 2; ++ks) { const bf16x8 bv = *(const LAS bf16x8*)(lds + GL_VT + (16 * wave + fr) * GROWB + (32 * ks + 8 * fq) * 2);
#pragma unroll
        for (int i = 0; i < 4; ++i) { const bf16x8 av = *(const LAS bf16x8*)(lds + GL_A + (16 * i + fr) * GROWB + (32 * ks + 8 * fq) * 2); acc[i] = __builtin_amdgcn_mfma_f32_16x16x32_bf16(av, bv, acc[i], 0, 0, 0); } }
#pragma unroll
    for (int i = 0; i < 4; ++i) *(f32x4*)(UT + ((size_t)it * 128 + 16 * wave + fr) * 64 + 16 * i + 4 * fq) = acc[i];
}
__device__ __forceinline__ void p4b_item(int j, const float* UT, bf16_t* SP, unsigned char* ws) {
    const int tid = threadIdx.x, bh = j >> 3, dv = (j & 7) * 16 + (tid >> 5), dk = (tid & 31) * 2; const float* DEC = (const float*)(ws + WS_MISC);
    typedef float f32x2v __attribute__((ext_vector_type(2)));
    f32x2v st = (f32x2v){0.f, 0.f};
#pragma unroll 8
    for (int n = 0; n < 64; ++n) { const size_t it = (size_t)bh * 64 + n; const size_t o = (it * 128 + dv) * 64 + dk;
        *(unsigned*)(SP + o) = cvtpk_s(st[0], st[1]);
        const f32x2v u = *(const f32x2v*)(UT + o), dc = *(const f32x2v*)(DEC + it * 64 + dk); st = dc * st + u; }
}
__device__ __forceinline__ void p4b_item4(int j, const float* UT, bf16_t* SP, unsigned char* ws) {
    const int tid = threadIdx.x, bh = j >> 3, dv0 = (j & 7) * 16 + (tid >> 5), dk = (tid & 31) * 2; const float* DEC = (const float*)(ws + WS_MISC);
    typedef float f32x2v __attribute__((ext_vector_type(2)));
    f32x2v st[4];
#pragma unroll
    for (int i = 0; i < 4; ++i) st[i] = (f32x2v){0.f, 0.f};
#pragma unroll 4
    for (int n = 0; n < 64; ++n) { const size_t it = (size_t)bh * 64 + n; const f32x2v dc = *(const f32x2v*)(DEC + it * 64 + dk);
#pragma unroll
        for (int i = 0; i < 4; ++i) { const size_t o = (it * 128 + dv0 + 4 * i) * 64 + dk;
            *(unsigned*)(SP + o) = cvtpk_s(st[i][0], st[i][1]);
            const f32x2v u = *(const f32x2v*)(UT + o); st[i] = dc * st[i] + u; } }
}
__device__ __forceinline__ void p5b_item(int it, const float* LGC, const float* ng, const bf16_t* SP, unsigned char* ws, LAS unsigned char* lds) {
    const int tid = threadIdx.x, lane = tid & 63, wave = tid >> 6, r32 = lane & 31, hh = lane >> 5;
    const int bh = it >> 6, n = it & 63, b = bh >> 2, h = bh & 3; const size_t r0 = (size_t)b * NS + 64 * n;
    const int c_ = tid >> 3, dg_ = tid & 7; const int dvb = wave >> 1, cb = wave & 1;
    const f32x4 lg0 = *(const f32x4*)(LGC + (size_t)it * 4096 + c_ * 64 + 8 * dg_), lg1 = *(const f32x4*)(LGC + (size_t)it * 4096 + c_ * 64 + 8 * dg_ + 4);
    const bf16_t* qp_ = (const bf16_t*)(ws + WS_GQK) + (r0 + c_) * 512 + h * 64 + 8 * dg_; const u32x4 qraw = *(const u32x4*)qp_, kraw = *(const u32x4*)(qp_ + 256);
    const bf16_t* vp_ = (const bf16_t*)(ws + WS_GV) + (r0 + c_) * 512 + h * 128 + dg_ * 16; const u32x4 va_ = *(const u32x4*)vp_, vb_ = *(const u32x4*)(vp_ + 8);
    bf16x8 spf[4];
#pragma unroll
    for (int ks = 0; ks < 4; ++ks) spf[ks] = *(const bf16x8*)(SP + ((size_t)it * 128 + 32 * dvb + r32) * 64 + 16 * ks + 8 * hh);
    const size_t trow = r0 + 32 * cb + r32; const int dvbase = h * 128 + 32 * dvb + 4 * hh;
    const bf16_t* grp = (const bf16_t*)(ws + WS_GR) + trow * 512 + dvbase; u32x2 grw[4];
#pragma unroll
    for (int g = 0; g < 4; ++g) grw[g] = *(const u32x2*)(grp + 8 * g);
    __syncthreads();
    { LAS float* LGw = (LAS float*)(lds + GL_LG); *(LAS f32x4*)(LGw + c_ * 64 + 8 * dg_) = lg0; *(LAS f32x4*)(LGw + c_ * 64 + 8 * dg_ + 4) = lg1; }
    __syncthreads();
    const LAS float* LG = (const LAS float*)(lds + GL_LG);
    {   const int c = tid >> 3, dg = tid & 7; float qf[8], kf[8]; bf8_to_f(qraw, qf); bf8_to_f(kraw, kf);
        float qr[8], ks[8], qi[8];
#pragma unroll
        for (int j = 0; j < 8; ++j) { const int d = 8 * dg + j; const float bc = LG[c * 64 + d], bl = LG[63 * 64 + d]; const float q8 = qf[j] * 0.125f;
            qr[j] = q8 * __expf(bc - bl); ks[j] = kf[j] * __expf(bl - bc); qi[j] = q8 * __expf(bc); }
        u32x4 w;
        w.x = cvtpk_s(qr[0], qr[1]); w.y = cvtpk_s(qr[2], qr[3]); w.z = cvtpk_s(qr[4], qr[5]); w.w = cvtpk_s(qr[6], qr[7]); *(LAS u32x4*)(lds + GL_A + c * GROWB + 16 * dg) = w;
        w.x = cvtpk_s(ks[0], ks[1]); w.y = cvtpk_s(ks[2], ks[3]); w.z = cvtpk_s(ks[4], ks[5]); w.w = cvtpk_s(ks[6], ks[7]); *(LAS u32x4*)(lds + GL_B + c * GROWB + 16 * dg) = w;
        w.x = cvtpk_s(qi[0], qi[1]); w.y = cvtpk_s(qi[2], qi[3]); w.z = cvtpk_s(qi[4], qi[5]); w.w = cvtpk_s(qi[6], qi[7]); *(LAS u32x4*)(lds + GL_C + c * GROWB + 16 * dg) = w;
    }
    gla_stage_vt(va_, vb_, lds);
    __syncthreads();
    f32x16 o;
#pragma unroll
    for (int i = 0; i < 16; ++i) o[i] = 0.f;
#pragma unroll
    for (int jb = 0; jb < 2; ++jb) if (jb <= cb) {
        f32x16 at;
#pragma unroll
        for (int i = 0; i < 16; ++i) at[i] = 0.f;
#pragma unroll
        for (int ks = 0; ks < 4; ++ks) { const bf16x8 av = *(const LAS bf16x8*)(lds + GL_B + (32 * jb + r32) * GROWB + 32 * ks + 16 * hh), bv = *(const LAS bf16x8*)(lds + GL_A + (32 * cb + r32) * GROWB + 32 * ks + 16 * hh);
            at = __builtin_amdgcn_mfma_f32_32x32x16_bf16(av, bv, at, 0, 0, 0); }
        if (jb == cb) {
#pragma unroll
            for (int i = 0; i < 16; ++i) if (crow(i, hh) > r32) at[i] = 0.f; }
#pragma unroll
        for (int s = 0; s < 2; ++s) {
            u32x4 pw; pw.x = cvtpk_s(at[8 * s], at[8 * s + 1]); pw.y = cvtpk_s(at[8 * s + 2], at[8 * s + 3]); pw.z = cvtpk_s(at[8 * s + 4], at[8 * s + 5]); pw.w = cvtpk_s(at[8 * s + 6], at[8 * s + 7]);
            const LAS unsigned char* vp = lds + GL_VT + (32 * dvb + r32) * GROWB + (32 * jb + 16 * s + 4 * hh) * 2;
            const u32x2 lo = *(const LAS u32x2*)vp, hi = *(const LAS u32x2*)(vp + 16);
            const u32x4 va = (u32x4){lo.x, lo.y, hi.x, hi.y};
            o = __builtin_amdgcn_mfma_f32_32x32x16_bf16(__builtin_bit_cast(bf16x8, va), __builtin_bit_cast(bf16x8, pw), o, 0, 0, 0);
        }
    }
#pragma unroll
    for (int ks = 0; ks < 4; ++ks) { const bf16x8 bv = *(const LAS bf16x8*)(lds + GL_C + (32 * cb + r32) * GROWB + 32 * ks + 16 * hh);
        o = __builtin_amdgcn_mfma_f32_32x32x16_bf16(spf[ks], bv, o, 0, 0, 0); }
    LAS float* ST = (LAS float*)(lds + GL_ST);
    float sm = 0.f;
#pragma unroll
    for (int i = 0; i < 16; ++i) sm += o[i];
    sm += __shfl_xor(sm, 32);
    if (hh == 0) ST[dvb * 64 + 32 * cb + r32] = sm;
    __syncthreads();
    const float mean = (ST[32 * cb + r32] + ST[64 + 32 * cb + r32] + ST[128 + 32 * cb + r32] + ST[192 + 32 * cb + r32]) * (1.f / 128.f);
    float sq = 0.f;
#pragma unroll
    for (int i = 0; i < 16; ++i) { o[i] -= mean; sq += o[i] * o[i]; }
    sq += __shfl_xor(sq, 32);
    if (hh == 0) ST[256 + dvb * 64 + 32 * cb + r32] = sq;
    __syncthreads();
    const float var = (ST[256 + 32 * cb + r32] + ST[256 + 64 + 32 * cb + r32] + ST[256 + 128 + 32 * cb + r32] + ST[256 + 192 + 32 * cb + r32]) * (1.f / 128.f);
    const float rstd = 1.f / sqrtf(var + LN_EPS);
    bf16_t* op = (bf16_t*)(ws + WS_OAB) + trow * 1024 + 512 + dvbase;
#pragma unroll
    for (int g = 0; g < 4; ++g) { const u32x2 gw = grw[g]; const f32x4 nv = *(const f32x4*)(ng + dvbase + 8 * g);
        float gr[4] = {__uint_as_float(gw.x << 16), __uint_as_float(gw.x & 0xffff0000u), __uint_as_float(gw.y << 16), __uint_as_float(gw.y & 0xffff0000u)}; float y[4];
#pragma unroll
        for (int e = 0; e < 4; ++e) y[e] = o[4 * g + e] * rstd * nv[e] * (gr[e] * __builtin_amdgcn_rcpf(1.f + __expf(-gr[e])));
        u32x2 w; w.x = cvtpk_s(y[0], y[1]); w.y = cvtpk_s(y[2], y[3]); *(u32x2*)(op + 8 * g) = w; }
}

constexpr int GL_HALF = 67584;
__device__ __forceinline__ void gla_cumdecay2(size_t r0, int h, const bf16_t* WGT, const float* bg, unsigned char* ws, LAS unsigned char* ldh, float* lgc) {
    const int tl = threadIdx.x & 255, lane = threadIdx.x & 63, wl = (threadIdx.x >> 6) & 3, r32 = lane & 31, hh = lane >> 5; LAS float* LG = (LAS float*)(ldh + GL_LG); LAS float* SEG = (LAS float*)(ldh + GL_SEG);
    {   const int cb = wl >> 1, db = wl & 1;
        const bf16x8 af = *(const bf16x8*)((const bf16_t*)(ws + WS_GLR) + (r0 + 32 * cb + r32) * 16 + 8 * hh), bfr = *(const bf16x8*)(WGT + (size_t)(h * 64 + 32 * db + r32) * 16 + 8 * hh);
        const float bias = bg[h * 64 + 32 * db + r32]; f32x16 z;
#pragma unroll
        for (int i = 0; i < 16; ++i) z[i] = bias;
        z = __builtin_amdgcn_mfma_f32_32x32x16_bf16(af, bfr, z, 0, 0, 0);
#pragma unroll
        for (int i = 0; i < 16; ++i) { const float zz = z[i]; LG[(32 * cb + crow(i, hh)) * 64 + 32 * db + r32] = (fminf(zz, 0.f) - __logf(1.f + __expf(-fabsf(zz)))) * (1.f / 16.f); }
    }
    __syncthreads();
    const int seg = tl >> 6, d = tl & 63; float v[16];
#pragma unroll
    for (int i = 0; i < 16; ++i) v[i] = LG[(16 * seg + i) * 64 + d];
#pragma unroll
    for (int i = 1; i < 16; ++i) v[i] += v[i - 1];
    SEG[seg * 64 + d] = v[15];
    __syncthreads();
    float off = 0.f;
#pragma unroll
    for (int s2 = 0; s2 < 4; ++s2) if (s2 < seg) off += SEG[s2 * 64 + d];
#pragma unroll
    for (int i = 0; i < 16; ++i) { const float bv = v[i] + off; LG[(16 * seg + i) * 64 + d] = bv; lgc[(16 * seg + i) * 64 + d] = bv; }
    __syncthreads();
}
__device__ __forceinline__ void gla_stage_vt2(const u32x4 (&vv)[4], LAS unsigned char* ldh) {
    const int tl = threadIdx.x & 255, c = tl >> 2, d0 = (tl & 3) * 32;
#pragma unroll
    for (int k = 0; k < 4; ++k)
#pragma unroll
        for (int j = 0; j < 4; ++j) {
            *(LAS unsigned short*)(ldh + GL_VT + (d0 + 8 * k + 2 * j) * GROWB + c * 2) = (unsigned short)(vv[k][j] & 0xffffu);
            *(LAS unsigned short*)(ldh + GL_VT + (d0 + 8 * k + 2 * j + 1) * GROWB + c * 2) = (unsigned short)(vv[k][j] >> 16); }
}
__device__ __forceinline__ void p3b_pair(int p, const float* wg, const float* bg, float* UT, float* LGC, unsigned char* ws, LAS unsigned char* lds) {
    const int tid = threadIdx.x, hb = tid >> 8, tl = tid & 255, lane = tid & 63, wl = (tid >> 6) & 3, fr = lane & 15, fq = lane >> 4;
    const int it = 2 * p + hb; LAS unsigned char* ldh = lds + hb * GL_HALF;
    const int bh = it >> 6, n = it & 63, b = bh >> 2, h = bh & 3; const size_t r0 = (size_t)b * NS + 64 * n;
    const int c_ = tl >> 2, dq_ = tl & 3;
    const bf16_t* kp_ = (const bf16_t*)(ws + WS_GQK) + (r0 + c_) * 512 + 256 + h * 64 + 16 * dq_; const u32x4 k0 = *(const u32x4*)kp_, k1 = *(const u32x4*)(kp_ + 8);
    const bf16_t* vp_ = (const bf16_t*)(ws + WS_GV) + (r0 + c_) * 512 + h * 128 + 32 * dq_; u32x4 vv[4];
#pragma unroll
    for (int k = 0; k < 4; ++k) vv[k] = *(const u32x4*)(vp_ + 8 * k);
    __syncthreads();
    gla_cumdecay2(r0, h, (const bf16_t*)(ws + WS_WGT), bg, ws, ldh, LGC + (size_t)it * 4096);
    const LAS float* LG = (const LAS float*)(ldh + GL_LG);
    {   float kf[16]; bf8_to_f(k0, kf); bf8_to_f(k1, kf + 8);
#pragma unroll
        for (int j = 0; j < 16; ++j) { const int d = 16 * dq_ + j; *(LAS unsigned short*)(ldh + GL_A + d * GROWB + c_ * 2) = f2bf_s(kf[j] * __expf(LG[63 * 64 + d] - LG[c_ * 64 + d])); }
        if (tl < 64) ((float*)(ws + WS_MISC))[(size_t)it * 64 + tl] = __expf(LG[63 * 64 + tl]);
    }
    gla_stage_vt2(vv, ldh);
    __syncthreads();
#pragma unroll
    for (int dvi = 0; dvi < 2; ++dvi) {
        const int dvblk = 2 * wl + dvi;
        f32x4 acc[4];
#pragma unroll
        for (int i = 0; i < 4; ++i) acc[i] = (f32x4){0.f, 0.f, 0.f, 0.f};
#pragma unroll
        for (int ks = 0; ks < 2; ++ks) { const bf16x8 bv = *(const LAS bf16x8*)(ldh + GL_VT + (16 * dvblk + fr) * GROWB + (32 * ks + 8 * fq) * 2);
#pragma unroll
            for (int i = 0; i < 4; ++i) { const bf16x8 av = *(const LAS bf16x8*)(ldh + GL_A + (16 * i + fr) * GROWB + (32 * ks + 8 * fq) * 2); acc[i] = __builtin_amdgcn_mfma_f32_16x16x32_bf16(av, bv, acc[i], 0, 0, 0); } }
#pragma unroll
        for (int i = 0; i < 4; ++i) *(f32x4*)(UT + ((size_t)it * 128 + 16 * dvblk + fr) * 64 + 16 * i + 4 * fq) = acc[i];
    }
}
__device__ __forceinline__ void p5b_pair(int p, const float* LGC, const float* ng, const bf16_t* SP, unsigned char* ws, LAS unsigned char* lds) {
    const int tid = threadIdx.x, hb = tid >> 8, tl = tid & 255, lane = tid & 63, wl = (tid >> 6) & 3, r32 = lane & 31, hh = lane >> 5;
    const int it = 2 * p + hb; LAS unsigned char* ldh = lds + hb * GL_HALF;
    const int bh = it >> 6, n = it & 63, b = bh >> 2, h = bh & 3; const size_t r0 = (size_t)b * NS + 64 * n;
    const int c_ = tl >> 2, dq_ = tl & 3; const int dvb = wl;
    f32x4 lg[4];
#pragma unroll
    for (int k = 0; k < 4; ++k) lg[k] = *(const f32x4*)(LGC + (size_t)it * 4096 + c_ * 64 + 16 * dq_ + 4 * k);
    const bf16_t* qp_ = (const bf16_t*)(ws + WS_GQK) + (r0 + c_) * 512 + h * 64 + 16 * dq_; const u32x4 q0 = *(const u32x4*)qp_, q1 = *(const u32x4*)(qp_ + 8), k0 = *(const u32x4*)(qp_ + 256), k1 = *(const u32x4*)(qp_ + 264);
    const bf16_t* vp_ = (const bf16_t*)(ws + WS_GV) + (r0 + c_) * 512 + h * 128 + 32 * dq_; u32x4 vv[4];
#pragma unroll
    for (int k = 0; k < 4; ++k) vv[k] = *(const u32x4*)(vp_ + 8 * k);
    bf16x8 spf[4];
#pragma unroll
    for (int ks = 0; ks < 4; ++ks) spf[ks] = *(const bf16x8*)(SP + ((size_t)it * 128 + 32 * dvb + r32) * 64 + 16 * ks + 8 * hh);
    const int dvbase = h * 128 + 32 * dvb + 4 * hh; u32x2 grw[2][4];
#pragma unroll
    for (int cb = 0; cb < 2; ++cb)
#pragma unroll
        for (int g = 0; g < 4; ++g) grw[cb][g] = *(const u32x2*)((const bf16_t*)(ws + WS_GR) + (r0 + 32 * cb + r32) * 512 + dvbase + 8 * g);
    __syncthreads();
    { LAS float* LGw = (LAS float*)(ldh + GL_LG);
#pragma unroll
      for (int k = 0; k < 4; ++k) *(LAS f32x4*)(LGw + c_ * 64 + 16 * dq_ + 4 * k) = lg[k]; }
    __syncthreads();
    const LAS float* LG = (const LAS float*)(ldh + GL_LG);
    {   float qf[16], kf[16]; bf8_to_f(q0, qf); bf8_to_f(q1, qf + 8); bf8_to_f(k0, kf); bf8_to_f(k1, kf + 8);
        float qr[16], ks[16], qi[16];
#pragma unroll
        for (int j = 0; j < 16; ++j) { const int d = 16 * dq_ + j; const float bc = LG[c_ * 64 + d], bl = LG[63 * 64 + d]; const float q8 = qf[j] * 0.125f;
            qr[j] = q8 * __expf(bc - bl); ks[j] = kf[j] * __expf(bl - bc); qi[j] = q8 * __expf(bc); }
#pragma unroll
        for (int k = 0; k < 2; ++k) { u32x4 w;
            w.x = cvtpk_s(qr[8 * k], qr[8 * k + 1]); w.y = cvtpk_s(qr[8 * k + 2], qr[8 * k + 3]); w.z = cvtpk_s(qr[8 * k + 4], qr[8 * k + 5]); w.w = cvtpk_s(qr[8 * k + 6], qr[8 * k + 7]); *(LAS u32x4*)(ldh + GL_A + c_ * GROWB + 32 * dq_ + 16 * k) = w;
            w.x = cvtpk_s(ks[8 * k], ks[8 * k + 1]); w.y = cvtpk_s(ks[8 * k + 2], ks[8 * k + 3]); w.z = cvtpk_s(ks[8 * k + 4], ks[8 * k + 5]); w.w = cvtpk_s(ks[8 * k + 6], ks[8 * k + 7]); *(LAS u32x4*)(ldh + GL_B + c_ * GROWB + 32 * dq_ + 16 * k) = w;
            w.x = cvtpk_s(qi[8 * k], qi[8 * k + 1]); w.y = cvtpk_s(qi[8 * k + 2], qi[8 * k + 3]); w.z = cvtpk_s(qi[8 * k + 4], qi[8 * k + 5]); w.w = cvtpk_s(qi[8 * k + 6], qi[8 * k + 7]); *(LAS u32x4*)(ldh + GL_C + c_ * GROWB + 32 * dq_ + 16 * k) = w; }
    }
    gla_stage_vt2(vv, ldh);
    __syncthreads();
    f32x16 o[2];
#pragma unroll
    for (int cb = 0; cb < 2; ++cb) {
#pragma unroll
        for (int i = 0; i < 16; ++i) o[cb][i] = 0.f;
#pragma unroll
        for (int jb = 0; jb < 2; ++jb) if (jb <= cb) {
            f32x16 at;
#pragma unroll
            for (int i = 0; i < 16; ++i) at[i] = 0.f;
#pragma unroll
            for (int ks = 0; ks < 4; ++ks) { const bf16x8 av = *(const LAS bf16x8*)(ldh + GL_B + (32 * jb + r32) * GROWB + 32 * ks + 16 * hh), bv = *(const LAS bf16x8*)(ldh + GL_A + (32 * cb + r32) * GROWB + 32 * ks + 16 * hh);
                at = __builtin_amdgcn_mfma_f32_32x32x16_bf16(av, bv, at, 0, 0, 0); }
            if (jb == cb) {
#pragma unroll
                for (int i = 0; i < 16; ++i) if (crow(i, hh) > r32) at[i] = 0.f; }
#pragma unroll
            for (int s2 = 0; s2 < 2; ++s2) {
                u32x4 pw; pw.x = cvtpk_s(at[8 * s2], at[8 * s2 + 1]); pw.y = cvtpk_s(at[8 * s2 + 2], at[8 * s2 + 3]); pw.z = cvtpk_s(at[8 * s2 + 4], at[8 * s2 + 5]); pw.w = cvtpk_s(at[8 * s2 + 6], at[8 * s2 + 7]);
                const LAS unsigned char* vp = ldh + GL_VT + (32 * dvb + r32) * GROWB + (32 * jb + 16 * s2 + 4 * hh) * 2;
                const u32x2 lo = *(const LAS u32x2*)vp, hi = *(const LAS u32x2*)(vp + 16);
                const u32x4 va = (u32x4){lo.x, lo.y, hi.x, hi.y};
                o[cb] = __builtin_amdgcn_mfma_f32_32x32x16_bf16(__builtin_bit_cast(bf16x8, va), __builtin_bit_cast(bf16x8, pw), o[cb], 0, 0, 0);
            }
        }
#pragma unroll
        for (int ks = 0; ks < 4; ++ks) { const bf16x8 bv = *(const LAS bf16x8*)(ldh + GL_C + (32 * cb + r32) * GROWB + 32 * ks + 16 * hh);
            o[cb] = __builtin_amdgcn_mfma_f32_32x32x16_bf16(spf[ks], bv, o[cb], 0, 0, 0); }
    }
    LAS float* ST = (LAS float*)(ldh + GL_ST);
#pragma unroll
    for (int cb = 0; cb < 2; ++cb) { float sm = 0.f;
#pragma unroll
        for (int i = 0; i < 16; ++i) sm += o[cb][i];
        sm += __shfl_xor(sm, 32);
        if (hh == 0) ST[dvb * 64 + 32 * cb + r32] = sm; }
    __syncthreads();
    float mean[2];
#pragma unroll
    for (int cb = 0; cb < 2; ++cb) { const int cc = 32 * cb + r32; mean[cb] = (ST[cc] + ST[64 + cc] + ST[128 + cc] + ST[192 + cc]) * (1.f / 128.f); float sq = 0.f;
#pragma unroll
        for (int i = 0; i < 16; ++i) { o[cb][i] -= mean[cb]; sq += o[cb][i] * o[cb][i]; }
        sq += __shfl_xor(sq, 32);
        if (hh == 0) ST[256 + dvb * 64 + cc] = sq; }
    __syncthreads();
#pragma unroll
    for (int cb = 0; cb < 2; ++cb) { const int cc = 32 * cb + r32; const float var = (ST[256 + cc] + ST[256 + 64 + cc] + ST[256 + 128 + cc] + ST[256 + 192 + cc]) * (1.f / 128.f);
        const float rstd = 1.f / sqrtf(var + LN_EPS);
        bf16_t* op = (bf16_t*)(ws + WS_OAB) + (r0 + cc) * 1024 + 512 + dvbase;
#pragma unroll
        for (int g = 0; g < 4; ++g) { const u32x2 gw = grw[cb][g]; const f32x4 nv = *(const f32x4*)(ng + dvbase + 8 * g);
            float gr[4] = {__uint_as_float(gw.x << 16), __uint_as_float(gw.x & 0xffff0000u), __uint_as_float(gw.y << 16), __uint_as_float(gw.y & 0xffff0000u)}; float y[4];
#pragma unroll
            for (int e = 0; e < 4; ++e) y[e] = o[cb][4 * g + e] * rstd * nv[e] * (gr[e] * __builtin_amdgcn_rcpf(1.f + __expf(-gr[e])));
            u32x2 w; w.x = cvtpk_s(y[0], y[1]); w.y = cvtpk_s(y[2], y[3]); *(u32x2*)(op + 8 * g) = w; } }
}

constexpr size_t WS_SG = 129 * MiB;
constexpr size_t WS_MRG = 257 * MiB;
constexpr size_t WS_H2 = WS_XN;
constexpr size_t WS_XG = 129 * MiB;
constexpr size_t WS_HID = 321 * MiB;
constexpr size_t WS_YG = 358 * MiB;
constexpr size_t WS_EID = WS_MISC + 1 * MiB, WS_EW = WS_EID + 256 * 1024, WS_POS = WS_EW + 256 * 1024, WS_ST1 = WS_POS + 256 * 1024;
constexpr size_t WS_LIST = 490 * MiB;
constexpr int LDS_TAB = 131072;
__device__ __forceinline__ u32x4 pack8(const f32x4 a, const f32x4 b) { u32x4 w; w.x = cvtpk_s(a[0], a[1]); w.y = cvtpk_s(a[2], a[3]); w.z = cvtpk_s(b[0], b[1]); w.w = cvtpk_s(b[2], b[3]); return w; }
__device__ __forceinline__ f32x4 sig4(const f32x4 v) { f32x4 r; r[0] = __builtin_amdgcn_rcpf(1.f + __expf(-v[0])); r[1] = __builtin_amdgcn_rcpf(1.f + __expf(-v[1])); r[2] = __builtin_amdgcn_rcpf(1.f + __expf(-v[2])); r[3] = __builtin_amdgcn_rcpf(1.f + __expf(-v[3])); return r; }
__device__ __forceinline__ void unpack8(const u32x4 w, f32x4& a, f32x4& b) {
    a[0] = __uint_as_float(w.x << 16); a[1] = __uint_as_float(w.x & 0xffff0000u); a[2] = __uint_as_float(w.y << 16); a[3] = __uint_as_float(w.y & 0xffff0000u);
    b[0] = __uint_as_float(w.z << 16); b[1] = __uint_as_float(w.z & 0xffff0000u); b[2] = __uint_as_float(w.w << 16); b[3] = __uint_as_float(w.w & 0xffff0000u);
}
#define EPI_ROWS(...) _Pragma("unroll") for (int ai = 0; ai < 2; ++ai) _Pragma("unroll") for (int m = 0; m < 4; ++m) { const size_t row = (size_t)(row0 + ai * 128 + m * 16); _Pragma("unroll") for (int bj = 0; bj < 2; ++bj) { __VA_ARGS__ } }
struct EpiSig {
    static constexpr bool PERM = true, AFTER_DRAIN = false, MID = false; unsigned char* ws; int half;
    __device__ __forceinline__ void operator()(const f32x4 (&acc)[2][2][4][2], const Unit& u, int wr, int wc, int fr, int fq) const {
        const int row0 = u.pm * 256 + wr * 64 + fr, col0 = half * 1024 + u.pn * 256 + wc * 32 + 8 * fq; bf16_t* SG = (bf16_t*)(ws + WS_SG);
        EPI_ROWS( *(u32x4*)(SG + row * 2048 + col0 + bj * 128) = pack8(sig4(acc[ai][bj][m][0]), sig4(acc[ai][bj][m][1])); )
    }
};
struct EpiMrgF {
    static constexpr bool PERM = true, AFTER_DRAIN = false, MID = true; unsigned char* ws;
    __device__ __forceinline__ void mid(f32x4 (&acc)[2][2][4][2], const Unit& u, int wr, int wc, int fr, int fq) const {
        const int row0 = u.pm * 256 + wr * 64 + fr, col0 = u.pn * 256 + wc * 32 + 8 * fq; const bf16_t* SG = (const bf16_t*)(ws + WS_SG);
        const bf16_t* p = SG + (size_t)row0 * 2048 + col0;
#pragma unroll
        for (int ai = 0; ai < 2; ++ai)
#pragma unroll
            for (int m = 0; m < 4; ++m) {
                asm volatile("" : "+v"(p));
#pragma unroll
                for (int bj = 0; bj < 2; ++bj) { f32x4 a0, a1, b0, b1; unpack8(*(const u32x4*)(p + bj * 128), a0, a1); unpack8(*(const u32x4*)(p + 1024 + bj * 128), b0, b1);
#pragma unroll
                    for (int e = 0; e < 4; ++e) { acc[ai][bj][m][0][e] *= a0[e] * __builtin_amdgcn_rcpf(fmaxf(b0[e], 1e-30f)); acc[ai][bj][m][1][e] *= a1[e] * __builtin_amdgcn_rcpf(fmaxf(b1[e], 1e-30f)); } }
                p += (m == 3 ? (128 - 48) : 16) * 2048; }
    }
    __device__ __forceinline__ void operator()(const f32x4 (&acc)[2][2][4][2], const Unit& u, int wr, int wc, int fr, int fq) const {
        const int row0 = u.pm * 256 + wr * 64 + fr, col0 = u.pn * 256 + wc * 32 + 8 * fq; const bf16_t* SG = (const bf16_t*)(ws + WS_SG) + 1024; bf16_t* MR = (bf16_t*)(ws + WS_MRG);
        EPI_ROWS( f32x4 g0, g1; unpack8(*(const u32x4*)(SG + row * 2048 + col0 + bj * 128), g0, g1); *(u32x4*)(MR + row * 1024 + col0 + bj * 128) = pack8(g0 * acc[ai][bj][m][0], g1 * acc[ai][bj][m][1]); )
    }
};
struct EpiV {
    static constexpr bool PERM = false, AFTER_DRAIN = false, MID = false; const float* x; const float* ada; float* out;
    __device__ __forceinline__ void operator()(const f32x4 (&acc)[2][2][4][2], const Unit& u, int wr, int wc, int fr, int fq) const {
        const int row0 = u.pm * 256 + wr * 64 + fr, col0 = u.pn * 256 + wc * 32 + 4 * fq; const float* gt1 = ada + (size_t)(u.pm >> 4) * 6 * D_MODEL + 2 * D_MODEL;
        EPI_ROWS( _Pragma("unroll") for (int n = 0; n < 2; ++n) { const int c = col0 + bj * 128 + n * 16; const f32x4 xv = *(const f32x4*)(x + row * D_MODEL + c), gv = *(const f32x4*)(gt1 + c);
                  *(f32x4*)(out + row * D_MODEL + c) = xv * DN_ALPHA + gv * acc[ai][bj][m][n]; } )
    }
};
struct EpiHid {
    static constexpr bool PERM = true, AFTER_DRAIN = false, MID = false; unsigned char* ws;
    __device__ __forceinline__ void operator()(const f32x4 (&acc)[2][2][4][2], const Unit& u, int wr, int wc, int fr, int fq) const {
        const int row0 = u.pm * 256 + wr * 64 + fr, col0 = u.pn * 128 + wc * 32 + 8 * fq; bf16_t* H = (bf16_t*)(ws + WS_HID);
#pragma unroll
        for (int ai = 0; ai < 2; ++ai)
#pragma unroll
            for (int m = 0; m < 4; ++m) { const size_t row = (size_t)(row0 + ai * 128 + m * 16); f32x4 h0, h1;
#pragma unroll
                for (int e = 0; e < 4; ++e) { const float g0 = acc[ai][0][m][0][e], g1 = acc[ai][0][m][1][e]; h0[e] = g0 * __builtin_amdgcn_rcpf(1.f + __expf(-g0)) * acc[ai][1][m][0][e]; h1[e] = g1 * __builtin_amdgcn_rcpf(1.f + __expf(-g1)) * acc[ai][1][m][1][e]; }
                *(u32x4*)(H + row * 256 + col0) = pack8(h0, h1); }
    }
};
struct EpiY {
    static constexpr bool PERM = true, AFTER_DRAIN = false, MID = false; unsigned char* ws;
    __device__ __forceinline__ void operator()(const f32x4 (&acc)[2][2][4][2], const Unit& u, int wr, int wc, int fr, int fq) const {
        const int row0 = u.pm * 256 + wr * 64 + fr, col0 = u.pn * 256 + wc * 32 + 8 * fq; bf16_t* Y = (bf16_t*)(ws + WS_YG);
        EPI_ROWS( *(u32x4*)(Y + row * 1024 + col0 + bj * 128) = pack8(acc[ai][bj][m][0], acc[ai][bj][m][1]); )
    }
};
__device__ __forceinline__ void build_tables(unsigned char* ws, LAS unsigned char* lds) {
    LAS int* toff = (LAS int*)(lds + LDS_TAB); LAS int* texp = toff + 64; const unsigned* gcnt = (const unsigned*)(ws + WS_CNT);
    __syncthreads();
    if (threadIdx.x == 0) { int o = 0; for (int e = 0; e < N_EXP; ++e) { toff[e] = o; const int ce = (int)gcnt[e * 32]; toff[400 + e] = ce; o += (ce + 255) >> 8; } toff[32] = o; }
    __syncthreads();
    for (int tl = threadIdx.x; tl < toff[32]; tl += NTHREADS) { int e = 0; while (toff[e + 1] <= tl) ++e; texp[tl] = e; }
    __syncthreads();
}
template <int NPN> struct GroupOrder {
    const LAS int* toff; const LAS int* texp; int G, c;
    __device__ __forceinline__ bool next(int i, Unit& u) const { const int L = i * G + c; if (L >= toff[32] * NPN) return false; const int tl = L / NPN, pn = L % NPN; u.pm = tl; u.pa = tl; u.pn = pn; u.pb = texp[tl] * NPN + pn; return true; }
    __device__ __forceinline__ void a_ready(const Unit&) const {}
    __device__ __forceinline__ void done(const Unit&) const {}
    const int* list;
    __device__ __forceinline__ int a_row(const Unit& u, int r) const { const int e = texp[u.pa]; const int idx = (u.pa - toff[e]) * 256 + r; return idx < toff[400 + e] ? list[e * 32768 + idx] : 0; }
};
constexpr int WT_LD = 1028;
constexpr int P8_LCNT = 36 * WT_LD * 4;
__device__ __forceinline__ float dot16(const f32x4 (&v)[4], const LAS float* wp, int lane) {
    float p = 0.f;
#pragma unroll
    for (int j = 0; j < 4; ++j) { const f32x4 w4 = *(const LAS f32x4*)(wp + 256 * j + 4 * lane); p += (v[j].x * w4.x + v[j].y * w4.y) + (v[j].z * w4.z + v[j].w * w4.w); }
    return p;
}
__device__ __forceinline__ float rl4sum(float v) {
    return (__int_as_float(__builtin_amdgcn_readlane(__float_as_int(v), 0)) + __int_as_float(__builtin_amdgcn_readlane(__float_as_int(v), 16)))
         + (__int_as_float(__builtin_amdgcn_readlane(__float_as_int(v), 32)) + __int_as_float(__builtin_amdgcn_readlane(__float_as_int(v), 48)));
}
template <bool REAL> __device__ __forceinline__ void p8_phase(const float* const* in, float* out, float* x1dst, bf16_t* h2dst, unsigned char* ws, LAS unsigned char* lds, int G) {
    const int tid = threadIdx.x, lane = tid & 63, wave = tid >> 6;
    LAS float* WT = (LAS float*)lds;
    LAS int* lcnt = (LAS int*)(lds + P8_LCNT); LAS int* lbase = lcnt + 32; LAS int* ent = lcnt + 64;
    const float* wrg = in[14]; const float* wre = in[16];
    __syncthreads();
    for (int i = tid; i < 1024; i += NTHREADS) { const f32x4 w = *(const f32x4*)(wrg + 4 * i); WT[0 * WT_LD + i] = w.x; WT[1 * WT_LD + i] = w.y; WT[2 * WT_LD + i] = w.z; WT[3 * WT_LD + i] = w.w; }
    for (int i = tid; i < 8192; i += NTHREADS) { const f32x4 w = *(const f32x4*)(wre + 4 * i); const int k = i >> 3, c = 4 * (i & 7);
        WT[(4 + c) * WT_LD + k] = w.x; WT[(5 + c) * WT_LD + k] = w.y; WT[(6 + c) * WT_LD + k] = w.z; WT[(7 + c) * WT_LD + k] = w.w; }
    const float* g1 = in[12]; const float* b1 = in[13]; const float* brg = in[15]; const float* bre = in[17];
    for (int blk = blockIdx.x; blk < NT / 128; blk += G) {
        const int b = blk / 32; const float* ada = (const float*)(ws + WS_ADA) + (size_t)b * 6 * D_MODEL; const float* sh2 = ada + 3 * D_MODEL; const float* sc2 = ada + 4 * D_MODEL;
        if (tid < 32) lcnt[tid] = 0;
        __syncthreads();
        for (int rb = 0; rb < 16; rb += 4) {
            const int rl0 = wave * 16 + rb; const size_t row0 = (size_t)blk * 128 + rl0;
            f32x4 v[4][4];
#pragma unroll
            for (int r = 0; r < 4; ++r) { const f32x4* xr = (const f32x4*)(out + (row0 + r) * D_MODEL) + lane;
#pragma unroll
                for (int j = 0; j < 4; ++j) v[r][j] = xr[64 * j]; }
            float rstd[4], mean1[4]; ln_center<4>(v, rstd, mean1);
            if (REAL && lane < 4) { typedef float f32x2v __attribute__((ext_vector_type(2))); ((f32x2v*)(ws + WS_ST1))[row0 + lane] = (f32x2v){lane == 0 ? mean1[0] : lane == 1 ? mean1[1] : lane == 2 ? mean1[2] : mean1[3], lane == 0 ? rstd[0] : lane == 1 ? rstd[1] : lane == 2 ? rstd[2] : rstd[3]}; }
#pragma unroll
            for (int j = 0; j < 4; ++j) { const f32x4 gg = *(const f32x4*)(g1 + 256 * j + 4 * lane), bb = *(const f32x4*)(b1 + 256 * j + 4 * lane);
#pragma unroll
                for (int r = 0; r < 4; ++r) v[r][j] = v[r][j] * rstd[r] * gg + bb; }
            ln_center<4>(v, rstd);
#pragma unroll
            for (int j = 0; j < 4; ++j) { const f32x4 a4 = *(const f32x4*)(sc2 + 256 * j + 4 * lane) + 1.f, c4 = *(const f32x4*)(sh2 + 256 * j + 4 * lane);
#pragma unroll
                for (int r = 0; r < 4; ++r) { v[r][j] = v[r][j] * rstd[r] * a4 + c4; u32x2 w; w.x = cvtpk_s(v[r][j].x, v[r][j].y); w.y = cvtpk_s(v[r][j].z, v[r][j].w);
                    ((u32x2*)(h2dst + (row0 + r) * D_MODEL) + lane)[64 * j] = w; } }
#pragma unroll
            for (int r = 0; r < 4; ++r) {
                float gp[N_GROUPS];
#pragma unroll
                for (int g = 0; g < N_GROUPS; ++g) gp[g] = dpp_row_sum_f(dot16(v[r], WT + g * WT_LD, lane));
                float gl[N_GROUPS];
#pragma unroll
                for (int g = 0; g < N_GROUPS; ++g) gl[g] = rl4sum(gp[g]) + brg[g];
                int gi = 0; float gm = gl[0];
#pragma unroll
                for (int g = 1; g < N_GROUPS; ++g) if (gl[g] > gm) { gm = gl[g]; gi = g; }
                float gs = 0.f;
#pragma unroll
                for (int g = 0; g < N_GROUPS; ++g) gs += __expf(gl[g] - gm);
                const float gw = 1.f / gs;
                float ep[EPG];
#pragma unroll
                for (int e = 0; e < EPG; ++e) ep[e] = dpp_row_sum_f(dot16(v[r], WT + (4 + gi * EPG + e) * WT_LD, lane));
                float v0 = -INFINITY, v1 = -INFINITY; int i0 = 0, i1 = 0;
#pragma unroll
                for (int e = 0; e < EPG; ++e) { const float ev = rl4sum(ep[e]) + bre[gi * EPG + e];
                    if (ev > v0) { v1 = v0; i1 = i0; v0 = ev; i0 = e; } else if (ev > v1) { v1 = ev; i1 = e; } }
                const float e1 = __expf(v1 - v0); const float w0 = gw / (1.f + e1), w1 = gw * e1 / (1.f + e1);
                if (REAL && lane == 0) { const int ea = gi * EPG + i0, eb = gi * EPG + i1; const int rl = rl0 + r; const size_t row = row0 + r;
                    const int pa = atomicAdd((int*)&lcnt[ea], 1), pb = atomicAdd((int*)&lcnt[eb], 1);
                    ent[rl * 2] = (ea << 16) | pa; ent[rl * 2 + 1] = (eb << 16) | pb;
                    ((int*)(ws + WS_EID))[row * 2] = ea; ((int*)(ws + WS_EID))[row * 2 + 1] = eb; ((float*)(ws + WS_EW))[row * 2] = w0; ((float*)(ws + WS_EW))[row * 2 + 1] = w1; }
            }
        }
        __syncthreads();
        if (REAL && tid < 32) lbase[tid] = (int)atomicAdd((unsigned*)(ws + WS_CNT) + tid * 32, (unsigned)lcnt[tid]);
        __syncthreads();
        if (REAL && tid < 256) { const int en = ent[tid]; const int e = en >> 16, pos = lbase[e] + (en & 0xffff); ((int*)(ws + WS_POS))[(size_t)blk * 256 + tid] = pos; ((int*)(ws + WS_LIST))[e * 32768 + pos] = blk * 128 + (tid >> 1); }
        __syncthreads();
    }
}
__device__ __forceinline__ void p9_phase(unsigned char* ws, LAS unsigned char* lds, int G) {
    build_tables(ws, lds); const LAS int* toff = (const LAS int*)(lds + LDS_TAB);
    const int lane = threadIdx.x & 63, wave = threadIdx.x >> 6;
    for (int base = (blockIdx.x * NWAVES + wave) * 32; base < NT * 2; base += G * NWAVES * 32) {
        for (int k = 0; k < 32; k += 4) {
            const int ts0 = base + k; const int li = ts0 + (lane & 3);
            const int ev = ((const int*)(ws + WS_EID))[li], pv = ((const int*)(ws + WS_POS))[li];
            u32x4 d0[4], d1[4]; size_t dst[4];
#pragma unroll
            for (int r = 0; r < 4; ++r) { const int e = __builtin_amdgcn_readlane(ev, r), pos = __builtin_amdgcn_readlane(pv, r); dst[r] = (size_t)toff[e] * 256 + pos;
                const u32x4* sp = (const u32x4*)((const bf16_t*)(ws + WS_H2) + (size_t)((ts0 + r) >> 1) * D_MODEL); d0[r] = sp[lane]; d1[r] = sp[lane + 64]; }
#pragma unroll
            for (int r = 0; r < 4; ++r) { u32x4* dp = (u32x4*)((bf16_t*)(ws + WS_XG) + dst[r] * D_MODEL); dp[lane] = d0[r]; dp[lane + 64] = d1[r]; }
        }
    }
}
__device__ __forceinline__ void p12_phase(const float* const* in, float* out, float* dst, unsigned char* ws, LAS unsigned char* lds, int G) {
    build_tables(ws, lds); const LAS int* toff = (const LAS int*)(lds + LDS_TAB);
    const int lane = threadIdx.x & 63, wave = threadIdx.x >> 6; const float* g2 = in[21]; const float* b2 = in[22]; const float* g1 = in[12]; const float* b1 = in[13];
    for (int blk = blockIdx.x; blk < NT / 128; blk += G) {
        const int b = blk / 32; const float* gt2 = (const float*)(ws + WS_ADA) + (size_t)b * 6 * D_MODEL + 5 * D_MODEL;
        for (int rb = 0; rb < 16; rb += 4) {
            const size_t row0 = (size_t)blk * 128 + wave * 16 + rb;
            const size_t li = row0 * 2 + (lane & 7);
            const int ev = ((const int*)(ws + WS_EID))[li], pv = ((const int*)(ws + WS_POS))[li]; const float wv = ((const float*)(ws + WS_EW))[li];
            typedef float f32x2v __attribute__((ext_vector_type(2))); const f32x2v stv = ((const f32x2v*)(ws + WS_ST1))[row0 + (lane & 3)];
            f32x4 v[4][4]; u32x2 ya[4][4], yb[4][4]; float w0[4], w1[4], m1[4], r1[4];
#pragma unroll
            for (int r = 0; r < 4; ++r) {
                const int e0 = __builtin_amdgcn_readlane(ev, 2 * r), e1 = __builtin_amdgcn_readlane(ev, 2 * r + 1), p0 = __builtin_amdgcn_readlane(pv, 2 * r), p1 = __builtin_amdgcn_readlane(pv, 2 * r + 1);
                w0[r] = __int_as_float(__builtin_amdgcn_readlane(__float_as_int(wv), 2 * r)); w1[r] = __int_as_float(__builtin_amdgcn_readlane(__float_as_int(wv), 2 * r + 1));
                m1[r] = __int_as_float(__builtin_amdgcn_readlane(__float_as_int(stv.x), r)); r1[r] = __int_as_float(__builtin_amdgcn_readlane(__float_as_int(stv.y), r));
                const u32x2* y0 = (const u32x2*)((const bf16_t*)(ws + WS_YG) + ((size_t)toff[e0] * 256 + p0) * D_MODEL) + lane; const u32x2* y1 = (const u32x2*)((const bf16_t*)(ws + WS_YG) + ((size_t)toff[e1] * 256 + p1) * D_MODEL) + lane;
                const f32x4* xr = (const f32x4*)(out + (row0 + r) * D_MODEL) + lane;
#pragma unroll
                for (int j = 0; j < 4; ++j) { v[r][j] = xr[64 * j]; ya[r][j] = y0[64 * j]; yb[r][j] = y1[64 * j]; } }
#pragma unroll
            for (int j = 0; j < 4; ++j) { const f32x4 gv = *(const f32x4*)(gt2 + 256 * j + 4 * lane), g1v = *(const f32x4*)(g1 + 256 * j + 4 * lane), b1v = *(const f32x4*)(b1 + 256 * j + 4 * lane);
#pragma unroll
                for (int r = 0; r < 4; ++r) { const u32x2 a = ya[r][j], c = yb[r][j]; f32x4 f; v[r][j] = (v[r][j] - m1[r]) * r1[r] * g1v + b1v;
                    f.x = w0[r] * __uint_as_float(a.x << 16) + w1[r] * __uint_as_float(c.x << 16); f.y = w0[r] * __uint_as_float(a.x & 0xffff0000u) + w1[r] * __uint_as_float(c.x & 0xffff0000u);
                    f.z = w0[r] * __uint_as_float(a.y << 16) + w1[r] * __uint_as_float(c.y << 16); f.w = w0[r] * __uint_as_float(a.y & 0xffff0000u) + w1[r] * __uint_as_float(c.y & 0xffff0000u);
                    v[r][j] = v[r][j] * DN_ALPHA + gv * f; } }
            float rstd[4]; ln_center<4>(v, rstd);
#pragma unroll
            for (int j = 0; j < 4; ++j) { const f32x4 gg = *(const f32x4*)(g2 + 256 * j + 4 * lane), bb = *(const f32x4*)(b2 + 256 * j + 4 * lane);
#pragma unroll
                for (int r = 0; r < 4; ++r) ((f32x4*)(dst + (row0 + r) * D_MODEL) + lane)[64 * j] = v[r][j] * rstd[r] * gg + bb; }
        }
    }
}

constexpr size_t WS_TS = 384 * 1024;
constexpr size_t WS_DEAD = 392 * 1024;
constexpr size_t WS_BAR = 320 * 1024;
#define RLX_AGENT __ATOMIC_RELAXED, __HIP_MEMORY_SCOPE_AGENT
#define XB_TMO      128
#define XB_XCNT(j)  (256  + 64 * (j))
#define XB_XSUB(j)  (1280 + 64 * (j))
#define XB_XGEN(j)  (2304 + 64 * (j))
#define XB_TOP      3328
#define XB_TOPGEN   3392
#define XCD_BAR_WORDS 3456
#define XB_SPIN_CAP (1u << 18)

__device__ __forceinline__ unsigned xb_ld(unsigned* p)              { return __hip_atomic_load(p, __ATOMIC_RELAXED, __HIP_MEMORY_SCOPE_AGENT); }
__device__ __forceinline__ unsigned xb_add(unsigned* p, unsigned v) { return __hip_atomic_fetch_add(p, v, __ATOMIC_RELAXED, __HIP_MEMORY_SCOPE_AGENT); }
__device__ __forceinline__ unsigned xb_xcc_id() { return (unsigned)__builtin_amdgcn_s_getreg((3 << 11) | 20) & 0xFu; }
#define XB_SPIN(cond, bar) do { unsigned _sp = 0; while (cond) { __builtin_amdgcn_s_sleep(1); \
    if ((++_sp & 255u) == 0u) { if (xb_ld(&(bar)[XB_TMO])) break; if (_sp > XB_SPIN_CAP) { atomicAdd(&(bar)[XB_TMO], 1u); break; } } } } while (0)

struct XcdBarrier {
    unsigned* bar; unsigned x;
    volatile LAS unsigned* st;
};

__device__ __forceinline__ XcdBarrier xcd_barrier_post(unsigned* bar, volatile LAS unsigned* st) {
    XcdBarrier b; b.bar = bar; b.x = xb_xcc_id(); b.st = st;
    if (threadIdx.x == 0) (void)xb_add(&bar[XB_XCNT(b.x)], 1u);
    return b;
}
__device__ __forceinline__ void xcd_barrier_complete(unsigned* bar, unsigned x, unsigned& nloc, unsigned& nx) {
    const unsigned G = gridDim.x * gridDim.y * gridDim.z;
    unsigned sum, cnt, mine, sp = 0u;
    for (;;) {
        sum = 0u; cnt = 0u; mine = 0u;
#pragma unroll
        for (unsigned j = 0; j < 16; ++j) { const unsigned c = xb_ld(&bar[XB_XCNT(j)]); sum += c; cnt += (c > 0u) ? 1u : 0u; mine = (j == x) ? c : mine; }
        if (sum == G) break;
        __builtin_amdgcn_s_sleep(1);
        if ((++sp & 255u) == 0u) { if (xb_ld(&bar[XB_TMO])) break; if (sp > XB_SPIN_CAP) { atomicAdd(&bar[XB_TMO], 1u); break; } }
    }
    nloc = mine > 0u ? mine : 1u; nx = cnt > 0u ? cnt : 1u;
}

__device__ __forceinline__ void xcd_barrier(const XcdBarrier& b) {
    asm volatile("s_waitcnt vmcnt(0)" ::: "memory");
    __syncthreads();
    if (threadIdx.x == 0) {
        unsigned* bar = b.bar;
        __builtin_amdgcn_s_waitcnt(0);
        unsigned nloc = b.st[0], nx = b.st[1];
        if (nloc == 0u) { xcd_barrier_complete(bar, b.x, nloc, nx); b.st[0] = nloc; b.st[1] = nx; }
        const unsigned old = xb_add(&bar[XB_XSUB(b.x)], 1u);
        const unsigned gen = old / nloc;
        if (old + 1u == (gen + 1u) * nloc) {
            __builtin_amdgcn_fence(__ATOMIC_RELEASE, "agent");
            asm volatile("s_waitcnt vmcnt(0)" ::: "memory");
            const unsigned og = xb_add(&bar[XB_TOP], 1u);
            const unsigned tg = og / nx;
            if (og + 1u == (tg + 1u) * nx) xb_add(&bar[XB_TOPGEN], 1u);
            else XB_SPIN(xb_ld(&bar[XB_TOPGEN]) == tg, bar);
            __builtin_amdgcn_fence(__ATOMIC_ACQUIRE, "agent");
            xb_add(&bar[XB_XGEN(b.x)], 1u);
            asm volatile("s_waitcnt vmcnt(0)" ::: "memory");
        } else {
            XB_SPIN(xb_ld(&bar[XB_XGEN(b.x)]) == gen, bar);
            __builtin_amdgcn_fence(__ATOMIC_ACQUIRE, "agent");
            asm volatile("s_waitcnt vmcnt(0)" ::: "memory");
        }
    }
    __syncthreads();
}

__device__ __forceinline__ int opaque_i(int v) {
#if DUPMASK_ON
    asm volatile("" : "+v"(v)); v = __builtin_amdgcn_readfirstlane(v);
#endif
    return v; }
constexpr int NPH = 14;
struct Args { const float* in[23]; float* out; unsigned char* ws; int ph_lo, ph_hi; };
__global__ void __launch_bounds__(NTHREADS, 2) mk_fwd(Args a) {
    extern __shared__ __attribute__((aligned(16))) unsigned char lds_raw[];
    LAS unsigned char* lds = (LAS unsigned char*)lds_raw;
    cg::grid_group grid = cg::this_grid();
    const int G = gridDim.x, tid = threadIdx.x, lane = tid & 63, wave = __builtin_amdgcn_readfirstlane(tid >> 6);
    const int lo = a.ph_lo, hi = a.ph_hi;
    unsigned char* ws = a.ws;
    volatile LAS unsigned* bst = (volatile LAS unsigned*)(lds + LDS_BYTES - 16);
    if (tid < 4) bst[tid] = 0u;
    __syncthreads();
    XcdBarrier bar = xcd_barrier_post((unsigned*)(ws + WS_BAR), bst);
    if (TSTAMP && blockIdx.x == 0 && tid == 0) ((unsigned long long*)(ws + WS_TS))[0] = __builtin_amdgcn_s_memrealtime();
    if (a.ph_hi > NPH) grid.sync();
#ifndef PHMASK
#define PHMASK 0xFFFF
#endif
#define IN(k) (((PHMASK >> (k)) & 1) && lo <= (k) && (k) < hi)
#define GRIDBAR() do { if (USE_CG_SYNC) grid.sync(); else xcd_barrier(bar); } while (0)
#define SEAM(k) do { if (IN(k) && IN((k) + 1)) GRIDBAR(); if (TSTAMP && blockIdx.x == 0 && tid == 0) ((unsigned long long*)(ws + WS_TS))[(k) + 1] = __builtin_amdgcn_s_memrealtime(); } while (0)
#define PH(k) for (int rep_ = 0; rep_ < (IN(k) ? 1 + ((DUPMASK >> (k)) & 1) : 0); ++rep_) if (rep_ > 0 && (xcd_barrier(bar), false)) {} else
    PH(0) {
        if (blockIdx.x == 0 && tid < 32) ((unsigned*)(ws + WS_CNT))[tid * 32] = 0u;
        if (blockIdx.x == 2 && tid < 64) ((unsigned*)(ws + WS_DEAD))[tid] = (unsigned)((tid & 15) << 6) * 0x00010001u;
        if (blockIdx.x == 1 && tid < 256) { const float* wgp = a.in[6] + tid; u32x4 w0, w1;
            w0.x = cvtpk_s(wgp[0], wgp[256]); w0.y = cvtpk_s(wgp[512], wgp[768]); w0.z = cvtpk_s(wgp[1024], wgp[1280]); w0.w = cvtpk_s(wgp[1536], wgp[1792]);
            w1.x = cvtpk_s(wgp[2048], wgp[2304]); w1.y = cvtpk_s(wgp[2560], wgp[2816]); w1.z = cvtpk_s(wgp[3072], wgp[3328]); w1.w = cvtpk_s(wgp[3584], wgp[3840]);
            u32x4* dst = (u32x4*)((bf16_t*)(ws + WS_WGT) + tid * 16); dst[0] = w0; dst[1] = w1; }
        LAS float* scr = (LAS float*)(lds + wave * 16384);
        for (int it = blockIdx.x * NWAVES + wave; it < P0_ITEMS; it += G * NWAVES) p0_item(it, a.in, ws, scr, lane);
    }
    SEAM(0);
    PH(1) p1_phase(a.in, ws, lds, G);
    SEAM(1);
    PH(2) {
        pg8::Gemm g{(const bf16_t*)(ws + WS_XN), (const bf16_t*)(ws + WS_WIN), NT, NPROJ, D_MODEL}; pg8::StaticOrder S; S.init(NT, NPROJ, G, (int)blockIdx.x);
        EpiProj E{ws};
        pg8::gemm_phase<EpiProj, pg8::StaticOrder, PG8_ALIGN, PG8_SP2>(lds, g, S, E);
#ifdef DUP_P2
        xcd_barrier(bar);
        pg8::gemm_phase<EpiProj, pg8::StaticOrder, PG8_ALIGN, PG8_SP2>(lds, g, S, E);
#endif
    }
    SEAM(2);
    PH(3) {
        for (int u = blockIdx.x; u < 256; u += G) { const int p = u >> 1, b = p >> 4, qi = p & 15, qj = 31 - qi; LAS unsigned char* lw = lds + wave * 17408;
            for (int rep = 0; rep < ((DUPSUB & 1) ? 2 : 1); ++rep) {
                if ((u & 1) == 0) { p3a_run(b, qi, 0, qi, ws, lw, wave, lane); if (qi < 15) p3a_run(b, qj, 0, 14 - qi, ws, lw, wave, lane); }
                else p3a_run(b, qj, 15 - qi, qj, ws, lw, wave, lane); } }
        for (int p = blockIdx.x; p < GLA_ITEMS / 2; p += G) { p3b_pair(p, a.in[6], a.in[7], a.out, a.out + 24 * MiB, ws, lds); if (DUPSUB & 2) p3b_pair(p, a.in[6], a.in[7], a.out, a.out + 24 * MiB, ws, lds); }
    }
    SEAM(3);
    PH(4) {
        LAS unsigned* rowctr = (LAS unsigned*)(lds + NWAVES * SEL_LDS);
        if (tid == 0) *rowctr = 0u;
        __syncthreads();
        if (wave < 2) for (int j = blockIdx.x; j < 256; j += G) { p4b_item4(j, a.out, (bf16_t*)(a.out + 16 * MiB), ws); if (DUPSUB & 8) p4b_item4(j, a.out, (bf16_t*)(a.out + 16 * MiB), ws); }
        {
            unsigned xa[32], xb[32]; LAS unsigned char* Hw = lds + wave * SEL_LDS;
#define SEL_GRAB() __builtin_amdgcn_readfirstlane((int)(lane == 0 ? __hip_atomic_fetch_add(rowctr, 1u, __ATOMIC_RELAXED, __HIP_MEMORY_SCOPE_WORKGROUP) : 0u))
#define SEL_ROW(i_) (((i_) < 64 ? (i_) >> 3 : ((i_) - 64) >> 3) * NS + ((i_) < 64 ? NS - 1 - ((int)blockIdx.x * NWAVES + ((i_) & 7)) : (int)blockIdx.x * NWAVES + ((i_) & 7)))
            int i0 = SEL_GRAB();
            p4a_load(SEL_ROW(i0 < 127 ? i0 : 127), ws, lane, xa);
#pragma unroll 1
            while (i0 < 128) {
                const int i1 = SEL_GRAB();
                p4a_load(SEL_ROW(i1 < 127 ? i1 : 127), ws, lane, xb);
                p4a_row(SEL_ROW(i0), ws, lane, xa, Hw); if (DUPSUB & 4) p4a_row(SEL_ROW(i0), ws, lane, xa, Hw);
                if (i1 >= 128) break;
                i0 = SEL_GRAB();
                p4a_load(SEL_ROW(i0 < 127 ? i0 : 127), ws, lane, xa);
                p4a_row(SEL_ROW(i1), ws, lane, xb, Hw); if (DUPSUB & 4) p4a_row(SEL_ROW(i1), ws, lane, xb, Hw);
            }
        }
    }
    SEAM(4);
    PH(5) {
        const int c = blockIdx.x; const int bh = c >> 2, sx = c & 3;
        for (int p = blockIdx.x; p < GLA_ITEMS / 2; p += G) { p5b_pair(p, a.out + 24 * MiB, a.in[8], (const bf16_t*)(a.out + 16 * MiB), ws, lds); if (DUPSUB & 32) p5b_pair(p, a.out + 24 * MiB, a.in[8], (const bf16_t*)(a.out + 16 * MiB), ws, lds); }
        if (c < 256) for (int i = 0; i < 4; ++i) { const int Q = (i == 0) ? sx : (i == 1) ? 7 - sx : (i == 2) ? 8 + sx : 15 - sx; if (wave < 4) attn_unit<false>(bh >> 3, bh & 7, Q, a.in[2], ws, lds); else attn_unit<true>(bh >> 3, bh & 7, Q, a.in[2], ws, lds);
            if (DUPSUB & 16) { if (wave < 4) attn_unit<false>(bh >> 3, bh & 7, Q, a.in[2], ws, lds); else attn_unit<true>(bh >> 3, bh & 7, Q, a.in[2], ws, lds); } }
    }
    SEAM(5);
    PH(6) {
        pg8::StaticOrder S; S.init(NT, D_MODEL, G, (int)blockIdx.x);
        { pg8::Gemm g{(const bf16_t*)(ws + WS_XN), (const bf16_t*)(ws + WS_WGAB), NT, D_MODEL, D_MODEL}; EpiSig E{ws, 0}; pg8::gemm_phase<EpiSig, pg8::StaticOrder, PG8_ALIGN, PG8_SP2>(lds, g, S, E); }
        { pg8::Gemm g{(const bf16_t*)(ws + WS_XN), (const bf16_t*)(ws + WS_WGAB) + (size_t)1024 * 1024, NT, D_MODEL, D_MODEL}; EpiSig E{ws, 1}; pg8::gemm_phase<EpiSig, pg8::StaticOrder, PG8_ALIGN, PG8_SP2>(lds, g, S, E); }
        { pg8::Gemm g{(const bf16_t*)(ws + WS_OAB), (const bf16_t*)(ws + WS_WBA), NT, D_MODEL, D_MODEL}; EpiMrgF E{ws}; pg8::gemm_phase<EpiMrgF, pg8::StaticOrder, PG8_ALIGN, PG8_SP2>(lds, g, S, E); }
    }
    SEAM(7);
    PH(8) {
        pg8::Gemm g{(const bf16_t*)(ws + WS_MRG), (const bf16_t*)(ws + WS_WOUT), NT, D_MODEL, D_MODEL}; pg8::StaticOrder S; S.init(NT, D_MODEL, G, (int)blockIdx.x);
        EpiV E{a.in[0], (const float*)(ws + WS_ADA), a.out}; pg8::gemm_phase<EpiV, pg8::StaticOrder, PG8_ALIGN, PG8_SP2>(lds, g, S, E);
    }
    SEAM(8);
#ifdef DUP_P8
    p8_phase<false>(a.in, a.out, (float*)(ws + 129 * MiB), (bf16_t*)(ws + 260 * MiB), ws, lds, G); xcd_barrier(bar);
#endif
    PH(9) p8_phase<true>(a.in, a.out, a.out, (bf16_t*)(ws + WS_H2), ws, lds, G);
    if (IN(9) && IN(11)) { GRIDBAR(); if (TSTAMP && blockIdx.x == 0 && tid == 0) ((unsigned long long*)(ws + WS_TS))[10] = __builtin_amdgcn_s_memrealtime(); }
    PH(11) {
        build_tables(ws, lds);
        pg8::Gemm g{(const bf16_t*)(ws + WS_H2), (const bf16_t*)(ws + WS_W13), 0, 0, D_MODEL}; GroupOrder<2> S{(const LAS int*)(lds + LDS_TAB), (const LAS int*)(lds + LDS_TAB) + 64, G, (int)blockIdx.x, (const int*)(ws + WS_LIST)};
        EpiHid E{ws}; pg8::gemm_phase<EpiHid, GroupOrder<2>, PG8_ALIGN, PG8_SP2, true>(lds, g, S, E);
    }
    SEAM(11);
    PH(12) {
        build_tables(ws, lds);
        int kd = D_EXP; asm volatile("" : "+s"(kd));
        pg8::Gemm g{(const bf16_t*)(ws + WS_HID), (const bf16_t*)(ws + WS_W2), 0, 0, kd}; GroupOrder<4> S{(const LAS int*)(lds + LDS_TAB), (const LAS int*)(lds + LDS_TAB) + 64, G, (int)blockIdx.x, nullptr};
        EpiY E{ws}; pg8::gemm_phase<EpiY, GroupOrder<4>, PG8_ALIGN, PG8_SP2>(lds, g, S, E);
    }
    SEAM(12);
#ifdef DUP_P12
    p12_phase(a.in, a.out, (float*)(ws + 129 * MiB), ws, lds, G); xcd_barrier(bar);
#endif
    PH(13) p12_phase(a.in, a.out, a.out, ws, lds, G);
    if (TSTAMP) { xcd_barrier(bar); if (blockIdx.x == 0 && tid == 0) ((unsigned long long*)(ws + WS_TS))[14] = __builtin_amdgcn_s_memrealtime(); }
#ifdef EXTRA_SYNCS
    for (int i_ = 0; i_ < EXTRA_SYNCS; ++i_) GRIDBAR();
#endif
#undef IN
#undef SEAM
#undef PH
}
}
#if TSTAMP
__global__ void kd_ts(float* out, long n, const unsigned long long* ts, int ka, int kb) {
    const float da = (ka == 14) ? (float)(ts[14] - ts[0]) * 0.01f / 10.f : (float)(ts[ka + 1] - ts[ka]) * 0.01f;
    const float sc = 1.f + da * 0.0005f;
    for (long i = (long)blockIdx.x * blockDim.x + threadIdx.x; i < n; i += (long)gridDim.x * blockDim.x) out[i] *= sc;
}
#endif
extern "C" void kernel_launch(void* const* d_in, const int* in_sizes, int n_in, void* d_out, int out_size,
                              void* d_ws, size_t ws_size, hipStream_t stream) {
    using namespace fk;
    static int grid = 0;
    if (grid == 0) {
        int dev = 0, cus = 0, per_cu = 0; (void)hipGetDevice(&dev); (void)hipDeviceGetAttribute(&cus, hipDeviceAttributeMultiprocessorCount, dev);
        (void)hipFuncSetAttribute((const void*)mk_fwd, hipFuncAttributeMaxDynamicSharedMemorySize, LDS_BYTES);
        (void)hipOccupancyMaxActiveBlocksPerMultiprocessor(&per_cu, (const void*)mk_fwd, NTHREADS, LDS_BYTES);
        (void)hipGetLastError();
        grid = cus * (per_cu >= 1 ? 1 : 1);
        if (ws_size < 512 * MiB) { fprintf(stderr, "kernel_launch: workspace too small\n"); grid = -1; }
    }
    if (grid < 0) return;
    (void)hipMemsetAsync((unsigned char*)d_ws + WS_BAR, 0, 16384, stream);
    Args a{}; for (int i = 0; i < 23; ++i) a.in[i] = (const float*)d_in[i]; a.out = (float*)d_out; a.ws = (unsigned char*)d_ws; a.ph_lo = 0; a.ph_hi = NPH;
    void* args[] = {&a};
    hipError_t e = hipLaunchCooperativeKernel((const void*)mk_fwd, dim3(grid), dim3(NTHREADS), args, LDS_BYTES, stream);
    if (e != hipSuccess) fprintf(stderr, "cooperative launch failed: %s\n", hipGetErrorString(e));
#if TSTAMP
    hipLaunchKernelGGL(kd_ts, dim3(1024), dim3(256), 0, stream, (float*)d_out, (long)out_size, (const unsigned long long*)((unsigned char*)d_ws + WS_TS), TS_A, TS_B);
#endif
}
```

```cpp
#include <hip/hip_runtime.h>
#include <hip/hip_cooperative_groups.h>
#include <cstdio>
#include <cstdint>
#include <cstring>
#include <cmath>
#ifdef HOST_EMU
#include <cmath>
#include <cstdio>
#include <cstdlib>
#include <cstring>
#include <cstdint>
struct Dim3e { int x, y, z; };
static thread_local Dim3e threadIdx, blockIdx, blockDim, gridDim;
#define __global__
#define __device__
#define __host__
#define __forceinline__ inline
#define __launch_bounds__(...)
typedef void* hipStream_t;
template <class F, class... A> static void host_launch(F f, long nb, int nt, A... a) {
#pragma omp parallel for schedule(dynamic, 4)
    for (long b = 0; b < nb; ++b) {
        blockIdx = {(int)b, 0, 0}; blockDim = {nt, 1, 1}; gridDim = {(int)nb, 1, 1};
        for (int t = 0; t < nt; ++t) { threadIdx = {t, 0, 0}; f(a...); }
    }
}
#define LAUNCH(k, nb, nt, st, ...) host_launch(k, (long)(nb), (int)(nt), __VA_ARGS__)
#define UNROLL
#else
#define LAUNCH(k, nb, nt, st, ...) hipLaunchKernelGGL(k, dim3((unsigned)(nb)), dim3((unsigned)(nt)), 0, st, __VA_ARGS__)
#endif

constexpr int D_MODEL = 1024, A_HEADS = 8, A_HD = 64, A_W = 512, I_HEADS = 16, I_DIM = 32, TOPK_MAX = 256, REL_B = 32,
              G_HEADS = 4, G_DK = 64, G_DV = 128, G_KW = 256, G_VW = 512, G_RANK = 16, N_GROUPS = 4, EPG = 8, N_EXP = 32, D_EXP = 256;
constexpr int O_AQ = 0, O_AK = 512, O_AV = 1024, O_IQ = 1536, O_IK = 2048, O_IW = 2080, O_GQ = 2096, O_GK = 2352, O_GV = 2608, O_GR = 3120,
              O_GLR = 3632, O_GA = 3648, O_GB = 4672, D_IN = 5696;
constexpr float DN_ALPHA = 1.189207115002721f, LN_EPS = 1e-5f;
#define V0_GID long gid = (long)blockIdx.x * blockDim.x + threadIdx.x

__device__ __forceinline__ float v0_silu(float v) { return v / (1.f + expf(-v)); }
__device__ __forceinline__ float v0_sigmoid(float v) { return 1.f / (1.f + expf(-v)); }

__global__ void k0_ada(const float* c, const float* w_ada, const float* b_ada, float* ada, int B) {
    V0_GID; if (gid >= (long)B * 6 * D_MODEL) return;
    const int b = (int)(gid / (6 * D_MODEL)), j = (int)(gid % (6 * D_MODEL));
    float acc = 0.f;
    for (int i = 0; i < D_MODEL; ++i) acc += v0_silu(c[b * D_MODEL + i]) * w_ada[(size_t)i * 6 * D_MODEL + j];
    ada[gid] = acc + b_ada[j];
}
__global__ void k0_lnmod(const float* x, const float* sh, const float* sc, float* h, int nrows) {
    V0_GID; if (gid >= nrows) return;
    const float* xr = x + (size_t)gid * D_MODEL; float* hr = h + (size_t)gid * D_MODEL;
    float mu = 0.f; for (int k = 0; k < D_MODEL; ++k) mu += xr[k]; mu *= (1.f / D_MODEL);
    float var = 0.f; for (int k = 0; k < D_MODEL; ++k) { const float d = xr[k] - mu; var += d * d; } var *= (1.f / D_MODEL);
    const float rs = 1.f / sqrtf(var + LN_EPS);
    for (int k = 0; k < D_MODEL; ++k) hr[k] = (xr[k] - mu) * rs * (1.f + sc[k]) + sh[k];
}
__global__ void k0_gemm(const float* A, int lda, const float* W, int ldw, float* C, int ldc, int M, int N, int K) {
    V0_GID; if (gid >= (long)(M / 4) * N) return;
    const int n = (int)(gid % N); const int m0 = (int)(gid / N) * 4;
    float a0 = 0.f, a1 = 0.f, a2 = 0.f, a3 = 0.f;
    const float* A0 = A + (size_t)m0 * lda;
    for (int k = 0; k < K; ++k) { const float w = W[(size_t)k * ldw + n]; a0 += A0[k] * w; a1 += A0[lda + k] * w; a2 += A0[2 * lda + k] * w; a3 += A0[3 * lda + k] * w; }
    C[(size_t)m0 * ldc + n] = a0; C[(size_t)(m0 + 1) * ldc + n] = a1; C[(size_t)(m0 + 2) * ldc + n] = a2; C[(size_t)(m0 + 3) * ldc + n] = a3;
}
__global__ void k0_scores(const float* P, float* scT, int S) {
    V0_GID; if (gid >= (long)S * S) return;
    const int t = (int)(gid % S), s = (int)(gid / S);
    if (s > t) { scT[gid] = -INFINITY; return; }
    const float* iq = P + (size_t)t * D_IN + O_IQ; const float* ik = P + (size_t)s * D_IN + O_IK; const float* iw = P + (size_t)t * D_IN + O_IW;
    const float cst = 0.044194173824159216f;
    float sc = 0.f;
    for (int h = 0; h < I_HEADS; ++h) { float d = 0.f; for (int k = 0; k < I_DIM; ++k) d += iq[h * I_DIM + k] * ik[k]; sc += (iw[h] * cst) * fmaxf(d, 0.f); }
    scT[gid] = sc;
}
__device__ __forceinline__ unsigned v0_key(float f) { unsigned u; memcpy(&u, &f, 4); return (u & 0x80000000u) ? ~u : (u | 0x80000000u); }
__global__ void k0_topk(const float* scT, int* sel, int* cnt, int S, int topk) {
    V0_GID; if (gid >= S) return;
    const int t = (int)gid; const int n = t + 1; int* sl = sel + (size_t)t * TOPK_MAX;
    if (n <= topk) { for (int s = 0; s < n; ++s) sl[s] = s; cnt[t] = n; return; }
    unsigned T = 0u;
    for (int bit = 31; bit >= 0; --bit) { const unsigned cand = T | (1u << bit); int c = 0; for (int s = 0; s < n; ++s) c += (v0_key(scT[(size_t)s * S + t]) >= cand) ? 1 : 0; if (c >= topk) T = cand; }
    int cgt = 0; for (int s = 0; s < n; ++s) cgt += (v0_key(scT[(size_t)s * S + t]) > T) ? 1 : 0;
    int need = topk - cgt, j = 0;
    for (int s = 0; s < n; ++s) { const unsigned k = v0_key(scT[(size_t)s * S + t]); if (k > T) sl[j++] = s; else if (k == T && need > 0) { sl[j++] = s; --need; } }
    cnt[t] = j;
}
__device__ __forceinline__ int v0_bucket(int d) {
    if (d < 16) return d;
    const float df = (float)d; int large = 16 + (int)(logf(df / 16.f) / 2.0794415416798357f * 16.f);
    return large < 31 ? large : 31;
}
__global__ void __launch_bounds__(256) k0_attn(const float* P, const int* sel, const int* cnt, const float* rel_bias, float* oa, int S) {
    V0_GID; if (gid >= (long)S * A_HEADS) return;
    const int t = (int)(gid / A_HEADS), h = (int)(gid % A_HEADS); const int n = cnt[t]; const int* sl = sel + (size_t)t * TOPK_MAX;
    const float* q = P + (size_t)t * D_IN + O_AQ + h * A_HD;
    float m = -INFINITY;
    for (int j = 0; j < n; ++j) { const int s = sl[j]; const float* k = P + (size_t)s * D_IN + O_AK + h * A_HD; float d = 0.f; for (int e = 0; e < A_HD; ++e) d += q[e] * k[e];
        const float l = d * 0.125f + rel_bias[v0_bucket(t - s) * A_HEADS + h]; m = fmaxf(m, l); }
    float o[A_HD];
#pragma unroll
    for (int e = 0; e < A_HD; ++e) o[e] = 0.f;
    float sum = 0.f;
    for (int j = 0; j < n; ++j) { const int s = sl[j]; const float* k = P + (size_t)s * D_IN + O_AK + h * A_HD; const float* v = P + (size_t)s * D_IN + O_AV + h * A_HD; float d = 0.f;
        for (int e = 0; e < A_HD; ++e) d += q[e] * k[e];
        const float p = expf(d * 0.125f + rel_bias[v0_bucket(t - s) * A_HEADS + h] - m); sum += p;
#pragma unroll
        for (int e = 0; e < A_HD; ++e) o[e] += p * v[e]; }
    const float inv = 1.f / sum;
#pragma unroll
    for (int e = 0; e < A_HD; ++e) oa[(size_t)t * A_W + h * A_HD + e] = o[e] * inv;
}
__global__ void k0_gate(const float* P, const float* wg, const float* bg, float* lg, int S) {
    V0_GID; if (gid >= (long)S * G_KW) return;
    const int t = (int)(gid / G_KW), j = (int)(gid % G_KW);
    float z = bg[j]; for (int r = 0; r < G_RANK; ++r) z += P[(size_t)t * D_IN + O_GLR + r] * wg[r * G_KW + j];
    lg[gid] = (fminf(z, 0.f) - log1pf(expf(-fabsf(z)))) * (1.f / 16.f);
}
__global__ void __launch_bounds__(64) k0_gla(const float* P, const float* lg, float* oraw, int S) {
    V0_GID; if (gid >= G_HEADS * G_DV) return;
    const int h = (int)(gid / G_DV), dv = (int)(gid % G_DV);
    float st[G_DK];
#pragma unroll
    for (int d = 0; d < G_DK; ++d) st[d] = 0.f;
    for (int t = 0; t < S; ++t) {
        const float* row = P + (size_t)t * D_IN; const float vv = row[O_GV + h * G_DV + dv]; float o = 0.f;
#pragma unroll
        for (int d = 0; d < G_DK; ++d) { const float a = expf(lg[(size_t)t * G_KW + h * G_DK + d]); st[d] = a * st[d] + row[O_GK + h * G_DK + d] * vv; o += row[O_GQ + h * G_DK + d] * st[d]; }
        oraw[(size_t)t * G_VW + h * G_DV + dv] = o * 0.125f;
    }
}
__global__ void k0_gla_post(const float* P, const float* oraw, const float* ng, float* ob, int S) {
    V0_GID; if (gid >= (long)S * G_HEADS) return;
    const int t = (int)(gid / G_HEADS), h = (int)(gid % G_HEADS); const float* o = oraw + (size_t)t * G_VW + h * G_DV;
    float mu = 0.f; for (int e = 0; e < G_DV; ++e) mu += o[e]; mu *= (1.f / G_DV);
    float var = 0.f; for (int e = 0; e < G_DV; ++e) { const float d = o[e] - mu; var += d * d; } var *= (1.f / G_DV);
    const float rs = 1.f / sqrtf(var + LN_EPS);
    for (int e = 0; e < G_DV; ++e) ob[(size_t)t * G_VW + h * G_DV + e] = (o[e] - mu) * rs * ng[h * G_DV + e] * v0_silu(P[(size_t)t * D_IN + O_GR + h * G_DV + e]);
}
__global__ void k0_merge(const float* P, const float* ba, const float* bb, float* mg, int S) {
    V0_GID; if (gid >= (long)S * D_MODEL) return;
    const int t = (int)(gid / D_MODEL), n = (int)(gid % D_MODEL);
    mg[gid] = v0_sigmoid(P[(size_t)t * D_IN + O_GA + n]) * ba[gid] + v0_sigmoid(P[(size_t)t * D_IN + O_GB + n]) * bb[gid];
}
__global__ void k0_ln1(const float* x, const float* y, const float* gt1, const float* g1, const float* b1, const float* sh2, const float* sc2, float* x1, float* h2, int nrows) {
    V0_GID; if (gid >= nrows) return;
    const float* xr = x + (size_t)gid * D_MODEL; const float* yr = y + (size_t)gid * D_MODEL; float* x1r = x1 + (size_t)gid * D_MODEL; float* h2r = h2 + (size_t)gid * D_MODEL;
    float mu = 0.f; for (int k = 0; k < D_MODEL; ++k) mu += DN_ALPHA * xr[k] + gt1[k] * yr[k]; mu *= (1.f / D_MODEL);
    float var = 0.f; for (int k = 0; k < D_MODEL; ++k) { const float d = DN_ALPHA * xr[k] + gt1[k] * yr[k] - mu; var += d * d; } var *= (1.f / D_MODEL);
    float rs = 1.f / sqrtf(var + LN_EPS);
    for (int k = 0; k < D_MODEL; ++k) x1r[k] = (DN_ALPHA * xr[k] + gt1[k] * yr[k] - mu) * rs * g1[k] + b1[k];
    mu = 0.f; for (int k = 0; k < D_MODEL; ++k) mu += x1r[k]; mu *= (1.f / D_MODEL);
    var = 0.f; for (int k = 0; k < D_MODEL; ++k) { const float d = x1r[k] - mu; var += d * d; } var *= (1.f / D_MODEL);
    rs = 1.f / sqrtf(var + LN_EPS);
    for (int k = 0; k < D_MODEL; ++k) h2r[k] = (x1r[k] - mu) * rs * (1.f + sc2[k]) + sh2[k];
}
__global__ void k0_route(const float* rl, const float* brg, const float* bre, int* eid, float* ew, int nrows) {
    V0_GID; if (gid >= nrows) return;
    const float* r = rl + (size_t)gid * 36;
    float gl[N_GROUPS]; float gm = -INFINITY; int gi = 0;
#pragma unroll
    for (int g = 0; g < N_GROUPS; ++g) { gl[g] = r[g] + brg[g]; if (gl[g] > gm) { gm = gl[g]; gi = g; } }
    float gs = 0.f;
#pragma unroll
    for (int g = 0; g < N_GROUPS; ++g) gs += expf(gl[g] - gm);
    const float gw = 1.f / gs;
    float v0 = -INFINITY, v1 = -INFINITY; int i0 = 0, i1 = 0;
    for (int e = 0; e < EPG; ++e) { const float v = r[4 + gi * EPG + e] + bre[gi * EPG + e];
        if (v > v0) { v1 = v0; i1 = i0; v0 = v; i0 = e; } else if (v > v1) { v1 = v; i1 = e; } }
    const float e1 = expf(v1 - v0); const float w0 = 1.f / (1.f + e1), w1 = e1 / (1.f + e1);
    eid[gid * 2] = gi * EPG + i0; eid[gid * 2 + 1] = gi * EPG + i1; ew[gid * 2] = w0 * gw; ew[gid * 2 + 1] = w1 * gw;
}
__global__ void k0_moe_hid(const float* h2, const int* eid, const float* w1, const float* w3, float* hid, int nrows) {
    V0_GID; if (gid >= (long)nrows * 2 * D_EXP) return;
    const int j = (int)(gid % D_EXP); const long ts = gid / D_EXP; const int t = (int)(ts / 2); const int e = eid[ts];
    const float* hr = h2 + (size_t)t * D_MODEL; const float* a = w1 + (size_t)e * D_MODEL * D_EXP + j; const float* b = w3 + (size_t)e * D_MODEL * D_EXP + j;
    float g = 0.f, u = 0.f; for (int k = 0; k < D_MODEL; ++k) { g += hr[k] * a[(size_t)k * D_EXP]; u += hr[k] * b[(size_t)k * D_EXP]; }
    hid[gid] = v0_silu(g) * u;
}
__global__ void k0_moe_out(const float* hid, const int* eid, const float* ew, const float* w2, float* f, int nrows) {
    V0_GID; if (gid >= (long)nrows * D_MODEL) return;
    const int n = (int)(gid % D_MODEL); const int t = (int)(gid / D_MODEL); float acc = 0.f;
    for (int sl = 0; sl < 2; ++sl) { const int e = eid[t * 2 + sl]; const float* hr = hid + ((size_t)t * 2 + sl) * D_EXP; const float* w = w2 + (size_t)e * D_EXP * D_MODEL + n; float a = 0.f;
        for (int j = 0; j < D_EXP; ++j) a += hr[j] * w[(size_t)j * D_MODEL]; acc += ew[t * 2 + sl] * a; }
    f[gid] = acc;
}
__global__ void k0_final(const float* x1, const float* f, const float* gt2, const float* g2, const float* b2, float* out, int nrows) {
    V0_GID; if (gid >= nrows) return;
    const float* xr = x1 + (size_t)gid * D_MODEL; const float* fr = f + (size_t)gid * D_MODEL; float* o = out + (size_t)gid * D_MODEL;
    float mu = 0.f; for (int k = 0; k < D_MODEL; ++k) mu += DN_ALPHA * xr[k] + gt2[k] * fr[k]; mu *= (1.f / D_MODEL);
    float var = 0.f; for (int k = 0; k < D_MODEL; ++k) { const float d = DN_ALPHA * xr[k] + gt2[k] * fr[k] - mu; var += d * d; } var *= (1.f / D_MODEL);
    const float rs = 1.f / sqrtf(var + LN_EPS);
    for (int k = 0; k < D_MODEL; ++k) o[k] = (DN_ALPHA * xr[k] + gt2[k] * fr[k] - mu) * rs * g2[k] + b2[k];
}

struct V0Buf { float *ada, *h, *P, *scT, *oa, *lg, *oraw, *ob, *ba, *bb, *mg, *y, *x1, *h2, *rl, *ew, *hid, *f; int *sel, *cnt, *eid; size_t bytes; };
static V0Buf v0_carve(void* base, int B, int S) {
    V0Buf b; char* p = (char*)base; auto take = [&](size_t n) { char* r = p; p += (n + 255) & ~(size_t)255; return r; };
    b.ada = (float*)take((size_t)B * 6 * D_MODEL * 4);
    b.P = (float*)take((size_t)S * D_IN * 4);
    b.h = (float*)take((size_t)S * D_MODEL * 4);
    b.scT = (float*)take((size_t)S * S * 4);
    b.sel = (int*)take((size_t)S * TOPK_MAX * 4); b.cnt = (int*)take((size_t)S * 4);
    b.oa = (float*)take((size_t)S * A_W * 4); b.lg = (float*)take((size_t)S * G_KW * 4); b.oraw = (float*)take((size_t)S * G_VW * 4); b.ob = (float*)take((size_t)S * G_VW * 4);
    b.ba = (float*)take((size_t)S * D_MODEL * 4); b.bb = (float*)take((size_t)S * D_MODEL * 4); b.y = (float*)take((size_t)S * D_MODEL * 4);
    b.x1 = (float*)take((size_t)S * D_MODEL * 4); b.h2 = (float*)take((size_t)S * D_MODEL * 4); b.f = (float*)take((size_t)S * D_MODEL * 4);
    b.mg = b.h;
    b.rl = (float*)take((size_t)S * 36 * 4); b.eid = (int*)take((size_t)S * 2 * 4); b.ew = (float*)take((size_t)S * 2 * 4); b.hid = (float*)take((size_t)S * 2 * D_EXP * 4);
    b.bytes = (size_t)(p - (char*)base); return b;
}
static void v0_forward(void* const* d_in, float* out, void* scratch, int B, int S, hipStream_t st, int only_batch = -1, int last_batch = -1) {
    const float *x = (const float*)d_in[0], *c = (const float*)d_in[1], *rel_bias = (const float*)d_in[2], *w_ada = (const float*)d_in[3], *b_ada = (const float*)d_in[4], *w_in = (const float*)d_in[5],
                *wg = (const float*)d_in[6], *bg = (const float*)d_in[7], *ng = (const float*)d_in[8], *wba = (const float*)d_in[9], *wbb = (const float*)d_in[10], *wout = (const float*)d_in[11],
                *g1 = (const float*)d_in[12], *b1 = (const float*)d_in[13], *wrg = (const float*)d_in[14], *brg = (const float*)d_in[15], *wre = (const float*)d_in[16], *bre = (const float*)d_in[17],
                *w1 = (const float*)d_in[18], *w3 = (const float*)d_in[19], *w2 = (const float*)d_in[20], *g2 = (const float*)d_in[21], *b2 = (const float*)d_in[22];
    V0Buf u = v0_carve(scratch, B, S);
    const int TB = 256; auto nb = [&](long n) { return (n + TB - 1) / TB; };
    const int topk = (TOPK_MAX < S / 4) ? TOPK_MAX : S / 4;
    LAUNCH(k0_ada, nb((long)B * 6 * D_MODEL), TB, st, c, w_ada, b_ada, u.ada, B);
    for (int bi = 0; bi < B; ++bi) {
        int b = bi; if (last_batch >= 0) b = (bi == B - 1) ? last_batch : (bi < last_batch ? bi : bi + 1);
        if (only_batch >= 0 && b != only_batch) continue;
        const float* xb = x + (size_t)b * S * D_MODEL; const float* ad = u.ada + (size_t)b * 6 * D_MODEL;
        const float *sh1 = ad, *sc1 = ad + D_MODEL, *gt1 = ad + 2 * D_MODEL, *sh2 = ad + 3 * D_MODEL, *sc2 = ad + 4 * D_MODEL, *gt2 = ad + 5 * D_MODEL;
        LAUNCH(k0_lnmod, nb(S), TB, st, xb, sh1, sc1, u.h, S);
        LAUNCH(k0_gemm, nb((long)(S / 4) * D_IN), TB, st, (const float*)u.h, D_MODEL, w_in, D_IN, u.P, D_IN, S, D_IN, D_MODEL);
        LAUNCH(k0_scores, nb((long)S * S), TB, st, (const float*)u.P, u.scT, S);
        LAUNCH(k0_topk, nb(S), TB, st, (const float*)u.scT, u.sel, u.cnt, S, topk);
        LAUNCH(k0_attn, nb((long)S * A_HEADS), TB, st, (const float*)u.P, (const int*)u.sel, (const int*)u.cnt, rel_bias, u.oa, S);
        LAUNCH(k0_gate, nb((long)S * G_KW), TB, st, (const float*)u.P, wg, bg, u.lg, S);
        LAUNCH(k0_gla, (G_HEADS * G_DV + 63) / 64, 64, st, (const float*)u.P, (const float*)u.lg, u.oraw, S);
        LAUNCH(k0_gla_post, nb((long)S * G_HEADS), TB, st, (const float*)u.P, (const float*)u.oraw, ng, u.ob, S);
        LAUNCH(k0_gemm, nb((long)(S / 4) * D_MODEL), TB, st, (const float*)u.oa, A_W, wba, D_MODEL, u.ba, D_MODEL, S, D_MODEL, A_W);
        LAUNCH(k0_gemm, nb((long)(S / 4) * D_MODEL), TB, st, (const float*)u.ob, G_VW, wbb, D_MODEL, u.bb, D_MODEL, S, D_MODEL, G_VW);
        LAUNCH(k0_merge, nb((long)S * D_MODEL), TB, st, (const float*)u.P, (const float*)u.ba, (const float*)u.bb, u.mg, S);
        LAUNCH(k0_gemm, nb((long)(S / 4) * D_MODEL), TB, st, (const float*)u.mg, D_MODEL, wout, D_MODEL, u.y, D_MODEL, S, D_MODEL, D_MODEL);
        LAUNCH(k0_ln1, nb(S), TB, st, xb, (const float*)u.y, gt1, g1, b1, sh2, sc2, u.x1, u.h2, S);
        LAUNCH(k0_gemm, nb((long)(S / 4) * N_GROUPS), TB, st, (const float*)u.h2, D_MODEL, wrg, N_GROUPS, u.rl, 36, S, N_GROUPS, D_MODEL);
        LAUNCH(k0_gemm, nb((long)(S / 4) * N_EXP), TB, st, (const float*)u.h2, D_MODEL, wre, N_EXP, u.rl + 4, 36, S, N_EXP, D_MODEL);
        LAUNCH(k0_route, nb(S), TB, st, (const float*)u.rl, brg, bre, u.eid, u.ew, S);
        LAUNCH(k0_moe_hid, nb((long)S * 2 * D_EXP), TB, st, (const float*)u.h2, (const int*)u.eid, w1, w3, u.hid, S);
        LAUNCH(k0_moe_out, nb((long)S * D_MODEL), TB, st, (const float*)u.hid, (const int*)u.eid, (const float*)u.ew, w2, u.f, S);
        LAUNCH(k0_final, nb(S), TB, st, (const float*)u.x1, (const float*)u.f, gt2, g2, b2, out + (size_t)b * S * D_MODEL, S);
    }
}
namespace pg8 {
#define PG8_LAS __attribute__((address_space(3)))
typedef unsigned short bf16_t;
typedef short bf16x8 __attribute__((ext_vector_type(8)));
typedef float f32x4 __attribute__((ext_vector_type(4)));
typedef unsigned u32x4 __attribute__((ext_vector_type(4)));
constexpr int BM = 256, BK = 64, HALF = 128, HTB = HALF * BK * 2  , STAGE_BYTES = 8 * HTB, NXCD = 8, WGM = 8;

__host__ __device__ __forceinline__ int lds_byte(int r, int c) { const int st = (r >> 4) * 2 + (c >> 5), rr = r & 15, cc = c & 31, ob = rr * 64 + cc * 2; return st * 1024 + (ob ^ (((ob >> 9) & 1) << 5)); }
__host__ __device__ __forceinline__ void stage_rc(int b, int& R, int& C) { const int st = b / 1024, sb = b % 1024, swz = sb ^ (((sb >> 9) & 1) << 5); R = (st >> 1) * 16 + swz / 64; C = (st & 1) * 32 + (swz % 64) / 2; }
__host__ __device__ __forceinline__ int perm32(int rho) { const int n = rho >> 4, i = rho & 15; return 8 * (i >> 2) + 4 * n + (i & 3); }

struct Unit { int pm, pn, pa, pb; };
struct Gemm { const bf16_t* A; const bf16_t* Bt; int M, N, K; };

struct StaticOrder {
    int nM, nN, nwg, G, c;
    __host__ __device__ void init(int M, int N, int G_, int c_) { nM = M / BM; nN = N / BM; nwg = nM * nN; G = G_; c = c_; }
    __host__ __device__ bool next(int i, Unit& u) const {
        const long L = (long)i * G + c; if (L >= nwg) return false;
        int wgid = (int)L; { const int q = nwg / NXCD, r = nwg % NXCD, xcd = wgid % NXCD, off = wgid / NXCD; wgid = (xcd < r ? xcd * (q + 1) : r * (q + 1) + (xcd - r) * q) + off; }
        const int nig = WGM * nN, gid = wgid / nig, fm = gid * WGM, gsz = (nM - fm) < WGM ? (nM - fm) : WGM;
        u.pm = fm + ((wgid % nig) % gsz); u.pn = (wgid % nig) / gsz; u.pa = u.pm; u.pb = u.pn; return true;
    }
    __device__ __forceinline__ void a_ready(const Unit&) const {}
    __device__ __forceinline__ void done(const Unit&) const {}
};

__device__ __forceinline__ unsigned cvt_pk_bf16(float lo, float hi) { unsigned r; asm volatile("v_cvt_pk_bf16_f32 %0, %1, %2" : "=v"(r) : "v"(lo), "v"(hi)); return r; }
typedef float f32x2 __attribute__((ext_vector_type(2)));

template <class Epi, class Sched, bool ALIGN_EPI = false, bool SP2 = false, bool GATHER = false>
__device__ __forceinline__ void gemm_phase(PG8_LAS unsigned char* lds, const Gemm g, const Sched& S, const Epi& E) {
    const int tid = threadIdx.x, wid = __builtin_amdgcn_readfirstlane(tid >> 6), lane = tid & 63, wr = wid >> 2, wc = wid & 3, fr = lane & 15, fq = lane >> 4;
    const int K = g.K, nt = K / BK;
    static_assert(!GATHER || SP2, "gathered A rows: SP2 loop only");
    unsigned voffA[2], voffB[2]; int Rr[2], Cc[2];
#pragma unroll
    for (int i = 0; i < 2; ++i) { int R, C; stage_rc(tid * 16 + i * 8192, R, C); const int Rb = Epi::PERM ? ((R & ~31) + perm32(R & 31)) : R; Rr[i] = R; Cc[i] = C;
        voffA[i] = (unsigned)(R * K + C) * 2u; voffB[i] = (unsigned)(Rb * K + C) * 2u; }
    unsigned vc0[2] = {voffA[0], voffA[1]}, vc1[2] = {voffA[0], voffA[1]}, vn0[2] = {voffA[0], voffA[1]}, vn1[2] = {voffA[0], voffA[1]};
    const size_t kstep = (size_t)(BK * 2);
    const size_t hstep = (size_t)HALF * K * 2;
    const size_t tstep = 2 * hstep;
    const unsigned ldsw = (unsigned)wid * 1024u;
    const int aoff = lds_byte(wr * 64 + fr, fq * 8), boff = lds_byte(wc * 32 + fr, fq * 8);
#define PG8_SA(b, h) (((b) * 2 + (h)) * HTB)
#define PG8_SB(b, h) ((4 + (b) * 2 + (h)) * HTB)
#define PG8_STAGE(bufoff, gbase, voff) do { _Pragma("unroll") for (int _i = 0; _i < 2; ++_i) \
        __builtin_amdgcn_global_load_lds((const unsigned*)((const char*)(gbase) + (voff)[_i]), (PG8_LAS unsigned*)(lds + (bufoff) + ldsw + _i * 8192), 16, 0, 0); } while (0)
#define PG8_LDA(dst, b, h) do { _Pragma("unroll") for (int m = 0; m < 4; ++m) _Pragma("unroll") for (int k = 0; k < 2; ++k) dst[m][k] = *(const PG8_LAS bf16x8*)(lds + PG8_SA(b, h) + aoff + m * 2048 + k * 1024); } while (0)
#define PG8_LDB(dst, b, h) do { _Pragma("unroll") for (int n = 0; n < 2; ++n) _Pragma("unroll") for (int k = 0; k < 2; ++k) dst[n][k] = *(const PG8_LAS bf16x8*)(lds + PG8_SB(b, h) + boff + n * 2048 + k * 1024); } while (0)
#define PG8_MMA(ai, bj, At, Bt) do { __builtin_amdgcn_s_setprio(1); _Pragma("unroll") for (int m = 0; m < 4; ++m) _Pragma("unroll") for (int n = 0; n < 2; ++n) _Pragma("unroll") for (int k = 0; k < 2; ++k) \
        acc[ai][bj][m][n] = __builtin_amdgcn_mfma_f32_16x16x32_bf16(Bt[n][k], At[m][k], acc[ai][bj][m][n], 0, 0, 0); __builtin_amdgcn_s_setprio(0); } while (0)
#define PG8_WAIT_V(n) asm volatile("s_waitcnt vmcnt(" #n ")" ::: "memory")
#define PG8_WAIT_L(n) asm volatile("s_waitcnt lgkmcnt(" #n ")" ::: "memory")
#define PG8_BAR __builtin_amdgcn_s_barrier()
#define PG8_SCHED __builtin_amdgcn_sched_barrier(0)
    Unit cur, nxt; int ui = 0;
    if (!S.next(0, cur)) return;
    f32x4 acc[2][2][4][2];
#pragma unroll
    for (int a = 0; a < 2; ++a)
#pragma unroll
        for (int b = 0; b < 2; ++b)
#pragma unroll
            for (int m = 0; m < 4; ++m)
#pragma unroll
                for (int n = 0; n < 2; ++n) acc[a][b][m][n] = (f32x4){0.f, 0.f, 0.f, 0.f};
    bf16x8 At[4][2], B0[2][2], B1[2][2];
    const char* cA = GATHER ? (const char*)g.A : (const char*)g.A + (size_t)cur.pa * tstep; const char* cB = (const char*)g.Bt + (size_t)cur.pb * tstep;
    const size_t hstepA = GATHER ? 0 : hstep;
    if constexpr (GATHER) {
#pragma unroll
        for (int i = 0; i < 2; ++i) { vc0[i] = (unsigned)S.a_row(cur, Rr[i]) * (unsigned)(K * 2) + (unsigned)(Cc[i] * 2); vc1[i] = (unsigned)S.a_row(cur, HALF + Rr[i]) * (unsigned)(K * 2) + (unsigned)(Cc[i] * 2); } }
    S.a_ready(cur);
    if constexpr (SP2) {
        PG8_STAGE(PG8_SB(0, 0), cB, voffB); PG8_STAGE(PG8_SB(0, 1), cB + hstep, voffB); PG8_STAGE(PG8_SA(0, 0), cA, vc0); PG8_STAGE(PG8_SA(0, 1), cA + hstepA, vc1);
        if (wr == 1) PG8_BAR;
        PG8_WAIT_V(2); PG8_BAR;
        PG8_STAGE(PG8_SB(1, 0), cB + kstep, voffB); PG8_STAGE(PG8_SA(1, 0), cA + kstep, vc0); PG8_STAGE(PG8_SB(1, 1), cB + hstep + kstep, voffB);
        PG8_WAIT_V(6); PG8_BAR;
    } else {
        PG8_STAGE(PG8_SB(0, 0), cB, voffB); PG8_STAGE(PG8_SA(0, 0), cA, voffA); PG8_STAGE(PG8_SB(0, 1), cB + hstep, voffB); PG8_STAGE(PG8_SA(0, 1), cA + hstep, voffA);
        if (wr == 1) PG8_BAR;
        PG8_WAIT_V(4); PG8_BAR;
        PG8_STAGE(PG8_SB(1, 0), cB + kstep, voffB); PG8_STAGE(PG8_SA(1, 0), cA + kstep, voffA); PG8_STAGE(PG8_SB(1, 1), cB + hstep + kstep, voffB);
        PG8_WAIT_V(6); PG8_BAR;
    }
    for (;;) {
        const bool has_next = S.next(ui + 1, nxt);
        const char* nA = GATHER ? cA : (has_next ? (const char*)g.A + (size_t)nxt.pa * tstep : cA); const char* nB = has_next ? (const char*)g.Bt + (size_t)nxt.pb * tstep : cB;
        if constexpr (GATHER) {
#pragma unroll
            for (int i = 0; i < 2; ++i) { vn0[i] = has_next ? (unsigned)S.a_row(nxt, Rr[i]) * (unsigned)(K * 2) + (unsigned)(Cc[i] * 2) : vc0[i]; vn1[i] = has_next ? (unsigned)S.a_row(nxt, HALF + Rr[i]) * (unsigned)(K * 2) + (unsigned)(Cc[i] * 2) : vc1[i]; } }
        for (int t = 0; t < nt; t += 2) {
            const bool last = (t == nt - 2);
            if constexpr (Epi::MID) { if (t == nt / 2) E.mid(acc, cur, wr, wc, fr, fq); }
            const char* a1 = cA + (size_t)(t + 1) * kstep;
            const char* a2 = last ? nA : cA + (size_t)(t + 2) * kstep; const char* b2 = last ? nB : cB + (size_t)(t + 2) * kstep;
            const char* a3 = a2 + kstep; const char* b3 = b2 + kstep;
            if (last && has_next) S.a_ready(nxt);
            if constexpr (SP2) {
            unsigned w0[2], w1[2];
#pragma unroll
            for (int i = 0; i < 2; ++i) { w0[i] = last ? vn0[i] : vc0[i]; w1[i] = last ? vn1[i] : vc1[i]; }
            PG8_LDB(B0, 0, 0); PG8_LDB(B1, 0, 1); PG8_SCHED; PG8_LDA(At, 0, 0); PG8_STAGE(PG8_SA(1, 1), a1 + hstepA, vc1);
            PG8_WAIT_V(8); PG8_WAIT_L(0); PG8_BAR; PG8_MMA(0, 0, At, B0); PG8_MMA(0, 1, At, B1); PG8_BAR; PG8_SCHED;
            PG8_LDA(At, 0, 1); PG8_STAGE(PG8_SB(0, 0), b2, voffB); PG8_STAGE(PG8_SB(0, 1), b2 + hstep, voffB); PG8_STAGE(PG8_SA(0, 0), a2, w0);
            PG8_WAIT_V(8); PG8_WAIT_L(0); PG8_BAR; PG8_MMA(1, 0, At, B0); PG8_MMA(1, 1, At, B1); PG8_BAR; PG8_SCHED;
            PG8_LDB(B0, 1, 0); PG8_LDB(B1, 1, 1); PG8_SCHED; PG8_LDA(At, 1, 0); PG8_STAGE(PG8_SA(0, 1), a2 + hstepA, w1);
            PG8_WAIT_V(8); PG8_WAIT_L(0); PG8_BAR; PG8_MMA(0, 0, At, B0); PG8_MMA(0, 1, At, B1); PG8_BAR; PG8_SCHED;
            PG8_LDA(At, 1, 1); PG8_STAGE(PG8_SB(1, 0), b3, voffB); PG8_STAGE(PG8_SB(1, 1), b3 + hstep, voffB); PG8_STAGE(PG8_SA(1, 0), a3, w0);
            PG8_WAIT_V(8); PG8_WAIT_L(0); PG8_BAR; PG8_MMA(1, 0, At, B0); PG8_MMA(1, 1, At, B1); PG8_BAR; PG8_SCHED;
            } else {
            PG8_LDB(B0, 0, 0); PG8_SCHED; PG8_LDA(At, 0, 0); PG8_STAGE(PG8_SA(1, 1), a1 + hstep, voffA);
            PG8_WAIT_L(8); PG8_BAR; PG8_WAIT_L(0); PG8_MMA(0, 0, At, B0); PG8_BAR; PG8_SCHED;
            PG8_LDB(B1, 0, 1); PG8_STAGE(PG8_SB(0, 0), b2, voffB);
            PG8_BAR; PG8_WAIT_L(0); PG8_MMA(0, 1, At, B1); PG8_BAR;
            PG8_LDA(At, 0, 1); PG8_STAGE(PG8_SA(0, 0), a2, voffA);
            PG8_BAR; PG8_WAIT_L(0); PG8_MMA(1, 0, At, B0); PG8_BAR; PG8_SCHED;
            PG8_STAGE(PG8_SB(0, 1), b2 + hstep, voffB);
            PG8_WAIT_V(6); PG8_BAR; PG8_MMA(1, 1, At, B1); PG8_BAR;
            PG8_LDB(B0, 1, 0); PG8_SCHED; PG8_LDA(At, 1, 0); PG8_STAGE(PG8_SA(0, 1), a2 + hstep, voffA);
            PG8_WAIT_L(8); PG8_BAR; PG8_WAIT_L(0); PG8_MMA(0, 0, At, B0); PG8_BAR; PG8_SCHED;
            PG8_LDB(B1, 1, 1); PG8_STAGE(PG8_SB(1, 0), b3, voffB);
            PG8_BAR; PG8_WAIT_L(0); PG8_MMA(0, 1, At, B1); PG8_BAR;
            PG8_LDA(At, 1, 1); PG8_STAGE(PG8_SA(1, 0), a3, voffA);
            PG8_BAR; PG8_WAIT_L(0); PG8_MMA(1, 0, At, B0); PG8_BAR; PG8_SCHED;
            PG8_STAGE(PG8_SB(1, 1), b3 + hstep, voffB);
            PG8_WAIT_V(6); PG8_BAR; PG8_MMA(1, 1, At, B1); PG8_BAR;
            }
        }
        if constexpr (ALIGN_EPI) { if (wr == 0) PG8_BAR; }
        if constexpr (!Epi::AFTER_DRAIN) { E(acc, cur, wr, wc, fr, fq); S.done(cur); }
        if (!has_next) break;
#pragma unroll
        for (int a = 0; a < 2; ++a)
#pragma unroll
            for (int b = 0; b < 2; ++b)
#pragma unroll
                for (int m = 0; m < 4; ++m)
#pragma unroll
                    for (int n = 0; n < 2; ++n) acc[a][b][m][n] = (f32x4){0.f, 0.f, 0.f, 0.f};
        cur = nxt; cA = nA; cB = nB; ++ui;
        if constexpr (GATHER) { vc0[0] = vn0[0]; vc0[1] = vn0[1]; vc1[0] = vn1[0]; vc1[1] = vn1[1]; }
        if constexpr (ALIGN_EPI) { if (wr == 1) PG8_BAR; }
    }
    PG8_WAIT_V(0);
    if constexpr (!ALIGN_EPI) { if (wr == 0) PG8_BAR; }
    PG8_BAR;
    if constexpr (Epi::AFTER_DRAIN) { E.fused(acc, cur, wr, wc, fr, fq, lds, wid, lane); S.done(cur); }
#undef PG8_SA
#undef PG8_SB
#undef PG8_STAGE
#undef PG8_LDA
#undef PG8_LDB
#undef PG8_MMA
#undef PG8_WAIT_V
#undef PG8_WAIT_L
#undef PG8_BAR
#undef PG8_SCHED
}
}

#ifndef PG8_SP2
#define PG8_SP2 true
#endif
#ifndef PG8_ALIGN
#define PG8_ALIGN true
#endif
#ifndef DUPSUB
#define DUPSUB 0
#endif
#ifndef TSTAMP
#define TSTAMP 0
#endif
#ifndef USE_CG_SYNC
#define USE_CG_SYNC 0
#endif
#ifndef DUPMASK
#define DUPMASK 0
#define DUPMASK_ON 0
#else
#define DUPMASK_ON 1
#endif
namespace cg = cooperative_groups;
namespace fk {
using pg8::bf16_t; using pg8::f32x4; using pg8::u32x4; using pg8::bf16x8; using pg8::Unit; using pg8::cvt_pk_bf16;
#define LAS __attribute__((address_space(3)))
#define LDS_WAIT() asm volatile("s_waitcnt lgkmcnt(0)" ::: "memory")
typedef unsigned u32x2 __attribute__((ext_vector_type(2)));
constexpr int NB = 8, NS = 4096, NT = NB * NS;
constexpr int NTHREADS = 512, NWAVES = 8, LDS_BYTES = 155648;
constexpr size_t MiB = (size_t)1 << 20;
constexpr size_t WS_ADA = 0, WS_CNT = 256 * 1024,
    WS_WIN = 1 * MiB, WS_WGAB = 9 * MiB, WS_WBA = 13 * MiB, WS_WBB = 14 * MiB, WS_WOUT = 15 * MiB, WS_W13 = 17 * MiB, WS_W2 = 49 * MiB,
    WS_XN = 65 * MiB, WS_QKV = 129 * MiB, WS_IQ = 225 * MiB, WS_GQK = 257 * MiB, WS_GV = 289 * MiB, WS_GR = 321 * MiB,
    WS_IK = 353 * MiB, WS_IW = 355 * MiB, WS_GLR = 357 * MiB, WS_SC = 358 * MiB, WS_MASK = 490 * MiB, WS_ADAP = 506 * MiB, WS_MISC = 509 * MiB;
constexpr int NPROJ = 3584;
constexpr size_t WS_WGT = 400 * 1024;
constexpr int KSL = 16;
constexpr float QSCALE = 0.125f * 1.4426950408889634f;
typedef float f32x2_t __attribute__((ext_vector_type(2))); typedef __bf16 bf16x2_t __attribute__((ext_vector_type(2)));
__device__ __forceinline__ unsigned cvtpk_s(float lo, float hi) { f32x2_t v = {lo, hi}; bf16x2_t b = __builtin_convertvector(v, bf16x2_t); return __builtin_bit_cast(unsigned, b); }
__device__ __forceinline__ void bf8_to_f(const u32x4 w, float* f) {
#pragma unroll
    for (int j = 0; j < 4; ++j) { f[2 * j] = __uint_as_float(w[j] << 16); f[2 * j + 1] = __uint_as_float(w[j] & 0xffff0000u); }
}

__device__ __forceinline__ void tr_item(const float* W, int ldw, int srccol, bf16_t* WT, int K, int dst_row0, int kb, LAS float* scr, int lane, int kdst0 = 0) {
    const int k0 = 64 * kb;
#pragma unroll
    for (int i = 0; i < 32; ++i) { const int kk = 2 * i + (lane >> 5); scr[kk * 33 + (lane & 31)] = W[(size_t)(k0 + kk) * ldw + srccol]; }
    LDS_WAIT();
    const int c = lane & 7;
#pragma unroll
    for (int j = 0; j < 4; ++j) { const int n = (lane >> 3) + 8 * j; const LAS float* s = scr + (8 * c) * 33 + n;
        u32x4 o; o.x = cvt_pk_bf16(s[0 * 33], s[1 * 33]); o.y = cvt_pk_bf16(s[2 * 33], s[3 * 33]); o.z = cvt_pk_bf16(s[4 * 33], s[5 * 33]); o.w = cvt_pk_bf16(s[6 * 33], s[7 * 33]);
        *(u32x4*)(WT + (size_t)(dst_row0 + n) * K + kdst0 + k0 + 8 * c) = o; }
    LDS_WAIT();
}
__device__ __forceinline__ int win_src(int n) {
    if (n < 2048) return n;
    if (n < 3584) return n + 48;
    if (n < 3616) return O_IK + (n - 3584);
    if (n < 3632) return O_IW + (n - 3616);
    return O_GLR + (n - 3632);
}
constexpr int I_ADA = 96 * KSL, I_WIN = 114 * 16, I_WGAB = 64 * 16, I_WB = 32 * 8, I_WOUT = 32 * 16, I_W13 = 32 * 16 * 16, I_W2 = 32 * 32 * 4;
constexpr int P0_ITEMS = I_ADA + I_WIN + I_WGAB + 2 * I_WB + I_WOUT + I_W13 + I_W2, P0_EARLY = I_ADA + I_WIN + I_WGAB + 2 * I_WB + I_WOUT;
__device__ __forceinline__ void p0_item(int it, const float* const* in, unsigned char* ws, LAS float* scr, int lane) {
    if (it < I_ADA) {
        const int cb = it / KSL, ks = it % KSL, k0 = ks * 64; const float* c = in[1]; const float* w = in[3];
#pragma unroll
        for (int b = 0; b < NB; ++b) { const float cv = c[b * D_MODEL + k0 + lane]; scr[b * 64 + lane] = cv / (1.f + __expf(-cv)); }
        LDS_WAIT();
        float acc[NB];
#pragma unroll
        for (int b = 0; b < NB; ++b) acc[b] = 0.f;
        const int col = cb * 64 + lane;
#pragma unroll 16
        for (int kk = 0; kk < 64; ++kk) { const float wv = w[(size_t)(k0 + kk) * (6 * D_MODEL) + col];
#pragma unroll
            for (int b = 0; b < NB; ++b) acc[b] += scr[b * 64 + kk] * wv; }
        float* adap = (float*)(ws + WS_ADAP);
#pragma unroll
        for (int b = 0; b < NB; ++b) adap[(size_t)(ks * NB + b) * (6 * D_MODEL) + col] = acc[b];
        LDS_WAIT(); return;
    }
    it -= I_ADA;
    const int l31 = lane & 31;
    if (it < I_WIN) { const int nb = it / 16, kb = it % 16; tr_item(in[5], D_IN, win_src(nb * 32 + l31), (bf16_t*)(ws + WS_WIN), 1024, nb * 32, kb, scr, lane); return; }
    it -= I_WIN;
    if (it < I_WGAB) { const int nb = it / 16, kb = it % 16; tr_item(in[5], D_IN, O_GA + nb * 32 + l31, (bf16_t*)(ws + WS_WGAB), 1024, nb * 32, kb, scr, lane); return; }
    it -= I_WGAB;
    if (it < I_WB) { const int nb = it / 8, kb = it % 8; tr_item(in[9], D_MODEL, nb * 32 + l31, (bf16_t*)(ws + WS_WBA), 1024, nb * 32, kb, scr, lane, 0); return; }
    it -= I_WB;
    if (it < I_WB) { const int nb = it / 8, kb = it % 8; tr_item(in[10], D_MODEL, nb * 32 + l31, (bf16_t*)(ws + WS_WBA), 1024, nb * 32, kb, scr, lane, 512); return; }
    it -= I_WB;
    if (it < I_WOUT) { const int nb = it / 16, kb = it % 16; tr_item(in[11], D_MODEL, nb * 32 + l31, (bf16_t*)(ws + WS_WOUT), 1024, nb * 32, kb, scr, lane); return; }
    it -= I_WOUT;
    if (it < I_W13) {
        const int e = it / 256, r = it % 256, nb = r / 16, kb = r % 16; const int row0 = nb * 32;
        const int half = (row0 & 255) >> 7; const int col = (row0 >> 8) * 128 + (row0 & 127) + l31;
        const float* src = (half ? in[19] : in[18]) + (size_t)e * D_MODEL * D_EXP;
        tr_item(src, D_EXP, col, (bf16_t*)(ws + WS_W13) + (size_t)e * 512 * 1024, 1024, row0, kb, scr, lane); return; }
    it -= I_W13;
    { const int e = it / 128, r = it % 128, nb = r / 4, kb = r % 4;
      tr_item(in[20] + (size_t)e * D_EXP * D_MODEL, D_MODEL, nb * 32 + l31, (bf16_t*)(ws + WS_W2) + (size_t)e * 1024 * 256, 256, nb * 32, kb, scr, lane); }
}

__device__ __forceinline__ float dpp_row_sum_f(float v) {
    v += __int_as_float(__builtin_amdgcn_update_dpp(0, __float_as_int(v), 0xB1, 0xF, 0xF, true));
    v += __int_as_float(__builtin_amdgcn_update_dpp(0, __float_as_int(v), 0x4E, 0xF, 0xF, true));
    v += __int_as_float(__builtin_amdgcn_update_dpp(0, __float_as_int(v), 0x141, 0xF, 0xF, true));
    v += __int_as_float(__builtin_amdgcn_update_dpp(0, __float_as_int(v), 0x140, 0xF, 0xF, true));
    return v;
}
__device__ __forceinline__ float wave_sum_u(float v) {
    v = dpp_row_sum_f(v);
    return (__int_as_float(__builtin_amdgcn_readlane(__float_as_int(v), 0)) + __int_as_float(__builtin_amdgcn_readlane(__float_as_int(v), 16)))
         + (__int_as_float(__builtin_amdgcn_readlane(__float_as_int(v), 32)) + __int_as_float(__builtin_amdgcn_readlane(__float_as_int(v), 48)));
}
template <int R> __device__ __forceinline__ void ln_center(f32x4 (&v)[R][4], float (&rstd)[R], float* meanout = nullptr) {
    float s[R];
#pragma unroll
    for (int r = 0; r < R; ++r) { s[r] = 0.f;
#pragma unroll
        for (int j = 0; j < 4; ++j) s[r] += (v[r][j].x + v[r][j].y) + (v[r][j].z + v[r][j].w); }
#pragma unroll
    for (int r = 0; r < R; ++r) s[r] = dpp_row_sum_f(s[r]);
    float q[R];
#pragma unroll
    for (int r = 0; r < R; ++r) { const float mean = ((__int_as_float(__builtin_amdgcn_readlane(__float_as_int(s[r]), 0)) + __int_as_float(__builtin_amdgcn_readlane(__float_as_int(s[r]), 16)))
                                                   + (__int_as_float(__builtin_amdgcn_readlane(__float_as_int(s[r]), 32)) + __int_as_float(__builtin_amdgcn_readlane(__float_as_int(s[r]), 48)))) * (1.f / D_MODEL);
        if (meanout) meanout[r] = mean;
        q[r] = 0.f;
#pragma unroll
        for (int j = 0; j < 4; ++j) { v[r][j] = v[r][j] - mean; q[r] += (v[r][j].x * v[r][j].x + v[r][j].y * v[r][j].y) + (v[r][j].z * v[r][j].z + v[r][j].w * v[r][j].w); } }
#pragma unroll
    for (int r = 0; r < R; ++r) q[r] = dpp_row_sum_f(q[r]);
#pragma unroll
    for (int r = 0; r < R; ++r) { const float var = ((__int_as_float(__builtin_amdgcn_readlane(__float_as_int(q[r]), 0)) + __int_as_float(__builtin_amdgcn_readlane(__float_as_int(q[r]), 16)))
                                                  + (__int_as_float(__builtin_amdgcn_readlane(__float_as_int(q[r]), 32)) + __int_as_float(__builtin_amdgcn_readlane(__float_as_int(q[r]), 48)))) * (1.f / D_MODEL);
        rstd[r] = 1.f / sqrtf(var + LN_EPS); }
}
__device__ __forceinline__ float wave_sum(float v) {
#pragma unroll
    for (int o = 1; o < 64; o <<= 1) v += __shfl_xor(v, o);
    return v;
}
__device__ __forceinline__ float ada_sum(const float* adap, const float* b_ada, int b, int j) {
    float s = b_ada[j];
#pragma unroll
    for (int k = 0; k < KSL; ++k) s += adap[(size_t)(k * NB + b) * (6 * D_MODEL) + j];
    return s;
}
__device__ __forceinline__ void p1_phase(const float* const* in, unsigned char* ws, LAS unsigned char* lds, int G) {
    const int tid = threadIdx.x, lane = tid & 63, wave = tid >> 6;
    const float* adap = (const float*)(ws + WS_ADAP); const float* b_ada = in[4]; const float* x = in[0];
    LAS float* sh = (LAS float*)lds; LAS float* sc = sh + D_MODEL;
    for (int blk = blockIdx.x; blk < NT / 128; blk += G) {
        const int b = blk / 32;
        __syncthreads();
        for (int j = tid; j < 2 * D_MODEL; j += NTHREADS) sh[j] = ada_sum(adap, b_ada, b, j);
        if ((blk & 31) == 0) { float* ada = (float*)(ws + WS_ADA) + (size_t)b * 6 * D_MODEL; for (int j = tid; j < 6 * D_MODEL; j += NTHREADS) ada[j] = ada_sum(adap, b_ada, b, j); }
        __syncthreads();
        for (int rb = 0; rb < 16; rb += 4) {
            const size_t row0 = (size_t)blk * 128 + wave * 16 + rb;
            f32x4 v[4][4];
#pragma unroll
            for (int r = 0; r < 4; ++r) { const f32x4* xr = (const f32x4*)(x + (row0 + r) * D_MODEL) + lane;
#pragma unroll
                for (int j = 0; j < 4; ++j) v[r][j] = xr[64 * j]; }
            float rstd[4]; ln_center<4>(v, rstd);
#pragma unroll
            for (int j = 0; j < 4; ++j) { const f32x4 a = *(const LAS f32x4*)(sc + 256 * j + 4 * lane) + 1.f, c = *(const LAS f32x4*)(sh + 256 * j + 4 * lane);
#pragma unroll
                for (int r = 0; r < 4; ++r) { const f32x4 y = v[r][j] * rstd[r] * a + c; u32x2 w; w.x = cvtpk_s(y.x, y.y); w.y = cvtpk_s(y.z, y.w);
                    ((u32x2*)((bf16_t*)(ws + WS_XN) + (row0 + r) * D_MODEL) + lane)[64 * j] = w; } }
        }
        asm volatile("s_waitcnt vmcnt(0)" ::: "memory"); __syncthreads();
        {   LAS unsigned char* W64 = lds + 8192; constexpr int WP = 2064;
            const bf16_t* wsrc = (const bf16_t*)(ws + WS_WIN) + (size_t)3584 * 1024;
            for (int i = tid; i < 64 * 128; i += NTHREADS) { const int n = i >> 7, c = i & 127; *(LAS u32x4*)(W64 + n * WP + c * 16) = *(const u32x4*)(wsrc + (size_t)n * 1024 + c * 8); }
            __syncthreads();
            const int fr = lane & 15, fq = lane >> 4; const size_t rowA = (size_t)blk * 128 + wave * 16 + fr;
            const bf16_t* xp = (const bf16_t*)(ws + WS_XN) + rowA * D_MODEL + 8 * fq;
            f32x4 acc[4];
#pragma unroll
            for (int nt = 0; nt < 4; ++nt) acc[nt] = (f32x4){0.f, 0.f, 0.f, 0.f};
#pragma unroll 8
            for (int ks = 0; ks < 32; ++ks) { const bf16x8 bfr = *(const bf16x8*)(xp + 32 * ks);
#pragma unroll
                for (int nt = 0; nt < 4; ++nt) { const bf16x8 afr = *(const LAS bf16x8*)(W64 + (16 * nt + fr) * WP + (32 * ks + 8 * fq) * 2); acc[nt] = __builtin_amdgcn_mfma_f32_16x16x32_bf16(afr, bfr, acc[nt], 0, 0, 0); } }
            { u32x2 w; w.x = cvtpk_s(acc[0][0], acc[0][1]); w.y = cvtpk_s(acc[0][2], acc[0][3]); *(u32x2*)((bf16_t*)(ws + WS_IK) + rowA * 32 + 4 * fq) = w;
              w.x = cvtpk_s(acc[1][0], acc[1][1]); w.y = cvtpk_s(acc[1][2], acc[1][3]); *(u32x2*)((bf16_t*)(ws + WS_IK) + rowA * 32 + 16 + 4 * fq) = w;
              *(f32x4*)((float*)(ws + WS_IW) + rowA * 16 + 4 * fq) = acc[2];
              w.x = cvtpk_s(acc[3][0], acc[3][1]); w.y = cvtpk_s(acc[3][2], acc[3][3]); *(u32x2*)((bf16_t*)(ws + WS_GLR) + rowA * 16 + 4 * fq) = w; }
        }
    }
}

struct EpiProj {
    static constexpr bool PERM = true, AFTER_DRAIN = false, MID = false;
    unsigned char* ws;
    __device__ __forceinline__ void operator()(const f32x4 (&acc)[2][2][4][2], const Unit& u, int wr, int wc, int fr, int fq) const {
        const int row0 = u.pm * 256 + wr * 64 + fr; const int pn = u.pn;
        {
            bf16_t* base; int ld, ct; float sc = 1.f;
            if (pn < 6) { base = (bf16_t*)(ws + WS_QKV); ld = 1536; ct = pn * 256; if (pn < 2) sc = QSCALE; }
            else if (pn < 8) { base = (bf16_t*)(ws + WS_IQ); ld = 512; ct = (pn - 6) * 256; }
            else if (pn < 10) { base = (bf16_t*)(ws + WS_GQK); ld = 512; ct = (pn - 8) * 256; }
            else if (pn < 12) { base = (bf16_t*)(ws + WS_GV); ld = 512; ct = (pn - 10) * 256; }
            else { base = (bf16_t*)(ws + WS_GR); ld = 512; ct = (pn - 12) * 256; }
            const int col0 = ct + wc * 32 + 8 * fq;
#pragma unroll
            for (int ai = 0; ai < 2; ++ai)
#pragma unroll
                for (int m = 0; m < 4; ++m) { bf16_t* rowp = base + (size_t)(row0 + ai * 128 + m * 16) * ld + col0;
#pragma unroll
                    for (int bj = 0; bj < 2; ++bj) { const f32x4 v0 = acc[ai][bj][m][0] * sc, v1 = acc[ai][bj][m][1] * sc;
                        u32x4 w; w.x = cvt_pk_bf16(v0[0], v0[1]); w.y = cvt_pk_bf16(v0[2], v0[3]); w.z = cvt_pk_bf16(v1[0], v1[1]); w.w = cvt_pk_bf16(v1[2], v1[3]);
                        *(u32x4*)(rowp + bj * 128) = w; } }
        }
    }
};

typedef float f32x4_t __attribute__((ext_vector_type(4)));
constexpr int SC_TILES_PER_B = 528, SC_ITEMS = NB * SC_TILES_PER_B;
__device__ __forceinline__ size_t keys_row_dw(int b, int t) {
    const int qi = t >> 7, r = t & 127; return (size_t)b * (SC_TILES_PER_B * 8192) + (size_t)8192 * (qi * (qi + 1) / 2) + (size_t)r * (qi + 1) * 64;
}
__device__ __forceinline__ unsigned score_key(float sc) {
    const _Float16 hf = (_Float16)sc; const unsigned short hb = __builtin_bit_cast(unsigned short, hf);
    return (hb & 0x8000u) ? (unsigned)(unsigned short)~hb : (unsigned)(hb | 0x8000u);
}
__device__ __forceinline__ void fma_abs4(f32x4& acc, const f32x4& d, float w) {
    float a0 = acc[0], a1 = acc[1], a2 = acc[2], a3 = acc[3];
    asm volatile("v_fma_f32 %0, |%4|, %8, %0\n\tv_fma_f32 %1, |%5|, %8, %1\n\tv_fma_f32 %2, |%6|, %8, %2\n\tv_fma_f32 %3, |%7|, %8, %3"
                 : "+v"(a0), "+v"(a1), "+v"(a2), "+v"(a3) : "v"(d[0]), "v"(d[1]), "v"(d[2]), "v"(d[3]), "v"(w));
    acc[0] = a0; acc[1] = a1; acc[2] = a2; acc[3] = a3;
}
constexpr int SC_SEGS_PER_B = 144, SC_SEGS = NB * SC_SEGS_PER_B;
__device__ __forceinline__ unsigned score_key2(float lo, float hi) {
    typedef _Float16 h2 __attribute__((ext_vector_type(2)));
    const unsigned x = __builtin_bit_cast(unsigned, __builtin_amdgcn_cvt_pkrtz(lo, hi));
    unsigned m; asm("v_pk_ashrrev_i16 %0, %2, %1" : "=v"(m) : "v"(x), "v"(0x000F000Fu));
    return x ^ (m | 0x80008000u);
}
__device__ __forceinline__ void p3a_run(int b, int qi, int kj0, int kj1, unsigned char* ws, LAS unsigned char* ldsw, int wave, int lane) {
    const int fr = lane & 15, fq = lane >> 4;
    const int t = qi * 128 + wave * 16 + fr; const size_t trow = (size_t)b * NS + t;
    const bf16_t* IQ = (const bf16_t*)(ws + WS_IQ) + trow * 512 + 8 * fq;
    const bf16_t* IK = (const bf16_t*)(ws + WS_IK) + ((size_t)b * NS + fr) * 32 + 8 * fq;
    const float* IW = (const float*)(ws + WS_IW) + trow * 16;
    LAS unsigned char* QL = ldsw; LAS float* WL = (LAS float*)(ldsw + 16384);
    bf16x8 kf[8];
#pragma unroll
    for (int kb = 0; kb < 8; ++kb) kf[kb] = *(const bf16x8*)(IK + ((size_t)kj0 * 128 + kb * 16) * 32);
    float qb[8];
#pragma unroll
    for (int j = 0; j < 8; ++j) qb[j] = 0.f;
#pragma unroll
    for (int hg = 0; hg < 4; ++hg) {
        const f32x4 w4 = *(const f32x4*)(IW + 4 * hg) * (0.5f * 0.044194173824159216f);
        u32x4 q4[4];
#pragma unroll
        for (int i = 0; i < 4; ++i) q4[i] = *(const u32x4*)(IQ + (4 * hg + i) * 32);
#pragma unroll
        for (int i = 0; i < 4; ++i) { *(LAS u32x4*)(QL + (4 * hg + i) * 1024 + lane * 16) = q4[i]; if (fq == 0) WL[(4 * hg + i) * 16 + fr] = w4[i]; float f[8]; bf8_to_f(q4[i], f);
#pragma unroll
            for (int j = 0; j < 8; ++j) qb[j] += w4[i] * f[j]; }
    }
    u32x4 qbw; qbw.x = cvtpk_s(qb[0], qb[1]); qbw.y = cvtpk_s(qb[2], qb[3]); qbw.z = cvtpk_s(qb[4], qb[5]); qbw.w = cvtpk_s(qb[6], qb[7]);
    const bf16x8 qbar = __builtin_bit_cast(bf16x8, qbw);
    LDS_WAIT();
    for (int kj = kj0; kj <= kj1; ++kj) {
        bf16x8 kn[8];
        const int kjn = (kj < kj1) ? kj + 1 : kj;
#pragma unroll
        for (int kb = 0; kb < 8; ++kb) kn[kb] = *(const bf16x8*)(IK + ((size_t)kjn * 128 + kb * 16) * 32);
        f32x4 acc[8];
#pragma unroll
        for (int kb = 0; kb < 8; ++kb) acc[kb] = __builtin_amdgcn_mfma_f32_16x16x32_bf16(kf[kb], qbar, (f32x4){0.f, 0.f, 0.f, 0.f}, 0, 0, 0);
        f32x4 dA[8], dB[8];
        { const bf16x8 qf = *(const LAS bf16x8*)(QL + lane * 16);
#pragma unroll
          for (int kb = 0; kb < 8; ++kb) dA[kb] = __builtin_amdgcn_mfma_f32_16x16x32_bf16(kf[kb], qf, (f32x4){0.f, 0.f, 0.f, 0.f}, 0, 0, 0); }
#pragma unroll 1
        for (int h = 0; h < I_HEADS; h += 2) {
            { const bf16x8 qf = *(const LAS bf16x8*)(QL + (h + 1) * 1024 + lane * 16);
#pragma unroll
              for (int kb = 0; kb < 8; ++kb) dB[kb] = __builtin_amdgcn_mfma_f32_16x16x32_bf16(kf[kb], qf, (f32x4){0.f, 0.f, 0.f, 0.f}, 0, 0, 0); }
            __builtin_amdgcn_sched_barrier(0);
            { const float w = WL[h * 16 + fr];
#pragma unroll
              for (int kb = 0; kb < 8; ++kb) fma_abs4(acc[kb], dA[kb], w); }
            __builtin_amdgcn_sched_barrier(0);
            { const int hn = (h + 2 < I_HEADS) ? h + 2 : h; const bf16x8 qf = *(const LAS bf16x8*)(QL + hn * 1024 + lane * 16);
#pragma unroll
              for (int kb = 0; kb < 8; ++kb) dA[kb] = __builtin_amdgcn_mfma_f32_16x16x32_bf16(kf[kb], qf, (f32x4){0.f, 0.f, 0.f, 0.f}, 0, 0, 0); }
            __builtin_amdgcn_sched_barrier(0);
            { const float w = WL[(h + 1) * 16 + fr];
#pragma unroll
              for (int kb = 0; kb < 8; ++kb) fma_abs4(acc[kb], dB[kb], w); }
            __builtin_amdgcn_sched_barrier(0);
        }
        unsigned* KEYS = (unsigned*)(ws + WS_SC) + keys_row_dw(b, t) + (size_t)kj * 64;
        const bool diag = (kj == qi);
#pragma unroll
        for (int kb = 0; kb < 4; ++kb) { u32x4 o;
#pragma unroll
            for (int r = 0; r < 4; ++r) o[r] = score_key2(acc[kb][r], acc[kb + 4][r]);
            if (diag) { asm volatile("" ::: "memory");
#pragma unroll
                for (int r = 0; r < 4; ++r) { const int sl = kb * 16 + 4 * fq + r, tl = wave * 16 + fr; if (sl > tl) o[r] &= 0xFFFF0000u; if (sl + 64 > tl) o[r] &= 0x0000FFFFu; } }
            *(u32x4*)(KEYS + kb * 16 + 4 * fq) = o; }
#pragma unroll
        for (int kb = 0; kb < 8; ++kb) kf[kb] = kn[kb];
    }
    LDS_WAIT();
}

__device__ __forceinline__ int dpp_row_sum(int v) {
    v += __builtin_amdgcn_update_dpp(0, v, 0xB1, 0xF, 0xF, true);
    v += __builtin_amdgcn_update_dpp(0, v, 0x4E, 0xF, 0xF, true);
    v += __builtin_amdgcn_update_dpp(0, v, 0x141, 0xF, 0xF, true);
    v += __builtin_amdgcn_update_dpp(0, v, 0x140, 0xF, 0xF, true);
    return v;
}
__device__ __forceinline__ int wave_sum_i(int v) {
    v = dpp_row_sum(v);
    return __builtin_amdgcn_readlane(v, 0) + __builtin_amdgcn_readlane(v, 16) + __builtin_amdgcn_readlane(v, 32) + __builtin_amdgcn_readlane(v, 48);
}
__device__ __forceinline__ void pk_ge_count4(unsigned x0, unsigned x1, unsigned x2, unsigned x3, unsigned c2m1, unsigned one2, unsigned& c0, unsigned& c1, unsigned& c2, unsigned& c3) {
    unsigned d0, d1, d2, d3;
    asm volatile("v_pk_sub_u16 %0, %8, %12 clamp\n\tv_pk_sub_u16 %1, %9, %12 clamp\n\tv_pk_sub_u16 %2, %10, %12 clamp\n\tv_pk_sub_u16 %3, %11, %12 clamp\n\t"
                 "v_pk_min_u16 %0, %0, %13\n\tv_pk_min_u16 %1, %1, %13\n\tv_pk_min_u16 %2, %2, %13\n\tv_pk_min_u16 %3, %3, %13\n\t"
                 "v_pk_add_u16 %4, %4, %0\n\tv_pk_add_u16 %5, %5, %1\n\tv_pk_add_u16 %6, %6, %2\n\tv_pk_add_u16 %7, %7, %3"
                 : "=&v"(d0), "=&v"(d1), "=&v"(d2), "=&v"(d3), "+v"(c0), "+v"(c1), "+v"(c2), "+v"(c3) : "v"(x0), "v"(x1), "v"(x2), "v"(x3), "v"(c2m1), "v"(one2));
}
constexpr int TOPK = 256;
__device__ __forceinline__ int count_ge(const unsigned (&x)[32], int ng, unsigned cand) {
    const unsigned c2m1 = (cand - 1u) * 0x00010001u, one2 = 0x00010001u; unsigned c0 = 0u, c1 = 0u, c2 = 0u, c3 = 0u;
#pragma unroll
    for (int g = 0; g < 4; ++g) if (g < ng) { pk_ge_count4(x[8 * g], x[8 * g + 1], x[8 * g + 2], x[8 * g + 3], c2m1, one2, c0, c1, c2, c3); pk_ge_count4(x[8 * g + 4], x[8 * g + 5], x[8 * g + 6], x[8 * g + 7], c2m1, one2, c0, c1, c2, c3); }
    const unsigned s = (c0 + c1) + (c2 + c3);
    return wave_sum_i((int)((s & 0xFFFFu) + (s >> 16)));
}
__device__ __forceinline__ void p4a_load(int row_, unsigned char* ws, int lane, unsigned (&x)[32]) {
    const int row = __builtin_amdgcn_readfirstlane(row_); const int b = row / NS, t = row % NS; const int nc = (t >> 7) + 1;
    const unsigned* KEYS = (const unsigned*)(ws + WS_SC) + keys_row_dw(b, t); const unsigned* DEADK = (const unsigned*)(ws + 392 * 1024);
#pragma unroll
    for (int c = 0; c < 32; ++c) { const unsigned* base = c < nc ? KEYS + c * 64 : DEADK; x[c] = base[lane]; }
}
__device__ __forceinline__ int scan16_incl(int v) {
    v += __builtin_amdgcn_update_dpp(0, v, 0x111, 0xF, 0xF, true);
    v += __builtin_amdgcn_update_dpp(0, v, 0x112, 0xF, 0xF, true);
    v += __builtin_amdgcn_update_dpp(0, v, 0x114, 0xF, 0xF, true);
    v += __builtin_amdgcn_update_dpp(0, v, 0x118, 0xF, 0xF, true);
    return v;
}
__device__ __forceinline__ int scan64_incl(int v, int lane) {
    v = scan16_incl(v);
    const int t0 = __builtin_amdgcn_readlane(v, 15), t1 = __builtin_amdgcn_readlane(v, 31), t2 = __builtin_amdgcn_readlane(v, 47);
    return v + (lane >= 16 ? t0 : 0) + (lane >= 32 ? t1 : 0) + (lane >= 48 ? t2 : 0);
}
__device__ __forceinline__ unsigned bin_lo(unsigned x, unsigned hb) { unsigned a; asm("v_bfe_u32 %0, %1, 6, 10\n\tv_lshl_add_u32 %0, %0, 2, %2" : "=&v"(a) : "v"(x), "s"(hb)); return a; }
__device__ __forceinline__ unsigned bin_hi(unsigned x, unsigned hb) { unsigned a; asm("v_lshrrev_b32 %0, 22, %1\n\tv_lshl_add_u32 %0, %0, 2, %2" : "=&v"(a) : "v"(x), "s"(hb)); return a; }
__device__ __forceinline__ void lds_inc(unsigned addr) { __hip_atomic_fetch_add((LAS unsigned*)(unsigned long)addr, 1u, __ATOMIC_RELAXED, __HIP_MEMORY_SCOPE_WORKGROUP); }
#define WAVE_LDS_ORDER() do { asm volatile("" ::: "memory"); __builtin_amdgcn_fence(__ATOMIC_ACQ_REL, "wavefront"); __builtin_amdgcn_wave_barrier(); asm volatile("" ::: "memory"); } while (0)
constexpr int SEL_LDS = 8192;
__device__ __forceinline__ void tie_fix(unsigned long long& m, unsigned long long e, int& run, int need) {
    if (e != 0ull) { const int n = __builtin_popcountll(e); int keep = need - run; run += n;
        if (keep < n) { if (keep < 0) keep = 0; unsigned long long d = e; for (int i = 0; i < keep; ++i) d &= d - 1ull; m &= ~d; } }
}
#define PUT4(mw0, mw1, a0, a1, a2, a3, L0) asm volatile("s_nop 3\n\tv_writelane_b32 %0, %2, %10\n\tv_writelane_b32 %1, %3, %10\n\tv_writelane_b32 %0, %4, %11\n\tv_writelane_b32 %1, %5, %11\n\t" \
        "v_writelane_b32 %0, %6, %12\n\tv_writelane_b32 %1, %7, %12\n\tv_writelane_b32 %0, %8, %13\n\tv_writelane_b32 %1, %9, %13" : "+v"(mw0), "+v"(mw1) \
        : "s"((unsigned)(a0)), "s"((unsigned)((a0) >> 32)), "s"((unsigned)(a1)), "s"((unsigned)((a1) >> 32)), "s"((unsigned)(a2)), "s"((unsigned)((a2) >> 32)), "s"((unsigned)(a3)), "s"((unsigned)((a3) >> 32)), \
          "n"(L0), "n"((L0) + 1), "n"((L0) + 2), "n"((L0) + 3))
__device__ __forceinline__ void p4a_row(int row_, unsigned char* ws, int lane, const unsigned (&x)[32], LAS unsigned char* H) {
    const int row = __builtin_amdgcn_readfirstlane(row_);
    const int t = row % NS; unsigned long long* MASK = (unsigned long long*)(ws + WS_MASK) + (size_t)row * 64;
    const int nc = (t >> 7) + 1;
    if (t < TOPK) {
        if (lane < 2 * nc) { const int lo = lane * 64; unsigned long long m = 0ull; if (t >= lo + 63) m = ~0ull; else if (t >= lo) m = (2ull << (t - lo)) - 1ull; MASK[lane] = m; }
        return;
    }
    const unsigned hb = (unsigned)(unsigned long)H;
    { const u32x4 z = (u32x4){0u, 0u, 0u, 0u};
#pragma unroll
      for (int i = 0; i < 4; ++i) *(LAS u32x4*)(H + i * 1024 + lane * 16) = z;
      *(LAS unsigned*)(H + 4096 + lane * 4) = 0u; }
    WAVE_LDS_ORDER();
#pragma unroll
    for (int c = 0; c < 32; c += 2) if (c < nc) {
        lds_inc(bin_lo(x[c], hb)); lds_inc(bin_hi(x[c], hb)); lds_inc(bin_lo(x[c + 1], hb)); lds_inc(bin_hi(x[c + 1], hb)); }
    WAVE_LDS_ORDER();
    int Bsel, cA;
    {   const LAS unsigned char* hp = H + (63 - lane) * 64;
        const u32x4 h0 = *(const LAS u32x4*)hp, h1 = *(const LAS u32x4*)(hp + 16), h2 = *(const LAS u32x4*)(hp + 32), h3 = *(const LAS u32x4*)(hp + 48);
        const int sl = (int)(((h0.x + h0.y) + (h0.z + h0.w)) + ((h1.x + h1.y) + (h1.z + h1.w)) + ((h2.x + h2.y) + (h2.z + h2.w)) + ((h3.x + h3.y) + (h3.z + h3.w)));
        const int P = scan64_incl(sl, lane);
        const int Ls = __builtin_ctzll(__ballot(P >= TOPK));
        const int E = __builtin_amdgcn_readlane(P - sl, Ls);
        const int hj = (int)*(const LAS unsigned*)(H + ((63 - Ls) * 16 + 15 - (lane & 15)) * 4);
        const int Pj = scan16_incl(hj);
        const int jl = __builtin_ctzll(__ballot(E + Pj >= TOPK) & 0xFFFFull);
        Bsel = (63 - Ls) * 16 + 15 - jl; cA = E + __builtin_amdgcn_readlane(Pj - hj, jl);
    }
    {   const unsigned Bs2 = ((unsigned)Bsel << 6) * 0x00010001u; const unsigned dump = 64u + (unsigned)lane, hb2 = hb + 4096u;
#pragma unroll
        for (int c = 0; c < 32; c += 2) if (c < nc) {
#pragma unroll
            for (int i = 0; i < 2; ++i) { const unsigned y = x[c + i] ^ Bs2;
                const unsigned il = (unsigned)(unsigned short)__builtin_elementwise_min((unsigned short)y, (unsigned short)dump), ih = __builtin_elementwise_min(y >> 16, dump);
                lds_inc((il << 2) + hb2); lds_inc((ih << 2) + hb2); } }
    }
    WAVE_LDS_ORDER();
    unsigned T; int cT, need;
    {   const int c2 = (int)*(const LAS unsigned*)(H + 4096 + (63 - lane) * 4);
        const int P2 = scan64_incl(c2, lane);
        const int L2 = __builtin_ctzll(__ballot(cA + P2 >= TOPK));
        cT = cA + __builtin_amdgcn_readlane(P2, L2); need = TOPK - (cT - __builtin_amdgcn_readlane(c2, L2));
        T = ((unsigned)Bsel << 6) + (unsigned)(63 - L2);
    }
    unsigned mw0 = 0u, mw1 = 0u;
    const bool tie = (cT != TOPK);
    const unsigned Th = T << 16; const unsigned short Ts = (unsigned short)T; int run = 0;
#pragma unroll
    for (int c = 0; c < 32; c += 2) if (c < nc) {
        unsigned long long a0 = __ballot((unsigned short)x[c] >= Ts), a1 = __ballot(x[c] >= Th), a2 = __ballot((unsigned short)x[c + 1] >= Ts), a3 = __ballot(x[c + 1] >= Th);
        if (tie) {
            const unsigned long long e0 = __ballot((unsigned short)x[c] == Ts), e1 = __ballot((x[c] >> 16) == T), e2 = __ballot((unsigned short)x[c + 1] == Ts), e3 = __ballot((x[c + 1] >> 16) == T);
            tie_fix(a0, e0, run, need); tie_fix(a1, e1, run, need); tie_fix(a2, e2, run, need); tie_fix(a3, e3, run, need);
        }
        PUT4(mw0, mw1, a0, a1, a2, a3, 2 * c);
    }
    if (lane < 2 * nc) MASK[lane] = ((unsigned long long)mw1 << 32) | mw0;
}

typedef float f32x16 __attribute__((ext_vector_type(16)));
typedef short s16x4 __attribute__((ext_vector_type(4)));
__device__ __forceinline__ int crow(int r, int hi) { return (r & 3) + 8 * (r >> 2) + 4 * hi; }
__device__ __forceinline__ s16x4 vtr(const LAS unsigned char* p) { return __builtin_bit_cast(s16x4, __builtin_amdgcn_ds_read_tr16_b64_v4i16((LAS s16x4*)p)); }
constexpr size_t WS_OAB = 358 * MiB;
constexpr int AT_ROWB = 144, AT_TILE = 64 * AT_ROWB;
constexpr int AT_VROWB = 192, AT_VTILE = 64 * AT_VROWB;
constexpr float LOG2E = 1.4426950408889634f;
constexpr float ATHR = 8.f;
__device__ __forceinline__ int sext_bit(unsigned w, int c) { int r; asm("v_bfe_i32 %0, %1, %2, 1" : "=v"(r) : "v"(w), "n"(c)); return r; }
__device__ __forceinline__ void attn_s(const LAS unsigned char* Kb, const LAS float* BT, const bf16x8 (&qr)[4], unsigned long long mword, bool far, bool first, int dist0,
                                       int r32, int hh, f32x16& o0, f32x16& o1, float& lsum, f32x16& nmB, float& mref, u32x4 (&pk)[4]) {
    f32x16 p0, p1;
#pragma unroll
    for (int ks = 0; ks < 4; ++ks) {
        const bf16x8 k0 = *(const LAS bf16x8*)(Kb + r32 * AT_ROWB + 32 * ks + 16 * hh);
        const bf16x8 k1 = *(const LAS bf16x8*)(Kb + (32 + r32) * AT_ROWB + 32 * ks + 16 * hh);
        if (ks == 0) { p0 = __builtin_amdgcn_mfma_f32_32x32x16_bf16(k0, qr[0], nmB, 0, 0, 0); p1 = __builtin_amdgcn_mfma_f32_32x32x16_bf16(k1, qr[0], nmB, 0, 0, 0); }
        else { p0 = __builtin_amdgcn_mfma_f32_32x32x16_bf16(k0, qr[ks], p0, 0, 0, 0); p1 = __builtin_amdgcn_mfma_f32_32x32x16_bf16(k1, qr[ks], p1, 0, 0, 0); }
    }
    if (!far) {
        const LAS float* bp = BT + (96 - 27 - 32) + dist0;
#pragma unroll
        for (int i = 0; i < 16; ++i) { const int c = (i & 3) + 8 * (i >> 2); p0[i] += bp[32 + 27 - c]; p1[i] += bp[27 - c]; }
    }
    float m0 = __builtin_fmaxf(__builtin_fmaxf(p0[0], p0[1]), p0[2]), m1 = __builtin_fmaxf(__builtin_fmaxf(p1[0], p1[1]), p1[2]);
#pragma unroll
    for (int i = 3; i < 15; i += 2) { m0 = __builtin_fmaxf(__builtin_fmaxf(m0, p0[i]), p0[i + 1]); m1 = __builtin_fmaxf(__builtin_fmaxf(m1, p1[i]), p1[i + 1]); }
    float mx = __builtin_fmaxf(__builtin_fmaxf(m0, m1), __builtin_fmaxf(p0[15], p1[15]));
    { const auto rr = __builtin_amdgcn_permlane32_swap(__float_as_uint(mx), __float_as_uint(mx), false, false); mx = __builtin_fmaxf(__uint_as_float(rr[0]), __uint_as_float(rr[1])); }
    if (first || __any(mx > ATHR)) {
        const float dl = (first || mx > ATHR) ? mx : 0.f; mref += dl; const float f = __builtin_amdgcn_exp2f(-dl);
#pragma unroll
        for (int i = 0; i < 16; ++i) { p0[i] -= dl; p1[i] -= dl; nmB[i] -= dl; o0[i] *= f; o1[i] *= f; }
        lsum *= f;
    }
    const unsigned wl = (unsigned)mword >> (4 * hh), wh = (unsigned)(mword >> 32) >> (4 * hh);
#pragma unroll
    for (int i = 0; i < 16; ++i) { const int c = (i & 3) + 8 * (i >> 2);
        p0[i] = __uint_as_float(__float_as_uint(__builtin_amdgcn_exp2f(p0[i])) & (unsigned)sext_bit(wl, c));
        p1[i] = __uint_as_float(__float_as_uint(__builtin_amdgcn_exp2f(p1[i])) & (unsigned)sext_bit(wh, c)); }
    {
        typedef float f32x2s __attribute__((ext_vector_type(2)));
        f32x2s a[8];
#pragma unroll
        for (int j = 0; j < 8; ++j) a[j] = (f32x2s){p0[2 * j], p0[2 * j + 1]} + (f32x2s){p1[2 * j], p1[2 * j + 1]};
        const f32x2s b0 = (a[0] + a[1]) + (a[2] + a[3]), b1 = (a[4] + a[5]) + (a[6] + a[7]); const f32x2s c2 = b0 + b1;
        lsum += c2.x + c2.y; }
#pragma unroll
    for (int s2 = 0; s2 < 2; ++s2) {
        pk[s2].x = cvtpk_s(p0[8 * s2], p0[8 * s2 + 1]); pk[s2].y = cvtpk_s(p0[8 * s2 + 2], p0[8 * s2 + 3]); pk[s2].z = cvtpk_s(p0[8 * s2 + 4], p0[8 * s2 + 5]); pk[s2].w = cvtpk_s(p0[8 * s2 + 6], p0[8 * s2 + 7]);
        pk[2 + s2].x = cvtpk_s(p1[8 * s2], p1[8 * s2 + 1]); pk[2 + s2].y = cvtpk_s(p1[8 * s2 + 2], p1[8 * s2 + 3]); pk[2 + s2].z = cvtpk_s(p1[8 * s2 + 4], p1[8 * s2 + 5]); pk[2 + s2].w = cvtpk_s(p1[8 * s2 + 6], p1[8 * s2 + 7]); }
}
__device__ __forceinline__ void attn_pv(const LAS unsigned char* Vb, const u32x4 (&pk)[4], int voff, f32x16& o0, f32x16& o1) {
#pragma unroll
    for (int q = 0; q < 4; ++q) {
        const bf16x8 pf = __builtin_bit_cast(bf16x8, pk[q]);
        const LAS unsigned char* vp = Vb + (16 * q) * AT_VROWB + voff;
        const s16x4 a0l = vtr(vp), a0h = vtr(vp + 8 * AT_VROWB), a1l = vtr(vp + 64), a1h = vtr(vp + 8 * AT_VROWB + 64);
        const bf16x8 va0 = (bf16x8){a0l[0], a0l[1], a0l[2], a0l[3], a0h[0], a0h[1], a0h[2], a0h[3]};
        const bf16x8 va1 = (bf16x8){a1l[0], a1l[1], a1l[2], a1l[3], a1h[0], a1h[1], a1h[2], a1h[3]};
        o0 = __builtin_amdgcn_mfma_f32_32x32x16_bf16(va0, pf, o0, 0, 0, 0);
        o1 = __builtin_amdgcn_mfma_f32_32x32x16_bf16(va1, pf, o1, 0, 0, 0);
    }
}
constexpr int AT_KB = 0, AT_VB = 2 * AT_TILE, AT_BT3 = AT_VB + 3 * AT_VTILE;
template <bool GB> __device__ __forceinline__ void attn_unit(int b, int h, int Q, const float* rel_bias, unsigned char* ws, LAS unsigned char* lds) {
    const int tid = threadIdx.x, lane = tid & 63, wave = __builtin_amdgcn_readfirstlane(tid >> 6), r32 = lane & 31, hh = lane >> 5;
    const size_t rowbase = (size_t)b * NS; const int t0w = 256 * Q + 32 * wave, t = t0w + r32;
    const bf16_t* QKV = (const bf16_t*)(ws + WS_QKV);
    LAS float* BT = (LAS float*)(lds + AT_BT3);
    const int NTL = 4 * (Q + 1);
    const int lastw = (t0w + 31) >> 6;
    const int srow = tid >> 3, sch = tid & 7;
    const bf16_t* kg = QKV + (rowbase + srow) * 1536 + 512 + h * 64 + sch * 8; const bf16_t* vg = kg + 512;
    const int soff = srow * AT_ROWB + sch * 16, svoff = srow * AT_VROWB + sch * 16;
    const unsigned long long* MK = (const unsigned long long*)(ws + WS_MASK) + (rowbase + t) * 64;
    const size_t tstride = (size_t)64 * 1536;
    u32x4 k0r = *(const u32x4*)kg, v0r = *(const u32x4*)vg;
    u32x4 kA = *(const u32x4*)(kg + tstride), vA = *(const u32x4*)(vg + tstride);
    u32x4 kB = *(const u32x4*)(kg + 2 * tstride), vB = *(const u32x4*)(vg + 2 * tstride);
    unsigned long long me = MK[0], mo = MK[(1 <= lastw) ? 1 : 0];
    bf16x8 qr[4];
#pragma unroll
    for (int ks = 0; ks < 4; ++ks) qr[ks] = *(const bf16x8*)(QKV + (rowbase + t) * 1536 + h * 64 + 16 * ks + 8 * hh);
    const float cB = rel_bias[31 * A_HEADS + h] * LOG2E;
    __syncthreads();
    if (tid < 352) { const int d = tid - 96; BT[tid] = rel_bias[v0_bucket(d < 0 ? 0 : d) * A_HEADS + h] * LOG2E - cB; }
    *(LAS u32x4*)(lds + AT_KB + soff) = k0r; *(LAS u32x4*)(lds + AT_VB + svoff) = v0r;
    f32x16 o0, o1, nmB; float lsum = 0.f;
#pragma unroll
    for (int i = 0; i < 16; ++i) { o0[i] = 0.f; o1[i] = 0.f; nmB[i] = cB; }
    float mref = 0.f;
    const int q4 = (lane & 15) >> 2, p4 = lane & 3, blk = (lane >> 4) & 1;
    const int voff = (4 * hh + q4) * AT_VROWB + (16 * blk + 4 * p4) * 2;
    u32x4 pk[4];
#pragma unroll
    for (int q = 0; q < 4; ++q) pk[q] = (u32x4){0u, 0u, 0u, 0u};
    int vcur = 0, vnext = AT_VTILE, vprev = 2 * AT_VTILE;
    for (int kt = 0; kt < NTL; kt += 2) {
        __syncthreads();
        *(LAS u32x4*)(lds + AT_KB + AT_TILE + soff) = kA; *(LAS u32x4*)(lds + AT_VB + vnext + svoff) = vA;
        { const int tn = (kt + 3 < NTL) ? kt + 3 : NTL - 1; kA = *(const u32x4*)(kg + (size_t)tn * tstride); vA = *(const u32x4*)(vg + (size_t)tn * tstride); }
        if (GB) { if (kt >= 1 && kt - 1 <= lastw) attn_pv(lds + AT_VB + vprev, pk, voff, o0, o1); }
        if (kt <= lastw) attn_s(lds + AT_KB, BT, qr, me, (t0w - (64 * kt + 63) >= 113), kt == 0, t - 64 * kt - 4 * hh, r32, hh, o0, o1, lsum, nmB, mref, pk);
        if (!GB) { if (kt <= lastw) attn_pv(lds + AT_VB + vcur, pk, voff, o0, o1); }
        me = MK[(kt + 2 <= lastw) ? kt + 2 : lastw];
        { const int tmp = vprev; vprev = vcur; vcur = vnext; vnext = tmp; }
        __syncthreads();
        *(LAS u32x4*)(lds + AT_KB + soff) = kB; *(LAS u32x4*)(lds + AT_VB + vnext + svoff) = vB;
        { const int tn = (kt + 4 < NTL) ? kt + 4 : NTL - 1; kB = *(const u32x4*)(kg + (size_t)tn * tstride); vB = *(const u32x4*)(vg + (size_t)tn * tstride); }
        if (GB) { if (kt <= lastw) attn_pv(lds + AT_VB + vprev, pk, voff, o0, o1); }
        if (kt + 1 <= lastw) attn_s(lds + AT_KB + AT_TILE, BT, qr, mo, (t0w - (64 * (kt + 1) + 63) >= 113), false, t - 64 * (kt + 1) - 4 * hh, r32, hh, o0, o1, lsum, nmB, mref, pk);
        if (!GB) { if (kt + 1 <= lastw) attn_pv(lds + AT_VB + vcur, pk, voff, o0, o1); }
        mo = MK[(kt + 3 <= lastw) ? kt + 3 : lastw];
        { const int tmp = vprev; vprev = vcur; vcur = vnext; vnext = tmp; }
    }
    if (GB) {
        if (NTL - 1 <= lastw) attn_pv(lds + AT_VB + vprev, pk, voff, o0, o1);
    }
    float inv; { const auto rr = __builtin_amdgcn_permlane32_swap(__float_as_uint(lsum), __float_as_uint(lsum), false, false); inv = 1.f / (__uint_as_float(rr[0]) + __uint_as_float(rr[1])); }
    bf16_t* O = (bf16_t*)(ws + WS_OAB) + (rowbase + t) * 1024 + h * 64 + 4 * hh;
#pragma unroll
    for (int g = 0; g < 4; ++g) {
        u32x2 w0, w1; w0.x = cvtpk_s(o0[4 * g] * inv, o0[4 * g + 1] * inv); w0.y = cvtpk_s(o0[4 * g + 2] * inv, o0[4 * g + 3] * inv);
        w1.x = cvtpk_s(o1[4 * g] * inv, o1[4 * g + 1] * inv); w1.y = cvtpk_s(o1[4 * g + 2] * inv, o1[4 * g + 3] * inv);
        *(u32x2*)(O + 8 * g) = w0; *(u32x2*)(O + 32 + 8 * g) = w1;
    }
}

constexpr int GL_LG = 0, GL_SEG = 16384, GL_A = 18432, GL_B = GL_A + 9216, GL_C = GL_B + 9216, GL_VT = GL_C + 9216, GL_ST = GL_VT + 18432;
constexpr int GROWB = 144;
constexpr int GLA_ITEMS = NB * G_HEADS * 64;
__device__ __forceinline__ void gla_cumdecay(const u32x4 g0, const u32x4 g1, int h, const float* wg, const float* bg, LAS unsigned char* lds, float* lgc) {
    const int tid = threadIdx.x; LAS float* LG = (LAS float*)(lds + GL_LG); LAS float* SEG = (LAS float*)(lds + GL_SEG);
    {   const int c = tid >> 3, dg = tid & 7; float gl[16];
#pragma unroll
        for (int j = 0; j < 4; ++j) { gl[2 * j] = __uint_as_float(g0[j] << 16); gl[2 * j + 1] = __uint_as_float(g0[j] & 0xffff0000u); gl[8 + 2 * j] = __uint_as_float(g1[j] << 16); gl[8 + 2 * j + 1] = __uint_as_float(g1[j] & 0xffff0000u); }
        float z[8];
#pragma unroll
        for (int j = 0; j < 8; ++j) z[j] = bg[h * 64 + 8 * dg + j];
#pragma unroll
        for (int r = 0; r < 16; ++r) { const f32x4 w0 = *(const f32x4*)(wg + r * G_KW + h * 64 + 8 * dg), w1 = *(const f32x4*)(wg + r * G_KW + h * 64 + 8 * dg + 4);
            z[0] += gl[r] * w0[0]; z[1] += gl[r] * w0[1]; z[2] += gl[r] * w0[2]; z[3] += gl[r] * w0[3]; z[4] += gl[r] * w1[0]; z[5] += gl[r] * w1[1]; z[6] += gl[r] * w1[2]; z[7] += gl[r] * w1[3]; }
#pragma unroll
        for (int j = 0; j < 8; ++j) z[j] = (fminf(z[j], 0.f) - log1pf(__expf(-fabsf(z[j])))) * (1.f / 16.f);
        *(LAS f32x4*)(LG + c * 64 + 8 * dg) = (f32x4){z[0], z[1], z[2], z[3]}; *(LAS f32x4*)(LG + c * 64 + 8 * dg + 4) = (f32x4){z[4], z[5], z[6], z[7]};
    }
    __syncthreads();
    const int seg = tid >> 6, d = tid & 63; float v[8];
#pragma unroll
    for (int i = 0; i < 8; ++i) v[i] = LG[(8 * seg + i) * 64 + d];
#pragma unroll
    for (int i = 1; i < 8; ++i) v[i] += v[i - 1];
    SEG[seg * 64 + d] = v[7];
    __syncthreads();
    float off = 0.f;
#pragma unroll
    for (int s2 = 0; s2 < 8; ++s2) if (s2 < seg) off += SEG[s2 * 64 + d];
#pragma unroll
    for (int i = 0; i < 8; ++i) { const float bv = v[i] + off; LG[(8 * seg + i) * 64 + d] = bv; lgc[(8 * seg + i) * 64 + d] = bv; }
    __syncthreads();
}
__device__ __forceinline__ unsigned short f2bf_s(float f) { return (unsigned short)(cvtpk_s(f, 0.f) & 0xffffu); }
__device__ __forceinline__ void gla_stage_vt(const u32x4 a, const u32x4 b2, LAS unsigned char* lds) {
    const int tid = threadIdx.x, c = tid >> 3, d0 = (tid & 7) * 16;
#pragma unroll
    for (int j = 0; j < 4; ++j) {
        *(LAS unsigned short*)(lds + GL_VT + (d0 + 2 * j) * GROWB + c * 2) = (unsigned short)(a[j] & 0xffffu); *(LAS unsigned short*)(lds + GL_VT + (d0 + 2 * j + 1) * GROWB + c * 2) = (unsigned short)(a[j] >> 16);
        *(LAS unsigned short*)(lds + GL_VT + (d0 + 8 + 2 * j) * GROWB + c * 2) = (unsigned short)(b2[j] & 0xffffu); *(LAS unsigned short*)(lds + GL_VT + (d0 + 8 + 2 * j + 1) * GROWB + c * 2) = (unsigned short)(b2[j] >> 16); }
}
__device__ __forceinline__ void p3b_item(int it, const float* wg, const float* bg, float* UT, float* LGC, unsigned char* ws, LAS unsigned char* lds) {
    const int tid = threadIdx.x, lane = tid & 63, wave = tid >> 6, fr = lane & 15, fq = lane >> 4;
    const int bh = it >> 6, n = it & 63, b = bh >> 2, h = bh & 3; const size_t r0 = (size_t)b * NS + 64 * n;
    const int c_ = tid >> 3, dg_ = tid & 7;
    const bf16_t* gp_ = (const bf16_t*)(ws + WS_GLR) + (r0 + c_) * 16; const u32x4 g0 = *(const u32x4*)gp_, g1 = *(const u32x4*)(gp_ + 8);
    const u32x4 kraw = *(const u32x4*)((const bf16_t*)(ws + WS_GQK) + (r0 + c_) * 512 + 256 + h * 64 + 8 * dg_);
    const bf16_t* vp_ = (const bf16_t*)(ws + WS_GV) + (r0 + c_) * 512 + h * 128 + dg_ * 16; const u32x4 va_ = *(const u32x4*)vp_, vb_ = *(const u32x4*)(vp_ + 8);
    __syncthreads();
    gla_cumdecay(g0, g1, h, wg, bg, lds, LGC + (size_t)it * 4096);
    const LAS float* LG = (const LAS float*)(lds + GL_LG);
    {   const int c = tid >> 3, dg = tid & 7; float kf[8]; bf8_to_f(kraw, kf);
#pragma unroll
        for (int j = 0; j < 8; ++j) { const int d = 8 * dg + j; *(LAS unsigned short*)(lds + GL_A + d * GROWB + c * 2) = f2bf_s(kf[j] * __expf(LG[63 * 64 + d] - LG[c * 64 + d])); }
        if (tid < 64) ((float*)(ws + WS_MISC))[(size_t)it * 64 + tid] = __expf(LG[63 * 64 + tid]);
    }
    gla_stage_vt(va_, vb_, lds);
    __syncthreads();
    f32x4 acc[4];
#pragma unroll
    for (int i = 0; i < 4; ++i) acc[i] = (f32x4){0.f, 0.f, 0.f, 0.f};
#pragma unroll
    for (int ks = 0; ks < 2; ++ks) { const bf16x8 bv = *(const LAS bf16x8*)(lds + GL_VT + (16 * wave + fr) * GROWB + (32 * ks + 8 * fq) * 2);
#pragma unroll
        for (int i = 0; i < 4; ++i) { const bf16x8 av = *(const LAS bf16x8*)(lds + GL_A + (16 * i + fr) * GROWB + (32 * ks + 8 * fq) * 2); acc[i] = __builtin_amdgcn_mfma_f32_16x16x32_bf16(av, bv, acc[i], 0, 0, 0); } }
#pragma unroll
    for (int i = 0; i < 4; ++i) *(f32x4*)(UT + ((size_t)it * 128 + 16 * wave + fr) * 64 + 16 * i + 4 * fq) = acc[i];
}
__device__ __forceinline__ void p4b_item(int j, const float* UT, bf16_t* SP, unsigned char* ws) {
    const int tid = threadIdx.x, bh = j >> 3, dv = (j & 7) * 16 + (tid >> 5), dk = (tid & 31) * 2; const float* DEC = (const float*)(ws + WS_MISC);
    typedef float f32x2v __attribute__((ext_vector_type(2)));
    f32x2v st = (f32x2v){0.f, 0.f};
#pragma unroll 8
    for (int n = 0; n < 64; ++n) { const size_t it = (size_t)bh * 64 + n; const size_t o = (it * 128 + dv) * 64 + dk;
        *(unsigned*)(SP + o) = cvtpk_s(st[0], st[1]);
        const f32x2v u = *(const f32x2v*)(UT + o), dc = *(const f32x2v*)(DEC + it * 64 + dk); st = dc * st + u; }
}
__device__ __forceinline__ void p4b_item4(int j, const float* UT, bf16_t* SP, unsigned char* ws) {
    const int tid = threadIdx.x, bh = j >> 3, dv0 = (j & 7) * 16 + (tid >> 5), dk = (tid & 31) * 2; const float* DEC = (const float*)(ws + WS_MISC);
    typedef float f32x2v __attribute__((ext_vector_type(2)));
    f32x2v st[4];
#pragma unroll
    for (int i = 0; i < 4; ++i) st[i] = (f32x2v){0.f, 0.f};
#pragma unroll 4
    for (int n = 0; n < 64; ++n) { const size_t it = (size_t)bh * 64 + n; const f32x2v dc = *(const f32x2v*)(DEC + it * 64 + dk);
#pragma unroll
        for (int i = 0; i < 4; ++i) { const size_t o = (it * 128 + dv0 + 4 * i) * 64 + dk;
            *(unsigned*)(SP + o) = cvtpk_s(st[i][0], st[i][1]);
            const f32x2v u = *(const f32x2v*)(UT + o); st[i] = dc * st[i] + u; } }
}
__device__ __forceinline__ void p5b_item(int it, const float* LGC, const float* ng, const bf16_t* SP, unsigned char* ws, LAS unsigned char* lds) {
    const int tid = threadIdx.x, lane = tid & 63, wave = tid >> 6, r32 = lane & 31, hh = lane >> 5;
    const int bh = it >> 6, n = it & 63, b = bh >> 2, h = bh & 3; const size_t r0 = (size_t)b * NS + 64 * n;
    const int c_ = tid >> 3, dg_ = tid & 7; const int dvb = wave >> 1, cb = wave & 1;
    const f32x4 lg0 = *(const f32x4*)(LGC + (size_t)it * 4096 + c_ * 64 + 8 * dg_), lg1 = *(const f32x4*)(LGC + (size_t)it * 4096 + c_ * 64 + 8 * dg_ + 4);
    const bf16_t* qp_ = (const bf16_t*)(ws + WS_GQK) + (r0 + c_) * 512 + h * 64 + 8 * dg_; const u32x4 qraw = *(const u32x4*)qp_, kraw = *(const u32x4*)(qp_ + 256);
    const bf16_t* vp_ = (const bf16_t*)(ws + WS_GV) + (r0 + c_) * 512 + h * 128 + dg_ * 16; const u32x4 va_ = *(const u32x4*)vp_, vb_ = *(const u32x4*)(vp_ + 8);
    bf16x8 spf[4];
#pragma unroll
    for (int ks = 0; ks < 4; ++ks) spf[ks] = *(const bf16x8*)(SP + ((size_t)it * 128 + 32 * dvb + r32) * 64 + 16 * ks + 8 * hh);
    const size_t trow = r0 + 32 * cb + r32; const int dvbase = h * 128 + 32 * dvb + 4 * hh;
    const bf16_t* grp = (const bf16_t*)(ws + WS_GR) + trow * 512 + dvbase; u32x2 grw[4];
#pragma unroll
    for (int g = 0; g < 4; ++g) grw[g] = *(const u32x2*)(grp + 8 * g);
    __syncthreads();
    { LAS float* LGw = (LAS float*)(lds + GL_LG); *(LAS f32x4*)(LGw + c_ * 64 + 8 * dg_) = lg0; *(LAS f32x4*)(LGw + c_ * 64 + 8 * dg_ + 4) = lg1; }
    __syncthreads();
    const LAS float* LG = (const LAS float*)(lds + GL_LG);
    {   const int c = tid >> 3, dg = tid & 7; float qf[8], kf[8]; bf8_to_f(qraw, qf); bf8_to_f(kraw, kf);
        float qr[8], ks[8], qi[8];
#pragma unroll
        for (int j = 0; j < 8; ++j) { const int d = 8 * dg + j; const float bc = LG[c * 64 + d], bl = LG[63 * 64 + d]; const float q8 = qf[j] * 0.125f;
            qr[j] = q8 * __expf(bc - bl); ks[j] = kf[j] * __expf(bl - bc); qi[j] = q8 * __expf(bc); }
        u32x4 w;
        w.x = cvtpk_s(qr[0], qr[1]); w.y = cvtpk_s(qr[2], qr[3]); w.z = cvtpk_s(qr[4], qr[5]); w.w = cvtpk_s(qr[6], qr[7]); *(LAS u32x4*)(lds + GL_A + c * GROWB + 16 * dg) = w;
        w.x = cvtpk_s(ks[0], ks[1]); w.y = cvtpk_s(ks[2], ks[3]); w.z = cvtpk_s(ks[4], ks[5]); w.w = cvtpk_s(ks[6], ks[7]); *(LAS u32x4*)(lds + GL_B + c * GROWB + 16 * dg) = w;
        w.x = cvtpk_s(qi[0], qi[1]); w.y = cvtpk_s(qi[2], qi[3]); w.z = cvtpk_s(qi[4], qi[5]); w.w = cvtpk_s(qi[6], qi[7]); *(LAS u32x4*)(lds + GL_C + c * GROWB + 16 * dg) = w;
    }
    gla_stage_vt(va_, vb_, lds);
    __syncthreads();
    f32x16 o;
#pragma unroll
    for (int i = 0; i < 16; ++i) o[i] = 0.f;
#pragma unroll
    for (int jb = 0; jb < 2; ++jb) if (jb <= cb) {
        f32x16 at;
#pragma unroll
        for (int i = 0; i < 16; ++i) at[i] = 0.f;
#pragma unroll
        for (int ks = 0; ks < 4; ++ks) { const bf16x8 av = *(const LAS bf16x8*)(lds + GL_B + (32 * jb + r32) * GROWB + 32 * ks + 16 * hh), bv = *(const LAS bf16x8*)(lds + GL_A + (32 * cb + r32) * GROWB + 32 * ks + 16 * hh);
            at = __builtin_amdgcn_mfma_f32_32x32x16_bf16(av, bv, at, 0, 0, 0); }
        if (jb == cb) {
#pragma unroll
            for (int i = 0; i < 16; ++i) if (crow(i, hh) > r32) at[i] = 0.f; }
#pragma unroll
        for (int s = 0; s < 2; ++s) {
            u32x4 pw; pw.x = cvtpk_s(at[8 * s], at[8 * s + 1]); pw.y = cvtpk_s(at[8 * s + 2], at[8 * s + 3]); pw.z = cvtpk_s(at[8 * s + 4], at[8 * s + 5]); pw.w = cvtpk_s(at[8 * s + 6], at[8 * s + 7]);
            const LAS unsigned char* vp = lds + GL_VT + (32 * dvb + r32) * GROWB + (32 * jb + 16 * s + 4 * hh) * 2;
            const u32x2 lo = *(const LAS u32x2*)vp, hi = *(const LAS u32x2*)(vp + 16);
            const u32x4 va = (u32x4){lo.x, lo.y, hi.x, hi.y};
            o = __builtin_amdgcn_mfma_f32_32x32x16_bf16(__builtin_bit_cast(bf16x8, va), __builtin_bit_cast(bf16x8, pw), o, 0, 0, 0);
        }
    }
#pragma unroll
    for (int ks = 0; ks < 4; ++ks) { const bf16x8 bv = *(const LAS bf16x8*)(lds + GL_C + (32 * cb + r32) * GROWB + 32 * ks + 16 * hh);
        o = __builtin_amdgcn_mfma_f32_32x32x16_bf16(spf[ks], bv, o, 0, 0, 0); }
    LAS float* ST = (LAS float*)(lds + GL_ST);
    float sm = 0.f;
#pragma unroll
    for (int i = 0; i < 16; ++i) sm += o[i];
    sm += __shfl_xor(sm, 32);
    if (hh == 0) ST[dvb * 64 + 32 * cb + r32] = sm;
    __syncthreads();
    const float mean = (ST[32 * cb + r32] + ST[64 + 32 * cb + r32] + ST[128 + 32 * cb + r32] + ST[192 + 32 * cb + r32]) * (1.f / 128.f);
    float sq = 0.f;
#pragma unroll
    for (int i = 0; i < 16; ++i) { o[i] -= mean; sq += o[i] * o[i]; }
    sq += __shfl_xor(sq, 32);
    if (hh == 0) ST[256 + dvb * 64 + 32 * cb + r32] = sq;
    __syncthreads();
    const float var = (ST[256 + 32 * cb + r32] + ST[256 + 64 + 32 * cb + r32] + ST[256 + 128 + 32 * cb + r32] + ST[256 + 192 + 32 * cb + r32]) * (1.f / 128.f);
    const float rstd = 1.f / sqrtf(var + LN_EPS);
    bf16_t* op = (bf16_t*)(ws + WS_OAB) + trow * 1024 + 512 + dvbase;
#pragma unroll
    for (int g = 0; g < 4; ++g) { const u32x2 gw = grw[g]; const f32x4 nv = *(const f32x4*)(ng + dvbase + 8 * g);
        float gr[4] = {__uint_as_float(gw.x << 16), __uint_as_float(gw.x & 0xffff0000u), __uint_as_float(gw.y << 16), __uint_as_float(gw.y & 0xffff0000u)}; float y[4];
#pragma unroll
        for (int e = 0; e < 4; ++e) y[e] = o[4 * g + e] * rstd * nv[e] * (gr[e] * __builtin_amdgcn_rcpf(1.f + __expf(-gr[e])));
        u32x2 w; w.x = cvtpk_s(y[0], y[1]); w.y = cvtpk_s(y[2], y[3]); *(u32x2*)(op + 8 * g) = w; }
}

constexpr int GL_HALF = 67584;
__device__ __forceinline__ void gla_cumdecay2(size_t r0, int h, const bf16_t* WGT, const float* bg, unsigned char* ws, LAS unsigned char* ldh, float* lgc) {
    const int tl = threadIdx.x & 255, lane = threadIdx.x & 63, wl = (threadIdx.x >> 6) & 3, r32 = lane & 31, hh = lane >> 5; LAS float* LG = (LAS float*)(ldh + GL_LG); LAS float* SEG = (LAS float*)(ldh + GL_SEG);
    {   const int cb = wl >> 1, db = wl & 1;
        const bf16x8 af = *(const bf16x8*)((const bf16_t*)(ws + WS_GLR) + (r0 + 32 * cb + r32) * 16 + 8 * hh), bfr = *(const bf16x8*)(WGT + (size_t)(h * 64 + 32 * db + r32) * 16 + 8 * hh);
        const float bias = bg[h * 64 + 32 * db + r32]; f32x16 z;
#pragma unroll
        for (int i = 0; i < 16; ++i) z[i] = bias;
        z = __builtin_amdgcn_mfma_f32_32x32x16_bf16(af, bfr, z, 0, 0, 0);
#pragma unroll
        for (int i = 0; i < 16; ++i) { const float zz = z[i]; LG[(32 * cb + crow(i, hh)) * 64 + 32 * db + r32] = (fminf(zz, 0.f) - __logf(1.f + __expf(-fabsf(zz)))) * (1.f / 16.f); }
    }
    __syncthreads();
    const int seg = tl >> 6, d = tl & 63; float v[16];
#pragma unroll
    for (int i = 0; i < 16; ++i) v[i] = LG[(16 * seg + i) * 64 + d];
#pragma unroll
    for (int i = 1; i < 16; ++i) v[i] += v[i - 1];
    SEG[seg * 64 + d] = v[15];
    __syncthreads();
    float off = 0.f;
#pragma unroll
    for (int s2 = 0; s2 < 4; ++s2) if (s2 < seg) off += SEG[s2 * 64 + d];
#pragma unroll
    for (int i = 0; i < 16; ++i) { const float bv = v[i] + off; LG[(16 * seg + i) * 64 + d] = bv; lgc[(16 * seg + i) * 64 + d] = bv; }
    __syncthreads();
}
__device__ __forceinline__ void gla_stage_vt2(const u32x4 (&vv)[4], LAS unsigned char* ldh) {
    const int tl = threadIdx.x & 255, c = tl >> 2, d0 = (tl & 3) * 32;
#pragma unroll
    for (int k = 0; k < 4; ++k)
#pragma unroll
        for (int j = 0; j < 4; ++j) {
            *(LAS unsigned short*)(ldh + GL_VT + (d0 + 8 * k + 2 * j) * GROWB + c * 2) = (unsigned short)(vv[k][j] & 0xffffu);
            *(LAS unsigned short*)(ldh + GL_VT + (d0 + 8 * k + 2 * j + 1) * GROWB + c * 2) = (unsigned short)(vv[k][j] >> 16); }
}
__device__ __forceinline__ void p3b_pair(int p, const float* wg, const float* bg, float* UT, float* LGC, unsigned char* ws, LAS unsigned char* lds) {
    const int tid = threadIdx.x, hb = tid >> 8, tl = tid & 255, lane = tid & 63, wl = (tid >> 6) & 3, fr = lane & 15, fq = lane >> 4;
    const int it = 2 * p + hb; LAS unsigned char* ldh = lds + hb * GL_HALF;
    const int bh = it >> 6, n = it & 63, b = bh >> 2, h = bh & 3; const size_t r0 = (size_t)b * NS + 64 * n;
    const int c_ = tl >> 2, dq_ = tl & 3;
    const bf16_t* kp_ = (const bf16_t*)(ws + WS_GQK) + (r0 + c_) * 512 + 256 + h * 64 + 16 * dq_; const u32x4 k0 = *(const u32x4*)kp_, k1 = *(const u32x4*)(kp_ + 8);
    const bf16_t* vp_ = (const bf16_t*)(ws + WS_GV) + (r0 + c_) * 512 + h * 128 + 32 * dq_; u32x4 vv[4];
#pragma unroll
    for (int k = 0; k < 4; ++k) vv[k] = *(const u32x4*)(vp_ + 8 * k);
    __syncthreads();
    gla_cumdecay2(r0, h, (const bf16_t*)(ws + WS_WGT), bg, ws, ldh, LGC + (size_t)it * 4096);
    const LAS float* LG = (const LAS float*)(ldh + GL_LG);
    {   float kf[16]; bf8_to_f(k0, kf); bf8_to_f(k1, kf + 8);
#pragma unroll
        for (int j = 0; j < 16; ++j) { const int d = 16 * dq_ + j; *(LAS unsigned short*)(ldh + GL_A + d * GROWB + c_ * 2) = f2bf_s(kf[j] * __expf(LG[63 * 64 + d] - LG[c_ * 64 + d])); }
        if (tl < 64) ((float*)(ws + WS_MISC))[(size_t)it * 64 + tl] = __expf(LG[63 * 64 + tl]);
    }
    gla_stage_vt2(vv, ldh);
    __syncthreads();
#pragma unroll
    for (int dvi = 0; dvi < 2; ++dvi) {
        const int dvblk = 2 * wl + dvi;
        f32x4 acc[4];
#pragma unroll
        for (int i = 0; i < 4; ++i) acc[i] = (f32x4){0.f, 0.f, 0.f, 0.f};
#pragma unroll
        for (int ks = 0; ks < 2; ++ks) { const bf16x8 bv = *(const LAS bf16x8*)(ldh + GL_VT + (16 * dvblk + fr) * GROWB + (32 * ks + 8 * fq) * 2);
#pragma unroll
            for (int i = 0; i < 4; ++i) { const bf16x8 av = *(const LAS bf16x8*)(ldh + GL_A + (16 * i + fr) * GROWB + (32 * ks + 8 * fq) * 2); acc[i] = __builtin_amdgcn_mfma_f32_16x16x32_bf16(av, bv, acc[i], 0, 0, 0); } }
#pragma unroll
        for (int i = 0; i < 4; ++i) *(f32x4*)(UT + ((size_t)it * 128 + 16 * dvblk + fr) * 64 + 16 * i + 4 * fq) = acc[i];
    }
}
__device__ __forceinline__ void p5b_pair(int p, const float* LGC, const float* ng, const bf16_t* SP, unsigned char* ws, LAS unsigned char* lds) {
    const int tid = threadIdx.x, hb = tid >> 8, tl = tid & 255, lane = tid & 63, wl = (tid >> 6) & 3, r32 = lane & 31, hh = lane >> 5;
    const int it = 2 * p + hb; LAS unsigned char* ldh = lds + hb * GL_HALF;
    const int bh = it >> 6, n = it & 63, b = bh >> 2, h = bh & 3; const size_t r0 = (size_t)b * NS + 64 * n;
    const int c_ = tl >> 2, dq_ = tl & 3; const int dvb = wl;
    f32x4 lg[4];
#pragma unroll
    for (int k = 0; k < 4; ++k) lg[k] = *(const f32x4*)(LGC + (size_t)it * 4096 + c_ * 64 + 16 * dq_ + 4 * k);
    const bf16_t* qp_ = (const bf16_t*)(ws + WS_GQK) + (r0 + c_) * 512 + h * 64 + 16 * dq_; const u32x4 q0 = *(const u32x4*)qp_, q1 = *(const u32x4*)(qp_ + 8), k0 = *(const u32x4*)(qp_ + 256), k1 = *(const u32x4*)(qp_ + 264);
    const bf16_t* vp_ = (const bf16_t*)(ws + WS_GV) + (r0 + c_) * 512 + h * 128 + 32 * dq_; u32x4 vv[4];
#pragma unroll
    for (int k = 0; k < 4; ++k) vv[k] = *(const u32x4*)(vp_ + 8 * k);
    bf16x8 spf[4];
#pragma unroll
    for (int ks = 0; ks < 4; ++ks) spf[ks] = *(const bf16x8*)(SP + ((size_t)it * 128 + 32 * dvb + r32) * 64 + 16 * ks + 8 * hh);
    const int dvbase = h * 128 + 32 * dvb + 4 * hh; u32x2 grw[2][4];
#pragma unroll
    for (int cb = 0; cb < 2; ++cb)
#pragma unroll
        for (int g = 0; g < 4; ++g) grw[cb][g] = *(const u32x2*)((const bf16_t*)(ws + WS_GR) + (r0 + 32 * cb + r32) * 512 + dvbase + 8 * g);
    __syncthreads();
    { LAS float* LGw = (LAS float*)(ldh + GL_LG);
#pragma unroll
      for (int k = 0; k < 4; ++k) *(LAS f32x4*)(LGw + c_ * 64 + 16 * dq_ + 4 * k) = lg[k]; }
    __syncthreads();
    const LAS float* LG = (const LAS float*)(ldh + GL_LG);
    {   float qf[16], kf[16]; bf8_to_f(q0, qf); bf8_to_f(q1, qf + 8); bf8_to_f(k0, kf); bf8_to_f(k1, kf + 8);
        float qr[16], ks[16], qi[16];
#pragma unroll
        for (int j = 0; j < 16; ++j) { const int d = 16 * dq_ + j; const float bc = LG[c_ * 64 + d], bl = LG[63 * 64 + d]; const float q8 = qf[j] * 0.125f;
            qr[j] = q8 * __expf(bc - bl); ks[j] = kf[j] * __expf(bl - bc); qi[j] = q8 * __expf(bc); }
#pragma unroll
        for (int k = 0; k < 2; ++k) { u32x4 w;
            w.x = cvtpk_s(qr[8 * k], qr[8 * k + 1]); w.y = cvtpk_s(qr[8 * k + 2], qr[8 * k + 3]); w.z = cvtpk_s(qr[8 * k + 4], qr[8 * k + 5]); w.w = cvtpk_s(qr[8 * k + 6], qr[8 * k + 7]); *(LAS u32x4*)(ldh + GL_A + c_ * GROWB + 32 * dq_ + 16 * k) = w;
            w.x = cvtpk_s(ks[8 * k], ks[8 * k + 1]); w.y = cvtpk_s(ks[8 * k + 2], ks[8 * k + 3]); w.z = cvtpk_s(ks[8 * k + 4], ks[8 * k + 5]); w.w = cvtpk_s(ks[8 * k + 6], ks[8 * k + 7]); *(LAS u32x4*)(ldh + GL_B + c_ * GROWB + 32 * dq_ + 16 * k) = w;
            w.x = cvtpk_s(qi[8 * k], qi[8 * k + 1]); w.y = cvtpk_s(qi[8 * k + 2], qi[8 * k + 3]); w.z = cvtpk_s(qi[8 * k + 4], qi[8 * k + 5]); w.w = cvtpk_s(qi[8 * k + 6], qi[8 * k + 7]); *(LAS u32x4*)(ldh + GL_C + c_ * GROWB + 32 * dq_ + 16 * k) = w; }
    }
    gla_stage_vt2(vv, ldh);
    __syncthreads();
    f32x16 o[2];
#pragma unroll
    for (int cb = 0; cb < 2; ++cb) {
#pragma unroll
        for (int i = 0; i < 16; ++i) o[cb][i] = 0.f;
#pragma unroll
        for (int jb = 0; jb < 2; ++jb) if (jb <= cb) {
            f32x16 at;
#pragma unroll
            for (int i = 0; i < 16; ++i) at[i] = 0.f;
#pragma unroll
            for (int ks = 0; ks < 4; ++ks) { const bf16x8 av = *(const LAS bf16x8*)(ldh + GL_B + (32 * jb + r32) * GROWB + 32 * ks + 16 * hh), bv = *(const LAS bf16x8*)(ldh + GL_A + (32 * cb + r32) * GROWB + 32 * ks + 16 * hh);
                at = __builtin_amdgcn_mfma_f32_32x32x16_bf16(av, bv, at, 0, 0, 0); }
            if (jb == cb) {
#pragma unroll
                for (int i = 0; i < 16; ++i) if (crow(i, hh) > r32) at[i] = 0.f; }
#pragma unroll
            for (int s2 = 0; s2 < 2; ++s2) {
                u32x4 pw; pw.x = cvtpk_s(at[8 * s2], at[8 * s2 + 1]); pw.y = cvtpk_s(at[8 * s2 + 2], at[8 * s2 + 3]); pw.z = cvtpk_s(at[8 * s2 + 4], at[8 * s2 + 5]); pw.w = cvtpk_s(at[8 * s2 + 6], at[8 * s2 + 7]);
                const LAS unsigned char* vp = ldh + GL_VT + (32 * dvb + r32) * GROWB + (32 * jb + 16 * s2 + 4 * hh) * 2;
                const u32x2 lo = *(const LAS u32x2*)vp, hi = *(const LAS u32x2*)(vp + 16);
                const u32x4 va = (u32x4){lo.x, lo.y, hi.x, hi.y};
                o[cb] = __builtin_amdgcn_mfma_f32_32x32x16_bf16(__builtin_bit_cast(bf16x8, va), __builtin_bit_cast(bf16x8, pw), o[cb], 0, 0, 0);
            }
        }
#pragma unroll
        for (int ks = 0; ks < 4; ++ks) { const bf16x8 bv = *(const LAS bf16x8*)(ldh + GL_C + (32 * cb + r32) * GROWB + 32 * ks + 16 * hh);
            o[cb] = __builtin_amdgcn_mfma_f32_32x32x16_bf16(spf[ks], bv, o[cb], 0, 0, 0); }
    }
    LAS float* ST = (LAS float*)(ldh + GL_ST);
#pragma unroll
    for (int cb = 0; cb < 2; ++cb) { float sm = 0.f;
#pragma unroll
        for (int i = 0; i < 16; ++i) sm += o[cb][i];
        sm += __shfl_xor(sm, 32);
        if (hh == 0) ST[dvb * 64 + 32 * cb + r32] = sm; }
    __syncthreads();
    float mean[2];
#pragma unroll
    for (int cb = 0; cb < 2; ++cb) { const int cc = 32 * cb + r32; mean[cb] = (ST[cc] + ST[64 + cc] + ST[128 + cc] + ST[192 + cc]) * (1.f / 128.f); float sq = 0.f;
#pragma unroll
        for (int i = 0; i < 16; ++i) { o[cb][i] -= mean[cb]; sq += o[cb][i] * o[cb][i]; }
        sq += __shfl_xor(sq, 32);
        if (hh == 0) ST[256 + dvb * 64 + cc] = sq; }
    __syncthreads();
#pragma unroll
    for (int cb = 0; cb < 2; ++cb) { const int cc = 32 * cb + r32; const float var = (ST[256 + cc] + ST[256 + 64 + cc] + ST[256 + 128 + cc] + ST[256 + 192 + cc]) * (1.f / 128.f);
        const float rstd = 1.f / sqrtf(var + LN_EPS);
        bf16_t* op = (bf16_t*)(ws + WS_OAB) + (r0 + cc) * 1024 + 512 + dvbase;
#pragma unroll
        for (int g = 0; g < 4; ++g) { const u32x2 gw = grw[cb][g]; const f32x4 nv = *(const f32x4*)(ng + dvbase + 8 * g);
            float gr[4] = {__uint_as_float(gw.x << 16), __uint_as_float(gw.x & 0xffff0000u), __uint_as_float(gw.y << 16), __uint_as_float(gw.y & 0xffff0000u)}; float y[4];
#pragma unroll
            for (int e = 0; e < 4; ++e) y[e] = o[cb][4 * g + e] * rstd * nv[e] * (gr[e] * __builtin_amdgcn_rcpf(1.f + __expf(-gr[e])));
            u32x2 w; w.x = cvtpk_s(y[0], y[1]); w.y = cvtpk_s(y[2], y[3]); *(u32x2*)(op + 8 * g) = w; } }
}

constexpr size_t WS_SG = 129 * MiB;
constexpr size_t WS_MRG = 257 * MiB;
constexpr size_t WS_H2 = WS_XN;
constexpr size_t WS_XG = 129 * MiB;
constexpr size_t WS_HID = 321 * MiB;
constexpr size_t WS_YG = 358 * MiB;
constexpr size_t WS_EID = WS_MISC + 1 * MiB, WS_EW = WS_EID + 256 * 1024, WS_POS = WS_EW + 256 * 1024, WS_ST1 = WS_POS + 256 * 1024;
constexpr size_t WS_LIST = 490 * MiB;
constexpr int LDS_TAB = 131072;
__device__ __forceinline__ u32x4 pack8(const f32x4 a, const f32x4 b) { u32x4 w; w.x = cvtpk_s(a[0], a[1]); w.y = cvtpk_s(a[2], a[3]); w.z = cvtpk_s(b[0], b[1]); w.w = cvtpk_s(b[2], b[3]); return w; }
__device__ __forceinline__ f32x4 sig4(const f32x4 v) { f32x4 r; r[0] = __builtin_amdgcn_rcpf(1.f + __expf(-v[0])); r[1] = __builtin_amdgcn_rcpf(1.f + __expf(-v[1])); r[2] = __builtin_amdgcn_rcpf(1.f + __expf(-v[2])); r[3] = __builtin_amdgcn_rcpf(1.f + __expf(-v[3])); return r; }
__device__ __forceinline__ void unpack8(const u32x4 w, f32x4& a, f32x4& b) {
    a[0] = __uint_as_float(w.x << 16); a[1] = __uint_as_float(w.x & 0xffff0000u); a[2] = __uint_as_float(w.y << 16); a[3] = __uint_as_float(w.y & 0xffff0000u);
    b[0] = __uint_as_float(w.z << 16); b[1] = __uint_as_float(w.z & 0xffff0000u); b[2] = __uint_as_float(w.w << 16); b[3] = __uint_as_float(w.w & 0xffff0000u);
}
#define EPI_ROWS(...) _Pragma("unroll") for (int ai = 0; ai < 2; ++ai) _Pragma("unroll") for (int m = 0; m < 4; ++m) { const size_t row = (size_t)(row0 + ai * 128 + m * 16); _Pragma("unroll") for (int bj = 0; bj < 2; ++bj) { __VA_ARGS__ } }
struct EpiSig {
    static constexpr bool PERM = true, AFTER_DRAIN = false, MID = false; unsigned char* ws; int half;
    __device__ __forceinline__ void operator()(const f32x4 (&acc)[2][2][4][2], const Unit& u, int wr, int wc, int fr, int fq) const {
        const int row0 = u.pm * 256 + wr * 64 + fr, col0 = half * 1024 + u.pn * 256 + wc * 32 + 8 * fq; bf16_t* SG = (bf16_t*)(ws + WS_SG);
        EPI_ROWS( *(u32x4*)(SG + row * 2048 + col0 + bj * 128) = pack8(sig4(acc[ai][bj][m][0]), sig4(acc[ai][bj][m][1])); )
    }
};
struct EpiMrgF {
    static constexpr bool PERM = true, AFTER_DRAIN = false, MID = true; unsigned char* ws;
    __device__ __forceinline__ void mid(f32x4 (&acc)[2][2][4][2], const Unit& u, int wr, int wc, int fr, int fq) const {
        const int row0 = u.pm * 256 + wr * 64 + fr, col0 = u.pn * 256 + wc * 32 + 8 * fq; const bf16_t* SG = (const bf16_t*)(ws + WS_SG);
        const bf16_t* p = SG + (size_t)row0 * 2048 + col0;
#pragma unroll
        for (int ai = 0; ai < 2; ++ai)
#pragma unroll
            for (int m = 0; m < 4; ++m) {
                asm volatile("" : "+v"(p));
#pragma unroll
                for (int bj = 0; bj < 2; ++bj) { f32x4 a0, a1, b0, b1; unpack8(*(const u32x4*)(p + bj * 128), a0, a1); unpack8(*(const u32x4*)(p + 1024 + bj * 128), b0, b1);
#pragma unroll
                    for (int e = 0; e < 4; ++e) { acc[ai][bj][m][0][e] *= a0[e] * __builtin_amdgcn_rcpf(fmaxf(b0[e], 1e-30f)); acc[ai][bj][m][1][e] *= a1[e] * __builtin_amdgcn_rcpf(fmaxf(b1[e], 1e-30f)); } }
                p += (m == 3 ? (128 - 48) : 16) * 2048; }
    }
    __device__ __forceinline__ void operator()(const f32x4 (&acc)[2][2][4][2], const Unit& u, int wr, int wc, int fr, int fq) const {
        const int row0 = u.pm * 256 + wr * 64 + fr, col0 = u.pn * 256 + wc * 32 + 8 * fq; const bf16_t* SG = (const bf16_t*)(ws + WS_SG) + 1024; bf16_t* MR = (bf16_t*)(ws + WS_MRG);
        EPI_ROWS( f32x4 g0, g1; unpack8(*(const u32x4*)(SG + row * 2048 + col0 + bj * 128), g0, g1); *(u32x4*)(MR + row * 1024 + col0 + bj * 128) = pack8(g0 * acc[ai][bj][m][0], g1 * acc[ai][bj][m][1]); )
    }
};
constexpr size_t WS_VB = 129 * MiB;
struct EpiV {
    static constexpr bool PERM = false, AFTER_DRAIN = false, MID = false; const float* x; const float* ada; bf16_t* out;
    __device__ __forceinline__ void operator()(const f32x4 (&acc)[2][2][4][2], const Unit& u, int wr, int wc, int fr, int fq) const {
        const int row0 = u.pm * 256 + wr * 64 + fr, col0 = u.pn * 256 + wc * 32 + 4 * fq; const float* gt1 = ada + (size_t)(u.pm >> 4) * 6 * D_MODEL + 2 * D_MODEL;
        EPI_ROWS( _Pragma("unroll") for (int n = 0; n < 2; ++n) { const int c = col0 + bj * 128 + n * 16; const f32x4 xv = *(const f32x4*)(x + row * D_MODEL + c), gv = *(const f32x4*)(gt1 + c);
                  const f32x4 vv = xv * DN_ALPHA + gv * acc[ai][bj][m][n]; u32x2 w; w.x = cvtpk_s(vv.x, vv.y); w.y = cvtpk_s(vv.z, vv.w); *(u32x2*)(out + row * D_MODEL + c) = w; } )
    }
};
struct EpiHid {
    static constexpr bool PERM = true, AFTER_DRAIN = false, MID = false; unsigned char* ws;
    __device__ __forceinline__ void operator()(const f32x4 (&acc)[2][2][4][2], const Unit& u, int wr, int wc, int fr, int fq) const {
        const int row0 = u.pm * 256 + wr * 64 + fr, col0 = u.pn * 128 + wc * 32 + 8 * fq; bf16_t* H = (bf16_t*)(ws + WS_HID);
#pragma unroll
        for (int ai = 0; ai < 2; ++ai)
#pragma unroll
            for (int m = 0; m < 4; ++m) { const size_t row = (size_t)(row0 + ai * 128 + m * 16); f32x4 h0, h1;
#pragma unroll
                for (int e = 0; e < 4; ++e) { const float g0 = acc[ai][0][m][0][e], g1 = acc[ai][0][m][1][e]; h0[e] = g0 * __builtin_amdgcn_rcpf(1.f + __expf(-g0)) * acc[ai][1][m][0][e]; h1[e] = g1 * __builtin_amdgcn_rcpf(1.f + __expf(-g1)) * acc[ai][1][m][1][e]; }
                *(u32x4*)(H + row * 256 + col0) = pack8(h0, h1); }
    }
};
struct EpiY {
    static constexpr bool PERM = true, AFTER_DRAIN = false, MID = false; unsigned char* ws;
    __device__ __forceinline__ void operator()(const f32x4 (&acc)[2][2][4][2], const Unit& u, int wr, int wc, int fr, int fq) const {
        const int row0 = u.pm * 256 + wr * 64 + fr, col0 = u.pn * 256 + wc * 32 + 8 * fq; bf16_t* Y = (bf16_t*)(ws + WS_YG);
        EPI_ROWS( *(u32x4*)(Y + row * 1024 + col0 + bj * 128) = pack8(acc[ai][bj][m][0], acc[ai][bj][m][1]); )
    }
};
__device__ __forceinline__ void build_tables(unsigned char* ws, LAS unsigned char* lds) {
    LAS int* toff = (LAS int*)(lds + LDS_TAB); LAS int* texp = toff + 64; const unsigned* gcnt = (const unsigned*)(ws + WS_CNT);
    __syncthreads();
    if (threadIdx.x == 0) { int o = 0; for (int e = 0; e < N_EXP; ++e) { toff[e] = o; const int ce = (int)gcnt[e * 32]; toff[400 + e] = ce; o += (ce + 255) >> 8; } toff[32] = o; }
    __syncthreads();
    for (int tl = threadIdx.x; tl < toff[32]; tl += NTHREADS) { int e = 0; while (toff[e + 1] <= tl) ++e; texp[tl] = e; }
    __syncthreads();
}
template <int NPN> struct GroupOrder {
    const LAS int* toff; const LAS int* texp; int G, c;
    __device__ __forceinline__ bool next(int i, Unit& u) const { const int L = i * G + c; if (L >= toff[32] * NPN) return false; const int tl = L / NPN, pn = L % NPN; u.pm = tl; u.pa = tl; u.pn = pn; u.pb = texp[tl] * NPN + pn; return true; }
    __device__ __forceinline__ void a_ready(const Unit&) const {}
    __device__ __forceinline__ void done(const Unit&) const {}
    const int* list;
    __device__ __forceinline__ int a_row(const Unit& u, int r) const { const int e = texp[u.pa]; const int idx = (u.pa - toff[e]) * 256 + r; return idx < toff[400 + e] ? list[e * 32768 + idx] : 0; }
};
constexpr int WT_LD = 1028;
constexpr int P8_LCNT = 36 * WT_LD * 4;
__device__ __forceinline__ float dot16(const f32x4 (&v)[4], const LAS float* wp, int lane) {
    float p = 0.f;
#pragma unroll
    for (int j = 0; j < 4; ++j) { const f32x4 w4 = *(const LAS f32x4*)(wp + 256 * j + 4 * lane); p += (v[j].x * w4.x + v[j].y * w4.y) + (v[j].z * w4.z + v[j].w * w4.w); }
    return p;
}
__device__ __forceinline__ float rl4sum(float v) {
    return (__int_as_float(__builtin_amdgcn_readlane(__float_as_int(v), 0)) + __int_as_float(__builtin_amdgcn_readlane(__float_as_int(v), 16)))
         + (__int_as_float(__builtin_amdgcn_readlane(__float_as_int(v), 32)) + __int_as_float(__builtin_amdgcn_readlane(__float_as_int(v), 48)));
}
template <bool REAL> __device__ __forceinline__ void p8_phase(const float* const* in, const bf16_t* vsrc, float* x1dst, bf16_t* h2dst, unsigned char* ws, LAS unsigned char* lds, int G) {
    const int tid = threadIdx.x, lane = tid & 63, wave = tid >> 6;
    LAS float* WT = (LAS float*)lds;
    LAS int* lcnt = (LAS int*)(lds + P8_LCNT); LAS int* lbase = lcnt + 32; LAS int* ent = lcnt + 64;
    const float* wrg = in[14]; const float* wre = in[16];
    __syncthreads();
    for (int i = tid; i < 1024; i += NTHREADS) { const f32x4 w = *(const f32x4*)(wrg + 4 * i); WT[0 * WT_LD + i] = w.x; WT[1 * WT_LD + i] = w.y; WT[2 * WT_LD + i] = w.z; WT[3 * WT_LD + i] = w.w; }
    for (int i = tid; i < 8192; i += NTHREADS) { const f32x4 w = *(const f32x4*)(wre + 4 * i); const int k = i >> 3, c = 4 * (i & 7);
        WT[(4 + c) * WT_LD + k] = w.x; WT[(5 + c) * WT_LD + k] = w.y; WT[(6 + c) * WT_LD + k] = w.z; WT[(7 + c) * WT_LD + k] = w.w; }
    const float* g1 = in[12]; const float* b1 = in[13]; const float* brg = in[15]; const float* bre = in[17];
    for (int blk = blockIdx.x; blk < NT / 128; blk += G) {
        const int b = blk / 32; const float* ada = (const float*)(ws + WS_ADA) + (size_t)b * 6 * D_MODEL; const float* sh2 = ada + 3 * D_MODEL; const float* sc2 = ada + 4 * D_MODEL;
        if (tid < 32) lcnt[tid] = 0;
        __syncthreads();
        for (int rb = 0; rb < 16; rb += 4) {
            const int rl0 = wave * 16 + rb; const size_t row0 = (size_t)blk * 128 + rl0;
            f32x4 v[4][4];
#pragma unroll
            for (int r = 0; r < 4; ++r) { const u32x2* xr = (const u32x2*)(vsrc + (row0 + r) * D_MODEL) + lane;
#pragma unroll
                for (int j = 0; j < 4; ++j) { const u32x2 w = xr[64 * j]; v[r][j] = (f32x4){__uint_as_float(w.x << 16), __uint_as_float(w.x & 0xffff0000u), __uint_as_float(w.y << 16), __uint_as_float(w.y & 0xffff0000u)}; } }
            float rstd[4], mean1[4]; ln_center<4>(v, rstd, mean1);
            if (REAL && lane < 4) { typedef float f32x2v __attribute__((ext_vector_type(2))); ((f32x2v*)(ws + WS_ST1))[row0 + lane] = (f32x2v){lane == 0 ? mean1[0] : lane == 1 ? mean1[1] : lane == 2 ? mean1[2] : mean1[3], lane == 0 ? rstd[0] : lane == 1 ? rstd[1] : lane == 2 ? rstd[2] : rstd[3]}; }
#pragma unroll
            for (int j = 0; j < 4; ++j) { const f32x4 gg = *(const f32x4*)(g1 + 256 * j + 4 * lane), bb = *(const f32x4*)(b1 + 256 * j + 4 * lane);
#pragma unroll
                for (int r = 0; r < 4; ++r) v[r][j] = v[r][j] * rstd[r] * gg + bb; }
            ln_center<4>(v, rstd);
#pragma unroll
            for (int j = 0; j < 4; ++j) { const f32x4 a4 = *(const f32x4*)(sc2 + 256 * j + 4 * lane) + 1.f, c4 = *(const f32x4*)(sh2 + 256 * j + 4 * lane);
#pragma unroll
                for (int r = 0; r < 4; ++r) { v[r][j] = v[r][j] * rstd[r] * a4 + c4; u32x2 w; w.x = cvtpk_s(v[r][j].x, v[r][j].y); w.y = cvtpk_s(v[r][j].z, v[r][j].w);
                    ((u32x2*)(h2dst + (row0 + r) * D_MODEL) + lane)[64 * j] = w; } }
#pragma unroll
            for (int r = 0; r < 4; ++r) {
                float gp[N_GROUPS];
#pragma unroll
                for (int g = 0; g < N_GROUPS; ++g) gp[g] = dpp_row_sum_f(dot16(v[r], WT + g * WT_LD, lane));
                float gl[N_GROUPS];
#pragma unroll
                for (int g = 0; g < N_GROUPS; ++g) gl[g] = rl4sum(gp[g]) + brg[g];
                int gi = 0; float gm = gl[0];
#pragma unroll
                for (int g = 1; g < N_GROUPS; ++g) if (gl[g] > gm) { gm = gl[g]; gi = g; }
                float gs = 0.f;
#pragma unroll
                for (int g = 0; g < N_GROUPS; ++g) gs += __expf(gl[g] - gm);
                const float gw = 1.f / gs;
                float ep[EPG];
#pragma unroll
                for (int e = 0; e < EPG; ++e) ep[e] = dpp_row_sum_f(dot16(v[r], WT + (4 + gi * EPG + e) * WT_LD, lane));
                float v0 = -INFINITY, v1 = -INFINITY; int i0 = 0, i1 = 0;
#pragma unroll
                for (int e = 0; e < EPG; ++e) { const float ev = rl4sum(ep[e]) + bre[gi * EPG + e];
                    if (ev > v0) { v1 = v0; i1 = i0; v0 = ev; i0 = e; } else if (ev > v1) { v1 = ev; i1 = e; } }
                const float e1 = __expf(v1 - v0); const float w0 = gw / (1.f + e1), w1 = gw * e1 / (1.f + e1);
                if (REAL && lane == 0) { const int ea = gi * EPG + i0, eb = gi * EPG + i1; const int rl = rl0 + r; const size_t row = row0 + r;
                    const int pa = atomicAdd((int*)&lcnt[ea], 1), pb = atomicAdd((int*)&lcnt[eb], 1);
                    ent[rl * 2] = (ea << 16) | pa; ent[rl * 2 + 1] = (eb << 16) | pb;
                    ((int*)(ws + WS_EID))[row * 2] = ea; ((int*)(ws + WS_EID))[row * 2 + 1] = eb; ((float*)(ws + WS_EW))[row * 2] = w0; ((float*)(ws + WS_EW))[row * 2 + 1] = w1; }
            }
        }
        __syncthreads();
        if (REAL && tid < 32) lbase[tid] = (int)atomicAdd((unsigned*)(ws + WS_CNT) + tid * 32, (unsigned)lcnt[tid]);
        __syncthreads();
        if (REAL && tid < 256) { const int en = ent[tid]; const int e = en >> 16, pos = lbase[e] + (en & 0xffff); ((int*)(ws + WS_POS))[(size_t)blk * 256 + tid] = pos; ((int*)(ws + WS_LIST))[e * 32768 + pos] = blk * 128 + (tid >> 1); }
        __syncthreads();
    }
}
__device__ __forceinline__ void p9_phase(unsigned char* ws, LAS unsigned char* lds, int G) {
    build_tables(ws, lds); const LAS int* toff = (const LAS int*)(lds + LDS_TAB);
    const int lane = threadIdx.x & 63, wave = threadIdx.x >> 6;
    for (int base = (blockIdx.x * NWAVES + wave) * 32; base < NT * 2; base += G * NWAVES * 32) {
        for (int k = 0; k < 32; k += 4) {
            const int ts0 = base + k; const int li = ts0 + (lane & 3);
            const int ev = ((const int*)(ws + WS_EID))[li], pv = ((const int*)(ws + WS_POS))[li];
            u32x4 d0[4], d1[4]; size_t dst[4];
#pragma unroll
            for (int r = 0; r < 4; ++r) { const int e = __builtin_amdgcn_readlane(ev, r), pos = __builtin_amdgcn_readlane(pv, r); dst[r] = (size_t)toff[e] * 256 + pos;
                const u32x4* sp = (const u32x4*)((const bf16_t*)(ws + WS_H2) + (size_t)((ts0 + r) >> 1) * D_MODEL); d0[r] = sp[lane]; d1[r] = sp[lane + 64]; }
#pragma unroll
            for (int r = 0; r < 4; ++r) { u32x4* dp = (u32x4*)((bf16_t*)(ws + WS_XG) + dst[r] * D_MODEL); dp[lane] = d0[r]; dp[lane + 64] = d1[r]; }
        }
    }
}
__device__ __forceinline__ void p12_phase(const float* const* in, const bf16_t* vsrc, float* dst, unsigned char* ws, LAS unsigned char* lds, int G) {
    build_tables(ws, lds); const LAS int* toff = (const LAS int*)(lds + LDS_TAB);
    const int lane = threadIdx.x & 63, wave = threadIdx.x >> 6; const float* g2 = in[21]; const float* b2 = in[22]; const float* g1 = in[12]; const float* b1 = in[13];
    for (int blk = blockIdx.x; blk < NT / 128; blk += G) {
        const int b = blk / 32; const float* gt2 = (const float*)(ws + WS_ADA) + (size_t)b * 6 * D_MODEL + 5 * D_MODEL;
        for (int rb = 0; rb < 16; rb += 4) {
            const size_t row0 = (size_t)blk * 128 + wave * 16 + rb;
            const size_t li = row0 * 2 + (lane & 7);
            const int ev = ((const int*)(ws + WS_EID))[li], pv = ((const int*)(ws + WS_POS))[li]; const float wv = ((const float*)(ws + WS_EW))[li];
            typedef float f32x2v __attribute__((ext_vector_type(2))); const f32x2v stv = ((const f32x2v*)(ws + WS_ST1))[row0 + (lane & 3)];
            f32x4 v[4][4]; u32x2 ya[4][4], yb[4][4]; float w0[4], w1[4], m1[4], r1[4];
#pragma unroll
            for (int r = 0; r < 4; ++r) {
                const int e0 = __builtin_amdgcn_readlane(ev, 2 * r), e1 = __builtin_amdgcn_readlane(ev, 2 * r + 1), p0 = __builtin_amdgcn_readlane(pv, 2 * r), p1 = __builtin_amdgcn_readlane(pv, 2 * r + 1);
                w0[r] = __int_as_float(__builtin_amdgcn_readlane(__float_as_int(wv), 2 * r)); w1[r] = __int_as_float(__builtin_amdgcn_readlane(__float_as_int(wv), 2 * r + 1));
                m1[r] = __int_as_float(__builtin_amdgcn_readlane(__float_as_int(stv.x), r)); r1[r] = __int_as_float(__builtin_amdgcn_readlane(__float_as_int(stv.y), r));
                const u32x2* y0 = (const u32x2*)((const bf16_t*)(ws + WS_YG) + ((size_t)toff[e0] * 256 + p0) * D_MODEL) + lane; const u32x2* y1 = (const u32x2*)((const bf16_t*)(ws + WS_YG) + ((size_t)toff[e1] * 256 + p1) * D_MODEL) + lane;
                const u32x2* xr = (const u32x2*)(vsrc + (row0 + r) * D_MODEL) + lane;
#pragma unroll
                for (int j = 0; j < 4; ++j) { const u32x2 w = xr[64 * j]; v[r][j] = (f32x4){__uint_as_float(w.x << 16), __uint_as_float(w.x & 0xffff0000u), __uint_as_float(w.y << 16), __uint_as_float(w.y & 0xffff0000u)};
                    ya[r][j] = y0[64 * j]; yb[r][j] = y1[64 * j]; } }
#pragma unroll
            for (int j = 0; j < 4; ++j) { const f32x4 gv = *(const f32x4*)(gt2 + 256 * j + 4 * lane), g1v = *(const f32x4*)(g1 + 256 * j + 4 * lane), b1v = *(const f32x4*)(b1 + 256 * j + 4 * lane);
#pragma unroll
                for (int r = 0; r < 4; ++r) { const u32x2 a = ya[r][j], c = yb[r][j]; f32x4 f; v[r][j] = (v[r][j] - m1[r]) * r1[r] * g1v + b1v;
                    f.x = w0[r] * __uint_as_float(a.x << 16) + w1[r] * __uint_as_float(c.x << 16); f.y = w0[r] * __uint_as_float(a.x & 0xffff0000u) + w1[r] * __uint_as_float(c.x & 0xffff0000u);
                    f.z = w0[r] * __uint_as_float(a.y << 16) + w1[r] * __uint_as_float(c.y << 16); f.w = w0[r] * __uint_as_float(a.y & 0xffff0000u) + w1[r] * __uint_as_float(c.y & 0xffff0000u);
                    v[r][j] = v[r][j] * DN_ALPHA + gv * f; } }
            float rstd[4]; ln_center<4>(v, rstd);
#pragma unroll
            for (int j = 0; j < 4; ++j) { const f32x4 gg = *(const f32x4*)(g2 + 256 * j + 4 * lane), bb = *(const f32x4*)(b2 + 256 * j + 4 * lane);
#pragma unroll
                for (int r = 0; r < 4; ++r) ((f32x4*)(dst + (row0 + r) * D_MODEL) + lane)[64 * j] = v[r][j] * rstd[r] * gg + bb; }
        }
    }
}

constexpr size_t WS_TS = 384 * 1024;
constexpr size_t WS_DEAD = 392 * 1024;
constexpr size_t WS_BAR = 320 * 1024;
#define RLX_AGENT __ATOMIC_RELAXED, __HIP_MEMORY_SCOPE_AGENT
#define XB_TMO      128
#define XB_XCNT(j)  (256  + 64 * (j))
#define XB_XSUB(j)  (1280 + 64 * (j))
#define XB_XGEN(j)  (2304 + 64 * (j))
#define XB_TOP      3328
#define XB_TOPGEN   3392
#define XCD_BAR_WORDS 3456
#define XB_SPIN_CAP (1u << 18)

__device__ __forceinline__ unsigned xb_ld(unsigned* p)              { return __hip_atomic_load(p, __ATOMIC_RELAXED, __HIP_MEMORY_SCOPE_AGENT); }
__device__ __forceinline__ unsigned xb_add(unsigned* p, unsigned v) { return __hip_atomic_fetch_add(p, v, __ATOMIC_RELAXED, __HIP_MEMORY_SCOPE_AGENT); }
__device__ __forceinline__ unsigned xb_xcc_id() { return (unsigned)__builtin_amdgcn_s_getreg((3 << 11) | 20) & 0xFu; }
#define XB_SPIN(cond, bar) do { unsigned _sp = 0; while (cond) { __builtin_amdgcn_s_sleep(1); \
    if ((++_sp & 255u) == 0u) { if (xb_ld(&(bar)[XB_TMO])) break; if (_sp > XB_SPIN_CAP) { atomicAdd(&(bar)[XB_TMO], 1u); break; } } } } while (0)

struct XcdBarrier {
    unsigned* bar; unsigned x;
    volatile LAS unsigned* st;
};

__device__ __forceinline__ XcdBarrier xcd_barrier_post(unsigned* bar, volatile LAS unsigned* st) {
    XcdBarrier b; b.bar = bar; b.x = xb_xcc_id(); b.st = st;
    if (threadIdx.x == 0) (void)xb_add(&bar[XB_XCNT(b.x)], 1u);
    return b;
}
__device__ __forceinline__ void xcd_barrier_complete(unsigned* bar, unsigned x, unsigned& nloc, unsigned& nx) {
    const unsigned G = gridDim.x * gridDim.y * gridDim.z;
    unsigned sum, cnt, mine, sp = 0u;
    for (;;) {
        sum = 0u; cnt = 0u; mine = 0u;
#pragma unroll
        for (unsigned j = 0; j < 16; ++j) { const unsigned c = xb_ld(&bar[XB_XCNT(j)]); sum += c; cnt += (c > 0u) ? 1u : 0u; mine = (j == x) ? c : mine; }
        if (sum == G) break;
        __builtin_amdgcn_s_sleep(1);
        if ((++sp & 255u) == 0u) { if (xb_ld(&bar[XB_TMO])) break; if (sp > XB_SPIN_CAP) { atomicAdd(&bar[XB_TMO], 1u); break; } }
    }
    nloc = mine > 0u ? mine : 1u; nx = cnt > 0u ? cnt : 1u;
}

__device__ __forceinline__ void xcd_barrier(const XcdBarrier& b) {
    asm volatile("s_waitcnt vmcnt(0)" ::: "memory");
    __syncthreads();
    if (threadIdx.x == 0) {
        unsigned* bar = b.bar;
        __builtin_amdgcn_s_waitcnt(0);
        unsigned nloc = b.st[0], nx = b.st[1];
        if (nloc == 0u) { xcd_barrier_complete(bar, b.x, nloc, nx); b.st[0] = nloc; b.st[1] = nx; }
        const unsigned old = xb_add(&bar[XB_XSUB(b.x)], 1u);
        const unsigned gen = old / nloc;
        if (old + 1u == (gen + 1u) * nloc) {
            __builtin_amdgcn_fence(__ATOMIC_RELEASE, "agent");
            asm volatile("s_waitcnt vmcnt(0)" ::: "memory");
            const unsigned og = xb_add(&bar[XB_TOP], 1u);
            const unsigned tg = og / nx;
            if (og + 1u == (tg + 1u) * nx) xb_add(&bar[XB_TOPGEN], 1u);
            else XB_SPIN(xb_ld(&bar[XB_TOPGEN]) == tg, bar);
            __builtin_amdgcn_fence(__ATOMIC_ACQUIRE, "agent");
            xb_add(&bar[XB_XGEN(b.x)], 1u);
            asm volatile("s_waitcnt vmcnt(0)" ::: "memory");
        } else {
            XB_SPIN(xb_ld(&bar[XB_XGEN(b.x)]) == gen, bar);
            __builtin_amdgcn_fence(__ATOMIC_ACQUIRE, "agent");
            asm volatile("s_waitcnt vmcnt(0)" ::: "memory");
        }
    }
    __syncthreads();
}

__device__ __forceinline__ int opaque_i(int v) {
#if DUPMASK_ON
    asm volatile("" : "+v"(v)); v = __builtin_amdgcn_readfirstlane(v);
#endif
    return v; }
constexpr int NPH = 14;
struct Args { const float* in[23]; float* out; unsigned char* ws; int ph_lo, ph_hi; };
__global__ void __launch_bounds__(NTHREADS, 2) mk_fwd(Args a) {
    extern __shared__ __attribute__((aligned(16))) unsigned char lds_raw[];
    LAS unsigned char* lds = (LAS unsigned char*)lds_raw;
    cg::grid_group grid = cg::this_grid();
    const int G = gridDim.x, tid = threadIdx.x, lane = tid & 63, wave = __builtin_amdgcn_readfirstlane(tid >> 6);
    const int lo = a.ph_lo, hi = a.ph_hi;
    unsigned char* ws = a.ws;
    volatile LAS unsigned* bst = (volatile LAS unsigned*)(lds + LDS_BYTES - 16);
    if (tid < 4) bst[tid] = 0u;
    __syncthreads();
    XcdBarrier bar = xcd_barrier_post((unsigned*)(ws + WS_BAR), bst);
    if (TSTAMP && blockIdx.x == 0 && tid == 0) ((unsigned long long*)(ws + WS_TS))[0] = __builtin_amdgcn_s_memrealtime();
    if (a.ph_hi > NPH) grid.sync();
#ifndef PHMASK
#define PHMASK 0xFFFF
#endif
#define IN(k) (((PHMASK >> (k)) & 1) && lo <= (k) && (k) < hi)
#define GRIDBAR() do { if (USE_CG_SYNC) grid.sync(); else xcd_barrier(bar); } while (0)
#define SEAM(k) do { if (IN(k) && IN((k) + 1)) GRIDBAR(); if (TSTAMP && blockIdx.x == 0 && tid == 0) ((unsigned long long*)(ws + WS_TS))[(k) + 1] = __builtin_amdgcn_s_memrealtime(); } while (0)
#define PH(k) for (int rep_ = 0; rep_ < (IN(k) ? 1 + ((DUPMASK >> (k)) & 1) : 0); ++rep_) if (rep_ > 0 && (xcd_barrier(bar), false)) {} else
    PH(0) {
        if (blockIdx.x == 0 && tid < 32) ((unsigned*)(ws + WS_CNT))[tid * 32] = 0u;
        if (blockIdx.x == 2 && tid < 64) ((unsigned*)(ws + WS_DEAD))[tid] = (unsigned)((tid & 15) << 6) * 0x00010001u;
        if (blockIdx.x == 1 && tid < 256) { const float* wgp = a.in[6] + tid; u32x4 w0, w1;
            w0.x = cvtpk_s(wgp[0], wgp[256]); w0.y = cvtpk_s(wgp[512], wgp[768]); w0.z = cvtpk_s(wgp[1024], wgp[1280]); w0.w = cvtpk_s(wgp[1536], wgp[1792]);
            w1.x = cvtpk_s(wgp[2048], wgp[2304]); w1.y = cvtpk_s(wgp[2560], wgp[2816]); w1.z = cvtpk_s(wgp[3072], wgp[3328]); w1.w = cvtpk_s(wgp[3584], wgp[3840]);
            u32x4* dst = (u32x4*)((bf16_t*)(ws + WS_WGT) + tid * 16); dst[0] = w0; dst[1] = w1; }
        LAS float* scr = (LAS float*)(lds + wave * 16384);
        for (int it = blockIdx.x * NWAVES + wave; it < P0_ITEMS; it += G * NWAVES) p0_item(it, a.in, ws, scr, lane);
    }
    SEAM(0);
    PH(1) p1_phase(a.in, ws, lds, G);
    SEAM(1);
    PH(2) {
        pg8::Gemm g{(const bf16_t*)(ws + WS_XN), (const bf16_t*)(ws + WS_WIN), NT, NPROJ, D_MODEL}; pg8::StaticOrder S; S.init(NT, NPROJ, G, (int)blockIdx.x);
        EpiProj E{ws};
        pg8::gemm_phase<EpiProj, pg8::StaticOrder, PG8_ALIGN, PG8_SP2>(lds, g, S, E);
#ifdef DUP_P2
        xcd_barrier(bar);
        pg8::gemm_phase<EpiProj, pg8::StaticOrder, PG8_ALIGN, PG8_SP2>(lds, g, S, E);
#endif
    }
    SEAM(2);
    PH(3) {
        for (int u = blockIdx.x; u < 256; u += G) { const int p = u >> 1, b = p >> 4, qi = p & 15, qj = 31 - qi; LAS unsigned char* lw = lds + wave * 17408;
            for (int rep = 0; rep < ((DUPSUB & 1) ? 2 : 1); ++rep) {
                if ((u & 1) == 0) { p3a_run(b, qi, 0, qi, ws, lw, wave, lane); if (qi < 15) p3a_run(b, qj, 0, 14 - qi, ws, lw, wave, lane); }
                else p3a_run(b, qj, 15 - qi, qj, ws, lw, wave, lane); } }
        for (int p = blockIdx.x; p < GLA_ITEMS / 2; p += G) { p3b_pair(p, a.in[6], a.in[7], a.out, a.out + 24 * MiB, ws, lds); if (DUPSUB & 2) p3b_pair(p, a.in[6], a.in[7], a.out, a.out + 24 * MiB, ws, lds); }
    }
    SEAM(3);
    PH(4) {
        LAS unsigned* rowctr = (LAS unsigned*)(lds + NWAVES * SEL_LDS);
        if (tid == 0) *rowctr = 0u;
        __syncthreads();
        if (wave < 2) for (int j = blockIdx.x; j < 256; j += G) { p4b_item4(j, a.out, (bf16_t*)(a.out + 16 * MiB), ws); if (DUPSUB & 8) p4b_item4(j, a.out, (bf16_t*)(a.out + 16 * MiB), ws); }
        {
            unsigned xa[32], xb[32]; LAS unsigned char* Hw = lds + wave * SEL_LDS;
#define SEL_GRAB() __builtin_amdgcn_readfirstlane((int)(lane == 0 ? __hip_atomic_fetch_add(rowctr, 1u, __ATOMIC_RELAXED, __HIP_MEMORY_SCOPE_WORKGROUP) : 0u))
#define SEL_ROW(i_) (((i_) < 64 ? (i_) >> 3 : ((i_) - 64) >> 3) * NS + ((i_) < 64 ? NS - 1 - ((int)blockIdx.x * NWAVES + ((i_) & 7)) : (int)blockIdx.x * NWAVES + ((i_) & 7)))
            int i0 = SEL_GRAB();
            p4a_load(SEL_ROW(i0 < 127 ? i0 : 127), ws, lane, xa);
#pragma unroll 1
            while (i0 < 128) {
                const int i1 = SEL_GRAB();
                p4a_load(SEL_ROW(i1 < 127 ? i1 : 127), ws, lane, xb);
                p4a_row(SEL_ROW(i0), ws, lane, xa, Hw); if (DUPSUB & 4) p4a_row(SEL_ROW(i0), ws, lane, xa, Hw);
                if (i1 >= 128) break;
                i0 = SEL_GRAB();
                p4a_load(SEL_ROW(i0 < 127 ? i0 : 127), ws, lane, xa);
                p4a_row(SEL_ROW(i1), ws, lane, xb, Hw); if (DUPSUB & 4) p4a_row(SEL_ROW(i1), ws, lane, xb, Hw);
            }
        }
    }
    SEAM(4);
    PH(5) {
        const int c = blockIdx.x; const int bh = c >> 2, sx = c & 3;
        for (int p = blockIdx.x; p < GLA_ITEMS / 2; p += G) { p5b_pair(p, a.out + 24 * MiB, a.in[8], (const bf16_t*)(a.out + 16 * MiB), ws, lds); if (DUPSUB & 32) p5b_pair(p, a.out + 24 * MiB, a.in[8], (const bf16_t*)(a.out + 16 * MiB), ws, lds); }
        if (c < 256) for (int i = 0; i < 4; ++i) { const int Q = (i == 0) ? sx : (i == 1) ? 7 - sx : (i == 2) ? 8 + sx : 15 - sx; if (wave < 4) attn_unit<false>(bh >> 3, bh & 7, Q, a.in[2], ws, lds); else attn_unit<true>(bh >> 3, bh & 7, Q, a.in[2], ws, lds);
            if (DUPSUB & 16) { if (wave < 4) attn_unit<false>(bh >> 3, bh & 7, Q, a.in[2], ws, lds); else attn_unit<true>(bh >> 3, bh & 7, Q, a.in[2], ws, lds); } }
    }
    SEAM(5);
    PH(6) {
        pg8::StaticOrder S; S.init(NT, D_MODEL, G, (int)blockIdx.x);
        { pg8::Gemm g{(const bf16_t*)(ws + WS_XN), (const bf16_t*)(ws + WS_WGAB), NT, D_MODEL, D_MODEL}; EpiSig E{ws, 0}; pg8::gemm_phase<EpiSig, pg8::StaticOrder, PG8_ALIGN, PG8_SP2>(lds, g, S, E); }
        { pg8::Gemm g{(const bf16_t*)(ws + WS_XN), (const bf16_t*)(ws + WS_WGAB) + (size_t)1024 * 1024, NT, D_MODEL, D_MODEL}; EpiSig E{ws, 1}; pg8::gemm_phase<EpiSig, pg8::StaticOrder, PG8_ALIGN, PG8_SP2>(lds, g, S, E); }
        { pg8::Gemm g{(const bf16_t*)(ws + WS_OAB), (const bf16_t*)(ws + WS_WBA), NT, D_MODEL, D_MODEL}; EpiMrgF E{ws}; pg8::gemm_phase<EpiMrgF, pg8::StaticOrder, PG8_ALIGN, PG8_SP2>(lds, g, S, E); }
    }
    SEAM(7);
    PH(8) {
        pg8::Gemm g{(const bf16_t*)(ws + WS_MRG), (const bf16_t*)(ws + WS_WOUT), NT, D_MODEL, D_MODEL}; pg8::StaticOrder S; S.init(NT, D_MODEL, G, (int)blockIdx.x);
        EpiV E{a.in[0], (const float*)(ws + WS_ADA), (bf16_t*)(ws + WS_VB)}; pg8::gemm_phase<EpiV, pg8::StaticOrder, PG8_ALIGN, PG8_SP2>(lds, g, S, E);
    }
    SEAM(8);
#ifdef DUP_P8
    p8_phase<false>(a.in, (const bf16_t*)(ws + WS_VB), (float*)(ws + 193 * MiB), (bf16_t*)(ws + 260 * MiB), ws, lds, G); xcd_barrier(bar);
#endif
    PH(9) p8_phase<true>(a.in, (const bf16_t*)(ws + WS_VB), a.out, (bf16_t*)(ws + WS_H2), ws, lds, G);
    if (IN(9) && IN(11)) { GRIDBAR(); if (TSTAMP && blockIdx.x == 0 && tid == 0) ((unsigned long long*)(ws + WS_TS))[10] = __builtin_amdgcn_s_memrealtime(); }
    PH(11) {
        build_tables(ws, lds);
        pg8::Gemm g{(const bf16_t*)(ws + WS_H2), (const bf16_t*)(ws + WS_W13), 0, 0, D_MODEL}; GroupOrder<2> S{(const LAS int*)(lds + LDS_TAB), (const LAS int*)(lds + LDS_TAB) + 64, G, (int)blockIdx.x, (const int*)(ws + WS_LIST)};
        EpiHid E{ws}; pg8::gemm_phase<EpiHid, GroupOrder<2>, PG8_ALIGN, PG8_SP2, true>(lds, g, S, E);
    }
    SEAM(11);
    PH(12) {
        build_tables(ws, lds);
        int kd = D_EXP; asm volatile("" : "+s"(kd));
        pg8::Gemm g{(const bf16_t*)(ws + WS_HID), (const bf16_t*)(ws + WS_W2), 0, 0, kd}; GroupOrder<4> S{(const LAS int*)(lds + LDS_TAB), (const LAS int*)(lds + LDS_TAB) + 64, G, (int)blockIdx.x, nullptr};
        EpiY E{ws}; pg8::gemm_phase<EpiY, GroupOrder<4>, PG8_ALIGN, PG8_SP2>(lds, g, S, E);
    }
    SEAM(12);
#ifdef DUP_P12
    p12_phase(a.in, (const bf16_t*)(ws + WS_VB), (float*)(ws + 193 * MiB), ws, lds, G); xcd_barrier(bar);
#endif
    PH(13) p12_phase(a.in, (const bf16_t*)(ws + WS_VB), a.out, ws, lds, G);
    if (TSTAMP) { xcd_barrier(bar); if (blockIdx.x == 0 && tid == 0) ((unsigned long long*)(ws + WS_TS))[14] = __builtin_amdgcn_s_memrealtime(); }
#ifdef EXTRA_SYNCS
    for (int i_ = 0; i_ < EXTRA_SYNCS; ++i_) GRIDBAR();
#endif
#undef IN
#undef SEAM
#undef PH
}
}
#if TSTAMP
__global__ void kd_ts(float* out, long n, const unsigned long long* ts, int ka, int kb) {
    const float da = (ka == 14) ? (float)(ts[14] - ts[0]) * 0.01f / 10.f : (float)(ts[ka + 1] - ts[ka]) * 0.01f;
    const float sc = 1.f + da * 0.0005f;
    for (long i = (long)blockIdx.x * blockDim.x + threadIdx.x; i < n; i += (long)gridDim.x * blockDim.x) out[i] *= sc;
}
#endif
extern "C" void kernel_launch(void* const* d_in, const int* in_sizes, int n_in, void* d_out, int out_size,
                              void* d_ws, size_t ws_size, hipStream_t stream) {
    using namespace fk;
    static int grid = 0;
    if (grid == 0) {
        int dev = 0, cus = 0, per_cu = 0; (void)hipGetDevice(&dev); (void)hipDeviceGetAttribute(&cus, hipDeviceAttributeMultiprocessorCount, dev);
        (void)hipFuncSetAttribute((const void*)mk_fwd, hipFuncAttributeMaxDynamicSharedMemorySize, LDS_BYTES);
        (void)hipOccupancyMaxActiveBlocksPerMultiprocessor(&per_cu, (const void*)mk_fwd, NTHREADS, LDS_BYTES);
        (void)hipGetLastError();
        grid = cus * (per_cu >= 1 ? 1 : 1);
        if (ws_size < 512 * MiB) { fprintf(stderr, "kernel_launch: workspace too small\n"); grid = -1; }
    }
    if (grid < 0) return;
    (void)hipMemsetAsync((unsigned char*)d_ws + WS_BAR, 0, 16384, stream);
    Args a{}; for (int i = 0; i < 23; ++i) a.in[i] = (const float*)d_in[i]; a.out = (float*)d_out; a.ws = (unsigned char*)d_ws; a.ph_lo = 0; a.ph_hi = NPH;
    void* args[] = {&a};
    hipError_t e = hipLaunchCooperativeKernel((const void*)mk_fwd, dim3(grid), dim3(NTHREADS), args, LDS_BYTES, stream);
    if (e != hipSuccess) fprintf(stderr, "cooperative launch failed: %s\n", hipGetErrorString(e));
#if TSTAMP
    hipLaunchKernelGGL(kd_ts, dim3(1024), dim3(256), 0, stream, (float*)d_out, (long)out_size, (const unsigned long long*)((unsigned char*)d_ws + WS_TS), TS_A, TS_B);
#endif
}
```

```cpp
#include <hip/hip_runtime.h>
#include <hip/hip_cooperative_groups.h>
#include <cstdio>
#include <cstdint>
#include <cstring>
#include <cmath>
#ifdef HOST_EMU
#include <cmath>
#include <cstdio>
#include <cstdlib>
#include <cstring>
#include <cstdint>
struct Dim3e { int x, y, z; };
static thread_local Dim3e threadIdx, blockIdx, blockDim, gridDim;
#define __global__
#define __device__
#define __host__
#define __forceinline__ inline
#define __launch_bounds__(...)
typedef void* hipStream_t;
template <class F, class... A> static void host_launch(F f, long nb, int nt, A... a) {
#pragma omp parallel for schedule(dynamic, 4)
    for (long b = 0; b < nb; ++b) {
        blockIdx = {(int)b, 0, 0}; blockDim = {nt, 1, 1}; gridDim = {(int)nb, 1, 1};
        for (int t = 0; t < nt; ++t) { threadIdx = {t, 0, 0}; f(a...); }
    }
}
#define LAUNCH(k, nb, nt, st, ...) host_launch(k, (long)(nb), (int)(nt), __VA_ARGS__)
#define UNROLL
#else
#define LAUNCH(k, nb, nt, st, ...) hipLaunchKernelGGL(k, dim3((unsigned)(nb)), dim3((unsigned)(nt)), 0, st, __VA_ARGS__)
#endif

constexpr int D_MODEL = 1024, A_HEADS = 8, A_HD = 64, A_W = 512, I_HEADS = 16, I_DIM = 32, TOPK_MAX = 256, REL_B = 32,
              G_HEADS = 4, G_DK = 64, G_DV = 128, G_KW = 256, G_VW = 512, G_RANK = 16, N_GROUPS = 4, EPG = 8, N_EXP = 32, D_EXP = 256;
constexpr int O_AQ = 0, O_AK = 512, O_AV = 1024, O_IQ = 1536, O_IK = 2048, O_IW = 2080, O_GQ = 2096, O_GK = 2352, O_GV = 2608, O_GR = 3120,
              O_GLR = 3632, O_GA = 3648, O_GB = 4672, D_IN = 5696;
constexpr float DN_ALPHA = 1.189207115002721f, LN_EPS = 1e-5f;
#define V0_GID long gid = (long)blockIdx.x * blockDim.x + threadIdx.x

__device__ __forceinline__ float v0_silu(float v) { return v / (1.f + expf(-v)); }
__device__ __forceinline__ float v0_sigmoid(float v) { return 1.f / (1.f + expf(-v)); }

__global__ void k0_ada(const float* c, const float* w_ada, const float* b_ada, float* ada, int B) {
    V0_GID; if (gid >= (long)B * 6 * D_MODEL) return;
    const int b = (int)(gid / (6 * D_MODEL)), j = (int)(gid % (6 * D_MODEL));
    float acc = 0.f;
    for (int i = 0; i < D_MODEL; ++i) acc += v0_silu(c[b * D_MODEL + i]) * w_ada[(size_t)i * 6 * D_MODEL + j];
    ada[gid] = acc + b_ada[j];
}
__global__ void k0_lnmod(const float* x, const float* sh, const float* sc, float* h, int nrows) {
    V0_GID; if (gid >= nrows) return;
    const float* xr = x + (size_t)gid * D_MODEL; float* hr = h + (size_t)gid * D_MODEL;
    float mu = 0.f; for (int k = 0; k < D_MODEL; ++k) mu += xr[k]; mu *= (1.f / D_MODEL);
    float var = 0.f; for (int k = 0; k < D_MODEL; ++k) { const float d = xr[k] - mu; var += d * d; } var *= (1.f / D_MODEL);
    const float rs = 1.f / sqrtf(var + LN_EPS);
    for (int k = 0; k < D_MODEL; ++k) hr[k] = (xr[k] - mu) * rs * (1.f + sc[k]) + sh[k];
}
__global__ void k0_gemm(const float* A, int lda, const float* W, int ldw, float* C, int ldc, int M, int N, int K) {
    V0_GID; if (gid >= (long)(M / 4) * N) return;
    const int n = (int)(gid % N); const int m0 = (int)(gid / N) * 4;
    float a0 = 0.f, a1 = 0.f, a2 = 0.f, a3 = 0.f;
    const float* A0 = A + (size_t)m0 * lda;
    for (int k = 0; k < K; ++k) { const float w = W[(size_t)k * ldw + n]; a0 += A0[k] * w; a1 += A0[lda + k] * w; a2 += A0[2 * lda + k] * w; a3 += A0[3 * lda + k] * w; }
    C[(size_t)m0 * ldc + n] = a0; C[(size_t)(m0 + 1) * ldc + n] = a1; C[(size_t)(m0 + 2) * ldc + n] = a2; C[(size_t)(m0 + 3) * ldc + n] = a3;
}
__global__ void k0_scores(const float* P, float* scT, int S) {
    V0_GID; if (gid >= (long)S * S) return;
    const int t = (int)(gid % S), s = (int)(gid / S);
    if (s > t) { scT[gid] = -INFINITY; return; }
    const float* iq = P + (size_t)t * D_IN + O_IQ; const float* ik = P + (size_t)s * D_IN + O_IK; const float* iw = P + (size_t)t * D_IN + O_IW;
    const float cst = 0.044194173824159216f;
    float sc = 0.f;
    for (int h = 0; h < I_HEADS; ++h) { float d = 0.f; for (int k = 0; k < I_DIM; ++k) d += iq[h * I_DIM + k] * ik[k]; sc += (iw[h] * cst) * fmaxf(d, 0.f); }
    scT[gid] = sc;
}
__device__ __forceinline__ unsigned v0_key(float f) { unsigned u; memcpy(&u, &f, 4); return (u & 0x80000000u) ? ~u : (u | 0x80000000u); }
__global__ void k0_topk(const float* scT, int* sel, int* cnt, int S, int topk) {
    V0_GID; if (gid >= S) return;
    const int t = (int)gid; const int n = t + 1; int* sl = sel + (size_t)t * TOPK_MAX;
    if (n <= topk) { for (int s = 0; s < n; ++s) sl[s] = s; cnt[t] = n; return; }
    unsigned T = 0u;
    for (int bit = 31; bit >= 0; --bit) { const unsigned cand = T | (1u << bit); int c = 0; for (int s = 0; s < n; ++s) c += (v0_key(scT[(size_t)s * S + t]) >= cand) ? 1 : 0; if (c >= topk) T = cand; }
    int cgt = 0; for (int s = 0; s < n; ++s) cgt += (v0_key(scT[(size_t)s * S + t]) > T) ? 1 : 0;
    int need = topk - cgt, j = 0;
    for (int s = 0; s < n; ++s) { const unsigned k = v0_key(scT[(size_t)s * S + t]); if (k > T) sl[j++] = s; else if (k == T && need > 0) { sl[j++] = s; --need; } }
    cnt[t] = j;
}
__device__ __forceinline__ int v0_bucket(int d) {
    if (d < 16) return d;
    const float df = (float)d; int large = 16 + (int)(logf(df / 16.f) / 2.0794415416798357f * 16.f);
    return large < 31 ? large : 31;
}
__global__ void __launch_bounds__(256) k0_attn(const float* P, const int* sel, const int* cnt, const float* rel_bias, float* oa, int S) {
    V0_GID; if (gid >= (long)S * A_HEADS) return;
    const int t = (int)(gid / A_HEADS), h = (int)(gid % A_HEADS); const int n = cnt[t]; const int* sl = sel + (size_t)t * TOPK_MAX;
    const float* q = P + (size_t)t * D_IN + O_AQ + h * A_HD;
    float m = -INFINITY;
    for (int j = 0; j < n; ++j) { const int s = sl[j]; const float* k = P + (size_t)s * D_IN + O_AK + h * A_HD; float d = 0.f; for (int e = 0; e < A_HD; ++e) d += q[e] * k[e];
        const float l = d * 0.125f + rel_bias[v0_bucket(t - s) * A_HEADS + h]; m = fmaxf(m, l); }
    float o[A_HD];
#pragma unroll
    for (int e = 0; e < A_HD; ++e) o[e] = 0.f;
    float sum = 0.f;
    for (int j = 0; j < n; ++j) { const int s = sl[j]; const float* k = P + (size_t)s * D_IN + O_AK + h * A_HD; const float* v = P + (size_t)s * D_IN + O_AV + h * A_HD; float d = 0.f;
        for (int e = 0; e < A_HD; ++e) d += q[e] * k[e];
        const float p = expf(d * 0.125f + rel_bias[v0_bucket(t - s) * A_HEADS + h] - m); sum += p;
#pragma unroll
        for (int e = 0; e < A_HD; ++e) o[e] += p * v[e]; }
    const float inv = 1.f / sum;
#pragma unroll
    for (int e = 0; e < A_HD; ++e) oa[(size_t)t * A_W + h * A_HD + e] = o[e] * inv;
}
__global__ void k0_gate(const float* P, const float* wg, const float* bg, float* lg, int S) {
    V0_GID; if (gid >= (long)S * G_KW) return;
    const int t = (int)(gid / G_KW), j = (int)(gid % G_KW);
    float z = bg[j]; for (int r = 0; r < G_RANK; ++r) z += P[(size_t)t * D_IN + O_GLR + r] * wg[r * G_KW + j];
    lg[gid] = (fminf(z, 0.f) - log1pf(expf(-fabsf(z)))) * (1.f / 16.f);
}
__global__ void __launch_bounds__(64) k0_gla(const float* P, const float* lg, float* oraw, int S) {
    V0_GID; if (gid >= G_HEADS * G_DV) return;
    const int h = (int)(gid / G_DV), dv = (int)(gid % G_DV);
    float st[G_DK];
#pragma unroll
    for (int d = 0; d < G_DK; ++d) st[d] = 0.f;
    for (int t = 0; t < S; ++t) {
        const float* row = P + (size_t)t * D_IN; const float vv = row[O_GV + h * G_DV + dv]; float o = 0.f;
#pragma unroll
        for (int d = 0; d < G_DK; ++d) { const float a = expf(lg[(size_t)t * G_KW + h * G_DK + d]); st[d] = a * st[d] + row[O_GK + h * G_DK + d] * vv; o += row[O_GQ + h * G_DK + d] * st[d]; }
        oraw[(size_t)t * G_VW + h * G_DV + dv] = o * 0.125f;
    }
}
__global__ void k0_gla_post(const float* P, const float* oraw, const float* ng, float* ob, int S) {
    V0_GID; if (gid >= (long)S * G_HEADS) return;
    const int t = (int)(gid / G_HEADS), h = (int)(gid % G_HEADS); const float* o = oraw + (size_t)t * G_VW + h * G_DV;
    float mu = 0.f; for (int e = 0; e < G_DV; ++e) mu += o[e]; mu *= (1.f / G_DV);
    float var = 0.f; for (int e = 0; e < G_DV; ++e) { const float d = o[e] - mu; var += d * d; } var *= (1.f / G_DV);
    const float rs = 1.f / sqrtf(var + LN_EPS);
    for (int e = 0; e < G_DV; ++e) ob[(size_t)t * G_VW + h * G_DV + e] = (o[e] - mu) * rs * ng[h * G_DV + e] * v0_silu(P[(size_t)t * D_IN + O_GR + h * G_DV + e]);
}
__global__ void k0_merge(const float* P, const float* ba, const float* bb, float* mg, int S) {
    V0_GID; if (gid >= (long)S * D_MODEL) return;
    const int t = (int)(gid / D_MODEL), n = (int)(gid % D_MODEL);
    mg[gid] = v0_sigmoid(P[(size_t)t * D_IN + O_GA + n]) * ba[gid] + v0_sigmoid(P[(size_t)t * D_IN + O_GB + n]) * bb[gid];
}
__global__ void k0_ln1(const float* x, const float* y, const float* gt1, const float* g1, const float* b1, const float* sh2, const float* sc2, float* x1, float* h2, int nrows) {
    V0_GID; if (gid >= nrows) return;
    const float* xr = x + (size_t)gid * D_MODEL; const float* yr = y + (size_t)gid * D_MODEL; float* x1r = x1 + (size_t)gid * D_MODEL; float* h2r = h2 + (size_t)gid * D_MODEL;
    float mu = 0.f; for (int k = 0; k < D_MODEL; ++k) mu += DN_ALPHA * xr[k] + gt1[k] * yr[k]; mu *= (1.f / D_MODEL);
    float var = 0.f; for (int k = 0; k < D_MODEL; ++k) { const float d = DN_ALPHA * xr[k] + gt1[k] * yr[k] - mu; var += d * d; } var *= (1.f / D_MODEL);
    float rs = 1.f / sqrtf(var + LN_EPS);
    for (int k = 0; k < D_MODEL; ++k) x1r[k] = (DN_ALPHA * xr[k] + gt1[k] * yr[k] - mu) * rs * g1[k] + b1[k];
    mu = 0.f; for (int k = 0; k < D_MODEL; ++k) mu += x1r[k]; mu *= (1.f / D_MODEL);
    var = 0.f; for (int k = 0; k < D_MODEL; ++k) { const float d = x1r[k] - mu; var += d * d; } var *= (1.f / D_MODEL);
    rs = 1.f / sqrtf(var + LN_EPS);
    for (int k = 0; k < D_MODEL; ++k) h2r[k] = (x1r[k] - mu) * rs * (1.f + sc2[k]) + sh2[k];
}
__global__ void k0_route(const float* rl, const float* brg, const float* bre, int* eid, float* ew, int nrows) {
    V0_GID; if (gid >= nrows) return;
    const float* r = rl + (size_t)gid * 36;
    float gl[N_GROUPS]; float gm = -INFINITY; int gi = 0;
#pragma unroll
    for (int g = 0; g < N_GROUPS; ++g) { gl[g] = r[g] + brg[g]; if (gl[g] > gm) { gm = gl[g]; gi = g; } }
    float gs = 0.f;
#pragma unroll
    for (int g = 0; g < N_GROUPS; ++g) gs += expf(gl[g] - gm);
    const float gw = 1.f / gs;
    float v0 = -INFINITY, v1 = -INFINITY; int i0 = 0, i1 = 0;
    for (int e = 0; e < EPG; ++e) { const float v = r[4 + gi * EPG + e] + bre[gi * EPG + e];
        if (v > v0) { v1 = v0; i1 = i0; v0 = v; i0 = e; } else if (v > v1) { v1 = v; i1 = e; } }
    const float e1 = expf(v1 - v0); const float w0 = 1.f / (1.f + e1), w1 = e1 / (1.f + e1);
    eid[gid * 2] = gi * EPG + i0; eid[gid * 2 + 1] = gi * EPG + i1; ew[gid * 2] = w0 * gw; ew[gid * 2 + 1] = w1 * gw;
}
__global__ void k0_moe_hid(const float* h2, const int* eid, const float* w1, const float* w3, float* hid, int nrows) {
    V0_GID; if (gid >= (long)nrows * 2 * D_EXP) return;
    const int j = (int)(gid % D_EXP); const long ts = gid / D_EXP; const int t = (int)(ts / 2); const int e = eid[ts];
    const float* hr = h2 + (size_t)t * D_MODEL; const float* a = w1 + (size_t)e * D_MODEL * D_EXP + j; const float* b = w3 + (size_t)e * D_MODEL * D_EXP + j;
    float g = 0.f, u = 0.f; for (int k = 0; k < D_MODEL; ++k) { g += hr[k] * a[(size_t)k * D_EXP]; u += hr[k] * b[(size_t)k * D_EXP]; }
    hid[gid] = v0_silu(g) * u;
}
__global__ void k0_moe_out(const float* hid, const int* eid, const float* ew, const float* w2, float* f, int nrows) {
    V0_GID; if (gid >= (long)nrows * D_MODEL) return;
    const int n = (int)(gid % D_MODEL); const int t = (int)(gid / D_MODEL); float acc = 0.f;
    for (int sl = 0; sl < 2; ++sl) { const int e = eid[t * 2 + sl]; const float* hr = hid + ((size_t)t * 2 + sl) * D_EXP; const float* w = w2 + (size_t)e * D_EXP * D_MODEL + n; float a = 0.f;
        for (int j = 0; j < D_EXP; ++j) a += hr[j] * w[(size_t)j * D_MODEL]; acc += ew[t * 2 + sl] * a; }
    f[gid] = acc;
}
__global__ void k0_final(const float* x1, const float* f, const float* gt2, const float* g2, const float* b2, float* out, int nrows) {
    V0_GID; if (gid >= nrows) return;
    const float* xr = x1 + (size_t)gid * D_MODEL; const float* fr = f + (size_t)gid * D_MODEL; float* o = out + (size_t)gid * D_MODEL;
    float mu = 0.f; for (int k = 0; k < D_MODEL; ++k) mu += DN_ALPHA * xr[k] + gt2[k] * fr[k]; mu *= (1.f / D_MODEL);
    float var = 0.f; for (int k = 0; k < D_MODEL; ++k) { const float d = DN_ALPHA * xr[k] + gt2[k] * fr[k] - mu; var += d * d; } var *= (1.f / D_MODEL);
    const float rs = 1.f / sqrtf(var + LN_EPS);
    for (int k = 0; k < D_MODEL; ++k) o[k] = (DN_ALPHA * xr[k] + gt2[k] * fr[k] - mu) * rs * g2[k] + b2[k];
}

struct V0Buf { float *ada, *h, *P, *scT, *oa, *lg, *oraw, *ob, *ba, *bb, *mg, *y, *x1, *h2, *rl, *ew, *hid, *f; int *sel, *cnt, *eid; size_t bytes; };
static V0Buf v0_carve(void* base, int B, int S) {
    V0Buf b; char* p = (char*)base; auto take = [&](size_t n) { char* r = p; p += (n + 255) & ~(size_t)255; return r; };
    b.ada = (float*)take((size_t)B * 6 * D_MODEL * 4);
    b.P = (float*)take((size_t)S * D_IN * 4);
    b.h = (float*)take((size_t)S * D_MODEL * 4);
    b.scT = (float*)take((size_t)S * S * 4);
    b.sel = (int*)take((size_t)S * TOPK_MAX * 4); b.cnt = (int*)take((size_t)S * 4);
    b.oa = (float*)take((size_t)S * A_W * 4); b.lg = (float*)take((size_t)S * G_KW * 4); b.oraw = (float*)take((size_t)S * G_VW * 4); b.ob = (float*)take((size_t)S * G_VW * 4);
    b.ba = (float*)take((size_t)S * D_MODEL * 4); b.bb = (float*)take((size_t)S * D_MODEL * 4); b.y = (float*)take((size_t)S * D_MODEL * 4);
    b.x1 = (float*)take((size_t)S * D_MODEL * 4); b.h2 = (float*)take((size_t)S * D_MODEL * 4); b.f = (float*)take((size_t)S * D_MODEL * 4);
    b.mg = b.h;
    b.rl = (float*)take((size_t)S * 36 * 4); b.eid = (int*)take((size_t)S * 2 * 4); b.ew = (float*)take((size_t)S * 2 * 4); b.hid = (float*)take((size_t)S * 2 * D_EXP * 4);
    b.bytes = (size_t)(p - (char*)base); return b;
}
static void v0_forward(void* const* d_in, float* out, void* scratch, int B, int S, hipStream_t st, int only_batch = -1, int last_batch = -1) {
    const float *x = (const float*)d_in[0], *c = (const float*)d_in[1], *rel_bias = (const float*)d_in[2], *w_ada = (const float*)d_in[3], *b_ada = (const float*)d_in[4], *w_in = (const float*)d_in[5],
                *wg = (const float*)d_in[6], *bg = (const float*)d_in[7], *ng = (const float*)d_in[8], *wba = (const float*)d_in[9], *wbb = (const float*)d_in[10], *wout = (const float*)d_in[11],
                *g1 = (const float*)d_in[12], *b1 = (const float*)d_in[13], *wrg = (const float*)d_in[14], *brg = (const float*)d_in[15], *wre = (const float*)d_in[16], *bre = (const float*)d_in[17],
                *w1 = (const float*)d_in[18], *w3 = (const float*)d_in[19], *w2 = (const float*)d_in[20], *g2 = (const float*)d_in[21], *b2 = (const float*)d_in[22];
    V0Buf u = v0_carve(scratch, B, S);
    const int TB = 256; auto nb = [&](long n) { return (n + TB - 1) / TB; };
    const int topk = (TOPK_MAX < S / 4) ? TOPK_MAX : S / 4;
    LAUNCH(k0_ada, nb((long)B * 6 * D_MODEL), TB, st, c, w_ada, b_ada, u.ada, B);
    for (int bi = 0; bi < B; ++bi) {
        int b = bi; if (last_batch >= 0) b = (bi == B - 1) ? last_batch : (bi < last_batch ? bi : bi + 1);
        if (only_batch >= 0 && b != only_batch) continue;
        const float* xb = x + (size_t)b * S * D_MODEL; const float* ad = u.ada + (size_t)b * 6 * D_MODEL;
        const float *sh1 = ad, *sc1 = ad + D_MODEL, *gt1 = ad + 2 * D_MODEL, *sh2 = ad + 3 * D_MODEL, *sc2 = ad + 4 * D_MODEL, *gt2 = ad + 5 * D_MODEL;
        LAUNCH(k0_lnmod, nb(S), TB, st, xb, sh1, sc1, u.h, S);
        LAUNCH(k0_gemm, nb((long)(S / 4) * D_IN), TB, st, (const float*)u.h, D_MODEL, w_in, D_IN, u.P, D_IN, S, D_IN, D_MODEL);
        LAUNCH(k0_scores, nb((long)S * S), TB, st, (const float*)u.P, u.scT, S);
        LAUNCH(k0_topk, nb(S), TB, st, (const float*)u.scT, u.sel, u.cnt, S, topk);
        LAUNCH(k0_attn, nb((long)S * A_HEADS), TB, st, (const float*)u.P, (const int*)u.sel, (const int*)u.cnt, rel_bias, u.oa, S);
        LAUNCH(k0_gate, nb((long)S * G_KW), TB, st, (const float*)u.P, wg, bg, u.lg, S);
        LAUNCH(k0_gla, (G_HEADS * G_DV + 63) / 64, 64, st, (const float*)u.P, (const float*)u.lg, u.oraw, S);
        LAUNCH(k0_gla_post, nb((long)S * G_HEADS), TB, st, (const float*)u.P, (const float*)u.oraw, ng, u.ob, S);
        LAUNCH(k0_gemm, nb((long)(S / 4) * D_MODEL), TB, st, (const float*)u.oa, A_W, wba, D_MODEL, u.ba, D_MODEL, S, D_MODEL, A_W);
        LAUNCH(k0_gemm, nb((long)(S / 4) * D_MODEL), TB, st, (const float*)u.ob, G_VW, wbb, D_MODEL, u.bb, D_MODEL, S, D_MODEL, G_VW);
        LAUNCH(k0_merge, nb((long)S * D_MODEL), TB, st, (const float*)u.P, (const float*)u.ba, (const float*)u.bb, u.mg, S);
        LAUNCH(k0_gemm, nb((long)(S / 4) * D_MODEL), TB, st, (const float*)u.mg, D_MODEL, wout, D_MODEL, u.y, D_MODEL, S, D_MODEL, D_MODEL);
        LAUNCH(k0_ln1, nb(S), TB, st, xb, (const float*)u.y, gt1, g1, b1, sh2, sc2, u.x1, u.h2, S);
        LAUNCH(k0_gemm, nb((long)(S / 4) * N_GROUPS), TB, st, (const float*)u.h2, D_MODEL, wrg, N_GROUPS, u.rl, 36, S, N_GROUPS, D_MODEL);
        LAUNCH(k0_gemm, nb((long)(S / 4) * N_EXP), TB, st, (const float*)u.h2, D_MODEL, wre, N_EXP, u.rl + 4, 36, S, N_EXP, D_MODEL);
        LAUNCH(k0_route, nb(S), TB, st, (const float*)u.rl, brg, bre, u.eid, u.ew, S);
        LAUNCH(k0_moe_hid, nb((long)S * 2 * D_EXP), TB, st, (const float*)u.h2, (const int*)u.eid, w1, w3, u.hid, S);
        LAUNCH(k0_moe_out, nb((long)S * D_MODEL), TB, st, (const float*)u.hid, (const int*)u.eid, (const float*)u.ew, w2, u.f, S);
        LAUNCH(k0_final, nb(S), TB, st, (const float*)u.x1, (const float*)u.f, gt2, g2, b2, out + (size_t)b * S * D_MODEL, S);
    }
}
namespace pg8 {
#define PG8_LAS __attribute__((address_space(3)))
typedef unsigned short bf16_t;
typedef short bf16x8 __attribute__((ext_vector_type(8)));
typedef float f32x4 __attribute__((ext_vector_type(4)));
typedef unsigned u32x4 __attribute__((ext_vector_type(4)));
constexpr int BM = 256, BK = 64, HALF = 128, HTB = HALF * BK * 2  , STAGE_BYTES = 8 * HTB, NXCD = 8, WGM = 8;

__host__ __device__ __forceinline__ int lds_byte(int r, int c) { const int st = (r >> 4) * 2 + (c >> 5), rr = r & 15, cc = c & 31, ob = rr * 64 + cc * 2; return st * 1024 + (ob ^ (((ob >> 9) & 1) << 5)); }
__host__ __device__ __forceinline__ void stage_rc(int b, int& R, int& C) { const int st = b / 1024, sb = b % 1024, swz = sb ^ (((sb >> 9) & 1) << 5); R = (st >> 1) * 16 + swz / 64; C = (st & 1) * 32 + (swz % 64) / 2; }
__host__ __device__ __forceinline__ int perm32(int rho) { const int n = rho >> 4, i = rho & 15; return 8 * (i >> 2) + 4 * n + (i & 3); }

struct Unit { int pm, pn, pa, pb; };
struct Gemm { const bf16_t* A; const bf16_t* Bt; int M, N, K; };

struct StaticOrder {
    int nM, nN, nwg, G, c;
    __host__ __device__ void init(int M, int N, int G_, int c_) { nM = M / BM; nN = N / BM; nwg = nM * nN; G = G_; c = c_; }
    __host__ __device__ bool next(int i, Unit& u) const {
        const long L = (long)i * G + c; if (L >= nwg) return false;
        int wgid = (int)L; { const int q = nwg / NXCD, r = nwg % NXCD, xcd = wgid % NXCD, off = wgid / NXCD; wgid = (xcd < r ? xcd * (q + 1) : r * (q + 1) + (xcd - r) * q) + off; }
        const int nig = WGM * nN, gid = wgid / nig, fm = gid * WGM, gsz = (nM - fm) < WGM ? (nM - fm) : WGM;
        u.pm = fm + ((wgid % nig) % gsz); u.pn = (wgid % nig) / gsz; u.pa = u.pm; u.pb = u.pn; return true;
    }
    __device__ __forceinline__ void a_ready(const Unit&) const {}
    __device__ __forceinline__ void done(const Unit&) const {}
};

__device__ __forceinline__ unsigned cvt_pk_bf16(float lo, float hi) { unsigned r; asm volatile("v_cvt_pk_bf16_f32 %0, %1, %2" : "=v"(r) : "v"(lo), "v"(hi)); return r; }
typedef float f32x2 __attribute__((ext_vector_type(2)));

template <class Epi, class Sched, bool ALIGN_EPI = false, bool SP2 = false, bool GATHER = false>
__device__ __forceinline__ void gemm_phase(PG8_LAS unsigned char* lds, const Gemm g, const Sched& S, const Epi& E) {
    const int tid = threadIdx.x, wid = __builtin_amdgcn_readfirstlane(tid >> 6), lane = tid & 63, wr = wid >> 2, wc = wid & 3, fr = lane & 15, fq = lane >> 4;
    const int K = g.K, nt = K / BK;
    static_assert(!GATHER || SP2, "gathered A rows: SP2 loop only");
    unsigned voffA[2], voffB[2]; int Rr[2], Cc[2];
#pragma unroll
    for (int i = 0; i < 2; ++i) { int R, C; stage_rc(tid * 16 + i * 8192, R, C); const int Rb = Epi::PERM ? ((R & ~31) + perm32(R & 31)) : R; Rr[i] = R; Cc[i] = C;
        voffA[i] = (unsigned)(R * K + C) * 2u; voffB[i] = (unsigned)(Rb * K + C) * 2u; }
    unsigned vc0[2] = {voffA[0], voffA[1]}, vc1[2] = {voffA[0], voffA[1]}, vn0[2] = {voffA[0], voffA[1]}, vn1[2] = {voffA[0], voffA[1]};
    const size_t kstep = (size_t)(BK * 2);
    const size_t hstep = (size_t)HALF * K * 2;
    const size_t tstep = 2 * hstep;
    const unsigned ldsw = (unsigned)wid * 1024u;
    const int aoff = lds_byte(wr * 64 + fr, fq * 8), boff = lds_byte(wc * 32 + fr, fq * 8);
#define PG8_SA(b, h) (((b) * 2 + (h)) * HTB)
#define PG8_SB(b, h) ((4 + (b) * 2 + (h)) * HTB)
#define PG8_STAGE(bufoff, gbase, voff) do { _Pragma("unroll") for (int _i = 0; _i < 2; ++_i) \
        __builtin_amdgcn_global_load_lds((const unsigned*)((const char*)(gbase) + (voff)[_i]), (PG8_LAS unsigned*)(lds + (bufoff) + ldsw + _i * 8192), 16, 0, 0); } while (0)
#define PG8_LDA(dst, b, h) do { _Pragma("unroll") for (int m = 0; m < 4; ++m) _Pragma("unroll") for (int k = 0; k < 2; ++k) dst[m][k] = *(const PG8_LAS bf16x8*)(lds + PG8_SA(b, h) + aoff + m * 2048 + k * 1024); } while (0)
#define PG8_LDB(dst, b, h) do { _Pragma("unroll") for (int n = 0; n < 2; ++n) _Pragma("unroll") for (int k = 0; k < 2; ++k) dst[n][k] = *(const PG8_LAS bf16x8*)(lds + PG8_SB(b, h) + boff + n * 2048 + k * 1024); } while (0)
#define PG8_MMA(ai, bj, At, Bt) do { __builtin_amdgcn_s_setprio(1); _Pragma("unroll") for (int m = 0; m < 4; ++m) _Pragma("unroll") for (int n = 0; n < 2; ++n) _Pragma("unroll") for (int k = 0; k < 2; ++k) \
        acc[ai][bj][m][n] = __builtin_amdgcn_mfma_f32_16x16x32_bf16(Bt[n][k], At[m][k], acc[ai][bj][m][n], 0, 0, 0); __builtin_amdgcn_s_setprio(0); } while (0)
#define PG8_WAIT_V(n) asm volatile("s_waitcnt vmcnt(" #n ")" ::: "memory")
#define PG8_WAIT_L(n) asm volatile("s_waitcnt lgkmcnt(" #n ")" ::: "memory")
#define PG8_BAR __builtin_amdgcn_s_barrier()
#define PG8_SCHED __builtin_amdgcn_sched_barrier(0)
    Unit cur, nxt; int ui = 0;
    if (!S.next(0, cur)) return;
    f32x4 acc[2][2][4][2];
#pragma unroll
    for (int a = 0; a < 2; ++a)
#pragma unroll
        for (int b = 0; b < 2; ++b)
#pragma unroll
            for (int m = 0; m < 4; ++m)
#pragma unroll
                for (int n = 0; n < 2; ++n) acc[a][b][m][n] = (f32x4){0.f, 0.f, 0.f, 0.f};
    bf16x8 At[4][2], B0[2][2], B1[2][2];
    const char* cA = GATHER ? (const char*)g.A : (const char*)g.A + (size_t)cur.pa * tstep; const char* cB = (const char*)g.Bt + (size_t)cur.pb * tstep;
    const size_t hstepA = GATHER ? 0 : hstep;
    if constexpr (GATHER) {
#pragma unroll
        for (int i = 0; i < 2; ++i) { vc0[i] = (unsigned)S.a_row(cur, Rr[i]) * (unsigned)(K * 2) + (unsigned)(Cc[i] * 2); vc1[i] = (unsigned)S.a_row(cur, HALF + Rr[i]) * (unsigned)(K * 2) + (unsigned)(Cc[i] * 2); } }
    S.a_ready(cur);
    if constexpr (SP2) {
        PG8_STAGE(PG8_SB(0, 0), cB, voffB); PG8_STAGE(PG8_SB(0, 1), cB + hstep, voffB); PG8_STAGE(PG8_SA(0, 0), cA, vc0); PG8_STAGE(PG8_SA(0, 1), cA + hstepA, vc1);
        if (wr == 1) PG8_BAR;
        PG8_WAIT_V(2); PG8_BAR;
        PG8_STAGE(PG8_SB(1, 0), cB + kstep, voffB); PG8_STAGE(PG8_SA(1, 0), cA + kstep, vc0); PG8_STAGE(PG8_SB(1, 1), cB + hstep + kstep, voffB);
        PG8_WAIT_V(6); PG8_BAR;
    } else {
        PG8_STAGE(PG8_SB(0, 0), cB, voffB); PG8_STAGE(PG8_SA(0, 0), cA, voffA); PG8_STAGE(PG8_SB(0, 1), cB + hstep, voffB); PG8_STAGE(PG8_SA(0, 1), cA + hstep, voffA);
        if (wr == 1) PG8_BAR;
        PG8_WAIT_V(4); PG8_BAR;
        PG8_STAGE(PG8_SB(1, 0), cB + kstep, voffB); PG8_STAGE(PG8_SA(1, 0), cA + kstep, voffA); PG8_STAGE(PG8_SB(1, 1), cB + hstep + kstep, voffB);
        PG8_WAIT_V(6); PG8_BAR;
    }
    for (;;) {
        const bool has_next = S.next(ui + 1, nxt);
        const char* nA = GATHER ? cA : (has_next ? (const char*)g.A + (size_t)nxt.pa * tstep : cA); const char* nB = has_next ? (const char*)g.Bt + (size_t)nxt.pb * tstep : cB;
        if constexpr (GATHER) {
#pragma unroll
            for (int i = 0; i < 2; ++i) { vn0[i] = has_next ? (unsigned)S.a_row(nxt, Rr[i]) * (unsigned)(K * 2) + (unsigned)(Cc[i] * 2) : vc0[i]; vn1[i] = has_next ? (unsigned)S.a_row(nxt, HALF + Rr[i]) * (unsigned)(K * 2) + (unsigned)(Cc[i] * 2) : vc1[i]; } }
        for (int t = 0; t < nt; t += 2) {
            const bool last = (t == nt - 2);
            if constexpr (Epi::MID) { if (t == nt / 2) E.mid(acc, cur, wr, wc, fr, fq); }
            const char* a1 = cA + (size_t)(t + 1) * kstep;
            const char* a2 = last ? nA : cA + (size_t)(t + 2) * kstep; const char* b2 = last ? nB : cB + (size_t)(t + 2) * kstep;
            const char* a3 = a2 + kstep; const char* b3 = b2 + kstep;
            if (last && has_next) S.a_ready(nxt);
            if constexpr (SP2) {
            unsigned w0[2], w1[2];
#pragma unroll
            for (int i = 0; i < 2; ++i) { w0[i] = last ? vn0[i] : vc0[i]; w1[i] = last ? vn1[i] : vc1[i]; }
            PG8_LDB(B0, 0, 0); PG8_LDB(B1, 0, 1); PG8_SCHED; PG8_LDA(At, 0, 0); PG8_STAGE(PG8_SA(1, 1), a1 + hstepA, vc1);
            PG8_WAIT_V(8); PG8_WAIT_L(0); PG8_BAR; PG8_MMA(0, 0, At, B0); PG8_MMA(0, 1, At, B1); PG8_BAR; PG8_SCHED;
            PG8_LDA(At, 0, 1); PG8_STAGE(PG8_SB(0, 0), b2, voffB); PG8_STAGE(PG8_SB(0, 1), b2 + hstep, voffB); PG8_STAGE(PG8_SA(0, 0), a2, w0);
            PG8_WAIT_V(8); PG8_WAIT_L(0); PG8_BAR; PG8_MMA(1, 0, At, B0); PG8_MMA(1, 1, At, B1); PG8_BAR; PG8_SCHED;
            PG8_LDB(B0, 1, 0); PG8_LDB(B1, 1, 1); PG8_SCHED; PG8_LDA(At, 1, 0); PG8_STAGE(PG8_SA(0, 1), a2 + hstepA, w1);
            PG8_WAIT_V(8); PG8_WAIT_L(0); PG8_BAR; PG8_MMA(0, 0, At, B0); PG8_MMA(0, 1, At, B1); PG8_BAR; PG8_SCHED;
            PG8_LDA(At, 1, 1); PG8_STAGE(PG8_SB(1, 0), b3, voffB); PG8_STAGE(PG8_SB(1, 1), b3 + hstep, voffB); PG8_STAGE(PG8_SA(1, 0), a3, w0);
            PG8_WAIT_V(8); PG8_WAIT_L(0); PG8_BAR; PG8_MMA(1, 0, At, B0); PG8_MMA(1, 1, At, B1); PG8_BAR; PG8_SCHED;
            } else {
            PG8_LDB(B0, 0, 0); PG8_SCHED; PG8_LDA(At, 0, 0); PG8_STAGE(PG8_SA(1, 1), a1 + hstep, voffA);
            PG8_WAIT_L(8); PG8_BAR; PG8_WAIT_L(0); PG8_MMA(0, 0, At, B0); PG8_BAR; PG8_SCHED;
            PG8_LDB(B1, 0, 1); PG8_STAGE(PG8_SB(0, 0), b2, voffB);
            PG8_BAR; PG8_WAIT_L(0); PG8_MMA(0, 1, At, B1); PG8_BAR;
            PG8_LDA(At, 0, 1); PG8_STAGE(PG8_SA(0, 0), a2, voffA);
            PG8_BAR; PG8_WAIT_L(0); PG8_MMA(1, 0, At, B0); PG8_BAR; PG8_SCHED;
            PG8_STAGE(PG8_SB(0, 1), b2 + hstep, voffB);
            PG8_WAIT_V(6); PG8_BAR; PG8_MMA(1, 1, At, B1); PG8_BAR;
            PG8_LDB(B0, 1, 0); PG8_SCHED; PG8_LDA(At, 1, 0); PG8_STAGE(PG8_SA(0, 1), a2 + hstep, voffA);
            PG8_WAIT_L(8); PG8_BAR; PG8_WAIT_L(0); PG8_MMA(0, 0, At, B0); PG8_BAR; PG8_SCHED;
            PG8_LDB(B1, 1, 1); PG8_STAGE(PG8_SB(1, 0), b3, voffB);
            PG8_BAR; PG8_WAIT_L(0); PG8_MMA(0, 1, At, B1); PG8_BAR;
            PG8_LDA(At, 1, 1); PG8_STAGE(PG8_SA(1, 0), a3, voffA);
            PG8_BAR; PG8_WAIT_L(0); PG8_MMA(1, 0, At, B0); PG8_BAR; PG8_SCHED;
            PG8_STAGE(PG8_SB(1, 1), b3 + hstep, voffB);
            PG8_WAIT_V(6); PG8_BAR; PG8_MMA(1, 1, At, B1); PG8_BAR;
            }
        }
        if constexpr (ALIGN_EPI) { if (wr == 0) PG8_BAR; }
        if constexpr (!Epi::AFTER_DRAIN) { E(acc, cur, wr, wc, fr, fq); S.done(cur); }
        if (!has_next) break;
#pragma unroll
        for (int a = 0; a < 2; ++a)
#pragma unroll
            for (int b = 0; b < 2; ++b)
#pragma unroll
                for (int m = 0; m < 4; ++m)
#pragma unroll
                    for (int n = 0; n < 2; ++n) acc[a][b][m][n] = (f32x4){0.f, 0.f, 0.f, 0.f};
        cur = nxt; cA = nA; cB = nB; ++ui;
        if constexpr (GATHER) { vc0[0] = vn0[0]; vc0[1] = vn0[1]; vc1[0] = vn1[0]; vc1[1] = vn1[1]; }
        if constexpr (ALIGN_EPI) { if (wr == 1) PG8_BAR; }
    }
    PG8_WAIT_V(0);
    if constexpr (!ALIGN_EPI) { if (wr == 0) PG8_BAR; }
    PG8_BAR;
    if constexpr (Epi::AFTER_DRAIN) { E.fused(acc, cur, wr, wc, fr, fq, lds, wid, lane); S.done(cur); }
#undef PG8_SA
#undef PG8_SB
#undef PG8_STAGE
#undef PG8_LDA
#undef PG8_LDB
#undef PG8_MMA
#undef PG8_WAIT_V
#undef PG8_WAIT_L
#undef PG8_BAR
#undef PG8_SCHED
}
}

#ifndef PG8_SP2
#define PG8_SP2 true
#endif
#ifndef PG8_ALIGN
#define PG8_ALIGN true
#endif
#ifndef DUPSUB
#define DUPSUB 0
#endif
#ifndef TSTAMP
#define TSTAMP 0
#endif
#ifndef USE_CG_SYNC
#define USE_CG_SYNC 0
#endif
#ifndef DUPMASK
#define DUPMASK 0
#define DUPMASK_ON 0
#else
#define DUPMASK_ON 1
#endif
namespace cg = cooperative_groups;
namespace fk {
using pg8::bf16_t; using pg8::f32x4; using pg8::u32x4; using pg8::bf16x8; using pg8::Unit; using pg8::cvt_pk_bf16;
#define LAS __attribute__((address_space(3)))
#define LDS_WAIT() asm volatile("s_waitcnt lgkmcnt(0)" ::: "memory")
typedef unsigned u32x2 __attribute__((ext_vector_type(2)));
constexpr int NB = 8, NS = 4096, NT = NB * NS;
constexpr int NTHREADS = 512, NWAVES = 8, LDS_BYTES = 155648;
constexpr size_t MiB = (size_t)1 << 20;
constexpr size_t WS_ADA = 0, WS_CNT = 256 * 1024,
    WS_WIN = 1 * MiB, WS_WGAB = 9 * MiB, WS_WBA = 13 * MiB, WS_WBB = 14 * MiB, WS_WOUT = 15 * MiB, WS_W13 = 17 * MiB, WS_W2 = 49 * MiB,
    WS_XN = 65 * MiB, WS_QKV = 129 * MiB, WS_IQ = 225 * MiB, WS_GQK = 257 * MiB, WS_GV = 289 * MiB, WS_GR = 321 * MiB,
    WS_IK = 353 * MiB, WS_IW = 355 * MiB, WS_GLR = 357 * MiB, WS_SC = 358 * MiB, WS_MASK = 490 * MiB, WS_ADAP = 506 * MiB, WS_MISC = 509 * MiB;
constexpr int NPROJ = 3584;
constexpr size_t WS_WGT = 400 * 1024;
constexpr int KSL = 16;
constexpr float QSCALE = 0.125f * 1.4426950408889634f;
typedef float f32x2_t __attribute__((ext_vector_type(2))); typedef __bf16 bf16x2_t __attribute__((ext_vector_type(2)));
__device__ __forceinline__ unsigned cvtpk_s(float lo, float hi) { f32x2_t v = {lo, hi}; bf16x2_t b = __builtin_convertvector(v, bf16x2_t); return __builtin_bit_cast(unsigned, b); }
__device__ __forceinline__ void bf8_to_f(const u32x4 w, float* f) {
#pragma unroll
    for (int j = 0; j < 4; ++j) { f[2 * j] = __uint_as_float(w[j] << 16); f[2 * j + 1] = __uint_as_float(w[j] & 0xffff0000u); }
}

__device__ __forceinline__ void tr_item(const float* W, int ldw, int srccol, bf16_t* WT, int K, int dst_row0, int kb, LAS float* scr, int lane, int kdst0 = 0) {
    const int k0 = 64 * kb;
#pragma unroll
    for (int i = 0; i < 32; ++i) { const int kk = 2 * i + (lane >> 5); scr[kk * 33 + (lane & 31)] = W[(size_t)(k0 + kk) * ldw + srccol]; }
    LDS_WAIT();
    const int c = lane & 7;
#pragma unroll
    for (int j = 0; j < 4; ++j) { const int n = (lane >> 3) + 8 * j; const LAS float* s = scr + (8 * c) * 33 + n;
        u32x4 o; o.x = cvt_pk_bf16(s[0 * 33], s[1 * 33]); o.y = cvt_pk_bf16(s[2 * 33], s[3 * 33]); o.z = cvt_pk_bf16(s[4 * 33], s[5 * 33]); o.w = cvt_pk_bf16(s[6 * 33], s[7 * 33]);
        *(u32x4*)(WT + (size_t)(dst_row0 + n) * K + kdst0 + k0 + 8 * c) = o; }
    LDS_WAIT();
}
__device__ __forceinline__ int win_src(int n) {
    if (n < 2048) return n;
    if (n < 3584) return n + 48;
    if (n < 3616) return O_IK + (n - 3584);
    if (n < 3632) return O_IW + (n - 3616);
    return O_GLR + (n - 3632);
}
constexpr int I_ADA = 96 * KSL, I_WIN = 114 * 16, I_WGAB = 64 * 16, I_WB = 32 * 8, I_WOUT = 32 * 16, I_W13 = 32 * 16 * 16, I_W2 = 32 * 32 * 4;
constexpr int P0_ITEMS = I_ADA + I_WIN + I_WGAB + 2 * I_WB + I_WOUT + I_W13 + I_W2, P0_EARLY = I_ADA + I_WIN + I_WGAB + 2 * I_WB + I_WOUT;
__device__ __forceinline__ void p0_item(int it, const float* const* in, unsigned char* ws, LAS float* scr, int lane) {
    if (it < I_ADA) {
        const int cb = it / KSL, ks = it % KSL, k0 = ks * 64; const float* c = in[1]; const float* w = in[3];
#pragma unroll
        for (int b = 0; b < NB; ++b) { const float cv = c[b * D_MODEL + k0 + lane]; scr[b * 64 + lane] = cv / (1.f + __expf(-cv)); }
        LDS_WAIT();
        float acc[NB];
#pragma unroll
        for (int b = 0; b < NB; ++b) acc[b] = 0.f;
        const int col = cb * 64 + lane;
#pragma unroll 16
        for (int kk = 0; kk < 64; ++kk) { const float wv = w[(size_t)(k0 + kk) * (6 * D_MODEL) + col];
#pragma unroll
            for (int b = 0; b < NB; ++b) acc[b] += scr[b * 64 + kk] * wv; }
        float* adap = (float*)(ws + WS_ADAP);
#pragma unroll
        for (int b = 0; b < NB; ++b) adap[(size_t)(ks * NB + b) * (6 * D_MODEL) + col] = acc[b];
        LDS_WAIT(); return;
    }
    it -= I_ADA;
    const int l31 = lane & 31;
    if (it < I_WIN) { const int nb = it / 16, kb = it % 16; tr_item(in[5], D_IN, win_src(nb * 32 + l31), (bf16_t*)(ws + WS_WIN), 1024, nb * 32, kb, scr, lane); return; }
    it -= I_WIN;
    if (it < I_WGAB) { const int nb = it / 16, kb = it % 16; tr_item(in[5], D_IN, O_GA + nb * 32 + l31, (bf16_t*)(ws + WS_WGAB), 1024, nb * 32, kb, scr, lane); return; }
    it -= I_WGAB;
    if (it < I_WB) { const int nb = it / 8, kb = it % 8; tr_item(in[9], D_MODEL, nb * 32 + l31, (bf16_t*)(ws + WS_WBA), 1024, nb * 32, kb, scr, lane, 0); return; }
    it -= I_WB;
    if (it < I_WB) { const int nb = it / 8, kb = it % 8; tr_item(in[10], D_MODEL, nb * 32 + l31, (bf16_t*)(ws + WS_WBA), 1024, nb * 32, kb, scr, lane, 512); return; }
    it -= I_WB;
    if (it < I_WOUT) { const int nb = it / 16, kb = it % 16; tr_item(in[11], D_MODEL, nb * 32 + l31, (bf16_t*)(ws + WS_WOUT), 1024, nb * 32, kb, scr, lane); return; }
    it -= I_WOUT;
    if (it < I_W13) {
        const int e = it / 256, r = it % 256, nb = r / 16, kb = r % 16; const int row0 = nb * 32;
        const int half = (row0 & 255) >> 7; const int col = (row0 >> 8) * 128 + (row0 & 127) + l31;
        const float* src = (half ? in[19] : in[18]) + (size_t)e * D_MODEL * D_EXP;
        tr_item(src, D_EXP, col, (bf16_t*)(ws + WS_W13) + (size_t)e * 512 * 1024, 1024, row0, kb, scr, lane); return; }
    it -= I_W13;
    { const int e = it / 128, r = it % 128, nb = r / 4, kb = r % 4;
      tr_item(in[20] + (size_t)e * D_EXP * D_MODEL, D_MODEL, nb * 32 + l31, (bf16_t*)(ws + WS_W2) + (size_t)e * 1024 * 256, 256, nb * 32, kb, scr, lane); }
}

struct TrP { const float* W; int ldw, srccol; bf16_t* WT; int K, dst_row0, kb, kdst0; };
__device__ __forceinline__ void tr_params(int it, const float* const* in, unsigned char* ws, int lane, TrP& P) {
    it -= I_ADA; const int l31 = lane & 31; P.kdst0 = 0;
    if (it < I_WIN) { const int nb = it / 16; P.kb = it % 16; P.W = in[5]; P.ldw = D_IN; P.srccol = win_src(nb * 32 + l31); P.WT = (bf16_t*)(ws + WS_WIN); P.K = 1024; P.dst_row0 = nb * 32; return; }
    it -= I_WIN;
    if (it < I_WGAB) { const int nb = it / 16; P.kb = it % 16; P.W = in[5]; P.ldw = D_IN; P.srccol = O_GA + nb * 32 + l31; P.WT = (bf16_t*)(ws + WS_WGAB); P.K = 1024; P.dst_row0 = nb * 32; return; }
    it -= I_WGAB;
    if (it < I_WB) { const int nb = it / 8; P.kb = it % 8; P.W = in[9]; P.ldw = D_MODEL; P.srccol = nb * 32 + l31; P.WT = (bf16_t*)(ws + WS_WBA); P.K = 1024; P.dst_row0 = nb * 32; return; }
    it -= I_WB;
    if (it < I_WB) { const int nb = it / 8; P.kb = it % 8; P.W = in[10]; P.ldw = D_MODEL; P.srccol = nb * 32 + l31; P.WT = (bf16_t*)(ws + WS_WBA); P.K = 1024; P.dst_row0 = nb * 32; P.kdst0 = 512; return; }
    it -= I_WB;
    if (it < I_WOUT) { const int nb = it / 16; P.kb = it % 16; P.W = in[11]; P.ldw = D_MODEL; P.srccol = nb * 32 + l31; P.WT = (bf16_t*)(ws + WS_WOUT); P.K = 1024; P.dst_row0 = nb * 32; return; }
    it -= I_WOUT;
    if (it < I_W13) { const int e = it / 256, r = it % 256, nb = r / 16; P.kb = r % 16; const int row0 = nb * 32; const int half = (row0 & 255) >> 7;
        P.W = (half ? in[19] : in[18]) + (size_t)e * D_MODEL * D_EXP; P.ldw = D_EXP; P.srccol = (row0 >> 8) * 128 + (row0 & 127) + l31; P.WT = (bf16_t*)(ws + WS_W13) + (size_t)e * 512 * 1024; P.K = 1024; P.dst_row0 = row0; return; }
    it -= I_W13;
    { const int e = it / 128, r = it % 128, nb = r / 4; P.kb = r % 4; P.W = in[20] + (size_t)e * D_EXP * D_MODEL; P.ldw = D_MODEL; P.srccol = nb * 32 + l31; P.WT = (bf16_t*)(ws + WS_W2) + (size_t)e * 1024 * 256; P.K = 256; P.dst_row0 = nb * 32; }
}
__device__ __forceinline__ void tr_load(const TrP& P, int lane, float (&val)[32]) {
    const int k0 = 64 * P.kb;
#pragma unroll
    for (int i = 0; i < 32; ++i) { const int kk = 2 * i + (lane >> 5); val[i] = P.W[(size_t)(k0 + kk) * P.ldw + P.srccol]; }
}
__device__ __forceinline__ void tr_finish(const TrP& P, const float (&val)[32], LAS float* scr, int lane) {
    const int k0 = 64 * P.kb;
#pragma unroll
    for (int i = 0; i < 32; ++i) { const int kk = 2 * i + (lane >> 5); scr[kk * 33 + (lane & 31)] = val[i]; }
    LDS_WAIT();
    const int c = lane & 7;
#pragma unroll
    for (int j = 0; j < 4; ++j) { const int n = (lane >> 3) + 8 * j; const LAS float* sp = scr + (8 * c) * 33 + n;
        u32x4 o; o.x = cvt_pk_bf16(sp[0 * 33], sp[1 * 33]); o.y = cvt_pk_bf16(sp[2 * 33], sp[3 * 33]); o.z = cvt_pk_bf16(sp[4 * 33], sp[5 * 33]); o.w = cvt_pk_bf16(sp[6 * 33], sp[7 * 33]);
        *(u32x4*)(P.WT + (size_t)(P.dst_row0 + n) * P.K + P.kdst0 + k0 + 8 * c) = o; }
    LDS_WAIT();
}
__device__ __forceinline__ float dpp_row_sum_f(float v) {
    v += __int_as_float(__builtin_amdgcn_update_dpp(0, __float_as_int(v), 0xB1, 0xF, 0xF, true));
    v += __int_as_float(__builtin_amdgcn_update_dpp(0, __float_as_int(v), 0x4E, 0xF, 0xF, true));
    v += __int_as_float(__builtin_amdgcn_update_dpp(0, __float_as_int(v), 0x141, 0xF, 0xF, true));
    v += __int_as_float(__builtin_amdgcn_update_dpp(0, __float_as_int(v), 0x140, 0xF, 0xF, true));
    return v;
}
__device__ __forceinline__ float wave_sum_u(float v) {
    v = dpp_row_sum_f(v);
    return (__int_as_float(__builtin_amdgcn_readlane(__float_as_int(v), 0)) + __int_as_float(__builtin_amdgcn_readlane(__float_as_int(v), 16)))
         + (__int_as_float(__builtin_amdgcn_readlane(__float_as_int(v), 32)) + __int_as_float(__builtin_amdgcn_readlane(__float_as_int(v), 48)));
}
template <int R> __device__ __forceinline__ void ln_center(f32x4 (&v)[R][4], float (&rstd)[R], float* meanout = nullptr) {
    typedef float f32x2l __attribute__((ext_vector_type(2)));
    float s[R];
#pragma unroll
    for (int r = 0; r < R; ++r) { f32x2l a2 = (f32x2l){0.f, 0.f};
#pragma unroll
        for (int j = 0; j < 4; ++j) { a2 += (f32x2l){v[r][j].x, v[r][j].y}; a2 += (f32x2l){v[r][j].z, v[r][j].w}; }
        s[r] = a2.x + a2.y; }
#pragma unroll
    for (int r = 0; r < R; ++r) s[r] = dpp_row_sum_f(s[r]);
    float q[R];
#pragma unroll
    for (int r = 0; r < R; ++r) { const float mean = ((__int_as_float(__builtin_amdgcn_readlane(__float_as_int(s[r]), 0)) + __int_as_float(__builtin_amdgcn_readlane(__float_as_int(s[r]), 16)))
                                                   + (__int_as_float(__builtin_amdgcn_readlane(__float_as_int(s[r]), 32)) + __int_as_float(__builtin_amdgcn_readlane(__float_as_int(s[r]), 48)))) * (1.f / D_MODEL);
        if (meanout) meanout[r] = mean;
        f32x2l q2 = (f32x2l){0.f, 0.f};
#pragma unroll
        for (int j = 0; j < 4; ++j) { v[r][j] = v[r][j] - mean; const f32x2l lo = (f32x2l){v[r][j].x, v[r][j].y}, hi = (f32x2l){v[r][j].z, v[r][j].w};
            q2 = __builtin_elementwise_fma(lo, lo, q2); q2 = __builtin_elementwise_fma(hi, hi, q2); }
        q[r] = q2.x + q2.y; }
#pragma unroll
    for (int r = 0; r < R; ++r) q[r] = dpp_row_sum_f(q[r]);
#pragma unroll
    for (int r = 0; r < R; ++r) { const float var = ((__int_as_float(__builtin_amdgcn_readlane(__float_as_int(q[r]), 0)) + __int_as_float(__builtin_amdgcn_readlane(__float_as_int(q[r]), 16)))
                                                  + (__int_as_float(__builtin_amdgcn_readlane(__float_as_int(q[r]), 32)) + __int_as_float(__builtin_amdgcn_readlane(__float_as_int(q[r]), 48)))) * (1.f / D_MODEL);
        rstd[r] = 1.f / sqrtf(var + LN_EPS); }
}
__device__ __forceinline__ float wave_sum(float v) {
#pragma unroll
    for (int o = 1; o < 64; o <<= 1) v += __shfl_xor(v, o);
    return v;
}
__device__ __forceinline__ float ada_sum(const float* adap, const float* b_ada, int b, int j) {
    float s = b_ada[j];
#pragma unroll
    for (int k = 0; k < KSL; ++k) s += adap[(size_t)(k * NB + b) * (6 * D_MODEL) + j];
    return s;
}
__device__ __forceinline__ void p1_phase(const float* const* in, unsigned char* ws, LAS unsigned char* lds, int G) {
    const int tid = threadIdx.x, lane = tid & 63, wave = tid >> 6;
    const float* adap = (const float*)(ws + WS_ADAP); const float* b_ada = in[4]; const float* x = in[0];
    LAS float* sh = (LAS float*)lds; LAS float* sc = sh + D_MODEL;
    for (int blk = blockIdx.x; blk < NT / 128; blk += G) {
        const int b = blk / 32;
        __syncthreads();
        for (int j = tid; j < 2 * D_MODEL; j += NTHREADS) sh[j] = ada_sum(adap, b_ada, b, j);
        if (blk < 256 && tid < 192) { const int j = (blk & 31) * 192 + tid; ((float*)(ws + WS_ADA) + (size_t)b * 6 * D_MODEL)[j] = ada_sum(adap, b_ada, b, j); }
        __syncthreads();
        for (int rb = 0; rb < 16; rb += 4) {
            const size_t row0 = (size_t)blk * 128 + wave * 16 + rb;
            f32x4 v[4][4];
#pragma unroll
            for (int r = 0; r < 4; ++r) { const f32x4* xr = (const f32x4*)(x + (row0 + r) * D_MODEL) + lane;
#pragma unroll
                for (int j = 0; j < 4; ++j) v[r][j] = xr[64 * j]; }
            float rstd[4]; ln_center<4>(v, rstd);
#pragma unroll
            for (int j = 0; j < 4; ++j) { const f32x4 a = *(const LAS f32x4*)(sc + 256 * j + 4 * lane) + 1.f, c = *(const LAS f32x4*)(sh + 256 * j + 4 * lane);
#pragma unroll
                for (int r = 0; r < 4; ++r) v[r][j] = v[r][j] * rstd[r] * a + c; }
#pragma unroll
            for (int r = 0; r < 4; ++r)
#pragma unroll
                for (int jp = 0; jp < 4; jp += 2) { const bool odd = lane & 1;
                    u32x2 w0, w1; w0.x = cvtpk_s(v[r][jp].x, v[r][jp].y); w0.y = cvtpk_s(v[r][jp].z, v[r][jp].w); w1.x = cvtpk_s(v[r][jp + 1].x, v[r][jp + 1].y); w1.y = cvtpk_s(v[r][jp + 1].z, v[r][jp + 1].w);
                    const unsigned gx = odd ? w0.x : w1.x, gy = odd ? w0.y : w1.y;
                    const unsigned tx = (unsigned)__builtin_amdgcn_update_dpp(0, (int)gx, 0xB1, 0xF, 0xF, true), ty = (unsigned)__builtin_amdgcn_update_dpp(0, (int)gy, 0xB1, 0xF, 0xF, true);
                    u32x4 o; o.x = odd ? tx : w0.x; o.y = odd ? ty : w0.y; o.z = odd ? w1.x : tx; o.w = odd ? w1.y : ty;
                    ((u32x4*)((bf16_t*)(ws + WS_XN) + (row0 + r) * D_MODEL))[32 * (jp + (lane & 1)) + (lane >> 1)] = o; }
        }
        asm volatile("s_waitcnt vmcnt(0)" ::: "memory"); __syncthreads();
        {   LAS unsigned char* W64 = lds + 8192; constexpr int WP = 2064;
            const bf16_t* wsrc = (const bf16_t*)(ws + WS_WIN) + (size_t)3584 * 1024;
            { u32x4 wq[16];
#pragma unroll
              for (int q = 0; q < 16; ++q) { const int i = tid + q * NTHREADS; wq[q] = *(const u32x4*)(wsrc + (size_t)(i >> 7) * 1024 + (i & 127) * 8); }
#pragma unroll
              for (int q = 0; q < 16; ++q) { const int i = tid + q * NTHREADS; *(LAS u32x4*)(W64 + (i >> 7) * WP + (i & 127) * 16) = wq[q]; } }
            __syncthreads();
            const int fr = lane & 15, fq = lane >> 4; const size_t rowA = (size_t)blk * 128 + wave * 16 + fr;
            const bf16_t* xp = (const bf16_t*)(ws + WS_XN) + rowA * D_MODEL + 8 * fq;
            f32x4 acc[4];
#pragma unroll
            for (int nt = 0; nt < 4; ++nt) acc[nt] = (f32x4){0.f, 0.f, 0.f, 0.f};
#pragma unroll 16
            for (int ks = 0; ks < 32; ++ks) { const bf16x8 bfr = *(const bf16x8*)(xp + 32 * ks);
#pragma unroll
                for (int nt = 0; nt < 4; ++nt) { const bf16x8 afr = *(const LAS bf16x8*)(W64 + (16 * nt + fr) * WP + (32 * ks + 8 * fq) * 2); acc[nt] = __builtin_amdgcn_mfma_f32_16x16x32_bf16(afr, bfr, acc[nt], 0, 0, 0); } }
            { u32x2 w; w.x = cvtpk_s(acc[0][0], acc[0][1]); w.y = cvtpk_s(acc[0][2], acc[0][3]); *(u32x2*)((bf16_t*)(ws + WS_IK) + rowA * 32 + 4 * fq) = w;
              w.x = cvtpk_s(acc[1][0], acc[1][1]); w.y = cvtpk_s(acc[1][2], acc[1][3]); *(u32x2*)((bf16_t*)(ws + WS_IK) + rowA * 32 + 16 + 4 * fq) = w;
              *(f32x4*)((float*)(ws + WS_IW) + rowA * 16 + 4 * fq) = acc[2];
              w.x = cvtpk_s(acc[3][0], acc[3][1]); w.y = cvtpk_s(acc[3][2], acc[3][3]); *(u32x2*)((bf16_t*)(ws + WS_GLR) + rowA * 16 + 4 * fq) = w; }
        }
    }
}

struct EpiProj {
    static constexpr bool PERM = true, AFTER_DRAIN = false, MID = false;
    unsigned char* ws;
    __device__ __forceinline__ void operator()(const f32x4 (&acc)[2][2][4][2], const Unit& u, int wr, int wc, int fr, int fq) const {
        const int row0 = u.pm * 256 + wr * 64 + fr; const int pn = u.pn;
        {
            bf16_t* base; int ld, ct; float sc = 1.f;
            if (pn < 6) { base = (bf16_t*)(ws + WS_QKV); ld = 1536; ct = pn * 256; if (pn < 2) sc = QSCALE; }
            else if (pn < 8) { base = (bf16_t*)(ws + WS_IQ); ld = 512; ct = (pn - 6) * 256; }
            else if (pn < 10) { base = (bf16_t*)(ws + WS_GQK); ld = 512; ct = (pn - 8) * 256; }
            else if (pn < 12) { base = (bf16_t*)(ws + WS_GV); ld = 512; ct = (pn - 10) * 256; }
            else { base = (bf16_t*)(ws + WS_GR); ld = 512; ct = (pn - 12) * 256; }
            const int col0 = ct + wc * 32 + 8 * fq;
#pragma unroll
            for (int ai = 0; ai < 2; ++ai)
#pragma unroll
                for (int m = 0; m < 4; ++m) { bf16_t* rowp = base + (size_t)(row0 + ai * 128 + m * 16) * ld + col0;
#pragma unroll
                    for (int bj = 0; bj < 2; ++bj) { const f32x4 v0 = acc[ai][bj][m][0] * sc, v1 = acc[ai][bj][m][1] * sc;
                        u32x4 w; w.x = cvt_pk_bf16(v0[0], v0[1]); w.y = cvt_pk_bf16(v0[2], v0[3]); w.z = cvt_pk_bf16(v1[0], v1[1]); w.w = cvt_pk_bf16(v1[2], v1[3]);
                        *(u32x4*)(rowp + bj * 128) = w; } }
        }
    }
};

typedef float f32x4_t __attribute__((ext_vector_type(4)));
constexpr int SC_TILES_PER_B = 528, SC_ITEMS = NB * SC_TILES_PER_B;
__device__ __forceinline__ size_t keys_row_dw(int b, int t) {
    const int qi = t >> 7, r = t & 127; return (size_t)b * (SC_TILES_PER_B * 8192) + (size_t)8192 * (qi * (qi + 1) / 2) + (size_t)r * (qi + 1) * 64;
}
__device__ __forceinline__ unsigned score_key(float sc) {
    const _Float16 hf = (_Float16)sc; const unsigned short hb = __builtin_bit_cast(unsigned short, hf);
    return (hb & 0x8000u) ? (unsigned)(unsigned short)~hb : (unsigned)(hb | 0x8000u);
}
__device__ __forceinline__ void fma_abs4(f32x4& acc, const f32x4& d, float w) {
    float a0 = acc[0], a1 = acc[1], a2 = acc[2], a3 = acc[3];
    asm volatile("v_fma_f32 %0, |%4|, %8, %0\n\tv_fma_f32 %1, |%5|, %8, %1\n\tv_fma_f32 %2, |%6|, %8, %2\n\tv_fma_f32 %3, |%7|, %8, %3"
                 : "+v"(a0), "+v"(a1), "+v"(a2), "+v"(a3) : "v"(d[0]), "v"(d[1]), "v"(d[2]), "v"(d[3]), "v"(w));
    acc[0] = a0; acc[1] = a1; acc[2] = a2; acc[3] = a3;
}
constexpr int SC_SEGS_PER_B = 144, SC_SEGS = NB * SC_SEGS_PER_B;
__device__ __forceinline__ unsigned score_key2(float lo, float hi) {
    typedef _Float16 h2 __attribute__((ext_vector_type(2)));
    const unsigned x = __builtin_bit_cast(unsigned, __builtin_amdgcn_cvt_pkrtz(lo, hi));
    unsigned m; asm("v_pk_ashrrev_i16 %0, %2, %1" : "=v"(m) : "v"(x), "v"(0x000F000Fu));
    return x ^ (m | 0x80008000u);
}
__device__ __forceinline__ void p3a_run(int b, int qi, int kj0, int kj1, unsigned char* ws, LAS unsigned char* ldsw, int wave, int lane) {
    const int fr = lane & 15, fq = lane >> 4;
    const int t = qi * 128 + wave * 16 + fr; const size_t trow = (size_t)b * NS + t;
    const bf16_t* IQ = (const bf16_t*)(ws + WS_IQ) + trow * 512 + 8 * fq;
    const bf16_t* IK = (const bf16_t*)(ws + WS_IK) + ((size_t)b * NS + fr) * 32 + 8 * fq;
    const float* IW = (const float*)(ws + WS_IW) + trow * 16;
    LAS unsigned char* QL = ldsw; LAS float* WL = (LAS float*)(ldsw + 16384);
    bf16x8 kf[8];
#pragma unroll
    for (int kb = 0; kb < 8; ++kb) kf[kb] = *(const bf16x8*)(IK + ((size_t)kj0 * 128 + kb * 16) * 32);
    float qb[8];
#pragma unroll
    for (int j = 0; j < 8; ++j) qb[j] = 0.f;
#pragma unroll
    for (int hg = 0; hg < 4; ++hg) {
        const f32x4 w4 = *(const f32x4*)(IW + 4 * hg) * (0.5f * 0.044194173824159216f);
        u32x4 q4[4];
#pragma unroll
        for (int i = 0; i < 4; ++i) q4[i] = *(const u32x4*)(IQ + (4 * hg + i) * 32);
#pragma unroll
        for (int i = 0; i < 4; ++i) { *(LAS u32x4*)(QL + (4 * hg + i) * 1024 + lane * 16) = q4[i]; if (fq == 0) WL[(4 * hg + i) * 16 + fr] = w4[i]; float f[8]; bf8_to_f(q4[i], f);
#pragma unroll
            for (int j = 0; j < 8; ++j) qb[j] += w4[i] * f[j]; }
    }
    u32x4 qbw; qbw.x = cvtpk_s(qb[0], qb[1]); qbw.y = cvtpk_s(qb[2], qb[3]); qbw.z = cvtpk_s(qb[4], qb[5]); qbw.w = cvtpk_s(qb[6], qb[7]);
    const bf16x8 qbar = __builtin_bit_cast(bf16x8, qbw);
    LDS_WAIT();
    for (int kj = kj0; kj <= kj1; ++kj) {
        bf16x8 kn[8];
        const int kjn = (kj < kj1) ? kj + 1 : kj;
#pragma unroll
        for (int kb = 0; kb < 8; ++kb) kn[kb] = *(const bf16x8*)(IK + ((size_t)kjn * 128 + kb * 16) * 32);
        f32x4 acc[8];
#pragma unroll
        for (int kb = 0; kb < 8; ++kb) acc[kb] = __builtin_amdgcn_mfma_f32_16x16x32_bf16(kf[kb], qbar, (f32x4){0.f, 0.f, 0.f, 0.f}, 0, 0, 0);
        f32x4 dA[8], dB[8];
        { const bf16x8 qf = *(const LAS bf16x8*)(QL + lane * 16);
#pragma unroll
          for (int kb = 0; kb < 8; ++kb) dA[kb] = __builtin_amdgcn_mfma_f32_16x16x32_bf16(kf[kb], qf, (f32x4){0.f, 0.f, 0.f, 0.f}, 0, 0, 0); }
#pragma unroll 1
        for (int h = 0; h < I_HEADS; h += 2) {
            { const bf16x8 qf = *(const LAS bf16x8*)(QL + (h + 1) * 1024 + lane * 16);
#pragma unroll
              for (int kb = 0; kb < 8; ++kb) dB[kb] = __builtin_amdgcn_mfma_f32_16x16x32_bf16(kf[kb], qf, (f32x4){0.f, 0.f, 0.f, 0.f}, 0, 0, 0); }
            __builtin_amdgcn_sched_barrier(0);
            { const float w = WL[h * 16 + fr];
#pragma unroll
              for (int kb = 0; kb < 8; ++kb) fma_abs4(acc[kb], dA[kb], w); }
            __builtin_amdgcn_sched_barrier(0);
            if (h + 2 < I_HEADS) { const bf16x8 qf = *(const LAS bf16x8*)(QL + (h + 2) * 1024 + lane * 16);
#pragma unroll
              for (int kb = 0; kb < 8; ++kb) dA[kb] = __builtin_amdgcn_mfma_f32_16x16x32_bf16(kf[kb], qf, (f32x4){0.f, 0.f, 0.f, 0.f}, 0, 0, 0); }
            __builtin_amdgcn_sched_barrier(0);
            { const float w = WL[(h + 1) * 16 + fr];
#pragma unroll
              for (int kb = 0; kb < 8; ++kb) fma_abs4(acc[kb], dB[kb], w); }
            __builtin_amdgcn_sched_barrier(0);
        }
        unsigned* KEYS = (unsigned*)(ws + WS_SC) + keys_row_dw(b, t) + (size_t)kj * 64;
        const bool diag = (kj == qi);
#pragma unroll
        for (int kb = 0; kb < 4; ++kb) { u32x4 o;
#pragma unroll
            for (int r = 0; r < 4; ++r) o[r] = score_key2(acc[kb][r], acc[kb + 4][r]);
            if (diag) { asm volatile("" ::: "memory");
#pragma unroll
                for (int r = 0; r < 4; ++r) { const int sl = kb * 16 + 4 * fq + r, tl = wave * 16 + fr; if (sl > tl) o[r] &= 0xFFFF0000u; if (sl + 64 > tl) o[r] &= 0x0000FFFFu; } }
            *(u32x4*)(KEYS + kb * 16 + 4 * fq) = o; }
#pragma unroll
        for (int kb = 0; kb < 8; ++kb) kf[kb] = kn[kb];
    }
    LDS_WAIT();
}

__device__ __forceinline__ int dpp_row_sum(int v) {
    v += __builtin_amdgcn_update_dpp(0, v, 0xB1, 0xF, 0xF, true);
    v += __builtin_amdgcn_update_dpp(0, v, 0x4E, 0xF, 0xF, true);
    v += __builtin_amdgcn_update_dpp(0, v, 0x141, 0xF, 0xF, true);
    v += __builtin_amdgcn_update_dpp(0, v, 0x140, 0xF, 0xF, true);
    return v;
}
__device__ __forceinline__ int wave_sum_i(int v) {
    v = dpp_row_sum(v);
    return __builtin_amdgcn_readlane(v, 0) + __builtin_amdgcn_readlane(v, 16) + __builtin_amdgcn_readlane(v, 32) + __builtin_amdgcn_readlane(v, 48);
}
__device__ __forceinline__ void pk_ge_count4(unsigned x0, unsigned x1, unsigned x2, unsigned x3, unsigned c2m1, unsigned one2, unsigned& c0, unsigned& c1, unsigned& c2, unsigned& c3) {
    unsigned d0, d1, d2, d3;
    asm volatile("v_pk_sub_u16 %0, %8, %12 clamp\n\tv_pk_sub_u16 %1, %9, %12 clamp\n\tv_pk_sub_u16 %2, %10, %12 clamp\n\tv_pk_sub_u16 %3, %11, %12 clamp\n\t"
                 "v_pk_min_u16 %0, %0, %13\n\tv_pk_min_u16 %1, %1, %13\n\tv_pk_min_u16 %2, %2, %13\n\tv_pk_min_u16 %3, %3, %13\n\t"
                 "v_pk_add_u16 %4, %4, %0\n\tv_pk_add_u16 %5, %5, %1\n\tv_pk_add_u16 %6, %6, %2\n\tv_pk_add_u16 %7, %7, %3"
                 : "=&v"(d0), "=&v"(d1), "=&v"(d2), "=&v"(d3), "+v"(c0), "+v"(c1), "+v"(c2), "+v"(c3) : "v"(x0), "v"(x1), "v"(x2), "v"(x3), "v"(c2m1), "v"(one2));
}
constexpr int TOPK = 256;
__device__ __forceinline__ int count_ge(const unsigned (&x)[32], int ng, unsigned cand) {
    const unsigned c2m1 = (cand - 1u) * 0x00010001u, one2 = 0x00010001u; unsigned c0 = 0u, c1 = 0u, c2 = 0u, c3 = 0u;
#pragma unroll
    for (int g = 0; g < 4; ++g) if (g < ng) { pk_ge_count4(x[8 * g], x[8 * g + 1], x[8 * g + 2], x[8 * g + 3], c2m1, one2, c0, c1, c2, c3); pk_ge_count4(x[8 * g + 4], x[8 * g + 5], x[8 * g + 6], x[8 * g + 7], c2m1, one2, c0, c1, c2, c3); }
    const unsigned s = (c0 + c1) + (c2 + c3);
    return wave_sum_i((int)((s & 0xFFFFu) + (s >> 16)));
}
__device__ __forceinline__ void p4a_load(int row_, unsigned char* ws, int lane, unsigned (&x)[32]) {
    const int row = __builtin_amdgcn_readfirstlane(row_); const int b = row / NS, t = row % NS; const int nc = (t >> 7) + 1;
    const unsigned* KEYS = (const unsigned*)(ws + WS_SC) + keys_row_dw(b, t); const unsigned* DEADK = (const unsigned*)(ws + 392 * 1024);
#pragma unroll
    for (int c = 0; c < 32; ++c) { const unsigned* base = c < nc ? KEYS + c * 64 : DEADK; x[c] = base[lane]; }
}
__device__ __forceinline__ int scan16_incl(int v) {
    v += __builtin_amdgcn_update_dpp(0, v, 0x111, 0xF, 0xF, true);
    v += __builtin_amdgcn_update_dpp(0, v, 0x112, 0xF, 0xF, true);
    v += __builtin_amdgcn_update_dpp(0, v, 0x114, 0xF, 0xF, true);
    v += __builtin_amdgcn_update_dpp(0, v, 0x118, 0xF, 0xF, true);
    return v;
}
__device__ __forceinline__ int scan64_incl(int v, int lane) {
    v = scan16_incl(v);
    const int t0 = __builtin_amdgcn_readlane(v, 15), t1 = __builtin_amdgcn_readlane(v, 31), t2 = __builtin_amdgcn_readlane(v, 47);
    return v + (lane >= 16 ? t0 : 0) + (lane >= 32 ? t1 : 0) + (lane >= 48 ? t2 : 0);
}
__device__ __forceinline__ unsigned bin_lo(unsigned x, unsigned hb) { unsigned a; asm("v_bfe_u32 %0, %1, 6, 10\n\tv_lshl_add_u32 %0, %0, 2, %2" : "=&v"(a) : "v"(x), "s"(hb)); return a; }
__device__ __forceinline__ unsigned bin_hi(unsigned x, unsigned hb) { unsigned a; asm("v_lshrrev_b32 %0, 22, %1\n\tv_lshl_add_u32 %0, %0, 2, %2" : "=&v"(a) : "v"(x), "s"(hb)); return a; }
__device__ __forceinline__ void lds_inc(unsigned addr) { __hip_atomic_fetch_add((LAS unsigned*)(unsigned long)addr, 1u, __ATOMIC_RELAXED, __HIP_MEMORY_SCOPE_WORKGROUP); }
#define WAVE_LDS_ORDER() do { asm volatile("" ::: "memory"); __builtin_amdgcn_fence(__ATOMIC_ACQ_REL, "wavefront"); __builtin_amdgcn_wave_barrier(); asm volatile("" ::: "memory"); } while (0)
constexpr int SEL_LDS = 8192;
__device__ __forceinline__ void tie_fix(unsigned long long& m, unsigned long long e, int& run, int need) {
    if (e != 0ull) { const int n = __builtin_popcountll(e); int keep = need - run; run += n;
        if (keep < n) { if (keep < 0) keep = 0; unsigned long long d = e; for (int i = 0; i < keep; ++i) d &= d - 1ull; m &= ~d; } }
}
#define PUT4(mw0, mw1, a0, a1, a2, a3, L0) asm volatile("s_nop 3\n\tv_writelane_b32 %0, %2, %10\n\tv_writelane_b32 %1, %3, %10\n\tv_writelane_b32 %0, %4, %11\n\tv_writelane_b32 %1, %5, %11\n\t" \
        "v_writelane_b32 %0, %6, %12\n\tv_writelane_b32 %1, %7, %12\n\tv_writelane_b32 %0, %8, %13\n\tv_writelane_b32 %1, %9, %13" : "+v"(mw0), "+v"(mw1) \
        : "s"((unsigned)(a0)), "s"((unsigned)((a0) >> 32)), "s"((unsigned)(a1)), "s"((unsigned)((a1) >> 32)), "s"((unsigned)(a2)), "s"((unsigned)((a2) >> 32)), "s"((unsigned)(a3)), "s"((unsigned)((a3) >> 32)), \
          "n"(L0), "n"((L0) + 1), "n"((L0) + 2), "n"((L0) + 3))
__device__ __forceinline__ void p4a_row(int row_, unsigned char* ws, int lane, const unsigned (&x)[32], LAS unsigned char* H) {
    const int row = __builtin_amdgcn_readfirstlane(row_);
    const int t = row % NS; unsigned long long* MASK = (unsigned long long*)(ws + WS_MASK) + (size_t)row * 64;
    const int nc = (t >> 7) + 1;
    if (t < TOPK) {
        if (lane < 2 * nc) { const int lo = lane * 64; unsigned long long m = 0ull; if (t >= lo + 63) m = ~0ull; else if (t >= lo) m = (2ull << (t - lo)) - 1ull; MASK[lane] = m; }
        return;
    }
    const unsigned hb = (unsigned)(unsigned long)H;
    { const u32x4 z = (u32x4){0u, 0u, 0u, 0u};
#pragma unroll
      for (int i = 0; i < 4; ++i) *(LAS u32x4*)(H + i * 1024 + lane * 16) = z;
      *(LAS unsigned*)(H + 4096 + lane * 4) = 0u; }
    WAVE_LDS_ORDER();
#pragma unroll
    for (int c = 0; c < 32; c += 2) if (c < nc) {
        lds_inc(bin_lo(x[c], hb)); lds_inc(bin_hi(x[c], hb)); lds_inc(bin_lo(x[c + 1], hb)); lds_inc(bin_hi(x[c + 1], hb)); }
    WAVE_LDS_ORDER();
    int Bsel, cA;
    {   const LAS unsigned char* hp = H + (63 - lane) * 64;
        const u32x4 h0 = *(const LAS u32x4*)hp, h1 = *(const LAS u32x4*)(hp + 16), h2 = *(const LAS u32x4*)(hp + 32), h3 = *(const LAS u32x4*)(hp + 48);
        const int sl = (int)(((h0.x + h0.y) + (h0.z + h0.w)) + ((h1.x + h1.y) + (h1.z + h1.w)) + ((h2.x + h2.y) + (h2.z + h2.w)) + ((h3.x + h3.y) + (h3.z + h3.w)));
        const int P = scan64_incl(sl, lane);
        const int Ls = __builtin_ctzll(__ballot(P >= TOPK));
        const int E = __builtin_amdgcn_readlane(P - sl, Ls);
        const int hj = (int)*(const LAS unsigned*)(H + ((63 - Ls) * 16 + 15 - (lane & 15)) * 4);
        const int Pj = scan16_incl(hj);
        const int jl = __builtin_ctzll(__ballot(E + Pj >= TOPK) & 0xFFFFull);
        Bsel = (63 - Ls) * 16 + 15 - jl; cA = E + __builtin_amdgcn_readlane(Pj - hj, jl);
    }
    {   const unsigned Bs2 = ((unsigned)Bsel << 6) * 0x00010001u; const unsigned dump = 64u + (unsigned)lane, hb2 = hb + 4096u;
#pragma unroll
        for (int c = 0; c < 32; c += 2) if (c < nc) {
#pragma unroll
            for (int i = 0; i < 2; ++i) { const unsigned y = x[c + i] ^ Bs2;
                const unsigned il = (unsigned)(unsigned short)__builtin_elementwise_min((unsigned short)y, (unsigned short)dump), ih = __builtin_elementwise_min(y >> 16, dump);
                lds_inc((il << 2) + hb2); lds_inc((ih << 2) + hb2); } }
    }
    WAVE_LDS_ORDER();
    unsigned T; int cT, need;
    {   const int c2 = (int)*(const LAS unsigned*)(H + 4096 + (63 - lane) * 4);
        const int P2 = scan64_incl(c2, lane);
        const int L2 = __builtin_ctzll(__ballot(cA + P2 >= TOPK));
        cT = cA + __builtin_amdgcn_readlane(P2, L2); need = TOPK - (cT - __builtin_amdgcn_readlane(c2, L2));
        T = ((unsigned)Bsel << 6) + (unsigned)(63 - L2);
    }
    unsigned mw0 = 0u, mw1 = 0u;
    const bool tie = (cT != TOPK);
    const unsigned Th = T << 16; const unsigned short Ts = (unsigned short)T; int run = 0;
#pragma unroll
    for (int c = 0; c < 32; c += 2) if (c < nc) {
        unsigned long long a0 = __ballot((unsigned short)x[c] >= Ts), a1 = __ballot(x[c] >= Th), a2 = __ballot((unsigned short)x[c + 1] >= Ts), a3 = __ballot(x[c + 1] >= Th);
        if (tie) {
            const unsigned long long e0 = __ballot((unsigned short)x[c] == Ts), e1 = __ballot((x[c] >> 16) == T), e2 = __ballot((unsigned short)x[c + 1] == Ts), e3 = __ballot((x[c + 1] >> 16) == T);
            tie_fix(a0, e0, run, need); tie_fix(a1, e1, run, need); tie_fix(a2, e2, run, need); tie_fix(a3, e3, run, need);
        }
        PUT4(mw0, mw1, a0, a1, a2, a3, 2 * c);
    }
    if (lane < 2 * nc) MASK[lane] = ((unsigned long long)mw1 << 32) | mw0;
}

typedef float f32x16 __attribute__((ext_vector_type(16)));
typedef short s16x4 __attribute__((ext_vector_type(4)));
__device__ __forceinline__ int crow(int r, int hi) { return (r & 3) + 8 * (r >> 2) + 4 * hi; }
__device__ __forceinline__ s16x4 vtr(const LAS unsigned char* p) { return __builtin_bit_cast(s16x4, __builtin_amdgcn_ds_read_tr16_b64_v4i16((LAS s16x4*)p)); }
constexpr size_t WS_OAB = 358 * MiB;
constexpr int AT_ROWB = 144, AT_TILE = 64 * AT_ROWB;
constexpr int AT_VROWB = 192, AT_VTILE = 64 * AT_VROWB;
constexpr float LOG2E = 1.4426950408889634f;
constexpr float ATHR = 8.f;
__device__ __forceinline__ int sext_bit(unsigned w, int c) { int r; asm("v_bfe_i32 %0, %1, %2, 1" : "=v"(r) : "v"(w), "n"(c)); return r; }
__device__ __forceinline__ void attn_s(const LAS unsigned char* Kb, const LAS float* BT, const bf16x8 (&qr)[4], unsigned long long mword, bool far, bool first, int dist0,
                                       int r32, int hh, f32x16& o0, f32x16& o1, float& lsum, f32x16& nmB, float& mref, u32x4 (&pk)[4]) {
    f32x16 p0, p1;
#pragma unroll
    for (int ks = 0; ks < 4; ++ks) {
        const bf16x8 k0 = *(const LAS bf16x8*)(Kb + r32 * AT_ROWB + 32 * ks + 16 * hh);
        const bf16x8 k1 = *(const LAS bf16x8*)(Kb + (32 + r32) * AT_ROWB + 32 * ks + 16 * hh);
        if (ks == 0) { p0 = __builtin_amdgcn_mfma_f32_32x32x16_bf16(k0, qr[0], nmB, 0, 0, 0); p1 = __builtin_amdgcn_mfma_f32_32x32x16_bf16(k1, qr[0], nmB, 0, 0, 0); }
        else { p0 = __builtin_amdgcn_mfma_f32_32x32x16_bf16(k0, qr[ks], p0, 0, 0, 0); p1 = __builtin_amdgcn_mfma_f32_32x32x16_bf16(k1, qr[ks], p1, 0, 0, 0); }
    }
    if (!far) {
        const LAS float* bp = BT + (96 - 27 - 32) + dist0;
#pragma unroll
        for (int i = 0; i < 16; ++i) { const int c = (i & 3) + 8 * (i >> 2); p0[i] += bp[32 + 27 - c]; p1[i] += bp[27 - c]; }
    }
    float m0 = __builtin_fmaxf(__builtin_fmaxf(p0[0], p0[1]), p0[2]), m1 = __builtin_fmaxf(__builtin_fmaxf(p1[0], p1[1]), p1[2]);
#pragma unroll
    for (int i = 3; i < 15; i += 2) { m0 = __builtin_fmaxf(__builtin_fmaxf(m0, p0[i]), p0[i + 1]); m1 = __builtin_fmaxf(__builtin_fmaxf(m1, p1[i]), p1[i + 1]); }
    float mx = __builtin_fmaxf(__builtin_fmaxf(m0, m1), __builtin_fmaxf(p0[15], p1[15]));
    { const auto rr = __builtin_amdgcn_permlane32_swap(__float_as_uint(mx), __float_as_uint(mx), false, false); mx = __builtin_fmaxf(__uint_as_float(rr[0]), __uint_as_float(rr[1])); }
    if (first || __any(mx > ATHR)) {
        const float dl = (first || mx > ATHR) ? mx : 0.f; mref += dl; const float f = __builtin_amdgcn_exp2f(-dl);
#pragma unroll
        for (int i = 0; i < 16; ++i) { p0[i] -= dl; p1[i] -= dl; nmB[i] -= dl; o0[i] *= f; o1[i] *= f; }
        lsum *= f;
    }
    const unsigned wl = (unsigned)mword >> (4 * hh), wh = (unsigned)(mword >> 32) >> (4 * hh);
#pragma unroll
    for (int i = 0; i < 16; ++i) { const int c = (i & 3) + 8 * (i >> 2);
        p0[i] = __uint_as_float(__float_as_uint(__builtin_amdgcn_exp2f(p0[i])) & (unsigned)sext_bit(wl, c));
        p1[i] = __uint_as_float(__float_as_uint(__builtin_amdgcn_exp2f(p1[i])) & (unsigned)sext_bit(wh, c)); }
    {
        typedef float f32x2s __attribute__((ext_vector_type(2)));
        f32x2s a[8];
#pragma unroll
        for (int j = 0; j < 8; ++j) a[j] = (f32x2s){p0[2 * j], p0[2 * j + 1]} + (f32x2s){p1[2 * j], p1[2 * j + 1]};
        const f32x2s b0 = (a[0] + a[1]) + (a[2] + a[3]), b1 = (a[4] + a[5]) + (a[6] + a[7]); const f32x2s c2 = b0 + b1;
        lsum += c2.x + c2.y; }
#pragma unroll
    for (int s2 = 0; s2 < 2; ++s2) {
        pk[s2].x = cvtpk_s(p0[8 * s2], p0[8 * s2 + 1]); pk[s2].y = cvtpk_s(p0[8 * s2 + 2], p0[8 * s2 + 3]); pk[s2].z = cvtpk_s(p0[8 * s2 + 4], p0[8 * s2 + 5]); pk[s2].w = cvtpk_s(p0[8 * s2 + 6], p0[8 * s2 + 7]);
        pk[2 + s2].x = cvtpk_s(p1[8 * s2], p1[8 * s2 + 1]); pk[2 + s2].y = cvtpk_s(p1[8 * s2 + 2], p1[8 * s2 + 3]); pk[2 + s2].z = cvtpk_s(p1[8 * s2 + 4], p1[8 * s2 + 5]); pk[2 + s2].w = cvtpk_s(p1[8 * s2 + 6], p1[8 * s2 + 7]); }
}
__device__ __forceinline__ void attn_pv(const LAS unsigned char* Vb, const u32x4 (&pk)[4], int voff, f32x16& o0, f32x16& o1) {
#pragma unroll
    for (int q = 0; q < 4; ++q) {
        const bf16x8 pf = __builtin_bit_cast(bf16x8, pk[q]);
        const LAS unsigned char* vp = Vb + (16 * q) * AT_VROWB + voff;
        const s16x4 a0l = vtr(vp), a0h = vtr(vp + 8 * AT_VROWB), a1l = vtr(vp + 64), a1h = vtr(vp + 8 * AT_VROWB + 64);
        const bf16x8 va0 = (bf16x8){a0l[0], a0l[1], a0l[2], a0l[3], a0h[0], a0h[1], a0h[2], a0h[3]};
        const bf16x8 va1 = (bf16x8){a1l[0], a1l[1], a1l[2], a1l[3], a1h[0], a1h[1], a1h[2], a1h[3]};
        o0 = __builtin_amdgcn_mfma_f32_32x32x16_bf16(va0, pf, o0, 0, 0, 0);
        o1 = __builtin_amdgcn_mfma_f32_32x32x16_bf16(va1, pf, o1, 0, 0, 0);
    }
}
constexpr int AT_KB = 0, AT_VB = 2 * AT_TILE, AT_BT3 = AT_VB + 3 * AT_VTILE;
template <bool GB> __device__ __forceinline__ void attn_unit(int b, int h, int Q, const float* rel_bias, unsigned char* ws, LAS unsigned char* lds) {
    const int tid = threadIdx.x, lane = tid & 63, wave = __builtin_amdgcn_readfirstlane(tid >> 6), r32 = lane & 31, hh = lane >> 5;
    const size_t rowbase = (size_t)b * NS; const int t0w = 256 * Q + 32 * wave, t = t0w + r32;
    const bf16_t* QKV = (const bf16_t*)(ws + WS_QKV);
    LAS float* BT = (LAS float*)(lds + AT_BT3);
    const int NTL = 4 * (Q + 1);
    const int lastw = (t0w + 31) >> 6;
    const int srow = tid >> 3, sch = tid & 7;
    const bf16_t* kg = QKV + (rowbase + srow) * 1536 + 512 + h * 64 + sch * 8; const bf16_t* vg = kg + 512;
    const int soff = srow * AT_ROWB + sch * 16, svoff = srow * AT_VROWB + sch * 16;
    const unsigned long long* MK = (const unsigned long long*)(ws + WS_MASK) + (rowbase + t) * 64;
    const size_t tstride = (size_t)64 * 1536;
    u32x4 k0r = *(const u32x4*)kg, v0r = *(const u32x4*)vg;
    u32x4 kA = *(const u32x4*)(kg + tstride), vA = *(const u32x4*)(vg + tstride);
    u32x4 kB = *(const u32x4*)(kg + 2 * tstride), vB = *(const u32x4*)(vg + 2 * tstride);
    unsigned long long me = MK[0], mo = MK[(1 <= lastw) ? 1 : 0];
    bf16x8 qr[4];
#pragma unroll
    for (int ks = 0; ks < 4; ++ks) qr[ks] = *(const bf16x8*)(QKV + (rowbase + t) * 1536 + h * 64 + 16 * ks + 8 * hh);
    const float cB = rel_bias[31 * A_HEADS + h] * LOG2E;
    __syncthreads();
    if (tid < 352) { const int d = tid - 96; BT[tid] = rel_bias[v0_bucket(d < 0 ? 0 : d) * A_HEADS + h] * LOG2E - cB; }
    *(LAS u32x4*)(lds + AT_KB + soff) = k0r; *(LAS u32x4*)(lds + AT_VB + svoff) = v0r;
    f32x16 o0, o1, nmB; float lsum = 0.f;
#pragma unroll
    for (int i = 0; i < 16; ++i) { o0[i] = 0.f; o1[i] = 0.f; nmB[i] = cB; }
    float mref = 0.f;
    const int q4 = (lane & 15) >> 2, p4 = lane & 3, blk = (lane >> 4) & 1;
    const int voff = (4 * hh + q4) * AT_VROWB + (16 * blk + 4 * p4) * 2;
    u32x4 pk[4];
#pragma unroll
    for (int q = 0; q < 4; ++q) pk[q] = (u32x4){0u, 0u, 0u, 0u};
    int vcur = 0, vnext = AT_VTILE, vprev = 2 * AT_VTILE;
    for (int kt = 0; kt < NTL; kt += 2) {
        __syncthreads();
        *(LAS u32x4*)(lds + AT_KB + AT_TILE + soff) = kA; *(LAS u32x4*)(lds + AT_VB + vnext + svoff) = vA;
        { const int tn = (kt + 3 < NTL) ? kt + 3 : NTL - 1; kA = *(const u32x4*)(kg + (size_t)tn * tstride); vA = *(const u32x4*)(vg + (size_t)tn * tstride); }
        if (GB) { if (kt >= 1 && kt - 1 <= lastw) attn_pv(lds + AT_VB + vprev, pk, voff, o0, o1); }
        if (kt <= lastw) attn_s(lds + AT_KB, BT, qr, me, (t0w - (64 * kt + 63) >= 113), kt == 0, t - 64 * kt - 4 * hh, r32, hh, o0, o1, lsum, nmB, mref, pk);
        if (!GB) { if (kt <= lastw) attn_pv(lds + AT_VB + vcur, pk, voff, o0, o1); }
        me = MK[(kt + 2 <= lastw) ? kt + 2 : lastw];
        { const int tmp = vprev; vprev = vcur; vcur = vnext; vnext = tmp; }
        __syncthreads();
        *(LAS u32x4*)(lds + AT_KB + soff) = kB; *(LAS u32x4*)(lds + AT_VB + vnext + svoff) = vB;
        { const int tn = (kt + 4 < NTL) ? kt + 4 : NTL - 1; kB = *(const u32x4*)(kg + (size_t)tn * tstride); vB = *(const u32x4*)(vg + (size_t)tn * tstride); }
        if (GB) { if (kt <= lastw) attn_pv(lds + AT_VB + vprev, pk, voff, o0, o1); }
        if (kt + 1 <= lastw) attn_s(lds + AT_KB + AT_TILE, BT, qr, mo, (t0w - (64 * (kt + 1) + 63) >= 113), false, t - 64 * (kt + 1) - 4 * hh, r32, hh, o0, o1, lsum, nmB, mref, pk);
        if (!GB) { if (kt + 1 <= lastw) attn_pv(lds + AT_VB + vcur, pk, voff, o0, o1); }
        mo = MK[(kt + 3 <= lastw) ? kt + 3 : lastw];
        { const int tmp = vprev; vprev = vcur; vcur = vnext; vnext = tmp; }
    }
    if (GB) {
        if (NTL - 1 <= lastw) attn_pv(lds + AT_VB + vprev, pk, voff, o0, o1);
    }
    float inv; { const auto rr = __builtin_amdgcn_permlane32_swap(__float_as_uint(lsum), __float_as_uint(lsum), false, false); inv = 1.f / (__uint_as_float(rr[0]) + __uint_as_float(rr[1])); }
    bf16_t* O = (bf16_t*)(ws + WS_OAB) + (rowbase + t) * 1024 + h * 64 + 4 * hh;
#pragma unroll
    for (int g = 0; g < 4; ++g) {
        u32x2 w0, w1; w0.x = cvtpk_s(o0[4 * g] * inv, o0[4 * g + 1] * inv); w0.y = cvtpk_s(o0[4 * g + 2] * inv, o0[4 * g + 3] * inv);
        w1.x = cvtpk_s(o1[4 * g] * inv, o1[4 * g + 1] * inv); w1.y = cvtpk_s(o1[4 * g + 2] * inv, o1[4 * g + 3] * inv);
        *(u32x2*)(O + 8 * g) = w0; *(u32x2*)(O + 32 + 8 * g) = w1;
    }
}

constexpr int GL_LG = 0, GL_SEG = 16384, GL_A = 18432, GL_B = GL_A + 9216, GL_C = GL_B + 9216, GL_VT = GL_C + 9216, GL_ST = GL_VT + 18432;
constexpr int GROWB = 144;
constexpr int GLA_ITEMS = NB * G_HEADS * 64;
__device__ __forceinline__ void gla_cumdecay(const u32x4 g0, const u32x4 g1, int h, const float* wg, const float* bg, LAS unsigned char* lds, float* lgc) {
    const int tid = threadIdx.x; LAS float* LG = (LAS float*)(lds + GL_LG); LAS float* SEG = (LAS float*)(lds + GL_SEG);
    {   const int c = tid >> 3, dg = tid & 7; float gl[16];
#pragma unroll
        for (int j = 0; j < 4; ++j) { gl[2 * j] = __uint_as_float(g0[j] << 16); gl[2 * j + 1] = __uint_as_float(g0[j] & 0xffff0000u); gl[8 + 2 * j] = __uint_as_float(g1[j] << 16); gl[8 + 2 * j + 1] = __uint_as_float(g1[j] & 0xffff0000u); }
        float z[8];
#pragma unroll
        for (int j = 0; j < 8; ++j) z[j] = bg[h * 64 + 8 * dg + j];
#pragma unroll
        for (int r = 0; r < 16; ++r) { const f32x4 w0 = *(const f32x4*)(wg + r * G_KW + h * 64 + 8 * dg), w1 = *(const f32x4*)(wg + r * G_KW + h * 64 + 8 * dg + 4);
            z[0] += gl[r] * w0[0]; z[1] += gl[r] * w0[1]; z[2] += gl[r] * w0[2]; z[3] += gl[r] * w0[3]; z[4] += gl[r] * w1[0]; z[5] += gl[r] * w1[1]; z[6] += gl[r] * w1[2]; z[7] += gl[r] * w1[3]; }
#pragma unroll
        for (int j = 0; j < 8; ++j) z[j] = (fminf(z[j], 0.f) - log1pf(__expf(-fabsf(z[j])))) * (1.f / 16.f);
        *(LAS f32x4*)(LG + c * 64 + 8 * dg) = (f32x4){z[0], z[1], z[2], z[3]}; *(LAS f32x4*)(LG + c * 64 + 8 * dg + 4) = (f32x4){z[4], z[5], z[6], z[7]};
    }
    __syncthreads();
    const int seg = tid >> 6, d = tid & 63; float v[8];
#pragma unroll
    for (int i = 0; i < 8; ++i) v[i] = LG[(8 * seg + i) * 64 + d];
#pragma unroll
    for (int i = 1; i < 8; ++i) v[i] += v[i - 1];
    SEG[seg * 64 + d] = v[7];
    __syncthreads();
    float off = 0.f;
#pragma unroll
    for (int s2 = 0; s2 < 8; ++s2) if (s2 < seg) off += SEG[s2 * 64 + d];
#pragma unroll
    for (int i = 0; i < 8; ++i) { const float bv = v[i] + off; LG[(8 * seg + i) * 64 + d] = bv; lgc[(8 * seg + i) * 64 + d] = bv; }
    __syncthreads();
}
__device__ __forceinline__ unsigned short f2bf_s(float f) { return (unsigned short)(cvtpk_s(f, 0.f) & 0xffffu); }
__device__ __forceinline__ void gla_stage_vt(const u32x4 a, const u32x4 b2, LAS unsigned char* lds) {
    const int tid = threadIdx.x, c = tid >> 3, d0 = (tid & 7) * 16;
#pragma unroll
    for (int j = 0; j < 4; ++j) {
        *(LAS unsigned short*)(lds + GL_VT + (d0 + 2 * j) * GROWB + c * 2) = (unsigned short)(a[j] & 0xffffu); *(LAS unsigned short*)(lds + GL_VT + (d0 + 2 * j + 1) * GROWB + c * 2) = (unsigned short)(a[j] >> 16);
        *(LAS unsigned short*)(lds + GL_VT + (d0 + 8 + 2 * j) * GROWB + c * 2) = (unsigned short)(b2[j] & 0xffffu); *(LAS unsigned short*)(lds + GL_VT + (d0 + 8 + 2 * j + 1) * GROWB + c * 2) = (unsigned short)(b2[j] >> 16); }
}
__device__ __forceinline__ void p3b_item(int it, const float* wg, const float* bg, float* UT, float* LGC, unsigned char* ws, LAS unsigned char* lds) {
    const int tid = threadIdx.x, lane = tid & 63, wave = tid >> 6, fr = lane & 15, fq = lane >> 4;
    const int bh = it >> 6, n = it & 63, b = bh >> 2, h = bh & 3; const size_t r0 = (size_t)b * NS + 64 * n;
    const int c_ = tid >> 3, dg_ = tid & 7;
    const bf16_t* gp_ = (const bf16_t*)(ws + WS_GLR) + (r0 + c_) * 16; const u32x4 g0 = *(const u32x4*)gp_, g1 = *(const u32x4*)(gp_ + 8);
    const u32x4 kraw = *(const u32x4*)((const bf16_t*)(ws + WS_GQK) + (r0 + c_) * 512 + 256 + h * 64 + 8 * dg_);
    const bf16_t* vp_ = (const bf16_t*)(ws + WS_GV) + (r0 + c_) * 512 + h * 128 + dg_ * 16; const u32x4 va_ = *(const u32x4*)vp_, vb_ = *(const u32x4*)(vp_ + 8);
    __syncthreads();
    gla_cumdecay(g0, g1, h, wg, bg, lds, LGC + (size_t)it * 4096);
    const LAS float* LG = (const LAS float*)(lds + GL_LG);
    {   const int c = tid >> 3, dg = tid & 7; float kf[8]; bf8_to_f(kraw, kf);
#pragma unroll
        for (int j = 0; j < 8; ++j) { const int d = 8 * dg + j; *(LAS unsigned short*)(lds + GL_A + d * GROWB + c * 2) = f2bf_s(kf[j] * __expf(LG[63 * 64 + d] - LG[c * 64 + d])); }
        if (tid < 64) ((float*)(ws + WS_MISC))[(size_t)it * 64 + tid] = __expf(LG[63 * 64 + tid]);
    }
    gla_stage_vt(va_, vb_, lds);
    __syncthreads();
    f32x4 acc[4];
#pragma unroll
    for (int i = 0; i < 4; ++i) acc[i] = (f32x4){0.f, 0.f, 0.f, 0.f};
#pragma unroll
    for (int ks = 0; ks < 2; ++ks) { const bf16x8 bv = *(const LAS bf16x8*)(lds + GL_VT + (16 * wave + fr) * GROWB + (32 * ks + 8 * fq) * 2);
#pragma unroll
        for (int i = 0; i < 4; ++i) { const bf16x8 av = *(const LAS bf16x8*)(lds + GL_A + (16 * i + fr) * GROWB + (32 * ks + 8 * fq) * 2); acc[i] = __builtin_amdgcn_mfma_f32_16x16x32_bf16(av, bv, acc[i], 0, 0, 0); } }
#pragma unroll
    for (int i = 0; i < 4; ++i) *(f32x4*)(UT + ((size_t)it * 128 + 16 * wave + fr) * 64 + 16 * i + 4 * fq) = acc[i];
}
__device__ __forceinline__ void p4b_item(int j, const float* UT, bf16_t* SP, unsigned char* ws) {
    const int tid = threadIdx.x, bh = j >> 3, dv = (j & 7) * 16 + (tid >> 5), dk = (tid & 31) * 2; const float* DEC = (const float*)(ws + WS_MISC);
    typedef float f32x2v __attribute__((ext_vector_type(2)));
    f32x2v st = (f32x2v){0.f, 0.f};
#pragma unroll 8
    for (int n = 0; n < 64; ++n) { const size_t it = (size_t)bh * 64 + n; const size_t o = (it * 128 + dv) * 64 + dk;
        *(unsigned*)(SP + o) = cvtpk_s(st[0], st[1]);
        const f32x2v u = *(const f32x2v*)(UT + o), dc = *(const f32x2v*)(DEC + it * 64 + dk); st = dc * st + u; }
}
__device__ __forceinline__ void p4b_item4(int j, const float* UT, bf16_t* SP, unsigned char* ws) {
    const int tid = threadIdx.x, bh = j >> 3, dv0 = (j & 7) * 16 + (tid >> 5), dk = (tid & 31) * 2; const float* DEC = (const float*)(ws + WS_MISC);
    typedef float f32x2v __attribute__((ext_vector_type(2)));
    f32x2v st[4];
#pragma unroll
    for (int i = 0; i < 4; ++i) st[i] = (f32x2v){0.f, 0.f};
#pragma unroll 4
    for (int n = 0; n < 64; ++n) { const size_t it = (size_t)bh * 64 + n; const f32x2v dc = *(const f32x2v*)(DEC + it * 64 + dk);
#pragma unroll
        for (int i = 0; i < 4; ++i) { const size_t o = (it * 128 + dv0 + 4 * i) * 64 + dk;
            *(unsigned*)(SP + o) = cvtpk_s(st[i][0], st[i][1]);
            const f32x2v u = *(const f32x2v*)(UT + o); st[i] = dc * st[i] + u; } }
}
__device__ __forceinline__ void p5b_item(int it, const float* LGC, const float* ng, const bf16_t* SP, unsigned char* ws, LAS unsigned char* lds) {
    const int tid = threadIdx.x, lane = tid & 63, wave = tid >> 6, r32 = lane & 31, hh = lane >> 5;
    const int bh = it >> 6, n = it & 63, b = bh >> 2, h = bh & 3; const size_t r0 = (size_t)b * NS + 64 * n;
    const int c_ = tid >> 3, dg_ = tid & 7; const int dvb = wave >> 1, cb = wave & 1;
    const f32x4 lg0 = *(const f32x4*)(LGC + (size_t)it * 4096 + c_ * 64 + 8 * dg_), lg1 = *(const f32x4*)(LGC + (size_t)it * 4096 + c_ * 64 + 8 * dg_ + 4);
    const bf16_t* qp_ = (const bf16_t*)(ws + WS_GQK) + (r0 + c_) * 512 + h * 64 + 8 * dg_; const u32x4 qraw = *(const u32x4*)qp_, kraw = *(const u32x4*)(qp_ + 256);
    const bf16_t* vp_ = (const bf16_t*)(ws + WS_GV) + (r0 + c_) * 512 + h * 128 + dg_ * 16; const u32x4 va_ = *(const u32x4*)vp_, vb_ = *(const u32x4*)(vp_ + 8);
    bf16x8 spf[4];
#pragma unroll
    for (int ks = 0; ks < 4; ++ks) spf[ks] = *(const bf16x8*)(SP + ((size_t)it * 128 + 32 * dvb + r32) * 64 + 16 * ks + 8 * hh);
    const size_t trow = r0 + 32 * cb + r32; const int dvbase = h * 128 + 32 * dvb + 4 * hh;
    const bf16_t* grp = (const bf16_t*)(ws + WS_GR) + trow * 512 + dvbase; u32x2 grw[4];
#pragma unroll
    for (int g = 0; g < 4; ++g) grw[g] = *(const u32x2*)(grp + 8 * g);
    __syncthreads();
    { LAS float* LGw = (LAS float*)(lds + GL_LG); *(LAS f32x4*)(LGw + c_ * 64 + 8 * dg_) = lg0; *(LAS f32x4*)(LGw + c_ * 64 + 8 * dg_ + 4) = lg1; }
    __syncthreads();
    const LAS float* LG = (const LAS float*)(lds + GL_LG);
    {   const int c = tid >> 3, dg = tid & 7; float qf[8], kf[8]; bf8_to_f(qraw, qf); bf8_to_f(kraw, kf);
        float qr[8], ks[8], qi[8];
#pragma unroll
        for (int j = 0; j < 8; ++j) { const int d = 8 * dg + j; const float bc = LG[c * 64 + d], bl = LG[63 * 64 + d]; const float q8 = qf[j] * 0.125f;
            qr[j] = q8 * __expf(bc - bl); ks[j] = kf[j] * __expf(bl - bc); qi[j] = q8 * __expf(bc); }
        u32x4 w;
        w.x = cvtpk_s(qr[0], qr[1]); w.y = cvtpk_s(qr[2], qr[3]); w.z = cvtpk_s(qr[4], qr[5]); w.w = cvtpk_s(qr[6], qr[7]); *(LAS u32x4*)(lds + GL_A + c * GROWB + 16 * dg) = w;
        w.x = cvtpk_s(ks[0], ks[1]); w.y = cvtpk_s(ks[2], ks[3]); w.z = cvtpk_s(ks[4], ks[5]); w.w = cvtpk_s(ks[6], ks[7]); *(LAS u32x4*)(lds + GL_B + c * GROWB + 16 * dg) = w;
        w.x = cvtpk_s(qi[0], qi[1]); w.y = cvtpk_s(qi[2], qi[3]); w.z = cvtpk_s(qi[4], qi[5]); w.w = cvtpk_s(qi[6], qi[7]); *(LAS u32x4*)(lds + GL_C + c * GROWB + 16 * dg) = w;
    }
    gla_stage_vt(va_, vb_, lds);
    __syncthreads();
    f32x16 o;
#pragma unroll
    for (int i = 0; i < 16; ++i) o[i] = 0.f;
#pragma unroll
    for (int jb = 0; jb < 2; ++jb) if (jb <= cb) {
        f32x16 at;
#pragma unroll
        for (int i = 0; i < 16; ++i) at[i] = 0.f;
#pragma unroll
        for (int ks = 0; ks < 4; ++ks) { const bf16x8 av = *(const LAS bf16x8*)(lds + GL_B + (32 * jb + r32) * GROWB + 32 * ks + 16 * hh), bv = *(const LAS bf16x8*)(lds + GL_A + (32 * cb + r32) * GROWB + 32 * ks + 16 * hh);
            at = __builtin_amdgcn_mfma_f32_32x32x16_bf16(av, bv, at, 0, 0, 0); }
        if (jb == cb) {
#pragma unroll
            for (int i = 0; i < 16; ++i) if (crow(i, hh) > r32) at[i] = 0.f; }
#pragma unroll
        for (int s = 0; s < 2; ++s) {
            u32x4 pw; pw.x = cvtpk_s(at[8 * s], at[8 * s + 1]); pw.y = cvtpk_s(at[8 * s + 2], at[8 * s + 3]); pw.z = cvtpk_s(at[8 * s + 4], at[8 * s + 5]); pw.w = cvtpk_s(at[8 * s + 6], at[8 * s + 7]);
            const LAS unsigned char* vp = lds + GL_VT + (32 * dvb + r32) * GROWB + (32 * jb + 16 * s + 4 * hh) * 2;
            const u32x2 lo = *(const LAS u32x2*)vp, hi = *(const LAS u32x2*)(vp + 16);
            const u32x4 va = (u32x4){lo.x, lo.y, hi.x, hi.y};
            o = __builtin_amdgcn_mfma_f32_32x32x16_bf16(__builtin_bit_cast(bf16x8, va), __builtin_bit_cast(bf16x8, pw), o, 0, 0, 0);
        }
    }
#pragma unroll
    for (int ks = 0; ks < 4; ++ks) { const bf16x8 bv = *(const LAS bf16x8*)(lds + GL_C + (32 * cb + r32) * GROWB + 32 * ks + 16 * hh);
        o = __builtin_amdgcn_mfma_f32_32x32x16_bf16(spf[ks], bv, o, 0, 0, 0); }
    LAS float* ST = (LAS float*)(lds + GL_ST);
    float sm = 0.f;
#pragma unroll
    for (int i = 0; i < 16; ++i) sm += o[i];
    sm += __shfl_xor(sm, 32);
    if (hh == 0) ST[dvb * 64 + 32 * cb + r32] = sm;
    __syncthreads();
    const float mean = (ST[32 * cb + r32] + ST[64 + 32 * cb + r32] + ST[128 + 32 * cb + r32] + ST[192 + 32 * cb + r32]) * (1.f / 128.f);
    float sq = 0.f;
#pragma unroll
    for (int i = 0; i < 16; ++i) { o[i] -= mean; sq += o[i] * o[i]; }
    sq += __shfl_xor(sq, 32);
    if (hh == 0) ST[256 + dvb * 64 + 32 * cb + r32] = sq;
    __syncthreads();
    const float var = (ST[256 + 32 * cb + r32] + ST[256 + 64 + 32 * cb + r32] + ST[256 + 128 + 32 * cb + r32] + ST[256 + 192 + 32 * cb + r32]) * (1.f / 128.f);
    const float rstd = 1.f / sqrtf(var + LN_EPS);
    bf16_t* op = (bf16_t*)(ws + WS_OAB) + trow * 1024 + 512 + dvbase;
#pragma unroll
    for (int g = 0; g < 4; ++g) { const u32x2 gw = grw[g]; const f32x4 nv = *(const f32x4*)(ng + dvbase + 8 * g);
        float gr[4] = {__uint_as_float(gw.x << 16), __uint_as_float(gw.x & 0xffff0000u), __uint_as_float(gw.y << 16), __uint_as_float(gw.y & 0xffff0000u)}; float y[4];
#pragma unroll
        for (int e = 0; e < 4; ++e) y[e] = o[4 * g + e] * rstd * nv[e] * (gr[e] * __builtin_amdgcn_rcpf(1.f + __expf(-gr[e])));
        u32x2 w; w.x = cvtpk_s(y[0], y[1]); w.y = cvtpk_s(y[2], y[3]); *(u32x2*)(op + 8 * g) = w; }
}

constexpr int GL_HALF = 67584;
__device__ __forceinline__ void gla_cumdecay2(size_t r0, int h, const bf16_t* WGT, const float* bg, unsigned char* ws, LAS unsigned char* ldh, float* lgc) {
    const int tl = threadIdx.x & 255, lane = threadIdx.x & 63, wl = (threadIdx.x >> 6) & 3, r32 = lane & 31, hh = lane >> 5; LAS float* LG = (LAS float*)(ldh + GL_LG); LAS float* SEG = (LAS float*)(ldh + GL_SEG);
    {   const int cb = wl >> 1, db = wl & 1;
        const bf16x8 af = *(const bf16x8*)((const bf16_t*)(ws + WS_GLR) + (r0 + 32 * cb + r32) * 16 + 8 * hh), bfr = *(const bf16x8*)(WGT + (size_t)(h * 64 + 32 * db + r32) * 16 + 8 * hh);
        const float bias = bg[h * 64 + 32 * db + r32]; f32x16 z;
#pragma unroll
        for (int i = 0; i < 16; ++i) z[i] = bias;
        z = __builtin_amdgcn_mfma_f32_32x32x16_bf16(af, bfr, z, 0, 0, 0);
#pragma unroll
        for (int i = 0; i < 16; ++i) { const float zz = z[i]; LG[(32 * cb + crow(i, hh)) * 64 + 32 * db + r32] = (fminf(zz, 0.f) - __logf(1.f + __expf(-fabsf(zz)))) * (1.f / 16.f); }
    }
    __syncthreads();
    const int seg = tl >> 6, d = tl & 63; float v[16];
#pragma unroll
    for (int i = 0; i < 16; ++i) v[i] = LG[(16 * seg + i) * 64 + d];
#pragma unroll
    for (int i = 1; i < 16; ++i) v[i] += v[i - 1];
    SEG[seg * 64 + d] = v[15];
    __syncthreads();
    float off = 0.f;
#pragma unroll
    for (int s2 = 0; s2 < 4; ++s2) if (s2 < seg) off += SEG[s2 * 64 + d];
#pragma unroll
    for (int i = 0; i < 16; ++i) { const float bv = v[i] + off; LG[(16 * seg + i) * 64 + d] = bv; lgc[(16 * seg + i) * 64 + d] = bv; }
    __syncthreads();
}
__device__ __forceinline__ void gla_stage_vt2(const u32x4 (&vv)[4], LAS unsigned char* ldh) {
    const int tl = threadIdx.x & 255, c = tl >> 2, d0 = (tl & 3) * 32;
#pragma unroll
    for (int k = 0; k < 4; ++k)
#pragma unroll
        for (int j = 0; j < 4; ++j) {
            *(LAS unsigned short*)(ldh + GL_VT + (d0 + 8 * k + 2 * j) * GROWB + c * 2) = (unsigned short)(vv[k][j] & 0xffffu);
            *(LAS unsigned short*)(ldh + GL_VT + (d0 + 8 * k + 2 * j + 1) * GROWB + c * 2) = (unsigned short)(vv[k][j] >> 16); }
}
__device__ __forceinline__ void p3b_pair(int p, const float* wg, const float* bg, float* UT, float* LGC, unsigned char* ws, LAS unsigned char* lds) {
    const int tid = threadIdx.x, hb = tid >> 8, tl = tid & 255, lane = tid & 63, wl = (tid >> 6) & 3, fr = lane & 15, fq = lane >> 4;
    const int it = 2 * p + hb; LAS unsigned char* ldh = lds + hb * GL_HALF;
    const int bh = it >> 6, n = it & 63, b = bh >> 2, h = bh & 3; const size_t r0 = (size_t)b * NS + 64 * n;
    const int c_ = tl >> 2, dq_ = tl & 3;
    const bf16_t* kp_ = (const bf16_t*)(ws + WS_GQK) + (r0 + c_) * 512 + 256 + h * 64 + 16 * dq_; const u32x4 k0 = *(const u32x4*)kp_, k1 = *(const u32x4*)(kp_ + 8);
    const bf16_t* vp_ = (const bf16_t*)(ws + WS_GV) + (r0 + c_) * 512 + h * 128 + 32 * dq_; u32x4 vv[4];
#pragma unroll
    for (int k = 0; k < 4; ++k) vv[k] = *(const u32x4*)(vp_ + 8 * k);
    __syncthreads();
    gla_cumdecay2(r0, h, (const bf16_t*)(ws + WS_WGT), bg, ws, ldh, LGC + (size_t)it * 4096);
    const LAS float* LG = (const LAS float*)(ldh + GL_LG);
    {   float kf[16]; bf8_to_f(k0, kf); bf8_to_f(k1, kf + 8);
#pragma unroll
        for (int j = 0; j < 16; ++j) { const int d = 16 * dq_ + j; *(LAS unsigned short*)(ldh + GL_A + d * GROWB + c_ * 2) = f2bf_s(kf[j] * __expf(LG[63 * 64 + d] - LG[c_ * 64 + d])); }
        if (tl < 64) ((float*)(ws + WS_MISC))[(size_t)it * 64 + tl] = __expf(LG[63 * 64 + tl]);
    }
    gla_stage_vt2(vv, ldh);
    __syncthreads();
#pragma unroll
    for (int dvi = 0; dvi < 2; ++dvi) {
        const int dvblk = 2 * wl + dvi;
        f32x4 acc[4];
#pragma unroll
        for (int i = 0; i < 4; ++i) acc[i] = (f32x4){0.f, 0.f, 0.f, 0.f};
#pragma unroll
        for (int ks = 0; ks < 2; ++ks) { const bf16x8 bv = *(const LAS bf16x8*)(ldh + GL_VT + (16 * dvblk + fr) * GROWB + (32 * ks + 8 * fq) * 2);
#pragma unroll
            for (int i = 0; i < 4; ++i) { const bf16x8 av = *(const LAS bf16x8*)(ldh + GL_A + (16 * i + fr) * GROWB + (32 * ks + 8 * fq) * 2); acc[i] = __builtin_amdgcn_mfma_f32_16x16x32_bf16(av, bv, acc[i], 0, 0, 0); } }
#pragma unroll
        for (int i = 0; i < 4; ++i) *(f32x4*)(UT + ((size_t)it * 128 + 16 * dvblk + fr) * 64 + 16 * i + 4 * fq) = acc[i];
    }
}
__device__ __forceinline__ void p5b_pair(int p, const float* LGC, const float* ng, const bf16_t* SP, unsigned char* ws, LAS unsigned char* lds) {
    const int tid = threadIdx.x, hb = tid >> 8, tl = tid & 255, lane = tid & 63, wl = (tid >> 6) & 3, r32 = lane & 31, hh = lane >> 5;
    const int it = 2 * p + hb; LAS unsigned char* ldh = lds + hb * GL_HALF;
    const int bh = it >> 6, n = it & 63, b = bh >> 2, h = bh & 3; const size_t r0 = (size_t)b * NS + 64 * n;
    const int c_ = tl >> 2, dq_ = tl & 3; const int dvb = wl;
    f32x4 lg[4];
#pragma unroll
    for (int k = 0; k < 4; ++k) lg[k] = *(const f32x4*)(LGC + (size_t)it * 4096 + c_ * 64 + 16 * dq_ + 4 * k);
    const bf16_t* qp_ = (const bf16_t*)(ws + WS_GQK) + (r0 + c_) * 512 + h * 64 + 16 * dq_; const u32x4 q0 = *(const u32x4*)qp_, q1 = *(const u32x4*)(qp_ + 8), k0 = *(const u32x4*)(qp_ + 256), k1 = *(const u32x4*)(qp_ + 264);
    const bf16_t* vp_ = (const bf16_t*)(ws + WS_GV) + (r0 + c_) * 512 + h * 128 + 32 * dq_; u32x4 vv[4];
#pragma unroll
    for (int k = 0; k < 4; ++k) vv[k] = *(const u32x4*)(vp_ + 8 * k);
    bf16x8 spf[4];
#pragma unroll
    for (int ks = 0; ks < 4; ++ks) spf[ks] = *(const bf16x8*)(SP + ((size_t)it * 128 + 32 * dvb + r32) * 64 + 16 * ks + 8 * hh);
    const int dvbase = h * 128 + 32 * dvb + 4 * hh; u32x2 grw[2][4];
#pragma unroll
    for (int cb = 0; cb < 2; ++cb)
#pragma unroll
        for (int g = 0; g < 4; ++g) grw[cb][g] = *(const u32x2*)((const bf16_t*)(ws + WS_GR) + (r0 + 32 * cb + r32) * 512 + dvbase + 8 * g);
    __syncthreads();
    { LAS float* LGw = (LAS float*)(ldh + GL_LG);
#pragma unroll
      for (int k = 0; k < 4; ++k) *(LAS f32x4*)(LGw + c_ * 64 + 16 * dq_ + 4 * k) = lg[k]; }
    __syncthreads();
    const LAS float* LG = (const LAS float*)(ldh + GL_LG);
    {   float qf[16], kf[16]; bf8_to_f(q0, qf); bf8_to_f(q1, qf + 8); bf8_to_f(k0, kf); bf8_to_f(k1, kf + 8);
        float qr[16], ks[16], qi[16];
#pragma unroll
        for (int j = 0; j < 16; ++j) { const int d = 16 * dq_ + j; const float bc = LG[c_ * 64 + d], bl = LG[63 * 64 + d]; const float q8 = qf[j] * 0.125f;
            qr[j] = q8 * __expf(bc - bl); ks[j] = kf[j] * __expf(bl - bc); qi[j] = q8 * __expf(bc); }
#pragma unroll
        for (int k = 0; k < 2; ++k) { u32x4 w;
            w.x = cvtpk_s(qr[8 * k], qr[8 * k + 1]); w.y = cvtpk_s(qr[8 * k + 2], qr[8 * k + 3]); w.z = cvtpk_s(qr[8 * k + 4], qr[8 * k + 5]); w.w = cvtpk_s(qr[8 * k + 6], qr[8 * k + 7]); *(LAS u32x4*)(ldh + GL_A + c_ * GROWB + 32 * dq_ + 16 * k) = w;
            w.x = cvtpk_s(ks[8 * k], ks[8 * k + 1]); w.y = cvtpk_s(ks[8 * k + 2], ks[8 * k + 3]); w.z = cvtpk_s(ks[8 * k + 4], ks[8 * k + 5]); w.w = cvtpk_s(ks[8 * k + 6], ks[8 * k + 7]); *(LAS u32x4*)(ldh + GL_B + c_ * GROWB + 32 * dq_ + 16 * k) = w;
            w.x = cvtpk_s(qi[8 * k], qi[8 * k + 1]); w.y = cvtpk_s(qi[8 * k + 2], qi[8 * k + 3]); w.z = cvtpk_s(qi[8 * k + 4], qi[8 * k + 5]); w.w = cvtpk_s(qi[8 * k + 6], qi[8 * k + 7]); *(LAS u32x4*)(ldh + GL_C + c_ * GROWB + 32 * dq_ + 16 * k) = w; }
    }
    gla_stage_vt2(vv, ldh);
    __syncthreads();
    f32x16 o[2];
#pragma unroll
    for (int cb = 0; cb < 2; ++cb) {
#pragma unroll
        for (int i = 0; i < 16; ++i) o[cb][i] = 0.f;
#pragma unroll
        for (int jb = 0; jb < 2; ++jb) if (jb <= cb) {
            f32x16 at;
#pragma unroll
            for (int i = 0; i < 16; ++i) at[i] = 0.f;
#pragma unroll
            for (int ks = 0; ks < 4; ++ks) { const bf16x8 av = *(const LAS bf16x8*)(ldh + GL_B + (32 * jb + r32) * GROWB + 32 * ks + 16 * hh), bv = *(const LAS bf16x8*)(ldh + GL_A + (32 * cb + r32) * GROWB + 32 * ks + 16 * hh);
                at = __builtin_amdgcn_mfma_f32_32x32x16_bf16(av, bv, at, 0, 0, 0); }
            if (jb == cb) {
#pragma unroll
                for (int i = 0; i < 16; ++i) if (crow(i, hh) > r32) at[i] = 0.f; }
#pragma unroll
            for (int s2 = 0; s2 < 2; ++s2) {
                u32x4 pw; pw.x = cvtpk_s(at[8 * s2], at[8 * s2 + 1]); pw.y = cvtpk_s(at[8 * s2 + 2], at[8 * s2 + 3]); pw.z = cvtpk_s(at[8 * s2 + 4], at[8 * s2 + 5]); pw.w = cvtpk_s(at[8 * s2 + 6], at[8 * s2 + 7]);
                const LAS unsigned char* vp = ldh + GL_VT + (32 * dvb + r32) * GROWB + (32 * jb + 16 * s2 + 4 * hh) * 2;
                const u32x2 lo = *(const LAS u32x2*)vp, hi = *(const LAS u32x2*)(vp + 16);
                const u32x4 va = (u32x4){lo.x, lo.y, hi.x, hi.y};
                o[cb] = __builtin_amdgcn_mfma_f32_32x32x16_bf16(__builtin_bit_cast(bf16x8, va), __builtin_bit_cast(bf16x8, pw), o[cb], 0, 0, 0);
            }
        }
#pragma unroll
        for (int ks = 0; ks < 4; ++ks) { const bf16x8 bv = *(const LAS bf16x8*)(ldh + GL_C + (32 * cb + r32) * GROWB + 32 * ks + 16 * hh);
            o[cb] = __builtin_amdgcn_mfma_f32_32x32x16_bf16(spf[ks], bv, o[cb], 0, 0, 0); }
    }
    LAS float* ST = (LAS float*)(ldh + GL_ST);
#pragma unroll
    for (int cb = 0; cb < 2; ++cb) { float sm = 0.f;
#pragma unroll
        for (int i = 0; i < 16; ++i) sm += o[cb][i];
        sm += __shfl_xor(sm, 32);
        if (hh == 0) ST[dvb * 64 + 32 * cb + r32] = sm; }
    __syncthreads();
    float mean[2];
#pragma unroll
    for (int cb = 0; cb < 2; ++cb) { const int cc = 32 * cb + r32; mean[cb] = (ST[cc] + ST[64 + cc] + ST[128 + cc] + ST[192 + cc]) * (1.f / 128.f); float sq = 0.f;
#pragma unroll
        for (int i = 0; i < 16; ++i) { o[cb][i] -= mean[cb]; sq += o[cb][i] * o[cb][i]; }
        sq += __shfl_xor(sq, 32);
        if (hh == 0) ST[256 + dvb * 64 + cc] = sq; }
    __syncthreads();
#pragma unroll
    for (int cb = 0; cb < 2; ++cb) { const int cc = 32 * cb + r32; const float var = (ST[256 + cc] + ST[256 + 64 + cc] + ST[256 + 128 + cc] + ST[256 + 192 + cc]) * (1.f / 128.f);
        const float rstd = 1.f / sqrtf(var + LN_EPS);
        bf16_t* op = (bf16_t*)(ws + WS_OAB) + (r0 + cc) * 1024 + 512 + dvbase;
#pragma unroll
        for (int g = 0; g < 4; ++g) { const u32x2 gw = grw[cb][g]; const f32x4 nv = *(const f32x4*)(ng + dvbase + 8 * g);
            float gr[4] = {__uint_as_float(gw.x << 16), __uint_as_float(gw.x & 0xffff0000u), __uint_as_float(gw.y << 16), __uint_as_float(gw.y & 0xffff0000u)}; float y[4];
#pragma unroll
            for (int e = 0; e < 4; ++e) y[e] = o[cb][4 * g + e] * rstd * nv[e] * (gr[e] * __builtin_amdgcn_rcpf(1.f + __expf(-gr[e])));
            u32x2 w; w.x = cvtpk_s(y[0], y[1]); w.y = cvtpk_s(y[2], y[3]); *(u32x2*)(op + 8 * g) = w; } }
}

constexpr size_t WS_SG = 129 * MiB;
constexpr size_t WS_MRG = 257 * MiB;
constexpr size_t WS_H2 = WS_XN;
constexpr size_t WS_XG = 129 * MiB;
constexpr size_t WS_HID = 321 * MiB;
constexpr size_t WS_YG = 358 * MiB;
constexpr size_t WS_EID = WS_MISC + 1 * MiB, WS_EW = WS_EID + 256 * 1024, WS_POS = WS_EW + 256 * 1024, WS_ST1 = WS_POS + 256 * 1024;
constexpr size_t WS_LIST = 490 * MiB;
constexpr int LDS_TAB = 131072;
__device__ __forceinline__ u32x4 pack8(const f32x4 a, const f32x4 b) { u32x4 w; w.x = cvtpk_s(a[0], a[1]); w.y = cvtpk_s(a[2], a[3]); w.z = cvtpk_s(b[0], b[1]); w.w = cvtpk_s(b[2], b[3]); return w; }
__device__ __forceinline__ f32x4 sig4(const f32x4 v) { f32x4 r; r[0] = __builtin_amdgcn_rcpf(1.f + __expf(-v[0])); r[1] = __builtin_amdgcn_rcpf(1.f + __expf(-v[1])); r[2] = __builtin_amdgcn_rcpf(1.f + __expf(-v[2])); r[3] = __builtin_amdgcn_rcpf(1.f + __expf(-v[3])); return r; }
__device__ __forceinline__ void unpack8(const u32x4 w, f32x4& a, f32x4& b) {
    a[0] = __uint_as_float(w.x << 16); a[1] = __uint_as_float(w.x & 0xffff0000u); a[2] = __uint_as_float(w.y << 16); a[3] = __uint_as_float(w.y & 0xffff0000u);
    b[0] = __uint_as_float(w.z << 16); b[1] = __uint_as_float(w.z & 0xffff0000u); b[2] = __uint_as_float(w.w << 16); b[3] = __uint_as_float(w.w & 0xffff0000u);
}
#define EPI_ROWS(...) _Pragma("unroll") for (int ai = 0; ai < 2; ++ai) _Pragma("unroll") for (int m = 0; m < 4; ++m) { const size_t row = (size_t)(row0 + ai * 128 + m * 16); _Pragma("unroll") for (int bj = 0; bj < 2; ++bj) { __VA_ARGS__ } }
struct EpiSig {
    static constexpr bool PERM = true, AFTER_DRAIN = false, MID = false; unsigned char* ws; int half;
    __device__ __forceinline__ void operator()(const f32x4 (&acc)[2][2][4][2], const Unit& u, int wr, int wc, int fr, int fq) const {
        const int row0 = u.pm * 256 + wr * 64 + fr, col0 = half * 1024 + u.pn * 256 + wc * 32 + 8 * fq; bf16_t* SG = (bf16_t*)(ws + WS_SG);
        EPI_ROWS( *(u32x4*)(SG + row * 2048 + col0 + bj * 128) = pack8(sig4(acc[ai][bj][m][0]), sig4(acc[ai][bj][m][1])); )
    }
};
struct EpiMrgF {
    static constexpr bool PERM = true, AFTER_DRAIN = false, MID = true; unsigned char* ws;
    __device__ __forceinline__ void mid(f32x4 (&acc)[2][2][4][2], const Unit& u, int wr, int wc, int fr, int fq) const {
        const int row0 = u.pm * 256 + wr * 64 + fr, col0 = u.pn * 256 + wc * 32 + 8 * fq; const bf16_t* SG = (const bf16_t*)(ws + WS_SG);
        const bf16_t* p = SG + (size_t)row0 * 2048 + col0;
#pragma unroll
        for (int ai = 0; ai < 2; ++ai)
#pragma unroll
            for (int mp = 0; mp < 4; mp += 2) {
                asm volatile("" : "+v"(p));
                u32x4 ga[2][2], gb[2][2];
#pragma unroll
                for (int mm = 0; mm < 2; ++mm)
#pragma unroll
                    for (int bj = 0; bj < 2; ++bj) { ga[mm][bj] = *(const u32x4*)(p + (size_t)mm * 16 * 2048 + bj * 128); gb[mm][bj] = *(const u32x4*)(p + (size_t)mm * 16 * 2048 + 1024 + bj * 128); }
#pragma unroll
                for (int mm = 0; mm < 2; ++mm)
#pragma unroll
                    for (int bj = 0; bj < 2; ++bj) { f32x4 a0, a1, b0, b1; unpack8(ga[mm][bj], a0, a1); unpack8(gb[mm][bj], b0, b1);
#pragma unroll
                        for (int e = 0; e < 4; ++e) { acc[ai][bj][mp + mm][0][e] *= a0[e] * __builtin_amdgcn_rcpf(fmaxf(b0[e], 1e-30f)); acc[ai][bj][mp + mm][1][e] *= a1[e] * __builtin_amdgcn_rcpf(fmaxf(b1[e], 1e-30f)); } }
                p += (mp == 2 ? (128 - 32) : 32) * 2048; }
    }
    __device__ __forceinline__ void operator()(const f32x4 (&acc)[2][2][4][2], const Unit& u, int wr, int wc, int fr, int fq) const {
        const int row0 = u.pm * 256 + wr * 64 + fr, col0 = u.pn * 256 + wc * 32 + 8 * fq; const bf16_t* SG = (const bf16_t*)(ws + WS_SG) + 1024; bf16_t* MR = (bf16_t*)(ws + WS_MRG);
        u32x4 g[2][4][2];
#pragma unroll
        for (int ai = 0; ai < 2; ++ai)
#pragma unroll
            for (int m = 0; m < 4; ++m)
#pragma unroll
                for (int bj = 0; bj < 2; ++bj) g[ai][m][bj] = *(const u32x4*)(SG + (size_t)(row0 + ai * 128 + m * 16) * 2048 + col0 + bj * 128);
        EPI_ROWS( f32x4 g0, g1; unpack8(g[ai][m][bj], g0, g1); *(u32x4*)(MR + row * 1024 + col0 + bj * 128) = pack8(g0 * acc[ai][bj][m][0], g1 * acc[ai][bj][m][1]); )
    }
};
constexpr size_t WS_VB = 129 * MiB;
struct EpiV {
    static constexpr bool PERM = true, AFTER_DRAIN = false, MID = false; const float* x; const float* ada; bf16_t* out;
    __device__ __forceinline__ void operator()(const f32x4 (&acc)[2][2][4][2], const Unit& u, int wr, int wc, int fr, int fq) const {
        const int row0 = u.pm * 256 + wr * 64 + fr, col0 = u.pn * 256 + wc * 32 + 8 * fq; const float* gt1 = ada + (size_t)(u.pm >> 4) * 6 * D_MODEL + 2 * D_MODEL;
        EPI_ROWS( const int c = col0 + bj * 128; const f32x4 x0 = *(const f32x4*)(x + row * D_MODEL + c), x1 = *(const f32x4*)(x + row * D_MODEL + c + 4), g0 = *(const f32x4*)(gt1 + c), g1 = *(const f32x4*)(gt1 + c + 4);
                  *(u32x4*)(out + row * D_MODEL + c) = pack8(x0 * DN_ALPHA + g0 * acc[ai][bj][m][0], x1 * DN_ALPHA + g1 * acc[ai][bj][m][1]); )
    }
};
struct EpiHid {
    static constexpr bool PERM = true, AFTER_DRAIN = false, MID = false; unsigned char* ws;
    __device__ __forceinline__ void operator()(const f32x4 (&acc)[2][2][4][2], const Unit& u, int wr, int wc, int fr, int fq) const {
        const int row0 = u.pm * 256 + wr * 64 + fr, col0 = u.pn * 128 + wc * 32 + 8 * fq; bf16_t* H = (bf16_t*)(ws + WS_HID);
#pragma unroll
        for (int ai = 0; ai < 2; ++ai)
#pragma unroll
            for (int m = 0; m < 4; ++m) { const size_t row = (size_t)(row0 + ai * 128 + m * 16); f32x4 h0, h1;
#pragma unroll
                for (int e = 0; e < 4; ++e) { const float g0 = acc[ai][0][m][0][e], g1 = acc[ai][0][m][1][e]; h0[e] = g0 * __builtin_amdgcn_rcpf(1.f + __expf(-g0)) * acc[ai][1][m][0][e]; h1[e] = g1 * __builtin_amdgcn_rcpf(1.f + __expf(-g1)) * acc[ai][1][m][1][e]; }
                *(u32x4*)(H + row * 256 + col0) = pack8(h0, h1); }
    }
};
struct EpiY {
    static constexpr bool PERM = true, AFTER_DRAIN = false, MID = false; unsigned char* ws;
    __device__ __forceinline__ void operator()(const f32x4 (&acc)[2][2][4][2], const Unit& u, int wr, int wc, int fr, int fq) const {
        const int row0 = u.pm * 256 + wr * 64 + fr, col0 = u.pn * 256 + wc * 32 + 8 * fq; bf16_t* Y = (bf16_t*)(ws + WS_YG);
        EPI_ROWS( *(u32x4*)(Y + row * 1024 + col0 + bj * 128) = pack8(acc[ai][bj][m][0], acc[ai][bj][m][1]); )
    }
};
__device__ __forceinline__ void build_tables(unsigned char* ws, LAS unsigned char* lds) {
    LAS int* toff = (LAS int*)(lds + LDS_TAB); LAS int* texp = toff + 64; const unsigned* gcnt = (const unsigned*)(ws + WS_CNT);
    __syncthreads();
    if (threadIdx.x < 64) {
        const int l = threadIdx.x; const int ce = l < N_EXP ? (int)gcnt[l * 32] : 0; const int te = (ce + 255) >> 8; int inc = te;
#pragma unroll
        for (int d = 1; d < 32; d <<= 1) { const int v = __shfl_up(inc, d); if (l >= d) inc += v; }
        if (l < N_EXP) { toff[l] = inc - te; toff[400 + l] = ce; }
        if (l == N_EXP - 1) toff[32] = inc; }
    __syncthreads();
    for (int tl = threadIdx.x; tl < toff[32]; tl += NTHREADS) { int e = 0;
#pragma unroll
        for (int d = 16; d >= 1; d >>= 1) if (toff[e + d] <= tl) e += d;
        texp[tl] = e; }
    __syncthreads();
}
template <int NPN> struct GroupOrder {
    const LAS int* toff; const LAS int* texp; int G, c;
    __device__ __forceinline__ bool next(int i, Unit& u) const { const int L = i * G + c; if (L >= toff[32] * NPN) return false; const int tl = L / NPN, pn = L % NPN; u.pm = tl; u.pa = tl; u.pn = pn; u.pb = texp[tl] * NPN + pn; return true; }
    __device__ __forceinline__ void a_ready(const Unit&) const {}
    __device__ __forceinline__ void done(const Unit&) const {}
    const int* list;
    __device__ __forceinline__ int a_row(const Unit& u, int r) const { const int e = texp[u.pa]; const int idx = (u.pa - toff[e]) * 256 + r; return idx < toff[400 + e] ? list[e * 32768 + idx] : 0; }
};
constexpr int WT_LD = 1028;
constexpr int P8_LCNT = 36 * WT_LD * 4;
__device__ __forceinline__ float dot16(const f32x4 (&v)[4], const LAS float* wp, int lane) {
    typedef float f32x2p __attribute__((ext_vector_type(2)));
    f32x2p acc = (f32x2p){0.f, 0.f};
#pragma unroll
    for (int j = 0; j < 4; ++j) { const f32x4 w4 = *(const LAS f32x4*)(wp + 256 * j + 4 * lane);
        acc = __builtin_elementwise_fma((f32x2p){v[j].x, v[j].y}, (f32x2p){w4.x, w4.y}, acc);
        acc = __builtin_elementwise_fma((f32x2p){v[j].z, v[j].w}, (f32x2p){w4.z, w4.w}, acc); }
    return acc.x + acc.y;
}
#define RDPP(v, ctrl) __int_as_float(__builtin_amdgcn_update_dpp(0, __float_as_int(v), ctrl, 0xF, 0xF, true))
__device__ __forceinline__ float red_tail(float r) {
    r += RDPP(r, 0x124); r += RDPP(r, 0x128);
    r += __shfl_xor(r, 16);
    { const auto rr = __builtin_amdgcn_permlane32_swap(__float_as_uint(r), __float_as_uint(r), false, false); r = __uint_as_float(rr[0]) + __uint_as_float(rr[1]); }
    return r;
}
#define RLF(v, l) __int_as_float(__builtin_amdgcn_readlane(__float_as_int(v), l))
__device__ __forceinline__ void reduce4(const float (&p)[4], int lane, float (&out)[4]) {
    const bool b0 = lane & 1, b1 = lane & 2;
    float k0 = b0 ? p[2] : p[0], k1 = b0 ? p[3] : p[1]; const float s0 = b0 ? p[0] : p[2], s1 = b0 ? p[1] : p[3];
    k0 += RDPP(s0, 0xB1); k1 += RDPP(s1, 0xB1);
    float k = b1 ? k1 : k0; const float s = b1 ? k0 : k1;
    k += RDPP(s, 0x4E);
    k = red_tail(k);
    out[0] = RLF(k, 0); out[1] = RLF(k, 2); out[2] = RLF(k, 1); out[3] = RLF(k, 3);
}
__device__ __forceinline__ void reduce8(const float (&p)[8], int lane, float (&out)[8]) {
    const bool b0 = lane & 1, b1 = lane & 2; float q[4];
#pragma unroll
    for (int i = 0; i < 4; ++i) { const float keep = b0 ? p[4 + i] : p[i], send = b0 ? p[i] : p[4 + i]; q[i] = keep + RDPP(send, 0xB1); }
    float k0 = b1 ? q[2] : q[0], k1 = b1 ? q[3] : q[1]; const float s0 = b1 ? q[0] : q[2], s1 = b1 ? q[1] : q[3];
    k0 += RDPP(s0, 0x4E); k1 += RDPP(s1, 0x4E);
    k0 = red_tail(k0); k1 = red_tail(k1);
    out[0] = RLF(k0, 0); out[1] = RLF(k1, 0); out[2] = RLF(k0, 2); out[3] = RLF(k1, 2); out[4] = RLF(k0, 1); out[5] = RLF(k1, 1); out[6] = RLF(k0, 3); out[7] = RLF(k1, 3);
}
__device__ __forceinline__ float rl4sum(float v) {
    return (__int_as_float(__builtin_amdgcn_readlane(__float_as_int(v), 0)) + __int_as_float(__builtin_amdgcn_readlane(__float_as_int(v), 16)))
         + (__int_as_float(__builtin_amdgcn_readlane(__float_as_int(v), 32)) + __int_as_float(__builtin_amdgcn_readlane(__float_as_int(v), 48)));
}
template <bool REAL> __device__ __forceinline__ void p8_phase(const float* const* in, const bf16_t* vsrc, float* x1dst, bf16_t* h2dst, unsigned char* ws, LAS unsigned char* lds, int G) {
    const int tid = threadIdx.x, lane = tid & 63, wave = tid >> 6;
    LAS float* WT = (LAS float*)lds;
    LAS int* lcnt = (LAS int*)(lds + P8_LCNT); LAS int* lbase = lcnt + 32; LAS int* ent = lcnt + 64;
    const float* wrg = in[14]; const float* wre = in[16];
    __syncthreads();
#define P8POS(k) (256 * (2 * ((k) >> 9) + (((k) >> 2) & 1)) + 4 * (((k) & 511) >> 3) + ((k) & 3))
#define COLW8(j) (512 * ((j) >> 1) + 8 * lane + 4 * ((j) & 1))
    {   f32x4 wq[18];
#pragma unroll
        for (int q = 0; q < 2; ++q) wq[q] = *(const f32x4*)(wrg + 4 * (tid + q * NTHREADS));
#pragma unroll
        for (int q = 0; q < 16; ++q) wq[2 + q] = *(const f32x4*)(wre + 4 * (tid + q * NTHREADS));
#pragma unroll
        for (int q = 0; q < 2; ++q) { const int i = tid + q * NTHREADS; const f32x4 w = wq[q]; const int p = P8POS(i); WT[0 * WT_LD + p] = w.x; WT[1 * WT_LD + p] = w.y; WT[2 * WT_LD + p] = w.z; WT[3 * WT_LD + p] = w.w; }
#pragma unroll
        for (int q = 0; q < 16; ++q) { const int i = tid + q * NTHREADS; const f32x4 w = wq[2 + q]; const int k = P8POS(i >> 3), c = 4 * (i & 7);
            WT[(4 + c) * WT_LD + k] = w.x; WT[(5 + c) * WT_LD + k] = w.y; WT[(6 + c) * WT_LD + k] = w.z; WT[(7 + c) * WT_LD + k] = w.w; } }
    const float* g1 = in[12]; const float* b1 = in[13];
    LAS float* BIAS = (LAS float*)(lds + P8_LCNT + 1280);
    if (tid < 4) BIAS[tid] = in[15][tid]; else if (tid < 36) BIAS[tid] = in[17][tid - 4];
    for (int blk = blockIdx.x; blk < NT / 128; blk += G) {
        const int b = blk / 32; const float* ada = (const float*)(ws + WS_ADA) + (size_t)b * 6 * D_MODEL; const float* sh2 = ada + 3 * D_MODEL; const float* sc2 = ada + 4 * D_MODEL;
        if (tid < 32) lcnt[tid] = 0;
        __syncthreads();
        for (int rb = 0; rb < 16; rb += 4) {
            const int rl0 = wave * 16 + rb; const size_t row0 = (size_t)blk * 128 + rl0;
            f32x4 v[4][4];
#pragma unroll
            for (int r = 0; r < 4; ++r) { const u32x4* xr = (const u32x4*)(vsrc + (row0 + r) * D_MODEL) + lane;
#pragma unroll
                for (int q = 0; q < 2; ++q) unpack8(xr[64 * q], v[r][2 * q], v[r][2 * q + 1]); }
            float rstd[4], mean1[4]; ln_center<4>(v, rstd, mean1);
            if (REAL && lane < 4) { typedef float f32x2v __attribute__((ext_vector_type(2))); ((f32x2v*)(ws + WS_ST1))[row0 + lane] = (f32x2v){lane == 0 ? mean1[0] : lane == 1 ? mean1[1] : lane == 2 ? mean1[2] : mean1[3], lane == 0 ? rstd[0] : lane == 1 ? rstd[1] : lane == 2 ? rstd[2] : rstd[3]}; }
#pragma unroll
            for (int j = 0; j < 4; ++j) { const f32x4 gg = *(const f32x4*)(g1 + COLW8(j)), bb = *(const f32x4*)(b1 + COLW8(j));
#pragma unroll
                for (int r = 0; r < 4; ++r) v[r][j] = v[r][j] * rstd[r] * gg + bb; }
            ln_center<4>(v, rstd);
#pragma unroll
            for (int j = 0; j < 4; ++j) { const f32x4 a4 = *(const f32x4*)(sc2 + COLW8(j)) + 1.f, c4 = *(const f32x4*)(sh2 + COLW8(j));
#pragma unroll
                for (int r = 0; r < 4; ++r) v[r][j] = v[r][j] * rstd[r] * a4 + c4; }
#pragma unroll
            for (int r = 0; r < 4; ++r)
#pragma unroll
                for (int q = 0; q < 2; ++q) ((u32x4*)(h2dst + (row0 + r) * D_MODEL) + lane)[64 * q] = pack8(v[r][2 * q], v[r][2 * q + 1]);
            float rw0[4], rw1[4]; int rea[4], reb[4];
#pragma unroll
            for (int r = 0; r < 4; ++r) {
                float gp[N_GROUPS];
#pragma unroll
                for (int g = 0; g < N_GROUPS; ++g) gp[g] = dot16(v[r], WT + g * WT_LD, lane);
                float gl[N_GROUPS]; reduce4(gp, lane, gl);
#pragma unroll
                for (int g = 0; g < N_GROUPS; ++g) gl[g] += BIAS[g];
                int gi = 0; float gm = gl[0];
#pragma unroll
                for (int g = 1; g < N_GROUPS; ++g) if (gl[g] > gm) { gm = gl[g]; gi = g; }
                float gs = 0.f;
#pragma unroll
                for (int g = 0; g < N_GROUPS; ++g) gs += __expf(gl[g] - gm);
                const float gw = __builtin_amdgcn_rcpf(gs);
                float ep[EPG];
#pragma unroll
                for (int e = 0; e < EPG; ++e) ep[e] = dot16(v[r], WT + (4 + gi * EPG + e) * WT_LD, lane);
                float et[EPG]; reduce8(ep, lane, et);
                float v0 = -INFINITY, v1 = -INFINITY; int i0 = 0, i1 = 0;
#pragma unroll
                for (int e = 0; e < EPG; ++e) { const float ev = et[e] + BIAS[4 + gi * EPG + e];
                    if (ev > v0) { v1 = v0; i1 = i0; v0 = ev; i0 = e; } else if (ev > v1) { v1 = ev; i1 = e; } }
                const float e1 = __expf(v1 - v0); const float w0 = gw * __builtin_amdgcn_rcpf(1.f + e1); rw0[r] = w0; rw1[r] = w0 * e1; rea[r] = gi * EPG + i0; reb[r] = gi * EPG + i1;
            }
#pragma unroll
            for (int r = 0; r < 4; ++r)
                if (REAL && lane == 0) { const int ea = rea[r], eb = reb[r]; const int rl = rl0 + r; const size_t row = row0 + r;
                    const int pa = atomicAdd((int*)&lcnt[ea], 1), pb = atomicAdd((int*)&lcnt[eb], 1);
                    ent[rl * 2] = (ea << 16) | pa; ent[rl * 2 + 1] = (eb << 16) | pb;
                    ((int*)(ws + WS_EID))[row * 2] = ea; ((int*)(ws + WS_EID))[row * 2 + 1] = eb; ((float*)(ws + WS_EW))[row * 2] = rw0[r]; ((float*)(ws + WS_EW))[row * 2 + 1] = rw1[r]; }
        }
        __syncthreads();
        if (REAL && tid < 32) lbase[tid] = (int)atomicAdd((unsigned*)(ws + WS_CNT) + tid * 32, (unsigned)lcnt[tid]);
        __syncthreads();
        if (REAL && tid < 256) { const int en = ent[tid]; const int e = en >> 16, pos = lbase[e] + (en & 0xffff); ((int*)(ws + WS_POS))[(size_t)blk * 256 + tid] = pos; ((int*)(ws + WS_LIST))[e * 32768 + pos] = blk * 128 + (tid >> 1); }
        __syncthreads();
    }
}
__device__ __forceinline__ void p9_phase(unsigned char* ws, LAS unsigned char* lds, int G) {
    build_tables(ws, lds); const LAS int* toff = (const LAS int*)(lds + LDS_TAB);
    const int lane = threadIdx.x & 63, wave = threadIdx.x >> 6;
    for (int base = (blockIdx.x * NWAVES + wave) * 32; base < NT * 2; base += G * NWAVES * 32) {
        for (int k = 0; k < 32; k += 4) {
            const int ts0 = base + k; const int li = ts0 + (lane & 3);
            const int ev = ((const int*)(ws + WS_EID))[li], pv = ((const int*)(ws + WS_POS))[li];
            u32x4 d0[4], d1[4]; size_t dst[4];
#pragma unroll
            for (int r = 0; r < 4; ++r) { const int e = __builtin_amdgcn_readlane(ev, r), pos = __builtin_amdgcn_readlane(pv, r); dst[r] = (size_t)toff[e] * 256 + pos;
                const u32x4* sp = (const u32x4*)((const bf16_t*)(ws + WS_H2) + (size_t)((ts0 + r) >> 1) * D_MODEL); d0[r] = sp[lane]; d1[r] = sp[lane + 64]; }
#pragma unroll
            for (int r = 0; r < 4; ++r) { u32x4* dp = (u32x4*)((bf16_t*)(ws + WS_XG) + dst[r] * D_MODEL); dp[lane] = d0[r]; dp[lane + 64] = d1[r]; }
        }
    }
}
__device__ __forceinline__ void pair_split(const u32x4 o, bool odd, u32x2& lo, u32x2& hi) {
    const unsigned gx = odd ? o.x : o.z, gy = odd ? o.y : o.w;
    const unsigned tx = (unsigned)__builtin_amdgcn_update_dpp(0, (int)gx, 0xB1, 0xF, 0xF, true), ty = (unsigned)__builtin_amdgcn_update_dpp(0, (int)gy, 0xB1, 0xF, 0xF, true);
    lo.x = odd ? tx : o.x; lo.y = odd ? ty : o.y; hi.x = odd ? o.z : tx; hi.y = odd ? o.w : ty;
}
__device__ __forceinline__ void p12_phase(const float* const* in, const bf16_t* vsrc, float* dst, unsigned char* ws, LAS unsigned char* lds, int G) {
    build_tables(ws, lds); const LAS int* toff = (const LAS int*)(lds + LDS_TAB);
    const int lane = threadIdx.x & 63, wave = threadIdx.x >> 6; const float* g2 = in[21]; const float* b2 = in[22]; const float* g1 = in[12]; const float* b1 = in[13];
    for (int blk = blockIdx.x; blk < NT / 128; blk += G) {
        const int b = blk / 32; const float* gt2 = (const float*)(ws + WS_ADA) + (size_t)b * 6 * D_MODEL + 5 * D_MODEL;
        LAS int* YR = (LAS int*)lds; LAS float* WV = (LAS float*)(lds + 1024); typedef float f32x2v __attribute__((ext_vector_type(2))); LAS f32x2v* STL = (LAS f32x2v*)(lds + 2048);
        __syncthreads();
        { const int tid = threadIdx.x;
          if (tid < 256) { const size_t li = (size_t)blk * 256 + tid; const int ev = ((const int*)(ws + WS_EID))[li], pv = ((const int*)(ws + WS_POS))[li]; WV[tid] = ((const float*)(ws + WS_EW))[li]; YR[tid] = toff[ev] * 256 + pv; }
          else if (tid < 384) STL[tid - 256] = ((const f32x2v*)(ws + WS_ST1))[(size_t)blk * 128 + (tid - 256)]; }
        __syncthreads();
        for (int rb = 0; rb < 16; rb += 4) {
            const size_t row0 = (size_t)blk * 128 + wave * 16 + rb;
            f32x4 v[4][4]; u32x2 ya[4][4], yb[4][4]; float w0[4], w1[4], m1[4], r1[4];
#pragma unroll
            for (int r = 0; r < 4; ++r) {
                const int rl = wave * 16 + rb + r;
                const int q0 = __builtin_amdgcn_readfirstlane(YR[2 * rl]), q1 = __builtin_amdgcn_readfirstlane(YR[2 * rl + 1]);
                w0[r] = __int_as_float(__builtin_amdgcn_readfirstlane(__float_as_int(WV[2 * rl]))); w1[r] = __int_as_float(__builtin_amdgcn_readfirstlane(__float_as_int(WV[2 * rl + 1])));
                { const f32x2v st = STL[rl]; m1[r] = __int_as_float(__builtin_amdgcn_readfirstlane(__float_as_int(st.x))); r1[r] = __int_as_float(__builtin_amdgcn_readfirstlane(__float_as_int(st.y))); }
                const bf16_t* y0 = (const bf16_t*)(ws + WS_YG) + (size_t)q0 * D_MODEL; const bf16_t* y1 = (const bf16_t*)(ws + WS_YG) + (size_t)q1 * D_MODEL;
                const u32x4* xr = (const u32x4*)(vsrc + (row0 + r) * D_MODEL);
#pragma unroll
                for (int jp = 0; jp < 4; jp += 2) { const int idx = 32 * (jp + (lane & 1)) + (lane >> 1); u32x2 lo, hi;
                    pair_split(xr[idx], lane & 1, lo, hi); v[r][jp] = (f32x4){__uint_as_float(lo.x << 16), __uint_as_float(lo.x & 0xffff0000u), __uint_as_float(lo.y << 16), __uint_as_float(lo.y & 0xffff0000u)};
                    v[r][jp + 1] = (f32x4){__uint_as_float(hi.x << 16), __uint_as_float(hi.x & 0xffff0000u), __uint_as_float(hi.y << 16), __uint_as_float(hi.y & 0xffff0000u)};
                    pair_split(((const u32x4*)y0)[idx], lane & 1, ya[r][jp], ya[r][jp + 1]); pair_split(((const u32x4*)y1)[idx], lane & 1, yb[r][jp], yb[r][jp + 1]); } }
#pragma unroll
            for (int j = 0; j < 4; ++j) { const f32x4 gv = *(const f32x4*)(gt2 + 256 * j + 4 * lane), g1v = *(const f32x4*)(g1 + 256 * j + 4 * lane), b1v = *(const f32x4*)(b1 + 256 * j + 4 * lane);
#pragma unroll
                for (int r = 0; r < 4; ++r) { const u32x2 a = ya[r][j], c = yb[r][j]; f32x4 f; v[r][j] = (v[r][j] - m1[r]) * r1[r] * g1v + b1v;
                    f.x = w0[r] * __uint_as_float(a.x << 16) + w1[r] * __uint_as_float(c.x << 16); f.y = w0[r] * __uint_as_float(a.x & 0xffff0000u) + w1[r] * __uint_as_float(c.x & 0xffff0000u);
                    f.z = w0[r] * __uint_as_float(a.y << 16) + w1[r] * __uint_as_float(c.y << 16); f.w = w0[r] * __uint_as_float(a.y & 0xffff0000u) + w1[r] * __uint_as_float(c.y & 0xffff0000u);
                    v[r][j] = v[r][j] * DN_ALPHA + gv * f; } }
            float rstd[4]; ln_center<4>(v, rstd);
#pragma unroll
            for (int j = 0; j < 4; ++j) { const f32x4 gg = *(const f32x4*)(g2 + 256 * j + 4 * lane), bb = *(const f32x4*)(b2 + 256 * j + 4 * lane);
#pragma unroll
                for (int r = 0; r < 4; ++r) ((f32x4*)(dst + (row0 + r) * D_MODEL) + lane)[64 * j] = v[r][j] * rstd[r] * gg + bb; }
        }
    }
}

constexpr size_t WS_TS = 384 * 1024;
constexpr size_t WS_DEAD = 392 * 1024;
constexpr size_t WS_BAR = 320 * 1024;
#define RLX_AGENT __ATOMIC_RELAXED, __HIP_MEMORY_SCOPE_AGENT
#define XB_TMO      128
#define XB_XCNT(j)  (256  + 64 * (j))
#define XB_XSUB(j)  (1280 + 64 * (j))
#define XB_XGEN(j)  (2304 + 64 * (j))
#define XB_TOP      3328
#define XB_TOPGEN   3392
#define XCD_BAR_WORDS 3456
#define XB_SPIN_CAP (1u << 18)

__device__ __forceinline__ unsigned xb_ld(unsigned* p)              { return __hip_atomic_load(p, __ATOMIC_RELAXED, __HIP_MEMORY_SCOPE_AGENT); }
__device__ __forceinline__ unsigned xb_add(unsigned* p, unsigned v) { return __hip_atomic_fetch_add(p, v, __ATOMIC_RELAXED, __HIP_MEMORY_SCOPE_AGENT); }
__device__ __forceinline__ unsigned xb_xcc_id() { return (unsigned)__builtin_amdgcn_s_getreg((3 << 11) | 20) & 0xFu; }
#define XB_SPIN(cond, bar) do { unsigned _sp = 0; while (cond) { __builtin_amdgcn_s_sleep(1); \
    if ((++_sp & 255u) == 0u) { if (xb_ld(&(bar)[XB_TMO])) break; if (_sp > XB_SPIN_CAP) { atomicAdd(&(bar)[XB_TMO], 1u); break; } } } } while (0)

struct XcdBarrier {
    unsigned* bar; unsigned x;
    volatile LAS unsigned* st;
};

__device__ __forceinline__ XcdBarrier xcd_barrier_post(unsigned* bar, volatile LAS unsigned* st) {
    XcdBarrier b; b.bar = bar; b.x = xb_xcc_id(); b.st = st;
    if (threadIdx.x == 0) (void)xb_add(&bar[XB_XCNT(b.x)], 1u);
    return b;
}
__device__ __forceinline__ void xcd_barrier_complete(unsigned* bar, unsigned x, unsigned& nloc, unsigned& nx) {
    const unsigned G = gridDim.x * gridDim.y * gridDim.z;
    unsigned sum, cnt, mine, sp = 0u;
    for (;;) {
        sum = 0u; cnt = 0u; mine = 0u;
#pragma unroll
        for (unsigned j = 0; j < 16; ++j) { const unsigned c = xb_ld(&bar[XB_XCNT(j)]); sum += c; cnt += (c > 0u) ? 1u : 0u; mine = (j == x) ? c : mine; }
        if (sum == G) break;
        __builtin_amdgcn_s_sleep(1);
        if ((++sp & 255u) == 0u) { if (xb_ld(&bar[XB_TMO])) break; if (sp > XB_SPIN_CAP) { atomicAdd(&bar[XB_TMO], 1u); break; } }
    }
    nloc = mine > 0u ? mine : 1u; nx = cnt > 0u ? cnt : 1u;
}

__device__ __forceinline__ void xcd_barrier(const XcdBarrier& b) {
    asm volatile("s_waitcnt vmcnt(0)" ::: "memory");
    __syncthreads();
    if (threadIdx.x == 0) {
        unsigned* bar = b.bar;
        __builtin_amdgcn_s_waitcnt(0);
        unsigned nloc = b.st[0], nx = b.st[1];
        if (nloc == 0u) { xcd_barrier_complete(bar, b.x, nloc, nx); b.st[0] = nloc; b.st[1] = nx; }
        const unsigned old = xb_add(&bar[XB_XSUB(b.x)], 1u);
        const unsigned gen = old / nloc;
        if (old + 1u == (gen + 1u) * nloc) {
            __builtin_amdgcn_fence(__ATOMIC_RELEASE, "agent");
            asm volatile("s_waitcnt vmcnt(0)" ::: "memory");
            const unsigned og = xb_add(&bar[XB_TOP], 1u);
            const unsigned tg = og / nx;
            if (og + 1u == (tg + 1u) * nx) xb_add(&bar[XB_TOPGEN], 1u);
            else XB_SPIN(xb_ld(&bar[XB_TOPGEN]) == tg, bar);
            __builtin_amdgcn_fence(__ATOMIC_ACQUIRE, "agent");
            xb_add(&bar[XB_XGEN(b.x)], 1u);
            asm volatile("s_waitcnt vmcnt(0)" ::: "memory");
        } else {
            XB_SPIN(xb_ld(&bar[XB_XGEN(b.x)]) == gen, bar);
            __builtin_amdgcn_fence(__ATOMIC_ACQUIRE, "agent");
            asm volatile("s_waitcnt vmcnt(0)" ::: "memory");
        }
    }
    __syncthreads();
}

__device__ __forceinline__ int opaque_i(int v) {
#if DUPMASK_ON
    asm volatile("" : "+v"(v)); v = __builtin_amdgcn_readfirstlane(v);
#endif
    return v; }
constexpr int NPH = 14;
struct Args { const float* in[23]; float* out; unsigned char* ws; int ph_lo, ph_hi; };
__global__ void __launch_bounds__(NTHREADS, 2) mk_fwd(Args a) {
    extern __shared__ __attribute__((aligned(16))) unsigned char lds_raw[];
    LAS unsigned char* lds = (LAS unsigned char*)lds_raw;
    cg::grid_group grid = cg::this_grid();
    const int G = gridDim.x, tid = threadIdx.x, lane = tid & 63, wave = __builtin_amdgcn_readfirstlane(tid >> 6);
    const int lo = a.ph_lo, hi = a.ph_hi;
    unsigned char* ws = a.ws;
    volatile LAS unsigned* bst = (volatile LAS unsigned*)(lds + LDS_BYTES - 16);
    if (tid < 4) bst[tid] = 0u;
    __syncthreads();
    XcdBarrier bar = xcd_barrier_post((unsigned*)(ws + WS_BAR), bst);
    if (TSTAMP && blockIdx.x == 0 && tid == 0) ((unsigned long long*)(ws + WS_TS))[0] = __builtin_amdgcn_s_memrealtime();
    if (a.ph_hi > NPH) grid.sync();
#ifndef PHMASK
#define PHMASK 0xFFFF
#endif
#define IN(k) (((PHMASK >> (k)) & 1) && lo <= (k) && (k) < hi)
#define GRIDBAR() do { if (USE_CG_SYNC) grid.sync(); else xcd_barrier(bar); } while (0)
#define SEAM(k) do { if (IN(k) && IN((k) + 1)) GRIDBAR(); if (TSTAMP && blockIdx.x == 0 && tid == 0) ((unsigned long long*)(ws + WS_TS))[(k) + 1] = __builtin_amdgcn_s_memrealtime(); } while (0)
#define PH(k) for (int rep_ = 0; rep_ < (IN(k) ? 1 + ((DUPMASK >> (k)) & 1) : 0); ++rep_) if (rep_ > 0 && (xcd_barrier(bar), false)) {} else
    PH(0) {
        if (blockIdx.x == 0 && tid < 32) ((unsigned*)(ws + WS_CNT))[tid * 32] = 0u;
        if (blockIdx.x == 2 && tid < 64) ((unsigned*)(ws + WS_DEAD))[tid] = (unsigned)((tid & 15) << 6) * 0x00010001u;
        if (blockIdx.x == 1 && tid < 256) { const float* wgp = a.in[6] + tid; u32x4 w0, w1;
            w0.x = cvtpk_s(wgp[0], wgp[256]); w0.y = cvtpk_s(wgp[512], wgp[768]); w0.z = cvtpk_s(wgp[1024], wgp[1280]); w0.w = cvtpk_s(wgp[1536], wgp[1792]);
            w1.x = cvtpk_s(wgp[2048], wgp[2304]); w1.y = cvtpk_s(wgp[2560], wgp[2816]); w1.z = cvtpk_s(wgp[3072], wgp[3328]); w1.w = cvtpk_s(wgp[3584], wgp[3840]);
            u32x4* dst = (u32x4*)((bf16_t*)(ws + WS_WGT) + tid * 16); dst[0] = w0; dst[1] = w1; }
        LAS float* scr = (LAS float*)(lds + wave * 16384);
        {   const int stride = G * NWAVES; int it = blockIdx.x * NWAVES + wave;
            if (it < I_ADA) { p0_item(it, a.in, ws, scr, lane); it += stride; }
            if (it < P0_ITEMS) {
                TrP PA, PB, PC; float va[32], vb[32], vc[32];
                const int last = it + ((P0_ITEMS - 1 - it) / stride) * stride;
#define TR_NEXT(P_, v_, i_) do { const int ii_ = (i_) <= last ? (i_) : last; tr_params(ii_, a.in, ws, lane, P_); tr_load(P_, lane, v_); } while (0)
                TR_NEXT(PA, va, it); TR_NEXT(PB, vb, it + stride);
                for (;;) {
                    TR_NEXT(PC, vc, it + 2 * stride); tr_finish(PA, va, scr, lane); if (it + stride > last) break; it += stride;
                    TR_NEXT(PA, va, it + 2 * stride); tr_finish(PB, vb, scr, lane); if (it + stride > last) break; it += stride;
                    TR_NEXT(PB, vb, it + 2 * stride); tr_finish(PC, vc, scr, lane); if (it + stride > last) break; it += stride;
                }
            }
        }
    }
    SEAM(0);
    PH(1) p1_phase(a.in, ws, lds, G);
    SEAM(1);
    PH(2) {
        pg8::Gemm g{(const bf16_t*)(ws + WS_XN), (const bf16_t*)(ws + WS_WIN), NT, NPROJ, D_MODEL}; pg8::StaticOrder S; S.init(NT, NPROJ, G, (int)blockIdx.x);
        EpiProj E{ws};
        pg8::gemm_phase<EpiProj, pg8::StaticOrder, PG8_ALIGN, PG8_SP2>(lds, g, S, E);
#ifdef DUP_P2
        xcd_barrier(bar);
        pg8::gemm_phase<EpiProj, pg8::StaticOrder, PG8_ALIGN, PG8_SP2>(lds, g, S, E);
#endif
    }
    SEAM(2);
    PH(3) {
        for (int u = blockIdx.x; u < 256; u += G) { const int p = u >> 1, b = p >> 4, qi = p & 15, qj = 31 - qi; LAS unsigned char* lw = lds + wave * 17408;
            for (int rep = 0; rep < ((DUPSUB & 1) ? 2 : 1); ++rep) {
                if ((u & 1) == 0) { p3a_run(b, qi, 0, qi, ws, lw, wave, lane); if (qi < 15) p3a_run(b, qj, 0, 14 - qi, ws, lw, wave, lane); }
                else p3a_run(b, qj, 15 - qi, qj, ws, lw, wave, lane); } }
        for (int p = blockIdx.x; p < GLA_ITEMS / 2; p += G) { p3b_pair(p, a.in[6], a.in[7], a.out, a.out + 24 * MiB, ws, lds); if (DUPSUB & 2) p3b_pair(p, a.in[6], a.in[7], a.out, a.out + 24 * MiB, ws, lds); }
    }
    SEAM(3);
    PH(4) {
        LAS unsigned* rowctr = (LAS unsigned*)(lds + NWAVES * SEL_LDS);
        if (tid == 0) *rowctr = 0u;
        __syncthreads();
        if (wave < 2) for (int j = blockIdx.x; j < 256; j += G) { p4b_item4(j, a.out, (bf16_t*)(a.out + 16 * MiB), ws); if (DUPSUB & 8) p4b_item4(j, a.out, (bf16_t*)(a.out + 16 * MiB), ws); }
        {
            unsigned xa[32], xb[32]; LAS unsigned char* Hw = lds + wave * SEL_LDS;
#define SEL_GRAB() __builtin_amdgcn_readfirstlane((int)(lane == 0 ? __hip_atomic_fetch_add(rowctr, 1u, __ATOMIC_RELAXED, __HIP_MEMORY_SCOPE_WORKGROUP) : 0u))
#define SEL_ROW(i_) (((i_) < 64 ? (i_) >> 3 : ((i_) - 64) >> 3) * NS + ((i_) < 64 ? NS - 1 - ((int)blockIdx.x * NWAVES + ((i_) & 7)) : (int)blockIdx.x * NWAVES + ((i_) & 7)))
            int i0 = SEL_GRAB();
            p4a_load(SEL_ROW(i0 < 127 ? i0 : 127), ws, lane, xa);
#pragma unroll 1
            while (i0 < 128) {
                const int i1 = SEL_GRAB();
                p4a_load(SEL_ROW(i1 < 127 ? i1 : 127), ws, lane, xb);
                p4a_row(SEL_ROW(i0), ws, lane, xa, Hw); if (DUPSUB & 4) p4a_row(SEL_ROW(i0), ws, lane, xa, Hw);
                if (i1 >= 128) break;
                i0 = SEL_GRAB();
                p4a_load(SEL_ROW(i0 < 127 ? i0 : 127), ws, lane, xa);
                p4a_row(SEL_ROW(i1), ws, lane, xb, Hw); if (DUPSUB & 4) p4a_row(SEL_ROW(i1), ws, lane, xb, Hw);
            }
        }
    }
    SEAM(4);
    PH(5) {
        const int c = blockIdx.x; const int bh = c >> 2, sx = c & 3;
        for (int p = blockIdx.x; p < GLA_ITEMS / 2; p += G) { p5b_pair(p, a.out + 24 * MiB, a.in[8], (const bf16_t*)(a.out + 16 * MiB), ws, lds); if (DUPSUB & 32) p5b_pair(p, a.out + 24 * MiB, a.in[8], (const bf16_t*)(a.out + 16 * MiB), ws, lds); }
        if (c < 256) for (int i = 0; i < 4; ++i) { const int Q = (i == 0) ? sx : (i == 1) ? 7 - sx : (i == 2) ? 8 + sx : 15 - sx; if (wave < 4) attn_unit<false>(bh >> 3, bh & 7, Q, a.in[2], ws, lds); else attn_unit<true>(bh >> 3, bh & 7, Q, a.in[2], ws, lds);
            if (DUPSUB & 16) { if (wave < 4) attn_unit<false>(bh >> 3, bh & 7, Q, a.in[2], ws, lds); else attn_unit<true>(bh >> 3, bh & 7, Q, a.in[2], ws, lds); } }
    }
    SEAM(5);
    PH(6) {
        pg8::StaticOrder S; S.init(NT, D_MODEL, G, (int)blockIdx.x);
        { pg8::Gemm g{(const bf16_t*)(ws + WS_XN), (const bf16_t*)(ws + WS_WGAB), NT, D_MODEL, D_MODEL}; EpiSig E{ws, 0}; pg8::gemm_phase<EpiSig, pg8::StaticOrder, PG8_ALIGN, PG8_SP2>(lds, g, S, E); }
        { pg8::Gemm g{(const bf16_t*)(ws + WS_XN), (const bf16_t*)(ws + WS_WGAB) + (size_t)1024 * 1024, NT, D_MODEL, D_MODEL}; EpiSig E{ws, 1}; pg8::gemm_phase<EpiSig, pg8::StaticOrder, PG8_ALIGN, PG8_SP2>(lds, g, S, E); }
        { pg8::Gemm g{(const bf16_t*)(ws + WS_OAB), (const bf16_t*)(ws + WS_WBA), NT, D_MODEL, D_MODEL}; EpiMrgF E{ws}; pg8::gemm_phase<EpiMrgF, pg8::StaticOrder, PG8_ALIGN, PG8_SP2>(lds, g, S, E); }
    }
    SEAM(7);
    PH(8) {
        pg8::Gemm g{(const bf16_t*)(ws + WS_MRG), (const bf16_t*)(ws + WS_WOUT), NT, D_MODEL, D_MODEL}; pg8::StaticOrder S; S.init(NT, D_MODEL, G, (int)blockIdx.x);
        EpiV E{a.in[0], (const float*)(ws + WS_ADA), (bf16_t*)(ws + WS_VB)}; pg8::gemm_phase<EpiV, pg8::StaticOrder, PG8_ALIGN, PG8_SP2>(lds, g, S, E);
    }
    SEAM(8);
#ifdef DUP_P8
    p8_phase<false>(a.in, (const bf16_t*)(ws + WS_VB), (float*)(ws + 193 * MiB), (bf16_t*)(ws + 260 * MiB), ws, lds, G); xcd_barrier(bar);
#endif
    PH(9) p8_phase<true>(a.in, (const bf16_t*)(ws + WS_VB), a.out, (bf16_t*)(ws + WS_H2), ws, lds, G);
    if (IN(9) && IN(11)) { GRIDBAR(); if (TSTAMP && blockIdx.x == 0 && tid == 0) ((unsigned long long*)(ws + WS_TS))[10] = __builtin_amdgcn_s_memrealtime(); }
    PH(11) {
        build_tables(ws, lds);
        pg8::Gemm g{(const bf16_t*)(ws + WS_H2), (const bf16_t*)(ws + WS_W13), 0, 0, D_MODEL}; GroupOrder<2> S{(const LAS int*)(lds + LDS_TAB), (const LAS int*)(lds + LDS_TAB) + 64, G, (int)blockIdx.x, (const int*)(ws + WS_LIST)};
        EpiHid E{ws}; pg8::gemm_phase<EpiHid, GroupOrder<2>, PG8_ALIGN, PG8_SP2, true>(lds, g, S, E);
    }
    SEAM(11);
    PH(12) {
        build_tables(ws, lds);
        int kd = D_EXP; asm volatile("" : "+s"(kd));
        pg8::Gemm g{(const bf16_t*)(ws + WS_HID), (const bf16_t*)(ws + WS_W2), 0, 0, kd}; GroupOrder<4> S{(const LAS int*)(lds + LDS_TAB), (const LAS int*)(lds + LDS_TAB) + 64, G, (int)blockIdx.x, nullptr};
        EpiY E{ws}; pg8::gemm_phase<EpiY, GroupOrder<4>, PG8_ALIGN, PG8_SP2>(lds, g, S, E);
    }
    SEAM(12);
#ifdef DUP_P12
    p12_phase(a.in, (const bf16_t*)(ws + WS_VB), (float*)(ws + 193 * MiB), ws, lds, G); xcd_barrier(bar);
#endif
    PH(13) p12_phase(a.in, (const bf16_t*)(ws + WS_VB), a.out, ws, lds, G);
    if (TSTAMP) { xcd_barrier(bar); if (blockIdx.x == 0 && tid == 0) ((unsigned long long*)(ws + WS_TS))[14] = __builtin_amdgcn_s_memrealtime(); }
#ifdef EXTRA_SYNCS
    for (int i_ = 0; i_ < EXTRA_SYNCS; ++i_) GRIDBAR();
#endif
#undef IN
#undef SEAM
#undef PH
}
}
#if TSTAMP
__global__ void kd_ts(float* out, long n, const unsigned long long* ts, int ka, int kb) {
    const float da = (ka == 14) ? (float)(ts[14] - ts[0]) * 0.01f / 10.f : (float)(ts[ka + 1] - ts[ka]) * 0.01f;
    const float sc = 1.f + da * 0.0005f;
    for (long i = (long)blockIdx.x * blockDim.x + threadIdx.x; i < n; i += (long)gridDim.x * blockDim.x) out[i] *= sc;
}
#endif
extern "C" void kernel_launch(void* const* d_in, const int* in_sizes, int n_in, void* d_out, int out_size,
                              void* d_ws, size_t ws_size, hipStream_t stream) {
    using namespace fk;
    static int grid = 0;
    if (grid == 0) {
        int dev = 0, cus = 0, per_cu = 0; (void)hipGetDevice(&dev); (void)hipDeviceGetAttribute(&cus, hipDeviceAttributeMultiprocessorCount, dev);
        (void)hipFuncSetAttribute((const void*)mk_fwd, hipFuncAttributeMaxDynamicSharedMemorySize, LDS_BYTES);
        (void)hipOccupancyMaxActiveBlocksPerMultiprocessor(&per_cu, (const void*)mk_fwd, NTHREADS, LDS_BYTES);
        (void)hipGetLastError();
        grid = cus * (per_cu >= 1 ? 1 : 1);
        if (ws_size < 512 * MiB) { fprintf(stderr, "kernel_launch: workspace too small\n"); grid = -1; }
    }
    if (grid < 0) return;
    (void)hipMemsetAsync((unsigned char*)d_ws + WS_BAR, 0, 16384, stream);
    Args a{}; for (int i = 0; i < 23; ++i) a.in[i] = (const float*)d_in[i]; a.out = (float*)d_out; a.ws = (unsigned char*)d_ws; a.ph_lo = 0; a.ph_hi = NPH;
    void* args[] = {&a};
    hipError_t e = hipLaunchCooperativeKernel((const void*)mk_fwd, dim3(grid), dim3(NTHREADS), args, LDS_BYTES, stream);
    if (e != hipSuccess) fprintf(stderr, "cooperative launch failed: %s\n", hipGetErrorString(e));
#if TSTAMP
    hipLaunchKernelGGL(kd_ts, dim3(1024), dim3(256), 0, stream, (float*)d_out, (long)out_size, (const unsigned long long*)((unsigned char*)d_ws + WS_TS), TS_A, TS_B);
#endif
}
```
